# Optimizing an MI355X kernel written in HIP

```python
import math
import jax, jax.numpy as jnp
from jax import lax
import numpy as np

D_MODEL = 1024
BATCH = 16
SEQ = 2048
DEPTH = 2

NSA_DH = 64
NSA_HEADS = (D_MODEL // 2) // NSA_DH
NSA_KV_GROUPS = 2
NSA_HPG = NSA_HEADS // NSA_KV_GROUPS
NSA_WIDTH = NSA_HEADS * NSA_DH
NSA_KV_WIDTH = NSA_KV_GROUPS * NSA_DH
CMP_LEN = 32
CMP_STRIDE = 16
CMP_HIDDEN = 2 * NSA_DH
SLC_BLOCK = 64
N_SELECT = 16
WINDOW = 512
Q_BLOCK = 64
ROPE_THETA = 500000.0
ROPE_DIMS = NSA_DH // 4
MLSTM_HEADS = 4
MLSTM_DH = (D_MODEL - NSA_WIDTH) // MLSTM_HEADS
MLSTM_WIDTH = MLSTM_HEADS * MLSTM_DH
MLSTM_CHUNK = 64
MLSTM_CONV = 4
D_MIX = NSA_WIDTH + MLSTM_WIDTH
D_FF = ((8 * D_MODEL // 3 + 127) // 128) * 128
EPS = 1e-6
NEG_INF = -1e30
FORCE_SCORE = 1e9
IN_SIZES = [NSA_WIDTH] + [NSA_KV_WIDTH] * 6 + [3 * NSA_HEADS] + [MLSTM_WIDTH] * 4 + [MLSTM_HEADS] * 2
IN_COLS = sum(IN_SIZES)
IN_SPLITS = [int(s) for s in np.cumsum(IN_SIZES)[:-1]]

kernel_name = 'hybrid_nsa_mlstm_macaron_sandwich'


def rms_norm(x, g):
    x32 = x.astype(jnp.float32)
    y = x32 * lax.rsqrt(jnp.mean(x32 * x32, axis=-1, keepdims=True) + EPS)
    return (y * g.astype(jnp.float32)).astype(x.dtype)


def swiglu(x, w_gu, w_down):
    gate, up = jnp.split(x @ w_gu, 2, axis=-1)
    return (jax.nn.silu(gate) * up) @ w_down


def rope_tables(seq):
    pos = jnp.arange(seq, dtype=jnp.float32)
    inv_freq = ROPE_THETA ** (-jnp.arange(0, ROPE_DIMS, 2, dtype=jnp.float32) / ROPE_DIMS)
    ang = pos[:, None] * inv_freq[None, :]
    return jnp.cos(ang), jnp.sin(ang)


def partial_rope(x, cos, sin):
    xr, xp = x[..., :ROPE_DIMS], x[..., ROPE_DIMS:]
    x1, x2 = jnp.split(xr, 2, axis=-1)
    c, s = cos[None, :, None, :], sin[None, :, None, :]
    rot = jnp.concatenate([x1 * c - x2 * s, x2 * c + x1 * s], axis=-1).astype(x.dtype)
    return jnp.concatenate([rot, xp], axis=-1)


def compress_blocks(tok, pe, w1, w2):
    b, s = tok.shape[:2]
    n_cmp = (s - CMP_LEN) // CMP_STRIDE + 1
    idx = np.arange(n_cmp)[:, None] * CMP_STRIDE + np.arange(CMP_LEN)[None, :]
    blocks = tok[:, idx] + pe[None, None, :, None, :].astype(tok.dtype)
    flat = blocks.transpose(0, 3, 1, 2, 4).reshape(b, NSA_KV_GROUPS, n_cmp, CMP_LEN * NSA_DH)
    return jax.nn.gelu(flat @ w1) @ w2


def nsa_group(q, k_cmp, v_cmp, k_slc, v_slc, k_win, v_win, gates, pe, w1, w2, cos, sin):
    b, s = q.shape[:2]
    dt = q.dtype
    q = partial_rope(q.reshape(b, s, NSA_HEADS, NSA_DH), cos, sin)
    q = q.reshape(b, s, NSA_KV_GROUPS, NSA_HPG, NSA_DH)
    kv_shape = (b, s, NSA_KV_GROUPS, NSA_DH)
    k_slc = partial_rope(k_slc.reshape(kv_shape), cos, sin)
    k_win = partial_rope(k_win.reshape(kv_shape), cos, sin)
    v_slc = v_slc.reshape(kv_shape)
    v_win = v_win.reshape(kv_shape)
    kc = compress_blocks(k_cmp.reshape(kv_shape), pe[0], w1[0], w2[0])
    vc = compress_blocks(v_cmp.reshape(kv_shape), pe[1], w1[1], w2[1])
    n_cmp = kc.shape[2]
    cmp_end = jnp.arange(n_cmp) * CMP_STRIDE + CMP_LEN - 1
    n_slc = s // SLC_BLOCK
    n_sel = min(N_SELECT, n_slc)
    ci = np.arange(n_cmp)[:, None] * CMP_STRIDE
    sj = np.arange(n_slc)[None, :] * SLC_BLOCK
    overlap = jnp.asarray(((ci < sj + SLC_BLOCK) & (ci + CMP_LEN > sj)).astype(np.float32))
    ks_blk = k_slc.reshape(b, n_slc, SLC_BLOCK, NSA_KV_GROUPS, NSA_DH).transpose(0, 3, 1, 2, 4)
    vs_blk = v_slc.reshape(b, n_slc, SLC_BLOCK, NSA_KV_GROUPS, NSA_DH).transpose(0, 3, 1, 2, 4)
    kw_pad = jnp.pad(k_win, ((0, 0), (WINDOW, 0), (0, 0), (0, 0)))
    vw_pad = jnp.pad(v_win, ((0, 0), (WINDOW, 0), (0, 0), (0, 0)))
    scale = NSA_DH ** -0.5
    n_qb = s // Q_BLOCK
    q_blocks = jnp.moveaxis(q.reshape(b, n_qb, Q_BLOCK, NSA_KV_GROUPS, NSA_HPG, NSA_DH), 1, 0)
    b_ix = jnp.arange(b)[:, None, None, None]
    g_ix = jnp.arange(NSA_KV_GROUPS)[None, :, None, None]
    blk = jnp.arange(n_slc)
    r_off = jnp.arange(SLC_BLOCK)

    def block_fn(args):
        c, qb = args
        t = c * Q_BLOCK + jnp.arange(Q_BLOCK)
        s_c = jnp.einsum('bqghd,bgnd->bghqn', qb, kc).astype(jnp.float32) * scale
        valid_c = cmp_end[None, :] <= t[:, None]
        p_c = jax.nn.softmax(jnp.where(valid_c, s_c, NEG_INF), axis=-1)
        p_c = p_c * jnp.any(valid_c, axis=-1)[:, None].astype(jnp.float32)
        o_c = jnp.einsum('bghqn,bgnd->bqghd', p_c.astype(dt), vc)
        imp = jnp.einsum('bghqn,nj->bgqj', p_c, overlap)
        cur = t // SLC_BLOCK
        forced = (blk[None, :] == 0) | (blk[None, :] == cur[:, None]) | (blk[None, :] == cur[:, None] - 1)
        blk_valid = blk[None, :] * SLC_BLOCK <= t[:, None]
        imp = jnp.where(forced, FORCE_SCORE, imp)
        imp = jnp.where(blk_valid, imp, NEG_INF)
        _, idx = lax.top_k(imp, n_sel)
        k_sel = ks_blk[b_ix, g_ix, idx]
        v_sel = vs_blk[b_ix, g_ix, idx]
        tok_pos = idx[..., None] * SLC_BLOCK + r_off
        valid_s = tok_pos <= t[None, None, :, None, None]
        s_s = jnp.einsum('bqghd,bgqnrd->bghqnr', qb, k_sel).astype(jnp.float32) * scale
        s_s = jnp.where(valid_s[:, :, None], s_s, NEG_INF)
        p_s = jax.nn.softmax(s_s.reshape(s_s.shape[:4] + (-1,)), axis=-1).reshape(s_s.shape)
        o_s = jnp.einsum('bghqnr,bgqnrd->bqghd', p_s.astype(dt), v_sel)
        start = c * Q_BLOCK
        k_w = lax.dynamic_slice_in_dim(kw_pad, start, Q_BLOCK + WINDOW, axis=1)
        v_w = lax.dynamic_slice_in_dim(vw_pad, start, Q_BLOCK + WINDOW, axis=1)
        kpos = start - WINDOW + jnp.arange(Q_BLOCK + WINDOW)
        valid_w = (kpos[None, :] <= t[:, None]) & (kpos[None, :] > t[:, None] - WINDOW) & (kpos[None, :] >= 0)
        s_w = jnp.einsum('bqghd,bkgd->bghqk', qb, k_w).astype(jnp.float32) * scale
        p_w = jax.nn.softmax(jnp.where(valid_w, s_w, NEG_INF), axis=-1)
        o_w = jnp.einsum('bghqk,bkgd->bqghd', p_w.astype(dt), v_w)
        return o_c, o_s, o_w

    o_c, o_s, o_w = lax.map(block_fn, (jnp.arange(n_qb), q_blocks))
    unblock = lambda o: jnp.moveaxis(o, 0, 1).reshape(b, s, NSA_HEADS, NSA_DH).astype(jnp.float32)
    g = jax.nn.sigmoid(gates.astype(jnp.float32)).reshape(b, s, 3, NSA_HEADS, 1)
    out = g[:, :, 0] * unblock(o_c) + g[:, :, 1] * unblock(o_s) + g[:, :, 2] * unblock(o_w)
    return out.reshape(b, s, NSA_WIDTH).astype(dt)


def mlstm_group(q, k, v, o_pre, i_pre, f_pre, conv_w, conv_b, norm_g, i_bias, f_bias):
    b, s = q.shape[:2]
    dt = q.dtype
    qk = jnp.concatenate([q, k], axis=-1)
    ch = qk.shape[-1]
    qk = lax.conv_general_dilated(qk, conv_w.astype(qk.dtype)[:, None, :], window_strides=(1,),
                                  padding=[(MLSTM_CONV - 1, 0)], dimension_numbers=('NWC', 'WIO', 'NWC'),
                                  feature_group_count=ch) + conv_b.astype(qk.dtype)
    q, k = jnp.split(jax.nn.silu(qk), 2, axis=-1)
    heads = lambda a: a.reshape(b, s, MLSTM_HEADS, MLSTM_DH).transpose(0, 2, 1, 3).astype(jnp.float32)
    q, k, v = heads(q), heads(k) * (MLSTM_DH ** -0.5), heads(v)
    i_log = (i_pre.astype(jnp.float32) + i_bias.astype(jnp.float32)).transpose(0, 2, 1)
    f_log = jax.nn.log_sigmoid(f_pre.astype(jnp.float32) + f_bias.astype(jnp.float32)).transpose(0, 2, 1)
    L = MLSTM_CHUNK
    nc = s // L
    chunk = lambda a: jnp.moveaxis(a.reshape(a.shape[:2] + (nc, L) + a.shape[3:]), 2, 0)
    xs = (chunk(q), chunk(k), chunk(v), chunk(i_log), chunk(f_log))
    tril = jnp.tril(jnp.ones((L, L), dtype=bool))

    def step(carry, inp):
        C, n, m = carry
        qc, kc, vc, ic, fc = inp
        bcum = jnp.cumsum(fc, axis=-1)
        D = jnp.where(tril, bcum[..., :, None] - bcum[..., None, :] + ic[..., None, :], NEG_INF)
        inter = bcum + m[..., None]
        m_t = jnp.maximum(jnp.max(D, axis=-1), inter)
        w_in = jnp.exp(D - m_t[..., None])
        w_prev = jnp.exp(inter - m_t)
        sc = jnp.einsum('bhtd,bhsd->bhts', qc, kc) * w_in
        num = jnp.einsum('bhts,bhsd->bhtd', sc, vc) + w_prev[..., None] * jnp.einsum('bhtd,bhde->bhte', qc, C)
        den = jnp.sum(sc, axis=-1) + w_prev * jnp.einsum('bhtd,bhd->bht', qc, n)
        h = num / jnp.maximum(jnp.abs(den), jnp.exp(-m_t))[..., None]
        b_last = bcum[..., -1]
        dec = b_last[..., None] - bcum + ic
        m_new = jnp.maximum(b_last + m, jnp.max(dec, axis=-1))
        wk = jnp.exp(dec - m_new[..., None])
        carry_scale = jnp.exp(b_last + m - m_new)
        C_new = carry_scale[..., None, None] * C + jnp.einsum('bhs,bhsd,bhse->bhde', wk, kc, vc)
        n_new = carry_scale[..., None] * n + jnp.einsum('bhs,bhsd->bhd', wk, kc)
        return (C_new, n_new, m_new), h

    init = (jnp.zeros((b, MLSTM_HEADS, MLSTM_DH, MLSTM_DH), jnp.float32),
            jnp.zeros((b, MLSTM_HEADS, MLSTM_DH), jnp.float32),
            jnp.zeros((b, MLSTM_HEADS), jnp.float32))
    _, hs = lax.scan(step, init, xs)
    h = jnp.moveaxis(hs, 0, 2).reshape(b, MLSTM_HEADS, s, MLSTM_DH).transpose(0, 2, 1, 3)
    h = h * lax.rsqrt(jnp.mean(h * h, axis=-1, keepdims=True) + EPS)
    h = h * norm_g.astype(jnp.float32).reshape(MLSTM_HEADS, MLSTM_DH)
    o = jax.nn.sigmoid(o_pre.astype(jnp.float32)).reshape(b, s, MLSTM_HEADS, MLSTM_DH)
    return (h * o).reshape(b, s, MLSTM_WIDTH).astype(dt)


def setup_inputs(seed: int = 0) -> dict:
    key = jax.random.key(seed)
    ks = jax.random.split(key, 16)
    nrm = lambda k, shape, sc: jax.random.normal(k, shape, jnp.float32) * sc
    return {
        'x': nrm(ks[0], (BATCH, SEQ, D_MODEL), 1.0),
        'norm_g': 1.0 + nrm(ks[1], (DEPTH, 6, D_MODEL), 0.02),
        'ffn1_w_gu': nrm(ks[2], (DEPTH, D_MODEL, 2 * D_FF), D_MODEL ** -0.5),
        'ffn1_w_down': nrm(ks[3], (DEPTH, D_FF, D_MODEL), D_FF ** -0.5),
        'ffn2_w_gu': nrm(ks[4], (DEPTH, D_MODEL, 2 * D_FF), D_MODEL ** -0.5),
        'ffn2_w_down': nrm(ks[5], (DEPTH, D_FF, D_MODEL), D_FF ** -0.5),
        'mix_w_in': nrm(ks[6], (DEPTH, D_MODEL, IN_COLS), D_MODEL ** -0.5),
        'mix_w_out': nrm(ks[7], (DEPTH, D_MIX, D_MODEL), D_MIX ** -0.5),
        'nsa_cmp_pe': nrm(ks[8], (DEPTH, 2, CMP_LEN, NSA_DH), 0.02),
        'nsa_cmp_w1': nrm(ks[9], (DEPTH, 2, CMP_LEN * NSA_DH, CMP_HIDDEN), (CMP_LEN * NSA_DH) ** -0.5),
        'nsa_cmp_w2': nrm(ks[10], (DEPTH, 2, CMP_HIDDEN, NSA_DH), CMP_HIDDEN ** -0.5),
        'mlstm_conv_w': nrm(ks[11], (DEPTH, MLSTM_CONV, 2 * MLSTM_WIDTH), MLSTM_CONV ** -0.5),
        'mlstm_conv_b': nrm(ks[12], (DEPTH, 2 * MLSTM_WIDTH), 0.02),
        'mlstm_i_bias': nrm(ks[13], (DEPTH, MLSTM_HEADS), 0.1),
        'mlstm_f_bias': jnp.linspace(3.0, 6.0, MLSTM_HEADS, dtype=jnp.float32)[None, :] + nrm(ks[14], (DEPTH, MLSTM_HEADS), 0.1),
        'mlstm_norm_g': 1.0 + nrm(ks[15], (DEPTH, MLSTM_WIDTH), 0.02),
    }


def reference(x, norm_g, ffn1_w_gu, ffn1_w_down, ffn2_w_gu, ffn2_w_down, mix_w_in, mix_w_out,
              nsa_cmp_pe, nsa_cmp_w1, nsa_cmp_w2, mlstm_conv_w, mlstm_conv_b, mlstm_i_bias,
              mlstm_f_bias, mlstm_norm_g):
    cos, sin = rope_tables(x.shape[1])
    for l in range(DEPTH):
        g = norm_g[l]
        h = swiglu(rms_norm(x, g[0]), ffn1_w_gu[l], ffn1_w_down[l])
        x = x + 0.5 * rms_norm(h, g[1])
        u = rms_norm(x, g[2])
        (nq, kcm, vcm, ksl, vsl, kwn, vwn, ngate,
         mq, mk, mv, mo, mi, mf) = jnp.split(u @ mix_w_in[l], IN_SPLITS, axis=-1)
        y_nsa = nsa_group(nq, kcm, vcm, ksl, vsl, kwn, vwn, ngate,
                          nsa_cmp_pe[l], nsa_cmp_w1[l], nsa_cmp_w2[l], cos, sin)
        y_mlstm = mlstm_group(mq, mk, mv, mo, mi, mf, mlstm_conv_w[l], mlstm_conv_b[l],
                              mlstm_norm_g[l], mlstm_i_bias[l], mlstm_f_bias[l])
        h = jnp.concatenate([y_nsa, y_mlstm], axis=-1) @ mix_w_out[l]
        x = x + rms_norm(h, g[3])
        h = swiglu(rms_norm(x, g[4]), ffn2_w_gu[l], ffn2_w_down[l])
        x = x + 0.5 * rms_norm(h, g[5])
    return x
```

```cpp
#include <hip/hip_runtime.h>
#include <cstdio>
#include <cstdint>
namespace pg8 {
#define PG8_LAS __attribute__((address_space(3)))
typedef unsigned short bf16_t;
typedef short bf16x8 __attribute__((ext_vector_type(8)));
typedef float f32x4 __attribute__((ext_vector_type(4)));
typedef unsigned u32x4 __attribute__((ext_vector_type(4)));
constexpr int BM = 256, BK = 64, HALF = 128, HTB = HALF * BK * 2  , STAGE_BYTES = 8 * HTB, NXCD = 8, WGM = 8;

__host__ __device__ __forceinline__ int lds_byte(int r, int c) { const int st = (r >> 4) * 2 + (c >> 5), rr = r & 15, cc = c & 31, ob = rr * 64 + cc * 2; return st * 1024 + (ob ^ (((ob >> 9) & 1) << 5)); }
__host__ __device__ __forceinline__ void stage_rc(int b, int& R, int& C) { const int st = b / 1024, sb = b % 1024, swz = sb ^ (((sb >> 9) & 1) << 5); R = (st >> 1) * 16 + swz / 64; C = (st & 1) * 32 + (swz % 64) / 2; }
__host__ __device__ __forceinline__ int perm32(int rho) { const int n = rho >> 4, i = rho & 15; return 8 * (i >> 2) + 4 * n + (i & 3); }

struct Unit { int pm, pn; };
struct Gemm { const bf16_t* A; const bf16_t* Bt; int M, N, K; };

struct StaticOrder {
    int nM, nN, nwg, G, c;
    __host__ __device__ void init(int M, int N, int G_, int c_) { nM = M / BM; nN = N / BM; nwg = nM * nN; G = G_; c = c_; }
    __host__ __device__ bool next(int i, Unit& u) const {
        const long L = (long)i * G + c; if (L >= nwg) return false;
        int wgid = (int)L; { const int q = nwg / NXCD, r = nwg % NXCD, xcd = wgid % NXCD, off = wgid / NXCD; wgid = (xcd < r ? xcd * (q + 1) : r * (q + 1) + (xcd - r) * q) + off; }
        const int nig = WGM * nN, gid = wgid / nig, fm = gid * WGM, gsz = (nM - fm) < WGM ? (nM - fm) : WGM;
        u.pm = fm + ((wgid % nig) % gsz); u.pn = (wgid % nig) / gsz; return true;
    }
    __device__ __forceinline__ void a_ready(const Unit&) const {}
    __device__ __forceinline__ void done(const Unit&) const {}
};

__device__ __forceinline__ unsigned cvt_pk_bf16(float lo, float hi) { unsigned r; asm volatile("v_cvt_pk_bf16_f32 %0, %1, %2" : "=v"(r) : "v"(lo), "v"(hi)); return r; }
typedef float f32x2 __attribute__((ext_vector_type(2)));
__device__ __forceinline__ f32x2 gelu_pk(f32x2 v) {
    const f32x2 av = __builtin_elementwise_abs(v), d = av * 0.2316418882f + 1.0f;
    f32x2 t; t.x = __builtin_amdgcn_rcpf(d.x); t.y = __builtin_amdgcn_rcpf(d.y);
    f32x2 q = t * 0.5307027145f + (-0.7265760135f); q = q * t + 0.7107068705f; q = q * t + (-0.142248368f); q = q * t + 0.127414796f; q = q * t;
    const f32x2 s = (v * v) * (-0.72134752044f);
    f32x2 e; e.x = __builtin_amdgcn_exp2f(s.x); e.y = __builtin_amdgcn_exp2f(s.y);
    const f32x2 m = v * (q * e), r = v - m;
    f32x2 o; o.x = v.x < 0.f ? m.x : r.x; o.y = v.y < 0.f ? m.y : r.y; return o;
}

template <int ACT  > struct EpiBf16 {
    static constexpr bool PERM = true, AFTER_DRAIN = false; static_assert(ACT == 0 || ACT == 1, "EpiBf16: ACT is 0 (none) or 1 (gelu_pk)");
    bf16_t* O; int ldc; const float* bias; int split_cols; size_t split_stride; float scale0;
    __device__ __forceinline__ void operator()(const f32x4 (&acc)[2][2][4][2], const Unit& u, int wr, int wc, int fr, int fq) const {
        const int row0 = u.pm * BM + wr * 64 + fr; int colt = u.pn * BM; bf16_t* base = O;
        float sc = 1.f; if (split_cols) { const int t = colt / split_cols; base += (size_t)t * split_stride; colt -= t * split_cols; if (t == 0) sc = scale0; }
        const int col0 = colt + wc * 32 + 8 * fq, bcol0 = u.pn * BM + wc * 32 + 8 * fq;
        f32x4 bv[2][2];
#pragma unroll
        for (int bj = 0; bj < 2; ++bj)
#pragma unroll
            for (int n = 0; n < 2; ++n) bv[bj][n] = bias ? *(const f32x4*)(bias + bcol0 + bj * HALF + 4 * n) : (f32x4){0.f, 0.f, 0.f, 0.f};
#pragma unroll
        for (int ai = 0; ai < 2; ++ai)
#pragma unroll
            for (int m = 0; m < 4; ++m) { bf16_t* rowp = base + (size_t)(row0 + ai * HALF + m * 16) * ldc + col0;
#pragma unroll
                for (int bj = 0; bj < 2; ++bj) { f32x4 v0 = acc[ai][bj][m][0] + bv[bj][0], v1 = acc[ai][bj][m][1] + bv[bj][1];
                    if (ACT == 1) { f32x2 a = gelu_pk((f32x2){v0[0], v0[1]}), b = gelu_pk((f32x2){v0[2], v0[3]}), c = gelu_pk((f32x2){v1[0], v1[1]}), d = gelu_pk((f32x2){v1[2], v1[3]});
                        v0 = (f32x4){a.x, a.y, b.x, b.y}; v1 = (f32x4){c.x, c.y, d.x, d.y}; }
                    v0 = v0 * sc; v1 = v1 * sc; u32x4 w; w.x = cvt_pk_bf16(v0[0], v0[1]); w.y = cvt_pk_bf16(v0[2], v0[3]); w.z = cvt_pk_bf16(v1[0], v1[1]); w.w = cvt_pk_bf16(v1[2], v1[3]);
                    *(u32x4*)(rowp + bj * HALF) = w; } }
    }
};
template <class Epi, class Sched, bool ALIGN_EPI = false, bool SP2 = false>
__device__ __forceinline__ void gemm_phase(PG8_LAS unsigned char* lds, const Gemm g, const Sched& S, const Epi& E) {
    int tid_l = threadIdx.x; asm volatile("" : "+v"(tid_l));
    const int tid = tid_l, wid = __builtin_amdgcn_readfirstlane(tid >> 6), lane = tid & 63, wr = wid >> 2, wc = wid & 3, fr = lane & 15, fq = lane >> 4;
    const int K = g.K, nt = K / BK;
    unsigned voffA[2], voffB[2];
#pragma unroll
    for (int i = 0; i < 2; ++i) { int R, C; stage_rc(tid * 16 + i * 8192, R, C); const int Rb = Epi::PERM ? ((R & ~31) + perm32(R & 31)) : R;
        voffA[i] = (unsigned)(R * K + C) * 2u; voffB[i] = (unsigned)(Rb * K + C) * 2u; }
    const size_t kstep = (size_t)(BK * 2);
    const size_t hstep = (size_t)HALF * K * 2;
    const size_t tstep = 2 * hstep;
    const unsigned ldsw = (unsigned)wid * 1024u;
    const int aoff = lds_byte(wr * 64 + fr, fq * 8), boff = lds_byte(wc * 32 + fr, fq * 8);
#define PG8_SA(b, h) (((b) * 2 + (h)) * HTB)
#define PG8_SB(b, h) ((4 + (b) * 2 + (h)) * HTB)
#define PG8_STAGE(bufoff, gbase, voff) do { _Pragma("unroll") for (int _i = 0; _i < 2; ++_i) \
        __builtin_amdgcn_global_load_lds((const unsigned*)((const char*)(gbase) + (voff)[_i]), (PG8_LAS unsigned*)(lds + (bufoff) + ldsw + _i * 8192), 16, 0, 0); } while (0)
#define PG8_LDA(dst, b, h) do { _Pragma("unroll") for (int m = 0; m < 4; ++m) _Pragma("unroll") for (int k = 0; k < 2; ++k) dst[m][k] = *(const PG8_LAS bf16x8*)(lds + PG8_SA(b, h) + aoff + m * 2048 + k * 1024); } while (0)
#define PG8_LDB(dst, b, h) do { _Pragma("unroll") for (int n = 0; n < 2; ++n) _Pragma("unroll") for (int k = 0; k < 2; ++k) dst[n][k] = *(const PG8_LAS bf16x8*)(lds + PG8_SB(b, h) + boff + n * 2048 + k * 1024); } while (0)
#define PG8_MMA(ai, bj, At, Bt) do { __builtin_amdgcn_s_setprio(1); _Pragma("unroll") for (int m = 0; m < 4; ++m) _Pragma("unroll") for (int n = 0; n < 2; ++n) _Pragma("unroll") for (int k = 0; k < 2; ++k) \
        acc[ai][bj][m][n] = __builtin_amdgcn_mfma_f32_16x16x32_bf16(Bt[n][k], At[m][k], acc[ai][bj][m][n], 0, 0, 0); __builtin_amdgcn_s_setprio(0); } while (0)
#define PG8_WAIT_V(n) asm volatile("s_waitcnt vmcnt(" #n ")" ::: "memory")
#define PG8_WAIT_L(n) asm volatile("s_waitcnt lgkmcnt(" #n ")" ::: "memory")
#define PG8_BAR __builtin_amdgcn_s_barrier()
#define PG8_SCHED __builtin_amdgcn_sched_barrier(0)
    Unit cur, nxt; int ui = 0;
    if (!S.next(0, cur)) return;
    f32x4 acc[2][2][4][2];
#pragma unroll
    for (int a = 0; a < 2; ++a)
#pragma unroll
        for (int b = 0; b < 2; ++b)
#pragma unroll
            for (int m = 0; m < 4; ++m)
#pragma unroll
                for (int n = 0; n < 2; ++n) acc[a][b][m][n] = (f32x4){0.f, 0.f, 0.f, 0.f};
    bf16x8 At[4][2], B0[2][2], B1[2][2];
    const char* cA = (const char*)g.A + (size_t)cur.pm * tstep; const char* cB = (const char*)g.Bt + (size_t)cur.pn * tstep;
    S.a_ready(cur);
    if constexpr (SP2) {
        PG8_STAGE(PG8_SB(0, 0), cB, voffB); PG8_STAGE(PG8_SB(0, 1), cB + hstep, voffB); PG8_STAGE(PG8_SA(0, 0), cA, voffA); PG8_STAGE(PG8_SA(0, 1), cA + hstep, voffA);
        if (wr == 1) PG8_BAR;
        PG8_WAIT_V(2); PG8_BAR;
        PG8_STAGE(PG8_SB(1, 0), cB + kstep, voffB); PG8_STAGE(PG8_SA(1, 0), cA + kstep, voffA); PG8_STAGE(PG8_SB(1, 1), cB + hstep + kstep, voffB);
        PG8_WAIT_V(6); PG8_BAR;
    } else {
        PG8_STAGE(PG8_SB(0, 0), cB, voffB); PG8_STAGE(PG8_SA(0, 0), cA, voffA); PG8_STAGE(PG8_SB(0, 1), cB + hstep, voffB); PG8_STAGE(PG8_SA(0, 1), cA + hstep, voffA);
        if (wr == 1) PG8_BAR;
        PG8_WAIT_V(4); PG8_BAR;
        PG8_STAGE(PG8_SB(1, 0), cB + kstep, voffB); PG8_STAGE(PG8_SA(1, 0), cA + kstep, voffA); PG8_STAGE(PG8_SB(1, 1), cB + hstep + kstep, voffB);
        PG8_WAIT_V(6); PG8_BAR;
    }
    for (;;) {
        const bool has_next = S.next(ui + 1, nxt);
        const char* nA = has_next ? (const char*)g.A + (size_t)nxt.pm * tstep : cA; const char* nB = has_next ? (const char*)g.Bt + (size_t)nxt.pn * tstep : cB;
        for (int t = 0; t < nt; t += 2) {
            const bool last = (t == nt - 2);
            const char* a1 = cA + (size_t)(t + 1) * kstep;
            const char* a2 = last ? nA : cA + (size_t)(t + 2) * kstep; const char* b2 = last ? nB : cB + (size_t)(t + 2) * kstep;
            const char* a3 = a2 + kstep; const char* b3 = b2 + kstep;
            if (last && has_next) S.a_ready(nxt);
            if constexpr (SP2) {
            PG8_LDB(B0, 0, 0); PG8_LDB(B1, 0, 1); PG8_SCHED; PG8_LDA(At, 0, 0); PG8_STAGE(PG8_SA(1, 1), a1 + hstep, voffA);
            PG8_WAIT_V(8); PG8_WAIT_L(0); PG8_BAR; PG8_MMA(0, 0, At, B0); PG8_MMA(0, 1, At, B1); PG8_BAR; PG8_SCHED;
            PG8_LDA(At, 0, 1); PG8_STAGE(PG8_SB(0, 0), b2, voffB); PG8_STAGE(PG8_SB(0, 1), b2 + hstep, voffB); PG8_STAGE(PG8_SA(0, 0), a2, voffA);
            PG8_WAIT_V(8); PG8_WAIT_L(0); PG8_BAR; PG8_MMA(1, 0, At, B0); PG8_MMA(1, 1, At, B1); PG8_BAR; PG8_SCHED;
            PG8_LDB(B0, 1, 0); PG8_LDB(B1, 1, 1); PG8_SCHED; PG8_LDA(At, 1, 0); PG8_STAGE(PG8_SA(0, 1), a2 + hstep, voffA);
            PG8_WAIT_V(8); PG8_WAIT_L(0); PG8_BAR; PG8_MMA(0, 0, At, B0); PG8_MMA(0, 1, At, B1); PG8_BAR; PG8_SCHED;
            PG8_LDA(At, 1, 1); PG8_STAGE(PG8_SB(1, 0), b3, voffB); PG8_STAGE(PG8_SB(1, 1), b3 + hstep, voffB); PG8_STAGE(PG8_SA(1, 0), a3, voffA);
            PG8_WAIT_V(8); PG8_WAIT_L(0); PG8_BAR; PG8_MMA(1, 0, At, B0); PG8_MMA(1, 1, At, B1); PG8_BAR; PG8_SCHED;
            } else {
            PG8_LDB(B0, 0, 0); PG8_SCHED; PG8_LDA(At, 0, 0); PG8_STAGE(PG8_SA(1, 1), a1 + hstep, voffA);
            PG8_WAIT_L(8); PG8_BAR; PG8_WAIT_L(0); PG8_MMA(0, 0, At, B0); PG8_BAR; PG8_SCHED;
            PG8_LDB(B1, 0, 1); PG8_STAGE(PG8_SB(0, 0), b2, voffB);
            PG8_BAR; PG8_WAIT_L(0); PG8_MMA(0, 1, At, B1); PG8_BAR;
            PG8_LDA(At, 0, 1); PG8_STAGE(PG8_SA(0, 0), a2, voffA);
            PG8_BAR; PG8_WAIT_L(0); PG8_MMA(1, 0, At, B0); PG8_BAR; PG8_SCHED;
            PG8_STAGE(PG8_SB(0, 1), b2 + hstep, voffB);
            PG8_WAIT_V(6); PG8_BAR; PG8_MMA(1, 1, At, B1); PG8_BAR;
            PG8_LDB(B0, 1, 0); PG8_SCHED; PG8_LDA(At, 1, 0); PG8_STAGE(PG8_SA(0, 1), a2 + hstep, voffA);
            PG8_WAIT_L(8); PG8_BAR; PG8_WAIT_L(0); PG8_MMA(0, 0, At, B0); PG8_BAR; PG8_SCHED;
            PG8_LDB(B1, 1, 1); PG8_STAGE(PG8_SB(1, 0), b3, voffB);
            PG8_BAR; PG8_WAIT_L(0); PG8_MMA(0, 1, At, B1); PG8_BAR;
            PG8_LDA(At, 1, 1); PG8_STAGE(PG8_SA(1, 0), a3, voffA);
            PG8_BAR; PG8_WAIT_L(0); PG8_MMA(1, 0, At, B0); PG8_BAR; PG8_SCHED;
            PG8_STAGE(PG8_SB(1, 1), b3 + hstep, voffB);
            PG8_WAIT_V(6); PG8_BAR; PG8_MMA(1, 1, At, B1); PG8_BAR;
            }
        }
        if constexpr (ALIGN_EPI) { if (wr == 0) PG8_BAR; }
        if constexpr (!Epi::AFTER_DRAIN) { E(acc, cur, wr, wc, fr, fq); S.done(cur); }
        if (!has_next) break;
#pragma unroll
        for (int a = 0; a < 2; ++a)
#pragma unroll
            for (int b = 0; b < 2; ++b)
#pragma unroll
                for (int m = 0; m < 4; ++m)
#pragma unroll
                    for (int n = 0; n < 2; ++n) acc[a][b][m][n] = (f32x4){0.f, 0.f, 0.f, 0.f};
        cur = nxt; cA = nA; cB = nB; ++ui;
        if constexpr (ALIGN_EPI) { if (wr == 1) PG8_BAR; }
    }
    PG8_WAIT_V(0);
    if constexpr (!ALIGN_EPI) { if (wr == 0) PG8_BAR; }
    PG8_BAR;
    if constexpr (Epi::AFTER_DRAIN) { E.fused(acc, cur, wr, wc, fr, fq, lds, wid, lane); S.done(cur); }
#undef PG8_SA
#undef PG8_SB
#undef PG8_STAGE
#undef PG8_LDA
#undef PG8_LDB
#undef PG8_MMA
#undef PG8_WAIT_V
#undef PG8_WAIT_L
#undef PG8_BAR
#undef PG8_SCHED
}
}

#define LAS __attribute__((address_space(3)))
#define XB_TMO      128
#define XB_XCNT(j)  (256  + 64 * (j))
#define XB_XSUB(j)  (1280 + 64 * (j))
#define XB_XGEN(j)  (2304 + 64 * (j))
#define XB_TOP      3328
#define XB_TOPGEN   3392
#define XCD_BAR_WORDS 3456
#define XB_SPIN_CAP (1u << 18)

__device__ __forceinline__ unsigned xb_ld(unsigned* p)              { return __hip_atomic_load(p, __ATOMIC_RELAXED, __HIP_MEMORY_SCOPE_AGENT); }
__device__ __forceinline__ unsigned xb_add(unsigned* p, unsigned v) { return __hip_atomic_fetch_add(p, v, __ATOMIC_RELAXED, __HIP_MEMORY_SCOPE_AGENT); }
__device__ __forceinline__ unsigned xb_xcc_id() { return (unsigned)__builtin_amdgcn_s_getreg((3 << 11) | 20) & 0xFu; }
#define XB_SPIN(cond, bar) do { unsigned _sp = 0; while (cond) { __builtin_amdgcn_s_sleep(1); \
    if ((++_sp & 255u) == 0u) { if (xb_ld(&(bar)[XB_TMO])) break; if (_sp > XB_SPIN_CAP) { atomicAdd(&(bar)[XB_TMO], 1u); break; } } } } while (0)

struct XcdBarrier {
    unsigned* bar; unsigned x;
    volatile LAS unsigned* st;
};

__device__ __forceinline__ XcdBarrier xcd_barrier_post(unsigned* bar, volatile LAS unsigned* st) {
    XcdBarrier b; b.bar = bar; b.x = xb_xcc_id(); b.st = st;
    if (threadIdx.x == 0) (void)xb_add(&bar[XB_XCNT(b.x)], 1u);
    return b;
}
__device__ __forceinline__ void xcd_barrier_complete(unsigned* bar, unsigned x, unsigned& nloc, unsigned& nx) {
    const unsigned G = gridDim.x * gridDim.y * gridDim.z;
    unsigned sum, cnt, mine, sp = 0u;
    for (;;) {
        sum = 0u; cnt = 0u; mine = 0u;
#pragma unroll
        for (unsigned j = 0; j < 16; ++j) { const unsigned c = xb_ld(&bar[XB_XCNT(j)]); sum += c; cnt += (c > 0u) ? 1u : 0u; mine = (j == x) ? c : mine; }
        if (sum == G) break;
        __builtin_amdgcn_s_sleep(1);
        if ((++sp & 255u) == 0u) { if (xb_ld(&bar[XB_TMO])) break; if (sp > XB_SPIN_CAP) { atomicAdd(&bar[XB_TMO], 1u); break; } }
    }
    nloc = mine > 0u ? mine : 1u; nx = cnt > 0u ? cnt : 1u;
}

__device__ __forceinline__ void xcd_barrier(const XcdBarrier& b) {
    asm volatile("s_waitcnt vmcnt(0)" ::: "memory");
    __syncthreads();
    if (threadIdx.x == 0) {
        unsigned* bar = b.bar;
        __builtin_amdgcn_s_waitcnt(0);
        unsigned nloc = b.st[0], nx = b.st[1];
        if (nloc == 0u) { xcd_barrier_complete(bar, b.x, nloc, nx); b.st[0] = nloc; b.st[1] = nx; }
        const unsigned old = xb_add(&bar[XB_XSUB(b.x)], 1u);
        const unsigned gen = old / nloc;
        if (old + 1u == (gen + 1u) * nloc) {
            __builtin_amdgcn_fence(__ATOMIC_RELEASE, "agent");
            asm volatile("s_waitcnt vmcnt(0)" ::: "memory");
            const unsigned og = xb_add(&bar[XB_TOP], 1u);
            const unsigned tg = og / nx;
            if (og + 1u == (tg + 1u) * nx) xb_add(&bar[XB_TOPGEN], 1u);
            else XB_SPIN(xb_ld(&bar[XB_TOPGEN]) == tg, bar);
            __builtin_amdgcn_fence(__ATOMIC_ACQUIRE, "agent");
            xb_add(&bar[XB_XGEN(b.x)], 1u);
            asm volatile("s_waitcnt vmcnt(0)" ::: "memory");
        } else {
            XB_SPIN(xb_ld(&bar[XB_XGEN(b.x)]) == gen, bar);
            __builtin_amdgcn_fence(__ATOMIC_ACQUIRE, "agent");
            asm volatile("s_waitcnt vmcnt(0)" ::: "memory");
        }
    }
    __syncthreads();
}

constexpr int BATCH = 16, SEQ = 2048, DM = 1024, MTOK = BATCH * SEQ, FF = 2816, NGU = 2 * FF, NINP = 3584, INCOLS = 3360, DEPTH = 2;
constexpr int NWAVES = 8;
constexpr float EPS = 1e-6f;
typedef unsigned short bf16;
typedef unsigned v4u __attribute__((ext_vector_type(4)));
typedef unsigned v2u __attribute__((ext_vector_type(2)));
typedef float f32x4 __attribute__((ext_vector_type(4)));
#define LDS_WAIT() asm volatile("s_waitcnt lgkmcnt(0)" ::: "memory")

constexpr size_t MiB = 1u << 20;
constexpr size_t WS_CTL = 0, CTL_ZERO_BYTES = MiB;
constexpr size_t WS_TAB = 1 * MiB;
constexpr size_t TAB_COS = 0, TAB_SIN = 65536, TAB_B1 = 131072;
constexpr size_t WS_W = 2 * MiB, W_LAYER = 43 * MiB;
constexpr size_t WO_GU1 = 0, WO_DN1 = 11 * MiB, WO_GU2 = 16 * MiB + MiB / 2, WO_DN2 = 27 * MiB + MiB / 2, WO_IN = 33 * MiB, WO_OUT = 40 * MiB, WO_CMP = 42 * MiB;
constexpr size_t WS_U = 88 * MiB;
constexpr size_t WS_HB = 152 * MiB;
constexpr size_t WS_HD = 328 * MiB;
constexpr size_t WS_PQ = 392 * MiB;
constexpr size_t WS_CC = 400 * MiB;
constexpr size_t WS_END = 401 * MiB;
constexpr size_t WS_QN = 152 * MiB, WS_KCR = 184 * MiB, WS_VCR = 192 * MiB, WS_KS = 200 * MiB, WS_VS = 208 * MiB, WS_KW = 216 * MiB, WS_VW = 224 * MiB;
constexpr size_t WS_MQ = 232 * MiB, WS_MK = 264 * MiB, WS_MV = 296 * MiB, WS_MO = 328 * MiB, WS_GATE = 360 * MiB;
static_assert(WS_GATE + 4 * MiB <= WS_PQ, "in-projection outputs end below PQ");
constexpr int CW_BAR = 4096;
constexpr int PH_BYTES = 143360, MISC_OFF = PH_BYTES, LDS_BYTES = 147456;

__device__ __forceinline__ unsigned f2bf(float f) { unsigned u = __builtin_bit_cast(unsigned, f); return (u + 0x7fffu + ((u >> 16) & 1u)) >> 16; }
__device__ __forceinline__ unsigned pk2(float lo, float hi) { return f2bf(lo) | (f2bf(hi) << 16); }
__device__ __forceinline__ float bflo(unsigned u) { return __builtin_bit_cast(float, u << 16); }
__device__ __forceinline__ float bfhi(unsigned u) { return __builtin_bit_cast(float, u & 0xffff0000u); }
__device__ __forceinline__ float bf2f(bf16 b) { return __builtin_bit_cast(float, (unsigned)b << 16); }
__device__ __forceinline__ float sigmoidf_(float x) { return 1.f / (1.f + __expf(-x)); }
__device__ __forceinline__ float wave_sum(float v) {
#pragma unroll
    for (int o = 1; o < 64; o <<= 1) v += __shfl_xor(v, o);
    return v;
}

struct SrcGU { const float* W; __device__ __forceinline__ float operator()(int k, int nd) const { const int pn = nd >> 8, r = nd & 255; const int col = (r < 128) ? (pn * 128 + r) : (FF + pn * 128 + r - 128); return W[(size_t)k * NGU + col]; } };
struct SrcPlain { const float* W; int N; __device__ __forceinline__ float operator()(int k, int nd) const { return W[(size_t)k * N + nd]; } };
struct SrcIN { const float* W; __device__ __forceinline__ float operator()(int k, int nd) const {
    const int col = nd < 1280 ? nd : (nd < 3328 ? nd + 24 : (nd < 3352 ? nd - 3328 + 1280 : (nd < 3360 ? nd : -1)));
    return col < 0 ? 0.f : W[(size_t)k * INCOLS + col]; } };
struct SrcCMP { const float* W1; __device__ __forceinline__ float operator()(int k, int nd) const { const int kv = nd >> 8, r = nd & 255;
    return r < 128 ? W1[((size_t)kv * 2048 + k) * 128 + r] : W1[((size_t)kv * 2048 + 1024 + k) * 128 + r - 128]; } };

template <class SrcF>
__device__ __forceinline__ void transpose_item(const SrcF& src, int K, bf16* WT, LAS float* scr, int kb, int nb, int lane) {
    const int k0 = 64 * kb, n0 = 32 * nb;
#pragma unroll 8
    for (int i = 0; i < 32; ++i) { const int kk = 2 * i + (lane >> 5); scr[kk * 33 + (lane & 31)] = src(k0 + kk, n0 + (lane & 31)); }
    LDS_WAIT(); asm volatile("" ::: "memory");
    const int c = lane & 7;
#pragma unroll
    for (int j = 0; j < 4; ++j) { const int n = (lane >> 3) + 8 * j; const LAS float* s = scr + (8 * c) * 33 + n;
        v4u o; o.x = pk2(s[0 * 33], s[1 * 33]); o.y = pk2(s[2 * 33], s[3 * 33]); o.z = pk2(s[4 * 33], s[5 * 33]); o.w = pk2(s[6 * 33], s[7 * 33]);
        *(v4u*)(WT + (size_t)(n0 + n) * K + k0 + 8 * c) = o; }
    LDS_WAIT(); asm volatile("" ::: "memory");
}

template <int MODE>
__device__ __forceinline__ void thin_phase(const bf16* HD, const float* xin, float* xout, const float* gpost, float cc, const float* gpre, bf16* U, int gw, int NGW, int lane) {
    f32x4 gp[4], gq[4];
#pragma unroll
    for (int j = 0; j < 4; ++j) { gp[j] = (MODE != 0) ? *(const f32x4*)(gpost + 4 * lane + 256 * j) : (f32x4){0.f, 0.f, 0.f, 0.f};
                                  gq[j] = (MODE != 2) ? *(const f32x4*)(gpre + 4 * lane + 256 * j) : (f32x4){0.f, 0.f, 0.f, 0.f}; }
    for (int m = gw; m < MTOK; m += NGW) {
        f32x4 x[4];
#pragma unroll
        for (int j = 0; j < 4; ++j) x[j] = *(const f32x4*)(xin + (size_t)m * DM + 4 * lane + 256 * j);
        if (MODE != 0) {
            f32x4 h[4]; float ss = 0.f;
#pragma unroll
            for (int j = 0; j < 4; ++j) { const v2u w = *(const v2u*)(HD + (size_t)m * DM + 4 * lane + 256 * j);
                h[j] = (f32x4){bflo(w.x), bfhi(w.x), bflo(w.y), bfhi(w.y)}; ss += (h[j].x * h[j].x + h[j].y * h[j].y) + (h[j].z * h[j].z + h[j].w * h[j].w); }
            const float r = cc * __frsqrt_rn(wave_sum(ss) * (1.f / DM) + EPS);
#pragma unroll
            for (int j = 0; j < 4; ++j) x[j] = x[j] + (h[j] * r) * gp[j];
        }
#pragma unroll
        for (int j = 0; j < 4; ++j) *(f32x4*)(xout + (size_t)m * DM + 4 * lane + 256 * j) = x[j];
        if (MODE != 2) {
            float s2 = 0.f;
#pragma unroll
            for (int j = 0; j < 4; ++j) s2 += (x[j].x * x[j].x + x[j].y * x[j].y) + (x[j].z * x[j].z + x[j].w * x[j].w);
            const float r2 = __frsqrt_rn(wave_sum(s2) * (1.f / DM) + EPS);
#pragma unroll
            for (int j = 0; j < 4; ++j) { const f32x4 y = (x[j] * r2) * gq[j]; v2u w; w.x = pk2(y.x, y.y); w.y = pk2(y.z, y.w);
                *(v2u*)(U + (size_t)m * DM + 4 * lane + 256 * j) = w; }
        }
    }
}

struct EpiSwiglu {
    static constexpr bool PERM = true, AFTER_DRAIN = false;
    bf16* H;
    __device__ __forceinline__ void operator()(const pg8::f32x4 (&acc)[2][2][4][2], const pg8::Unit& u, int wr, int wc, int fr, int fq) const {
#pragma unroll
        for (int ai = 0; ai < 2; ++ai)
#pragma unroll
            for (int m = 0; m < 4; ++m) {
                const int row = u.pm * 256 + ai * 128 + wr * 64 + m * 16 + fr;
                float o[8];
#pragma unroll
                for (int n = 0; n < 2; ++n)
#pragma unroll
                    for (int e = 0; e < 4; ++e) { const float g = acc[ai][0][m][n][e], up = acc[ai][1][m][n][e]; o[n * 4 + e] = g * up / (1.f + __expf(-g)); }
                v4u w; w.x = pg8::cvt_pk_bf16(o[0], o[1]); w.y = pg8::cvt_pk_bf16(o[2], o[3]); w.z = pg8::cvt_pk_bf16(o[4], o[5]); w.w = pg8::cvt_pk_bf16(o[6], o[7]);
                *(v4u*)(H + (size_t)row * FF + u.pn * 128 + wc * 32 + fq * 8) = w;
            }
    }
};
struct EpiPQ {
    static constexpr bool PERM = true, AFTER_DRAIN = false;
    float* O;
    __device__ __forceinline__ void operator()(const pg8::f32x4 (&acc)[2][2][4][2], const pg8::Unit& u, int wr, int wc, int fr, int fq) const {
#pragma unroll
        for (int ai = 0; ai < 2; ++ai)
#pragma unroll
            for (int m = 0; m < 4; ++m) {
                const int row = u.pm * 256 + ai * 128 + wr * 64 + m * 16 + fr;
#pragma unroll
                for (int bj = 0; bj < 2; ++bj) { float* p = O + (size_t)row * 256 + bj * 128 + wc * 32 + fq * 8;
                    *(pg8::f32x4*)p = acc[ai][bj][m][0]; *(pg8::f32x4*)(p + 4) = acc[ai][bj][m][1]; }
            }
    }
};
struct CmpOrder {
    int c, G;
    __device__ __forceinline__ bool next(int i, pg8::Unit& u) const { const int idx = i * G + c; if (idx >= 32) return false; u.pm = idx; u.pn = idx >> 4; return true; }
    __device__ __forceinline__ void a_ready(const pg8::Unit&) const {}
    __device__ __forceinline__ void done(const pg8::Unit&) const {}
};
struct EpiInProj {
    static constexpr bool PERM = true, AFTER_DRAIN = false;
    unsigned char* ws;
    __device__ __forceinline__ void operator()(const pg8::f32x4 (&acc)[2][2][4][2], const pg8::Unit& u, int wr, int wc, int fr, int fq) const {
        const int pn = u.pn;
        const float* cosT = (const float*)(ws + WS_TAB + TAB_COS); const float* sinT = (const float*)(ws + WS_TAB + TAB_SIN);
        const bool ropet = (pn < 2) || (pn == 3) || (pn == 4);
        const bool ropew = ropet && ((wc & 1) == 0);
#pragma unroll
        for (int ai = 0; ai < 2; ++ai)
#pragma unroll
            for (int m = 0; m < 4; ++m) {
                const int row = u.pm * 256 + ai * 128 + wr * 64 + m * 16 + fr;
                const int b = row >> 11, t = row & 2047;
                f32x4 c0, c1, s0, s1;
                if (ropew) { c0 = *(const f32x4*)(cosT + t * 8); c1 = *(const f32x4*)(cosT + t * 8 + 4); s0 = *(const f32x4*)(sinT + t * 8); s1 = *(const f32x4*)(sinT + t * 8 + 4); }
#pragma unroll
                for (int bj = 0; bj < 2; ++bj) {
                    f32x4 v0 = acc[ai][bj][m][0], v1 = acc[ai][bj][m][1];
                    const int cl = bj * 128 + wc * 32 + fq * 8;
                    if (ropew && (pn < 2 || bj == 0)) {
                        f32x4 p0, p1;
                        p0.x = __shfl_xor(v0.x, 16); p0.y = __shfl_xor(v0.y, 16); p0.z = __shfl_xor(v0.z, 16); p0.w = __shfl_xor(v0.w, 16);
                        p1.x = __shfl_xor(v1.x, 16); p1.y = __shfl_xor(v1.y, 16); p1.z = __shfl_xor(v1.z, 16); p1.w = __shfl_xor(v1.w, 16);
                        const float sg = (fq == 0) ? -1.f : 1.f;
                        if (fq < 2) { v0 = v0 * c0 + (p0 * s0) * sg; v1 = v1 * c1 + (p1 * s1) * sg; }
                    }
                    if (pn == 13) { if (cl < 32) { float* p = (float*)(ws + WS_GATE) + (size_t)row * 32 + cl; *(f32x4*)p = v0; *(f32x4*)(p + 4) = v1; } }
                    else {
                        size_t off;
                        if (pn < 2) off = WS_QN + ((size_t)row * 512 + pn * 256 + cl) * 2;
                        else if (pn < 5) { const int g = wc >> 1, d = (wc & 1) * 32 + fq * 8; off = WS_KCR + (size_t)((pn - 2) * 2 + bj) * (8 * MiB) + (((size_t)(b * 2 + g) * SEQ + t) * 64 + d) * 2; }
                        else { const int q = pn - 5; off = WS_MQ + (size_t)(q >> 1) * (32 * MiB) + ((size_t)row * 512 + (q & 1) * 256 + cl) * 2; }
                        v4u w; w.x = pg8::cvt_pk_bf16(v0.x, v0.y); w.y = pg8::cvt_pk_bf16(v0.z, v0.w); w.z = pg8::cvt_pk_bf16(v1.x, v1.y); w.w = pg8::cvt_pk_bf16(v1.z, v1.w);
                        *(v4u*)(ws + off) = w;
                    }
                }
            }
    }
};
static_assert(WS_VCR == WS_KCR + 8 * MiB && WS_KS == WS_KCR + 16 * MiB && WS_VS == WS_KCR + 24 * MiB && WS_KW == WS_KCR + 32 * MiB && WS_VW == WS_KCR + 40 * MiB, "kv buffers are 8 MiB apart in (pn, bj) order");
static_assert(WS_MK == WS_MQ + 32 * MiB && WS_MV == WS_MQ + 64 * MiB && WS_MO == WS_MQ + 96 * MiB, "mLSTM buffers are 32 MiB apart");

__device__ __forceinline__ float dot64(const float (&q)[64], const LAS unsigned char* krow) {
    float s0 = 0.f, s1 = 0.f;
#pragma unroll
    for (int c8 = 0; c8 < 8; ++c8) { const v4u kk = *(const LAS v4u*)(krow + c8 * 16);
        s0 += q[c8 * 8 + 0] * bflo(kk.x) + q[c8 * 8 + 2] * bflo(kk.y) + q[c8 * 8 + 4] * bflo(kk.z) + q[c8 * 8 + 6] * bflo(kk.w);
        s1 += q[c8 * 8 + 1] * bfhi(kk.x) + q[c8 * 8 + 3] * bfhi(kk.y) + q[c8 * 8 + 5] * bfhi(kk.z) + q[c8 * 8 + 7] * bfhi(kk.w); }
    return s0 + s1;
}
__device__ __forceinline__ unsigned long long bits_upto(int hi) { return hi < 0 ? 0ull : (hi >= 63 ? ~0ull : ((2ull << hi) - 1ull)); }

struct MixPtrs { unsigned char* ws; const float *conv_w, *conv_b, *i_bias, *f_bias, *mnorm_g; };
#define MP_QN ((const bf16*)(P.ws + WS_QN))
#define MP_KS ((const bf16*)(P.ws + WS_KS))
#define MP_VS ((const bf16*)(P.ws + WS_VS))
#define MP_KW ((const bf16*)(P.ws + WS_KW))
#define MP_VW ((const bf16*)(P.ws + WS_VW))
#define MP_KC ((const bf16*)(P.ws + WS_CC))
#define MP_VC ((const bf16*)(P.ws + WS_CC) + (size_t)4096 * 64)
#define MP_MQ ((const bf16*)(P.ws + WS_MQ))
#define MP_MK ((const bf16*)(P.ws + WS_MK))
#define MP_MV ((const bf16*)(P.ws + WS_MV))
#define MP_MO ((const bf16*)(P.ws + WS_MO))
#define MP_GATE ((const float*)(P.ws + WS_GATE))
#define MP_Y ((bf16*)(P.ws + WS_U))

constexpr int NS_KT = 0, NS_VT = 8192, NS_IMP = 16384, NS_IMS = 50176, NS_SEL = 58624, NS_OUT = 59136;
__device__ __forceinline__ void nsa_unit_simple(LAS unsigned char* L, const MixPtrs& P, int b, int g, int c) {
    int tid_l = threadIdx.x; asm volatile("" : "+v"(tid_l));
    const int tid = tid_l, lane = tid & 63, w = __builtin_amdgcn_readfirstlane(tid >> 6);
    const bool act = w < 4; const int h = w & 3, t = c * 64 + lane; const size_t row = (size_t)b * SEQ + t;
    LAS float* OUT = (LAS float*)(L + NS_OUT) + tid * 65;
    LAS unsigned* SEL = (LAS unsigned*)(L + NS_SEL);
    float q[64];
    if (act) {
        const bf16* qp = MP_QN + row * 512 + (g * 4 + h) * 64;
#pragma unroll
        for (int c8 = 0; c8 < 8; ++c8) { const v4u v = *(const v4u*)(qp + c8 * 8);
            q[c8 * 8 + 0] = bflo(v.x) * 0.125f; q[c8 * 8 + 1] = bfhi(v.x) * 0.125f; q[c8 * 8 + 2] = bflo(v.y) * 0.125f; q[c8 * 8 + 3] = bfhi(v.y) * 0.125f;
            q[c8 * 8 + 4] = bflo(v.z) * 0.125f; q[c8 * 8 + 5] = bfhi(v.z) * 0.125f; q[c8 * 8 + 6] = bflo(v.w) * 0.125f; q[c8 * 8 + 7] = bfhi(v.w) * 0.125f; }
#pragma unroll
        for (int d = 0; d < 64; ++d) OUT[d] = 0.f;
    } else {
#pragma unroll
        for (int d = 0; d < 64; ++d) q[d] = 0.f;
    }
    const size_t kvbase = (size_t)(b * 2 + g) * SEQ * 64, ccbase = (size_t)(b * 2 + g) * 128 * 64;
    const int nlim = (t >= 31) ? (((t - 31) >> 4) < 126 ? ((t - 31) >> 4) : 126) : -1;
    unsigned un = 0u, mysel = 0u;
#pragma unroll 1
    for (int br = 0; br < 3; ++br) {
        float o[64], mx = -1e30f, l = 0.f;
#pragma unroll
        for (int d = 0; d < 64; ++d) o[d] = 0.f;
        int j0, j1; const bf16 *Kp, *Vp;
        if (br == 0) { j0 = 0; j1 = 1; Kp = MP_KC + ccbase; Vp = MP_VC + ccbase; }
        else if (br == 1) { j0 = 0; j1 = c; Kp = MP_KS + kvbase; Vp = MP_VS + kvbase; }
        else { j0 = (c - 8 > 0) ? c - 8 : 0; j1 = c; Kp = MP_KW + kvbase; Vp = MP_VW + kvbase; }
#pragma unroll 1
        for (int j = j0; j <= j1; ++j) {
            if (br == 1 && !((un >> j) & 1u)) continue;
            __syncthreads();
            *(LAS v4u*)(L + NS_KT + tid * 16) = *(const v4u*)(Kp + (size_t)j * 4096 + tid * 8);
            *(LAS v4u*)(L + NS_VT + tid * 16) = *(const v4u*)(Vp + (size_t)j * 4096 + tid * 8);
            __syncthreads();
            if (act) {
                unsigned long long mask;
                if (br == 0) mask = bits_upto(nlim - 64 * j);
                else if (br == 1) mask = ((mysel >> j) & 1u) ? ((j < c) ? ~0ull : bits_upto(lane)) : 0ull;
                else { const int lo = t - 511 - 64 * j, hi = t - 64 * j; mask = bits_upto(hi) & ~((lo > 0) ? bits_upto(lo - 1) : 0ull); }
#pragma unroll 1
                for (int r = 0; r < 64; ++r) {
                    const bool on = (mask >> r) & 1ull;
                    if (!__any(on)) continue;
                    const float s = dot64(q, L + NS_KT + r * 128);
                    if (on) {
                        if (s > mx) { const float corr = __expf(mx - s); l *= corr;
#pragma unroll
                            for (int d = 0; d < 64; ++d) o[d] *= corr;
                            mx = s; }
                        const float p = __expf(s - mx); l += p;
                        const LAS unsigned char* vr = L + NS_VT + r * 128;
#pragma unroll
                        for (int c8 = 0; c8 < 8; ++c8) { const v4u vv = *(const LAS v4u*)(vr + c8 * 16);
                            o[c8 * 8 + 0] += p * bflo(vv.x); o[c8 * 8 + 1] += p * bfhi(vv.x); o[c8 * 8 + 2] += p * bflo(vv.y); o[c8 * 8 + 3] += p * bfhi(vv.y);
                            o[c8 * 8 + 4] += p * bflo(vv.z); o[c8 * 8 + 5] += p * bfhi(vv.z); o[c8 * 8 + 6] += p * bflo(vv.w); o[c8 * 8 + 7] += p * bfhi(vv.w); }
                    }
                }
            }
        }
        if (act) { const float gate = sigmoidf_(MP_GATE[row * 32 + br * 8 + g * 4 + h]); const float sc = (l > 0.f) ? gate / l : 0.f;
#pragma unroll
            for (int d = 0; d < 64; ++d) OUT[d] += sc * o[d]; }
        if (br == 0) {
            __syncthreads();
            *(LAS v4u*)(L + NS_KT + tid * 16) = *(const v4u*)(Kp + tid * 8);
            *(LAS v4u*)(L + NS_KT + 8192 + tid * 16) = *(const v4u*)(Kp + 4096 + tid * 8);
            __syncthreads();
            if (act) {
                const float il = (l > 0.f) ? 1.f / l : 0.f;
                LAS float* IMP = (LAS float*)(L + NS_IMP) + tid * 33;
#pragma unroll 1
                for (int jb = 0; jb < 32; ++jb) { float a = 0.f;
#pragma unroll 1
                    for (int n = (jb ? 4 * jb - 1 : 0); n <= 4 * jb + 3 && n <= 126; ++n) { const float s = dot64(q, L + NS_KT + n * 128); if (n <= nlim) a += __expf(s - mx); }
                    IMP[jb] = a * il; }
            }
            __syncthreads();
            if (w == 0) {
                LAS float* IMS = (LAS float*)(L + NS_IMS) + lane * 33; const LAS float* I4 = (const LAS float*)(L + NS_IMP);
                for (int jb = 0; jb < 32; ++jb) IMS[jb] = (I4[lane * 33 + jb] + I4[(64 + lane) * 33 + jb]) + (I4[(128 + lane) * 33 + jb] + I4[(192 + lane) * 33 + jb]);
                unsigned sel;
                if (c + 1 <= 16) sel = (1u << (c + 1)) - 1u;
                else { sel = 1u | (1u << c) | (1u << (c - 1));
                    for (int jb = 1; jb <= c - 2; ++jb) { const float vj = IMS[jb]; int rank = 0;
                        for (int i2 = 1; i2 <= c - 2; ++i2) { const float vi = IMS[i2]; rank += (vi > vj || (vi == vj && i2 < jb)) ? 1 : 0; }
                        if (rank < 13) sel |= 1u << jb; } }
                SEL[lane] = sel; unsigned so = sel;
#pragma unroll
                for (int o2 = 32; o2; o2 >>= 1) so |= __shfl_xor(so, o2);
                if (lane == 0) SEL[64] = so;
            }
            __syncthreads();
            un = SEL[64]; mysel = SEL[lane];
        }
    }
    if (act) { bf16* yp = MP_Y + row * DM + (g * 4 + h) * 64;
#pragma unroll
        for (int c8 = 0; c8 < 8; ++c8) { v4u wv; wv.x = pk2(OUT[c8 * 8 + 0], OUT[c8 * 8 + 1]); wv.y = pk2(OUT[c8 * 8 + 2], OUT[c8 * 8 + 3]); wv.z = pk2(OUT[c8 * 8 + 4], OUT[c8 * 8 + 5]); wv.w = pk2(OUT[c8 * 8 + 6], OUT[c8 * 8 + 7]);
            *(v4u*)(yp + c8 * 8) = wv; } }
    __syncthreads();
}

constexpr int ML_Q = 0, ML_K = 16384, ML_V = 32768, ML_SC = 49152, ML_C = 65536, ML_N = 131072, ML_S = 131584;
__device__ __forceinline__ void mlstm_unit_simple(LAS unsigned char* L, const MixPtrs& P, int b, int h) {
    int tid_l = threadIdx.x; asm volatile("" : "+v"(tid_l));
    const int tid = tid_l, lane = tid & 63, w = __builtin_amdgcn_readfirstlane(tid >> 6);
    LAS float* Cm = (LAS float*)(L + ML_C); LAS float* Nv = (LAS float*)(L + ML_N); LAS float* SC = (LAS float*)(L + ML_SC);
    LAS float* S_bcum = (LAS float*)(L + ML_S), *S_a = S_bcum + 64, *S_mt = S_bcum + 128, *S_wp = S_bcum + 192, *S_wk = S_bcum + 256, *S_x = S_bcum + 320;
    LAS bf16* Qs = (LAS bf16*)(L + ML_Q); LAS bf16* Ks = (LAS bf16*)(L + ML_K); LAS bf16* Vs = (LAS bf16*)(L + ML_V);
    float zf = 0.f; asm volatile("" : "+v"(zf));
    for (int i = tid; i < 128 * 128; i += 512) Cm[i] = zf;
    if (tid < 128) Nv[tid] = zf;
    if (tid == 0) { S_x[0] = zf; S_x[1] = zf; }
    const int ch = tid & 127, sg = tid >> 7;
    float wq[4], wk4[4];
#pragma unroll
    for (int j = 0; j < 4; ++j) { wq[j] = P.conv_w[j * 1024 + h * 128 + ch]; wk4[j] = P.conv_w[j * 1024 + 512 + h * 128 + ch]; }
    const float bq = P.conv_b[h * 128 + ch], bk = P.conv_b[512 + h * 128 + ch];
    const float ib = P.i_bias[h], fb = P.f_bias[h];
    __syncthreads();
#pragma unroll 1
    for (int c = 0; c < 32; ++c) {
        const int t0 = c * 64; const size_t rb = (size_t)b * SEQ;
#pragma unroll 1
        for (int s = 0; s < 16; ++s) { const int sl = sg * 16 + s, t = t0 + sl; float aq = bq, ak = bk;
#pragma unroll
            for (int j = 0; j < 4; ++j) { const int tt = t - 3 + j; if (tt >= 0) { aq += wq[j] * bf2f(MP_MQ[(rb + tt) * 512 + h * 128 + ch]); ak += wk4[j] * bf2f(MP_MK[(rb + tt) * 512 + h * 128 + ch]); } }
            aq = aq / (1.f + __expf(-aq)); ak = ak / (1.f + __expf(-ak)) * 0.08838834764831845f;
            Qs[sl * 128 + ch] = (bf16)f2bf(aq); Ks[sl * 128 + ch] = (bf16)f2bf(ak); Vs[sl * 128 + ch] = MP_MV[(rb + t) * 512 + h * 128 + ch]; }
        if (w == 0) {
            const size_t row = rb + t0 + lane;
            const float il = MP_GATE[row * 32 + 24 + h] + ib; const float fx = MP_GATE[row * 32 + 28 + h] + fb;
            const float fl = fminf(fx, 0.f) - log1pf(__expf(-fabsf(fx)));
            float f = fl;
#pragma unroll
            for (int o = 1; o < 64; o <<= 1) { const float v = __shfl_up(f, o); if (lane >= o) f += v; }
            const float a = il - f; float pm = a;
#pragma unroll
            for (int o = 1; o < 64; o <<= 1) { const float v = __shfl_up(pm, o); if (lane >= o) pm = fmaxf(pm, v); }
            const float b_last = __shfl(f, 63), amax = __shfl(pm, 63), mc = S_x[0];
            const float inter = f + mc, mt = fmaxf(f + pm, inter);
            const float m_new = fmaxf(b_last + mc, b_last + amax);
            S_bcum[lane] = f; S_a[lane] = a; S_mt[lane] = mt; S_wp[lane] = __expf(inter - mt); S_wk[lane] = __expf(b_last + a - m_new);
            if (lane == 0) { S_x[1] = __expf(b_last + mc - m_new); S_x[0] = m_new; }
        }
        __syncthreads();
        { const int t = tid >> 3; const float bt = S_bcum[t] - S_mt[t];
#pragma unroll 1
          for (int jj = 0; jj < 8; ++jj) { const int s = (tid & 7) + 8 * jj; float v = 0.f;
              if (s <= t) { float d0 = 0.f;
#pragma unroll
                  for (int c8 = 0; c8 < 16; ++c8) { const v4u qa = *(const LAS v4u*)(Qs + t * 128 + c8 * 8), ka = *(const LAS v4u*)(Ks + s * 128 + c8 * 8);
                      d0 += bflo(qa.x) * bflo(ka.x) + bfhi(qa.x) * bfhi(ka.x) + bflo(qa.y) * bflo(ka.y) + bfhi(qa.y) * bfhi(ka.y) + bflo(qa.z) * bflo(ka.z) + bfhi(qa.z) * bfhi(ka.z) + bflo(qa.w) * bflo(ka.w) + bfhi(qa.w) * bfhi(ka.w); }
                  v = d0 * __expf(bt + S_a[s]); }
              SC[t * 64 + s] = v; } }
        __syncthreads();
        { const int t = tid >> 3, e0 = (tid & 7) * 16; float acc[16], acc2[16], dsum = 0.f, dqn = 0.f;
#pragma unroll
          for (int e = 0; e < 16; ++e) { acc[e] = 0.f; acc2[e] = 0.f; }
#pragma unroll 1
          for (int s = 0; s < 64; ++s) { const float wv = SC[t * 64 + s]; dsum += wv;
              const v4u v0 = *(const LAS v4u*)(Vs + s * 128 + e0), v1 = *(const LAS v4u*)(Vs + s * 128 + e0 + 8);
              acc[0] += wv * bflo(v0.x); acc[1] += wv * bfhi(v0.x); acc[2] += wv * bflo(v0.y); acc[3] += wv * bfhi(v0.y); acc[4] += wv * bflo(v0.z); acc[5] += wv * bfhi(v0.z); acc[6] += wv * bflo(v0.w); acc[7] += wv * bfhi(v0.w);
              acc[8] += wv * bflo(v1.x); acc[9] += wv * bfhi(v1.x); acc[10] += wv * bflo(v1.y); acc[11] += wv * bfhi(v1.y); acc[12] += wv * bflo(v1.z); acc[13] += wv * bfhi(v1.z); acc[14] += wv * bflo(v1.w); acc[15] += wv * bfhi(v1.w); }
#pragma unroll 1
          for (int d = 0; d < 128; ++d) { const float qd = bf2f(Qs[t * 128 + d]); dqn += qd * Nv[d];
              const LAS f32x4* cr = (const LAS f32x4*)(Cm + d * 128 + e0);
#pragma unroll
              for (int e4 = 0; e4 < 4; ++e4) { const f32x4 cv = cr[e4]; acc2[e4 * 4 + 0] += qd * cv.x; acc2[e4 * 4 + 1] += qd * cv.y; acc2[e4 * 4 + 2] += qd * cv.z; acc2[e4 * 4 + 3] += qd * cv.w; } }
          const float wp = S_wp[t], den = dsum + wp * dqn; const float dn = fmaxf(fabsf(den), __expf(-S_mt[t])); const float idn = 1.f / dn;
          float ss = 0.f;
#pragma unroll
          for (int e = 0; e < 16; ++e) { acc[e] = (acc[e] + wp * acc2[e]) * idn; ss += acc[e] * acc[e]; }
          ss += __shfl_xor(ss, 1); ss += __shfl_xor(ss, 2); ss += __shfl_xor(ss, 4);
          const float rn = __frsqrt_rn(ss * (1.f / 128.f) + EPS);
          const size_t row = rb + t0 + t; const bf16* op = MP_MO + row * 512 + h * 128 + e0; const float* gn = P.mnorm_g + h * 128 + e0;
          const v4u o0 = *(const v4u*)op, o1 = *(const v4u*)(op + 8);
          const float ov[16] = {bflo(o0.x), bfhi(o0.x), bflo(o0.y), bfhi(o0.y), bflo(o0.z), bfhi(o0.z), bflo(o0.w), bfhi(o0.w), bflo(o1.x), bfhi(o1.x), bflo(o1.y), bfhi(o1.y), bflo(o1.z), bfhi(o1.z), bflo(o1.w), bfhi(o1.w)};
          float y[16];
#pragma unroll
          for (int e = 0; e < 16; ++e) y[e] = acc[e] * rn * gn[e] * sigmoidf_(ov[e]);
          v4u w0, w1; w0.x = pk2(y[0], y[1]); w0.y = pk2(y[2], y[3]); w0.z = pk2(y[4], y[5]); w0.w = pk2(y[6], y[7]); w1.x = pk2(y[8], y[9]); w1.y = pk2(y[10], y[11]); w1.z = pk2(y[12], y[13]); w1.w = pk2(y[14], y[15]);
          bf16* yp = MP_Y + row * DM + 512 + h * 128 + e0; *(v4u*)yp = w0; *(v4u*)(yp + 8) = w1; }
        __syncthreads();
        { const int d = tid >> 2, e0 = (tid & 3) * 32; const float cs = S_x[1]; float ca[32], na = 0.f;
#pragma unroll
          for (int e = 0; e < 32; ++e) ca[e] = cs * Cm[d * 128 + e0 + e];
#pragma unroll 1
          for (int s = 0; s < 64; ++s) { const float kk = S_wk[s] * bf2f(Ks[s * 128 + d]); na += kk;
#pragma unroll
              for (int c8 = 0; c8 < 4; ++c8) { const v4u vv = *(const LAS v4u*)(Vs + s * 128 + e0 + c8 * 8);
                  ca[c8 * 8 + 0] += kk * bflo(vv.x); ca[c8 * 8 + 1] += kk * bfhi(vv.x); ca[c8 * 8 + 2] += kk * bflo(vv.y); ca[c8 * 8 + 3] += kk * bfhi(vv.y);
                  ca[c8 * 8 + 4] += kk * bflo(vv.z); ca[c8 * 8 + 5] += kk * bfhi(vv.z); ca[c8 * 8 + 6] += kk * bflo(vv.w); ca[c8 * 8 + 7] += kk * bfhi(vv.w); } }
#pragma unroll
          for (int e = 0; e < 32; ++e) Cm[d * 128 + e0 + e] = ca[e];
          if ((tid & 3) == 0) Nv[d] = cs * Nv[d] + na; }
        __syncthreads();
    }
}

#ifndef MK_MULTI
#define MK_MULTI 1
#endif
constexpr int PH_PER_LAYER = 12, N_PHASES = 1 + DEPTH * PH_PER_LAYER;
struct Args { const float* in[16]; float* out; unsigned char* ws; int ph_lo, ph_hi; };
static_assert(sizeof(Args) == 16 * 8 + 8 + 8 + 8, "Args has no padding");

__global__ void __launch_bounds__(NWAVES * 64, 2) fwd_kernel(Args args) {
    extern __shared__ __attribute__((aligned(16))) unsigned char lds_raw[];
    LAS unsigned char* L = (LAS unsigned char*)lds_raw;
    const int G0 = gridDim.x, blk0 = blockIdx.x;
#define PH_IDS() PH_WS(); int tid = threadIdx.x; asm volatile("" : "+v"(tid)); const int lane = tid & 63, wave = __builtin_amdgcn_readfirstlane(tid >> 6), gw = blk * NWAVES + wave; (void)lane; (void)gw
#define PH_WS() unsigned char* ws = args.ws; asm volatile("" : "+s"(ws)); int blk = blk0, G = G0; asm volatile("" : "+s"(blk), "+s"(G)); const int NGW = G * NWAVES; (void)NGW; float* xres = args.out; bf16* U = (bf16*)(ws + WS_U); bf16* HB = (bf16*)(ws + WS_HB); bf16* HD = (bf16*)(ws + WS_HD); \
    unsigned char* wl = ws + WS_W + (size_t)l_ * W_LAYER; const float* ng = args.in[1] + (size_t)l_ * 6 * DM; (void)xres; (void)U; (void)HB; (void)HD; (void)wl; (void)ng
    unsigned char* ws0 = args.ws;
    volatile LAS unsigned* MISC = (volatile LAS unsigned*)(L + MISC_OFF);
    if (threadIdx.x < 16) MISC[threadIdx.x] = 0u;
    __syncthreads();
    XcdBarrier bar; bar.bar = (unsigned*)(ws0 + WS_CTL) + CW_BAR; bar.x = 0; bar.st = nullptr;
    if (!MK_MULTI) bar = xcd_barrier_post((unsigned*)(ws0 + WS_CTL) + CW_BAR, MISC + 8);
    const int lo = args.ph_lo, hi = args.ph_hi;
#define IN(k) (lo <= (k) && (k) < hi)
#define SEAM(k) do { if (IN(k) && IN((k) + 1)) xcd_barrier(bar); } while (0)

    if (IN(0)) {
        const int l_ = 0; PH_IDS();
        const float* x_in = args.in[0]; float* cosT = (float*)(ws + WS_TAB + TAB_COS); float* sinT = (float*)(ws + WS_TAB + TAB_SIN); float* b1T = (float*)(ws + WS_TAB + TAB_B1);
        LAS float* scr = (LAS float*)(L + wave * 16384);
        constexpr int I_GU = 16 * 176, I_DN = 44 * 32, I_IN = 16 * 112, I_OUT = 16 * 32, I_CMP = 16 * 16, I_LAYER = 2 * I_GU + 2 * I_DN + I_IN + I_OUT + I_CMP;
        for (int it = gw; it < DEPTH * I_LAYER; it += NGW) {
            const int l = it / I_LAYER; int r = it % I_LAYER; unsigned char* wl = ws + WS_W + (size_t)l * W_LAYER;
            if (r < I_GU) { SrcGU s{args.in[2] + (size_t)l * DM * NGU}; transpose_item(s, DM, (bf16*)(wl + WO_GU1), scr, r / 176, r % 176, lane); continue; } r -= I_GU;
            if (r < I_DN) { SrcPlain s{args.in[3] + (size_t)l * FF * DM, DM}; transpose_item(s, FF, (bf16*)(wl + WO_DN1), scr, r / 32, r % 32, lane); continue; } r -= I_DN;
            if (r < I_GU) { SrcGU s{args.in[4] + (size_t)l * DM * NGU}; transpose_item(s, DM, (bf16*)(wl + WO_GU2), scr, r / 176, r % 176, lane); continue; } r -= I_GU;
            if (r < I_DN) { SrcPlain s{args.in[5] + (size_t)l * FF * DM, DM}; transpose_item(s, FF, (bf16*)(wl + WO_DN2), scr, r / 32, r % 32, lane); continue; } r -= I_DN;
            if (r < I_IN) { SrcIN s{args.in[6] + (size_t)l * DM * INCOLS}; transpose_item(s, DM, (bf16*)(wl + WO_IN), scr, r / 112, r % 112, lane); continue; } r -= I_IN;
            if (r < I_OUT) { SrcPlain s{args.in[7] + (size_t)l * DM * DM, DM}; transpose_item(s, DM, (bf16*)(wl + WO_OUT), scr, r / 32, r % 32, lane); continue; } r -= I_OUT;
            { SrcCMP s{args.in[9] + (size_t)l * 2 * 2048 * 128}; transpose_item(s, DM, (bf16*)(wl + WO_CMP), scr, r / 16, r % 16, lane); }
        }
        for (int i = blk * 512 + tid; i < SEQ * 8; i += G * 512) { const int pos = i >> 3, k = i & 7;
            const double inv = pow(500000.0, -(double)k / 8.0), ang = (double)pos * inv; cosT[i] = (float)cos(ang); sinT[i] = (float)sin(ang); }
        for (int o = gw; o < DEPTH * 2 * 128; o += NGW) { const int lk = o >> 7, c = o & 127; const float* pe = args.in[8] + (size_t)lk * 2048; const float* w1 = args.in[9] + (size_t)lk * 2048 * 128;
            float s = 0.f; for (int r = lane; r < 2048; r += 64) s += pe[r] * w1[(size_t)r * 128 + c];
            s = wave_sum(s); if (lane == 0) b1T[o] = s; }
        thin_phase<0>(nullptr, x_in, xres, nullptr, 0.f, args.in[1] + 0 * DM, U, gw, NGW, lane);
    }
    SEAM(0);

#pragma unroll 1
    for (int l = 0; l < DEPTH; ++l) {
        const int pb = 1 + l * PH_PER_LAYER, l_ = l;
        if (IN(pb + 0)) { PH_WS(); pg8::Gemm g{U, (const bf16*)(wl + WO_GU1), MTOK, NGU, DM}; pg8::StaticOrder S; S.init(MTOK, NGU, G, blk); EpiSwiglu E{HB};
            pg8::gemm_phase<EpiSwiglu, pg8::StaticOrder, true, true>(L, g, S, E); }
        SEAM(pb + 0);
        if (IN(pb + 1)) { PH_WS(); pg8::Gemm g{HB, (const bf16*)(wl + WO_DN1), MTOK, DM, FF}; pg8::StaticOrder S; S.init(MTOK, DM, G, blk); pg8::EpiBf16<0> E{HD, DM, nullptr, 0, 0, 1.f};
            pg8::gemm_phase<pg8::EpiBf16<0>, pg8::StaticOrder, true, true>(L, g, S, E); }
        SEAM(pb + 1);
        if (IN(pb + 2)) { PH_IDS(); thin_phase<1>(HD, xres, xres, ng + 1 * DM, 0.5f, ng + 2 * DM, U, gw, NGW, lane); }
        SEAM(pb + 2);
        if (IN(pb + 3)) { PH_WS(); pg8::Gemm g{U, (const bf16*)(wl + WO_IN), MTOK, NINP, DM}; pg8::StaticOrder S; S.init(MTOK, NINP, G, blk);
            EpiInProj E{ws};
            pg8::gemm_phase<EpiInProj, pg8::StaticOrder, true, true>(L, g, S, E); }
        SEAM(pb + 3);
        if (IN(pb + 4)) { PH_WS(); pg8::Gemm g{(const bf16*)(ws + WS_KCR), (const bf16*)(wl + WO_CMP), 8192, 512, DM}; CmpOrder S{blk, G}; EpiPQ E{(float*)(ws + WS_PQ)};
            pg8::gemm_phase<EpiPQ, CmpOrder, false, true>(L, g, S, E); }
        SEAM(pb + 4);
        if (IN(pb + 5)) {
            PH_IDS();
            const float* b1T = (const float*)(ws + WS_TAB + TAB_B1); const float* PQ = (const float*)(ws + WS_PQ); bf16* CC = (bf16*)(ws + WS_CC); LAS float* hs = (LAS float*)(L + wave * 1024);
            for (int r = gw; r < 2 * 32 * 128; r += NGW) {
                const int kv = r >> 12, bgn = r & 4095, n = bgn & 127;
                if (n == 127) { CC[(size_t)r * 64 + lane] = 0; continue; }
                const float* w2 = args.in[10] + (size_t)(l * 2 + kv) * 128 * 64; const float* b1 = b1T + (l * 2 + kv) * 128;
#pragma unroll
                for (int q2 = 0; q2 < 2; ++q2) { const int c = lane + 64 * q2; const float v = PQ[(size_t)r * 256 + c] + PQ[(size_t)(r + 1) * 256 + 128 + c] + b1[c];
                    const float u3 = 0.7978845608028654f * (v + 0.044715f * v * v * v); hs[c] = 0.5f * v * (1.f + tanhf(u3)); }
                LDS_WAIT(); asm volatile("" ::: "memory");
                float o = 0.f;
#pragma unroll 8
                for (int c = 0; c < 128; ++c) o += hs[c] * w2[c * 64 + lane];
                CC[(size_t)r * 64 + lane] = (bf16)f2bf(o);
                LDS_WAIT(); asm volatile("" ::: "memory");
            }
        }
        SEAM(pb + 5);
        if (IN(pb + 6)) {
            PH_WS();
            MixPtrs P{ws, args.in[11] + (size_t)l * 4 * 1024, args.in[12] + (size_t)l * 1024, args.in[13] + l * 4, args.in[14] + l * 4, args.in[15] + l * 512};
            const int nml = (G > 64) ? 64 : 0;
            if (blk < nml) mlstm_unit_simple(L, P, blk >> 2, blk & 3);
            else { for (int u = blk - nml; u < 1024; u += G - nml) { const int c = 31 - (u >> 5), bg = u & 31; nsa_unit_simple(L, P, bg >> 1, bg & 1, c); } }
            if (nml == 0) { for (int u = blk; u < 64; u += G) mlstm_unit_simple(L, P, u >> 2, u & 3); }
        }
        SEAM(pb + 6);
        if (IN(pb + 7)) { PH_WS(); pg8::Gemm g{U, (const bf16*)(wl + WO_OUT), MTOK, DM, DM}; pg8::StaticOrder S; S.init(MTOK, DM, G, blk); pg8::EpiBf16<0> E{HD, DM, nullptr, 0, 0, 1.f};
            pg8::gemm_phase<pg8::EpiBf16<0>, pg8::StaticOrder, true, true>(L, g, S, E); }
        SEAM(pb + 7);
        if (IN(pb + 8)) { PH_IDS(); thin_phase<1>(HD, xres, xres, ng + 3 * DM, 1.0f, ng + 4 * DM, U, gw, NGW, lane); }
        SEAM(pb + 8);
        if (IN(pb + 9)) { PH_WS(); pg8::Gemm g{U, (const bf16*)(wl + WO_GU2), MTOK, NGU, DM}; pg8::StaticOrder S; S.init(MTOK, NGU, G, blk); EpiSwiglu E{HB};
            pg8::gemm_phase<EpiSwiglu, pg8::StaticOrder, true, true>(L, g, S, E); }
        SEAM(pb + 9);
        if (IN(pb + 10)) { PH_WS(); pg8::Gemm g{HB, (const bf16*)(wl + WO_DN2), MTOK, DM, FF}; pg8::StaticOrder S; S.init(MTOK, DM, G, blk); pg8::EpiBf16<0> E{HD, DM, nullptr, 0, 0, 1.f};
            pg8::gemm_phase<pg8::EpiBf16<0>, pg8::StaticOrder, true, true>(L, g, S, E); }
        SEAM(pb + 10);
        if (IN(pb + 11)) { PH_IDS(); if (l + 1 < DEPTH) thin_phase<1>(HD, xres, xres, ng + 5 * DM, 0.5f, ng + 6 * DM, U, gw, NGW, lane);
                           else thin_phase<2>(HD, xres, xres, ng + 5 * DM, 0.5f, nullptr, nullptr, gw, NGW, lane); }
        if (l + 1 < DEPTH) SEAM(pb + 11);
    }
#undef IN
#undef SEAM
#undef PH_IDS
#undef PH_WS
}

extern "C" void kernel_launch(void* const* d_in, const int* in_sizes, int n_in, void* d_out, int out_size, void* d_ws, size_t ws_size, hipStream_t stream) {
    static int grid = 0;
    if (grid == 0) {
        if (n_in != 16 || in_sizes[0] != MTOK * DM || out_size != MTOK * DM || ws_size < WS_END) { fprintf(stderr, "kernel_launch: unexpected problem (n_in %d, ws %zu)\n", n_in, ws_size); grid = -1; return; }
        int dev = 0, cus = 0, per_cu = 0;
        if (hipGetDevice(&dev) != hipSuccess || hipDeviceGetAttribute(&cus, hipDeviceAttributeMultiprocessorCount, dev) != hipSuccess) { grid = -1; return; }
        if (hipFuncSetAttribute((const void*)fwd_kernel, hipFuncAttributeMaxDynamicSharedMemorySize, LDS_BYTES) != hipSuccess) { grid = -1; return; }
        if (hipOccupancyMaxActiveBlocksPerMultiprocessor(&per_cu, (const void*)fwd_kernel, NWAVES * 64, LDS_BYTES) != hipSuccess || per_cu < 1) { fprintf(stderr, "kernel_launch: occupancy query says %d\n", per_cu); }
        (void)hipGetLastError();
        grid = cus;
    }
    if (grid < 0) return;
    (void)hipMemsetAsync((char*)d_ws + WS_CTL, 0, CTL_ZERO_BYTES, stream);
    Args a{};
    for (int i = 0; i < 16; ++i) a.in[i] = (const float*)d_in[i];
    a.out = (float*)d_out; a.ws = (unsigned char*)d_ws;
#if MK_MULTI
    for (int p = 0; p < N_PHASES; ++p) { a.ph_lo = p; a.ph_hi = p + 1; hipLaunchKernelGGL(fwd_kernel, dim3(grid), dim3(NWAVES * 64), LDS_BYTES, stream, a); }
#else
    a.ph_lo = 0; a.ph_hi = N_PHASES; hipLaunchKernelGGL(fwd_kernel, dim3(grid), dim3(NWAVES * 64), LDS_BYTES, stream, a);
#endif
}
```

```cpp
#include <hip/hip_runtime.h>
#include <cstdio>
#include <cstdint>
namespace pg8 {
#define PG8_LAS __attribute__((address_space(3)))
typedef unsigned short bf16_t;
typedef short bf16x8 __attribute__((ext_vector_type(8)));
typedef float f32x4 __attribute__((ext_vector_type(4)));
typedef unsigned u32x4 __attribute__((ext_vector_type(4)));
constexpr int BM = 256, BK = 64, HALF = 128, HTB = HALF * BK * 2  , STAGE_BYTES = 8 * HTB, NXCD = 8, WGM = 8;

__host__ __device__ __forceinline__ int lds_byte(int r, int c) { const int st = (r >> 4) * 2 + (c >> 5), rr = r & 15, cc = c & 31, ob = rr * 64 + cc * 2; return st * 1024 + (ob ^ (((ob >> 9) & 1) << 5)); }
__host__ __device__ __forceinline__ void stage_rc(int b, int& R, int& C) { const int st = b / 1024, sb = b % 1024, swz = sb ^ (((sb >> 9) & 1) << 5); R = (st >> 1) * 16 + swz / 64; C = (st & 1) * 32 + (swz % 64) / 2; }
__host__ __device__ __forceinline__ int perm32(int rho) { const int n = rho >> 4, i = rho & 15; return 8 * (i >> 2) + 4 * n + (i & 3); }

struct Unit { int pm, pn; };
struct Gemm { const bf16_t* A; const bf16_t* Bt; int M, N, K; };

struct StaticOrder {
    int nM, nN, nwg, G, c;
    __host__ __device__ void init(int M, int N, int G_, int c_) { nM = M / BM; nN = N / BM; nwg = nM * nN; G = G_; c = c_; }
    __host__ __device__ bool next(int i, Unit& u) const {
        const long L = (long)i * G + c; if (L >= nwg) return false;
        int wgid = (int)L; { const int q = nwg / NXCD, r = nwg % NXCD, xcd = wgid % NXCD, off = wgid / NXCD; wgid = (xcd < r ? xcd * (q + 1) : r * (q + 1) + (xcd - r) * q) + off; }
        const int nig = WGM * nN, gid = wgid / nig, fm = gid * WGM, gsz = (nM - fm) < WGM ? (nM - fm) : WGM;
        u.pm = fm + ((wgid % nig) % gsz); u.pn = (wgid % nig) / gsz; return true;
    }
    __device__ __forceinline__ void a_ready(const Unit&) const {}
    __device__ __forceinline__ void done(const Unit&) const {}
};

__device__ __forceinline__ unsigned cvt_pk_bf16(float lo, float hi) { unsigned r; asm volatile("v_cvt_pk_bf16_f32 %0, %1, %2" : "=v"(r) : "v"(lo), "v"(hi)); return r; }
typedef float f32x2 __attribute__((ext_vector_type(2)));
__device__ __forceinline__ f32x2 gelu_pk(f32x2 v) {
    const f32x2 av = __builtin_elementwise_abs(v), d = av * 0.2316418882f + 1.0f;
    f32x2 t; t.x = __builtin_amdgcn_rcpf(d.x); t.y = __builtin_amdgcn_rcpf(d.y);
    f32x2 q = t * 0.5307027145f + (-0.7265760135f); q = q * t + 0.7107068705f; q = q * t + (-0.142248368f); q = q * t + 0.127414796f; q = q * t;
    const f32x2 s = (v * v) * (-0.72134752044f);
    f32x2 e; e.x = __builtin_amdgcn_exp2f(s.x); e.y = __builtin_amdgcn_exp2f(s.y);
    const f32x2 m = v * (q * e), r = v - m;
    f32x2 o; o.x = v.x < 0.f ? m.x : r.x; o.y = v.y < 0.f ? m.y : r.y; return o;
}

template <int ACT  > struct EpiBf16 {
    static constexpr bool PERM = true, AFTER_DRAIN = false; static_assert(ACT == 0 || ACT == 1, "EpiBf16: ACT is 0 (none) or 1 (gelu_pk)");
    bf16_t* O; int ldc; const float* bias; int split_cols; size_t split_stride; float scale0;
    __device__ __forceinline__ void operator()(const f32x4 (&acc)[2][2][4][2], const Unit& u, int wr, int wc, int fr, int fq) const {
        const int row0 = u.pm * BM + wr * 64 + fr; int colt = u.pn * BM; bf16_t* base = O;
        float sc = 1.f; if (split_cols) { const int t = colt / split_cols; base += (size_t)t * split_stride; colt -= t * split_cols; if (t == 0) sc = scale0; }
        const int col0 = colt + wc * 32 + 8 * fq, bcol0 = u.pn * BM + wc * 32 + 8 * fq;
        f32x4 bv[2][2];
#pragma unroll
        for (int bj = 0; bj < 2; ++bj)
#pragma unroll
            for (int n = 0; n < 2; ++n) bv[bj][n] = bias ? *(const f32x4*)(bias + bcol0 + bj * HALF + 4 * n) : (f32x4){0.f, 0.f, 0.f, 0.f};
#pragma unroll
        for (int ai = 0; ai < 2; ++ai)
#pragma unroll
            for (int m = 0; m < 4; ++m) { bf16_t* rowp = base + (size_t)(row0 + ai * HALF + m * 16) * ldc + col0;
#pragma unroll
                for (int bj = 0; bj < 2; ++bj) { f32x4 v0 = acc[ai][bj][m][0] + bv[bj][0], v1 = acc[ai][bj][m][1] + bv[bj][1];
                    if (ACT == 1) { f32x2 a = gelu_pk((f32x2){v0[0], v0[1]}), b = gelu_pk((f32x2){v0[2], v0[3]}), c = gelu_pk((f32x2){v1[0], v1[1]}), d = gelu_pk((f32x2){v1[2], v1[3]});
                        v0 = (f32x4){a.x, a.y, b.x, b.y}; v1 = (f32x4){c.x, c.y, d.x, d.y}; }
                    v0 = v0 * sc; v1 = v1 * sc; u32x4 w; w.x = cvt_pk_bf16(v0[0], v0[1]); w.y = cvt_pk_bf16(v0[2], v0[3]); w.z = cvt_pk_bf16(v1[0], v1[1]); w.w = cvt_pk_bf16(v1[2], v1[3]);
                    *(u32x4*)(rowp + bj * HALF) = w; } }
    }
};
template <class Epi, class Sched, bool ALIGN_EPI = false, bool SP2 = false>
__device__ __forceinline__ void gemm_phase(PG8_LAS unsigned char* lds, const Gemm g, const Sched& S, const Epi& E) {
    int tid_l = threadIdx.x; asm volatile("" : "+v"(tid_l));
    const int tid = tid_l, wid = __builtin_amdgcn_readfirstlane(tid >> 6), lane = tid & 63, wr = wid >> 2, wc = wid & 3, fr = lane & 15, fq = lane >> 4;
    const int K = g.K, nt = K / BK;
    unsigned voffA[2], voffB[2];
#pragma unroll
    for (int i = 0; i < 2; ++i) { int R, C; stage_rc(tid * 16 + i * 8192, R, C); const int Rb = Epi::PERM ? ((R & ~31) + perm32(R & 31)) : R;
        voffA[i] = (unsigned)(R * K + C) * 2u; voffB[i] = (unsigned)(Rb * K + C) * 2u; }
    const size_t kstep = (size_t)(BK * 2);
    const size_t hstep = (size_t)HALF * K * 2;
    const size_t tstep = 2 * hstep;
    const unsigned ldsw = (unsigned)wid * 1024u;
    const int aoff = lds_byte(wr * 64 + fr, fq * 8), boff = lds_byte(wc * 32 + fr, fq * 8);
#define PG8_SA(b, h) (((b) * 2 + (h)) * HTB)
#define PG8_SB(b, h) ((4 + (b) * 2 + (h)) * HTB)
#define PG8_STAGE(bufoff, gbase, voff) do { _Pragma("unroll") for (int _i = 0; _i < 2; ++_i) \
        __builtin_amdgcn_global_load_lds((const unsigned*)((const char*)(gbase) + (voff)[_i]), (PG8_LAS unsigned*)(lds + (bufoff) + ldsw + _i * 8192), 16, 0, 0); } while (0)
#define PG8_LDA(dst, b, h) do { _Pragma("unroll") for (int m = 0; m < 4; ++m) _Pragma("unroll") for (int k = 0; k < 2; ++k) dst[m][k] = *(const PG8_LAS bf16x8*)(lds + PG8_SA(b, h) + aoff + m * 2048 + k * 1024); } while (0)
#define PG8_LDB(dst, b, h) do { _Pragma("unroll") for (int n = 0; n < 2; ++n) _Pragma("unroll") for (int k = 0; k < 2; ++k) dst[n][k] = *(const PG8_LAS bf16x8*)(lds + PG8_SB(b, h) + boff + n * 2048 + k * 1024); } while (0)
#define PG8_MMA(ai, bj, At, Bt) do { __builtin_amdgcn_s_setprio(1); _Pragma("unroll") for (int m = 0; m < 4; ++m) _Pragma("unroll") for (int n = 0; n < 2; ++n) _Pragma("unroll") for (int k = 0; k < 2; ++k) \
        acc[ai][bj][m][n] = __builtin_amdgcn_mfma_f32_16x16x32_bf16(Bt[n][k], At[m][k], acc[ai][bj][m][n], 0, 0, 0); __builtin_amdgcn_s_setprio(0); } while (0)
#define PG8_WAIT_V(n) asm volatile("s_waitcnt vmcnt(" #n ")" ::: "memory")
#define PG8_WAIT_L(n) asm volatile("s_waitcnt lgkmcnt(" #n ")" ::: "memory")
#define PG8_BAR __builtin_amdgcn_s_barrier()
#define PG8_SCHED __builtin_amdgcn_sched_barrier(0)
    Unit cur, nxt; int ui = 0;
    if (!S.next(0, cur)) return;
    f32x4 acc[2][2][4][2];
#pragma unroll
    for (int a = 0; a < 2; ++a)
#pragma unroll
        for (int b = 0; b < 2; ++b)
#pragma unroll
            for (int m = 0; m < 4; ++m)
#pragma unroll
                for (int n = 0; n < 2; ++n) acc[a][b][m][n] = (f32x4){0.f, 0.f, 0.f, 0.f};
    bf16x8 At[4][2], B0[2][2], B1[2][2];
    const char* cA = (const char*)g.A + (size_t)cur.pm * tstep; const char* cB = (const char*)g.Bt + (size_t)cur.pn * tstep;
    S.a_ready(cur);
    if constexpr (SP2) {
        PG8_STAGE(PG8_SB(0, 0), cB, voffB); PG8_STAGE(PG8_SB(0, 1), cB + hstep, voffB); PG8_STAGE(PG8_SA(0, 0), cA, voffA); PG8_STAGE(PG8_SA(0, 1), cA + hstep, voffA);
        if (wr == 1) PG8_BAR;
        PG8_WAIT_V(2); PG8_BAR;
        PG8_STAGE(PG8_SB(1, 0), cB + kstep, voffB); PG8_STAGE(PG8_SA(1, 0), cA + kstep, voffA); PG8_STAGE(PG8_SB(1, 1), cB + hstep + kstep, voffB);
        PG8_WAIT_V(6); PG8_BAR;
    } else {
        PG8_STAGE(PG8_SB(0, 0), cB, voffB); PG8_STAGE(PG8_SA(0, 0), cA, voffA); PG8_STAGE(PG8_SB(0, 1), cB + hstep, voffB); PG8_STAGE(PG8_SA(0, 1), cA + hstep, voffA);
        if (wr == 1) PG8_BAR;
        PG8_WAIT_V(4); PG8_BAR;
        PG8_STAGE(PG8_SB(1, 0), cB + kstep, voffB); PG8_STAGE(PG8_SA(1, 0), cA + kstep, voffA); PG8_STAGE(PG8_SB(1, 1), cB + hstep + kstep, voffB);
        PG8_WAIT_V(6); PG8_BAR;
    }
    for (;;) {
        const bool has_next = S.next(ui + 1, nxt);
        const char* nA = has_next ? (const char*)g.A + (size_t)nxt.pm * tstep : cA; const char* nB = has_next ? (const char*)g.Bt + (size_t)nxt.pn * tstep : cB;
        for (int t = 0; t < nt; t += 2) {
            const bool last = (t == nt - 2);
            const char* a1 = cA + (size_t)(t + 1) * kstep;
            const char* a2 = last ? nA : cA + (size_t)(t + 2) * kstep; const char* b2 = last ? nB : cB + (size_t)(t + 2) * kstep;
            const char* a3 = a2 + kstep; const char* b3 = b2 + kstep;
            if (last && has_next) S.a_ready(nxt);
            if constexpr (SP2) {
            PG8_LDB(B0, 0, 0); PG8_LDB(B1, 0, 1); PG8_SCHED; PG8_LDA(At, 0, 0); PG8_STAGE(PG8_SA(1, 1), a1 + hstep, voffA);
            PG8_WAIT_V(8); PG8_WAIT_L(0); PG8_BAR; PG8_MMA(0, 0, At, B0); PG8_MMA(0, 1, At, B1); PG8_BAR; PG8_SCHED;
            PG8_LDA(At, 0, 1); PG8_STAGE(PG8_SB(0, 0), b2, voffB); PG8_STAGE(PG8_SB(0, 1), b2 + hstep, voffB); PG8_STAGE(PG8_SA(0, 0), a2, voffA);
            PG8_WAIT_V(8); PG8_WAIT_L(0); PG8_BAR; PG8_MMA(1, 0, At, B0); PG8_MMA(1, 1, At, B1); PG8_BAR; PG8_SCHED;
            PG8_LDB(B0, 1, 0); PG8_LDB(B1, 1, 1); PG8_SCHED; PG8_LDA(At, 1, 0); PG8_STAGE(PG8_SA(0, 1), a2 + hstep, voffA);
            PG8_WAIT_V(8); PG8_WAIT_L(0); PG8_BAR; PG8_MMA(0, 0, At, B0); PG8_MMA(0, 1, At, B1); PG8_BAR; PG8_SCHED;
            PG8_LDA(At, 1, 1); PG8_STAGE(PG8_SB(1, 0), b3, voffB); PG8_STAGE(PG8_SB(1, 1), b3 + hstep, voffB); PG8_STAGE(PG8_SA(1, 0), a3, voffA);
            PG8_WAIT_V(8); PG8_WAIT_L(0); PG8_BAR; PG8_MMA(1, 0, At, B0); PG8_MMA(1, 1, At, B1); PG8_BAR; PG8_SCHED;
            } else {
            PG8_LDB(B0, 0, 0); PG8_SCHED; PG8_LDA(At, 0, 0); PG8_STAGE(PG8_SA(1, 1), a1 + hstep, voffA);
            PG8_WAIT_L(8); PG8_BAR; PG8_WAIT_L(0); PG8_MMA(0, 0, At, B0); PG8_BAR; PG8_SCHED;
            PG8_LDB(B1, 0, 1); PG8_STAGE(PG8_SB(0, 0), b2, voffB);
            PG8_BAR; PG8_WAIT_L(0); PG8_MMA(0, 1, At, B1); PG8_BAR;
            PG8_LDA(At, 0, 1); PG8_STAGE(PG8_SA(0, 0), a2, voffA);
            PG8_BAR; PG8_WAIT_L(0); PG8_MMA(1, 0, At, B0); PG8_BAR; PG8_SCHED;
            PG8_STAGE(PG8_SB(0, 1), b2 + hstep, voffB);
            PG8_WAIT_V(6); PG8_BAR; PG8_MMA(1, 1, At, B1); PG8_BAR;
            PG8_LDB(B0, 1, 0); PG8_SCHED; PG8_LDA(At, 1, 0); PG8_STAGE(PG8_SA(0, 1), a2 + hstep, voffA);
            PG8_WAIT_L(8); PG8_BAR; PG8_WAIT_L(0); PG8_MMA(0, 0, At, B0); PG8_BAR; PG8_SCHED;
            PG8_LDB(B1, 1, 1); PG8_STAGE(PG8_SB(1, 0), b3, voffB);
            PG8_BAR; PG8_WAIT_L(0); PG8_MMA(0, 1, At, B1); PG8_BAR;
            PG8_LDA(At, 1, 1); PG8_STAGE(PG8_SA(1, 0), a3, voffA);
            PG8_BAR; PG8_WAIT_L(0); PG8_MMA(1, 0, At, B0); PG8_BAR; PG8_SCHED;
            PG8_STAGE(PG8_SB(1, 1), b3 + hstep, voffB);
            PG8_WAIT_V(6); PG8_BAR; PG8_MMA(1, 1, At, B1); PG8_BAR;
            }
        }
        if constexpr (ALIGN_EPI) { if (wr == 0) PG8_BAR; }
        if constexpr (!Epi::AFTER_DRAIN) { E(acc, cur, wr, wc, fr, fq); S.done(cur); }
        if (!has_next) break;
#pragma unroll
        for (int a = 0; a < 2; ++a)
#pragma unroll
            for (int b = 0; b < 2; ++b)
#pragma unroll
                for (int m = 0; m < 4; ++m)
#pragma unroll
                    for (int n = 0; n < 2; ++n) acc[a][b][m][n] = (f32x4){0.f, 0.f, 0.f, 0.f};
        cur = nxt; cA = nA; cB = nB; ++ui;
        if constexpr (ALIGN_EPI) { if (wr == 1) PG8_BAR; }
    }
    PG8_WAIT_V(0);
    if constexpr (!ALIGN_EPI) { if (wr == 0) PG8_BAR; }
    PG8_BAR;
    if constexpr (Epi::AFTER_DRAIN) { E.fused(acc, cur, wr, wc, fr, fq, lds, wid, lane); S.done(cur); }
#undef PG8_SA
#undef PG8_SB
#undef PG8_STAGE
#undef PG8_LDA
#undef PG8_LDB
#undef PG8_MMA
#undef PG8_WAIT_V
#undef PG8_WAIT_L
#undef PG8_BAR
#undef PG8_SCHED
}
}

#define LAS __attribute__((address_space(3)))
#define XB_TMO      128
#define XB_XCNT(j)  (256  + 64 * (j))
#define XB_XSUB(j)  (1280 + 64 * (j))
#define XB_XGEN(j)  (2304 + 64 * (j))
#define XB_TOP      3328
#define XB_TOPGEN   3392
#define XCD_BAR_WORDS 3456
#define XB_SPIN_CAP (1u << 18)

__device__ __forceinline__ unsigned xb_ld(unsigned* p)              { return __hip_atomic_load(p, __ATOMIC_RELAXED, __HIP_MEMORY_SCOPE_AGENT); }
__device__ __forceinline__ unsigned xb_add(unsigned* p, unsigned v) { return __hip_atomic_fetch_add(p, v, __ATOMIC_RELAXED, __HIP_MEMORY_SCOPE_AGENT); }
__device__ __forceinline__ unsigned xb_xcc_id() { return (unsigned)__builtin_amdgcn_s_getreg((3 << 11) | 20) & 0xFu; }
#define XB_SPIN(cond, bar) do { unsigned _sp = 0; while (cond) { __builtin_amdgcn_s_sleep(1); \
    if ((++_sp & 255u) == 0u) { if (xb_ld(&(bar)[XB_TMO])) break; if (_sp > XB_SPIN_CAP) { atomicAdd(&(bar)[XB_TMO], 1u); break; } } } } while (0)

struct XcdBarrier {
    unsigned* bar; unsigned x;
    volatile LAS unsigned* st;
};

__device__ __forceinline__ XcdBarrier xcd_barrier_post(unsigned* bar, volatile LAS unsigned* st) {
    XcdBarrier b; b.bar = bar; b.x = xb_xcc_id(); b.st = st;
    if (threadIdx.x == 0) (void)xb_add(&bar[XB_XCNT(b.x)], 1u);
    return b;
}
__device__ __forceinline__ void xcd_barrier_complete(unsigned* bar, unsigned x, unsigned& nloc, unsigned& nx) {
    const unsigned G = gridDim.x * gridDim.y * gridDim.z;
    unsigned sum, cnt, mine, sp = 0u;
    for (;;) {
        sum = 0u; cnt = 0u; mine = 0u;
#pragma unroll
        for (unsigned j = 0; j < 16; ++j) { const unsigned c = xb_ld(&bar[XB_XCNT(j)]); sum += c; cnt += (c > 0u) ? 1u : 0u; mine = (j == x) ? c : mine; }
        if (sum == G) break;
        __builtin_amdgcn_s_sleep(1);
        if ((++sp & 255u) == 0u) { if (xb_ld(&bar[XB_TMO])) break; if (sp > XB_SPIN_CAP) { atomicAdd(&bar[XB_TMO], 1u); break; } }
    }
    nloc = mine > 0u ? mine : 1u; nx = cnt > 0u ? cnt : 1u;
}

__device__ __forceinline__ void xcd_barrier(const XcdBarrier& b) {
    asm volatile("s_waitcnt vmcnt(0)" ::: "memory");
    __syncthreads();
    if (threadIdx.x == 0) {
        unsigned* bar = b.bar;
        __builtin_amdgcn_s_waitcnt(0);
        unsigned nloc = b.st[0], nx = b.st[1];
        if (nloc == 0u) { xcd_barrier_complete(bar, b.x, nloc, nx); b.st[0] = nloc; b.st[1] = nx; }
        const unsigned old = xb_add(&bar[XB_XSUB(b.x)], 1u);
        const unsigned gen = old / nloc;
        if (old + 1u == (gen + 1u) * nloc) {
            __builtin_amdgcn_fence(__ATOMIC_RELEASE, "agent");
            asm volatile("s_waitcnt vmcnt(0)" ::: "memory");
            const unsigned og = xb_add(&bar[XB_TOP], 1u);
            const unsigned tg = og / nx;
            if (og + 1u == (tg + 1u) * nx) xb_add(&bar[XB_TOPGEN], 1u);
            else XB_SPIN(xb_ld(&bar[XB_TOPGEN]) == tg, bar);
            __builtin_amdgcn_fence(__ATOMIC_ACQUIRE, "agent");
            xb_add(&bar[XB_XGEN(b.x)], 1u);
            asm volatile("s_waitcnt vmcnt(0)" ::: "memory");
        } else {
            XB_SPIN(xb_ld(&bar[XB_XGEN(b.x)]) == gen, bar);
            __builtin_amdgcn_fence(__ATOMIC_ACQUIRE, "agent");
            asm volatile("s_waitcnt vmcnt(0)" ::: "memory");
        }
    }
    __syncthreads();
}

constexpr int BATCH = 16, SEQ = 2048, DM = 1024, MTOK = BATCH * SEQ, FF = 2816, NGU = 2 * FF, NINP = 3584, INCOLS = 3360, DEPTH = 2;
constexpr int NWAVES = 8;
constexpr float EPS = 1e-6f;
typedef unsigned short bf16;
typedef unsigned v4u __attribute__((ext_vector_type(4)));
typedef unsigned v2u __attribute__((ext_vector_type(2)));
typedef float f32x4 __attribute__((ext_vector_type(4)));
#define LDS_WAIT() asm volatile("s_waitcnt lgkmcnt(0)" ::: "memory")

constexpr size_t MiB = 1u << 20;
constexpr size_t WS_CTL = 0, CTL_ZERO_BYTES = MiB;
constexpr size_t WS_TAB = 1 * MiB;
constexpr size_t TAB_COS = 0, TAB_SIN = 65536, TAB_B1 = 131072;
constexpr size_t WS_W = 2 * MiB, W_LAYER = 43 * MiB;
constexpr size_t WO_GU1 = 0, WO_DN1 = 11 * MiB, WO_GU2 = 16 * MiB + MiB / 2, WO_DN2 = 27 * MiB + MiB / 2, WO_IN = 33 * MiB, WO_OUT = 40 * MiB, WO_CMP = 42 * MiB;
constexpr size_t WS_U = 88 * MiB;
constexpr size_t WS_HB = 152 * MiB;
constexpr size_t WS_HD = 328 * MiB;
constexpr size_t WS_PQ = 392 * MiB;
constexpr size_t WS_CC = 400 * MiB;
constexpr size_t WS_END = 401 * MiB;
constexpr size_t WS_QN = 152 * MiB, WS_KCR = 184 * MiB, WS_VCR = 192 * MiB, WS_KS = 200 * MiB, WS_VS = 208 * MiB, WS_KW = 216 * MiB, WS_VW = 224 * MiB;
constexpr size_t WS_MQ = 232 * MiB, WS_MK = 264 * MiB, WS_MV = 296 * MiB, WS_MO = 328 * MiB, WS_GATE = 360 * MiB;
static_assert(WS_GATE + 4 * MiB <= WS_PQ, "in-projection outputs end below PQ");
constexpr int CW_BAR = 4096;
constexpr int PH_BYTES = 143360, MISC_OFF = PH_BYTES, LDS_BYTES = 147456;

__device__ __forceinline__ unsigned f2bf(float f) { unsigned u = __builtin_bit_cast(unsigned, f); return (u + 0x7fffu + ((u >> 16) & 1u)) >> 16; }
__device__ __forceinline__ unsigned pk2(float lo, float hi) { return f2bf(lo) | (f2bf(hi) << 16); }
__device__ __forceinline__ float bflo(unsigned u) { return __builtin_bit_cast(float, u << 16); }
__device__ __forceinline__ float bfhi(unsigned u) { return __builtin_bit_cast(float, u & 0xffff0000u); }
__device__ __forceinline__ float bf2f(bf16 b) { return __builtin_bit_cast(float, (unsigned)b << 16); }
__device__ __forceinline__ float sigmoidf_(float x) { return 1.f / (1.f + __expf(-x)); }
__device__ __forceinline__ float wave_sum(float v) {
#pragma unroll
    for (int o = 1; o < 64; o <<= 1) v += __shfl_xor(v, o);
    return v;
}

struct SrcGU { const float* W; __device__ __forceinline__ float operator()(int k, int nd) const { const int pn = nd >> 8, r = nd & 255; const int col = (r < 128) ? (pn * 128 + r) : (FF + pn * 128 + r - 128); return W[(size_t)k * NGU + col]; } };
struct SrcPlain { const float* W; int N; __device__ __forceinline__ float operator()(int k, int nd) const { return W[(size_t)k * N + nd]; } };
struct SrcIN { const float* W; __device__ __forceinline__ float operator()(int k, int nd) const {
    const int col = nd < 1280 ? nd : (nd < 3328 ? nd + 24 : (nd < 3352 ? nd - 3328 + 1280 : (nd < 3360 ? nd : -1)));
    return col < 0 ? 0.f : W[(size_t)k * INCOLS + col]; } };
struct SrcCMP { const float* W1; __device__ __forceinline__ float operator()(int k, int nd) const { const int kv = nd >> 8, r = nd & 255;
    return r < 128 ? W1[((size_t)kv * 2048 + k) * 128 + r] : W1[((size_t)kv * 2048 + 1024 + k) * 128 + r - 128]; } };

template <class SrcF>
__device__ __forceinline__ void transpose_item(const SrcF& src, int K, bf16* WT, LAS float* scr, int kb, int nb, int lane) {
    const int k0 = 64 * kb, n0 = 32 * nb;
#pragma unroll 8
    for (int i = 0; i < 32; ++i) { const int kk = 2 * i + (lane >> 5); scr[kk * 33 + (lane & 31)] = src(k0 + kk, n0 + (lane & 31)); }
    LDS_WAIT(); asm volatile("" ::: "memory");
    const int c = lane & 7;
#pragma unroll
    for (int j = 0; j < 4; ++j) { const int n = (lane >> 3) + 8 * j; const LAS float* s = scr + (8 * c) * 33 + n;
        v4u o; o.x = pk2(s[0 * 33], s[1 * 33]); o.y = pk2(s[2 * 33], s[3 * 33]); o.z = pk2(s[4 * 33], s[5 * 33]); o.w = pk2(s[6 * 33], s[7 * 33]);
        *(v4u*)(WT + (size_t)(n0 + n) * K + k0 + 8 * c) = o; }
    LDS_WAIT(); asm volatile("" ::: "memory");
}

template <int MODE>
__device__ __forceinline__ void thin_phase(const bf16* HD, const float* xin, float* xout, const float* gpost, float cc, const float* gpre, bf16* U, int gw, int NGW, int lane) {
    f32x4 gp[4], gq[4];
#pragma unroll
    for (int j = 0; j < 4; ++j) { gp[j] = (MODE != 0) ? *(const f32x4*)(gpost + 4 * lane + 256 * j) : (f32x4){0.f, 0.f, 0.f, 0.f};
                                  gq[j] = (MODE != 2) ? *(const f32x4*)(gpre + 4 * lane + 256 * j) : (f32x4){0.f, 0.f, 0.f, 0.f}; }
    for (int m = gw; m < MTOK; m += NGW) {
        f32x4 x[4];
#pragma unroll
        for (int j = 0; j < 4; ++j) x[j] = *(const f32x4*)(xin + (size_t)m * DM + 4 * lane + 256 * j);
        if (MODE != 0) {
            f32x4 h[4]; float ss = 0.f;
#pragma unroll
            for (int j = 0; j < 4; ++j) { const v2u w = *(const v2u*)(HD + (size_t)m * DM + 4 * lane + 256 * j);
                h[j] = (f32x4){bflo(w.x), bfhi(w.x), bflo(w.y), bfhi(w.y)}; ss += (h[j].x * h[j].x + h[j].y * h[j].y) + (h[j].z * h[j].z + h[j].w * h[j].w); }
            const float r = cc * __frsqrt_rn(wave_sum(ss) * (1.f / DM) + EPS);
#pragma unroll
            for (int j = 0; j < 4; ++j) x[j] = x[j] + (h[j] * r) * gp[j];
        }
#pragma unroll
        for (int j = 0; j < 4; ++j) *(f32x4*)(xout + (size_t)m * DM + 4 * lane + 256 * j) = x[j];
        if (MODE != 2) {
            float s2 = 0.f;
#pragma unroll
            for (int j = 0; j < 4; ++j) s2 += (x[j].x * x[j].x + x[j].y * x[j].y) + (x[j].z * x[j].z + x[j].w * x[j].w);
            const float r2 = __frsqrt_rn(wave_sum(s2) * (1.f / DM) + EPS);
#pragma unroll
            for (int j = 0; j < 4; ++j) { const f32x4 y = (x[j] * r2) * gq[j]; v2u w; w.x = pk2(y.x, y.y); w.y = pk2(y.z, y.w);
                *(v2u*)(U + (size_t)m * DM + 4 * lane + 256 * j) = w; }
        }
    }
}

struct EpiSwiglu {
    static constexpr bool PERM = true, AFTER_DRAIN = false;
    bf16* H;
    __device__ __forceinline__ void operator()(const pg8::f32x4 (&acc)[2][2][4][2], const pg8::Unit& u, int wr, int wc, int fr, int fq) const {
#pragma unroll
        for (int ai = 0; ai < 2; ++ai)
#pragma unroll
            for (int m = 0; m < 4; ++m) {
                const int row = u.pm * 256 + ai * 128 + wr * 64 + m * 16 + fr;
                float o[8];
#pragma unroll
                for (int n = 0; n < 2; ++n)
#pragma unroll
                    for (int e = 0; e < 4; ++e) { const float g = acc[ai][0][m][n][e], up = acc[ai][1][m][n][e]; o[n * 4 + e] = g * up / (1.f + __expf(-g)); }
                v4u w; w.x = pg8::cvt_pk_bf16(o[0], o[1]); w.y = pg8::cvt_pk_bf16(o[2], o[3]); w.z = pg8::cvt_pk_bf16(o[4], o[5]); w.w = pg8::cvt_pk_bf16(o[6], o[7]);
                *(v4u*)(H + (size_t)row * FF + u.pn * 128 + wc * 32 + fq * 8) = w;
            }
    }
};
struct EpiPQ {
    static constexpr bool PERM = true, AFTER_DRAIN = false;
    float* O;
    __device__ __forceinline__ void operator()(const pg8::f32x4 (&acc)[2][2][4][2], const pg8::Unit& u, int wr, int wc, int fr, int fq) const {
#pragma unroll
        for (int ai = 0; ai < 2; ++ai)
#pragma unroll
            for (int m = 0; m < 4; ++m) {
                const int row = u.pm * 256 + ai * 128 + wr * 64 + m * 16 + fr;
#pragma unroll
                for (int bj = 0; bj < 2; ++bj) { float* p = O + (size_t)row * 256 + bj * 128 + wc * 32 + fq * 8;
                    *(pg8::f32x4*)p = acc[ai][bj][m][0]; *(pg8::f32x4*)(p + 4) = acc[ai][bj][m][1]; }
            }
    }
};
struct CmpOrder {
    int c, G;
    __device__ __forceinline__ bool next(int i, pg8::Unit& u) const { const int idx = i * G + c; if (idx >= 32) return false; u.pm = idx; u.pn = idx >> 4; return true; }
    __device__ __forceinline__ void a_ready(const pg8::Unit&) const {}
    __device__ __forceinline__ void done(const pg8::Unit&) const {}
};
struct EpiInProj {
    static constexpr bool PERM = true, AFTER_DRAIN = false;
    unsigned char* ws;
    __device__ __forceinline__ void operator()(const pg8::f32x4 (&acc)[2][2][4][2], const pg8::Unit& u, int wr, int wc, int fr, int fq) const {
        const int pn = u.pn;
        const float* cosT = (const float*)(ws + WS_TAB + TAB_COS); const float* sinT = (const float*)(ws + WS_TAB + TAB_SIN);
        const bool ropet = (pn < 2) || (pn == 3) || (pn == 4);
        const bool ropew = ropet && ((wc & 1) == 0);
#pragma unroll
        for (int ai = 0; ai < 2; ++ai)
#pragma unroll
            for (int m = 0; m < 4; ++m) {
                const int row = u.pm * 256 + ai * 128 + wr * 64 + m * 16 + fr;
                const int b = row >> 11, t = row & 2047;
                f32x4 c0, c1, s0, s1;
                if (ropew) { c0 = *(const f32x4*)(cosT + t * 8); c1 = *(const f32x4*)(cosT + t * 8 + 4); s0 = *(const f32x4*)(sinT + t * 8); s1 = *(const f32x4*)(sinT + t * 8 + 4); }
#pragma unroll
                for (int bj = 0; bj < 2; ++bj) {
                    f32x4 v0 = acc[ai][bj][m][0], v1 = acc[ai][bj][m][1];
                    const int cl = bj * 128 + wc * 32 + fq * 8;
                    if (ropew && (pn < 2 || bj == 0)) {
                        f32x4 p0, p1;
                        p0.x = __shfl_xor(v0.x, 16); p0.y = __shfl_xor(v0.y, 16); p0.z = __shfl_xor(v0.z, 16); p0.w = __shfl_xor(v0.w, 16);
                        p1.x = __shfl_xor(v1.x, 16); p1.y = __shfl_xor(v1.y, 16); p1.z = __shfl_xor(v1.z, 16); p1.w = __shfl_xor(v1.w, 16);
                        const float sg = (fq == 0) ? -1.f : 1.f;
                        if (fq < 2) { v0 = v0 * c0 + (p0 * s0) * sg; v1 = v1 * c1 + (p1 * s1) * sg; }
                    }
                    if (pn == 13) { if (cl < 32) { float* p = (float*)(ws + WS_GATE) + (size_t)row * 32 + cl; *(f32x4*)p = v0; *(f32x4*)(p + 4) = v1; } }
                    else {
                        size_t off;
                        if (pn < 2) off = WS_QN + ((size_t)row * 512 + pn * 256 + cl) * 2;
                        else if (pn < 5) { const int g = wc >> 1, d = (wc & 1) * 32 + fq * 8; off = WS_KCR + (size_t)((pn - 2) * 2 + bj) * (8 * MiB) + (((size_t)(b * 2 + g) * SEQ + t) * 64 + d) * 2; }
                        else { const int q = pn - 5; off = WS_MQ + (size_t)(q >> 1) * (32 * MiB) + ((size_t)row * 512 + (q & 1) * 256 + cl) * 2; }
                        v4u w; w.x = pg8::cvt_pk_bf16(v0.x, v0.y); w.y = pg8::cvt_pk_bf16(v0.z, v0.w); w.z = pg8::cvt_pk_bf16(v1.x, v1.y); w.w = pg8::cvt_pk_bf16(v1.z, v1.w);
                        *(v4u*)(ws + off) = w;
                    }
                }
            }
    }
};
static_assert(WS_VCR == WS_KCR + 8 * MiB && WS_KS == WS_KCR + 16 * MiB && WS_VS == WS_KCR + 24 * MiB && WS_KW == WS_KCR + 32 * MiB && WS_VW == WS_KCR + 40 * MiB, "kv buffers are 8 MiB apart in (pn, bj) order");
static_assert(WS_MK == WS_MQ + 32 * MiB && WS_MV == WS_MQ + 64 * MiB && WS_MO == WS_MQ + 96 * MiB, "mLSTM buffers are 32 MiB apart");

__device__ __forceinline__ float dot64(const float (&q)[64], const LAS unsigned char* krow) {
    float s0 = 0.f, s1 = 0.f;
#pragma unroll
    for (int c8 = 0; c8 < 8; ++c8) { const v4u kk = *(const LAS v4u*)(krow + c8 * 16);
        s0 += q[c8 * 8 + 0] * bflo(kk.x) + q[c8 * 8 + 2] * bflo(kk.y) + q[c8 * 8 + 4] * bflo(kk.z) + q[c8 * 8 + 6] * bflo(kk.w);
        s1 += q[c8 * 8 + 1] * bfhi(kk.x) + q[c8 * 8 + 3] * bfhi(kk.y) + q[c8 * 8 + 5] * bfhi(kk.z) + q[c8 * 8 + 7] * bfhi(kk.w); }
    return s0 + s1;
}
__device__ __forceinline__ unsigned long long bits_upto(int hi) { return hi < 0 ? 0ull : (hi >= 63 ? ~0ull : ((2ull << hi) - 1ull)); }

struct MixPtrs { unsigned char* ws; const float *conv_w, *conv_b, *i_bias, *f_bias, *mnorm_g; };
#define MP_QN ((const bf16*)(P.ws + WS_QN))
#define MP_KS ((const bf16*)(P.ws + WS_KS))
#define MP_VS ((const bf16*)(P.ws + WS_VS))
#define MP_KW ((const bf16*)(P.ws + WS_KW))
#define MP_VW ((const bf16*)(P.ws + WS_VW))
#define MP_KC ((const bf16*)(P.ws + WS_CC))
#define MP_VC ((const bf16*)(P.ws + WS_CC) + (size_t)4096 * 64)
#define MP_MQ ((const bf16*)(P.ws + WS_MQ))
#define MP_MK ((const bf16*)(P.ws + WS_MK))
#define MP_MV ((const bf16*)(P.ws + WS_MV))
#define MP_MO ((const bf16*)(P.ws + WS_MO))
#define MP_GATE ((const float*)(P.ws + WS_GATE))
#define MP_Y ((bf16*)(P.ws + WS_U))

constexpr int NS_KT = 0, NS_VT = 8192, NS_IMP = 16384, NS_IMS = 50176, NS_SEL = 58624, NS_OUT = 59136;
__device__ __forceinline__ void nsa_unit_simple(LAS unsigned char* L, const MixPtrs& P, int b, int g, int c) {
    int tid_l = threadIdx.x; asm volatile("" : "+v"(tid_l));
    const int tid = tid_l, lane = tid & 63, w = __builtin_amdgcn_readfirstlane(tid >> 6);
    const bool act = w < 4; const int h = w & 3, t = c * 64 + lane; const size_t row = (size_t)b * SEQ + t;
    LAS float* OUT = (LAS float*)(L + NS_OUT) + tid * 65;
    LAS unsigned* SEL = (LAS unsigned*)(L + NS_SEL);
    float q[64];
    if (act) {
        const bf16* qp = MP_QN + row * 512 + (g * 4 + h) * 64;
#pragma unroll
        for (int c8 = 0; c8 < 8; ++c8) { const v4u v = *(const v4u*)(qp + c8 * 8);
            q[c8 * 8 + 0] = bflo(v.x) * 0.125f; q[c8 * 8 + 1] = bfhi(v.x) * 0.125f; q[c8 * 8 + 2] = bflo(v.y) * 0.125f; q[c8 * 8 + 3] = bfhi(v.y) * 0.125f;
            q[c8 * 8 + 4] = bflo(v.z) * 0.125f; q[c8 * 8 + 5] = bfhi(v.z) * 0.125f; q[c8 * 8 + 6] = bflo(v.w) * 0.125f; q[c8 * 8 + 7] = bfhi(v.w) * 0.125f; }
#pragma unroll
        for (int d = 0; d < 64; ++d) OUT[d] = 0.f;
    } else {
#pragma unroll
        for (int d = 0; d < 64; ++d) q[d] = 0.f;
    }
    const size_t kvbase = (size_t)(b * 2 + g) * SEQ * 64, ccbase = (size_t)(b * 2 + g) * 128 * 64;
    const int nlim = (t >= 31) ? (((t - 31) >> 4) < 126 ? ((t - 31) >> 4) : 126) : -1;
    unsigned un = 0u, mysel = 0u;
#pragma unroll 1
    for (int br = 0; br < 3; ++br) {
        float o[64], mx = -1e30f, l = 0.f;
#pragma unroll
        for (int d = 0; d < 64; ++d) o[d] = 0.f;
        int j0, j1; const bf16 *Kp, *Vp;
        if (br == 0) { j0 = 0; j1 = 1; Kp = MP_KC + ccbase; Vp = MP_VC + ccbase; }
        else if (br == 1) { j0 = 0; j1 = c; Kp = MP_KS + kvbase; Vp = MP_VS + kvbase; }
        else { j0 = (c - 8 > 0) ? c - 8 : 0; j1 = c; Kp = MP_KW + kvbase; Vp = MP_VW + kvbase; }
#pragma unroll 1
        for (int j = j0; j <= j1; ++j) {
            if (br == 1 && !((un >> j) & 1u)) continue;
            __syncthreads();
            *(LAS v4u*)(L + NS_KT + tid * 16) = *(const v4u*)(Kp + (size_t)j * 4096 + tid * 8);
            *(LAS v4u*)(L + NS_VT + tid * 16) = *(const v4u*)(Vp + (size_t)j * 4096 + tid * 8);
            __syncthreads();
            if (act) {
                unsigned long long mask;
                if (br == 0) mask = bits_upto(nlim - 64 * j);
                else if (br == 1) mask = ((mysel >> j) & 1u) ? ((j < c) ? ~0ull : bits_upto(lane)) : 0ull;
                else { const int lo = t - 511 - 64 * j, hi = t - 64 * j; mask = bits_upto(hi) & ~((lo > 0) ? bits_upto(lo - 1) : 0ull); }
#pragma unroll 1
                for (int r = 0; r < 64; ++r) {
                    const bool on = (mask >> r) & 1ull;
                    if (!__any(on)) continue;
                    const float s = dot64(q, L + NS_KT + r * 128);
                    if (on) {
                        if (s > mx) { const float corr = __expf(mx - s); l *= corr;
#pragma unroll
                            for (int d = 0; d < 64; ++d) o[d] *= corr;
                            mx = s; }
                        const float p = __expf(s - mx); l += p;
                        const LAS unsigned char* vr = L + NS_VT + r * 128;
#pragma unroll
                        for (int c8 = 0; c8 < 8; ++c8) { const v4u vv = *(const LAS v4u*)(vr + c8 * 16);
                            o[c8 * 8 + 0] += p * bflo(vv.x); o[c8 * 8 + 1] += p * bfhi(vv.x); o[c8 * 8 + 2] += p * bflo(vv.y); o[c8 * 8 + 3] += p * bfhi(vv.y);
                            o[c8 * 8 + 4] += p * bflo(vv.z); o[c8 * 8 + 5] += p * bfhi(vv.z); o[c8 * 8 + 6] += p * bflo(vv.w); o[c8 * 8 + 7] += p * bfhi(vv.w); }
                    }
                }
            }
        }
        if (act) { const float gate = sigmoidf_(MP_GATE[row * 32 + br * 8 + g * 4 + h]); const float sc = (l > 0.f) ? gate / l : 0.f;
#pragma unroll
            for (int d = 0; d < 64; ++d) OUT[d] += sc * o[d]; }
        if (br == 0) {
            __syncthreads();
            *(LAS v4u*)(L + NS_KT + tid * 16) = *(const v4u*)(Kp + tid * 8);
            *(LAS v4u*)(L + NS_KT + 8192 + tid * 16) = *(const v4u*)(Kp + 4096 + tid * 8);
            __syncthreads();
            if (act) {
                const float il = (l > 0.f) ? 1.f / l : 0.f;
                LAS float* IMP = (LAS float*)(L + NS_IMP) + tid * 33;
#pragma unroll 1
                for (int jb = 0; jb < 32; ++jb) { float a = 0.f;
#pragma unroll 1
                    for (int n = (jb ? 4 * jb - 1 : 0); n <= 4 * jb + 3 && n <= 126; ++n) { const float s = dot64(q, L + NS_KT + n * 128); if (n <= nlim) a += __expf(s - mx); }
                    IMP[jb] = a * il; }
            }
            __syncthreads();
            if (w == 0) {
                LAS float* IMS = (LAS float*)(L + NS_IMS) + lane * 33; const LAS float* I4 = (const LAS float*)(L + NS_IMP);
                for (int jb = 0; jb < 32; ++jb) IMS[jb] = (I4[lane * 33 + jb] + I4[(64 + lane) * 33 + jb]) + (I4[(128 + lane) * 33 + jb] + I4[(192 + lane) * 33 + jb]);
                unsigned sel;
                if (c + 1 <= 16) sel = (1u << (c + 1)) - 1u;
                else { sel = 1u | (1u << c) | (1u << (c - 1));
                    for (int jb = 1; jb <= c - 2; ++jb) { const float vj = IMS[jb]; int rank = 0;
                        for (int i2 = 1; i2 <= c - 2; ++i2) { const float vi = IMS[i2]; rank += (vi > vj || (vi == vj && i2 < jb)) ? 1 : 0; }
                        if (rank < 13) sel |= 1u << jb; } }
                SEL[lane] = sel; unsigned so = sel;
#pragma unroll
                for (int o2 = 32; o2; o2 >>= 1) so |= __shfl_xor(so, o2);
                if (lane == 0) SEL[64] = so;
            }
            __syncthreads();
            un = SEL[64]; mysel = SEL[lane];
        }
    }
    if (act) { bf16* yp = MP_Y + row * DM + (g * 4 + h) * 64;
#pragma unroll
        for (int c8 = 0; c8 < 8; ++c8) { v4u wv; wv.x = pk2(OUT[c8 * 8 + 0], OUT[c8 * 8 + 1]); wv.y = pk2(OUT[c8 * 8 + 2], OUT[c8 * 8 + 3]); wv.z = pk2(OUT[c8 * 8 + 4], OUT[c8 * 8 + 5]); wv.w = pk2(OUT[c8 * 8 + 6], OUT[c8 * 8 + 7]);
            *(v4u*)(yp + c8 * 8) = wv; } }
    __syncthreads();
}

constexpr int ML_Q = 0, ML_K = 16384, ML_V = 32768, ML_SC = 49152, ML_C = 65536, ML_N = 131072, ML_S = 131584;
__device__ __forceinline__ void mlstm_unit_simple(LAS unsigned char* L, const MixPtrs& P, int b, int h) {
    int tid_l = threadIdx.x; asm volatile("" : "+v"(tid_l));
    const int tid = tid_l, lane = tid & 63, w = __builtin_amdgcn_readfirstlane(tid >> 6);
    LAS float* Cm = (LAS float*)(L + ML_C); LAS float* Nv = (LAS float*)(L + ML_N); LAS float* SC = (LAS float*)(L + ML_SC);
    LAS float* S_bcum = (LAS float*)(L + ML_S), *S_a = S_bcum + 64, *S_mt = S_bcum + 128, *S_wp = S_bcum + 192, *S_wk = S_bcum + 256, *S_x = S_bcum + 320;
    LAS bf16* Qs = (LAS bf16*)(L + ML_Q); LAS bf16* Ks = (LAS bf16*)(L + ML_K); LAS bf16* Vs = (LAS bf16*)(L + ML_V);
    float zf = 0.f; asm volatile("" : "+v"(zf));
    for (int i = tid; i < 128 * 128; i += 512) Cm[i] = zf;
    if (tid < 128) Nv[tid] = zf;
    if (tid == 0) { S_x[0] = zf; S_x[1] = zf; }
    const int ch = tid & 127, sg = tid >> 7;
    float wq[4], wk4[4];
#pragma unroll
    for (int j = 0; j < 4; ++j) { wq[j] = P.conv_w[j * 1024 + h * 128 + ch]; wk4[j] = P.conv_w[j * 1024 + 512 + h * 128 + ch]; }
    const float bq = P.conv_b[h * 128 + ch], bk = P.conv_b[512 + h * 128 + ch];
    const float ib = P.i_bias[h], fb = P.f_bias[h];
    __syncthreads();
#pragma unroll 1
    for (int c = 0; c < 32; ++c) {
        const int t0 = c * 64; const size_t rb = (size_t)b * SEQ;
#pragma unroll 1
        for (int s = 0; s < 16; ++s) { const int sl = sg * 16 + s, t = t0 + sl; float aq = bq, ak = bk;
#pragma unroll
            for (int j = 0; j < 4; ++j) { const int tt = t - 3 + j; if (tt >= 0) { aq += wq[j] * bf2f(MP_MQ[(rb + tt) * 512 + h * 128 + ch]); ak += wk4[j] * bf2f(MP_MK[(rb + tt) * 512 + h * 128 + ch]); } }
            aq = aq / (1.f + __expf(-aq)); ak = ak / (1.f + __expf(-ak)) * 0.08838834764831845f;
            Qs[sl * 128 + ch] = (bf16)f2bf(aq); Ks[sl * 128 + ch] = (bf16)f2bf(ak); Vs[sl * 128 + ch] = MP_MV[(rb + t) * 512 + h * 128 + ch]; }
        if (w == 0) {
            const size_t row = rb + t0 + lane;
            const float il = MP_GATE[row * 32 + 24 + h] + ib; const float fx = MP_GATE[row * 32 + 28 + h] + fb;
            const float fl = fminf(fx, 0.f) - log1pf(__expf(-fabsf(fx)));
            float f = fl;
#pragma unroll
            for (int o = 1; o < 64; o <<= 1) { const float v = __shfl_up(f, o); if (lane >= o) f += v; }
            const float a = il - f; float pm = a;
#pragma unroll
            for (int o = 1; o < 64; o <<= 1) { const float v = __shfl_up(pm, o); if (lane >= o) pm = fmaxf(pm, v); }
            const float b_last = __shfl(f, 63), amax = __shfl(pm, 63), mc = S_x[0];
            const float inter = f + mc, mt = fmaxf(f + pm, inter);
            const float m_new = fmaxf(b_last + mc, b_last + amax);
            S_bcum[lane] = f; S_a[lane] = a; S_mt[lane] = mt; S_wp[lane] = __expf(inter - mt); S_wk[lane] = __expf(b_last + a - m_new);
            if (lane == 0) { S_x[1] = __expf(b_last + mc - m_new); S_x[0] = m_new; }
        }
        __syncthreads();
        { const int t = tid >> 3; const float bt = S_bcum[t] - S_mt[t];
#pragma unroll 1
          for (int jj = 0; jj < 8; ++jj) { const int s = (tid & 7) + 8 * jj; float v = 0.f;
              if (s <= t) { float d0 = 0.f;
#pragma unroll
                  for (int c8 = 0; c8 < 16; ++c8) { const v4u qa = *(const LAS v4u*)(Qs + t * 128 + c8 * 8), ka = *(const LAS v4u*)(Ks + s * 128 + c8 * 8);
                      d0 += bflo(qa.x) * bflo(ka.x) + bfhi(qa.x) * bfhi(ka.x) + bflo(qa.y) * bflo(ka.y) + bfhi(qa.y) * bfhi(ka.y) + bflo(qa.z) * bflo(ka.z) + bfhi(qa.z) * bfhi(ka.z) + bflo(qa.w) * bflo(ka.w) + bfhi(qa.w) * bfhi(ka.w); }
                  v = d0 * __expf(bt + S_a[s]); }
              SC[t * 64 + s] = v; } }
        __syncthreads();
        { const int t = tid >> 3, e0 = (tid & 7) * 16; float acc[16], acc2[16], dsum = 0.f, dqn = 0.f;
#pragma unroll
          for (int e = 0; e < 16; ++e) { acc[e] = 0.f; acc2[e] = 0.f; }
#pragma unroll 1
          for (int s = 0; s < 64; ++s) { const float wv = SC[t * 64 + s]; dsum += wv;
              const v4u v0 = *(const LAS v4u*)(Vs + s * 128 + e0), v1 = *(const LAS v4u*)(Vs + s * 128 + e0 + 8);
              acc[0] += wv * bflo(v0.x); acc[1] += wv * bfhi(v0.x); acc[2] += wv * bflo(v0.y); acc[3] += wv * bfhi(v0.y); acc[4] += wv * bflo(v0.z); acc[5] += wv * bfhi(v0.z); acc[6] += wv * bflo(v0.w); acc[7] += wv * bfhi(v0.w);
              acc[8] += wv * bflo(v1.x); acc[9] += wv * bfhi(v1.x); acc[10] += wv * bflo(v1.y); acc[11] += wv * bfhi(v1.y); acc[12] += wv * bflo(v1.z); acc[13] += wv * bfhi(v1.z); acc[14] += wv * bflo(v1.w); acc[15] += wv * bfhi(v1.w); }
#pragma unroll 1
          for (int d = 0; d < 128; ++d) { const float qd = bf2f(Qs[t * 128 + d]); dqn += qd * Nv[d];
              const LAS f32x4* cr = (const LAS f32x4*)(Cm + d * 128 + e0);
#pragma unroll
              for (int e4 = 0; e4 < 4; ++e4) { const f32x4 cv = cr[e4]; acc2[e4 * 4 + 0] += qd * cv.x; acc2[e4 * 4 + 1] += qd * cv.y; acc2[e4 * 4 + 2] += qd * cv.z; acc2[e4 * 4 + 3] += qd * cv.w; } }
          const float wp = S_wp[t], den = dsum + wp * dqn; const float dn = fmaxf(fabsf(den), __expf(-S_mt[t])); const float idn = 1.f / dn;
          float ss = 0.f;
#pragma unroll
          for (int e = 0; e < 16; ++e) { acc[e] = (acc[e] + wp * acc2[e]) * idn; ss += acc[e] * acc[e]; }
          ss += __shfl_xor(ss, 1); ss += __shfl_xor(ss, 2); ss += __shfl_xor(ss, 4);
          const float rn = __frsqrt_rn(ss * (1.f / 128.f) + EPS);
          const size_t row = rb + t0 + t; const bf16* op = MP_MO + row * 512 + h * 128 + e0; const float* gn = P.mnorm_g + h * 128 + e0;
          const v4u o0 = *(const v4u*)op, o1 = *(const v4u*)(op + 8);
          const float ov[16] = {bflo(o0.x), bfhi(o0.x), bflo(o0.y), bfhi(o0.y), bflo(o0.z), bfhi(o0.z), bflo(o0.w), bfhi(o0.w), bflo(o1.x), bfhi(o1.x), bflo(o1.y), bfhi(o1.y), bflo(o1.z), bfhi(o1.z), bflo(o1.w), bfhi(o1.w)};
          float y[16];
#pragma unroll
          for (int e = 0; e < 16; ++e) y[e] = acc[e] * rn * gn[e] * sigmoidf_(ov[e]);
          v4u w0, w1; w0.x = pk2(y[0], y[1]); w0.y = pk2(y[2], y[3]); w0.z = pk2(y[4], y[5]); w0.w = pk2(y[6], y[7]); w1.x = pk2(y[8], y[9]); w1.y = pk2(y[10], y[11]); w1.z = pk2(y[12], y[13]); w1.w = pk2(y[14], y[15]);
          bf16* yp = MP_Y + row * DM + 512 + h * 128 + e0; *(v4u*)yp = w0; *(v4u*)(yp + 8) = w1; }
        __syncthreads();
        { const int d = tid >> 2, e0 = (tid & 3) * 32; const float cs = S_x[1]; float ca[32], na = 0.f;
#pragma unroll
          for (int e = 0; e < 32; ++e) ca[e] = cs * Cm[d * 128 + e0 + e];
#pragma unroll 1
          for (int s = 0; s < 64; ++s) { const float kk = S_wk[s] * bf2f(Ks[s * 128 + d]); na += kk;
#pragma unroll
              for (int c8 = 0; c8 < 4; ++c8) { const v4u vv = *(const LAS v4u*)(Vs + s * 128 + e0 + c8 * 8);
                  ca[c8 * 8 + 0] += kk * bflo(vv.x); ca[c8 * 8 + 1] += kk * bfhi(vv.x); ca[c8 * 8 + 2] += kk * bflo(vv.y); ca[c8 * 8 + 3] += kk * bfhi(vv.y);
                  ca[c8 * 8 + 4] += kk * bflo(vv.z); ca[c8 * 8 + 5] += kk * bfhi(vv.z); ca[c8 * 8 + 6] += kk * bflo(vv.w); ca[c8 * 8 + 7] += kk * bfhi(vv.w); } }
#pragma unroll
          for (int e = 0; e < 32; ++e) Cm[d * 128 + e0 + e] = ca[e];
          if ((tid & 3) == 0) Nv[d] = cs * Nv[d] + na; }
        __syncthreads();
    }
}

#ifndef MK_MULTI
#define MK_MULTI 0
#endif
constexpr int PH_PER_LAYER = 12, N_PHASES = 1 + DEPTH * PH_PER_LAYER;
struct Args { const float* in[16]; float* out; unsigned char* ws; int ph_lo, ph_hi; };
static_assert(sizeof(Args) == 16 * 8 + 8 + 8 + 8, "Args has no padding");

__global__ void __launch_bounds__(NWAVES * 64, 2) fwd_kernel(Args args) {
    extern __shared__ __attribute__((aligned(16))) unsigned char lds_raw[];
    LAS unsigned char* L = (LAS unsigned char*)lds_raw;
    const int G0 = gridDim.x, blk0 = blockIdx.x;
#define PH_IDS() PH_WS(); int tid = threadIdx.x; asm volatile("" : "+v"(tid)); const int lane = tid & 63, wave = __builtin_amdgcn_readfirstlane(tid >> 6), gw = blk * NWAVES + wave; (void)lane; (void)gw
#define PH_WS() unsigned char* ws = args.ws; asm volatile("" : "+s"(ws)); int blk = blk0, G = G0; asm volatile("" : "+s"(blk), "+s"(G)); const int NGW = G * NWAVES; (void)NGW; float* xres = args.out; bf16* U = (bf16*)(ws + WS_U); bf16* HB = (bf16*)(ws + WS_HB); bf16* HD = (bf16*)(ws + WS_HD); \
    unsigned char* wl = ws + WS_W + (size_t)l_ * W_LAYER; const float* ng = args.in[1] + (size_t)l_ * 6 * DM; (void)xres; (void)U; (void)HB; (void)HD; (void)wl; (void)ng
    unsigned char* ws0 = args.ws;
    volatile LAS unsigned* MISC = (volatile LAS unsigned*)(L + MISC_OFF);
    if (threadIdx.x < 16) MISC[threadIdx.x] = 0u;
    __syncthreads();
    XcdBarrier bar; bar.bar = (unsigned*)(ws0 + WS_CTL) + CW_BAR; bar.x = 0; bar.st = nullptr;
    if (!MK_MULTI) bar = xcd_barrier_post((unsigned*)(ws0 + WS_CTL) + CW_BAR, MISC + 8);
    const int lo = args.ph_lo, hi = args.ph_hi;
#define IN(k) (lo <= (k) && (k) < hi)
#define SEAM(k) do { if (IN(k) && IN((k) + 1)) xcd_barrier(bar); } while (0)

    if (IN(0)) {
        const int l_ = 0; PH_IDS();
        const float* x_in = args.in[0]; float* cosT = (float*)(ws + WS_TAB + TAB_COS); float* sinT = (float*)(ws + WS_TAB + TAB_SIN); float* b1T = (float*)(ws + WS_TAB + TAB_B1);
        LAS float* scr = (LAS float*)(L + wave * 16384);
        constexpr int I_GU = 16 * 176, I_DN = 44 * 32, I_IN = 16 * 112, I_OUT = 16 * 32, I_CMP = 16 * 16, I_LAYER = 2 * I_GU + 2 * I_DN + I_IN + I_OUT + I_CMP;
        for (int it = gw; it < DEPTH * I_LAYER; it += NGW) {
            const int l = it / I_LAYER; int r = it % I_LAYER; unsigned char* wl = ws + WS_W + (size_t)l * W_LAYER;
            if (r < I_GU) { SrcGU s{args.in[2] + (size_t)l * DM * NGU}; transpose_item(s, DM, (bf16*)(wl + WO_GU1), scr, r / 176, r % 176, lane); continue; } r -= I_GU;
            if (r < I_DN) { SrcPlain s{args.in[3] + (size_t)l * FF * DM, DM}; transpose_item(s, FF, (bf16*)(wl + WO_DN1), scr, r / 32, r % 32, lane); continue; } r -= I_DN;
            if (r < I_GU) { SrcGU s{args.in[4] + (size_t)l * DM * NGU}; transpose_item(s, DM, (bf16*)(wl + WO_GU2), scr, r / 176, r % 176, lane); continue; } r -= I_GU;
            if (r < I_DN) { SrcPlain s{args.in[5] + (size_t)l * FF * DM, DM}; transpose_item(s, FF, (bf16*)(wl + WO_DN2), scr, r / 32, r % 32, lane); continue; } r -= I_DN;
            if (r < I_IN) { SrcIN s{args.in[6] + (size_t)l * DM * INCOLS}; transpose_item(s, DM, (bf16*)(wl + WO_IN), scr, r / 112, r % 112, lane); continue; } r -= I_IN;
            if (r < I_OUT) { SrcPlain s{args.in[7] + (size_t)l * DM * DM, DM}; transpose_item(s, DM, (bf16*)(wl + WO_OUT), scr, r / 32, r % 32, lane); continue; } r -= I_OUT;
            { SrcCMP s{args.in[9] + (size_t)l * 2 * 2048 * 128}; transpose_item(s, DM, (bf16*)(wl + WO_CMP), scr, r / 16, r % 16, lane); }
        }
        for (int i = blk * 512 + tid; i < SEQ * 8; i += G * 512) { const int pos = i >> 3, k = i & 7;
            const double inv = pow(500000.0, -(double)k / 8.0), ang = (double)pos * inv; cosT[i] = (float)cos(ang); sinT[i] = (float)sin(ang); }
        for (int o = gw; o < DEPTH * 2 * 128; o += NGW) { const int lk = o >> 7, c = o & 127; const float* pe = args.in[8] + (size_t)lk * 2048; const float* w1 = args.in[9] + (size_t)lk * 2048 * 128;
            float s = 0.f; for (int r = lane; r < 2048; r += 64) s += pe[r] * w1[(size_t)r * 128 + c];
            s = wave_sum(s); if (lane == 0) b1T[o] = s; }
        thin_phase<0>(nullptr, x_in, xres, nullptr, 0.f, args.in[1] + 0 * DM, U, gw, NGW, lane);
    }
    SEAM(0);

#pragma unroll 1
    for (int l = 0; l < DEPTH; ++l) {
        const int pb = 1 + l * PH_PER_LAYER, l_ = l;
        if (IN(pb + 0)) { PH_WS(); pg8::Gemm g{U, (const bf16*)(wl + WO_GU1), MTOK, NGU, DM}; pg8::StaticOrder S; S.init(MTOK, NGU, G, blk); EpiSwiglu E{HB};
            pg8::gemm_phase<EpiSwiglu, pg8::StaticOrder, true, true>(L, g, S, E); }
        SEAM(pb + 0);
        if (IN(pb + 1)) { PH_WS(); pg8::Gemm g{HB, (const bf16*)(wl + WO_DN1), MTOK, DM, FF}; pg8::StaticOrder S; S.init(MTOK, DM, G, blk); pg8::EpiBf16<0> E{HD, DM, nullptr, 0, 0, 1.f};
            pg8::gemm_phase<pg8::EpiBf16<0>, pg8::StaticOrder, true, true>(L, g, S, E); }
        SEAM(pb + 1);
        if (IN(pb + 2)) { PH_IDS(); thin_phase<1>(HD, xres, xres, ng + 1 * DM, 0.5f, ng + 2 * DM, U, gw, NGW, lane); }
        SEAM(pb + 2);
        if (IN(pb + 3)) { PH_WS(); pg8::Gemm g{U, (const bf16*)(wl + WO_IN), MTOK, NINP, DM}; pg8::StaticOrder S; S.init(MTOK, NINP, G, blk);
            EpiInProj E{ws};
            pg8::gemm_phase<EpiInProj, pg8::StaticOrder, true, true>(L, g, S, E); }
        SEAM(pb + 3);
        if (IN(pb + 4)) { PH_WS(); pg8::Gemm g{(const bf16*)(ws + WS_KCR), (const bf16*)(wl + WO_CMP), 8192, 512, DM}; CmpOrder S{blk, G}; EpiPQ E{(float*)(ws + WS_PQ)};
            pg8::gemm_phase<EpiPQ, CmpOrder, false, true>(L, g, S, E); }
        SEAM(pb + 4);
        if (IN(pb + 5)) {
            PH_IDS();
            const float* b1T = (const float*)(ws + WS_TAB + TAB_B1); const float* PQ = (const float*)(ws + WS_PQ); bf16* CC = (bf16*)(ws + WS_CC); LAS float* hs = (LAS float*)(L + wave * 1024);
            for (int r = gw; r < 2 * 32 * 128; r += NGW) {
                const int kv = r >> 12, bgn = r & 4095, n = bgn & 127;
                if (n == 127) { CC[(size_t)r * 64 + lane] = 0; continue; }
                const float* w2 = args.in[10] + (size_t)(l * 2 + kv) * 128 * 64; const float* b1 = b1T + (l * 2 + kv) * 128;
#pragma unroll
                for (int q2 = 0; q2 < 2; ++q2) { const int c = lane + 64 * q2; const float v = PQ[(size_t)r * 256 + c] + PQ[(size_t)(r + 1) * 256 + 128 + c] + b1[c];
                    const float u3 = 0.7978845608028654f * (v + 0.044715f * v * v * v); hs[c] = 0.5f * v * (1.f + tanhf(u3)); }
                LDS_WAIT(); asm volatile("" ::: "memory");
                float o = 0.f;
#pragma unroll 8
                for (int c = 0; c < 128; ++c) o += hs[c] * w2[c * 64 + lane];
                CC[(size_t)r * 64 + lane] = (bf16)f2bf(o);
                LDS_WAIT(); asm volatile("" ::: "memory");
            }
        }
        SEAM(pb + 5);
        if (IN(pb + 6)) {
            PH_WS();
            MixPtrs P{ws, args.in[11] + (size_t)l * 4 * 1024, args.in[12] + (size_t)l * 1024, args.in[13] + l * 4, args.in[14] + l * 4, args.in[15] + l * 512};
            const int nml = (G > 64) ? 64 : 0;
            if (blk < nml) mlstm_unit_simple(L, P, blk >> 2, blk & 3);
            else { for (int u = blk - nml; u < 1024; u += G - nml) { const int c = 31 - (u >> 5), bg = u & 31; nsa_unit_simple(L, P, bg >> 1, bg & 1, c); } }
            if (nml == 0) { for (int u = blk; u < 64; u += G) mlstm_unit_simple(L, P, u >> 2, u & 3); }
        }
        SEAM(pb + 6);
        if (IN(pb + 7)) { PH_WS(); pg8::Gemm g{U, (const bf16*)(wl + WO_OUT), MTOK, DM, DM}; pg8::StaticOrder S; S.init(MTOK, DM, G, blk); pg8::EpiBf16<0> E{HD, DM, nullptr, 0, 0, 1.f};
            pg8::gemm_phase<pg8::EpiBf16<0>, pg8::StaticOrder, true, true>(L, g, S, E); }
        SEAM(pb + 7);
        if (IN(pb + 8)) { PH_IDS(); thin_phase<1>(HD, xres, xres, ng + 3 * DM, 1.0f, ng + 4 * DM, U, gw, NGW, lane); }
        SEAM(pb + 8);
        if (IN(pb + 9)) { PH_WS(); pg8::Gemm g{U, (const bf16*)(wl + WO_GU2), MTOK, NGU, DM}; pg8::StaticOrder S; S.init(MTOK, NGU, G, blk); EpiSwiglu E{HB};
            pg8::gemm_phase<EpiSwiglu, pg8::StaticOrder, true, true>(L, g, S, E); }
        SEAM(pb + 9);
        if (IN(pb + 10)) { PH_WS(); pg8::Gemm g{HB, (const bf16*)(wl + WO_DN2), MTOK, DM, FF}; pg8::StaticOrder S; S.init(MTOK, DM, G, blk); pg8::EpiBf16<0> E{HD, DM, nullptr, 0, 0, 1.f};
            pg8::gemm_phase<pg8::EpiBf16<0>, pg8::StaticOrder, true, true>(L, g, S, E); }
        SEAM(pb + 10);
        if (IN(pb + 11)) { PH_IDS(); if (l + 1 < DEPTH) thin_phase<1>(HD, xres, xres, ng + 5 * DM, 0.5f, ng + 6 * DM, U, gw, NGW, lane);
                           else thin_phase<2>(HD, xres, xres, ng + 5 * DM, 0.5f, nullptr, nullptr, gw, NGW, lane); }
        if (l + 1 < DEPTH) SEAM(pb + 11);
    }
#undef IN
#undef SEAM
#undef PH_IDS
#undef PH_WS
}

extern "C" void kernel_launch(void* const* d_in, const int* in_sizes, int n_in, void* d_out, int out_size, void* d_ws, size_t ws_size, hipStream_t stream) {
    static int grid = 0;
    if (grid == 0) {
        if (n_in != 16 || in_sizes[0] != MTOK * DM || out_size != MTOK * DM || ws_size < WS_END) { fprintf(stderr, "kernel_launch: unexpected problem (n_in %d, ws %zu)\n", n_in, ws_size); grid = -1; return; }
        int dev = 0, cus = 0, per_cu = 0;
        if (hipGetDevice(&dev) != hipSuccess || hipDeviceGetAttribute(&cus, hipDeviceAttributeMultiprocessorCount, dev) != hipSuccess) { grid = -1; return; }
        if (hipFuncSetAttribute((const void*)fwd_kernel, hipFuncAttributeMaxDynamicSharedMemorySize, LDS_BYTES) != hipSuccess) { grid = -1; return; }
        if (hipOccupancyMaxActiveBlocksPerMultiprocessor(&per_cu, (const void*)fwd_kernel, NWAVES * 64, LDS_BYTES) != hipSuccess || per_cu < 1) { fprintf(stderr, "kernel_launch: occupancy query says %d\n", per_cu); }
        (void)hipGetLastError();
        grid = cus;
    }
    if (grid < 0) return;
    (void)hipMemsetAsync((char*)d_ws + WS_CTL, 0, CTL_ZERO_BYTES, stream);
    Args a{};
    for (int i = 0; i < 16; ++i) a.in[i] = (const float*)d_in[i];
    a.out = (float*)d_out; a.ws = (unsigned char*)d_ws;
#if MK_MULTI
    for (int p = 0; p < N_PHASES; ++p) { a.ph_lo = p; a.ph_hi = p + 1; hipLaunchKernelGGL(fwd_kernel, dim3(grid), dim3(NWAVES * 64), LDS_BYTES, stream, a); }
#else
    a.ph_lo = 0; a.ph_hi = N_PHASES; hipLaunchKernelGGL(fwd_kernel, dim3(grid), dim3(NWAVES * 64), LDS_BYTES, stream, a);
#endif
}
```

```cpp
#include <hip/hip_runtime.h>
#include <cstdio>
#include <cstdint>
namespace pg8 {
#define PG8_LAS __attribute__((address_space(3)))
typedef unsigned short bf16_t;
typedef short bf16x8 __attribute__((ext_vector_type(8)));
typedef float f32x4 __attribute__((ext_vector_type(4)));
typedef unsigned u32x4 __attribute__((ext_vector_type(4)));
constexpr int BM = 256, BK = 64, HALF = 128, HTB = HALF * BK * 2  , STAGE_BYTES = 8 * HTB, NXCD = 8, WGM = 8;

__host__ __device__ __forceinline__ int lds_byte(int r, int c) { const int st = (r >> 4) * 2 + (c >> 5), rr = r & 15, cc = c & 31, ob = rr * 64 + cc * 2; return st * 1024 + (ob ^ (((ob >> 9) & 1) << 5)); }
__host__ __device__ __forceinline__ void stage_rc(int b, int& R, int& C) { const int st = b / 1024, sb = b % 1024, swz = sb ^ (((sb >> 9) & 1) << 5); R = (st >> 1) * 16 + swz / 64; C = (st & 1) * 32 + (swz % 64) / 2; }
__host__ __device__ __forceinline__ int perm32(int rho) { const int n = rho >> 4, i = rho & 15; return 8 * (i >> 2) + 4 * n + (i & 3); }

struct Unit { int pm, pn; };
struct Gemm { const bf16_t* A; const bf16_t* Bt; int M, N, K; };

struct StaticOrder {
    int nM, nN, nwg, G, c;
    __host__ __device__ void init(int M, int N, int G_, int c_) { nM = M / BM; nN = N / BM; nwg = nM * nN; G = G_; c = c_; }
    __host__ __device__ bool next(int i, Unit& u) const {
        const long L = (long)i * G + c; if (L >= nwg) return false;
        int wgid = (int)L; { const int q = nwg / NXCD, r = nwg % NXCD, xcd = wgid % NXCD, off = wgid / NXCD; wgid = (xcd < r ? xcd * (q + 1) : r * (q + 1) + (xcd - r) * q) + off; }
        const int nig = WGM * nN, gid = wgid / nig, fm = gid * WGM, gsz = (nM - fm) < WGM ? (nM - fm) : WGM;
        u.pm = fm + ((wgid % nig) % gsz); u.pn = (wgid % nig) / gsz; return true;
    }
    __device__ __forceinline__ void a_ready(const Unit&) const {}
    __device__ __forceinline__ void done(const Unit&) const {}
};

__device__ __forceinline__ unsigned cvt_pk_bf16(float lo, float hi) { unsigned r; asm volatile("v_cvt_pk_bf16_f32 %0, %1, %2" : "=v"(r) : "v"(lo), "v"(hi)); return r; }
typedef float f32x2 __attribute__((ext_vector_type(2)));
__device__ __forceinline__ f32x2 gelu_pk(f32x2 v) {
    const f32x2 av = __builtin_elementwise_abs(v), d = av * 0.2316418882f + 1.0f;
    f32x2 t; t.x = __builtin_amdgcn_rcpf(d.x); t.y = __builtin_amdgcn_rcpf(d.y);
    f32x2 q = t * 0.5307027145f + (-0.7265760135f); q = q * t + 0.7107068705f; q = q * t + (-0.142248368f); q = q * t + 0.127414796f; q = q * t;
    const f32x2 s = (v * v) * (-0.72134752044f);
    f32x2 e; e.x = __builtin_amdgcn_exp2f(s.x); e.y = __builtin_amdgcn_exp2f(s.y);
    const f32x2 m = v * (q * e), r = v - m;
    f32x2 o; o.x = v.x < 0.f ? m.x : r.x; o.y = v.y < 0.f ? m.y : r.y; return o;
}

template <int ACT  > struct EpiBf16 {
    static constexpr bool PERM = true, AFTER_DRAIN = false; static_assert(ACT == 0 || ACT == 1, "EpiBf16: ACT is 0 (none) or 1 (gelu_pk)");
    bf16_t* O; int ldc; const float* bias; int split_cols; size_t split_stride; float scale0;
    __device__ __forceinline__ void operator()(const f32x4 (&acc)[2][2][4][2], const Unit& u, int wr, int wc, int fr, int fq) const {
        const int row0 = u.pm * BM + wr * 64 + fr; int colt = u.pn * BM; bf16_t* base = O;
        float sc = 1.f; if (split_cols) { const int t = colt / split_cols; base += (size_t)t * split_stride; colt -= t * split_cols; if (t == 0) sc = scale0; }
        const int col0 = colt + wc * 32 + 8 * fq, bcol0 = u.pn * BM + wc * 32 + 8 * fq;
        f32x4 bv[2][2];
#pragma unroll
        for (int bj = 0; bj < 2; ++bj)
#pragma unroll
            for (int n = 0; n < 2; ++n) bv[bj][n] = bias ? *(const f32x4*)(bias + bcol0 + bj * HALF + 4 * n) : (f32x4){0.f, 0.f, 0.f, 0.f};
#pragma unroll
        for (int ai = 0; ai < 2; ++ai)
#pragma unroll
            for (int m = 0; m < 4; ++m) { bf16_t* rowp = base + (size_t)(row0 + ai * HALF + m * 16) * ldc + col0;
#pragma unroll
                for (int bj = 0; bj < 2; ++bj) { f32x4 v0 = acc[ai][bj][m][0] + bv[bj][0], v1 = acc[ai][bj][m][1] + bv[bj][1];
                    if (ACT == 1) { f32x2 a = gelu_pk((f32x2){v0[0], v0[1]}), b = gelu_pk((f32x2){v0[2], v0[3]}), c = gelu_pk((f32x2){v1[0], v1[1]}), d = gelu_pk((f32x2){v1[2], v1[3]});
                        v0 = (f32x4){a.x, a.y, b.x, b.y}; v1 = (f32x4){c.x, c.y, d.x, d.y}; }
                    v0 = v0 * sc; v1 = v1 * sc; u32x4 w; w.x = cvt_pk_bf16(v0[0], v0[1]); w.y = cvt_pk_bf16(v0[2], v0[3]); w.z = cvt_pk_bf16(v1[0], v1[1]); w.w = cvt_pk_bf16(v1[2], v1[3]);
                    *(u32x4*)(rowp + bj * HALF) = w; } }
    }
};
template <class Epi, class Sched, bool ALIGN_EPI = false, bool SP2 = false>
__device__ __forceinline__ void gemm_phase(PG8_LAS unsigned char* lds, const Gemm g, const Sched& S, const Epi& E) {
    int tid_l = threadIdx.x; asm volatile("" : "+v"(tid_l));
    const int tid = tid_l, wid = __builtin_amdgcn_readfirstlane(tid >> 6), lane = tid & 63, wr = wid >> 2, wc = wid & 3, fr = lane & 15, fq = lane >> 4;
    const int K = g.K, nt = K / BK;
    unsigned voffA[2], voffB[2];
#pragma unroll
    for (int i = 0; i < 2; ++i) { int R, C; stage_rc(tid * 16 + i * 8192, R, C); const int Rb = Epi::PERM ? ((R & ~31) + perm32(R & 31)) : R;
        voffA[i] = (unsigned)(R * K + C) * 2u; voffB[i] = (unsigned)(Rb * K + C) * 2u; }
    const size_t kstep = (size_t)(BK * 2);
    const size_t hstep = (size_t)HALF * K * 2;
    const size_t tstep = 2 * hstep;
    const unsigned ldsw = (unsigned)wid * 1024u;
    const int aoff = lds_byte(wr * 64 + fr, fq * 8), boff = lds_byte(wc * 32 + fr, fq * 8);
#define PG8_SA(b, h) (((b) * 2 + (h)) * HTB)
#define PG8_SB(b, h) ((4 + (b) * 2 + (h)) * HTB)
#define PG8_STAGE(bufoff, gbase, voff) do { _Pragma("unroll") for (int _i = 0; _i < 2; ++_i) \
        __builtin_amdgcn_global_load_lds((const unsigned*)((const char*)(gbase) + (voff)[_i]), (PG8_LAS unsigned*)(lds + (bufoff) + ldsw + _i * 8192), 16, 0, 0); } while (0)
#define PG8_LDA(dst, b, h) do { _Pragma("unroll") for (int m = 0; m < 4; ++m) _Pragma("unroll") for (int k = 0; k < 2; ++k) dst[m][k] = *(const PG8_LAS bf16x8*)(lds + PG8_SA(b, h) + aoff + m * 2048 + k * 1024); } while (0)
#define PG8_LDB(dst, b, h) do { _Pragma("unroll") for (int n = 0; n < 2; ++n) _Pragma("unroll") for (int k = 0; k < 2; ++k) dst[n][k] = *(const PG8_LAS bf16x8*)(lds + PG8_SB(b, h) + boff + n * 2048 + k * 1024); } while (0)
#define PG8_MMA(ai, bj, At, Bt) do { __builtin_amdgcn_s_setprio(1); _Pragma("unroll") for (int m = 0; m < 4; ++m) _Pragma("unroll") for (int n = 0; n < 2; ++n) _Pragma("unroll") for (int k = 0; k < 2; ++k) \
        acc[ai][bj][m][n] = __builtin_amdgcn_mfma_f32_16x16x32_bf16(Bt[n][k], At[m][k], acc[ai][bj][m][n], 0, 0, 0); __builtin_amdgcn_s_setprio(0); } while (0)
#define PG8_WAIT_V(n) asm volatile("s_waitcnt vmcnt(" #n ")" ::: "memory")
#define PG8_WAIT_L(n) asm volatile("s_waitcnt lgkmcnt(" #n ")" ::: "memory")
#define PG8_BAR __builtin_amdgcn_s_barrier()
#define PG8_SCHED __builtin_amdgcn_sched_barrier(0)
    Unit cur, nxt; int ui = 0;
    if (!S.next(0, cur)) return;
    f32x4 acc[2][2][4][2];
#pragma unroll
    for (int a = 0; a < 2; ++a)
#pragma unroll
        for (int b = 0; b < 2; ++b)
#pragma unroll
            for (int m = 0; m < 4; ++m)
#pragma unroll
                for (int n = 0; n < 2; ++n) acc[a][b][m][n] = (f32x4){0.f, 0.f, 0.f, 0.f};
    bf16x8 At[4][2], B0[2][2], B1[2][2];
    const char* cA = (const char*)g.A + (size_t)cur.pm * tstep; const char* cB = (const char*)g.Bt + (size_t)cur.pn * tstep;
    S.a_ready(cur);
    if constexpr (SP2) {
        PG8_STAGE(PG8_SB(0, 0), cB, voffB); PG8_STAGE(PG8_SB(0, 1), cB + hstep, voffB); PG8_STAGE(PG8_SA(0, 0), cA, voffA); PG8_STAGE(PG8_SA(0, 1), cA + hstep, voffA);
        if (wr == 1) PG8_BAR;
        PG8_WAIT_V(2); PG8_BAR;
        PG8_STAGE(PG8_SB(1, 0), cB + kstep, voffB); PG8_STAGE(PG8_SA(1, 0), cA + kstep, voffA); PG8_STAGE(PG8_SB(1, 1), cB + hstep + kstep, voffB);
        PG8_WAIT_V(6); PG8_BAR;
    } else {
        PG8_STAGE(PG8_SB(0, 0), cB, voffB); PG8_STAGE(PG8_SA(0, 0), cA, voffA); PG8_STAGE(PG8_SB(0, 1), cB + hstep, voffB); PG8_STAGE(PG8_SA(0, 1), cA + hstep, voffA);
        if (wr == 1) PG8_BAR;
        PG8_WAIT_V(4); PG8_BAR;
        PG8_STAGE(PG8_SB(1, 0), cB + kstep, voffB); PG8_STAGE(PG8_SA(1, 0), cA + kstep, voffA); PG8_STAGE(PG8_SB(1, 1), cB + hstep + kstep, voffB);
        PG8_WAIT_V(6); PG8_BAR;
    }
    for (;;) {
        const bool has_next = S.next(ui + 1, nxt);
        const char* nA = has_next ? (const char*)g.A + (size_t)nxt.pm * tstep : cA; const char* nB = has_next ? (const char*)g.Bt + (size_t)nxt.pn * tstep : cB;
        for (int t = 0; t < nt; t += 2) {
            const bool last = (t == nt - 2);
            const char* a1 = cA + (size_t)(t + 1) * kstep;
            const char* a2 = last ? nA : cA + (size_t)(t + 2) * kstep; const char* b2 = last ? nB : cB + (size_t)(t + 2) * kstep;
            const char* a3 = a2 + kstep; const char* b3 = b2 + kstep;
            if (last && has_next) S.a_ready(nxt);
            if constexpr (SP2) {
            PG8_LDB(B0, 0, 0); PG8_LDB(B1, 0, 1); PG8_SCHED; PG8_LDA(At, 0, 0); PG8_STAGE(PG8_SA(1, 1), a1 + hstep, voffA);
            PG8_WAIT_V(8); PG8_WAIT_L(0); PG8_BAR; PG8_MMA(0, 0, At, B0); PG8_MMA(0, 1, At, B1); PG8_BAR; PG8_SCHED;
            PG8_LDA(At, 0, 1); PG8_STAGE(PG8_SB(0, 0), b2, voffB); PG8_STAGE(PG8_SB(0, 1), b2 + hstep, voffB); PG8_STAGE(PG8_SA(0, 0), a2, voffA);
            PG8_WAIT_V(8); PG8_WAIT_L(0); PG8_BAR; PG8_MMA(1, 0, At, B0); PG8_MMA(1, 1, At, B1); PG8_BAR; PG8_SCHED;
            PG8_LDB(B0, 1, 0); PG8_LDB(B1, 1, 1); PG8_SCHED; PG8_LDA(At, 1, 0); PG8_STAGE(PG8_SA(0, 1), a2 + hstep, voffA);
            PG8_WAIT_V(8); PG8_WAIT_L(0); PG8_BAR; PG8_MMA(0, 0, At, B0); PG8_MMA(0, 1, At, B1); PG8_BAR; PG8_SCHED;
            PG8_LDA(At, 1, 1); PG8_STAGE(PG8_SB(1, 0), b3, voffB); PG8_STAGE(PG8_SB(1, 1), b3 + hstep, voffB); PG8_STAGE(PG8_SA(1, 0), a3, voffA);
            PG8_WAIT_V(8); PG8_WAIT_L(0); PG8_BAR; PG8_MMA(1, 0, At, B0); PG8_MMA(1, 1, At, B1); PG8_BAR; PG8_SCHED;
            } else {
            PG8_LDB(B0, 0, 0); PG8_SCHED; PG8_LDA(At, 0, 0); PG8_STAGE(PG8_SA(1, 1), a1 + hstep, voffA);
            PG8_WAIT_L(8); PG8_BAR; PG8_WAIT_L(0); PG8_MMA(0, 0, At, B0); PG8_BAR; PG8_SCHED;
            PG8_LDB(B1, 0, 1); PG8_STAGE(PG8_SB(0, 0), b2, voffB);
            PG8_BAR; PG8_WAIT_L(0); PG8_MMA(0, 1, At, B1); PG8_BAR;
            PG8_LDA(At, 0, 1); PG8_STAGE(PG8_SA(0, 0), a2, voffA);
            PG8_BAR; PG8_WAIT_L(0); PG8_MMA(1, 0, At, B0); PG8_BAR; PG8_SCHED;
            PG8_STAGE(PG8_SB(0, 1), b2 + hstep, voffB);
            PG8_WAIT_V(6); PG8_BAR; PG8_MMA(1, 1, At, B1); PG8_BAR;
            PG8_LDB(B0, 1, 0); PG8_SCHED; PG8_LDA(At, 1, 0); PG8_STAGE(PG8_SA(0, 1), a2 + hstep, voffA);
            PG8_WAIT_L(8); PG8_BAR; PG8_WAIT_L(0); PG8_MMA(0, 0, At, B0); PG8_BAR; PG8_SCHED;
            PG8_LDB(B1, 1, 1); PG8_STAGE(PG8_SB(1, 0), b3, voffB);
            PG8_BAR; PG8_WAIT_L(0); PG8_MMA(0, 1, At, B1); PG8_BAR;
            PG8_LDA(At, 1, 1); PG8_STAGE(PG8_SA(1, 0), a3, voffA);
            PG8_BAR; PG8_WAIT_L(0); PG8_MMA(1, 0, At, B0); PG8_BAR; PG8_SCHED;
            PG8_STAGE(PG8_SB(1, 1), b3 + hstep, voffB);
            PG8_WAIT_V(6); PG8_BAR; PG8_MMA(1, 1, At, B1); PG8_BAR;
            }
        }
        if constexpr (ALIGN_EPI) { if (wr == 0) PG8_BAR; }
        if constexpr (!Epi::AFTER_DRAIN) { E(acc, cur, wr, wc, fr, fq); S.done(cur); }
        if (!has_next) break;
#pragma unroll
        for (int a = 0; a < 2; ++a)
#pragma unroll
            for (int b = 0; b < 2; ++b)
#pragma unroll
                for (int m = 0; m < 4; ++m)
#pragma unroll
                    for (int n = 0; n < 2; ++n) acc[a][b][m][n] = (f32x4){0.f, 0.f, 0.f, 0.f};
        cur = nxt; cA = nA; cB = nB; ++ui;
        if constexpr (ALIGN_EPI) { if (wr == 1) PG8_BAR; }
    }
    PG8_WAIT_V(0);
    if constexpr (!ALIGN_EPI) { if (wr == 0) PG8_BAR; }
    PG8_BAR;
    if constexpr (Epi::AFTER_DRAIN) { E.fused(acc, cur, wr, wc, fr, fq, lds, wid, lane); S.done(cur); }
#undef PG8_SA
#undef PG8_SB
#undef PG8_STAGE
#undef PG8_LDA
#undef PG8_LDB
#undef PG8_MMA
#undef PG8_WAIT_V
#undef PG8_WAIT_L
#undef PG8_BAR
#undef PG8_SCHED
}
}

#define LAS __attribute__((address_space(3)))
#define XB_TMO      128
#define XB_XCNT(j)  (256  + 64 * (j))
#define XB_XSUB(j)  (1280 + 64 * (j))
#define XB_XGEN(j)  (2304 + 64 * (j))
#define XB_TOP      3328
#define XB_TOPGEN   3392
#define XCD_BAR_WORDS 3456
#define XB_SPIN_CAP (1u << 18)

__device__ __forceinline__ unsigned xb_ld(unsigned* p)              { return __hip_atomic_load(p, __ATOMIC_RELAXED, __HIP_MEMORY_SCOPE_AGENT); }
__device__ __forceinline__ unsigned xb_add(unsigned* p, unsigned v) { return __hip_atomic_fetch_add(p, v, __ATOMIC_RELAXED, __HIP_MEMORY_SCOPE_AGENT); }
__device__ __forceinline__ unsigned xb_xcc_id() { return (unsigned)__builtin_amdgcn_s_getreg((3 << 11) | 20) & 0xFu; }
#define XB_SPIN(cond, bar) do { unsigned _sp = 0; while (cond) { __builtin_amdgcn_s_sleep(1); \
    if ((++_sp & 255u) == 0u) { if (xb_ld(&(bar)[XB_TMO])) break; if (_sp > XB_SPIN_CAP) { atomicAdd(&(bar)[XB_TMO], 1u); break; } } } } while (0)

struct XcdBarrier {
    unsigned* bar; unsigned x;
    volatile LAS unsigned* st;
};

__device__ __forceinline__ XcdBarrier xcd_barrier_post(unsigned* bar, volatile LAS unsigned* st) {
    XcdBarrier b; b.bar = bar; b.x = xb_xcc_id(); b.st = st;
    if (threadIdx.x == 0) (void)xb_add(&bar[XB_XCNT(b.x)], 1u);
    return b;
}
__device__ __forceinline__ void xcd_barrier_complete(unsigned* bar, unsigned x, unsigned& nloc, unsigned& nx) {
    const unsigned G = gridDim.x * gridDim.y * gridDim.z;
    unsigned sum, cnt, mine, sp = 0u;
    for (;;) {
        sum = 0u; cnt = 0u; mine = 0u;
#pragma unroll
        for (unsigned j = 0; j < 16; ++j) { const unsigned c = xb_ld(&bar[XB_XCNT(j)]); sum += c; cnt += (c > 0u) ? 1u : 0u; mine = (j == x) ? c : mine; }
        if (sum == G) break;
        __builtin_amdgcn_s_sleep(1);
        if ((++sp & 255u) == 0u) { if (xb_ld(&bar[XB_TMO])) break; if (sp > XB_SPIN_CAP) { atomicAdd(&bar[XB_TMO], 1u); break; } }
    }
    nloc = mine > 0u ? mine : 1u; nx = cnt > 0u ? cnt : 1u;
}

__device__ __forceinline__ void xcd_barrier(const XcdBarrier& b) {
    asm volatile("s_waitcnt vmcnt(0)" ::: "memory");
    __syncthreads();
    if (threadIdx.x == 0) {
        unsigned* bar = b.bar;
        __builtin_amdgcn_s_waitcnt(0);
        unsigned nloc = b.st[0], nx = b.st[1];
        if (nloc == 0u) { xcd_barrier_complete(bar, b.x, nloc, nx); b.st[0] = nloc; b.st[1] = nx; }
        const unsigned old = xb_add(&bar[XB_XSUB(b.x)], 1u);
        const unsigned gen = old / nloc;
        if (old + 1u == (gen + 1u) * nloc) {
            __builtin_amdgcn_fence(__ATOMIC_RELEASE, "agent");
            asm volatile("s_waitcnt vmcnt(0)" ::: "memory");
            const unsigned og = xb_add(&bar[XB_TOP], 1u);
            const unsigned tg = og / nx;
            if (og + 1u == (tg + 1u) * nx) xb_add(&bar[XB_TOPGEN], 1u);
            else XB_SPIN(xb_ld(&bar[XB_TOPGEN]) == tg, bar);
            __builtin_amdgcn_fence(__ATOMIC_ACQUIRE, "agent");
            xb_add(&bar[XB_XGEN(b.x)], 1u);
            asm volatile("s_waitcnt vmcnt(0)" ::: "memory");
        } else {
            XB_SPIN(xb_ld(&bar[XB_XGEN(b.x)]) == gen, bar);
            __builtin_amdgcn_fence(__ATOMIC_ACQUIRE, "agent");
            asm volatile("s_waitcnt vmcnt(0)" ::: "memory");
        }
    }
    __syncthreads();
}

constexpr int BATCH = 16, SEQ = 2048, DM = 1024, MTOK = BATCH * SEQ, FF = 2816, NGU = 2 * FF, NINP = 3584, INCOLS = 3360, DEPTH = 2;
constexpr int NWAVES = 8;
constexpr float EPS = 1e-6f;
typedef unsigned short bf16;
typedef unsigned v4u __attribute__((ext_vector_type(4)));
typedef unsigned v2u __attribute__((ext_vector_type(2)));
typedef float f32x4 __attribute__((ext_vector_type(4)));
#define LDS_WAIT() asm volatile("s_waitcnt lgkmcnt(0)" ::: "memory")

constexpr size_t MiB = 1u << 20;
constexpr size_t WS_CTL = 0, CTL_ZERO_BYTES = MiB;
constexpr size_t WS_TAB = 1 * MiB;
constexpr size_t TAB_COS = 0, TAB_SIN = 65536, TAB_B1 = 131072;
constexpr size_t WS_W = 2 * MiB, W_LAYER = 43 * MiB;
constexpr size_t WO_GU1 = 0, WO_DN1 = 11 * MiB, WO_GU2 = 16 * MiB + MiB / 2, WO_DN2 = 27 * MiB + MiB / 2, WO_IN = 33 * MiB, WO_OUT = 40 * MiB, WO_CMP = 42 * MiB;
constexpr size_t WS_U = 88 * MiB;
constexpr size_t WS_HB = 152 * MiB;
constexpr size_t WS_HD = 328 * MiB;
constexpr size_t WS_PQ = 392 * MiB;
constexpr size_t WS_CC = 400 * MiB;
constexpr size_t WS_END = 401 * MiB;
constexpr size_t WS_QN = 152 * MiB, WS_KCR = 184 * MiB, WS_VCR = 192 * MiB, WS_KS = 200 * MiB, WS_VS = 208 * MiB, WS_KW = 216 * MiB, WS_VW = 224 * MiB;
constexpr size_t WS_MQ = 232 * MiB, WS_MK = 264 * MiB, WS_MV = 296 * MiB, WS_MO = 328 * MiB, WS_GATE = 360 * MiB;
static_assert(WS_GATE + 4 * MiB <= WS_PQ, "in-projection outputs end below PQ");
constexpr int CW_BAR = 4096;
constexpr int PH_BYTES = 143360, MISC_OFF = PH_BYTES, LDS_BYTES = 147456;

__device__ __forceinline__ unsigned f2bf(float f) { unsigned u = __builtin_bit_cast(unsigned, f); return (u + 0x7fffu + ((u >> 16) & 1u)) >> 16; }
__device__ __forceinline__ unsigned pk2(float lo, float hi) { return f2bf(lo) | (f2bf(hi) << 16); }
__device__ __forceinline__ float bflo(unsigned u) { return __builtin_bit_cast(float, u << 16); }
__device__ __forceinline__ float bfhi(unsigned u) { return __builtin_bit_cast(float, u & 0xffff0000u); }
__device__ __forceinline__ float bf2f(bf16 b) { return __builtin_bit_cast(float, (unsigned)b << 16); }
__device__ __forceinline__ float sigmoidf_(float x) { return 1.f / (1.f + __expf(-x)); }
__device__ __forceinline__ float wave_sum(float v) {
#pragma unroll
    for (int o = 1; o < 64; o <<= 1) v += __shfl_xor(v, o);
    return v;
}

struct SrcGU { const float* W; __device__ __forceinline__ float operator()(int k, int nd) const { const int pn = nd >> 8, r = nd & 255; const int col = (r < 128) ? (pn * 128 + r) : (FF + pn * 128 + r - 128); return W[(size_t)k * NGU + col]; } };
struct SrcPlain { const float* W; int N; __device__ __forceinline__ float operator()(int k, int nd) const { return W[(size_t)k * N + nd]; } };
struct SrcIN { const float* W; __device__ __forceinline__ float operator()(int k, int nd) const {
    const int col = nd < 1280 ? nd : (nd < 3328 ? nd + 24 : (nd < 3352 ? nd - 3328 + 1280 : (nd < 3360 ? nd : -1)));
    return col < 0 ? 0.f : W[(size_t)k * INCOLS + col]; } };
struct SrcCMP { const float* W1; __device__ __forceinline__ float operator()(int k, int nd) const { const int kv = nd >> 8, r = nd & 255;
    return r < 128 ? W1[((size_t)kv * 2048 + k) * 128 + r] : W1[((size_t)kv * 2048 + 1024 + k) * 128 + r - 128]; } };

template <class SrcF>
__device__ __forceinline__ void transpose_item(const SrcF& src, int K, bf16* WT, LAS float* scr, int kb, int nb, int lane) {
    const int k0 = 64 * kb, n0 = 32 * nb;
#pragma unroll 8
    for (int i = 0; i < 32; ++i) { const int kk = 2 * i + (lane >> 5); scr[kk * 33 + (lane & 31)] = src(k0 + kk, n0 + (lane & 31)); }
    LDS_WAIT(); asm volatile("" ::: "memory");
    const int c = lane & 7;
#pragma unroll
    for (int j = 0; j < 4; ++j) { const int n = (lane >> 3) + 8 * j; const LAS float* s = scr + (8 * c) * 33 + n;
        v4u o; o.x = pk2(s[0 * 33], s[1 * 33]); o.y = pk2(s[2 * 33], s[3 * 33]); o.z = pk2(s[4 * 33], s[5 * 33]); o.w = pk2(s[6 * 33], s[7 * 33]);
        *(v4u*)(WT + (size_t)(n0 + n) * K + k0 + 8 * c) = o; }
    LDS_WAIT(); asm volatile("" ::: "memory");
}

template <int MODE>
__device__ __forceinline__ void thin_phase(const bf16* HD, const float* xin, float* xout, const float* gpost, float cc, const float* gpre, bf16* U, int gw, int NGW, int lane) {
    f32x4 gp[4], gq[4];
#pragma unroll
    for (int j = 0; j < 4; ++j) { gp[j] = (MODE != 0) ? *(const f32x4*)(gpost + 4 * lane + 256 * j) : (f32x4){0.f, 0.f, 0.f, 0.f};
                                  gq[j] = (MODE != 2) ? *(const f32x4*)(gpre + 4 * lane + 256 * j) : (f32x4){0.f, 0.f, 0.f, 0.f}; }
    for (int m = gw; m < MTOK; m += NGW) {
        f32x4 x[4];
#pragma unroll
        for (int j = 0; j < 4; ++j) x[j] = *(const f32x4*)(xin + (size_t)m * DM + 4 * lane + 256 * j);
        if (MODE != 0) {
            f32x4 h[4]; float ss = 0.f;
#pragma unroll
            for (int j = 0; j < 4; ++j) { const v2u w = *(const v2u*)(HD + (size_t)m * DM + 4 * lane + 256 * j);
                h[j] = (f32x4){bflo(w.x), bfhi(w.x), bflo(w.y), bfhi(w.y)}; ss += (h[j].x * h[j].x + h[j].y * h[j].y) + (h[j].z * h[j].z + h[j].w * h[j].w); }
            const float r = cc * __frsqrt_rn(wave_sum(ss) * (1.f / DM) + EPS);
#pragma unroll
            for (int j = 0; j < 4; ++j) x[j] = x[j] + (h[j] * r) * gp[j];
        }
#pragma unroll
        for (int j = 0; j < 4; ++j) *(f32x4*)(xout + (size_t)m * DM + 4 * lane + 256 * j) = x[j];
        if (MODE != 2) {
            float s2 = 0.f;
#pragma unroll
            for (int j = 0; j < 4; ++j) s2 += (x[j].x * x[j].x + x[j].y * x[j].y) + (x[j].z * x[j].z + x[j].w * x[j].w);
            const float r2 = __frsqrt_rn(wave_sum(s2) * (1.f / DM) + EPS);
#pragma unroll
            for (int j = 0; j < 4; ++j) { const f32x4 y = (x[j] * r2) * gq[j]; v2u w; w.x = pk2(y.x, y.y); w.y = pk2(y.z, y.w);
                *(v2u*)(U + (size_t)m * DM + 4 * lane + 256 * j) = w; }
        }
    }
}

struct EpiSwiglu {
    static constexpr bool PERM = true, AFTER_DRAIN = false;
    bf16* H;
    __device__ __forceinline__ void operator()(const pg8::f32x4 (&acc)[2][2][4][2], const pg8::Unit& u, int wr, int wc, int fr, int fq) const {
#pragma unroll
        for (int ai = 0; ai < 2; ++ai)
#pragma unroll
            for (int m = 0; m < 4; ++m) {
                const int row = u.pm * 256 + ai * 128 + wr * 64 + m * 16 + fr;
                float o[8];
#pragma unroll
                for (int n = 0; n < 2; ++n)
#pragma unroll
                    for (int e = 0; e < 4; ++e) { const float g = acc[ai][0][m][n][e], up = acc[ai][1][m][n][e]; o[n * 4 + e] = g * up / (1.f + __expf(-g)); }
                v4u w; w.x = pg8::cvt_pk_bf16(o[0], o[1]); w.y = pg8::cvt_pk_bf16(o[2], o[3]); w.z = pg8::cvt_pk_bf16(o[4], o[5]); w.w = pg8::cvt_pk_bf16(o[6], o[7]);
                *(v4u*)(H + (size_t)row * FF + u.pn * 128 + wc * 32 + fq * 8) = w;
            }
    }
};
struct EpiPQ {
    static constexpr bool PERM = true, AFTER_DRAIN = false;
    float* O;
    __device__ __forceinline__ void operator()(const pg8::f32x4 (&acc)[2][2][4][2], const pg8::Unit& u, int wr, int wc, int fr, int fq) const {
#pragma unroll
        for (int ai = 0; ai < 2; ++ai)
#pragma unroll
            for (int m = 0; m < 4; ++m) {
                const int row = u.pm * 256 + ai * 128 + wr * 64 + m * 16 + fr;
#pragma unroll
                for (int bj = 0; bj < 2; ++bj) { float* p = O + (size_t)row * 256 + bj * 128 + wc * 32 + fq * 8;
                    *(pg8::f32x4*)p = acc[ai][bj][m][0]; *(pg8::f32x4*)(p + 4) = acc[ai][bj][m][1]; }
            }
    }
};
struct CmpOrder {
    int c, G;
    __device__ __forceinline__ bool next(int i, pg8::Unit& u) const { const int idx = i * G + c; if (idx >= 32) return false; u.pm = idx; u.pn = idx >> 4; return true; }
    __device__ __forceinline__ void a_ready(const pg8::Unit&) const {}
    __device__ __forceinline__ void done(const pg8::Unit&) const {}
};
struct EpiInProj {
    static constexpr bool PERM = true, AFTER_DRAIN = false;
    unsigned char* ws;
    __device__ __forceinline__ void operator()(const pg8::f32x4 (&acc)[2][2][4][2], const pg8::Unit& u, int wr, int wc, int fr, int fq) const {
        const int pn = u.pn;
        const float* cosT = (const float*)(ws + WS_TAB + TAB_COS); const float* sinT = (const float*)(ws + WS_TAB + TAB_SIN);
        const bool ropet = (pn < 2) || (pn == 3) || (pn == 4);
        const bool ropew = ropet && ((wc & 1) == 0);
#pragma unroll
        for (int ai = 0; ai < 2; ++ai)
#pragma unroll
            for (int m = 0; m < 4; ++m) {
                const int row = u.pm * 256 + ai * 128 + wr * 64 + m * 16 + fr;
                const int b = row >> 11, t = row & 2047;
                f32x4 c0, c1, s0, s1;
                if (ropew) { c0 = *(const f32x4*)(cosT + t * 8); c1 = *(const f32x4*)(cosT + t * 8 + 4); s0 = *(const f32x4*)(sinT + t * 8); s1 = *(const f32x4*)(sinT + t * 8 + 4); }
#pragma unroll
                for (int bj = 0; bj < 2; ++bj) {
                    f32x4 v0 = acc[ai][bj][m][0], v1 = acc[ai][bj][m][1];
                    const int cl = bj * 128 + wc * 32 + fq * 8;
                    if (ropew && (pn < 2 || bj == 0)) {
                        f32x4 p0, p1;
                        p0.x = __shfl_xor(v0.x, 16); p0.y = __shfl_xor(v0.y, 16); p0.z = __shfl_xor(v0.z, 16); p0.w = __shfl_xor(v0.w, 16);
                        p1.x = __shfl_xor(v1.x, 16); p1.y = __shfl_xor(v1.y, 16); p1.z = __shfl_xor(v1.z, 16); p1.w = __shfl_xor(v1.w, 16);
                        const float sg = (fq == 0) ? -1.f : 1.f;
                        if (fq < 2) { v0 = v0 * c0 + (p0 * s0) * sg; v1 = v1 * c1 + (p1 * s1) * sg; }
                    }
                    if (pn == 13) { if (cl < 32) { float* p = (float*)(ws + WS_GATE) + (size_t)row * 32 + cl; *(f32x4*)p = v0; *(f32x4*)(p + 4) = v1; } }
                    else {
                        size_t off;
                        if (pn < 2) off = WS_QN + ((size_t)row * 512 + pn * 256 + cl) * 2;
                        else if (pn < 5) { const int g = wc >> 1, d = (wc & 1) * 32 + fq * 8; off = WS_KCR + (size_t)((pn - 2) * 2 + bj) * (8 * MiB) + (((size_t)(b * 2 + g) * SEQ + t) * 64 + d) * 2; }
                        else { const int q = pn - 5; off = WS_MQ + (size_t)(q >> 1) * (32 * MiB) + ((size_t)row * 512 + (q & 1) * 256 + cl) * 2; }
                        v4u w; w.x = pg8::cvt_pk_bf16(v0.x, v0.y); w.y = pg8::cvt_pk_bf16(v0.z, v0.w); w.z = pg8::cvt_pk_bf16(v1.x, v1.y); w.w = pg8::cvt_pk_bf16(v1.z, v1.w);
                        *(v4u*)(ws + off) = w;
                    }
                }
            }
    }
};
static_assert(WS_VCR == WS_KCR + 8 * MiB && WS_KS == WS_KCR + 16 * MiB && WS_VS == WS_KCR + 24 * MiB && WS_KW == WS_KCR + 32 * MiB && WS_VW == WS_KCR + 40 * MiB, "kv buffers are 8 MiB apart in (pn, bj) order");
static_assert(WS_MK == WS_MQ + 32 * MiB && WS_MV == WS_MQ + 64 * MiB && WS_MO == WS_MQ + 96 * MiB, "mLSTM buffers are 32 MiB apart");

__device__ __forceinline__ float dot64(const float (&q)[64], const LAS unsigned char* krow) {
    float s0 = 0.f, s1 = 0.f;
#pragma unroll
    for (int c8 = 0; c8 < 8; ++c8) { const v4u kk = *(const LAS v4u*)(krow + c8 * 16);
        s0 += q[c8 * 8 + 0] * bflo(kk.x) + q[c8 * 8 + 2] * bflo(kk.y) + q[c8 * 8 + 4] * bflo(kk.z) + q[c8 * 8 + 6] * bflo(kk.w);
        s1 += q[c8 * 8 + 1] * bfhi(kk.x) + q[c8 * 8 + 3] * bfhi(kk.y) + q[c8 * 8 + 5] * bfhi(kk.z) + q[c8 * 8 + 7] * bfhi(kk.w); }
    return s0 + s1;
}
__device__ __forceinline__ unsigned long long bits_upto(int hi) { return hi < 0 ? 0ull : (hi >= 63 ? ~0ull : ((2ull << hi) - 1ull)); }

struct MixPtrs { unsigned char* ws; const float *conv_w, *conv_b, *i_bias, *f_bias, *mnorm_g; };
#define MP_QN ((const bf16*)(P.ws + WS_QN))
#define MP_KS ((const bf16*)(P.ws + WS_KS))
#define MP_VS ((const bf16*)(P.ws + WS_VS))
#define MP_KW ((const bf16*)(P.ws + WS_KW))
#define MP_VW ((const bf16*)(P.ws + WS_VW))
#define MP_KC ((const bf16*)(P.ws + WS_CC))
#define MP_VC ((const bf16*)(P.ws + WS_CC) + (size_t)4096 * 64)
#define MP_MQ ((const bf16*)(P.ws + WS_MQ))
#define MP_MK ((const bf16*)(P.ws + WS_MK))
#define MP_MV ((const bf16*)(P.ws + WS_MV))
#define MP_MO ((const bf16*)(P.ws + WS_MO))
#define MP_GATE ((const float*)(P.ws + WS_GATE))
#define MP_Y ((bf16*)(P.ws + WS_U))

constexpr int NS_KT = 0, NS_VT = 8192, NS_IMP = 16384, NS_IMS = 50176, NS_SEL = 58624, NS_OUT = 59136;
__device__ __forceinline__ void nsa_unit_simple(LAS unsigned char* L, const MixPtrs& P, int b, int g, int c) {
    int tid_l = threadIdx.x; asm volatile("" : "+v"(tid_l));
    const int tid = tid_l, lane = tid & 63, w = __builtin_amdgcn_readfirstlane(tid >> 6);
    const bool act = w < 4; const int h = w & 3, t = c * 64 + lane; const size_t row = (size_t)b * SEQ + t;
    LAS float* OUT = (LAS float*)(L + NS_OUT) + tid * 65;
    LAS unsigned* SEL = (LAS unsigned*)(L + NS_SEL);
    float q[64];
    if (act) {
        const bf16* qp = MP_QN + row * 512 + (g * 4 + h) * 64;
#pragma unroll
        for (int c8 = 0; c8 < 8; ++c8) { const v4u v = *(const v4u*)(qp + c8 * 8);
            q[c8 * 8 + 0] = bflo(v.x) * 0.125f; q[c8 * 8 + 1] = bfhi(v.x) * 0.125f; q[c8 * 8 + 2] = bflo(v.y) * 0.125f; q[c8 * 8 + 3] = bfhi(v.y) * 0.125f;
            q[c8 * 8 + 4] = bflo(v.z) * 0.125f; q[c8 * 8 + 5] = bfhi(v.z) * 0.125f; q[c8 * 8 + 6] = bflo(v.w) * 0.125f; q[c8 * 8 + 7] = bfhi(v.w) * 0.125f; }
#pragma unroll
        for (int d = 0; d < 64; ++d) OUT[d] = 0.f;
    } else {
#pragma unroll
        for (int d = 0; d < 64; ++d) q[d] = 0.f;
    }
    const size_t kvbase = (size_t)(b * 2 + g) * SEQ * 64, ccbase = (size_t)(b * 2 + g) * 128 * 64;
    const int nlim = (t >= 31) ? (((t - 31) >> 4) < 126 ? ((t - 31) >> 4) : 126) : -1;
    unsigned un = 0u, mysel = 0u;
#pragma unroll 1
    for (int br = 0; br < 3; ++br) {
        float o[64], mx = -1e30f, l = 0.f;
#pragma unroll
        for (int d = 0; d < 64; ++d) o[d] = 0.f;
        int j0, j1; const bf16 *Kp, *Vp;
        if (br == 0) { j0 = 0; j1 = 1; Kp = MP_KC + ccbase; Vp = MP_VC + ccbase; }
        else if (br == 1) { j0 = 0; j1 = c; Kp = MP_KS + kvbase; Vp = MP_VS + kvbase; }
        else { j0 = (c - 8 > 0) ? c - 8 : 0; j1 = c; Kp = MP_KW + kvbase; Vp = MP_VW + kvbase; }
#pragma unroll 1
        for (int j = j0; j <= j1; ++j) {
            if (br == 1 && !((un >> j) & 1u)) continue;
            __syncthreads();
            *(LAS v4u*)(L + NS_KT + tid * 16) = *(const v4u*)(Kp + (size_t)j * 4096 + tid * 8);
            *(LAS v4u*)(L + NS_VT + tid * 16) = *(const v4u*)(Vp + (size_t)j * 4096 + tid * 8);
            __syncthreads();
            if (act) {
                unsigned long long mask;
                if (br == 0) mask = bits_upto(nlim - 64 * j);
                else if (br == 1) mask = ((mysel >> j) & 1u) ? ((j < c) ? ~0ull : bits_upto(lane)) : 0ull;
                else { const int lo = t - 511 - 64 * j, hi = t - 64 * j; mask = bits_upto(hi) & ~((lo > 0) ? bits_upto(lo - 1) : 0ull); }
#pragma unroll 1
                for (int r = 0; r < 64; ++r) {
                    const bool on = (mask >> r) & 1ull;
                    if (!__any(on)) continue;
                    const float s = dot64(q, L + NS_KT + r * 128);
                    if (on) {
                        if (s > mx) { const float corr = __expf(mx - s); l *= corr;
#pragma unroll
                            for (int d = 0; d < 64; ++d) o[d] *= corr;
                            mx = s; }
                        const float p = __expf(s - mx); l += p;
                        const LAS unsigned char* vr = L + NS_VT + r * 128;
#pragma unroll
                        for (int c8 = 0; c8 < 8; ++c8) { const v4u vv = *(const LAS v4u*)(vr + c8 * 16);
                            o[c8 * 8 + 0] += p * bflo(vv.x); o[c8 * 8 + 1] += p * bfhi(vv.x); o[c8 * 8 + 2] += p * bflo(vv.y); o[c8 * 8 + 3] += p * bfhi(vv.y);
                            o[c8 * 8 + 4] += p * bflo(vv.z); o[c8 * 8 + 5] += p * bfhi(vv.z); o[c8 * 8 + 6] += p * bflo(vv.w); o[c8 * 8 + 7] += p * bfhi(vv.w); }
                    }
                }
            }
        }
        if (act) { const float gate = sigmoidf_(MP_GATE[row * 32 + br * 8 + g * 4 + h]); const float sc = (l > 0.f) ? gate / l : 0.f;
#pragma unroll
            for (int d = 0; d < 64; ++d) OUT[d] += sc * o[d]; }
        if (br == 0) {
            __syncthreads();
            *(LAS v4u*)(L + NS_KT + tid * 16) = *(const v4u*)(Kp + tid * 8);
            *(LAS v4u*)(L + NS_KT + 8192 + tid * 16) = *(const v4u*)(Kp + 4096 + tid * 8);
            __syncthreads();
            if (act) {
                const float il = (l > 0.f) ? 1.f / l : 0.f;
                LAS float* IMP = (LAS float*)(L + NS_IMP) + tid * 33;
#pragma unroll 1
                for (int jb = 0; jb < 32; ++jb) { float a = 0.f;
#pragma unroll 1
                    for (int n = (jb ? 4 * jb - 1 : 0); n <= 4 * jb + 3 && n <= 126; ++n) { const float s = dot64(q, L + NS_KT + n * 128); if (n <= nlim) a += __expf(s - mx); }
                    IMP[jb] = a * il; }
            }
            __syncthreads();
            if (w == 0) {
                LAS float* IMS = (LAS float*)(L + NS_IMS) + lane * 33; const LAS float* I4 = (const LAS float*)(L + NS_IMP);
                for (int jb = 0; jb < 32; ++jb) IMS[jb] = (I4[lane * 33 + jb] + I4[(64 + lane) * 33 + jb]) + (I4[(128 + lane) * 33 + jb] + I4[(192 + lane) * 33 + jb]);
                unsigned sel;
                if (c + 1 <= 16) sel = (1u << (c + 1)) - 1u;
                else { sel = 1u | (1u << c) | (1u << (c - 1));
                    for (int jb = 1; jb <= c - 2; ++jb) { const float vj = IMS[jb]; int rank = 0;
                        for (int i2 = 1; i2 <= c - 2; ++i2) { const float vi = IMS[i2]; rank += (vi > vj || (vi == vj && i2 < jb)) ? 1 : 0; }
                        if (rank < 13) sel |= 1u << jb; } }
                SEL[lane] = sel; unsigned so = sel;
#pragma unroll
                for (int o2 = 32; o2; o2 >>= 1) so |= __shfl_xor(so, o2);
                if (lane == 0) SEL[64] = so;
            }
            __syncthreads();
            un = SEL[64]; mysel = SEL[lane];
        }
    }
    if (act) { bf16* yp = MP_Y + row * DM + (g * 4 + h) * 64;
#pragma unroll
        for (int c8 = 0; c8 < 8; ++c8) { v4u wv; wv.x = pk2(OUT[c8 * 8 + 0], OUT[c8 * 8 + 1]); wv.y = pk2(OUT[c8 * 8 + 2], OUT[c8 * 8 + 3]); wv.z = pk2(OUT[c8 * 8 + 4], OUT[c8 * 8 + 5]); wv.w = pk2(OUT[c8 * 8 + 6], OUT[c8 * 8 + 7]);
            *(v4u*)(yp + c8 * 8) = wv; } }
    __syncthreads();
}

constexpr int ML_Q = 0, ML_K = 16384, ML_V = 32768, ML_SC = 49152, ML_C = 65536, ML_N = 131072, ML_S = 131584;
__device__ __forceinline__ void mlstm_unit_simple(LAS unsigned char* L, const MixPtrs& P, int b, int h) {
    int tid_l = threadIdx.x; asm volatile("" : "+v"(tid_l));
    const int tid = tid_l, lane = tid & 63, w = __builtin_amdgcn_readfirstlane(tid >> 6);
    LAS float* Cm = (LAS float*)(L + ML_C); LAS float* Nv = (LAS float*)(L + ML_N); LAS float* SC = (LAS float*)(L + ML_SC);
    LAS float* S_bcum = (LAS float*)(L + ML_S), *S_a = S_bcum + 64, *S_mt = S_bcum + 128, *S_wp = S_bcum + 192, *S_wk = S_bcum + 256, *S_x = S_bcum + 320;
    LAS bf16* Qs = (LAS bf16*)(L + ML_Q); LAS bf16* Ks = (LAS bf16*)(L + ML_K); LAS bf16* Vs = (LAS bf16*)(L + ML_V);
    float zf = 0.f; asm volatile("" : "+v"(zf));
    for (int i = tid; i < 128 * 128; i += 512) Cm[i] = zf;
    if (tid < 128) Nv[tid] = zf;
    if (tid == 0) { S_x[0] = zf; S_x[1] = zf; }
    const int ch = tid & 127, sg = tid >> 7;
    float wq[4], wk4[4];
#pragma unroll
    for (int j = 0; j < 4; ++j) { wq[j] = P.conv_w[j * 1024 + h * 128 + ch]; wk4[j] = P.conv_w[j * 1024 + 512 + h * 128 + ch]; }
    const float bq = P.conv_b[h * 128 + ch], bk = P.conv_b[512 + h * 128 + ch];
    const float ib = P.i_bias[h], fb = P.f_bias[h];
    __syncthreads();
#pragma unroll 1
    for (int c = 0; c < 32; ++c) {
        const int t0 = c * 64; const size_t rb = (size_t)b * SEQ;
#pragma unroll 1
        for (int s = 0; s < 16; ++s) { const int sl = sg * 16 + s, t = t0 + sl; float aq = bq, ak = bk;
#pragma unroll
            for (int j = 0; j < 4; ++j) { const int tt = t - 3 + j; if (tt >= 0) { aq += wq[j] * bf2f(MP_MQ[(rb + tt) * 512 + h * 128 + ch]); ak += wk4[j] * bf2f(MP_MK[(rb + tt) * 512 + h * 128 + ch]); } }
            aq = aq / (1.f + __expf(-aq)); ak = ak / (1.f + __expf(-ak)) * 0.08838834764831845f;
            Qs[sl * 128 + ch] = (bf16)f2bf(aq); Ks[sl * 128 + ch] = (bf16)f2bf(ak); Vs[sl * 128 + ch] = MP_MV[(rb + t) * 512 + h * 128 + ch]; }
        if (w == 0) {
            const size_t row = rb + t0 + lane;
            const float il = MP_GATE[row * 32 + 24 + h] + ib; const float fx = MP_GATE[row * 32 + 28 + h] + fb;
            const float fl = fminf(fx, 0.f) - log1pf(__expf(-fabsf(fx)));
            float f = fl;
#pragma unroll
            for (int o = 1; o < 64; o <<= 1) { const float v = __shfl_up(f, o); if (lane >= o) f += v; }
            const float a = il - f; float pm = a;
#pragma unroll
            for (int o = 1; o < 64; o <<= 1) { const float v = __shfl_up(pm, o); if (lane >= o) pm = fmaxf(pm, v); }
            const float b_last = __shfl(f, 63), amax = __shfl(pm, 63), mc = S_x[0];
            const float inter = f + mc, mt = fmaxf(f + pm, inter);
            const float m_new = fmaxf(b_last + mc, b_last + amax);
            S_bcum[lane] = f; S_a[lane] = a; S_mt[lane] = mt; S_wp[lane] = __expf(inter - mt); S_wk[lane] = __expf(b_last + a - m_new);
            if (lane == 0) { S_x[1] = __expf(b_last + mc - m_new); S_x[0] = m_new; }
        }
        __syncthreads();
        { const int t = tid >> 3; const float bt = S_bcum[t] - S_mt[t];
#pragma unroll 1
          for (int jj = 0; jj < 8; ++jj) { const int s = (tid & 7) + 8 * jj; float v = 0.f;
              if (s <= t) { float d0 = 0.f;
#pragma unroll
                  for (int c8 = 0; c8 < 16; ++c8) { const v4u qa = *(const LAS v4u*)(Qs + t * 128 + c8 * 8), ka = *(const LAS v4u*)(Ks + s * 128 + c8 * 8);
                      d0 += bflo(qa.x) * bflo(ka.x) + bfhi(qa.x) * bfhi(ka.x) + bflo(qa.y) * bflo(ka.y) + bfhi(qa.y) * bfhi(ka.y) + bflo(qa.z) * bflo(ka.z) + bfhi(qa.z) * bfhi(ka.z) + bflo(qa.w) * bflo(ka.w) + bfhi(qa.w) * bfhi(ka.w); }
                  v = d0 * __expf(bt + S_a[s]); }
              SC[t * 64 + s] = v; } }
        __syncthreads();
        { const int t = tid >> 3, e0 = (tid & 7) * 16; float acc[16], acc2[16], dsum = 0.f, dqn = 0.f;
#pragma unroll
          for (int e = 0; e < 16; ++e) { acc[e] = 0.f; acc2[e] = 0.f; }
#pragma unroll 1
          for (int s = 0; s < 64; ++s) { const float wv = SC[t * 64 + s]; dsum += wv;
              const v4u v0 = *(const LAS v4u*)(Vs + s * 128 + e0), v1 = *(const LAS v4u*)(Vs + s * 128 + e0 + 8);
              acc[0] += wv * bflo(v0.x); acc[1] += wv * bfhi(v0.x); acc[2] += wv * bflo(v0.y); acc[3] += wv * bfhi(v0.y); acc[4] += wv * bflo(v0.z); acc[5] += wv * bfhi(v0.z); acc[6] += wv * bflo(v0.w); acc[7] += wv * bfhi(v0.w);
              acc[8] += wv * bflo(v1.x); acc[9] += wv * bfhi(v1.x); acc[10] += wv * bflo(v1.y); acc[11] += wv * bfhi(v1.y); acc[12] += wv * bflo(v1.z); acc[13] += wv * bfhi(v1.z); acc[14] += wv * bflo(v1.w); acc[15] += wv * bfhi(v1.w); }
#pragma unroll 1
          for (int d = 0; d < 128; ++d) { const float qd = bf2f(Qs[t * 128 + d]); dqn += qd * Nv[d];
              const LAS f32x4* cr = (const LAS f32x4*)(Cm + d * 128 + e0);
#pragma unroll
              for (int e4 = 0; e4 < 4; ++e4) { const f32x4 cv = cr[e4]; acc2[e4 * 4 + 0] += qd * cv.x; acc2[e4 * 4 + 1] += qd * cv.y; acc2[e4 * 4 + 2] += qd * cv.z; acc2[e4 * 4 + 3] += qd * cv.w; } }
          const float wp = S_wp[t], den = dsum + wp * dqn; const float dn = fmaxf(fabsf(den), __expf(-S_mt[t])); const float idn = 1.f / dn;
          float ss = 0.f;
#pragma unroll
          for (int e = 0; e < 16; ++e) { acc[e] = (acc[e] + wp * acc2[e]) * idn; ss += acc[e] * acc[e]; }
          ss += __shfl_xor(ss, 1); ss += __shfl_xor(ss, 2); ss += __shfl_xor(ss, 4);
          const float rn = __frsqrt_rn(ss * (1.f / 128.f) + EPS);
          const size_t row = rb + t0 + t; const bf16* op = MP_MO + row * 512 + h * 128 + e0; const float* gn = P.mnorm_g + h * 128 + e0;
          const v4u o0 = *(const v4u*)op, o1 = *(const v4u*)(op + 8);
          const float ov[16] = {bflo(o0.x), bfhi(o0.x), bflo(o0.y), bfhi(o0.y), bflo(o0.z), bfhi(o0.z), bflo(o0.w), bfhi(o0.w), bflo(o1.x), bfhi(o1.x), bflo(o1.y), bfhi(o1.y), bflo(o1.z), bfhi(o1.z), bflo(o1.w), bfhi(o1.w)};
          float y[16];
#pragma unroll
          for (int e = 0; e < 16; ++e) y[e] = acc[e] * rn * gn[e] * sigmoidf_(ov[e]);
          v4u w0, w1; w0.x = pk2(y[0], y[1]); w0.y = pk2(y[2], y[3]); w0.z = pk2(y[4], y[5]); w0.w = pk2(y[6], y[7]); w1.x = pk2(y[8], y[9]); w1.y = pk2(y[10], y[11]); w1.z = pk2(y[12], y[13]); w1.w = pk2(y[14], y[15]);
          bf16* yp = MP_Y + row * DM + 512 + h * 128 + e0; *(v4u*)yp = w0; *(v4u*)(yp + 8) = w1; }
        __syncthreads();
        { const int d = tid >> 2, e0 = (tid & 3) * 32; const float cs = S_x[1]; float ca[32], na = 0.f;
#pragma unroll
          for (int e = 0; e < 32; ++e) ca[e] = cs * Cm[d * 128 + e0 + e];
#pragma unroll 1
          for (int s = 0; s < 64; ++s) { const float kk = S_wk[s] * bf2f(Ks[s * 128 + d]); na += kk;
#pragma unroll
              for (int c8 = 0; c8 < 4; ++c8) { const v4u vv = *(const LAS v4u*)(Vs + s * 128 + e0 + c8 * 8);
                  ca[c8 * 8 + 0] += kk * bflo(vv.x); ca[c8 * 8 + 1] += kk * bfhi(vv.x); ca[c8 * 8 + 2] += kk * bflo(vv.y); ca[c8 * 8 + 3] += kk * bfhi(vv.y);
                  ca[c8 * 8 + 4] += kk * bflo(vv.z); ca[c8 * 8 + 5] += kk * bfhi(vv.z); ca[c8 * 8 + 6] += kk * bflo(vv.w); ca[c8 * 8 + 7] += kk * bfhi(vv.w); } }
#pragma unroll
          for (int e = 0; e < 32; ++e) Cm[d * 128 + e0 + e] = ca[e];
          if ((tid & 3) == 0) Nv[d] = cs * Nv[d] + na; }
        __syncthreads();
    }
}

typedef float f32x16 __attribute__((ext_vector_type(16)));
typedef short bf16x8v __attribute__((ext_vector_type(8)));
typedef short s16x4v __attribute__((ext_vector_type(4)));
typedef float f32x2v __attribute__((ext_vector_type(2)));
typedef __bf16 bf16x2v __attribute__((ext_vector_type(2)));
#define MFMA32(a, b, c) __builtin_amdgcn_mfma_f32_32x32x16_bf16((a), (b), (c), 0, 0, 0)
__device__ __forceinline__ unsigned cvtpk(float lo, float hi) { f32x2v v = {lo, hi}; bf16x2v b = __builtin_convertvector(v, bf16x2v); return __builtin_bit_cast(unsigned, b); }
__device__ __forceinline__ s16x4v tr_read(const LAS unsigned char* p) { return __builtin_bit_cast(s16x4v, __builtin_amdgcn_ds_read_tr16_b64_v4i16((LAS s16x4v*)p)); }
__device__ __forceinline__ int tile_off(int key, int ch8) { return (ch8 >> 2) * 4096 + key * 64 + (((ch8 & 3) ^ ((key >> 2) & 3)) << 4); }
constexpr int NM_SLOT = 0, NM_IMP = 32768, NM_IMS = 66560, NM_SEL = 75008, NM_ITEM = 75328;
constexpr float QK_SCALE = 0.125f * 1.4426950408889634f;

__device__ __forceinline__ void qk_tile(const LAS unsigned char* Ks, const bf16x8v (&qf)[4], int r, int h, f32x16& p0, f32x16& p1) {
    const f32x16 z = {0.f, 0.f, 0.f, 0.f, 0.f, 0.f, 0.f, 0.f, 0.f, 0.f, 0.f, 0.f, 0.f, 0.f, 0.f, 0.f};
    const int sw = (r >> 2) & 3;
#pragma unroll
    for (int ks = 0; ks < 4; ++ks) {
        const int off = (ks >> 1) * 4096 + r * 64 + (((((ks & 1) << 1) + h) ^ sw) << 4);
        const bf16x8v a0 = *(const LAS bf16x8v*)(Ks + off), a1 = *(const LAS bf16x8v*)(Ks + off + 2048);
        p0 = MFMA32(a0, qf[ks], ks ? p0 : z); p1 = MFMA32(a1, qf[ks], ks ? p1 : z);
    }
}
__device__ __forceinline__ void pv_tile(const LAS unsigned char* Vs, const f32x16& p0, const f32x16& p1, f32x16 (&o)[2], int lane) {
    const int h = lane >> 5, i16 = lane & 15, q = i16 >> 2, p = i16 & 3, gi = (lane >> 4) & 1;
    const int cidx = 2 * gi + (p >> 1), e8 = (p & 1) << 3;
    const int offlo = q * 64 + ((cidx ^ h) << 4) + e8 + h * 256, offhi = q * 64 + ((cidx ^ (h | 2)) << 4) + e8 + h * 256 + 512;
#pragma unroll
    for (int kb = 0; kb < 2; ++kb)
#pragma unroll
        for (int s = 0; s < 2; ++s) {
            const f32x16& P = kb ? p1 : p0;
            v4u pw; pw.x = cvtpk(P[8 * s + 0], P[8 * s + 1]); pw.y = cvtpk(P[8 * s + 2], P[8 * s + 3]); pw.z = cvtpk(P[8 * s + 4], P[8 * s + 5]); pw.w = cvtpk(P[8 * s + 6], P[8 * s + 7]);
            const bf16x8v pf = __builtin_bit_cast(bf16x8v, pw);
#pragma unroll
            for (int db = 0; db < 2; ++db) {
                const LAS unsigned char* base = Vs + db * 4096 + (kb * 32 + s * 16) * 64;
                const s16x4v lo = tr_read(base + offlo), hi = tr_read(base + offhi);
                const bf16x8v vf = __builtin_shufflevector(lo, hi, 0, 1, 2, 3, 4, 5, 6, 7);
                o[db] = MFMA32(vf, pf, o[db]);
            }
        }
}

__device__ __forceinline__ void nsa_unit_mfma(LAS unsigned char* L, const MixPtrs& P, int b, int g, int c) {
    int tid_l = threadIdx.x; asm volatile("" : "+v"(tid_l));
    const int tid = tid_l, lane = tid & 63, w = __builtin_amdgcn_readfirstlane(tid >> 6);
    const int r = lane & 31, h = lane >> 5, head = w >> 1, qi = (w & 1) * 32 + r, t = c * 64 + qi;
    const size_t row = (size_t)b * SEQ + t;
    LAS unsigned* SEL = (LAS unsigned*)(L + NM_SEL); LAS int* ITEM = (LAS int*)(L + NM_ITEM);
    const size_t kvbase = (size_t)(b * 2 + g) * SEQ * 64, ccbase = (size_t)(b * 2 + g) * 128 * 64;
    const int skey = tid >> 3, sch = tid & 7, soff = tile_off(skey, sch);
    bf16x8v qf[4];
    { const bf16* qp = MP_QN + row * 512 + (g * 4 + head) * 64 + 8 * h;
#pragma unroll
      for (int ks = 0; ks < 4; ++ks) qf[ks] = *(const bf16x8v*)(qp + 16 * ks); }
    const float* gp = MP_GATE + row * 32 + g * 4 + head;
    const float gate_c = sigmoidf_(gp[0]), gate_s = sigmoidf_(gp[8]), gate_w = sigmoidf_(gp[16]);
    f32x16 oacc[2];
    {
        const bf16* kc = MP_KC + ccbase; const bf16* vc = MP_VC + ccbase;
        const v4u k0 = *(const v4u*)(kc + tid * 8), k1 = *(const v4u*)(kc + 4096 + tid * 8), v0 = *(const v4u*)(vc + tid * 8), v1 = *(const v4u*)(vc + 4096 + tid * 8);
        __syncthreads();
        *(LAS v4u*)(L + NM_SLOT + soff) = k0; *(LAS v4u*)(L + NM_SLOT + 8192 + soff) = v0; *(LAS v4u*)(L + NM_SLOT + 16384 + soff) = k1; *(LAS v4u*)(L + NM_SLOT + 24576 + soff) = v1;
        if (tid < 64) SEL[tid] = 0u;
        __syncthreads();
        f32x16 s0, s1, s2, s3;
        qk_tile(L + NM_SLOT, qf, r, h, s0, s1); qk_tile(L + NM_SLOT + 16384, qf, r, h, s2, s3);
        const int nlim = (t >= 31) ? (((t - 31) >> 4) < 126 ? ((t - 31) >> 4) : 126) : -1;
        float mx = -1e20f;
#pragma unroll
        for (int e = 0; e < 16; ++e) { const int cr = (e & 3) + 8 * (e >> 2) + 4 * h;
            s0[e] = (cr <= nlim) ? s0[e] * QK_SCALE : -1e30f; s1[e] = (cr + 32 <= nlim) ? s1[e] * QK_SCALE : -1e30f;
            s2[e] = (cr + 64 <= nlim) ? s2[e] * QK_SCALE : -1e30f; s3[e] = (cr + 96 <= nlim) ? s3[e] * QK_SCALE : -1e30f;
            mx = fmaxf(fmaxf(mx, fmaxf(s0[e], s1[e])), fmaxf(s2[e], s3[e])); }
        mx = fmaxf(mx, __shfl_xor(mx, 32));
        float ls = 0.f;
#pragma unroll
        for (int e = 0; e < 16; ++e) { s0[e] = __builtin_amdgcn_exp2f(s0[e] - mx); s1[e] = __builtin_amdgcn_exp2f(s1[e] - mx); s2[e] = __builtin_amdgcn_exp2f(s2[e] - mx); s3[e] = __builtin_amdgcn_exp2f(s3[e] - mx);
            ls += (s0[e] + s1[e]) + (s2[e] + s3[e]); }
        ls += __shfl_xor(ls, 32);
        const float il = (ls > 0.f) ? 1.f / ls : 0.f;
#pragma unroll
        for (int e = 0; e < 16; ++e) { s0[e] *= il; s1[e] *= il; s2[e] *= il; s3[e] *= il; }
        { LAS float* IMP = (LAS float*)(L + NM_IMP) + (w * 32 + r) * 33; float plprev = 0.f;
#pragma unroll
          for (int x = 0; x < 16; ++x) {
              const f32x16& S = (x < 4) ? s0 : ((x < 8) ? s1 : ((x < 12) ? s2 : s3)); const int g4 = (x & 3) * 4;
              const float own = (S[g4] + S[g4 + 1]) + (S[g4 + 2] + S[g4 + 3]);
              const float pl = __shfl_xor(S[g4 + 3], 32);
              if (h == 1) IMP[2 * x + 1] = own + pl; else IMP[2 * x] = own + plprev;
              plprev = pl;
          }
        }
        oacc[0] = (f32x16){0.f, 0.f, 0.f, 0.f, 0.f, 0.f, 0.f, 0.f, 0.f, 0.f, 0.f, 0.f, 0.f, 0.f, 0.f, 0.f}; oacc[1] = oacc[0];
        pv_tile(L + NM_SLOT + 8192, s0, s1, oacc, lane); pv_tile(L + NM_SLOT + 24576, s2, s3, oacc, lane);
#pragma unroll
        for (int e = 0; e < 16; ++e) { oacc[0][e] *= gate_c; oacc[1][e] *= gate_c; }
    }
    __syncthreads();
    { const int i = tid & 63, jg = tid >> 6; const LAS float* I8 = (const LAS float*)(L + NM_IMP); LAS float* IMS = (LAS float*)(L + NM_IMS);
#pragma unroll
      for (int jj = 0; jj < 4; ++jj) { const int j = 4 * jg + jj; const int wq = (i >> 5), rq = i & 31;
          IMS[i * 33 + j] = (I8[((0 + wq) * 32 + rq) * 33 + j] + I8[((2 + wq) * 32 + rq) * 33 + j]) + (I8[((4 + wq) * 32 + rq) * 33 + j] + I8[((6 + wq) * 32 + rq) * 33 + j]); }
      __syncthreads();
      unsigned bits = 0u;
      if (c + 1 <= 16) { if (jg == 0) bits = (1u << (c + 1)) - 1u; }
      else { if (jg == 0) bits = 1u | (1u << c) | (1u << (c - 1));
#pragma unroll 1
          for (int jj = 0; jj < 4; ++jj) { const int j = 4 * jg + jj; if (j >= 1 && j <= c - 2) { const float vj = IMS[i * 33 + j]; int rank = 0;
#pragma unroll 1
              for (int i2 = 1; i2 <= c - 2; ++i2) { const float vi = IMS[i * 33 + i2]; rank += (vi > vj || (vi == vj && i2 < j)) ? 1 : 0; }
              if (rank < 13) bits |= 1u << j; } } }
      if (bits) atomicOr((unsigned*)&SEL[i], bits);
      __syncthreads();
      if (w == 0) { unsigned so = SEL[lane];
#pragma unroll
          for (int o2 = 32; o2; o2 >>= 1) so |= __shfl_xor(so, o2);
          if (lane == 0) { int n = 0; for (int j = 0; j <= c; ++j) if ((so >> j) & 1u) ITEM[n++] = j; const int j0 = (c - 8 > 0) ? c - 8 : 0; for (int j = j0; j <= c; ++j) ITEM[n++] = 64 + j; ITEM[47] = n; } }
      __syncthreads();
    }
    const unsigned mysel = SEL[qi]; const int nitem = ITEM[47];
    f32x16 o[2]; float m = -1e20f, lsum = 0.f; int prev_kind = 0;
    o[0] = (f32x16){0.f, 0.f, 0.f, 0.f, 0.f, 0.f, 0.f, 0.f, 0.f, 0.f, 0.f, 0.f, 0.f, 0.f, 0.f, 0.f}; o[1] = o[0];
    v4u rk, rv;
    { const int it0 = ITEM[0]; const bf16* kp = ((it0 & 64) ? MP_KW : MP_KS) + kvbase + (size_t)(it0 & 63) * 4096; const bf16* vp = ((it0 & 64) ? MP_VW : MP_VS) + kvbase + (size_t)(it0 & 63) * 4096;
      rk = *(const v4u*)(kp + tid * 8); rv = *(const v4u*)(vp + tid * 8); }
    __syncthreads();
    *(LAS v4u*)(L + NM_SLOT + soff) = rk; *(LAS v4u*)(L + NM_SLOT + 8192 + soff) = rv;
    __syncthreads();
#pragma unroll 1
    for (int it = 0; it < nitem; ++it) {
        const int item = ITEM[it], kind = item >> 6, j = item & 63;
        if (it + 1 < nitem) { const int it1 = ITEM[it + 1]; const bf16* kp = ((it1 & 64) ? MP_KW : MP_KS) + kvbase + (size_t)(it1 & 63) * 4096; const bf16* vp = ((it1 & 64) ? MP_VW : MP_VS) + kvbase + (size_t)(it1 & 63) * 4096;
            rk = *(const v4u*)(kp + tid * 8); rv = *(const v4u*)(vp + tid * 8); }
        if (kind != prev_kind) {
            const float tot = lsum + __shfl_xor(lsum, 32); const float sc = gate_s / tot;
#pragma unroll
            for (int e = 0; e < 16; ++e) { oacc[0][e] += o[0][e] * sc; oacc[1][e] += o[1][e] * sc; o[0][e] = 0.f; o[1][e] = 0.f; }
            m = -1e20f; lsum = 0.f; prev_kind = kind;
        }
        int klo, khi;
        if (kind == 0) { klo = 0; khi = ((mysel >> j) & 1u) ? ((j < c) ? 63 : qi) : -1; }
        else { klo = t - 511 - 64 * j; khi = t - 64 * j; if (khi > 63) khi = 63; if (klo < 0) klo = 0; }
        const LAS unsigned char* slot = L + NM_SLOT + (it & 1) * 16384;
        if (__any(khi >= klo)) {
            f32x16 p0, p1;
            qk_tile(slot, qf, r, h, p0, p1);
            if (!__all(klo == 0 && khi == 63)) {
                const int a = klo - 4 * h, z = khi - 4 * h;
#pragma unroll
                for (int e = 0; e < 16; ++e) { const int cr = (e & 3) + 8 * (e >> 2);
                    p0[e] = (cr >= a && cr <= z) ? p0[e] : -1e30f; p1[e] = (cr + 32 >= a && cr + 32 <= z) ? p1[e] : -1e30f; }
            }
            float tm = fmaxf(p0[0], p1[0]);
#pragma unroll
            for (int e = 1; e < 16; ++e) tm = fmaxf(tm, fmaxf(p0[e], p1[e]));
            tm = fmaxf(tm, __shfl_xor(tm, 32));
            const float mn = fmaxf(m, tm * QK_SCALE);
            if (!__all(mn == m)) { const float corr = __builtin_amdgcn_exp2f(m - mn); lsum *= corr;
#pragma unroll
                for (int e = 0; e < 16; ++e) { o[0][e] *= corr; o[1][e] *= corr; }
                m = mn; }
            float ts = 0.f;
#pragma unroll
            for (int e = 0; e < 16; ++e) { p0[e] = __builtin_amdgcn_exp2f(p0[e] * QK_SCALE - m); p1[e] = __builtin_amdgcn_exp2f(p1[e] * QK_SCALE - m); ts += p0[e] + p1[e]; }
            lsum += ts;
            pv_tile(slot + 8192, p0, p1, o, lane);
        }
        if (it + 1 < nitem) { const int so = NM_SLOT + ((it + 1) & 1) * 16384; *(LAS v4u*)(L + so + soff) = rk; *(LAS v4u*)(L + so + 8192 + soff) = rv; }
        __syncthreads();
    }
    { const float tot = lsum + __shfl_xor(lsum, 32); const float sc = gate_w / tot;
#pragma unroll
      for (int e = 0; e < 16; ++e) { oacc[0][e] += o[0][e] * sc; oacc[1][e] += o[1][e] * sc; } }
    { bf16* yp = MP_Y + row * DM + (g * 4 + head) * 64 + 4 * h;
#pragma unroll
      for (int db = 0; db < 2; ++db)
#pragma unroll
          for (int g4 = 0; g4 < 4; ++g4) { v2u wv; wv.x = cvtpk(oacc[db][4 * g4], oacc[db][4 * g4 + 1]); wv.y = cvtpk(oacc[db][4 * g4 + 2], oacc[db][4 * g4 + 3]); *(v2u*)(yp + db * 32 + g4 * 8) = wv; } }
}

#ifndef MK_MULTI
#define MK_MULTI 0
#endif
constexpr int PH_PER_LAYER = 12, N_PHASES = 1 + DEPTH * PH_PER_LAYER;
struct Args { const float* in[16]; float* out; unsigned char* ws; int ph_lo, ph_hi; };
static_assert(sizeof(Args) == 16 * 8 + 8 + 8 + 8, "Args has no padding");

__global__ void __launch_bounds__(NWAVES * 64, 2) fwd_kernel(Args args) {
    extern __shared__ __attribute__((aligned(16))) unsigned char lds_raw[];
    LAS unsigned char* L = (LAS unsigned char*)lds_raw;
    const int G0 = gridDim.x, blk0 = blockIdx.x;
#define PH_IDS() PH_WS(); int tid = threadIdx.x; asm volatile("" : "+v"(tid)); const int lane = tid & 63, wave = __builtin_amdgcn_readfirstlane(tid >> 6), gw = blk * NWAVES + wave; (void)lane; (void)gw
#define PH_WS() unsigned char* ws = args.ws; asm volatile("" : "+s"(ws)); int blk = blk0, G = G0; asm volatile("" : "+s"(blk), "+s"(G)); const int NGW = G * NWAVES; (void)NGW; float* xres = args.out; bf16* U = (bf16*)(ws + WS_U); bf16* HB = (bf16*)(ws + WS_HB); bf16* HD = (bf16*)(ws + WS_HD); \
    unsigned char* wl = ws + WS_W + (size_t)l_ * W_LAYER; const float* ng = args.in[1] + (size_t)l_ * 6 * DM; (void)xres; (void)U; (void)HB; (void)HD; (void)wl; (void)ng
    unsigned char* ws0 = args.ws;
    volatile LAS unsigned* MISC = (volatile LAS unsigned*)(L + MISC_OFF);
    if (threadIdx.x < 16) MISC[threadIdx.x] = 0u;
    __syncthreads();
    XcdBarrier bar; bar.bar = (unsigned*)(ws0 + WS_CTL) + CW_BAR; bar.x = 0; bar.st = nullptr;
    if (!MK_MULTI) bar = xcd_barrier_post((unsigned*)(ws0 + WS_CTL) + CW_BAR, MISC + 8);
    const int lo = args.ph_lo, hi = args.ph_hi;
#define IN(k) (lo <= (k) && (k) < hi)
#define SEAM(k) do { if (IN(k) && IN((k) + 1)) xcd_barrier(bar); } while (0)

    if (IN(0)) {
        const int l_ = 0; PH_IDS();
        const float* x_in = args.in[0]; float* cosT = (float*)(ws + WS_TAB + TAB_COS); float* sinT = (float*)(ws + WS_TAB + TAB_SIN); float* b1T = (float*)(ws + WS_TAB + TAB_B1);
        LAS float* scr = (LAS float*)(L + wave * 16384);
        constexpr int I_GU = 16 * 176, I_DN = 44 * 32, I_IN = 16 * 112, I_OUT = 16 * 32, I_CMP = 16 * 16, I_LAYER = 2 * I_GU + 2 * I_DN + I_IN + I_OUT + I_CMP;
        for (int it = gw; it < DEPTH * I_LAYER; it += NGW) {
            const int l = it / I_LAYER; int r = it % I_LAYER; unsigned char* wl = ws + WS_W + (size_t)l * W_LAYER;
            if (r < I_GU) { SrcGU s{args.in[2] + (size_t)l * DM * NGU}; transpose_item(s, DM, (bf16*)(wl + WO_GU1), scr, r / 176, r % 176, lane); continue; } r -= I_GU;
            if (r < I_DN) { SrcPlain s{args.in[3] + (size_t)l * FF * DM, DM}; transpose_item(s, FF, (bf16*)(wl + WO_DN1), scr, r / 32, r % 32, lane); continue; } r -= I_DN;
            if (r < I_GU) { SrcGU s{args.in[4] + (size_t)l * DM * NGU}; transpose_item(s, DM, (bf16*)(wl + WO_GU2), scr, r / 176, r % 176, lane); continue; } r -= I_GU;
            if (r < I_DN) { SrcPlain s{args.in[5] + (size_t)l * FF * DM, DM}; transpose_item(s, FF, (bf16*)(wl + WO_DN2), scr, r / 32, r % 32, lane); continue; } r -= I_DN;
            if (r < I_IN) { SrcIN s{args.in[6] + (size_t)l * DM * INCOLS}; transpose_item(s, DM, (bf16*)(wl + WO_IN), scr, r / 112, r % 112, lane); continue; } r -= I_IN;
            if (r < I_OUT) { SrcPlain s{args.in[7] + (size_t)l * DM * DM, DM}; transpose_item(s, DM, (bf16*)(wl + WO_OUT), scr, r / 32, r % 32, lane); continue; } r -= I_OUT;
            { SrcCMP s{args.in[9] + (size_t)l * 2 * 2048 * 128}; transpose_item(s, DM, (bf16*)(wl + WO_CMP), scr, r / 16, r % 16, lane); }
        }
        for (int i = blk * 512 + tid; i < SEQ * 8; i += G * 512) { const int pos = i >> 3, k = i & 7;
            const double inv = pow(500000.0, -(double)k / 8.0), ang = (double)pos * inv; cosT[i] = (float)cos(ang); sinT[i] = (float)sin(ang); }
        for (int o = gw; o < DEPTH * 2 * 128; o += NGW) { const int lk = o >> 7, c = o & 127; const float* pe = args.in[8] + (size_t)lk * 2048; const float* w1 = args.in[9] + (size_t)lk * 2048 * 128;
            float s = 0.f; for (int r = lane; r < 2048; r += 64) s += pe[r] * w1[(size_t)r * 128 + c];
            s = wave_sum(s); if (lane == 0) b1T[o] = s; }
        thin_phase<0>(nullptr, x_in, xres, nullptr, 0.f, args.in[1] + 0 * DM, U, gw, NGW, lane);
    }
    SEAM(0);

#pragma unroll 1
    for (int l = 0; l < DEPTH; ++l) {
        const int pb = 1 + l * PH_PER_LAYER, l_ = l;
        if (IN(pb + 0)) { PH_WS(); pg8::Gemm g{U, (const bf16*)(wl + WO_GU1), MTOK, NGU, DM}; pg8::StaticOrder S; S.init(MTOK, NGU, G, blk); EpiSwiglu E{HB};
            pg8::gemm_phase<EpiSwiglu, pg8::StaticOrder, true, true>(L, g, S, E); }
        SEAM(pb + 0);
        if (IN(pb + 1)) { PH_WS(); pg8::Gemm g{HB, (const bf16*)(wl + WO_DN1), MTOK, DM, FF}; pg8::StaticOrder S; S.init(MTOK, DM, G, blk); pg8::EpiBf16<0> E{HD, DM, nullptr, 0, 0, 1.f};
            pg8::gemm_phase<pg8::EpiBf16<0>, pg8::StaticOrder, true, true>(L, g, S, E); }
        SEAM(pb + 1);
        if (IN(pb + 2)) { PH_IDS(); thin_phase<1>(HD, xres, xres, ng + 1 * DM, 0.5f, ng + 2 * DM, U, gw, NGW, lane); }
        SEAM(pb + 2);
        if (IN(pb + 3)) { PH_WS(); pg8::Gemm g{U, (const bf16*)(wl + WO_IN), MTOK, NINP, DM}; pg8::StaticOrder S; S.init(MTOK, NINP, G, blk);
            EpiInProj E{ws};
            pg8::gemm_phase<EpiInProj, pg8::StaticOrder, true, true>(L, g, S, E); }
        SEAM(pb + 3);
        if (IN(pb + 4)) { PH_WS(); pg8::Gemm g{(const bf16*)(ws + WS_KCR), (const bf16*)(wl + WO_CMP), 8192, 512, DM}; CmpOrder S{blk, G}; EpiPQ E{(float*)(ws + WS_PQ)};
            pg8::gemm_phase<EpiPQ, CmpOrder, false, true>(L, g, S, E); }
        SEAM(pb + 4);
        if (IN(pb + 5)) {
            PH_IDS();
            const float* b1T = (const float*)(ws + WS_TAB + TAB_B1); const float* PQ = (const float*)(ws + WS_PQ); bf16* CC = (bf16*)(ws + WS_CC); LAS float* hs = (LAS float*)(L + wave * 1024);
            for (int r = gw; r < 2 * 32 * 128; r += NGW) {
                const int kv = r >> 12, bgn = r & 4095, n = bgn & 127;
                if (n == 127) { CC[(size_t)r * 64 + lane] = 0; continue; }
                const float* w2 = args.in[10] + (size_t)(l * 2 + kv) * 128 * 64; const float* b1 = b1T + (l * 2 + kv) * 128;
#pragma unroll
                for (int q2 = 0; q2 < 2; ++q2) { const int c = lane + 64 * q2; const float v = PQ[(size_t)r * 256 + c] + PQ[(size_t)(r + 1) * 256 + 128 + c] + b1[c];
                    const float u3 = 0.7978845608028654f * (v + 0.044715f * v * v * v); hs[c] = 0.5f * v * (1.f + tanhf(u3)); }
                LDS_WAIT(); asm volatile("" ::: "memory");
                float o = 0.f;
#pragma unroll 8
                for (int c = 0; c < 128; ++c) o += hs[c] * w2[c * 64 + lane];
                CC[(size_t)r * 64 + lane] = (bf16)f2bf(o);
                LDS_WAIT(); asm volatile("" ::: "memory");
            }
        }
        SEAM(pb + 5);
        if (IN(pb + 6)) {
            PH_WS();
            MixPtrs P{ws, args.in[11] + (size_t)l * 4 * 1024, args.in[12] + (size_t)l * 1024, args.in[13] + l * 4, args.in[14] + l * 4, args.in[15] + l * 512};
            const int nml = (G > 64) ? 64 : 0;
            if (blk < nml) mlstm_unit_simple(L, P, blk >> 2, blk & 3);
            else { for (int u = blk - nml; u < 1024; u += G - nml) { const int c = 31 - (u >> 5), bg = u & 31; nsa_unit_mfma(L, P, bg >> 1, bg & 1, c); } }
            if (nml == 0) { for (int u = blk; u < 64; u += G) mlstm_unit_simple(L, P, u >> 2, u & 3); }
        }
        SEAM(pb + 6);
        if (IN(pb + 7)) { PH_WS(); pg8::Gemm g{U, (const bf16*)(wl + WO_OUT), MTOK, DM, DM}; pg8::StaticOrder S; S.init(MTOK, DM, G, blk); pg8::EpiBf16<0> E{HD, DM, nullptr, 0, 0, 1.f};
            pg8::gemm_phase<pg8::EpiBf16<0>, pg8::StaticOrder, true, true>(L, g, S, E); }
        SEAM(pb + 7);
        if (IN(pb + 8)) { PH_IDS(); thin_phase<1>(HD, xres, xres, ng + 3 * DM, 1.0f, ng + 4 * DM, U, gw, NGW, lane); }
        SEAM(pb + 8);
        if (IN(pb + 9)) { PH_WS(); pg8::Gemm g{U, (const bf16*)(wl + WO_GU2), MTOK, NGU, DM}; pg8::StaticOrder S; S.init(MTOK, NGU, G, blk); EpiSwiglu E{HB};
            pg8::gemm_phase<EpiSwiglu, pg8::StaticOrder, true, true>(L, g, S, E); }
        SEAM(pb + 9);
        if (IN(pb + 10)) { PH_WS(); pg8::Gemm g{HB, (const bf16*)(wl + WO_DN2), MTOK, DM, FF}; pg8::StaticOrder S; S.init(MTOK, DM, G, blk); pg8::EpiBf16<0> E{HD, DM, nullptr, 0, 0, 1.f};
            pg8::gemm_phase<pg8::EpiBf16<0>, pg8::StaticOrder, true, true>(L, g, S, E); }
        SEAM(pb + 10);
        if (IN(pb + 11)) { PH_IDS(); if (l + 1 < DEPTH) thin_phase<1>(HD, xres, xres, ng + 5 * DM, 0.5f, ng + 6 * DM, U, gw, NGW, lane);
                           else thin_phase<2>(HD, xres, xres, ng + 5 * DM, 0.5f, nullptr, nullptr, gw, NGW, lane); }
        if (l + 1 < DEPTH) SEAM(pb + 11);
    }
#undef IN
#undef SEAM
#undef PH_IDS
#undef PH_WS
}

extern "C" void kernel_launch(void* const* d_in, const int* in_sizes, int n_in, void* d_out, int out_size, void* d_ws, size_t ws_size, hipStream_t stream) {
    static int grid = 0;
    if (grid == 0) {
        if (n_in != 16 || in_sizes[0] != MTOK * DM || out_size != MTOK * DM || ws_size < WS_END) { fprintf(stderr, "kernel_launch: unexpected problem (n_in %d, ws %zu)\n", n_in, ws_size); grid = -1; return; }
        int dev = 0, cus = 0, per_cu = 0;
        if (hipGetDevice(&dev) != hipSuccess || hipDeviceGetAttribute(&cus, hipDeviceAttributeMultiprocessorCount, dev) != hipSuccess) { grid = -1; return; }
        if (hipFuncSetAttribute((const void*)fwd_kernel, hipFuncAttributeMaxDynamicSharedMemorySize, LDS_BYTES) != hipSuccess) { grid = -1; return; }
        if (hipOccupancyMaxActiveBlocksPerMultiprocessor(&per_cu, (const void*)fwd_kernel, NWAVES * 64, LDS_BYTES) != hipSuccess || per_cu < 1) { fprintf(stderr, "kernel_launch: occupancy query says %d\n", per_cu); }
        (void)hipGetLastError();
        grid = cus;
    }
    if (grid < 0) return;
    (void)hipMemsetAsync((char*)d_ws + WS_CTL, 0, CTL_ZERO_BYTES, stream);
    Args a{};
    for (int i = 0; i < 16; ++i) a.in[i] = (const float*)d_in[i];
    a.out = (float*)d_out; a.ws = (unsigned char*)d_ws;
#if MK_MULTI
    for (int p = 0; p < N_PHASES; ++p) { a.ph_lo = p; a.ph_hi = p + 1; hipLaunchKernelGGL(fwd_kernel, dim3(grid), dim3(NWAVES * 64), LDS_BYTES, stream, a); }
#else
    a.ph_lo = 0; a.ph_hi = N_PHASES; hipLaunchKernelGGL(fwd_kernel, dim3(grid), dim3(NWAVES * 64), LDS_BYTES, stream, a);
#endif
}
```

```cpp
#include <hip/hip_runtime.h>
#include <cstdio>
#include <cstdint>
namespace pg8 {
#define PG8_LAS __attribute__((address_space(3)))
typedef unsigned short bf16_t;
typedef short bf16x8 __attribute__((ext_vector_type(8)));
typedef float f32x4 __attribute__((ext_vector_type(4)));
typedef unsigned u32x4 __attribute__((ext_vector_type(4)));
constexpr int BM = 256, BK = 64, HALF = 128, HTB = HALF * BK * 2  , STAGE_BYTES = 8 * HTB, NXCD = 8, WGM = 8;

__host__ __device__ __forceinline__ int lds_byte(int r, int c) { const int st = (r >> 4) * 2 + (c >> 5), rr = r & 15, cc = c & 31, ob = rr * 64 + cc * 2; return st * 1024 + (ob ^ (((ob >> 9) & 1) << 5)); }
__host__ __device__ __forceinline__ void stage_rc(int b, int& R, int& C) { const int st = b / 1024, sb = b % 1024, swz = sb ^ (((sb >> 9) & 1) << 5); R = (st >> 1) * 16 + swz / 64; C = (st & 1) * 32 + (swz % 64) / 2; }
__host__ __device__ __forceinline__ int perm32(int rho) { const int n = rho >> 4, i = rho & 15; return 8 * (i >> 2) + 4 * n + (i & 3); }

struct Unit { int pm, pn; };
struct Gemm { const bf16_t* A; const bf16_t* Bt; int M, N, K; };

struct StaticOrder {
    int nM, nN, nwg, G, c;
    __host__ __device__ void init(int M, int N, int G_, int c_) { nM = M / BM; nN = N / BM; nwg = nM * nN; G = G_; c = c_; }
    __host__ __device__ bool next(int i, Unit& u) const {
        const long L = (long)i * G + c; if (L >= nwg) return false;
        int wgid = (int)L; { const int q = nwg / NXCD, r = nwg % NXCD, xcd = wgid % NXCD, off = wgid / NXCD; wgid = (xcd < r ? xcd * (q + 1) : r * (q + 1) + (xcd - r) * q) + off; }
        const int nig = WGM * nN, gid = wgid / nig, fm = gid * WGM, gsz = (nM - fm) < WGM ? (nM - fm) : WGM;
        u.pm = fm + ((wgid % nig) % gsz); u.pn = (wgid % nig) / gsz; return true;
    }
    __device__ __forceinline__ void a_ready(const Unit&) const {}
    __device__ __forceinline__ void done(const Unit&) const {}
};

__device__ __forceinline__ unsigned cvt_pk_bf16(float lo, float hi) { unsigned r; asm volatile("v_cvt_pk_bf16_f32 %0, %1, %2" : "=v"(r) : "v"(lo), "v"(hi)); return r; }
typedef float f32x2 __attribute__((ext_vector_type(2)));
__device__ __forceinline__ f32x2 gelu_pk(f32x2 v) {
    const f32x2 av = __builtin_elementwise_abs(v), d = av * 0.2316418882f + 1.0f;
    f32x2 t; t.x = __builtin_amdgcn_rcpf(d.x); t.y = __builtin_amdgcn_rcpf(d.y);
    f32x2 q = t * 0.5307027145f + (-0.7265760135f); q = q * t + 0.7107068705f; q = q * t + (-0.142248368f); q = q * t + 0.127414796f; q = q * t;
    const f32x2 s = (v * v) * (-0.72134752044f);
    f32x2 e; e.x = __builtin_amdgcn_exp2f(s.x); e.y = __builtin_amdgcn_exp2f(s.y);
    const f32x2 m = v * (q * e), r = v - m;
    f32x2 o; o.x = v.x < 0.f ? m.x : r.x; o.y = v.y < 0.f ? m.y : r.y; return o;
}

template <int ACT  > struct EpiBf16 {
    static constexpr bool PERM = true, AFTER_DRAIN = false; static_assert(ACT == 0 || ACT == 1, "EpiBf16: ACT is 0 (none) or 1 (gelu_pk)");
    bf16_t* O; int ldc; const float* bias; int split_cols; size_t split_stride; float scale0;
    __device__ __forceinline__ void operator()(const f32x4 (&acc)[2][2][4][2], const Unit& u, int wr, int wc, int fr, int fq) const {
        const int row0 = u.pm * BM + wr * 64 + fr; int colt = u.pn * BM; bf16_t* base = O;
        float sc = 1.f; if (split_cols) { const int t = colt / split_cols; base += (size_t)t * split_stride; colt -= t * split_cols; if (t == 0) sc = scale0; }
        const int col0 = colt + wc * 32 + 8 * fq, bcol0 = u.pn * BM + wc * 32 + 8 * fq;
        f32x4 bv[2][2];
#pragma unroll
        for (int bj = 0; bj < 2; ++bj)
#pragma unroll
            for (int n = 0; n < 2; ++n) bv[bj][n] = bias ? *(const f32x4*)(bias + bcol0 + bj * HALF + 4 * n) : (f32x4){0.f, 0.f, 0.f, 0.f};
#pragma unroll
        for (int ai = 0; ai < 2; ++ai)
#pragma unroll
            for (int m = 0; m < 4; ++m) { bf16_t* rowp = base + (size_t)(row0 + ai * HALF + m * 16) * ldc + col0;
#pragma unroll
                for (int bj = 0; bj < 2; ++bj) { f32x4 v0 = acc[ai][bj][m][0] + bv[bj][0], v1 = acc[ai][bj][m][1] + bv[bj][1];
                    if (ACT == 1) { f32x2 a = gelu_pk((f32x2){v0[0], v0[1]}), b = gelu_pk((f32x2){v0[2], v0[3]}), c = gelu_pk((f32x2){v1[0], v1[1]}), d = gelu_pk((f32x2){v1[2], v1[3]});
                        v0 = (f32x4){a.x, a.y, b.x, b.y}; v1 = (f32x4){c.x, c.y, d.x, d.y}; }
                    v0 = v0 * sc; v1 = v1 * sc; u32x4 w; w.x = cvt_pk_bf16(v0[0], v0[1]); w.y = cvt_pk_bf16(v0[2], v0[3]); w.z = cvt_pk_bf16(v1[0], v1[1]); w.w = cvt_pk_bf16(v1[2], v1[3]);
                    *(u32x4*)(rowp + bj * HALF) = w; } }
    }
};
template <class Epi, class Sched, bool ALIGN_EPI = false, bool SP2 = false>
__device__ __forceinline__ void gemm_phase(PG8_LAS unsigned char* lds, const Gemm g, const Sched& S, const Epi& E) {
    int tid_l = threadIdx.x; asm volatile("" : "+v"(tid_l));
    const int tid = tid_l, wid = __builtin_amdgcn_readfirstlane(tid >> 6), lane = tid & 63, wr = wid >> 2, wc = wid & 3, fr = lane & 15, fq = lane >> 4;
    const int K = g.K, nt = K / BK;
    unsigned voffA[2], voffB[2];
#pragma unroll
    for (int i = 0; i < 2; ++i) { int R, C; stage_rc(tid * 16 + i * 8192, R, C); const int Rb = Epi::PERM ? ((R & ~31) + perm32(R & 31)) : R;
        voffA[i] = (unsigned)(R * K + C) * 2u; voffB[i] = (unsigned)(Rb * K + C) * 2u; }
    const size_t kstep = (size_t)(BK * 2);
    const size_t hstep = (size_t)HALF * K * 2;
    const size_t tstep = 2 * hstep;
    const unsigned ldsw = (unsigned)wid * 1024u;
    const int aoff = lds_byte(wr * 64 + fr, fq * 8), boff = lds_byte(wc * 32 + fr, fq * 8);
#define PG8_SA(b, h) (((b) * 2 + (h)) * HTB)
#define PG8_SB(b, h) ((4 + (b) * 2 + (h)) * HTB)
#define PG8_STAGE(bufoff, gbase, voff) do { _Pragma("unroll") for (int _i = 0; _i < 2; ++_i) \
        __builtin_amdgcn_global_load_lds((const unsigned*)((const char*)(gbase) + (voff)[_i]), (PG8_LAS unsigned*)(lds + (bufoff) + ldsw + _i * 8192), 16, 0, 0); } while (0)
#define PG8_LDA(dst, b, h) do { _Pragma("unroll") for (int m = 0; m < 4; ++m) _Pragma("unroll") for (int k = 0; k < 2; ++k) dst[m][k] = *(const PG8_LAS bf16x8*)(lds + PG8_SA(b, h) + aoff + m * 2048 + k * 1024); } while (0)
#define PG8_LDB(dst, b, h) do { _Pragma("unroll") for (int n = 0; n < 2; ++n) _Pragma("unroll") for (int k = 0; k < 2; ++k) dst[n][k] = *(const PG8_LAS bf16x8*)(lds + PG8_SB(b, h) + boff + n * 2048 + k * 1024); } while (0)
#define PG8_MMA(ai, bj, At, Bt) do { __builtin_amdgcn_s_setprio(1); _Pragma("unroll") for (int m = 0; m < 4; ++m) _Pragma("unroll") for (int n = 0; n < 2; ++n) _Pragma("unroll") for (int k = 0; k < 2; ++k) \
        acc[ai][bj][m][n] = __builtin_amdgcn_mfma_f32_16x16x32_bf16(Bt[n][k], At[m][k], acc[ai][bj][m][n], 0, 0, 0); __builtin_amdgcn_s_setprio(0); } while (0)
#define PG8_WAIT_V(n) asm volatile("s_waitcnt vmcnt(" #n ")" ::: "memory")
#define PG8_WAIT_L(n) asm volatile("s_waitcnt lgkmcnt(" #n ")" ::: "memory")
#define PG8_BAR __builtin_amdgcn_s_barrier()
#define PG8_SCHED __builtin_amdgcn_sched_barrier(0)
    Unit cur, nxt; int ui = 0;
    if (!S.next(0, cur)) return;
    f32x4 acc[2][2][4][2];
#pragma unroll
    for (int a = 0; a < 2; ++a)
#pragma unroll
        for (int b = 0; b < 2; ++b)
#pragma unroll
            for (int m = 0; m < 4; ++m)
#pragma unroll
                for (int n = 0; n < 2; ++n) acc[a][b][m][n] = (f32x4){0.f, 0.f, 0.f, 0.f};
    bf16x8 At[4][2], B0[2][2], B1[2][2];
    const char* cA = (const char*)g.A + (size_t)cur.pm * tstep; const char* cB = (const char*)g.Bt + (size_t)cur.pn * tstep;
    S.a_ready(cur);
    if constexpr (SP2) {
        PG8_STAGE(PG8_SB(0, 0), cB, voffB); PG8_STAGE(PG8_SB(0, 1), cB + hstep, voffB); PG8_STAGE(PG8_SA(0, 0), cA, voffA); PG8_STAGE(PG8_SA(0, 1), cA + hstep, voffA);
        if (wr == 1) PG8_BAR;
        PG8_WAIT_V(2); PG8_BAR;
        PG8_STAGE(PG8_SB(1, 0), cB + kstep, voffB); PG8_STAGE(PG8_SA(1, 0), cA + kstep, voffA); PG8_STAGE(PG8_SB(1, 1), cB + hstep + kstep, voffB);
        PG8_WAIT_V(6); PG8_BAR;
    } else {
        PG8_STAGE(PG8_SB(0, 0), cB, voffB); PG8_STAGE(PG8_SA(0, 0), cA, voffA); PG8_STAGE(PG8_SB(0, 1), cB + hstep, voffB); PG8_STAGE(PG8_SA(0, 1), cA + hstep, voffA);
        if (wr == 1) PG8_BAR;
        PG8_WAIT_V(4); PG8_BAR;
        PG8_STAGE(PG8_SB(1, 0), cB + kstep, voffB); PG8_STAGE(PG8_SA(1, 0), cA + kstep, voffA); PG8_STAGE(PG8_SB(1, 1), cB + hstep + kstep, voffB);
        PG8_WAIT_V(6); PG8_BAR;
    }
    for (;;) {
        const bool has_next = S.next(ui + 1, nxt);
        const char* nA = has_next ? (const char*)g.A + (size_t)nxt.pm * tstep : cA; const char* nB = has_next ? (const char*)g.Bt + (size_t)nxt.pn * tstep : cB;
        for (int t = 0; t < nt; t += 2) {
            const bool last = (t == nt - 2);
            const char* a1 = cA + (size_t)(t + 1) * kstep;
            const char* a2 = last ? nA : cA + (size_t)(t + 2) * kstep; const char* b2 = last ? nB : cB + (size_t)(t + 2) * kstep;
            const char* a3 = a2 + kstep; const char* b3 = b2 + kstep;
            if (last && has_next) S.a_ready(nxt);
            if constexpr (SP2) {
            PG8_LDB(B0, 0, 0); PG8_LDB(B1, 0, 1); PG8_SCHED; PG8_LDA(At, 0, 0); PG8_STAGE(PG8_SA(1, 1), a1 + hstep, voffA);
            PG8_WAIT_V(8); PG8_WAIT_L(0); PG8_BAR; PG8_MMA(0, 0, At, B0); PG8_MMA(0, 1, At, B1); PG8_BAR; PG8_SCHED;
            PG8_LDA(At, 0, 1); PG8_STAGE(PG8_SB(0, 0), b2, voffB); PG8_STAGE(PG8_SB(0, 1), b2 + hstep, voffB); PG8_STAGE(PG8_SA(0, 0), a2, voffA);
            PG8_WAIT_V(8); PG8_WAIT_L(0); PG8_BAR; PG8_MMA(1, 0, At, B0); PG8_MMA(1, 1, At, B1); PG8_BAR; PG8_SCHED;
            PG8_LDB(B0, 1, 0); PG8_LDB(B1, 1, 1); PG8_SCHED; PG8_LDA(At, 1, 0); PG8_STAGE(PG8_SA(0, 1), a2 + hstep, voffA);
            PG8_WAIT_V(8); PG8_WAIT_L(0); PG8_BAR; PG8_MMA(0, 0, At, B0); PG8_MMA(0, 1, At, B1); PG8_BAR; PG8_SCHED;
            PG8_LDA(At, 1, 1); PG8_STAGE(PG8_SB(1, 0), b3, voffB); PG8_STAGE(PG8_SB(1, 1), b3 + hstep, voffB); PG8_STAGE(PG8_SA(1, 0), a3, voffA);
            PG8_WAIT_V(8); PG8_WAIT_L(0); PG8_BAR; PG8_MMA(1, 0, At, B0); PG8_MMA(1, 1, At, B1); PG8_BAR; PG8_SCHED;
            } else {
            PG8_LDB(B0, 0, 0); PG8_SCHED; PG8_LDA(At, 0, 0); PG8_STAGE(PG8_SA(1, 1), a1 + hstep, voffA);
            PG8_WAIT_L(8); PG8_BAR; PG8_WAIT_L(0); PG8_MMA(0, 0, At, B0); PG8_BAR; PG8_SCHED;
            PG8_LDB(B1, 0, 1); PG8_STAGE(PG8_SB(0, 0), b2, voffB);
            PG8_BAR; PG8_WAIT_L(0); PG8_MMA(0, 1, At, B1); PG8_BAR;
            PG8_LDA(At, 0, 1); PG8_STAGE(PG8_SA(0, 0), a2, voffA);
            PG8_BAR; PG8_WAIT_L(0); PG8_MMA(1, 0, At, B0); PG8_BAR; PG8_SCHED;
            PG8_STAGE(PG8_SB(0, 1), b2 + hstep, voffB);
            PG8_WAIT_V(6); PG8_BAR; PG8_MMA(1, 1, At, B1); PG8_BAR;
            PG8_LDB(B0, 1, 0); PG8_SCHED; PG8_LDA(At, 1, 0); PG8_STAGE(PG8_SA(0, 1), a2 + hstep, voffA);
            PG8_WAIT_L(8); PG8_BAR; PG8_WAIT_L(0); PG8_MMA(0, 0, At, B0); PG8_BAR; PG8_SCHED;
            PG8_LDB(B1, 1, 1); PG8_STAGE(PG8_SB(1, 0), b3, voffB);
            PG8_BAR; PG8_WAIT_L(0); PG8_MMA(0, 1, At, B1); PG8_BAR;
            PG8_LDA(At, 1, 1); PG8_STAGE(PG8_SA(1, 0), a3, voffA);
            PG8_BAR; PG8_WAIT_L(0); PG8_MMA(1, 0, At, B0); PG8_BAR; PG8_SCHED;
            PG8_STAGE(PG8_SB(1, 1), b3 + hstep, voffB);
            PG8_WAIT_V(6); PG8_BAR; PG8_MMA(1, 1, At, B1); PG8_BAR;
            }
        }
        if constexpr (ALIGN_EPI) { if (wr == 0) PG8_BAR; }
        if constexpr (!Epi::AFTER_DRAIN) { E(acc, cur, wr, wc, fr, fq); S.done(cur); }
        if (!has_next) break;
#pragma unroll
        for (int a = 0; a < 2; ++a)
#pragma unroll
            for (int b = 0; b < 2; ++b)
#pragma unroll
                for (int m = 0; m < 4; ++m)
#pragma unroll
                    for (int n = 0; n < 2; ++n) acc[a][b][m][n] = (f32x4){0.f, 0.f, 0.f, 0.f};
        cur = nxt; cA = nA; cB = nB; ++ui;
        if constexpr (ALIGN_EPI) { if (wr == 1) PG8_BAR; }
    }
    PG8_WAIT_V(0);
    if constexpr (!ALIGN_EPI) { if (wr == 0) PG8_BAR; }
    PG8_BAR;
    if constexpr (Epi::AFTER_DRAIN) { E.fused(acc, cur, wr, wc, fr, fq, lds, wid, lane); S.done(cur); }
#undef PG8_SA
#undef PG8_SB
#undef PG8_STAGE
#undef PG8_LDA
#undef PG8_LDB
#undef PG8_MMA
#undef PG8_WAIT_V
#undef PG8_WAIT_L
#undef PG8_BAR
#undef PG8_SCHED
}
}

#define LAS __attribute__((address_space(3)))
#define XB_TMO      128
#define XB_XCNT(j)  (256  + 64 * (j))
#define XB_XSUB(j)  (1280 + 64 * (j))
#define XB_XGEN(j)  (2304 + 64 * (j))
#define XB_TOP      3328
#define XB_TOPGEN   3392
#define XCD_BAR_WORDS 3456
#define XB_SPIN_CAP (1u << 18)

__device__ __forceinline__ unsigned xb_ld(unsigned* p)              { return __hip_atomic_load(p, __ATOMIC_RELAXED, __HIP_MEMORY_SCOPE_AGENT); }
__device__ __forceinline__ unsigned xb_add(unsigned* p, unsigned v) { return __hip_atomic_fetch_add(p, v, __ATOMIC_RELAXED, __HIP_MEMORY_SCOPE_AGENT); }
__device__ __forceinline__ unsigned xb_xcc_id() { return (unsigned)__builtin_amdgcn_s_getreg((3 << 11) | 20) & 0xFu; }
#define XB_SPIN(cond, bar) do { unsigned _sp = 0; while (cond) { __builtin_amdgcn_s_sleep(1); \
    if ((++_sp & 255u) == 0u) { if (xb_ld(&(bar)[XB_TMO])) break; if (_sp > XB_SPIN_CAP) { atomicAdd(&(bar)[XB_TMO], 1u); break; } } } } while (0)

struct XcdBarrier {
    unsigned* bar; unsigned x;
    volatile LAS unsigned* st;
};

__device__ __forceinline__ XcdBarrier xcd_barrier_post(unsigned* bar, volatile LAS unsigned* st) {
    XcdBarrier b; b.bar = bar; b.x = xb_xcc_id(); b.st = st;
    if (threadIdx.x == 0) (void)xb_add(&bar[XB_XCNT(b.x)], 1u);
    return b;
}
__device__ __forceinline__ void xcd_barrier_complete(unsigned* bar, unsigned x, unsigned& nloc, unsigned& nx) {
    const unsigned G = gridDim.x * gridDim.y * gridDim.z;
    unsigned sum, cnt, mine, sp = 0u;
    for (;;) {
        sum = 0u; cnt = 0u; mine = 0u;
#pragma unroll
        for (unsigned j = 0; j < 16; ++j) { const unsigned c = xb_ld(&bar[XB_XCNT(j)]); sum += c; cnt += (c > 0u) ? 1u : 0u; mine = (j == x) ? c : mine; }
        if (sum == G) break;
        __builtin_amdgcn_s_sleep(1);
        if ((++sp & 255u) == 0u) { if (xb_ld(&bar[XB_TMO])) break; if (sp > XB_SPIN_CAP) { atomicAdd(&bar[XB_TMO], 1u); break; } }
    }
    nloc = mine > 0u ? mine : 1u; nx = cnt > 0u ? cnt : 1u;
}

__device__ __forceinline__ void xcd_barrier(const XcdBarrier& b) {
    asm volatile("s_waitcnt vmcnt(0)" ::: "memory");
    __syncthreads();
    if (threadIdx.x == 0) {
        unsigned* bar = b.bar;
        __builtin_amdgcn_s_waitcnt(0);
        unsigned nloc = b.st[0], nx = b.st[1];
        if (nloc == 0u) { xcd_barrier_complete(bar, b.x, nloc, nx); b.st[0] = nloc; b.st[1] = nx; }
        const unsigned old = xb_add(&bar[XB_XSUB(b.x)], 1u);
        const unsigned gen = old / nloc;
        if (old + 1u == (gen + 1u) * nloc) {
            __builtin_amdgcn_fence(__ATOMIC_RELEASE, "agent");
            asm volatile("s_waitcnt vmcnt(0)" ::: "memory");
            const unsigned og = xb_add(&bar[XB_TOP], 1u);
            const unsigned tg = og / nx;
            if (og + 1u == (tg + 1u) * nx) xb_add(&bar[XB_TOPGEN], 1u);
            else XB_SPIN(xb_ld(&bar[XB_TOPGEN]) == tg, bar);
            __builtin_amdgcn_fence(__ATOMIC_ACQUIRE, "agent");
            xb_add(&bar[XB_XGEN(b.x)], 1u);
            asm volatile("s_waitcnt vmcnt(0)" ::: "memory");
        } else {
            XB_SPIN(xb_ld(&bar[XB_XGEN(b.x)]) == gen, bar);
            __builtin_amdgcn_fence(__ATOMIC_ACQUIRE, "agent");
            asm volatile("s_waitcnt vmcnt(0)" ::: "memory");
        }
    }
    __syncthreads();
}

constexpr int BATCH = 16, SEQ = 2048, DM = 1024, MTOK = BATCH * SEQ, FF = 2816, NGU = 2 * FF, NINP = 3584, INCOLS = 3360, DEPTH = 2;
constexpr int NWAVES = 8;
constexpr float EPS = 1e-6f;
typedef unsigned short bf16;
typedef unsigned v4u __attribute__((ext_vector_type(4)));
typedef unsigned v2u __attribute__((ext_vector_type(2)));
typedef float f32x4 __attribute__((ext_vector_type(4)));
#define LDS_WAIT() asm volatile("s_waitcnt lgkmcnt(0)" ::: "memory")

constexpr size_t MiB = 1u << 20;
constexpr size_t WS_CTL = 0, CTL_ZERO_BYTES = MiB;
constexpr size_t WS_TAB = 1 * MiB;
constexpr size_t TAB_COS = 0, TAB_SIN = 65536, TAB_B1 = 131072;
constexpr size_t WS_W = 2 * MiB, W_LAYER = 43 * MiB;
constexpr size_t WO_GU1 = 0, WO_DN1 = 11 * MiB, WO_GU2 = 16 * MiB + MiB / 2, WO_DN2 = 27 * MiB + MiB / 2, WO_IN = 33 * MiB, WO_OUT = 40 * MiB, WO_CMP = 42 * MiB;
constexpr size_t WS_U = 88 * MiB;
constexpr size_t WS_HB = 152 * MiB;
constexpr size_t WS_HD = 328 * MiB;
constexpr size_t WS_PQ = 392 * MiB;
constexpr size_t WS_CC = 400 * MiB;
constexpr size_t WS_END = 401 * MiB;
constexpr size_t WS_QN = 152 * MiB, WS_KCR = 184 * MiB, WS_VCR = 192 * MiB, WS_KS = 200 * MiB, WS_VS = 208 * MiB, WS_KW = 216 * MiB, WS_VW = 224 * MiB;
constexpr size_t WS_MQ = 232 * MiB, WS_MK = 264 * MiB, WS_MV = 296 * MiB, WS_MO = 328 * MiB, WS_GATE = 360 * MiB;
static_assert(WS_GATE + 4 * MiB <= WS_PQ, "in-projection outputs end below PQ");
constexpr int CW_BAR = 4096;
constexpr int PH_BYTES = 143360, MISC_OFF = PH_BYTES, LDS_BYTES = 147456;

__device__ __forceinline__ unsigned f2bf(float f) { unsigned u = __builtin_bit_cast(unsigned, f); return (u + 0x7fffu + ((u >> 16) & 1u)) >> 16; }
__device__ __forceinline__ unsigned pk2(float lo, float hi) { return f2bf(lo) | (f2bf(hi) << 16); }
__device__ __forceinline__ float bflo(unsigned u) { return __builtin_bit_cast(float, u << 16); }
__device__ __forceinline__ float bfhi(unsigned u) { return __builtin_bit_cast(float, u & 0xffff0000u); }
__device__ __forceinline__ float bf2f(bf16 b) { return __builtin_bit_cast(float, (unsigned)b << 16); }
__device__ __forceinline__ float sigmoidf_(float x) { return 1.f / (1.f + __expf(-x)); }
__device__ __forceinline__ float wave_sum(float v) {
#pragma unroll
    for (int o = 1; o < 64; o <<= 1) v += __shfl_xor(v, o);
    return v;
}

struct SrcGU { const float* W; __device__ __forceinline__ float operator()(int k, int nd) const { const int pn = nd >> 8, r = nd & 255; const int col = (r < 128) ? (pn * 128 + r) : (FF + pn * 128 + r - 128); return W[(size_t)k * NGU + col]; } };
struct SrcPlain { const float* W; int N; __device__ __forceinline__ float operator()(int k, int nd) const { return W[(size_t)k * N + nd]; } };
struct SrcIN { const float* W; __device__ __forceinline__ float operator()(int k, int nd) const {
    const int col = nd < 1280 ? nd : (nd < 3328 ? nd + 24 : (nd < 3352 ? nd - 3328 + 1280 : (nd < 3360 ? nd : -1)));
    return col < 0 ? 0.f : W[(size_t)k * INCOLS + col]; } };
struct SrcCMP { const float* W1; __device__ __forceinline__ float operator()(int k, int nd) const { const int kv = nd >> 8, r = nd & 255;
    return r < 128 ? W1[((size_t)kv * 2048 + k) * 128 + r] : W1[((size_t)kv * 2048 + 1024 + k) * 128 + r - 128]; } };

template <class SrcF>
__device__ __forceinline__ void transpose_item(const SrcF& src, int K, bf16* WT, LAS float* scr, int kb, int nb, int lane) {
    const int k0 = 64 * kb, n0 = 32 * nb;
#pragma unroll 8
    for (int i = 0; i < 32; ++i) { const int kk = 2 * i + (lane >> 5); scr[kk * 33 + (lane & 31)] = src(k0 + kk, n0 + (lane & 31)); }
    LDS_WAIT(); asm volatile("" ::: "memory");
    const int c = lane & 7;
#pragma unroll
    for (int j = 0; j < 4; ++j) { const int n = (lane >> 3) + 8 * j; const LAS float* s = scr + (8 * c) * 33 + n;
        v4u o; o.x = pk2(s[0 * 33], s[1 * 33]); o.y = pk2(s[2 * 33], s[3 * 33]); o.z = pk2(s[4 * 33], s[5 * 33]); o.w = pk2(s[6 * 33], s[7 * 33]);
        *(v4u*)(WT + (size_t)(n0 + n) * K + k0 + 8 * c) = o; }
    LDS_WAIT(); asm volatile("" ::: "memory");
}

template <int MODE>
__device__ __forceinline__ void thin_phase(const bf16* HD, const float* xin, float* xout, const float* gpost, float cc, const float* gpre, bf16* U, int gw, int NGW, int lane) {
    f32x4 gp[4], gq[4];
#pragma unroll
    for (int j = 0; j < 4; ++j) { gp[j] = (MODE != 0) ? *(const f32x4*)(gpost + 4 * lane + 256 * j) : (f32x4){0.f, 0.f, 0.f, 0.f};
                                  gq[j] = (MODE != 2) ? *(const f32x4*)(gpre + 4 * lane + 256 * j) : (f32x4){0.f, 0.f, 0.f, 0.f}; }
    for (int m = gw; m < MTOK; m += NGW) {
        f32x4 x[4];
#pragma unroll
        for (int j = 0; j < 4; ++j) x[j] = *(const f32x4*)(xin + (size_t)m * DM + 4 * lane + 256 * j);
        if (MODE != 0) {
            f32x4 h[4]; float ss = 0.f;
#pragma unroll
            for (int j = 0; j < 4; ++j) { const v2u w = *(const v2u*)(HD + (size_t)m * DM + 4 * lane + 256 * j);
                h[j] = (f32x4){bflo(w.x), bfhi(w.x), bflo(w.y), bfhi(w.y)}; ss += (h[j].x * h[j].x + h[j].y * h[j].y) + (h[j].z * h[j].z + h[j].w * h[j].w); }
            const float r = cc * __frsqrt_rn(wave_sum(ss) * (1.f / DM) + EPS);
#pragma unroll
            for (int j = 0; j < 4; ++j) x[j] = x[j] + (h[j] * r) * gp[j];
        }
#pragma unroll
        for (int j = 0; j < 4; ++j) *(f32x4*)(xout + (size_t)m * DM + 4 * lane + 256 * j) = x[j];
        if (MODE != 2) {
            float s2 = 0.f;
#pragma unroll
            for (int j = 0; j < 4; ++j) s2 += (x[j].x * x[j].x + x[j].y * x[j].y) + (x[j].z * x[j].z + x[j].w * x[j].w);
            const float r2 = __frsqrt_rn(wave_sum(s2) * (1.f / DM) + EPS);
#pragma unroll
            for (int j = 0; j < 4; ++j) { const f32x4 y = (x[j] * r2) * gq[j]; v2u w; w.x = pk2(y.x, y.y); w.y = pk2(y.z, y.w);
                *(v2u*)(U + (size_t)m * DM + 4 * lane + 256 * j) = w; }
        }
    }
}

struct EpiSwiglu {
    static constexpr bool PERM = true, AFTER_DRAIN = false;
    bf16* H;
    __device__ __forceinline__ void operator()(const pg8::f32x4 (&acc)[2][2][4][2], const pg8::Unit& u, int wr, int wc, int fr, int fq) const {
#pragma unroll
        for (int ai = 0; ai < 2; ++ai)
#pragma unroll
            for (int m = 0; m < 4; ++m) {
                const int row = u.pm * 256 + ai * 128 + wr * 64 + m * 16 + fr;
                float o[8];
#pragma unroll
                for (int n = 0; n < 2; ++n)
#pragma unroll
                    for (int e = 0; e < 4; ++e) { const float g = acc[ai][0][m][n][e], up = acc[ai][1][m][n][e]; o[n * 4 + e] = g * up / (1.f + __expf(-g)); }
                v4u w; w.x = pg8::cvt_pk_bf16(o[0], o[1]); w.y = pg8::cvt_pk_bf16(o[2], o[3]); w.z = pg8::cvt_pk_bf16(o[4], o[5]); w.w = pg8::cvt_pk_bf16(o[6], o[7]);
                *(v4u*)(H + (size_t)row * FF + u.pn * 128 + wc * 32 + fq * 8) = w;
            }
    }
};
struct EpiPQ {
    static constexpr bool PERM = true, AFTER_DRAIN = false;
    float* O;
    __device__ __forceinline__ void operator()(const pg8::f32x4 (&acc)[2][2][4][2], const pg8::Unit& u, int wr, int wc, int fr, int fq) const {
#pragma unroll
        for (int ai = 0; ai < 2; ++ai)
#pragma unroll
            for (int m = 0; m < 4; ++m) {
                const int row = u.pm * 256 + ai * 128 + wr * 64 + m * 16 + fr;
#pragma unroll
                for (int bj = 0; bj < 2; ++bj) { float* p = O + (size_t)row * 256 + bj * 128 + wc * 32 + fq * 8;
                    *(pg8::f32x4*)p = acc[ai][bj][m][0]; *(pg8::f32x4*)(p + 4) = acc[ai][bj][m][1]; }
            }
    }
};
struct CmpOrder {
    int c, G;
    __device__ __forceinline__ bool next(int i, pg8::Unit& u) const { const int idx = i * G + c; if (idx >= 32) return false; u.pm = idx; u.pn = idx >> 4; return true; }
    __device__ __forceinline__ void a_ready(const pg8::Unit&) const {}
    __device__ __forceinline__ void done(const pg8::Unit&) const {}
};
struct EpiInProj {
    static constexpr bool PERM = true, AFTER_DRAIN = false;
    unsigned char* ws;
    __device__ __forceinline__ void operator()(const pg8::f32x4 (&acc)[2][2][4][2], const pg8::Unit& u, int wr, int wc, int fr, int fq) const {
        const int pn = u.pn;
        const float* cosT = (const float*)(ws + WS_TAB + TAB_COS); const float* sinT = (const float*)(ws + WS_TAB + TAB_SIN);
        const bool ropet = (pn < 2) || (pn == 3) || (pn == 4);
        const bool ropew = ropet && ((wc & 1) == 0);
#pragma unroll
        for (int ai = 0; ai < 2; ++ai)
#pragma unroll
            for (int m = 0; m < 4; ++m) {
                const int row = u.pm * 256 + ai * 128 + wr * 64 + m * 16 + fr;
                const int b = row >> 11, t = row & 2047;
                f32x4 c0, c1, s0, s1;
                if (ropew) { c0 = *(const f32x4*)(cosT + t * 8); c1 = *(const f32x4*)(cosT + t * 8 + 4); s0 = *(const f32x4*)(sinT + t * 8); s1 = *(const f32x4*)(sinT + t * 8 + 4); }
#pragma unroll
                for (int bj = 0; bj < 2; ++bj) {
                    f32x4 v0 = acc[ai][bj][m][0], v1 = acc[ai][bj][m][1];
                    const int cl = bj * 128 + wc * 32 + fq * 8;
                    if (ropew && (pn < 2 || bj == 0)) {
                        f32x4 p0, p1;
                        p0.x = __shfl_xor(v0.x, 16); p0.y = __shfl_xor(v0.y, 16); p0.z = __shfl_xor(v0.z, 16); p0.w = __shfl_xor(v0.w, 16);
                        p1.x = __shfl_xor(v1.x, 16); p1.y = __shfl_xor(v1.y, 16); p1.z = __shfl_xor(v1.z, 16); p1.w = __shfl_xor(v1.w, 16);
                        const float sg = (fq == 0) ? -1.f : 1.f;
                        if (fq < 2) { v0 = v0 * c0 + (p0 * s0) * sg; v1 = v1 * c1 + (p1 * s1) * sg; }
                    }
                    if (pn == 13) { if (cl < 32) { float* p = (float*)(ws + WS_GATE) + (size_t)row * 32 + cl; *(f32x4*)p = v0; *(f32x4*)(p + 4) = v1; } }
                    else {
                        size_t off;
                        if (pn < 2) off = WS_QN + ((size_t)row * 512 + pn * 256 + cl) * 2;
                        else if (pn < 5) { const int g = wc >> 1, d = (wc & 1) * 32 + fq * 8; off = WS_KCR + (size_t)((pn - 2) * 2 + bj) * (8 * MiB) + (((size_t)(b * 2 + g) * SEQ + t) * 64 + d) * 2; }
                        else { const int q = pn - 5; off = WS_MQ + (size_t)(q >> 1) * (32 * MiB) + ((size_t)row * 512 + (q & 1) * 256 + cl) * 2; }
                        v4u w; w.x = pg8::cvt_pk_bf16(v0.x, v0.y); w.y = pg8::cvt_pk_bf16(v0.z, v0.w); w.z = pg8::cvt_pk_bf16(v1.x, v1.y); w.w = pg8::cvt_pk_bf16(v1.z, v1.w);
                        *(v4u*)(ws + off) = w;
                    }
                }
            }
    }
};
static_assert(WS_VCR == WS_KCR + 8 * MiB && WS_KS == WS_KCR + 16 * MiB && WS_VS == WS_KCR + 24 * MiB && WS_KW == WS_KCR + 32 * MiB && WS_VW == WS_KCR + 40 * MiB, "kv buffers are 8 MiB apart in (pn, bj) order");
static_assert(WS_MK == WS_MQ + 32 * MiB && WS_MV == WS_MQ + 64 * MiB && WS_MO == WS_MQ + 96 * MiB, "mLSTM buffers are 32 MiB apart");

__device__ __forceinline__ float dot64(const float (&q)[64], const LAS unsigned char* krow) {
    float s0 = 0.f, s1 = 0.f;
#pragma unroll
    for (int c8 = 0; c8 < 8; ++c8) { const v4u kk = *(const LAS v4u*)(krow + c8 * 16);
        s0 += q[c8 * 8 + 0] * bflo(kk.x) + q[c8 * 8 + 2] * bflo(kk.y) + q[c8 * 8 + 4] * bflo(kk.z) + q[c8 * 8 + 6] * bflo(kk.w);
        s1 += q[c8 * 8 + 1] * bfhi(kk.x) + q[c8 * 8 + 3] * bfhi(kk.y) + q[c8 * 8 + 5] * bfhi(kk.z) + q[c8 * 8 + 7] * bfhi(kk.w); }
    return s0 + s1;
}
__device__ __forceinline__ unsigned long long bits_upto(int hi) { return hi < 0 ? 0ull : (hi >= 63 ? ~0ull : ((2ull << hi) - 1ull)); }

struct MixPtrs { unsigned char* ws; const float *conv_w, *conv_b, *i_bias, *f_bias, *mnorm_g; };
#define MP_QN ((const bf16*)(P.ws + WS_QN))
#define MP_KS ((const bf16*)(P.ws + WS_KS))
#define MP_VS ((const bf16*)(P.ws + WS_VS))
#define MP_KW ((const bf16*)(P.ws + WS_KW))
#define MP_VW ((const bf16*)(P.ws + WS_VW))
#define MP_KC ((const bf16*)(P.ws + WS_CC))
#define MP_VC ((const bf16*)(P.ws + WS_CC) + (size_t)4096 * 64)
#define MP_MQ ((const bf16*)(P.ws + WS_MQ))
#define MP_MK ((const bf16*)(P.ws + WS_MK))
#define MP_MV ((const bf16*)(P.ws + WS_MV))
#define MP_MO ((const bf16*)(P.ws + WS_MO))
#define MP_GATE ((const float*)(P.ws + WS_GATE))
#define MP_Y ((bf16*)(P.ws + WS_U))

constexpr int NS_KT = 0, NS_VT = 8192, NS_IMP = 16384, NS_IMS = 50176, NS_SEL = 58624, NS_OUT = 59136;
__device__ __forceinline__ void nsa_unit_simple(LAS unsigned char* L, const MixPtrs& P, int b, int g, int c) {
    int tid_l = threadIdx.x; asm volatile("" : "+v"(tid_l));
    const int tid = tid_l, lane = tid & 63, w = __builtin_amdgcn_readfirstlane(tid >> 6);
    const bool act = w < 4; const int h = w & 3, t = c * 64 + lane; const size_t row = (size_t)b * SEQ + t;
    LAS float* OUT = (LAS float*)(L + NS_OUT) + tid * 65;
    LAS unsigned* SEL = (LAS unsigned*)(L + NS_SEL);
    float q[64];
    if (act) {
        const bf16* qp = MP_QN + row * 512 + (g * 4 + h) * 64;
#pragma unroll
        for (int c8 = 0; c8 < 8; ++c8) { const v4u v = *(const v4u*)(qp + c8 * 8);
            q[c8 * 8 + 0] = bflo(v.x) * 0.125f; q[c8 * 8 + 1] = bfhi(v.x) * 0.125f; q[c8 * 8 + 2] = bflo(v.y) * 0.125f; q[c8 * 8 + 3] = bfhi(v.y) * 0.125f;
            q[c8 * 8 + 4] = bflo(v.z) * 0.125f; q[c8 * 8 + 5] = bfhi(v.z) * 0.125f; q[c8 * 8 + 6] = bflo(v.w) * 0.125f; q[c8 * 8 + 7] = bfhi(v.w) * 0.125f; }
#pragma unroll
        for (int d = 0; d < 64; ++d) OUT[d] = 0.f;
    } else {
#pragma unroll
        for (int d = 0; d < 64; ++d) q[d] = 0.f;
    }
    const size_t kvbase = (size_t)(b * 2 + g) * SEQ * 64, ccbase = (size_t)(b * 2 + g) * 128 * 64;
    const int nlim = (t >= 31) ? (((t - 31) >> 4) < 126 ? ((t - 31) >> 4) : 126) : -1;
    unsigned un = 0u, mysel = 0u;
#pragma unroll 1
    for (int br = 0; br < 3; ++br) {
        float o[64], mx = -1e30f, l = 0.f;
#pragma unroll
        for (int d = 0; d < 64; ++d) o[d] = 0.f;
        int j0, j1; const bf16 *Kp, *Vp;
        if (br == 0) { j0 = 0; j1 = 1; Kp = MP_KC + ccbase; Vp = MP_VC + ccbase; }
        else if (br == 1) { j0 = 0; j1 = c; Kp = MP_KS + kvbase; Vp = MP_VS + kvbase; }
        else { j0 = (c - 8 > 0) ? c - 8 : 0; j1 = c; Kp = MP_KW + kvbase; Vp = MP_VW + kvbase; }
#pragma unroll 1
        for (int j = j0; j <= j1; ++j) {
            if (br == 1 && !((un >> j) & 1u)) continue;
            __syncthreads();
            *(LAS v4u*)(L + NS_KT + tid * 16) = *(const v4u*)(Kp + (size_t)j * 4096 + tid * 8);
            *(LAS v4u*)(L + NS_VT + tid * 16) = *(const v4u*)(Vp + (size_t)j * 4096 + tid * 8);
            __syncthreads();
            if (act) {
                unsigned long long mask;
                if (br == 0) mask = bits_upto(nlim - 64 * j);
                else if (br == 1) mask = ((mysel >> j) & 1u) ? ((j < c) ? ~0ull : bits_upto(lane)) : 0ull;
                else { const int lo = t - 511 - 64 * j, hi = t - 64 * j; mask = bits_upto(hi) & ~((lo > 0) ? bits_upto(lo - 1) : 0ull); }
#pragma unroll 1
                for (int r = 0; r < 64; ++r) {
                    const bool on = (mask >> r) & 1ull;
                    if (!__any(on)) continue;
                    const float s = dot64(q, L + NS_KT + r * 128);
                    if (on) {
                        if (s > mx) { const float corr = __expf(mx - s); l *= corr;
#pragma unroll
                            for (int d = 0; d < 64; ++d) o[d] *= corr;
                            mx = s; }
                        const float p = __expf(s - mx); l += p;
                        const LAS unsigned char* vr = L + NS_VT + r * 128;
#pragma unroll
                        for (int c8 = 0; c8 < 8; ++c8) { const v4u vv = *(const LAS v4u*)(vr + c8 * 16);
                            o[c8 * 8 + 0] += p * bflo(vv.x); o[c8 * 8 + 1] += p * bfhi(vv.x); o[c8 * 8 + 2] += p * bflo(vv.y); o[c8 * 8 + 3] += p * bfhi(vv.y);
                            o[c8 * 8 + 4] += p * bflo(vv.z); o[c8 * 8 + 5] += p * bfhi(vv.z); o[c8 * 8 + 6] += p * bflo(vv.w); o[c8 * 8 + 7] += p * bfhi(vv.w); }
                    }
                }
            }
        }
        if (act) { const float gate = sigmoidf_(MP_GATE[row * 32 + br * 8 + g * 4 + h]); const float sc = (l > 0.f) ? gate / l : 0.f;
#pragma unroll
            for (int d = 0; d < 64; ++d) OUT[d] += sc * o[d]; }
        if (br == 0) {
            __syncthreads();
            *(LAS v4u*)(L + NS_KT + tid * 16) = *(const v4u*)(Kp + tid * 8);
            *(LAS v4u*)(L + NS_KT + 8192 + tid * 16) = *(const v4u*)(Kp + 4096 + tid * 8);
            __syncthreads();
            if (act) {
                const float il = (l > 0.f) ? 1.f / l : 0.f;
                LAS float* IMP = (LAS float*)(L + NS_IMP) + tid * 33;
#pragma unroll 1
                for (int jb = 0; jb < 32; ++jb) { float a = 0.f;
#pragma unroll 1
                    for (int n = (jb ? 4 * jb - 1 : 0); n <= 4 * jb + 3 && n <= 126; ++n) { const float s = dot64(q, L + NS_KT + n * 128); if (n <= nlim) a += __expf(s - mx); }
                    IMP[jb] = a * il; }
            }
            __syncthreads();
            if (w == 0) {
                LAS float* IMS = (LAS float*)(L + NS_IMS) + lane * 33; const LAS float* I4 = (const LAS float*)(L + NS_IMP);
                for (int jb = 0; jb < 32; ++jb) IMS[jb] = (I4[lane * 33 + jb] + I4[(64 + lane) * 33 + jb]) + (I4[(128 + lane) * 33 + jb] + I4[(192 + lane) * 33 + jb]);
                unsigned sel;
                if (c + 1 <= 16) sel = (1u << (c + 1)) - 1u;
                else { sel = 1u | (1u << c) | (1u << (c - 1));
                    for (int jb = 1; jb <= c - 2; ++jb) { const float vj = IMS[jb]; int rank = 0;
                        for (int i2 = 1; i2 <= c - 2; ++i2) { const float vi = IMS[i2]; rank += (vi > vj || (vi == vj && i2 < jb)) ? 1 : 0; }
                        if (rank < 13) sel |= 1u << jb; } }
                SEL[lane] = sel; unsigned so = sel;
#pragma unroll
                for (int o2 = 32; o2; o2 >>= 1) so |= __shfl_xor(so, o2);
                if (lane == 0) SEL[64] = so;
            }
            __syncthreads();
            un = SEL[64]; mysel = SEL[lane];
        }
    }
    if (act) { bf16* yp = MP_Y + row * DM + (g * 4 + h) * 64;
#pragma unroll
        for (int c8 = 0; c8 < 8; ++c8) { v4u wv; wv.x = pk2(OUT[c8 * 8 + 0], OUT[c8 * 8 + 1]); wv.y = pk2(OUT[c8 * 8 + 2], OUT[c8 * 8 + 3]); wv.z = pk2(OUT[c8 * 8 + 4], OUT[c8 * 8 + 5]); wv.w = pk2(OUT[c8 * 8 + 6], OUT[c8 * 8 + 7]);
            *(v4u*)(yp + c8 * 8) = wv; } }
    __syncthreads();
}

constexpr int ML_Q = 0, ML_K = 16384, ML_V = 32768, ML_SC = 49152, ML_C = 65536, ML_N = 131072, ML_S = 131584;
__device__ __forceinline__ void mlstm_unit_simple(LAS unsigned char* L, const MixPtrs& P, int b, int h) {
    int tid_l = threadIdx.x; asm volatile("" : "+v"(tid_l));
    const int tid = tid_l, lane = tid & 63, w = __builtin_amdgcn_readfirstlane(tid >> 6);
    LAS float* Cm = (LAS float*)(L + ML_C); LAS float* Nv = (LAS float*)(L + ML_N); LAS float* SC = (LAS float*)(L + ML_SC);
    LAS float* S_bcum = (LAS float*)(L + ML_S), *S_a = S_bcum + 64, *S_mt = S_bcum + 128, *S_wp = S_bcum + 192, *S_wk = S_bcum + 256, *S_x = S_bcum + 320;
    LAS bf16* Qs = (LAS bf16*)(L + ML_Q); LAS bf16* Ks = (LAS bf16*)(L + ML_K); LAS bf16* Vs = (LAS bf16*)(L + ML_V);
    float zf = 0.f; asm volatile("" : "+v"(zf));
    for (int i = tid; i < 128 * 128; i += 512) Cm[i] = zf;
    if (tid < 128) Nv[tid] = zf;
    if (tid == 0) { S_x[0] = zf; S_x[1] = zf; }
    const int ch = tid & 127, sg = tid >> 7;
    float wq[4], wk4[4];
#pragma unroll
    for (int j = 0; j < 4; ++j) { wq[j] = P.conv_w[j * 1024 + h * 128 + ch]; wk4[j] = P.conv_w[j * 1024 + 512 + h * 128 + ch]; }
    const float bq = P.conv_b[h * 128 + ch], bk = P.conv_b[512 + h * 128 + ch];
    const float ib = P.i_bias[h], fb = P.f_bias[h];
    __syncthreads();
#pragma unroll 1
    for (int c = 0; c < 32; ++c) {
        const int t0 = c * 64; const size_t rb = (size_t)b * SEQ;
#pragma unroll 1
        for (int s = 0; s < 16; ++s) { const int sl = sg * 16 + s, t = t0 + sl; float aq = bq, ak = bk;
#pragma unroll
            for (int j = 0; j < 4; ++j) { const int tt = t - 3 + j; if (tt >= 0) { aq += wq[j] * bf2f(MP_MQ[(rb + tt) * 512 + h * 128 + ch]); ak += wk4[j] * bf2f(MP_MK[(rb + tt) * 512 + h * 128 + ch]); } }
            aq = aq / (1.f + __expf(-aq)); ak = ak / (1.f + __expf(-ak)) * 0.08838834764831845f;
            Qs[sl * 128 + ch] = (bf16)f2bf(aq); Ks[sl * 128 + ch] = (bf16)f2bf(ak); Vs[sl * 128 + ch] = MP_MV[(rb + t) * 512 + h * 128 + ch]; }
        if (w == 0) {
            const size_t row = rb + t0 + lane;
            const float il = MP_GATE[row * 32 + 24 + h] + ib; const float fx = MP_GATE[row * 32 + 28 + h] + fb;
            const float fl = fminf(fx, 0.f) - log1pf(__expf(-fabsf(fx)));
            float f = fl;
#pragma unroll
            for (int o = 1; o < 64; o <<= 1) { const float v = __shfl_up(f, o); if (lane >= o) f += v; }
            const float a = il - f; float pm = a;
#pragma unroll
            for (int o = 1; o < 64; o <<= 1) { const float v = __shfl_up(pm, o); if (lane >= o) pm = fmaxf(pm, v); }
            const float b_last = __shfl(f, 63), amax = __shfl(pm, 63), mc = S_x[0];
            const float inter = f + mc, mt = fmaxf(f + pm, inter);
            const float m_new = fmaxf(b_last + mc, b_last + amax);
            S_bcum[lane] = f; S_a[lane] = a; S_mt[lane] = mt; S_wp[lane] = __expf(inter - mt); S_wk[lane] = __expf(b_last + a - m_new);
            if (lane == 0) { S_x[1] = __expf(b_last + mc - m_new); S_x[0] = m_new; }
        }
        __syncthreads();
        { const int t = tid >> 3; const float bt = S_bcum[t] - S_mt[t];
#pragma unroll 1
          for (int jj = 0; jj < 8; ++jj) { const int s = (tid & 7) + 8 * jj; float v = 0.f;
              if (s <= t) { float d0 = 0.f;
#pragma unroll
                  for (int c8 = 0; c8 < 16; ++c8) { const v4u qa = *(const LAS v4u*)(Qs + t * 128 + c8 * 8), ka = *(const LAS v4u*)(Ks + s * 128 + c8 * 8);
                      d0 += bflo(qa.x) * bflo(ka.x) + bfhi(qa.x) * bfhi(ka.x) + bflo(qa.y) * bflo(ka.y) + bfhi(qa.y) * bfhi(ka.y) + bflo(qa.z) * bflo(ka.z) + bfhi(qa.z) * bfhi(ka.z) + bflo(qa.w) * bflo(ka.w) + bfhi(qa.w) * bfhi(ka.w); }
                  v = d0 * __expf(bt + S_a[s]); }
              SC[t * 64 + s] = v; } }
        __syncthreads();
        { const int t = tid >> 3, e0 = (tid & 7) * 16; float acc[16], acc2[16], dsum = 0.f, dqn = 0.f;
#pragma unroll
          for (int e = 0; e < 16; ++e) { acc[e] = 0.f; acc2[e] = 0.f; }
#pragma unroll 1
          for (int s = 0; s < 64; ++s) { const float wv = SC[t * 64 + s]; dsum += wv;
              const v4u v0 = *(const LAS v4u*)(Vs + s * 128 + e0), v1 = *(const LAS v4u*)(Vs + s * 128 + e0 + 8);
              acc[0] += wv * bflo(v0.x); acc[1] += wv * bfhi(v0.x); acc[2] += wv * bflo(v0.y); acc[3] += wv * bfhi(v0.y); acc[4] += wv * bflo(v0.z); acc[5] += wv * bfhi(v0.z); acc[6] += wv * bflo(v0.w); acc[7] += wv * bfhi(v0.w);
              acc[8] += wv * bflo(v1.x); acc[9] += wv * bfhi(v1.x); acc[10] += wv * bflo(v1.y); acc[11] += wv * bfhi(v1.y); acc[12] += wv * bflo(v1.z); acc[13] += wv * bfhi(v1.z); acc[14] += wv * bflo(v1.w); acc[15] += wv * bfhi(v1.w); }
#pragma unroll 1
          for (int d = 0; d < 128; ++d) { const float qd = bf2f(Qs[t * 128 + d]); dqn += qd * Nv[d];
              const LAS f32x4* cr = (const LAS f32x4*)(Cm + d * 128 + e0);
#pragma unroll
              for (int e4 = 0; e4 < 4; ++e4) { const f32x4 cv = cr[e4]; acc2[e4 * 4 + 0] += qd * cv.x; acc2[e4 * 4 + 1] += qd * cv.y; acc2[e4 * 4 + 2] += qd * cv.z; acc2[e4 * 4 + 3] += qd * cv.w; } }
          const float wp = S_wp[t], den = dsum + wp * dqn; const float dn = fmaxf(fabsf(den), __expf(-S_mt[t])); const float idn = 1.f / dn;
          float ss = 0.f;
#pragma unroll
          for (int e = 0; e < 16; ++e) { acc[e] = (acc[e] + wp * acc2[e]) * idn; ss += acc[e] * acc[e]; }
          ss += __shfl_xor(ss, 1); ss += __shfl_xor(ss, 2); ss += __shfl_xor(ss, 4);
          const float rn = __frsqrt_rn(ss * (1.f / 128.f) + EPS);
          const size_t row = rb + t0 + t; const bf16* op = MP_MO + row * 512 + h * 128 + e0; const float* gn = P.mnorm_g + h * 128 + e0;
          const v4u o0 = *(const v4u*)op, o1 = *(const v4u*)(op + 8);
          const float ov[16] = {bflo(o0.x), bfhi(o0.x), bflo(o0.y), bfhi(o0.y), bflo(o0.z), bfhi(o0.z), bflo(o0.w), bfhi(o0.w), bflo(o1.x), bfhi(o1.x), bflo(o1.y), bfhi(o1.y), bflo(o1.z), bfhi(o1.z), bflo(o1.w), bfhi(o1.w)};
          float y[16];
#pragma unroll
          for (int e = 0; e < 16; ++e) y[e] = acc[e] * rn * gn[e] * sigmoidf_(ov[e]);
          v4u w0, w1; w0.x = pk2(y[0], y[1]); w0.y = pk2(y[2], y[3]); w0.z = pk2(y[4], y[5]); w0.w = pk2(y[6], y[7]); w1.x = pk2(y[8], y[9]); w1.y = pk2(y[10], y[11]); w1.z = pk2(y[12], y[13]); w1.w = pk2(y[14], y[15]);
          bf16* yp = MP_Y + row * DM + 512 + h * 128 + e0; *(v4u*)yp = w0; *(v4u*)(yp + 8) = w1; }
        __syncthreads();
        { const int d = tid >> 2, e0 = (tid & 3) * 32; const float cs = S_x[1]; float ca[32], na = 0.f;
#pragma unroll
          for (int e = 0; e < 32; ++e) ca[e] = cs * Cm[d * 128 + e0 + e];
#pragma unroll 1
          for (int s = 0; s < 64; ++s) { const float kk = S_wk[s] * bf2f(Ks[s * 128 + d]); na += kk;
#pragma unroll
              for (int c8 = 0; c8 < 4; ++c8) { const v4u vv = *(const LAS v4u*)(Vs + s * 128 + e0 + c8 * 8);
                  ca[c8 * 8 + 0] += kk * bflo(vv.x); ca[c8 * 8 + 1] += kk * bfhi(vv.x); ca[c8 * 8 + 2] += kk * bflo(vv.y); ca[c8 * 8 + 3] += kk * bfhi(vv.y);
                  ca[c8 * 8 + 4] += kk * bflo(vv.z); ca[c8 * 8 + 5] += kk * bfhi(vv.z); ca[c8 * 8 + 6] += kk * bflo(vv.w); ca[c8 * 8 + 7] += kk * bfhi(vv.w); } }
#pragma unroll
          for (int e = 0; e < 32; ++e) Cm[d * 128 + e0 + e] = ca[e];
          if ((tid & 3) == 0) Nv[d] = cs * Nv[d] + na; }
        __syncthreads();
    }
}

typedef float f32x16 __attribute__((ext_vector_type(16)));
typedef short bf16x8v __attribute__((ext_vector_type(8)));
typedef short s16x4v __attribute__((ext_vector_type(4)));
typedef float f32x2v __attribute__((ext_vector_type(2)));
typedef __bf16 bf16x2v __attribute__((ext_vector_type(2)));
#define MFMA32(a, b, c) __builtin_amdgcn_mfma_f32_32x32x16_bf16((a), (b), (c), 0, 0, 0)
__device__ __forceinline__ unsigned cvtpk(float lo, float hi) { f32x2v v = {lo, hi}; bf16x2v b = __builtin_convertvector(v, bf16x2v); return __builtin_bit_cast(unsigned, b); }
__device__ __forceinline__ s16x4v tr_read(const LAS unsigned char* p) { return __builtin_bit_cast(s16x4v, __builtin_amdgcn_ds_read_tr16_b64_v4i16((LAS s16x4v*)p)); }
__device__ __forceinline__ int tile_off(int key, int ch8) { return (ch8 >> 2) * 4096 + key * 64 + (((ch8 & 3) ^ ((key >> 2) & 3)) << 4); }
constexpr int NM_SLOT = 0, NM_IMP = 32768, NM_IMS = 66560, NM_SEL = 75008, NM_ITEM = 75328;
constexpr float QK_SCALE = 0.125f * 1.4426950408889634f;

__device__ __forceinline__ void qk_tile(const LAS unsigned char* Ks, const bf16x8v (&qf)[4], int r, int h, f32x16& p0, f32x16& p1) {
    const f32x16 z = {0.f, 0.f, 0.f, 0.f, 0.f, 0.f, 0.f, 0.f, 0.f, 0.f, 0.f, 0.f, 0.f, 0.f, 0.f, 0.f};
    const int sw = (r >> 2) & 3;
#pragma unroll
    for (int ks = 0; ks < 4; ++ks) {
        const int off = (ks >> 1) * 4096 + r * 64 + (((((ks & 1) << 1) + h) ^ sw) << 4);
        const bf16x8v a0 = *(const LAS bf16x8v*)(Ks + off), a1 = *(const LAS bf16x8v*)(Ks + off + 2048);
        p0 = MFMA32(a0, qf[ks], ks ? p0 : z); p1 = MFMA32(a1, qf[ks], ks ? p1 : z);
    }
}
__device__ __forceinline__ void pv_tile(const LAS unsigned char* Vs, const f32x16& p0, const f32x16& p1, f32x16 (&o)[2], int lane) {
    const int h = lane >> 5, i16 = lane & 15, q = i16 >> 2, p = i16 & 3, gi = (lane >> 4) & 1;
    const int cidx = 2 * gi + (p >> 1), e8 = (p & 1) << 3;
    const int offlo = q * 64 + ((cidx ^ h) << 4) + e8 + h * 256, offhi = q * 64 + ((cidx ^ (h | 2)) << 4) + e8 + h * 256 + 512;
#pragma unroll
    for (int kb = 0; kb < 2; ++kb)
#pragma unroll
        for (int s = 0; s < 2; ++s) {
            const f32x16& P = kb ? p1 : p0;
            v4u pw; pw.x = cvtpk(P[8 * s + 0], P[8 * s + 1]); pw.y = cvtpk(P[8 * s + 2], P[8 * s + 3]); pw.z = cvtpk(P[8 * s + 4], P[8 * s + 5]); pw.w = cvtpk(P[8 * s + 6], P[8 * s + 7]);
            const bf16x8v pf = __builtin_bit_cast(bf16x8v, pw);
#pragma unroll
            for (int db = 0; db < 2; ++db) {
                const LAS unsigned char* base = Vs + db * 4096 + (kb * 32 + s * 16) * 64;
                const s16x4v lo = tr_read(base + offlo), hi = tr_read(base + offhi);
                const bf16x8v vf = __builtin_shufflevector(lo, hi, 0, 1, 2, 3, 4, 5, 6, 7);
                o[db] = MFMA32(vf, pf, o[db]);
            }
        }
}

__device__ __forceinline__ void nsa_unit_mfma(LAS unsigned char* L, const MixPtrs& P, int b, int g, int c) {
    int tid_l = threadIdx.x; asm volatile("" : "+v"(tid_l));
    const int tid = tid_l, lane = tid & 63, w = __builtin_amdgcn_readfirstlane(tid >> 6);
    const int r = lane & 31, h = lane >> 5, head = w >> 1, qi = (w & 1) * 32 + r, t = c * 64 + qi;
    const size_t row = (size_t)b * SEQ + t;
    LAS unsigned* SEL = (LAS unsigned*)(L + NM_SEL); LAS int* ITEM = (LAS int*)(L + NM_ITEM);
    const size_t kvbase = (size_t)(b * 2 + g) * SEQ * 64, ccbase = (size_t)(b * 2 + g) * 128 * 64;
    const int skey = tid >> 3, sch = tid & 7, soff = tile_off(skey, sch);
    bf16x8v qf[4];
    { const bf16* qp = MP_QN + row * 512 + (g * 4 + head) * 64 + 8 * h;
#pragma unroll
      for (int ks = 0; ks < 4; ++ks) qf[ks] = *(const bf16x8v*)(qp + 16 * ks); }
    const float* gp = MP_GATE + row * 32 + g * 4 + head;
    float one = 1.f; asm volatile("" : "+v"(one));
    const float gate_c = one / (one + __expf(-gp[0])), gate_s = one / (one + __expf(-gp[8])), gate_w = one / (one + __expf(-gp[16]));
    f32x16 oacc[2];
    {
        const bf16* kc = MP_KC + ccbase; const bf16* vc = MP_VC + ccbase;
        const v4u k0 = *(const v4u*)(kc + tid * 8), k1 = *(const v4u*)(kc + 4096 + tid * 8), v0 = *(const v4u*)(vc + tid * 8), v1 = *(const v4u*)(vc + 4096 + tid * 8);
        __syncthreads();
        *(LAS v4u*)(L + NM_SLOT + soff) = k0; *(LAS v4u*)(L + NM_SLOT + 8192 + soff) = v0; *(LAS v4u*)(L + NM_SLOT + 16384 + soff) = k1; *(LAS v4u*)(L + NM_SLOT + 24576 + soff) = v1;
        if (tid < 64) SEL[tid] = 0u;
        __syncthreads();
        f32x16 s0, s1, s2, s3;
        qk_tile(L + NM_SLOT, qf, r, h, s0, s1); qk_tile(L + NM_SLOT + 16384, qf, r, h, s2, s3);
        const int nlim = (t >= 31) ? (((t - 31) >> 4) < 126 ? ((t - 31) >> 4) : 126) : -1;
        float mx = -1e20f;
#pragma unroll
        for (int e = 0; e < 16; ++e) { const int cr = (e & 3) + 8 * (e >> 2) + 4 * h;
            s0[e] = (cr <= nlim) ? s0[e] * QK_SCALE : -1e30f; s1[e] = (cr + 32 <= nlim) ? s1[e] * QK_SCALE : -1e30f;
            s2[e] = (cr + 64 <= nlim) ? s2[e] * QK_SCALE : -1e30f; s3[e] = (cr + 96 <= nlim) ? s3[e] * QK_SCALE : -1e30f;
            mx = fmaxf(fmaxf(mx, fmaxf(s0[e], s1[e])), fmaxf(s2[e], s3[e])); }
        mx = fmaxf(mx, __shfl_xor(mx, 32));
        float ls = 0.f;
#pragma unroll
        for (int e = 0; e < 16; ++e) { s0[e] = __builtin_amdgcn_exp2f(s0[e] - mx); s1[e] = __builtin_amdgcn_exp2f(s1[e] - mx); s2[e] = __builtin_amdgcn_exp2f(s2[e] - mx); s3[e] = __builtin_amdgcn_exp2f(s3[e] - mx);
            ls += (s0[e] + s1[e]) + (s2[e] + s3[e]); }
        ls += __shfl_xor(ls, 32);
        const float il = (ls > 0.f) ? 1.f / ls : 0.f;
#pragma unroll
        for (int e = 0; e < 16; ++e) { s0[e] *= il; s1[e] *= il; s2[e] *= il; s3[e] *= il; }
        { LAS float* IMP = (LAS float*)(L + NM_IMP) + (w * 32 + r) * 33; float plprev = 0.f;
#pragma unroll
          for (int x = 0; x < 16; ++x) {
              const f32x16& S = (x < 4) ? s0 : ((x < 8) ? s1 : ((x < 12) ? s2 : s3)); const int g4 = (x & 3) * 4;
              const float own = (S[g4] + S[g4 + 1]) + (S[g4 + 2] + S[g4 + 3]);
              const float pl = __shfl_xor(S[g4 + 3], 32);
              if (h == 1) IMP[2 * x + 1] = own + pl; else IMP[2 * x] = own + plprev;
              plprev = pl;
          }
        }
        oacc[0] = (f32x16){0.f, 0.f, 0.f, 0.f, 0.f, 0.f, 0.f, 0.f, 0.f, 0.f, 0.f, 0.f, 0.f, 0.f, 0.f, 0.f}; oacc[1] = oacc[0];
        pv_tile(L + NM_SLOT + 8192, s0, s1, oacc, lane); pv_tile(L + NM_SLOT + 24576, s2, s3, oacc, lane);
#pragma unroll
        for (int e = 0; e < 16; ++e) { oacc[0][e] *= gate_c; oacc[1][e] *= gate_c; }
    }
    __syncthreads();
    { const int i = tid & 63, jg = tid >> 6; const LAS float* I8 = (const LAS float*)(L + NM_IMP); LAS float* IMS = (LAS float*)(L + NM_IMS);
#pragma unroll
      for (int jj = 0; jj < 4; ++jj) { const int j = 4 * jg + jj; const int wq = (i >> 5), rq = i & 31;
          IMS[i * 33 + j] = (I8[((0 + wq) * 32 + rq) * 33 + j] + I8[((2 + wq) * 32 + rq) * 33 + j]) + (I8[((4 + wq) * 32 + rq) * 33 + j] + I8[((6 + wq) * 32 + rq) * 33 + j]); }
      __syncthreads();
      unsigned bits = 0u;
      if (c + 1 <= 16) { if (jg == 0) bits = (1u << (c + 1)) - 1u; }
      else { if (jg == 0) bits = 1u | (1u << c) | (1u << (c - 1));
#pragma unroll 1
          for (int jj = 0; jj < 4; ++jj) { const int j = 4 * jg + jj; if (j >= 1 && j <= c - 2) { const float vj = IMS[i * 33 + j]; int rank = 0;
#pragma unroll 1
              for (int i2 = 1; i2 <= c - 2; ++i2) { const float vi = IMS[i * 33 + i2]; rank += (vi > vj || (vi == vj && i2 < j)) ? 1 : 0; }
              if (rank < 13) bits |= 1u << j; } } }
      if (bits) atomicOr((unsigned*)&SEL[i], bits);
      __syncthreads();
      if (w == 0) { unsigned so = SEL[lane];
#pragma unroll
          for (int o2 = 32; o2; o2 >>= 1) so |= __shfl_xor(so, o2);
          if (lane == 0) { int n = 0; for (int j = 0; j <= c; ++j) if ((so >> j) & 1u) ITEM[n++] = j; const int j0 = (c - 8 > 0) ? c - 8 : 0; for (int j = j0; j <= c; ++j) ITEM[n++] = 64 + j; ITEM[47] = n; } }
      __syncthreads();
    }
    const unsigned mysel = SEL[qi]; const int nitem = ITEM[47];
    f32x16 o[2]; float m = -1e20f, lsum = 0.f; int prev_kind = 0;
    o[0] = (f32x16){0.f, 0.f, 0.f, 0.f, 0.f, 0.f, 0.f, 0.f, 0.f, 0.f, 0.f, 0.f, 0.f, 0.f, 0.f, 0.f}; o[1] = o[0];
    v4u rk, rv;
    { const int it0 = ITEM[0]; const bf16* kp = ((it0 & 64) ? MP_KW : MP_KS) + kvbase + (size_t)(it0 & 63) * 4096; const bf16* vp = ((it0 & 64) ? MP_VW : MP_VS) + kvbase + (size_t)(it0 & 63) * 4096;
      rk = *(const v4u*)(kp + tid * 8); rv = *(const v4u*)(vp + tid * 8); }
    __syncthreads();
    *(LAS v4u*)(L + NM_SLOT + soff) = rk; *(LAS v4u*)(L + NM_SLOT + 8192 + soff) = rv;
    __syncthreads();
#pragma unroll 1
    for (int it = 0; it < nitem; ++it) {
        const int item = ITEM[it], kind = item >> 6, j = item & 63;
        if (it + 1 < nitem) { const int it1 = ITEM[it + 1]; const bf16* kp = ((it1 & 64) ? MP_KW : MP_KS) + kvbase + (size_t)(it1 & 63) * 4096; const bf16* vp = ((it1 & 64) ? MP_VW : MP_VS) + kvbase + (size_t)(it1 & 63) * 4096;
            rk = *(const v4u*)(kp + tid * 8); rv = *(const v4u*)(vp + tid * 8); }
        if (kind != prev_kind) {
            const float tot = lsum + __shfl_xor(lsum, 32); const float sc = gate_s / tot;
#pragma unroll
            for (int e = 0; e < 16; ++e) { oacc[0][e] += o[0][e] * sc; oacc[1][e] += o[1][e] * sc; o[0][e] = 0.f; o[1][e] = 0.f; }
            m = -1e20f; lsum = 0.f; prev_kind = kind;
        }
        int klo, khi;
        if (kind == 0) { klo = 0; khi = ((mysel >> j) & 1u) ? ((j < c) ? 63 : qi) : -1; }
        else { klo = t - 511 - 64 * j; khi = t - 64 * j; if (khi > 63) khi = 63; if (klo < 0) klo = 0; }
        const LAS unsigned char* slot = L + NM_SLOT + (it & 1) * 16384;
        if (__any(khi >= klo)) {
            f32x16 p0, p1;
            qk_tile(slot, qf, r, h, p0, p1);
            if (!__all(klo == 0 && khi == 63)) {
                const int a = klo - 4 * h, z = khi - 4 * h;
#pragma unroll
                for (int e = 0; e < 16; ++e) { const int cr = (e & 3) + 8 * (e >> 2);
                    p0[e] = (cr >= a && cr <= z) ? p0[e] : -1e30f; p1[e] = (cr + 32 >= a && cr + 32 <= z) ? p1[e] : -1e30f; }
            }
            float tm = fmaxf(p0[0], p1[0]);
#pragma unroll
            for (int e = 1; e < 16; ++e) tm = fmaxf(tm, fmaxf(p0[e], p1[e]));
            tm = fmaxf(tm, __shfl_xor(tm, 32));
            const float mn = fmaxf(m, tm * QK_SCALE);
            if (!__all(mn == m)) { const float corr = __builtin_amdgcn_exp2f(m - mn); lsum *= corr;
#pragma unroll
                for (int e = 0; e < 16; ++e) { o[0][e] *= corr; o[1][e] *= corr; }
                m = mn; }
            float ts = 0.f;
#pragma unroll
            for (int e = 0; e < 16; ++e) { p0[e] = __builtin_amdgcn_exp2f(p0[e] * QK_SCALE - m); p1[e] = __builtin_amdgcn_exp2f(p1[e] * QK_SCALE - m); ts += p0[e] + p1[e]; }
            lsum += ts;
            pv_tile(slot + 8192, p0, p1, o, lane);
        }
        if (it + 1 < nitem) { const int so = NM_SLOT + ((it + 1) & 1) * 16384; *(LAS v4u*)(L + so + soff) = rk; *(LAS v4u*)(L + so + 8192 + soff) = rv; }
        __syncthreads();
    }
    { const float tot = lsum + __shfl_xor(lsum, 32); const float sc = gate_w / tot;
#pragma unroll
      for (int e = 0; e < 16; ++e) { oacc[0][e] += o[0][e] * sc; oacc[1][e] += o[1][e] * sc; } }
    { bf16* yp = MP_Y + row * DM + (g * 4 + head) * 64 + 4 * h;
#pragma unroll
      for (int db = 0; db < 2; ++db)
#pragma unroll
          for (int g4 = 0; g4 < 4; ++g4) { v2u wv; wv.x = cvtpk(oacc[db][4 * g4], oacc[db][4 * g4 + 1]); wv.y = cvtpk(oacc[db][4 * g4 + 2], oacc[db][4 * g4 + 3]); *(v2u*)(yp + db * 32 + g4 * 8) = wv; } }
}

#define MFMA16(a, b, c) __builtin_amdgcn_mfma_f32_16x16x32_bf16((a), (b), (c), 0, 0, 0)
constexpr size_t WS_QC = 401 * MiB, WS_KC2 = 433 * MiB, WS_END2 = 465 * MiB;
#define MP_QC ((const bf16*)(P.ws + WS_QC))
#define MP_KC2 ((const bf16*)(P.ws + WS_KC2))
__device__ __forceinline__ int img_off(int row, int ch) { return 256 * row + 16 * (ch ^ (((row & 3) << 2) | ((row >> 2) & 3))); }
constexpr int M2_IMG = 0, M2_SC = 98304, M2_DEN = 106496, M2_QN = 107520, M2_N = 107776, M2_SSQ = 108288;

__device__ __forceinline__ void mlstm_conv_pass(unsigned char* ws, const float* conv_w, const float* conv_b, int gthread, int nthreads) {
    for (int idx = gthread; idx < BATCH * 128 * 128; idx += nthreads) {
        const int cc = idx & 127, tg = (idx >> 7) & 127, b = idx >> 14;
        const int isk = cc >> 6, ch0 = (cc & 63) * 8;
        const bf16* src = (const bf16*)(ws + (isk ? WS_MK : WS_MQ)) + (size_t)b * SEQ * 512 + ch0;
        bf16* dst = (bf16*)(ws + (isk ? WS_KC2 : WS_QC)) + ((size_t)(b * 4 + (ch0 >> 7)) * SEQ) * 128 + (ch0 & 127);
        float wt[4][8], bs[8];
#pragma unroll
        for (int j = 0; j < 4; ++j) { const f32x4 a = *(const f32x4*)(conv_w + j * 1024 + isk * 512 + ch0), c2 = *(const f32x4*)(conv_w + j * 1024 + isk * 512 + ch0 + 4);
            wt[j][0] = a.x; wt[j][1] = a.y; wt[j][2] = a.z; wt[j][3] = a.w; wt[j][4] = c2.x; wt[j][5] = c2.y; wt[j][6] = c2.z; wt[j][7] = c2.w; }
        { const f32x4 a = *(const f32x4*)(conv_b + isk * 512 + ch0), c2 = *(const f32x4*)(conv_b + isk * 512 + ch0 + 4); bs[0] = a.x; bs[1] = a.y; bs[2] = a.z; bs[3] = a.w; bs[4] = c2.x; bs[5] = c2.y; bs[6] = c2.z; bs[7] = c2.w; }
        const float osc = isk ? 0.08838834764831845f : 1.f;
        const int t0 = tg * 16;
        float x0[8], x1[8], x2[8];
#pragma unroll
        for (int e = 0; e < 8; ++e) { x0[e] = 0.f; x1[e] = 0.f; x2[e] = 0.f; }
        if (t0 > 0) {
            const v4u a = *(const v4u*)(src + (size_t)(t0 - 3) * 512), c2 = *(const v4u*)(src + (size_t)(t0 - 2) * 512), d2 = *(const v4u*)(src + (size_t)(t0 - 1) * 512);
            x0[0] = bflo(a.x); x0[1] = bfhi(a.x); x0[2] = bflo(a.y); x0[3] = bfhi(a.y); x0[4] = bflo(a.z); x0[5] = bfhi(a.z); x0[6] = bflo(a.w); x0[7] = bfhi(a.w);
            x1[0] = bflo(c2.x); x1[1] = bfhi(c2.x); x1[2] = bflo(c2.y); x1[3] = bfhi(c2.y); x1[4] = bflo(c2.z); x1[5] = bfhi(c2.z); x1[6] = bflo(c2.w); x1[7] = bfhi(c2.w);
            x2[0] = bflo(d2.x); x2[1] = bfhi(d2.x); x2[2] = bflo(d2.y); x2[3] = bfhi(d2.y); x2[4] = bflo(d2.z); x2[5] = bfhi(d2.z); x2[6] = bflo(d2.w); x2[7] = bfhi(d2.w);
        }
#pragma unroll 4
        for (int s = 0; s < 16; ++s) {
            const v4u a = *(const v4u*)(src + (size_t)(t0 + s) * 512);
            const float x3[8] = {bflo(a.x), bfhi(a.x), bflo(a.y), bfhi(a.y), bflo(a.z), bfhi(a.z), bflo(a.w), bfhi(a.w)};
            float o[8];
#pragma unroll
            for (int e = 0; e < 8; ++e) { float v = bs[e] + wt[0][e] * x0[e] + wt[1][e] * x1[e] + wt[2][e] * x2[e] + wt[3][e] * x3[e]; v = v / (1.f + __expf(-v)); o[e] = v * osc; x0[e] = x1[e]; x1[e] = x2[e]; x2[e] = x3[e]; }
            v4u wv; wv.x = pk2(o[0], o[1]); wv.y = pk2(o[2], o[3]); wv.z = pk2(o[4], o[5]); wv.w = pk2(o[6], o[7]);
            *(v4u*)(dst + (size_t)(t0 + s) * 128) = wv;
        }
    }
}

__device__ __forceinline__ void mlstm_unit_mfma(LAS unsigned char* L, const MixPtrs& P, int b, int hh) {
    int tid_l = threadIdx.x; asm volatile("" : "+v"(tid_l));
    const int tid = tid_l, lane = tid & 63, w = __builtin_amdgcn_readfirstlane(tid >> 6), l15 = lane & 15, kg = lane >> 4;
    const float ib = P.i_bias[hh], fb = P.f_bias[hh];
    const size_t rb = (size_t)b * SEQ;
    const bf16* QCp = MP_QC + ((size_t)(b * 4 + hh) * SEQ) * 128; const bf16* KCp = MP_KC2 + ((size_t)(b * 4 + hh) * SEQ) * 128;
    const bf16* Vp = MP_MV + rb * 512 + hh * 128; const bf16* Op = MP_MO + rb * 512 + hh * 128 + 16 * w + 4 * kg;
    const float* Gp = MP_GATE + rb * 32 + hh;
    bf16* Yp = MP_Y + rb * DM + 512 + hh * 128 + 16 * w + 4 * kg;
    LAS float* DEN = (LAS float*)(L + M2_DEN); LAS float* QN = (LAS float*)(L + M2_QN); LAS float* NV = (LAS float*)(L + M2_N); LAS float* SSQ = (LAS float*)(L + M2_SSQ);
    float zf = 0.f; asm volatile("" : "+v"(zf));
    f32x4 Cacc[8], nacc = {zf, zf, zf, zf}; bf16x8v Cfrag[4];
#pragma unroll
    for (int i = 0; i < 8; ++i) Cacc[i] = (f32x4){zf, zf, zf, zf};
#pragma unroll
    for (int i = 0; i < 4; ++i) Cfrag[i] = (bf16x8v){0, 0, 0, 0, 0, 0, 0, 0};
    float mc = zf;
    const f32x4 gn = *(const f32x4*)(P.mnorm_g + hh * 128 + 16 * w + 4 * kg);
    const int r0s = tid >> 4, c0s = tid & 15, so0 = img_off(r0s, c0s), so1 = img_off(r0s + 32, c0s);
    v4u sq0, sq1, sk0, sk1, sv0, sv1;
    sq0 = *(const v4u*)(QCp + (size_t)r0s * 128 + c0s * 8); sq1 = *(const v4u*)(QCp + (size_t)(r0s + 32) * 128 + c0s * 8);
    sk0 = *(const v4u*)(KCp + (size_t)r0s * 128 + c0s * 8); sk1 = *(const v4u*)(KCp + (size_t)(r0s + 32) * 128 + c0s * 8);
    sv0 = *(const v4u*)(Vp + (size_t)r0s * 512 + c0s * 8);  sv1 = *(const v4u*)(Vp + (size_t)(r0s + 32) * 512 + c0s * 8);
    float gi = Gp[(size_t)lane * 32 + 24], gf = Gp[(size_t)lane * 32 + 28];
    __syncthreads();
    *(LAS v4u*)(L + M2_IMG + so0) = sq0; *(LAS v4u*)(L + M2_IMG + so1) = sq1; *(LAS v4u*)(L + M2_IMG + 16384 + so0) = sk0; *(LAS v4u*)(L + M2_IMG + 16384 + so1) = sk1;
    *(LAS v4u*)(L + M2_IMG + 32768 + so0) = sv0; *(LAS v4u*)(L + M2_IMG + 32768 + so1) = sv1;
    if (tid < 128) NV[tid] = zf;
    __syncthreads();
#pragma unroll 1
    for (int c = 0; c < 32; ++c) {
        const int t0 = c * 64; const LAS unsigned char* Qi = L + M2_IMG + (c & 1) * 49152; const LAS unsigned char* Ki = Qi + 16384; const LAS unsigned char* Vi = Qi + 32768;
        float gi_n = 0.f, gf_n = 0.f;
        if (c + 1 < 32) { const int tn = t0 + 64;
            sq0 = *(const v4u*)(QCp + (size_t)(tn + r0s) * 128 + c0s * 8); sq1 = *(const v4u*)(QCp + (size_t)(tn + r0s + 32) * 128 + c0s * 8);
            sk0 = *(const v4u*)(KCp + (size_t)(tn + r0s) * 128 + c0s * 8); sk1 = *(const v4u*)(KCp + (size_t)(tn + r0s + 32) * 128 + c0s * 8);
            sv0 = *(const v4u*)(Vp + (size_t)(tn + r0s) * 512 + c0s * 8);  sv1 = *(const v4u*)(Vp + (size_t)(tn + r0s + 32) * 512 + c0s * 8);
            gi_n = Gp[(size_t)(tn + lane) * 32 + 24]; gf_n = Gp[(size_t)(tn + lane) * 32 + 28]; }
        v2u og[4];
#pragma unroll
        for (int tb = 0; tb < 4; ++tb) og[tb] = *(const v2u*)(Op + (size_t)(t0 + 16 * tb + l15) * 512);
        float s_a, s_bt, s_wp, s_emt, s_wk, cs;
        { const float il = gi + ib, fx = gf + fb; const float fl = fminf(fx, 0.f) - log1pf(__expf(-fabsf(fx)));
          float f = fl;
#pragma unroll
          for (int o = 1; o < 64; o <<= 1) { const float v = __shfl_up(f, o); if (lane >= o) f += v; }
          const float a = il - f; float pm = a;
#pragma unroll
          for (int o = 1; o < 64; o <<= 1) { const float v = __shfl_up(pm, o); if (lane >= o) pm = fmaxf(pm, v); }
          const float b_last = __shfl(f, 63), amax = __shfl(pm, 63);
          const float inter = f + mc, mt = fmaxf(f + pm, inter), m_new = fmaxf(b_last + mc, b_last + amax);
          s_a = a; s_bt = f - mt; s_wp = __expf(inter - mt); s_emt = __expf(-mt); s_wk = __expf(b_last + a - m_new); cs = __expf(b_last + mc - m_new); mc = m_new; }
        { const int tblk = w >> 1, t = 16 * tblk + l15; const float bt_t = __shfl(s_bt, t);
          LAS unsigned char* SC = L + M2_SC;
#pragma unroll
          for (int sb = 0; sb < 2; ++sb) { const int sblk = 2 * (w & 1) + sb; f32x4 acc = {0.f, 0.f, 0.f, 0.f}; float rp = 0.f; v2u wv; wv.x = 0u; wv.y = 0u;
              if (sblk <= tblk) {
#pragma unroll
                  for (int ks = 0; ks < 4; ++ks) { const bf16x8v ka = *(const LAS bf16x8v*)(Ki + img_off(16 * sblk + l15, 4 * ks + kg)), qb = *(const LAS bf16x8v*)(Qi + img_off(t, 4 * ks + kg)); acc = MFMA16(ka, qb, acc); }
                  float v[4];
#pragma unroll
                  for (int e = 0; e < 4; ++e) { const float a_s = __shfl(s_a, 16 * sblk + 4 * kg + e); const float x = acc[e] * __expf(bt_t + a_s); v[e] = (sblk == tblk && 4 * kg + e > l15) ? 0.f : x; }
                  rp = (v[0] + v[1]) + (v[2] + v[3]); wv.x = cvtpk(v[0], v[1]); wv.y = cvtpk(v[2], v[3]);
              }
              rp += __shfl_xor(rp, 16); rp += __shfl_xor(rp, 32);
              *(LAS v2u*)(SC + t * 128 + (((2 * sblk + (kg >> 1)) ^ (t & 7)) << 4) + 8 * (kg & 1)) = wv;
              if (kg == 0) DEN[sblk * 64 + t] = rp; }
          { const int tq = tid >> 3, dp = tid & 7; const v4u q0 = *(const LAS v4u*)(Qi + img_off(tq, 2 * dp)), q1 = *(const LAS v4u*)(Qi + img_off(tq, 2 * dp + 1));
            const LAS f32x4* np = (const LAS f32x4*)(NV + 16 * dp); const f32x4 n0 = np[0], n1 = np[1], n2 = np[2], n3 = np[3];
            float s = bflo(q0.x) * n0.x + bfhi(q0.x) * n0.y + bflo(q0.y) * n0.z + bfhi(q0.y) * n0.w + bflo(q0.z) * n1.x + bfhi(q0.z) * n1.y + bflo(q0.w) * n1.z + bfhi(q0.w) * n1.w
                    + bflo(q1.x) * n2.x + bfhi(q1.x) * n2.y + bflo(q1.y) * n2.z + bfhi(q1.y) * n2.w + bflo(q1.z) * n3.x + bfhi(q1.z) * n3.y + bflo(q1.w) * n3.z + bfhi(q1.w) * n3.w;
            s += __shfl_xor(s, 1); s += __shfl_xor(s, 2); s += __shfl_xor(s, 4);
            if (dp == 0) QN[tq] = s; } }
        __syncthreads();
        const int q4 = l15 >> 2, p4 = l15 & 3;
        bf16x8v vf[2];
#pragma unroll
        for (int ks = 0; ks < 2; ++ks) { const int r0 = 32 * ks + 8 * kg;
            const s16x4v lo = tr_read(Vi + 256 * (r0 + q4) + 16 * ((2 * w + (p4 >> 1)) ^ ((q4 << 2) | ((r0 >> 2) & 3))) + 8 * (p4 & 1));
            const s16x4v hi = tr_read(Vi + 256 * (r0 + 4 + q4) + 16 * ((2 * w + (p4 >> 1)) ^ ((q4 << 2) | (((r0 + 4) >> 2) & 3))) + 8 * (p4 & 1));
            vf[ks] = __builtin_shufflevector(lo, hi, 0, 1, 2, 3, 4, 5, 6, 7); }
        f32x4 hv[4];
#pragma unroll
        for (int tb = 0; tb < 4; ++tb) { const int t = 16 * tb + l15; f32x4 an = {0.f, 0.f, 0.f, 0.f}, a2 = {0.f, 0.f, 0.f, 0.f};
#pragma unroll
            for (int ks = 0; ks < 2; ++ks) { const bf16x8v sf = *(const LAS bf16x8v*)(L + M2_SC + t * 128 + (((4 * ks + kg) ^ (t & 7)) << 4)); an = MFMA16(vf[ks], sf, an); }
            const int swz = ((t & 3) << 2) | ((t >> 2) & 3);
#pragma unroll
            for (int kp = 0; kp < 4; ++kp) { const v2u qlo = *(const LAS v2u*)(Qi + 256 * t + 16 * ((4 * kp + (kg >> 1)) ^ swz) + 8 * (kg & 1)), qhi = *(const LAS v2u*)(Qi + 256 * t + 16 * ((4 * kp + 2 + (kg >> 1)) ^ swz) + 8 * (kg & 1));
                v4u qq; qq.x = qlo.x; qq.y = qlo.y; qq.z = qhi.x; qq.w = qhi.y; a2 = MFMA16(Cfrag[kp], __builtin_bit_cast(bf16x8v, qq), a2); }
            const float wp = __shfl(s_wp, t), emt = __shfl(s_emt, t);
            const float dn = (DEN[t] + DEN[64 + t]) + (DEN[128 + t] + DEN[192 + t]) + wp * QN[t];
            const float idn = 1.f / fmaxf(fabsf(dn), emt);
            hv[tb] = (an + a2 * wp) * idn;
            float ss = (hv[tb].x * hv[tb].x + hv[tb].y * hv[tb].y) + (hv[tb].z * hv[tb].z + hv[tb].w * hv[tb].w);
            ss += __shfl_xor(ss, 16); ss += __shfl_xor(ss, 32);
            if (kg == 0) SSQ[((c & 1) * 8 + w) * 64 + t] = ss; }
        { bf16x8v vpf[2], wkf[2];
#pragma unroll
          for (int ks = 0; ks < 2; ++ks) { float wkv[8]; unsigned vp[4], wp2[4]; const v4u vu = __builtin_bit_cast(v4u, vf[ks]); const unsigned vw[4] = {vu.x, vu.y, vu.z, vu.w};
#pragma unroll
              for (int j = 0; j < 8; ++j) wkv[j] = __shfl(s_wk, 32 * ks + 8 * kg + j);
#pragma unroll
              for (int j2 = 0; j2 < 4; ++j2) { vp[j2] = cvtpk(bflo(vw[j2]) * wkv[2 * j2], bfhi(vw[j2]) * wkv[2 * j2 + 1]); wp2[j2] = cvtpk(wkv[2 * j2], wkv[2 * j2 + 1]); }
              v4u a; a.x = vp[0]; a.y = vp[1]; a.z = vp[2]; a.w = vp[3]; vpf[ks] = __builtin_bit_cast(bf16x8v, a);
              v4u b2; b2.x = wp2[0]; b2.y = wp2[1]; b2.z = wp2[2]; b2.w = wp2[3]; wkf[ks] = __builtin_bit_cast(bf16x8v, b2); }
          nacc = nacc * cs;
#pragma unroll
          for (int i = 0; i < 8; ++i) { Cacc[i] = Cacc[i] * cs;
#pragma unroll
              for (int ks = 0; ks < 2; ++ks) { const int r0 = 32 * ks + 8 * kg;
                  const s16x4v lo = tr_read(Ki + 256 * (r0 + q4) + 16 * ((2 * i + (p4 >> 1)) ^ ((q4 << 2) | ((r0 >> 2) & 3))) + 8 * (p4 & 1));
                  const s16x4v hi = tr_read(Ki + 256 * (r0 + 4 + q4) + 16 * ((2 * i + (p4 >> 1)) ^ ((q4 << 2) | (((r0 + 4) >> 2) & 3))) + 8 * (p4 & 1));
                  const bf16x8v kf = __builtin_shufflevector(lo, hi, 0, 1, 2, 3, 4, 5, 6, 7);
                  Cacc[i] = MFMA16(kf, vpf[ks], Cacc[i]);
                  if (i == w) nacc = MFMA16(kf, wkf[ks], nacc); } }
          if (l15 == 0) *(LAS f32x4*)(NV + 16 * w + 4 * kg) = nacc;
#pragma unroll
          for (int kp = 0; kp < 4; ++kp) { v4u a; a.x = cvtpk(Cacc[2 * kp].x, Cacc[2 * kp].y); a.y = cvtpk(Cacc[2 * kp].z, Cacc[2 * kp].w); a.z = cvtpk(Cacc[2 * kp + 1].x, Cacc[2 * kp + 1].y); a.w = cvtpk(Cacc[2 * kp + 1].z, Cacc[2 * kp + 1].w);
              Cfrag[kp] = __builtin_bit_cast(bf16x8v, a); } }
        if (c + 1 < 32) { LAS unsigned char* Nx = L + M2_IMG + ((c + 1) & 1) * 49152;
            *(LAS v4u*)(Nx + so0) = sq0; *(LAS v4u*)(Nx + so1) = sq1; *(LAS v4u*)(Nx + 16384 + so0) = sk0; *(LAS v4u*)(Nx + 16384 + so1) = sk1; *(LAS v4u*)(Nx + 32768 + so0) = sv0; *(LAS v4u*)(Nx + 32768 + so1) = sv1; }
        gi = gi_n; gf = gf_n;
        __syncthreads();
#pragma unroll
        for (int tb = 0; tb < 4; ++tb) { const int t = 16 * tb + l15; const LAS float* sp = SSQ + (c & 1) * 512 + t;
            const float tot = ((sp[0] + sp[64]) + (sp[128] + sp[192])) + ((sp[256] + sp[320]) + (sp[384] + sp[448]));
            const float rn = __frsqrt_rn(tot * (1.f / 128.f) + EPS);
            const float y0 = hv[tb].x * rn * gn.x * sigmoidf_(bflo(og[tb].x)), y1 = hv[tb].y * rn * gn.y * sigmoidf_(bfhi(og[tb].x)), y2 = hv[tb].z * rn * gn.z * sigmoidf_(bflo(og[tb].y)), y3 = hv[tb].w * rn * gn.w * sigmoidf_(bfhi(og[tb].y));
            v2u wv; wv.x = cvtpk(y0, y1); wv.y = cvtpk(y2, y3);
            *(v2u*)(Yp + (size_t)(t0 + t) * DM) = wv; }
    }
}

#ifndef MK_MULTI
#define MK_MULTI 0
#endif
constexpr int PH_PER_LAYER = 12, N_PHASES = 1 + DEPTH * PH_PER_LAYER;
struct Args { const float* in[16]; float* out; unsigned char* ws; int ph_lo, ph_hi; };
static_assert(sizeof(Args) == 16 * 8 + 8 + 8 + 8, "Args has no padding");

__global__ void __launch_bounds__(NWAVES * 64, 2) fwd_kernel(Args args) {
    extern __shared__ __attribute__((aligned(16))) unsigned char lds_raw[];
    LAS unsigned char* L = (LAS unsigned char*)lds_raw;
    const int G0 = gridDim.x, blk0 = blockIdx.x;
#define PH_IDS() PH_WS(); int tid = threadIdx.x; asm volatile("" : "+v"(tid)); const int lane = tid & 63, wave = __builtin_amdgcn_readfirstlane(tid >> 6), gw = blk * NWAVES + wave; (void)lane; (void)gw
#define PH_WS() unsigned char* ws = args.ws; asm volatile("" : "+s"(ws)); int blk = blk0, G = G0; asm volatile("" : "+s"(blk), "+s"(G)); const int NGW = G * NWAVES; (void)NGW; float* xres = args.out; bf16* U = (bf16*)(ws + WS_U); bf16* HB = (bf16*)(ws + WS_HB); bf16* HD = (bf16*)(ws + WS_HD); \
    unsigned char* wl = ws + WS_W + (size_t)l_ * W_LAYER; const float* ng = args.in[1] + (size_t)l_ * 6 * DM; (void)xres; (void)U; (void)HB; (void)HD; (void)wl; (void)ng
    unsigned char* ws0 = args.ws;
    volatile LAS unsigned* MISC = (volatile LAS unsigned*)(L + MISC_OFF);
    if (threadIdx.x < 16) MISC[threadIdx.x] = 0u;
    __syncthreads();
    XcdBarrier bar; bar.bar = (unsigned*)(ws0 + WS_CTL) + CW_BAR; bar.x = 0; bar.st = nullptr;
    if (!MK_MULTI) bar = xcd_barrier_post((unsigned*)(ws0 + WS_CTL) + CW_BAR, MISC + 8);
    const int lo = args.ph_lo, hi = args.ph_hi;
#define IN(k) (lo <= (k) && (k) < hi)
#define SEAM(k) do { if (IN(k) && IN((k) + 1)) xcd_barrier(bar); } while (0)

    if (IN(0)) {
        const int l_ = 0; PH_IDS();
        const float* x_in = args.in[0]; float* cosT = (float*)(ws + WS_TAB + TAB_COS); float* sinT = (float*)(ws + WS_TAB + TAB_SIN); float* b1T = (float*)(ws + WS_TAB + TAB_B1);
        LAS float* scr = (LAS float*)(L + wave * 16384);
        constexpr int I_GU = 16 * 176, I_DN = 44 * 32, I_IN = 16 * 112, I_OUT = 16 * 32, I_CMP = 16 * 16, I_LAYER = 2 * I_GU + 2 * I_DN + I_IN + I_OUT + I_CMP;
        for (int it = gw; it < DEPTH * I_LAYER; it += NGW) {
            const int l = it / I_LAYER; int r = it % I_LAYER; unsigned char* wl = ws + WS_W + (size_t)l * W_LAYER;
            if (r < I_GU) { SrcGU s{args.in[2] + (size_t)l * DM * NGU}; transpose_item(s, DM, (bf16*)(wl + WO_GU1), scr, r / 176, r % 176, lane); continue; } r -= I_GU;
            if (r < I_DN) { SrcPlain s{args.in[3] + (size_t)l * FF * DM, DM}; transpose_item(s, FF, (bf16*)(wl + WO_DN1), scr, r / 32, r % 32, lane); continue; } r -= I_DN;
            if (r < I_GU) { SrcGU s{args.in[4] + (size_t)l * DM * NGU}; transpose_item(s, DM, (bf16*)(wl + WO_GU2), scr, r / 176, r % 176, lane); continue; } r -= I_GU;
            if (r < I_DN) { SrcPlain s{args.in[5] + (size_t)l * FF * DM, DM}; transpose_item(s, FF, (bf16*)(wl + WO_DN2), scr, r / 32, r % 32, lane); continue; } r -= I_DN;
            if (r < I_IN) { SrcIN s{args.in[6] + (size_t)l * DM * INCOLS}; transpose_item(s, DM, (bf16*)(wl + WO_IN), scr, r / 112, r % 112, lane); continue; } r -= I_IN;
            if (r < I_OUT) { SrcPlain s{args.in[7] + (size_t)l * DM * DM, DM}; transpose_item(s, DM, (bf16*)(wl + WO_OUT), scr, r / 32, r % 32, lane); continue; } r -= I_OUT;
            { SrcCMP s{args.in[9] + (size_t)l * 2 * 2048 * 128}; transpose_item(s, DM, (bf16*)(wl + WO_CMP), scr, r / 16, r % 16, lane); }
        }
        for (int i = blk * 512 + tid; i < SEQ * 8; i += G * 512) { const int pos = i >> 3, k = i & 7;
            const double inv = pow(500000.0, -(double)k / 8.0), ang = (double)pos * inv; cosT[i] = (float)cos(ang); sinT[i] = (float)sin(ang); }
        for (int o = gw; o < DEPTH * 2 * 128; o += NGW) { const int lk = o >> 7, c = o & 127; const float* pe = args.in[8] + (size_t)lk * 2048; const float* w1 = args.in[9] + (size_t)lk * 2048 * 128;
            float s = 0.f; for (int r = lane; r < 2048; r += 64) s += pe[r] * w1[(size_t)r * 128 + c];
            s = wave_sum(s); if (lane == 0) b1T[o] = s; }
        thin_phase<0>(nullptr, x_in, xres, nullptr, 0.f, args.in[1] + 0 * DM, U, gw, NGW, lane);
    }
    SEAM(0);

#pragma unroll 1
    for (int l = 0; l < DEPTH; ++l) {
        const int pb = 1 + l * PH_PER_LAYER, l_ = l;
        if (IN(pb + 0)) { PH_WS(); pg8::Gemm g{U, (const bf16*)(wl + WO_GU1), MTOK, NGU, DM}; pg8::StaticOrder S; S.init(MTOK, NGU, G, blk); EpiSwiglu E{HB};
            pg8::gemm_phase<EpiSwiglu, pg8::StaticOrder, true, true>(L, g, S, E); }
        SEAM(pb + 0);
        if (IN(pb + 1)) { PH_WS(); pg8::Gemm g{HB, (const bf16*)(wl + WO_DN1), MTOK, DM, FF}; pg8::StaticOrder S; S.init(MTOK, DM, G, blk); pg8::EpiBf16<0> E{HD, DM, nullptr, 0, 0, 1.f};
            pg8::gemm_phase<pg8::EpiBf16<0>, pg8::StaticOrder, true, true>(L, g, S, E); }
        SEAM(pb + 1);
        if (IN(pb + 2)) { PH_IDS(); thin_phase<1>(HD, xres, xres, ng + 1 * DM, 0.5f, ng + 2 * DM, U, gw, NGW, lane); }
        SEAM(pb + 2);
        if (IN(pb + 3)) { PH_WS(); pg8::Gemm g{U, (const bf16*)(wl + WO_IN), MTOK, NINP, DM}; pg8::StaticOrder S; S.init(MTOK, NINP, G, blk);
            EpiInProj E{ws};
            pg8::gemm_phase<EpiInProj, pg8::StaticOrder, true, true>(L, g, S, E); }
        SEAM(pb + 3);
        if (IN(pb + 4)) { PH_WS(); pg8::Gemm g{(const bf16*)(ws + WS_KCR), (const bf16*)(wl + WO_CMP), 8192, 512, DM}; CmpOrder S{blk, G}; EpiPQ E{(float*)(ws + WS_PQ)};
            pg8::gemm_phase<EpiPQ, CmpOrder, false, true>(L, g, S, E);
            { const int nb = (G > 32) ? 32 : 0; if (blk >= nb) { int tid2 = threadIdx.x; asm volatile("" : "+v"(tid2)); mlstm_conv_pass(ws, args.in[11] + (size_t)l_ * 4 * 1024, args.in[12] + (size_t)l_ * 1024, (blk - nb) * 512 + tid2, (G - nb) * 512); } } }
        SEAM(pb + 4);
        if (IN(pb + 5)) {
            PH_IDS();
            const float* b1T = (const float*)(ws + WS_TAB + TAB_B1); const float* PQ = (const float*)(ws + WS_PQ); bf16* CC = (bf16*)(ws + WS_CC); LAS float* hs = (LAS float*)(L + wave * 1024);
            for (int r = gw; r < 2 * 32 * 128; r += NGW) {
                const int kv = r >> 12, bgn = r & 4095, n = bgn & 127;
                if (n == 127) { CC[(size_t)r * 64 + lane] = 0; continue; }
                const float* w2 = args.in[10] + (size_t)(l * 2 + kv) * 128 * 64; const float* b1 = b1T + (l * 2 + kv) * 128;
#pragma unroll
                for (int q2 = 0; q2 < 2; ++q2) { const int c = lane + 64 * q2; const float v = PQ[(size_t)r * 256 + c] + PQ[(size_t)(r + 1) * 256 + 128 + c] + b1[c];
                    const float u3 = 0.7978845608028654f * (v + 0.044715f * v * v * v); hs[c] = 0.5f * v * (1.f + tanhf(u3)); }
                LDS_WAIT(); asm volatile("" ::: "memory");
                float o = 0.f;
#pragma unroll 8
                for (int c = 0; c < 128; ++c) o += hs[c] * w2[c * 64 + lane];
                CC[(size_t)r * 64 + lane] = (bf16)f2bf(o);
                LDS_WAIT(); asm volatile("" ::: "memory");
            }
        }
        SEAM(pb + 5);
        if (IN(pb + 6)) {
            PH_WS();
            MixPtrs P{ws, args.in[11] + (size_t)l * 4 * 1024, args.in[12] + (size_t)l * 1024, args.in[13] + l * 4, args.in[14] + l * 4, args.in[15] + l * 512};
            const int nml = (G > 64) ? 64 : 0;
            if (blk < nml) mlstm_unit_mfma(L, P, blk >> 2, blk & 3);
            else { for (int u = blk - nml; u < 1024; u += G - nml) { const int c = 31 - (u >> 5), bg = u & 31; nsa_unit_mfma(L, P, bg >> 1, bg & 1, c); } }
            if (nml == 0) { for (int u = blk; u < 64; u += G) mlstm_unit_mfma(L, P, u >> 2, u & 3); }
        }
        SEAM(pb + 6);
        if (IN(pb + 7)) { PH_WS(); pg8::Gemm g{U, (const bf16*)(wl + WO_OUT), MTOK, DM, DM}; pg8::StaticOrder S; S.init(MTOK, DM, G, blk); pg8::EpiBf16<0> E{HD, DM, nullptr, 0, 0, 1.f};
            pg8::gemm_phase<pg8::EpiBf16<0>, pg8::StaticOrder, true, true>(L, g, S, E); }
        SEAM(pb + 7);
        if (IN(pb + 8)) { PH_IDS(); thin_phase<1>(HD, xres, xres, ng + 3 * DM, 1.0f, ng + 4 * DM, U, gw, NGW, lane); }
        SEAM(pb + 8);
        if (IN(pb + 9)) { PH_WS(); pg8::Gemm g{U, (const bf16*)(wl + WO_GU2), MTOK, NGU, DM}; pg8::StaticOrder S; S.init(MTOK, NGU, G, blk); EpiSwiglu E{HB};
            pg8::gemm_phase<EpiSwiglu, pg8::StaticOrder, true, true>(L, g, S, E); }
        SEAM(pb + 9);
        if (IN(pb + 10)) { PH_WS(); pg8::Gemm g{HB, (const bf16*)(wl + WO_DN2), MTOK, DM, FF}; pg8::StaticOrder S; S.init(MTOK, DM, G, blk); pg8::EpiBf16<0> E{HD, DM, nullptr, 0, 0, 1.f};
            pg8::gemm_phase<pg8::EpiBf16<0>, pg8::StaticOrder, true, true>(L, g, S, E); }
        SEAM(pb + 10);
        if (IN(pb + 11)) { PH_IDS(); if (l + 1 < DEPTH) thin_phase<1>(HD, xres, xres, ng + 5 * DM, 0.5f, ng + 6 * DM, U, gw, NGW, lane);
                           else thin_phase<2>(HD, xres, xres, ng + 5 * DM, 0.5f, nullptr, nullptr, gw, NGW, lane); }
        if (l + 1 < DEPTH) SEAM(pb + 11);
    }
#undef IN
#undef SEAM
#undef PH_IDS
#undef PH_WS
}

extern "C" void kernel_launch(void* const* d_in, const int* in_sizes, int n_in, void* d_out, int out_size, void* d_ws, size_t ws_size, hipStream_t stream) {
    static int grid = 0;
    if (grid == 0) {
        if (n_in != 16 || in_sizes[0] != MTOK * DM || out_size != MTOK * DM || ws_size < WS_END2) { fprintf(stderr, "kernel_launch: unexpected problem (n_in %d, ws %zu)\n", n_in, ws_size); grid = -1; return; }
        int dev = 0, cus = 0, per_cu = 0;
        if (hipGetDevice(&dev) != hipSuccess || hipDeviceGetAttribute(&cus, hipDeviceAttributeMultiprocessorCount, dev) != hipSuccess) { grid = -1; return; }
        if (hipFuncSetAttribute((const void*)fwd_kernel, hipFuncAttributeMaxDynamicSharedMemorySize, LDS_BYTES) != hipSuccess) { grid = -1; return; }
        if (hipOccupancyMaxActiveBlocksPerMultiprocessor(&per_cu, (const void*)fwd_kernel, NWAVES * 64, LDS_BYTES) != hipSuccess || per_cu < 1) { fprintf(stderr, "kernel_launch: occupancy query says %d\n", per_cu); }
        (void)hipGetLastError();
        grid = cus;
    }
    if (grid < 0) return;
    (void)hipMemsetAsync((char*)d_ws + WS_CTL, 0, CTL_ZERO_BYTES, stream);
    Args a{};
    for (int i = 0; i < 16; ++i) a.in[i] = (const float*)d_in[i];
    a.out = (float*)d_out; a.ws = (unsigned char*)d_ws;
#if MK_MULTI
    for (int p = 0; p < N_PHASES; ++p) { a.ph_lo = p; a.ph_hi = p + 1; hipLaunchKernelGGL(fwd_kernel, dim3(grid), dim3(NWAVES * 64), LDS_BYTES, stream, a); }
#else
    a.ph_lo = 0; a.ph_hi = N_PHASES; hipLaunchKernelGGL(fwd_kernel, dim3(grid), dim3(NWAVES * 64), LDS_BYTES, stream, a);
#endif
}
```

```cpp
#include <hip/hip_runtime.h>
#include <cstdio>
#include <cstdint>
namespace pg8 {
#define PG8_LAS __attribute__((address_space(3)))
typedef unsigned short bf16_t;
typedef short bf16x8 __attribute__((ext_vector_type(8)));
typedef float f32x4 __attribute__((ext_vector_type(4)));
typedef unsigned u32x4 __attribute__((ext_vector_type(4)));
constexpr int BM = 256, BK = 64, HALF = 128, HTB = HALF * BK * 2  , STAGE_BYTES = 8 * HTB, NXCD = 8, WGM = 8;

__host__ __device__ __forceinline__ int lds_byte(int r, int c) { const int st = (r >> 4) * 2 + (c >> 5), rr = r & 15, cc = c & 31, ob = rr * 64 + cc * 2; return st * 1024 + (ob ^ (((ob >> 9) & 1) << 5)); }
__host__ __device__ __forceinline__ void stage_rc(int b, int& R, int& C) { const int st = b / 1024, sb = b % 1024, swz = sb ^ (((sb >> 9) & 1) << 5); R = (st >> 1) * 16 + swz / 64; C = (st & 1) * 32 + (swz % 64) / 2; }
__host__ __device__ __forceinline__ int perm32(int rho) { const int n = rho >> 4, i = rho & 15; return 8 * (i >> 2) + 4 * n + (i & 3); }

struct Unit { int pm, pn; };
struct Gemm { const bf16_t* A; const bf16_t* Bt; int M, N, K; };

struct StaticOrder {
    int nM, nN, nwg, G, c;
    __host__ __device__ void init(int M, int N, int G_, int c_) { nM = M / BM; nN = N / BM; nwg = nM * nN; G = G_; c = c_; }
    __host__ __device__ bool next(int i, Unit& u) const {
        const long L = (long)i * G + c; if (L >= nwg) return false;
        int wgid = (int)L; { const int q = nwg / NXCD, r = nwg % NXCD, xcd = wgid % NXCD, off = wgid / NXCD; wgid = (xcd < r ? xcd * (q + 1) : r * (q + 1) + (xcd - r) * q) + off; }
        const int nig = WGM * nN, gid = wgid / nig, fm = gid * WGM, gsz = (nM - fm) < WGM ? (nM - fm) : WGM;
        u.pm = fm + ((wgid % nig) % gsz); u.pn = (wgid % nig) / gsz; return true;
    }
    __device__ __forceinline__ void a_ready(const Unit&) const {}
    __device__ __forceinline__ void done(const Unit&) const {}
};

__device__ __forceinline__ unsigned cvt_pk_bf16(float lo, float hi) { unsigned r; asm volatile("v_cvt_pk_bf16_f32 %0, %1, %2" : "=v"(r) : "v"(lo), "v"(hi)); return r; }
typedef float f32x2 __attribute__((ext_vector_type(2)));
__device__ __forceinline__ f32x2 gelu_pk(f32x2 v) {
    const f32x2 av = __builtin_elementwise_abs(v), d = av * 0.2316418882f + 1.0f;
    f32x2 t; t.x = __builtin_amdgcn_rcpf(d.x); t.y = __builtin_amdgcn_rcpf(d.y);
    f32x2 q = t * 0.5307027145f + (-0.7265760135f); q = q * t + 0.7107068705f; q = q * t + (-0.142248368f); q = q * t + 0.127414796f; q = q * t;
    const f32x2 s = (v * v) * (-0.72134752044f);
    f32x2 e; e.x = __builtin_amdgcn_exp2f(s.x); e.y = __builtin_amdgcn_exp2f(s.y);
    const f32x2 m = v * (q * e), r = v - m;
    f32x2 o; o.x = v.x < 0.f ? m.x : r.x; o.y = v.y < 0.f ? m.y : r.y; return o;
}

template <int ACT  > struct EpiBf16 {
    static constexpr bool PERM = true, AFTER_DRAIN = false; static_assert(ACT == 0 || ACT == 1, "EpiBf16: ACT is 0 (none) or 1 (gelu_pk)");
    bf16_t* O; int ldc; const float* bias; int split_cols; size_t split_stride; float scale0;
    __device__ __forceinline__ void operator()(const f32x4 (&acc)[2][2][4][2], const Unit& u, int wr, int wc, int fr, int fq) const {
        const int row0 = u.pm * BM + wr * 64 + fr; int colt = u.pn * BM; bf16_t* base = O;
        float sc = 1.f; if (split_cols) { const int t = colt / split_cols; base += (size_t)t * split_stride; colt -= t * split_cols; if (t == 0) sc = scale0; }
        const int col0 = colt + wc * 32 + 8 * fq, bcol0 = u.pn * BM + wc * 32 + 8 * fq;
        f32x4 bv[2][2];
#pragma unroll
        for (int bj = 0; bj < 2; ++bj)
#pragma unroll
            for (int n = 0; n < 2; ++n) bv[bj][n] = bias ? *(const f32x4*)(bias + bcol0 + bj * HALF + 4 * n) : (f32x4){0.f, 0.f, 0.f, 0.f};
#pragma unroll
        for (int ai = 0; ai < 2; ++ai)
#pragma unroll
            for (int m = 0; m < 4; ++m) { bf16_t* rowp = base + (size_t)(row0 + ai * HALF + m * 16) * ldc + col0;
#pragma unroll
                for (int bj = 0; bj < 2; ++bj) { f32x4 v0 = acc[ai][bj][m][0] + bv[bj][0], v1 = acc[ai][bj][m][1] + bv[bj][1];
                    if (ACT == 1) { f32x2 a = gelu_pk((f32x2){v0[0], v0[1]}), b = gelu_pk((f32x2){v0[2], v0[3]}), c = gelu_pk((f32x2){v1[0], v1[1]}), d = gelu_pk((f32x2){v1[2], v1[3]});
                        v0 = (f32x4){a.x, a.y, b.x, b.y}; v1 = (f32x4){c.x, c.y, d.x, d.y}; }
                    v0 = v0 * sc; v1 = v1 * sc; u32x4 w; w.x = cvt_pk_bf16(v0[0], v0[1]); w.y = cvt_pk_bf16(v0[2], v0[3]); w.z = cvt_pk_bf16(v1[0], v1[1]); w.w = cvt_pk_bf16(v1[2], v1[3]);
                    *(u32x4*)(rowp + bj * HALF) = w; } }
    }
};
template <class Epi, class Sched, bool ALIGN_EPI = false, bool SP2 = false>
__device__ __forceinline__ void gemm_phase(PG8_LAS unsigned char* lds, const Gemm g, const Sched& S, const Epi& E, int tid_in) {
    int tid_l = tid_in; asm volatile("" : "+v"(tid_l));
    const int tid = tid_l, wid = __builtin_amdgcn_readfirstlane(tid >> 6), lane = tid & 63, wr = wid >> 2, wc = wid & 3, fr = lane & 15, fq = lane >> 4;
    const int K = g.K, nt = K / BK;
    unsigned voffA[2], voffB[2];
#pragma unroll
    for (int i = 0; i < 2; ++i) { int R, C; stage_rc(tid * 16 + i * 8192, R, C); const int Rb = Epi::PERM ? ((R & ~31) + perm32(R & 31)) : R;
        voffA[i] = (unsigned)(R * K + C) * 2u; voffB[i] = (unsigned)(Rb * K + C) * 2u; }
    const size_t kstep = (size_t)(BK * 2);
    const size_t hstep = (size_t)HALF * K * 2;
    const size_t tstep = 2 * hstep;
    const unsigned ldsw = (unsigned)wid * 1024u;
    const int aoff = lds_byte(wr * 64 + fr, fq * 8), boff = lds_byte(wc * 32 + fr, fq * 8);
#define PG8_SA(b, h) (((b) * 2 + (h)) * HTB)
#define PG8_SB(b, h) ((4 + (b) * 2 + (h)) * HTB)
#define PG8_STAGE(bufoff, gbase, voff) do { _Pragma("unroll") for (int _i = 0; _i < 2; ++_i) \
        __builtin_amdgcn_global_load_lds((const unsigned*)((const char*)(gbase) + (voff)[_i]), (PG8_LAS unsigned*)(lds + (bufoff) + ldsw + _i * 8192), 16, 0, 0); } while (0)
#define PG8_LDA(dst, b, h) do { _Pragma("unroll") for (int m = 0; m < 4; ++m) _Pragma("unroll") for (int k = 0; k < 2; ++k) dst[m][k] = *(const PG8_LAS bf16x8*)(lds + PG8_SA(b, h) + aoff + m * 2048 + k * 1024); } while (0)
#define PG8_LDB(dst, b, h) do { _Pragma("unroll") for (int n = 0; n < 2; ++n) _Pragma("unroll") for (int k = 0; k < 2; ++k) dst[n][k] = *(const PG8_LAS bf16x8*)(lds + PG8_SB(b, h) + boff + n * 2048 + k * 1024); } while (0)
#define PG8_MMA(ai, bj, At, Bt) do { __builtin_amdgcn_s_setprio(1); _Pragma("unroll") for (int m = 0; m < 4; ++m) _Pragma("unroll") for (int n = 0; n < 2; ++n) _Pragma("unroll") for (int k = 0; k < 2; ++k) \
        acc[ai][bj][m][n] = __builtin_amdgcn_mfma_f32_16x16x32_bf16(Bt[n][k], At[m][k], acc[ai][bj][m][n], 0, 0, 0); __builtin_amdgcn_s_setprio(0); } while (0)
#define PG8_WAIT_V(n) asm volatile("s_waitcnt vmcnt(" #n ")" ::: "memory")
#define PG8_WAIT_L(n) asm volatile("s_waitcnt lgkmcnt(" #n ")" ::: "memory")
#define PG8_BAR __builtin_amdgcn_s_barrier()
#define PG8_SCHED __builtin_amdgcn_sched_barrier(0)
    Unit cur, nxt; int ui = 0;
    if (!S.next(0, cur)) return;
    f32x4 acc[2][2][4][2];
#pragma unroll
    for (int a = 0; a < 2; ++a)
#pragma unroll
        for (int b = 0; b < 2; ++b)
#pragma unroll
            for (int m = 0; m < 4; ++m)
#pragma unroll
                for (int n = 0; n < 2; ++n) acc[a][b][m][n] = (f32x4){0.f, 0.f, 0.f, 0.f};
    bf16x8 At[4][2], B0[2][2], B1[2][2];
    const char* cA = (const char*)g.A + (size_t)cur.pm * tstep; const char* cB = (const char*)g.Bt + (size_t)cur.pn * tstep;
    S.a_ready(cur);
    if constexpr (SP2) {
        PG8_STAGE(PG8_SB(0, 0), cB, voffB); PG8_STAGE(PG8_SB(0, 1), cB + hstep, voffB); PG8_STAGE(PG8_SA(0, 0), cA, voffA); PG8_STAGE(PG8_SA(0, 1), cA + hstep, voffA);
        if (wr == 1) PG8_BAR;
        PG8_WAIT_V(2); PG8_BAR;
        PG8_STAGE(PG8_SB(1, 0), cB + kstep, voffB); PG8_STAGE(PG8_SA(1, 0), cA + kstep, voffA); PG8_STAGE(PG8_SB(1, 1), cB + hstep + kstep, voffB);
        PG8_WAIT_V(6); PG8_BAR;
    } else {
        PG8_STAGE(PG8_SB(0, 0), cB, voffB); PG8_STAGE(PG8_SA(0, 0), cA, voffA); PG8_STAGE(PG8_SB(0, 1), cB + hstep, voffB); PG8_STAGE(PG8_SA(0, 1), cA + hstep, voffA);
        if (wr == 1) PG8_BAR;
        PG8_WAIT_V(4); PG8_BAR;
        PG8_STAGE(PG8_SB(1, 0), cB + kstep, voffB); PG8_STAGE(PG8_SA(1, 0), cA + kstep, voffA); PG8_STAGE(PG8_SB(1, 1), cB + hstep + kstep, voffB);
        PG8_WAIT_V(6); PG8_BAR;
    }
    for (;;) {
        const bool has_next = S.next(ui + 1, nxt);
        const char* nA = has_next ? (const char*)g.A + (size_t)nxt.pm * tstep : cA; const char* nB = has_next ? (const char*)g.Bt + (size_t)nxt.pn * tstep : cB;
        for (int t = 0; t < nt; t += 2) {
            const bool last = (t == nt - 2);
            const char* a1 = cA + (size_t)(t + 1) * kstep;
            const char* a2 = last ? nA : cA + (size_t)(t + 2) * kstep; const char* b2 = last ? nB : cB + (size_t)(t + 2) * kstep;
            const char* a3 = a2 + kstep; const char* b3 = b2 + kstep;
            if (last && has_next) S.a_ready(nxt);
            if constexpr (SP2) {
            PG8_LDB(B0, 0, 0); PG8_LDB(B1, 0, 1); PG8_SCHED; PG8_LDA(At, 0, 0); PG8_STAGE(PG8_SA(1, 1), a1 + hstep, voffA);
            PG8_WAIT_V(8); PG8_WAIT_L(0); PG8_BAR; PG8_MMA(0, 0, At, B0); PG8_MMA(0, 1, At, B1); PG8_BAR; PG8_SCHED;
            PG8_LDA(At, 0, 1); PG8_STAGE(PG8_SB(0, 0), b2, voffB); PG8_STAGE(PG8_SB(0, 1), b2 + hstep, voffB); PG8_STAGE(PG8_SA(0, 0), a2, voffA);
            PG8_WAIT_V(8); PG8_WAIT_L(0); PG8_BAR; PG8_MMA(1, 0, At, B0); PG8_MMA(1, 1, At, B1); PG8_BAR; PG8_SCHED;
            PG8_LDB(B0, 1, 0); PG8_LDB(B1, 1, 1); PG8_SCHED; PG8_LDA(At, 1, 0); PG8_STAGE(PG8_SA(0, 1), a2 + hstep, voffA);
            PG8_WAIT_V(8); PG8_WAIT_L(0); PG8_BAR; PG8_MMA(0, 0, At, B0); PG8_MMA(0, 1, At, B1); PG8_BAR; PG8_SCHED;
            PG8_LDA(At, 1, 1); PG8_STAGE(PG8_SB(1, 0), b3, voffB); PG8_STAGE(PG8_SB(1, 1), b3 + hstep, voffB); PG8_STAGE(PG8_SA(1, 0), a3, voffA);
            PG8_WAIT_V(8); PG8_WAIT_L(0); PG8_BAR; PG8_MMA(1, 0, At, B0); PG8_MMA(1, 1, At, B1); PG8_BAR; PG8_SCHED;
            } else {
            PG8_LDB(B0, 0, 0); PG8_SCHED; PG8_LDA(At, 0, 0); PG8_STAGE(PG8_SA(1, 1), a1 + hstep, voffA);
            PG8_WAIT_L(8); PG8_BAR; PG8_WAIT_L(0); PG8_MMA(0, 0, At, B0); PG8_BAR; PG8_SCHED;
            PG8_LDB(B1, 0, 1); PG8_STAGE(PG8_SB(0, 0), b2, voffB);
            PG8_BAR; PG8_WAIT_L(0); PG8_MMA(0, 1, At, B1); PG8_BAR;
            PG8_LDA(At, 0, 1); PG8_STAGE(PG8_SA(0, 0), a2, voffA);
            PG8_BAR; PG8_WAIT_L(0); PG8_MMA(1, 0, At, B0); PG8_BAR; PG8_SCHED;
            PG8_STAGE(PG8_SB(0, 1), b2 + hstep, voffB);
            PG8_WAIT_V(6); PG8_BAR; PG8_MMA(1, 1, At, B1); PG8_BAR;
            PG8_LDB(B0, 1, 0); PG8_SCHED; PG8_LDA(At, 1, 0); PG8_STAGE(PG8_SA(0, 1), a2 + hstep, voffA);
            PG8_WAIT_L(8); PG8_BAR; PG8_WAIT_L(0); PG8_MMA(0, 0, At, B0); PG8_BAR; PG8_SCHED;
            PG8_LDB(B1, 1, 1); PG8_STAGE(PG8_SB(1, 0), b3, voffB);
            PG8_BAR; PG8_WAIT_L(0); PG8_MMA(0, 1, At, B1); PG8_BAR;
            PG8_LDA(At, 1, 1); PG8_STAGE(PG8_SA(1, 0), a3, voffA);
            PG8_BAR; PG8_WAIT_L(0); PG8_MMA(1, 0, At, B0); PG8_BAR; PG8_SCHED;
            PG8_STAGE(PG8_SB(1, 1), b3 + hstep, voffB);
            PG8_WAIT_V(6); PG8_BAR; PG8_MMA(1, 1, At, B1); PG8_BAR;
            }
        }
        if constexpr (ALIGN_EPI) { if (wr == 0) PG8_BAR; }
        if constexpr (!Epi::AFTER_DRAIN) { E(acc, cur, wr, wc, fr, fq); S.done(cur); }
        if (!has_next) break;
#pragma unroll
        for (int a = 0; a < 2; ++a)
#pragma unroll
            for (int b = 0; b < 2; ++b)
#pragma unroll
                for (int m = 0; m < 4; ++m)
#pragma unroll
                    for (int n = 0; n < 2; ++n) acc[a][b][m][n] = (f32x4){0.f, 0.f, 0.f, 0.f};
        cur = nxt; cA = nA; cB = nB; ++ui;
        if constexpr (ALIGN_EPI) { if (wr == 1) PG8_BAR; }
    }
    PG8_WAIT_V(0);
    if constexpr (!ALIGN_EPI) { if (wr == 0) PG8_BAR; }
    PG8_BAR;
    if constexpr (Epi::AFTER_DRAIN) { E.fused(acc, cur, wr, wc, fr, fq, lds, wid, lane); S.done(cur); }
#undef PG8_SA
#undef PG8_SB
#undef PG8_STAGE
#undef PG8_LDA
#undef PG8_LDB
#undef PG8_MMA
#undef PG8_WAIT_V
#undef PG8_WAIT_L
#undef PG8_BAR
#undef PG8_SCHED
}
}

#define LAS __attribute__((address_space(3)))
#define XB_TMO      128
#define XB_XCNT(j)  (256  + 64 * (j))
#define XB_XSUB(j)  (1280 + 64 * (j))
#define XB_XGEN(j)  (2304 + 64 * (j))
#define XB_TOP      3328
#define XB_TOPGEN   3392
#define XCD_BAR_WORDS 3456
#define XB_SPIN_CAP (1u << 18)

__device__ __forceinline__ unsigned xb_ld(unsigned* p)              { return __hip_atomic_load(p, __ATOMIC_RELAXED, __HIP_MEMORY_SCOPE_AGENT); }
__device__ __forceinline__ unsigned xb_add(unsigned* p, unsigned v) { return __hip_atomic_fetch_add(p, v, __ATOMIC_RELAXED, __HIP_MEMORY_SCOPE_AGENT); }
__device__ __forceinline__ unsigned xb_xcc_id() { return (unsigned)__builtin_amdgcn_s_getreg((3 << 11) | 20) & 0xFu; }
#define XB_SPIN(cond, bar) do { unsigned _sp = 0; while (cond) { __builtin_amdgcn_s_sleep(1); \
    if ((++_sp & 255u) == 0u) { if (xb_ld(&(bar)[XB_TMO])) break; if (_sp > XB_SPIN_CAP) { atomicAdd(&(bar)[XB_TMO], 1u); break; } } } } while (0)

struct XcdBarrier {
    unsigned* bar; unsigned x;
    volatile LAS unsigned* st;
};

__device__ __forceinline__ XcdBarrier xcd_barrier_post(unsigned* bar, volatile LAS unsigned* st, bool leader) {
    XcdBarrier b; b.bar = bar; b.x = xb_xcc_id(); b.st = st;
    if (leader) (void)xb_add(&bar[XB_XCNT(b.x)], 1u);
    return b;
}
__device__ __forceinline__ void xcd_barrier_complete(unsigned* bar, unsigned x, unsigned& nloc, unsigned& nx) {
    const unsigned G = gridDim.x * gridDim.y * gridDim.z;
    unsigned sum, cnt, mine, sp = 0u;
    for (;;) {
        sum = 0u; cnt = 0u; mine = 0u;
#pragma unroll
        for (unsigned j = 0; j < 16; ++j) { const unsigned c = xb_ld(&bar[XB_XCNT(j)]); sum += c; cnt += (c > 0u) ? 1u : 0u; mine = (j == x) ? c : mine; }
        if (sum == G) break;
        __builtin_amdgcn_s_sleep(1);
        if ((++sp & 255u) == 0u) { if (xb_ld(&bar[XB_TMO])) break; if (sp > XB_SPIN_CAP) { atomicAdd(&bar[XB_TMO], 1u); break; } }
    }
    nloc = mine > 0u ? mine : 1u; nx = cnt > 0u ? cnt : 1u;
}

__device__ __forceinline__ void xcd_barrier(const XcdBarrier& b, bool leader) {
    asm volatile("s_waitcnt vmcnt(0)" ::: "memory");
    __syncthreads();
    if (leader) {
        unsigned* bar = b.bar;
        __builtin_amdgcn_s_waitcnt(0);
        unsigned nloc = b.st[0], nx = b.st[1];
        if (nloc == 0u) { xcd_barrier_complete(bar, b.x, nloc, nx); b.st[0] = nloc; b.st[1] = nx; }
        const unsigned old = xb_add(&bar[XB_XSUB(b.x)], 1u);
        const unsigned gen = old / nloc;
        if (old + 1u == (gen + 1u) * nloc) {
            __builtin_amdgcn_fence(__ATOMIC_RELEASE, "agent");
            asm volatile("s_waitcnt vmcnt(0)" ::: "memory");
            const unsigned og = xb_add(&bar[XB_TOP], 1u);
            const unsigned tg = og / nx;
            if (og + 1u == (tg + 1u) * nx) xb_add(&bar[XB_TOPGEN], 1u);
            else XB_SPIN(xb_ld(&bar[XB_TOPGEN]) == tg, bar);
            __builtin_amdgcn_fence(__ATOMIC_ACQUIRE, "agent");
            xb_add(&bar[XB_XGEN(b.x)], 1u);
            asm volatile("s_waitcnt vmcnt(0)" ::: "memory");
        } else {
            XB_SPIN(xb_ld(&bar[XB_XGEN(b.x)]) == gen, bar);
            __builtin_amdgcn_fence(__ATOMIC_ACQUIRE, "agent");
            asm volatile("s_waitcnt vmcnt(0)" ::: "memory");
        }
    }
    __syncthreads();
}

constexpr int BATCH = 16, SEQ = 2048, DM = 1024, MTOK = BATCH * SEQ, FF = 2816, NGU = 2 * FF, NINP = 3584, INCOLS = 3360, DEPTH = 2;
constexpr int NWAVES = 8;
constexpr float EPS = 1e-6f;
typedef unsigned short bf16;
typedef unsigned v4u __attribute__((ext_vector_type(4)));
typedef unsigned v2u __attribute__((ext_vector_type(2)));
typedef float f32x4 __attribute__((ext_vector_type(4)));
#define LDS_WAIT() asm volatile("s_waitcnt lgkmcnt(0)" ::: "memory")

constexpr size_t MiB = 1u << 20;
constexpr size_t WS_CTL = 0, CTL_ZERO_BYTES = MiB;
constexpr size_t WS_TAB = 1 * MiB;
constexpr size_t TAB_COS = 0, TAB_SIN = 65536, TAB_B1 = 131072;
constexpr size_t WS_W = 2 * MiB, W_LAYER = 43 * MiB;
constexpr size_t WO_GU1 = 0, WO_DN1 = 11 * MiB, WO_GU2 = 16 * MiB + MiB / 2, WO_DN2 = 27 * MiB + MiB / 2, WO_IN = 33 * MiB, WO_OUT = 40 * MiB, WO_CMP = 42 * MiB;
constexpr size_t WS_U = 88 * MiB;
constexpr size_t WS_HB = 152 * MiB;
constexpr size_t WS_HD = 328 * MiB;
constexpr size_t WS_PQ = 392 * MiB;
constexpr size_t WS_CC = 400 * MiB;
constexpr size_t WS_END = 401 * MiB;
constexpr size_t WS_QN = 152 * MiB, WS_KCR = 184 * MiB, WS_VCR = 192 * MiB, WS_KS = 200 * MiB, WS_VS = 208 * MiB, WS_KW = 216 * MiB, WS_VW = 224 * MiB;
constexpr size_t WS_MQ = 232 * MiB, WS_MK = 264 * MiB, WS_MV = 296 * MiB, WS_MO = 328 * MiB, WS_GATE = 360 * MiB;
static_assert(WS_GATE + 4 * MiB <= WS_PQ, "in-projection outputs end below PQ");
constexpr int CW_BAR = 4096, CW_QUEUE = 16384;
constexpr int PH_BYTES = 143360, MISC_OFF = PH_BYTES, LDS_BYTES = 147456;

__device__ __forceinline__ unsigned f2bf(float f) { unsigned u = __builtin_bit_cast(unsigned, f); return (u + 0x7fffu + ((u >> 16) & 1u)) >> 16; }
__device__ __forceinline__ unsigned pk2(float lo, float hi) { return f2bf(lo) | (f2bf(hi) << 16); }
typedef float f32x2v_ __attribute__((ext_vector_type(2))); typedef __bf16 bf16x2v_ __attribute__((ext_vector_type(2)));
__device__ __forceinline__ unsigned cvtpk(float lo, float hi) { f32x2v_ v = {lo, hi}; bf16x2v_ b = __builtin_convertvector(v, bf16x2v_); return __builtin_bit_cast(unsigned, b); }
__device__ __forceinline__ float bflo(unsigned u) { return __builtin_bit_cast(float, u << 16); }
__device__ __forceinline__ float bfhi(unsigned u) { return __builtin_bit_cast(float, u & 0xffff0000u); }
__device__ __forceinline__ float bf2f(bf16 b) { return __builtin_bit_cast(float, (unsigned)b << 16); }
__device__ __forceinline__ float sigmoidf_(float x) { return __builtin_amdgcn_rcpf(1.f + __expf(-x)); }
__device__ __forceinline__ int fresh_lane() { unsigned z = 0u; asm volatile("" : "+v"(z)); return (int)__builtin_amdgcn_mbcnt_hi(~0u, __builtin_amdgcn_mbcnt_lo(~0u, z)); }
__device__ __forceinline__ float shx(float v, int mask, int lane) { return __builtin_bit_cast(float, __builtin_amdgcn_ds_bpermute((lane ^ mask) << 2, __builtin_bit_cast(int, v))); }
__device__ __forceinline__ unsigned shxu(unsigned v, int mask, int lane) { return (unsigned)__builtin_amdgcn_ds_bpermute((lane ^ mask) << 2, (int)v); }
__device__ __forceinline__ float shi(float v, int src) { return __builtin_bit_cast(float, __builtin_amdgcn_ds_bpermute(src << 2, __builtin_bit_cast(int, v))); }
__device__ __forceinline__ float wave_sum(float v, int lane) {
#pragma unroll
    for (int o = 1; o < 64; o <<= 1) v += shx(v, o, lane);
    return v;
}

struct SrcGU { const float* W; __device__ __forceinline__ float operator()(int k, int nd) const { const int pn = nd >> 8, r = nd & 255; const int col = (r < 128) ? (pn * 128 + r) : (FF + pn * 128 + r - 128); return W[(size_t)k * NGU + col]; } };
struct SrcPlain { const float* W; int N; __device__ __forceinline__ float operator()(int k, int nd) const { return W[(size_t)k * N + nd]; } };
struct SrcIN { const float* W; __device__ __forceinline__ float operator()(int k, int nd) const {
    const int col = nd < 1280 ? nd : (nd < 3328 ? nd + 24 : (nd < 3352 ? nd - 3328 + 1280 : (nd < 3360 ? nd : -1)));
    return col < 0 ? 0.f : W[(size_t)k * INCOLS + col]; } };
struct SrcCMP { const float* W1; __device__ __forceinline__ float operator()(int k, int nd) const { const int kv = nd >> 8, r = nd & 255;
    return r < 128 ? W1[((size_t)kv * 2048 + k) * 128 + r] : W1[((size_t)kv * 2048 + 1024 + k) * 128 + r - 128]; } };

template <class SrcF>
__device__ __forceinline__ void transpose_item(const SrcF& src, int K, bf16* WT, LAS float* scr, int kb, int nb, int lane) {
    const int k0 = 64 * kb, n0 = 32 * nb;
#pragma unroll 8
    for (int i = 0; i < 32; ++i) { const int kk = 2 * i + (lane >> 5); scr[kk * 33 + (lane & 31)] = src(k0 + kk, n0 + (lane & 31)); }
    LDS_WAIT(); asm volatile("" ::: "memory");
    const int c = lane & 7;
#pragma unroll
    for (int j = 0; j < 4; ++j) { const int n = (lane >> 3) + 8 * j; const LAS float* s = scr + (8 * c) * 33 + n;
        v4u o; o.x = pk2(s[0 * 33], s[1 * 33]); o.y = pk2(s[2 * 33], s[3 * 33]); o.z = pk2(s[4 * 33], s[5 * 33]); o.w = pk2(s[6 * 33], s[7 * 33]);
        *(v4u*)(WT + (size_t)(n0 + n) * K + k0 + 8 * c) = o; }
    LDS_WAIT(); asm volatile("" ::: "memory");
}

template <int MODE>
__device__ __forceinline__ void thin_phase(const bf16* HD, const float* xin, float* xout, const float* gpost, float cc, const float* gpre, bf16* U, int gw, int NGW, int lane) {
    f32x4 gp[4], gq[4];
#pragma unroll
    for (int j = 0; j < 4; ++j) { gp[j] = (MODE == 1 || MODE == 2) ? *(const f32x4*)(gpost + 4 * lane + 256 * j) : (f32x4){0.f, 0.f, 0.f, 0.f};
                                  gq[j] = (MODE != 2) ? *(const f32x4*)(gpre + 4 * lane + 256 * j) : (f32x4){0.f, 0.f, 0.f, 0.f}; }
    f32x4 xn[4]; v2u hn[4];
    if (gw < MTOK) {
#pragma unroll
        for (int j = 0; j < 4; ++j) { xn[j] = *(const f32x4*)(xin + (size_t)gw * DM + 4 * lane + 256 * j); if (MODE == 1 || MODE == 2) hn[j] = *(const v2u*)(HD + (size_t)gw * DM + 4 * lane + 256 * j); }
    }
    for (int m = gw; m < MTOK; m += NGW) {
        f32x4 x[4]; v2u hw[4];
#pragma unroll
        for (int j = 0; j < 4; ++j) { x[j] = xn[j]; if (MODE == 1 || MODE == 2) hw[j] = hn[j]; }
        const int m2 = m + NGW;
        if (m2 < MTOK) {
#pragma unroll
            for (int j = 0; j < 4; ++j) { xn[j] = *(const f32x4*)(xin + (size_t)m2 * DM + 4 * lane + 256 * j); if (MODE == 1 || MODE == 2) hn[j] = *(const v2u*)(HD + (size_t)m2 * DM + 4 * lane + 256 * j); }
        }
        if (MODE == 1 || MODE == 2) {
            f32x4 h[4]; float ss = 0.f;
#pragma unroll
            for (int j = 0; j < 4; ++j) { h[j] = (f32x4){bflo(hw[j].x), bfhi(hw[j].x), bflo(hw[j].y), bfhi(hw[j].y)}; ss += (h[j].x * h[j].x + h[j].y * h[j].y) + (h[j].z * h[j].z + h[j].w * h[j].w); }
            const float r = cc * __frsqrt_rn(wave_sum(ss, lane) * (1.f / DM) + EPS);
#pragma unroll
            for (int j = 0; j < 4; ++j) x[j] = x[j] + (h[j] * r) * gp[j];
        }
        if (MODE != 3) {
#pragma unroll
            for (int j = 0; j < 4; ++j) *(f32x4*)(xout + (size_t)m * DM + 4 * lane + 256 * j) = x[j]; }
        if (MODE != 2) {
            float s2 = 0.f;
#pragma unroll
            for (int j = 0; j < 4; ++j) s2 += (x[j].x * x[j].x + x[j].y * x[j].y) + (x[j].z * x[j].z + x[j].w * x[j].w);
            const float r2 = __frsqrt_rn(wave_sum(s2, lane) * (1.f / DM) + EPS);
#pragma unroll
            for (int j = 0; j < 4; ++j) { const f32x4 y = (x[j] * r2) * gq[j]; v2u w; w.x = cvtpk(y.x, y.y); w.y = cvtpk(y.z, y.w);
                *(v2u*)(U + (size_t)m * DM + 4 * lane + 256 * j) = w; }
        }
    }
}

struct EpiSwiglu {
    static constexpr bool PERM = true, AFTER_DRAIN = false;
    bf16* H;
    __device__ __forceinline__ void operator()(const pg8::f32x4 (&acc)[2][2][4][2], const pg8::Unit& u, int wr, int wc, int fr, int fq) const {
#pragma unroll
        for (int ai = 0; ai < 2; ++ai)
#pragma unroll
            for (int m = 0; m < 4; ++m) {
                const int row = u.pm * 256 + ai * 128 + wr * 64 + m * 16 + fr;
                float o[8];
#pragma unroll
                for (int n = 0; n < 2; ++n)
#pragma unroll
                    for (int e = 0; e < 4; ++e) { const float g = acc[ai][0][m][n][e], up = acc[ai][1][m][n][e]; o[n * 4 + e] = g * up * __builtin_amdgcn_rcpf(1.f + __expf(-g)); }
                v4u w; w.x = pg8::cvt_pk_bf16(o[0], o[1]); w.y = pg8::cvt_pk_bf16(o[2], o[3]); w.z = pg8::cvt_pk_bf16(o[4], o[5]); w.w = pg8::cvt_pk_bf16(o[6], o[7]);
                *(v4u*)(H + (size_t)row * FF + u.pn * 128 + wc * 32 + fq * 8) = w;
            }
    }
};
struct EpiPQ {
    static constexpr bool PERM = true, AFTER_DRAIN = false;
    float* O;
    __device__ __forceinline__ void operator()(const pg8::f32x4 (&acc)[2][2][4][2], const pg8::Unit& u, int wr, int wc, int fr, int fq) const {
#pragma unroll
        for (int ai = 0; ai < 2; ++ai)
#pragma unroll
            for (int m = 0; m < 4; ++m) {
                const int row = u.pm * 256 + ai * 128 + wr * 64 + m * 16 + fr;
#pragma unroll
                for (int bj = 0; bj < 2; ++bj) { float* p = O + (size_t)row * 256 + bj * 128 + wc * 32 + fq * 8;
                    *(pg8::f32x4*)p = acc[ai][bj][m][0]; *(pg8::f32x4*)(p + 4) = acc[ai][bj][m][1]; }
            }
    }
};
struct CmpOrder {
    int c, G;
    __device__ __forceinline__ bool next(int i, pg8::Unit& u) const { const int idx = i * G + c; if (idx >= 32) return false; u.pm = idx; u.pn = idx >> 4; return true; }
    __device__ __forceinline__ void a_ready(const pg8::Unit&) const {}
    __device__ __forceinline__ void done(const pg8::Unit&) const {}
};
struct EpiInProj {
    static constexpr bool PERM = true, AFTER_DRAIN = false;
    unsigned char* ws;
    __device__ __forceinline__ void operator()(const pg8::f32x4 (&acc)[2][2][4][2], const pg8::Unit& u, int wr, int wc, int fr, int fq) const {
        const int pn = u.pn;
        const float* cosT = (const float*)(ws + WS_TAB + TAB_COS); const float* sinT = (const float*)(ws + WS_TAB + TAB_SIN);
        const bool ropet = (pn < 2) || (pn == 3) || (pn == 4);
        const bool ropew = ropet && ((wc & 1) == 0);
#pragma unroll
        for (int ai = 0; ai < 2; ++ai)
#pragma unroll
            for (int m = 0; m < 4; ++m) {
                const int row = u.pm * 256 + ai * 128 + wr * 64 + m * 16 + fr;
                const int b = row >> 11, t = row & 2047;
                f32x4 c0, c1, s0, s1;
                if (ropew) { c0 = *(const f32x4*)(cosT + t * 8); c1 = *(const f32x4*)(cosT + t * 8 + 4); s0 = *(const f32x4*)(sinT + t * 8); s1 = *(const f32x4*)(sinT + t * 8 + 4); }
#pragma unroll
                for (int bj = 0; bj < 2; ++bj) {
                    f32x4 v0 = acc[ai][bj][m][0], v1 = acc[ai][bj][m][1];
                    const int cl = bj * 128 + wc * 32 + fq * 8;
                    if (ropew && (pn < 2 || bj == 0)) {
                        f32x4 p0, p1; const int ln = fq * 16 + fr;
                        p0.x = shx(v0.x, 16, ln); p0.y = shx(v0.y, 16, ln); p0.z = shx(v0.z, 16, ln); p0.w = shx(v0.w, 16, ln);
                        p1.x = shx(v1.x, 16, ln); p1.y = shx(v1.y, 16, ln); p1.z = shx(v1.z, 16, ln); p1.w = shx(v1.w, 16, ln);
                        const float sg = (fq == 0) ? -1.f : 1.f;
                        if (fq < 2) { v0 = v0 * c0 + (p0 * s0) * sg; v1 = v1 * c1 + (p1 * s1) * sg; }
                    }
                    if (pn == 13) { if (cl < 32) { float* p = (float*)(ws + WS_GATE) + (size_t)row * 32 + cl; *(f32x4*)p = v0; *(f32x4*)(p + 4) = v1; } }
                    else {
                        size_t off;
                        if (pn < 2) off = WS_QN + ((size_t)row * 512 + pn * 256 + cl) * 2;
                        else if (pn < 5) { const int g = wc >> 1, d = (wc & 1) * 32 + fq * 8; off = WS_KCR + (size_t)((pn - 2) * 2 + bj) * (8 * MiB) + (((size_t)(b * 2 + g) * SEQ + t) * 64 + d) * 2; }
                        else { const int q = pn - 5; off = WS_MQ + (size_t)(q >> 1) * (32 * MiB) + ((size_t)row * 512 + (q & 1) * 256 + cl) * 2; }
                        v4u w; w.x = pg8::cvt_pk_bf16(v0.x, v0.y); w.y = pg8::cvt_pk_bf16(v0.z, v0.w); w.z = pg8::cvt_pk_bf16(v1.x, v1.y); w.w = pg8::cvt_pk_bf16(v1.z, v1.w);
                        *(v4u*)(ws + off) = w;
                    }
                }
            }
    }
};
static_assert(WS_VCR == WS_KCR + 8 * MiB && WS_KS == WS_KCR + 16 * MiB && WS_VS == WS_KCR + 24 * MiB && WS_KW == WS_KCR + 32 * MiB && WS_VW == WS_KCR + 40 * MiB, "kv buffers are 8 MiB apart in (pn, bj) order");
static_assert(WS_MK == WS_MQ + 32 * MiB && WS_MV == WS_MQ + 64 * MiB && WS_MO == WS_MQ + 96 * MiB, "mLSTM buffers are 32 MiB apart");

struct MixPtrs { unsigned char* ws; const float *conv_w, *conv_b, *i_bias, *f_bias, *mnorm_g; };
#define MP_QN ((const bf16*)(P.ws + WS_QN))
#define MP_KS ((const bf16*)(P.ws + WS_KS))
#define MP_VS ((const bf16*)(P.ws + WS_VS))
#define MP_KW ((const bf16*)(P.ws + WS_KW))
#define MP_VW ((const bf16*)(P.ws + WS_VW))
#define MP_KC ((const bf16*)(P.ws + WS_CC))
#define MP_VC ((const bf16*)(P.ws + WS_CC) + (size_t)4096 * 64)
#define MP_MQ ((const bf16*)(P.ws + WS_MQ))
#define MP_MK ((const bf16*)(P.ws + WS_MK))
#define MP_MV ((const bf16*)(P.ws + WS_MV))
#define MP_MO ((const bf16*)(P.ws + WS_MO))
#define MP_GATE ((const float*)(P.ws + WS_GATE))
#define MP_Y ((bf16*)(P.ws + WS_U))


typedef float f32x16 __attribute__((ext_vector_type(16)));
typedef short bf16x8v __attribute__((ext_vector_type(8)));
typedef short s16x4v __attribute__((ext_vector_type(4)));
typedef float f32x2v __attribute__((ext_vector_type(2)));
typedef __bf16 bf16x2v __attribute__((ext_vector_type(2)));
#define MFMA32(a, b, c) __builtin_amdgcn_mfma_f32_32x32x16_bf16((a), (b), (c), 0, 0, 0)
__device__ __forceinline__ s16x4v tr_read(const LAS unsigned char* p) { return __builtin_bit_cast(s16x4v, __builtin_amdgcn_ds_read_tr16_b64_v4i16((LAS s16x4v*)p)); }
__device__ __forceinline__ int tile_off(int key, int ch8) { return (ch8 >> 2) * 4096 + key * 64 + (((ch8 & 3) ^ ((key >> 2) & 3)) << 4); }
constexpr int NM_SLOT = 0, NM_IMP = 65536, NM_IMS = 99328, NM_SEL = 108544, NM_ITEM = 108864;
constexpr float QK_SCALE = 0.125f * 1.4426950408889634f;

#define SBAR() __builtin_amdgcn_sched_barrier(0)
#define LBAR() asm volatile("s_waitcnt lgkmcnt(0)\n\ts_barrier" ::: "memory")
__device__ __forceinline__ void k_load(const LAS unsigned char* Ks, int r, int h, bf16x8v (&kf)[8]) {
    const int sw = (r >> 2) & 3;
#pragma unroll
    for (int ks = 0; ks < 4; ++ks) { const int off = (ks >> 1) * 4096 + r * 64 + (((((ks & 1) << 1) + h) ^ sw) << 4);
        kf[2 * ks] = *(const LAS bf16x8v*)(Ks + off); kf[2 * ks + 1] = *(const LAS bf16x8v*)(Ks + off + 2048); }
}
__device__ __forceinline__ void qk_mma(const bf16x8v (&kf)[8], const bf16x8v (&qf)[4], f32x16& p0, f32x16& p1) {
    const f32x16 z = {0.f, 0.f, 0.f, 0.f, 0.f, 0.f, 0.f, 0.f, 0.f, 0.f, 0.f, 0.f, 0.f, 0.f, 0.f, 0.f};
#pragma unroll
    for (int ks = 0; ks < 4; ++ks) { p0 = MFMA32(kf[2 * ks], qf[ks], ks ? p0 : z); p1 = MFMA32(kf[2 * ks + 1], qf[ks], ks ? p1 : z); }
}
__device__ __forceinline__ void v_load(const LAS unsigned char* Vs, int lane, bf16x8v (&vf)[8]) {
    const int h = lane >> 5, i16 = lane & 15, q = i16 >> 2, p = i16 & 3, gi = (lane >> 4) & 1;
    const int cidx = 2 * gi + (p >> 1), e8 = (p & 1) << 3;
    const int offlo = q * 64 + ((cidx ^ h) << 4) + e8 + h * 256, offhi = q * 64 + ((cidx ^ (h | 2)) << 4) + e8 + h * 256 + 512;
#pragma unroll
    for (int kb = 0; kb < 2; ++kb)
#pragma unroll
        for (int s = 0; s < 2; ++s)
#pragma unroll
            for (int db = 0; db < 2; ++db) { const LAS unsigned char* base = Vs + db * 4096 + (kb * 32 + s * 16) * 64;
                const s16x4v lo = tr_read(base + offlo), hi = tr_read(base + offhi);
                vf[(kb * 2 + s) * 2 + db] = __builtin_shufflevector(lo, hi, 0, 1, 2, 3, 4, 5, 6, 7); }
}
__device__ __forceinline__ void pv_mma(const bf16x8v (&vf)[8], const f32x16& p0, const f32x16& p1, f32x16 (&o)[2]) {
#pragma unroll
    for (int kb = 0; kb < 2; ++kb)
#pragma unroll
        for (int s = 0; s < 2; ++s) {
            const f32x16& P = kb ? p1 : p0;
            v4u pw; pw.x = cvtpk(P[8 * s + 0], P[8 * s + 1]); pw.y = cvtpk(P[8 * s + 2], P[8 * s + 3]); pw.z = cvtpk(P[8 * s + 4], P[8 * s + 5]); pw.w = cvtpk(P[8 * s + 6], P[8 * s + 7]);
            const bf16x8v pf = __builtin_bit_cast(bf16x8v, pw);
            o[0] = MFMA32(vf[(kb * 2 + s) * 2], pf, o[0]); o[1] = MFMA32(vf[(kb * 2 + s) * 2 + 1], pf, o[1]);
        }
}

__device__ __forceinline__ void nsa_unit_mfma(LAS unsigned char* L, const MixPtrs& P, int b, int g, int c, int tid_in) {
    int tid_l = tid_in; asm volatile("" : "+v"(tid_l));
    const int tid = tid_l, lane = tid & 63, w = __builtin_amdgcn_readfirstlane(tid >> 6);
    const int r = lane & 31, h = lane >> 5, head = w >> 1, qi = (w & 1) * 32 + r, t = c * 64 + qi;
    const size_t row = (size_t)b * SEQ + t;
    LAS unsigned* SEL = (LAS unsigned*)(L + NM_SEL); LAS int* ITEM = (LAS int*)(L + NM_ITEM);
    const size_t kvbase = (size_t)(b * 2 + g) * SEQ * 64, ccbase = (size_t)(b * 2 + g) * 128 * 64;
    const int skey = tid >> 3, sch = tid & 7, soff = tile_off(skey, sch);
    bf16x8v qf[4];
    { const bf16* qp = MP_QN + row * 512 + (g * 4 + head) * 64 + 8 * h;
#pragma unroll
      for (int ks = 0; ks < 4; ++ks) qf[ks] = *(const bf16x8v*)(qp + 16 * ks); }
    const float* gp = MP_GATE + row * 32 + g * 4 + head;
    float one = 1.f; asm volatile("" : "+v"(one));
    const float gate_c = __builtin_amdgcn_rcpf(one + __expf(-gp[0])), gate_s = __builtin_amdgcn_rcpf(one + __expf(-gp[8])), gate_w = __builtin_amdgcn_rcpf(one + __expf(-gp[16]));
    f32x16 oacc[2];
    {
        const bf16* kc = MP_KC + ccbase; const bf16* vc = MP_VC + ccbase;
        const v4u k0 = *(const v4u*)(kc + tid * 8), k1 = *(const v4u*)(kc + 4096 + tid * 8), v0 = *(const v4u*)(vc + tid * 8), v1 = *(const v4u*)(vc + 4096 + tid * 8);
        LBAR();
        *(LAS v4u*)(L + NM_SLOT + soff) = k0; *(LAS v4u*)(L + NM_SLOT + 8192 + soff) = v0; *(LAS v4u*)(L + NM_SLOT + 16384 + soff) = k1; *(LAS v4u*)(L + NM_SLOT + 24576 + soff) = v1;
        if (tid < 64) SEL[tid] = 0u;
        LBAR();
        f32x16 s0, s1, s2, s3;
        { bf16x8v kfa[8], kfb[8]; k_load(L + NM_SLOT, r, h, kfa); k_load(L + NM_SLOT + 16384, r, h, kfb); SBAR(); qk_mma(kfa, qf, s0, s1); qk_mma(kfb, qf, s2, s3); }
        const int nlim = (t >= 31) ? (((t - 31) >> 4) < 126 ? ((t - 31) >> 4) : 126) : -1;
        float mx = -1e20f;
#pragma unroll
        for (int e = 0; e < 16; ++e) { const int cr = (e & 3) + 8 * (e >> 2) + 4 * h;
            s0[e] = (cr <= nlim) ? s0[e] * QK_SCALE : -1e30f; s1[e] = (cr + 32 <= nlim) ? s1[e] * QK_SCALE : -1e30f;
            s2[e] = (cr + 64 <= nlim) ? s2[e] * QK_SCALE : -1e30f; s3[e] = (cr + 96 <= nlim) ? s3[e] * QK_SCALE : -1e30f;
            mx = fmaxf(fmaxf(mx, fmaxf(s0[e], s1[e])), fmaxf(s2[e], s3[e])); }
        mx = fmaxf(mx, shx(mx, 32, lane));
        float ls = 0.f;
#pragma unroll
        for (int e = 0; e < 16; ++e) { s0[e] = __builtin_amdgcn_exp2f(s0[e] - mx); s1[e] = __builtin_amdgcn_exp2f(s1[e] - mx); s2[e] = __builtin_amdgcn_exp2f(s2[e] - mx); s3[e] = __builtin_amdgcn_exp2f(s3[e] - mx);
            ls += (s0[e] + s1[e]) + (s2[e] + s3[e]); }
        ls += shx(ls, 32, lane);
        const float il = (ls > 0.f) ? __builtin_amdgcn_rcpf(ls) : 0.f;
#pragma unroll
        for (int e = 0; e < 16; ++e) { s0[e] *= il; s1[e] *= il; s2[e] *= il; s3[e] *= il; }
        { LAS float* IMP = (LAS float*)(L + NM_IMP) + (w * 32 + r) * 33; float plprev = 0.f;
#pragma unroll
          for (int x = 0; x < 16; ++x) {
              const f32x16& S = (x < 4) ? s0 : ((x < 8) ? s1 : ((x < 12) ? s2 : s3)); const int g4 = (x & 3) * 4;
              const float own = (S[g4] + S[g4 + 1]) + (S[g4 + 2] + S[g4 + 3]);
              const float pl = shx(S[g4 + 3], 32, lane);
              if (h == 1) IMP[2 * x + 1] = own + pl; else IMP[2 * x] = own + plprev;
              plprev = pl;
          }
        }
        oacc[0] = (f32x16){0.f, 0.f, 0.f, 0.f, 0.f, 0.f, 0.f, 0.f, 0.f, 0.f, 0.f, 0.f, 0.f, 0.f, 0.f, 0.f}; oacc[1] = oacc[0];
        { bf16x8v vfa[8], vfb[8]; v_load(L + NM_SLOT + 8192, lane, vfa); v_load(L + NM_SLOT + 24576, lane, vfb); SBAR(); pv_mma(vfa, s0, s1, oacc); pv_mma(vfb, s2, s3, oacc); }
#pragma unroll
        for (int e = 0; e < 16; ++e) { oacc[0][e] *= gate_c; oacc[1][e] *= gate_c; }
    }
    LBAR();
    { const int i = tid & 63, jg = tid >> 6; const LAS float* I8 = (const LAS float*)(L + NM_IMP); LAS float* IMS = (LAS float*)(L + NM_IMS);
#pragma unroll
      for (int jj = 0; jj < 4; ++jj) { const int j = 4 * jg + jj; const int wq = (i >> 5), rq = i & 31;
          IMS[i * 36 + j] = (I8[((0 + wq) * 32 + rq) * 33 + j] + I8[((2 + wq) * 32 + rq) * 33 + j]) + (I8[((4 + wq) * 32 + rq) * 33 + j] + I8[((6 + wq) * 32 + rq) * 33 + j]); }
      LBAR();
      unsigned bits = 0u;
      if (c + 1 <= 16) { if (jg == 0) bits = (1u << (c + 1)) - 1u; }
      else { if (jg == 0) bits = 1u | (1u << c) | (1u << (c - 1));
          { float iv[32];
#pragma unroll
            for (int q8 = 0; q8 < 8; ++q8) { const f32x4 x = *(const LAS f32x4*)(IMS + i * 36 + 4 * q8); iv[4 * q8] = x.x; iv[4 * q8 + 1] = x.y; iv[4 * q8 + 2] = x.z; iv[4 * q8 + 3] = x.w; }
#pragma unroll
            for (int jj = 0; jj < 4; ++jj) { const int j = 4 * jg + jj; const float vj = IMS[i * 36 + j]; int rank = 0;
#pragma unroll
                for (int i2 = 1; i2 < 30; ++i2) rank += (i2 <= c - 2 && (iv[i2] > vj || (iv[i2] == vj && i2 < j))) ? 1 : 0;
                if (j >= 1 && j <= c - 2 && rank < 13) bits |= 1u << j; } } }
      if (bits) atomicOr((unsigned*)&SEL[i], bits);
      LBAR();
      if (w == 0) { unsigned so = SEL[lane];
#pragma unroll
          for (int o2 = 32; o2; o2 >>= 1) so |= shxu(so, o2, lane);
          if (lane == 0) { int n = 0; for (int j = 0; j <= c; ++j) if ((so >> j) & 1u) ITEM[n++] = j; const int j0 = (c - 8 > 0) ? c - 8 : 0; for (int j = j0; j <= c; ++j) ITEM[n++] = 64 + j; ITEM[n] = -1; ITEM[47] = n; } }
      LBAR();
    }
    const unsigned mysel = SEL[qi]; const int nitem = ITEM[47];
    f32x16 o[2]; float m = -1e20f, lsum = 0.f; int prev_kind = 0;
    o[0] = (f32x16){0.f, 0.f, 0.f, 0.f, 0.f, 0.f, 0.f, 0.f, 0.f, 0.f, 0.f, 0.f, 0.f, 0.f, 0.f, 0.f}; o[1] = o[0];
    const int npair = (nitem + 1) >> 1;
    v4u rk0, rv0, rk1, rv1;
#define NSA_LOAD_PAIR(ip_) do { const int ia_ = ITEM[2 * (ip_)], ib_ = ITEM[2 * (ip_) + 1]; \
        { const bf16* kp = ((ia_ & 64) ? MP_KW : MP_KS) + kvbase + (size_t)(ia_ & 63) * 4096; const bf16* vp = ((ia_ & 64) ? MP_VW : MP_VS) + kvbase + (size_t)(ia_ & 63) * 4096; rk0 = *(const v4u*)(kp + tid * 8); rv0 = *(const v4u*)(vp + tid * 8); } \
        if (ib_ >= 0) { const bf16* kp = ((ib_ & 64) ? MP_KW : MP_KS) + kvbase + (size_t)(ib_ & 63) * 4096; const bf16* vp = ((ib_ & 64) ? MP_VW : MP_VS) + kvbase + (size_t)(ib_ & 63) * 4096; rk1 = *(const v4u*)(kp + tid * 8); rv1 = *(const v4u*)(vp + tid * 8); } } while (0)
#define NSA_WRITE_PAIR(sb_) do { *(LAS v4u*)(L + (sb_) + soff) = rk0; *(LAS v4u*)(L + (sb_) + 8192 + soff) = rv0; *(LAS v4u*)(L + (sb_) + 16384 + soff) = rk1; *(LAS v4u*)(L + (sb_) + 24576 + soff) = rv1; } while (0)
    rk1 = (v4u){0u, 0u, 0u, 0u}; rv1 = rk1;
    NSA_LOAD_PAIR(0);
    NSA_WRITE_PAIR(NM_SLOT + 32768);
    LBAR();
#pragma unroll 1
    for (int ip = 0; ip < npair; ++ip) {
        if (ip + 1 < npair) NSA_LOAD_PAIR(ip + 1);
        const int sbase = NM_SLOT + ((ip + 1) & 1) * 32768;
#pragma unroll 1
        for (int half = 0; half < 2; ++half) {
            const int item = ITEM[2 * ip + half];
            if (item < 0) break;
            const int kind = item >> 6, j = item & 63;
            if (kind != prev_kind) {
                const float tot = lsum + shx(lsum, 32, lane); const float sc = gate_s * __builtin_amdgcn_rcpf(tot);
#pragma unroll
                for (int e = 0; e < 16; ++e) { oacc[0][e] += o[0][e] * sc; oacc[1][e] += o[1][e] * sc; o[0][e] = 0.f; o[1][e] = 0.f; }
                m = -1e20f; lsum = 0.f; prev_kind = kind;
            }
            int klo, khi;
            if (kind == 0) { klo = 0; khi = ((mysel >> j) & 1u) ? ((j < c) ? 63 : qi) : -1; }
            else { klo = t - 511 - 64 * j; khi = t - 64 * j; if (khi > 63) khi = 63; if (klo < 0) klo = 0; }
            const LAS unsigned char* slot = L + sbase + half * 16384;
            if (__any(khi >= klo)) {
                f32x16 p0, p1; bf16x8v vf[8];
                { bf16x8v kf[8]; k_load(slot, r, h, kf); SBAR(); qk_mma(kf, qf, p0, p1); }
                v_load(slot + 8192, lane, vf); SBAR();
                if (!__all(klo == 0 && khi == 63)) {
                    const int a = klo - 4 * h, z = khi - 4 * h;
#pragma unroll
                    for (int e = 0; e < 16; ++e) { const int cr = (e & 3) + 8 * (e >> 2);
                        p0[e] = (cr >= a && cr <= z) ? p0[e] : -1e30f; p1[e] = (cr + 32 >= a && cr + 32 <= z) ? p1[e] : -1e30f; }
                }
                float tm = fmaxf(p0[0], p1[0]);
#pragma unroll
                for (int e = 1; e < 16; ++e) tm = fmaxf(tm, fmaxf(p0[e], p1[e]));
                tm = fmaxf(tm, shx(tm, 32, lane));
                const float mn = fmaxf(m, tm * QK_SCALE);
                if (!__all(mn == m)) { const float corr = __builtin_amdgcn_exp2f(m - mn); lsum *= corr;
#pragma unroll
                    for (int e = 0; e < 16; ++e) { o[0][e] *= corr; o[1][e] *= corr; }
                    m = mn; }
                float ts = 0.f;
#pragma unroll
                for (int e = 0; e < 16; ++e) { p0[e] = __builtin_amdgcn_exp2f(p0[e] * QK_SCALE - m); p1[e] = __builtin_amdgcn_exp2f(p1[e] * QK_SCALE - m); ts += p0[e] + p1[e]; }
                lsum += ts;
                SBAR(); pv_mma(vf, p0, p1, o);
            }
        }
        if (ip + 1 < npair) NSA_WRITE_PAIR(NM_SLOT + (ip & 1) * 32768);
        LBAR();
    }
#undef NSA_LOAD_PAIR
#undef NSA_WRITE_PAIR
    { const float tot = lsum + shx(lsum, 32, lane); const float sc = gate_w * __builtin_amdgcn_rcpf(tot);
#pragma unroll
      for (int e = 0; e < 16; ++e) { oacc[0][e] += o[0][e] * sc; oacc[1][e] += o[1][e] * sc; } }
    { bf16* yp = MP_Y + row * DM + (g * 4 + head) * 64 + 4 * h;
#pragma unroll
      for (int db = 0; db < 2; ++db)
#pragma unroll
          for (int g4 = 0; g4 < 4; ++g4) { v2u wv; wv.x = cvtpk(oacc[db][4 * g4], oacc[db][4 * g4 + 1]); wv.y = cvtpk(oacc[db][4 * g4 + 2], oacc[db][4 * g4 + 3]); *(v2u*)(yp + db * 32 + g4 * 8) = wv; } }
}

#define MFMA16(a, b, c) __builtin_amdgcn_mfma_f32_16x16x32_bf16((a), (b), (c), 0, 0, 0)
constexpr size_t WS_QC = 401 * MiB, WS_KC2 = 433 * MiB, WS_END2 = 465 * MiB;
#define MP_QC ((const bf16*)(P.ws + WS_QC))
#define MP_KC2 ((const bf16*)(P.ws + WS_KC2))
__device__ __forceinline__ int img_off(int row, int ch) { return 256 * row + 16 * (ch ^ (((row & 3) << 2) | ((row >> 2) & 3))); }
constexpr int M2_IMG = 0, M2_SC = 98304, M2_DEN = 106496, M2_QN = 107520, M2_N = 107776, M2_SSQ = 108288;

__device__ __forceinline__ void mlstm_conv_pass(unsigned char* ws, const float* conv_w, const float* conv_b, int gthread, int nthreads) {
    for (int idx = gthread; idx < BATCH * 128 * 128; idx += nthreads) {
        const int cc = idx & 127, tg = (idx >> 7) & 127, b = idx >> 14;
        const int isk = cc >> 6, ch0 = (cc & 63) * 8;
        const bf16* src = (const bf16*)(ws + (isk ? WS_MK : WS_MQ)) + (size_t)b * SEQ * 512 + ch0;
        bf16* dst = (bf16*)(ws + (isk ? WS_KC2 : WS_QC)) + ((size_t)(b * 4 + (ch0 >> 7)) * SEQ) * 128 + (ch0 & 127);
        float wt[4][8], bs[8];
#pragma unroll
        for (int j = 0; j < 4; ++j) { const f32x4 a = *(const f32x4*)(conv_w + j * 1024 + isk * 512 + ch0), c2 = *(const f32x4*)(conv_w + j * 1024 + isk * 512 + ch0 + 4);
            wt[j][0] = a.x; wt[j][1] = a.y; wt[j][2] = a.z; wt[j][3] = a.w; wt[j][4] = c2.x; wt[j][5] = c2.y; wt[j][6] = c2.z; wt[j][7] = c2.w; }
        { const f32x4 a = *(const f32x4*)(conv_b + isk * 512 + ch0), c2 = *(const f32x4*)(conv_b + isk * 512 + ch0 + 4); bs[0] = a.x; bs[1] = a.y; bs[2] = a.z; bs[3] = a.w; bs[4] = c2.x; bs[5] = c2.y; bs[6] = c2.z; bs[7] = c2.w; }
        const float osc = isk ? 0.08838834764831845f : 1.f;
        const int t0 = tg * 16;
        float x0[8], x1[8], x2[8];
#pragma unroll
        for (int e = 0; e < 8; ++e) { x0[e] = 0.f; x1[e] = 0.f; x2[e] = 0.f; }
        if (t0 > 0) {
            const v4u a = *(const v4u*)(src + (size_t)(t0 - 3) * 512), c2 = *(const v4u*)(src + (size_t)(t0 - 2) * 512), d2 = *(const v4u*)(src + (size_t)(t0 - 1) * 512);
            x0[0] = bflo(a.x); x0[1] = bfhi(a.x); x0[2] = bflo(a.y); x0[3] = bfhi(a.y); x0[4] = bflo(a.z); x0[5] = bfhi(a.z); x0[6] = bflo(a.w); x0[7] = bfhi(a.w);
            x1[0] = bflo(c2.x); x1[1] = bfhi(c2.x); x1[2] = bflo(c2.y); x1[3] = bfhi(c2.y); x1[4] = bflo(c2.z); x1[5] = bfhi(c2.z); x1[6] = bflo(c2.w); x1[7] = bfhi(c2.w);
            x2[0] = bflo(d2.x); x2[1] = bfhi(d2.x); x2[2] = bflo(d2.y); x2[3] = bfhi(d2.y); x2[4] = bflo(d2.z); x2[5] = bfhi(d2.z); x2[6] = bflo(d2.w); x2[7] = bfhi(d2.w);
        }
#pragma unroll 4
        for (int s = 0; s < 16; ++s) {
            const v4u a = *(const v4u*)(src + (size_t)(t0 + s) * 512);
            const float x3[8] = {bflo(a.x), bfhi(a.x), bflo(a.y), bfhi(a.y), bflo(a.z), bfhi(a.z), bflo(a.w), bfhi(a.w)};
            float o[8];
#pragma unroll
            for (int e = 0; e < 8; ++e) { float v = bs[e] + wt[0][e] * x0[e] + wt[1][e] * x1[e] + wt[2][e] * x2[e] + wt[3][e] * x3[e]; v = v * __builtin_amdgcn_rcpf(1.f + __expf(-v)); o[e] = v * osc; x0[e] = x1[e]; x1[e] = x2[e]; x2[e] = x3[e]; }
            v4u wv; wv.x = pk2(o[0], o[1]); wv.y = pk2(o[2], o[3]); wv.z = pk2(o[4], o[5]); wv.w = pk2(o[6], o[7]);
            *(v4u*)(dst + (size_t)(t0 + s) * 128) = wv;
        }
    }
}

constexpr int M2_A = 112384, M2_PM = 120576, M2_F = 128768, M2_BL = 136960, M2_AMX = 137088, M2_MC = 137216;
__device__ __forceinline__ void mlstm_unit_mfma(LAS unsigned char* L, const MixPtrs& P, int b, int hh, int tid_in) {
    int tid_l = tid_in; asm volatile("" : "+v"(tid_l));
    const int tid = tid_l, lane = tid & 63, w = __builtin_amdgcn_readfirstlane(tid >> 6), l15 = lane & 15, kg = lane >> 4;
    const size_t rb = (size_t)b * SEQ;
    const bf16* QCp = MP_QC + ((size_t)(b * 4 + hh) * SEQ) * 128; const bf16* KCp = MP_KC2 + ((size_t)(b * 4 + hh) * SEQ) * 128;
    const bf16* Vp = MP_MV + rb * 512 + hh * 128; const bf16* Op = MP_MO + rb * 512 + hh * 128 + 16 * w + 4 * kg;
    bf16* Yp = MP_Y + rb * DM + 512 + hh * 128 + 16 * w + 4 * kg;
    LAS float* DEN = (LAS float*)(L + M2_DEN); LAS float* QN = (LAS float*)(L + M2_QN); LAS float* NV = (LAS float*)(L + M2_N); LAS float* SSQ = (LAS float*)(L + M2_SSQ);
    LAS float* SA = (LAS float*)(L + M2_A); LAS float* SPM = (LAS float*)(L + M2_PM); LAS float* SF = (LAS float*)(L + M2_F);
    LAS float* SBL = (LAS float*)(L + M2_BL); LAS float* SAMX = (LAS float*)(L + M2_AMX); LAS float* SMC = (LAS float*)(L + M2_MC);
    float zf = 0.f; asm volatile("" : "+v"(zf));
    f32x4 Cacc[8], nacc = {zf, zf, zf, zf};
#pragma unroll
    for (int i = 0; i < 8; ++i) Cacc[i] = (f32x4){zf, zf, zf, zf};
    const f32x4 gn = *(const f32x4*)(P.mnorm_g + hh * 128 + 16 * w + 4 * kg);
    const int r0s = tid >> 4, c0s = tid & 15, so0 = img_off(r0s, c0s), so1 = img_off(r0s + 32, c0s);
    v4u sq0, sq1, sk0, sk1, sv0, sv1;
    sq0 = *(const v4u*)(QCp + (size_t)r0s * 128 + c0s * 8); sq1 = *(const v4u*)(QCp + (size_t)(r0s + 32) * 128 + c0s * 8);
    sk0 = *(const v4u*)(KCp + (size_t)r0s * 128 + c0s * 8); sk1 = *(const v4u*)(KCp + (size_t)(r0s + 32) * 128 + c0s * 8);
    sv0 = *(const v4u*)(Vp + (size_t)r0s * 512 + c0s * 8);  sv1 = *(const v4u*)(Vp + (size_t)(r0s + 32) * 512 + c0s * 8);
    LBAR();
    { const float ib = P.i_bias[hh], fb = P.f_bias[hh]; const float* Gp = MP_GATE + rb * 32 + hh;
#pragma unroll 1
      for (int cc = w; cc < 32; cc += 8) { const int tk = 64 * cc + lane;
          const float il = Gp[(size_t)tk * 32 + 24] + ib, fx = Gp[(size_t)tk * 32 + 28] + fb; const float fl = fminf(fx, 0.f) - log1pf(__expf(-fabsf(fx)));
          float f = fl;
#pragma unroll
          for (int o = 1; o < 64; o <<= 1) { const float v = shi(f, lane - o); if (lane >= o) f += v; }
          const float a = il - f; float pm = a;
#pragma unroll
          for (int o = 1; o < 64; o <<= 1) { const float v = shi(pm, lane - o); if (lane >= o) pm = fmaxf(pm, v); }
          SA[tk] = a; SPM[tk] = pm; SF[tk] = f; if (lane == 63) { SBL[cc] = f; SAMX[cc] = pm; } } }
    *(LAS v4u*)(L + M2_IMG + so0) = sq0; *(LAS v4u*)(L + M2_IMG + so1) = sq1; *(LAS v4u*)(L + M2_IMG + 16384 + so0) = sk0; *(LAS v4u*)(L + M2_IMG + 16384 + so1) = sk1;
    *(LAS v4u*)(L + M2_IMG + 32768 + so0) = sv0; *(LAS v4u*)(L + M2_IMG + 32768 + so1) = sv1;
    if (tid < 128) NV[tid] = zf;
    LBAR();
    if (tid == 0) { float mcar = zf; for (int cc = 0; cc < 32; ++cc) { SMC[cc] = mcar; mcar = SBL[cc] + fmaxf(mcar, SAMX[cc]); } }
    LBAR();
#pragma unroll 1
    for (int c = 0; c < 32; ++c) {
        int lc = lane; asm volatile("" : "+v"(lc));
        const int l15 = lc & 15, kg = lc >> 4, q4 = l15 >> 2, p4 = l15 & 3;
        const int t0 = c * 64; const LAS unsigned char* Qi = L + M2_IMG + (c & 1) * 49152; const LAS unsigned char* Ki = Qi + 16384; const LAS unsigned char* Vi = Qi + 32768;
        if (c + 1 < 32) { const int tn = t0 + 64;
            sq0 = *(const v4u*)(QCp + (size_t)(tn + r0s) * 128 + c0s * 8); sq1 = *(const v4u*)(QCp + (size_t)(tn + r0s + 32) * 128 + c0s * 8);
            sk0 = *(const v4u*)(KCp + (size_t)(tn + r0s) * 128 + c0s * 8); sk1 = *(const v4u*)(KCp + (size_t)(tn + r0s + 32) * 128 + c0s * 8);
            sv0 = *(const v4u*)(Vp + (size_t)(tn + r0s) * 512 + c0s * 8);  sv1 = *(const v4u*)(Vp + (size_t)(tn + r0s + 32) * 512 + c0s * 8); }
        const float mc = SMC[c], mxa = fmaxf(mc, SAMX[c]); const float cs = __expf(mc - mxa);
        { const int tblk = w >> 1, t = 16 * tblk + l15; const int sb0 = 2 * (w & 1);
          bf16x8v ka[2][4], qb[4];
#pragma unroll
          for (int ks = 0; ks < 4; ++ks) { qb[ks] = *(const LAS bf16x8v*)(Qi + img_off(t, 4 * ks + kg)); ka[0][ks] = *(const LAS bf16x8v*)(Ki + img_off(16 * sb0 + l15, 4 * ks + kg)); ka[1][ks] = *(const LAS bf16x8v*)(Ki + img_off(16 * sb0 + 16 + l15, 4 * ks + kg)); }
          const float Mt = fmaxf(SPM[t0 + t], mc);
          const f32x4 as0 = *(const LAS f32x4*)(SA + t0 + 16 * sb0 + 4 * kg), as1 = *(const LAS f32x4*)(SA + t0 + 16 * sb0 + 16 + 4 * kg);
          const int tq = tid >> 3, dp = tid & 7; const v4u q0 = *(const LAS v4u*)(Qi + img_off(tq, 2 * dp)), q1 = *(const LAS v4u*)(Qi + img_off(tq, 2 * dp + 1));
          const LAS f32x4* np = (const LAS f32x4*)(NV + 16 * dp); const f32x4 n0 = np[0], n1 = np[1], n2 = np[2], n3 = np[3];
          SBAR();
          LAS unsigned char* SC = L + M2_SC;
#pragma unroll
          for (int sb = 0; sb < 2; ++sb) { const int sblk = sb0 + sb; f32x4 acc = {0.f, 0.f, 0.f, 0.f}; float rp = 0.f; v2u wv; wv.x = 0u; wv.y = 0u;
              if (sblk <= tblk) {
#pragma unroll
                  for (int ks = 0; ks < 4; ++ks) acc = MFMA16(ka[sb][ks], qb[ks], acc);
                  const f32x4 as = sb ? as1 : as0; float v[4];
#pragma unroll
                  for (int e = 0; e < 4; ++e) { const float x = acc[e] * __expf(as[e] - Mt); v[e] = (sblk == tblk && 4 * kg + e > l15) ? 0.f : x; }
                  rp = (v[0] + v[1]) + (v[2] + v[3]); wv.x = cvtpk(v[0], v[1]); wv.y = cvtpk(v[2], v[3]);
              }
              rp += shx(rp, 16, lane); rp += shx(rp, 32, lane);
              *(LAS v2u*)(SC + t * 128 + (((2 * sblk + (kg >> 1)) ^ (t & 7)) << 4) + 8 * (kg & 1)) = wv;
              if (kg == 0) DEN[sblk * 64 + t] = rp; }
          { float s = bflo(q0.x) * n0.x + bfhi(q0.x) * n0.y + bflo(q0.y) * n0.z + bfhi(q0.y) * n0.w + bflo(q0.z) * n1.x + bfhi(q0.z) * n1.y + bflo(q0.w) * n1.z + bfhi(q0.w) * n1.w
                    + bflo(q1.x) * n2.x + bfhi(q1.x) * n2.y + bflo(q1.y) * n2.z + bfhi(q1.y) * n2.w + bflo(q1.z) * n3.x + bfhi(q1.z) * n3.y + bflo(q1.w) * n3.z + bfhi(q1.w) * n3.w;
            s += shx(s, 1, lane); s += shx(s, 2, lane); s += shx(s, 4, lane);
            if (dp == 0) QN[tq] = s; } }
        LBAR();
        v2u og[4];
#pragma unroll
        for (int tb = 0; tb < 4; ++tb) og[tb] = *(const v2u*)(Op + (size_t)(t0 + 16 * tb + l15) * 512);
        bf16x8v vf[2]; f32x4 hv[4];
        { float pmt[4], ft[4], dnp[4], qn4[4]; bf16x8v Cfrag[4];
#pragma unroll
          for (int kp = 0; kp < 4; ++kp) { v4u a; a.x = cvtpk(Cacc[2 * kp].x, Cacc[2 * kp].y); a.y = cvtpk(Cacc[2 * kp].z, Cacc[2 * kp].w); a.z = cvtpk(Cacc[2 * kp + 1].x, Cacc[2 * kp + 1].y); a.w = cvtpk(Cacc[2 * kp + 1].z, Cacc[2 * kp + 1].w);
              Cfrag[kp] = __builtin_bit_cast(bf16x8v, a); }
#pragma unroll
          for (int ks = 0; ks < 2; ++ks) { const int r0 = 32 * ks + 8 * kg;
              const s16x4v lo = tr_read(Vi + 256 * (r0 + q4) + 16 * ((2 * w + (p4 >> 1)) ^ ((q4 << 2) | ((r0 >> 2) & 3))) + 8 * (p4 & 1));
              const s16x4v hi = tr_read(Vi + 256 * (r0 + 4 + q4) + 16 * ((2 * w + (p4 >> 1)) ^ ((q4 << 2) | (((r0 + 4) >> 2) & 3))) + 8 * (p4 & 1));
              vf[ks] = __builtin_shufflevector(lo, hi, 0, 1, 2, 3, 4, 5, 6, 7); }
#pragma unroll
          for (int tb = 0; tb < 4; ++tb) { const int t = 16 * tb + l15; pmt[tb] = SPM[t0 + t]; ft[tb] = SF[t0 + t]; dnp[tb] = (DEN[t] + DEN[64 + t]) + (DEN[128 + t] + DEN[192 + t]); qn4[tb] = QN[t]; }
#pragma unroll
          for (int tp = 0; tp < 2; ++tp) {
              bf16x8v sf[2][2]; v2u qlo[2][4], qhi[2][4];
#pragma unroll
              for (int t2 = 0; t2 < 2; ++t2) { const int t = 16 * (2 * tp + t2) + l15; const int swz = ((t & 3) << 2) | ((t >> 2) & 3);
#pragma unroll
                  for (int ks = 0; ks < 2; ++ks) sf[t2][ks] = *(const LAS bf16x8v*)(L + M2_SC + t * 128 + (((4 * ks + kg) ^ (t & 7)) << 4));
#pragma unroll
                  for (int kp = 0; kp < 4; ++kp) { qlo[t2][kp] = *(const LAS v2u*)(Qi + 256 * t + 16 * ((4 * kp + (kg >> 1)) ^ swz) + 8 * (kg & 1)); qhi[t2][kp] = *(const LAS v2u*)(Qi + 256 * t + 16 * ((4 * kp + 2 + (kg >> 1)) ^ swz) + 8 * (kg & 1)); } }
              SBAR();
#pragma unroll
              for (int t2 = 0; t2 < 2; ++t2) { const int tb = 2 * tp + t2; f32x4 an = {0.f, 0.f, 0.f, 0.f}, a2 = {0.f, 0.f, 0.f, 0.f};
#pragma unroll
                  for (int ks = 0; ks < 2; ++ks) an = MFMA16(vf[ks], sf[t2][ks], an);
#pragma unroll
                  for (int kp = 0; kp < 4; ++kp) { v4u qq; qq.x = qlo[t2][kp].x; qq.y = qlo[t2][kp].y; qq.z = qhi[t2][kp].x; qq.w = qhi[t2][kp].y; a2 = MFMA16(Cfrag[kp], __builtin_bit_cast(bf16x8v, qq), a2); }
                  const float Mt = fmaxf(pmt[tb], mc), wp = __expf(mc - Mt), emt = __expf(-ft[tb] - Mt);
                  const float dn = dnp[tb] + wp * qn4[tb];
                  const float idn = __builtin_amdgcn_rcpf(fmaxf(fabsf(dn), emt));
                  hv[tb] = (an + a2 * wp) * idn;
                  float ss = (hv[tb].x * hv[tb].x + hv[tb].y * hv[tb].y) + (hv[tb].z * hv[tb].z + hv[tb].w * hv[tb].w);
                  ss += shx(ss, 16, lane); ss += shx(ss, 32, lane);
                  if (kg == 0) SSQ[((c & 1) * 8 + w) * 64 + 16 * tb + l15] = ss; }
              SBAR();
          } }
        { bf16x8v vpf[2], wkf[2];
          f32x4 aw[2][2];
#pragma unroll
          for (int ks = 0; ks < 2; ++ks) { aw[ks][0] = *(const LAS f32x4*)(SA + t0 + 32 * ks + 8 * kg); aw[ks][1] = *(const LAS f32x4*)(SA + t0 + 32 * ks + 8 * kg + 4); }
#pragma unroll
          for (int ks = 0; ks < 2; ++ks) { float wkv[8]; unsigned vp[4], wp2[4]; const v4u vu = __builtin_bit_cast(v4u, vf[ks]); const unsigned vw[4] = {vu.x, vu.y, vu.z, vu.w};
#pragma unroll
              for (int j = 0; j < 8; ++j) wkv[j] = __expf(aw[ks][j >> 2][j & 3] - mxa);
#pragma unroll
              for (int j2 = 0; j2 < 4; ++j2) { vp[j2] = cvtpk(bflo(vw[j2]) * wkv[2 * j2], bfhi(vw[j2]) * wkv[2 * j2 + 1]); wp2[j2] = cvtpk(wkv[2 * j2], wkv[2 * j2 + 1]); }
              v4u a; a.x = vp[0]; a.y = vp[1]; a.z = vp[2]; a.w = vp[3]; vpf[ks] = __builtin_bit_cast(bf16x8v, a);
              v4u b2; b2.x = wp2[0]; b2.y = wp2[1]; b2.z = wp2[2]; b2.w = wp2[3]; wkf[ks] = __builtin_bit_cast(bf16x8v, b2); }
          nacc = nacc * cs;
#pragma unroll
          for (int ih = 0; ih < 2; ++ih) {
              bf16x8v kf[4][2];
#pragma unroll
              for (int i4 = 0; i4 < 4; ++i4)
#pragma unroll
                  for (int ks = 0; ks < 2; ++ks) { const int i = 4 * ih + i4, r0 = 32 * ks + 8 * kg;
                      const s16x4v lo = tr_read(Ki + 256 * (r0 + q4) + 16 * ((2 * i + (p4 >> 1)) ^ ((q4 << 2) | ((r0 >> 2) & 3))) + 8 * (p4 & 1));
                      const s16x4v hi = tr_read(Ki + 256 * (r0 + 4 + q4) + 16 * ((2 * i + (p4 >> 1)) ^ ((q4 << 2) | (((r0 + 4) >> 2) & 3))) + 8 * (p4 & 1));
                      kf[i4][ks] = __builtin_shufflevector(lo, hi, 0, 1, 2, 3, 4, 5, 6, 7); }
              SBAR();
#pragma unroll
              for (int i4 = 0; i4 < 4; ++i4) { const int i = 4 * ih + i4; Cacc[i] = Cacc[i] * cs;
#pragma unroll
                  for (int ks = 0; ks < 2; ++ks) { Cacc[i] = MFMA16(kf[i4][ks], vpf[ks], Cacc[i]); if (i == w) nacc = MFMA16(kf[i4][ks], wkf[ks], nacc); } }
              SBAR();
          }
          if (l15 == 0) *(LAS f32x4*)(NV + 16 * w + 4 * kg) = nacc;
 }
        if (c + 1 < 32) { LAS unsigned char* Nx = L + M2_IMG + ((c + 1) & 1) * 49152;
            *(LAS v4u*)(Nx + so0) = sq0; *(LAS v4u*)(Nx + so1) = sq1; *(LAS v4u*)(Nx + 16384 + so0) = sk0; *(LAS v4u*)(Nx + 16384 + so1) = sk1; *(LAS v4u*)(Nx + 32768 + so0) = sv0; *(LAS v4u*)(Nx + 32768 + so1) = sv1; }
        LBAR();
#pragma unroll
        for (int tb = 0; tb < 4; ++tb) { const int t = 16 * tb + l15; const LAS float* sp = SSQ + (c & 1) * 512 + t;
            const float tot = ((sp[0] + sp[64]) + (sp[128] + sp[192])) + ((sp[256] + sp[320]) + (sp[384] + sp[448]));
            const float rn = __frsqrt_rn(tot * (1.f / 128.f) + EPS);
            const float y0 = hv[tb].x * rn * gn.x * sigmoidf_(bflo(og[tb].x)), y1 = hv[tb].y * rn * gn.y * sigmoidf_(bfhi(og[tb].x)), y2 = hv[tb].z * rn * gn.z * sigmoidf_(bflo(og[tb].y)), y3 = hv[tb].w * rn * gn.w * sigmoidf_(bfhi(og[tb].y));
            v2u wv; wv.x = cvtpk(y0, y1); wv.y = cvtpk(y2, y3);
            *(v2u*)(Yp + (size_t)(t0 + t) * DM) = wv; }
    }
    LBAR();
}

#ifndef MK_MULTI
#define MK_MULTI 0
#endif
constexpr int PH_PER_LAYER = 12, N_PHASES = 1 + DEPTH * PH_PER_LAYER;
struct Args { const float* in[16]; float* out; unsigned char* ws; int ph_lo, ph_hi; };
static_assert(sizeof(Args) == 16 * 8 + 8 + 8 + 8, "Args has no padding");

__global__ void __launch_bounds__(NWAVES * 64, 2) fwd_kernel(Args args) {
    extern __shared__ __attribute__((aligned(16))) unsigned char lds_raw[];
    LAS unsigned char* L = (LAS unsigned char*)lds_raw;
    const int G0 = gridDim.x, blk0 = blockIdx.x;
    const int wave0 = __builtin_amdgcn_readfirstlane((int)threadIdx.x >> 6);
#define PH_IDS() PH_WS(); int wave = wave0; asm volatile("" : "+s"(wave)); const int lane = fresh_lane(), tid = wave * 64 + lane, gw = blk * NWAVES + wave; (void)gw
#define PH_WS() unsigned char* ws = args.ws; asm volatile("" : "+s"(ws)); int blk = blk0, G = G0; asm volatile("" : "+s"(blk), "+s"(G)); const int NGW = G * NWAVES; (void)NGW; float* xres = args.out; bf16* U = (bf16*)(ws + WS_U); bf16* HB = (bf16*)(ws + WS_HB); bf16* HD = (bf16*)(ws + WS_HD); \
    unsigned char* wl = ws + WS_W + (size_t)l_ * W_LAYER; const float* ng = args.in[1] + (size_t)l_ * 6 * DM; (void)xres; (void)U; (void)HB; (void)HD; (void)wl; (void)ng
    unsigned char* ws0 = args.ws;
    volatile LAS unsigned* MISC = (volatile LAS unsigned*)(L + MISC_OFF);
    { const int tid_e = wave0 * 64 + fresh_lane(); if (tid_e < 16) MISC[tid_e] = 0u; }
    __syncthreads();
    XcdBarrier bar; bar.bar = (unsigned*)(ws0 + WS_CTL) + CW_BAR; bar.x = 0; bar.st = nullptr;
    if (!MK_MULTI) bar = xcd_barrier_post((unsigned*)(ws0 + WS_CTL) + CW_BAR, MISC + 8, wave0 * 64 + fresh_lane() == 0);
    const int lo = args.ph_lo, hi = args.ph_hi;
#define IN(k) (lo <= (k) && (k) < hi)
#define SEAM(k) do { if (IN(k) && IN((k) + 1)) xcd_barrier(bar, wave0 * 64 + fresh_lane() == 0); } while (0)

    if (IN(0)) {
        const int l_ = 0; PH_IDS();
        const float* x_in = args.in[0]; float* cosT = (float*)(ws + WS_TAB + TAB_COS); float* sinT = (float*)(ws + WS_TAB + TAB_SIN); float* b1T = (float*)(ws + WS_TAB + TAB_B1);
        LAS float* scr = (LAS float*)(L + wave * 16384);
        constexpr int I_GU = 16 * 176, I_DN = 44 * 32, I_IN = 16 * 112, I_OUT = 16 * 32, I_CMP = 16 * 16, I_LAYER = 2 * I_GU + 2 * I_DN + I_IN + I_OUT + I_CMP;
        for (int it = gw; it < DEPTH * I_LAYER; it += NGW) {
            const int l = it / I_LAYER; int r = it % I_LAYER; unsigned char* wl = ws + WS_W + (size_t)l * W_LAYER;
            if (r < I_GU) { SrcGU s{args.in[2] + (size_t)l * DM * NGU}; transpose_item(s, DM, (bf16*)(wl + WO_GU1), scr, r / 176, r % 176, lane); continue; } r -= I_GU;
            if (r < I_DN) { SrcPlain s{args.in[3] + (size_t)l * FF * DM, DM}; transpose_item(s, FF, (bf16*)(wl + WO_DN1), scr, r / 32, r % 32, lane); continue; } r -= I_DN;
            if (r < I_GU) { SrcGU s{args.in[4] + (size_t)l * DM * NGU}; transpose_item(s, DM, (bf16*)(wl + WO_GU2), scr, r / 176, r % 176, lane); continue; } r -= I_GU;
            if (r < I_DN) { SrcPlain s{args.in[5] + (size_t)l * FF * DM, DM}; transpose_item(s, FF, (bf16*)(wl + WO_DN2), scr, r / 32, r % 32, lane); continue; } r -= I_DN;
            if (r < I_IN) { SrcIN s{args.in[6] + (size_t)l * DM * INCOLS}; transpose_item(s, DM, (bf16*)(wl + WO_IN), scr, r / 112, r % 112, lane); continue; } r -= I_IN;
            if (r < I_OUT) { SrcPlain s{args.in[7] + (size_t)l * DM * DM, DM}; transpose_item(s, DM, (bf16*)(wl + WO_OUT), scr, r / 32, r % 32, lane); continue; } r -= I_OUT;
            { SrcCMP s{args.in[9] + (size_t)l * 2 * 2048 * 128}; transpose_item(s, DM, (bf16*)(wl + WO_CMP), scr, r / 16, r % 16, lane); }
        }
        for (int i = blk * 512 + tid; i < SEQ * 8; i += G * 512) { const int pos = i >> 3, k = i & 7;
            const double inv = pow(500000.0, -(double)k / 8.0), ang = (double)pos * inv; cosT[i] = (float)cos(ang); sinT[i] = (float)sin(ang); }
        for (int o = gw; o < DEPTH * 2 * 128; o += NGW) { const int lk = o >> 7, c = o & 127; const float* pe = args.in[8] + (size_t)lk * 2048; const float* w1 = args.in[9] + (size_t)lk * 2048 * 128;
            float s = 0.f; for (int r = lane; r < 2048; r += 64) s += pe[r] * w1[(size_t)r * 128 + c];
            s = wave_sum(s, lane); if (lane == 0) b1T[o] = s; }
        thin_phase<3>(nullptr, x_in, nullptr, nullptr, 0.f, args.in[1] + 0 * DM, U, gw, NGW, lane);
    }
    SEAM(0);

#pragma unroll 1
    for (int l = 0; l < DEPTH; ++l) {
        const int pb = 1 + l * PH_PER_LAYER, l_ = l;
        if (IN(pb + 0)) { PH_IDS(); pg8::Gemm g{U, (const bf16*)(wl + WO_GU1), MTOK, NGU, DM}; pg8::StaticOrder S; S.init(MTOK, NGU, G, blk); EpiSwiglu E{HB};
            pg8::gemm_phase<EpiSwiglu, pg8::StaticOrder, true, true>(L, g, S, E, tid); }
        SEAM(pb + 0);
        if (IN(pb + 1)) { PH_IDS(); pg8::Gemm g{HB, (const bf16*)(wl + WO_DN1), MTOK, DM, FF}; pg8::StaticOrder S; S.init(MTOK, DM, G, blk); pg8::EpiBf16<0> E{HD, DM, nullptr, 0, 0, 1.f};
            pg8::gemm_phase<pg8::EpiBf16<0>, pg8::StaticOrder, true, true>(L, g, S, E, tid); }
        SEAM(pb + 1);
        if (IN(pb + 2)) { PH_IDS(); thin_phase<1>(HD, (l_ == 0) ? args.in[0] : (const float*)xres, xres, ng + 1 * DM, 0.5f, ng + 2 * DM, U, gw, NGW, lane); }
        SEAM(pb + 2);
        if (IN(pb + 3)) { PH_IDS(); pg8::Gemm g{U, (const bf16*)(wl + WO_IN), MTOK, NINP, DM}; pg8::StaticOrder S; S.init(MTOK, NINP, G, blk);
            EpiInProj E{ws};
            pg8::gemm_phase<EpiInProj, pg8::StaticOrder, true, true>(L, g, S, E, tid); }
        SEAM(pb + 3);
        if (IN(pb + 4)) { PH_IDS(); pg8::Gemm g{(const bf16*)(ws + WS_KCR), (const bf16*)(wl + WO_CMP), 8192, 512, DM}; CmpOrder S{blk, G}; EpiPQ E{(float*)(ws + WS_PQ)};
            pg8::gemm_phase<EpiPQ, CmpOrder, false, true>(L, g, S, E, tid);
            { const int nb = (G > 32) ? 32 : 0; if (blk >= nb) { mlstm_conv_pass(ws, args.in[11] + (size_t)l_ * 4 * 1024, args.in[12] + (size_t)l_ * 1024, (blk - nb) * 512 + tid, (G - nb) * 512); } } }
        SEAM(pb + 4);
        if (IN(pb + 5)) {
            PH_IDS();
            const float* b1T = (const float*)(ws + WS_TAB + TAB_B1); const float* PQ = (const float*)(ws + WS_PQ); bf16* CC = (bf16*)(ws + WS_CC); LAS float* hs = (LAS float*)(L + wave * 1024);
            for (int r = gw; r < 2 * 32 * 128; r += NGW) {
                const int kv = r >> 12, bgn = r & 4095, n = bgn & 127;
                if (n == 127) { CC[(size_t)r * 64 + lane] = 0; continue; }
                const float* w2 = args.in[10] + (size_t)(l * 2 + kv) * 128 * 64; const float* b1 = b1T + (l * 2 + kv) * 128;
#pragma unroll
                for (int q2 = 0; q2 < 2; ++q2) { const int c = lane + 64 * q2; const float v = PQ[(size_t)r * 256 + c] + PQ[(size_t)(r + 1) * 256 + 128 + c] + b1[c];
                    const float u3 = 0.7978845608028654f * (v + 0.044715f * v * v * v); hs[c] = 0.5f * v * (1.f + tanhf(u3)); }
                LDS_WAIT(); asm volatile("" ::: "memory");
                float o = 0.f;
#pragma unroll 8
                for (int c = 0; c < 128; ++c) o += hs[c] * w2[c * 64 + lane];
                CC[(size_t)r * 64 + lane] = (bf16)f2bf(o);
                LDS_WAIT(); asm volatile("" ::: "memory");
            }
        }
        SEAM(pb + 5);
        if (IN(pb + 6)) {
            PH_IDS();
            MixPtrs P{ws, args.in[11] + (size_t)l * 4 * 1024, args.in[12] + (size_t)l * 1024, args.in[13] + l * 4, args.in[14] + l * 4, args.in[15] + l * 512};
#ifndef PROBE_MIX_REP
#define PROBE_MIX_REP 1
#endif
            for (int rep = 0; rep < PROBE_MIX_REP; ++rep) {
            for (int u = blk; u < 64; u += G) mlstm_unit_mfma(L, P, u >> 2, u & 3, tid);
            { unsigned* qbase = (unsigned*)(ws + WS_CTL) + CW_QUEUE + 1024 * l_; volatile LAS unsigned* QW = (volatile LAS unsigned*)(L + MISC_OFF);
              const unsigned q0 = xb_xcc_id() & 7u;
#pragma unroll 1
              for (unsigned qq = 0; qq < 8u; ++qq) { unsigned* qctr = qbase + 64 * ((q0 + qq) & 7u); const int bg0 = 4 * (int)((q0 + qq) & 7u);
                  __syncthreads();
                  if (tid == 0) QW[0] = __hip_atomic_fetch_add(qctr, 1u, __ATOMIC_RELAXED, __HIP_MEMORY_SCOPE_AGENT);
                  __syncthreads();
                  unsigned u = QW[0];
                  while (u < 128u) { unsigned nxt = 0u; if (tid == 0) nxt = __hip_atomic_fetch_add(qctr, 1u, __ATOMIC_RELAXED, __HIP_MEMORY_SCOPE_AGENT);
                      const int c = 31 - (int)(u & 31u), bg = bg0 + (int)(u >> 5); nsa_unit_mfma(L, P, bg >> 1, bg & 1, c, tid);
                      __syncthreads(); if (tid == 0) QW[0] = nxt; __syncthreads(); u = QW[0]; } } }
            }
        }
        SEAM(pb + 6);
        if (IN(pb + 7)) { PH_IDS(); pg8::Gemm g{U, (const bf16*)(wl + WO_OUT), MTOK, DM, DM}; pg8::StaticOrder S; S.init(MTOK, DM, G, blk); pg8::EpiBf16<0> E{HD, DM, nullptr, 0, 0, 1.f};
            pg8::gemm_phase<pg8::EpiBf16<0>, pg8::StaticOrder, true, true>(L, g, S, E, tid); }
        SEAM(pb + 7);
        if (IN(pb + 8)) { PH_IDS(); thin_phase<1>(HD, xres, xres, ng + 3 * DM, 1.0f, ng + 4 * DM, U, gw, NGW, lane); }
        SEAM(pb + 8);
        if (IN(pb + 9)) { PH_IDS(); pg8::Gemm g{U, (const bf16*)(wl + WO_GU2), MTOK, NGU, DM}; pg8::StaticOrder S; S.init(MTOK, NGU, G, blk); EpiSwiglu E{HB};
            pg8::gemm_phase<EpiSwiglu, pg8::StaticOrder, true, true>(L, g, S, E, tid); }
        SEAM(pb + 9);
        if (IN(pb + 10)) { PH_IDS(); pg8::Gemm g{HB, (const bf16*)(wl + WO_DN2), MTOK, DM, FF}; pg8::StaticOrder S; S.init(MTOK, DM, G, blk); pg8::EpiBf16<0> E{HD, DM, nullptr, 0, 0, 1.f};
            pg8::gemm_phase<pg8::EpiBf16<0>, pg8::StaticOrder, true, true>(L, g, S, E, tid); }
        SEAM(pb + 10);
        if (IN(pb + 11)) { PH_IDS(); if (l + 1 < DEPTH) thin_phase<1>(HD, xres, xres, ng + 5 * DM, 0.5f, ng + 6 * DM, U, gw, NGW, lane);
                           else thin_phase<2>(HD, xres, xres, ng + 5 * DM, 0.5f, nullptr, nullptr, gw, NGW, lane); }
        if (l + 1 < DEPTH) SEAM(pb + 11);
    }
#undef IN
#undef SEAM
#undef PH_IDS
#undef PH_WS
}

extern "C" void kernel_launch(void* const* d_in, const int* in_sizes, int n_in, void* d_out, int out_size, void* d_ws, size_t ws_size, hipStream_t stream) {
    static int grid = 0;
    if (grid == 0) {
        if (n_in != 16 || in_sizes[0] != MTOK * DM || out_size != MTOK * DM || ws_size < WS_END2) { fprintf(stderr, "kernel_launch: unexpected problem (n_in %d, ws %zu)\n", n_in, ws_size); grid = -1; return; }
        int dev = 0, cus = 0, per_cu = 0;
        if (hipGetDevice(&dev) != hipSuccess || hipDeviceGetAttribute(&cus, hipDeviceAttributeMultiprocessorCount, dev) != hipSuccess) { grid = -1; return; }
        if (hipFuncSetAttribute((const void*)fwd_kernel, hipFuncAttributeMaxDynamicSharedMemorySize, LDS_BYTES) != hipSuccess) { grid = -1; return; }
        if (hipOccupancyMaxActiveBlocksPerMultiprocessor(&per_cu, (const void*)fwd_kernel, NWAVES * 64, LDS_BYTES) != hipSuccess || per_cu < 1) { fprintf(stderr, "kernel_launch: occupancy query says %d\n", per_cu); }
        (void)hipGetLastError();
        grid = cus;
    }
    if (grid < 0) return;
    (void)hipMemsetAsync((char*)d_ws + WS_CTL, 0, CTL_ZERO_BYTES, stream);
    Args a{};
    for (int i = 0; i < 16; ++i) a.in[i] = (const float*)d_in[i];
    a.out = (float*)d_out; a.ws = (unsigned char*)d_ws;
#if MK_MULTI
    for (int p = 0; p < N_PHASES; ++p) { a.ph_lo = p; a.ph_hi = p + 1; hipLaunchKernelGGL(fwd_kernel, dim3(grid), dim3(NWAVES * 64), LDS_BYTES, stream, a); }
#else
    a.ph_lo = 0; a.ph_hi = N_PHASES; hipLaunchKernelGGL(fwd_kernel, dim3(grid), dim3(NWAVES * 64), LDS_BYTES, stream, a);
#endif
}
```

```cpp
#include <hip/hip_runtime.h>
#include <cstdio>
#include <cstdint>
namespace pg8 {
#define PG8_LAS __attribute__((address_space(3)))
typedef unsigned short bf16_t;
typedef short bf16x8 __attribute__((ext_vector_type(8)));
typedef float f32x4 __attribute__((ext_vector_type(4)));
typedef unsigned u32x4 __attribute__((ext_vector_type(4)));
constexpr int BM = 256, BK = 64, HALF = 128, HTB = HALF * BK * 2  , STAGE_BYTES = 8 * HTB, NXCD = 8, WGM = 8;

__host__ __device__ __forceinline__ int lds_byte(int r, int c) { const int st = (r >> 4) * 2 + (c >> 5), rr = r & 15, cc = c & 31, ob = rr * 64 + cc * 2; return st * 1024 + (ob ^ (((ob >> 9) & 1) << 5)); }
__host__ __device__ __forceinline__ void stage_rc(int b, int& R, int& C) { const int st = b / 1024, sb = b % 1024, swz = sb ^ (((sb >> 9) & 1) << 5); R = (st >> 1) * 16 + swz / 64; C = (st & 1) * 32 + (swz % 64) / 2; }
__host__ __device__ __forceinline__ int perm32(int rho) { const int n = rho >> 4, i = rho & 15; return 8 * (i >> 2) + 4 * n + (i & 3); }

struct Unit { int pm, pn; };
struct Gemm { const bf16_t* A; const bf16_t* Bt; int M, N, K; };

struct StaticOrder {
    int nM, nN, nwg, G, c;
    __host__ __device__ void init(int M, int N, int G_, int c_) { nM = M / BM; nN = N / BM; nwg = nM * nN; G = G_; c = c_; }
    __host__ __device__ bool next(int i, Unit& u) const {
        const long L = (long)i * G + c; if (L >= nwg) return false;
        int wgid = (int)L; { const int q = nwg / NXCD, r = nwg % NXCD, xcd = wgid % NXCD, off = wgid / NXCD; wgid = (xcd < r ? xcd * (q + 1) : r * (q + 1) + (xcd - r) * q) + off; }
        const int nig = WGM * nN, gid = wgid / nig, fm = gid * WGM, gsz = (nM - fm) < WGM ? (nM - fm) : WGM;
        u.pm = fm + ((wgid % nig) % gsz); u.pn = (wgid % nig) / gsz; return true;
    }
    __device__ __forceinline__ void a_ready(const Unit&) const {}
    __device__ __forceinline__ void done(const Unit&) const {}
};

__device__ __forceinline__ unsigned cvt_pk_bf16(float lo, float hi) { unsigned r; asm volatile("v_cvt_pk_bf16_f32 %0, %1, %2" : "=v"(r) : "v"(lo), "v"(hi)); return r; }
typedef float f32x2 __attribute__((ext_vector_type(2)));
__device__ __forceinline__ f32x2 gelu_pk(f32x2 v) {
    const f32x2 av = __builtin_elementwise_abs(v), d = av * 0.2316418882f + 1.0f;
    f32x2 t; t.x = __builtin_amdgcn_rcpf(d.x); t.y = __builtin_amdgcn_rcpf(d.y);
    f32x2 q = t * 0.5307027145f + (-0.7265760135f); q = q * t + 0.7107068705f; q = q * t + (-0.142248368f); q = q * t + 0.127414796f; q = q * t;
    const f32x2 s = (v * v) * (-0.72134752044f);
    f32x2 e; e.x = __builtin_amdgcn_exp2f(s.x); e.y = __builtin_amdgcn_exp2f(s.y);
    const f32x2 m = v * (q * e), r = v - m;
    f32x2 o; o.x = v.x < 0.f ? m.x : r.x; o.y = v.y < 0.f ? m.y : r.y; return o;
}

template <int ACT  > struct EpiBf16 {
    static constexpr bool PERM = true, AFTER_DRAIN = false; static_assert(ACT == 0 || ACT == 1, "EpiBf16: ACT is 0 (none) or 1 (gelu_pk)");
    bf16_t* O; int ldc; const float* bias; int split_cols; size_t split_stride; float scale0;
    __device__ __forceinline__ void operator()(const f32x4 (&acc)[2][2][4][2], const Unit& u, int wr, int wc, int fr, int fq) const {
        const int row0 = u.pm * BM + wr * 64 + fr; int colt = u.pn * BM; bf16_t* base = O;
        float sc = 1.f; if (split_cols) { const int t = colt / split_cols; base += (size_t)t * split_stride; colt -= t * split_cols; if (t == 0) sc = scale0; }
        const int col0 = colt + wc * 32 + 8 * fq, bcol0 = u.pn * BM + wc * 32 + 8 * fq;
        f32x4 bv[2][2];
#pragma unroll
        for (int bj = 0; bj < 2; ++bj)
#pragma unroll
            for (int n = 0; n < 2; ++n) bv[bj][n] = bias ? *(const f32x4*)(bias + bcol0 + bj * HALF + 4 * n) : (f32x4){0.f, 0.f, 0.f, 0.f};
#pragma unroll
        for (int ai = 0; ai < 2; ++ai)
#pragma unroll
            for (int m = 0; m < 4; ++m) { bf16_t* rowp = base + (size_t)(row0 + ai * HALF + m * 16) * ldc + col0;
#pragma unroll
                for (int bj = 0; bj < 2; ++bj) { f32x4 v0 = acc[ai][bj][m][0] + bv[bj][0], v1 = acc[ai][bj][m][1] + bv[bj][1];
                    if (ACT == 1) { f32x2 a = gelu_pk((f32x2){v0[0], v0[1]}), b = gelu_pk((f32x2){v0[2], v0[3]}), c = gelu_pk((f32x2){v1[0], v1[1]}), d = gelu_pk((f32x2){v1[2], v1[3]});
                        v0 = (f32x4){a.x, a.y, b.x, b.y}; v1 = (f32x4){c.x, c.y, d.x, d.y}; }
                    v0 = v0 * sc; v1 = v1 * sc; u32x4 w; w.x = cvt_pk_bf16(v0[0], v0[1]); w.y = cvt_pk_bf16(v0[2], v0[3]); w.z = cvt_pk_bf16(v1[0], v1[1]); w.w = cvt_pk_bf16(v1[2], v1[3]);
                    *(u32x4*)(rowp + bj * HALF) = w; } }
    }
};
template <class Epi, class Sched, bool ALIGN_EPI = false, bool SP2 = false>
__device__ __forceinline__ void gemm_phase(PG8_LAS unsigned char* lds, const Gemm g, const Sched& S, const Epi& E, int tid_in) {
    int tid_l = tid_in; asm volatile("" : "+v"(tid_l));
    const int tid = tid_l, wid = __builtin_amdgcn_readfirstlane(tid >> 6), lane = tid & 63, wr = wid >> 2, wc = wid & 3, fr = lane & 15, fq = lane >> 4;
    const int K = g.K, nt = K / BK;
    unsigned voffA[2], voffB[2];
#pragma unroll
    for (int i = 0; i < 2; ++i) { int R, C; stage_rc(tid * 16 + i * 8192, R, C); const int Rb = Epi::PERM ? ((R & ~31) + perm32(R & 31)) : R;
        voffA[i] = (unsigned)(R * K + C) * 2u; voffB[i] = (unsigned)(Rb * K + C) * 2u; }
    const size_t kstep = (size_t)(BK * 2);
    const size_t hstep = (size_t)HALF * K * 2;
    const size_t tstep = 2 * hstep;
    const unsigned ldsw = (unsigned)wid * 1024u;
    const int aoff = lds_byte(wr * 64 + fr, fq * 8), boff = lds_byte(wc * 32 + fr, fq * 8);
#define PG8_SA(b, h) (((b) * 2 + (h)) * HTB)
#define PG8_SB(b, h) ((4 + (b) * 2 + (h)) * HTB)
#define PG8_STAGE(bufoff, gbase, voff) do { _Pragma("unroll") for (int _i = 0; _i < 2; ++_i) \
        __builtin_amdgcn_global_load_lds((const unsigned*)((const char*)(gbase) + (voff)[_i]), (PG8_LAS unsigned*)(lds + (bufoff) + ldsw + _i * 8192), 16, 0, 0); } while (0)
#define PG8_LDA(dst, b, h) do { _Pragma("unroll") for (int m = 0; m < 4; ++m) _Pragma("unroll") for (int k = 0; k < 2; ++k) dst[m][k] = *(const PG8_LAS bf16x8*)(lds + PG8_SA(b, h) + aoff + m * 2048 + k * 1024); } while (0)
#define PG8_LDB(dst, b, h) do { _Pragma("unroll") for (int n = 0; n < 2; ++n) _Pragma("unroll") for (int k = 0; k < 2; ++k) dst[n][k] = *(const PG8_LAS bf16x8*)(lds + PG8_SB(b, h) + boff + n * 2048 + k * 1024); } while (0)
#define PG8_MMA(ai, bj, At, Bt) do { __builtin_amdgcn_s_setprio(1); _Pragma("unroll") for (int m = 0; m < 4; ++m) _Pragma("unroll") for (int n = 0; n < 2; ++n) _Pragma("unroll") for (int k = 0; k < 2; ++k) \
        acc[ai][bj][m][n] = __builtin_amdgcn_mfma_f32_16x16x32_bf16(Bt[n][k], At[m][k], acc[ai][bj][m][n], 0, 0, 0); __builtin_amdgcn_s_setprio(0); } while (0)
#define PG8_WAIT_V(n) asm volatile("s_waitcnt vmcnt(" #n ")" ::: "memory")
#define PG8_WAIT_L(n) asm volatile("s_waitcnt lgkmcnt(" #n ")" ::: "memory")
#define PG8_BAR __builtin_amdgcn_s_barrier()
#define PG8_SCHED __builtin_amdgcn_sched_barrier(0)
    Unit cur, nxt; int ui = 0;
    if (!S.next(0, cur)) return;
    f32x4 acc[2][2][4][2];
#pragma unroll
    for (int a = 0; a < 2; ++a)
#pragma unroll
        for (int b = 0; b < 2; ++b)
#pragma unroll
            for (int m = 0; m < 4; ++m)
#pragma unroll
                for (int n = 0; n < 2; ++n) acc[a][b][m][n] = (f32x4){0.f, 0.f, 0.f, 0.f};
    bf16x8 At[4][2], B0[2][2], B1[2][2];
    const char* cA = (const char*)g.A + (size_t)cur.pm * tstep; const char* cB = (const char*)g.Bt + (size_t)cur.pn * tstep;
    S.a_ready(cur);
    if constexpr (SP2) {
        PG8_STAGE(PG8_SB(0, 0), cB, voffB); PG8_STAGE(PG8_SB(0, 1), cB + hstep, voffB); PG8_STAGE(PG8_SA(0, 0), cA, voffA); PG8_STAGE(PG8_SA(0, 1), cA + hstep, voffA);
        if (wr == 1) PG8_BAR;
        PG8_WAIT_V(2); PG8_BAR;
        PG8_STAGE(PG8_SB(1, 0), cB + kstep, voffB); PG8_STAGE(PG8_SA(1, 0), cA + kstep, voffA); PG8_STAGE(PG8_SB(1, 1), cB + hstep + kstep, voffB);
        PG8_WAIT_V(6); PG8_BAR;
    } else {
        PG8_STAGE(PG8_SB(0, 0), cB, voffB); PG8_STAGE(PG8_SA(0, 0), cA, voffA); PG8_STAGE(PG8_SB(0, 1), cB + hstep, voffB); PG8_STAGE(PG8_SA(0, 1), cA + hstep, voffA);
        if (wr == 1) PG8_BAR;
        PG8_WAIT_V(4); PG8_BAR;
        PG8_STAGE(PG8_SB(1, 0), cB + kstep, voffB); PG8_STAGE(PG8_SA(1, 0), cA + kstep, voffA); PG8_STAGE(PG8_SB(1, 1), cB + hstep + kstep, voffB);
        PG8_WAIT_V(6); PG8_BAR;
    }
    for (;;) {
        const bool has_next = S.next(ui + 1, nxt);
        const char* nA = has_next ? (const char*)g.A + (size_t)nxt.pm * tstep : cA; const char* nB = has_next ? (const char*)g.Bt + (size_t)nxt.pn * tstep : cB;
        for (int t = 0; t < nt; t += 2) {
            const bool last = (t == nt - 2);
            const char* a1 = cA + (size_t)(t + 1) * kstep;
            const char* a2 = last ? nA : cA + (size_t)(t + 2) * kstep; const char* b2 = last ? nB : cB + (size_t)(t + 2) * kstep;
            const char* a3 = a2 + kstep; const char* b3 = b2 + kstep;
            if (last && has_next) S.a_ready(nxt);
            if constexpr (SP2) {
            PG8_LDB(B0, 0, 0); PG8_LDB(B1, 0, 1); PG8_SCHED; PG8_LDA(At, 0, 0); PG8_STAGE(PG8_SA(1, 1), a1 + hstep, voffA);
            PG8_WAIT_V(8); PG8_WAIT_L(0); PG8_BAR; PG8_MMA(0, 0, At, B0); PG8_MMA(0, 1, At, B1); PG8_BAR; PG8_SCHED;
            PG8_LDA(At, 0, 1); PG8_STAGE(PG8_SB(0, 0), b2, voffB); PG8_STAGE(PG8_SB(0, 1), b2 + hstep, voffB); PG8_STAGE(PG8_SA(0, 0), a2, voffA);
            PG8_WAIT_V(8); PG8_WAIT_L(0); PG8_BAR; PG8_MMA(1, 0, At, B0); PG8_MMA(1, 1, At, B1); PG8_BAR; PG8_SCHED;
            PG8_LDB(B0, 1, 0); PG8_LDB(B1, 1, 1); PG8_SCHED; PG8_LDA(At, 1, 0); PG8_STAGE(PG8_SA(0, 1), a2 + hstep, voffA);
            PG8_WAIT_V(8); PG8_WAIT_L(0); PG8_BAR; PG8_MMA(0, 0, At, B0); PG8_MMA(0, 1, At, B1); PG8_BAR; PG8_SCHED;
            PG8_LDA(At, 1, 1); PG8_STAGE(PG8_SB(1, 0), b3, voffB); PG8_STAGE(PG8_SB(1, 1), b3 + hstep, voffB); PG8_STAGE(PG8_SA(1, 0), a3, voffA);
            PG8_WAIT_V(8); PG8_WAIT_L(0); PG8_BAR; PG8_MMA(1, 0, At, B0); PG8_MMA(1, 1, At, B1); PG8_BAR; PG8_SCHED;
            } else {
            PG8_LDB(B0, 0, 0); PG8_SCHED; PG8_LDA(At, 0, 0); PG8_STAGE(PG8_SA(1, 1), a1 + hstep, voffA);
            PG8_WAIT_L(8); PG8_BAR; PG8_WAIT_L(0); PG8_MMA(0, 0, At, B0); PG8_BAR; PG8_SCHED;
            PG8_LDB(B1, 0, 1); PG8_STAGE(PG8_SB(0, 0), b2, voffB);
            PG8_BAR; PG8_WAIT_L(0); PG8_MMA(0, 1, At, B1); PG8_BAR;
            PG8_LDA(At, 0, 1); PG8_STAGE(PG8_SA(0, 0), a2, voffA);
            PG8_BAR; PG8_WAIT_L(0); PG8_MMA(1, 0, At, B0); PG8_BAR; PG8_SCHED;
            PG8_STAGE(PG8_SB(0, 1), b2 + hstep, voffB);
            PG8_WAIT_V(6); PG8_BAR; PG8_MMA(1, 1, At, B1); PG8_BAR;
            PG8_LDB(B0, 1, 0); PG8_SCHED; PG8_LDA(At, 1, 0); PG8_STAGE(PG8_SA(0, 1), a2 + hstep, voffA);
            PG8_WAIT_L(8); PG8_BAR; PG8_WAIT_L(0); PG8_MMA(0, 0, At, B0); PG8_BAR; PG8_SCHED;
            PG8_LDB(B1, 1, 1); PG8_STAGE(PG8_SB(1, 0), b3, voffB);
            PG8_BAR; PG8_WAIT_L(0); PG8_MMA(0, 1, At, B1); PG8_BAR;
            PG8_LDA(At, 1, 1); PG8_STAGE(PG8_SA(1, 0), a3, voffA);
            PG8_BAR; PG8_WAIT_L(0); PG8_MMA(1, 0, At, B0); PG8_BAR; PG8_SCHED;
            PG8_STAGE(PG8_SB(1, 1), b3 + hstep, voffB);
            PG8_WAIT_V(6); PG8_BAR; PG8_MMA(1, 1, At, B1); PG8_BAR;
            }
        }
        if constexpr (ALIGN_EPI) { if (wr == 0) PG8_BAR; }
        if constexpr (!Epi::AFTER_DRAIN) { E(acc, cur, wr, wc, fr, fq); S.done(cur); }
        if (!has_next) break;
#pragma unroll
        for (int a = 0; a < 2; ++a)
#pragma unroll
            for (int b = 0; b < 2; ++b)
#pragma unroll
                for (int m = 0; m < 4; ++m)
#pragma unroll
                    for (int n = 0; n < 2; ++n) acc[a][b][m][n] = (f32x4){0.f, 0.f, 0.f, 0.f};
        cur = nxt; cA = nA; cB = nB; ++ui;
        if constexpr (ALIGN_EPI) { if (wr == 1) PG8_BAR; }
    }
    PG8_WAIT_V(0);
    if constexpr (!ALIGN_EPI) { if (wr == 0) PG8_BAR; }
    PG8_BAR;
    if constexpr (Epi::AFTER_DRAIN) { E.fused(acc, cur, wr, wc, fr, fq, lds, wid, lane); S.done(cur); }
#undef PG8_SA
#undef PG8_SB
#undef PG8_STAGE
#undef PG8_LDA
#undef PG8_LDB
#undef PG8_MMA
#undef PG8_WAIT_V
#undef PG8_WAIT_L
#undef PG8_BAR
#undef PG8_SCHED
}
}

#define LAS __attribute__((address_space(3)))
#define XB_TMO      128
#define XB_XCNT(j)  (256  + 64 * (j))
#define XB_XSUB(j)  (1280 + 64 * (j))
#define XB_XGEN(j)  (2304 + 64 * (j))
#define XB_TOP      3328
#define XB_TOPGEN   3392
#define XCD_BAR_WORDS 3456
#define XB_SPIN_CAP (1u << 18)

__device__ __forceinline__ unsigned xb_ld(unsigned* p)              { return __hip_atomic_load(p, __ATOMIC_RELAXED, __HIP_MEMORY_SCOPE_AGENT); }
__device__ __forceinline__ unsigned xb_add(unsigned* p, unsigned v) { return __hip_atomic_fetch_add(p, v, __ATOMIC_RELAXED, __HIP_MEMORY_SCOPE_AGENT); }
__device__ __forceinline__ unsigned xb_xcc_id() { return (unsigned)__builtin_amdgcn_s_getreg((3 << 11) | 20) & 0xFu; }
#define XB_SPIN(cond, bar) do { unsigned _sp = 0; while (cond) { __builtin_amdgcn_s_sleep(1); \
    if ((++_sp & 255u) == 0u) { if (xb_ld(&(bar)[XB_TMO])) break; if (_sp > XB_SPIN_CAP) { atomicAdd(&(bar)[XB_TMO], 1u); break; } } } } while (0)

struct XcdBarrier {
    unsigned* bar; unsigned x;
    volatile LAS unsigned* st;
};

__device__ __forceinline__ XcdBarrier xcd_barrier_post(unsigned* bar, volatile LAS unsigned* st, bool leader) {
    XcdBarrier b; b.bar = bar; b.x = xb_xcc_id(); b.st = st;
    if (leader) (void)xb_add(&bar[XB_XCNT(b.x)], 1u);
    return b;
}
__device__ __forceinline__ void xcd_barrier_complete(unsigned* bar, unsigned x, unsigned& nloc, unsigned& nx) {
    const unsigned G = gridDim.x * gridDim.y * gridDim.z;
    unsigned sum, cnt, mine, sp = 0u;
    for (;;) {
        sum = 0u; cnt = 0u; mine = 0u;
#pragma unroll
        for (unsigned j = 0; j < 16; ++j) { const unsigned c = xb_ld(&bar[XB_XCNT(j)]); sum += c; cnt += (c > 0u) ? 1u : 0u; mine = (j == x) ? c : mine; }
        if (sum == G) break;
        __builtin_amdgcn_s_sleep(1);
        if ((++sp & 255u) == 0u) { if (xb_ld(&bar[XB_TMO])) break; if (sp > XB_SPIN_CAP) { atomicAdd(&bar[XB_TMO], 1u); break; } }
    }
    nloc = mine > 0u ? mine : 1u; nx = cnt > 0u ? cnt : 1u;
}

__device__ __forceinline__ void xcd_barrier(const XcdBarrier& b, bool leader) {
    asm volatile("s_waitcnt vmcnt(0)" ::: "memory");
    __syncthreads();
    if (leader) {
        unsigned* bar = b.bar;
        __builtin_amdgcn_s_waitcnt(0);
        unsigned nloc = b.st[0], nx = b.st[1];
        if (nloc == 0u) { xcd_barrier_complete(bar, b.x, nloc, nx); b.st[0] = nloc; b.st[1] = nx; }
        const unsigned old = xb_add(&bar[XB_XSUB(b.x)], 1u);
        const unsigned gen = old / nloc;
        if (old + 1u == (gen + 1u) * nloc) {
            __builtin_amdgcn_fence(__ATOMIC_RELEASE, "agent");
            asm volatile("s_waitcnt vmcnt(0)" ::: "memory");
            const unsigned og = xb_add(&bar[XB_TOP], 1u);
            const unsigned tg = og / nx;
            if (og + 1u == (tg + 1u) * nx) xb_add(&bar[XB_TOPGEN], 1u);
            else XB_SPIN(xb_ld(&bar[XB_TOPGEN]) == tg, bar);
            __builtin_amdgcn_fence(__ATOMIC_ACQUIRE, "agent");
            xb_add(&bar[XB_XGEN(b.x)], 1u);
            asm volatile("s_waitcnt vmcnt(0)" ::: "memory");
        } else {
            XB_SPIN(xb_ld(&bar[XB_XGEN(b.x)]) == gen, bar);
            __builtin_amdgcn_fence(__ATOMIC_ACQUIRE, "agent");
            asm volatile("s_waitcnt vmcnt(0)" ::: "memory");
        }
    }
    __syncthreads();
}

constexpr int BATCH = 16, SEQ = 2048, DM = 1024, MTOK = BATCH * SEQ, FF = 2816, NGU = 2 * FF, NINP = 3584, INCOLS = 3360, DEPTH = 2;
constexpr int NWAVES = 8;
constexpr float EPS = 1e-6f;
typedef unsigned short bf16;
typedef unsigned v4u __attribute__((ext_vector_type(4)));
typedef unsigned v2u __attribute__((ext_vector_type(2)));
typedef float f32x4 __attribute__((ext_vector_type(4)));
#define LDS_WAIT() asm volatile("s_waitcnt lgkmcnt(0)" ::: "memory")

constexpr size_t MiB = 1u << 20;
constexpr size_t WS_CTL = 0, CTL_ZERO_BYTES = MiB;
constexpr size_t WS_TAB = 1 * MiB;
constexpr size_t TAB_COS = 0, TAB_SIN = 65536, TAB_B1 = 131072, TAB_R2 = 262144;
constexpr size_t WS_W = 2 * MiB;
constexpr size_t WO_GU1 = 0, WO_DN1 = 11 * MiB, WO_GU2 = 16 * MiB + MiB / 2, WO_DN2 = 27 * MiB + MiB / 2, WO_IN = 33 * MiB, WO_OUT = 40 * MiB, WO_CMP = 42 * MiB;
constexpr size_t WS_X16 = 45 * MiB;
constexpr size_t WS_U = 109 * MiB;
constexpr size_t WS_HB = 173 * MiB;
constexpr size_t WS_HD = 349 * MiB;
constexpr size_t WS_PQ = 413 * MiB;
constexpr size_t WS_CC = 421 * MiB;
constexpr size_t WS_END = 422 * MiB;
constexpr size_t WS_QN = 173 * MiB, WS_KCR = 205 * MiB, WS_VCR = 213 * MiB, WS_KS = 221 * MiB, WS_VS = 229 * MiB, WS_KW = 237 * MiB, WS_VW = 245 * MiB;
constexpr size_t WS_MQ = 253 * MiB, WS_MK = 285 * MiB, WS_MV = 317 * MiB, WS_MO = 349 * MiB, WS_GATE = 381 * MiB;
static_assert(WS_GATE + 4 * MiB <= WS_PQ, "in-projection outputs end below PQ");
constexpr int CW_BAR = 4096, CW_QUEUE = 16384;
constexpr int PH_BYTES = 143360, MISC_OFF = PH_BYTES, LDS_BYTES = 147456;

__device__ __forceinline__ unsigned f2bf(float f) { unsigned u = __builtin_bit_cast(unsigned, f); return (u + 0x7fffu + ((u >> 16) & 1u)) >> 16; }
__device__ __forceinline__ unsigned pk2(float lo, float hi) { return f2bf(lo) | (f2bf(hi) << 16); }
typedef float f32x2v_ __attribute__((ext_vector_type(2))); typedef __bf16 bf16x2v_ __attribute__((ext_vector_type(2)));
__device__ __forceinline__ unsigned cvtpk(float lo, float hi) { f32x2v_ v = {lo, hi}; bf16x2v_ b = __builtin_convertvector(v, bf16x2v_); return __builtin_bit_cast(unsigned, b); }
__device__ __forceinline__ float bflo(unsigned u) { return __builtin_bit_cast(float, u << 16); }
__device__ __forceinline__ float bfhi(unsigned u) { return __builtin_bit_cast(float, u & 0xffff0000u); }
__device__ __forceinline__ float bf2f(bf16 b) { return __builtin_bit_cast(float, (unsigned)b << 16); }
__device__ __forceinline__ float sigmoidf_(float x) { return __builtin_amdgcn_rcpf(1.f + __expf(-x)); }
__device__ __forceinline__ int fresh_lane() { unsigned z = 0u; asm volatile("" : "+v"(z)); return (int)__builtin_amdgcn_mbcnt_hi(~0u, __builtin_amdgcn_mbcnt_lo(~0u, z)); }
__device__ __forceinline__ float shx(float v, int mask, int lane) { return __builtin_bit_cast(float, __builtin_amdgcn_ds_bpermute((lane ^ mask) << 2, __builtin_bit_cast(int, v))); }
__device__ __forceinline__ unsigned shxu(unsigned v, int mask, int lane) { return (unsigned)__builtin_amdgcn_ds_bpermute((lane ^ mask) << 2, (int)v); }
__device__ __forceinline__ float shi(float v, int src) { return __builtin_bit_cast(float, __builtin_amdgcn_ds_bpermute(src << 2, __builtin_bit_cast(int, v))); }
__device__ __forceinline__ float wave_sum(float v, int lane) {
    (void)lane;
    v += __builtin_bit_cast(float, __builtin_amdgcn_update_dpp(0, __builtin_bit_cast(int, v), 0xB1, 0xF, 0xF, false));
    v += __builtin_bit_cast(float, __builtin_amdgcn_update_dpp(0, __builtin_bit_cast(int, v), 0x4E, 0xF, 0xF, false));
    v += __builtin_bit_cast(float, __builtin_amdgcn_update_dpp(0, __builtin_bit_cast(int, v), 0x124, 0xF, 0xF, false));
    v += __builtin_bit_cast(float, __builtin_amdgcn_update_dpp(0, __builtin_bit_cast(int, v), 0x128, 0xF, 0xF, false));
    const int iv = __builtin_bit_cast(int, v);
    const float a = __builtin_bit_cast(float, __builtin_amdgcn_readlane(iv, 0)), b = __builtin_bit_cast(float, __builtin_amdgcn_readlane(iv, 16));
    const float c = __builtin_bit_cast(float, __builtin_amdgcn_readlane(iv, 32)), d = __builtin_bit_cast(float, __builtin_amdgcn_readlane(iv, 48));
    return (a + b) + (c + d);
}

struct SrcGU { const float* W; const float* g; __device__ __forceinline__ float operator()(int k, int nd) const { const int pn = nd >> 8, r = nd & 255; const int col = (r < 128) ? (pn * 128 + r) : (FF + pn * 128 + r - 128); return W[(size_t)k * NGU + col] * g[k]; } };
struct SrcPlain { const float* W; int N; __device__ __forceinline__ float operator()(int k, int nd) const { return W[(size_t)k * N + nd]; } };
struct SrcIN { const float* W; const float* g; __device__ __forceinline__ float operator()(int k, int nd) const {
    const int col = nd < 1280 ? nd : (nd < 3328 ? nd + 24 : (nd < 3352 ? nd - 3328 + 1280 : (nd < 3360 ? nd : -1)));
    return col < 0 ? 0.f : W[(size_t)k * INCOLS + col] * g[k]; } };
struct SrcCMP { const float* W1; __device__ __forceinline__ float operator()(int k, int nd) const { const int kv = nd >> 8, r = nd & 255;
    return r < 128 ? W1[((size_t)kv * 2048 + k) * 128 + r] : W1[((size_t)kv * 2048 + 1024 + k) * 128 + r - 128]; } };

template <class SrcF>
__device__ __forceinline__ void transpose_item(const SrcF& src, int K, bf16* WT, LAS float* scr, int kb, int nb, int lane) {
    const int k0 = 64 * kb, n0 = 32 * nb;
#pragma unroll 8
    for (int i = 0; i < 32; ++i) { const int kk = 2 * i + (lane >> 5); scr[kk * 33 + (lane & 31)] = src(k0 + kk, n0 + (lane & 31)); }
    LDS_WAIT(); asm volatile("" ::: "memory");
    const int c = lane & 7;
#pragma unroll
    for (int j = 0; j < 4; ++j) { const int n = (lane >> 3) + 8 * j; const LAS float* s = scr + (8 * c) * 33 + n;
        v4u o; o.x = pk2(s[0 * 33], s[1 * 33]); o.y = pk2(s[2 * 33], s[3 * 33]); o.z = pk2(s[4 * 33], s[5 * 33]); o.w = pk2(s[6 * 33], s[7 * 33]);
        *(v4u*)(WT + (size_t)(n0 + n) * K + k0 + 8 * c) = o; }
    LDS_WAIT(); asm volatile("" ::: "memory");
}

template <int MODE>
__device__ __forceinline__ void thin_phase(const bf16* HD, const float* xin_f32, bf16* X16, float* out_f32, float* R2, const float* gpost, float cc, int gw, int NGW, int lane) {
    f32x4 gp[4];
#pragma unroll
    for (int j = 0; j < 4; ++j) gp[j] = (MODE != 0) ? *(const f32x4*)(gpost + 4 * lane + 256 * j) : (f32x4){0.f, 0.f, 0.f, 0.f};
    f32x4 xf[4]; v2u xn[4], hn[4];
    if (gw < MTOK) {
#pragma unroll
        for (int j = 0; j < 4; ++j) { if (MODE == 0) xf[j] = *(const f32x4*)(xin_f32 + (size_t)gw * DM + 4 * lane + 256 * j);
            else { xn[j] = *(const v2u*)(X16 + (size_t)gw * DM + 4 * lane + 256 * j); hn[j] = *(const v2u*)(HD + (size_t)gw * DM + 4 * lane + 256 * j); } }
    }
    for (int m = gw; m < MTOK; m += NGW) {
        f32x4 x[4]; v2u hw[4];
#pragma unroll
        for (int j = 0; j < 4; ++j) { if (MODE == 0) x[j] = xf[j]; else { x[j] = (f32x4){bflo(xn[j].x), bfhi(xn[j].x), bflo(xn[j].y), bfhi(xn[j].y)}; hw[j] = hn[j]; } }
        const int m2 = m + NGW;
        if (m2 < MTOK) {
#pragma unroll
            for (int j = 0; j < 4; ++j) { if (MODE == 0) xf[j] = *(const f32x4*)(xin_f32 + (size_t)m2 * DM + 4 * lane + 256 * j);
                else { xn[j] = *(const v2u*)(X16 + (size_t)m2 * DM + 4 * lane + 256 * j); hn[j] = *(const v2u*)(HD + (size_t)m2 * DM + 4 * lane + 256 * j); } }
        }
        if (MODE != 0) {
            f32x4 h[4]; float ss = 0.f;
#pragma unroll
            for (int j = 0; j < 4; ++j) { h[j] = (f32x4){bflo(hw[j].x), bfhi(hw[j].x), bflo(hw[j].y), bfhi(hw[j].y)}; ss += (h[j].x * h[j].x + h[j].y * h[j].y) + (h[j].z * h[j].z + h[j].w * h[j].w); }
            const float r = cc * __frsqrt_rn(wave_sum(ss, lane) * (1.f / DM) + EPS);
#pragma unroll
            for (int j = 0; j < 4; ++j) x[j] = x[j] + (h[j] * r) * gp[j];
        }
        if (MODE == 2) {
#pragma unroll
            for (int j = 0; j < 4; ++j) *(f32x4*)(out_f32 + (size_t)m * DM + 4 * lane + 256 * j) = x[j];
        } else {
            float s2 = 0.f;
#pragma unroll
            for (int j = 0; j < 4; ++j) { s2 += (x[j].x * x[j].x + x[j].y * x[j].y) + (x[j].z * x[j].z + x[j].w * x[j].w);
                v2u w; w.x = cvtpk(x[j].x, x[j].y); w.y = cvtpk(x[j].z, x[j].w); *(v2u*)(X16 + (size_t)m * DM + 4 * lane + 256 * j) = w; }
            const float r2 = __frsqrt_rn(wave_sum(s2, lane) * (1.f / DM) + EPS);
            if (lane == 0) R2[m] = r2;
        }
    }
}

struct EpiSwiglu {
    static constexpr bool PERM = true, AFTER_DRAIN = false;
    bf16* H; const float* R2;
    __device__ __forceinline__ void operator()(const pg8::f32x4 (&acc)[2][2][4][2], const pg8::Unit& u, int wr, int wc, int fr, int fq) const {
#pragma unroll
        for (int ai = 0; ai < 2; ++ai)
#pragma unroll
            for (int m = 0; m < 4; ++m) {
                const int row = u.pm * 256 + ai * 128 + wr * 64 + m * 16 + fr; const float rs = R2[row];
                float o[8];
#pragma unroll
                for (int n = 0; n < 2; ++n)
#pragma unroll
                    for (int e = 0; e < 4; ++e) { const float g = acc[ai][0][m][n][e] * rs, up = acc[ai][1][m][n][e] * rs; o[n * 4 + e] = g * up * __builtin_amdgcn_rcpf(1.f + __expf(-g)); }
                v4u w; w.x = pg8::cvt_pk_bf16(o[0], o[1]); w.y = pg8::cvt_pk_bf16(o[2], o[3]); w.z = pg8::cvt_pk_bf16(o[4], o[5]); w.w = pg8::cvt_pk_bf16(o[6], o[7]);
                *(v4u*)(H + (size_t)row * FF + u.pn * 128 + wc * 32 + fq * 8) = w;
            }
    }
};
struct EpiPQ {
    static constexpr bool PERM = true, AFTER_DRAIN = false;
    float* O;
    __device__ __forceinline__ void operator()(const pg8::f32x4 (&acc)[2][2][4][2], const pg8::Unit& u, int wr, int wc, int fr, int fq) const {
#pragma unroll
        for (int ai = 0; ai < 2; ++ai)
#pragma unroll
            for (int m = 0; m < 4; ++m) {
                const int row = u.pm * 256 + ai * 128 + wr * 64 + m * 16 + fr;
#pragma unroll
                for (int bj = 0; bj < 2; ++bj) { float* p = O + (size_t)row * 256 + bj * 128 + wc * 32 + fq * 8;
                    *(pg8::f32x4*)p = acc[ai][bj][m][0]; *(pg8::f32x4*)(p + 4) = acc[ai][bj][m][1]; }
            }
    }
};
struct CmpOrder {
    int c, G;
    __device__ __forceinline__ bool next(int i, pg8::Unit& u) const { const int idx = i * G + c; if (idx >= 32) return false; u.pm = idx; u.pn = idx >> 4; return true; }
    __device__ __forceinline__ void a_ready(const pg8::Unit&) const {}
    __device__ __forceinline__ void done(const pg8::Unit&) const {}
};
struct EpiInProj {
    static constexpr bool PERM = true, AFTER_DRAIN = false;
    unsigned char* ws;
    __device__ __forceinline__ void operator()(const pg8::f32x4 (&acc)[2][2][4][2], const pg8::Unit& u, int wr, int wc, int fr, int fq) const {
        const int pn = u.pn;
        const float* cosT = (const float*)(ws + WS_TAB + TAB_COS); const float* sinT = (const float*)(ws + WS_TAB + TAB_SIN);
        const bool ropet = (pn < 2) || (pn == 3) || (pn == 4);
        const bool ropew = ropet && ((wc & 1) == 0);
#pragma unroll
        for (int ai = 0; ai < 2; ++ai)
#pragma unroll
            for (int m = 0; m < 4; ++m) {
                const int row = u.pm * 256 + ai * 128 + wr * 64 + m * 16 + fr;
                const int b = row >> 11, t = row & 2047; const float rs = ((const float*)(ws + WS_TAB + TAB_R2))[row];
                f32x4 c0, c1, s0, s1;
                if (ropew) { c0 = *(const f32x4*)(cosT + t * 8); c1 = *(const f32x4*)(cosT + t * 8 + 4); s0 = *(const f32x4*)(sinT + t * 8); s1 = *(const f32x4*)(sinT + t * 8 + 4); }
#pragma unroll
                for (int bj = 0; bj < 2; ++bj) {
                    f32x4 v0 = acc[ai][bj][m][0] * rs, v1 = acc[ai][bj][m][1] * rs;
                    const int cl = bj * 128 + wc * 32 + fq * 8;
                    if (ropew && (pn < 2 || bj == 0)) {
                        f32x4 p0, p1; const int ln = fq * 16 + fr;
                        p0.x = shx(v0.x, 16, ln); p0.y = shx(v0.y, 16, ln); p0.z = shx(v0.z, 16, ln); p0.w = shx(v0.w, 16, ln);
                        p1.x = shx(v1.x, 16, ln); p1.y = shx(v1.y, 16, ln); p1.z = shx(v1.z, 16, ln); p1.w = shx(v1.w, 16, ln);
                        const float sg = (fq == 0) ? -1.f : 1.f;
                        if (fq < 2) { v0 = v0 * c0 + (p0 * s0) * sg; v1 = v1 * c1 + (p1 * s1) * sg; }
                    }
                    if (pn == 13) { if (cl < 32) { float* p = (float*)(ws + WS_GATE) + (size_t)row * 32 + cl; *(f32x4*)p = v0; *(f32x4*)(p + 4) = v1; } }
                    else {
                        size_t off;
                        if (pn < 2) off = WS_QN + ((size_t)row * 512 + pn * 256 + cl) * 2;
                        else if (pn < 5) { const int g = wc >> 1, d = (wc & 1) * 32 + fq * 8; off = WS_KCR + (size_t)((pn - 2) * 2 + bj) * (8 * MiB) + (((size_t)(b * 2 + g) * SEQ + t) * 64 + d) * 2; }
                        else { const int q = pn - 5; off = WS_MQ + (size_t)(q >> 1) * (32 * MiB) + ((size_t)row * 512 + (q & 1) * 256 + cl) * 2; }
                        v4u w; w.x = pg8::cvt_pk_bf16(v0.x, v0.y); w.y = pg8::cvt_pk_bf16(v0.z, v0.w); w.z = pg8::cvt_pk_bf16(v1.x, v1.y); w.w = pg8::cvt_pk_bf16(v1.z, v1.w);
                        *(v4u*)(ws + off) = w;
                    }
                }
            }
    }
};
static_assert(WS_VCR == WS_KCR + 8 * MiB && WS_KS == WS_KCR + 16 * MiB && WS_VS == WS_KCR + 24 * MiB && WS_KW == WS_KCR + 32 * MiB && WS_VW == WS_KCR + 40 * MiB, "kv buffers are 8 MiB apart in (pn, bj) order");
static_assert(WS_MK == WS_MQ + 32 * MiB && WS_MV == WS_MQ + 64 * MiB && WS_MO == WS_MQ + 96 * MiB, "mLSTM buffers are 32 MiB apart");

struct MixPtrs { unsigned char* ws; const float *conv_w, *conv_b, *i_bias, *f_bias, *mnorm_g; };
#define MP_QN ((const bf16*)(P.ws + WS_QN))
#define MP_KS ((const bf16*)(P.ws + WS_KS))
#define MP_VS ((const bf16*)(P.ws + WS_VS))
#define MP_KW ((const bf16*)(P.ws + WS_KW))
#define MP_VW ((const bf16*)(P.ws + WS_VW))
#define MP_KC ((const bf16*)(P.ws + WS_CC))
#define MP_VC ((const bf16*)(P.ws + WS_CC) + (size_t)4096 * 64)
#define MP_MQ ((const bf16*)(P.ws + WS_MQ))
#define MP_MK ((const bf16*)(P.ws + WS_MK))
#define MP_MV ((const bf16*)(P.ws + WS_MV))
#define MP_MO ((const bf16*)(P.ws + WS_MO))
#define MP_GATE ((const float*)(P.ws + WS_GATE))
#define MP_Y ((bf16*)(P.ws + WS_U))


typedef float f32x16 __attribute__((ext_vector_type(16)));
typedef short bf16x8v __attribute__((ext_vector_type(8)));
typedef short s16x4v __attribute__((ext_vector_type(4)));
typedef float f32x2v __attribute__((ext_vector_type(2)));
typedef __bf16 bf16x2v __attribute__((ext_vector_type(2)));
#define MFMA32(a, b, c) __builtin_amdgcn_mfma_f32_32x32x16_bf16((a), (b), (c), 0, 0, 0)
__device__ __forceinline__ s16x4v tr_read(const LAS unsigned char* p) { return __builtin_bit_cast(s16x4v, __builtin_amdgcn_ds_read_tr16_b64_v4i16((LAS s16x4v*)p)); }
__device__ __forceinline__ int tile_off(int key, int ch8) { return (ch8 >> 2) * 4096 + key * 64 + (((ch8 & 3) ^ ((key >> 2) & 3)) << 4); }
constexpr int NM_SLOT = 0, NM_IMP = 65536, NM_IMS = 99328, NM_SEL = 108544, NM_ITEM = 108864;
constexpr float QK_SCALE = 0.125f * 1.4426950408889634f;

#define SBAR() __builtin_amdgcn_sched_barrier(0)
#define LBAR() asm volatile("s_waitcnt lgkmcnt(0)\n\ts_barrier" ::: "memory")
__device__ __forceinline__ void k_load(const LAS unsigned char* Ks, int r, int h, bf16x8v (&kf)[8]) {
    const int sw = (r >> 2) & 3;
#pragma unroll
    for (int ks = 0; ks < 4; ++ks) { const int off = (ks >> 1) * 4096 + r * 64 + (((((ks & 1) << 1) + h) ^ sw) << 4);
        kf[2 * ks] = *(const LAS bf16x8v*)(Ks + off); kf[2 * ks + 1] = *(const LAS bf16x8v*)(Ks + off + 2048); }
}
__device__ __forceinline__ void qk_mma(const bf16x8v (&kf)[8], const bf16x8v (&qf)[4], f32x16& p0, f32x16& p1) {
    const f32x16 z = {0.f, 0.f, 0.f, 0.f, 0.f, 0.f, 0.f, 0.f, 0.f, 0.f, 0.f, 0.f, 0.f, 0.f, 0.f, 0.f};
#pragma unroll
    for (int ks = 0; ks < 4; ++ks) { p0 = MFMA32(kf[2 * ks], qf[ks], ks ? p0 : z); p1 = MFMA32(kf[2 * ks + 1], qf[ks], ks ? p1 : z); }
}
__device__ __forceinline__ void v_load(const LAS unsigned char* Vs, int lane, bf16x8v (&vf)[8]) {
    const int h = lane >> 5, i16 = lane & 15, q = i16 >> 2, p = i16 & 3, gi = (lane >> 4) & 1;
    const int cidx = 2 * gi + (p >> 1), e8 = (p & 1) << 3;
    const int offlo = q * 64 + ((cidx ^ h) << 4) + e8 + h * 256, offhi = q * 64 + ((cidx ^ (h | 2)) << 4) + e8 + h * 256 + 512;
#pragma unroll
    for (int kb = 0; kb < 2; ++kb)
#pragma unroll
        for (int s = 0; s < 2; ++s)
#pragma unroll
            for (int db = 0; db < 2; ++db) { const LAS unsigned char* base = Vs + db * 4096 + (kb * 32 + s * 16) * 64;
                const s16x4v lo = tr_read(base + offlo), hi = tr_read(base + offhi);
                vf[(kb * 2 + s) * 2 + db] = __builtin_shufflevector(lo, hi, 0, 1, 2, 3, 4, 5, 6, 7); }
}
__device__ __forceinline__ void pv_mma(const bf16x8v (&vf)[8], const f32x16& p0, const f32x16& p1, f32x16 (&o)[2]) {
#pragma unroll
    for (int kb = 0; kb < 2; ++kb)
#pragma unroll
        for (int s = 0; s < 2; ++s) {
            const f32x16& P = kb ? p1 : p0;
            v4u pw; pw.x = cvtpk(P[8 * s + 0], P[8 * s + 1]); pw.y = cvtpk(P[8 * s + 2], P[8 * s + 3]); pw.z = cvtpk(P[8 * s + 4], P[8 * s + 5]); pw.w = cvtpk(P[8 * s + 6], P[8 * s + 7]);
            const bf16x8v pf = __builtin_bit_cast(bf16x8v, pw);
            o[0] = MFMA32(vf[(kb * 2 + s) * 2], pf, o[0]); o[1] = MFMA32(vf[(kb * 2 + s) * 2 + 1], pf, o[1]);
        }
}

__device__ __forceinline__ void nsa_unit_mfma(LAS unsigned char* L, const MixPtrs& P, int b, int g, int c, int tid_in) {
    int tid_l = tid_in; asm volatile("" : "+v"(tid_l));
    const int tid = tid_l, lane = tid & 63, w = __builtin_amdgcn_readfirstlane(tid >> 6);
    const int r = lane & 31, h = lane >> 5, head = w >> 1, qi = (w & 1) * 32 + r, t = c * 64 + qi;
    const size_t row = (size_t)b * SEQ + t;
    LAS unsigned* SEL = (LAS unsigned*)(L + NM_SEL); LAS int* ITEM = (LAS int*)(L + NM_ITEM);
    const size_t kvbase = (size_t)(b * 2 + g) * SEQ * 64, ccbase = (size_t)(b * 2 + g) * 128 * 64;
    const int skey = tid >> 3, sch = tid & 7, soff = tile_off(skey, sch);
    bf16x8v qf[4];
    { const bf16* qp = MP_QN + row * 512 + (g * 4 + head) * 64 + 8 * h;
#pragma unroll
      for (int ks = 0; ks < 4; ++ks) qf[ks] = *(const bf16x8v*)(qp + 16 * ks); }
    const float* gp = MP_GATE + row * 32 + g * 4 + head;
    float one = 1.f; asm volatile("" : "+v"(one));
    const float gate_c = __builtin_amdgcn_rcpf(one + __expf(-gp[0])), gate_s = __builtin_amdgcn_rcpf(one + __expf(-gp[8])), gate_w = __builtin_amdgcn_rcpf(one + __expf(-gp[16]));
    f32x16 oacc[2];
    {
        const bf16* kc = MP_KC + ccbase; const bf16* vc = MP_VC + ccbase;
        const v4u k0 = *(const v4u*)(kc + tid * 8), k1 = *(const v4u*)(kc + 4096 + tid * 8), v0 = *(const v4u*)(vc + tid * 8), v1 = *(const v4u*)(vc + 4096 + tid * 8);
        LBAR();
        *(LAS v4u*)(L + NM_SLOT + soff) = k0; *(LAS v4u*)(L + NM_SLOT + 8192 + soff) = v0; *(LAS v4u*)(L + NM_SLOT + 16384 + soff) = k1; *(LAS v4u*)(L + NM_SLOT + 24576 + soff) = v1;
        if (tid < 64) SEL[tid] = 0u;
        LBAR();
        f32x16 s0, s1, s2, s3;
        { bf16x8v kfa[8], kfb[8]; k_load(L + NM_SLOT, r, h, kfa); k_load(L + NM_SLOT + 16384, r, h, kfb); SBAR(); qk_mma(kfa, qf, s0, s1); qk_mma(kfb, qf, s2, s3); }
        const int nlim = (t >= 31) ? (((t - 31) >> 4) < 126 ? ((t - 31) >> 4) : 126) : -1;
        float mx = -1e20f;
#pragma unroll
        for (int e = 0; e < 16; ++e) { const int cr = (e & 3) + 8 * (e >> 2) + 4 * h;
            s0[e] = (cr <= nlim) ? s0[e] * QK_SCALE : -1e30f; s1[e] = (cr + 32 <= nlim) ? s1[e] * QK_SCALE : -1e30f;
            s2[e] = (cr + 64 <= nlim) ? s2[e] * QK_SCALE : -1e30f; s3[e] = (cr + 96 <= nlim) ? s3[e] * QK_SCALE : -1e30f;
            mx = fmaxf(fmaxf(mx, fmaxf(s0[e], s1[e])), fmaxf(s2[e], s3[e])); }
        mx = fmaxf(mx, shx(mx, 32, lane));
        float ls = 0.f;
#pragma unroll
        for (int e = 0; e < 16; ++e) { s0[e] = __builtin_amdgcn_exp2f(s0[e] - mx); s1[e] = __builtin_amdgcn_exp2f(s1[e] - mx); s2[e] = __builtin_amdgcn_exp2f(s2[e] - mx); s3[e] = __builtin_amdgcn_exp2f(s3[e] - mx);
            ls += (s0[e] + s1[e]) + (s2[e] + s3[e]); }
        ls += shx(ls, 32, lane);
        const float il = (ls > 0.f) ? __builtin_amdgcn_rcpf(ls) : 0.f;
#pragma unroll
        for (int e = 0; e < 16; ++e) { s0[e] *= il; s1[e] *= il; s2[e] *= il; s3[e] *= il; }
        { LAS float* IMP = (LAS float*)(L + NM_IMP) + (w * 32 + r) * 33; float plprev = 0.f;
#pragma unroll
          for (int x = 0; x < 16; ++x) {
              const f32x16& S = (x < 4) ? s0 : ((x < 8) ? s1 : ((x < 12) ? s2 : s3)); const int g4 = (x & 3) * 4;
              const float own = (S[g4] + S[g4 + 1]) + (S[g4 + 2] + S[g4 + 3]);
              const float pl = shx(S[g4 + 3], 32, lane);
              if (h == 1) IMP[2 * x + 1] = own + pl; else IMP[2 * x] = own + plprev;
              plprev = pl;
          }
        }
        oacc[0] = (f32x16){0.f, 0.f, 0.f, 0.f, 0.f, 0.f, 0.f, 0.f, 0.f, 0.f, 0.f, 0.f, 0.f, 0.f, 0.f, 0.f}; oacc[1] = oacc[0];
        { bf16x8v vfa[8], vfb[8]; v_load(L + NM_SLOT + 8192, lane, vfa); v_load(L + NM_SLOT + 24576, lane, vfb); SBAR(); pv_mma(vfa, s0, s1, oacc); pv_mma(vfb, s2, s3, oacc); }
#pragma unroll
        for (int e = 0; e < 16; ++e) { oacc[0][e] *= gate_c; oacc[1][e] *= gate_c; }
    }
    LBAR();
    { const int i = tid & 63, jg = tid >> 6; const LAS float* I8 = (const LAS float*)(L + NM_IMP); LAS float* IMS = (LAS float*)(L + NM_IMS);
#pragma unroll
      for (int jj = 0; jj < 4; ++jj) { const int j = 4 * jg + jj; const int wq = (i >> 5), rq = i & 31;
          IMS[i * 36 + j] = (I8[((0 + wq) * 32 + rq) * 33 + j] + I8[((2 + wq) * 32 + rq) * 33 + j]) + (I8[((4 + wq) * 32 + rq) * 33 + j] + I8[((6 + wq) * 32 + rq) * 33 + j]); }
      LBAR();
      unsigned bits = 0u;
      if (c + 1 <= 16) { if (jg == 0) bits = (1u << (c + 1)) - 1u; }
      else { if (jg == 0) bits = 1u | (1u << c) | (1u << (c - 1));
          { float iv[32];
#pragma unroll
            for (int q8 = 0; q8 < 8; ++q8) { const f32x4 x = *(const LAS f32x4*)(IMS + i * 36 + 4 * q8); iv[4 * q8] = x.x; iv[4 * q8 + 1] = x.y; iv[4 * q8 + 2] = x.z; iv[4 * q8 + 3] = x.w; }
#pragma unroll
            for (int jj = 0; jj < 4; ++jj) { const int j = 4 * jg + jj; const float vj = IMS[i * 36 + j]; int rank = 0;
#pragma unroll
                for (int i2 = 1; i2 < 30; ++i2) rank += (i2 <= c - 2 && (iv[i2] > vj || (iv[i2] == vj && i2 < j))) ? 1 : 0;
                if (j >= 1 && j <= c - 2 && rank < 13) bits |= 1u << j; } } }
      if (bits) atomicOr((unsigned*)&SEL[i], bits);
      LBAR();
      if (w == 0) { unsigned so = SEL[lane];
#pragma unroll
          for (int o2 = 32; o2; o2 >>= 1) so |= shxu(so, o2, lane);
          if (lane == 0) { int n = 0; for (int j = 0; j <= c; ++j) if ((so >> j) & 1u) ITEM[n++] = j; const int j0 = (c - 8 > 0) ? c - 8 : 0; for (int j = j0; j <= c; ++j) ITEM[n++] = 64 + j; ITEM[n] = -1; ITEM[47] = n; } }
      LBAR();
    }
    const unsigned mysel = SEL[qi]; const int nitem = ITEM[47];
    f32x16 o[2]; float m = -1e20f, lsum = 0.f; int prev_kind = 0;
    o[0] = (f32x16){0.f, 0.f, 0.f, 0.f, 0.f, 0.f, 0.f, 0.f, 0.f, 0.f, 0.f, 0.f, 0.f, 0.f, 0.f, 0.f}; o[1] = o[0];
    const int npair = (nitem + 1) >> 1;
    v4u rk0, rv0, rk1, rv1;
#define NSA_LOAD_PAIR(ip_) do { const int ia_ = ITEM[2 * (ip_)], ib_ = ITEM[2 * (ip_) + 1]; \
        { const bf16* kp = ((ia_ & 64) ? MP_KW : MP_KS) + kvbase + (size_t)(ia_ & 63) * 4096; const bf16* vp = ((ia_ & 64) ? MP_VW : MP_VS) + kvbase + (size_t)(ia_ & 63) * 4096; rk0 = *(const v4u*)(kp + tid * 8); rv0 = *(const v4u*)(vp + tid * 8); } \
        if (ib_ >= 0) { const bf16* kp = ((ib_ & 64) ? MP_KW : MP_KS) + kvbase + (size_t)(ib_ & 63) * 4096; const bf16* vp = ((ib_ & 64) ? MP_VW : MP_VS) + kvbase + (size_t)(ib_ & 63) * 4096; rk1 = *(const v4u*)(kp + tid * 8); rv1 = *(const v4u*)(vp + tid * 8); } } while (0)
#define NSA_WRITE_PAIR(sb_) do { *(LAS v4u*)(L + (sb_) + soff) = rk0; *(LAS v4u*)(L + (sb_) + 8192 + soff) = rv0; *(LAS v4u*)(L + (sb_) + 16384 + soff) = rk1; *(LAS v4u*)(L + (sb_) + 24576 + soff) = rv1; } while (0)
    rk1 = (v4u){0u, 0u, 0u, 0u}; rv1 = rk1;
    NSA_LOAD_PAIR(0);
    NSA_WRITE_PAIR(NM_SLOT + 32768);
    LBAR();
#pragma unroll 1
    for (int ip = 0; ip < npair; ++ip) {
        if (ip + 1 < npair) NSA_LOAD_PAIR(ip + 1);
        const int sbase = NM_SLOT + ((ip + 1) & 1) * 32768;
#pragma unroll 1
        for (int half = 0; half < 2; ++half) {
            const int item = ITEM[2 * ip + half];
            if (item < 0) break;
            const int kind = item >> 6, j = item & 63;
            if (kind != prev_kind) {
                const float tot = lsum + shx(lsum, 32, lane); const float sc = gate_s * __builtin_amdgcn_rcpf(tot);
#pragma unroll
                for (int e = 0; e < 16; ++e) { oacc[0][e] += o[0][e] * sc; oacc[1][e] += o[1][e] * sc; o[0][e] = 0.f; o[1][e] = 0.f; }
                m = -1e20f; lsum = 0.f; prev_kind = kind;
            }
            int klo, khi;
            if (kind == 0) { klo = 0; khi = ((mysel >> j) & 1u) ? ((j < c) ? 63 : qi) : -1; }
            else { klo = t - 511 - 64 * j; khi = t - 64 * j; if (khi > 63) khi = 63; if (klo < 0) klo = 0; }
            const LAS unsigned char* slot = L + sbase + half * 16384;
            if (__any(khi >= klo)) {
                f32x16 p0, p1; bf16x8v vf[8];
                { bf16x8v kf[8]; k_load(slot, r, h, kf); SBAR(); qk_mma(kf, qf, p0, p1); }
                v_load(slot + 8192, lane, vf); SBAR();
                if (!__all(klo == 0 && khi == 63)) {
                    const int a = klo - 4 * h, z = khi - 4 * h;
#pragma unroll
                    for (int e = 0; e < 16; ++e) { const int cr = (e & 3) + 8 * (e >> 2);
                        p0[e] = (cr >= a && cr <= z) ? p0[e] : -1e30f; p1[e] = (cr + 32 >= a && cr + 32 <= z) ? p1[e] : -1e30f; }
                }
                float tm = fmaxf(p0[0], p1[0]);
#pragma unroll
                for (int e = 1; e < 16; ++e) tm = fmaxf(tm, fmaxf(p0[e], p1[e]));
                tm = fmaxf(tm, shx(tm, 32, lane));
                const float mn = fmaxf(m, tm * QK_SCALE);
                if (!__all(mn == m)) { const float corr = __builtin_amdgcn_exp2f(m - mn); lsum *= corr;
#pragma unroll
                    for (int e = 0; e < 16; ++e) { o[0][e] *= corr; o[1][e] *= corr; }
                    m = mn; }
                float ts = 0.f;
#pragma unroll
                for (int e = 0; e < 16; ++e) { p0[e] = __builtin_amdgcn_exp2f(p0[e] * QK_SCALE - m); p1[e] = __builtin_amdgcn_exp2f(p1[e] * QK_SCALE - m); ts += p0[e] + p1[e]; }
                lsum += ts;
                SBAR(); pv_mma(vf, p0, p1, o);
            }
        }
        if (ip + 1 < npair) NSA_WRITE_PAIR(NM_SLOT + (ip & 1) * 32768);
        LBAR();
    }
#undef NSA_LOAD_PAIR
#undef NSA_WRITE_PAIR
    { const float tot = lsum + shx(lsum, 32, lane); const float sc = gate_w * __builtin_amdgcn_rcpf(tot);
#pragma unroll
      for (int e = 0; e < 16; ++e) { oacc[0][e] += o[0][e] * sc; oacc[1][e] += o[1][e] * sc; } }
    { bf16* yp = MP_Y + row * DM + (g * 4 + head) * 64 + 4 * h;
#pragma unroll
      for (int db = 0; db < 2; ++db)
#pragma unroll
          for (int g4 = 0; g4 < 4; ++g4) { v2u wv; wv.x = cvtpk(oacc[db][4 * g4], oacc[db][4 * g4 + 1]); wv.y = cvtpk(oacc[db][4 * g4 + 2], oacc[db][4 * g4 + 3]); *(v2u*)(yp + db * 32 + g4 * 8) = wv; } }
}

#define MFMA16(a, b, c) __builtin_amdgcn_mfma_f32_16x16x32_bf16((a), (b), (c), 0, 0, 0)
constexpr size_t WS_QC = 422 * MiB, WS_KC2 = 454 * MiB, WS_END2 = 486 * MiB;
#define MP_QC ((const bf16*)(P.ws + WS_QC))
#define MP_KC2 ((const bf16*)(P.ws + WS_KC2))
__device__ __forceinline__ int img_off(int row, int ch) { return 256 * row + 16 * (ch ^ (((row & 3) << 2) | ((row >> 2) & 3))); }
constexpr int M2_IMG = 0, M2_SC = 98304, M2_DEN = 106496, M2_QN = 107520, M2_N = 107776, M2_SSQ = 108288;

__device__ __forceinline__ void mlstm_conv_pass(unsigned char* ws, const float* conv_w, const float* conv_b, int gthread, int nthreads) {
    for (int idx = gthread; idx < BATCH * 128 * 128; idx += nthreads) {
        const int cc = idx & 127, tg = (idx >> 7) & 127, b = idx >> 14;
        const int isk = cc >> 6, ch0 = (cc & 63) * 8;
        const bf16* src = (const bf16*)(ws + (isk ? WS_MK : WS_MQ)) + (size_t)b * SEQ * 512 + ch0;
        bf16* dst = (bf16*)(ws + (isk ? WS_KC2 : WS_QC)) + ((size_t)(b * 4 + (ch0 >> 7)) * SEQ) * 128 + (ch0 & 127);
        float wt[4][8], bs[8];
#pragma unroll
        for (int j = 0; j < 4; ++j) { const f32x4 a = *(const f32x4*)(conv_w + j * 1024 + isk * 512 + ch0), c2 = *(const f32x4*)(conv_w + j * 1024 + isk * 512 + ch0 + 4);
            wt[j][0] = a.x; wt[j][1] = a.y; wt[j][2] = a.z; wt[j][3] = a.w; wt[j][4] = c2.x; wt[j][5] = c2.y; wt[j][6] = c2.z; wt[j][7] = c2.w; }
        { const f32x4 a = *(const f32x4*)(conv_b + isk * 512 + ch0), c2 = *(const f32x4*)(conv_b + isk * 512 + ch0 + 4); bs[0] = a.x; bs[1] = a.y; bs[2] = a.z; bs[3] = a.w; bs[4] = c2.x; bs[5] = c2.y; bs[6] = c2.z; bs[7] = c2.w; }
        const float osc = isk ? 0.08838834764831845f : 1.f;
        const int t0 = tg * 16;
        float x0[8], x1[8], x2[8];
#pragma unroll
        for (int e = 0; e < 8; ++e) { x0[e] = 0.f; x1[e] = 0.f; x2[e] = 0.f; }
        if (t0 > 0) {
            const v4u a = *(const v4u*)(src + (size_t)(t0 - 3) * 512), c2 = *(const v4u*)(src + (size_t)(t0 - 2) * 512), d2 = *(const v4u*)(src + (size_t)(t0 - 1) * 512);
            x0[0] = bflo(a.x); x0[1] = bfhi(a.x); x0[2] = bflo(a.y); x0[3] = bfhi(a.y); x0[4] = bflo(a.z); x0[5] = bfhi(a.z); x0[6] = bflo(a.w); x0[7] = bfhi(a.w);
            x1[0] = bflo(c2.x); x1[1] = bfhi(c2.x); x1[2] = bflo(c2.y); x1[3] = bfhi(c2.y); x1[4] = bflo(c2.z); x1[5] = bfhi(c2.z); x1[6] = bflo(c2.w); x1[7] = bfhi(c2.w);
            x2[0] = bflo(d2.x); x2[1] = bfhi(d2.x); x2[2] = bflo(d2.y); x2[3] = bfhi(d2.y); x2[4] = bflo(d2.z); x2[5] = bfhi(d2.z); x2[6] = bflo(d2.w); x2[7] = bfhi(d2.w);
        }
#pragma unroll 4
        for (int s = 0; s < 16; ++s) {
            const v4u a = *(const v4u*)(src + (size_t)(t0 + s) * 512);
            const float x3[8] = {bflo(a.x), bfhi(a.x), bflo(a.y), bfhi(a.y), bflo(a.z), bfhi(a.z), bflo(a.w), bfhi(a.w)};
            float o[8];
#pragma unroll
            for (int e = 0; e < 8; ++e) { float v = bs[e] + wt[0][e] * x0[e] + wt[1][e] * x1[e] + wt[2][e] * x2[e] + wt[3][e] * x3[e]; v = v * __builtin_amdgcn_rcpf(1.f + __expf(-v)); o[e] = v * osc; x0[e] = x1[e]; x1[e] = x2[e]; x2[e] = x3[e]; }
            v4u wv; wv.x = pk2(o[0], o[1]); wv.y = pk2(o[2], o[3]); wv.z = pk2(o[4], o[5]); wv.w = pk2(o[6], o[7]);
            *(v4u*)(dst + (size_t)(t0 + s) * 128) = wv;
        }
    }
}

constexpr int M2_A = 112384, M2_PM = 120576, M2_F = 128768, M2_BL = 136960, M2_AMX = 137088, M2_MC = 137216;
__device__ __forceinline__ void mlstm_unit_mfma(LAS unsigned char* L, const MixPtrs& P, int b, int hh, int tid_in) {
    int tid_l = tid_in; asm volatile("" : "+v"(tid_l));
    const int tid = tid_l, lane = tid & 63, w = __builtin_amdgcn_readfirstlane(tid >> 6), l15 = lane & 15, kg = lane >> 4;
    const size_t rb = (size_t)b * SEQ;
    const bf16* QCp = MP_QC + ((size_t)(b * 4 + hh) * SEQ) * 128; const bf16* KCp = MP_KC2 + ((size_t)(b * 4 + hh) * SEQ) * 128;
    const bf16* Vp = MP_MV + rb * 512 + hh * 128; const bf16* Op = MP_MO + rb * 512 + hh * 128 + 16 * w + 4 * kg;
    bf16* Yp = MP_Y + rb * DM + 512 + hh * 128 + 16 * w + 4 * kg;
    LAS float* DEN = (LAS float*)(L + M2_DEN); LAS float* QN = (LAS float*)(L + M2_QN); LAS float* NV = (LAS float*)(L + M2_N); LAS float* SSQ = (LAS float*)(L + M2_SSQ);
    LAS float* SA = (LAS float*)(L + M2_A); LAS float* SPM = (LAS float*)(L + M2_PM); LAS float* SF = (LAS float*)(L + M2_F);
    LAS float* SBL = (LAS float*)(L + M2_BL); LAS float* SAMX = (LAS float*)(L + M2_AMX); LAS float* SMC = (LAS float*)(L + M2_MC);
    float zf = 0.f; asm volatile("" : "+v"(zf));
    f32x4 Cacc[8], nacc = {zf, zf, zf, zf};
#pragma unroll
    for (int i = 0; i < 8; ++i) Cacc[i] = (f32x4){zf, zf, zf, zf};
    const f32x4 gn = *(const f32x4*)(P.mnorm_g + hh * 128 + 16 * w + 4 * kg);
    const int r0s = tid >> 4, c0s = tid & 15, so0 = img_off(r0s, c0s), so1 = img_off(r0s + 32, c0s);
    v4u sq0, sq1, sk0, sk1, sv0, sv1;
    sq0 = *(const v4u*)(QCp + (size_t)r0s * 128 + c0s * 8); sq1 = *(const v4u*)(QCp + (size_t)(r0s + 32) * 128 + c0s * 8);
    sk0 = *(const v4u*)(KCp + (size_t)r0s * 128 + c0s * 8); sk1 = *(const v4u*)(KCp + (size_t)(r0s + 32) * 128 + c0s * 8);
    sv0 = *(const v4u*)(Vp + (size_t)r0s * 512 + c0s * 8);  sv1 = *(const v4u*)(Vp + (size_t)(r0s + 32) * 512 + c0s * 8);
    LBAR();
    { const float ib = P.i_bias[hh], fb = P.f_bias[hh]; const float* Gp = MP_GATE + rb * 32 + hh;
#pragma unroll 1
      for (int cc = w; cc < 32; cc += 8) { const int tk = 64 * cc + lane;
          const float il = Gp[(size_t)tk * 32 + 24] + ib, fx = Gp[(size_t)tk * 32 + 28] + fb; const float fl = fminf(fx, 0.f) - log1pf(__expf(-fabsf(fx)));
          float f = fl;
#pragma unroll
          for (int o = 1; o < 64; o <<= 1) { const float v = shi(f, lane - o); if (lane >= o) f += v; }
          const float a = il - f; float pm = a;
#pragma unroll
          for (int o = 1; o < 64; o <<= 1) { const float v = shi(pm, lane - o); if (lane >= o) pm = fmaxf(pm, v); }
          SA[tk] = a; SPM[tk] = pm; SF[tk] = f; if (lane == 63) { SBL[cc] = f; SAMX[cc] = pm; } } }
    *(LAS v4u*)(L + M2_IMG + so0) = sq0; *(LAS v4u*)(L + M2_IMG + so1) = sq1; *(LAS v4u*)(L + M2_IMG + 16384 + so0) = sk0; *(LAS v4u*)(L + M2_IMG + 16384 + so1) = sk1;
    *(LAS v4u*)(L + M2_IMG + 32768 + so0) = sv0; *(LAS v4u*)(L + M2_IMG + 32768 + so1) = sv1;
    if (tid < 128) NV[tid] = zf;
    LBAR();
    if (tid == 0) { float mcar = zf; for (int cc = 0; cc < 32; ++cc) { SMC[cc] = mcar; mcar = SBL[cc] + fmaxf(mcar, SAMX[cc]); } }
    LBAR();
#pragma unroll 1
    for (int c = 0; c < 32; ++c) {
        int lc = lane; asm volatile("" : "+v"(lc));
        const int l15 = lc & 15, kg = lc >> 4, q4 = l15 >> 2, p4 = l15 & 3;
        const int t0 = c * 64; const LAS unsigned char* Qi = L + M2_IMG + (c & 1) * 49152; const LAS unsigned char* Ki = Qi + 16384; const LAS unsigned char* Vi = Qi + 32768;
        if (c + 1 < 32) { const int tn = t0 + 64;
            sq0 = *(const v4u*)(QCp + (size_t)(tn + r0s) * 128 + c0s * 8); sq1 = *(const v4u*)(QCp + (size_t)(tn + r0s + 32) * 128 + c0s * 8);
            sk0 = *(const v4u*)(KCp + (size_t)(tn + r0s) * 128 + c0s * 8); sk1 = *(const v4u*)(KCp + (size_t)(tn + r0s + 32) * 128 + c0s * 8);
            sv0 = *(const v4u*)(Vp + (size_t)(tn + r0s) * 512 + c0s * 8);  sv1 = *(const v4u*)(Vp + (size_t)(tn + r0s + 32) * 512 + c0s * 8); }
        const float mc = SMC[c], mxa = fmaxf(mc, SAMX[c]); const float cs = __expf(mc - mxa);
        { const int tblk = w >> 1, t = 16 * tblk + l15; const int sb0 = 2 * (w & 1);
          bf16x8v ka[2][4], qb[4];
#pragma unroll
          for (int ks = 0; ks < 4; ++ks) { qb[ks] = *(const LAS bf16x8v*)(Qi + img_off(t, 4 * ks + kg)); ka[0][ks] = *(const LAS bf16x8v*)(Ki + img_off(16 * sb0 + l15, 4 * ks + kg)); ka[1][ks] = *(const LAS bf16x8v*)(Ki + img_off(16 * sb0 + 16 + l15, 4 * ks + kg)); }
          const float Mt = fmaxf(SPM[t0 + t], mc);
          const f32x4 as0 = *(const LAS f32x4*)(SA + t0 + 16 * sb0 + 4 * kg), as1 = *(const LAS f32x4*)(SA + t0 + 16 * sb0 + 16 + 4 * kg);
          const int tq = tid >> 3, dp = tid & 7; const v4u q0 = *(const LAS v4u*)(Qi + img_off(tq, 2 * dp)), q1 = *(const LAS v4u*)(Qi + img_off(tq, 2 * dp + 1));
          const LAS f32x4* np = (const LAS f32x4*)(NV + 16 * dp); const f32x4 n0 = np[0], n1 = np[1], n2 = np[2], n3 = np[3];
          SBAR();
          LAS unsigned char* SC = L + M2_SC;
#pragma unroll
          for (int sb = 0; sb < 2; ++sb) { const int sblk = sb0 + sb; f32x4 acc = {0.f, 0.f, 0.f, 0.f}; float rp = 0.f; v2u wv; wv.x = 0u; wv.y = 0u;
              if (sblk <= tblk) {
#pragma unroll
                  for (int ks = 0; ks < 4; ++ks) acc = MFMA16(ka[sb][ks], qb[ks], acc);
                  const f32x4 as = sb ? as1 : as0; float v[4];
#pragma unroll
                  for (int e = 0; e < 4; ++e) { const float x = acc[e] * __expf(as[e] - Mt); v[e] = (sblk == tblk && 4 * kg + e > l15) ? 0.f : x; }
                  rp = (v[0] + v[1]) + (v[2] + v[3]); wv.x = cvtpk(v[0], v[1]); wv.y = cvtpk(v[2], v[3]);
              }
              rp += shx(rp, 16, lane); rp += shx(rp, 32, lane);
              *(LAS v2u*)(SC + t * 128 + (((2 * sblk + (kg >> 1)) ^ (t & 7)) << 4) + 8 * (kg & 1)) = wv;
              if (kg == 0) DEN[sblk * 64 + t] = rp; }
          { float s = bflo(q0.x) * n0.x + bfhi(q0.x) * n0.y + bflo(q0.y) * n0.z + bfhi(q0.y) * n0.w + bflo(q0.z) * n1.x + bfhi(q0.z) * n1.y + bflo(q0.w) * n1.z + bfhi(q0.w) * n1.w
                    + bflo(q1.x) * n2.x + bfhi(q1.x) * n2.y + bflo(q1.y) * n2.z + bfhi(q1.y) * n2.w + bflo(q1.z) * n3.x + bfhi(q1.z) * n3.y + bflo(q1.w) * n3.z + bfhi(q1.w) * n3.w;
            s += shx(s, 1, lane); s += shx(s, 2, lane); s += shx(s, 4, lane);
            if (dp == 0) QN[tq] = s; } }
        LBAR();
        v2u og[4];
#pragma unroll
        for (int tb = 0; tb < 4; ++tb) og[tb] = *(const v2u*)(Op + (size_t)(t0 + 16 * tb + l15) * 512);
        bf16x8v vf[2]; f32x4 hv[4];
        { float pmt[4], ft[4], dnp[4], qn4[4]; bf16x8v Cfrag[4];
#pragma unroll
          for (int kp = 0; kp < 4; ++kp) { v4u a; a.x = cvtpk(Cacc[2 * kp].x, Cacc[2 * kp].y); a.y = cvtpk(Cacc[2 * kp].z, Cacc[2 * kp].w); a.z = cvtpk(Cacc[2 * kp + 1].x, Cacc[2 * kp + 1].y); a.w = cvtpk(Cacc[2 * kp + 1].z, Cacc[2 * kp + 1].w);
              Cfrag[kp] = __builtin_bit_cast(bf16x8v, a); }
#pragma unroll
          for (int ks = 0; ks < 2; ++ks) { const int r0 = 32 * ks + 8 * kg;
              const s16x4v lo = tr_read(Vi + 256 * (r0 + q4) + 16 * ((2 * w + (p4 >> 1)) ^ ((q4 << 2) | ((r0 >> 2) & 3))) + 8 * (p4 & 1));
              const s16x4v hi = tr_read(Vi + 256 * (r0 + 4 + q4) + 16 * ((2 * w + (p4 >> 1)) ^ ((q4 << 2) | (((r0 + 4) >> 2) & 3))) + 8 * (p4 & 1));
              vf[ks] = __builtin_shufflevector(lo, hi, 0, 1, 2, 3, 4, 5, 6, 7); }
#pragma unroll
          for (int tb = 0; tb < 4; ++tb) { const int t = 16 * tb + l15; pmt[tb] = SPM[t0 + t]; ft[tb] = SF[t0 + t]; dnp[tb] = (DEN[t] + DEN[64 + t]) + (DEN[128 + t] + DEN[192 + t]); qn4[tb] = QN[t]; }
#pragma unroll
          for (int tp = 0; tp < 2; ++tp) {
              bf16x8v sf[2][2]; v2u qlo[2][4], qhi[2][4];
#pragma unroll
              for (int t2 = 0; t2 < 2; ++t2) { const int t = 16 * (2 * tp + t2) + l15; const int swz = ((t & 3) << 2) | ((t >> 2) & 3);
#pragma unroll
                  for (int ks = 0; ks < 2; ++ks) sf[t2][ks] = *(const LAS bf16x8v*)(L + M2_SC + t * 128 + (((4 * ks + kg) ^ (t & 7)) << 4));
#pragma unroll
                  for (int kp = 0; kp < 4; ++kp) { qlo[t2][kp] = *(const LAS v2u*)(Qi + 256 * t + 16 * ((4 * kp + (kg >> 1)) ^ swz) + 8 * (kg & 1)); qhi[t2][kp] = *(const LAS v2u*)(Qi + 256 * t + 16 * ((4 * kp + 2 + (kg >> 1)) ^ swz) + 8 * (kg & 1)); } }
              SBAR();
#pragma unroll
              for (int t2 = 0; t2 < 2; ++t2) { const int tb = 2 * tp + t2; f32x4 an = {0.f, 0.f, 0.f, 0.f}, a2 = {0.f, 0.f, 0.f, 0.f};
#pragma unroll
                  for (int ks = 0; ks < 2; ++ks) an = MFMA16(vf[ks], sf[t2][ks], an);
#pragma unroll
                  for (int kp = 0; kp < 4; ++kp) { v4u qq; qq.x = qlo[t2][kp].x; qq.y = qlo[t2][kp].y; qq.z = qhi[t2][kp].x; qq.w = qhi[t2][kp].y; a2 = MFMA16(Cfrag[kp], __builtin_bit_cast(bf16x8v, qq), a2); }
                  const float Mt = fmaxf(pmt[tb], mc), wp = __expf(mc - Mt), emt = __expf(-ft[tb] - Mt);
                  const float dn = dnp[tb] + wp * qn4[tb];
                  const float idn = __builtin_amdgcn_rcpf(fmaxf(fabsf(dn), emt));
                  hv[tb] = (an + a2 * wp) * idn;
                  float ss = (hv[tb].x * hv[tb].x + hv[tb].y * hv[tb].y) + (hv[tb].z * hv[tb].z + hv[tb].w * hv[tb].w);
                  ss += shx(ss, 16, lane); ss += shx(ss, 32, lane);
                  if (kg == 0) SSQ[((c & 1) * 8 + w) * 64 + 16 * tb + l15] = ss; }
              SBAR();
          } }
        { bf16x8v vpf[2], wkf[2];
          f32x4 aw[2][2];
#pragma unroll
          for (int ks = 0; ks < 2; ++ks) { aw[ks][0] = *(const LAS f32x4*)(SA + t0 + 32 * ks + 8 * kg); aw[ks][1] = *(const LAS f32x4*)(SA + t0 + 32 * ks + 8 * kg + 4); }
#pragma unroll
          for (int ks = 0; ks < 2; ++ks) { float wkv[8]; unsigned vp[4], wp2[4]; const v4u vu = __builtin_bit_cast(v4u, vf[ks]); const unsigned vw[4] = {vu.x, vu.y, vu.z, vu.w};
#pragma unroll
              for (int j = 0; j < 8; ++j) wkv[j] = __expf(aw[ks][j >> 2][j & 3] - mxa);
#pragma unroll
              for (int j2 = 0; j2 < 4; ++j2) { vp[j2] = cvtpk(bflo(vw[j2]) * wkv[2 * j2], bfhi(vw[j2]) * wkv[2 * j2 + 1]); wp2[j2] = cvtpk(wkv[2 * j2], wkv[2 * j2 + 1]); }
              v4u a; a.x = vp[0]; a.y = vp[1]; a.z = vp[2]; a.w = vp[3]; vpf[ks] = __builtin_bit_cast(bf16x8v, a);
              v4u b2; b2.x = wp2[0]; b2.y = wp2[1]; b2.z = wp2[2]; b2.w = wp2[3]; wkf[ks] = __builtin_bit_cast(bf16x8v, b2); }
          nacc = nacc * cs;
#pragma unroll
          for (int ih = 0; ih < 2; ++ih) {
              bf16x8v kf[4][2];
#pragma unroll
              for (int i4 = 0; i4 < 4; ++i4)
#pragma unroll
                  for (int ks = 0; ks < 2; ++ks) { const int i = 4 * ih + i4, r0 = 32 * ks + 8 * kg;
                      const s16x4v lo = tr_read(Ki + 256 * (r0 + q4) + 16 * ((2 * i + (p4 >> 1)) ^ ((q4 << 2) | ((r0 >> 2) & 3))) + 8 * (p4 & 1));
                      const s16x4v hi = tr_read(Ki + 256 * (r0 + 4 + q4) + 16 * ((2 * i + (p4 >> 1)) ^ ((q4 << 2) | (((r0 + 4) >> 2) & 3))) + 8 * (p4 & 1));
                      kf[i4][ks] = __builtin_shufflevector(lo, hi, 0, 1, 2, 3, 4, 5, 6, 7); }
              SBAR();
#pragma unroll
              for (int i4 = 0; i4 < 4; ++i4) { const int i = 4 * ih + i4; Cacc[i] = Cacc[i] * cs;
#pragma unroll
                  for (int ks = 0; ks < 2; ++ks) { Cacc[i] = MFMA16(kf[i4][ks], vpf[ks], Cacc[i]); if (i == w) nacc = MFMA16(kf[i4][ks], wkf[ks], nacc); } }
              SBAR();
          }
          if (l15 == 0) *(LAS f32x4*)(NV + 16 * w + 4 * kg) = nacc;
 }
        if (c + 1 < 32) { LAS unsigned char* Nx = L + M2_IMG + ((c + 1) & 1) * 49152;
            *(LAS v4u*)(Nx + so0) = sq0; *(LAS v4u*)(Nx + so1) = sq1; *(LAS v4u*)(Nx + 16384 + so0) = sk0; *(LAS v4u*)(Nx + 16384 + so1) = sk1; *(LAS v4u*)(Nx + 32768 + so0) = sv0; *(LAS v4u*)(Nx + 32768 + so1) = sv1; }
        LBAR();
#pragma unroll
        for (int tb = 0; tb < 4; ++tb) { const int t = 16 * tb + l15; const LAS float* sp = SSQ + (c & 1) * 512 + t;
            const float tot = ((sp[0] + sp[64]) + (sp[128] + sp[192])) + ((sp[256] + sp[320]) + (sp[384] + sp[448]));
            const float rn = __frsqrt_rn(tot * (1.f / 128.f) + EPS);
            const float y0 = hv[tb].x * rn * gn.x * sigmoidf_(bflo(og[tb].x)), y1 = hv[tb].y * rn * gn.y * sigmoidf_(bfhi(og[tb].x)), y2 = hv[tb].z * rn * gn.z * sigmoidf_(bflo(og[tb].y)), y3 = hv[tb].w * rn * gn.w * sigmoidf_(bfhi(og[tb].y));
            v2u wv; wv.x = cvtpk(y0, y1); wv.y = cvtpk(y2, y3);
            *(v2u*)(Yp + (size_t)(t0 + t) * DM) = wv; }
    }
    LBAR();
}

#ifndef MK_MULTI
#define MK_MULTI 0
#endif
constexpr int PH_PER_LAYER = 12, N_PHASES = 1 + DEPTH * PH_PER_LAYER;
struct Args { const float* in[16]; float* out; unsigned char* ws; int ph_lo, ph_hi; };
static_assert(sizeof(Args) == 16 * 8 + 8 + 8 + 8, "Args has no padding");

__global__ void __launch_bounds__(NWAVES * 64, 2) fwd_kernel(Args args) {
    extern __shared__ __attribute__((aligned(16))) unsigned char lds_raw[];
    LAS unsigned char* L = (LAS unsigned char*)lds_raw;
    const int G0 = gridDim.x, blk0 = blockIdx.x;
    const int wave0 = __builtin_amdgcn_readfirstlane((int)threadIdx.x >> 6);
#define PH_IDS() PH_WS(); int wave = wave0; asm volatile("" : "+s"(wave)); const int lane = fresh_lane(), tid = wave * 64 + lane, gw = blk * NWAVES + wave; (void)gw
#define PH_WS() unsigned char* ws = args.ws; asm volatile("" : "+s"(ws)); int blk = blk0, G = G0; asm volatile("" : "+s"(blk), "+s"(G)); const int NGW = G * NWAVES; (void)NGW; bf16* X16 = (bf16*)(ws + WS_X16); float* R2 = (float*)(ws + WS_TAB + TAB_R2); bf16* U = (bf16*)(ws + WS_U); bf16* HB = (bf16*)(ws + WS_HB); bf16* HD = (bf16*)(ws + WS_HD); \
    unsigned char* wl = ws + WS_W; const float* ng = args.in[1] + (size_t)l_ * 6 * DM; (void)X16; (void)R2; (void)U; (void)HB; (void)HD; (void)wl; (void)ng
    unsigned char* ws0 = args.ws;
    volatile LAS unsigned* MISC = (volatile LAS unsigned*)(L + MISC_OFF);
    { const int tid_e = wave0 * 64 + fresh_lane(); if (tid_e < 16) MISC[tid_e] = 0u; }
    __syncthreads();
    XcdBarrier bar; bar.bar = (unsigned*)(ws0 + WS_CTL) + CW_BAR; bar.x = 0; bar.st = nullptr;
    if (!MK_MULTI) bar = xcd_barrier_post((unsigned*)(ws0 + WS_CTL) + CW_BAR, MISC + 8, wave0 * 64 + fresh_lane() == 0);
    const int lo = args.ph_lo, hi = args.ph_hi;
#define IN(k) (lo <= (k) && (k) < hi)
#define SEAM(k) do { if (IN(k) && IN((k) + 1)) xcd_barrier(bar, wave0 * 64 + fresh_lane() == 0); } while (0)

    if (IN(0)) {
        const int l_ = 0; PH_IDS();
        const float* x_in = args.in[0]; float* cosT = (float*)(ws + WS_TAB + TAB_COS); float* sinT = (float*)(ws + WS_TAB + TAB_SIN); float* b1T = (float*)(ws + WS_TAB + TAB_B1);
#define CONVERT_WEIGHTS(lw) do { LAS float* scr = (LAS float*)(L + wave * 16384); const float* ngw = args.in[1] + (size_t)(lw) * 6 * DM; \
        constexpr int I_GU = 16 * 176, I_DN = 44 * 32, I_IN = 16 * 112, I_OUT = 16 * 32, I_CMP = 16 * 16, I_LAYER = 2 * I_GU + 2 * I_DN + I_IN + I_OUT + I_CMP; \
        for (int it = gw; it < I_LAYER; it += NGW) { int r = it; unsigned char* wlw = ws + WS_W; \
            if (r < I_GU) { SrcGU s{args.in[2] + (size_t)(lw) * DM * NGU, ngw + 0 * DM}; transpose_item(s, DM, (bf16*)(wlw + WO_GU1), scr, r / 176, r % 176, lane); continue; } r -= I_GU; \
            if (r < I_DN) { SrcPlain s{args.in[3] + (size_t)(lw) * FF * DM, DM}; transpose_item(s, FF, (bf16*)(wlw + WO_DN1), scr, r / 32, r % 32, lane); continue; } r -= I_DN; \
            if (r < I_GU) { SrcGU s{args.in[4] + (size_t)(lw) * DM * NGU, ngw + 4 * DM}; transpose_item(s, DM, (bf16*)(wlw + WO_GU2), scr, r / 176, r % 176, lane); continue; } r -= I_GU; \
            if (r < I_DN) { SrcPlain s{args.in[5] + (size_t)(lw) * FF * DM, DM}; transpose_item(s, FF, (bf16*)(wlw + WO_DN2), scr, r / 32, r % 32, lane); continue; } r -= I_DN; \
            if (r < I_IN) { SrcIN s{args.in[6] + (size_t)(lw) * DM * INCOLS, ngw + 2 * DM}; transpose_item(s, DM, (bf16*)(wlw + WO_IN), scr, r / 112, r % 112, lane); continue; } r -= I_IN; \
            if (r < I_OUT) { SrcPlain s{args.in[7] + (size_t)(lw) * DM * DM, DM}; transpose_item(s, DM, (bf16*)(wlw + WO_OUT), scr, r / 32, r % 32, lane); continue; } r -= I_OUT; \
            { SrcCMP s{args.in[9] + (size_t)(lw) * 2 * 2048 * 128}; transpose_item(s, DM, (bf16*)(wlw + WO_CMP), scr, r / 16, r % 16, lane); } } } while (0)
        CONVERT_WEIGHTS(0);
        for (int i = blk * 512 + tid; i < SEQ * 8; i += G * 512) { const int pos = i >> 3, k = i & 7;
            const double inv = pow(500000.0, -(double)k / 8.0), ang = (double)pos * inv; cosT[i] = (float)cos(ang); sinT[i] = (float)sin(ang); }
        for (int o = gw; o < DEPTH * 2 * 128; o += NGW) { const int lk = o >> 7, c = o & 127; const float* pe = args.in[8] + (size_t)lk * 2048; const float* w1 = args.in[9] + (size_t)lk * 2048 * 128;
            float s = 0.f; for (int r = lane; r < 2048; r += 64) s += pe[r] * w1[(size_t)r * 128 + c];
            s = wave_sum(s, lane); if (lane == 0) b1T[o] = s; }
        thin_phase<0>(nullptr, x_in, X16, nullptr, R2, nullptr, 0.f, gw, NGW, lane);
    }
    SEAM(0);

#pragma unroll 1
    for (int l = 0; l < DEPTH; ++l) {
        const int pb = 1 + l * PH_PER_LAYER, l_ = l;
        if (IN(pb + 0)) { PH_IDS(); pg8::Gemm g{X16, (const bf16*)(wl + WO_GU1), MTOK, NGU, DM}; pg8::StaticOrder S; S.init(MTOK, NGU, G, blk); EpiSwiglu E{HB, R2};
            pg8::gemm_phase<EpiSwiglu, pg8::StaticOrder, true, true>(L, g, S, E, tid); }
        SEAM(pb + 0);
        if (IN(pb + 1)) { PH_IDS(); pg8::Gemm g{HB, (const bf16*)(wl + WO_DN1), MTOK, DM, FF}; pg8::StaticOrder S; S.init(MTOK, DM, G, blk); pg8::EpiBf16<0> E{HD, DM, nullptr, 0, 0, 1.f};
            pg8::gemm_phase<pg8::EpiBf16<0>, pg8::StaticOrder, true, true>(L, g, S, E, tid); }
        SEAM(pb + 1);
        if (IN(pb + 2)) { PH_IDS(); thin_phase<1>(HD, nullptr, X16, nullptr, R2, ng + 1 * DM, 0.5f, gw, NGW, lane); }
        SEAM(pb + 2);
        if (IN(pb + 3)) { PH_IDS(); pg8::Gemm g{X16, (const bf16*)(wl + WO_IN), MTOK, NINP, DM}; pg8::StaticOrder S; S.init(MTOK, NINP, G, blk);
            EpiInProj E{ws};
            pg8::gemm_phase<EpiInProj, pg8::StaticOrder, true, true>(L, g, S, E, tid); }
        SEAM(pb + 3);
        if (IN(pb + 4)) { PH_IDS(); pg8::Gemm g{(const bf16*)(ws + WS_KCR), (const bf16*)(wl + WO_CMP), 8192, 512, DM}; CmpOrder S{blk, G}; EpiPQ E{(float*)(ws + WS_PQ)};
            pg8::gemm_phase<EpiPQ, CmpOrder, false, true>(L, g, S, E, tid);
            { const int nb = (G > 32) ? 32 : 0; if (blk >= nb) { mlstm_conv_pass(ws, args.in[11] + (size_t)l_ * 4 * 1024, args.in[12] + (size_t)l_ * 1024, (blk - nb) * 512 + tid, (G - nb) * 512); } } }
        SEAM(pb + 4);
        if (IN(pb + 5)) {
            PH_IDS();
            const float* b1T = (const float*)(ws + WS_TAB + TAB_B1); const float* PQ = (const float*)(ws + WS_PQ); bf16* CC = (bf16*)(ws + WS_CC); LAS float* hs = (LAS float*)(L + wave * 1024);
            for (int r = gw; r < 2 * 32 * 128; r += NGW) {
                const int kv = r >> 12, bgn = r & 4095, n = bgn & 127;
                if (n == 127) { CC[(size_t)r * 64 + lane] = 0; continue; }
                const float* w2 = args.in[10] + (size_t)(l * 2 + kv) * 128 * 64; const float* b1 = b1T + (l * 2 + kv) * 128;
#pragma unroll
                for (int q2 = 0; q2 < 2; ++q2) { const int c = lane + 64 * q2; const float v = PQ[(size_t)r * 256 + c] + PQ[(size_t)(r + 1) * 256 + 128 + c] + b1[c];
                    const float u3 = 0.7978845608028654f * (v + 0.044715f * v * v * v); hs[c] = 0.5f * v * (1.f + tanhf(u3)); }
                LDS_WAIT(); asm volatile("" ::: "memory");
                float o = 0.f;
#pragma unroll 8
                for (int c = 0; c < 128; ++c) o += hs[c] * w2[c * 64 + lane];
                CC[(size_t)r * 64 + lane] = (bf16)f2bf(o);
                LDS_WAIT(); asm volatile("" ::: "memory");
            }
        }
        SEAM(pb + 5);
        if (IN(pb + 6)) {
            PH_IDS();
            MixPtrs P{ws, args.in[11] + (size_t)l * 4 * 1024, args.in[12] + (size_t)l * 1024, args.in[13] + l * 4, args.in[14] + l * 4, args.in[15] + l * 512};
#ifndef PROBE_MIX_REP
#define PROBE_MIX_REP 1
#endif
            for (int rep = 0; rep < PROBE_MIX_REP; ++rep) {
            for (int u = blk; u < 64; u += G) mlstm_unit_mfma(L, P, u >> 2, u & 3, tid);
            { unsigned* qbase = (unsigned*)(ws + WS_CTL) + CW_QUEUE + 1024 * l_; volatile LAS unsigned* QW = (volatile LAS unsigned*)(L + MISC_OFF);
              const unsigned q0 = xb_xcc_id() & 7u;
#pragma unroll 1
              for (unsigned qq = 0; qq < 8u; ++qq) { unsigned* qctr = qbase + 64 * ((q0 + qq) & 7u); const int bg0 = 4 * (int)((q0 + qq) & 7u);
                  __syncthreads();
                  if (tid == 0) QW[0] = __hip_atomic_fetch_add(qctr, 1u, __ATOMIC_RELAXED, __HIP_MEMORY_SCOPE_AGENT);
                  __syncthreads();
                  unsigned u = QW[0];
                  while (u < 128u) { unsigned nxt = 0u; if (tid == 0) nxt = __hip_atomic_fetch_add(qctr, 1u, __ATOMIC_RELAXED, __HIP_MEMORY_SCOPE_AGENT);
                      const int c = 31 - (int)(u & 31u), bg = bg0 + (int)(u >> 5); nsa_unit_mfma(L, P, bg >> 1, bg & 1, c, tid);
                      __syncthreads(); if (tid == 0) QW[0] = nxt; __syncthreads(); u = QW[0]; } } }
            }
        }
        SEAM(pb + 6);
        if (IN(pb + 7)) { PH_IDS(); pg8::Gemm g{U, (const bf16*)(wl + WO_OUT), MTOK, DM, DM}; pg8::StaticOrder S; S.init(MTOK, DM, G, blk); pg8::EpiBf16<0> E{HD, DM, nullptr, 0, 0, 1.f};
            pg8::gemm_phase<pg8::EpiBf16<0>, pg8::StaticOrder, true, true>(L, g, S, E, tid); }
        SEAM(pb + 7);
        if (IN(pb + 8)) { PH_IDS(); thin_phase<1>(HD, nullptr, X16, nullptr, R2, ng + 3 * DM, 1.0f, gw, NGW, lane); }
        SEAM(pb + 8);
        if (IN(pb + 9)) { PH_IDS(); pg8::Gemm g{X16, (const bf16*)(wl + WO_GU2), MTOK, NGU, DM}; pg8::StaticOrder S; S.init(MTOK, NGU, G, blk); EpiSwiglu E{HB, R2};
            pg8::gemm_phase<EpiSwiglu, pg8::StaticOrder, true, true>(L, g, S, E, tid); }
        SEAM(pb + 9);
        if (IN(pb + 10)) { PH_IDS(); pg8::Gemm g{HB, (const bf16*)(wl + WO_DN2), MTOK, DM, FF}; pg8::StaticOrder S; S.init(MTOK, DM, G, blk); pg8::EpiBf16<0> E{HD, DM, nullptr, 0, 0, 1.f};
            pg8::gemm_phase<pg8::EpiBf16<0>, pg8::StaticOrder, true, true>(L, g, S, E, tid); }
        SEAM(pb + 10);
        if (IN(pb + 11)) { PH_IDS(); if (l + 1 < DEPTH) { thin_phase<1>(HD, nullptr, X16, nullptr, R2, ng + 5 * DM, 0.5f, gw, NGW, lane); CONVERT_WEIGHTS(l_ + 1); }
                           else thin_phase<2>(HD, nullptr, X16, args.out, nullptr, ng + 5 * DM, 0.5f, gw, NGW, lane); }
        if (l + 1 < DEPTH) SEAM(pb + 11);
    }
#undef IN
#undef SEAM
#undef CONVERT_WEIGHTS
#undef PH_IDS
#undef PH_WS
}

extern "C" void kernel_launch(void* const* d_in, const int* in_sizes, int n_in, void* d_out, int out_size, void* d_ws, size_t ws_size, hipStream_t stream) {
    static int grid = 0;
    if (grid == 0) {
        if (n_in != 16 || in_sizes[0] != MTOK * DM || out_size != MTOK * DM || ws_size < WS_END2) { fprintf(stderr, "kernel_launch: unexpected problem (n_in %d, ws %zu)\n", n_in, ws_size); grid = -1; return; }
        int dev = 0, cus = 0, per_cu = 0;
        if (hipGetDevice(&dev) != hipSuccess || hipDeviceGetAttribute(&cus, hipDeviceAttributeMultiprocessorCount, dev) != hipSuccess) { grid = -1; return; }
        if (hipFuncSetAttribute((const void*)fwd_kernel, hipFuncAttributeMaxDynamicSharedMemorySize, LDS_BYTES) != hipSuccess) { grid = -1; return; }
        if (hipOccupancyMaxActiveBlocksPerMultiprocessor(&per_cu, (const void*)fwd_kernel, NWAVES * 64, LDS_BYTES) != hipSuccess || per_cu < 1) { fprintf(stderr, "kernel_launch: occupancy query says %d\n", per_cu); }
        (void)hipGetLastError();
        grid = cus;
    }
    if (grid < 0) return;
    (void)hipMemsetAsync((char*)d_ws + WS_CTL, 0, CTL_ZERO_BYTES, stream);
    Args a{};
    for (int i = 0; i < 16; ++i) a.in[i] = (const float*)d_in[i];
    a.out = (float*)d_out; a.ws = (unsigned char*)d_ws;
#if MK_MULTI
    for (int p = 0; p < N_PHASES; ++p) { a.ph_lo = p; a.ph_hi = p + 1; hipLaunchKernelGGL(fwd_kernel, dim3(grid), dim3(NWAVES * 64), LDS_BYTES, stream, a); }
#else
    a.ph_lo = 0; a.ph_hi = N_PHASES; hipLaunchKernelGGL(fwd_kernel, dim3(grid), dim3(NWAVES * 64), LDS_BYTES, stream, a);
#endif
}
```

```cpp
#include <hip/hip_runtime.h>
#include <cstdio>
#include <cstdint>
namespace pg8 {
#define PG8_LAS __attribute__((address_space(3)))
typedef unsigned short bf16_t;
typedef short bf16x8 __attribute__((ext_vector_type(8)));
typedef float f32x4 __attribute__((ext_vector_type(4)));
typedef unsigned u32x4 __attribute__((ext_vector_type(4)));
constexpr int BM = 256, BK = 64, HALF = 128, HTB = HALF * BK * 2  , STAGE_BYTES = 8 * HTB, NXCD = 8, WGM = 4;

__host__ __device__ __forceinline__ int lds_byte(int r, int c) { const int st = (r >> 4) * 2 + (c >> 5), rr = r & 15, cc = c & 31, ob = rr * 64 + cc * 2; return st * 1024 + (ob ^ (((ob >> 9) & 1) << 5)); }
__host__ __device__ __forceinline__ void stage_rc(int b, int& R, int& C) { const int st = b / 1024, sb = b % 1024, swz = sb ^ (((sb >> 9) & 1) << 5); R = (st >> 1) * 16 + swz / 64; C = (st & 1) * 32 + (swz % 64) / 2; }
__host__ __device__ __forceinline__ int perm32(int rho) { const int n = rho >> 4, i = rho & 15; return 8 * (i >> 2) + 4 * n + (i & 3); }

struct Unit { int pm, pn; };
struct Gemm { const bf16_t* A; const bf16_t* Bt; int M, N, K; };

struct StaticOrder {
    int nM, nN, nwg, G, c;
    __host__ __device__ void init(int M, int N, int G_, int c_) { nM = M / BM; nN = N / BM; nwg = nM * nN; G = G_; c = c_; }
    __host__ __device__ bool next(int i, Unit& u) const {
        const long L = (long)i * G + c; if (L >= nwg) return false;
        int wgid = (int)L; { const int q = nwg / NXCD, r = nwg % NXCD, xcd = wgid % NXCD, off = wgid / NXCD; wgid = (xcd < r ? xcd * (q + 1) : r * (q + 1) + (xcd - r) * q) + off; }
        const int nig = WGM * nN, gid = wgid / nig, fm = gid * WGM, gsz = (nM - fm) < WGM ? (nM - fm) : WGM;
        u.pm = fm + ((wgid % nig) % gsz); u.pn = (wgid % nig) / gsz; return true;
    }
    __device__ __forceinline__ void a_ready(const Unit&) const {}
    __device__ __forceinline__ void done(const Unit&) const {}
};

__device__ __forceinline__ unsigned cvt_pk_bf16(float lo, float hi) { unsigned r; asm volatile("v_cvt_pk_bf16_f32 %0, %1, %2" : "=v"(r) : "v"(lo), "v"(hi)); return r; }
typedef float f32x2 __attribute__((ext_vector_type(2)));
__device__ __forceinline__ f32x2 gelu_pk(f32x2 v) {
    const f32x2 av = __builtin_elementwise_abs(v), d = av * 0.2316418882f + 1.0f;
    f32x2 t; t.x = __builtin_amdgcn_rcpf(d.x); t.y = __builtin_amdgcn_rcpf(d.y);
    f32x2 q = t * 0.5307027145f + (-0.7265760135f); q = q * t + 0.7107068705f; q = q * t + (-0.142248368f); q = q * t + 0.127414796f; q = q * t;
    const f32x2 s = (v * v) * (-0.72134752044f);
    f32x2 e; e.x = __builtin_amdgcn_exp2f(s.x); e.y = __builtin_amdgcn_exp2f(s.y);
    const f32x2 m = v * (q * e), r = v - m;
    f32x2 o; o.x = v.x < 0.f ? m.x : r.x; o.y = v.y < 0.f ? m.y : r.y; return o;
}

template <int ACT  > struct EpiBf16 {
    static constexpr bool PERM = true, AFTER_DRAIN = false; static_assert(ACT == 0 || ACT == 1, "EpiBf16: ACT is 0 (none) or 1 (gelu_pk)");
    bf16_t* O; int ldc; const float* bias; int split_cols; size_t split_stride; float scale0;
    __device__ __forceinline__ void operator()(const f32x4 (&acc)[2][2][4][2], const Unit& u, int wr, int wc, int fr, int fq) const {
        const int row0 = u.pm * BM + wr * 64 + fr; int colt = u.pn * BM; bf16_t* base = O;
        float sc = 1.f; if (split_cols) { const int t = colt / split_cols; base += (size_t)t * split_stride; colt -= t * split_cols; if (t == 0) sc = scale0; }
        const int col0 = colt + wc * 32 + 8 * fq, bcol0 = u.pn * BM + wc * 32 + 8 * fq;
        f32x4 bv[2][2];
#pragma unroll
        for (int bj = 0; bj < 2; ++bj)
#pragma unroll
            for (int n = 0; n < 2; ++n) bv[bj][n] = bias ? *(const f32x4*)(bias + bcol0 + bj * HALF + 4 * n) : (f32x4){0.f, 0.f, 0.f, 0.f};
#pragma unroll
        for (int ai = 0; ai < 2; ++ai)
#pragma unroll
            for (int m = 0; m < 4; ++m) { bf16_t* rowp = base + (size_t)(row0 + ai * HALF + m * 16) * ldc + col0;
#pragma unroll
                for (int bj = 0; bj < 2; ++bj) { f32x4 v0 = acc[ai][bj][m][0] + bv[bj][0], v1 = acc[ai][bj][m][1] + bv[bj][1];
                    if (ACT == 1) { f32x2 a = gelu_pk((f32x2){v0[0], v0[1]}), b = gelu_pk((f32x2){v0[2], v0[3]}), c = gelu_pk((f32x2){v1[0], v1[1]}), d = gelu_pk((f32x2){v1[2], v1[3]});
                        v0 = (f32x4){a.x, a.y, b.x, b.y}; v1 = (f32x4){c.x, c.y, d.x, d.y}; }
                    v0 = v0 * sc; v1 = v1 * sc; u32x4 w; w.x = cvt_pk_bf16(v0[0], v0[1]); w.y = cvt_pk_bf16(v0[2], v0[3]); w.z = cvt_pk_bf16(v1[0], v1[1]); w.w = cvt_pk_bf16(v1[2], v1[3]);
                    *(u32x4*)(rowp + bj * HALF) = w; } }
    }
};
template <class Epi, class Sched, bool ALIGN_EPI = false, bool SP2 = false>
__device__ __forceinline__ void gemm_phase(PG8_LAS unsigned char* lds, const Gemm g, const Sched& S, const Epi& E, int tid_in) {
    int tid_l = tid_in; asm volatile("" : "+v"(tid_l));
    const int tid = tid_l, wid = __builtin_amdgcn_readfirstlane(tid >> 6), lane = tid & 63, wr = wid >> 2, wc = wid & 3, fr = lane & 15, fq = lane >> 4;
    const int K = g.K, nt = K / BK;
    unsigned voffA[2], voffB[2];
#pragma unroll
    for (int i = 0; i < 2; ++i) { int R, C; stage_rc(tid * 16 + i * 8192, R, C); const int Rb = Epi::PERM ? ((R & ~31) + perm32(R & 31)) : R;
        voffA[i] = (unsigned)(R * K + C) * 2u; voffB[i] = (unsigned)(Rb * K + C) * 2u; }
    const size_t kstep = (size_t)(BK * 2);
    const size_t hstep = (size_t)HALF * K * 2;
    const size_t tstep = 2 * hstep;
    const unsigned ldsw = (unsigned)wid * 1024u;
    const int aoff = lds_byte(wr * 64 + fr, fq * 8), boff = lds_byte(wc * 32 + fr, fq * 8);
#define PG8_SA(b, h) (((b) * 2 + (h)) * HTB)
#define PG8_SB(b, h) ((4 + (b) * 2 + (h)) * HTB)
#define PG8_STAGE(bufoff, gbase, voff) do { _Pragma("unroll") for (int _i = 0; _i < 2; ++_i) \
        __builtin_amdgcn_global_load_lds((const unsigned*)((const char*)(gbase) + (voff)[_i]), (PG8_LAS unsigned*)(lds + (bufoff) + ldsw + _i * 8192), 16, 0, 0); } while (0)
#define PG8_LDA(dst, b, h) do { _Pragma("unroll") for (int m = 0; m < 4; ++m) _Pragma("unroll") for (int k = 0; k < 2; ++k) dst[m][k] = *(const PG8_LAS bf16x8*)(lds + PG8_SA(b, h) + aoff + m * 2048 + k * 1024); } while (0)
#define PG8_LDB(dst, b, h) do { _Pragma("unroll") for (int n = 0; n < 2; ++n) _Pragma("unroll") for (int k = 0; k < 2; ++k) dst[n][k] = *(const PG8_LAS bf16x8*)(lds + PG8_SB(b, h) + boff + n * 2048 + k * 1024); } while (0)
#define PG8_MMA(ai, bj, At, Bt) do { __builtin_amdgcn_s_setprio(1); _Pragma("unroll") for (int m = 0; m < 4; ++m) _Pragma("unroll") for (int n = 0; n < 2; ++n) _Pragma("unroll") for (int k = 0; k < 2; ++k) \
        acc[ai][bj][m][n] = __builtin_amdgcn_mfma_f32_16x16x32_bf16(Bt[n][k], At[m][k], acc[ai][bj][m][n], 0, 0, 0); __builtin_amdgcn_s_setprio(0); } while (0)
#define PG8_WAIT_V(n) asm volatile("s_waitcnt vmcnt(" #n ")" ::: "memory")
#define PG8_WAIT_L(n) asm volatile("s_waitcnt lgkmcnt(" #n ")" ::: "memory")
#define PG8_BAR __builtin_amdgcn_s_barrier()
#define PG8_SCHED __builtin_amdgcn_sched_barrier(0)
    Unit cur, nxt; int ui = 0;
    if (!S.next(0, cur)) return;
    f32x4 acc[2][2][4][2];
#pragma unroll
    for (int a = 0; a < 2; ++a)
#pragma unroll
        for (int b = 0; b < 2; ++b)
#pragma unroll
            for (int m = 0; m < 4; ++m)
#pragma unroll
                for (int n = 0; n < 2; ++n) acc[a][b][m][n] = (f32x4){0.f, 0.f, 0.f, 0.f};
    bf16x8 At[4][2], B0[2][2], B1[2][2];
    const char* cA = (const char*)g.A + (size_t)cur.pm * tstep; const char* cB = (const char*)g.Bt + (size_t)cur.pn * tstep;
    S.a_ready(cur);
    if constexpr (SP2) {
        PG8_STAGE(PG8_SB(0, 0), cB, voffB); PG8_STAGE(PG8_SB(0, 1), cB + hstep, voffB); PG8_STAGE(PG8_SA(0, 0), cA, voffA); PG8_STAGE(PG8_SA(0, 1), cA + hstep, voffA);
        if (wr == 1) PG8_BAR;
        PG8_WAIT_V(2); PG8_BAR;
        PG8_STAGE(PG8_SB(1, 0), cB + kstep, voffB); PG8_STAGE(PG8_SA(1, 0), cA + kstep, voffA); PG8_STAGE(PG8_SB(1, 1), cB + hstep + kstep, voffB);
        PG8_WAIT_V(6); PG8_BAR;
    } else {
        PG8_STAGE(PG8_SB(0, 0), cB, voffB); PG8_STAGE(PG8_SA(0, 0), cA, voffA); PG8_STAGE(PG8_SB(0, 1), cB + hstep, voffB); PG8_STAGE(PG8_SA(0, 1), cA + hstep, voffA);
        if (wr == 1) PG8_BAR;
        PG8_WAIT_V(4); PG8_BAR;
        PG8_STAGE(PG8_SB(1, 0), cB + kstep, voffB); PG8_STAGE(PG8_SA(1, 0), cA + kstep, voffA); PG8_STAGE(PG8_SB(1, 1), cB + hstep + kstep, voffB);
        PG8_WAIT_V(6); PG8_BAR;
    }
    for (;;) {
        const bool has_next = S.next(ui + 1, nxt);
        const char* nA = has_next ? (const char*)g.A + (size_t)nxt.pm * tstep : cA; const char* nB = has_next ? (const char*)g.Bt + (size_t)nxt.pn * tstep : cB;
        for (int t = 0; t < nt; t += 2) {
            const bool last = (t == nt - 2);
            const char* a1 = cA + (size_t)(t + 1) * kstep;
            const char* a2 = last ? nA : cA + (size_t)(t + 2) * kstep; const char* b2 = last ? nB : cB + (size_t)(t + 2) * kstep;
            const char* a3 = a2 + kstep; const char* b3 = b2 + kstep;
            if (last && has_next) S.a_ready(nxt);
            if constexpr (SP2) {
            PG8_LDB(B0, 0, 0); PG8_LDB(B1, 0, 1); PG8_SCHED; PG8_LDA(At, 0, 0); PG8_STAGE(PG8_SA(1, 1), a1 + hstep, voffA);
            PG8_WAIT_V(8); PG8_WAIT_L(0); PG8_BAR; PG8_MMA(0, 0, At, B0); PG8_MMA(0, 1, At, B1); PG8_BAR; PG8_SCHED;
            PG8_LDA(At, 0, 1); PG8_STAGE(PG8_SB(0, 0), b2, voffB); PG8_STAGE(PG8_SB(0, 1), b2 + hstep, voffB); PG8_STAGE(PG8_SA(0, 0), a2, voffA);
            PG8_WAIT_V(8); PG8_WAIT_L(0); PG8_BAR; PG8_MMA(1, 0, At, B0); PG8_MMA(1, 1, At, B1); PG8_BAR; PG8_SCHED;
            PG8_LDB(B0, 1, 0); PG8_LDB(B1, 1, 1); PG8_SCHED; PG8_LDA(At, 1, 0); PG8_STAGE(PG8_SA(0, 1), a2 + hstep, voffA);
            PG8_WAIT_V(8); PG8_WAIT_L(0); PG8_BAR; PG8_MMA(0, 0, At, B0); PG8_MMA(0, 1, At, B1); PG8_BAR; PG8_SCHED;
            PG8_LDA(At, 1, 1); PG8_STAGE(PG8_SB(1, 0), b3, voffB); PG8_STAGE(PG8_SB(1, 1), b3 + hstep, voffB); PG8_STAGE(PG8_SA(1, 0), a3, voffA);
            PG8_WAIT_V(8); PG8_WAIT_L(0); PG8_BAR; PG8_MMA(1, 0, At, B0); PG8_MMA(1, 1, At, B1); PG8_BAR; PG8_SCHED;
            } else {
            PG8_LDB(B0, 0, 0); PG8_SCHED; PG8_LDA(At, 0, 0); PG8_STAGE(PG8_SA(1, 1), a1 + hstep, voffA);
            PG8_WAIT_L(8); PG8_BAR; PG8_WAIT_L(0); PG8_MMA(0, 0, At, B0); PG8_BAR; PG8_SCHED;
            PG8_LDB(B1, 0, 1); PG8_STAGE(PG8_SB(0, 0), b2, voffB);
            PG8_BAR; PG8_WAIT_L(0); PG8_MMA(0, 1, At, B1); PG8_BAR;
            PG8_LDA(At, 0, 1); PG8_STAGE(PG8_SA(0, 0), a2, voffA);
            PG8_BAR; PG8_WAIT_L(0); PG8_MMA(1, 0, At, B0); PG8_BAR; PG8_SCHED;
            PG8_STAGE(PG8_SB(0, 1), b2 + hstep, voffB);
            PG8_WAIT_V(6); PG8_BAR; PG8_MMA(1, 1, At, B1); PG8_BAR;
            PG8_LDB(B0, 1, 0); PG8_SCHED; PG8_LDA(At, 1, 0); PG8_STAGE(PG8_SA(0, 1), a2 + hstep, voffA);
            PG8_WAIT_L(8); PG8_BAR; PG8_WAIT_L(0); PG8_MMA(0, 0, At, B0); PG8_BAR; PG8_SCHED;
            PG8_LDB(B1, 1, 1); PG8_STAGE(PG8_SB(1, 0), b3, voffB);
            PG8_BAR; PG8_WAIT_L(0); PG8_MMA(0, 1, At, B1); PG8_BAR;
            PG8_LDA(At, 1, 1); PG8_STAGE(PG8_SA(1, 0), a3, voffA);
            PG8_BAR; PG8_WAIT_L(0); PG8_MMA(1, 0, At, B0); PG8_BAR; PG8_SCHED;
            PG8_STAGE(PG8_SB(1, 1), b3 + hstep, voffB);
            PG8_WAIT_V(6); PG8_BAR; PG8_MMA(1, 1, At, B1); PG8_BAR;
            }
        }
        if constexpr (ALIGN_EPI) { if (wr == 0) PG8_BAR; }
        if constexpr (!Epi::AFTER_DRAIN) { E(acc, cur, wr, wc, fr, fq); S.done(cur); }
        if (!has_next) break;
#pragma unroll
        for (int a = 0; a < 2; ++a)
#pragma unroll
            for (int b = 0; b < 2; ++b)
#pragma unroll
                for (int m = 0; m < 4; ++m)
#pragma unroll
                    for (int n = 0; n < 2; ++n) acc[a][b][m][n] = (f32x4){0.f, 0.f, 0.f, 0.f};
        cur = nxt; cA = nA; cB = nB; ++ui;
        if constexpr (ALIGN_EPI) { if (wr == 1) PG8_BAR; }
    }
    PG8_WAIT_V(0);
    if constexpr (!ALIGN_EPI) { if (wr == 0) PG8_BAR; }
    PG8_BAR;
    if constexpr (Epi::AFTER_DRAIN) { E.fused(acc, cur, wr, wc, fr, fq, lds, wid, lane); S.done(cur); }
#undef PG8_SA
#undef PG8_SB
#undef PG8_STAGE
#undef PG8_LDA
#undef PG8_LDB
#undef PG8_MMA
#undef PG8_WAIT_V
#undef PG8_WAIT_L
#undef PG8_BAR
#undef PG8_SCHED
}
}

#define LAS __attribute__((address_space(3)))
#define XB_TMO      128
#define XB_XCNT(j)  (256  + 64 * (j))
#define XB_XSUB(j)  (1280 + 64 * (j))
#define XB_XGEN(j)  (2304 + 64 * (j))
#define XB_TOP      3328
#define XB_TOPGEN   3392
#define XCD_BAR_WORDS 3456
#define XB_SPIN_CAP (1u << 18)

__device__ __forceinline__ unsigned xb_ld(unsigned* p)              { return __hip_atomic_load(p, __ATOMIC_RELAXED, __HIP_MEMORY_SCOPE_AGENT); }
__device__ __forceinline__ unsigned xb_add(unsigned* p, unsigned v) { return __hip_atomic_fetch_add(p, v, __ATOMIC_RELAXED, __HIP_MEMORY_SCOPE_AGENT); }
__device__ __forceinline__ unsigned xb_xcc_id() { return (unsigned)__builtin_amdgcn_s_getreg((3 << 11) | 20) & 0xFu; }
#define XB_SPIN(cond, bar) do { unsigned _sp = 0; while (cond) { __builtin_amdgcn_s_sleep(1); \
    if ((++_sp & 255u) == 0u) { if (xb_ld(&(bar)[XB_TMO])) break; if (_sp > XB_SPIN_CAP) { atomicAdd(&(bar)[XB_TMO], 1u); break; } } } } while (0)

struct XcdBarrier {
    unsigned* bar; unsigned x;
    volatile LAS unsigned* st;
};

__device__ __forceinline__ XcdBarrier xcd_barrier_post(unsigned* bar, volatile LAS unsigned* st, bool leader) {
    XcdBarrier b; b.bar = bar; b.x = xb_xcc_id(); b.st = st;
    if (leader) (void)xb_add(&bar[XB_XCNT(b.x)], 1u);
    return b;
}
__device__ __forceinline__ void xcd_barrier_complete(unsigned* bar, unsigned x, unsigned& nloc, unsigned& nx) {
    const unsigned G = gridDim.x * gridDim.y * gridDim.z;
    unsigned sum, cnt, mine, sp = 0u;
    for (;;) {
        sum = 0u; cnt = 0u; mine = 0u;
#pragma unroll
        for (unsigned j = 0; j < 16; ++j) { const unsigned c = xb_ld(&bar[XB_XCNT(j)]); sum += c; cnt += (c > 0u) ? 1u : 0u; mine = (j == x) ? c : mine; }
        if (sum == G) break;
        __builtin_amdgcn_s_sleep(1);
        if ((++sp & 255u) == 0u) { if (xb_ld(&bar[XB_TMO])) break; if (sp > XB_SPIN_CAP) { atomicAdd(&bar[XB_TMO], 1u); break; } }
    }
    nloc = mine > 0u ? mine : 1u; nx = cnt > 0u ? cnt : 1u;
}

__device__ __forceinline__ void xcd_barrier(const XcdBarrier& b, bool leader) {
    asm volatile("s_waitcnt vmcnt(0)" ::: "memory");
    __syncthreads();
    if (leader) {
        unsigned* bar = b.bar;
        __builtin_amdgcn_s_waitcnt(0);
        unsigned nloc = b.st[0], nx = b.st[1];
        if (nloc == 0u) { xcd_barrier_complete(bar, b.x, nloc, nx); b.st[0] = nloc; b.st[1] = nx; }
        const unsigned old = xb_add(&bar[XB_XSUB(b.x)], 1u);
        const unsigned gen = old / nloc;
        if (old + 1u == (gen + 1u) * nloc) {
            __builtin_amdgcn_fence(__ATOMIC_RELEASE, "agent");
            asm volatile("s_waitcnt vmcnt(0)" ::: "memory");
            const unsigned og = xb_add(&bar[XB_TOP], 1u);
            const unsigned tg = og / nx;
            if (og + 1u == (tg + 1u) * nx) xb_add(&bar[XB_TOPGEN], 1u);
            else XB_SPIN(xb_ld(&bar[XB_TOPGEN]) == tg, bar);
            __builtin_amdgcn_fence(__ATOMIC_ACQUIRE, "agent");
            xb_add(&bar[XB_XGEN(b.x)], 1u);
            asm volatile("s_waitcnt vmcnt(0)" ::: "memory");
        } else {
            XB_SPIN(xb_ld(&bar[XB_XGEN(b.x)]) == gen, bar);
            __builtin_amdgcn_fence(__ATOMIC_ACQUIRE, "agent");
            asm volatile("s_waitcnt vmcnt(0)" ::: "memory");
        }
    }
    __syncthreads();
}

constexpr int BATCH = 16, SEQ = 2048, DM = 1024, MTOK = BATCH * SEQ, FF = 2816, NGU = 2 * FF, NINP = 3584, INCOLS = 3360, DEPTH = 2;
constexpr int NWAVES = 8;
constexpr float EPS = 1e-6f;
typedef unsigned short bf16;
typedef unsigned v4u __attribute__((ext_vector_type(4)));
typedef unsigned v2u __attribute__((ext_vector_type(2)));
typedef float f32x4 __attribute__((ext_vector_type(4)));
#define LDS_WAIT() asm volatile("s_waitcnt lgkmcnt(0)" ::: "memory")

constexpr size_t MiB = 1u << 20;
constexpr size_t WS_CTL = 0, CTL_ZERO_BYTES = MiB;
constexpr size_t WS_TAB = 1 * MiB;
constexpr size_t TAB_COS = 0, TAB_SIN = 65536, TAB_B1 = 131072, TAB_R2 = 262144;
constexpr size_t WS_W = 2 * MiB;
constexpr size_t WO_GU1 = 0, WO_DN1 = 11 * MiB, WO_GU2 = 16 * MiB + MiB / 2, WO_DN2 = 27 * MiB + MiB / 2, WO_IN = 33 * MiB, WO_OUT = 40 * MiB, WO_CMP = 42 * MiB;
constexpr size_t WS_X16 = 45 * MiB;
constexpr size_t WS_U = 109 * MiB;
constexpr size_t WS_HB = 173 * MiB;
constexpr size_t WS_HD = 349 * MiB;
constexpr size_t WS_PQ = 413 * MiB;
constexpr size_t WS_CC = 421 * MiB;
constexpr size_t WS_END = 422 * MiB;
constexpr size_t WS_QN = 173 * MiB, WS_KCR = 205 * MiB, WS_VCR = 213 * MiB, WS_KS = 221 * MiB, WS_VS = 229 * MiB, WS_KW = 237 * MiB, WS_VW = 245 * MiB;
constexpr size_t WS_MQ = 253 * MiB, WS_MK = 285 * MiB, WS_MV = 317 * MiB, WS_MO = 349 * MiB, WS_GATE = 381 * MiB;
static_assert(WS_GATE + 4 * MiB <= WS_PQ, "in-projection outputs end below PQ");
constexpr int CW_BAR = 4096, CW_QUEUE = 16384;
constexpr int PH_BYTES = 143360, MISC_OFF = PH_BYTES, LDS_BYTES = 147456;

__device__ __forceinline__ unsigned f2bf(float f) { unsigned u = __builtin_bit_cast(unsigned, f); return (u + 0x7fffu + ((u >> 16) & 1u)) >> 16; }
__device__ __forceinline__ unsigned pk2(float lo, float hi) { return f2bf(lo) | (f2bf(hi) << 16); }
typedef float f32x2v_ __attribute__((ext_vector_type(2))); typedef __bf16 bf16x2v_ __attribute__((ext_vector_type(2)));
__device__ __forceinline__ unsigned cvtpk(float lo, float hi) { f32x2v_ v = {lo, hi}; bf16x2v_ b = __builtin_convertvector(v, bf16x2v_); return __builtin_bit_cast(unsigned, b); }
__device__ __forceinline__ float bflo(unsigned u) { return __builtin_bit_cast(float, u << 16); }
__device__ __forceinline__ float bfhi(unsigned u) { return __builtin_bit_cast(float, u & 0xffff0000u); }
__device__ __forceinline__ float bf2f(bf16 b) { return __builtin_bit_cast(float, (unsigned)b << 16); }
__device__ __forceinline__ float sigmoidf_(float x) { return __builtin_amdgcn_rcpf(1.f + __expf(-x)); }
__device__ __forceinline__ int fresh_lane() { unsigned z = 0u; asm volatile("" : "+v"(z)); return (int)__builtin_amdgcn_mbcnt_hi(~0u, __builtin_amdgcn_mbcnt_lo(~0u, z)); }
__device__ __forceinline__ float shx(float v, int mask, int lane) { return __builtin_bit_cast(float, __builtin_amdgcn_ds_bpermute((lane ^ mask) << 2, __builtin_bit_cast(int, v))); }
__device__ __forceinline__ unsigned shxu(unsigned v, int mask, int lane) { return (unsigned)__builtin_amdgcn_ds_bpermute((lane ^ mask) << 2, (int)v); }
__device__ __forceinline__ float shi(float v, int src) { return __builtin_bit_cast(float, __builtin_amdgcn_ds_bpermute(src << 2, __builtin_bit_cast(int, v))); }
__device__ __forceinline__ float wave_sum(float v, int lane) {
    (void)lane;
    v += __builtin_bit_cast(float, __builtin_amdgcn_update_dpp(0, __builtin_bit_cast(int, v), 0xB1, 0xF, 0xF, false));
    v += __builtin_bit_cast(float, __builtin_amdgcn_update_dpp(0, __builtin_bit_cast(int, v), 0x4E, 0xF, 0xF, false));
    v += __builtin_bit_cast(float, __builtin_amdgcn_update_dpp(0, __builtin_bit_cast(int, v), 0x124, 0xF, 0xF, false));
    v += __builtin_bit_cast(float, __builtin_amdgcn_update_dpp(0, __builtin_bit_cast(int, v), 0x128, 0xF, 0xF, false));
    const int iv = __builtin_bit_cast(int, v);
    const float a = __builtin_bit_cast(float, __builtin_amdgcn_readlane(iv, 0)), b = __builtin_bit_cast(float, __builtin_amdgcn_readlane(iv, 16));
    const float c = __builtin_bit_cast(float, __builtin_amdgcn_readlane(iv, 32)), d = __builtin_bit_cast(float, __builtin_amdgcn_readlane(iv, 48));
    return (a + b) + (c + d);
}

struct SrcGU { const float* W; const float* g; __device__ __forceinline__ float operator()(int k, int nd) const { const int pn = nd >> 8, r = nd & 255; const int col = (r < 128) ? (pn * 128 + r) : (FF + pn * 128 + r - 128); return W[(size_t)k * NGU + col] * g[k]; } };
struct SrcPlain { const float* W; int N; __device__ __forceinline__ float operator()(int k, int nd) const { return W[(size_t)k * N + nd]; } };
struct SrcIN { const float* W; const float* g; __device__ __forceinline__ float operator()(int k, int nd) const {
    const int col = nd < 1280 ? nd : (nd < 3328 ? nd + 24 : (nd < 3352 ? nd - 3328 + 1280 : (nd < 3360 ? nd : -1)));
    return col < 0 ? 0.f : W[(size_t)k * INCOLS + col] * g[k]; } };
struct SrcCMP { const float* W1; __device__ __forceinline__ float operator()(int k, int nd) const { const int kv = nd >> 8, r = nd & 255;
    return r < 128 ? W1[((size_t)kv * 2048 + k) * 128 + r] : W1[((size_t)kv * 2048 + 1024 + k) * 128 + r - 128]; } };

template <class SrcF>
__device__ __forceinline__ void transpose_item(const SrcF& src, int K, bf16* WT, LAS float* scr, int kb, int nb, int lane) {
    const int k0 = 64 * kb, n0 = 32 * nb;
#pragma unroll 8
    for (int i = 0; i < 32; ++i) { const int kk = 2 * i + (lane >> 5); scr[kk * 33 + (lane & 31)] = src(k0 + kk, n0 + (lane & 31)); }
    LDS_WAIT(); asm volatile("" ::: "memory");
    const int c = lane & 7;
#pragma unroll
    for (int j = 0; j < 4; ++j) { const int n = (lane >> 3) + 8 * j; const LAS float* s = scr + (8 * c) * 33 + n;
        v4u o; o.x = pk2(s[0 * 33], s[1 * 33]); o.y = pk2(s[2 * 33], s[3 * 33]); o.z = pk2(s[4 * 33], s[5 * 33]); o.w = pk2(s[6 * 33], s[7 * 33]);
        *(v4u*)(WT + (size_t)(n0 + n) * K + k0 + 8 * c) = o; }
    LDS_WAIT(); asm volatile("" ::: "memory");
}

template <int MODE>
__device__ __forceinline__ void thin_phase(const bf16* HD, const float* xin_f32, bf16* X16, float* out_f32, float* R2, const float* gpost, float cc, int gw, int NGW, int lane) {
    f32x4 gp[4];
#pragma unroll
    for (int j = 0; j < 4; ++j) gp[j] = (MODE != 0) ? *(const f32x4*)(gpost + 4 * lane + 256 * j) : (f32x4){0.f, 0.f, 0.f, 0.f};
    f32x4 xf[4]; v2u xn[4], hn[4];
    if (gw < MTOK) {
#pragma unroll
        for (int j = 0; j < 4; ++j) { if (MODE == 0) xf[j] = *(const f32x4*)(xin_f32 + (size_t)gw * DM + 4 * lane + 256 * j);
            else { xn[j] = *(const v2u*)(X16 + (size_t)gw * DM + 4 * lane + 256 * j); hn[j] = *(const v2u*)(HD + (size_t)gw * DM + 4 * lane + 256 * j); } }
    }
    for (int m = gw; m < MTOK; m += NGW) {
        f32x4 x[4]; v2u hw[4];
#pragma unroll
        for (int j = 0; j < 4; ++j) { if (MODE == 0) x[j] = xf[j]; else { x[j] = (f32x4){bflo(xn[j].x), bfhi(xn[j].x), bflo(xn[j].y), bfhi(xn[j].y)}; hw[j] = hn[j]; } }
        const int m2 = m + NGW;
        if (m2 < MTOK) {
#pragma unroll
            for (int j = 0; j < 4; ++j) { if (MODE == 0) xf[j] = *(const f32x4*)(xin_f32 + (size_t)m2 * DM + 4 * lane + 256 * j);
                else { xn[j] = *(const v2u*)(X16 + (size_t)m2 * DM + 4 * lane + 256 * j); hn[j] = *(const v2u*)(HD + (size_t)m2 * DM + 4 * lane + 256 * j); } }
        }
        if (MODE != 0) {
            f32x4 h[4]; float ss = 0.f;
#pragma unroll
            for (int j = 0; j < 4; ++j) { h[j] = (f32x4){bflo(hw[j].x), bfhi(hw[j].x), bflo(hw[j].y), bfhi(hw[j].y)}; ss += (h[j].x * h[j].x + h[j].y * h[j].y) + (h[j].z * h[j].z + h[j].w * h[j].w); }
            const float r = cc * __frsqrt_rn(wave_sum(ss, lane) * (1.f / DM) + EPS);
#pragma unroll
            for (int j = 0; j < 4; ++j) x[j] = x[j] + (h[j] * r) * gp[j];
        }
        if (MODE == 2) {
#pragma unroll
            for (int j = 0; j < 4; ++j) *(f32x4*)(out_f32 + (size_t)m * DM + 4 * lane + 256 * j) = x[j];
        } else {
            float s2 = 0.f;
#pragma unroll
            for (int j = 0; j < 4; ++j) { s2 += (x[j].x * x[j].x + x[j].y * x[j].y) + (x[j].z * x[j].z + x[j].w * x[j].w);
                v2u w; w.x = cvtpk(x[j].x, x[j].y); w.y = cvtpk(x[j].z, x[j].w); *(v2u*)(X16 + (size_t)m * DM + 4 * lane + 256 * j) = w; }
            const float r2 = __frsqrt_rn(wave_sum(s2, lane) * (1.f / DM) + EPS);
            if (lane == 0) R2[m] = r2;
        }
    }
}

struct EpiSwiglu {
    static constexpr bool PERM = true, AFTER_DRAIN = false;
    bf16* H; const float* R2;
    __device__ __forceinline__ void operator()(const pg8::f32x4 (&acc)[2][2][4][2], const pg8::Unit& u, int wr, int wc, int fr, int fq) const {
#pragma unroll
        for (int ai = 0; ai < 2; ++ai)
#pragma unroll
            for (int m = 0; m < 4; ++m) {
                const int row = u.pm * 256 + ai * 128 + wr * 64 + m * 16 + fr; const float rs = R2[row];
                float o[8];
#pragma unroll
                for (int n = 0; n < 2; ++n)
#pragma unroll
                    for (int e = 0; e < 4; ++e) { const float g = acc[ai][0][m][n][e] * rs, up = acc[ai][1][m][n][e] * rs; o[n * 4 + e] = g * up * __builtin_amdgcn_rcpf(1.f + __expf(-g)); }
                v4u w; w.x = pg8::cvt_pk_bf16(o[0], o[1]); w.y = pg8::cvt_pk_bf16(o[2], o[3]); w.z = pg8::cvt_pk_bf16(o[4], o[5]); w.w = pg8::cvt_pk_bf16(o[6], o[7]);
                *(v4u*)(H + (size_t)row * FF + u.pn * 128 + wc * 32 + fq * 8) = w;
            }
    }
};
struct EpiPQ {
    static constexpr bool PERM = true, AFTER_DRAIN = false;
    float* O;
    __device__ __forceinline__ void operator()(const pg8::f32x4 (&acc)[2][2][4][2], const pg8::Unit& u, int wr, int wc, int fr, int fq) const {
#pragma unroll
        for (int ai = 0; ai < 2; ++ai)
#pragma unroll
            for (int m = 0; m < 4; ++m) {
                const int row = u.pm * 256 + ai * 128 + wr * 64 + m * 16 + fr;
#pragma unroll
                for (int bj = 0; bj < 2; ++bj) { float* p = O + (size_t)row * 256 + bj * 128 + wc * 32 + fq * 8;
                    *(pg8::f32x4*)p = acc[ai][bj][m][0]; *(pg8::f32x4*)(p + 4) = acc[ai][bj][m][1]; }
            }
    }
};
struct CmpOrder {
    int c, G;
    __device__ __forceinline__ bool next(int i, pg8::Unit& u) const { const int idx = i * G + c; if (idx >= 32) return false; u.pm = idx; u.pn = idx >> 4; return true; }
    __device__ __forceinline__ void a_ready(const pg8::Unit&) const {}
    __device__ __forceinline__ void done(const pg8::Unit&) const {}
};
struct EpiInProj {
    static constexpr bool PERM = true, AFTER_DRAIN = false;
    unsigned char* ws;
    __device__ __forceinline__ void operator()(const pg8::f32x4 (&acc)[2][2][4][2], const pg8::Unit& u, int wr, int wc, int fr, int fq) const {
        const int pn = u.pn;
        const float* cosT = (const float*)(ws + WS_TAB + TAB_COS); const float* sinT = (const float*)(ws + WS_TAB + TAB_SIN);
        const bool ropet = (pn < 2) || (pn == 3) || (pn == 4);
        const bool ropew = ropet && ((wc & 1) == 0);
#pragma unroll
        for (int ai = 0; ai < 2; ++ai)
#pragma unroll
            for (int m = 0; m < 4; ++m) {
                const int row = u.pm * 256 + ai * 128 + wr * 64 + m * 16 + fr;
                const int b = row >> 11, t = row & 2047; const float rs = ((const float*)(ws + WS_TAB + TAB_R2))[row];
                f32x4 c0, c1, s0, s1;
                if (ropew) { c0 = *(const f32x4*)(cosT + t * 8); c1 = *(const f32x4*)(cosT + t * 8 + 4); s0 = *(const f32x4*)(sinT + t * 8); s1 = *(const f32x4*)(sinT + t * 8 + 4); }
#pragma unroll
                for (int bj = 0; bj < 2; ++bj) {
                    f32x4 v0 = acc[ai][bj][m][0] * rs, v1 = acc[ai][bj][m][1] * rs;
                    const int cl = bj * 128 + wc * 32 + fq * 8;
                    if (ropew && (pn < 2 || bj == 0)) {
                        f32x4 p0, p1; const int ln = fq * 16 + fr;
                        p0.x = shx(v0.x, 16, ln); p0.y = shx(v0.y, 16, ln); p0.z = shx(v0.z, 16, ln); p0.w = shx(v0.w, 16, ln);
                        p1.x = shx(v1.x, 16, ln); p1.y = shx(v1.y, 16, ln); p1.z = shx(v1.z, 16, ln); p1.w = shx(v1.w, 16, ln);
                        const float sg = (fq == 0) ? -1.f : 1.f;
                        if (fq < 2) { v0 = v0 * c0 + (p0 * s0) * sg; v1 = v1 * c1 + (p1 * s1) * sg; }
                    }
                    if (pn == 13) { if (cl < 32) { float* p = (float*)(ws + WS_GATE) + (size_t)row * 32 + cl; *(f32x4*)p = v0; *(f32x4*)(p + 4) = v1; } }
                    else {
                        size_t off;
                        if (pn < 2) off = WS_QN + ((size_t)row * 512 + pn * 256 + cl) * 2;
                        else if (pn < 5) { const int g = wc >> 1, d = (wc & 1) * 32 + fq * 8; off = WS_KCR + (size_t)((pn - 2) * 2 + bj) * (8 * MiB) + (((size_t)(b * 2 + g) * SEQ + t) * 64 + d) * 2; }
                        else { const int q = pn - 5; off = WS_MQ + (size_t)(q >> 1) * (32 * MiB) + ((size_t)row * 512 + (q & 1) * 256 + cl) * 2; }
                        v4u w; w.x = pg8::cvt_pk_bf16(v0.x, v0.y); w.y = pg8::cvt_pk_bf16(v0.z, v0.w); w.z = pg8::cvt_pk_bf16(v1.x, v1.y); w.w = pg8::cvt_pk_bf16(v1.z, v1.w);
                        *(v4u*)(ws + off) = w;
                    }
                }
            }
    }
};
static_assert(WS_VCR == WS_KCR + 8 * MiB && WS_KS == WS_KCR + 16 * MiB && WS_VS == WS_KCR + 24 * MiB && WS_KW == WS_KCR + 32 * MiB && WS_VW == WS_KCR + 40 * MiB, "kv buffers are 8 MiB apart in (pn, bj) order");
static_assert(WS_MK == WS_MQ + 32 * MiB && WS_MV == WS_MQ + 64 * MiB && WS_MO == WS_MQ + 96 * MiB, "mLSTM buffers are 32 MiB apart");

struct MixPtrs { unsigned char* ws; const float *conv_w, *conv_b, *i_bias, *f_bias, *mnorm_g; };
#define MP_QN ((const bf16*)(P.ws + WS_QN))
#define MP_KS ((const bf16*)(P.ws + WS_KS))
#define MP_VS ((const bf16*)(P.ws + WS_VS))
#define MP_KW ((const bf16*)(P.ws + WS_KW))
#define MP_VW ((const bf16*)(P.ws + WS_VW))
#define MP_KC ((const bf16*)(P.ws + WS_CC))
#define MP_VC ((const bf16*)(P.ws + WS_CC) + (size_t)4096 * 64)
#define MP_MQ ((const bf16*)(P.ws + WS_MQ))
#define MP_MK ((const bf16*)(P.ws + WS_MK))
#define MP_MV ((const bf16*)(P.ws + WS_MV))
#define MP_MO ((const bf16*)(P.ws + WS_MO))
#define MP_GATE ((const float*)(P.ws + WS_GATE))
#define MP_Y ((bf16*)(P.ws + WS_U))


typedef float f32x16 __attribute__((ext_vector_type(16)));
typedef short bf16x8v __attribute__((ext_vector_type(8)));
typedef short s16x4v __attribute__((ext_vector_type(4)));
typedef float f32x2v __attribute__((ext_vector_type(2)));
typedef __bf16 bf16x2v __attribute__((ext_vector_type(2)));
#define MFMA32(a, b, c) __builtin_amdgcn_mfma_f32_32x32x16_bf16((a), (b), (c), 0, 0, 0)
__device__ __forceinline__ s16x4v tr_read(const LAS unsigned char* p) { return __builtin_bit_cast(s16x4v, __builtin_amdgcn_ds_read_tr16_b64_v4i16((LAS s16x4v*)p)); }
__device__ __forceinline__ int tile_off(int key, int ch8) { return (ch8 >> 2) * 4096 + key * 64 + (((ch8 & 3) ^ ((key >> 2) & 3)) << 4); }
constexpr int NM_SLOT = 0, NM_IMP = 65536, NM_IMS = 99328, NM_SEL = 108544, NM_ITEM = 108864;
constexpr float QK_SCALE = 0.125f * 1.4426950408889634f;

#define SBAR() __builtin_amdgcn_sched_barrier(0)
#define LBAR() asm volatile("s_waitcnt lgkmcnt(0)\n\ts_barrier" ::: "memory")
__device__ __forceinline__ void k_load(const LAS unsigned char* Ks, int r, int h, bf16x8v (&kf)[8]) {
    const int sw = (r >> 2) & 3;
#pragma unroll
    for (int ks = 0; ks < 4; ++ks) { const int off = (ks >> 1) * 4096 + r * 64 + (((((ks & 1) << 1) + h) ^ sw) << 4);
        kf[2 * ks] = *(const LAS bf16x8v*)(Ks + off); kf[2 * ks + 1] = *(const LAS bf16x8v*)(Ks + off + 2048); }
}
__device__ __forceinline__ void qk_mma(const bf16x8v (&kf)[8], const bf16x8v (&qf)[4], f32x16& p0, f32x16& p1) {
    const f32x16 z = {0.f, 0.f, 0.f, 0.f, 0.f, 0.f, 0.f, 0.f, 0.f, 0.f, 0.f, 0.f, 0.f, 0.f, 0.f, 0.f};
#pragma unroll
    for (int ks = 0; ks < 4; ++ks) { p0 = MFMA32(kf[2 * ks], qf[ks], ks ? p0 : z); p1 = MFMA32(kf[2 * ks + 1], qf[ks], ks ? p1 : z); }
}
__device__ __forceinline__ void v_load(const LAS unsigned char* Vs, int lane, bf16x8v (&vf)[8]) {
    const int h = lane >> 5, i16 = lane & 15, q = i16 >> 2, p = i16 & 3, gi = (lane >> 4) & 1;
    const int cidx = 2 * gi + (p >> 1), e8 = (p & 1) << 3;
    const int offlo = q * 64 + ((cidx ^ h) << 4) + e8 + h * 256, offhi = q * 64 + ((cidx ^ (h | 2)) << 4) + e8 + h * 256 + 512;
#pragma unroll
    for (int kb = 0; kb < 2; ++kb)
#pragma unroll
        for (int s = 0; s < 2; ++s)
#pragma unroll
            for (int db = 0; db < 2; ++db) { const LAS unsigned char* base = Vs + db * 4096 + (kb * 32 + s * 16) * 64;
                const s16x4v lo = tr_read(base + offlo), hi = tr_read(base + offhi);
                vf[(kb * 2 + s) * 2 + db] = __builtin_shufflevector(lo, hi, 0, 1, 2, 3, 4, 5, 6, 7); }
}
__device__ __forceinline__ void pv_mma(const bf16x8v (&vf)[8], const f32x16& p0, const f32x16& p1, f32x16 (&o)[2]) {
#pragma unroll
    for (int kb = 0; kb < 2; ++kb)
#pragma unroll
        for (int s = 0; s < 2; ++s) {
            const f32x16& P = kb ? p1 : p0;
            v4u pw; pw.x = cvtpk(P[8 * s + 0], P[8 * s + 1]); pw.y = cvtpk(P[8 * s + 2], P[8 * s + 3]); pw.z = cvtpk(P[8 * s + 4], P[8 * s + 5]); pw.w = cvtpk(P[8 * s + 6], P[8 * s + 7]);
            const bf16x8v pf = __builtin_bit_cast(bf16x8v, pw);
            o[0] = MFMA32(vf[(kb * 2 + s) * 2], pf, o[0]); o[1] = MFMA32(vf[(kb * 2 + s) * 2 + 1], pf, o[1]);
        }
}

__device__ __forceinline__ void nsa_unit_mfma(LAS unsigned char* L, const MixPtrs& P, int b, int g, int c, int tid_in) {
    int tid_l = tid_in; asm volatile("" : "+v"(tid_l));
    const int tid = tid_l, lane = tid & 63, w = __builtin_amdgcn_readfirstlane(tid >> 6);
    const int r = lane & 31, h = lane >> 5, head = w >> 1, qi = (w & 1) * 32 + r, t = c * 64 + qi;
    const size_t row = (size_t)b * SEQ + t;
    LAS unsigned* SEL = (LAS unsigned*)(L + NM_SEL); LAS int* ITEM = (LAS int*)(L + NM_ITEM);
    const size_t kvbase = (size_t)(b * 2 + g) * SEQ * 64, ccbase = (size_t)(b * 2 + g) * 128 * 64;
    const int skey = tid >> 3, sch = tid & 7, soff = tile_off(skey, sch);
    bf16x8v qf[4];
    { const bf16* qp = MP_QN + row * 512 + (g * 4 + head) * 64 + 8 * h;
#pragma unroll
      for (int ks = 0; ks < 4; ++ks) qf[ks] = *(const bf16x8v*)(qp + 16 * ks); }
    const float* gp = MP_GATE + row * 32 + g * 4 + head;
    float one = 1.f; asm volatile("" : "+v"(one));
    const float gate_c = __builtin_amdgcn_rcpf(one + __expf(-gp[0])), gate_s = __builtin_amdgcn_rcpf(one + __expf(-gp[8])), gate_w = __builtin_amdgcn_rcpf(one + __expf(-gp[16]));
    f32x16 oacc[2];
    {
        const bf16* kc = MP_KC + ccbase; const bf16* vc = MP_VC + ccbase;
        const v4u k0 = *(const v4u*)(kc + tid * 8), k1 = *(const v4u*)(kc + 4096 + tid * 8), v0 = *(const v4u*)(vc + tid * 8), v1 = *(const v4u*)(vc + 4096 + tid * 8);
        LBAR();
        *(LAS v4u*)(L + NM_SLOT + soff) = k0; *(LAS v4u*)(L + NM_SLOT + 8192 + soff) = v0; *(LAS v4u*)(L + NM_SLOT + 16384 + soff) = k1; *(LAS v4u*)(L + NM_SLOT + 24576 + soff) = v1;
        if (tid < 64) SEL[tid] = 0u;
        LBAR();
        f32x16 s0, s1, s2, s3;
        { bf16x8v kfa[8], kfb[8]; k_load(L + NM_SLOT, r, h, kfa); k_load(L + NM_SLOT + 16384, r, h, kfb); SBAR(); qk_mma(kfa, qf, s0, s1); qk_mma(kfb, qf, s2, s3); }
        const int nlim = (t >= 31) ? (((t - 31) >> 4) < 126 ? ((t - 31) >> 4) : 126) : -1;
        float mx, mxv[4] = {-1e20f, -1e20f, -1e20f, -1e20f};
#pragma unroll
        for (int e = 0; e < 16; ++e) { const int cr = (e & 3) + 8 * (e >> 2) + 4 * h;
            s0[e] = (cr <= nlim) ? s0[e] * QK_SCALE : -1e30f; s1[e] = (cr + 32 <= nlim) ? s1[e] * QK_SCALE : -1e30f;
            s2[e] = (cr + 64 <= nlim) ? s2[e] * QK_SCALE : -1e30f; s3[e] = (cr + 96 <= nlim) ? s3[e] * QK_SCALE : -1e30f;
            mxv[e & 3] = fmaxf(fmaxf(mxv[e & 3], fmaxf(s0[e], s1[e])), fmaxf(s2[e], s3[e])); }
        mx = fmaxf(fmaxf(mxv[0], mxv[1]), fmaxf(mxv[2], mxv[3]));
        mx = fmaxf(mx, shx(mx, 32, lane));
        float ls, lsv[4] = {0.f, 0.f, 0.f, 0.f};
#pragma unroll
        for (int e = 0; e < 16; ++e) { s0[e] = __builtin_amdgcn_exp2f(s0[e] - mx); s1[e] = __builtin_amdgcn_exp2f(s1[e] - mx); s2[e] = __builtin_amdgcn_exp2f(s2[e] - mx); s3[e] = __builtin_amdgcn_exp2f(s3[e] - mx);
            lsv[e & 3] += (s0[e] + s1[e]) + (s2[e] + s3[e]); }
        ls = (lsv[0] + lsv[1]) + (lsv[2] + lsv[3]);
        ls += shx(ls, 32, lane);
        const float il = (ls > 0.f) ? __builtin_amdgcn_rcpf(ls) : 0.f;
#pragma unroll
        for (int e = 0; e < 16; ++e) { s0[e] *= il; s1[e] *= il; s2[e] *= il; s3[e] *= il; }
        { LAS float* IMP = (LAS float*)(L + NM_IMP) + (w * 32 + r) * 33; float plprev = 0.f;
#pragma unroll
          for (int x = 0; x < 16; ++x) {
              const f32x16& S = (x < 4) ? s0 : ((x < 8) ? s1 : ((x < 12) ? s2 : s3)); const int g4 = (x & 3) * 4;
              const float own = (S[g4] + S[g4 + 1]) + (S[g4 + 2] + S[g4 + 3]);
              const float pl = shx(S[g4 + 3], 32, lane);
              if (h == 1) IMP[2 * x + 1] = own + pl; else IMP[2 * x] = own + plprev;
              plprev = pl;
          }
        }
        oacc[0] = (f32x16){0.f, 0.f, 0.f, 0.f, 0.f, 0.f, 0.f, 0.f, 0.f, 0.f, 0.f, 0.f, 0.f, 0.f, 0.f, 0.f}; oacc[1] = oacc[0];
        { bf16x8v vfa[8], vfb[8]; v_load(L + NM_SLOT + 8192, lane, vfa); v_load(L + NM_SLOT + 24576, lane, vfb); SBAR(); pv_mma(vfa, s0, s1, oacc); pv_mma(vfb, s2, s3, oacc); }
#pragma unroll
        for (int e = 0; e < 16; ++e) { oacc[0][e] *= gate_c; oacc[1][e] *= gate_c; }
    }
    LBAR();
    { const int i = tid & 63, jg = tid >> 6; const LAS float* I8 = (const LAS float*)(L + NM_IMP); LAS float* IMS = (LAS float*)(L + NM_IMS);
#pragma unroll
      for (int jj = 0; jj < 4; ++jj) { const int j = 4 * jg + jj; const int wq = (i >> 5), rq = i & 31;
          IMS[i * 36 + j] = (I8[((0 + wq) * 32 + rq) * 33 + j] + I8[((2 + wq) * 32 + rq) * 33 + j]) + (I8[((4 + wq) * 32 + rq) * 33 + j] + I8[((6 + wq) * 32 + rq) * 33 + j]); }
      LBAR();
      unsigned bits = 0u;
      if (c + 1 <= 16) { if (jg == 0) bits = (1u << (c + 1)) - 1u; }
      else { if (jg == 0) bits = 1u | (1u << c) | (1u << (c - 1));
          { float iv[32];
#pragma unroll
            for (int q8 = 0; q8 < 8; ++q8) { const f32x4 x = *(const LAS f32x4*)(IMS + i * 36 + 4 * q8); iv[4 * q8] = x.x; iv[4 * q8 + 1] = x.y; iv[4 * q8 + 2] = x.z; iv[4 * q8 + 3] = x.w; }
#pragma unroll
            for (int jj = 0; jj < 4; ++jj) { const int j = 4 * jg + jj; const float vj = IMS[i * 36 + j]; int rank = 0;
#pragma unroll
                for (int i2 = 1; i2 < 30; ++i2) rank += (i2 <= c - 2 && (iv[i2] > vj || (iv[i2] == vj && i2 < j))) ? 1 : 0;
                if (j >= 1 && j <= c - 2 && rank < 13) bits |= 1u << j; } } }
      if (bits) atomicOr((unsigned*)&SEL[i], bits);
      LBAR();
      if (w == 0) { unsigned so = SEL[lane];
#pragma unroll
          for (int o2 = 32; o2; o2 >>= 1) so |= shxu(so, o2, lane);
          if (lane == 0) { int n = 0; for (int j = 0; j <= c; ++j) if ((so >> j) & 1u) ITEM[n++] = j; const int j0 = (c - 8 > 0) ? c - 8 : 0; for (int j = j0; j <= c; ++j) ITEM[n++] = 64 + j; ITEM[n] = -1; ITEM[47] = n; } }
      LBAR();
    }
    const unsigned mysel = SEL[qi]; const int nitem = ITEM[47];
    f32x16 o[2]; float m = -1e20f, lsum = 0.f; int prev_kind = 0;
    o[0] = (f32x16){0.f, 0.f, 0.f, 0.f, 0.f, 0.f, 0.f, 0.f, 0.f, 0.f, 0.f, 0.f, 0.f, 0.f, 0.f, 0.f}; o[1] = o[0];
    const int npair = (nitem + 1) >> 1;
    v4u rk0, rv0, rk1, rv1;
#define NSA_LOAD_PAIR(ip_) do { const int ia_ = ITEM[2 * (ip_)], ib_ = ITEM[2 * (ip_) + 1]; \
        { const bf16* kp = ((ia_ & 64) ? MP_KW : MP_KS) + kvbase + (size_t)(ia_ & 63) * 4096; const bf16* vp = ((ia_ & 64) ? MP_VW : MP_VS) + kvbase + (size_t)(ia_ & 63) * 4096; rk0 = *(const v4u*)(kp + tid * 8); rv0 = *(const v4u*)(vp + tid * 8); } \
        if (ib_ >= 0) { const bf16* kp = ((ib_ & 64) ? MP_KW : MP_KS) + kvbase + (size_t)(ib_ & 63) * 4096; const bf16* vp = ((ib_ & 64) ? MP_VW : MP_VS) + kvbase + (size_t)(ib_ & 63) * 4096; rk1 = *(const v4u*)(kp + tid * 8); rv1 = *(const v4u*)(vp + tid * 8); } } while (0)
#define NSA_WRITE_PAIR(sb_) do { *(LAS v4u*)(L + (sb_) + soff) = rk0; *(LAS v4u*)(L + (sb_) + 8192 + soff) = rv0; *(LAS v4u*)(L + (sb_) + 16384 + soff) = rk1; *(LAS v4u*)(L + (sb_) + 24576 + soff) = rv1; } while (0)
    rk1 = (v4u){0u, 0u, 0u, 0u}; rv1 = rk1;
    NSA_LOAD_PAIR(0);
    NSA_WRITE_PAIR(NM_SLOT + 32768);
    LBAR();
#pragma unroll 1
    for (int ip = 0; ip < npair; ++ip) {
        if (ip + 1 < npair) NSA_LOAD_PAIR(ip + 1);
        const int sbase = NM_SLOT + ((ip + 1) & 1) * 32768;
#pragma unroll 1
        for (int half = 0; half < 2; ++half) {
            const int item = ITEM[2 * ip + half];
            if (item < 0) break;
            const int kind = item >> 6, j = item & 63;
            if (kind != prev_kind) {
                const float tot = lsum + shx(lsum, 32, lane); const float sc = gate_s * __builtin_amdgcn_rcpf(tot);
#pragma unroll
                for (int e = 0; e < 16; ++e) { oacc[0][e] += o[0][e] * sc; oacc[1][e] += o[1][e] * sc; o[0][e] = 0.f; o[1][e] = 0.f; }
                m = -1e20f; lsum = 0.f; prev_kind = kind;
            }
            int klo, khi;
            if (kind == 0) { klo = 0; khi = ((mysel >> j) & 1u) ? ((j < c) ? 63 : qi) : -1; }
            else { klo = t - 511 - 64 * j; khi = t - 64 * j; if (khi > 63) khi = 63; if (klo < 0) klo = 0; }
            const LAS unsigned char* slot = L + sbase + half * 16384;
            if (__any(khi >= klo)) {
                f32x16 p0, p1; bf16x8v vf[8];
                { bf16x8v kf[8]; k_load(slot, r, h, kf); SBAR(); qk_mma(kf, qf, p0, p1); }
                v_load(slot + 8192, lane, vf); SBAR();
                if (!__all(klo == 0 && khi == 63)) {
                    const int a = klo - 4 * h, z = khi - 4 * h;
#pragma unroll
                    for (int e = 0; e < 16; ++e) { const int cr = (e & 3) + 8 * (e >> 2);
                        p0[e] = (cr >= a && cr <= z) ? p0[e] : -1e30f; p1[e] = (cr + 32 >= a && cr + 32 <= z) ? p1[e] : -1e30f; }
                }
                float tm;
                { float ma = fmaxf(p0[0], p1[0]), mb = fmaxf(p0[1], p1[1]), mc2 = fmaxf(p0[2], p1[2]), md = fmaxf(p0[3], p1[3]);
#pragma unroll
                  for (int e = 4; e < 16; e += 4) { ma = fmaxf(ma, fmaxf(p0[e], p1[e])); mb = fmaxf(mb, fmaxf(p0[e + 1], p1[e + 1])); mc2 = fmaxf(mc2, fmaxf(p0[e + 2], p1[e + 2])); md = fmaxf(md, fmaxf(p0[e + 3], p1[e + 3])); }
                  tm = fmaxf(fmaxf(ma, mb), fmaxf(mc2, md)); }
                tm = fmaxf(tm, shx(tm, 32, lane));
                const float mn = fmaxf(m, tm * QK_SCALE);
                if (!__all(mn == m)) { const float corr = __builtin_amdgcn_exp2f(m - mn); lsum *= corr;
#pragma unroll
                    for (int e = 0; e < 16; ++e) { o[0][e] *= corr; o[1][e] *= corr; }
                    m = mn; }
                { float ta = 0.f, tb = 0.f, tc = 0.f, td = 0.f;
#pragma unroll
                  for (int e = 0; e < 16; ++e) { p0[e] = __builtin_amdgcn_exp2f(p0[e] * QK_SCALE - m); p1[e] = __builtin_amdgcn_exp2f(p1[e] * QK_SCALE - m); }
#pragma unroll
                  for (int e = 0; e < 16; e += 4) { ta += p0[e] + p1[e]; tb += p0[e + 1] + p1[e + 1]; tc += p0[e + 2] + p1[e + 2]; td += p0[e + 3] + p1[e + 3]; }
                  lsum += (ta + tb) + (tc + td); }
                SBAR(); pv_mma(vf, p0, p1, o);
            }
        }
        if (ip + 1 < npair) NSA_WRITE_PAIR(NM_SLOT + (ip & 1) * 32768);
        LBAR();
    }
#undef NSA_LOAD_PAIR
#undef NSA_WRITE_PAIR
    { const float tot = lsum + shx(lsum, 32, lane); const float sc = gate_w * __builtin_amdgcn_rcpf(tot);
#pragma unroll
      for (int e = 0; e < 16; ++e) { oacc[0][e] += o[0][e] * sc; oacc[1][e] += o[1][e] * sc; } }
    { bf16* yp = MP_Y + row * DM + (g * 4 + head) * 64 + 4 * h;
#pragma unroll
      for (int db = 0; db < 2; ++db)
#pragma unroll
          for (int g4 = 0; g4 < 4; ++g4) { v2u wv; wv.x = cvtpk(oacc[db][4 * g4], oacc[db][4 * g4 + 1]); wv.y = cvtpk(oacc[db][4 * g4 + 2], oacc[db][4 * g4 + 3]); *(v2u*)(yp + db * 32 + g4 * 8) = wv; } }
}

#define MFMA16(a, b, c) __builtin_amdgcn_mfma_f32_16x16x32_bf16((a), (b), (c), 0, 0, 0)
constexpr size_t WS_QC = 422 * MiB, WS_KC2 = 454 * MiB, WS_END2 = 486 * MiB;
#define MP_QC ((const bf16*)(P.ws + WS_QC))
#define MP_KC2 ((const bf16*)(P.ws + WS_KC2))
__device__ __forceinline__ int img_off(int row, int ch) { return 256 * row + 16 * (ch ^ (((row & 3) << 2) | ((row >> 2) & 3))); }
constexpr int M2_IMG = 0, M2_SC = 98304, M2_DEN = 106496, M2_QN = 107520, M2_N = 107776, M2_SSQ = 108288;

__device__ __forceinline__ void mlstm_conv_pass(unsigned char* ws, const float* conv_w, const float* conv_b, int gthread, int nthreads) {
    for (int idx = gthread; idx < BATCH * 128 * 128; idx += nthreads) {
        const int cc = idx & 127, tg = (idx >> 7) & 127, b = idx >> 14;
        const int isk = cc >> 6, ch0 = (cc & 63) * 8;
        const bf16* src = (const bf16*)(ws + (isk ? WS_MK : WS_MQ)) + (size_t)b * SEQ * 512 + ch0;
        bf16* dst = (bf16*)(ws + (isk ? WS_KC2 : WS_QC)) + ((size_t)(b * 4 + (ch0 >> 7)) * SEQ) * 128 + (ch0 & 127);
        float wt[4][8], bs[8];
#pragma unroll
        for (int j = 0; j < 4; ++j) { const f32x4 a = *(const f32x4*)(conv_w + j * 1024 + isk * 512 + ch0), c2 = *(const f32x4*)(conv_w + j * 1024 + isk * 512 + ch0 + 4);
            wt[j][0] = a.x; wt[j][1] = a.y; wt[j][2] = a.z; wt[j][3] = a.w; wt[j][4] = c2.x; wt[j][5] = c2.y; wt[j][6] = c2.z; wt[j][7] = c2.w; }
        { const f32x4 a = *(const f32x4*)(conv_b + isk * 512 + ch0), c2 = *(const f32x4*)(conv_b + isk * 512 + ch0 + 4); bs[0] = a.x; bs[1] = a.y; bs[2] = a.z; bs[3] = a.w; bs[4] = c2.x; bs[5] = c2.y; bs[6] = c2.z; bs[7] = c2.w; }
        const float osc = isk ? 0.08838834764831845f : 1.f;
        const int t0 = tg * 16;
        float x0[8], x1[8], x2[8];
#pragma unroll
        for (int e = 0; e < 8; ++e) { x0[e] = 0.f; x1[e] = 0.f; x2[e] = 0.f; }
        if (t0 > 0) {
            const v4u a = *(const v4u*)(src + (size_t)(t0 - 3) * 512), c2 = *(const v4u*)(src + (size_t)(t0 - 2) * 512), d2 = *(const v4u*)(src + (size_t)(t0 - 1) * 512);
            x0[0] = bflo(a.x); x0[1] = bfhi(a.x); x0[2] = bflo(a.y); x0[3] = bfhi(a.y); x0[4] = bflo(a.z); x0[5] = bfhi(a.z); x0[6] = bflo(a.w); x0[7] = bfhi(a.w);
            x1[0] = bflo(c2.x); x1[1] = bfhi(c2.x); x1[2] = bflo(c2.y); x1[3] = bfhi(c2.y); x1[4] = bflo(c2.z); x1[5] = bfhi(c2.z); x1[6] = bflo(c2.w); x1[7] = bfhi(c2.w);
            x2[0] = bflo(d2.x); x2[1] = bfhi(d2.x); x2[2] = bflo(d2.y); x2[3] = bfhi(d2.y); x2[4] = bflo(d2.z); x2[5] = bfhi(d2.z); x2[6] = bflo(d2.w); x2[7] = bfhi(d2.w);
        }
#pragma unroll 4
        for (int s = 0; s < 16; ++s) {
            const v4u a = *(const v4u*)(src + (size_t)(t0 + s) * 512);
            const float x3[8] = {bflo(a.x), bfhi(a.x), bflo(a.y), bfhi(a.y), bflo(a.z), bfhi(a.z), bflo(a.w), bfhi(a.w)};
            float o[8];
#pragma unroll
            for (int e = 0; e < 8; ++e) { float v = bs[e] + wt[0][e] * x0[e] + wt[1][e] * x1[e] + wt[2][e] * x2[e] + wt[3][e] * x3[e]; v = v * __builtin_amdgcn_rcpf(1.f + __expf(-v)); o[e] = v * osc; x0[e] = x1[e]; x1[e] = x2[e]; x2[e] = x3[e]; }
            v4u wv; wv.x = pk2(o[0], o[1]); wv.y = pk2(o[2], o[3]); wv.z = pk2(o[4], o[5]); wv.w = pk2(o[6], o[7]);
            *(v4u*)(dst + (size_t)(t0 + s) * 128) = wv;
        }
    }
}

constexpr int M2_A = 112384, M2_PM = 120576, M2_F = 128768, M2_BL = 136960, M2_AMX = 137088, M2_MC = 137216;
__device__ __forceinline__ void mlstm_unit_mfma(LAS unsigned char* L, const MixPtrs& P, int b, int hh, int tid_in) {
    int tid_l = tid_in; asm volatile("" : "+v"(tid_l));
    const int tid = tid_l, lane = tid & 63, w = __builtin_amdgcn_readfirstlane(tid >> 6), l15 = lane & 15, kg = lane >> 4;
    const size_t rb = (size_t)b * SEQ;
    const bf16* QCp = MP_QC + ((size_t)(b * 4 + hh) * SEQ) * 128; const bf16* KCp = MP_KC2 + ((size_t)(b * 4 + hh) * SEQ) * 128;
    const bf16* Vp = MP_MV + rb * 512 + hh * 128; const bf16* Op = MP_MO + rb * 512 + hh * 128 + 16 * w + 4 * kg;
    bf16* Yp = MP_Y + rb * DM + 512 + hh * 128 + 16 * w + 4 * kg;
    LAS float* DEN = (LAS float*)(L + M2_DEN); LAS float* QN = (LAS float*)(L + M2_QN); LAS float* NV = (LAS float*)(L + M2_N); LAS float* SSQ = (LAS float*)(L + M2_SSQ);
    LAS float* SA = (LAS float*)(L + M2_A); LAS float* SPM = (LAS float*)(L + M2_PM); LAS float* SF = (LAS float*)(L + M2_F);
    LAS float* SBL = (LAS float*)(L + M2_BL); LAS float* SAMX = (LAS float*)(L + M2_AMX); LAS float* SMC = (LAS float*)(L + M2_MC);
    float zf = 0.f; asm volatile("" : "+v"(zf));
    f32x4 Cacc[8], nacc = {zf, zf, zf, zf};
#pragma unroll
    for (int i = 0; i < 8; ++i) Cacc[i] = (f32x4){zf, zf, zf, zf};
    const f32x4 gn = *(const f32x4*)(P.mnorm_g + hh * 128 + 16 * w + 4 * kg);
    const int r0s = tid >> 4, c0s = tid & 15, so0 = img_off(r0s, c0s), so1 = img_off(r0s + 32, c0s);
    v4u sq0, sq1, sk0, sk1, sv0, sv1;
    sq0 = *(const v4u*)(QCp + (size_t)r0s * 128 + c0s * 8); sq1 = *(const v4u*)(QCp + (size_t)(r0s + 32) * 128 + c0s * 8);
    sk0 = *(const v4u*)(KCp + (size_t)r0s * 128 + c0s * 8); sk1 = *(const v4u*)(KCp + (size_t)(r0s + 32) * 128 + c0s * 8);
    sv0 = *(const v4u*)(Vp + (size_t)r0s * 512 + c0s * 8);  sv1 = *(const v4u*)(Vp + (size_t)(r0s + 32) * 512 + c0s * 8);
    LBAR();
    { const float ib = P.i_bias[hh], fb = P.f_bias[hh]; const float* Gp = MP_GATE + rb * 32 + hh;
#pragma unroll 1
      for (int cc = w; cc < 32; cc += 8) { const int tk = 64 * cc + lane;
          const float il = Gp[(size_t)tk * 32 + 24] + ib, fx = Gp[(size_t)tk * 32 + 28] + fb; const float fl = fminf(fx, 0.f) - log1pf(__expf(-fabsf(fx)));
          float f = fl;
#pragma unroll
          for (int o = 1; o < 64; o <<= 1) { const float v = shi(f, lane - o); if (lane >= o) f += v; }
          const float a = il - f; float pm = a;
#pragma unroll
          for (int o = 1; o < 64; o <<= 1) { const float v = shi(pm, lane - o); if (lane >= o) pm = fmaxf(pm, v); }
          SA[tk] = a; SPM[tk] = pm; SF[tk] = f; if (lane == 63) { SBL[cc] = f; SAMX[cc] = pm; } } }
    *(LAS v4u*)(L + M2_IMG + so0) = sq0; *(LAS v4u*)(L + M2_IMG + so1) = sq1; *(LAS v4u*)(L + M2_IMG + 16384 + so0) = sk0; *(LAS v4u*)(L + M2_IMG + 16384 + so1) = sk1;
    *(LAS v4u*)(L + M2_IMG + 32768 + so0) = sv0; *(LAS v4u*)(L + M2_IMG + 32768 + so1) = sv1;
    if (tid < 128) NV[tid] = zf;
    LBAR();
    if (tid == 0) { float mcar = zf; for (int cc = 0; cc < 32; ++cc) { SMC[cc] = mcar; mcar = SBL[cc] + fmaxf(mcar, SAMX[cc]); } }
    LBAR();
#pragma unroll 1
    for (int c = 0; c < 32; ++c) {
        int lc = lane; asm volatile("" : "+v"(lc));
        const int l15 = lc & 15, kg = lc >> 4, q4 = l15 >> 2, p4 = l15 & 3;
        const int t0 = c * 64; const LAS unsigned char* Qi = L + M2_IMG + (c & 1) * 49152; const LAS unsigned char* Ki = Qi + 16384; const LAS unsigned char* Vi = Qi + 32768;
        if (c + 1 < 32) { const int tn = t0 + 64;
            sq0 = *(const v4u*)(QCp + (size_t)(tn + r0s) * 128 + c0s * 8); sq1 = *(const v4u*)(QCp + (size_t)(tn + r0s + 32) * 128 + c0s * 8);
            sk0 = *(const v4u*)(KCp + (size_t)(tn + r0s) * 128 + c0s * 8); sk1 = *(const v4u*)(KCp + (size_t)(tn + r0s + 32) * 128 + c0s * 8);
            sv0 = *(const v4u*)(Vp + (size_t)(tn + r0s) * 512 + c0s * 8);  sv1 = *(const v4u*)(Vp + (size_t)(tn + r0s + 32) * 512 + c0s * 8); }
        const float mc = SMC[c], mxa = fmaxf(mc, SAMX[c]); const float cs = __expf(mc - mxa);
        { const int tblk = w >> 1, t = 16 * tblk + l15; const int sb0 = 2 * (w & 1);
          bf16x8v ka[2][4], qb[4];
#pragma unroll
          for (int ks = 0; ks < 4; ++ks) { qb[ks] = *(const LAS bf16x8v*)(Qi + img_off(t, 4 * ks + kg)); ka[0][ks] = *(const LAS bf16x8v*)(Ki + img_off(16 * sb0 + l15, 4 * ks + kg)); ka[1][ks] = *(const LAS bf16x8v*)(Ki + img_off(16 * sb0 + 16 + l15, 4 * ks + kg)); }
          const float Mt = fmaxf(SPM[t0 + t], mc);
          const f32x4 as0 = *(const LAS f32x4*)(SA + t0 + 16 * sb0 + 4 * kg), as1 = *(const LAS f32x4*)(SA + t0 + 16 * sb0 + 16 + 4 * kg);
          const int tq = tid >> 3, dp = tid & 7; const v4u q0 = *(const LAS v4u*)(Qi + img_off(tq, 2 * dp)), q1 = *(const LAS v4u*)(Qi + img_off(tq, 2 * dp + 1));
          const LAS f32x4* np = (const LAS f32x4*)(NV + 16 * dp); const f32x4 n0 = np[0], n1 = np[1], n2 = np[2], n3 = np[3];
          SBAR();
          LAS unsigned char* SC = L + M2_SC;
#pragma unroll
          for (int sb = 0; sb < 2; ++sb) { const int sblk = sb0 + sb; f32x4 acc = {0.f, 0.f, 0.f, 0.f}; float rp = 0.f; v2u wv; wv.x = 0u; wv.y = 0u;
              if (sblk <= tblk) {
#pragma unroll
                  for (int ks = 0; ks < 4; ++ks) acc = MFMA16(ka[sb][ks], qb[ks], acc);
                  const f32x4 as = sb ? as1 : as0; float v[4];
#pragma unroll
                  for (int e = 0; e < 4; ++e) { const float x = acc[e] * __expf(as[e] - Mt); v[e] = (sblk == tblk && 4 * kg + e > l15) ? 0.f : x; }
                  rp = (v[0] + v[1]) + (v[2] + v[3]); wv.x = cvtpk(v[0], v[1]); wv.y = cvtpk(v[2], v[3]);
              }
              rp += shx(rp, 16, lane); rp += shx(rp, 32, lane);
              *(LAS v2u*)(SC + t * 128 + (((2 * sblk + (kg >> 1)) ^ (t & 7)) << 4) + 8 * (kg & 1)) = wv;
              if (kg == 0) DEN[sblk * 64 + t] = rp; }
          { float s = bflo(q0.x) * n0.x + bfhi(q0.x) * n0.y + bflo(q0.y) * n0.z + bfhi(q0.y) * n0.w + bflo(q0.z) * n1.x + bfhi(q0.z) * n1.y + bflo(q0.w) * n1.z + bfhi(q0.w) * n1.w
                    + bflo(q1.x) * n2.x + bfhi(q1.x) * n2.y + bflo(q1.y) * n2.z + bfhi(q1.y) * n2.w + bflo(q1.z) * n3.x + bfhi(q1.z) * n3.y + bflo(q1.w) * n3.z + bfhi(q1.w) * n3.w;
            s += shx(s, 1, lane); s += shx(s, 2, lane); s += shx(s, 4, lane);
            if (dp == 0) QN[tq] = s; } }
        LBAR();
        v2u og[4];
#pragma unroll
        for (int tb = 0; tb < 4; ++tb) og[tb] = *(const v2u*)(Op + (size_t)(t0 + 16 * tb + l15) * 512);
        bf16x8v vf[2]; f32x4 hv[4];
        { float pmt[4], ft[4], dnp[4], qn4[4]; bf16x8v Cfrag[4];
#pragma unroll
          for (int kp = 0; kp < 4; ++kp) { v4u a; a.x = cvtpk(Cacc[2 * kp].x, Cacc[2 * kp].y); a.y = cvtpk(Cacc[2 * kp].z, Cacc[2 * kp].w); a.z = cvtpk(Cacc[2 * kp + 1].x, Cacc[2 * kp + 1].y); a.w = cvtpk(Cacc[2 * kp + 1].z, Cacc[2 * kp + 1].w);
              Cfrag[kp] = __builtin_bit_cast(bf16x8v, a); }
#pragma unroll
          for (int ks = 0; ks < 2; ++ks) { const int r0 = 32 * ks + 8 * kg;
              const s16x4v lo = tr_read(Vi + 256 * (r0 + q4) + 16 * ((2 * w + (p4 >> 1)) ^ ((q4 << 2) | ((r0 >> 2) & 3))) + 8 * (p4 & 1));
              const s16x4v hi = tr_read(Vi + 256 * (r0 + 4 + q4) + 16 * ((2 * w + (p4 >> 1)) ^ ((q4 << 2) | (((r0 + 4) >> 2) & 3))) + 8 * (p4 & 1));
              vf[ks] = __builtin_shufflevector(lo, hi, 0, 1, 2, 3, 4, 5, 6, 7); }
#pragma unroll
          for (int tb = 0; tb < 4; ++tb) { const int t = 16 * tb + l15; pmt[tb] = SPM[t0 + t]; ft[tb] = SF[t0 + t]; dnp[tb] = (DEN[t] + DEN[64 + t]) + (DEN[128 + t] + DEN[192 + t]); qn4[tb] = QN[t]; }
#pragma unroll
          for (int tp = 0; tp < 2; ++tp) {
              bf16x8v sf[2][2]; v2u qlo[2][4], qhi[2][4];
#pragma unroll
              for (int t2 = 0; t2 < 2; ++t2) { const int t = 16 * (2 * tp + t2) + l15; const int swz = ((t & 3) << 2) | ((t >> 2) & 3);
#pragma unroll
                  for (int ks = 0; ks < 2; ++ks) sf[t2][ks] = *(const LAS bf16x8v*)(L + M2_SC + t * 128 + (((4 * ks + kg) ^ (t & 7)) << 4));
#pragma unroll
                  for (int kp = 0; kp < 4; ++kp) { qlo[t2][kp] = *(const LAS v2u*)(Qi + 256 * t + 16 * ((4 * kp + (kg >> 1)) ^ swz) + 8 * (kg & 1)); qhi[t2][kp] = *(const LAS v2u*)(Qi + 256 * t + 16 * ((4 * kp + 2 + (kg >> 1)) ^ swz) + 8 * (kg & 1)); } }
              SBAR();
#pragma unroll
              for (int t2 = 0; t2 < 2; ++t2) { const int tb = 2 * tp + t2; f32x4 an = {0.f, 0.f, 0.f, 0.f}, a2 = {0.f, 0.f, 0.f, 0.f};
#pragma unroll
                  for (int ks = 0; ks < 2; ++ks) an = MFMA16(vf[ks], sf[t2][ks], an);
#pragma unroll
                  for (int kp = 0; kp < 4; ++kp) { v4u qq; qq.x = qlo[t2][kp].x; qq.y = qlo[t2][kp].y; qq.z = qhi[t2][kp].x; qq.w = qhi[t2][kp].y; a2 = MFMA16(Cfrag[kp], __builtin_bit_cast(bf16x8v, qq), a2); }
                  const float Mt = fmaxf(pmt[tb], mc), wp = __expf(mc - Mt), emt = __expf(-ft[tb] - Mt);
                  const float dn = dnp[tb] + wp * qn4[tb];
                  const float idn = __builtin_amdgcn_rcpf(fmaxf(fabsf(dn), emt));
                  hv[tb] = (an + a2 * wp) * idn;
                  float ss = (hv[tb].x * hv[tb].x + hv[tb].y * hv[tb].y) + (hv[tb].z * hv[tb].z + hv[tb].w * hv[tb].w);
                  ss += shx(ss, 16, lane); ss += shx(ss, 32, lane);
                  if (kg == 0) SSQ[((c & 1) * 8 + w) * 64 + 16 * tb + l15] = ss; }
              SBAR();
          } }
        { bf16x8v vpf[2], wkf[2];
          f32x4 aw[2][2];
#pragma unroll
          for (int ks = 0; ks < 2; ++ks) { aw[ks][0] = *(const LAS f32x4*)(SA + t0 + 32 * ks + 8 * kg); aw[ks][1] = *(const LAS f32x4*)(SA + t0 + 32 * ks + 8 * kg + 4); }
#pragma unroll
          for (int ks = 0; ks < 2; ++ks) { float wkv[8]; unsigned vp[4], wp2[4]; const v4u vu = __builtin_bit_cast(v4u, vf[ks]); const unsigned vw[4] = {vu.x, vu.y, vu.z, vu.w};
#pragma unroll
              for (int j = 0; j < 8; ++j) wkv[j] = __expf(aw[ks][j >> 2][j & 3] - mxa);
#pragma unroll
              for (int j2 = 0; j2 < 4; ++j2) { vp[j2] = cvtpk(bflo(vw[j2]) * wkv[2 * j2], bfhi(vw[j2]) * wkv[2 * j2 + 1]); wp2[j2] = cvtpk(wkv[2 * j2], wkv[2 * j2 + 1]); }
              v4u a; a.x = vp[0]; a.y = vp[1]; a.z = vp[2]; a.w = vp[3]; vpf[ks] = __builtin_bit_cast(bf16x8v, a);
              v4u b2; b2.x = wp2[0]; b2.y = wp2[1]; b2.z = wp2[2]; b2.w = wp2[3]; wkf[ks] = __builtin_bit_cast(bf16x8v, b2); }
          nacc = nacc * cs;
#pragma unroll
          for (int ih = 0; ih < 2; ++ih) {
              bf16x8v kf[4][2];
#pragma unroll
              for (int i4 = 0; i4 < 4; ++i4)
#pragma unroll
                  for (int ks = 0; ks < 2; ++ks) { const int i = 4 * ih + i4, r0 = 32 * ks + 8 * kg;
                      const s16x4v lo = tr_read(Ki + 256 * (r0 + q4) + 16 * ((2 * i + (p4 >> 1)) ^ ((q4 << 2) | ((r0 >> 2) & 3))) + 8 * (p4 & 1));
                      const s16x4v hi = tr_read(Ki + 256 * (r0 + 4 + q4) + 16 * ((2 * i + (p4 >> 1)) ^ ((q4 << 2) | (((r0 + 4) >> 2) & 3))) + 8 * (p4 & 1));
                      kf[i4][ks] = __builtin_shufflevector(lo, hi, 0, 1, 2, 3, 4, 5, 6, 7); }
              SBAR();
#pragma unroll
              for (int i4 = 0; i4 < 4; ++i4) { const int i = 4 * ih + i4; Cacc[i] = Cacc[i] * cs;
#pragma unroll
                  for (int ks = 0; ks < 2; ++ks) { Cacc[i] = MFMA16(kf[i4][ks], vpf[ks], Cacc[i]); if (i == w) nacc = MFMA16(kf[i4][ks], wkf[ks], nacc); } }
              SBAR();
          }
          if (l15 == 0) *(LAS f32x4*)(NV + 16 * w + 4 * kg) = nacc;
 }
        if (c + 1 < 32) { LAS unsigned char* Nx = L + M2_IMG + ((c + 1) & 1) * 49152;
            *(LAS v4u*)(Nx + so0) = sq0; *(LAS v4u*)(Nx + so1) = sq1; *(LAS v4u*)(Nx + 16384 + so0) = sk0; *(LAS v4u*)(Nx + 16384 + so1) = sk1; *(LAS v4u*)(Nx + 32768 + so0) = sv0; *(LAS v4u*)(Nx + 32768 + so1) = sv1; }
        LBAR();
#pragma unroll
        for (int tb = 0; tb < 4; ++tb) { const int t = 16 * tb + l15; const LAS float* sp = SSQ + (c & 1) * 512 + t;
            const float tot = ((sp[0] + sp[64]) + (sp[128] + sp[192])) + ((sp[256] + sp[320]) + (sp[384] + sp[448]));
            const float rn = __frsqrt_rn(tot * (1.f / 128.f) + EPS);
            const float y0 = hv[tb].x * rn * gn.x * sigmoidf_(bflo(og[tb].x)), y1 = hv[tb].y * rn * gn.y * sigmoidf_(bfhi(og[tb].x)), y2 = hv[tb].z * rn * gn.z * sigmoidf_(bflo(og[tb].y)), y3 = hv[tb].w * rn * gn.w * sigmoidf_(bfhi(og[tb].y));
            v2u wv; wv.x = cvtpk(y0, y1); wv.y = cvtpk(y2, y3);
            *(v2u*)(Yp + (size_t)(t0 + t) * DM) = wv; }
    }
    LBAR();
}

#ifndef MK_MULTI
#define MK_MULTI 0
#endif
constexpr int PH_PER_LAYER = 12, N_PHASES = 1 + DEPTH * PH_PER_LAYER;
struct Args { const float* in[16]; float* out; unsigned char* ws; int ph_lo, ph_hi; };
static_assert(sizeof(Args) == 16 * 8 + 8 + 8 + 8, "Args has no padding");

__global__ void __launch_bounds__(NWAVES * 64, 2) fwd_kernel(Args args) {
    extern __shared__ __attribute__((aligned(16))) unsigned char lds_raw[];
    LAS unsigned char* L = (LAS unsigned char*)lds_raw;
    const int G0 = gridDim.x, blk0 = blockIdx.x;
    const int wave0 = __builtin_amdgcn_readfirstlane((int)threadIdx.x >> 6);
#define PH_IDS() PH_WS(); int wave = wave0; asm volatile("" : "+s"(wave)); const int lane = fresh_lane(), tid = wave * 64 + lane, gw = blk * NWAVES + wave; (void)gw
#define PH_WS() unsigned char* ws = args.ws; asm volatile("" : "+s"(ws)); int blk = blk0, G = G0; asm volatile("" : "+s"(blk), "+s"(G)); const int NGW = G * NWAVES; (void)NGW; bf16* X16 = (bf16*)(ws + WS_X16); float* R2 = (float*)(ws + WS_TAB + TAB_R2); bf16* U = (bf16*)(ws + WS_U); bf16* HB = (bf16*)(ws + WS_HB); bf16* HD = (bf16*)(ws + WS_HD); \
    unsigned char* wl = ws + WS_W; const float* ng = args.in[1] + (size_t)l_ * 6 * DM; (void)X16; (void)R2; (void)U; (void)HB; (void)HD; (void)wl; (void)ng
    unsigned char* ws0 = args.ws;
    volatile LAS unsigned* MISC = (volatile LAS unsigned*)(L + MISC_OFF);
    { const int tid_e = wave0 * 64 + fresh_lane(); if (tid_e < 16) MISC[tid_e] = 0u; }
    __syncthreads();
    XcdBarrier bar; bar.bar = (unsigned*)(ws0 + WS_CTL) + CW_BAR; bar.x = 0; bar.st = nullptr;
    if (!MK_MULTI) bar = xcd_barrier_post((unsigned*)(ws0 + WS_CTL) + CW_BAR, MISC + 8, wave0 * 64 + fresh_lane() == 0);
    const int lo = args.ph_lo, hi = args.ph_hi;
#define IN(k) (lo <= (k) && (k) < hi)
#define SEAM(k) do { if (IN(k) && IN((k) + 1)) xcd_barrier(bar, wave0 * 64 + fresh_lane() == 0); } while (0)

    if (IN(0)) {
        const int l_ = 0; PH_IDS();
        const float* x_in = args.in[0]; float* cosT = (float*)(ws + WS_TAB + TAB_COS); float* sinT = (float*)(ws + WS_TAB + TAB_SIN); float* b1T = (float*)(ws + WS_TAB + TAB_B1);
#define CONVERT_WEIGHTS(lw) do { LAS float* scr = (LAS float*)(L + wave * 16384); const float* ngw = args.in[1] + (size_t)(lw) * 6 * DM; \
        constexpr int I_GU = 16 * 176, I_DN = 44 * 32, I_IN = 16 * 112, I_OUT = 16 * 32, I_CMP = 16 * 16, I_LAYER = 2 * I_GU + 2 * I_DN + I_IN + I_OUT + I_CMP; \
        for (int it = gw; it < I_LAYER; it += NGW) { int r = it; unsigned char* wlw = ws + WS_W; \
            if (r < I_GU) { SrcGU s{args.in[2] + (size_t)(lw) * DM * NGU, ngw + 0 * DM}; transpose_item(s, DM, (bf16*)(wlw + WO_GU1), scr, r / 176, r % 176, lane); continue; } r -= I_GU; \
            if (r < I_DN) { SrcPlain s{args.in[3] + (size_t)(lw) * FF * DM, DM}; transpose_item(s, FF, (bf16*)(wlw + WO_DN1), scr, r / 32, r % 32, lane); continue; } r -= I_DN; \
            if (r < I_GU) { SrcGU s{args.in[4] + (size_t)(lw) * DM * NGU, ngw + 4 * DM}; transpose_item(s, DM, (bf16*)(wlw + WO_GU2), scr, r / 176, r % 176, lane); continue; } r -= I_GU; \
            if (r < I_DN) { SrcPlain s{args.in[5] + (size_t)(lw) * FF * DM, DM}; transpose_item(s, FF, (bf16*)(wlw + WO_DN2), scr, r / 32, r % 32, lane); continue; } r -= I_DN; \
            if (r < I_IN) { SrcIN s{args.in[6] + (size_t)(lw) * DM * INCOLS, ngw + 2 * DM}; transpose_item(s, DM, (bf16*)(wlw + WO_IN), scr, r / 112, r % 112, lane); continue; } r -= I_IN; \
            if (r < I_OUT) { SrcPlain s{args.in[7] + (size_t)(lw) * DM * DM, DM}; transpose_item(s, DM, (bf16*)(wlw + WO_OUT), scr, r / 32, r % 32, lane); continue; } r -= I_OUT; \
            { SrcCMP s{args.in[9] + (size_t)(lw) * 2 * 2048 * 128}; transpose_item(s, DM, (bf16*)(wlw + WO_CMP), scr, r / 16, r % 16, lane); } } } while (0)
        CONVERT_WEIGHTS(0);
        for (int i = blk * 512 + tid; i < SEQ * 8; i += G * 512) { const int pos = i >> 3, k = i & 7;
            const double inv = pow(500000.0, -(double)k / 8.0), ang = (double)pos * inv; cosT[i] = (float)cos(ang); sinT[i] = (float)sin(ang); }
        { LAS float* part = (LAS float*)(L + 131072);
          for (int ob = blk; ob < DEPTH * 2 * 128 / 2; ob += G) { const int o = 2 * ob + (wave >> 2), qr = wave & 3; const int lk = o >> 7, c = o & 127;
              const float* pe = args.in[8] + (size_t)lk * 2048; const float* w1 = args.in[9] + (size_t)lk * 2048 * 128;
              float s = 0.f; for (int r = qr * 512 + lane; r < qr * 512 + 512; r += 64) s += pe[r] * w1[(size_t)r * 128 + c];
              s = wave_sum(s, lane); if (lane == 0) part[wave] = s;
              __syncthreads();
              if (lane == 0 && qr == 0) b1T[o] = (part[wave] + part[wave + 1]) + (part[wave + 2] + part[wave + 3]);
              __syncthreads(); } }
        thin_phase<0>(nullptr, x_in, X16, nullptr, R2, nullptr, 0.f, gw, NGW, lane);
    }
    SEAM(0);

#pragma unroll 1
    for (int l = 0; l < DEPTH; ++l) {
        const int pb = 1 + l * PH_PER_LAYER, l_ = l;
        if (IN(pb + 0)) { PH_IDS(); pg8::Gemm g{X16, (const bf16*)(wl + WO_GU1), MTOK, NGU, DM}; pg8::StaticOrder S; S.init(MTOK, NGU, G, blk); EpiSwiglu E{HB, R2};
            pg8::gemm_phase<EpiSwiglu, pg8::StaticOrder, true, true>(L, g, S, E, tid); }
        SEAM(pb + 0);
        if (IN(pb + 1)) { PH_IDS(); pg8::Gemm g{HB, (const bf16*)(wl + WO_DN1), MTOK, DM, FF}; pg8::StaticOrder S; S.init(MTOK, DM, G, blk); pg8::EpiBf16<0> E{HD, DM, nullptr, 0, 0, 1.f};
            pg8::gemm_phase<pg8::EpiBf16<0>, pg8::StaticOrder, true, true>(L, g, S, E, tid); }
        SEAM(pb + 1);
        if (IN(pb + 2)) { PH_IDS(); thin_phase<1>(HD, nullptr, X16, nullptr, R2, ng + 1 * DM, 0.5f, gw, NGW, lane); }
        SEAM(pb + 2);
        if (IN(pb + 3)) { PH_IDS(); pg8::Gemm g{X16, (const bf16*)(wl + WO_IN), MTOK, NINP, DM}; pg8::StaticOrder S; S.init(MTOK, NINP, G, blk);
            EpiInProj E{ws};
            pg8::gemm_phase<EpiInProj, pg8::StaticOrder, true, true>(L, g, S, E, tid); }
        SEAM(pb + 3);
        if (IN(pb + 4)) { PH_IDS(); pg8::Gemm g{(const bf16*)(ws + WS_KCR), (const bf16*)(wl + WO_CMP), 8192, 512, DM}; CmpOrder S{blk, G}; EpiPQ E{(float*)(ws + WS_PQ)};
            pg8::gemm_phase<EpiPQ, CmpOrder, false, true>(L, g, S, E, tid);
            { const int nb = (G > 32) ? 32 : 0; if (blk >= nb) { mlstm_conv_pass(ws, args.in[11] + (size_t)l_ * 4 * 1024, args.in[12] + (size_t)l_ * 1024, (blk - nb) * 512 + tid, (G - nb) * 512); } } }
        SEAM(pb + 4);
        if (IN(pb + 5)) {
            PH_IDS();
            const float* b1T = (const float*)(ws + WS_TAB + TAB_B1); const float* PQ = (const float*)(ws + WS_PQ); bf16* CC = (bf16*)(ws + WS_CC);
            LAS float* w2s = (LAS float*)L; LAS float* hs = (LAS float*)(L + 32768) + wave * 4 * 128;
            for (int item = blk; item < 256; item += G) {
                const int kv = item >> 7, r0 = (item & 127) * 32 + wave * 4;
                const float* w2 = args.in[10] + (size_t)(l_ * 2 + kv) * 128 * 64; const float* b1 = b1T + (l_ * 2 + kv) * 128;
                __syncthreads();
                for (int i = tid; i < 128 * 64 / 4; i += 512) ((LAS f32x4*)w2s)[i] = ((const f32x4*)w2)[i];
#pragma unroll
                for (int rr = 0; rr < 4; ++rr) { const int r = kv * 4096 + r0 + rr, n = (r0 + rr) & 127;
#pragma unroll
                    for (int q2 = 0; q2 < 2; ++q2) { const int c = lane + 64 * q2; float hval = 0.f;
                        if (n != 127) { const float v = PQ[(size_t)r * 256 + c] + PQ[(size_t)(r + 1) * 256 + 128 + c] + b1[c];
                            const float u3 = 0.7978845608028654f * (v + 0.044715f * v * v * v); hval = 0.5f * v * (1.f + tanhf(u3)); }
                        hs[rr * 128 + c] = hval; } }
                __syncthreads();
                float o0 = 0.f, o1 = 0.f, o2 = 0.f, o3 = 0.f;
#pragma unroll 8
                for (int c = 0; c < 128; ++c) { const float wv = w2s[c * 64 + lane]; o0 += hs[c] * wv; o1 += hs[128 + c] * wv; o2 += hs[256 + c] * wv; o3 += hs[384 + c] * wv; }
                bf16* cp = CC + ((size_t)kv * 4096 + r0) * 64 + lane;
                cp[0] = (bf16)f2bf(o0); cp[64] = (bf16)f2bf(o1); cp[128] = (bf16)f2bf(o2); cp[192] = (bf16)f2bf(o3);
            }
        }
        SEAM(pb + 5);
        if (IN(pb + 6)) {
            PH_IDS();
            MixPtrs P{ws, args.in[11] + (size_t)l * 4 * 1024, args.in[12] + (size_t)l * 1024, args.in[13] + l * 4, args.in[14] + l * 4, args.in[15] + l * 512};
#ifndef PROBE_MIX_REP
#define PROBE_MIX_REP 1
#endif
            for (int rep = 0; rep < PROBE_MIX_REP; ++rep) {
            for (int u = blk; u < 64; u += G) mlstm_unit_mfma(L, P, u >> 2, u & 3, tid);
            { unsigned* qbase = (unsigned*)(ws + WS_CTL) + CW_QUEUE + 1024 * l_; volatile LAS unsigned* QW = (volatile LAS unsigned*)(L + MISC_OFF);
              const unsigned q0 = xb_xcc_id() & 7u;
#pragma unroll 1
              for (unsigned qq = 0; qq < 8u; ++qq) { unsigned* qctr = qbase + 64 * ((q0 + qq) & 7u); const int bg0 = 4 * (int)((q0 + qq) & 7u);
                  __syncthreads();
                  if (tid == 0) QW[0] = __hip_atomic_fetch_add(qctr, 1u, __ATOMIC_RELAXED, __HIP_MEMORY_SCOPE_AGENT);
                  __syncthreads();
                  unsigned u = QW[0];
                  while (u < 128u) { unsigned nxt = 0u; if (tid == 0) nxt = __hip_atomic_fetch_add(qctr, 1u, __ATOMIC_RELAXED, __HIP_MEMORY_SCOPE_AGENT);
                      const int c = 31 - (int)(u & 31u), bg = bg0 + (int)(u >> 5); nsa_unit_mfma(L, P, bg >> 1, bg & 1, c, tid);
                      __syncthreads(); if (tid == 0) QW[0] = nxt; __syncthreads(); u = QW[0]; } } }
            }
        }
        SEAM(pb + 6);
        if (IN(pb + 7)) { PH_IDS(); pg8::Gemm g{U, (const bf16*)(wl + WO_OUT), MTOK, DM, DM}; pg8::StaticOrder S; S.init(MTOK, DM, G, blk); pg8::EpiBf16<0> E{HD, DM, nullptr, 0, 0, 1.f};
            pg8::gemm_phase<pg8::EpiBf16<0>, pg8::StaticOrder, true, true>(L, g, S, E, tid); }
        SEAM(pb + 7);
        if (IN(pb + 8)) { PH_IDS(); thin_phase<1>(HD, nullptr, X16, nullptr, R2, ng + 3 * DM, 1.0f, gw, NGW, lane); }
        SEAM(pb + 8);
        if (IN(pb + 9)) { PH_IDS(); pg8::Gemm g{X16, (const bf16*)(wl + WO_GU2), MTOK, NGU, DM}; pg8::StaticOrder S; S.init(MTOK, NGU, G, blk); EpiSwiglu E{HB, R2};
            pg8::gemm_phase<EpiSwiglu, pg8::StaticOrder, true, true>(L, g, S, E, tid); }
        SEAM(pb + 9);
        if (IN(pb + 10)) { PH_IDS(); pg8::Gemm g{HB, (const bf16*)(wl + WO_DN2), MTOK, DM, FF}; pg8::StaticOrder S; S.init(MTOK, DM, G, blk); pg8::EpiBf16<0> E{HD, DM, nullptr, 0, 0, 1.f};
            pg8::gemm_phase<pg8::EpiBf16<0>, pg8::StaticOrder, true, true>(L, g, S, E, tid); }
        SEAM(pb + 10);
        if (IN(pb + 11)) { PH_IDS(); if (l + 1 < DEPTH) { thin_phase<1>(HD, nullptr, X16, nullptr, R2, ng + 5 * DM, 0.5f, gw, NGW, lane); CONVERT_WEIGHTS(l_ + 1); }
                           else thin_phase<2>(HD, nullptr, X16, args.out, nullptr, ng + 5 * DM, 0.5f, gw, NGW, lane); }
        if (l + 1 < DEPTH) SEAM(pb + 11);
    }
#undef IN
#undef SEAM
#undef CONVERT_WEIGHTS
#undef PH_IDS
#undef PH_WS
}

extern "C" void kernel_launch(void* const* d_in, const int* in_sizes, int n_in, void* d_out, int out_size, void* d_ws, size_t ws_size, hipStream_t stream) {
    static int grid = 0;
    if (grid == 0) {
        if (n_in != 16 || in_sizes[0] != MTOK * DM || out_size != MTOK * DM || ws_size < WS_END2) { fprintf(stderr, "kernel_launch: unexpected problem (n_in %d, ws %zu)\n", n_in, ws_size); grid = -1; return; }
        int dev = 0, cus = 0, per_cu = 0;
        if (hipGetDevice(&dev) != hipSuccess || hipDeviceGetAttribute(&cus, hipDeviceAttributeMultiprocessorCount, dev) != hipSuccess) { grid = -1; return; }
        if (hipFuncSetAttribute((const void*)fwd_kernel, hipFuncAttributeMaxDynamicSharedMemorySize, LDS_BYTES) != hipSuccess) { grid = -1; return; }
        if (hipOccupancyMaxActiveBlocksPerMultiprocessor(&per_cu, (const void*)fwd_kernel, NWAVES * 64, LDS_BYTES) != hipSuccess || per_cu < 1) { fprintf(stderr, "kernel_launch: occupancy query says %d\n", per_cu); }
        (void)hipGetLastError();
        grid = cus;
    }
    if (grid < 0) return;
    (void)hipMemsetAsync((char*)d_ws + WS_CTL, 0, CTL_ZERO_BYTES, stream);
    Args a{};
    for (int i = 0; i < 16; ++i) a.in[i] = (const float*)d_in[i];
    a.out = (float*)d_out; a.ws = (unsigned char*)d_ws;
#if MK_MULTI
    for (int p = 0; p < N_PHASES; ++p) { a.ph_lo = p; a.ph_hi = p + 1; hipLaunchKernelGGL(fwd_kernel, dim3(grid), dim3(NWAVES * 64), LDS_BYTES, stream, a); }
#else
    a.ph_lo = 0; a.ph_hi = N_PHASES; hipLaunchKernelGGL(fwd_kernel, dim3(grid), dim3(NWAVES * 64), LDS_BYTES, stream, a);
#endif
}
```

```cpp
#include <hip/hip_runtime.h>
#include <cstdio>
#include <cstdint>
namespace pg8 {
#define PG8_LAS __attribute__((address_space(3)))
typedef unsigned short bf16_t;
typedef short bf16x8 __attribute__((ext_vector_type(8)));
typedef float f32x4 __attribute__((ext_vector_type(4)));
typedef unsigned u32x4 __attribute__((ext_vector_type(4)));
constexpr int BM = 256, BK = 64, HALF = 128, HTB = HALF * BK * 2  , STAGE_BYTES = 8 * HTB, NXCD = 8, WGM = 4;

__host__ __device__ __forceinline__ int lds_byte(int r, int c) { const int st = (r >> 4) * 2 + (c >> 5), rr = r & 15, cc = c & 31, ob = rr * 64 + cc * 2; return st * 1024 + (ob ^ (((ob >> 9) & 1) << 5)); }
__host__ __device__ __forceinline__ void stage_rc(int b, int& R, int& C) { const int st = b / 1024, sb = b % 1024, swz = sb ^ (((sb >> 9) & 1) << 5); R = (st >> 1) * 16 + swz / 64; C = (st & 1) * 32 + (swz % 64) / 2; }
__host__ __device__ __forceinline__ int perm32(int rho) { const int n = rho >> 4, i = rho & 15; return 8 * (i >> 2) + 4 * n + (i & 3); }

struct Unit { int pm, pn; };
struct Gemm { const bf16_t* A; const bf16_t* Bt; int M, N, K; };

struct StaticOrder {
    int nM, nN, nwg, G, c;
    __host__ __device__ void init(int M, int N, int G_, int c_) { nM = M / BM; nN = N / BM; nwg = nM * nN; G = G_; c = c_; }
    __host__ __device__ bool next(int i, Unit& u) const {
        const long L = (long)i * G + c; if (L >= nwg) return false;
        int wgid = (int)L; { const int q = nwg / NXCD, r = nwg % NXCD, xcd = wgid % NXCD, off = wgid / NXCD; wgid = (xcd < r ? xcd * (q + 1) : r * (q + 1) + (xcd - r) * q) + off; }
        const int nig = WGM * nN, gid = wgid / nig, fm = gid * WGM, gsz = (nM - fm) < WGM ? (nM - fm) : WGM;
        u.pm = fm + ((wgid % nig) % gsz); u.pn = (wgid % nig) / gsz; return true;
    }
    __device__ __forceinline__ void a_ready(const Unit&) const {}
    __device__ __forceinline__ void done(const Unit&) const {}
};

__device__ __forceinline__ unsigned cvt_pk_bf16(float lo, float hi) { unsigned r; asm volatile("v_cvt_pk_bf16_f32 %0, %1, %2" : "=v"(r) : "v"(lo), "v"(hi)); return r; }
typedef float f32x2 __attribute__((ext_vector_type(2)));
__device__ __forceinline__ f32x2 gelu_pk(f32x2 v) {
    const f32x2 av = __builtin_elementwise_abs(v), d = av * 0.2316418882f + 1.0f;
    f32x2 t; t.x = __builtin_amdgcn_rcpf(d.x); t.y = __builtin_amdgcn_rcpf(d.y);
    f32x2 q = t * 0.5307027145f + (-0.7265760135f); q = q * t + 0.7107068705f; q = q * t + (-0.142248368f); q = q * t + 0.127414796f; q = q * t;
    const f32x2 s = (v * v) * (-0.72134752044f);
    f32x2 e; e.x = __builtin_amdgcn_exp2f(s.x); e.y = __builtin_amdgcn_exp2f(s.y);
    const f32x2 m = v * (q * e), r = v - m;
    f32x2 o; o.x = v.x < 0.f ? m.x : r.x; o.y = v.y < 0.f ? m.y : r.y; return o;
}

template <int ACT  > struct EpiBf16 {
    static constexpr bool PERM = true, AFTER_DRAIN = false; static_assert(ACT == 0 || ACT == 1, "EpiBf16: ACT is 0 (none) or 1 (gelu_pk)");
    bf16_t* O; int ldc; const float* bias; int split_cols; size_t split_stride; float scale0;
    __device__ __forceinline__ void operator()(const f32x4 (&acc)[2][2][4][2], const Unit& u, int wr, int wc, int fr, int fq) const {
        const int row0 = u.pm * BM + wr * 64 + fr; int colt = u.pn * BM; bf16_t* base = O;
        float sc = 1.f; if (split_cols) { const int t = colt / split_cols; base += (size_t)t * split_stride; colt -= t * split_cols; if (t == 0) sc = scale0; }
        const int col0 = colt + wc * 32 + 8 * fq, bcol0 = u.pn * BM + wc * 32 + 8 * fq;
        f32x4 bv[2][2];
#pragma unroll
        for (int bj = 0; bj < 2; ++bj)
#pragma unroll
            for (int n = 0; n < 2; ++n) bv[bj][n] = bias ? *(const f32x4*)(bias + bcol0 + bj * HALF + 4 * n) : (f32x4){0.f, 0.f, 0.f, 0.f};
#pragma unroll
        for (int ai = 0; ai < 2; ++ai)
#pragma unroll
            for (int m = 0; m < 4; ++m) { bf16_t* rowp = base + (size_t)(row0 + ai * HALF + m * 16) * ldc + col0;
#pragma unroll
                for (int bj = 0; bj < 2; ++bj) { f32x4 v0 = acc[ai][bj][m][0] + bv[bj][0], v1 = acc[ai][bj][m][1] + bv[bj][1];
                    if (ACT == 1) { f32x2 a = gelu_pk((f32x2){v0[0], v0[1]}), b = gelu_pk((f32x2){v0[2], v0[3]}), c = gelu_pk((f32x2){v1[0], v1[1]}), d = gelu_pk((f32x2){v1[2], v1[3]});
                        v0 = (f32x4){a.x, a.y, b.x, b.y}; v1 = (f32x4){c.x, c.y, d.x, d.y}; }
                    v0 = v0 * sc; v1 = v1 * sc; u32x4 w; w.x = cvt_pk_bf16(v0[0], v0[1]); w.y = cvt_pk_bf16(v0[2], v0[3]); w.z = cvt_pk_bf16(v1[0], v1[1]); w.w = cvt_pk_bf16(v1[2], v1[3]);
                    *(u32x4*)(rowp + bj * HALF) = w; } }
    }
};
template <class Epi, class Sched, bool ALIGN_EPI = false, bool SP2 = false>
__device__ __forceinline__ void gemm_phase(PG8_LAS unsigned char* lds, const Gemm g, const Sched& S, const Epi& E, int tid_in) {
    int tid_l = tid_in; asm volatile("" : "+v"(tid_l));
    const int tid = tid_l, wid = __builtin_amdgcn_readfirstlane(tid >> 6), lane = tid & 63, wr = wid >> 2, wc = wid & 3, fr = lane & 15, fq = lane >> 4;
    const int K = g.K, nt = K / BK;
    unsigned voffA[2], voffB[2];
#pragma unroll
    for (int i = 0; i < 2; ++i) { int R, C; stage_rc(tid * 16 + i * 8192, R, C); const int Rb = Epi::PERM ? ((R & ~31) + perm32(R & 31)) : R;
        voffA[i] = (unsigned)(R * K + C) * 2u; voffB[i] = (unsigned)(Rb * K + C) * 2u; }
    const size_t kstep = (size_t)(BK * 2);
    const size_t hstep = (size_t)HALF * K * 2;
    const size_t tstep = 2 * hstep;
    const unsigned ldsw = (unsigned)wid * 1024u;
    const int aoff = lds_byte(wr * 64 + fr, fq * 8), boff = lds_byte(wc * 32 + fr, fq * 8);
#define PG8_SA(b, h) (((b) * 2 + (h)) * HTB)
#define PG8_SB(b, h) ((4 + (b) * 2 + (h)) * HTB)
#define PG8_STAGE(bufoff, gbase, voff) do { _Pragma("unroll") for (int _i = 0; _i < 2; ++_i) \
        __builtin_amdgcn_global_load_lds((const unsigned*)((const char*)(gbase) + (voff)[_i]), (PG8_LAS unsigned*)(lds + (bufoff) + ldsw + _i * 8192), 16, 0, 0); } while (0)
#define PG8_LDA(dst, b, h) do { _Pragma("unroll") for (int m = 0; m < 4; ++m) _Pragma("unroll") for (int k = 0; k < 2; ++k) dst[m][k] = *(const PG8_LAS bf16x8*)(lds + PG8_SA(b, h) + aoff + m * 2048 + k * 1024); } while (0)
#define PG8_LDB(dst, b, h) do { _Pragma("unroll") for (int n = 0; n < 2; ++n) _Pragma("unroll") for (int k = 0; k < 2; ++k) dst[n][k] = *(const PG8_LAS bf16x8*)(lds + PG8_SB(b, h) + boff + n * 2048 + k * 1024); } while (0)
#define PG8_MMA(ai, bj, At, Bt) do { __builtin_amdgcn_s_setprio(1); _Pragma("unroll") for (int m = 0; m < 4; ++m) _Pragma("unroll") for (int n = 0; n < 2; ++n) _Pragma("unroll") for (int k = 0; k < 2; ++k) \
        acc[ai][bj][m][n] = __builtin_amdgcn_mfma_f32_16x16x32_bf16(Bt[n][k], At[m][k], acc[ai][bj][m][n], 0, 0, 0); __builtin_amdgcn_s_setprio(0); } while (0)
#define PG8_WAIT_V(n) asm volatile("s_waitcnt vmcnt(" #n ")" ::: "memory")
#define PG8_WAIT_L(n) asm volatile("s_waitcnt lgkmcnt(" #n ")" ::: "memory")
#define PG8_BAR __builtin_amdgcn_s_barrier()
#define PG8_SCHED __builtin_amdgcn_sched_barrier(0)
    Unit cur, nxt; int ui = 0;
    if (!S.next(0, cur)) return;
    f32x4 acc[2][2][4][2];
#pragma unroll
    for (int a = 0; a < 2; ++a)
#pragma unroll
        for (int b = 0; b < 2; ++b)
#pragma unroll
            for (int m = 0; m < 4; ++m)
#pragma unroll
                for (int n = 0; n < 2; ++n) acc[a][b][m][n] = (f32x4){0.f, 0.f, 0.f, 0.f};
    bf16x8 At[4][2], B0[2][2], B1[2][2];
    const char* cA = (const char*)g.A + (size_t)cur.pm * tstep; const char* cB = (const char*)g.Bt + (size_t)cur.pn * tstep;
    S.a_ready(cur);
    if constexpr (SP2) {
        PG8_STAGE(PG8_SB(0, 0), cB, voffB); PG8_STAGE(PG8_SB(0, 1), cB + hstep, voffB); PG8_STAGE(PG8_SA(0, 0), cA, voffA); PG8_STAGE(PG8_SA(0, 1), cA + hstep, voffA);
        if (wr == 1) PG8_BAR;
        PG8_WAIT_V(2); PG8_BAR;
        PG8_STAGE(PG8_SB(1, 0), cB + kstep, voffB); PG8_STAGE(PG8_SA(1, 0), cA + kstep, voffA); PG8_STAGE(PG8_SB(1, 1), cB + hstep + kstep, voffB);
        PG8_WAIT_V(6); PG8_BAR;
    } else {
        PG8_STAGE(PG8_SB(0, 0), cB, voffB); PG8_STAGE(PG8_SA(0, 0), cA, voffA); PG8_STAGE(PG8_SB(0, 1), cB + hstep, voffB); PG8_STAGE(PG8_SA(0, 1), cA + hstep, voffA);
        if (wr == 1) PG8_BAR;
        PG8_WAIT_V(4); PG8_BAR;
        PG8_STAGE(PG8_SB(1, 0), cB + kstep, voffB); PG8_STAGE(PG8_SA(1, 0), cA + kstep, voffA); PG8_STAGE(PG8_SB(1, 1), cB + hstep + kstep, voffB);
        PG8_WAIT_V(6); PG8_BAR;
    }
    for (;;) {
        const bool has_next = S.next(ui + 1, nxt);
        const char* nA = has_next ? (const char*)g.A + (size_t)nxt.pm * tstep : cA; const char* nB = has_next ? (const char*)g.Bt + (size_t)nxt.pn * tstep : cB;
        for (int t = 0; t < nt; t += 2) {
            const bool last = (t == nt - 2);
            const char* a1 = cA + (size_t)(t + 1) * kstep;
            const char* a2 = last ? nA : cA + (size_t)(t + 2) * kstep; const char* b2 = last ? nB : cB + (size_t)(t + 2) * kstep;
            const char* a3 = a2 + kstep; const char* b3 = b2 + kstep;
            if (last && has_next) S.a_ready(nxt);
            if constexpr (SP2) {
            PG8_LDB(B0, 0, 0); PG8_LDB(B1, 0, 1); PG8_SCHED; PG8_LDA(At, 0, 0); PG8_STAGE(PG8_SA(1, 1), a1 + hstep, voffA);
            PG8_WAIT_V(8); PG8_WAIT_L(0); PG8_BAR; PG8_MMA(0, 0, At, B0); PG8_MMA(0, 1, At, B1); PG8_BAR; PG8_SCHED;
            PG8_LDA(At, 0, 1); PG8_STAGE(PG8_SB(0, 0), b2, voffB); PG8_STAGE(PG8_SB(0, 1), b2 + hstep, voffB); PG8_STAGE(PG8_SA(0, 0), a2, voffA);
            PG8_WAIT_V(8); PG8_WAIT_L(0); PG8_BAR; PG8_MMA(1, 0, At, B0); PG8_MMA(1, 1, At, B1); PG8_BAR; PG8_SCHED;
            PG8_LDB(B0, 1, 0); PG8_LDB(B1, 1, 1); PG8_SCHED; PG8_LDA(At, 1, 0); PG8_STAGE(PG8_SA(0, 1), a2 + hstep, voffA);
            PG8_WAIT_V(8); PG8_WAIT_L(0); PG8_BAR; PG8_MMA(0, 0, At, B0); PG8_MMA(0, 1, At, B1); PG8_BAR; PG8_SCHED;
            PG8_LDA(At, 1, 1); PG8_STAGE(PG8_SB(1, 0), b3, voffB); PG8_STAGE(PG8_SB(1, 1), b3 + hstep, voffB); PG8_STAGE(PG8_SA(1, 0), a3, voffA);
            PG8_WAIT_V(8); PG8_WAIT_L(0); PG8_BAR; PG8_MMA(1, 0, At, B0); PG8_MMA(1, 1, At, B1); PG8_BAR; PG8_SCHED;
            } else {
            PG8_LDB(B0, 0, 0); PG8_SCHED; PG8_LDA(At, 0, 0); PG8_STAGE(PG8_SA(1, 1), a1 + hstep, voffA);
            PG8_WAIT_L(8); PG8_BAR; PG8_WAIT_L(0); PG8_MMA(0, 0, At, B0); PG8_BAR; PG8_SCHED;
            PG8_LDB(B1, 0, 1); PG8_STAGE(PG8_SB(0, 0), b2, voffB);
            PG8_BAR; PG8_WAIT_L(0); PG8_MMA(0, 1, At, B1); PG8_BAR;
            PG8_LDA(At, 0, 1); PG8_STAGE(PG8_SA(0, 0), a2, voffA);
            PG8_BAR; PG8_WAIT_L(0); PG8_MMA(1, 0, At, B0); PG8_BAR; PG8_SCHED;
            PG8_STAGE(PG8_SB(0, 1), b2 + hstep, voffB);
            PG8_WAIT_V(6); PG8_BAR; PG8_MMA(1, 1, At, B1); PG8_BAR;
            PG8_LDB(B0, 1, 0); PG8_SCHED; PG8_LDA(At, 1, 0); PG8_STAGE(PG8_SA(0, 1), a2 + hstep, voffA);
            PG8_WAIT_L(8); PG8_BAR; PG8_WAIT_L(0); PG8_MMA(0, 0, At, B0); PG8_BAR; PG8_SCHED;
            PG8_LDB(B1, 1, 1); PG8_STAGE(PG8_SB(1, 0), b3, voffB);
            PG8_BAR; PG8_WAIT_L(0); PG8_MMA(0, 1, At, B1); PG8_BAR;
            PG8_LDA(At, 1, 1); PG8_STAGE(PG8_SA(1, 0), a3, voffA);
            PG8_BAR; PG8_WAIT_L(0); PG8_MMA(1, 0, At, B0); PG8_BAR; PG8_SCHED;
            PG8_STAGE(PG8_SB(1, 1), b3 + hstep, voffB);
            PG8_WAIT_V(6); PG8_BAR; PG8_MMA(1, 1, At, B1); PG8_BAR;
            }
        }
        if constexpr (ALIGN_EPI) { if (wr == 0) PG8_BAR; }
        if constexpr (!Epi::AFTER_DRAIN) { E(acc, cur, wr, wc, fr, fq); S.done(cur); }
        if (!has_next) break;
#pragma unroll
        for (int a = 0; a < 2; ++a)
#pragma unroll
            for (int b = 0; b < 2; ++b)
#pragma unroll
                for (int m = 0; m < 4; ++m)
#pragma unroll
                    for (int n = 0; n < 2; ++n) acc[a][b][m][n] = (f32x4){0.f, 0.f, 0.f, 0.f};
        cur = nxt; cA = nA; cB = nB; ++ui;
        if constexpr (ALIGN_EPI) { if (wr == 1) PG8_BAR; }
    }
    PG8_WAIT_V(0);
    if constexpr (!ALIGN_EPI) { if (wr == 0) PG8_BAR; }
    PG8_BAR;
    if constexpr (Epi::AFTER_DRAIN) { E.fused(acc, cur, wr, wc, fr, fq, lds, wid, lane); S.done(cur); }
#undef PG8_SA
#undef PG8_SB
#undef PG8_STAGE
#undef PG8_LDA
#undef PG8_LDB
#undef PG8_MMA
#undef PG8_WAIT_V
#undef PG8_WAIT_L
#undef PG8_BAR
#undef PG8_SCHED
}
}

#define LAS __attribute__((address_space(3)))
#define XB_TMO      128
#define XB_XCNT(j)  (256  + 64 * (j))
#define XB_XSUB(j)  (1280 + 64 * (j))
#define XB_XGEN(j)  (2304 + 64 * (j))
#define XB_TOP      3328
#define XB_TOPGEN   3392
#define XCD_BAR_WORDS 3456
#define XB_SPIN_CAP (1u << 18)

__device__ __forceinline__ unsigned xb_ld(unsigned* p)              { return __hip_atomic_load(p, __ATOMIC_RELAXED, __HIP_MEMORY_SCOPE_AGENT); }
__device__ __forceinline__ unsigned xb_add(unsigned* p, unsigned v) { return __hip_atomic_fetch_add(p, v, __ATOMIC_RELAXED, __HIP_MEMORY_SCOPE_AGENT); }
__device__ __forceinline__ unsigned xb_xcc_id() { return (unsigned)__builtin_amdgcn_s_getreg((3 << 11) | 20) & 0xFu; }
#define XB_SPIN(cond, bar) do { unsigned _sp = 0; while (cond) { __builtin_amdgcn_s_sleep(1); \
    if ((++_sp & 255u) == 0u) { if (xb_ld(&(bar)[XB_TMO])) break; if (_sp > XB_SPIN_CAP) { atomicAdd(&(bar)[XB_TMO], 1u); break; } } } } while (0)

struct XcdBarrier {
    unsigned* bar; unsigned x;
    volatile LAS unsigned* st;
};

__device__ __forceinline__ XcdBarrier xcd_barrier_post(unsigned* bar, volatile LAS unsigned* st, bool leader) {
    XcdBarrier b; b.bar = bar; b.x = xb_xcc_id(); b.st = st;
    if (leader) (void)xb_add(&bar[XB_XCNT(b.x)], 1u);
    return b;
}
__device__ __forceinline__ void xcd_barrier_complete(unsigned* bar, unsigned x, unsigned& nloc, unsigned& nx) {
    const unsigned G = gridDim.x * gridDim.y * gridDim.z;
    unsigned sum, cnt, mine, sp = 0u;
    for (;;) {
        sum = 0u; cnt = 0u; mine = 0u;
#pragma unroll
        for (unsigned j = 0; j < 16; ++j) { const unsigned c = xb_ld(&bar[XB_XCNT(j)]); sum += c; cnt += (c > 0u) ? 1u : 0u; mine = (j == x) ? c : mine; }
        if (sum == G) break;
        __builtin_amdgcn_s_sleep(1);
        if ((++sp & 255u) == 0u) { if (xb_ld(&bar[XB_TMO])) break; if (sp > XB_SPIN_CAP) { atomicAdd(&bar[XB_TMO], 1u); break; } }
    }
    nloc = mine > 0u ? mine : 1u; nx = cnt > 0u ? cnt : 1u;
}

__device__ __forceinline__ void xcd_barrier(const XcdBarrier& b, bool leader) {
    asm volatile("s_waitcnt vmcnt(0)" ::: "memory");
    __syncthreads();
    if (leader) {
        unsigned* bar = b.bar;
        __builtin_amdgcn_s_waitcnt(0);
        unsigned nloc = b.st[0], nx = b.st[1];
        if (nloc == 0u) { xcd_barrier_complete(bar, b.x, nloc, nx); b.st[0] = nloc; b.st[1] = nx; }
        const unsigned old = xb_add(&bar[XB_XSUB(b.x)], 1u);
        const unsigned gen = old / nloc;
        if (old + 1u == (gen + 1u) * nloc) {
            __builtin_amdgcn_fence(__ATOMIC_RELEASE, "agent");
            asm volatile("s_waitcnt vmcnt(0)" ::: "memory");
            const unsigned og = xb_add(&bar[XB_TOP], 1u);
            const unsigned tg = og / nx;
            if (og + 1u == (tg + 1u) * nx) xb_add(&bar[XB_TOPGEN], 1u);
            else XB_SPIN(xb_ld(&bar[XB_TOPGEN]) == tg, bar);
            __builtin_amdgcn_fence(__ATOMIC_ACQUIRE, "agent");
            xb_add(&bar[XB_XGEN(b.x)], 1u);
            asm volatile("s_waitcnt vmcnt(0)" ::: "memory");
        } else {
            XB_SPIN(xb_ld(&bar[XB_XGEN(b.x)]) == gen, bar);
            __builtin_amdgcn_fence(__ATOMIC_ACQUIRE, "agent");
            asm volatile("s_waitcnt vmcnt(0)" ::: "memory");
        }
    }
    __syncthreads();
}

constexpr int BATCH = 16, SEQ = 2048, DM = 1024, MTOK = BATCH * SEQ, FF = 2816, NGU = 2 * FF, NINP = 3584, INCOLS = 3360, DEPTH = 2;
constexpr int NWAVES = 8;
constexpr float EPS = 1e-6f;
typedef unsigned short bf16;
typedef unsigned v4u __attribute__((ext_vector_type(4)));
typedef unsigned v2u __attribute__((ext_vector_type(2)));
typedef float f32x4 __attribute__((ext_vector_type(4)));
#define LDS_WAIT() asm volatile("s_waitcnt lgkmcnt(0)" ::: "memory")

constexpr size_t MiB = 1u << 20;
constexpr size_t WS_CTL = 0, CTL_ZERO_BYTES = MiB;
constexpr size_t WS_TAB = 1 * MiB;
constexpr size_t TAB_COS = 0, TAB_SIN = 65536, TAB_B1 = 131072, TAB_R2 = 262144;
constexpr size_t WS_W = 2 * MiB;
constexpr size_t WO_GU1 = 0, WO_DN1 = 11 * MiB, WO_GU2 = 16 * MiB + MiB / 2, WO_DN2 = 27 * MiB + MiB / 2, WO_IN = 33 * MiB, WO_OUT = 40 * MiB, WO_CMP = 42 * MiB;
constexpr size_t WS_X16 = 45 * MiB;
constexpr size_t WS_U = 109 * MiB;
constexpr size_t WS_HB = 173 * MiB;
constexpr size_t WS_HD = 349 * MiB;
constexpr size_t WS_PQ = 413 * MiB;
constexpr size_t WS_CC = 421 * MiB;
constexpr size_t WS_END = 422 * MiB;
constexpr size_t WS_QN = 173 * MiB, WS_KCR = 205 * MiB, WS_VCR = 213 * MiB, WS_KS = 221 * MiB, WS_VS = 229 * MiB, WS_KW = 237 * MiB, WS_VW = 245 * MiB;
constexpr size_t WS_MQ = 253 * MiB, WS_MK = 285 * MiB, WS_MV = 317 * MiB, WS_MO = 349 * MiB, WS_GATE = 381 * MiB;
static_assert(WS_GATE + 4 * MiB <= WS_PQ, "in-projection outputs end below PQ");
constexpr int CW_BAR = 4096, CW_QUEUE = 16384;
constexpr int PH_BYTES = 143360, MISC_OFF = PH_BYTES, LDS_BYTES = 147456;

__device__ __forceinline__ unsigned f2bf(float f) { unsigned u = __builtin_bit_cast(unsigned, f); return (u + 0x7fffu + ((u >> 16) & 1u)) >> 16; }
__device__ __forceinline__ unsigned pk2(float lo, float hi) { return f2bf(lo) | (f2bf(hi) << 16); }
typedef float f32x2v_ __attribute__((ext_vector_type(2))); typedef __bf16 bf16x2v_ __attribute__((ext_vector_type(2)));
__device__ __forceinline__ unsigned cvtpk(float lo, float hi) { f32x2v_ v = {lo, hi}; bf16x2v_ b = __builtin_convertvector(v, bf16x2v_); return __builtin_bit_cast(unsigned, b); }
__device__ __forceinline__ float bflo(unsigned u) { return __builtin_bit_cast(float, u << 16); }
__device__ __forceinline__ float bfhi(unsigned u) { return __builtin_bit_cast(float, u & 0xffff0000u); }
__device__ __forceinline__ float bf2f(bf16 b) { return __builtin_bit_cast(float, (unsigned)b << 16); }
__device__ __forceinline__ float sigmoidf_(float x) { return __builtin_amdgcn_rcpf(1.f + __expf(-x)); }
__device__ __forceinline__ int fresh_lane() { unsigned z = 0u; asm volatile("" : "+v"(z)); return (int)__builtin_amdgcn_mbcnt_hi(~0u, __builtin_amdgcn_mbcnt_lo(~0u, z)); }
__device__ __forceinline__ float shx(float v, int mask, int lane) { return __builtin_bit_cast(float, __builtin_amdgcn_ds_bpermute((lane ^ mask) << 2, __builtin_bit_cast(int, v))); }
__device__ __forceinline__ unsigned shxu(unsigned v, int mask, int lane) { return (unsigned)__builtin_amdgcn_ds_bpermute((lane ^ mask) << 2, (int)v); }
__device__ __forceinline__ float shi(float v, int src) { return __builtin_bit_cast(float, __builtin_amdgcn_ds_bpermute(src << 2, __builtin_bit_cast(int, v))); }
__device__ __forceinline__ float wave_sum(float v, int lane) {
    (void)lane;
    v += __builtin_bit_cast(float, __builtin_amdgcn_update_dpp(0, __builtin_bit_cast(int, v), 0xB1, 0xF, 0xF, false));
    v += __builtin_bit_cast(float, __builtin_amdgcn_update_dpp(0, __builtin_bit_cast(int, v), 0x4E, 0xF, 0xF, false));
    v += __builtin_bit_cast(float, __builtin_amdgcn_update_dpp(0, __builtin_bit_cast(int, v), 0x124, 0xF, 0xF, false));
    v += __builtin_bit_cast(float, __builtin_amdgcn_update_dpp(0, __builtin_bit_cast(int, v), 0x128, 0xF, 0xF, false));
    const int iv = __builtin_bit_cast(int, v);
    const float a = __builtin_bit_cast(float, __builtin_amdgcn_readlane(iv, 0)), b = __builtin_bit_cast(float, __builtin_amdgcn_readlane(iv, 16));
    const float c = __builtin_bit_cast(float, __builtin_amdgcn_readlane(iv, 32)), d = __builtin_bit_cast(float, __builtin_amdgcn_readlane(iv, 48));
    return (a + b) + (c + d);
}

struct SrcGU { const float* W; const float* g; __device__ __forceinline__ float operator()(int k, int nd) const { const int pn = nd >> 8, r = nd & 255; const int col = (r < 128) ? (pn * 128 + r) : (FF + pn * 128 + r - 128); return W[(size_t)k * NGU + col] * g[k]; } };
struct SrcPlain { const float* W; int N; __device__ __forceinline__ float operator()(int k, int nd) const { return W[(size_t)k * N + nd]; } };
struct SrcIN { const float* W; const float* g; __device__ __forceinline__ float operator()(int k, int nd) const {
    const int col = nd < 1280 ? nd : (nd < 3328 ? nd + 24 : (nd < 3352 ? nd - 3328 + 1280 : (nd < 3360 ? nd : -1)));
    return col < 0 ? 0.f : W[(size_t)k * INCOLS + col] * g[k]; } };
struct SrcCMP { const float* W1; __device__ __forceinline__ float operator()(int k, int nd) const { const int kv = nd >> 8, r = nd & 255;
    return r < 128 ? W1[((size_t)kv * 2048 + k) * 128 + r] : W1[((size_t)kv * 2048 + 1024 + k) * 128 + r - 128]; } };

template <class SrcF>
__device__ __forceinline__ void transpose_item(const SrcF& src, int K, bf16* WT, LAS float* scr, int kb, int nb, int lane) {
    const int k0 = 64 * kb, n0 = 32 * nb;
#pragma unroll 8
    for (int i = 0; i < 32; ++i) { const int kk = 2 * i + (lane >> 5); scr[kk * 33 + (lane & 31)] = src(k0 + kk, n0 + (lane & 31)); }
    LDS_WAIT(); asm volatile("" ::: "memory");
    const int c = lane & 7;
#pragma unroll
    for (int j = 0; j < 4; ++j) { const int n = (lane >> 3) + 8 * j; const LAS float* s = scr + (8 * c) * 33 + n;
        v4u o; o.x = pk2(s[0 * 33], s[1 * 33]); o.y = pk2(s[2 * 33], s[3 * 33]); o.z = pk2(s[4 * 33], s[5 * 33]); o.w = pk2(s[6 * 33], s[7 * 33]);
        *(v4u*)(WT + (size_t)(n0 + n) * K + k0 + 8 * c) = o; }
    LDS_WAIT(); asm volatile("" ::: "memory");
}

template <int MODE>
__device__ __forceinline__ void thin_phase(const bf16* HD, const float* xin_f32, bf16* X16, float* out_f32, float* R2, const float* gpost, float cc, int gw, int NGW, int lane) {
    f32x4 gp[4];
#pragma unroll
    for (int j = 0; j < 4; ++j) gp[j] = (MODE != 0) ? *(const f32x4*)(gpost + 4 * lane + 256 * j) : (f32x4){0.f, 0.f, 0.f, 0.f};
    f32x4 xf[4]; v2u xn[4], hn[4];
    if (gw < MTOK) {
#pragma unroll
        for (int j = 0; j < 4; ++j) { if (MODE == 0) xf[j] = *(const f32x4*)(xin_f32 + (size_t)gw * DM + 4 * lane + 256 * j);
            else { xn[j] = *(const v2u*)(X16 + (size_t)gw * DM + 4 * lane + 256 * j); hn[j] = *(const v2u*)(HD + (size_t)gw * DM + 4 * lane + 256 * j); } }
    }
    for (int m = gw; m < MTOK; m += NGW) {
        f32x4 x[4]; v2u hw[4];
#pragma unroll
        for (int j = 0; j < 4; ++j) { if (MODE == 0) x[j] = xf[j]; else { x[j] = (f32x4){bflo(xn[j].x), bfhi(xn[j].x), bflo(xn[j].y), bfhi(xn[j].y)}; hw[j] = hn[j]; } }
        const int m2 = m + NGW;
        if (m2 < MTOK) {
#pragma unroll
            for (int j = 0; j < 4; ++j) { if (MODE == 0) xf[j] = *(const f32x4*)(xin_f32 + (size_t)m2 * DM + 4 * lane + 256 * j);
                else { xn[j] = *(const v2u*)(X16 + (size_t)m2 * DM + 4 * lane + 256 * j); hn[j] = *(const v2u*)(HD + (size_t)m2 * DM + 4 * lane + 256 * j); } }
        }
        if (MODE != 0) {
            f32x4 h[4]; float ss = 0.f;
#pragma unroll
            for (int j = 0; j < 4; ++j) { h[j] = (f32x4){bflo(hw[j].x), bfhi(hw[j].x), bflo(hw[j].y), bfhi(hw[j].y)}; ss += (h[j].x * h[j].x + h[j].y * h[j].y) + (h[j].z * h[j].z + h[j].w * h[j].w); }
            const float r = cc * __frsqrt_rn(wave_sum(ss, lane) * (1.f / DM) + EPS);
#pragma unroll
            for (int j = 0; j < 4; ++j) x[j] = x[j] + (h[j] * r) * gp[j];
        }
        if (MODE == 2) {
#pragma unroll
            for (int j = 0; j < 4; ++j) *(f32x4*)(out_f32 + (size_t)m * DM + 4 * lane + 256 * j) = x[j];
        } else {
            float s2 = 0.f;
#pragma unroll
            for (int j = 0; j < 4; ++j) { s2 += (x[j].x * x[j].x + x[j].y * x[j].y) + (x[j].z * x[j].z + x[j].w * x[j].w);
                v2u w; w.x = cvtpk(x[j].x, x[j].y); w.y = cvtpk(x[j].z, x[j].w); *(v2u*)(X16 + (size_t)m * DM + 4 * lane + 256 * j) = w; }
            const float r2 = __frsqrt_rn(wave_sum(s2, lane) * (1.f / DM) + EPS);
            if (lane == 0) R2[m] = r2;
        }
    }
}

struct EpiSwiglu {
    static constexpr bool PERM = true, AFTER_DRAIN = false;
    bf16* H; const float* R2;
    __device__ __forceinline__ void operator()(const pg8::f32x4 (&acc)[2][2][4][2], const pg8::Unit& u, int wr, int wc, int fr, int fq) const {
#pragma unroll
        for (int ai = 0; ai < 2; ++ai)
#pragma unroll
            for (int m = 0; m < 4; ++m) {
                const int row = u.pm * 256 + ai * 128 + wr * 64 + m * 16 + fr; const float rs = R2[row];
                float o[8], tg[8], tu[8], ex[8];
#pragma unroll
                for (int n = 0; n < 2; ++n)
#pragma unroll
                    for (int e = 0; e < 4; ++e) { tg[n * 4 + e] = acc[ai][0][m][n][e] * rs; tu[n * 4 + e] = acc[ai][1][m][n][e] * rs; }
#pragma unroll
                for (int e = 0; e < 8; ++e) ex[e] = __builtin_amdgcn_exp2f(tg[e] * -1.4426950408889634f);
#pragma unroll
                for (int e = 0; e < 8; ++e) { ex[e] = __builtin_amdgcn_rcpf(1.f + ex[e]); tu[e] = tg[e] * tu[e]; }
#pragma unroll
                for (int e = 0; e < 8; ++e) o[e] = tu[e] * ex[e];
                v4u w; w.x = pg8::cvt_pk_bf16(o[0], o[1]); w.y = pg8::cvt_pk_bf16(o[2], o[3]); w.z = pg8::cvt_pk_bf16(o[4], o[5]); w.w = pg8::cvt_pk_bf16(o[6], o[7]);
                *(v4u*)(H + (size_t)row * FF + u.pn * 128 + wc * 32 + fq * 8) = w;
            }
    }
};
struct EpiPQ {
    static constexpr bool PERM = true, AFTER_DRAIN = false;
    float* O;
    __device__ __forceinline__ void operator()(const pg8::f32x4 (&acc)[2][2][4][2], const pg8::Unit& u, int wr, int wc, int fr, int fq) const {
#pragma unroll
        for (int ai = 0; ai < 2; ++ai)
#pragma unroll
            for (int m = 0; m < 4; ++m) {
                const int row = u.pm * 256 + ai * 128 + wr * 64 + m * 16 + fr;
#pragma unroll
                for (int bj = 0; bj < 2; ++bj) { float* p = O + (size_t)row * 256 + bj * 128 + wc * 32 + fq * 8;
                    *(pg8::f32x4*)p = acc[ai][bj][m][0]; *(pg8::f32x4*)(p + 4) = acc[ai][bj][m][1]; }
            }
    }
};
struct CmpOrder {
    int c, G;
    __device__ __forceinline__ bool next(int i, pg8::Unit& u) const { const int idx = i * G + c; if (idx >= 32) return false; u.pm = idx; u.pn = idx >> 4; return true; }
    __device__ __forceinline__ void a_ready(const pg8::Unit&) const {}
    __device__ __forceinline__ void done(const pg8::Unit&) const {}
};
struct EpiInProj {
    static constexpr bool PERM = true, AFTER_DRAIN = false;
    unsigned char* ws;
    __device__ __forceinline__ void operator()(const pg8::f32x4 (&acc)[2][2][4][2], const pg8::Unit& u, int wr, int wc, int fr, int fq) const {
        const int pn = u.pn;
        const float* cosT = (const float*)(ws + WS_TAB + TAB_COS); const float* sinT = (const float*)(ws + WS_TAB + TAB_SIN);
        const bool ropet = (pn < 2) || (pn == 3) || (pn == 4);
        const bool ropew = ropet && ((wc & 1) == 0);
#pragma unroll
        for (int ai = 0; ai < 2; ++ai)
#pragma unroll
            for (int m = 0; m < 4; ++m) {
                const int row = u.pm * 256 + ai * 128 + wr * 64 + m * 16 + fr;
                const int b = row >> 11, t = row & 2047; const float rs = ((const float*)(ws + WS_TAB + TAB_R2))[row];
                f32x4 c0, c1, s0, s1;
                if (ropew) { c0 = *(const f32x4*)(cosT + t * 8); c1 = *(const f32x4*)(cosT + t * 8 + 4); s0 = *(const f32x4*)(sinT + t * 8); s1 = *(const f32x4*)(sinT + t * 8 + 4); }
#pragma unroll
                for (int bj = 0; bj < 2; ++bj) {
                    f32x4 v0 = acc[ai][bj][m][0] * rs, v1 = acc[ai][bj][m][1] * rs;
                    const int cl = bj * 128 + wc * 32 + fq * 8;
                    if (ropew && (pn < 2 || bj == 0)) {
                        f32x4 p0, p1; const int ln = fq * 16 + fr;
                        p0.x = shx(v0.x, 16, ln); p0.y = shx(v0.y, 16, ln); p0.z = shx(v0.z, 16, ln); p0.w = shx(v0.w, 16, ln);
                        p1.x = shx(v1.x, 16, ln); p1.y = shx(v1.y, 16, ln); p1.z = shx(v1.z, 16, ln); p1.w = shx(v1.w, 16, ln);
                        const float sg = (fq == 0) ? -1.f : 1.f;
                        if (fq < 2) { v0 = v0 * c0 + (p0 * s0) * sg; v1 = v1 * c1 + (p1 * s1) * sg; }
                    }
                    if (pn == 13) { if (cl < 32) { float* p = (float*)(ws + WS_GATE) + (size_t)row * 32 + cl; *(f32x4*)p = v0; *(f32x4*)(p + 4) = v1; } }
                    else {
                        size_t off;
                        if (pn < 2) off = WS_QN + ((size_t)row * 512 + pn * 256 + cl) * 2;
                        else if (pn < 5) { const int g = wc >> 1, d = (wc & 1) * 32 + fq * 8; off = WS_KCR + (size_t)((pn - 2) * 2 + bj) * (8 * MiB) + (((size_t)(b * 2 + g) * SEQ + t) * 64 + d) * 2; }
                        else { const int q = pn - 5; off = WS_MQ + (size_t)(q >> 1) * (32 * MiB) + ((size_t)row * 512 + (q & 1) * 256 + cl) * 2; }
                        v4u w; w.x = pg8::cvt_pk_bf16(v0.x, v0.y); w.y = pg8::cvt_pk_bf16(v0.z, v0.w); w.z = pg8::cvt_pk_bf16(v1.x, v1.y); w.w = pg8::cvt_pk_bf16(v1.z, v1.w);
                        *(v4u*)(ws + off) = w;
                    }
                }
            }
    }
};
static_assert(WS_VCR == WS_KCR + 8 * MiB && WS_KS == WS_KCR + 16 * MiB && WS_VS == WS_KCR + 24 * MiB && WS_KW == WS_KCR + 32 * MiB && WS_VW == WS_KCR + 40 * MiB, "kv buffers are 8 MiB apart in (pn, bj) order");
static_assert(WS_MK == WS_MQ + 32 * MiB && WS_MV == WS_MQ + 64 * MiB && WS_MO == WS_MQ + 96 * MiB, "mLSTM buffers are 32 MiB apart");

struct MixPtrs { unsigned char* ws; const float *conv_w, *conv_b, *i_bias, *f_bias, *mnorm_g; };
#define MP_QN ((const bf16*)(P.ws + WS_QN))
#define MP_KS ((const bf16*)(P.ws + WS_KS))
#define MP_VS ((const bf16*)(P.ws + WS_VS))
#define MP_KW ((const bf16*)(P.ws + WS_KW))
#define MP_VW ((const bf16*)(P.ws + WS_VW))
#define MP_KC ((const bf16*)(P.ws + WS_CC))
#define MP_VC ((const bf16*)(P.ws + WS_CC) + (size_t)4096 * 64)
#define MP_MQ ((const bf16*)(P.ws + WS_MQ))
#define MP_MK ((const bf16*)(P.ws + WS_MK))
#define MP_MV ((const bf16*)(P.ws + WS_MV))
#define MP_MO ((const bf16*)(P.ws + WS_MO))
#define MP_GATE ((const float*)(P.ws + WS_GATE))
#define MP_Y ((bf16*)(P.ws + WS_U))


typedef float f32x16 __attribute__((ext_vector_type(16)));
typedef short bf16x8v __attribute__((ext_vector_type(8)));
typedef short s16x4v __attribute__((ext_vector_type(4)));
typedef float f32x2v __attribute__((ext_vector_type(2)));
typedef __bf16 bf16x2v __attribute__((ext_vector_type(2)));
#define MFMA32(a, b, c) __builtin_amdgcn_mfma_f32_32x32x16_bf16((a), (b), (c), 0, 0, 0)
__device__ __forceinline__ s16x4v tr_read(const LAS unsigned char* p) { return __builtin_bit_cast(s16x4v, __builtin_amdgcn_ds_read_tr16_b64_v4i16((LAS s16x4v*)p)); }
__device__ __forceinline__ int tile_off(int key, int ch8) { return (ch8 >> 2) * 4096 + key * 64 + (((ch8 & 3) ^ ((key >> 2) & 3)) << 4); }
constexpr int NM_SLOT = 0, NM_IMP = 65536, NM_IMS = 99328, NM_SEL = 108544, NM_ITEM = 108864;
constexpr float QK_SCALE = 0.125f * 1.4426950408889634f;

#define SBAR() __builtin_amdgcn_sched_barrier(0)
__device__ __forceinline__ void xor32_pair(float v, float& lo, float& hi) { float a = v, b = v; asm volatile("s_nop 1\n\tv_permlane32_swap_b32 %0, %1" : "+v"(a), "+v"(b)); lo = a; hi = b; }
__device__ __forceinline__ float xor32_max(float v) { float lo, hi; xor32_pair(v, lo, hi); float r; asm("v_max_f32 %0, %1, %2" : "=v"(r) : "v"(lo), "v"(hi)); return r; }
__device__ __forceinline__ float xor32_sum(float v) { float lo, hi; xor32_pair(v, lo, hi); return lo + hi; }
__device__ __forceinline__ float max2f(float a, float b) { float r; asm("v_max_f32 %0, %1, %2" : "=v"(r) : "v"(a), "v"(b)); return r; }
__device__ __forceinline__ float max3f(float a, float b, float c) { float r; asm("v_max3_f32 %0, %1, %2, %3" : "=v"(r) : "v"(a), "v"(b), "v"(c)); return r; }
#define LBAR() asm volatile("s_waitcnt lgkmcnt(0)\n\ts_barrier" ::: "memory")
__device__ __forceinline__ void k_load(const LAS unsigned char* Ks, int r, int h, bf16x8v (&kf)[8]) {
    const int sw = (r >> 2) & 3;
#pragma unroll
    for (int ks = 0; ks < 4; ++ks) { const int off = (ks >> 1) * 4096 + r * 64 + (((((ks & 1) << 1) + h) ^ sw) << 4);
        kf[2 * ks] = *(const LAS bf16x8v*)(Ks + off); kf[2 * ks + 1] = *(const LAS bf16x8v*)(Ks + off + 2048); }
}
__device__ __forceinline__ void qk_mma(const bf16x8v (&kf)[8], const bf16x8v (&qf)[4], f32x16& p0, f32x16& p1) {
    const f32x16 z = {0.f, 0.f, 0.f, 0.f, 0.f, 0.f, 0.f, 0.f, 0.f, 0.f, 0.f, 0.f, 0.f, 0.f, 0.f, 0.f};
#pragma unroll
    for (int ks = 0; ks < 4; ++ks) { p0 = MFMA32(kf[2 * ks], qf[ks], ks ? p0 : z); p1 = MFMA32(kf[2 * ks + 1], qf[ks], ks ? p1 : z); }
}
__device__ __forceinline__ void v_load(const LAS unsigned char* Vs, int lane, bf16x8v (&vf)[8]) {
    const int h = lane >> 5, i16 = lane & 15, q = i16 >> 2, p = i16 & 3, gi = (lane >> 4) & 1;
    const int cidx = 2 * gi + (p >> 1), e8 = (p & 1) << 3;
    const int offlo = q * 64 + ((cidx ^ h) << 4) + e8 + h * 256, offhi = q * 64 + ((cidx ^ (h | 2)) << 4) + e8 + h * 256 + 512;
#pragma unroll
    for (int kb = 0; kb < 2; ++kb)
#pragma unroll
        for (int s = 0; s < 2; ++s)
#pragma unroll
            for (int db = 0; db < 2; ++db) { const LAS unsigned char* base = Vs + db * 4096 + (kb * 32 + s * 16) * 64;
                const s16x4v lo = tr_read(base + offlo), hi = tr_read(base + offhi);
                vf[(kb * 2 + s) * 2 + db] = __builtin_shufflevector(lo, hi, 0, 1, 2, 3, 4, 5, 6, 7); }
}
__device__ __forceinline__ void pv_mma(const bf16x8v (&vf)[8], const f32x16& p0, const f32x16& p1, f32x16 (&o)[2]) {
#pragma unroll
    for (int kb = 0; kb < 2; ++kb)
#pragma unroll
        for (int s = 0; s < 2; ++s) {
            const f32x16& P = kb ? p1 : p0;
            v4u pw; pw.x = cvtpk(P[8 * s + 0], P[8 * s + 1]); pw.y = cvtpk(P[8 * s + 2], P[8 * s + 3]); pw.z = cvtpk(P[8 * s + 4], P[8 * s + 5]); pw.w = cvtpk(P[8 * s + 6], P[8 * s + 7]);
            const bf16x8v pf = __builtin_bit_cast(bf16x8v, pw);
            o[0] = MFMA32(vf[(kb * 2 + s) * 2], pf, o[0]); o[1] = MFMA32(vf[(kb * 2 + s) * 2 + 1], pf, o[1]);
        }
}

__device__ __forceinline__ void nsa_unit_mfma(LAS unsigned char* L, const MixPtrs& P, int b, int g, int c, int tid_in) {
    int tid_l = tid_in; asm volatile("" : "+v"(tid_l));
    const int tid = tid_l, lane = tid & 63, w = __builtin_amdgcn_readfirstlane(tid >> 6);
    const int r = lane & 31, h = lane >> 5, head = w >> 1, qi = (w & 1) * 32 + r, t = c * 64 + qi;
    const size_t row = (size_t)b * SEQ + t;
    LAS unsigned* SEL = (LAS unsigned*)(L + NM_SEL); LAS int* ITEM = (LAS int*)(L + NM_ITEM);
    const size_t kvbase = (size_t)(b * 2 + g) * SEQ * 64, ccbase = (size_t)(b * 2 + g) * 128 * 64;
    const int skey = tid >> 3, sch = tid & 7, soff = tile_off(skey, sch);
    bf16x8v qf[4];
    { const bf16* qp = MP_QN + row * 512 + (g * 4 + head) * 64 + 8 * h;
#pragma unroll
      for (int ks = 0; ks < 4; ++ks) qf[ks] = *(const bf16x8v*)(qp + 16 * ks); }
    const float* gp = MP_GATE + row * 32 + g * 4 + head;
    float one = 1.f; asm volatile("" : "+v"(one));
    const float gate_c = __builtin_amdgcn_rcpf(one + __expf(-gp[0])), gate_s = __builtin_amdgcn_rcpf(one + __expf(-gp[8])), gate_w = __builtin_amdgcn_rcpf(one + __expf(-gp[16]));
    f32x16 oacc[2];
    {
        const bf16* kc = MP_KC + ccbase; const bf16* vc = MP_VC + ccbase;
        const v4u k0 = *(const v4u*)(kc + tid * 8), k1 = *(const v4u*)(kc + 4096 + tid * 8), v0 = *(const v4u*)(vc + tid * 8), v1 = *(const v4u*)(vc + 4096 + tid * 8);
        LBAR();
        *(LAS v4u*)(L + NM_SLOT + soff) = k0; *(LAS v4u*)(L + NM_SLOT + 8192 + soff) = v0; *(LAS v4u*)(L + NM_SLOT + 16384 + soff) = k1; *(LAS v4u*)(L + NM_SLOT + 24576 + soff) = v1;
        if (tid < 64) SEL[tid] = 0u;
        LBAR();
        f32x16 s0, s1, s2, s3;
        { bf16x8v kfa[8], kfb[8]; k_load(L + NM_SLOT, r, h, kfa); k_load(L + NM_SLOT + 16384, r, h, kfb); SBAR(); qk_mma(kfa, qf, s0, s1); qk_mma(kfb, qf, s2, s3); }
        const int nlim = (t >= 31) ? (((t - 31) >> 4) < 126 ? ((t - 31) >> 4) : 126) : -1;
        float mx, mxv[4] = {-1e20f, -1e20f, -1e20f, -1e20f};
#pragma unroll
        for (int e = 0; e < 16; ++e) { const int cr = (e & 3) + 8 * (e >> 2) + 4 * h;
            s0[e] = (cr <= nlim) ? s0[e] * QK_SCALE : -1e30f; s1[e] = (cr + 32 <= nlim) ? s1[e] * QK_SCALE : -1e30f;
            s2[e] = (cr + 64 <= nlim) ? s2[e] * QK_SCALE : -1e30f; s3[e] = (cr + 96 <= nlim) ? s3[e] * QK_SCALE : -1e30f;
            mxv[e & 3] = fmaxf(fmaxf(mxv[e & 3], fmaxf(s0[e], s1[e])), fmaxf(s2[e], s3[e])); }
        mx = fmaxf(fmaxf(mxv[0], mxv[1]), fmaxf(mxv[2], mxv[3]));
        mx = xor32_max(mx);
        float ls, lsv[4] = {0.f, 0.f, 0.f, 0.f};
#pragma unroll
        for (int e = 0; e < 16; ++e) { s0[e] = __builtin_amdgcn_exp2f(s0[e] - mx); s1[e] = __builtin_amdgcn_exp2f(s1[e] - mx); s2[e] = __builtin_amdgcn_exp2f(s2[e] - mx); s3[e] = __builtin_amdgcn_exp2f(s3[e] - mx);
            lsv[e & 3] += (s0[e] + s1[e]) + (s2[e] + s3[e]); }
        ls = (lsv[0] + lsv[1]) + (lsv[2] + lsv[3]);
        ls = xor32_sum(ls);
        const float il = (ls > 0.f) ? __builtin_amdgcn_rcpf(ls) : 0.f;
#pragma unroll
        for (int e = 0; e < 16; ++e) { s0[e] *= il; s1[e] *= il; s2[e] *= il; s3[e] *= il; }
        { LAS float* IMP = (LAS float*)(L + NM_IMP) + (w * 32 + r) * 33; float plprev = 0.f;
#pragma unroll
          for (int x = 0; x < 16; ++x) {
              const f32x16& S = (x < 4) ? s0 : ((x < 8) ? s1 : ((x < 12) ? s2 : s3)); const int g4 = (x & 3) * 4;
              const float own = (S[g4] + S[g4 + 1]) + (S[g4 + 2] + S[g4 + 3]);
              const float pl = shx(S[g4 + 3], 32, lane);
              if (h == 1) IMP[2 * x + 1] = own + pl; else IMP[2 * x] = own + plprev;
              plprev = pl;
          }
        }
        oacc[0] = (f32x16){0.f, 0.f, 0.f, 0.f, 0.f, 0.f, 0.f, 0.f, 0.f, 0.f, 0.f, 0.f, 0.f, 0.f, 0.f, 0.f}; oacc[1] = oacc[0];
        { bf16x8v vfa[8], vfb[8]; v_load(L + NM_SLOT + 8192, lane, vfa); v_load(L + NM_SLOT + 24576, lane, vfb); SBAR(); pv_mma(vfa, s0, s1, oacc); pv_mma(vfb, s2, s3, oacc); }
#pragma unroll
        for (int e = 0; e < 16; ++e) { oacc[0][e] *= gate_c; oacc[1][e] *= gate_c; }
    }
    LBAR();
    { const int i = tid & 63, jg = tid >> 6; const LAS float* I8 = (const LAS float*)(L + NM_IMP); LAS float* IMS = (LAS float*)(L + NM_IMS);
#pragma unroll
      for (int jj = 0; jj < 4; ++jj) { const int j = 4 * jg + jj; const int wq = (i >> 5), rq = i & 31;
          IMS[i * 36 + j] = (I8[((0 + wq) * 32 + rq) * 33 + j] + I8[((2 + wq) * 32 + rq) * 33 + j]) + (I8[((4 + wq) * 32 + rq) * 33 + j] + I8[((6 + wq) * 32 + rq) * 33 + j]); }
      LBAR();
      unsigned bits = 0u;
      if (c + 1 <= 16) { if (jg == 0) bits = (1u << (c + 1)) - 1u; }
      else { if (jg == 0) bits = 1u | (1u << c) | (1u << (c - 1));
          { float iv[32];
#pragma unroll
            for (int q8 = 0; q8 < 8; ++q8) { const f32x4 x = *(const LAS f32x4*)(IMS + i * 36 + 4 * q8); iv[4 * q8] = x.x; iv[4 * q8 + 1] = x.y; iv[4 * q8 + 2] = x.z; iv[4 * q8 + 3] = x.w; }
#pragma unroll
            for (int jj = 0; jj < 4; ++jj) { const int j = 4 * jg + jj; const float vj = IMS[i * 36 + j]; int rank = 0;
#pragma unroll
                for (int i2 = 1; i2 < 30; ++i2) rank += (i2 <= c - 2 && (iv[i2] > vj || (iv[i2] == vj && i2 < j))) ? 1 : 0;
                if (j >= 1 && j <= c - 2 && rank < 13) bits |= 1u << j; } } }
      if (bits) atomicOr((unsigned*)&SEL[i], bits);
      LBAR();
      if (w == 0) { unsigned so = SEL[lane];
#pragma unroll
          for (int o2 = 32; o2; o2 >>= 1) so |= shxu(so, o2, lane);
          if (lane == 0) { int n = 0; for (int j = 0; j <= c; ++j) if ((so >> j) & 1u) ITEM[n++] = j; const int j0 = (c - 8 > 0) ? c - 8 : 0; for (int j = j0; j <= c; ++j) ITEM[n++] = 64 + j; ITEM[n] = -1; ITEM[47] = n; } }
      LBAR();
    }
    const unsigned mysel = SEL[qi]; const int nitem = ITEM[47];
    f32x16 o[2]; float m = -1e20f, lsum = 0.f; int prev_kind = 0;
    o[0] = (f32x16){0.f, 0.f, 0.f, 0.f, 0.f, 0.f, 0.f, 0.f, 0.f, 0.f, 0.f, 0.f, 0.f, 0.f, 0.f, 0.f}; o[1] = o[0];
    const int npair = (nitem + 1) >> 1;
    v4u rk0, rv0, rk1, rv1;
#define NSA_LOAD_PAIR(ip_) do { const int ia_ = ITEM[2 * (ip_)], ib_ = ITEM[2 * (ip_) + 1]; \
        { const bf16* kp = ((ia_ & 64) ? MP_KW : MP_KS) + kvbase + (size_t)(ia_ & 63) * 4096; const bf16* vp = ((ia_ & 64) ? MP_VW : MP_VS) + kvbase + (size_t)(ia_ & 63) * 4096; rk0 = *(const v4u*)(kp + tid * 8); rv0 = *(const v4u*)(vp + tid * 8); } \
        if (ib_ >= 0) { const bf16* kp = ((ib_ & 64) ? MP_KW : MP_KS) + kvbase + (size_t)(ib_ & 63) * 4096; const bf16* vp = ((ib_ & 64) ? MP_VW : MP_VS) + kvbase + (size_t)(ib_ & 63) * 4096; rk1 = *(const v4u*)(kp + tid * 8); rv1 = *(const v4u*)(vp + tid * 8); } } while (0)
#define NSA_WRITE_PAIR(sb_) do { *(LAS v4u*)(L + (sb_) + soff) = rk0; *(LAS v4u*)(L + (sb_) + 8192 + soff) = rv0; *(LAS v4u*)(L + (sb_) + 16384 + soff) = rk1; *(LAS v4u*)(L + (sb_) + 24576 + soff) = rv1; } while (0)
    rk1 = (v4u){0u, 0u, 0u, 0u}; rv1 = rk1;
    NSA_LOAD_PAIR(0);
    NSA_WRITE_PAIR(NM_SLOT + 32768);
    LBAR();
#pragma unroll 1
    for (int ip = 0; ip < npair; ++ip) {
        if (ip + 1 < npair) NSA_LOAD_PAIR(ip + 1);
        const int sbase = NM_SLOT + ((ip + 1) & 1) * 32768;
#pragma unroll 1
        for (int half = 0; half < 2; ++half) {
            const int item = ITEM[2 * ip + half];
            if (item < 0) break;
            const int kind = item >> 6, j = item & 63;
            if (kind != prev_kind) {
                const float tot = xor32_sum(lsum); const float sc = gate_s * __builtin_amdgcn_rcpf(tot);
#pragma unroll
                for (int e = 0; e < 16; ++e) { oacc[0][e] += o[0][e] * sc; oacc[1][e] += o[1][e] * sc; o[0][e] = 0.f; o[1][e] = 0.f; }
                m = -1e20f; lsum = 0.f; prev_kind = kind;
            }
            int klo, khi;
            if (kind == 0) { klo = 0; khi = ((mysel >> j) & 1u) ? ((j < c) ? 63 : qi) : -1; }
            else { klo = t - 511 - 64 * j; khi = t - 64 * j; if (khi > 63) khi = 63; if (klo < 0) klo = 0; }
            const LAS unsigned char* slot = L + sbase + half * 16384;
            if (__any(khi >= klo)) {
                f32x16 p0, p1; bf16x8v vf[8];
                { bf16x8v kf[8]; k_load(slot, r, h, kf); SBAR(); qk_mma(kf, qf, p0, p1); }
                v_load(slot + 8192, lane, vf); SBAR();
                if (!__all(klo == 0 && khi == 63)) {
                    const int a = klo - 4 * h, z = khi - 4 * h;
#pragma unroll
                    for (int e = 0; e < 16; ++e) { const int cr = (e & 3) + 8 * (e >> 2);
                        p0[e] = (cr >= a && cr <= z) ? p0[e] : -1e30f; p1[e] = (cr + 32 >= a && cr + 32 <= z) ? p1[e] : -1e30f; }
                }
                float tm;
                { float ma = max2f(p0[0], p1[0]), mb = max2f(p0[1], p1[1]), mc2 = max2f(p0[2], p1[2]), md = max2f(p0[3], p1[3]);
#pragma unroll
                  for (int e = 4; e < 16; e += 4) { ma = max3f(ma, p0[e], p1[e]); mb = max3f(mb, p0[e + 1], p1[e + 1]); mc2 = max3f(mc2, p0[e + 2], p1[e + 2]); md = max3f(md, p0[e + 3], p1[e + 3]); }
                  tm = max3f(ma, mb, max2f(mc2, md)); }
                tm = xor32_max(tm);
                const float mn = fmaxf(m, tm * QK_SCALE);
                if (!__all(mn == m)) { const float corr = __builtin_amdgcn_exp2f(m - mn); lsum *= corr;
#pragma unroll
                    for (int e = 0; e < 16; ++e) { o[0][e] *= corr; o[1][e] *= corr; }
                    m = mn; }
                { const f32x2v sc2 = {QK_SCALE, QK_SCALE}, mm2 = {m, m}; f32x2v ta = {0.f, 0.f}, tb = {0.f, 0.f};
#pragma unroll
                  for (int e = 0; e < 16; e += 2) { const f32x2v a0 = (f32x2v){p0[e], p0[e + 1]} * sc2 - mm2, a1 = (f32x2v){p1[e], p1[e + 1]} * sc2 - mm2; p0[e] = a0.x; p0[e + 1] = a0.y; p1[e] = a1.x; p1[e + 1] = a1.y; }
#pragma unroll
                  for (int e = 0; e < 16; ++e) { p0[e] = __builtin_amdgcn_exp2f(p0[e]); p1[e] = __builtin_amdgcn_exp2f(p1[e]); }
#pragma unroll
                  for (int e = 0; e < 16; e += 2) { ta += (f32x2v){p0[e], p0[e + 1]}; tb += (f32x2v){p1[e], p1[e + 1]}; }
                  lsum += (ta.x + ta.y) + (tb.x + tb.y); }
                SBAR(); pv_mma(vf, p0, p1, o);
            }
        }
        if (ip + 1 < npair) NSA_WRITE_PAIR(NM_SLOT + (ip & 1) * 32768);
        LBAR();
    }
#undef NSA_LOAD_PAIR
#undef NSA_WRITE_PAIR
    { const float tot = xor32_sum(lsum); const float sc = gate_w * __builtin_amdgcn_rcpf(tot);
#pragma unroll
      for (int e = 0; e < 16; ++e) { oacc[0][e] += o[0][e] * sc; oacc[1][e] += o[1][e] * sc; } }
    { bf16* yp = MP_Y + row * DM + (g * 4 + head) * 64 + 4 * h;
#pragma unroll
      for (int db = 0; db < 2; ++db)
#pragma unroll
          for (int g4 = 0; g4 < 4; ++g4) { v2u wv; wv.x = cvtpk(oacc[db][4 * g4], oacc[db][4 * g4 + 1]); wv.y = cvtpk(oacc[db][4 * g4 + 2], oacc[db][4 * g4 + 3]); *(v2u*)(yp + db * 32 + g4 * 8) = wv; } }
}

#define MFMA16(a, b, c) __builtin_amdgcn_mfma_f32_16x16x32_bf16((a), (b), (c), 0, 0, 0)
constexpr size_t WS_QC = 422 * MiB, WS_KC2 = 454 * MiB, WS_END2 = 486 * MiB;
#define MP_QC ((const bf16*)(P.ws + WS_QC))
#define MP_KC2 ((const bf16*)(P.ws + WS_KC2))
__device__ __forceinline__ int img_off(int row, int ch) { return 256 * row + 16 * (ch ^ (((row & 3) << 2) | ((row >> 2) & 3))); }
constexpr int M2_IMG = 0, M2_SC = 98304, M2_DEN = 106496, M2_QN = 107520, M2_N = 107776, M2_SSQ = 108288;

__device__ __forceinline__ void mlstm_conv_pass(unsigned char* ws, const float* conv_w, const float* conv_b, int gthread, int nthreads) {
    for (int idx = gthread; idx < BATCH * 128 * 128; idx += nthreads) {
        const int cc = idx & 127, tg = (idx >> 7) & 127, b = idx >> 14;
        const int isk = cc >> 6, ch0 = (cc & 63) * 8;
        const bf16* src = (const bf16*)(ws + (isk ? WS_MK : WS_MQ)) + (size_t)b * SEQ * 512 + ch0;
        bf16* dst = (bf16*)(ws + (isk ? WS_KC2 : WS_QC)) + ((size_t)(b * 4 + (ch0 >> 7)) * SEQ) * 128 + (ch0 & 127);
        float wt[4][8], bs[8];
#pragma unroll
        for (int j = 0; j < 4; ++j) { const f32x4 a = *(const f32x4*)(conv_w + j * 1024 + isk * 512 + ch0), c2 = *(const f32x4*)(conv_w + j * 1024 + isk * 512 + ch0 + 4);
            wt[j][0] = a.x; wt[j][1] = a.y; wt[j][2] = a.z; wt[j][3] = a.w; wt[j][4] = c2.x; wt[j][5] = c2.y; wt[j][6] = c2.z; wt[j][7] = c2.w; }
        { const f32x4 a = *(const f32x4*)(conv_b + isk * 512 + ch0), c2 = *(const f32x4*)(conv_b + isk * 512 + ch0 + 4); bs[0] = a.x; bs[1] = a.y; bs[2] = a.z; bs[3] = a.w; bs[4] = c2.x; bs[5] = c2.y; bs[6] = c2.z; bs[7] = c2.w; }
        const float osc = isk ? 0.08838834764831845f : 1.f;
        const int t0 = tg * 16;
        float x0[8], x1[8], x2[8];
#pragma unroll
        for (int e = 0; e < 8; ++e) { x0[e] = 0.f; x1[e] = 0.f; x2[e] = 0.f; }
        if (t0 > 0) {
            const v4u a = *(const v4u*)(src + (size_t)(t0 - 3) * 512), c2 = *(const v4u*)(src + (size_t)(t0 - 2) * 512), d2 = *(const v4u*)(src + (size_t)(t0 - 1) * 512);
            x0[0] = bflo(a.x); x0[1] = bfhi(a.x); x0[2] = bflo(a.y); x0[3] = bfhi(a.y); x0[4] = bflo(a.z); x0[5] = bfhi(a.z); x0[6] = bflo(a.w); x0[7] = bfhi(a.w);
            x1[0] = bflo(c2.x); x1[1] = bfhi(c2.x); x1[2] = bflo(c2.y); x1[3] = bfhi(c2.y); x1[4] = bflo(c2.z); x1[5] = bfhi(c2.z); x1[6] = bflo(c2.w); x1[7] = bfhi(c2.w);
            x2[0] = bflo(d2.x); x2[1] = bfhi(d2.x); x2[2] = bflo(d2.y); x2[3] = bfhi(d2.y); x2[4] = bflo(d2.z); x2[5] = bfhi(d2.z); x2[6] = bflo(d2.w); x2[7] = bfhi(d2.w);
        }
#pragma unroll 4
        for (int s = 0; s < 16; ++s) {
            const v4u a = *(const v4u*)(src + (size_t)(t0 + s) * 512);
            const float x3[8] = {bflo(a.x), bfhi(a.x), bflo(a.y), bfhi(a.y), bflo(a.z), bfhi(a.z), bflo(a.w), bfhi(a.w)};
            float o[8];
#pragma unroll
            for (int e = 0; e < 8; ++e) { float v = bs[e] + wt[0][e] * x0[e] + wt[1][e] * x1[e] + wt[2][e] * x2[e] + wt[3][e] * x3[e]; v = v * __builtin_amdgcn_rcpf(1.f + __expf(-v)); o[e] = v * osc; x0[e] = x1[e]; x1[e] = x2[e]; x2[e] = x3[e]; }
            v4u wv; wv.x = pk2(o[0], o[1]); wv.y = pk2(o[2], o[3]); wv.z = pk2(o[4], o[5]); wv.w = pk2(o[6], o[7]);
            *(v4u*)(dst + (size_t)(t0 + s) * 128) = wv;
        }
    }
}

constexpr int M2_A = 112384, M2_PM = 120576, M2_F = 128768, M2_BL = 136960, M2_AMX = 137088, M2_MC = 137216;
__device__ __forceinline__ void mlstm_unit_mfma(LAS unsigned char* L, const MixPtrs& P, int b, int hh, int tid_in) {
    int tid_l = tid_in; asm volatile("" : "+v"(tid_l));
    const int tid = tid_l, lane = tid & 63, w = __builtin_amdgcn_readfirstlane(tid >> 6), l15 = lane & 15, kg = lane >> 4;
    const size_t rb = (size_t)b * SEQ;
    const bf16* QCp = MP_QC + ((size_t)(b * 4 + hh) * SEQ) * 128; const bf16* KCp = MP_KC2 + ((size_t)(b * 4 + hh) * SEQ) * 128;
    const bf16* Vp = MP_MV + rb * 512 + hh * 128; const bf16* Op = MP_MO + rb * 512 + hh * 128 + 16 * w + 4 * kg;
    bf16* Yp = MP_Y + rb * DM + 512 + hh * 128 + 16 * w + 4 * kg;
    LAS float* DEN = (LAS float*)(L + M2_DEN); LAS float* QN = (LAS float*)(L + M2_QN); LAS float* NV = (LAS float*)(L + M2_N); LAS float* SSQ = (LAS float*)(L + M2_SSQ);
    LAS float* SA = (LAS float*)(L + M2_A); LAS float* SPM = (LAS float*)(L + M2_PM); LAS float* SF = (LAS float*)(L + M2_F);
    LAS float* SBL = (LAS float*)(L + M2_BL); LAS float* SAMX = (LAS float*)(L + M2_AMX); LAS float* SMC = (LAS float*)(L + M2_MC);
    float zf = 0.f; asm volatile("" : "+v"(zf));
    f32x4 Cacc[8], nacc = {zf, zf, zf, zf};
#pragma unroll
    for (int i = 0; i < 8; ++i) Cacc[i] = (f32x4){zf, zf, zf, zf};
    const f32x4 gn = *(const f32x4*)(P.mnorm_g + hh * 128 + 16 * w + 4 * kg);
    const int r0s = tid >> 4, c0s = tid & 15, so0 = img_off(r0s, c0s), so1 = img_off(r0s + 32, c0s);
    v4u sq0, sq1, sk0, sk1, sv0, sv1;
    sq0 = *(const v4u*)(QCp + (size_t)r0s * 128 + c0s * 8); sq1 = *(const v4u*)(QCp + (size_t)(r0s + 32) * 128 + c0s * 8);
    sk0 = *(const v4u*)(KCp + (size_t)r0s * 128 + c0s * 8); sk1 = *(const v4u*)(KCp + (size_t)(r0s + 32) * 128 + c0s * 8);
    sv0 = *(const v4u*)(Vp + (size_t)r0s * 512 + c0s * 8);  sv1 = *(const v4u*)(Vp + (size_t)(r0s + 32) * 512 + c0s * 8);
    LBAR();
    { const float ib = P.i_bias[hh], fb = P.f_bias[hh]; const float* Gp = MP_GATE + rb * 32 + hh;
#pragma unroll 1
      for (int cc = w; cc < 32; cc += 8) { const int tk = 64 * cc + lane;
          const float il = Gp[(size_t)tk * 32 + 24] + ib, fx = Gp[(size_t)tk * 32 + 28] + fb; const float fl = fminf(fx, 0.f) - log1pf(__expf(-fabsf(fx)));
          float f = fl;
#pragma unroll
          for (int o = 1; o < 64; o <<= 1) { const float v = shi(f, lane - o); if (lane >= o) f += v; }
          const float a = il - f; float pm = a;
#pragma unroll
          for (int o = 1; o < 64; o <<= 1) { const float v = shi(pm, lane - o); if (lane >= o) pm = fmaxf(pm, v); }
          SA[tk] = a; SPM[tk] = pm; SF[tk] = f; if (lane == 63) { SBL[cc] = f; SAMX[cc] = pm; } } }
    *(LAS v4u*)(L + M2_IMG + so0) = sq0; *(LAS v4u*)(L + M2_IMG + so1) = sq1; *(LAS v4u*)(L + M2_IMG + 16384 + so0) = sk0; *(LAS v4u*)(L + M2_IMG + 16384 + so1) = sk1;
    *(LAS v4u*)(L + M2_IMG + 32768 + so0) = sv0; *(LAS v4u*)(L + M2_IMG + 32768 + so1) = sv1;
    if (tid < 128) NV[tid] = zf;
    LBAR();
    if (tid == 0) { float mcar = zf; for (int cc = 0; cc < 32; ++cc) { SMC[cc] = mcar; mcar = SBL[cc] + fmaxf(mcar, SAMX[cc]); } }
    LBAR();
#pragma unroll 1
    for (int c = 0; c < 32; ++c) {
        int lc = lane; asm volatile("" : "+v"(lc));
        const int l15 = lc & 15, kg = lc >> 4, q4 = l15 >> 2, p4 = l15 & 3;
        const int t0 = c * 64; const LAS unsigned char* Qi = L + M2_IMG + (c & 1) * 49152; const LAS unsigned char* Ki = Qi + 16384; const LAS unsigned char* Vi = Qi + 32768;
        if (c + 1 < 32) { const int tn = t0 + 64;
            sq0 = *(const v4u*)(QCp + (size_t)(tn + r0s) * 128 + c0s * 8); sq1 = *(const v4u*)(QCp + (size_t)(tn + r0s + 32) * 128 + c0s * 8);
            sk0 = *(const v4u*)(KCp + (size_t)(tn + r0s) * 128 + c0s * 8); sk1 = *(const v4u*)(KCp + (size_t)(tn + r0s + 32) * 128 + c0s * 8);
            sv0 = *(const v4u*)(Vp + (size_t)(tn + r0s) * 512 + c0s * 8);  sv1 = *(const v4u*)(Vp + (size_t)(tn + r0s + 32) * 512 + c0s * 8); }
        const float mc = SMC[c], mxa = fmaxf(mc, SAMX[c]); const float cs = __expf(mc - mxa);
        { const int tblk = w >> 1, t = 16 * tblk + l15; const int sb0 = 2 * (w & 1);
          bf16x8v ka[2][4], qb[4];
#pragma unroll
          for (int ks = 0; ks < 4; ++ks) { qb[ks] = *(const LAS bf16x8v*)(Qi + img_off(t, 4 * ks + kg)); ka[0][ks] = *(const LAS bf16x8v*)(Ki + img_off(16 * sb0 + l15, 4 * ks + kg)); ka[1][ks] = *(const LAS bf16x8v*)(Ki + img_off(16 * sb0 + 16 + l15, 4 * ks + kg)); }
          const float Mt = fmaxf(SPM[t0 + t], mc);
          const f32x4 as0 = *(const LAS f32x4*)(SA + t0 + 16 * sb0 + 4 * kg), as1 = *(const LAS f32x4*)(SA + t0 + 16 * sb0 + 16 + 4 * kg);
          const int tq = tid >> 3, dp = tid & 7; const v4u q0 = *(const LAS v4u*)(Qi + img_off(tq, 2 * dp)), q1 = *(const LAS v4u*)(Qi + img_off(tq, 2 * dp + 1));
          const LAS f32x4* np = (const LAS f32x4*)(NV + 16 * dp); const f32x4 n0 = np[0], n1 = np[1], n2 = np[2], n3 = np[3];
          SBAR();
          LAS unsigned char* SC = L + M2_SC;
#pragma unroll
          for (int sb = 0; sb < 2; ++sb) { const int sblk = sb0 + sb; f32x4 acc = {0.f, 0.f, 0.f, 0.f}; float rp = 0.f; v2u wv; wv.x = 0u; wv.y = 0u;
              if (sblk <= tblk) {
#pragma unroll
                  for (int ks = 0; ks < 4; ++ks) acc = MFMA16(ka[sb][ks], qb[ks], acc);
                  const f32x4 as = sb ? as1 : as0; float v[4];
#pragma unroll
                  for (int e = 0; e < 4; ++e) { const float x = acc[e] * __expf(as[e] - Mt); v[e] = (sblk == tblk && 4 * kg + e > l15) ? 0.f : x; }
                  rp = (v[0] + v[1]) + (v[2] + v[3]); wv.x = cvtpk(v[0], v[1]); wv.y = cvtpk(v[2], v[3]);
              }
              rp += shx(rp, 16, lane); rp += shx(rp, 32, lane);
              *(LAS v2u*)(SC + t * 128 + (((2 * sblk + (kg >> 1)) ^ (t & 7)) << 4) + 8 * (kg & 1)) = wv;
              if (kg == 0) DEN[sblk * 64 + t] = rp; }
          { float s = bflo(q0.x) * n0.x + bfhi(q0.x) * n0.y + bflo(q0.y) * n0.z + bfhi(q0.y) * n0.w + bflo(q0.z) * n1.x + bfhi(q0.z) * n1.y + bflo(q0.w) * n1.z + bfhi(q0.w) * n1.w
                    + bflo(q1.x) * n2.x + bfhi(q1.x) * n2.y + bflo(q1.y) * n2.z + bfhi(q1.y) * n2.w + bflo(q1.z) * n3.x + bfhi(q1.z) * n3.y + bflo(q1.w) * n3.z + bfhi(q1.w) * n3.w;
            s += shx(s, 1, lane); s += shx(s, 2, lane); s += shx(s, 4, lane);
            if (dp == 0) QN[tq] = s; } }
        LBAR();
        v2u og[4];
#pragma unroll
        for (int tb = 0; tb < 4; ++tb) og[tb] = *(const v2u*)(Op + (size_t)(t0 + 16 * tb + l15) * 512);
        bf16x8v vf[2]; f32x4 hv[4];
        { float pmt[4], ft[4], dnp[4], qn4[4]; bf16x8v Cfrag[4];
#pragma unroll
          for (int kp = 0; kp < 4; ++kp) { v4u a; a.x = cvtpk(Cacc[2 * kp].x, Cacc[2 * kp].y); a.y = cvtpk(Cacc[2 * kp].z, Cacc[2 * kp].w); a.z = cvtpk(Cacc[2 * kp + 1].x, Cacc[2 * kp + 1].y); a.w = cvtpk(Cacc[2 * kp + 1].z, Cacc[2 * kp + 1].w);
              Cfrag[kp] = __builtin_bit_cast(bf16x8v, a); }
#pragma unroll
          for (int ks = 0; ks < 2; ++ks) { const int r0 = 32 * ks + 8 * kg;
              const s16x4v lo = tr_read(Vi + 256 * (r0 + q4) + 16 * ((2 * w + (p4 >> 1)) ^ ((q4 << 2) | ((r0 >> 2) & 3))) + 8 * (p4 & 1));
              const s16x4v hi = tr_read(Vi + 256 * (r0 + 4 + q4) + 16 * ((2 * w + (p4 >> 1)) ^ ((q4 << 2) | (((r0 + 4) >> 2) & 3))) + 8 * (p4 & 1));
              vf[ks] = __builtin_shufflevector(lo, hi, 0, 1, 2, 3, 4, 5, 6, 7); }
#pragma unroll
          for (int tb = 0; tb < 4; ++tb) { const int t = 16 * tb + l15; pmt[tb] = SPM[t0 + t]; ft[tb] = SF[t0 + t]; dnp[tb] = (DEN[t] + DEN[64 + t]) + (DEN[128 + t] + DEN[192 + t]); qn4[tb] = QN[t]; }
#pragma unroll
          for (int tp = 0; tp < 2; ++tp) {
              bf16x8v sf[2][2]; v2u qlo[2][4], qhi[2][4];
#pragma unroll
              for (int t2 = 0; t2 < 2; ++t2) { const int t = 16 * (2 * tp + t2) + l15; const int swz = ((t & 3) << 2) | ((t >> 2) & 3);
#pragma unroll
                  for (int ks = 0; ks < 2; ++ks) sf[t2][ks] = *(const LAS bf16x8v*)(L + M2_SC + t * 128 + (((4 * ks + kg) ^ (t & 7)) << 4));
#pragma unroll
                  for (int kp = 0; kp < 4; ++kp) { qlo[t2][kp] = *(const LAS v2u*)(Qi + 256 * t + 16 * ((4 * kp + (kg >> 1)) ^ swz) + 8 * (kg & 1)); qhi[t2][kp] = *(const LAS v2u*)(Qi + 256 * t + 16 * ((4 * kp + 2 + (kg >> 1)) ^ swz) + 8 * (kg & 1)); } }
              SBAR();
#pragma unroll
              for (int t2 = 0; t2 < 2; ++t2) { const int tb = 2 * tp + t2; f32x4 an = {0.f, 0.f, 0.f, 0.f}, a2 = {0.f, 0.f, 0.f, 0.f};
#pragma unroll
                  for (int ks = 0; ks < 2; ++ks) an = MFMA16(vf[ks], sf[t2][ks], an);
#pragma unroll
                  for (int kp = 0; kp < 4; ++kp) { v4u qq; qq.x = qlo[t2][kp].x; qq.y = qlo[t2][kp].y; qq.z = qhi[t2][kp].x; qq.w = qhi[t2][kp].y; a2 = MFMA16(Cfrag[kp], __builtin_bit_cast(bf16x8v, qq), a2); }
                  const float Mt = fmaxf(pmt[tb], mc), wp = __expf(mc - Mt), emt = __expf(-ft[tb] - Mt);
                  const float dn = dnp[tb] + wp * qn4[tb];
                  const float idn = __builtin_amdgcn_rcpf(fmaxf(fabsf(dn), emt));
                  hv[tb] = (an + a2 * wp) * idn;
                  float ss = (hv[tb].x * hv[tb].x + hv[tb].y * hv[tb].y) + (hv[tb].z * hv[tb].z + hv[tb].w * hv[tb].w);
                  ss += shx(ss, 16, lane); ss += shx(ss, 32, lane);
                  if (kg == 0) SSQ[((c & 1) * 8 + w) * 64 + 16 * tb + l15] = ss; }
              SBAR();
          } }
        { bf16x8v vpf[2], wkf[2];
          f32x4 aw[2][2];
#pragma unroll
          for (int ks = 0; ks < 2; ++ks) { aw[ks][0] = *(const LAS f32x4*)(SA + t0 + 32 * ks + 8 * kg); aw[ks][1] = *(const LAS f32x4*)(SA + t0 + 32 * ks + 8 * kg + 4); }
#pragma unroll
          for (int ks = 0; ks < 2; ++ks) { float wkv[8]; unsigned vp[4], wp2[4]; const v4u vu = __builtin_bit_cast(v4u, vf[ks]); const unsigned vw[4] = {vu.x, vu.y, vu.z, vu.w};
#pragma unroll
              for (int j = 0; j < 8; ++j) wkv[j] = __expf(aw[ks][j >> 2][j & 3] - mxa);
#pragma unroll
              for (int j2 = 0; j2 < 4; ++j2) { vp[j2] = cvtpk(bflo(vw[j2]) * wkv[2 * j2], bfhi(vw[j2]) * wkv[2 * j2 + 1]); wp2[j2] = cvtpk(wkv[2 * j2], wkv[2 * j2 + 1]); }
              v4u a; a.x = vp[0]; a.y = vp[1]; a.z = vp[2]; a.w = vp[3]; vpf[ks] = __builtin_bit_cast(bf16x8v, a);
              v4u b2; b2.x = wp2[0]; b2.y = wp2[1]; b2.z = wp2[2]; b2.w = wp2[3]; wkf[ks] = __builtin_bit_cast(bf16x8v, b2); }
          nacc = nacc * cs;
#pragma unroll
          for (int ih = 0; ih < 2; ++ih) {
              bf16x8v kf[4][2];
#pragma unroll
              for (int i4 = 0; i4 < 4; ++i4)
#pragma unroll
                  for (int ks = 0; ks < 2; ++ks) { const int i = 4 * ih + i4, r0 = 32 * ks + 8 * kg;
                      const s16x4v lo = tr_read(Ki + 256 * (r0 + q4) + 16 * ((2 * i + (p4 >> 1)) ^ ((q4 << 2) | ((r0 >> 2) & 3))) + 8 * (p4 & 1));
                      const s16x4v hi = tr_read(Ki + 256 * (r0 + 4 + q4) + 16 * ((2 * i + (p4 >> 1)) ^ ((q4 << 2) | (((r0 + 4) >> 2) & 3))) + 8 * (p4 & 1));
                      kf[i4][ks] = __builtin_shufflevector(lo, hi, 0, 1, 2, 3, 4, 5, 6, 7); }
              SBAR();
#pragma unroll
              for (int i4 = 0; i4 < 4; ++i4) { const int i = 4 * ih + i4; Cacc[i] = Cacc[i] * cs;
#pragma unroll
                  for (int ks = 0; ks < 2; ++ks) { Cacc[i] = MFMA16(kf[i4][ks], vpf[ks], Cacc[i]); if (i == w) nacc = MFMA16(kf[i4][ks], wkf[ks], nacc); } }
              SBAR();
          }
          if (l15 == 0) *(LAS f32x4*)(NV + 16 * w + 4 * kg) = nacc;
 }
        if (c + 1 < 32) { LAS unsigned char* Nx = L + M2_IMG + ((c + 1) & 1) * 49152;
            *(LAS v4u*)(Nx + so0) = sq0; *(LAS v4u*)(Nx + so1) = sq1; *(LAS v4u*)(Nx + 16384 + so0) = sk0; *(LAS v4u*)(Nx + 16384 + so1) = sk1; *(LAS v4u*)(Nx + 32768 + so0) = sv0; *(LAS v4u*)(Nx + 32768 + so1) = sv1; }
        LBAR();
#pragma unroll
        for (int tb = 0; tb < 4; ++tb) { const int t = 16 * tb + l15; const LAS float* sp = SSQ + (c & 1) * 512 + t;
            const float tot = ((sp[0] + sp[64]) + (sp[128] + sp[192])) + ((sp[256] + sp[320]) + (sp[384] + sp[448]));
            const float rn = __frsqrt_rn(tot * (1.f / 128.f) + EPS);
            const float y0 = hv[tb].x * rn * gn.x * sigmoidf_(bflo(og[tb].x)), y1 = hv[tb].y * rn * gn.y * sigmoidf_(bfhi(og[tb].x)), y2 = hv[tb].z * rn * gn.z * sigmoidf_(bflo(og[tb].y)), y3 = hv[tb].w * rn * gn.w * sigmoidf_(bfhi(og[tb].y));
            v2u wv; wv.x = cvtpk(y0, y1); wv.y = cvtpk(y2, y3);
            *(v2u*)(Yp + (size_t)(t0 + t) * DM) = wv; }
    }
    LBAR();
}

#ifndef MK_MULTI
#define MK_MULTI 0
#endif
constexpr int PH_PER_LAYER = 12, N_PHASES = 1 + DEPTH * PH_PER_LAYER;
struct Args { const float* in[16]; float* out; unsigned char* ws; int ph_lo, ph_hi; };
static_assert(sizeof(Args) == 16 * 8 + 8 + 8 + 8, "Args has no padding");

__global__ void __launch_bounds__(NWAVES * 64, 2) fwd_kernel(Args args) {
    extern __shared__ __attribute__((aligned(16))) unsigned char lds_raw[];
    LAS unsigned char* L = (LAS unsigned char*)lds_raw;
    const int G0 = gridDim.x, blk0 = blockIdx.x;
    const int wave0 = __builtin_amdgcn_readfirstlane((int)threadIdx.x >> 6);
#define PH_IDS() PH_WS(); int wave = wave0; asm volatile("" : "+s"(wave)); const int lane = fresh_lane(), tid = wave * 64 + lane, gw = blk * NWAVES + wave; (void)gw
#define PH_WS() unsigned char* ws = args.ws; asm volatile("" : "+s"(ws)); int blk = blk0, G = G0; asm volatile("" : "+s"(blk), "+s"(G)); const int NGW = G * NWAVES; (void)NGW; bf16* X16 = (bf16*)(ws + WS_X16); float* R2 = (float*)(ws + WS_TAB + TAB_R2); bf16* U = (bf16*)(ws + WS_U); bf16* HB = (bf16*)(ws + WS_HB); bf16* HD = (bf16*)(ws + WS_HD); \
    unsigned char* wl = ws + WS_W; const float* ng = args.in[1] + (size_t)l_ * 6 * DM; (void)X16; (void)R2; (void)U; (void)HB; (void)HD; (void)wl; (void)ng
    unsigned char* ws0 = args.ws;
    volatile LAS unsigned* MISC = (volatile LAS unsigned*)(L + MISC_OFF);
    { const int tid_e = wave0 * 64 + fresh_lane(); if (tid_e < 16) MISC[tid_e] = 0u; }
    __syncthreads();
    XcdBarrier bar; bar.bar = (unsigned*)(ws0 + WS_CTL) + CW_BAR; bar.x = 0; bar.st = nullptr;
    if (!MK_MULTI) bar = xcd_barrier_post((unsigned*)(ws0 + WS_CTL) + CW_BAR, MISC + 8, wave0 * 64 + fresh_lane() == 0);
    const int lo = args.ph_lo, hi = args.ph_hi;
#define IN(k) (lo <= (k) && (k) < hi)
#define SEAM(k) do { if (IN(k) && IN((k) + 1)) xcd_barrier(bar, wave0 * 64 + fresh_lane() == 0); } while (0)

    if (IN(0)) {
        const int l_ = 0; PH_IDS();
        const float* x_in = args.in[0]; float* cosT = (float*)(ws + WS_TAB + TAB_COS); float* sinT = (float*)(ws + WS_TAB + TAB_SIN); float* b1T = (float*)(ws + WS_TAB + TAB_B1);
#define CONVERT_WEIGHTS(lw) do { LAS float* scr = (LAS float*)(L + wave * 16384); const float* ngw = args.in[1] + (size_t)(lw) * 6 * DM; \
        constexpr int I_GU = 16 * 176, I_DN = 44 * 32, I_IN = 16 * 112, I_OUT = 16 * 32, I_CMP = 16 * 16, I_LAYER = 2 * I_GU + 2 * I_DN + I_IN + I_OUT + I_CMP; \
        for (int it = gw; it < I_LAYER; it += NGW) { int r = it; unsigned char* wlw = ws + WS_W; \
            if (r < I_GU) { SrcGU s{args.in[2] + (size_t)(lw) * DM * NGU, ngw + 0 * DM}; transpose_item(s, DM, (bf16*)(wlw + WO_GU1), scr, r / 176, r % 176, lane); continue; } r -= I_GU; \
            if (r < I_DN) { SrcPlain s{args.in[3] + (size_t)(lw) * FF * DM, DM}; transpose_item(s, FF, (bf16*)(wlw + WO_DN1), scr, r / 32, r % 32, lane); continue; } r -= I_DN; \
            if (r < I_GU) { SrcGU s{args.in[4] + (size_t)(lw) * DM * NGU, ngw + 4 * DM}; transpose_item(s, DM, (bf16*)(wlw + WO_GU2), scr, r / 176, r % 176, lane); continue; } r -= I_GU; \
            if (r < I_DN) { SrcPlain s{args.in[5] + (size_t)(lw) * FF * DM, DM}; transpose_item(s, FF, (bf16*)(wlw + WO_DN2), scr, r / 32, r % 32, lane); continue; } r -= I_DN; \
            if (r < I_IN) { SrcIN s{args.in[6] + (size_t)(lw) * DM * INCOLS, ngw + 2 * DM}; transpose_item(s, DM, (bf16*)(wlw + WO_IN), scr, r / 112, r % 112, lane); continue; } r -= I_IN; \
            if (r < I_OUT) { SrcPlain s{args.in[7] + (size_t)(lw) * DM * DM, DM}; transpose_item(s, DM, (bf16*)(wlw + WO_OUT), scr, r / 32, r % 32, lane); continue; } r -= I_OUT; \
            { SrcCMP s{args.in[9] + (size_t)(lw) * 2 * 2048 * 128}; transpose_item(s, DM, (bf16*)(wlw + WO_CMP), scr, r / 16, r % 16, lane); } } } while (0)
        CONVERT_WEIGHTS(0);
        for (int i = blk * 512 + tid; i < SEQ * 8; i += G * 512) { const int pos = i >> 3, k = i & 7;
            const double inv = pow(500000.0, -(double)k / 8.0), ang = (double)pos * inv; cosT[i] = (float)cos(ang); sinT[i] = (float)sin(ang); }
        { LAS float* part = (LAS float*)(L + 131072);
          for (int ob = blk; ob < DEPTH * 2 * 128 / 2; ob += G) { const int o = 2 * ob + (wave >> 2), qr = wave & 3; const int lk = o >> 7, c = o & 127;
              const float* pe = args.in[8] + (size_t)lk * 2048; const float* w1 = args.in[9] + (size_t)lk * 2048 * 128;
              float s = 0.f; for (int r = qr * 512 + lane; r < qr * 512 + 512; r += 64) s += pe[r] * w1[(size_t)r * 128 + c];
              s = wave_sum(s, lane); if (lane == 0) part[wave] = s;
              __syncthreads();
              if (lane == 0 && qr == 0) b1T[o] = (part[wave] + part[wave + 1]) + (part[wave + 2] + part[wave + 3]);
              __syncthreads(); } }
        thin_phase<0>(nullptr, x_in, X16, nullptr, R2, nullptr, 0.f, gw, NGW, lane);
    }
    SEAM(0);

#pragma unroll 1
    for (int l = 0; l < DEPTH; ++l) {
        const int pb = 1 + l * PH_PER_LAYER, l_ = l;
        if (IN(pb + 0)) { PH_IDS(); pg8::Gemm g{X16, (const bf16*)(wl + WO_GU1), MTOK, NGU, DM}; pg8::StaticOrder S; S.init(MTOK, NGU, G, blk); EpiSwiglu E{HB, R2};
            pg8::gemm_phase<EpiSwiglu, pg8::StaticOrder, true, true>(L, g, S, E, tid); }
        SEAM(pb + 0);
        if (IN(pb + 1)) { PH_IDS(); pg8::Gemm g{HB, (const bf16*)(wl + WO_DN1), MTOK, DM, FF}; pg8::StaticOrder S; S.init(MTOK, DM, G, blk); pg8::EpiBf16<0> E{HD, DM, nullptr, 0, 0, 1.f};
            pg8::gemm_phase<pg8::EpiBf16<0>, pg8::StaticOrder, true, true>(L, g, S, E, tid); }
        SEAM(pb + 1);
        if (IN(pb + 2)) { PH_IDS(); thin_phase<1>(HD, nullptr, X16, nullptr, R2, ng + 1 * DM, 0.5f, gw, NGW, lane); }
        SEAM(pb + 2);
        if (IN(pb + 3)) { PH_IDS(); pg8::Gemm g{X16, (const bf16*)(wl + WO_IN), MTOK, NINP, DM}; pg8::StaticOrder S; S.init(MTOK, NINP, G, blk);
            EpiInProj E{ws};
            pg8::gemm_phase<EpiInProj, pg8::StaticOrder, true, true>(L, g, S, E, tid); }
        SEAM(pb + 3);
        if (IN(pb + 4)) { PH_IDS(); pg8::Gemm g{(const bf16*)(ws + WS_KCR), (const bf16*)(wl + WO_CMP), 8192, 512, DM}; CmpOrder S{blk, G}; EpiPQ E{(float*)(ws + WS_PQ)};
            pg8::gemm_phase<EpiPQ, CmpOrder, false, true>(L, g, S, E, tid);
            { const int nb = (G > 32) ? 32 : 0; if (blk >= nb) { mlstm_conv_pass(ws, args.in[11] + (size_t)l_ * 4 * 1024, args.in[12] + (size_t)l_ * 1024, (blk - nb) * 512 + tid, (G - nb) * 512); } } }
        SEAM(pb + 4);
        if (IN(pb + 5)) {
            PH_IDS();
            const float* b1T = (const float*)(ws + WS_TAB + TAB_B1); const float* PQ = (const float*)(ws + WS_PQ); bf16* CC = (bf16*)(ws + WS_CC);
            LAS float* w2s = (LAS float*)L; LAS float* hs = (LAS float*)(L + 32768) + wave * 4 * 128;
            for (int item = blk; item < 256; item += G) {
                const int kv = item >> 7, r0 = (item & 127) * 32 + wave * 4;
                const float* w2 = args.in[10] + (size_t)(l_ * 2 + kv) * 128 * 64; const float* b1 = b1T + (l_ * 2 + kv) * 128;
                __syncthreads();
                for (int i = tid; i < 128 * 64 / 4; i += 512) ((LAS f32x4*)w2s)[i] = ((const f32x4*)w2)[i];
#pragma unroll
                for (int rr = 0; rr < 4; ++rr) { const int r = kv * 4096 + r0 + rr, n = (r0 + rr) & 127;
#pragma unroll
                    for (int q2 = 0; q2 < 2; ++q2) { const int c = lane + 64 * q2; float hval = 0.f;
                        if (n != 127) { const float v = PQ[(size_t)r * 256 + c] + PQ[(size_t)(r + 1) * 256 + 128 + c] + b1[c];
                            const float u3 = 0.7978845608028654f * (v + 0.044715f * v * v * v); hval = 0.5f * v * (1.f + tanhf(u3)); }
                        hs[rr * 128 + c] = hval; } }
                __syncthreads();
                float o0 = 0.f, o1 = 0.f, o2 = 0.f, o3 = 0.f;
#pragma unroll 8
                for (int c = 0; c < 128; ++c) { const float wv = w2s[c * 64 + lane]; o0 += hs[c] * wv; o1 += hs[128 + c] * wv; o2 += hs[256 + c] * wv; o3 += hs[384 + c] * wv; }
                bf16* cp = CC + ((size_t)kv * 4096 + r0) * 64 + lane;
                cp[0] = (bf16)f2bf(o0); cp[64] = (bf16)f2bf(o1); cp[128] = (bf16)f2bf(o2); cp[192] = (bf16)f2bf(o3);
            }
        }
        SEAM(pb + 5);
        if (IN(pb + 6)) {
            PH_IDS();
            MixPtrs P{ws, args.in[11] + (size_t)l * 4 * 1024, args.in[12] + (size_t)l * 1024, args.in[13] + l * 4, args.in[14] + l * 4, args.in[15] + l * 512};
#ifndef PROBE_MIX_REP
#define PROBE_MIX_REP 1
#endif
            for (int rep = 0; rep < PROBE_MIX_REP; ++rep) {
            for (int u = blk; u < 64; u += G) mlstm_unit_mfma(L, P, u >> 2, u & 3, tid);
            { unsigned* qbase = (unsigned*)(ws + WS_CTL) + CW_QUEUE + 1024 * l_; volatile LAS unsigned* QW = (volatile LAS unsigned*)(L + MISC_OFF);
              const unsigned q0 = xb_xcc_id() & 7u;
#pragma unroll 1
              for (unsigned qq = 0; qq < 8u; ++qq) { unsigned* qctr = qbase + 64 * ((q0 + qq) & 7u); const int bg0 = 4 * (int)((q0 + qq) & 7u);
                  __syncthreads();
                  if (tid == 0) QW[0] = __hip_atomic_fetch_add(qctr, 1u, __ATOMIC_RELAXED, __HIP_MEMORY_SCOPE_AGENT);
                  __syncthreads();
                  unsigned u = QW[0];
                  while (u < 128u) { unsigned nxt = 0u; if (tid == 0) nxt = __hip_atomic_fetch_add(qctr, 1u, __ATOMIC_RELAXED, __HIP_MEMORY_SCOPE_AGENT);
                      const int c = 31 - (int)(u & 31u), bg = bg0 + (int)(u >> 5); nsa_unit_mfma(L, P, bg >> 1, bg & 1, c, tid);
                      __syncthreads(); if (tid == 0) QW[0] = nxt; __syncthreads(); u = QW[0]; } } }
            }
        }
        SEAM(pb + 6);
        if (IN(pb + 7)) { PH_IDS(); pg8::Gemm g{U, (const bf16*)(wl + WO_OUT), MTOK, DM, DM}; pg8::StaticOrder S; S.init(MTOK, DM, G, blk); pg8::EpiBf16<0> E{HD, DM, nullptr, 0, 0, 1.f};
            pg8::gemm_phase<pg8::EpiBf16<0>, pg8::StaticOrder, true, true>(L, g, S, E, tid); }
        SEAM(pb + 7);
        if (IN(pb + 8)) { PH_IDS(); thin_phase<1>(HD, nullptr, X16, nullptr, R2, ng + 3 * DM, 1.0f, gw, NGW, lane); }
        SEAM(pb + 8);
        if (IN(pb + 9)) { PH_IDS(); pg8::Gemm g{X16, (const bf16*)(wl + WO_GU2), MTOK, NGU, DM}; pg8::StaticOrder S; S.init(MTOK, NGU, G, blk); EpiSwiglu E{HB, R2};
            pg8::gemm_phase<EpiSwiglu, pg8::StaticOrder, true, true>(L, g, S, E, tid); }
        SEAM(pb + 9);
        if (IN(pb + 10)) { PH_IDS(); pg8::Gemm g{HB, (const bf16*)(wl + WO_DN2), MTOK, DM, FF}; pg8::StaticOrder S; S.init(MTOK, DM, G, blk); pg8::EpiBf16<0> E{HD, DM, nullptr, 0, 0, 1.f};
            pg8::gemm_phase<pg8::EpiBf16<0>, pg8::StaticOrder, true, true>(L, g, S, E, tid); }
        SEAM(pb + 10);
        if (IN(pb + 11)) { PH_IDS(); if (l + 1 < DEPTH) { thin_phase<1>(HD, nullptr, X16, nullptr, R2, ng + 5 * DM, 0.5f, gw, NGW, lane); CONVERT_WEIGHTS(l_ + 1); }
                           else thin_phase<2>(HD, nullptr, X16, args.out, nullptr, ng + 5 * DM, 0.5f, gw, NGW, lane); }
        if (l + 1 < DEPTH) SEAM(pb + 11);
    }
#undef IN
#undef SEAM
#undef CONVERT_WEIGHTS
#undef PH_IDS
#undef PH_WS
}

extern "C" void kernel_launch(void* const* d_in, const int* in_sizes, int n_in, void* d_out, int out_size, void* d_ws, size_t ws_size, hipStream_t stream) {
    static int grid = 0;
    if (grid == 0) {
        if (n_in != 16 || in_sizes[0] != MTOK * DM || out_size != MTOK * DM || ws_size < WS_END2) { fprintf(stderr, "kernel_launch: unexpected problem (n_in %d, ws %zu)\n", n_in, ws_size); grid = -1; return; }
        int dev = 0, cus = 0, per_cu = 0;
        if (hipGetDevice(&dev) != hipSuccess || hipDeviceGetAttribute(&cus, hipDeviceAttributeMultiprocessorCount, dev) != hipSuccess) { grid = -1; return; }
        if (hipFuncSetAttribute((const void*)fwd_kernel, hipFuncAttributeMaxDynamicSharedMemorySize, LDS_BYTES) != hipSuccess) { grid = -1; return; }
        if (hipOccupancyMaxActiveBlocksPerMultiprocessor(&per_cu, (const void*)fwd_kernel, NWAVES * 64, LDS_BYTES) != hipSuccess || per_cu < 1) { fprintf(stderr, "kernel_launch: occupancy query says %d\n", per_cu); }
        (void)hipGetLastError();
        grid = cus;
    }
    if (grid < 0) return;
    (void)hipMemsetAsync((char*)d_ws + WS_CTL, 0, CTL_ZERO_BYTES, stream);
    Args a{};
    for (int i = 0; i < 16; ++i) a.in[i] = (const float*)d_in[i];
    a.out = (float*)d_out; a.ws = (unsigned char*)d_ws;
#if MK_MULTI
    for (int p = 0; p < N_PHASES; ++p) { a.ph_lo = p; a.ph_hi = p + 1; hipLaunchKernelGGL(fwd_kernel, dim3(grid), dim3(NWAVES * 64), LDS_BYTES, stream, a); }
#else
    a.ph_lo = 0; a.ph_hi = N_PHASES; hipLaunchKernelGGL(fwd_kernel, dim3(grid), dim3(NWAVES * 64), LDS_BYTES, stream, a);
#endif
}
```

```cpp
#include <hip/hip_runtime.h>
#include <cstdio>
#include <cstdint>
namespace pg8 {
#define PG8_LAS __attribute__((address_space(3)))
typedef unsigned short bf16_t;
typedef short bf16x8 __attribute__((ext_vector_type(8)));
typedef float f32x4 __attribute__((ext_vector_type(4)));
typedef unsigned u32x4 __attribute__((ext_vector_type(4)));
constexpr int BM = 256, BK = 64, HALF = 128, HTB = HALF * BK * 2  , STAGE_BYTES = 8 * HTB, NXCD = 8, WGM = 4;

__host__ __device__ __forceinline__ int lds_byte(int r, int c) { const int st = (r >> 4) * 2 + (c >> 5), rr = r & 15, cc = c & 31, ob = rr * 64 + cc * 2; return st * 1024 + (ob ^ (((ob >> 9) & 1) << 5)); }
__host__ __device__ __forceinline__ void stage_rc(int b, int& R, int& C) { const int st = b / 1024, sb = b % 1024, swz = sb ^ (((sb >> 9) & 1) << 5); R = (st >> 1) * 16 + swz / 64; C = (st & 1) * 32 + (swz % 64) / 2; }
__host__ __device__ __forceinline__ int perm32(int rho) { const int n = rho >> 4, i = rho & 15; return 8 * (i >> 2) + 4 * n + (i & 3); }

struct Unit { int pm, pn; };
struct Gemm { const bf16_t* A; const bf16_t* Bt; int M, N, K; };

struct StaticOrder {
    int nM, nN, nwg, G, c;
    __host__ __device__ void init(int M, int N, int G_, int c_) { nM = M / BM; nN = N / BM; nwg = nM * nN; G = G_; c = c_; }
    __host__ __device__ bool next(int i, Unit& u) const {
        const long L = (long)i * G + c; if (L >= nwg) return false;
        int wgid = (int)L; { const int q = nwg / NXCD, r = nwg % NXCD, xcd = wgid % NXCD, off = wgid / NXCD; wgid = (xcd < r ? xcd * (q + 1) : r * (q + 1) + (xcd - r) * q) + off; }
        const int nig = WGM * nN, gid = wgid / nig, fm = gid * WGM, gsz = (nM - fm) < WGM ? (nM - fm) : WGM;
        u.pm = fm + ((wgid % nig) % gsz); u.pn = (wgid % nig) / gsz; return true;
    }
    __device__ __forceinline__ void a_ready(const Unit&) const {}
    __device__ __forceinline__ void done(const Unit&) const {}
};

__device__ __forceinline__ unsigned cvt_pk_bf16(float lo, float hi) { unsigned r; asm volatile("v_cvt_pk_bf16_f32 %0, %1, %2" : "=v"(r) : "v"(lo), "v"(hi)); return r; }
typedef float f32x2 __attribute__((ext_vector_type(2)));
__device__ __forceinline__ f32x2 gelu_pk(f32x2 v) {
    const f32x2 av = __builtin_elementwise_abs(v), d = av * 0.2316418882f + 1.0f;
    f32x2 t; t.x = __builtin_amdgcn_rcpf(d.x); t.y = __builtin_amdgcn_rcpf(d.y);
    f32x2 q = t * 0.5307027145f + (-0.7265760135f); q = q * t + 0.7107068705f; q = q * t + (-0.142248368f); q = q * t + 0.127414796f; q = q * t;
    const f32x2 s = (v * v) * (-0.72134752044f);
    f32x2 e; e.x = __builtin_amdgcn_exp2f(s.x); e.y = __builtin_amdgcn_exp2f(s.y);
    const f32x2 m = v * (q * e), r = v - m;
    f32x2 o; o.x = v.x < 0.f ? m.x : r.x; o.y = v.y < 0.f ? m.y : r.y; return o;
}

template <int ACT  > struct EpiBf16 {
    static constexpr bool PERM = true, AFTER_DRAIN = false; static_assert(ACT == 0 || ACT == 1, "EpiBf16: ACT is 0 (none) or 1 (gelu_pk)");
    bf16_t* O; int ldc; const float* bias; int split_cols; size_t split_stride; float scale0;
    __device__ __forceinline__ void operator()(const f32x4 (&acc)[2][2][4][2], const Unit& u, int wr, int wc, int fr, int fq) const {
        const int row0 = u.pm * BM + wr * 64 + fr; int colt = u.pn * BM; bf16_t* base = O;
        float sc = 1.f; if (split_cols) { const int t = colt / split_cols; base += (size_t)t * split_stride; colt -= t * split_cols; if (t == 0) sc = scale0; }
        const int col0 = colt + wc * 32 + 8 * fq, bcol0 = u.pn * BM + wc * 32 + 8 * fq;
        f32x4 bv[2][2];
#pragma unroll
        for (int bj = 0; bj < 2; ++bj)
#pragma unroll
            for (int n = 0; n < 2; ++n) bv[bj][n] = bias ? *(const f32x4*)(bias + bcol0 + bj * HALF + 4 * n) : (f32x4){0.f, 0.f, 0.f, 0.f};
#pragma unroll
        for (int ai = 0; ai < 2; ++ai)
#pragma unroll
            for (int m = 0; m < 4; ++m) { bf16_t* rowp = base + (size_t)(row0 + ai * HALF + m * 16) * ldc + col0;
#pragma unroll
                for (int bj = 0; bj < 2; ++bj) { f32x4 v0 = acc[ai][bj][m][0] + bv[bj][0], v1 = acc[ai][bj][m][1] + bv[bj][1];
                    if (ACT == 1) { f32x2 a = gelu_pk((f32x2){v0[0], v0[1]}), b = gelu_pk((f32x2){v0[2], v0[3]}), c = gelu_pk((f32x2){v1[0], v1[1]}), d = gelu_pk((f32x2){v1[2], v1[3]});
                        v0 = (f32x4){a.x, a.y, b.x, b.y}; v1 = (f32x4){c.x, c.y, d.x, d.y}; }
                    v0 = v0 * sc; v1 = v1 * sc; u32x4 w; w.x = cvt_pk_bf16(v0[0], v0[1]); w.y = cvt_pk_bf16(v0[2], v0[3]); w.z = cvt_pk_bf16(v1[0], v1[1]); w.w = cvt_pk_bf16(v1[2], v1[3]);
                    *(u32x4*)(rowp + bj * HALF) = w; } }
    }
};
template <class Epi, class Sched, bool ALIGN_EPI = false, bool SP2 = false>
__device__ __forceinline__ void gemm_phase(PG8_LAS unsigned char* lds, const Gemm g, const Sched& S, const Epi& E, int tid_in) {
    int tid_l = tid_in; asm volatile("" : "+v"(tid_l));
    const int tid = tid_l, wid = __builtin_amdgcn_readfirstlane(tid >> 6), lane = tid & 63, wr = wid >> 2, wc = wid & 3, fr = lane & 15, fq = lane >> 4;
    const int K = g.K, nt = K / BK;
    unsigned voffA[2], voffB[2];
#pragma unroll
    for (int i = 0; i < 2; ++i) { int R, C; stage_rc(tid * 16 + i * 8192, R, C); const int Rb = Epi::PERM ? ((R & ~31) + perm32(R & 31)) : R;
        voffA[i] = (unsigned)(R * K + C) * 2u; voffB[i] = (unsigned)(Rb * K + C) * 2u; }
    const size_t kstep = (size_t)(BK * 2);
    const size_t hstep = (size_t)HALF * K * 2;
    const size_t tstep = 2 * hstep;
    const unsigned ldsw = (unsigned)wid * 1024u;
    const int aoff = lds_byte(wr * 64 + fr, fq * 8), boff = lds_byte(wc * 32 + fr, fq * 8);
#define PG8_SA(b, h) (((b) * 2 + (h)) * HTB)
#define PG8_SB(b, h) ((4 + (b) * 2 + (h)) * HTB)
#define PG8_STAGE(bufoff, gbase, voff) do { _Pragma("unroll") for (int _i = 0; _i < 2; ++_i) \
        __builtin_amdgcn_global_load_lds((const unsigned*)((const char*)(gbase) + (voff)[_i]), (PG8_LAS unsigned*)(lds + (bufoff) + ldsw + _i * 8192), 16, 0, 0); } while (0)
#define PG8_LDA(dst, b, h) do { _Pragma("unroll") for (int m = 0; m < 4; ++m) _Pragma("unroll") for (int k = 0; k < 2; ++k) dst[m][k] = *(const PG8_LAS bf16x8*)(lds + PG8_SA(b, h) + aoff + m * 2048 + k * 1024); } while (0)
#define PG8_LDB(dst, b, h) do { _Pragma("unroll") for (int n = 0; n < 2; ++n) _Pragma("unroll") for (int k = 0; k < 2; ++k) dst[n][k] = *(const PG8_LAS bf16x8*)(lds + PG8_SB(b, h) + boff + n * 2048 + k * 1024); } while (0)
#define PG8_MMA(ai, bj, At, Bt) do { __builtin_amdgcn_s_setprio(1); _Pragma("unroll") for (int m = 0; m < 4; ++m) _Pragma("unroll") for (int n = 0; n < 2; ++n) _Pragma("unroll") for (int k = 0; k < 2; ++k) \
        acc[ai][bj][m][n] = __builtin_amdgcn_mfma_f32_16x16x32_bf16(Bt[n][k], At[m][k], acc[ai][bj][m][n], 0, 0, 0); __builtin_amdgcn_s_setprio(0); } while (0)
#define PG8_WAIT_V(n) asm volatile("s_waitcnt vmcnt(" #n ")" ::: "memory")
#define PG8_WAIT_L(n) asm volatile("s_waitcnt lgkmcnt(" #n ")" ::: "memory")
#define PG8_BAR __builtin_amdgcn_s_barrier()
#define PG8_SCHED __builtin_amdgcn_sched_barrier(0)
    Unit cur, nxt; int ui = 0;
    if (!S.next(0, cur)) return;
    f32x4 acc[2][2][4][2];
#pragma unroll
    for (int a = 0; a < 2; ++a)
#pragma unroll
        for (int b = 0; b < 2; ++b)
#pragma unroll
            for (int m = 0; m < 4; ++m)
#pragma unroll
                for (int n = 0; n < 2; ++n) acc[a][b][m][n] = (f32x4){0.f, 0.f, 0.f, 0.f};
    bf16x8 At[4][2], B0[2][2], B1[2][2];
    const char* cA = (const char*)g.A + (size_t)cur.pm * tstep; const char* cB = (const char*)g.Bt + (size_t)cur.pn * tstep;
    S.a_ready(cur);
    if constexpr (SP2) {
        PG8_STAGE(PG8_SB(0, 0), cB, voffB); PG8_STAGE(PG8_SB(0, 1), cB + hstep, voffB); PG8_STAGE(PG8_SA(0, 0), cA, voffA); PG8_STAGE(PG8_SA(0, 1), cA + hstep, voffA);
        if (wr == 1) PG8_BAR;
        PG8_WAIT_V(2); PG8_BAR;
        PG8_STAGE(PG8_SB(1, 0), cB + kstep, voffB); PG8_STAGE(PG8_SA(1, 0), cA + kstep, voffA); PG8_STAGE(PG8_SB(1, 1), cB + hstep + kstep, voffB);
        PG8_WAIT_V(6); PG8_BAR;
    } else {
        PG8_STAGE(PG8_SB(0, 0), cB, voffB); PG8_STAGE(PG8_SA(0, 0), cA, voffA); PG8_STAGE(PG8_SB(0, 1), cB + hstep, voffB); PG8_STAGE(PG8_SA(0, 1), cA + hstep, voffA);
        if (wr == 1) PG8_BAR;
        PG8_WAIT_V(4); PG8_BAR;
        PG8_STAGE(PG8_SB(1, 0), cB + kstep, voffB); PG8_STAGE(PG8_SA(1, 0), cA + kstep, voffA); PG8_STAGE(PG8_SB(1, 1), cB + hstep + kstep, voffB);
        PG8_WAIT_V(6); PG8_BAR;
    }
    for (;;) {
        const bool has_next = S.next(ui + 1, nxt);
        const char* nA = has_next ? (const char*)g.A + (size_t)nxt.pm * tstep : cA; const char* nB = has_next ? (const char*)g.Bt + (size_t)nxt.pn * tstep : cB;
        for (int t = 0; t < nt; t += 2) {
            const bool last = (t == nt - 2);
            const char* a1 = cA + (size_t)(t + 1) * kstep;
            const char* a2 = last ? nA : cA + (size_t)(t + 2) * kstep; const char* b2 = last ? nB : cB + (size_t)(t + 2) * kstep;
            const char* a3 = a2 + kstep; const char* b3 = b2 + kstep;
            if (last && has_next) S.a_ready(nxt);
            if constexpr (SP2) {
            PG8_LDB(B0, 0, 0); PG8_LDB(B1, 0, 1); PG8_SCHED; PG8_LDA(At, 0, 0); PG8_STAGE(PG8_SA(1, 1), a1 + hstep, voffA);
            PG8_WAIT_V(8); PG8_WAIT_L(0); PG8_BAR; PG8_MMA(0, 0, At, B0); PG8_MMA(0, 1, At, B1); PG8_BAR; PG8_SCHED;
            PG8_LDA(At, 0, 1); PG8_STAGE(PG8_SB(0, 0), b2, voffB); PG8_STAGE(PG8_SB(0, 1), b2 + hstep, voffB); PG8_STAGE(PG8_SA(0, 0), a2, voffA);
            PG8_WAIT_V(8); PG8_WAIT_L(0); PG8_BAR; PG8_MMA(1, 0, At, B0); PG8_MMA(1, 1, At, B1); PG8_BAR; PG8_SCHED;
            PG8_LDB(B0, 1, 0); PG8_LDB(B1, 1, 1); PG8_SCHED; PG8_LDA(At, 1, 0); PG8_STAGE(PG8_SA(0, 1), a2 + hstep, voffA);
            PG8_WAIT_V(8); PG8_WAIT_L(0); PG8_BAR; PG8_MMA(0, 0, At, B0); PG8_MMA(0, 1, At, B1); PG8_BAR; PG8_SCHED;
            PG8_LDA(At, 1, 1); PG8_STAGE(PG8_SB(1, 0), b3, voffB); PG8_STAGE(PG8_SB(1, 1), b3 + hstep, voffB); PG8_STAGE(PG8_SA(1, 0), a3, voffA);
            PG8_WAIT_V(8); PG8_WAIT_L(0); PG8_BAR; PG8_MMA(1, 0, At, B0); PG8_MMA(1, 1, At, B1); PG8_BAR; PG8_SCHED;
            } else {
            PG8_LDB(B0, 0, 0); PG8_SCHED; PG8_LDA(At, 0, 0); PG8_STAGE(PG8_SA(1, 1), a1 + hstep, voffA);
            PG8_WAIT_L(8); PG8_BAR; PG8_WAIT_L(0); PG8_MMA(0, 0, At, B0); PG8_BAR; PG8_SCHED;
            PG8_LDB(B1, 0, 1); PG8_STAGE(PG8_SB(0, 0), b2, voffB);
            PG8_BAR; PG8_WAIT_L(0); PG8_MMA(0, 1, At, B1); PG8_BAR;
            PG8_LDA(At, 0, 1); PG8_STAGE(PG8_SA(0, 0), a2, voffA);
            PG8_BAR; PG8_WAIT_L(0); PG8_MMA(1, 0, At, B0); PG8_BAR; PG8_SCHED;
            PG8_STAGE(PG8_SB(0, 1), b2 + hstep, voffB);
            PG8_WAIT_V(6); PG8_BAR; PG8_MMA(1, 1, At, B1); PG8_BAR;
            PG8_LDB(B0, 1, 0); PG8_SCHED; PG8_LDA(At, 1, 0); PG8_STAGE(PG8_SA(0, 1), a2 + hstep, voffA);
            PG8_WAIT_L(8); PG8_BAR; PG8_WAIT_L(0); PG8_MMA(0, 0, At, B0); PG8_BAR; PG8_SCHED;
            PG8_LDB(B1, 1, 1); PG8_STAGE(PG8_SB(1, 0), b3, voffB);
            PG8_BAR; PG8_WAIT_L(0); PG8_MMA(0, 1, At, B1); PG8_BAR;
            PG8_LDA(At, 1, 1); PG8_STAGE(PG8_SA(1, 0), a3, voffA);
            PG8_BAR; PG8_WAIT_L(0); PG8_MMA(1, 0, At, B0); PG8_BAR; PG8_SCHED;
            PG8_STAGE(PG8_SB(1, 1), b3 + hstep, voffB);
            PG8_WAIT_V(6); PG8_BAR; PG8_MMA(1, 1, At, B1); PG8_BAR;
            }
        }
        if constexpr (ALIGN_EPI) { if (wr == 0) PG8_BAR; }
        if constexpr (!Epi::AFTER_DRAIN) { E(acc, cur, wr, wc, fr, fq); S.done(cur); }
        if (!has_next) break;
#pragma unroll
        for (int a = 0; a < 2; ++a)
#pragma unroll
            for (int b = 0; b < 2; ++b)
#pragma unroll
                for (int m = 0; m < 4; ++m)
#pragma unroll
                    for (int n = 0; n < 2; ++n) acc[a][b][m][n] = (f32x4){0.f, 0.f, 0.f, 0.f};
        cur = nxt; cA = nA; cB = nB; ++ui;
        if constexpr (ALIGN_EPI) { if (wr == 1) PG8_BAR; }
    }
    PG8_WAIT_V(0);
    if constexpr (!ALIGN_EPI) { if (wr == 0) PG8_BAR; }
    PG8_BAR;
    if constexpr (Epi::AFTER_DRAIN) { E.fused(acc, cur, wr, wc, fr, fq, lds, wid, lane); S.done(cur); }
#undef PG8_SA
#undef PG8_SB
#undef PG8_STAGE
#undef PG8_LDA
#undef PG8_LDB
#undef PG8_MMA
#undef PG8_WAIT_V
#undef PG8_WAIT_L
#undef PG8_BAR
#undef PG8_SCHED
}
}

#define LAS __attribute__((address_space(3)))
#define XB_TMO      128
#define XB_XCNT(j)  (256  + 64 * (j))
#define XB_XSUB(j)  (1280 + 64 * (j))
#define XB_XGEN(j)  (2304 + 64 * (j))
#define XB_TOP      3328
#define XB_TOPGEN   3392
#define XCD_BAR_WORDS 3456
#define XB_SPIN_CAP (1u << 18)

__device__ __forceinline__ unsigned xb_ld(unsigned* p)              { return __hip_atomic_load(p, __ATOMIC_RELAXED, __HIP_MEMORY_SCOPE_AGENT); }
__device__ __forceinline__ unsigned xb_add(unsigned* p, unsigned v) { return __hip_atomic_fetch_add(p, v, __ATOMIC_RELAXED, __HIP_MEMORY_SCOPE_AGENT); }
__device__ __forceinline__ unsigned xb_xcc_id() { return (unsigned)__builtin_amdgcn_s_getreg((3 << 11) | 20) & 0xFu; }
#define XB_SPIN(cond, bar) do { unsigned _sp = 0; while (cond) { __builtin_amdgcn_s_sleep(1); \
    if ((++_sp & 255u) == 0u) { if (xb_ld(&(bar)[XB_TMO])) break; if (_sp > XB_SPIN_CAP) { atomicAdd(&(bar)[XB_TMO], 1u); break; } } } } while (0)

struct XcdBarrier {
    unsigned* bar; unsigned x;
    volatile LAS unsigned* st;
};

__device__ __forceinline__ XcdBarrier xcd_barrier_post(unsigned* bar, volatile LAS unsigned* st, bool leader) {
    XcdBarrier b; b.bar = bar; b.x = xb_xcc_id(); b.st = st;
    if (leader) (void)xb_add(&bar[XB_XCNT(b.x)], 1u);
    return b;
}
__device__ __forceinline__ void xcd_barrier_complete(unsigned* bar, unsigned x, unsigned& nloc, unsigned& nx) {
    const unsigned G = gridDim.x * gridDim.y * gridDim.z;
    unsigned sum, cnt, mine, sp = 0u;
    for (;;) {
        sum = 0u; cnt = 0u; mine = 0u;
#pragma unroll
        for (unsigned j = 0; j < 16; ++j) { const unsigned c = xb_ld(&bar[XB_XCNT(j)]); sum += c; cnt += (c > 0u) ? 1u : 0u; mine = (j == x) ? c : mine; }
        if (sum == G) break;
        __builtin_amdgcn_s_sleep(1);
        if ((++sp & 255u) == 0u) { if (xb_ld(&bar[XB_TMO])) break; if (sp > XB_SPIN_CAP) { atomicAdd(&bar[XB_TMO], 1u); break; } }
    }
    nloc = mine > 0u ? mine : 1u; nx = cnt > 0u ? cnt : 1u;
}

__device__ __forceinline__ void xcd_barrier(const XcdBarrier& b, bool leader) {
    asm volatile("s_waitcnt vmcnt(0)" ::: "memory");
    __syncthreads();
    if (leader) {
        unsigned* bar = b.bar;
        __builtin_amdgcn_s_waitcnt(0);
        unsigned nloc = b.st[0], nx = b.st[1];
        if (nloc == 0u) { xcd_barrier_complete(bar, b.x, nloc, nx); b.st[0] = nloc; b.st[1] = nx; }
        const unsigned old = xb_add(&bar[XB_XSUB(b.x)], 1u);
        const unsigned gen = old / nloc;
        if (old + 1u == (gen + 1u) * nloc) {
            __builtin_amdgcn_fence(__ATOMIC_RELEASE, "agent");
            asm volatile("s_waitcnt vmcnt(0)" ::: "memory");
            const unsigned og = xb_add(&bar[XB_TOP], 1u);
            const unsigned tg = og / nx;
            if (og + 1u == (tg + 1u) * nx) xb_add(&bar[XB_TOPGEN], 1u);
            else XB_SPIN(xb_ld(&bar[XB_TOPGEN]) == tg, bar);
            __builtin_amdgcn_fence(__ATOMIC_ACQUIRE, "agent");
            xb_add(&bar[XB_XGEN(b.x)], 1u);
            asm volatile("s_waitcnt vmcnt(0)" ::: "memory");
        } else {
            XB_SPIN(xb_ld(&bar[XB_XGEN(b.x)]) == gen, bar);
            __builtin_amdgcn_fence(__ATOMIC_ACQUIRE, "agent");
            asm volatile("s_waitcnt vmcnt(0)" ::: "memory");
        }
    }
    __syncthreads();
}

constexpr int BATCH = 16, SEQ = 2048, DM = 1024, MTOK = BATCH * SEQ, FF = 2816, NGU = 2 * FF, NINP = 3584, INCOLS = 3360, DEPTH = 2;
constexpr int NWAVES = 8;
constexpr float EPS = 1e-6f;
typedef unsigned short bf16;
typedef unsigned v4u __attribute__((ext_vector_type(4)));
typedef unsigned v2u __attribute__((ext_vector_type(2)));
typedef float f32x4 __attribute__((ext_vector_type(4)));
#define LDS_WAIT() asm volatile("s_waitcnt lgkmcnt(0)" ::: "memory")

constexpr size_t MiB = 1u << 20;
constexpr size_t WS_CTL = 0, CTL_ZERO_BYTES = MiB;
constexpr size_t WS_TAB = 1 * MiB;
constexpr size_t TAB_COS = 0, TAB_SIN = 65536, TAB_B1 = 131072, TAB_R2 = 262144;
constexpr size_t WS_W = 2 * MiB;
constexpr size_t WO_GU1 = 0, WO_DN1 = 11 * MiB, WO_GU2 = 16 * MiB + MiB / 2, WO_DN2 = 27 * MiB + MiB / 2, WO_IN = 33 * MiB, WO_OUT = 40 * MiB, WO_CMP = 42 * MiB;
constexpr size_t WS_X16 = 45 * MiB;
constexpr size_t WS_U = 109 * MiB;
constexpr size_t WS_HB = 173 * MiB;
constexpr size_t WS_HD = 349 * MiB;
constexpr size_t WS_PQ = 413 * MiB;
constexpr size_t WS_CC = 421 * MiB;
constexpr size_t WS_END = 422 * MiB;
constexpr size_t WS_QN = 173 * MiB, WS_KCR = 205 * MiB, WS_VCR = 213 * MiB, WS_KS = 221 * MiB, WS_VS = 229 * MiB, WS_KW = 237 * MiB, WS_VW = 245 * MiB;
constexpr size_t WS_MQ = 253 * MiB, WS_MK = 285 * MiB, WS_MV = 317 * MiB, WS_MO = 349 * MiB, WS_GATE = 381 * MiB;
static_assert(WS_GATE + 4 * MiB <= WS_PQ, "in-projection outputs end below PQ");
constexpr int CW_BAR = 4096, CW_QUEUE = 16384;
constexpr int PH_BYTES = 143360, MISC_OFF = PH_BYTES, LDS_BYTES = 147456;

__device__ __forceinline__ unsigned f2bf(float f) { unsigned u = __builtin_bit_cast(unsigned, f); return (u + 0x7fffu + ((u >> 16) & 1u)) >> 16; }
__device__ __forceinline__ unsigned pk2(float lo, float hi) { return f2bf(lo) | (f2bf(hi) << 16); }
typedef float f32x2v_ __attribute__((ext_vector_type(2))); typedef __bf16 bf16x2v_ __attribute__((ext_vector_type(2)));
__device__ __forceinline__ unsigned cvtpk(float lo, float hi) { f32x2v_ v = {lo, hi}; bf16x2v_ b = __builtin_convertvector(v, bf16x2v_); return __builtin_bit_cast(unsigned, b); }
__device__ __forceinline__ float bflo(unsigned u) { return __builtin_bit_cast(float, u << 16); }
__device__ __forceinline__ float bfhi(unsigned u) { return __builtin_bit_cast(float, u & 0xffff0000u); }
__device__ __forceinline__ float bf2f(bf16 b) { return __builtin_bit_cast(float, (unsigned)b << 16); }
__device__ __forceinline__ float sigmoidf_(float x) { return __builtin_amdgcn_rcpf(1.f + __expf(-x)); }
__device__ __forceinline__ int fresh_lane() { unsigned z = 0u; asm volatile("" : "+v"(z)); return (int)__builtin_amdgcn_mbcnt_hi(~0u, __builtin_amdgcn_mbcnt_lo(~0u, z)); }
__device__ __forceinline__ float shx(float v, int mask, int lane) { return __builtin_bit_cast(float, __builtin_amdgcn_ds_bpermute((lane ^ mask) << 2, __builtin_bit_cast(int, v))); }
__device__ __forceinline__ unsigned shxu(unsigned v, int mask, int lane) { return (unsigned)__builtin_amdgcn_ds_bpermute((lane ^ mask) << 2, (int)v); }
__device__ __forceinline__ float shi(float v, int src) { return __builtin_bit_cast(float, __builtin_amdgcn_ds_bpermute(src << 2, __builtin_bit_cast(int, v))); }
__device__ __forceinline__ float wave_sum(float v, int lane) {
    (void)lane;
    v += __builtin_bit_cast(float, __builtin_amdgcn_update_dpp(0, __builtin_bit_cast(int, v), 0xB1, 0xF, 0xF, false));
    v += __builtin_bit_cast(float, __builtin_amdgcn_update_dpp(0, __builtin_bit_cast(int, v), 0x4E, 0xF, 0xF, false));
    v += __builtin_bit_cast(float, __builtin_amdgcn_update_dpp(0, __builtin_bit_cast(int, v), 0x124, 0xF, 0xF, false));
    v += __builtin_bit_cast(float, __builtin_amdgcn_update_dpp(0, __builtin_bit_cast(int, v), 0x128, 0xF, 0xF, false));
    const int iv = __builtin_bit_cast(int, v);
    const float a = __builtin_bit_cast(float, __builtin_amdgcn_readlane(iv, 0)), b = __builtin_bit_cast(float, __builtin_amdgcn_readlane(iv, 16));
    const float c = __builtin_bit_cast(float, __builtin_amdgcn_readlane(iv, 32)), d = __builtin_bit_cast(float, __builtin_amdgcn_readlane(iv, 48));
    return (a + b) + (c + d);
}

struct SrcGU { const float* W; const float* g; __device__ __forceinline__ float operator()(int k, int nd) const { const int pn = nd >> 8, r = nd & 255; const int col = (r < 128) ? (pn * 128 + r) : (FF + pn * 128 + r - 128); return W[(size_t)k * NGU + col] * g[k]; } };
struct SrcPlain { const float* W; int N; __device__ __forceinline__ float operator()(int k, int nd) const { return W[(size_t)k * N + nd]; } };
struct SrcIN { const float* W; const float* g; __device__ __forceinline__ float operator()(int k, int nd) const {
    const int col = nd < 1280 ? nd : (nd < 3328 ? nd + 24 : (nd < 3352 ? nd - 3328 + 1280 : (nd < 3360 ? nd : -1)));
    return col < 0 ? 0.f : W[(size_t)k * INCOLS + col] * g[k]; } };
struct SrcCMP { const float* W1; __device__ __forceinline__ float operator()(int k, int nd) const { const int kv = nd >> 8, r = nd & 255;
    return r < 128 ? W1[((size_t)kv * 2048 + k) * 128 + r] : W1[((size_t)kv * 2048 + 1024 + k) * 128 + r - 128]; } };

template <class SrcF>
__device__ __forceinline__ void transpose_item(const SrcF& src, int K, bf16* WT, LAS float* scr, int kb, int nb, int lane) {
    const int k0 = 64 * kb, n0 = 32 * nb;
#pragma unroll 8
    for (int i = 0; i < 32; ++i) { const int kk = 2 * i + (lane >> 5); scr[kk * 33 + (lane & 31)] = src(k0 + kk, n0 + (lane & 31)); }
    LDS_WAIT(); asm volatile("" ::: "memory");
    const int c = lane & 7;
#pragma unroll
    for (int j = 0; j < 4; ++j) { const int n = (lane >> 3) + 8 * j; const LAS float* s = scr + (8 * c) * 33 + n;
        v4u o; o.x = pk2(s[0 * 33], s[1 * 33]); o.y = pk2(s[2 * 33], s[3 * 33]); o.z = pk2(s[4 * 33], s[5 * 33]); o.w = pk2(s[6 * 33], s[7 * 33]);
        *(v4u*)(WT + (size_t)(n0 + n) * K + k0 + 8 * c) = o; }
    LDS_WAIT(); asm volatile("" ::: "memory");
}

template <int MODE>
__device__ __forceinline__ void thin_phase(const bf16* HD, const float* xin_f32, bf16* X16, float* out_f32, float* R2, const float* gpost, float cc, int gw, int NGW, int lane) {
    f32x4 gp[4];
#pragma unroll
    for (int j = 0; j < 4; ++j) gp[j] = (MODE != 0) ? *(const f32x4*)(gpost + 4 * lane + 256 * j) : (f32x4){0.f, 0.f, 0.f, 0.f};
    f32x4 xf[4]; v2u xn[4], hn[4];
    if (gw < MTOK) {
#pragma unroll
        for (int j = 0; j < 4; ++j) { if (MODE == 0) xf[j] = *(const f32x4*)(xin_f32 + (size_t)gw * DM + 4 * lane + 256 * j);
            else { xn[j] = *(const v2u*)(X16 + (size_t)gw * DM + 4 * lane + 256 * j); hn[j] = *(const v2u*)(HD + (size_t)gw * DM + 4 * lane + 256 * j); } }
    }
    for (int m = gw; m < MTOK; m += NGW) {
        f32x4 x[4]; v2u hw[4];
#pragma unroll
        for (int j = 0; j < 4; ++j) { if (MODE == 0) x[j] = xf[j]; else { x[j] = (f32x4){bflo(xn[j].x), bfhi(xn[j].x), bflo(xn[j].y), bfhi(xn[j].y)}; hw[j] = hn[j]; } }
        const int m2 = m + NGW;
        if (m2 < MTOK) {
#pragma unroll
            for (int j = 0; j < 4; ++j) { if (MODE == 0) xf[j] = *(const f32x4*)(xin_f32 + (size_t)m2 * DM + 4 * lane + 256 * j);
                else { xn[j] = *(const v2u*)(X16 + (size_t)m2 * DM + 4 * lane + 256 * j); hn[j] = *(const v2u*)(HD + (size_t)m2 * DM + 4 * lane + 256 * j); } }
        }
        if (MODE != 0) {
            f32x4 h[4]; float ss = 0.f;
#pragma unroll
            for (int j = 0; j < 4; ++j) { h[j] = (f32x4){bflo(hw[j].x), bfhi(hw[j].x), bflo(hw[j].y), bfhi(hw[j].y)}; ss += (h[j].x * h[j].x + h[j].y * h[j].y) + (h[j].z * h[j].z + h[j].w * h[j].w); }
            const float r = cc * __frsqrt_rn(wave_sum(ss, lane) * (1.f / DM) + EPS);
#pragma unroll
            for (int j = 0; j < 4; ++j) x[j] = x[j] + (h[j] * r) * gp[j];
        }
        if (MODE == 2) {
#pragma unroll
            for (int j = 0; j < 4; ++j) *(f32x4*)(out_f32 + (size_t)m * DM + 4 * lane + 256 * j) = x[j];
        } else {
            float s2 = 0.f;
#pragma unroll
            for (int j = 0; j < 4; ++j) { s2 += (x[j].x * x[j].x + x[j].y * x[j].y) + (x[j].z * x[j].z + x[j].w * x[j].w);
                v2u w; w.x = cvtpk(x[j].x, x[j].y); w.y = cvtpk(x[j].z, x[j].w); *(v2u*)(X16 + (size_t)m * DM + 4 * lane + 256 * j) = w; }
            const float r2 = __frsqrt_rn(wave_sum(s2, lane) * (1.f / DM) + EPS);
            if (lane == 0) R2[m] = r2;
        }
    }
}

struct EpiSwiglu {
    static constexpr bool PERM = true, AFTER_DRAIN = false;
    bf16* H; const float* R2;
    __device__ __forceinline__ void operator()(const pg8::f32x4 (&acc)[2][2][4][2], const pg8::Unit& u, int wr, int wc, int fr, int fq) const {
#pragma unroll
        for (int ai = 0; ai < 2; ++ai)
#pragma unroll
            for (int m = 0; m < 4; ++m) {
                const int row = u.pm * 256 + ai * 128 + wr * 64 + m * 16 + fr; const float rs = R2[row];
                typedef float f2 __attribute__((ext_vector_type(2)));
                f2 tg[4], tu[4], ex[4]; float o[8];
#pragma unroll
                for (int n = 0; n < 2; ++n) { const pg8::f32x4 g4 = acc[ai][0][m][n], u4 = acc[ai][1][m][n];
                    tg[2 * n] = (f2){g4[0], g4[1]} * rs; tg[2 * n + 1] = (f2){g4[2], g4[3]} * rs; tu[2 * n] = (f2){u4[0], u4[1]} * rs; tu[2 * n + 1] = (f2){u4[2], u4[3]} * rs; }
#pragma unroll
                for (int e = 0; e < 4; ++e) { const f2 a2 = tg[e] * -1.4426950408889634f; ex[e].x = __builtin_amdgcn_exp2f(a2.x); ex[e].y = __builtin_amdgcn_exp2f(a2.y); }
#pragma unroll
                for (int e = 0; e < 4; ++e) { const f2 d2 = ex[e] + 1.0f; ex[e].x = __builtin_amdgcn_rcpf(d2.x); ex[e].y = __builtin_amdgcn_rcpf(d2.y); tu[e] = tg[e] * tu[e]; }
#pragma unroll
                for (int e = 0; e < 4; ++e) { const f2 r2 = tu[e] * ex[e]; o[2 * e] = r2.x; o[2 * e + 1] = r2.y; }
                v4u w; w.x = pg8::cvt_pk_bf16(o[0], o[1]); w.y = pg8::cvt_pk_bf16(o[2], o[3]); w.z = pg8::cvt_pk_bf16(o[4], o[5]); w.w = pg8::cvt_pk_bf16(o[6], o[7]);
                *(v4u*)(H + (size_t)row * FF + u.pn * 128 + wc * 32 + fq * 8) = w;
            }
    }
};
struct EpiPQ {
    static constexpr bool PERM = true, AFTER_DRAIN = false;
    float* O;
    __device__ __forceinline__ void operator()(const pg8::f32x4 (&acc)[2][2][4][2], const pg8::Unit& u, int wr, int wc, int fr, int fq) const {
#pragma unroll
        for (int ai = 0; ai < 2; ++ai)
#pragma unroll
            for (int m = 0; m < 4; ++m) {
                const int row = u.pm * 256 + ai * 128 + wr * 64 + m * 16 + fr;
#pragma unroll
                for (int bj = 0; bj < 2; ++bj) { float* p = O + (size_t)row * 256 + bj * 128 + wc * 32 + fq * 8;
                    *(pg8::f32x4*)p = acc[ai][bj][m][0]; *(pg8::f32x4*)(p + 4) = acc[ai][bj][m][1]; }
            }
    }
};
struct CmpOrder {
    int c, G;
    __device__ __forceinline__ bool next(int i, pg8::Unit& u) const { const int idx = i * G + c; if (idx >= 32) return false; u.pm = idx; u.pn = idx >> 4; return true; }
    __device__ __forceinline__ void a_ready(const pg8::Unit&) const {}
    __device__ __forceinline__ void done(const pg8::Unit&) const {}
};
struct EpiInProj {
    static constexpr bool PERM = true, AFTER_DRAIN = false;
    unsigned char* ws;
    __device__ __forceinline__ void operator()(const pg8::f32x4 (&acc)[2][2][4][2], const pg8::Unit& u, int wr, int wc, int fr, int fq) const {
        const int pn = u.pn;
        const float* cosT = (const float*)(ws + WS_TAB + TAB_COS); const float* sinT = (const float*)(ws + WS_TAB + TAB_SIN);
        const bool ropet = (pn < 2) || (pn == 3) || (pn == 4);
        const bool ropew = ropet && ((wc & 1) == 0);
#pragma unroll
        for (int ai = 0; ai < 2; ++ai)
#pragma unroll
            for (int m = 0; m < 4; ++m) {
                const int row = u.pm * 256 + ai * 128 + wr * 64 + m * 16 + fr;
                const int b = row >> 11, t = row & 2047; const float rs = ((const float*)(ws + WS_TAB + TAB_R2))[row];
                f32x4 c0, c1, s0, s1;
                if (ropew) { c0 = *(const f32x4*)(cosT + t * 8); c1 = *(const f32x4*)(cosT + t * 8 + 4); s0 = *(const f32x4*)(sinT + t * 8); s1 = *(const f32x4*)(sinT + t * 8 + 4); }
#pragma unroll
                for (int bj = 0; bj < 2; ++bj) {
                    f32x4 v0 = acc[ai][bj][m][0] * rs, v1 = acc[ai][bj][m][1] * rs;
                    const int cl = bj * 128 + wc * 32 + fq * 8;
                    if (ropew && (pn < 2 || bj == 0)) {
                        f32x4 p0, p1; const int ln = fq * 16 + fr;
                        p0.x = shx(v0.x, 16, ln); p0.y = shx(v0.y, 16, ln); p0.z = shx(v0.z, 16, ln); p0.w = shx(v0.w, 16, ln);
                        p1.x = shx(v1.x, 16, ln); p1.y = shx(v1.y, 16, ln); p1.z = shx(v1.z, 16, ln); p1.w = shx(v1.w, 16, ln);
                        const float sg = (fq == 0) ? -1.f : 1.f;
                        if (fq < 2) { v0 = v0 * c0 + (p0 * s0) * sg; v1 = v1 * c1 + (p1 * s1) * sg; }
                    }
                    if (pn == 13) { if (cl < 32) { float* p = (float*)(ws + WS_GATE) + (size_t)row * 32 + cl; *(f32x4*)p = v0; *(f32x4*)(p + 4) = v1; } }
                    else {
                        size_t off;
                        if (pn < 2) off = WS_QN + ((size_t)row * 512 + pn * 256 + cl) * 2;
                        else if (pn < 5) { const int g = wc >> 1, d = (wc & 1) * 32 + fq * 8; off = WS_KCR + (size_t)((pn - 2) * 2 + bj) * (8 * MiB) + (((size_t)(b * 2 + g) * SEQ + t) * 64 + d) * 2; }
                        else { const int q = pn - 5; off = WS_MQ + (size_t)(q >> 1) * (32 * MiB) + ((size_t)row * 512 + (q & 1) * 256 + cl) * 2; }
                        v4u w; w.x = pg8::cvt_pk_bf16(v0.x, v0.y); w.y = pg8::cvt_pk_bf16(v0.z, v0.w); w.z = pg8::cvt_pk_bf16(v1.x, v1.y); w.w = pg8::cvt_pk_bf16(v1.z, v1.w);
                        *(v4u*)(ws + off) = w;
                    }
                }
            }
    }
};
static_assert(WS_VCR == WS_KCR + 8 * MiB && WS_KS == WS_KCR + 16 * MiB && WS_VS == WS_KCR + 24 * MiB && WS_KW == WS_KCR + 32 * MiB && WS_VW == WS_KCR + 40 * MiB, "kv buffers are 8 MiB apart in (pn, bj) order");
static_assert(WS_MK == WS_MQ + 32 * MiB && WS_MV == WS_MQ + 64 * MiB && WS_MO == WS_MQ + 96 * MiB, "mLSTM buffers are 32 MiB apart");

struct MixPtrs { unsigned char* ws; const float *conv_w, *conv_b, *i_bias, *f_bias, *mnorm_g; };
#define MP_QN ((const bf16*)(P.ws + WS_QN))
#define MP_KS ((const bf16*)(P.ws + WS_KS))
#define MP_VS ((const bf16*)(P.ws + WS_VS))
#define MP_KW ((const bf16*)(P.ws + WS_KW))
#define MP_VW ((const bf16*)(P.ws + WS_VW))
#define MP_KC ((const bf16*)(P.ws + WS_CC))
#define MP_VC ((const bf16*)(P.ws + WS_CC) + (size_t)4096 * 64)
#define MP_MQ ((const bf16*)(P.ws + WS_MQ))
#define MP_MK ((const bf16*)(P.ws + WS_MK))
#define MP_MV ((const bf16*)(P.ws + WS_MV))
#define MP_MO ((const bf16*)(P.ws + WS_MO))
#define MP_GATE ((const float*)(P.ws + WS_GATE))
#define MP_Y ((bf16*)(P.ws + WS_U))


typedef float f32x16 __attribute__((ext_vector_type(16)));
typedef short bf16x8v __attribute__((ext_vector_type(8)));
typedef short s16x4v __attribute__((ext_vector_type(4)));
typedef float f32x2v __attribute__((ext_vector_type(2)));
typedef __bf16 bf16x2v __attribute__((ext_vector_type(2)));
#define MFMA32(a, b, c) __builtin_amdgcn_mfma_f32_32x32x16_bf16((a), (b), (c), 0, 0, 0)
__device__ __forceinline__ s16x4v tr_read(const LAS unsigned char* p) { return __builtin_bit_cast(s16x4v, __builtin_amdgcn_ds_read_tr16_b64_v4i16((LAS s16x4v*)p)); }
__device__ __forceinline__ int tile_off(int key, int ch8) { return (ch8 >> 2) * 4096 + key * 64 + (((ch8 & 3) ^ ((key >> 2) & 3)) << 4); }
constexpr int NM_SLOT = 0, NM_IMP = 65536, NM_IMS = 99328, NM_SEL = 108544, NM_ITEM = 108864;
constexpr float QK_SCALE = 0.125f * 1.4426950408889634f;

#define SBAR() __builtin_amdgcn_sched_barrier(0)
__device__ __forceinline__ void xor32_pair(float v, float& lo, float& hi) { float a = v, b = v; asm volatile("s_nop 1\n\tv_permlane32_swap_b32 %0, %1" : "+v"(a), "+v"(b)); lo = a; hi = b; }
__device__ __forceinline__ float xor32_max(float v) { float lo, hi; xor32_pair(v, lo, hi); float r; asm("v_max_f32 %0, %1, %2" : "=v"(r) : "v"(lo), "v"(hi)); return r; }
__device__ __forceinline__ float xor32_sum(float v) { float lo, hi; xor32_pair(v, lo, hi); return lo + hi; }
__device__ __forceinline__ float max2f(float a, float b) { float r; asm("v_max_f32 %0, %1, %2" : "=v"(r) : "v"(a), "v"(b)); return r; }
__device__ __forceinline__ float max3f(float a, float b, float c) { float r; asm("v_max3_f32 %0, %1, %2, %3" : "=v"(r) : "v"(a), "v"(b), "v"(c)); return r; }
#define LBAR() asm volatile("s_waitcnt lgkmcnt(0)\n\ts_barrier" ::: "memory")
__device__ __forceinline__ void k_load(const LAS unsigned char* Ks, int r, int h, bf16x8v (&kf)[8]) {
    const int sw = (r >> 2) & 3;
#pragma unroll
    for (int ks = 0; ks < 4; ++ks) { const int off = (ks >> 1) * 4096 + r * 64 + (((((ks & 1) << 1) + h) ^ sw) << 4);
        kf[2 * ks] = *(const LAS bf16x8v*)(Ks + off); kf[2 * ks + 1] = *(const LAS bf16x8v*)(Ks + off + 2048); }
}
__device__ __forceinline__ void qk_mma(const bf16x8v (&kf)[8], const bf16x8v (&qf)[4], f32x16& p0, f32x16& p1) {
    const f32x16 z = {0.f, 0.f, 0.f, 0.f, 0.f, 0.f, 0.f, 0.f, 0.f, 0.f, 0.f, 0.f, 0.f, 0.f, 0.f, 0.f};
#pragma unroll
    for (int ks = 0; ks < 4; ++ks) { p0 = MFMA32(kf[2 * ks], qf[ks], ks ? p0 : z); p1 = MFMA32(kf[2 * ks + 1], qf[ks], ks ? p1 : z); }
}
__device__ __forceinline__ void v_load(const LAS unsigned char* Vs, int lane, bf16x8v (&vf)[8]) {
    const int h = lane >> 5, i16 = lane & 15, q = i16 >> 2, p = i16 & 3, gi = (lane >> 4) & 1;
    const int cidx = 2 * gi + (p >> 1), e8 = (p & 1) << 3;
    const int offlo = q * 64 + ((cidx ^ h) << 4) + e8 + h * 256, offhi = q * 64 + ((cidx ^ (h | 2)) << 4) + e8 + h * 256 + 512;
#pragma unroll
    for (int kb = 0; kb < 2; ++kb)
#pragma unroll
        for (int s = 0; s < 2; ++s)
#pragma unroll
            for (int db = 0; db < 2; ++db) { const LAS unsigned char* base = Vs + db * 4096 + (kb * 32 + s * 16) * 64;
                const s16x4v lo = tr_read(base + offlo), hi = tr_read(base + offhi);
                vf[(kb * 2 + s) * 2 + db] = __builtin_shufflevector(lo, hi, 0, 1, 2, 3, 4, 5, 6, 7); }
}
__device__ __forceinline__ void pv_mma(const bf16x8v (&vf)[8], const f32x16& p0, const f32x16& p1, f32x16 (&o)[2]) {
#pragma unroll
    for (int kb = 0; kb < 2; ++kb)
#pragma unroll
        for (int s = 0; s < 2; ++s) {
            const f32x16& P = kb ? p1 : p0;
            v4u pw; pw.x = cvtpk(P[8 * s + 0], P[8 * s + 1]); pw.y = cvtpk(P[8 * s + 2], P[8 * s + 3]); pw.z = cvtpk(P[8 * s + 4], P[8 * s + 5]); pw.w = cvtpk(P[8 * s + 6], P[8 * s + 7]);
            const bf16x8v pf = __builtin_bit_cast(bf16x8v, pw);
            o[0] = MFMA32(vf[(kb * 2 + s) * 2], pf, o[0]); o[1] = MFMA32(vf[(kb * 2 + s) * 2 + 1], pf, o[1]);
        }
}

__device__ __forceinline__ void nsa_unit_mfma(LAS unsigned char* L, const MixPtrs& P, int b, int g, int c, int tid_in) {
    int tid_l = tid_in; asm volatile("" : "+v"(tid_l));
    const int tid = tid_l, lane = tid & 63, w = __builtin_amdgcn_readfirstlane(tid >> 6);
    const int r = lane & 31, h = lane >> 5, head = w >> 1, qi = (w & 1) * 32 + r, t = c * 64 + qi;
    const size_t row = (size_t)b * SEQ + t;
    LAS unsigned* SEL = (LAS unsigned*)(L + NM_SEL); LAS int* ITEM = (LAS int*)(L + NM_ITEM);
    const size_t kvbase = (size_t)(b * 2 + g) * SEQ * 64, ccbase = (size_t)(b * 2 + g) * 128 * 64;
    const int skey = tid >> 3, sch = tid & 7, soff = tile_off(skey, sch);
    bf16x8v qf[4];
    { const bf16* qp = MP_QN + row * 512 + (g * 4 + head) * 64 + 8 * h;
#pragma unroll
      for (int ks = 0; ks < 4; ++ks) qf[ks] = *(const bf16x8v*)(qp + 16 * ks); }
    const float* gp = MP_GATE + row * 32 + g * 4 + head;
    float one = 1.f; asm volatile("" : "+v"(one));
    const float gate_c = __builtin_amdgcn_rcpf(one + __expf(-gp[0])), gate_s = __builtin_amdgcn_rcpf(one + __expf(-gp[8])), gate_w = __builtin_amdgcn_rcpf(one + __expf(-gp[16]));
    f32x16 oacc[2];
    {
        const bf16* kc = MP_KC + ccbase; const bf16* vc = MP_VC + ccbase;
        const v4u k0 = *(const v4u*)(kc + tid * 8), k1 = *(const v4u*)(kc + 4096 + tid * 8), v0 = *(const v4u*)(vc + tid * 8), v1 = *(const v4u*)(vc + 4096 + tid * 8);
        LBAR();
        *(LAS v4u*)(L + NM_SLOT + soff) = k0; *(LAS v4u*)(L + NM_SLOT + 8192 + soff) = v0; *(LAS v4u*)(L + NM_SLOT + 16384 + soff) = k1; *(LAS v4u*)(L + NM_SLOT + 24576 + soff) = v1;
        if (tid < 64) SEL[tid] = 0u;
        LBAR();
        f32x16 s0, s1, s2, s3;
        { bf16x8v kfa[8], kfb[8]; k_load(L + NM_SLOT, r, h, kfa); k_load(L + NM_SLOT + 16384, r, h, kfb); SBAR(); qk_mma(kfa, qf, s0, s1); qk_mma(kfb, qf, s2, s3); }
        const int nlim = (t >= 31) ? (((t - 31) >> 4) < 126 ? ((t - 31) >> 4) : 126) : -1;
        float mx, mxv[4] = {-1e20f, -1e20f, -1e20f, -1e20f};
#pragma unroll
        for (int e = 0; e < 16; ++e) { const int cr = (e & 3) + 8 * (e >> 2) + 4 * h;
            s0[e] = (cr <= nlim) ? s0[e] * QK_SCALE : -1e30f; s1[e] = (cr + 32 <= nlim) ? s1[e] * QK_SCALE : -1e30f;
            s2[e] = (cr + 64 <= nlim) ? s2[e] * QK_SCALE : -1e30f; s3[e] = (cr + 96 <= nlim) ? s3[e] * QK_SCALE : -1e30f;
            mxv[e & 3] = fmaxf(fmaxf(mxv[e & 3], fmaxf(s0[e], s1[e])), fmaxf(s2[e], s3[e])); }
        mx = fmaxf(fmaxf(mxv[0], mxv[1]), fmaxf(mxv[2], mxv[3]));
        mx = xor32_max(mx);
        float ls, lsv[4] = {0.f, 0.f, 0.f, 0.f};
#pragma unroll
        for (int e = 0; e < 16; ++e) { s0[e] = __builtin_amdgcn_exp2f(s0[e] - mx); s1[e] = __builtin_amdgcn_exp2f(s1[e] - mx); s2[e] = __builtin_amdgcn_exp2f(s2[e] - mx); s3[e] = __builtin_amdgcn_exp2f(s3[e] - mx);
            lsv[e & 3] += (s0[e] + s1[e]) + (s2[e] + s3[e]); }
        ls = (lsv[0] + lsv[1]) + (lsv[2] + lsv[3]);
        ls = xor32_sum(ls);
        const float il = (ls > 0.f) ? __builtin_amdgcn_rcpf(ls) : 0.f;
#pragma unroll
        for (int e = 0; e < 16; ++e) { s0[e] *= il; s1[e] *= il; s2[e] *= il; s3[e] *= il; }
        { LAS float* IMP = (LAS float*)(L + NM_IMP) + (w * 32 + r) * 33; float plprev = 0.f;
#pragma unroll
          for (int x = 0; x < 16; ++x) {
              const f32x16& S = (x < 4) ? s0 : ((x < 8) ? s1 : ((x < 12) ? s2 : s3)); const int g4 = (x & 3) * 4;
              const float own = (S[g4] + S[g4 + 1]) + (S[g4 + 2] + S[g4 + 3]);
              const float pl = shx(S[g4 + 3], 32, lane);
              if (h == 1) IMP[2 * x + 1] = own + pl; else IMP[2 * x] = own + plprev;
              plprev = pl;
          }
        }
        oacc[0] = (f32x16){0.f, 0.f, 0.f, 0.f, 0.f, 0.f, 0.f, 0.f, 0.f, 0.f, 0.f, 0.f, 0.f, 0.f, 0.f, 0.f}; oacc[1] = oacc[0];
        { bf16x8v vfa[8], vfb[8]; v_load(L + NM_SLOT + 8192, lane, vfa); v_load(L + NM_SLOT + 24576, lane, vfb); SBAR(); pv_mma(vfa, s0, s1, oacc); pv_mma(vfb, s2, s3, oacc); }
#pragma unroll
        for (int e = 0; e < 16; ++e) { oacc[0][e] *= gate_c; oacc[1][e] *= gate_c; }
    }
    LBAR();
    { const int i = tid & 63, jg = tid >> 6; const LAS float* I8 = (const LAS float*)(L + NM_IMP); LAS float* IMS = (LAS float*)(L + NM_IMS);
#pragma unroll
      for (int jj = 0; jj < 4; ++jj) { const int j = 4 * jg + jj; const int wq = (i >> 5), rq = i & 31;
          IMS[i * 36 + j] = (I8[((0 + wq) * 32 + rq) * 33 + j] + I8[((2 + wq) * 32 + rq) * 33 + j]) + (I8[((4 + wq) * 32 + rq) * 33 + j] + I8[((6 + wq) * 32 + rq) * 33 + j]); }
      LBAR();
      unsigned bits = 0u;
      if (c + 1 <= 16) { if (jg == 0) bits = (1u << (c + 1)) - 1u; }
      else { if (jg == 0) bits = 1u | (1u << c) | (1u << (c - 1));
          { float iv[32];
#pragma unroll
            for (int q8 = 0; q8 < 8; ++q8) { const f32x4 x = *(const LAS f32x4*)(IMS + i * 36 + 4 * q8); iv[4 * q8] = x.x; iv[4 * q8 + 1] = x.y; iv[4 * q8 + 2] = x.z; iv[4 * q8 + 3] = x.w; }
#pragma unroll
            for (int jj = 0; jj < 4; ++jj) { const int j = 4 * jg + jj; const float vj = IMS[i * 36 + j]; int rank = 0;
#pragma unroll
                for (int i2 = 1; i2 < 30; ++i2) rank += (i2 <= c - 2 && (iv[i2] > vj || (iv[i2] == vj && i2 < j))) ? 1 : 0;
                if (j >= 1 && j <= c - 2 && rank < 13) bits |= 1u << j; } } }
      if (bits) atomicOr((unsigned*)&SEL[i], bits);
      LBAR();
      if (w == 0) { unsigned so = SEL[lane];
#pragma unroll
          for (int o2 = 32; o2; o2 >>= 1) so |= shxu(so, o2, lane);
          if (lane == 0) { int n = 0; for (int j = 0; j <= c; ++j) if ((so >> j) & 1u) ITEM[n++] = j; const int j0 = (c - 8 > 0) ? c - 8 : 0; for (int j = j0; j <= c; ++j) ITEM[n++] = 64 + j; ITEM[n] = -1; ITEM[47] = n; } }
      LBAR();
    }
    const unsigned mysel = SEL[qi]; const int nitem = ITEM[47];
    f32x16 o[2]; float m = -1e20f, lsum = 0.f; int prev_kind = 0;
    o[0] = (f32x16){0.f, 0.f, 0.f, 0.f, 0.f, 0.f, 0.f, 0.f, 0.f, 0.f, 0.f, 0.f, 0.f, 0.f, 0.f, 0.f}; o[1] = o[0];
    const int npair = (nitem + 1) >> 1;
    v4u rk0, rv0, rk1, rv1;
#define NSA_LOAD_PAIR(ip_) do { const int ia_ = ITEM[2 * (ip_)], ib_ = ITEM[2 * (ip_) + 1]; \
        { const bf16* kp = ((ia_ & 64) ? MP_KW : MP_KS) + kvbase + (size_t)(ia_ & 63) * 4096; const bf16* vp = ((ia_ & 64) ? MP_VW : MP_VS) + kvbase + (size_t)(ia_ & 63) * 4096; rk0 = *(const v4u*)(kp + tid * 8); rv0 = *(const v4u*)(vp + tid * 8); } \
        if (ib_ >= 0) { const bf16* kp = ((ib_ & 64) ? MP_KW : MP_KS) + kvbase + (size_t)(ib_ & 63) * 4096; const bf16* vp = ((ib_ & 64) ? MP_VW : MP_VS) + kvbase + (size_t)(ib_ & 63) * 4096; rk1 = *(const v4u*)(kp + tid * 8); rv1 = *(const v4u*)(vp + tid * 8); } } while (0)
#define NSA_WRITE_PAIR(sb_) do { *(LAS v4u*)(L + (sb_) + soff) = rk0; *(LAS v4u*)(L + (sb_) + 8192 + soff) = rv0; *(LAS v4u*)(L + (sb_) + 16384 + soff) = rk1; *(LAS v4u*)(L + (sb_) + 24576 + soff) = rv1; } while (0)
    rk1 = (v4u){0u, 0u, 0u, 0u}; rv1 = rk1;
    NSA_LOAD_PAIR(0);
    NSA_WRITE_PAIR(NM_SLOT + 32768);
    LBAR();
#pragma unroll 1
    for (int ip = 0; ip < npair; ++ip) {
        if (ip + 1 < npair) NSA_LOAD_PAIR(ip + 1);
        const int sbase = NM_SLOT + ((ip + 1) & 1) * 32768;
#pragma unroll 1
        for (int half = 0; half < 2; ++half) {
            const int item = ITEM[2 * ip + half];
            if (item < 0) break;
            const int kind = item >> 6, j = item & 63;
            if (kind != prev_kind) {
                const float tot = xor32_sum(lsum); const float sc = gate_s * __builtin_amdgcn_rcpf(tot);
#pragma unroll
                for (int e = 0; e < 16; ++e) { oacc[0][e] += o[0][e] * sc; oacc[1][e] += o[1][e] * sc; o[0][e] = 0.f; o[1][e] = 0.f; }
                m = -1e20f; lsum = 0.f; prev_kind = kind;
            }
            int klo, khi;
            if (kind == 0) { klo = 0; khi = ((mysel >> j) & 1u) ? ((j < c) ? 63 : qi) : -1; }
            else { klo = t - 511 - 64 * j; khi = t - 64 * j; if (khi > 63) khi = 63; if (klo < 0) klo = 0; }
            const LAS unsigned char* slot = L + sbase + half * 16384;
            if (__any(khi >= klo)) {
                f32x16 p0, p1; bf16x8v vf[8];
                { bf16x8v kf[8]; k_load(slot, r, h, kf); SBAR(); qk_mma(kf, qf, p0, p1); }
                v_load(slot + 8192, lane, vf); SBAR();
                if (!__all(klo == 0 && khi == 63)) {
                    const int a = klo - 4 * h, z = khi - 4 * h;
#pragma unroll
                    for (int e = 0; e < 16; ++e) { const int cr = (e & 3) + 8 * (e >> 2);
                        p0[e] = (cr >= a && cr <= z) ? p0[e] : -1e30f; p1[e] = (cr + 32 >= a && cr + 32 <= z) ? p1[e] : -1e30f; }
                }
                float tm;
                { float ma = max2f(p0[0], p1[0]), mb = max2f(p0[1], p1[1]), mc2 = max2f(p0[2], p1[2]), md = max2f(p0[3], p1[3]);
#pragma unroll
                  for (int e = 4; e < 16; e += 4) { ma = max3f(ma, p0[e], p1[e]); mb = max3f(mb, p0[e + 1], p1[e + 1]); mc2 = max3f(mc2, p0[e + 2], p1[e + 2]); md = max3f(md, p0[e + 3], p1[e + 3]); }
                  tm = max3f(ma, mb, max2f(mc2, md)); }
                tm = xor32_max(tm);
                const float mn = fmaxf(m, tm * QK_SCALE);
                if (!__all(mn == m)) { const float corr = __builtin_amdgcn_exp2f(m - mn); lsum *= corr;
#pragma unroll
                    for (int e = 0; e < 16; ++e) { o[0][e] *= corr; o[1][e] *= corr; }
                    m = mn; }
                { const f32x2v sc2 = {QK_SCALE, QK_SCALE}, mm2 = {m, m}; f32x2v ta = {0.f, 0.f}, tb = {0.f, 0.f};
#pragma unroll
                  for (int e = 0; e < 16; e += 2) { const f32x2v a0 = (f32x2v){p0[e], p0[e + 1]} * sc2 - mm2, a1 = (f32x2v){p1[e], p1[e + 1]} * sc2 - mm2; p0[e] = a0.x; p0[e + 1] = a0.y; p1[e] = a1.x; p1[e + 1] = a1.y; }
#pragma unroll
                  for (int e = 0; e < 16; ++e) { p0[e] = __builtin_amdgcn_exp2f(p0[e]); p1[e] = __builtin_amdgcn_exp2f(p1[e]); }
#pragma unroll
                  for (int e = 0; e < 16; e += 2) { ta += (f32x2v){p0[e], p0[e + 1]}; tb += (f32x2v){p1[e], p1[e + 1]}; }
                  lsum += (ta.x + ta.y) + (tb.x + tb.y); }
                SBAR(); pv_mma(vf, p0, p1, o);
            }
        }
        if (ip + 1 < npair) NSA_WRITE_PAIR(NM_SLOT + (ip & 1) * 32768);
        LBAR();
    }
#undef NSA_LOAD_PAIR
#undef NSA_WRITE_PAIR
    { const float tot = xor32_sum(lsum); const float sc = gate_w * __builtin_amdgcn_rcpf(tot);
#pragma unroll
      for (int e = 0; e < 16; ++e) { oacc[0][e] += o[0][e] * sc; oacc[1][e] += o[1][e] * sc; } }
    { bf16* yp = MP_Y + row * DM + (g * 4 + head) * 64 + 4 * h;
#pragma unroll
      for (int db = 0; db < 2; ++db)
#pragma unroll
          for (int g4 = 0; g4 < 4; ++g4) { v2u wv; wv.x = cvtpk(oacc[db][4 * g4], oacc[db][4 * g4 + 1]); wv.y = cvtpk(oacc[db][4 * g4 + 2], oacc[db][4 * g4 + 3]); *(v2u*)(yp + db * 32 + g4 * 8) = wv; } }
}

#define MFMA16(a, b, c) __builtin_amdgcn_mfma_f32_16x16x32_bf16((a), (b), (c), 0, 0, 0)
constexpr size_t WS_QC = 422 * MiB, WS_KC2 = 454 * MiB, WS_END2 = 486 * MiB;
#define MP_QC ((const bf16*)(P.ws + WS_QC))
#define MP_KC2 ((const bf16*)(P.ws + WS_KC2))
__device__ __forceinline__ int img_off(int row, int ch) { return 256 * row + 16 * (ch ^ (((row & 3) << 2) | ((row >> 2) & 3))); }
constexpr int M2_IMG = 0, M2_SC = 98304, M2_DEN = 106496, M2_QN = 107520, M2_N = 107776, M2_SSQ = 108288;

__device__ __forceinline__ void mlstm_conv_pass(unsigned char* ws, const float* conv_w, const float* conv_b, int gthread, int nthreads) {
    for (int idx = gthread; idx < BATCH * 128 * 128; idx += nthreads) {
        const int cc = idx & 127, tg = (idx >> 7) & 127, b = idx >> 14;
        const int isk = cc >> 6, ch0 = (cc & 63) * 8;
        const bf16* src = (const bf16*)(ws + (isk ? WS_MK : WS_MQ)) + (size_t)b * SEQ * 512 + ch0;
        bf16* dst = (bf16*)(ws + (isk ? WS_KC2 : WS_QC)) + ((size_t)(b * 4 + (ch0 >> 7)) * SEQ) * 128 + (ch0 & 127);
        float wt[4][8], bs[8];
#pragma unroll
        for (int j = 0; j < 4; ++j) { const f32x4 a = *(const f32x4*)(conv_w + j * 1024 + isk * 512 + ch0), c2 = *(const f32x4*)(conv_w + j * 1024 + isk * 512 + ch0 + 4);
            wt[j][0] = a.x; wt[j][1] = a.y; wt[j][2] = a.z; wt[j][3] = a.w; wt[j][4] = c2.x; wt[j][5] = c2.y; wt[j][6] = c2.z; wt[j][7] = c2.w; }
        { const f32x4 a = *(const f32x4*)(conv_b + isk * 512 + ch0), c2 = *(const f32x4*)(conv_b + isk * 512 + ch0 + 4); bs[0] = a.x; bs[1] = a.y; bs[2] = a.z; bs[3] = a.w; bs[4] = c2.x; bs[5] = c2.y; bs[6] = c2.z; bs[7] = c2.w; }
        const float osc = isk ? 0.08838834764831845f : 1.f;
        const int t0 = tg * 16;
        float x0[8], x1[8], x2[8];
#pragma unroll
        for (int e = 0; e < 8; ++e) { x0[e] = 0.f; x1[e] = 0.f; x2[e] = 0.f; }
        if (t0 > 0) {
            const v4u a = *(const v4u*)(src + (size_t)(t0 - 3) * 512), c2 = *(const v4u*)(src + (size_t)(t0 - 2) * 512), d2 = *(const v4u*)(src + (size_t)(t0 - 1) * 512);
            x0[0] = bflo(a.x); x0[1] = bfhi(a.x); x0[2] = bflo(a.y); x0[3] = bfhi(a.y); x0[4] = bflo(a.z); x0[5] = bfhi(a.z); x0[6] = bflo(a.w); x0[7] = bfhi(a.w);
            x1[0] = bflo(c2.x); x1[1] = bfhi(c2.x); x1[2] = bflo(c2.y); x1[3] = bfhi(c2.y); x1[4] = bflo(c2.z); x1[5] = bfhi(c2.z); x1[6] = bflo(c2.w); x1[7] = bfhi(c2.w);
            x2[0] = bflo(d2.x); x2[1] = bfhi(d2.x); x2[2] = bflo(d2.y); x2[3] = bfhi(d2.y); x2[4] = bflo(d2.z); x2[5] = bfhi(d2.z); x2[6] = bflo(d2.w); x2[7] = bfhi(d2.w);
        }
#pragma unroll 4
        for (int s = 0; s < 16; ++s) {
            const v4u a = *(const v4u*)(src + (size_t)(t0 + s) * 512);
            const float x3[8] = {bflo(a.x), bfhi(a.x), bflo(a.y), bfhi(a.y), bflo(a.z), bfhi(a.z), bflo(a.w), bfhi(a.w)};
            float o[8];
#pragma unroll
            for (int e = 0; e < 8; ++e) { float v = bs[e] + wt[0][e] * x0[e] + wt[1][e] * x1[e] + wt[2][e] * x2[e] + wt[3][e] * x3[e]; v = v * __builtin_amdgcn_rcpf(1.f + __expf(-v)); o[e] = v * osc; x0[e] = x1[e]; x1[e] = x2[e]; x2[e] = x3[e]; }
            v4u wv; wv.x = pk2(o[0], o[1]); wv.y = pk2(o[2], o[3]); wv.z = pk2(o[4], o[5]); wv.w = pk2(o[6], o[7]);
            *(v4u*)(dst + (size_t)(t0 + s) * 128) = wv;
        }
    }
}

constexpr int M2_A = 112384, M2_PM = 120576, M2_F = 128768, M2_BL = 136960, M2_AMX = 137088, M2_MC = 137216;
__device__ __forceinline__ void mlstm_unit_mfma(LAS unsigned char* L, const MixPtrs& P, int b, int hh, int tid_in) {
    int tid_l = tid_in; asm volatile("" : "+v"(tid_l));
    const int tid = tid_l, lane = tid & 63, w = __builtin_amdgcn_readfirstlane(tid >> 6), l15 = lane & 15, kg = lane >> 4;
    const size_t rb = (size_t)b * SEQ;
    const bf16* QCp = MP_QC + ((size_t)(b * 4 + hh) * SEQ) * 128; const bf16* KCp = MP_KC2 + ((size_t)(b * 4 + hh) * SEQ) * 128;
    const bf16* Vp = MP_MV + rb * 512 + hh * 128; const bf16* Op = MP_MO + rb * 512 + hh * 128 + 16 * w + 4 * kg;
    bf16* Yp = MP_Y + rb * DM + 512 + hh * 128 + 16 * w + 4 * kg;
    LAS float* DEN = (LAS float*)(L + M2_DEN); LAS float* QN = (LAS float*)(L + M2_QN); LAS float* NV = (LAS float*)(L + M2_N); LAS float* SSQ = (LAS float*)(L + M2_SSQ);
    LAS float* SA = (LAS float*)(L + M2_A); LAS float* SPM = (LAS float*)(L + M2_PM); LAS float* SF = (LAS float*)(L + M2_F);
    LAS float* SBL = (LAS float*)(L + M2_BL); LAS float* SAMX = (LAS float*)(L + M2_AMX); LAS float* SMC = (LAS float*)(L + M2_MC);
    float zf = 0.f; asm volatile("" : "+v"(zf));
    f32x4 Cacc[8], nacc = {zf, zf, zf, zf};
#pragma unroll
    for (int i = 0; i < 8; ++i) Cacc[i] = (f32x4){zf, zf, zf, zf};
    const f32x4 gn = *(const f32x4*)(P.mnorm_g + hh * 128 + 16 * w + 4 * kg);
    const int r0s = tid >> 4, c0s = tid & 15, so0 = img_off(r0s, c0s), so1 = img_off(r0s + 32, c0s);
    v4u sq0, sq1, sk0, sk1, sv0, sv1;
    sq0 = *(const v4u*)(QCp + (size_t)r0s * 128 + c0s * 8); sq1 = *(const v4u*)(QCp + (size_t)(r0s + 32) * 128 + c0s * 8);
    sk0 = *(const v4u*)(KCp + (size_t)r0s * 128 + c0s * 8); sk1 = *(const v4u*)(KCp + (size_t)(r0s + 32) * 128 + c0s * 8);
    sv0 = *(const v4u*)(Vp + (size_t)r0s * 512 + c0s * 8);  sv1 = *(const v4u*)(Vp + (size_t)(r0s + 32) * 512 + c0s * 8);
    LBAR();
    { const float ib = P.i_bias[hh], fb = P.f_bias[hh]; const float* Gp = MP_GATE + rb * 32 + hh;
#pragma unroll 1
      for (int cc = w; cc < 32; cc += 8) { const int tk = 64 * cc + lane;
          const float il = Gp[(size_t)tk * 32 + 24] + ib, fx = Gp[(size_t)tk * 32 + 28] + fb; const float fl = fminf(fx, 0.f) - log1pf(__expf(-fabsf(fx)));
          float f = fl;
#pragma unroll
          for (int o = 1; o < 64; o <<= 1) { const float v = shi(f, lane - o); if (lane >= o) f += v; }
          const float a = il - f; float pm = a;
#pragma unroll
          for (int o = 1; o < 64; o <<= 1) { const float v = shi(pm, lane - o); if (lane >= o) pm = fmaxf(pm, v); }
          SA[tk] = a; SPM[tk] = pm; SF[tk] = f; if (lane == 63) { SBL[cc] = f; SAMX[cc] = pm; } } }
    *(LAS v4u*)(L + M2_IMG + so0) = sq0; *(LAS v4u*)(L + M2_IMG + so1) = sq1; *(LAS v4u*)(L + M2_IMG + 16384 + so0) = sk0; *(LAS v4u*)(L + M2_IMG + 16384 + so1) = sk1;
    *(LAS v4u*)(L + M2_IMG + 32768 + so0) = sv0; *(LAS v4u*)(L + M2_IMG + 32768 + so1) = sv1;
    if (tid < 128) NV[tid] = zf;
    LBAR();
    if (tid == 0) { float mcar = zf; for (int cc = 0; cc < 32; ++cc) { SMC[cc] = mcar; mcar = SBL[cc] + fmaxf(mcar, SAMX[cc]); } }
    LBAR();
#pragma unroll 1
    for (int c = 0; c < 32; ++c) {
        int lc = lane; asm volatile("" : "+v"(lc));
        const int l15 = lc & 15, kg = lc >> 4, q4 = l15 >> 2, p4 = l15 & 3;
        const int t0 = c * 64; const LAS unsigned char* Qi = L + M2_IMG + (c & 1) * 49152; const LAS unsigned char* Ki = Qi + 16384; const LAS unsigned char* Vi = Qi + 32768;
        if (c + 1 < 32) { const int tn = t0 + 64;
            sq0 = *(const v4u*)(QCp + (size_t)(tn + r0s) * 128 + c0s * 8); sq1 = *(const v4u*)(QCp + (size_t)(tn + r0s + 32) * 128 + c0s * 8);
            sk0 = *(const v4u*)(KCp + (size_t)(tn + r0s) * 128 + c0s * 8); sk1 = *(const v4u*)(KCp + (size_t)(tn + r0s + 32) * 128 + c0s * 8);
            sv0 = *(const v4u*)(Vp + (size_t)(tn + r0s) * 512 + c0s * 8);  sv1 = *(const v4u*)(Vp + (size_t)(tn + r0s + 32) * 512 + c0s * 8); }
        const float mc = SMC[c], mxa = fmaxf(mc, SAMX[c]); const float cs = __expf(mc - mxa);
        { const int tblk = w >> 1, t = 16 * tblk + l15; const int sb0 = 2 * (w & 1);
          bf16x8v ka[2][4], qb[4];
#pragma unroll
          for (int ks = 0; ks < 4; ++ks) { qb[ks] = *(const LAS bf16x8v*)(Qi + img_off(t, 4 * ks + kg)); ka[0][ks] = *(const LAS bf16x8v*)(Ki + img_off(16 * sb0 + l15, 4 * ks + kg)); ka[1][ks] = *(const LAS bf16x8v*)(Ki + img_off(16 * sb0 + 16 + l15, 4 * ks + kg)); }
          const float Mt = fmaxf(SPM[t0 + t], mc);
          const f32x4 as0 = *(const LAS f32x4*)(SA + t0 + 16 * sb0 + 4 * kg), as1 = *(const LAS f32x4*)(SA + t0 + 16 * sb0 + 16 + 4 * kg);
          const int tq = tid >> 3, dp = tid & 7; const v4u q0 = *(const LAS v4u*)(Qi + img_off(tq, 2 * dp)), q1 = *(const LAS v4u*)(Qi + img_off(tq, 2 * dp + 1));
          const LAS f32x4* np = (const LAS f32x4*)(NV + 16 * dp); const f32x4 n0 = np[0], n1 = np[1], n2 = np[2], n3 = np[3];
          SBAR();
          LAS unsigned char* SC = L + M2_SC;
#pragma unroll
          for (int sb = 0; sb < 2; ++sb) { const int sblk = sb0 + sb; f32x4 acc = {0.f, 0.f, 0.f, 0.f}; float rp = 0.f; v2u wv; wv.x = 0u; wv.y = 0u;
              if (sblk <= tblk) {
#pragma unroll
                  for (int ks = 0; ks < 4; ++ks) acc = MFMA16(ka[sb][ks], qb[ks], acc);
                  const f32x4 as = sb ? as1 : as0; float v[4];
#pragma unroll
                  for (int e = 0; e < 4; ++e) { const float x = acc[e] * __expf(as[e] - Mt); v[e] = (sblk == tblk && 4 * kg + e > l15) ? 0.f : x; }
                  rp = (v[0] + v[1]) + (v[2] + v[3]); wv.x = cvtpk(v[0], v[1]); wv.y = cvtpk(v[2], v[3]);
              }
              rp += shx(rp, 16, lane); rp += shx(rp, 32, lane);
              *(LAS v2u*)(SC + t * 128 + (((2 * sblk + (kg >> 1)) ^ (t & 7)) << 4) + 8 * (kg & 1)) = wv;
              if (kg == 0) DEN[sblk * 64 + t] = rp; }
          { float s = bflo(q0.x) * n0.x + bfhi(q0.x) * n0.y + bflo(q0.y) * n0.z + bfhi(q0.y) * n0.w + bflo(q0.z) * n1.x + bfhi(q0.z) * n1.y + bflo(q0.w) * n1.z + bfhi(q0.w) * n1.w
                    + bflo(q1.x) * n2.x + bfhi(q1.x) * n2.y + bflo(q1.y) * n2.z + bfhi(q1.y) * n2.w + bflo(q1.z) * n3.x + bfhi(q1.z) * n3.y + bflo(q1.w) * n3.z + bfhi(q1.w) * n3.w;
            s += shx(s, 1, lane); s += shx(s, 2, lane); s += shx(s, 4, lane);
            if (dp == 0) QN[tq] = s; } }
        LBAR();
        v2u og[4];
#pragma unroll
        for (int tb = 0; tb < 4; ++tb) og[tb] = *(const v2u*)(Op + (size_t)(t0 + 16 * tb + l15) * 512);
        bf16x8v vf[2]; f32x4 hv[4];
        { float pmt[4], ft[4], dnp[4], qn4[4]; bf16x8v Cfrag[4];
#pragma unroll
          for (int kp = 0; kp < 4; ++kp) { v4u a; a.x = cvtpk(Cacc[2 * kp].x, Cacc[2 * kp].y); a.y = cvtpk(Cacc[2 * kp].z, Cacc[2 * kp].w); a.z = cvtpk(Cacc[2 * kp + 1].x, Cacc[2 * kp + 1].y); a.w = cvtpk(Cacc[2 * kp + 1].z, Cacc[2 * kp + 1].w);
              Cfrag[kp] = __builtin_bit_cast(bf16x8v, a); }
#pragma unroll
          for (int ks = 0; ks < 2; ++ks) { const int r0 = 32 * ks + 8 * kg;
              const s16x4v lo = tr_read(Vi + 256 * (r0 + q4) + 16 * ((2 * w + (p4 >> 1)) ^ ((q4 << 2) | ((r0 >> 2) & 3))) + 8 * (p4 & 1));
              const s16x4v hi = tr_read(Vi + 256 * (r0 + 4 + q4) + 16 * ((2 * w + (p4 >> 1)) ^ ((q4 << 2) | (((r0 + 4) >> 2) & 3))) + 8 * (p4 & 1));
              vf[ks] = __builtin_shufflevector(lo, hi, 0, 1, 2, 3, 4, 5, 6, 7); }
#pragma unroll
          for (int tb = 0; tb < 4; ++tb) { const int t = 16 * tb + l15; pmt[tb] = SPM[t0 + t]; ft[tb] = SF[t0 + t]; dnp[tb] = (DEN[t] + DEN[64 + t]) + (DEN[128 + t] + DEN[192 + t]); qn4[tb] = QN[t]; }
#pragma unroll
          for (int tp = 0; tp < 2; ++tp) {
              bf16x8v sf[2][2]; v2u qlo[2][4], qhi[2][4];
#pragma unroll
              for (int t2 = 0; t2 < 2; ++t2) { const int t = 16 * (2 * tp + t2) + l15; const int swz = ((t & 3) << 2) | ((t >> 2) & 3);
#pragma unroll
                  for (int ks = 0; ks < 2; ++ks) sf[t2][ks] = *(const LAS bf16x8v*)(L + M2_SC + t * 128 + (((4 * ks + kg) ^ (t & 7)) << 4));
#pragma unroll
                  for (int kp = 0; kp < 4; ++kp) { qlo[t2][kp] = *(const LAS v2u*)(Qi + 256 * t + 16 * ((4 * kp + (kg >> 1)) ^ swz) + 8 * (kg & 1)); qhi[t2][kp] = *(const LAS v2u*)(Qi + 256 * t + 16 * ((4 * kp + 2 + (kg >> 1)) ^ swz) + 8 * (kg & 1)); } }
              SBAR();
#pragma unroll
              for (int t2 = 0; t2 < 2; ++t2) { const int tb = 2 * tp + t2; f32x4 an = {0.f, 0.f, 0.f, 0.f}, a2 = {0.f, 0.f, 0.f, 0.f};
#pragma unroll
                  for (int ks = 0; ks < 2; ++ks) an = MFMA16(vf[ks], sf[t2][ks], an);
#pragma unroll
                  for (int kp = 0; kp < 4; ++kp) { v4u qq; qq.x = qlo[t2][kp].x; qq.y = qlo[t2][kp].y; qq.z = qhi[t2][kp].x; qq.w = qhi[t2][kp].y; a2 = MFMA16(Cfrag[kp], __builtin_bit_cast(bf16x8v, qq), a2); }
                  const float Mt = fmaxf(pmt[tb], mc), wp = __expf(mc - Mt), emt = __expf(-ft[tb] - Mt);
                  const float dn = dnp[tb] + wp * qn4[tb];
                  const float idn = __builtin_amdgcn_rcpf(fmaxf(fabsf(dn), emt));
                  hv[tb] = (an + a2 * wp) * idn;
                  float ss = (hv[tb].x * hv[tb].x + hv[tb].y * hv[tb].y) + (hv[tb].z * hv[tb].z + hv[tb].w * hv[tb].w);
                  ss += shx(ss, 16, lane); ss += shx(ss, 32, lane);
                  if (kg == 0) SSQ[((c & 1) * 8 + w) * 64 + 16 * tb + l15] = ss; }
              SBAR();
          } }
        { bf16x8v vpf[2], wkf[2];
          f32x4 aw[2][2];
#pragma unroll
          for (int ks = 0; ks < 2; ++ks) { aw[ks][0] = *(const LAS f32x4*)(SA + t0 + 32 * ks + 8 * kg); aw[ks][1] = *(const LAS f32x4*)(SA + t0 + 32 * ks + 8 * kg + 4); }
#pragma unroll
          for (int ks = 0; ks < 2; ++ks) { float wkv[8]; unsigned vp[4], wp2[4]; const v4u vu = __builtin_bit_cast(v4u, vf[ks]); const unsigned vw[4] = {vu.x, vu.y, vu.z, vu.w};
#pragma unroll
              for (int j = 0; j < 8; ++j) wkv[j] = __expf(aw[ks][j >> 2][j & 3] - mxa);
#pragma unroll
              for (int j2 = 0; j2 < 4; ++j2) { vp[j2] = cvtpk(bflo(vw[j2]) * wkv[2 * j2], bfhi(vw[j2]) * wkv[2 * j2 + 1]); wp2[j2] = cvtpk(wkv[2 * j2], wkv[2 * j2 + 1]); }
              v4u a; a.x = vp[0]; a.y = vp[1]; a.z = vp[2]; a.w = vp[3]; vpf[ks] = __builtin_bit_cast(bf16x8v, a);
              v4u b2; b2.x = wp2[0]; b2.y = wp2[1]; b2.z = wp2[2]; b2.w = wp2[3]; wkf[ks] = __builtin_bit_cast(bf16x8v, b2); }
          nacc = nacc * cs;
#pragma unroll
          for (int ih = 0; ih < 2; ++ih) {
              bf16x8v kf[4][2];
#pragma unroll
              for (int i4 = 0; i4 < 4; ++i4)
#pragma unroll
                  for (int ks = 0; ks < 2; ++ks) { const int i = 4 * ih + i4, r0 = 32 * ks + 8 * kg;
                      const s16x4v lo = tr_read(Ki + 256 * (r0 + q4) + 16 * ((2 * i + (p4 >> 1)) ^ ((q4 << 2) | ((r0 >> 2) & 3))) + 8 * (p4 & 1));
                      const s16x4v hi = tr_read(Ki + 256 * (r0 + 4 + q4) + 16 * ((2 * i + (p4 >> 1)) ^ ((q4 << 2) | (((r0 + 4) >> 2) & 3))) + 8 * (p4 & 1));
                      kf[i4][ks] = __builtin_shufflevector(lo, hi, 0, 1, 2, 3, 4, 5, 6, 7); }
              SBAR();
#pragma unroll
              for (int i4 = 0; i4 < 4; ++i4) { const int i = 4 * ih + i4; Cacc[i] = Cacc[i] * cs;
#pragma unroll
                  for (int ks = 0; ks < 2; ++ks) Cacc[i] = MFMA16(kf[i4][ks], vpf[ks], Cacc[i]); }
              SBAR();
          }
          { bf16x8v kw[2];
#pragma unroll
            for (int ks = 0; ks < 2; ++ks) { const int r0 = 32 * ks + 8 * kg;
                const s16x4v lo = tr_read(Ki + 256 * (r0 + q4) + 16 * ((2 * w + (p4 >> 1)) ^ ((q4 << 2) | ((r0 >> 2) & 3))) + 8 * (p4 & 1));
                const s16x4v hi = tr_read(Ki + 256 * (r0 + 4 + q4) + 16 * ((2 * w + (p4 >> 1)) ^ ((q4 << 2) | (((r0 + 4) >> 2) & 3))) + 8 * (p4 & 1));
                kw[ks] = __builtin_shufflevector(lo, hi, 0, 1, 2, 3, 4, 5, 6, 7); }
            nacc = MFMA16(kw[0], wkf[0], nacc); nacc = MFMA16(kw[1], wkf[1], nacc); }
          if (l15 == 0) *(LAS f32x4*)(NV + 16 * w + 4 * kg) = nacc;
 }
        if (c + 1 < 32) { LAS unsigned char* Nx = L + M2_IMG + ((c + 1) & 1) * 49152;
            *(LAS v4u*)(Nx + so0) = sq0; *(LAS v4u*)(Nx + so1) = sq1; *(LAS v4u*)(Nx + 16384 + so0) = sk0; *(LAS v4u*)(Nx + 16384 + so1) = sk1; *(LAS v4u*)(Nx + 32768 + so0) = sv0; *(LAS v4u*)(Nx + 32768 + so1) = sv1; }
        LBAR();
#pragma unroll
        for (int tb = 0; tb < 4; ++tb) { const int t = 16 * tb + l15; const LAS float* sp = SSQ + (c & 1) * 512 + t;
            const float tot = ((sp[0] + sp[64]) + (sp[128] + sp[192])) + ((sp[256] + sp[320]) + (sp[384] + sp[448]));
            const float rn = __frsqrt_rn(tot * (1.f / 128.f) + EPS);
            const float y0 = hv[tb].x * rn * gn.x * sigmoidf_(bflo(og[tb].x)), y1 = hv[tb].y * rn * gn.y * sigmoidf_(bfhi(og[tb].x)), y2 = hv[tb].z * rn * gn.z * sigmoidf_(bflo(og[tb].y)), y3 = hv[tb].w * rn * gn.w * sigmoidf_(bfhi(og[tb].y));
            v2u wv; wv.x = cvtpk(y0, y1); wv.y = cvtpk(y2, y3);
            *(v2u*)(Yp + (size_t)(t0 + t) * DM) = wv; }
    }
    LBAR();
}

#ifndef MK_MULTI
#define MK_MULTI 0
#endif
constexpr int PH_PER_LAYER = 12, N_PHASES = 1 + DEPTH * PH_PER_LAYER;
struct Args { const float* in[16]; float* out; unsigned char* ws; int ph_lo, ph_hi; };
static_assert(sizeof(Args) == 16 * 8 + 8 + 8 + 8, "Args has no padding");

__global__ void __launch_bounds__(NWAVES * 64, 2) fwd_kernel(Args args) {
    extern __shared__ __attribute__((aligned(16))) unsigned char lds_raw[];
    LAS unsigned char* L = (LAS unsigned char*)lds_raw;
    const int G0 = gridDim.x, blk0 = blockIdx.x;
    const int wave0 = __builtin_amdgcn_readfirstlane((int)threadIdx.x >> 6);
#define PH_IDS() PH_WS(); int wave = wave0; asm volatile("" : "+s"(wave)); const int lane = fresh_lane(), tid = wave * 64 + lane, gw = blk * NWAVES + wave; (void)gw
#define PH_WS() unsigned char* ws = args.ws; asm volatile("" : "+s"(ws)); int blk = blk0, G = G0; asm volatile("" : "+s"(blk), "+s"(G)); const int NGW = G * NWAVES; (void)NGW; bf16* X16 = (bf16*)(ws + WS_X16); float* R2 = (float*)(ws + WS_TAB + TAB_R2); bf16* U = (bf16*)(ws + WS_U); bf16* HB = (bf16*)(ws + WS_HB); bf16* HD = (bf16*)(ws + WS_HD); \
    unsigned char* wl = ws + WS_W; const float* ng = args.in[1] + (size_t)l_ * 6 * DM; (void)X16; (void)R2; (void)U; (void)HB; (void)HD; (void)wl; (void)ng
    unsigned char* ws0 = args.ws;
    volatile LAS unsigned* MISC = (volatile LAS unsigned*)(L + MISC_OFF);
    { const int tid_e = wave0 * 64 + fresh_lane(); if (tid_e < 16) MISC[tid_e] = 0u; }
    __syncthreads();
    XcdBarrier bar; bar.bar = (unsigned*)(ws0 + WS_CTL) + CW_BAR; bar.x = 0; bar.st = nullptr;
    if (!MK_MULTI) bar = xcd_barrier_post((unsigned*)(ws0 + WS_CTL) + CW_BAR, MISC + 8, wave0 * 64 + fresh_lane() == 0);
    const int lo = args.ph_lo, hi = args.ph_hi;
#define IN(k) (lo <= (k) && (k) < hi)
#define SEAM(k) do { if (IN(k) && IN((k) + 1)) xcd_barrier(bar, wave0 * 64 + fresh_lane() == 0); } while (0)

    if (IN(0)) {
        const int l_ = 0; PH_IDS();
        const float* x_in = args.in[0]; float* cosT = (float*)(ws + WS_TAB + TAB_COS); float* sinT = (float*)(ws + WS_TAB + TAB_SIN); float* b1T = (float*)(ws + WS_TAB + TAB_B1);
#define CONVERT_WEIGHTS(lw) do { LAS float* scr = (LAS float*)(L + wave * 16384); const float* ngw = args.in[1] + (size_t)(lw) * 6 * DM; \
        constexpr int I_GU = 16 * 176, I_DN = 44 * 32, I_IN = 16 * 112, I_OUT = 16 * 32, I_CMP = 16 * 16, I_LAYER = 2 * I_GU + 2 * I_DN + I_IN + I_OUT + I_CMP; \
        for (int it = gw; it < I_LAYER; it += NGW) { int r = it; unsigned char* wlw = ws + WS_W; \
            if (r < I_GU) { SrcGU s{args.in[2] + (size_t)(lw) * DM * NGU, ngw + 0 * DM}; transpose_item(s, DM, (bf16*)(wlw + WO_GU1), scr, r / 176, r % 176, lane); continue; } r -= I_GU; \
            if (r < I_DN) { SrcPlain s{args.in[3] + (size_t)(lw) * FF * DM, DM}; transpose_item(s, FF, (bf16*)(wlw + WO_DN1), scr, r / 32, r % 32, lane); continue; } r -= I_DN; \
            if (r < I_GU) { SrcGU s{args.in[4] + (size_t)(lw) * DM * NGU, ngw + 4 * DM}; transpose_item(s, DM, (bf16*)(wlw + WO_GU2), scr, r / 176, r % 176, lane); continue; } r -= I_GU; \
            if (r < I_DN) { SrcPlain s{args.in[5] + (size_t)(lw) * FF * DM, DM}; transpose_item(s, FF, (bf16*)(wlw + WO_DN2), scr, r / 32, r % 32, lane); continue; } r -= I_DN; \
            if (r < I_IN) { SrcIN s{args.in[6] + (size_t)(lw) * DM * INCOLS, ngw + 2 * DM}; transpose_item(s, DM, (bf16*)(wlw + WO_IN), scr, r / 112, r % 112, lane); continue; } r -= I_IN; \
            if (r < I_OUT) { SrcPlain s{args.in[7] + (size_t)(lw) * DM * DM, DM}; transpose_item(s, DM, (bf16*)(wlw + WO_OUT), scr, r / 32, r % 32, lane); continue; } r -= I_OUT; \
            { SrcCMP s{args.in[9] + (size_t)(lw) * 2 * 2048 * 128}; transpose_item(s, DM, (bf16*)(wlw + WO_CMP), scr, r / 16, r % 16, lane); } } } while (0)
        CONVERT_WEIGHTS(0);
        for (int i = blk * 512 + tid; i < SEQ * 8; i += G * 512) { const int pos = i >> 3, k = i & 7;
            const double inv = pow(500000.0, -(double)k / 8.0), ang = (double)pos * inv; cosT[i] = (float)cos(ang); sinT[i] = (float)sin(ang); }
        { LAS float* part = (LAS float*)(L + 131072);
          for (int ob = blk; ob < DEPTH * 2 * 128 / 2; ob += G) { const int o = 2 * ob + (wave >> 2), qr = wave & 3; const int lk = o >> 7, c = o & 127;
              const float* pe = args.in[8] + (size_t)lk * 2048; const float* w1 = args.in[9] + (size_t)lk * 2048 * 128;
              float s = 0.f; for (int r = qr * 512 + lane; r < qr * 512 + 512; r += 64) s += pe[r] * w1[(size_t)r * 128 + c];
              s = wave_sum(s, lane); if (lane == 0) part[wave] = s;
              __syncthreads();
              if (lane == 0 && qr == 0) b1T[o] = (part[wave] + part[wave + 1]) + (part[wave + 2] + part[wave + 3]);
              __syncthreads(); } }
        thin_phase<0>(nullptr, x_in, X16, nullptr, R2, nullptr, 0.f, gw, NGW, lane);
    }
    SEAM(0);

#pragma unroll 1
    for (int l = 0; l < DEPTH; ++l) {
        const int pb = 1 + l * PH_PER_LAYER, l_ = l;
        if (IN(pb + 0)) { PH_IDS(); pg8::Gemm g{X16, (const bf16*)(wl + WO_GU1), MTOK, NGU, DM}; pg8::StaticOrder S; S.init(MTOK, NGU, G, blk); EpiSwiglu E{HB, R2};
            pg8::gemm_phase<EpiSwiglu, pg8::StaticOrder, true, true>(L, g, S, E, tid); }
        SEAM(pb + 0);
        if (IN(pb + 1)) { PH_IDS(); pg8::Gemm g{HB, (const bf16*)(wl + WO_DN1), MTOK, DM, FF}; pg8::StaticOrder S; S.init(MTOK, DM, G, blk); pg8::EpiBf16<0> E{HD, DM, nullptr, 0, 0, 1.f};
            pg8::gemm_phase<pg8::EpiBf16<0>, pg8::StaticOrder, true, true>(L, g, S, E, tid); }
        SEAM(pb + 1);
        if (IN(pb + 2)) { PH_IDS(); thin_phase<1>(HD, nullptr, X16, nullptr, R2, ng + 1 * DM, 0.5f, gw, NGW, lane); }
        SEAM(pb + 2);
        if (IN(pb + 3)) { PH_IDS(); pg8::Gemm g{X16, (const bf16*)(wl + WO_IN), MTOK, NINP, DM}; pg8::StaticOrder S; S.init(MTOK, NINP, G, blk);
            EpiInProj E{ws};
            pg8::gemm_phase<EpiInProj, pg8::StaticOrder, true, true>(L, g, S, E, tid); }
        SEAM(pb + 3);
        if (IN(pb + 4)) { PH_IDS(); pg8::Gemm g{(const bf16*)(ws + WS_KCR), (const bf16*)(wl + WO_CMP), 8192, 512, DM}; CmpOrder S{blk, G}; EpiPQ E{(float*)(ws + WS_PQ)};
            pg8::gemm_phase<EpiPQ, CmpOrder, false, true>(L, g, S, E, tid);
            { const int nb = (G > 32) ? 32 : 0; if (blk >= nb) { mlstm_conv_pass(ws, args.in[11] + (size_t)l_ * 4 * 1024, args.in[12] + (size_t)l_ * 1024, (blk - nb) * 512 + tid, (G - nb) * 512); } } }
        SEAM(pb + 4);
        if (IN(pb + 5)) {
            PH_IDS();
            const float* b1T = (const float*)(ws + WS_TAB + TAB_B1); const float* PQ = (const float*)(ws + WS_PQ); bf16* CC = (bf16*)(ws + WS_CC);
            LAS float* w2s = (LAS float*)L; LAS float* hs = (LAS float*)(L + 32768) + wave * 4 * 128;
            for (int item = blk; item < 256; item += G) {
                const int kv = item >> 7, r0 = (item & 127) * 32 + wave * 4;
                const float* w2 = args.in[10] + (size_t)(l_ * 2 + kv) * 128 * 64; const float* b1 = b1T + (l_ * 2 + kv) * 128;
                __syncthreads();
                for (int i = tid; i < 128 * 64 / 4; i += 512) ((LAS f32x4*)w2s)[i] = ((const f32x4*)w2)[i];
#pragma unroll
                for (int rr = 0; rr < 4; ++rr) { const int r = kv * 4096 + r0 + rr, n = (r0 + rr) & 127;
#pragma unroll
                    for (int q2 = 0; q2 < 2; ++q2) { const int c = lane + 64 * q2; float hval = 0.f;
                        if (n != 127) { const float v = PQ[(size_t)r * 256 + c] + PQ[(size_t)(r + 1) * 256 + 128 + c] + b1[c];
                            const float u3 = 0.7978845608028654f * (v + 0.044715f * v * v * v); hval = 0.5f * v * (1.f + tanhf(u3)); }
                        hs[rr * 128 + c] = hval; } }
                __syncthreads();
                float o0 = 0.f, o1 = 0.f, o2 = 0.f, o3 = 0.f;
#pragma unroll 8
                for (int c = 0; c < 128; ++c) { const float wv = w2s[c * 64 + lane]; o0 += hs[c] * wv; o1 += hs[128 + c] * wv; o2 += hs[256 + c] * wv; o3 += hs[384 + c] * wv; }
                bf16* cp = CC + ((size_t)kv * 4096 + r0) * 64 + lane;
                cp[0] = (bf16)f2bf(o0); cp[64] = (bf16)f2bf(o1); cp[128] = (bf16)f2bf(o2); cp[192] = (bf16)f2bf(o3);
            }
        }
        SEAM(pb + 5);
        if (IN(pb + 6)) {
            PH_IDS();
            MixPtrs P{ws, args.in[11] + (size_t)l * 4 * 1024, args.in[12] + (size_t)l * 1024, args.in[13] + l * 4, args.in[14] + l * 4, args.in[15] + l * 512};
#ifndef PROBE_MIX_REP
#define PROBE_MIX_REP 1
#endif
            for (int rep = 0; rep < PROBE_MIX_REP; ++rep) {
            for (int u = blk; u < 64; u += G) mlstm_unit_mfma(L, P, u >> 2, u & 3, tid);
            { unsigned* qbase = (unsigned*)(ws + WS_CTL) + CW_QUEUE + 1024 * l_; volatile LAS unsigned* QW = (volatile LAS unsigned*)(L + MISC_OFF);
              const unsigned q0 = xb_xcc_id() & 7u;
#pragma unroll 1
              for (unsigned qq = 0; qq < 8u; ++qq) { unsigned* qctr = qbase + 64 * ((q0 + qq) & 7u); const int bg0 = 4 * (int)((q0 + qq) & 7u);
                  __syncthreads();
                  if (tid == 0) QW[0] = __hip_atomic_fetch_add(qctr, 1u, __ATOMIC_RELAXED, __HIP_MEMORY_SCOPE_AGENT);
                  __syncthreads();
                  unsigned u = QW[0];
                  while (u < 128u) { unsigned nxt = 0u; if (tid == 0) nxt = __hip_atomic_fetch_add(qctr, 1u, __ATOMIC_RELAXED, __HIP_MEMORY_SCOPE_AGENT);
                      const int c = 31 - (int)(u & 31u), bg = bg0 + (int)(u >> 5); nsa_unit_mfma(L, P, bg >> 1, bg & 1, c, tid);
                      __syncthreads(); if (tid == 0) QW[0] = nxt; __syncthreads(); u = QW[0]; } } }
            }
        }
        SEAM(pb + 6);
        if (IN(pb + 7)) { PH_IDS(); pg8::Gemm g{U, (const bf16*)(wl + WO_OUT), MTOK, DM, DM}; pg8::StaticOrder S; S.init(MTOK, DM, G, blk); pg8::EpiBf16<0> E{HD, DM, nullptr, 0, 0, 1.f};
            pg8::gemm_phase<pg8::EpiBf16<0>, pg8::StaticOrder, true, true>(L, g, S, E, tid); }
        SEAM(pb + 7);
        if (IN(pb + 8)) { PH_IDS(); thin_phase<1>(HD, nullptr, X16, nullptr, R2, ng + 3 * DM, 1.0f, gw, NGW, lane); }
        SEAM(pb + 8);
        if (IN(pb + 9)) { PH_IDS(); pg8::Gemm g{X16, (const bf16*)(wl + WO_GU2), MTOK, NGU, DM}; pg8::StaticOrder S; S.init(MTOK, NGU, G, blk); EpiSwiglu E{HB, R2};
            pg8::gemm_phase<EpiSwiglu, pg8::StaticOrder, true, true>(L, g, S, E, tid); }
        SEAM(pb + 9);
        if (IN(pb + 10)) { PH_IDS(); pg8::Gemm g{HB, (const bf16*)(wl + WO_DN2), MTOK, DM, FF}; pg8::StaticOrder S; S.init(MTOK, DM, G, blk); pg8::EpiBf16<0> E{HD, DM, nullptr, 0, 0, 1.f};
            pg8::gemm_phase<pg8::EpiBf16<0>, pg8::StaticOrder, true, true>(L, g, S, E, tid); }
        SEAM(pb + 10);
        if (IN(pb + 11)) { PH_IDS(); if (l + 1 < DEPTH) { thin_phase<1>(HD, nullptr, X16, nullptr, R2, ng + 5 * DM, 0.5f, gw, NGW, lane); CONVERT_WEIGHTS(l_ + 1); }
                           else thin_phase<2>(HD, nullptr, X16, args.out, nullptr, ng + 5 * DM, 0.5f, gw, NGW, lane); }
        if (l + 1 < DEPTH) SEAM(pb + 11);
    }
#undef IN
#undef SEAM
#undef CONVERT_WEIGHTS
#undef PH_IDS
#undef PH_WS
}

extern "C" void kernel_launch(void* const* d_in, const int* in_sizes, int n_in, void* d_out, int out_size, void* d_ws, size_t ws_size, hipStream_t stream) {
    static int grid = 0;
    if (grid == 0) {
        if (n_in != 16 || in_sizes[0] != MTOK * DM || out_size != MTOK * DM || ws_size < WS_END2) { fprintf(stderr, "kernel_launch: unexpected problem (n_in %d, ws %zu)\n", n_in, ws_size); grid = -1; return; }
        int dev = 0, cus = 0, per_cu = 0;
        if (hipGetDevice(&dev) != hipSuccess || hipDeviceGetAttribute(&cus, hipDeviceAttributeMultiprocessorCount, dev) != hipSuccess) { grid = -1; return; }
        if (hipFuncSetAttribute((const void*)fwd_kernel, hipFuncAttributeMaxDynamicSharedMemorySize, LDS_BYTES) != hipSuccess) { grid = -1; return; }
        if (hipOccupancyMaxActiveBlocksPerMultiprocessor(&per_cu, (const void*)fwd_kernel, NWAVES * 64, LDS_BYTES) != hipSuccess || per_cu < 1) { fprintf(stderr, "kernel_launch: occupancy query says %d\n", per_cu); }
        (void)hipGetLastError();
        grid = cus;
    }
    if (grid < 0) return;
    (void)hipMemsetAsync((char*)d_ws + WS_CTL, 0, CTL_ZERO_BYTES, stream);
    Args a{};
    for (int i = 0; i < 16; ++i) a.in[i] = (const float*)d_in[i];
    a.out = (float*)d_out; a.ws = (unsigned char*)d_ws;
#if MK_MULTI
    for (int p = 0; p < N_PHASES; ++p) { a.ph_lo = p; a.ph_hi = p + 1; hipLaunchKernelGGL(fwd_kernel, dim3(grid), dim3(NWAVES * 64), LDS_BYTES, stream, a); }
#else
    a.ph_lo = 0; a.ph_hi = N_PHASES; hipLaunchKernelGGL(fwd_kernel, dim3(grid), dim3(NWAVES * 64), LDS_BYTES, stream, a);
#endif
}
```

```cpp
#include <hip/hip_runtime.h>
#include <cstdio>
#include <cstdint>
namespace pg8 {
#define PG8_LAS __attribute__((address_space(3)))
typedef unsigned short bf16_t;
typedef short bf16x8 __attribute__((ext_vector_type(8)));
typedef float f32x4 __attribute__((ext_vector_type(4)));
typedef unsigned u32x4 __attribute__((ext_vector_type(4)));
constexpr int BM = 256, BK = 64, HALF = 128, HTB = HALF * BK * 2  , STAGE_BYTES = 8 * HTB, NXCD = 8, WGM = 4;

__host__ __device__ __forceinline__ int lds_byte(int r, int c) { const int st = (r >> 4) * 2 + (c >> 5), rr = r & 15, cc = c & 31, ob = rr * 64 + cc * 2; return st * 1024 + (ob ^ (((ob >> 9) & 1) << 5)); }
__host__ __device__ __forceinline__ void stage_rc(int b, int& R, int& C) { const int st = b / 1024, sb = b % 1024, swz = sb ^ (((sb >> 9) & 1) << 5); R = (st >> 1) * 16 + swz / 64; C = (st & 1) * 32 + (swz % 64) / 2; }
__host__ __device__ __forceinline__ int perm32(int rho) { const int n = rho >> 4, i = rho & 15; return 8 * (i >> 2) + 4 * n + (i & 3); }

struct Unit { int pm, pn; };
struct Gemm { const bf16_t* A; const bf16_t* Bt; int M, N, K; };

struct StaticOrder {
    int nM, nN, nwg, G, c;
    __host__ __device__ void init(int M, int N, int G_, int c_) { nM = M / BM; nN = N / BM; nwg = nM * nN; G = G_; c = c_; }
    __host__ __device__ bool next(int i, Unit& u) const {
        const long L = (long)i * G + c; if (L >= nwg) return false;
        int wgid = (int)L; { const int q = nwg / NXCD, r = nwg % NXCD, xcd = wgid % NXCD, off = wgid / NXCD; wgid = (xcd < r ? xcd * (q + 1) : r * (q + 1) + (xcd - r) * q) + off; }
        const int nig = WGM * nN, gid = wgid / nig, fm = gid * WGM, gsz = (nM - fm) < WGM ? (nM - fm) : WGM;
        u.pm = fm + ((wgid % nig) % gsz); u.pn = (wgid % nig) / gsz; return true;
    }
    __device__ __forceinline__ void a_ready(const Unit&) const {}
    __device__ __forceinline__ void done(const Unit&) const {}
};

__device__ __forceinline__ unsigned cvt_pk_bf16(float lo, float hi) { unsigned r; asm volatile("v_cvt_pk_bf16_f32 %0, %1, %2" : "=v"(r) : "v"(lo), "v"(hi)); return r; }
typedef float f32x2 __attribute__((ext_vector_type(2)));
__device__ __forceinline__ f32x2 gelu_pk(f32x2 v) {
    const f32x2 av = __builtin_elementwise_abs(v), d = av * 0.2316418882f + 1.0f;
    f32x2 t; t.x = __builtin_amdgcn_rcpf(d.x); t.y = __builtin_amdgcn_rcpf(d.y);
    f32x2 q = t * 0.5307027145f + (-0.7265760135f); q = q * t + 0.7107068705f; q = q * t + (-0.142248368f); q = q * t + 0.127414796f; q = q * t;
    const f32x2 s = (v * v) * (-0.72134752044f);
    f32x2 e; e.x = __builtin_amdgcn_exp2f(s.x); e.y = __builtin_amdgcn_exp2f(s.y);
    const f32x2 m = v * (q * e), r = v - m;
    f32x2 o; o.x = v.x < 0.f ? m.x : r.x; o.y = v.y < 0.f ? m.y : r.y; return o;
}

template <int ACT  > struct EpiBf16 {
    static constexpr bool PERM = true, AFTER_DRAIN = false; static_assert(ACT == 0 || ACT == 1, "EpiBf16: ACT is 0 (none) or 1 (gelu_pk)");
    bf16_t* O; int ldc; const float* bias; int split_cols; size_t split_stride; float scale0;
    __device__ __forceinline__ void operator()(const f32x4 (&acc)[2][2][4][2], const Unit& u, int wr, int wc, int fr, int fq) const {
        const int row0 = u.pm * BM + wr * 64 + fr; int colt = u.pn * BM; bf16_t* base = O;
        float sc = 1.f; if (split_cols) { const int t = colt / split_cols; base += (size_t)t * split_stride; colt -= t * split_cols; if (t == 0) sc = scale0; }
        const int col0 = colt + wc * 32 + 8 * fq, bcol0 = u.pn * BM + wc * 32 + 8 * fq;
        f32x4 bv[2][2];
#pragma unroll
        for (int bj = 0; bj < 2; ++bj)
#pragma unroll
            for (int n = 0; n < 2; ++n) bv[bj][n] = bias ? *(const f32x4*)(bias + bcol0 + bj * HALF + 4 * n) : (f32x4){0.f, 0.f, 0.f, 0.f};
#pragma unroll
        for (int ai = 0; ai < 2; ++ai)
#pragma unroll
            for (int m = 0; m < 4; ++m) { bf16_t* rowp = base + (size_t)(row0 + ai * HALF + m * 16) * ldc + col0;
#pragma unroll
                for (int bj = 0; bj < 2; ++bj) { f32x4 v0 = acc[ai][bj][m][0] + bv[bj][0], v1 = acc[ai][bj][m][1] + bv[bj][1];
                    if (ACT == 1) { f32x2 a = gelu_pk((f32x2){v0[0], v0[1]}), b = gelu_pk((f32x2){v0[2], v0[3]}), c = gelu_pk((f32x2){v1[0], v1[1]}), d = gelu_pk((f32x2){v1[2], v1[3]});
                        v0 = (f32x4){a.x, a.y, b.x, b.y}; v1 = (f32x4){c.x, c.y, d.x, d.y}; }
                    v0 = v0 * sc; v1 = v1 * sc; u32x4 w; w.x = cvt_pk_bf16(v0[0], v0[1]); w.y = cvt_pk_bf16(v0[2], v0[3]); w.z = cvt_pk_bf16(v1[0], v1[1]); w.w = cvt_pk_bf16(v1[2], v1[3]);
                    *(u32x4*)(rowp + bj * HALF) = w; } }
    }
};
template <class Epi, class Sched, bool ALIGN_EPI = false, bool SP2 = false>
__device__ __forceinline__ void gemm_phase(PG8_LAS unsigned char* lds, const Gemm g, const Sched& S, const Epi& E, int tid_in) {
    int tid_l = tid_in; asm volatile("" : "+v"(tid_l));
    const int tid = tid_l, wid = __builtin_amdgcn_readfirstlane(tid >> 6), lane = tid & 63, wr = wid >> 2, wc = wid & 3, fr = lane & 15, fq = lane >> 4;
    const int K = g.K, nt = K / BK;
    unsigned voffA[2], voffB[2];
#pragma unroll
    for (int i = 0; i < 2; ++i) { int R, C; stage_rc(tid * 16 + i * 8192, R, C); const int Rb = Epi::PERM ? ((R & ~31) + perm32(R & 31)) : R;
        voffA[i] = (unsigned)(R * K + C) * 2u; voffB[i] = (unsigned)(Rb * K + C) * 2u; }
    const size_t kstep = (size_t)(BK * 2);
    const size_t hstep = (size_t)HALF * K * 2;
    const size_t tstep = 2 * hstep;
    const unsigned ldsw = (unsigned)wid * 1024u;
    const int aoff = lds_byte(wr * 64 + fr, fq * 8), boff = lds_byte(wc * 32 + fr, fq * 8);
#define PG8_SA(b, h) (((b) * 2 + (h)) * HTB)
#define PG8_SB(b, h) ((4 + (b) * 2 + (h)) * HTB)
#define PG8_STAGE(bufoff, gbase, voff) do { _Pragma("unroll") for (int _i = 0; _i < 2; ++_i) \
        __builtin_amdgcn_global_load_lds((const unsigned*)((const char*)(gbase) + (voff)[_i]), (PG8_LAS unsigned*)(lds + (bufoff) + ldsw + _i * 8192), 16, 0, 0); } while (0)
#define PG8_LDA(dst, b, h) do { _Pragma("unroll") for (int m = 0; m < 4; ++m) _Pragma("unroll") for (int k = 0; k < 2; ++k) dst[m][k] = *(const PG8_LAS bf16x8*)(lds + PG8_SA(b, h) + aoff + m * 2048 + k * 1024); } while (0)
#define PG8_LDB(dst, b, h) do { _Pragma("unroll") for (int n = 0; n < 2; ++n) _Pragma("unroll") for (int k = 0; k < 2; ++k) dst[n][k] = *(const PG8_LAS bf16x8*)(lds + PG8_SB(b, h) + boff + n * 2048 + k * 1024); } while (0)
#define PG8_MMA(ai, bj, At, Bt) do { __builtin_amdgcn_s_setprio(1); _Pragma("unroll") for (int m = 0; m < 4; ++m) _Pragma("unroll") for (int n = 0; n < 2; ++n) _Pragma("unroll") for (int k = 0; k < 2; ++k) \
        acc[ai][bj][m][n] = __builtin_amdgcn_mfma_f32_16x16x32_bf16(Bt[n][k], At[m][k], acc[ai][bj][m][n], 0, 0, 0); __builtin_amdgcn_s_setprio(0); } while (0)
#define PG8_WAIT_V(n) asm volatile("s_waitcnt vmcnt(" #n ")" ::: "memory")
#define PG8_WAIT_L(n) asm volatile("s_waitcnt lgkmcnt(" #n ")" ::: "memory")
#define PG8_BAR __builtin_amdgcn_s_barrier()
#define PG8_SCHED __builtin_amdgcn_sched_barrier(0)
    Unit cur, nxt; int ui = 0;
    if (!S.next(0, cur)) return;
    f32x4 acc[2][2][4][2];
#pragma unroll
    for (int a = 0; a < 2; ++a)
#pragma unroll
        for (int b = 0; b < 2; ++b)
#pragma unroll
            for (int m = 0; m < 4; ++m)
#pragma unroll
                for (int n = 0; n < 2; ++n) acc[a][b][m][n] = (f32x4){0.f, 0.f, 0.f, 0.f};
    bf16x8 At[4][2], B0[2][2], B1[2][2];
    const char* cA = (const char*)g.A + (size_t)cur.pm * tstep; const char* cB = (const char*)g.Bt + (size_t)cur.pn * tstep;
    S.a_ready(cur);
    if constexpr (SP2) {
        PG8_STAGE(PG8_SB(0, 0), cB, voffB); PG8_STAGE(PG8_SB(0, 1), cB + hstep, voffB); PG8_STAGE(PG8_SA(0, 0), cA, voffA); PG8_STAGE(PG8_SA(0, 1), cA + hstep, voffA);
        if (wr == 1) PG8_BAR;
        PG8_WAIT_V(2); PG8_BAR;
        PG8_STAGE(PG8_SB(1, 0), cB + kstep, voffB); PG8_STAGE(PG8_SA(1, 0), cA + kstep, voffA); PG8_STAGE(PG8_SB(1, 1), cB + hstep + kstep, voffB);
        PG8_WAIT_V(6); PG8_BAR;
    } else {
        PG8_STAGE(PG8_SB(0, 0), cB, voffB); PG8_STAGE(PG8_SA(0, 0), cA, voffA); PG8_STAGE(PG8_SB(0, 1), cB + hstep, voffB); PG8_STAGE(PG8_SA(0, 1), cA + hstep, voffA);
        if (wr == 1) PG8_BAR;
        PG8_WAIT_V(4); PG8_BAR;
        PG8_STAGE(PG8_SB(1, 0), cB + kstep, voffB); PG8_STAGE(PG8_SA(1, 0), cA + kstep, voffA); PG8_STAGE(PG8_SB(1, 1), cB + hstep + kstep, voffB);
        PG8_WAIT_V(6); PG8_BAR;
    }
    for (;;) {
        const bool has_next = S.next(ui + 1, nxt);
        const char* nA = has_next ? (const char*)g.A + (size_t)nxt.pm * tstep : cA; const char* nB = has_next ? (const char*)g.Bt + (size_t)nxt.pn * tstep : cB;
        for (int t = 0; t < nt; t += 2) {
            const bool last = (t == nt - 2);
            const char* a1 = cA + (size_t)(t + 1) * kstep;
            const char* a2 = last ? nA : cA + (size_t)(t + 2) * kstep; const char* b2 = last ? nB : cB + (size_t)(t + 2) * kstep;
            const char* a3 = a2 + kstep; const char* b3 = b2 + kstep;
            if (last && has_next) S.a_ready(nxt);
            if constexpr (SP2) {
            PG8_LDB(B0, 0, 0); PG8_LDB(B1, 0, 1); PG8_SCHED; PG8_LDA(At, 0, 0); PG8_STAGE(PG8_SA(1, 1), a1 + hstep, voffA);
            PG8_WAIT_V(8); PG8_WAIT_L(0); PG8_BAR; PG8_MMA(0, 0, At, B0); PG8_MMA(0, 1, At, B1); PG8_BAR; PG8_SCHED;
            PG8_LDA(At, 0, 1); PG8_STAGE(PG8_SB(0, 0), b2, voffB); PG8_STAGE(PG8_SB(0, 1), b2 + hstep, voffB); PG8_STAGE(PG8_SA(0, 0), a2, voffA);
            PG8_WAIT_V(8); PG8_WAIT_L(0); PG8_BAR; PG8_MMA(1, 0, At, B0); PG8_MMA(1, 1, At, B1); PG8_BAR; PG8_SCHED;
            PG8_LDB(B0, 1, 0); PG8_LDB(B1, 1, 1); PG8_SCHED; PG8_LDA(At, 1, 0); PG8_STAGE(PG8_SA(0, 1), a2 + hstep, voffA);
            PG8_WAIT_V(8); PG8_WAIT_L(0); PG8_BAR; PG8_MMA(0, 0, At, B0); PG8_MMA(0, 1, At, B1); PG8_BAR; PG8_SCHED;
            PG8_LDA(At, 1, 1); PG8_STAGE(PG8_SB(1, 0), b3, voffB); PG8_STAGE(PG8_SB(1, 1), b3 + hstep, voffB); PG8_STAGE(PG8_SA(1, 0), a3, voffA);
            PG8_WAIT_V(8); PG8_WAIT_L(0); PG8_BAR; PG8_MMA(1, 0, At, B0); PG8_MMA(1, 1, At, B1); PG8_BAR; PG8_SCHED;
            } else {
            PG8_LDB(B0, 0, 0); PG8_SCHED; PG8_LDA(At, 0, 0); PG8_STAGE(PG8_SA(1, 1), a1 + hstep, voffA);
            PG8_WAIT_L(8); PG8_BAR; PG8_WAIT_L(0); PG8_MMA(0, 0, At, B0); PG8_BAR; PG8_SCHED;
            PG8_LDB(B1, 0, 1); PG8_STAGE(PG8_SB(0, 0), b2, voffB);
            PG8_BAR; PG8_WAIT_L(0); PG8_MMA(0, 1, At, B1); PG8_BAR;
            PG8_LDA(At, 0, 1); PG8_STAGE(PG8_SA(0, 0), a2, voffA);
            PG8_BAR; PG8_WAIT_L(0); PG8_MMA(1, 0, At, B0); PG8_BAR; PG8_SCHED;
            PG8_STAGE(PG8_SB(0, 1), b2 + hstep, voffB);
            PG8_WAIT_V(6); PG8_BAR; PG8_MMA(1, 1, At, B1); PG8_BAR;
            PG8_LDB(B0, 1, 0); PG8_SCHED; PG8_LDA(At, 1, 0); PG8_STAGE(PG8_SA(0, 1), a2 + hstep, voffA);
            PG8_WAIT_L(8); PG8_BAR; PG8_WAIT_L(0); PG8_MMA(0, 0, At, B0); PG8_BAR; PG8_SCHED;
            PG8_LDB(B1, 1, 1); PG8_STAGE(PG8_SB(1, 0), b3, voffB);
            PG8_BAR; PG8_WAIT_L(0); PG8_MMA(0, 1, At, B1); PG8_BAR;
            PG8_LDA(At, 1, 1); PG8_STAGE(PG8_SA(1, 0), a3, voffA);
            PG8_BAR; PG8_WAIT_L(0); PG8_MMA(1, 0, At, B0); PG8_BAR; PG8_SCHED;
            PG8_STAGE(PG8_SB(1, 1), b3 + hstep, voffB);
            PG8_WAIT_V(6); PG8_BAR; PG8_MMA(1, 1, At, B1); PG8_BAR;
            }
        }
        if constexpr (ALIGN_EPI) { if (wr == 0) PG8_BAR; }
        if constexpr (!Epi::AFTER_DRAIN) { E(acc, cur, wr, wc, fr, fq); S.done(cur); }
        if (!has_next) break;
#pragma unroll
        for (int a = 0; a < 2; ++a)
#pragma unroll
            for (int b = 0; b < 2; ++b)
#pragma unroll
                for (int m = 0; m < 4; ++m)
#pragma unroll
                    for (int n = 0; n < 2; ++n) acc[a][b][m][n] = (f32x4){0.f, 0.f, 0.f, 0.f};
        cur = nxt; cA = nA; cB = nB; ++ui;
        if constexpr (ALIGN_EPI) { if (wr == 1) PG8_BAR; }
    }
    PG8_WAIT_V(0);
    if constexpr (!ALIGN_EPI) { if (wr == 0) PG8_BAR; }
    PG8_BAR;
    if constexpr (Epi::AFTER_DRAIN) { E.fused(acc, cur, wr, wc, fr, fq, lds, wid, lane); S.done(cur); }
#undef PG8_SA
#undef PG8_SB
#undef PG8_STAGE
#undef PG8_LDA
#undef PG8_LDB
#undef PG8_MMA
#undef PG8_WAIT_V
#undef PG8_WAIT_L
#undef PG8_BAR
#undef PG8_SCHED
}
}

#define LAS __attribute__((address_space(3)))
#define XB_TMO      128
#define XB_XCNT(j)  (256  + 64 * (j))
#define XB_XSUB(j)  (1280 + 64 * (j))
#define XB_XGEN(j)  (2304 + 64 * (j))
#define XB_TOP      3328
#define XB_TOPGEN   3392
#define XCD_BAR_WORDS 3456
#define XB_SPIN_CAP (1u << 18)

__device__ __forceinline__ unsigned xb_ld(unsigned* p)              { return __hip_atomic_load(p, __ATOMIC_RELAXED, __HIP_MEMORY_SCOPE_AGENT); }
__device__ __forceinline__ unsigned xb_add(unsigned* p, unsigned v) { return __hip_atomic_fetch_add(p, v, __ATOMIC_RELAXED, __HIP_MEMORY_SCOPE_AGENT); }
__device__ __forceinline__ unsigned xb_xcc_id() { return (unsigned)__builtin_amdgcn_s_getreg((3 << 11) | 20) & 0xFu; }
#define XB_SPIN(cond, bar) do { unsigned _sp = 0; while (cond) { __builtin_amdgcn_s_sleep(1); \
    if ((++_sp & 255u) == 0u) { if (xb_ld(&(bar)[XB_TMO])) break; if (_sp > XB_SPIN_CAP) { atomicAdd(&(bar)[XB_TMO], 1u); break; } } } } while (0)

struct XcdBarrier {
    unsigned* bar; unsigned x;
    volatile LAS unsigned* st;
};

__device__ __forceinline__ XcdBarrier xcd_barrier_post(unsigned* bar, volatile LAS unsigned* st, bool leader) {
    XcdBarrier b; b.bar = bar; b.x = xb_xcc_id(); b.st = st;
    if (leader) (void)xb_add(&bar[XB_XCNT(b.x)], 1u);
    return b;
}
__device__ __forceinline__ void xcd_barrier_complete(unsigned* bar, unsigned x, unsigned& nloc, unsigned& nx) {
    const unsigned G = gridDim.x * gridDim.y * gridDim.z;
    unsigned sum, cnt, mine, sp = 0u;
    for (;;) {
        sum = 0u; cnt = 0u; mine = 0u;
#pragma unroll
        for (unsigned j = 0; j < 16; ++j) { const unsigned c = xb_ld(&bar[XB_XCNT(j)]); sum += c; cnt += (c > 0u) ? 1u : 0u; mine = (j == x) ? c : mine; }
        if (sum == G) break;
        __builtin_amdgcn_s_sleep(1);
        if ((++sp & 255u) == 0u) { if (xb_ld(&bar[XB_TMO])) break; if (sp > XB_SPIN_CAP) { atomicAdd(&bar[XB_TMO], 1u); break; } }
    }
    nloc = mine > 0u ? mine : 1u; nx = cnt > 0u ? cnt : 1u;
}

__device__ __forceinline__ void xcd_barrier(const XcdBarrier& b, bool leader) {
    asm volatile("s_waitcnt vmcnt(0)" ::: "memory");
    __syncthreads();
    if (leader) {
        unsigned* bar = b.bar;
        __builtin_amdgcn_s_waitcnt(0);
        unsigned nloc = b.st[0], nx = b.st[1];
        if (nloc == 0u) { xcd_barrier_complete(bar, b.x, nloc, nx); b.st[0] = nloc; b.st[1] = nx; }
        const unsigned old = xb_add(&bar[XB_XSUB(b.x)], 1u);
        const unsigned gen = old / nloc;
        if (old + 1u == (gen + 1u) * nloc) {
            __builtin_amdgcn_fence(__ATOMIC_RELEASE, "agent");
            asm volatile("s_waitcnt vmcnt(0)" ::: "memory");
            const unsigned og = xb_add(&bar[XB_TOP], 1u);
            const unsigned tg = og / nx;
            if (og + 1u == (tg + 1u) * nx) xb_add(&bar[XB_TOPGEN], 1u);
            else XB_SPIN(xb_ld(&bar[XB_TOPGEN]) == tg, bar);
            __builtin_amdgcn_fence(__ATOMIC_ACQUIRE, "agent");
            xb_add(&bar[XB_XGEN(b.x)], 1u);
            asm volatile("s_waitcnt vmcnt(0)" ::: "memory");
        } else {
            XB_SPIN(xb_ld(&bar[XB_XGEN(b.x)]) == gen, bar);
            __builtin_amdgcn_fence(__ATOMIC_ACQUIRE, "agent");
            asm volatile("s_waitcnt vmcnt(0)" ::: "memory");
        }
    }
    __syncthreads();
}

constexpr int BATCH = 16, SEQ = 2048, DM = 1024, MTOK = BATCH * SEQ, FF = 2816, NGU = 2 * FF, NINP = 3584, INCOLS = 3360, DEPTH = 2;
constexpr int NWAVES = 8;
constexpr float EPS = 1e-6f;
typedef unsigned short bf16;
typedef unsigned v4u __attribute__((ext_vector_type(4)));
typedef unsigned v2u __attribute__((ext_vector_type(2)));
typedef float f32x4 __attribute__((ext_vector_type(4)));
#define LDS_WAIT() asm volatile("s_waitcnt lgkmcnt(0)" ::: "memory")

constexpr size_t MiB = 1u << 20;
constexpr size_t WS_CTL = 0, CTL_ZERO_BYTES = MiB;
constexpr size_t WS_TAB = 1 * MiB;
constexpr size_t TAB_COS = 0, TAB_SIN = 65536, TAB_B1 = 131072, TAB_R2 = 262144;
constexpr size_t WS_W = 2 * MiB;
constexpr size_t WO_GU1 = 0, WO_DN1 = 11 * MiB, WO_GU2 = 16 * MiB + MiB / 2, WO_DN2 = 27 * MiB + MiB / 2, WO_IN = 33 * MiB, WO_OUT = 40 * MiB, WO_CMP = 42 * MiB;
constexpr size_t WS_X16 = 45 * MiB;
constexpr size_t WS_U = 109 * MiB;
constexpr size_t WS_HB = 173 * MiB;
constexpr size_t WS_HD = 349 * MiB;
constexpr size_t WS_PQ = 413 * MiB;
constexpr size_t WS_CC = 421 * MiB;
constexpr size_t WS_END = 422 * MiB;
constexpr size_t WS_QN = 173 * MiB, WS_KCR = 205 * MiB, WS_VCR = 213 * MiB, WS_KS = 221 * MiB, WS_VS = 229 * MiB, WS_KW = 237 * MiB, WS_VW = 245 * MiB;
constexpr size_t WS_MQ = 253 * MiB, WS_MK = 285 * MiB, WS_MV = 317 * MiB, WS_MO = 349 * MiB, WS_GATE = 381 * MiB;
static_assert(WS_GATE + 4 * MiB <= WS_PQ, "in-projection outputs end below PQ");
constexpr int CW_BAR = 4096, CW_QUEUE = 16384;
constexpr int PH_BYTES = 143360, MISC_OFF = PH_BYTES, LDS_BYTES = 147456;

__device__ __forceinline__ unsigned f2bf(float f) { unsigned u = __builtin_bit_cast(unsigned, f); return (u + 0x7fffu + ((u >> 16) & 1u)) >> 16; }
__device__ __forceinline__ unsigned pk2(float lo, float hi) { return f2bf(lo) | (f2bf(hi) << 16); }
typedef float f32x2v_ __attribute__((ext_vector_type(2))); typedef __bf16 bf16x2v_ __attribute__((ext_vector_type(2)));
__device__ __forceinline__ unsigned cvtpk(float lo, float hi) { f32x2v_ v = {lo, hi}; bf16x2v_ b = __builtin_convertvector(v, bf16x2v_); return __builtin_bit_cast(unsigned, b); }
__device__ __forceinline__ float bflo(unsigned u) { return __builtin_bit_cast(float, u << 16); }
__device__ __forceinline__ float bfhi(unsigned u) { return __builtin_bit_cast(float, u & 0xffff0000u); }
__device__ __forceinline__ float bf2f(bf16 b) { return __builtin_bit_cast(float, (unsigned)b << 16); }
__device__ __forceinline__ float sigmoidf_(float x) { return __builtin_amdgcn_rcpf(1.f + __expf(-x)); }
__device__ __forceinline__ int fresh_lane() { unsigned z = 0u; asm volatile("" : "+v"(z)); return (int)__builtin_amdgcn_mbcnt_hi(~0u, __builtin_amdgcn_mbcnt_lo(~0u, z)); }
__device__ __forceinline__ float shx(float v, int mask, int lane) { return __builtin_bit_cast(float, __builtin_amdgcn_ds_bpermute((lane ^ mask) << 2, __builtin_bit_cast(int, v))); }
__device__ __forceinline__ unsigned shxu(unsigned v, int mask, int lane) { return (unsigned)__builtin_amdgcn_ds_bpermute((lane ^ mask) << 2, (int)v); }
__device__ __forceinline__ float shi(float v, int src) { return __builtin_bit_cast(float, __builtin_amdgcn_ds_bpermute(src << 2, __builtin_bit_cast(int, v))); }
__device__ __forceinline__ float wave_sum(float v, int lane) {
    (void)lane;
    v += __builtin_bit_cast(float, __builtin_amdgcn_update_dpp(0, __builtin_bit_cast(int, v), 0xB1, 0xF, 0xF, false));
    v += __builtin_bit_cast(float, __builtin_amdgcn_update_dpp(0, __builtin_bit_cast(int, v), 0x4E, 0xF, 0xF, false));
    v += __builtin_bit_cast(float, __builtin_amdgcn_update_dpp(0, __builtin_bit_cast(int, v), 0x124, 0xF, 0xF, false));
    v += __builtin_bit_cast(float, __builtin_amdgcn_update_dpp(0, __builtin_bit_cast(int, v), 0x128, 0xF, 0xF, false));
    const int iv = __builtin_bit_cast(int, v);
    const float a = __builtin_bit_cast(float, __builtin_amdgcn_readlane(iv, 0)), b = __builtin_bit_cast(float, __builtin_amdgcn_readlane(iv, 16));
    const float c = __builtin_bit_cast(float, __builtin_amdgcn_readlane(iv, 32)), d = __builtin_bit_cast(float, __builtin_amdgcn_readlane(iv, 48));
    return (a + b) + (c + d);
}

struct SrcGU { const float* W; const float* g; __device__ __forceinline__ float operator()(int k, int nd) const { const int pn = nd >> 8, r = nd & 255; const int col = (r < 128) ? (pn * 128 + r) : (FF + pn * 128 + r - 128); return W[(size_t)k * NGU + col] * g[k]; } };
struct SrcPlain { const float* W; int N; __device__ __forceinline__ float operator()(int k, int nd) const { return W[(size_t)k * N + nd]; } };
struct SrcIN { const float* W; const float* g; __device__ __forceinline__ float operator()(int k, int nd) const {
    const int col = nd < 1280 ? nd : (nd < 3328 ? nd + 24 : (nd < 3352 ? nd - 3328 + 1280 : (nd < 3360 ? nd : -1)));
    return col < 0 ? 0.f : W[(size_t)k * INCOLS + col] * g[k]; } };
struct SrcCMP { const float* W1; __device__ __forceinline__ float operator()(int k, int nd) const { const int kv = nd >> 8, r = nd & 255;
    return r < 128 ? W1[((size_t)kv * 2048 + k) * 128 + r] : W1[((size_t)kv * 2048 + 1024 + k) * 128 + r - 128]; } };

template <class SrcF>
__device__ __forceinline__ void transpose_item(const SrcF& src, int K, bf16* WT, LAS float* scr, int kb, int nb, int lane) {
    const int k0 = 64 * kb, n0 = 32 * nb;
#pragma unroll 8
    for (int i = 0; i < 32; ++i) { const int kk = 2 * i + (lane >> 5); scr[kk * 33 + (lane & 31)] = src(k0 + kk, n0 + (lane & 31)); }
    LDS_WAIT(); asm volatile("" ::: "memory");
    const int c = lane & 7;
#pragma unroll
    for (int j = 0; j < 4; ++j) { const int n = (lane >> 3) + 8 * j; const LAS float* s = scr + (8 * c) * 33 + n;
        v4u o; o.x = pk2(s[0 * 33], s[1 * 33]); o.y = pk2(s[2 * 33], s[3 * 33]); o.z = pk2(s[4 * 33], s[5 * 33]); o.w = pk2(s[6 * 33], s[7 * 33]);
        *(v4u*)(WT + (size_t)(n0 + n) * K + k0 + 8 * c) = o; }
    LDS_WAIT(); asm volatile("" ::: "memory");
}

template <int MODE>
__device__ __forceinline__ void thin_phase(const bf16* HD, const float* xin_f32, bf16* X16, float* out_f32, float* R2, const float* gpost, float cc, int gw, int NGW, int lane) {
    f32x4 gp[4];
#pragma unroll
    for (int j = 0; j < 4; ++j) gp[j] = (MODE != 0) ? *(const f32x4*)(gpost + 4 * lane + 256 * j) : (f32x4){0.f, 0.f, 0.f, 0.f};
    f32x4 xf[4]; v2u xn[4], hn[4];
    if (gw < MTOK) {
#pragma unroll
        for (int j = 0; j < 4; ++j) { if (MODE == 0) xf[j] = *(const f32x4*)(xin_f32 + (size_t)gw * DM + 4 * lane + 256 * j);
            else { xn[j] = *(const v2u*)(X16 + (size_t)gw * DM + 4 * lane + 256 * j); hn[j] = *(const v2u*)(HD + (size_t)gw * DM + 4 * lane + 256 * j); } }
    }
    for (int m = gw; m < MTOK; m += NGW) {
        f32x4 x[4]; v2u hw[4];
#pragma unroll
        for (int j = 0; j < 4; ++j) { if (MODE == 0) x[j] = xf[j]; else { x[j] = (f32x4){bflo(xn[j].x), bfhi(xn[j].x), bflo(xn[j].y), bfhi(xn[j].y)}; hw[j] = hn[j]; } }
        const int m2 = m + NGW;
        if (m2 < MTOK) {
#pragma unroll
            for (int j = 0; j < 4; ++j) { if (MODE == 0) xf[j] = *(const f32x4*)(xin_f32 + (size_t)m2 * DM + 4 * lane + 256 * j);
                else { xn[j] = *(const v2u*)(X16 + (size_t)m2 * DM + 4 * lane + 256 * j); hn[j] = *(const v2u*)(HD + (size_t)m2 * DM + 4 * lane + 256 * j); } }
        }
        if (MODE != 0) {
            f32x4 h[4]; float ss = 0.f;
#pragma unroll
            for (int j = 0; j < 4; ++j) { h[j] = (f32x4){bflo(hw[j].x), bfhi(hw[j].x), bflo(hw[j].y), bfhi(hw[j].y)}; ss += (h[j].x * h[j].x + h[j].y * h[j].y) + (h[j].z * h[j].z + h[j].w * h[j].w); }
            const float r = cc * __frsqrt_rn(wave_sum(ss, lane) * (1.f / DM) + EPS);
#pragma unroll
            for (int j = 0; j < 4; ++j) x[j] = x[j] + (h[j] * r) * gp[j];
        }
        if (MODE == 2) {
#pragma unroll
            for (int j = 0; j < 4; ++j) *(f32x4*)(out_f32 + (size_t)m * DM + 4 * lane + 256 * j) = x[j];
        } else {
            float s2 = 0.f;
#pragma unroll
            for (int j = 0; j < 4; ++j) { s2 += (x[j].x * x[j].x + x[j].y * x[j].y) + (x[j].z * x[j].z + x[j].w * x[j].w);
                v2u w; w.x = cvtpk(x[j].x, x[j].y); w.y = cvtpk(x[j].z, x[j].w); *(v2u*)(X16 + (size_t)m * DM + 4 * lane + 256 * j) = w; }
            const float r2 = __frsqrt_rn(wave_sum(s2, lane) * (1.f / DM) + EPS);
            if (lane == 0) R2[m] = r2;
        }
    }
}

struct EpiSwiglu {
    static constexpr bool PERM = true, AFTER_DRAIN = false;
    bf16* H; const float* R2;
    __device__ __forceinline__ void operator()(const pg8::f32x4 (&acc)[2][2][4][2], const pg8::Unit& u, int wr, int wc, int fr, int fq) const {
#pragma unroll
        for (int ai = 0; ai < 2; ++ai)
#pragma unroll
            for (int m = 0; m < 4; ++m) {
                const int row = u.pm * 256 + ai * 128 + wr * 64 + m * 16 + fr; const float rs = R2[row];
                typedef float f2 __attribute__((ext_vector_type(2)));
                f2 tg[4], tu[4], ex[4]; float o[8];
#pragma unroll
                for (int n = 0; n < 2; ++n) { const pg8::f32x4 g4 = acc[ai][0][m][n], u4 = acc[ai][1][m][n];
                    tg[2 * n] = (f2){g4[0], g4[1]} * rs; tg[2 * n + 1] = (f2){g4[2], g4[3]} * rs; tu[2 * n] = (f2){u4[0], u4[1]} * rs; tu[2 * n + 1] = (f2){u4[2], u4[3]} * rs; }
#pragma unroll
                for (int e = 0; e < 4; ++e) { const f2 a2 = tg[e] * -1.4426950408889634f; ex[e].x = __builtin_amdgcn_exp2f(a2.x); ex[e].y = __builtin_amdgcn_exp2f(a2.y); }
#pragma unroll
                for (int e = 0; e < 4; ++e) { const f2 d2 = ex[e] + 1.0f; ex[e].x = __builtin_amdgcn_rcpf(d2.x); ex[e].y = __builtin_amdgcn_rcpf(d2.y); tu[e] = tg[e] * tu[e]; }
#pragma unroll
                for (int e = 0; e < 4; ++e) { const f2 r2 = tu[e] * ex[e]; o[2 * e] = r2.x; o[2 * e + 1] = r2.y; }
                v4u w; w.x = pg8::cvt_pk_bf16(o[0], o[1]); w.y = pg8::cvt_pk_bf16(o[2], o[3]); w.z = pg8::cvt_pk_bf16(o[4], o[5]); w.w = pg8::cvt_pk_bf16(o[6], o[7]);
                *(v4u*)(H + (size_t)row * FF + u.pn * 128 + wc * 32 + fq * 8) = w;
            }
    }
};
struct EpiPQ {
    static constexpr bool PERM = true, AFTER_DRAIN = false;
    float* O;
    __device__ __forceinline__ void operator()(const pg8::f32x4 (&acc)[2][2][4][2], const pg8::Unit& u, int wr, int wc, int fr, int fq) const {
#pragma unroll
        for (int ai = 0; ai < 2; ++ai)
#pragma unroll
            for (int m = 0; m < 4; ++m) {
                const int row = u.pm * 256 + ai * 128 + wr * 64 + m * 16 + fr;
#pragma unroll
                for (int bj = 0; bj < 2; ++bj) { float* p = O + (size_t)row * 256 + bj * 128 + wc * 32 + fq * 8;
                    *(pg8::f32x4*)p = acc[ai][bj][m][0]; *(pg8::f32x4*)(p + 4) = acc[ai][bj][m][1]; }
            }
    }
};
struct CmpOrder {
    int c, G;
    __device__ __forceinline__ bool next(int i, pg8::Unit& u) const { const int idx = i * G + c; if (idx >= 32) return false; u.pm = idx; u.pn = idx >> 4; return true; }
    __device__ __forceinline__ void a_ready(const pg8::Unit&) const {}
    __device__ __forceinline__ void done(const pg8::Unit&) const {}
};
struct EpiInProj {
    static constexpr bool PERM = true, AFTER_DRAIN = false;
    unsigned char* ws;
    __device__ __forceinline__ void operator()(const pg8::f32x4 (&acc)[2][2][4][2], const pg8::Unit& u, int wr, int wc, int fr, int fq) const {
        const int pn = u.pn;
        const float* cosT = (const float*)(ws + WS_TAB + TAB_COS); const float* sinT = (const float*)(ws + WS_TAB + TAB_SIN);
        const bool ropet = (pn < 2) || (pn == 3) || (pn == 4);
        const bool ropew = ropet && ((wc & 1) == 0);
#pragma unroll
        for (int ai = 0; ai < 2; ++ai)
#pragma unroll
            for (int m = 0; m < 4; ++m) {
                const int row = u.pm * 256 + ai * 128 + wr * 64 + m * 16 + fr;
                const int b = row >> 11, t = row & 2047; const float rs = ((const float*)(ws + WS_TAB + TAB_R2))[row];
                f32x4 c0, c1, s0, s1;
                if (ropew) { c0 = *(const f32x4*)(cosT + t * 8); c1 = *(const f32x4*)(cosT + t * 8 + 4); s0 = *(const f32x4*)(sinT + t * 8); s1 = *(const f32x4*)(sinT + t * 8 + 4); }
#pragma unroll
                for (int bj = 0; bj < 2; ++bj) {
                    f32x4 v0 = acc[ai][bj][m][0] * rs, v1 = acc[ai][bj][m][1] * rs;
                    const int cl = bj * 128 + wc * 32 + fq * 8;
                    if (ropew && (pn < 2 || bj == 0)) {
                        f32x4 p0, p1; const int ln = fq * 16 + fr;
                        p0.x = shx(v0.x, 16, ln); p0.y = shx(v0.y, 16, ln); p0.z = shx(v0.z, 16, ln); p0.w = shx(v0.w, 16, ln);
                        p1.x = shx(v1.x, 16, ln); p1.y = shx(v1.y, 16, ln); p1.z = shx(v1.z, 16, ln); p1.w = shx(v1.w, 16, ln);
                        const float sg = (fq == 0) ? -1.f : 1.f;
                        if (fq < 2) { v0 = v0 * c0 + (p0 * s0) * sg; v1 = v1 * c1 + (p1 * s1) * sg; }
                    }
                    if (pn == 13) { if (cl < 32) { float* p = (float*)(ws + WS_GATE) + (size_t)row * 32 + cl; *(f32x4*)p = v0; *(f32x4*)(p + 4) = v1; } }
                    else {
                        size_t off;
                        if (pn < 2) off = WS_QN + ((size_t)row * 512 + pn * 256 + cl) * 2;
                        else if (pn < 5) { const int g = wc >> 1, d = (wc & 1) * 32 + fq * 8; off = WS_KCR + (size_t)((pn - 2) * 2 + bj) * (8 * MiB) + (((size_t)(b * 2 + g) * SEQ + t) * 64 + d) * 2; }
                        else { const int q = pn - 5; off = WS_MQ + (size_t)(q >> 1) * (32 * MiB) + ((size_t)row * 512 + (q & 1) * 256 + cl) * 2; }
                        v4u w; w.x = pg8::cvt_pk_bf16(v0.x, v0.y); w.y = pg8::cvt_pk_bf16(v0.z, v0.w); w.z = pg8::cvt_pk_bf16(v1.x, v1.y); w.w = pg8::cvt_pk_bf16(v1.z, v1.w);
                        *(v4u*)(ws + off) = w;
                    }
                }
            }
    }
};
static_assert(WS_VCR == WS_KCR + 8 * MiB && WS_KS == WS_KCR + 16 * MiB && WS_VS == WS_KCR + 24 * MiB && WS_KW == WS_KCR + 32 * MiB && WS_VW == WS_KCR + 40 * MiB, "kv buffers are 8 MiB apart in (pn, bj) order");
static_assert(WS_MK == WS_MQ + 32 * MiB && WS_MV == WS_MQ + 64 * MiB && WS_MO == WS_MQ + 96 * MiB, "mLSTM buffers are 32 MiB apart");

struct MixPtrs { unsigned char* ws; const float *conv_w, *conv_b, *i_bias, *f_bias, *mnorm_g; };
#define MP_QN ((const bf16*)(P.ws + WS_QN))
#define MP_KS ((const bf16*)(P.ws + WS_KS))
#define MP_VS ((const bf16*)(P.ws + WS_VS))
#define MP_KW ((const bf16*)(P.ws + WS_KW))
#define MP_VW ((const bf16*)(P.ws + WS_VW))
#define MP_KC ((const bf16*)(P.ws + WS_CC))
#define MP_VC ((const bf16*)(P.ws + WS_CC) + (size_t)4096 * 64)
#define MP_MQ ((const bf16*)(P.ws + WS_MQ))
#define MP_MK ((const bf16*)(P.ws + WS_MK))
#define MP_MV ((const bf16*)(P.ws + WS_MV))
#define MP_MO ((const bf16*)(P.ws + WS_MO))
#define MP_GATE ((const float*)(P.ws + WS_GATE))
#define MP_Y ((bf16*)(P.ws + WS_U))


typedef float f32x16 __attribute__((ext_vector_type(16)));
typedef short bf16x8v __attribute__((ext_vector_type(8)));
typedef short s16x4v __attribute__((ext_vector_type(4)));
typedef float f32x2v __attribute__((ext_vector_type(2)));
typedef __bf16 bf16x2v __attribute__((ext_vector_type(2)));
#define MFMA32(a, b, c) __builtin_amdgcn_mfma_f32_32x32x16_bf16((a), (b), (c), 0, 0, 0)
__device__ __forceinline__ s16x4v tr_read(const LAS unsigned char* p) { return __builtin_bit_cast(s16x4v, __builtin_amdgcn_ds_read_tr16_b64_v4i16((LAS s16x4v*)p)); }
__device__ __forceinline__ int tile_off(int key, int ch8) { return (ch8 >> 2) * 4096 + key * 64 + (((ch8 & 3) ^ ((key >> 2) & 3)) << 4); }
constexpr int NM_SLOT = 0, NM_IMP = 65536, NM_IMS = 99328, NM_SEL = 108544, NM_ITEM = 108864;
constexpr float QK_SCALE = 0.125f * 1.4426950408889634f;

#define SBAR() __builtin_amdgcn_sched_barrier(0)
__device__ __forceinline__ void xor32_pair(float v, float& lo, float& hi) { float a = v, b = v; asm volatile("s_nop 1\n\tv_permlane32_swap_b32 %0, %1" : "+v"(a), "+v"(b)); lo = a; hi = b; }
__device__ __forceinline__ float xor32_max(float v) { float lo, hi; xor32_pair(v, lo, hi); float r; asm("v_max_f32 %0, %1, %2" : "=v"(r) : "v"(lo), "v"(hi)); return r; }
__device__ __forceinline__ float xor32_sum(float v) { float lo, hi; xor32_pair(v, lo, hi); return lo + hi; }
__device__ __forceinline__ float max2f(float a, float b) { float r; asm("v_max_f32 %0, %1, %2" : "=v"(r) : "v"(a), "v"(b)); return r; }
__device__ __forceinline__ float max3f(float a, float b, float c) { float r; asm("v_max3_f32 %0, %1, %2, %3" : "=v"(r) : "v"(a), "v"(b), "v"(c)); return r; }
#define LBAR() asm volatile("s_waitcnt lgkmcnt(0)\n\ts_barrier" ::: "memory")
__device__ __forceinline__ void k_load(const LAS unsigned char* Ks, int r, int h, bf16x8v (&kf)[8]) {
    const int sw = (r >> 2) & 3;
#pragma unroll
    for (int ks = 0; ks < 4; ++ks) { const int off = (ks >> 1) * 4096 + r * 64 + (((((ks & 1) << 1) + h) ^ sw) << 4);
        kf[2 * ks] = *(const LAS bf16x8v*)(Ks + off); kf[2 * ks + 1] = *(const LAS bf16x8v*)(Ks + off + 2048); }
}
__device__ __forceinline__ void qk_mma(const bf16x8v (&kf)[8], const bf16x8v (&qf)[4], f32x16& p0, f32x16& p1) {
    const f32x16 z = {0.f, 0.f, 0.f, 0.f, 0.f, 0.f, 0.f, 0.f, 0.f, 0.f, 0.f, 0.f, 0.f, 0.f, 0.f, 0.f};
#pragma unroll
    for (int ks = 0; ks < 4; ++ks) { p0 = MFMA32(kf[2 * ks], qf[ks], ks ? p0 : z); p1 = MFMA32(kf[2 * ks + 1], qf[ks], ks ? p1 : z); }
}
__device__ __forceinline__ void v_load(const LAS unsigned char* Vs, int lane, bf16x8v (&vf)[8]) {
    const int h = lane >> 5, i16 = lane & 15, q = i16 >> 2, p = i16 & 3, gi = (lane >> 4) & 1;
    const int cidx = 2 * gi + (p >> 1), e8 = (p & 1) << 3;
    const int offlo = q * 64 + ((cidx ^ h) << 4) + e8 + h * 256, offhi = q * 64 + ((cidx ^ (h | 2)) << 4) + e8 + h * 256 + 512;
#pragma unroll
    for (int kb = 0; kb < 2; ++kb)
#pragma unroll
        for (int s = 0; s < 2; ++s)
#pragma unroll
            for (int db = 0; db < 2; ++db) { const LAS unsigned char* base = Vs + db * 4096 + (kb * 32 + s * 16) * 64;
                const s16x4v lo = tr_read(base + offlo), hi = tr_read(base + offhi);
                vf[(kb * 2 + s) * 2 + db] = __builtin_shufflevector(lo, hi, 0, 1, 2, 3, 4, 5, 6, 7); }
}
__device__ __forceinline__ void pv_mma(const bf16x8v (&vf)[8], const f32x16& p0, const f32x16& p1, f32x16 (&o)[2]) {
#pragma unroll
    for (int kb = 0; kb < 2; ++kb)
#pragma unroll
        for (int s = 0; s < 2; ++s) {
            const f32x16& P = kb ? p1 : p0;
            v4u pw; pw.x = cvtpk(P[8 * s + 0], P[8 * s + 1]); pw.y = cvtpk(P[8 * s + 2], P[8 * s + 3]); pw.z = cvtpk(P[8 * s + 4], P[8 * s + 5]); pw.w = cvtpk(P[8 * s + 6], P[8 * s + 7]);
            const bf16x8v pf = __builtin_bit_cast(bf16x8v, pw);
            o[0] = MFMA32(vf[(kb * 2 + s) * 2], pf, o[0]); o[1] = MFMA32(vf[(kb * 2 + s) * 2 + 1], pf, o[1]);
        }
}

__device__ __forceinline__ void nsa_unit_mfma(LAS unsigned char* L, const MixPtrs& P, int b, int g, int c, int tid_in) {
    int tid_l = tid_in; asm volatile("" : "+v"(tid_l));
    const int tid = tid_l, lane = tid & 63, w = __builtin_amdgcn_readfirstlane(tid >> 6);
    const int r = lane & 31, h = lane >> 5, head = w >> 1, qi = (w & 1) * 32 + r, t = c * 64 + qi;
    const size_t row = (size_t)b * SEQ + t;
    LAS unsigned* SEL = (LAS unsigned*)(L + NM_SEL); LAS int* ITEM = (LAS int*)(L + NM_ITEM);
    const size_t kvbase = (size_t)(b * 2 + g) * SEQ * 64, ccbase = (size_t)(b * 2 + g) * 128 * 64;
    const int skey = tid >> 3, sch = tid & 7, soff = tile_off(skey, sch);
    bf16x8v qf[4];
    { const bf16* qp = MP_QN + row * 512 + (g * 4 + head) * 64 + 8 * h;
#pragma unroll
      for (int ks = 0; ks < 4; ++ks) qf[ks] = *(const bf16x8v*)(qp + 16 * ks); }
    const float* gp = MP_GATE + row * 32 + g * 4 + head;
    float one = 1.f; asm volatile("" : "+v"(one));
    const float gate_c = __builtin_amdgcn_rcpf(one + __expf(-gp[0])), gate_s = __builtin_amdgcn_rcpf(one + __expf(-gp[8])), gate_w = __builtin_amdgcn_rcpf(one + __expf(-gp[16]));
    f32x16 oacc[2];
    {
        const bf16* kc = MP_KC + ccbase; const bf16* vc = MP_VC + ccbase;
        const v4u k0 = *(const v4u*)(kc + tid * 8), k1 = *(const v4u*)(kc + 4096 + tid * 8), v0 = *(const v4u*)(vc + tid * 8), v1 = *(const v4u*)(vc + 4096 + tid * 8);
        LBAR();
        *(LAS v4u*)(L + NM_SLOT + soff) = k0; *(LAS v4u*)(L + NM_SLOT + 8192 + soff) = v0; *(LAS v4u*)(L + NM_SLOT + 16384 + soff) = k1; *(LAS v4u*)(L + NM_SLOT + 24576 + soff) = v1;
        if (tid < 64) SEL[tid] = 0u;
        LBAR();
        f32x16 s0, s1, s2, s3;
        { bf16x8v kfa[8], kfb[8]; k_load(L + NM_SLOT, r, h, kfa); k_load(L + NM_SLOT + 16384, r, h, kfb); SBAR(); qk_mma(kfa, qf, s0, s1); qk_mma(kfb, qf, s2, s3); }
        const int nlim = (t >= 31) ? (((t - 31) >> 4) < 126 ? ((t - 31) >> 4) : 126) : -1;
        float mx, mxv[4] = {-1e20f, -1e20f, -1e20f, -1e20f};
#pragma unroll
        for (int e = 0; e < 16; ++e) { const int cr = (e & 3) + 8 * (e >> 2) + 4 * h;
            s0[e] = (cr <= nlim) ? s0[e] * QK_SCALE : -1e30f; s1[e] = (cr + 32 <= nlim) ? s1[e] * QK_SCALE : -1e30f;
            s2[e] = (cr + 64 <= nlim) ? s2[e] * QK_SCALE : -1e30f; s3[e] = (cr + 96 <= nlim) ? s3[e] * QK_SCALE : -1e30f;
            mxv[e & 3] = fmaxf(fmaxf(mxv[e & 3], fmaxf(s0[e], s1[e])), fmaxf(s2[e], s3[e])); }
        mx = fmaxf(fmaxf(mxv[0], mxv[1]), fmaxf(mxv[2], mxv[3]));
        mx = xor32_max(mx);
        float ls, lsv[4] = {0.f, 0.f, 0.f, 0.f};
#pragma unroll
        for (int e = 0; e < 16; ++e) { s0[e] = __builtin_amdgcn_exp2f(s0[e] - mx); s1[e] = __builtin_amdgcn_exp2f(s1[e] - mx); s2[e] = __builtin_amdgcn_exp2f(s2[e] - mx); s3[e] = __builtin_amdgcn_exp2f(s3[e] - mx);
            lsv[e & 3] += (s0[e] + s1[e]) + (s2[e] + s3[e]); }
        ls = (lsv[0] + lsv[1]) + (lsv[2] + lsv[3]);
        ls = xor32_sum(ls);
        const float il = (ls > 0.f) ? __builtin_amdgcn_rcpf(ls) : 0.f;
#pragma unroll
        for (int e = 0; e < 16; ++e) { s0[e] *= il; s1[e] *= il; s2[e] *= il; s3[e] *= il; }
        { LAS float* IMP = (LAS float*)(L + NM_IMP) + (w * 32 + r) * 33; float plprev = 0.f;
#pragma unroll
          for (int x = 0; x < 16; ++x) {
              const f32x16& S = (x < 4) ? s0 : ((x < 8) ? s1 : ((x < 12) ? s2 : s3)); const int g4 = (x & 3) * 4;
              const float own = (S[g4] + S[g4 + 1]) + (S[g4 + 2] + S[g4 + 3]);
              const float pl = shx(S[g4 + 3], 32, lane);
              if (h == 1) IMP[2 * x + 1] = own + pl; else IMP[2 * x] = own + plprev;
              plprev = pl;
          }
        }
        oacc[0] = (f32x16){0.f, 0.f, 0.f, 0.f, 0.f, 0.f, 0.f, 0.f, 0.f, 0.f, 0.f, 0.f, 0.f, 0.f, 0.f, 0.f}; oacc[1] = oacc[0];
        { bf16x8v vfa[8], vfb[8]; v_load(L + NM_SLOT + 8192, lane, vfa); v_load(L + NM_SLOT + 24576, lane, vfb); SBAR(); pv_mma(vfa, s0, s1, oacc); pv_mma(vfb, s2, s3, oacc); }
#pragma unroll
        for (int e = 0; e < 16; ++e) { oacc[0][e] *= gate_c; oacc[1][e] *= gate_c; }
    }
    LBAR();
    { const int i = tid & 63, jg = tid >> 6; const LAS float* I8 = (const LAS float*)(L + NM_IMP); LAS float* IMS = (LAS float*)(L + NM_IMS);
#pragma unroll
      for (int jj = 0; jj < 4; ++jj) { const int j = 4 * jg + jj; const int wq = (i >> 5), rq = i & 31;
          IMS[i * 36 + j] = (I8[((0 + wq) * 32 + rq) * 33 + j] + I8[((2 + wq) * 32 + rq) * 33 + j]) + (I8[((4 + wq) * 32 + rq) * 33 + j] + I8[((6 + wq) * 32 + rq) * 33 + j]); }
      LBAR();
      unsigned bits = 0u;
      if (c + 1 <= 16) { if (jg == 0) bits = (1u << (c + 1)) - 1u; }
      else { if (jg == 0) bits = 1u | (1u << c) | (1u << (c - 1));
          { float iv[32];
#pragma unroll
            for (int q8 = 0; q8 < 8; ++q8) { const f32x4 x = *(const LAS f32x4*)(IMS + i * 36 + 4 * q8); iv[4 * q8] = x.x; iv[4 * q8 + 1] = x.y; iv[4 * q8 + 2] = x.z; iv[4 * q8 + 3] = x.w; }
#pragma unroll
            for (int jj = 0; jj < 4; ++jj) { const int j = 4 * jg + jj; const float vj = IMS[i * 36 + j]; int rank = 0;
#pragma unroll
                for (int i2 = 1; i2 < 30; ++i2) rank += (i2 <= c - 2 && (iv[i2] > vj || (iv[i2] == vj && i2 < j))) ? 1 : 0;
                if (j >= 1 && j <= c - 2 && rank < 13) bits |= 1u << j; } } }
      if (bits) atomicOr((unsigned*)&SEL[i], bits);
      LBAR();
      if (w == 0) { unsigned so = SEL[lane];
#pragma unroll
          for (int o2 = 32; o2; o2 >>= 1) so |= shxu(so, o2, lane);
          if (lane == 0) { int n = 0; for (int j = 0; j <= c; ++j) if ((so >> j) & 1u) ITEM[n++] = j; const int j0 = (c - 8 > 0) ? c - 8 : 0; for (int j = j0; j <= c; ++j) ITEM[n++] = 64 + j; ITEM[n] = -1; ITEM[47] = n; } }
      LBAR();
    }
    const unsigned mysel = SEL[qi]; const int nitem = ITEM[47];
    f32x16 o[2]; float m = -1e20f, lsum = 0.f; int prev_kind = 0;
    o[0] = (f32x16){0.f, 0.f, 0.f, 0.f, 0.f, 0.f, 0.f, 0.f, 0.f, 0.f, 0.f, 0.f, 0.f, 0.f, 0.f, 0.f}; o[1] = o[0];
    const int npair = (nitem + 1) >> 1;
    v4u rk0, rv0, rk1, rv1;
#define NSA_LOAD_PAIR(ip_) do { const int ia_ = ITEM[2 * (ip_)], ib_ = ITEM[2 * (ip_) + 1]; \
        { const bf16* kp = ((ia_ & 64) ? MP_KW : MP_KS) + kvbase + (size_t)(ia_ & 63) * 4096; const bf16* vp = ((ia_ & 64) ? MP_VW : MP_VS) + kvbase + (size_t)(ia_ & 63) * 4096; rk0 = *(const v4u*)(kp + tid * 8); rv0 = *(const v4u*)(vp + tid * 8); } \
        if (ib_ >= 0) { const bf16* kp = ((ib_ & 64) ? MP_KW : MP_KS) + kvbase + (size_t)(ib_ & 63) * 4096; const bf16* vp = ((ib_ & 64) ? MP_VW : MP_VS) + kvbase + (size_t)(ib_ & 63) * 4096; rk1 = *(const v4u*)(kp + tid * 8); rv1 = *(const v4u*)(vp + tid * 8); } } while (0)
#define NSA_WRITE_PAIR(sb_) do { *(LAS v4u*)(L + (sb_) + soff) = rk0; *(LAS v4u*)(L + (sb_) + 8192 + soff) = rv0; *(LAS v4u*)(L + (sb_) + 16384 + soff) = rk1; *(LAS v4u*)(L + (sb_) + 24576 + soff) = rv1; } while (0)
    rk1 = (v4u){0u, 0u, 0u, 0u}; rv1 = rk1;
    NSA_LOAD_PAIR(0);
    NSA_WRITE_PAIR(NM_SLOT + 32768);
    LBAR();
#pragma unroll 1
    for (int ip = 0; ip < npair; ++ip) {
        if (ip + 1 < npair) NSA_LOAD_PAIR(ip + 1);
        const int sbase = NM_SLOT + ((ip + 1) & 1) * 32768;
#pragma unroll 1
        for (int half = 0; half < 2; ++half) {
            const int item = ITEM[2 * ip + half];
            if (item < 0) break;
            const int kind = item >> 6, j = item & 63;
            if (kind != prev_kind) {
                const float tot = xor32_sum(lsum); const float sc = gate_s * __builtin_amdgcn_rcpf(tot);
#pragma unroll
                for (int e = 0; e < 16; ++e) { oacc[0][e] += o[0][e] * sc; oacc[1][e] += o[1][e] * sc; o[0][e] = 0.f; o[1][e] = 0.f; }
                m = -1e20f; lsum = 0.f; prev_kind = kind;
            }
            int klo, khi;
            if (kind == 0) { klo = 0; khi = ((mysel >> j) & 1u) ? ((j < c) ? 63 : qi) : -1; }
            else { klo = t - 511 - 64 * j; khi = t - 64 * j; if (khi > 63) khi = 63; if (klo < 0) klo = 0; }
            const LAS unsigned char* slot = L + sbase + half * 16384;
            if (__any(khi >= klo)) {
                f32x16 p0, p1; bf16x8v vf[8];
                { bf16x8v kf[8]; k_load(slot, r, h, kf); SBAR(); qk_mma(kf, qf, p0, p1); }
                v_load(slot + 8192, lane, vf); SBAR();
                if (!__all(klo == 0 && khi == 63)) {
                    const int a = klo - 4 * h, z = khi - 4 * h;
#pragma unroll
                    for (int e = 0; e < 16; ++e) { const int cr = (e & 3) + 8 * (e >> 2);
                        p0[e] = (cr >= a && cr <= z) ? p0[e] : -1e30f; p1[e] = (cr + 32 >= a && cr + 32 <= z) ? p1[e] : -1e30f; }
                }
                float tm;
                { float ma = max2f(p0[0], p1[0]), mb = max2f(p0[1], p1[1]), mc2 = max2f(p0[2], p1[2]), md = max2f(p0[3], p1[3]);
#pragma unroll
                  for (int e = 4; e < 16; e += 4) { ma = max3f(ma, p0[e], p1[e]); mb = max3f(mb, p0[e + 1], p1[e + 1]); mc2 = max3f(mc2, p0[e + 2], p1[e + 2]); md = max3f(md, p0[e + 3], p1[e + 3]); }
                  tm = max3f(ma, mb, max2f(mc2, md)); }
                tm = xor32_max(tm);
                const float mn = fmaxf(m, tm * QK_SCALE);
                if (!__all(mn == m)) { const float corr = __builtin_amdgcn_exp2f(m - mn); lsum *= corr;
#pragma unroll
                    for (int e = 0; e < 16; ++e) { o[0][e] *= corr; o[1][e] *= corr; }
                    m = mn; }
                { const f32x2v sc2 = {QK_SCALE, QK_SCALE}, mm2 = {m, m}; f32x2v ta = {0.f, 0.f}, tb = {0.f, 0.f};
#pragma unroll
                  for (int e = 0; e < 16; e += 2) { const f32x2v a0 = (f32x2v){p0[e], p0[e + 1]} * sc2 - mm2, a1 = (f32x2v){p1[e], p1[e + 1]} * sc2 - mm2; p0[e] = a0.x; p0[e + 1] = a0.y; p1[e] = a1.x; p1[e + 1] = a1.y; }
#pragma unroll
                  for (int e = 0; e < 16; ++e) { p0[e] = __builtin_amdgcn_exp2f(p0[e]); p1[e] = __builtin_amdgcn_exp2f(p1[e]); }
#pragma unroll
                  for (int e = 0; e < 16; e += 2) { ta += (f32x2v){p0[e], p0[e + 1]}; tb += (f32x2v){p1[e], p1[e + 1]}; }
                  lsum += (ta.x + ta.y) + (tb.x + tb.y); }
                SBAR(); pv_mma(vf, p0, p1, o);
            }
        }
        if (ip + 1 < npair) NSA_WRITE_PAIR(NM_SLOT + (ip & 1) * 32768);
        LBAR();
    }
#undef NSA_LOAD_PAIR
#undef NSA_WRITE_PAIR
    { const float tot = xor32_sum(lsum); const float sc = gate_w * __builtin_amdgcn_rcpf(tot);
#pragma unroll
      for (int e = 0; e < 16; ++e) { oacc[0][e] += o[0][e] * sc; oacc[1][e] += o[1][e] * sc; } }
    { bf16* yp = MP_Y + row * DM + (g * 4 + head) * 64 + 4 * h;
#pragma unroll
      for (int db = 0; db < 2; ++db)
#pragma unroll
          for (int g4 = 0; g4 < 4; ++g4) { v2u wv; wv.x = cvtpk(oacc[db][4 * g4], oacc[db][4 * g4 + 1]); wv.y = cvtpk(oacc[db][4 * g4 + 2], oacc[db][4 * g4 + 3]); *(v2u*)(yp + db * 32 + g4 * 8) = wv; } }
}

#define MFMA16(a, b, c) __builtin_amdgcn_mfma_f32_16x16x32_bf16((a), (b), (c), 0, 0, 0)
constexpr size_t WS_QC = 422 * MiB, WS_KC2 = 454 * MiB, WS_END2 = 486 * MiB;
#define MP_QC ((const bf16*)(P.ws + WS_QC))
#define MP_KC2 ((const bf16*)(P.ws + WS_KC2))
__device__ __forceinline__ int img_off(int row, int ch) { return 256 * row + 16 * (ch ^ (((row & 3) << 2) | ((row >> 2) & 3))); }
constexpr int M2_IMG = 0, M2_SC = 98304, M2_DEN = 106496, M2_QN = 107520, M2_N = 107776, M2_SSQ = 108288;

__device__ __forceinline__ void mlstm_conv_pass(unsigned char* ws, const float* conv_w, const float* conv_b, int gthread, int nthreads) {
    for (int idx = gthread; idx < BATCH * 128 * 128; idx += nthreads) {
        const int cc = idx & 127, tg = (idx >> 7) & 127, b = idx >> 14;
        const int isk = cc >> 6, ch0 = (cc & 63) * 8;
        const bf16* src = (const bf16*)(ws + (isk ? WS_MK : WS_MQ)) + (size_t)b * SEQ * 512 + ch0;
        bf16* dst = (bf16*)(ws + (isk ? WS_KC2 : WS_QC)) + ((size_t)(b * 4 + (ch0 >> 7)) * SEQ) * 128 + (ch0 & 127);
        float wt[4][8], bs[8];
#pragma unroll
        for (int j = 0; j < 4; ++j) { const f32x4 a = *(const f32x4*)(conv_w + j * 1024 + isk * 512 + ch0), c2 = *(const f32x4*)(conv_w + j * 1024 + isk * 512 + ch0 + 4);
            wt[j][0] = a.x; wt[j][1] = a.y; wt[j][2] = a.z; wt[j][3] = a.w; wt[j][4] = c2.x; wt[j][5] = c2.y; wt[j][6] = c2.z; wt[j][7] = c2.w; }
        { const f32x4 a = *(const f32x4*)(conv_b + isk * 512 + ch0), c2 = *(const f32x4*)(conv_b + isk * 512 + ch0 + 4); bs[0] = a.x; bs[1] = a.y; bs[2] = a.z; bs[3] = a.w; bs[4] = c2.x; bs[5] = c2.y; bs[6] = c2.z; bs[7] = c2.w; }
        const float osc = isk ? 0.08838834764831845f : 1.f;
        const int t0 = tg * 16;
        float x0[8], x1[8], x2[8];
#pragma unroll
        for (int e = 0; e < 8; ++e) { x0[e] = 0.f; x1[e] = 0.f; x2[e] = 0.f; }
        if (t0 > 0) {
            const v4u a = *(const v4u*)(src + (size_t)(t0 - 3) * 512), c2 = *(const v4u*)(src + (size_t)(t0 - 2) * 512), d2 = *(const v4u*)(src + (size_t)(t0 - 1) * 512);
            x0[0] = bflo(a.x); x0[1] = bfhi(a.x); x0[2] = bflo(a.y); x0[3] = bfhi(a.y); x0[4] = bflo(a.z); x0[5] = bfhi(a.z); x0[6] = bflo(a.w); x0[7] = bfhi(a.w);
            x1[0] = bflo(c2.x); x1[1] = bfhi(c2.x); x1[2] = bflo(c2.y); x1[3] = bfhi(c2.y); x1[4] = bflo(c2.z); x1[5] = bfhi(c2.z); x1[6] = bflo(c2.w); x1[7] = bfhi(c2.w);
            x2[0] = bflo(d2.x); x2[1] = bfhi(d2.x); x2[2] = bflo(d2.y); x2[3] = bfhi(d2.y); x2[4] = bflo(d2.z); x2[5] = bfhi(d2.z); x2[6] = bflo(d2.w); x2[7] = bfhi(d2.w);
        }
#pragma unroll 4
        for (int s = 0; s < 16; ++s) {
            const v4u a = *(const v4u*)(src + (size_t)(t0 + s) * 512);
            const float x3[8] = {bflo(a.x), bfhi(a.x), bflo(a.y), bfhi(a.y), bflo(a.z), bfhi(a.z), bflo(a.w), bfhi(a.w)};
            float o[8];
#pragma unroll
            for (int e = 0; e < 8; ++e) { float v = bs[e] + wt[0][e] * x0[e] + wt[1][e] * x1[e] + wt[2][e] * x2[e] + wt[3][e] * x3[e]; v = v * __builtin_amdgcn_rcpf(1.f + __expf(-v)); o[e] = v * osc; x0[e] = x1[e]; x1[e] = x2[e]; x2[e] = x3[e]; }
            v4u wv; wv.x = pk2(o[0], o[1]); wv.y = pk2(o[2], o[3]); wv.z = pk2(o[4], o[5]); wv.w = pk2(o[6], o[7]);
            *(v4u*)(dst + (size_t)(t0 + s) * 128) = wv;
        }
    }
}

constexpr int M2_A = 112384, M2_PM = 120576, M2_F = 128768, M2_BL = 136960, M2_AMX = 137088, M2_MC = 137216;
__device__ __forceinline__ void mlstm_unit_mfma(LAS unsigned char* L, const MixPtrs& P, int b, int hh, int tid_in) {
    int tid_l = tid_in; asm volatile("" : "+v"(tid_l));
    const int tid = tid_l, lane = tid & 63, w = __builtin_amdgcn_readfirstlane(tid >> 6), l15 = lane & 15, kg = lane >> 4;
    const size_t rb = (size_t)b * SEQ;
    const bf16* QCp = MP_QC + ((size_t)(b * 4 + hh) * SEQ) * 128; const bf16* KCp = MP_KC2 + ((size_t)(b * 4 + hh) * SEQ) * 128;
    const bf16* Vp = MP_MV + rb * 512 + hh * 128; const bf16* Op = MP_MO + rb * 512 + hh * 128 + 16 * w + 4 * kg;
    bf16* Yp = MP_Y + rb * DM + 512 + hh * 128 + 16 * w + 4 * kg;
    LAS float* DEN = (LAS float*)(L + M2_DEN); LAS float* QN = (LAS float*)(L + M2_QN); LAS float* NV = (LAS float*)(L + M2_N); LAS float* SSQ = (LAS float*)(L + M2_SSQ);
    LAS float* SA = (LAS float*)(L + M2_A); LAS float* SPM = (LAS float*)(L + M2_PM); LAS float* SF = (LAS float*)(L + M2_F);
    LAS float* SBL = (LAS float*)(L + M2_BL); LAS float* SAMX = (LAS float*)(L + M2_AMX); LAS float* SMC = (LAS float*)(L + M2_MC);
    float zf = 0.f; asm volatile("" : "+v"(zf));
    f32x4 Cacc[8], nacc = {zf, zf, zf, zf};
#pragma unroll
    for (int i = 0; i < 8; ++i) Cacc[i] = (f32x4){zf, zf, zf, zf};
    const f32x4 gn = *(const f32x4*)(P.mnorm_g + hh * 128 + 16 * w + 4 * kg);
    const int r0s = tid >> 4, c0s = tid & 15, so0 = img_off(r0s, c0s), so1 = img_off(r0s + 32, c0s);
    v4u sq0, sq1, sk0, sk1, sv0, sv1;
    sq0 = *(const v4u*)(QCp + (size_t)r0s * 128 + c0s * 8); sq1 = *(const v4u*)(QCp + (size_t)(r0s + 32) * 128 + c0s * 8);
    sk0 = *(const v4u*)(KCp + (size_t)r0s * 128 + c0s * 8); sk1 = *(const v4u*)(KCp + (size_t)(r0s + 32) * 128 + c0s * 8);
    sv0 = *(const v4u*)(Vp + (size_t)r0s * 512 + c0s * 8);  sv1 = *(const v4u*)(Vp + (size_t)(r0s + 32) * 512 + c0s * 8);
    LBAR();
    { const float ib = P.i_bias[hh], fb = P.f_bias[hh]; const float* Gp = MP_GATE + rb * 32 + hh;
#pragma unroll 1
      for (int cc = w; cc < 32; cc += 8) { const int tk = 64 * cc + lane;
          const float il = Gp[(size_t)tk * 32 + 24] + ib, fx = Gp[(size_t)tk * 32 + 28] + fb; const float fl = fminf(fx, 0.f) - log1pf(__expf(-fabsf(fx)));
          float f = fl;
#pragma unroll
          for (int o = 1; o < 64; o <<= 1) { const float v = shi(f, lane - o); if (lane >= o) f += v; }
          const float a = il - f; float pm = a;
#pragma unroll
          for (int o = 1; o < 64; o <<= 1) { const float v = shi(pm, lane - o); if (lane >= o) pm = fmaxf(pm, v); }
          SA[tk] = a; SPM[tk] = pm; SF[tk] = f; if (lane == 63) { SBL[cc] = f; SAMX[cc] = pm; } } }
    *(LAS v4u*)(L + M2_IMG + so0) = sq0; *(LAS v4u*)(L + M2_IMG + so1) = sq1; *(LAS v4u*)(L + M2_IMG + 16384 + so0) = sk0; *(LAS v4u*)(L + M2_IMG + 16384 + so1) = sk1;
    *(LAS v4u*)(L + M2_IMG + 32768 + so0) = sv0; *(LAS v4u*)(L + M2_IMG + 32768 + so1) = sv1;
    if (tid < 128) NV[tid] = zf;
    LBAR();
    if (tid == 0) { float mcar = zf; for (int cc = 0; cc < 32; ++cc) { SMC[cc] = mcar; mcar = SBL[cc] + fmaxf(mcar, SAMX[cc]); } }
    LBAR();
#pragma unroll 1
    for (int c = 0; c < 32; ++c) {
        int lc = lane; asm volatile("" : "+v"(lc));
        const int l15 = lc & 15, kg = lc >> 4, q4 = l15 >> 2, p4 = l15 & 3;
        const int t0 = c * 64; const LAS unsigned char* Qi = L + M2_IMG + (c & 1) * 49152; const LAS unsigned char* Ki = Qi + 16384; const LAS unsigned char* Vi = Qi + 32768;
        if (c + 1 < 32) { const int tn = t0 + 64;
            sq0 = *(const v4u*)(QCp + (size_t)(tn + r0s) * 128 + c0s * 8); sq1 = *(const v4u*)(QCp + (size_t)(tn + r0s + 32) * 128 + c0s * 8);
            sk0 = *(const v4u*)(KCp + (size_t)(tn + r0s) * 128 + c0s * 8); sk1 = *(const v4u*)(KCp + (size_t)(tn + r0s + 32) * 128 + c0s * 8);
            sv0 = *(const v4u*)(Vp + (size_t)(tn + r0s) * 512 + c0s * 8);  sv1 = *(const v4u*)(Vp + (size_t)(tn + r0s + 32) * 512 + c0s * 8); }
        const float mc = SMC[c], mxa = fmaxf(mc, SAMX[c]); const float cs = __expf(mc - mxa);
        { const int tblk = w >> 1, t = 16 * tblk + l15; const int sb0 = 2 * (w & 1);
          bf16x8v ka[2][4], qb[4];
#pragma unroll
          for (int ks = 0; ks < 4; ++ks) { qb[ks] = *(const LAS bf16x8v*)(Qi + img_off(t, 4 * ks + kg)); ka[0][ks] = *(const LAS bf16x8v*)(Ki + img_off(16 * sb0 + l15, 4 * ks + kg)); ka[1][ks] = *(const LAS bf16x8v*)(Ki + img_off(16 * sb0 + 16 + l15, 4 * ks + kg)); }
          const float Mt = fmaxf(SPM[t0 + t], mc);
          const f32x4 as0 = *(const LAS f32x4*)(SA + t0 + 16 * sb0 + 4 * kg), as1 = *(const LAS f32x4*)(SA + t0 + 16 * sb0 + 16 + 4 * kg);
          const int tq = tid >> 3, dp = tid & 7; const v4u q0 = *(const LAS v4u*)(Qi + img_off(tq, 2 * dp)), q1 = *(const LAS v4u*)(Qi + img_off(tq, 2 * dp + 1));
          const LAS f32x4* np = (const LAS f32x4*)(NV + 16 * dp); const f32x4 n0 = np[0], n1 = np[1], n2 = np[2], n3 = np[3];
          SBAR();
          LAS unsigned char* SC = L + M2_SC;
#pragma unroll
          for (int sb = 0; sb < 2; ++sb) { const int sblk = sb0 + sb; f32x4 acc = {0.f, 0.f, 0.f, 0.f}; float rp = 0.f; v2u wv; wv.x = 0u; wv.y = 0u;
              if (sblk <= tblk) {
#pragma unroll
                  for (int ks = 0; ks < 4; ++ks) acc = MFMA16(ka[sb][ks], qb[ks], acc);
                  const f32x4 as = sb ? as1 : as0; float v[4];
#pragma unroll
                  for (int e = 0; e < 4; ++e) { const float x = acc[e] * __expf(as[e] - Mt); v[e] = (sblk == tblk && 4 * kg + e > l15) ? 0.f : x; }
                  rp = (v[0] + v[1]) + (v[2] + v[3]); wv.x = cvtpk(v[0], v[1]); wv.y = cvtpk(v[2], v[3]);
              }
              rp += shx(rp, 16, lane); rp += shx(rp, 32, lane);
              *(LAS v2u*)(SC + t * 128 + (((2 * sblk + (kg >> 1)) ^ (t & 7)) << 4) + 8 * (kg & 1)) = wv;
              if (kg == 0) DEN[sblk * 64 + t] = rp; }
          { float s = bflo(q0.x) * n0.x + bfhi(q0.x) * n0.y + bflo(q0.y) * n0.z + bfhi(q0.y) * n0.w + bflo(q0.z) * n1.x + bfhi(q0.z) * n1.y + bflo(q0.w) * n1.z + bfhi(q0.w) * n1.w
                    + bflo(q1.x) * n2.x + bfhi(q1.x) * n2.y + bflo(q1.y) * n2.z + bfhi(q1.y) * n2.w + bflo(q1.z) * n3.x + bfhi(q1.z) * n3.y + bflo(q1.w) * n3.z + bfhi(q1.w) * n3.w;
            s += shx(s, 1, lane); s += shx(s, 2, lane); s += shx(s, 4, lane);
            if (dp == 0) QN[tq] = s; } }
        LBAR();
        v2u og[4];
#pragma unroll
        for (int tb = 0; tb < 4; ++tb) og[tb] = *(const v2u*)(Op + (size_t)(t0 + 16 * tb + l15) * 512);
        bf16x8v vf[2]; f32x4 hv[4];
        { float pmt[4], ft[4], dnp[4], qn4[4]; bf16x8v Cfrag[4];
#pragma unroll
          for (int kp = 0; kp < 4; ++kp) { v4u a; a.x = cvtpk(Cacc[2 * kp].x, Cacc[2 * kp].y); a.y = cvtpk(Cacc[2 * kp].z, Cacc[2 * kp].w); a.z = cvtpk(Cacc[2 * kp + 1].x, Cacc[2 * kp + 1].y); a.w = cvtpk(Cacc[2 * kp + 1].z, Cacc[2 * kp + 1].w);
              Cfrag[kp] = __builtin_bit_cast(bf16x8v, a); }
#pragma unroll
          for (int ks = 0; ks < 2; ++ks) { const int r0 = 32 * ks + 8 * kg;
              const s16x4v lo = tr_read(Vi + 256 * (r0 + q4) + 16 * ((2 * w + (p4 >> 1)) ^ ((q4 << 2) | ((r0 >> 2) & 3))) + 8 * (p4 & 1));
              const s16x4v hi = tr_read(Vi + 256 * (r0 + 4 + q4) + 16 * ((2 * w + (p4 >> 1)) ^ ((q4 << 2) | (((r0 + 4) >> 2) & 3))) + 8 * (p4 & 1));
              vf[ks] = __builtin_shufflevector(lo, hi, 0, 1, 2, 3, 4, 5, 6, 7); }
#pragma unroll
          for (int tb = 0; tb < 4; ++tb) { const int t = 16 * tb + l15; pmt[tb] = SPM[t0 + t]; ft[tb] = SF[t0 + t]; dnp[tb] = (DEN[t] + DEN[64 + t]) + (DEN[128 + t] + DEN[192 + t]); qn4[tb] = QN[t]; }
#pragma unroll
          for (int tp = 0; tp < 2; ++tp) {
              bf16x8v sf[2][2]; v2u qlo[2][4], qhi[2][4];
#pragma unroll
              for (int t2 = 0; t2 < 2; ++t2) { const int t = 16 * (2 * tp + t2) + l15; const int swz = ((t & 3) << 2) | ((t >> 2) & 3);
#pragma unroll
                  for (int ks = 0; ks < 2; ++ks) sf[t2][ks] = *(const LAS bf16x8v*)(L + M2_SC + t * 128 + (((4 * ks + kg) ^ (t & 7)) << 4));
#pragma unroll
                  for (int kp = 0; kp < 4; ++kp) { qlo[t2][kp] = *(const LAS v2u*)(Qi + 256 * t + 16 * ((4 * kp + (kg >> 1)) ^ swz) + 8 * (kg & 1)); qhi[t2][kp] = *(const LAS v2u*)(Qi + 256 * t + 16 * ((4 * kp + 2 + (kg >> 1)) ^ swz) + 8 * (kg & 1)); } }
              SBAR();
#pragma unroll
              for (int t2 = 0; t2 < 2; ++t2) { const int tb = 2 * tp + t2; f32x4 an = {0.f, 0.f, 0.f, 0.f}, a2 = {0.f, 0.f, 0.f, 0.f};
#pragma unroll
                  for (int ks = 0; ks < 2; ++ks) an = MFMA16(vf[ks], sf[t2][ks], an);
#pragma unroll
                  for (int kp = 0; kp < 4; ++kp) { v4u qq; qq.x = qlo[t2][kp].x; qq.y = qlo[t2][kp].y; qq.z = qhi[t2][kp].x; qq.w = qhi[t2][kp].y; a2 = MFMA16(Cfrag[kp], __builtin_bit_cast(bf16x8v, qq), a2); }
                  const float Mt = fmaxf(pmt[tb], mc), wp = __expf(mc - Mt), emt = __expf(-ft[tb] - Mt);
                  const float dn = dnp[tb] + wp * qn4[tb];
                  const float idn = __builtin_amdgcn_rcpf(fmaxf(fabsf(dn), emt));
                  hv[tb] = (an + a2 * wp) * idn;
                  float ss = (hv[tb].x * hv[tb].x + hv[tb].y * hv[tb].y) + (hv[tb].z * hv[tb].z + hv[tb].w * hv[tb].w);
                  ss += shx(ss, 16, lane); ss += shx(ss, 32, lane);
                  if (kg == 0) SSQ[((c & 1) * 8 + w) * 64 + 16 * tb + l15] = ss; }
              SBAR();
          } }
        { bf16x8v vpf[2], wkf[2];
          f32x4 aw[2][2];
#pragma unroll
          for (int ks = 0; ks < 2; ++ks) { aw[ks][0] = *(const LAS f32x4*)(SA + t0 + 32 * ks + 8 * kg); aw[ks][1] = *(const LAS f32x4*)(SA + t0 + 32 * ks + 8 * kg + 4); }
#pragma unroll
          for (int ks = 0; ks < 2; ++ks) { float wkv[8]; unsigned vp[4], wp2[4]; const v4u vu = __builtin_bit_cast(v4u, vf[ks]); const unsigned vw[4] = {vu.x, vu.y, vu.z, vu.w};
#pragma unroll
              for (int j = 0; j < 8; ++j) wkv[j] = __expf(aw[ks][j >> 2][j & 3] - mxa);
#pragma unroll
              for (int j2 = 0; j2 < 4; ++j2) { vp[j2] = cvtpk(bflo(vw[j2]) * wkv[2 * j2], bfhi(vw[j2]) * wkv[2 * j2 + 1]); wp2[j2] = cvtpk(wkv[2 * j2], wkv[2 * j2 + 1]); }
              v4u a; a.x = vp[0]; a.y = vp[1]; a.z = vp[2]; a.w = vp[3]; vpf[ks] = __builtin_bit_cast(bf16x8v, a);
              v4u b2; b2.x = wp2[0]; b2.y = wp2[1]; b2.z = wp2[2]; b2.w = wp2[3]; wkf[ks] = __builtin_bit_cast(bf16x8v, b2); }
          nacc = nacc * cs;
#pragma unroll
          for (int ih = 0; ih < 2; ++ih) {
              bf16x8v kf[4][2];
#pragma unroll
              for (int i4 = 0; i4 < 4; ++i4)
#pragma unroll
                  for (int ks = 0; ks < 2; ++ks) { const int i = 4 * ih + i4, r0 = 32 * ks + 8 * kg;
                      const s16x4v lo = tr_read(Ki + 256 * (r0 + q4) + 16 * ((2 * i + (p4 >> 1)) ^ ((q4 << 2) | ((r0 >> 2) & 3))) + 8 * (p4 & 1));
                      const s16x4v hi = tr_read(Ki + 256 * (r0 + 4 + q4) + 16 * ((2 * i + (p4 >> 1)) ^ ((q4 << 2) | (((r0 + 4) >> 2) & 3))) + 8 * (p4 & 1));
                      kf[i4][ks] = __builtin_shufflevector(lo, hi, 0, 1, 2, 3, 4, 5, 6, 7); }
              SBAR();
#pragma unroll
              for (int i4 = 0; i4 < 4; ++i4) { const int i = 4 * ih + i4; Cacc[i] = Cacc[i] * cs;
#pragma unroll
                  for (int ks = 0; ks < 2; ++ks) Cacc[i] = MFMA16(kf[i4][ks], vpf[ks], Cacc[i]); }
              SBAR();
          }
          { bf16x8v kw[2];
#pragma unroll
            for (int ks = 0; ks < 2; ++ks) { const int r0 = 32 * ks + 8 * kg;
                const s16x4v lo = tr_read(Ki + 256 * (r0 + q4) + 16 * ((2 * w + (p4 >> 1)) ^ ((q4 << 2) | ((r0 >> 2) & 3))) + 8 * (p4 & 1));
                const s16x4v hi = tr_read(Ki + 256 * (r0 + 4 + q4) + 16 * ((2 * w + (p4 >> 1)) ^ ((q4 << 2) | (((r0 + 4) >> 2) & 3))) + 8 * (p4 & 1));
                kw[ks] = __builtin_shufflevector(lo, hi, 0, 1, 2, 3, 4, 5, 6, 7); }
            nacc = MFMA16(kw[0], wkf[0], nacc); nacc = MFMA16(kw[1], wkf[1], nacc); }
          if (l15 == 0) *(LAS f32x4*)(NV + 16 * w + 4 * kg) = nacc;
 }
        if (c + 1 < 32) { LAS unsigned char* Nx = L + M2_IMG + ((c + 1) & 1) * 49152;
            *(LAS v4u*)(Nx + so0) = sq0; *(LAS v4u*)(Nx + so1) = sq1; *(LAS v4u*)(Nx + 16384 + so0) = sk0; *(LAS v4u*)(Nx + 16384 + so1) = sk1; *(LAS v4u*)(Nx + 32768 + so0) = sv0; *(LAS v4u*)(Nx + 32768 + so1) = sv1; }
        LBAR();
#pragma unroll
        for (int tb = 0; tb < 4; ++tb) { const int t = 16 * tb + l15; const LAS float* sp = SSQ + (c & 1) * 512 + t;
            const float tot = ((sp[0] + sp[64]) + (sp[128] + sp[192])) + ((sp[256] + sp[320]) + (sp[384] + sp[448]));
            const float rn = __frsqrt_rn(tot * (1.f / 128.f) + EPS);
            const float y0 = hv[tb].x * rn * gn.x * sigmoidf_(bflo(og[tb].x)), y1 = hv[tb].y * rn * gn.y * sigmoidf_(bfhi(og[tb].x)), y2 = hv[tb].z * rn * gn.z * sigmoidf_(bflo(og[tb].y)), y3 = hv[tb].w * rn * gn.w * sigmoidf_(bfhi(og[tb].y));
            v2u wv; wv.x = cvtpk(y0, y1); wv.y = cvtpk(y2, y3);
            *(v2u*)(Yp + (size_t)(t0 + t) * DM) = wv; }
    }
    LBAR();
}

#ifndef MK_MULTI
#define MK_MULTI 0
#endif
constexpr int PH_PER_LAYER = 12, N_PHASES = 1 + DEPTH * PH_PER_LAYER;
struct Args { const float* in[16]; float* out; unsigned char* ws; int ph_lo, ph_hi; };
static_assert(sizeof(Args) == 16 * 8 + 8 + 8 + 8, "Args has no padding");

__global__ void __launch_bounds__(NWAVES * 64, 2) fwd_kernel(Args args) {
    extern __shared__ __attribute__((aligned(16))) unsigned char lds_raw[];
    LAS unsigned char* L = (LAS unsigned char*)lds_raw;
    const int G0 = gridDim.x, blk0 = blockIdx.x;
    const int wave0 = __builtin_amdgcn_readfirstlane((int)threadIdx.x >> 6);
#define PH_IDS() PH_WS(); int wave = wave0; asm volatile("" : "+s"(wave)); const int lane = fresh_lane(), tid = wave * 64 + lane, gw = blk * NWAVES + wave; (void)gw
#define PH_WS() size_t zoff_ = 0; asm volatile("" : "+s"(zoff_)); unsigned char* ws = (unsigned char*)__builtin_assume_aligned(args.ws, 256) + zoff_; int blk = blk0, G = G0; asm volatile("" : "+s"(blk), "+s"(G)); const int NGW = G * NWAVES; (void)NGW; bf16* X16 = (bf16*)(ws + WS_X16); float* R2 = (float*)(ws + WS_TAB + TAB_R2); bf16* U = (bf16*)(ws + WS_U); bf16* HB = (bf16*)(ws + WS_HB); bf16* HD = (bf16*)(ws + WS_HD); \
    unsigned char* wl = ws + WS_W; const float* ng = args.in[1] + (size_t)l_ * 6 * DM; (void)X16; (void)R2; (void)U; (void)HB; (void)HD; (void)wl; (void)ng
    unsigned char* ws0 = args.ws;
    volatile LAS unsigned* MISC = (volatile LAS unsigned*)(L + MISC_OFF);
    { const int tid_e = wave0 * 64 + fresh_lane(); if (tid_e < 16) MISC[tid_e] = 0u; }
    __syncthreads();
    XcdBarrier bar; bar.bar = (unsigned*)(ws0 + WS_CTL) + CW_BAR; bar.x = 0; bar.st = nullptr;
    if (!MK_MULTI) bar = xcd_barrier_post((unsigned*)(ws0 + WS_CTL) + CW_BAR, MISC + 8, wave0 * 64 + fresh_lane() == 0);
    const int lo = args.ph_lo, hi = args.ph_hi;
#define IN(k) (lo <= (k) && (k) < hi)
#define SEAM(k) do { if (IN(k) && IN((k) + 1)) xcd_barrier(bar, wave0 * 64 + fresh_lane() == 0); } while (0)

    if (IN(0)) {
        const int l_ = 0; PH_IDS();
        const float* x_in = args.in[0]; float* cosT = (float*)(ws + WS_TAB + TAB_COS); float* sinT = (float*)(ws + WS_TAB + TAB_SIN); float* b1T = (float*)(ws + WS_TAB + TAB_B1);
#define CONVERT_WEIGHTS(lw) do { LAS float* scr = (LAS float*)(L + wave * 16384); const float* ngw = args.in[1] + (size_t)(lw) * 6 * DM; \
        constexpr int I_GU = 16 * 176, I_DN = 44 * 32, I_IN = 16 * 112, I_OUT = 16 * 32, I_CMP = 16 * 16, I_LAYER = 2 * I_GU + 2 * I_DN + I_IN + I_OUT + I_CMP; \
        for (int it = gw; it < I_LAYER; it += NGW) { int r = it; unsigned char* wlw = ws + WS_W; \
            if (r < I_GU) { SrcGU s{args.in[2] + (size_t)(lw) * DM * NGU, ngw + 0 * DM}; transpose_item(s, DM, (bf16*)(wlw + WO_GU1), scr, r / 176, r % 176, lane); continue; } r -= I_GU; \
            if (r < I_DN) { SrcPlain s{args.in[3] + (size_t)(lw) * FF * DM, DM}; transpose_item(s, FF, (bf16*)(wlw + WO_DN1), scr, r / 32, r % 32, lane); continue; } r -= I_DN; \
            if (r < I_GU) { SrcGU s{args.in[4] + (size_t)(lw) * DM * NGU, ngw + 4 * DM}; transpose_item(s, DM, (bf16*)(wlw + WO_GU2), scr, r / 176, r % 176, lane); continue; } r -= I_GU; \
            if (r < I_DN) { SrcPlain s{args.in[5] + (size_t)(lw) * FF * DM, DM}; transpose_item(s, FF, (bf16*)(wlw + WO_DN2), scr, r / 32, r % 32, lane); continue; } r -= I_DN; \
            if (r < I_IN) { SrcIN s{args.in[6] + (size_t)(lw) * DM * INCOLS, ngw + 2 * DM}; transpose_item(s, DM, (bf16*)(wlw + WO_IN), scr, r / 112, r % 112, lane); continue; } r -= I_IN; \
            if (r < I_OUT) { SrcPlain s{args.in[7] + (size_t)(lw) * DM * DM, DM}; transpose_item(s, DM, (bf16*)(wlw + WO_OUT), scr, r / 32, r % 32, lane); continue; } r -= I_OUT; \
            { SrcCMP s{args.in[9] + (size_t)(lw) * 2 * 2048 * 128}; transpose_item(s, DM, (bf16*)(wlw + WO_CMP), scr, r / 16, r % 16, lane); } } } while (0)
        CONVERT_WEIGHTS(0);
        for (int i = blk * 512 + tid; i < SEQ * 8; i += G * 512) { const int pos = i >> 3, k = i & 7;
            const double inv = pow(500000.0, -(double)k / 8.0), ang = (double)pos * inv; cosT[i] = (float)cos(ang); sinT[i] = (float)sin(ang); }
        { LAS float* part = (LAS float*)(L + 131072);
          for (int ob = blk; ob < DEPTH * 2 * 128 / 2; ob += G) { const int o = 2 * ob + (wave >> 2), qr = wave & 3; const int lk = o >> 7, c = o & 127;
              const float* pe = args.in[8] + (size_t)lk * 2048; const float* w1 = args.in[9] + (size_t)lk * 2048 * 128;
              float s = 0.f; for (int r = qr * 512 + lane; r < qr * 512 + 512; r += 64) s += pe[r] * w1[(size_t)r * 128 + c];
              s = wave_sum(s, lane); if (lane == 0) part[wave] = s;
              __syncthreads();
              if (lane == 0 && qr == 0) b1T[o] = (part[wave] + part[wave + 1]) + (part[wave + 2] + part[wave + 3]);
              __syncthreads(); } }
        thin_phase<0>(nullptr, x_in, X16, nullptr, R2, nullptr, 0.f, gw, NGW, lane);
    }
    SEAM(0);

#pragma unroll 1
    for (int l = 0; l < DEPTH; ++l) {
        const int pb = 1 + l * PH_PER_LAYER, l_ = l;
        if (IN(pb + 0)) { PH_IDS(); pg8::Gemm g{X16, (const bf16*)(wl + WO_GU1), MTOK, NGU, DM}; pg8::StaticOrder S; S.init(MTOK, NGU, G, blk); EpiSwiglu E{HB, R2};
            pg8::gemm_phase<EpiSwiglu, pg8::StaticOrder, true, true>(L, g, S, E, tid); }
        SEAM(pb + 0);
        if (IN(pb + 1)) { PH_IDS(); pg8::Gemm g{HB, (const bf16*)(wl + WO_DN1), MTOK, DM, FF}; pg8::StaticOrder S; S.init(MTOK, DM, G, blk); pg8::EpiBf16<0> E{HD, DM, nullptr, 0, 0, 1.f};
            pg8::gemm_phase<pg8::EpiBf16<0>, pg8::StaticOrder, true, true>(L, g, S, E, tid); }
        SEAM(pb + 1);
        if (IN(pb + 2)) { PH_IDS(); thin_phase<1>(HD, nullptr, X16, nullptr, R2, ng + 1 * DM, 0.5f, gw, NGW, lane); }
        SEAM(pb + 2);
        if (IN(pb + 3)) { PH_IDS(); pg8::Gemm g{X16, (const bf16*)(wl + WO_IN), MTOK, NINP, DM}; pg8::StaticOrder S; S.init(MTOK, NINP, G, blk);
            EpiInProj E{ws};
            pg8::gemm_phase<EpiInProj, pg8::StaticOrder, true, true>(L, g, S, E, tid); }
        SEAM(pb + 3);
        if (IN(pb + 4)) { PH_IDS(); pg8::Gemm g{(const bf16*)(ws + WS_KCR), (const bf16*)(wl + WO_CMP), 8192, 512, DM}; CmpOrder S{blk, G}; EpiPQ E{(float*)(ws + WS_PQ)};
            pg8::gemm_phase<EpiPQ, CmpOrder, false, true>(L, g, S, E, tid);
            { const int nb = (G > 32) ? 32 : 0; if (blk >= nb) { mlstm_conv_pass(ws, args.in[11] + (size_t)l_ * 4 * 1024, args.in[12] + (size_t)l_ * 1024, (blk - nb) * 512 + tid, (G - nb) * 512); } } }
        SEAM(pb + 4);
        if (IN(pb + 5)) {
            PH_IDS();
            const float* b1T = (const float*)(ws + WS_TAB + TAB_B1); const float* PQ = (const float*)(ws + WS_PQ); bf16* CC = (bf16*)(ws + WS_CC);
            LAS float* w2s = (LAS float*)L; LAS float* hs = (LAS float*)(L + 32768) + wave * 4 * 128;
            for (int item = blk; item < 256; item += G) {
                const int kv = item >> 7, r0 = (item & 127) * 32 + wave * 4;
                const float* w2 = args.in[10] + (size_t)(l_ * 2 + kv) * 128 * 64; const float* b1 = b1T + (l_ * 2 + kv) * 128;
                __syncthreads();
                for (int i = tid; i < 128 * 64 / 4; i += 512) ((LAS f32x4*)w2s)[i] = ((const f32x4*)w2)[i];
#pragma unroll
                for (int rr = 0; rr < 4; ++rr) { const int r = kv * 4096 + r0 + rr, n = (r0 + rr) & 127;
#pragma unroll
                    for (int q2 = 0; q2 < 2; ++q2) { const int c = lane + 64 * q2; float hval = 0.f;
                        if (n != 127) { const float v = PQ[(size_t)r * 256 + c] + PQ[(size_t)(r + 1) * 256 + 128 + c] + b1[c];
                            const float u3 = 0.7978845608028654f * (v + 0.044715f * v * v * v); hval = 0.5f * v * (1.f + tanhf(u3)); }
                        hs[rr * 128 + c] = hval; } }
                __syncthreads();
                float o0 = 0.f, o1 = 0.f, o2 = 0.f, o3 = 0.f;
#pragma unroll 8
                for (int c = 0; c < 128; ++c) { const float wv = w2s[c * 64 + lane]; o0 += hs[c] * wv; o1 += hs[128 + c] * wv; o2 += hs[256 + c] * wv; o3 += hs[384 + c] * wv; }
                bf16* cp = CC + ((size_t)kv * 4096 + r0) * 64 + lane;
                cp[0] = (bf16)f2bf(o0); cp[64] = (bf16)f2bf(o1); cp[128] = (bf16)f2bf(o2); cp[192] = (bf16)f2bf(o3);
            }
        }
        SEAM(pb + 5);
        if (IN(pb + 6)) {
            PH_IDS();
            MixPtrs P{ws, args.in[11] + (size_t)l * 4 * 1024, args.in[12] + (size_t)l * 1024, args.in[13] + l * 4, args.in[14] + l * 4, args.in[15] + l * 512};
#ifndef PROBE_MIX_REP
#define PROBE_MIX_REP 1
#endif
            for (int rep = 0; rep < PROBE_MIX_REP; ++rep) {
            for (int u = blk; u < 64; u += G) mlstm_unit_mfma(L, P, u >> 2, u & 3, tid);
            { unsigned* qbase = (unsigned*)(ws + WS_CTL) + CW_QUEUE + 1024 * l_; volatile LAS unsigned* QW = (volatile LAS unsigned*)(L + MISC_OFF);
              const unsigned q0 = xb_xcc_id() & 7u;
#pragma unroll 1
              for (unsigned qq = 0; qq < 8u; ++qq) { unsigned* qctr = qbase + 64 * ((q0 + qq) & 7u); const int bg0 = 4 * (int)((q0 + qq) & 7u);
                  __syncthreads();
                  if (tid == 0) QW[0] = __hip_atomic_fetch_add(qctr, 1u, __ATOMIC_RELAXED, __HIP_MEMORY_SCOPE_AGENT);
                  __syncthreads();
                  unsigned u = QW[0];
                  while (u < 128u) { unsigned nxt = 0u; if (tid == 0) nxt = __hip_atomic_fetch_add(qctr, 1u, __ATOMIC_RELAXED, __HIP_MEMORY_SCOPE_AGENT);
                      const int c = 31 - (int)(u & 31u), bg = bg0 + (int)(u >> 5); nsa_unit_mfma(L, P, bg >> 1, bg & 1, c, tid);
                      __syncthreads(); if (tid == 0) QW[0] = nxt; __syncthreads(); u = QW[0]; } } }
            }
        }
        SEAM(pb + 6);
        if (IN(pb + 7)) { PH_IDS(); pg8::Gemm g{U, (const bf16*)(wl + WO_OUT), MTOK, DM, DM}; pg8::StaticOrder S; S.init(MTOK, DM, G, blk); pg8::EpiBf16<0> E{HD, DM, nullptr, 0, 0, 1.f};
            pg8::gemm_phase<pg8::EpiBf16<0>, pg8::StaticOrder, true, true>(L, g, S, E, tid); }
        SEAM(pb + 7);
        if (IN(pb + 8)) { PH_IDS(); thin_phase<1>(HD, nullptr, X16, nullptr, R2, ng + 3 * DM, 1.0f, gw, NGW, lane); }
        SEAM(pb + 8);
        if (IN(pb + 9)) { PH_IDS(); pg8::Gemm g{X16, (const bf16*)(wl + WO_GU2), MTOK, NGU, DM}; pg8::StaticOrder S; S.init(MTOK, NGU, G, blk); EpiSwiglu E{HB, R2};
            pg8::gemm_phase<EpiSwiglu, pg8::StaticOrder, true, true>(L, g, S, E, tid); }
        SEAM(pb + 9);
        if (IN(pb + 10)) { PH_IDS(); pg8::Gemm g{HB, (const bf16*)(wl + WO_DN2), MTOK, DM, FF}; pg8::StaticOrder S; S.init(MTOK, DM, G, blk); pg8::EpiBf16<0> E{HD, DM, nullptr, 0, 0, 1.f};
            pg8::gemm_phase<pg8::EpiBf16<0>, pg8::StaticOrder, true, true>(L, g, S, E, tid); }
        SEAM(pb + 10);
        if (IN(pb + 11)) { PH_IDS(); if (l + 1 < DEPTH) { thin_phase<1>(HD, nullptr, X16, nullptr, R2, ng + 5 * DM, 0.5f, gw, NGW, lane); CONVERT_WEIGHTS(l_ + 1); }
                           else thin_phase<2>(HD, nullptr, X16, args.out, nullptr, ng + 5 * DM, 0.5f, gw, NGW, lane); }
        if (l + 1 < DEPTH) SEAM(pb + 11);
    }
#undef IN
#undef SEAM
#undef CONVERT_WEIGHTS
#undef PH_IDS
#undef PH_WS
}

extern "C" void kernel_launch(void* const* d_in, const int* in_sizes, int n_in, void* d_out, int out_size, void* d_ws, size_t ws_size, hipStream_t stream) {
    static int grid = 0;
    if (grid == 0) {
        if (n_in != 16 || in_sizes[0] != MTOK * DM || out_size != MTOK * DM || ws_size < WS_END2) { fprintf(stderr, "kernel_launch: unexpected problem (n_in %d, ws %zu)\n", n_in, ws_size); grid = -1; return; }
        int dev = 0, cus = 0, per_cu = 0;
        if (hipGetDevice(&dev) != hipSuccess || hipDeviceGetAttribute(&cus, hipDeviceAttributeMultiprocessorCount, dev) != hipSuccess) { grid = -1; return; }
        if (hipFuncSetAttribute((const void*)fwd_kernel, hipFuncAttributeMaxDynamicSharedMemorySize, LDS_BYTES) != hipSuccess) { grid = -1; return; }
        if (hipOccupancyMaxActiveBlocksPerMultiprocessor(&per_cu, (const void*)fwd_kernel, NWAVES * 64, LDS_BYTES) != hipSuccess || per_cu < 1) { fprintf(stderr, "kernel_launch: occupancy query says %d\n", per_cu); }
        (void)hipGetLastError();
        grid = cus;
    }
    if (grid < 0) return;
    (void)hipMemsetAsync((char*)d_ws + WS_CTL, 0, CTL_ZERO_BYTES, stream);
    Args a{};
    for (int i = 0; i < 16; ++i) a.in[i] = (const float*)d_in[i];
    a.out = (float*)d_out; a.ws = (unsigned char*)d_ws;
#if MK_MULTI
    for (int p = 0; p < N_PHASES; ++p) { a.ph_lo = p; a.ph_hi = p + 1; hipLaunchKernelGGL(fwd_kernel, dim3(grid), dim3(NWAVES * 64), LDS_BYTES, stream, a); }
#else
    a.ph_lo = 0; a.ph_hi = N_PHASES; hipLaunchKernelGGL(fwd_kernel, dim3(grid), dim3(NWAVES * 64), LDS_BYTES, stream, a);
#endif
}
```

```cpp
#include <hip/hip_runtime.h>
#include <cstdio>
#include <cstdint>
namespace pg8 {
#define PG8_LAS __attribute__((address_space(3)))
typedef unsigned short bf16_t;
typedef short bf16x8 __attribute__((ext_vector_type(8)));
typedef float f32x4 __attribute__((ext_vector_type(4)));
typedef unsigned u32x4 __attribute__((ext_vector_type(4)));
constexpr int BM = 256, BK = 64, HALF = 128, HTB = HALF * BK * 2  , STAGE_BYTES = 8 * HTB, NXCD = 8, WGM = 4;

__host__ __device__ __forceinline__ int lds_byte(int r, int c) { const int st = (r >> 4) * 2 + (c >> 5), rr = r & 15, cc = c & 31, ob = rr * 64 + cc * 2; return st * 1024 + (ob ^ (((ob >> 9) & 1) << 5)); }
__host__ __device__ __forceinline__ void stage_rc(int b, int& R, int& C) { const int st = b / 1024, sb = b % 1024, swz = sb ^ (((sb >> 9) & 1) << 5); R = (st >> 1) * 16 + swz / 64; C = (st & 1) * 32 + (swz % 64) / 2; }
__host__ __device__ __forceinline__ int perm32(int rho) { const int n = rho >> 4, i = rho & 15; return 8 * (i >> 2) + 4 * n + (i & 3); }

struct Unit { int pm, pn; };
struct Gemm { const bf16_t* A; const bf16_t* Bt; int M, N, K; };

struct StaticOrder {
    int nM, nN, nwg, G, c;
    __host__ __device__ void init(int M, int N, int G_, int c_) { nM = M / BM; nN = N / BM; nwg = nM * nN; G = G_; c = c_; }
    __host__ __device__ bool next(int i, Unit& u) const {
        const long L = (long)i * G + c; if (L >= nwg) return false;
        int wgid = (int)L; { const int q = nwg / NXCD, r = nwg % NXCD, xcd = wgid % NXCD, off = wgid / NXCD; wgid = (xcd < r ? xcd * (q + 1) : r * (q + 1) + (xcd - r) * q) + off; }
        const int nig = WGM * nN, gid = wgid / nig, fm = gid * WGM, gsz = (nM - fm) < WGM ? (nM - fm) : WGM;
        u.pm = fm + ((wgid % nig) % gsz); u.pn = (wgid % nig) / gsz; return true;
    }
    __device__ __forceinline__ void a_ready(const Unit&) const {}
    __device__ __forceinline__ void done(const Unit&) const {}
};

__device__ __forceinline__ unsigned cvt_pk_bf16(float lo, float hi) { unsigned r; asm volatile("v_cvt_pk_bf16_f32 %0, %1, %2" : "=v"(r) : "v"(lo), "v"(hi)); return r; }
typedef float f32x2 __attribute__((ext_vector_type(2)));
__device__ __forceinline__ f32x2 gelu_pk(f32x2 v) {
    const f32x2 av = __builtin_elementwise_abs(v), d = av * 0.2316418882f + 1.0f;
    f32x2 t; t.x = __builtin_amdgcn_rcpf(d.x); t.y = __builtin_amdgcn_rcpf(d.y);
    f32x2 q = t * 0.5307027145f + (-0.7265760135f); q = q * t + 0.7107068705f; q = q * t + (-0.142248368f); q = q * t + 0.127414796f; q = q * t;
    const f32x2 s = (v * v) * (-0.72134752044f);
    f32x2 e; e.x = __builtin_amdgcn_exp2f(s.x); e.y = __builtin_amdgcn_exp2f(s.y);
    const f32x2 m = v * (q * e), r = v - m;
    f32x2 o; o.x = v.x < 0.f ? m.x : r.x; o.y = v.y < 0.f ? m.y : r.y; return o;
}

template <int ACT  > struct EpiBf16 {
    static constexpr bool PERM = true, AFTER_DRAIN = false; static_assert(ACT == 0 || ACT == 1, "EpiBf16: ACT is 0 (none) or 1 (gelu_pk)");
    bf16_t* O; int ldc; const float* bias; int split_cols; size_t split_stride; float scale0;
    __device__ __forceinline__ void operator()(const f32x4 (&acc)[2][2][4][2], const Unit& u, int wr, int wc, int fr, int fq) const {
        const int row0 = u.pm * BM + wr * 64 + fr; int colt = u.pn * BM; bf16_t* base = O;
        float sc = 1.f; if (split_cols) { const int t = colt / split_cols; base += (size_t)t * split_stride; colt -= t * split_cols; if (t == 0) sc = scale0; }
        const int col0 = colt + wc * 32 + 8 * fq, bcol0 = u.pn * BM + wc * 32 + 8 * fq;
        f32x4 bv[2][2];
#pragma unroll
        for (int bj = 0; bj < 2; ++bj)
#pragma unroll
            for (int n = 0; n < 2; ++n) bv[bj][n] = bias ? *(const f32x4*)(bias + bcol0 + bj * HALF + 4 * n) : (f32x4){0.f, 0.f, 0.f, 0.f};
#pragma unroll
        for (int ai = 0; ai < 2; ++ai)
#pragma unroll
            for (int m = 0; m < 4; ++m) { bf16_t* rowp = base + (size_t)(row0 + ai * HALF + m * 16) * ldc + col0;
#pragma unroll
                for (int bj = 0; bj < 2; ++bj) { f32x4 v0 = acc[ai][bj][m][0] + bv[bj][0], v1 = acc[ai][bj][m][1] + bv[bj][1];
                    if (ACT == 1) { f32x2 a = gelu_pk((f32x2){v0[0], v0[1]}), b = gelu_pk((f32x2){v0[2], v0[3]}), c = gelu_pk((f32x2){v1[0], v1[1]}), d = gelu_pk((f32x2){v1[2], v1[3]});
                        v0 = (f32x4){a.x, a.y, b.x, b.y}; v1 = (f32x4){c.x, c.y, d.x, d.y}; }
                    v0 = v0 * sc; v1 = v1 * sc; u32x4 w; w.x = cvt_pk_bf16(v0[0], v0[1]); w.y = cvt_pk_bf16(v0[2], v0[3]); w.z = cvt_pk_bf16(v1[0], v1[1]); w.w = cvt_pk_bf16(v1[2], v1[3]);
                    *(u32x4*)(rowp + bj * HALF) = w; } }
    }
};
template <class Epi, class Sched, bool ALIGN_EPI = false, bool SP2 = false>
__device__ __forceinline__ void gemm_phase(PG8_LAS unsigned char* lds, const Gemm g, const Sched& S, const Epi& E, int tid_in) {
    int tid_l = tid_in; asm volatile("" : "+v"(tid_l));
    const int tid = tid_l, wid = __builtin_amdgcn_readfirstlane(tid >> 6), lane = tid & 63, wr = wid >> 2, wc = wid & 3, fr = lane & 15, fq = lane >> 4;
    const int K = g.K, nt = K / BK;
    unsigned voffA[2], voffB[2];
#pragma unroll
    for (int i = 0; i < 2; ++i) { int R, C; stage_rc(tid * 16 + i * 8192, R, C); const int Rb = Epi::PERM ? ((R & ~31) + perm32(R & 31)) : R;
        voffA[i] = (unsigned)(R * K + C) * 2u; voffB[i] = (unsigned)(Rb * K + C) * 2u; }
    const size_t kstep = (size_t)(BK * 2);
    const size_t hstep = (size_t)HALF * K * 2;
    const size_t tstep = 2 * hstep;
    const unsigned ldsw = (unsigned)wid * 1024u;
    const int aoff = lds_byte(wr * 64 + fr, fq * 8), boff = lds_byte(wc * 32 + fr, fq * 8);
#define PG8_SA(b, h) (((b) * 2 + (h)) * HTB)
#define PG8_SB(b, h) ((4 + (b) * 2 + (h)) * HTB)
#define PG8_STAGE(bufoff, gbase, voff) do { _Pragma("unroll") for (int _i = 0; _i < 2; ++_i) \
        __builtin_amdgcn_global_load_lds((const unsigned*)((const char*)(gbase) + (voff)[_i]), (PG8_LAS unsigned*)(lds + (bufoff) + ldsw + _i * 8192), 16, 0, 0); } while (0)
#define PG8_LDA(dst, b, h) do { _Pragma("unroll") for (int m = 0; m < 4; ++m) _Pragma("unroll") for (int k = 0; k < 2; ++k) dst[m][k] = *(const PG8_LAS bf16x8*)(lds + PG8_SA(b, h) + aoff + m * 2048 + k * 1024); } while (0)
#define PG8_LDB(dst, b, h) do { _Pragma("unroll") for (int n = 0; n < 2; ++n) _Pragma("unroll") for (int k = 0; k < 2; ++k) dst[n][k] = *(const PG8_LAS bf16x8*)(lds + PG8_SB(b, h) + boff + n * 2048 + k * 1024); } while (0)
#define PG8_MMA(ai, bj, At, Bt) do { __builtin_amdgcn_s_setprio(1); _Pragma("unroll") for (int m = 0; m < 4; ++m) _Pragma("unroll") for (int n = 0; n < 2; ++n) _Pragma("unroll") for (int k = 0; k < 2; ++k) \
        acc[ai][bj][m][n] = __builtin_amdgcn_mfma_f32_16x16x32_bf16(Bt[n][k], At[m][k], acc[ai][bj][m][n], 0, 0, 0); __builtin_amdgcn_s_setprio(0); } while (0)
#define PG8_WAIT_V(n) asm volatile("s_waitcnt vmcnt(" #n ")" ::: "memory")
#define PG8_WAIT_L(n) asm volatile("s_waitcnt lgkmcnt(" #n ")" ::: "memory")
#define PG8_BAR __builtin_amdgcn_s_barrier()
#define PG8_SCHED __builtin_amdgcn_sched_barrier(0)
    Unit cur, nxt; int ui = 0;
    if (!S.next(0, cur)) return;
    f32x4 acc[2][2][4][2];
#pragma unroll
    for (int a = 0; a < 2; ++a)
#pragma unroll
        for (int b = 0; b < 2; ++b)
#pragma unroll
            for (int m = 0; m < 4; ++m)
#pragma unroll
                for (int n = 0; n < 2; ++n) acc[a][b][m][n] = (f32x4){0.f, 0.f, 0.f, 0.f};
    bf16x8 At[4][2], B0[2][2], B1[2][2];
    const char* cA = (const char*)g.A + (size_t)cur.pm * tstep; const char* cB = (const char*)g.Bt + (size_t)cur.pn * tstep;
    S.a_ready(cur);
    if constexpr (SP2) {
        PG8_STAGE(PG8_SB(0, 0), cB, voffB); PG8_STAGE(PG8_SB(0, 1), cB + hstep, voffB); PG8_STAGE(PG8_SA(0, 0), cA, voffA); PG8_STAGE(PG8_SA(0, 1), cA + hstep, voffA);
        if (wr == 1) PG8_BAR;
        PG8_WAIT_V(2); PG8_BAR;
        PG8_STAGE(PG8_SB(1, 0), cB + kstep, voffB); PG8_STAGE(PG8_SA(1, 0), cA + kstep, voffA); PG8_STAGE(PG8_SB(1, 1), cB + hstep + kstep, voffB);
        PG8_WAIT_V(6); PG8_BAR;
    } else {
        PG8_STAGE(PG8_SB(0, 0), cB, voffB); PG8_STAGE(PG8_SA(0, 0), cA, voffA); PG8_STAGE(PG8_SB(0, 1), cB + hstep, voffB); PG8_STAGE(PG8_SA(0, 1), cA + hstep, voffA);
        if (wr == 1) PG8_BAR;
        PG8_WAIT_V(4); PG8_BAR;
        PG8_STAGE(PG8_SB(1, 0), cB + kstep, voffB); PG8_STAGE(PG8_SA(1, 0), cA + kstep, voffA); PG8_STAGE(PG8_SB(1, 1), cB + hstep + kstep, voffB);
        PG8_WAIT_V(6); PG8_BAR;
    }
    for (;;) {
        const bool has_next = S.next(ui + 1, nxt);
        const char* nA = has_next ? (const char*)g.A + (size_t)nxt.pm * tstep : cA; const char* nB = has_next ? (const char*)g.Bt + (size_t)nxt.pn * tstep : cB;
        for (int t = 0; t < nt; t += 2) {
            const bool last = (t == nt - 2);
            const char* a1 = cA + (size_t)(t + 1) * kstep;
            const char* a2 = last ? nA : cA + (size_t)(t + 2) * kstep; const char* b2 = last ? nB : cB + (size_t)(t + 2) * kstep;
            const char* a3 = a2 + kstep; const char* b3 = b2 + kstep;
            if (last && has_next) S.a_ready(nxt);
            if constexpr (SP2) {
            PG8_LDB(B0, 0, 0); PG8_LDB(B1, 0, 1); PG8_SCHED; PG8_LDA(At, 0, 0); PG8_STAGE(PG8_SA(1, 1), a1 + hstep, voffA);
            PG8_WAIT_V(8); PG8_WAIT_L(0); PG8_BAR; PG8_MMA(0, 0, At, B0); PG8_MMA(0, 1, At, B1); PG8_BAR; PG8_SCHED;
            PG8_LDA(At, 0, 1); PG8_STAGE(PG8_SB(0, 0), b2, voffB); PG8_STAGE(PG8_SB(0, 1), b2 + hstep, voffB); PG8_STAGE(PG8_SA(0, 0), a2, voffA);
            PG8_WAIT_V(8); PG8_WAIT_L(0); PG8_BAR; PG8_MMA(1, 0, At, B0); PG8_MMA(1, 1, At, B1); PG8_BAR; PG8_SCHED;
            PG8_LDB(B0, 1, 0); PG8_LDB(B1, 1, 1); PG8_SCHED; PG8_LDA(At, 1, 0); PG8_STAGE(PG8_SA(0, 1), a2 + hstep, voffA);
            PG8_WAIT_V(8); PG8_WAIT_L(0); PG8_BAR; PG8_MMA(0, 0, At, B0); PG8_MMA(0, 1, At, B1); PG8_BAR; PG8_SCHED;
            PG8_LDA(At, 1, 1); PG8_STAGE(PG8_SB(1, 0), b3, voffB); PG8_STAGE(PG8_SB(1, 1), b3 + hstep, voffB); PG8_STAGE(PG8_SA(1, 0), a3, voffA);
            PG8_WAIT_V(8); PG8_WAIT_L(0); PG8_BAR; PG8_MMA(1, 0, At, B0); PG8_MMA(1, 1, At, B1); PG8_BAR; PG8_SCHED;
            } else {
            PG8_LDB(B0, 0, 0); PG8_SCHED; PG8_LDA(At, 0, 0); PG8_STAGE(PG8_SA(1, 1), a1 + hstep, voffA);
            PG8_WAIT_L(8); PG8_BAR; PG8_WAIT_L(0); PG8_MMA(0, 0, At, B0); PG8_BAR; PG8_SCHED;
            PG8_LDB(B1, 0, 1); PG8_STAGE(PG8_SB(0, 0), b2, voffB);
            PG8_BAR; PG8_WAIT_L(0); PG8_MMA(0, 1, At, B1); PG8_BAR;
            PG8_LDA(At, 0, 1); PG8_STAGE(PG8_SA(0, 0), a2, voffA);
            PG8_BAR; PG8_WAIT_L(0); PG8_MMA(1, 0, At, B0); PG8_BAR; PG8_SCHED;
            PG8_STAGE(PG8_SB(0, 1), b2 + hstep, voffB);
            PG8_WAIT_V(6); PG8_BAR; PG8_MMA(1, 1, At, B1); PG8_BAR;
            PG8_LDB(B0, 1, 0); PG8_SCHED; PG8_LDA(At, 1, 0); PG8_STAGE(PG8_SA(0, 1), a2 + hstep, voffA);
            PG8_WAIT_L(8); PG8_BAR; PG8_WAIT_L(0); PG8_MMA(0, 0, At, B0); PG8_BAR; PG8_SCHED;
            PG8_LDB(B1, 1, 1); PG8_STAGE(PG8_SB(1, 0), b3, voffB);
            PG8_BAR; PG8_WAIT_L(0); PG8_MMA(0, 1, At, B1); PG8_BAR;
            PG8_LDA(At, 1, 1); PG8_STAGE(PG8_SA(1, 0), a3, voffA);
            PG8_BAR; PG8_WAIT_L(0); PG8_MMA(1, 0, At, B0); PG8_BAR; PG8_SCHED;
            PG8_STAGE(PG8_SB(1, 1), b3 + hstep, voffB);
            PG8_WAIT_V(6); PG8_BAR; PG8_MMA(1, 1, At, B1); PG8_BAR;
            }
        }
        if constexpr (ALIGN_EPI) { if (wr == 0) PG8_BAR; }
        if constexpr (!Epi::AFTER_DRAIN) { E(acc, cur, wr, wc, fr, fq); S.done(cur); }
        if (!has_next) break;
#pragma unroll
        for (int a = 0; a < 2; ++a)
#pragma unroll
            for (int b = 0; b < 2; ++b)
#pragma unroll
                for (int m = 0; m < 4; ++m)
#pragma unroll
                    for (int n = 0; n < 2; ++n) acc[a][b][m][n] = (f32x4){0.f, 0.f, 0.f, 0.f};
        cur = nxt; cA = nA; cB = nB; ++ui;
        if constexpr (ALIGN_EPI) { if (wr == 1) PG8_BAR; }
    }
    PG8_WAIT_V(0);
    if constexpr (!ALIGN_EPI) { if (wr == 0) PG8_BAR; }
    PG8_BAR;
    if constexpr (Epi::AFTER_DRAIN) { E.fused(acc, cur, wr, wc, fr, fq, lds, wid, lane); S.done(cur); }
#undef PG8_SA
#undef PG8_SB
#undef PG8_STAGE
#undef PG8_LDA
#undef PG8_LDB
#undef PG8_MMA
#undef PG8_WAIT_V
#undef PG8_WAIT_L
#undef PG8_BAR
#undef PG8_SCHED
}
}

#define LAS __attribute__((address_space(3)))
#define XB_TMO      128
#define XB_XCNT(j)  (256  + 64 * (j))
#define XB_XSUB(j)  (1280 + 64 * (j))
#define XB_XGEN(j)  (2304 + 64 * (j))
#define XB_TOP      3328
#define XB_TOPGEN   3392
#define XCD_BAR_WORDS 3456
#define XB_SPIN_CAP (1u << 18)

__device__ __forceinline__ unsigned xb_ld(unsigned* p)              { return __hip_atomic_load(p, __ATOMIC_RELAXED, __HIP_MEMORY_SCOPE_AGENT); }
__device__ __forceinline__ unsigned xb_add(unsigned* p, unsigned v) { return __hip_atomic_fetch_add(p, v, __ATOMIC_RELAXED, __HIP_MEMORY_SCOPE_AGENT); }
__device__ __forceinline__ unsigned xb_xcc_id() { return (unsigned)__builtin_amdgcn_s_getreg((3 << 11) | 20) & 0xFu; }
#define XB_SPIN(cond, bar) do { unsigned _sp = 0; while (cond) { __builtin_amdgcn_s_sleep(1); \
    if ((++_sp & 255u) == 0u) { if (xb_ld(&(bar)[XB_TMO])) break; if (_sp > XB_SPIN_CAP) { atomicAdd(&(bar)[XB_TMO], 1u); break; } } } } while (0)

struct XcdBarrier {
    unsigned* bar; unsigned x;
    volatile LAS unsigned* st;
};

__device__ __forceinline__ XcdBarrier xcd_barrier_post(unsigned* bar, volatile LAS unsigned* st, bool leader) {
    XcdBarrier b; b.bar = bar; b.x = xb_xcc_id(); b.st = st;
    if (leader) (void)xb_add(&bar[XB_XCNT(b.x)], 1u);
    return b;
}
__device__ __forceinline__ void xcd_barrier_complete(unsigned* bar, unsigned x, unsigned& nloc, unsigned& nx) {
    const unsigned G = gridDim.x * gridDim.y * gridDim.z;
    unsigned sum, cnt, mine, sp = 0u;
    for (;;) {
        sum = 0u; cnt = 0u; mine = 0u;
#pragma unroll
        for (unsigned j = 0; j < 16; ++j) { const unsigned c = xb_ld(&bar[XB_XCNT(j)]); sum += c; cnt += (c > 0u) ? 1u : 0u; mine = (j == x) ? c : mine; }
        if (sum == G) break;
        __builtin_amdgcn_s_sleep(1);
        if ((++sp & 255u) == 0u) { if (xb_ld(&bar[XB_TMO])) break; if (sp > XB_SPIN_CAP) { atomicAdd(&bar[XB_TMO], 1u); break; } }
    }
    nloc = mine > 0u ? mine : 1u; nx = cnt > 0u ? cnt : 1u;
}

__device__ __forceinline__ void xcd_barrier(const XcdBarrier& b, bool leader) {
    asm volatile("s_waitcnt vmcnt(0)" ::: "memory");
    __syncthreads();
    if (leader) {
        unsigned* bar = b.bar;
        __builtin_amdgcn_s_waitcnt(0);
        unsigned nloc = b.st[0], nx = b.st[1];
        if (nloc == 0u) { xcd_barrier_complete(bar, b.x, nloc, nx); b.st[0] = nloc; b.st[1] = nx; }
        const unsigned old = xb_add(&bar[XB_XSUB(b.x)], 1u);
        const unsigned gen = old / nloc;
        if (old + 1u == (gen + 1u) * nloc) {
            __builtin_amdgcn_fence(__ATOMIC_RELEASE, "agent");
            asm volatile("s_waitcnt vmcnt(0)" ::: "memory");
            const unsigned og = xb_add(&bar[XB_TOP], 1u);
            const unsigned tg = og / nx;
            if (og + 1u == (tg + 1u) * nx) xb_add(&bar[XB_TOPGEN], 1u);
            else XB_SPIN(xb_ld(&bar[XB_TOPGEN]) == tg, bar);
            __builtin_amdgcn_fence(__ATOMIC_ACQUIRE, "agent");
            xb_add(&bar[XB_XGEN(b.x)], 1u);
            asm volatile("s_waitcnt vmcnt(0)" ::: "memory");
        } else {
            XB_SPIN(xb_ld(&bar[XB_XGEN(b.x)]) == gen, bar);
            __builtin_amdgcn_fence(__ATOMIC_ACQUIRE, "agent");
            asm volatile("s_waitcnt vmcnt(0)" ::: "memory");
        }
    }
    __syncthreads();
}

constexpr int BATCH = 16, SEQ = 2048, DM = 1024, MTOK = BATCH * SEQ, FF = 2816, NGU = 2 * FF, NINP = 3584, INCOLS = 3360, DEPTH = 2;
constexpr int NWAVES = 8;
constexpr float EPS = 1e-6f;
typedef unsigned short bf16;
typedef unsigned v4u __attribute__((ext_vector_type(4)));
typedef unsigned v2u __attribute__((ext_vector_type(2)));
typedef float f32x4 __attribute__((ext_vector_type(4)));
#define LDS_WAIT() asm volatile("s_waitcnt lgkmcnt(0)" ::: "memory")

constexpr size_t MiB = 1u << 20;
constexpr size_t WS_CTL = 0, CTL_ZERO_BYTES = 160 * 1024;
constexpr size_t WS_TAB = 1 * MiB;
constexpr size_t TAB_COS = 0, TAB_SIN = 65536, TAB_B1 = 131072, TAB_SS2 = 262144;
constexpr size_t WS_W = 2 * MiB;
constexpr size_t WO_GU1 = 0, WO_DN1 = 11 * MiB, WO_GU2 = 16 * MiB + MiB / 2, WO_DN2 = 27 * MiB + MiB / 2, WO_IN = 33 * MiB, WO_OUT = 40 * MiB, WO_CMP = 42 * MiB;
constexpr size_t WS_X16 = 45 * MiB;
constexpr size_t WS_U = 109 * MiB;
constexpr size_t WS_HB = 173 * MiB;
constexpr size_t WS_HD = 349 * MiB;
constexpr size_t WS_PQ = 413 * MiB;
constexpr size_t WS_CC = 421 * MiB;
constexpr size_t WS_END = 422 * MiB;
constexpr size_t WS_QN = 173 * MiB, WS_KCR = 205 * MiB, WS_VCR = 213 * MiB, WS_KS = 221 * MiB, WS_VS = 229 * MiB, WS_KW = 237 * MiB, WS_VW = 245 * MiB;
constexpr size_t WS_MQ = 253 * MiB, WS_MK = 285 * MiB, WS_MV = 317 * MiB, WS_MO = 349 * MiB, WS_GATE = 381 * MiB;
static_assert(WS_GATE + 4 * MiB <= WS_PQ, "in-projection outputs end below PQ");
constexpr int CW_BAR = 4096, CW_QUEUE = 16384, CW_GRP = 20480;
constexpr size_t WS_PART = 486 * MiB, WS_END3 = 489 * MiB;
static_assert((CW_QUEUE + 2 * 1024) <= CW_GRP && (CW_GRP + 6 * 128 * 16) * 4 <= (int)CTL_ZERO_BYTES && (CW_BAR + 3456) <= CW_QUEUE && WS_TAB + TAB_SS2 + 16 * 32768 <= WS_W, "control words inside the zeroed region");
constexpr int PH_BYTES = 143360, MISC_OFF = PH_BYTES, LDS_BYTES = 147456;

__device__ __forceinline__ unsigned f2bf(float f) { unsigned u = __builtin_bit_cast(unsigned, f); return (u + 0x7fffu + ((u >> 16) & 1u)) >> 16; }
__device__ __forceinline__ unsigned pk2(float lo, float hi) { return f2bf(lo) | (f2bf(hi) << 16); }
typedef float f32x2v_ __attribute__((ext_vector_type(2))); typedef __bf16 bf16x2v_ __attribute__((ext_vector_type(2)));
__device__ __forceinline__ unsigned cvtpk(float lo, float hi) { f32x2v_ v = {lo, hi}; bf16x2v_ b = __builtin_convertvector(v, bf16x2v_); return __builtin_bit_cast(unsigned, b); }
__device__ __forceinline__ float bflo(unsigned u) { return __builtin_bit_cast(float, u << 16); }
__device__ __forceinline__ float bfhi(unsigned u) { return __builtin_bit_cast(float, u & 0xffff0000u); }
__device__ __forceinline__ float bf2f(bf16 b) { return __builtin_bit_cast(float, (unsigned)b << 16); }
__device__ __forceinline__ float sigmoidf_(float x) { return __builtin_amdgcn_rcpf(1.f + __expf(-x)); }
__device__ __forceinline__ int fresh_lane() { unsigned z = 0u; asm volatile("" : "+v"(z)); return (int)__builtin_amdgcn_mbcnt_hi(~0u, __builtin_amdgcn_mbcnt_lo(~0u, z)); }
__device__ __forceinline__ float shx(float v, int mask, int lane) { return __builtin_bit_cast(float, __builtin_amdgcn_ds_bpermute((lane ^ mask) << 2, __builtin_bit_cast(int, v))); }
__device__ __forceinline__ unsigned shxu(unsigned v, int mask, int lane) { return (unsigned)__builtin_amdgcn_ds_bpermute((lane ^ mask) << 2, (int)v); }
__device__ __forceinline__ float shi(float v, int src) { return __builtin_bit_cast(float, __builtin_amdgcn_ds_bpermute(src << 2, __builtin_bit_cast(int, v))); }
__device__ __forceinline__ float wave_sum(float v, int lane) {
    (void)lane;
    v += __builtin_bit_cast(float, __builtin_amdgcn_update_dpp(0, __builtin_bit_cast(int, v), 0xB1, 0xF, 0xF, false));
    v += __builtin_bit_cast(float, __builtin_amdgcn_update_dpp(0, __builtin_bit_cast(int, v), 0x4E, 0xF, 0xF, false));
    v += __builtin_bit_cast(float, __builtin_amdgcn_update_dpp(0, __builtin_bit_cast(int, v), 0x124, 0xF, 0xF, false));
    v += __builtin_bit_cast(float, __builtin_amdgcn_update_dpp(0, __builtin_bit_cast(int, v), 0x128, 0xF, 0xF, false));
    const int iv = __builtin_bit_cast(int, v);
    const float a = __builtin_bit_cast(float, __builtin_amdgcn_readlane(iv, 0)), b = __builtin_bit_cast(float, __builtin_amdgcn_readlane(iv, 16));
    const float c = __builtin_bit_cast(float, __builtin_amdgcn_readlane(iv, 32)), d = __builtin_bit_cast(float, __builtin_amdgcn_readlane(iv, 48));
    return (a + b) + (c + d);
}

struct SrcGU { const float* W; const float* g; __device__ __forceinline__ float operator()(int k, int nd) const { const int pn = nd >> 8, r = nd & 255; const int col = (r < 128) ? (pn * 128 + r) : (FF + pn * 128 + r - 128); return W[(size_t)k * NGU + col] * g[k]; } };
struct SrcPlain { const float* W; int N; __device__ __forceinline__ float operator()(int k, int nd) const { return W[(size_t)k * N + nd]; } };
struct SrcIN { const float* W; const float* g; __device__ __forceinline__ float operator()(int k, int nd) const {
    const int col = nd < 1280 ? nd : (nd < 3328 ? nd + 24 : (nd < 3352 ? nd - 3328 + 1280 : (nd < 3360 ? nd : -1)));
    return col < 0 ? 0.f : W[(size_t)k * INCOLS + col] * g[k]; } };
struct SrcCMP { const float* W1; __device__ __forceinline__ float operator()(int k, int nd) const { const int kv = nd >> 8, r = nd & 255;
    return r < 128 ? W1[((size_t)kv * 2048 + k) * 128 + r] : W1[((size_t)kv * 2048 + 1024 + k) * 128 + r - 128]; } };

template <class SrcF>
__device__ __forceinline__ void transpose_item(const SrcF& src, int K, bf16* WT, LAS float* scr, int kb, int nb, int lane) {
    const int k0 = 64 * kb, n0 = 32 * nb;
#pragma unroll 8
    for (int i = 0; i < 32; ++i) { const int kk = 2 * i + (lane >> 5); scr[kk * 33 + (lane & 31)] = src(k0 + kk, n0 + (lane & 31)); }
    LDS_WAIT(); asm volatile("" ::: "memory");
    const int c = lane & 7;
#pragma unroll
    for (int j = 0; j < 4; ++j) { const int n = (lane >> 3) + 8 * j; const LAS float* s = scr + (8 * c) * 33 + n;
        v4u o; o.x = pk2(s[0 * 33], s[1 * 33]); o.y = pk2(s[2 * 33], s[3 * 33]); o.z = pk2(s[4 * 33], s[5 * 33]); o.w = pk2(s[6 * 33], s[7 * 33]);
        *(v4u*)(WT + (size_t)(n0 + n) * K + k0 + 8 * c) = o; }
    LDS_WAIT(); asm volatile("" ::: "memory");
}

template <int MODE>
__device__ __forceinline__ void thin_phase(const bf16* HD, const float* xin_f32, bf16* X16, float* out_f32, float* R2, const float* gpost, float cc, int gw, int NGW, int lane) {
    f32x4 gp[4];
#pragma unroll
    for (int j = 0; j < 4; ++j) gp[j] = (MODE != 0) ? *(const f32x4*)(gpost + 4 * lane + 256 * j) : (f32x4){0.f, 0.f, 0.f, 0.f};
    f32x4 xf[4]; v2u xn[4], hn[4];
    if (gw < MTOK) {
#pragma unroll
        for (int j = 0; j < 4; ++j) { if (MODE == 0) xf[j] = *(const f32x4*)(xin_f32 + (size_t)gw * DM + 4 * lane + 256 * j);
            else { xn[j] = *(const v2u*)(X16 + (size_t)gw * DM + 4 * lane + 256 * j); hn[j] = *(const v2u*)(HD + (size_t)gw * DM + 4 * lane + 256 * j); } }
    }
    for (int m = gw; m < MTOK; m += NGW) {
        f32x4 x[4]; v2u hw[4];
#pragma unroll
        for (int j = 0; j < 4; ++j) { if (MODE == 0) x[j] = xf[j]; else { x[j] = (f32x4){bflo(xn[j].x), bfhi(xn[j].x), bflo(xn[j].y), bfhi(xn[j].y)}; hw[j] = hn[j]; } }
        const int m2 = m + NGW;
        if (m2 < MTOK) {
#pragma unroll
            for (int j = 0; j < 4; ++j) { if (MODE == 0) xf[j] = *(const f32x4*)(xin_f32 + (size_t)m2 * DM + 4 * lane + 256 * j);
                else { xn[j] = *(const v2u*)(X16 + (size_t)m2 * DM + 4 * lane + 256 * j); hn[j] = *(const v2u*)(HD + (size_t)m2 * DM + 4 * lane + 256 * j); } }
        }
        if (MODE != 0) {
            f32x4 h[4]; float ss = 0.f;
#pragma unroll
            for (int j = 0; j < 4; ++j) { h[j] = (f32x4){bflo(hw[j].x), bfhi(hw[j].x), bflo(hw[j].y), bfhi(hw[j].y)}; ss += (h[j].x * h[j].x + h[j].y * h[j].y) + (h[j].z * h[j].z + h[j].w * h[j].w); }
            const float r = cc * __frsqrt_rn(wave_sum(ss, lane) * (1.f / DM) + EPS);
#pragma unroll
            for (int j = 0; j < 4; ++j) x[j] = x[j] + (h[j] * r) * gp[j];
        }
        if (MODE == 2) {
#pragma unroll
            for (int j = 0; j < 4; ++j) *(f32x4*)(out_f32 + (size_t)m * DM + 4 * lane + 256 * j) = x[j];
        } else {
            float s2 = 0.f;
#pragma unroll
            for (int j = 0; j < 4; ++j) { s2 += (x[j].x * x[j].x + x[j].y * x[j].y) + (x[j].z * x[j].z + x[j].w * x[j].w);
                v2u w; w.x = cvtpk(x[j].x, x[j].y); w.y = cvtpk(x[j].z, x[j].w); *(v2u*)(X16 + (size_t)m * DM + 4 * lane + 256 * j) = w; }
            const float st = wave_sum(s2, lane);
            if (lane == 0) *(f32x4*)(R2 + (size_t)m * 4) = (f32x4){st, 0.f, 0.f, 0.f};
        }
    }
}

struct EpiSwiglu {
    static constexpr bool PERM = true, AFTER_DRAIN = false;
    bf16* H; const float* SS2;
    __device__ __forceinline__ void operator()(const pg8::f32x4 (&acc)[2][2][4][2], const pg8::Unit& u, int wr, int wc, int fr, int fq) const {
        float rsv[2][4];
#pragma unroll
        for (int ai = 0; ai < 2; ++ai)
#pragma unroll
            for (int m = 0; m < 4; ++m) { const f32x4 p = *(const f32x4*)(SS2 + (size_t)(u.pm * 256 + ai * 128 + wr * 64 + m * 16 + fr) * 4); rsv[ai][m] = __frsqrt_rn(((p.x + p.y) + (p.z + p.w)) * (1.f / DM) + EPS); }
#pragma unroll
        for (int ai = 0; ai < 2; ++ai)
#pragma unroll
            for (int m = 0; m < 4; ++m) {
                const int row = u.pm * 256 + ai * 128 + wr * 64 + m * 16 + fr; const float rs = rsv[ai][m];
                typedef float f2 __attribute__((ext_vector_type(2)));
                f2 tg[4], tu[4], ex[4]; float o[8];
#pragma unroll
                for (int n = 0; n < 2; ++n) { const pg8::f32x4 g4 = acc[ai][0][m][n], u4 = acc[ai][1][m][n];
                    tg[2 * n] = (f2){g4[0], g4[1]} * rs; tg[2 * n + 1] = (f2){g4[2], g4[3]} * rs; tu[2 * n] = (f2){u4[0], u4[1]} * rs; tu[2 * n + 1] = (f2){u4[2], u4[3]} * rs; }
#pragma unroll
                for (int e = 0; e < 4; ++e) { const f2 a2 = tg[e] * -1.4426950408889634f; ex[e].x = __builtin_amdgcn_exp2f(a2.x); ex[e].y = __builtin_amdgcn_exp2f(a2.y); }
#pragma unroll
                for (int e = 0; e < 4; ++e) { const f2 d2 = ex[e] + 1.0f; ex[e].x = __builtin_amdgcn_rcpf(d2.x); ex[e].y = __builtin_amdgcn_rcpf(d2.y); tu[e] = tg[e] * tu[e]; }
#pragma unroll
                for (int e = 0; e < 4; ++e) { const f2 r2 = tu[e] * ex[e]; o[2 * e] = r2.x; o[2 * e + 1] = r2.y; }
                v4u w; w.x = pg8::cvt_pk_bf16(o[0], o[1]); w.y = pg8::cvt_pk_bf16(o[2], o[3]); w.z = pg8::cvt_pk_bf16(o[4], o[5]); w.w = pg8::cvt_pk_bf16(o[6], o[7]);
                *(v4u*)(H + (size_t)row * FF + u.pn * 128 + wc * 32 + fq * 8) = w;
            }
    }
};
#define EPI_LBAR() do { asm volatile("s_waitcnt lgkmcnt(0)" ::: "memory"); __builtin_amdgcn_s_barrier(); } while (0)
template <bool FINAL>
struct EpiResNorm {
    static constexpr bool PERM = true, AFTER_DRAIN = false;
    unsigned char* ws; LAS float* red; const float* gpost; float* outf; float cc; int inst;
    __device__ __forceinline__ void operator()(const pg8::f32x4 (&acc)[2][2][4][2], const pg8::Unit& u, int wr, int wc, int fr_, int fq_) const {
        int fr = fr_, fq = fq_;
        bf16* X16 = (bf16*)(ws + WS_X16);
        const int ln = fresh_lane(), wv = wr * 4 + wc, tid = wv * 64 + ln; fr = ln & 15; fq = ln >> 4;
        const int r0 = u.pm * 256 + wr * 64 + fr, c0 = u.pn * 256 + wc * 32 + fq * 8;
        v4u xv[2][4][2];
        if (wv != 0) {
#pragma unroll
            for (int ai = 0; ai < 2; ++ai)
#pragma unroll
                for (int m = 0; m < 4; ++m)
#pragma unroll
                    for (int bj = 0; bj < 2; ++bj) xv[ai][m][bj] = *(const v4u*)(X16 + (size_t)(r0 + ai * 128 + m * 16) * DM + c0 + bj * 128);
        }
        if (tid >= 256) red[1280 + tid - 256] = gpost[u.pn * 256 + tid - 256];
#pragma unroll
        for (int ai = 0; ai < 2; ++ai)
#pragma unroll
            for (int m = 0; m < 4; ++m) { float s = 0.f;
#pragma unroll
                for (int bj = 0; bj < 2; ++bj)
#pragma unroll
                    for (int n = 0; n < 2; ++n) { const pg8::f32x4 a = acc[ai][bj][m][n]; s += (a[0] * a[0] + a[1] * a[1]) + (a[2] * a[2] + a[3] * a[3]); }
                s += shx(s, 16, ln); s += shx(s, 32, ln);
                if (fq == 0) red[wc * 256 + ai * 128 + wr * 64 + m * 16 + fr] = s; }
        EPI_LBAR();
        if (wv == 0) {
            unsigned* ctr = (unsigned*)(ws + WS_CTL) + CW_GRP + (inst * 128 + u.pm) * 16;
            unsigned* part = (unsigned*)(ws + WS_PART) + (size_t)inst * 4 * MTOK + u.pm * 256 + 4 * ln;
            const f32x4 p0 = *(const LAS f32x4*)(red + 4 * ln), p1 = *(const LAS f32x4*)(red + 256 + 4 * ln), p2 = *(const LAS f32x4*)(red + 512 + 4 * ln), p3 = *(const LAS f32x4*)(red + 768 + 4 * ln);
            const f32x4 ps = (p0 + p1) + (p2 + p3);
            unsigned* mine = part + (size_t)u.pn * MTOK;
            asm volatile("global_store_dwordx4 %0, %1, off sc1\n\ts_waitcnt vmcnt(0)" :: "v"(mine), "v"(ps) : "memory");
            if (ln == 0) { (void)__hip_atomic_fetch_add(ctr, 1u, __ATOMIC_RELAXED, __HIP_MEMORY_SCOPE_AGENT);
                unsigned sp = 0u; while (__hip_atomic_load(ctr, __ATOMIC_RELAXED, __HIP_MEMORY_SCOPE_AGENT) < 4u) { __builtin_amdgcn_s_sleep(1); if (++sp > (1u << 22)) break; } }
            asm volatile("" ::: "memory");
            f32x4 q0, q1, q2, q3;
            asm volatile("global_load_dwordx4 %0, %4, off sc1\n\tglobal_load_dwordx4 %1, %5, off sc1\n\tglobal_load_dwordx4 %2, %6, off sc1\n\tglobal_load_dwordx4 %3, %7, off sc1\n\ts_waitcnt vmcnt(0)"
                         : "=&v"(q0), "=&v"(q1), "=&v"(q2), "=&v"(q3) : "v"(part), "v"(part + MTOK), "v"(part + 2 * (size_t)MTOK), "v"(part + 3 * (size_t)MTOK) : "memory");
            const f32x4 t = ((q0 + q1) + (q2 + q3)) * (1.f / DM) + EPS;
            *(LAS f32x4*)(red + 1024 + 4 * ln) = (f32x4){cc * __frsqrt_rn(t.x), cc * __frsqrt_rn(t.y), cc * __frsqrt_rn(t.z), cc * __frsqrt_rn(t.w)};
#pragma unroll
            for (int ai = 0; ai < 2; ++ai)
#pragma unroll
                for (int m = 0; m < 4; ++m)
#pragma unroll
                    for (int bj = 0; bj < 2; ++bj) xv[ai][m][bj] = *(const v4u*)(X16 + (size_t)(r0 + ai * 128 + m * 16) * DM + c0 + bj * 128);
        }
        EPI_LBAR();
#pragma unroll
        for (int ai = 0; ai < 2; ++ai)
#pragma unroll
            for (int m = 0; m < 4; ++m) { const float inv = red[1024 + ai * 128 + wr * 64 + m * 16 + fr]; float s = 0.f; const size_t rowo = (size_t)(r0 + ai * 128 + m * 16) * DM + c0;
                asm volatile("" ::: "memory");
#pragma unroll
                for (int bj = 0; bj < 2; ++bj) { const v4u xw = xv[ai][m][bj]; const LAS float* gl = red + 1280 + bj * 128 + wc * 32 + fq * 8; const f32x4 gv0 = *(const LAS f32x4*)gl, gv1 = *(const LAS f32x4*)(gl + 4);
                    f32x4 x0 = (f32x4){bflo(xw.x), bfhi(xw.x), bflo(xw.y), bfhi(xw.y)}, x1 = (f32x4){bflo(xw.z), bfhi(xw.z), bflo(xw.w), bfhi(xw.w)};
                    x0 = x0 + (acc[ai][bj][m][0] * inv) * gv0; x1 = x1 + (acc[ai][bj][m][1] * inv) * gv1;
                    if (FINAL) { float* op = outf + rowo + bj * 128; *(f32x4*)op = x0; *(f32x4*)(op + 4) = x1; }
                    else { s += ((x0.x * x0.x + x0.y * x0.y) + (x0.z * x0.z + x0.w * x0.w)) + ((x1.x * x1.x + x1.y * x1.y) + (x1.z * x1.z + x1.w * x1.w));
                        v4u w; w.x = pg8::cvt_pk_bf16(x0.x, x0.y); w.y = pg8::cvt_pk_bf16(x0.z, x0.w); w.z = pg8::cvt_pk_bf16(x1.x, x1.y); w.w = pg8::cvt_pk_bf16(x1.z, x1.w);
                        *(v4u*)(X16 + rowo + bj * 128) = w; } }
                if (!FINAL) { s += shx(s, 16, ln); s += shx(s, 32, ln); if (fq == 0) red[wc * 256 + ai * 128 + wr * 64 + m * 16 + fr] = s; } }
        if (!FINAL) {
            EPI_LBAR();
            if (tid < 256) ((float*)(ws + WS_TAB + TAB_SS2))[(size_t)(u.pm * 256 + tid) * 4 + u.pn] = (red[tid] + red[256 + tid]) + (red[512 + tid] + red[768 + tid]);
        }
    }
};
struct EpiPQ {
    static constexpr bool PERM = true, AFTER_DRAIN = false;
    float* O;
    __device__ __forceinline__ void operator()(const pg8::f32x4 (&acc)[2][2][4][2], const pg8::Unit& u, int wr, int wc, int fr, int fq) const {
#pragma unroll
        for (int ai = 0; ai < 2; ++ai)
#pragma unroll
            for (int m = 0; m < 4; ++m) {
                const int row = u.pm * 256 + ai * 128 + wr * 64 + m * 16 + fr;
#pragma unroll
                for (int bj = 0; bj < 2; ++bj) { float* p = O + (size_t)row * 256 + bj * 128 + wc * 32 + fq * 8;
                    *(pg8::f32x4*)p = acc[ai][bj][m][0]; *(pg8::f32x4*)(p + 4) = acc[ai][bj][m][1]; }
            }
    }
};
struct CmpOrder {
    int c, G;
    __device__ __forceinline__ bool next(int i, pg8::Unit& u) const { const int idx = i * G + c; if (idx >= 32) return false; u.pm = idx; u.pn = idx >> 4; return true; }
    __device__ __forceinline__ void a_ready(const pg8::Unit&) const {}
    __device__ __forceinline__ void done(const pg8::Unit&) const {}
};
struct EpiInProj {
    static constexpr bool PERM = true, AFTER_DRAIN = false;
    unsigned char* ws;
    __device__ __forceinline__ void operator()(const pg8::f32x4 (&acc)[2][2][4][2], const pg8::Unit& u, int wr, int wc, int fr, int fq) const {
        const int pn = u.pn;
        const float* cosT = (const float*)(ws + WS_TAB + TAB_COS); const float* sinT = (const float*)(ws + WS_TAB + TAB_SIN);
        const bool ropet = (pn < 2) || (pn == 3) || (pn == 4);
        const bool ropew = ropet && ((wc & 1) == 0);
        float rsv[2][4];
#pragma unroll
        for (int ai = 0; ai < 2; ++ai)
#pragma unroll
            for (int m = 0; m < 4; ++m) { const f32x4 p = *(const f32x4*)((const float*)(ws + WS_TAB + TAB_SS2) + (size_t)(u.pm * 256 + ai * 128 + wr * 64 + m * 16 + fr) * 4); rsv[ai][m] = __frsqrt_rn(((p.x + p.y) + (p.z + p.w)) * (1.f / DM) + EPS); }
#pragma unroll
        for (int ai = 0; ai < 2; ++ai)
#pragma unroll
            for (int m = 0; m < 4; ++m) {
                const int row = u.pm * 256 + ai * 128 + wr * 64 + m * 16 + fr;
                const int b = row >> 11, t = row & 2047; const float rs = rsv[ai][m];
                f32x4 c0, c1, s0, s1;
                if (ropew) {
                    const float tf = (float)t; float cs_[8], sn_[8];
                    const float ifr[8] = {1.5915494309e-01f, 3.0863763405e-02f, 5.9851857127e-03f, 1.1606636412e-03f, 2.2507907904e-04f, 4.3647952793e-05f, 8.4643308082e-06f, 1.6414262628e-06f};
#pragma unroll
                    for (int e = 0; e < 8; ++e) { const float rv = __builtin_amdgcn_fractf(tf * ifr[e]); cs_[e] = __builtin_amdgcn_cosf(rv); sn_[e] = __builtin_amdgcn_sinf(rv); }
                    c0 = (f32x4){cs_[0], cs_[1], cs_[2], cs_[3]}; c1 = (f32x4){cs_[4], cs_[5], cs_[6], cs_[7]}; s0 = (f32x4){sn_[0], sn_[1], sn_[2], sn_[3]}; s1 = (f32x4){sn_[4], sn_[5], sn_[6], sn_[7]}; }
#pragma unroll
                for (int bj = 0; bj < 2; ++bj) {
                    f32x4 v0 = acc[ai][bj][m][0] * rs, v1 = acc[ai][bj][m][1] * rs;
                    const int cl = bj * 128 + wc * 32 + fq * 8;
                    if (ropew && (pn < 2 || bj == 0)) {
                        f32x4 p0, p1; const int ln = fq * 16 + fr;
                        p0.x = shx(v0.x, 16, ln); p0.y = shx(v0.y, 16, ln); p0.z = shx(v0.z, 16, ln); p0.w = shx(v0.w, 16, ln);
                        p1.x = shx(v1.x, 16, ln); p1.y = shx(v1.y, 16, ln); p1.z = shx(v1.z, 16, ln); p1.w = shx(v1.w, 16, ln);
                        const float sg = (fq == 0) ? -1.f : 1.f;
                        if (fq < 2) { v0 = v0 * c0 + (p0 * s0) * sg; v1 = v1 * c1 + (p1 * s1) * sg; }
                    }
                    if (pn < 2) { v0 = v0 * 0.18033688011112042f; v1 = v1 * 0.18033688011112042f; }
                    if (pn == 13) { if (cl < 32) { float* p = (float*)(ws + WS_GATE) + (size_t)row * 32 + cl; *(f32x4*)p = v0; *(f32x4*)(p + 4) = v1; } }
                    else {
                        size_t off;
                        if (pn < 2) off = WS_QN + ((size_t)row * 512 + pn * 256 + cl) * 2;
                        else if (pn < 5) { const int g = wc >> 1, d = (wc & 1) * 32 + fq * 8; off = WS_KCR + (size_t)((pn - 2) * 2 + bj) * (8 * MiB) + (((size_t)(b * 2 + g) * SEQ + t) * 64 + d) * 2; }
                        else { const int q = pn - 5; off = WS_MQ + (size_t)(q >> 1) * (32 * MiB) + ((size_t)row * 512 + (q & 1) * 256 + cl) * 2; }
                        v4u w; w.x = pg8::cvt_pk_bf16(v0.x, v0.y); w.y = pg8::cvt_pk_bf16(v0.z, v0.w); w.z = pg8::cvt_pk_bf16(v1.x, v1.y); w.w = pg8::cvt_pk_bf16(v1.z, v1.w);
                        *(v4u*)(ws + off) = w;
                    }
                }
            }
    }
};
static_assert(WS_VCR == WS_KCR + 8 * MiB && WS_KS == WS_KCR + 16 * MiB && WS_VS == WS_KCR + 24 * MiB && WS_KW == WS_KCR + 32 * MiB && WS_VW == WS_KCR + 40 * MiB, "kv buffers are 8 MiB apart in (pn, bj) order");
static_assert(WS_MK == WS_MQ + 32 * MiB && WS_MV == WS_MQ + 64 * MiB && WS_MO == WS_MQ + 96 * MiB, "mLSTM buffers are 32 MiB apart");

struct MixPtrs { unsigned char* ws; const float *conv_w, *conv_b, *i_bias, *f_bias, *mnorm_g; };
#define MP_QN ((const bf16*)(P.ws + WS_QN))
#define MP_KS ((const bf16*)(P.ws + WS_KS))
#define MP_VS ((const bf16*)(P.ws + WS_VS))
#define MP_KW ((const bf16*)(P.ws + WS_KW))
#define MP_VW ((const bf16*)(P.ws + WS_VW))
#define MP_KC ((const bf16*)(P.ws + WS_CC))
#define MP_VC ((const bf16*)(P.ws + WS_CC) + (size_t)4096 * 64)
#define MP_MQ ((const bf16*)(P.ws + WS_MQ))
#define MP_MK ((const bf16*)(P.ws + WS_MK))
#define MP_MV ((const bf16*)(P.ws + WS_MV))
#define MP_MO ((const bf16*)(P.ws + WS_MO))
#define MP_GATE ((const float*)(P.ws + WS_GATE))
#define MP_Y ((bf16*)(P.ws + WS_U))


typedef float f32x16 __attribute__((ext_vector_type(16)));
typedef short bf16x8v __attribute__((ext_vector_type(8)));
typedef short s16x4v __attribute__((ext_vector_type(4)));
typedef float f32x2v __attribute__((ext_vector_type(2)));
typedef __bf16 bf16x2v __attribute__((ext_vector_type(2)));
#define MFMA32(a, b, c) __builtin_amdgcn_mfma_f32_32x32x16_bf16((a), (b), (c), 0, 0, 0)
__device__ __forceinline__ s16x4v tr_read(const LAS unsigned char* p) { return __builtin_bit_cast(s16x4v, __builtin_amdgcn_ds_read_tr16_b64_v4i16((LAS s16x4v*)p)); }
__device__ __forceinline__ int tile_off(int key, int ch8) { return (ch8 >> 2) * 4096 + key * 64 + (((ch8 & 3) ^ ((key >> 2) & 3)) << 4); }
constexpr int NM_SLOT = 0, NM_IMP = 65536, NM_IMS = 99328, NM_SEL = 108544, NM_ITEM = 108864;
constexpr float QK_SCALE = 0.125f * 1.4426950408889634f;

#define SBAR() __builtin_amdgcn_sched_barrier(0)
__device__ __forceinline__ void xor32_pair(float v, float& lo, float& hi) { float a = v, b = v; asm volatile("s_nop 1\n\tv_permlane32_swap_b32 %0, %1" : "+v"(a), "+v"(b)); lo = a; hi = b; }
__device__ __forceinline__ float xor32_max(float v) { float lo, hi; xor32_pair(v, lo, hi); float r; asm("v_max_f32 %0, %1, %2" : "=v"(r) : "v"(lo), "v"(hi)); return r; }
__device__ __forceinline__ float xor32_sum(float v) { float lo, hi; xor32_pair(v, lo, hi); return lo + hi; }
__device__ __forceinline__ float max2f(float a, float b) { float r; asm("v_max_f32 %0, %1, %2" : "=v"(r) : "v"(a), "v"(b)); return r; }
__device__ __forceinline__ float max3f(float a, float b, float c) { float r; asm("v_max3_f32 %0, %1, %2, %3" : "=v"(r) : "v"(a), "v"(b), "v"(c)); return r; }
#define LBAR() asm volatile("s_waitcnt lgkmcnt(0)\n\ts_barrier" ::: "memory")
__device__ __forceinline__ void k_load(const LAS unsigned char* Ks, int r, int h, bf16x8v (&kf)[8]) {
    const int sw = (r >> 2) & 3;
#pragma unroll
    for (int ks = 0; ks < 4; ++ks) { const int off = (ks >> 1) * 4096 + r * 64 + (((((ks & 1) << 1) + h) ^ sw) << 4);
        kf[2 * ks] = *(const LAS bf16x8v*)(Ks + off); kf[2 * ks + 1] = *(const LAS bf16x8v*)(Ks + off + 2048); }
}
__device__ __forceinline__ void qk_mma(const bf16x8v (&kf)[8], const bf16x8v (&qf)[4], f32x16& p0, f32x16& p1) {
    const f32x16 z = {0.f, 0.f, 0.f, 0.f, 0.f, 0.f, 0.f, 0.f, 0.f, 0.f, 0.f, 0.f, 0.f, 0.f, 0.f, 0.f};
#pragma unroll
    for (int ks = 0; ks < 4; ++ks) { p0 = MFMA32(kf[2 * ks], qf[ks], ks ? p0 : z); p1 = MFMA32(kf[2 * ks + 1], qf[ks], ks ? p1 : z); }
}
__device__ __forceinline__ void v_load(const LAS unsigned char* Vs, int lane, bf16x8v (&vf)[8]) {
    const int h = lane >> 5, i16 = lane & 15, q = i16 >> 2, p = i16 & 3, gi = (lane >> 4) & 1;
    const int cidx = 2 * gi + (p >> 1), e8 = (p & 1) << 3;
    const int offlo = q * 64 + ((cidx ^ h) << 4) + e8 + h * 256, offhi = q * 64 + ((cidx ^ (h | 2)) << 4) + e8 + h * 256 + 512;
#pragma unroll
    for (int kb = 0; kb < 2; ++kb)
#pragma unroll
        for (int s = 0; s < 2; ++s)
#pragma unroll
            for (int db = 0; db < 2; ++db) { const LAS unsigned char* base = Vs + db * 4096 + (kb * 32 + s * 16) * 64;
                const s16x4v lo = tr_read(base + offlo), hi = tr_read(base + offhi);
                vf[(kb * 2 + s) * 2 + db] = __builtin_shufflevector(lo, hi, 0, 1, 2, 3, 4, 5, 6, 7); }
}
__device__ __forceinline__ void pv_mma(const bf16x8v (&vf)[8], const f32x16& p0, const f32x16& p1, f32x16 (&o)[2]) {
#pragma unroll
    for (int kb = 0; kb < 2; ++kb)
#pragma unroll
        for (int s = 0; s < 2; ++s) {
            const f32x16& P = kb ? p1 : p0;
            v4u pw; pw.x = cvtpk(P[8 * s + 0], P[8 * s + 1]); pw.y = cvtpk(P[8 * s + 2], P[8 * s + 3]); pw.z = cvtpk(P[8 * s + 4], P[8 * s + 5]); pw.w = cvtpk(P[8 * s + 6], P[8 * s + 7]);
            const bf16x8v pf = __builtin_bit_cast(bf16x8v, pw);
            o[0] = MFMA32(vf[(kb * 2 + s) * 2], pf, o[0]); o[1] = MFMA32(vf[(kb * 2 + s) * 2 + 1], pf, o[1]);
        }
}

__device__ __forceinline__ void nsa_unit_mfma(LAS unsigned char* L, const MixPtrs& P, int b, int g, int c, int tid_in) {
    int tid_l = tid_in; asm volatile("" : "+v"(tid_l));
    const int tid = tid_l, lane = tid & 63, w = __builtin_amdgcn_readfirstlane(tid >> 6);
    const int r = lane & 31, h = lane >> 5, head = w >> 1, qi = (w & 1) * 32 + r, t = c * 64 + qi;
    const size_t row = (size_t)b * SEQ + t;
    LAS unsigned* SEL = (LAS unsigned*)(L + NM_SEL); LAS int* ITEM = (LAS int*)(L + NM_ITEM);
    const size_t kvbase = (size_t)(b * 2 + g) * SEQ * 64, ccbase = (size_t)(b * 2 + g) * 128 * 64;
    const int skey = tid >> 3, sch = tid & 7, soff = tile_off(skey, sch);
    bf16x8v qf[4];
    { const bf16* qp = MP_QN + row * 512 + (g * 4 + head) * 64 + 8 * h;
#pragma unroll
      for (int ks = 0; ks < 4; ++ks) qf[ks] = *(const bf16x8v*)(qp + 16 * ks); }
    const float* gp = MP_GATE + row * 32 + g * 4 + head;
    float one = 1.f; asm volatile("" : "+v"(one));
    const float gate_c = __builtin_amdgcn_rcpf(one + __expf(-gp[0])), gate_s = __builtin_amdgcn_rcpf(one + __expf(-gp[8])), gate_w = __builtin_amdgcn_rcpf(one + __expf(-gp[16]));
    f32x16 oacc[2];
    {
        const bf16* kc = MP_KC + ccbase; const bf16* vc = MP_VC + ccbase;
        const v4u k0 = *(const v4u*)(kc + tid * 8), k1 = *(const v4u*)(kc + 4096 + tid * 8), v0 = *(const v4u*)(vc + tid * 8), v1 = *(const v4u*)(vc + 4096 + tid * 8);
        LBAR();
        *(LAS v4u*)(L + NM_SLOT + soff) = k0; *(LAS v4u*)(L + NM_SLOT + 8192 + soff) = v0; *(LAS v4u*)(L + NM_SLOT + 16384 + soff) = k1; *(LAS v4u*)(L + NM_SLOT + 24576 + soff) = v1;
        if (tid < 64) SEL[tid] = 0u;
        LBAR();
        f32x16 s0, s1, s2, s3;
        { bf16x8v kfa[8], kfb[8]; k_load(L + NM_SLOT, r, h, kfa); k_load(L + NM_SLOT + 16384, r, h, kfb); SBAR(); qk_mma(kfa, qf, s0, s1); qk_mma(kfb, qf, s2, s3); }
        const int nlim = (t >= 31) ? (((t - 31) >> 4) < 126 ? ((t - 31) >> 4) : 126) : -1;
        float mx, mxv[4] = {-1e20f, -1e20f, -1e20f, -1e20f};
#pragma unroll
        for (int e = 0; e < 16; ++e) { const int cr = (e & 3) + 8 * (e >> 2) + 4 * h;
            s0[e] = (cr <= nlim) ? s0[e] * QK_SCALE : -1e30f; s1[e] = (cr + 32 <= nlim) ? s1[e] * QK_SCALE : -1e30f;
            s2[e] = (cr + 64 <= nlim) ? s2[e] * QK_SCALE : -1e30f; s3[e] = (cr + 96 <= nlim) ? s3[e] * QK_SCALE : -1e30f;
            mxv[e & 3] = fmaxf(fmaxf(mxv[e & 3], fmaxf(s0[e], s1[e])), fmaxf(s2[e], s3[e])); }
        mx = fmaxf(fmaxf(mxv[0], mxv[1]), fmaxf(mxv[2], mxv[3]));
        mx = xor32_max(mx);
        float ls, lsv[4] = {0.f, 0.f, 0.f, 0.f};
#pragma unroll
        for (int e = 0; e < 16; ++e) { s0[e] = __builtin_amdgcn_exp2f(s0[e] - mx); s1[e] = __builtin_amdgcn_exp2f(s1[e] - mx); s2[e] = __builtin_amdgcn_exp2f(s2[e] - mx); s3[e] = __builtin_amdgcn_exp2f(s3[e] - mx);
            lsv[e & 3] += (s0[e] + s1[e]) + (s2[e] + s3[e]); }
        ls = (lsv[0] + lsv[1]) + (lsv[2] + lsv[3]);
        ls = xor32_sum(ls);
        const float il = (ls > 0.f) ? __builtin_amdgcn_rcpf(ls) : 0.f;
#pragma unroll
        for (int e = 0; e < 16; ++e) { s0[e] *= il; s1[e] *= il; s2[e] *= il; s3[e] *= il; }
        { LAS float* IMP = (LAS float*)(L + NM_IMP) + (w * 32 + r) * 33; float plprev = 0.f;
#pragma unroll
          for (int x = 0; x < 16; ++x) {
              const f32x16& S = (x < 4) ? s0 : ((x < 8) ? s1 : ((x < 12) ? s2 : s3)); const int g4 = (x & 3) * 4;
              const float own = (S[g4] + S[g4 + 1]) + (S[g4 + 2] + S[g4 + 3]);
              const float pl = shx(S[g4 + 3], 32, lane);
              if (h == 1) IMP[2 * x + 1] = own + pl; else IMP[2 * x] = own + plprev;
              plprev = pl;
          }
        }
        oacc[0] = (f32x16){0.f, 0.f, 0.f, 0.f, 0.f, 0.f, 0.f, 0.f, 0.f, 0.f, 0.f, 0.f, 0.f, 0.f, 0.f, 0.f}; oacc[1] = oacc[0];
        { bf16x8v vfa[8], vfb[8]; v_load(L + NM_SLOT + 8192, lane, vfa); v_load(L + NM_SLOT + 24576, lane, vfb); SBAR(); pv_mma(vfa, s0, s1, oacc); pv_mma(vfb, s2, s3, oacc); }
#pragma unroll
        for (int e = 0; e < 16; ++e) { oacc[0][e] *= gate_c; oacc[1][e] *= gate_c; }
    }
    LBAR();
    { const int i = tid & 63, jg = tid >> 6; const LAS float* I8 = (const LAS float*)(L + NM_IMP); LAS float* IMS = (LAS float*)(L + NM_IMS);
#pragma unroll
      for (int jj = 0; jj < 4; ++jj) { const int j = 4 * jg + jj; const int wq = (i >> 5), rq = i & 31;
          IMS[i * 36 + j] = (I8[((0 + wq) * 32 + rq) * 33 + j] + I8[((2 + wq) * 32 + rq) * 33 + j]) + (I8[((4 + wq) * 32 + rq) * 33 + j] + I8[((6 + wq) * 32 + rq) * 33 + j]); }
      LBAR();
      unsigned bits = 0u;
      if (c + 1 <= 16) { if (jg == 0) bits = (1u << (c + 1)) - 1u; }
      else { if (jg == 0) bits = 1u | (1u << c) | (1u << (c - 1));
          { float iv[32];
#pragma unroll
            for (int q8 = 0; q8 < 8; ++q8) { const f32x4 x = *(const LAS f32x4*)(IMS + i * 36 + 4 * q8); iv[4 * q8] = x.x; iv[4 * q8 + 1] = x.y; iv[4 * q8 + 2] = x.z; iv[4 * q8 + 3] = x.w; }
#pragma unroll
            for (int jj = 0; jj < 4; ++jj) { const int j = 4 * jg + jj; const float vj = IMS[i * 36 + j]; int rank = 0;
#pragma unroll
                for (int i2 = 1; i2 < 30; ++i2) rank += (i2 <= c - 2 && (iv[i2] > vj || (iv[i2] == vj && i2 < j))) ? 1 : 0;
                if (j >= 1 && j <= c - 2 && rank < 13) bits |= 1u << j; } } }
      if (bits) atomicOr((unsigned*)&SEL[i], bits);
      LBAR();
      if (w == 0) { unsigned so = SEL[lane];
#pragma unroll
          for (int o2 = 32; o2; o2 >>= 1) so |= shxu(so, o2, lane);
          if (lane == 0) { int n = 0; for (int j = 0; j <= c; ++j) if ((so >> j) & 1u) ITEM[n++] = j; const int j0 = (c - 8 > 0) ? c - 8 : 0; for (int j = j0; j <= c; ++j) ITEM[n++] = 64 + j; ITEM[n] = -1; ITEM[47] = n; } }
      LBAR();
    }
    const unsigned mysel = SEL[qi]; const int nitem = ITEM[47];
    f32x16 o[2]; float m = -1e20f, lsum = 0.f; int prev_kind = 0;
    o[0] = (f32x16){0.f, 0.f, 0.f, 0.f, 0.f, 0.f, 0.f, 0.f, 0.f, 0.f, 0.f, 0.f, 0.f, 0.f, 0.f, 0.f}; o[1] = o[0];
    const int npair = (nitem + 1) >> 1;
    v4u rk0, rv0, rk1, rv1;
#define NSA_LOAD_PAIR(ip_) do { const int ia_ = ITEM[2 * (ip_)], ib_ = ITEM[2 * (ip_) + 1]; \
        { const bf16* kp = ((ia_ & 64) ? MP_KW : MP_KS) + kvbase + (size_t)(ia_ & 63) * 4096; const bf16* vp = ((ia_ & 64) ? MP_VW : MP_VS) + kvbase + (size_t)(ia_ & 63) * 4096; rk0 = *(const v4u*)(kp + tid * 8); rv0 = *(const v4u*)(vp + tid * 8); } \
        if (ib_ >= 0) { const bf16* kp = ((ib_ & 64) ? MP_KW : MP_KS) + kvbase + (size_t)(ib_ & 63) * 4096; const bf16* vp = ((ib_ & 64) ? MP_VW : MP_VS) + kvbase + (size_t)(ib_ & 63) * 4096; rk1 = *(const v4u*)(kp + tid * 8); rv1 = *(const v4u*)(vp + tid * 8); } } while (0)
#define NSA_WRITE_PAIR(sb_) do { *(LAS v4u*)(L + (sb_) + soff) = rk0; *(LAS v4u*)(L + (sb_) + 8192 + soff) = rv0; *(LAS v4u*)(L + (sb_) + 16384 + soff) = rk1; *(LAS v4u*)(L + (sb_) + 24576 + soff) = rv1; } while (0)
    rk1 = (v4u){0u, 0u, 0u, 0u}; rv1 = rk1;
    NSA_LOAD_PAIR(0);
    NSA_WRITE_PAIR(NM_SLOT + 32768);
    LBAR();
#pragma unroll 1
    for (int ip = 0; ip < npair; ++ip) {
        if (ip + 1 < npair) NSA_LOAD_PAIR(ip + 1);
        const int sbase = NM_SLOT + ((ip + 1) & 1) * 32768;
#pragma unroll 1
        for (int half = 0; half < 2; ++half) {
            const int item = ITEM[2 * ip + half];
            if (item < 0) break;
            const int kind = item >> 6, j = item & 63;
            if (kind != prev_kind) {
                const float tot = xor32_sum(lsum); const float sc = gate_s * __builtin_amdgcn_rcpf(tot);
#pragma unroll
                for (int e = 0; e < 16; ++e) { oacc[0][e] += o[0][e] * sc; oacc[1][e] += o[1][e] * sc; o[0][e] = 0.f; o[1][e] = 0.f; }
                m = -1e20f; lsum = 0.f; prev_kind = kind;
            }
            int klo, khi;
            if (kind == 0) { klo = 0; khi = ((mysel >> j) & 1u) ? ((j < c) ? 63 : qi) : -1; }
            else { klo = t - 511 - 64 * j; khi = t - 64 * j; if (khi > 63) khi = 63; if (klo < 0) klo = 0; }
            const LAS unsigned char* slot = L + sbase + half * 16384;
            if (__any(khi >= klo)) {
                f32x16 p0, p1; bf16x8v vf[8];
                { bf16x8v kf[8]; k_load(slot, r, h, kf); SBAR(); qk_mma(kf, qf, p0, p1); }
                v_load(slot + 8192, lane, vf); SBAR();
                if (!__all(klo == 0 && khi == 63)) {
                    const int a = klo - 4 * h, z = khi - 4 * h;
#pragma unroll
                    for (int e = 0; e < 16; ++e) { const int cr = (e & 3) + 8 * (e >> 2);
                        p0[e] = (cr >= a && cr <= z) ? p0[e] : -1e30f; p1[e] = (cr + 32 >= a && cr + 32 <= z) ? p1[e] : -1e30f; }
                }
                float tm;
                { float ma = max2f(p0[0], p1[0]), mb = max2f(p0[1], p1[1]), mc2 = max2f(p0[2], p1[2]), md = max2f(p0[3], p1[3]);
#pragma unroll
                  for (int e = 4; e < 16; e += 4) { ma = max3f(ma, p0[e], p1[e]); mb = max3f(mb, p0[e + 1], p1[e + 1]); mc2 = max3f(mc2, p0[e + 2], p1[e + 2]); md = max3f(md, p0[e + 3], p1[e + 3]); }
                  tm = max3f(ma, mb, max2f(mc2, md)); }
                tm = xor32_max(tm);
                const float mn = fmaxf(m, tm * QK_SCALE);
                if (!__all(mn == m)) { const float corr = __builtin_amdgcn_exp2f(m - mn); lsum *= corr;
#pragma unroll
                    for (int e = 0; e < 16; ++e) { o[0][e] *= corr; o[1][e] *= corr; }
                    m = mn; }
                { const f32x2v sc2 = {QK_SCALE, QK_SCALE}, mm2 = {m, m}; f32x2v ta = {0.f, 0.f}, tb = {0.f, 0.f};
#pragma unroll
                  for (int e = 0; e < 16; e += 2) { const f32x2v a0 = (f32x2v){p0[e], p0[e + 1]} * sc2 - mm2, a1 = (f32x2v){p1[e], p1[e + 1]} * sc2 - mm2; p0[e] = a0.x; p0[e + 1] = a0.y; p1[e] = a1.x; p1[e + 1] = a1.y; }
#pragma unroll
                  for (int e = 0; e < 16; ++e) { p0[e] = __builtin_amdgcn_exp2f(p0[e]); p1[e] = __builtin_amdgcn_exp2f(p1[e]); }
#pragma unroll
                  for (int e = 0; e < 16; e += 2) { ta += (f32x2v){p0[e], p0[e + 1]}; tb += (f32x2v){p1[e], p1[e + 1]}; }
                  lsum += (ta.x + ta.y) + (tb.x + tb.y); }
                SBAR(); pv_mma(vf, p0, p1, o);
            }
        }
        if (ip + 1 < npair) NSA_WRITE_PAIR(NM_SLOT + (ip & 1) * 32768);
        LBAR();
    }
#undef NSA_LOAD_PAIR
#undef NSA_WRITE_PAIR
    { const float tot = xor32_sum(lsum); const float sc = gate_w * __builtin_amdgcn_rcpf(tot);
#pragma unroll
      for (int e = 0; e < 16; ++e) { oacc[0][e] += o[0][e] * sc; oacc[1][e] += o[1][e] * sc; } }
    { bf16* yp = MP_Y + row * DM + (g * 4 + head) * 64 + 4 * h;
#pragma unroll
      for (int db = 0; db < 2; ++db)
#pragma unroll
          for (int g4 = 0; g4 < 4; ++g4) { v2u wv; wv.x = cvtpk(oacc[db][4 * g4], oacc[db][4 * g4 + 1]); wv.y = cvtpk(oacc[db][4 * g4 + 2], oacc[db][4 * g4 + 3]); *(v2u*)(yp + db * 32 + g4 * 8) = wv; } }
}

namespace ns3 {
using f32x16 = __attribute__((ext_vector_type(16))) float;
using bf16x8 = __attribute__((ext_vector_type(8))) short;
using s16x4 = __attribute__((ext_vector_type(4))) short;
using u32x4 = __attribute__((ext_vector_type(4))) unsigned;
typedef short v4i16_t __attribute__((ext_vector_type(4)));
typedef LAS const char* lds_cptr;
constexpr int NSLOT = 3, SLOTB = 8192;
constexpr int A_K = 0, A_V = NSLOT * SLOTB, A_WS = 2 * NSLOT * SLOTB, A_OST = A_WS + 8 * 64 * 4, A_END = A_OST + 8 * 8192;
constexpr int A_IMP = A_OST, A_IMS = A_OST + 33792, A_SEL = A_END, A_TTS = A_END + 512, A_TTW = A_TTS + 256;
#define SBAR3() __builtin_amdgcn_sched_barrier(0)
#define WAIT_BAR3(N) asm volatile("s_waitcnt vmcnt(" #N ") lgkmcnt(0)\n\ts_barrier":::"memory")
__device__ __forceinline__ int crow(int r, int hi) { return (r & 3) + 8 * (r >> 2) + 4 * hi; }
__device__ __forceinline__ void glds16(const void* gsrc, unsigned lds_dst) { unsigned keep;
  asm volatile("s_mov_b32 %0, m0\n\ts_mov_b32 m0, %2\n\ts_nop 0\n\tglobal_load_lds_dwordx4 %1, off\n\ts_mov_b32 m0, %0" : "=&s"(keep) : "v"(gsrc), "s"(lds_dst) : "memory"); }
__device__ __forceinline__ float fadd_s(float a, float b) { float r; asm("v_add_f32_e32 %0, %1, %2" : "=v"(r) : "v"(a), "v"(b)); return r; }
__device__ __forceinline__ float fsub_s(float a, float b) { float r; asm("v_sub_f32_e32 %0, %1, %2" : "=v"(r) : "v"(a), "v"(b)); return r; }
__device__ __forceinline__ s16x4 vtr(lds_cptr p) { return __builtin_bit_cast(s16x4, __builtin_amdgcn_ds_read_tr16_b64_v4i16((LAS v4i16_t*)p)); }
__device__ __forceinline__ void qkt(f32x16& p0, f32x16& p1, lds_cptr Kslot, const bf16x8* qr, const f32x16& negm, int r32, int hi) {
  lds_cptr kb = Kslot + hi * 1024 + r32 * 16;
#pragma unroll
  for (int d0 = 0; d0 < 4; ++d0) {
    const bf16x8 b0 = *(const LAS bf16x8*)(kb + d0 * 2048), b1 = *(const LAS bf16x8*)(kb + d0 * 2048 + 512);
    if (d0 == 0) { p0 = __builtin_amdgcn_mfma_f32_32x32x16_bf16(b0, qr[0], negm, 0, 0, 0); p1 = __builtin_amdgcn_mfma_f32_32x32x16_bf16(b1, qr[0], negm, 0, 0, 0); }
    else { p0 = __builtin_amdgcn_mfma_f32_32x32x16_bf16(b0, qr[d0], p0, 0, 0, 0); p1 = __builtin_amdgcn_mfma_f32_32x32x16_bf16(b1, qr[d0], p1, 0, 0, 0); } }
}
__device__ __forceinline__ void kload8(bf16x8* kf, lds_cptr kp) {
  kf[0] = *(const LAS bf16x8*)(kp);        kf[1] = *(const LAS bf16x8*)(kp + 512);
  kf[2] = *(const LAS bf16x8*)(kp + 2048); kf[3] = *(const LAS bf16x8*)(kp + 2560);
  kf[4] = *(const LAS bf16x8*)(kp + 4096); kf[5] = *(const LAS bf16x8*)(kp + 4608);
  kf[6] = *(const LAS bf16x8*)(kp + 6144); kf[7] = *(const LAS bf16x8*)(kp + 6656);
}
__device__ __forceinline__ void kload2(bf16x8* kf, lds_cptr kp, int j) { kf[2 * j] = *(const LAS bf16x8*)(kp + j * 2048); kf[2 * j + 1] = *(const LAS bf16x8*)(kp + j * 2048 + 512); }
__device__ __forceinline__ float rowmax(const f32x16& p0, const f32x16& p1) {
  float a = max3f(p0[0], p0[1], p1[0]), b = max3f(p0[2], p0[3], p1[1]); a = max3f(a, p1[2], p1[3]);
#pragma unroll
  for (int r = 4; r < 16; r += 4) { a = max3f(a, p0[r], p0[r + 1]); b = max3f(b, p0[r + 2], p0[r + 3]); a = max3f(a, p1[r], p1[r + 1]); b = max3f(b, p1[r + 2], p1[r + 3]); }
  return xor32_max(max2f(a, b));
}
__device__ __forceinline__ void pv(f32x16* o, int vb, bf16x8 pa0, bf16x8 pa1, bf16x8 pa2, bf16x8 pa3) {
#pragma unroll
  for (int d0 = 0; d0 < 2; ++d0) { s16x4 lo[4], hi[4];
#pragma unroll
    for (int ks = 0; ks < 4; ++ks) {
      asm volatile("ds_read_b64_tr_b16 %0,%1 offset:%c2" : "=&v"(lo[ks]) : "v"(vb), "i"(d0 * 4096 + ks * 1024) : "memory");
      asm volatile("ds_read_b64_tr_b16 %0,%1 offset:%c2" : "=&v"(hi[ks]) : "v"(vb), "i"(d0 * 4096 + ks * 1024 + 512) : "memory"); }
    asm volatile("s_waitcnt lgkmcnt(0)" ::: "memory"); SBAR3();
#define PK3(k) (bf16x8){lo[k][0], lo[k][1], lo[k][2], lo[k][3], hi[k][0], hi[k][1], hi[k][2], hi[k][3]}
    o[d0] = __builtin_amdgcn_mfma_f32_32x32x16_bf16(pa0, PK3(0), o[d0], 0, 0, 0);
    o[d0] = __builtin_amdgcn_mfma_f32_32x32x16_bf16(pa1, PK3(1), o[d0], 0, 0, 0);
    o[d0] = __builtin_amdgcn_mfma_f32_32x32x16_bf16(pa2, PK3(2), o[d0], 0, 0, 0);
    o[d0] = __builtin_amdgcn_mfma_f32_32x32x16_bf16(pa3, PK3(3), o[d0], 0, 0, 0);
#undef PK3
  }
}
__device__ __forceinline__ void rmask(f32x16& p0, f32x16& p1, int e, unsigned mysel, int qi, int tq, int c, int hi) {
  const int kind = e >> 6, j = e & 63; int klo, khi;
  if (kind == 0) { klo = 0; khi = ((mysel >> j) & 1u) ? ((j < c) ? 63 : qi) : -1; }
  else if (kind == 1) { klo = tq - 511 - 64 * j; khi = tq - 64 * j; if (khi > 63) khi = 63; if (klo < 0) klo = 0; }
  else { klo = 0; khi = -1; }
  if (!__all(klo == 0 && khi == 63)) { const float NEG = -INFINITY; const int a = klo - 4 * hi, z = khi - 4 * hi;
#pragma unroll
    for (int r = 0; r < 16; ++r) { const int cr = (r & 3) + 8 * (r >> 2); if (cr < a || cr > z) p0[r] = NEG; if (cr + 32 < a || cr + 32 > z) p1[r] = NEG; } }
}

template <int THRL>
__device__ __forceinline__ void stream(LAS unsigned char* L, const bf16* Kb, const bf16* Vb, const LAS int* TT, const int NT, const bf16x8 (&qr)[4],
                                       int lane, int wid, unsigned mysel, int qi, int tq, int c, float gate, bool first_write) {
  const int r32 = lane & 31, hi = lane >> 5;
  const unsigned lds0 = (unsigned)(uintptr_t)L;
  LAS float* wsf = (LAS float*)(L + A_WS) + wid * 64;
  const bf16* ksrc = Kb + (long)lane * 64 + wid * 8;
  const bf16* vsrc = Vb + (long)(16 * (wid & 3) + (lane >> 2)) * 64 + (wid >> 2) * 32 + (lane & 3) * 8;
  const unsigned kdst = lds0 + A_K + wid * 1024, vdst = lds0 + A_V + wid * 1024;
#define TJ(x) ((long)(__builtin_amdgcn_readfirstlane(TT[(x)]) & 63) * 4096)
#define DMA_K(t, slot) glds16(ksrc + TJ(t), (unsigned)__builtin_amdgcn_readfirstlane(kdst + (slot)))
#define DMA_V(t, slot) glds16(vsrc + TJ(t), (unsigned)__builtin_amdgcn_readfirstlane(vdst + (slot)))
  const int vb0 = (int)(lds0 + A_V) + ((lane >> 4) & 1) * 32 + (lane & 3) * 8 + (4 * hi + ((lane & 15) >> 2)) * 64;
  bf16x8 kf[8];
  const lds_cptr shm3 = (lds_cptr)L; const lds_cptr kp0 = shm3 + A_K + hi * 1024 + r32 * 16; const lds_cptr vp0 = shm3 + A_V + ((lane >> 4) & 1) * 32 + (lane & 3) * 8 + (4 * hi + ((lane & 15) >> 2)) * 64;
  DMA_K(0, 0); DMA_V(0, 0); DMA_K(1, SLOTB);
  float mhat = 0.f, l_reg = 0.f; f32x16 o[2]; o[0] = f32x16{}; o[1] = f32x16{}; f32x16 negm = f32x16{}; asm volatile("" : "+v"(negm));
#define CMASK(P0, P1, t) rmask(P0, P1, __builtin_amdgcn_readfirstlane(TT[(t)]), mysel, qi, tq, c, hi)
  bool resc = false;
#define START(P0, P1) do { const float rm = rowmax(P0, P1); resc = false; \
    { const float dl = rm; mhat = fadd_s(mhat, dl); \
      _Pragma("unroll") for (int r = 0; r < 16; ++r) { P0[r] = fsub_s(P0[r], dl); P1[r] = fsub_s(P1[r], dl); } \
      _Pragma("unroll") for (int r = 0; r < 16; ++r) negm[r] = -mhat; asm volatile("" : "+v"(negm)); } \
    _Pragma("unroll") for (int r = 0; r < 16; ++r) P0[r] = __builtin_amdgcn_exp2f(P0[r]); } while (0)
#define RESC() do { if (resc) { asm volatile("s_waitcnt lgkmcnt(0)" ::: "memory"); \
      _Pragma("unroll") for (int d_ = 0; d_ < 2; ++d_) _Pragma("unroll") for (int r = 0; r < 16; ++r) o[d_][r] *= wsf[crow(r, hi)]; } } while (0)
  f32x16 pA0, pA1, pB0, pB1;
  int sl_prev = 0, sl_cur = 0, sl_next = SLOTB;
#define ROT() do { sl_prev = sl_cur; sl_cur = sl_next; sl_next = (sl_next == (NSLOT - 1) * SLOTB) ? 0 : sl_next + SLOTB; } while (0)
  DMA_K(2, 2 * SLOTB);
  WAIT_BAR3(3);
  qkt(pA0, pA1, shm3 + A_K, qr, negm, r32, hi); asm volatile("s_nop 15\n\ts_nop 7" : "+v"(pA0), "+v"(pA1)); CMASK(pA0, pA1, 0);
  START(pA0, pA1);
  _Pragma("unroll") for (int r = 0; r < 16; ++r) pA1[r] = __builtin_amdgcn_exp2f(pA1[r]);
  WAIT_BAR3(0);
  DMA_K(3, 0); DMA_V(1, SLOTB);
  ROT();
  kload8(kf, kp0 + sl_cur);
  WAIT_BAR3(2);
  s16x4 vlo[8], vhi[8]; u32x4 pw0, pw1, pw2, pw3;
#define PKW(P, B) cvtpk(P[B], P[B + 1])
#define PAF(k) __builtin_bit_cast(bf16x8, pw##k)
#define VFR(i) (bf16x8){vlo[i][0], vlo[i][1], vlo[i][2], vlo[i][3], vhi[i][0], vhi[i][1], vhi[i][2], vhi[i][3]}
#define PIN(x) asm volatile("" : "+v"(x))
#define MX3(a, b, c) __builtin_fmaxf(__builtin_fmaxf((a), (b)), (c))
#define GAPA(MF, A0, A1, A2, A3, W0, W1, PW) do { MF; sacc += A0; sacc += A1; sacc += A2; sacc += A3; PIN(sacc); W0; W1; PIN(PW); SBAR3(); } while (0)
#define EX(v) __builtin_amdgcn_exp2f(v)
#define GAPB(MF, X, B) do { MF; X[B] = EX(X[B]); X[B + 1] = EX(X[B + 1]); X[B + 2] = EX(X[B + 2]); X[B + 3] = EX(X[B + 3]); PIN(X); SBAR3(); } while (0)
#define VRD(i) do { vlo[i] = vtr(vp_ + (((i) >> 2) * 4096 + ((i) & 3) * 1024)); vhi[i] = vtr(vp_ + (((i) >> 2) * 4096 + ((i) & 3) * 1024 + 512)); } while (0)
#define KRD(G, j) do { if (G) { kload2(kf, kp0 + sl_next, j); SBAR3(); } } while (0)
#define STEP(C0, C1, P0, P1, t, GK, GV, GL) do { SBAR3(); \
    const lds_cptr vp_ = vp0 + sl_prev; \
    VRD(0); SBAR3(); float sacc = (P0[0] + P0[1]); \
    GAPA(C0 = __builtin_amdgcn_mfma_f32_32x32x16_bf16(kf[0], qr[0], negm, 0, 0, 0), P0[2], P0[3], P0[4], P0[5],     pw0[0] = PKW(P0, 0), pw0[1] = PKW(P0, 2), pw0); \
    VRD(4); SBAR3(); GAPA(C1 = __builtin_amdgcn_mfma_f32_32x32x16_bf16(kf[1], qr[0], negm, 0, 0, 0), P0[6], P0[7], P0[8], P0[9],     pw0[2] = PKW(P0, 4), pw0[3] = PKW(P0, 6), pw0); \
    VRD(1); SBAR3(); GAPA(C0 = __builtin_amdgcn_mfma_f32_32x32x16_bf16(kf[2], qr[1], C0, 0, 0, 0),   P0[10], P0[11], P0[12], P0[13], pw1[0] = PKW(P0, 8), pw1[1] = PKW(P0, 10), pw1); \
    VRD(5); SBAR3(); GAPA(C1 = __builtin_amdgcn_mfma_f32_32x32x16_bf16(kf[3], qr[1], C1, 0, 0, 0),   P0[14], P0[15], P1[0], P1[1],   pw1[2] = PKW(P0, 12), pw1[3] = PKW(P0, 14), pw1); \
    VRD(2); SBAR3(); GAPA(C0 = __builtin_amdgcn_mfma_f32_32x32x16_bf16(kf[4], qr[2], C0, 0, 0, 0),   P1[2], P1[3], P1[4], P1[5],     pw2[0] = PKW(P1, 0), pw2[1] = PKW(P1, 2), pw2); \
    VRD(6); SBAR3(); GAPA(C1 = __builtin_amdgcn_mfma_f32_32x32x16_bf16(kf[5], qr[2], C1, 0, 0, 0),   P1[6], P1[7], P1[8], P1[9],     pw2[2] = PKW(P1, 4), pw2[3] = PKW(P1, 6), pw2); \
    VRD(3); SBAR3(); GAPA(C0 = __builtin_amdgcn_mfma_f32_32x32x16_bf16(kf[6], qr[3], C0, 0, 0, 0),   P1[10], P1[11], P1[12], P1[13], pw3[0] = PKW(P1, 8), pw3[1] = PKW(P1, 10), pw3); \
    VRD(7); SBAR3(); GAPA(C1 = __builtin_amdgcn_mfma_f32_32x32x16_bf16(kf[7], qr[3], C1, 0, 0, 0),   P1[14], P1[15], 0.f, 0.f,       pw3[2] = PKW(P1, 12), pw3[3] = PKW(P1, 14), pw3); \
    l_reg += sacc; \
    if (GK) { DMA_K((t) + 3, sl_cur); } if (GV) { DMA_V((t) + 1, sl_next); } \
    CMASK(C0, C1, t); \
    { float a = MX3(C0[0], C0[1], C1[0]), b = MX3(C0[2], C0[3], C1[1]); a = MX3(a, C1[2], C1[3]); \
      _Pragma("unroll") for (int r = 4; r < 16; r += 4) { a = MX3(a, C0[r], C0[r + 1]); b = MX3(b, C0[r + 2], C0[r + 3]); a = MX3(a, C1[r], C1[r + 1]); b = MX3(b, C1[r + 2], C1[r + 3]); } \
      float rm = xor32_max(__builtin_fmaxf(a, b)); \
      resc = false; \
      if (__builtin_expect(__any(rm > (float)THRL), 0)) { const float dl = __builtin_fmaxf(rm, 0.f); mhat += dl; \
        _Pragma("unroll") for (int r = 0; r < 16; ++r) { C0[r] -= dl; C1[r] -= dl; } \
        _Pragma("unroll") for (int r = 0; r < 16; ++r) negm[r] = -mhat; asm volatile("" : "+v"(negm)); \
        const float f = __builtin_amdgcn_exp2f(-dl); l_reg *= f; if (hi == 0) wsf[r32] = f; resc = true; } } \
    SBAR3(); \
    GAPB(o[0] = __builtin_amdgcn_mfma_f32_32x32x16_bf16(PAF(0), VFR(0), o[0], 0, 0, 0), C0, 0); \
    GAPB(o[1] = __builtin_amdgcn_mfma_f32_32x32x16_bf16(PAF(0), VFR(4), o[1], 0, 0, 0), C0, 4); \
    KRD(GL, 0); GAPB(o[0] = __builtin_amdgcn_mfma_f32_32x32x16_bf16(PAF(1), VFR(1), o[0], 0, 0, 0), C0, 8); \
    KRD(GL, 1); GAPB(o[1] = __builtin_amdgcn_mfma_f32_32x32x16_bf16(PAF(1), VFR(5), o[1], 0, 0, 0), C0, 12); \
    KRD(GL, 2); GAPB(o[0] = __builtin_amdgcn_mfma_f32_32x32x16_bf16(PAF(2), VFR(2), o[0], 0, 0, 0), C1, 0); \
    KRD(GL, 3); GAPB(o[1] = __builtin_amdgcn_mfma_f32_32x32x16_bf16(PAF(2), VFR(6), o[1], 0, 0, 0), C1, 4); \
    GAPB(o[0] = __builtin_amdgcn_mfma_f32_32x32x16_bf16(PAF(3), VFR(3), o[0], 0, 0, 0), C1, 8); \
    GAPB(o[1] = __builtin_amdgcn_mfma_f32_32x32x16_bf16(PAF(3), VFR(7), o[1], 0, 0, 0), C1, 12); \
    } while (0)
#define ENDW(tt) do { if ((tt) + 3 < NT) { WAIT_BAR3(2); } else if ((tt) + 2 < NT) { WAIT_BAR3(1); } else { WAIT_BAR3(0); } } while (0)
  int t = 1;
#pragma unroll 1
  for (; t + 1 < NT; t += 2) {
    STEP(pB0, pB1, pA0, pA1, t, (t + 3 < NT), (t + 1 < NT), (t + 1 < NT));       ENDW(t);     RESC(); ROT();
    STEP(pA0, pA1, pB0, pB1, t + 1, (t + 4 < NT), (t + 2 < NT), (t + 2 < NT));   ENDW(t + 1); RESC(); ROT();
  }
  STEP(pB0, pB1, pA0, pA1, NT - 1, false, false, false); RESC();
  { float sacc = pB0[0] + pB0[1]; _Pragma("unroll") for (int r = 2; r < 16; ++r) sacc += pB0[r]; _Pragma("unroll") for (int r = 0; r < 16; ++r) sacc += pB1[r]; l_reg += sacc;
    pw0 = (u32x4){PKW(pB0, 0), PKW(pB0, 2), PKW(pB0, 4), PKW(pB0, 6)}; pw1 = (u32x4){PKW(pB0, 8), PKW(pB0, 10), PKW(pB0, 12), PKW(pB0, 14)}; pw2 = (u32x4){PKW(pB1, 0), PKW(pB1, 2), PKW(pB1, 4), PKW(pB1, 6)}; pw3 = (u32x4){PKW(pB1, 8), PKW(pB1, 10), PKW(pB1, 12), PKW(pB1, 14)};
    SBAR3(); pv(o, vb0 + sl_cur, PAF(0), PAF(1), PAF(2), PAF(3)); }
#undef PKW
#undef PAF
#undef VFR
#undef PIN
#undef MX3
#undef GAPA
#undef GAPB
#undef EX
#undef VRD
#undef KRD
#undef STEP
#undef ENDW
  l_reg = xor32_sum(l_reg);
  if (hi == 0) wsf[32 + r32] = gate * __builtin_amdgcn_rcpf(l_reg);
  asm volatile("s_waitcnt lgkmcnt(0)" ::: "memory");
  { LAS float* stg = (LAS float*)(L + A_OST) + wid * 2048;
#pragma unroll
    for (int r = 0; r < 16; ++r) { const int orow = crow(r, hi); const float fl = wsf[32 + orow];
#pragma unroll
      for (int d0 = 0; d0 < 2; ++d0) { LAS float* p = stg + orow * 64 + d0 * 32 + r32; const float v = o[d0][r] * fl; *p = first_write ? v : (*p + v); } } }
  asm volatile("s_waitcnt lgkmcnt(0)\n\ts_barrier" ::: "memory");
#undef TJ
#undef DMA_K
#undef DMA_V
#undef CMASK
#undef START
#undef RESC
#undef ROT
}
}

__device__ __forceinline__ void nsa_unit_v3(LAS unsigned char* L, const MixPtrs& P, int b, int g, int c, int tid_in) {
    int tid_l = tid_in; asm volatile("" : "+v"(tid_l));
    const int tid = tid_l, lane = tid & 63, w = __builtin_amdgcn_readfirstlane(tid >> 6);
    const int r = lane & 31, h = lane >> 5, head = w >> 1, qi = (w & 1) * 32 + r, t = c * 64 + qi;
    const size_t row = (size_t)b * SEQ + t;
    LAS unsigned* SEL = (LAS unsigned*)(L + ns3::A_SEL); LAS int* TTS = (LAS int*)(L + ns3::A_TTS); LAS int* TTW = (LAS int*)(L + ns3::A_TTW);
    const size_t kvbase = (size_t)(b * 2 + g) * SEQ * 64, ccbase = (size_t)(b * 2 + g) * 128 * 64;
    const int skey = tid >> 3, sch = tid & 7, soff = tile_off(skey, sch);
    bf16x8v qf[4];
    { const bf16* qp = MP_QN + row * 512 + (g * 4 + head) * 64 + 8 * h;
#pragma unroll
      for (int ks = 0; ks < 4; ++ks) qf[ks] = *(const bf16x8v*)(qp + 16 * ks); }
    const float* gp = MP_GATE + row * 32 + g * 4 + head;
    float one = 1.f; asm volatile("" : "+v"(one));
    const float gate_c = __builtin_amdgcn_rcpf(one + __expf(-gp[0])), gate_s = __builtin_amdgcn_rcpf(one + __expf(-gp[8])), gate_w = __builtin_amdgcn_rcpf(one + __expf(-gp[16]));
    f32x16 oacc[2];
    {
        const bf16* kc = MP_KC + ccbase; const bf16* vc = MP_VC + ccbase;
        const v4u k0 = *(const v4u*)(kc + tid * 8), k1 = *(const v4u*)(kc + 4096 + tid * 8), v0 = *(const v4u*)(vc + tid * 8), v1 = *(const v4u*)(vc + 4096 + tid * 8);
        LBAR();
        *(LAS v4u*)(L + soff) = k0; *(LAS v4u*)(L + 8192 + soff) = v0; *(LAS v4u*)(L + 16384 + soff) = k1; *(LAS v4u*)(L + 24576 + soff) = v1;
        if (tid < 64) SEL[tid] = 0u;
        LBAR();
        f32x16 s0, s1, s2, s3;
        { bf16x8v kfa[8], kfb[8]; k_load(L, r, h, kfa); k_load(L + 16384, r, h, kfb); SBAR(); qk_mma(kfa, qf, s0, s1); qk_mma(kfb, qf, s2, s3); }
        const int nlim = (t >= 31) ? (((t - 31) >> 4) < 126 ? ((t - 31) >> 4) : 126) : -1;
        float mx, mxv[4] = {-1e20f, -1e20f, -1e20f, -1e20f};
#pragma unroll
        for (int e = 0; e < 16; ++e) { const int cr = (e & 3) + 8 * (e >> 2) + 4 * h;
            s0[e] = (cr <= nlim) ? s0[e] : -1e30f; s1[e] = (cr + 32 <= nlim) ? s1[e] : -1e30f;
            s2[e] = (cr + 64 <= nlim) ? s2[e] : -1e30f; s3[e] = (cr + 96 <= nlim) ? s3[e] : -1e30f;
            mxv[e & 3] = fmaxf(fmaxf(mxv[e & 3], fmaxf(s0[e], s1[e])), fmaxf(s2[e], s3[e])); }
        mx = fmaxf(fmaxf(mxv[0], mxv[1]), fmaxf(mxv[2], mxv[3]));
        mx = xor32_max(mx);
        float ls, lsv[4] = {0.f, 0.f, 0.f, 0.f};
#pragma unroll
        for (int e = 0; e < 16; ++e) { s0[e] = __builtin_amdgcn_exp2f(s0[e] - mx); s1[e] = __builtin_amdgcn_exp2f(s1[e] - mx); s2[e] = __builtin_amdgcn_exp2f(s2[e] - mx); s3[e] = __builtin_amdgcn_exp2f(s3[e] - mx);
            lsv[e & 3] += (s0[e] + s1[e]) + (s2[e] + s3[e]); }
        ls = (lsv[0] + lsv[1]) + (lsv[2] + lsv[3]);
        ls = xor32_sum(ls);
        const float il = (ls > 0.f) ? __builtin_amdgcn_rcpf(ls) : 0.f;
#pragma unroll
        for (int e = 0; e < 16; ++e) { s0[e] *= il; s1[e] *= il; s2[e] *= il; s3[e] *= il; }
        { LAS float* IMP = (LAS float*)(L + ns3::A_IMP) + (w * 32 + r) * 33; float plprev = 0.f;
#pragma unroll
          for (int x = 0; x < 16; ++x) {
              const f32x16& S = (x < 4) ? s0 : ((x < 8) ? s1 : ((x < 12) ? s2 : s3)); const int g4 = (x & 3) * 4;
              const float own = (S[g4] + S[g4 + 1]) + (S[g4 + 2] + S[g4 + 3]);
              const float pl = shx(S[g4 + 3], 32, lane);
              if (h == 1) IMP[2 * x + 1] = own + pl; else IMP[2 * x] = own + plprev;
              plprev = pl;
          }
        }
        oacc[0] = (f32x16){0.f, 0.f, 0.f, 0.f, 0.f, 0.f, 0.f, 0.f, 0.f, 0.f, 0.f, 0.f, 0.f, 0.f, 0.f, 0.f}; oacc[1] = oacc[0];
        { bf16x8v vfa[8], vfb[8]; v_load(L + 8192, lane, vfa); v_load(L + 24576, lane, vfb); SBAR(); pv_mma(vfa, s0, s1, oacc); pv_mma(vfb, s2, s3, oacc); }
    }
    LBAR();
    { const int i = tid & 63, jg = tid >> 6; const LAS float* I8 = (const LAS float*)(L + ns3::A_IMP); LAS float* IMS = (LAS float*)(L + ns3::A_IMS);
#pragma unroll
      for (int jj = 0; jj < 4; ++jj) { const int j = 4 * jg + jj; const int wq = (i >> 5), rq = i & 31;
          IMS[i * 36 + j] = (I8[((0 + wq) * 32 + rq) * 33 + j] + I8[((2 + wq) * 32 + rq) * 33 + j]) + (I8[((4 + wq) * 32 + rq) * 33 + j] + I8[((6 + wq) * 32 + rq) * 33 + j]); }
      LBAR();
      unsigned bits = 0u;
      if (c + 1 <= 16) { if (jg == 0) bits = (1u << (c + 1)) - 1u; }
      else { if (jg == 0) bits = 1u | (1u << c) | (1u << (c - 1));
          { float iv[32];
#pragma unroll
            for (int q8 = 0; q8 < 8; ++q8) { const f32x4 x = *(const LAS f32x4*)(IMS + i * 36 + 4 * q8); iv[4 * q8] = x.x; iv[4 * q8 + 1] = x.y; iv[4 * q8 + 2] = x.z; iv[4 * q8 + 3] = x.w; }
#pragma unroll
            for (int jj = 0; jj < 4; ++jj) { const int j = 4 * jg + jj; const float vj = IMS[i * 36 + j]; int rank = 0;
#pragma unroll
                for (int i2 = 1; i2 < 30; ++i2) rank += (i2 <= c - 2 && (iv[i2] > vj || (iv[i2] == vj && i2 < j))) ? 1 : 0;
                if (j >= 1 && j <= c - 2 && rank < 13) bits |= 1u << j; } } }
      if (bits) atomicOr((unsigned*)&SEL[i], bits);
      LBAR();
      if (w == 0) { unsigned so = SEL[lane];
#pragma unroll
          for (int o2 = 32; o2; o2 >>= 1) so |= shxu(so, o2, lane);
          if (lane == 0) { int n = 0; for (int j = 0; j <= c; ++j) if ((so >> j) & 1u) TTS[n++] = j; while (n < 4 || (n & 1)) TTS[n++] = 128; TTS[46] = n; TTS[n] = 128; TTS[n + 1] = 128;
              int m2 = 0; TTW[m2++] = 64 + c; const int j0 = (c - 8 > 0) ? c - 8 : 0; for (int j = j0; j < c; ++j) TTW[m2++] = 64 + j; while (m2 < 4 || (m2 & 1)) TTW[m2++] = 128; TTW[14] = m2; } }
      LBAR();
    }
    const unsigned mysel = SEL[qi]; const int nts = TTS[46], ntw = TTW[14];
    { LAS float* stg = (LAS float*)(L + ns3::A_OST) + w * 2048 + r * 64 + 4 * h;
#pragma unroll
      for (int db = 0; db < 2; ++db)
#pragma unroll
          for (int g4 = 0; g4 < 4; ++g4) *(LAS f32x4*)(stg + db * 32 + g4 * 8) = (f32x4){oacc[db][4 * g4] * gate_c, oacc[db][4 * g4 + 1] * gate_c, oacc[db][4 * g4 + 2] * gate_c, oacc[db][4 * g4 + 3] * gate_c}; }
    LBAR();
    ns3::stream<8>(L, MP_KS + kvbase, MP_VS + kvbase, TTS, nts, qf, lane, w, mysel, qi, t, c, gate_s, false);
    ns3::stream<8>(L, MP_KW + kvbase, MP_VW + kvbase, TTW, ntw, qf, lane, w, mysel, qi, t, c, gate_w, false);
    { const LAS float* stg = (const LAS float*)(L + ns3::A_OST) + w * 2048; bf16* yb = MP_Y + ((size_t)b * SEQ + c * 64 + (w & 1) * 32) * DM + (g * 4 + head) * 64;
#pragma unroll
      for (int i4 = 0; i4 < 4; ++i4) { const int rr = i4 * 8 + (lane >> 3), ch = lane & 7; const f32x4 a = *(const LAS f32x4*)(stg + rr * 64 + ch * 8), bq = *(const LAS f32x4*)(stg + rr * 64 + ch * 8 + 4);
          v4u wv; wv.x = cvtpk(a.x, a.y); wv.y = cvtpk(a.z, a.w); wv.z = cvtpk(bq.x, bq.y); wv.w = cvtpk(bq.z, bq.w);
          *(v4u*)(yb + (size_t)rr * DM + ch * 8) = wv; } }
}

#define MFMA16(a, b, c) __builtin_amdgcn_mfma_f32_16x16x32_bf16((a), (b), (c), 0, 0, 0)
constexpr size_t WS_QC = 422 * MiB, WS_KC2 = 454 * MiB, WS_END2 = 486 * MiB; static_assert(WS_END2 <= WS_PART, "row-partial buffers follow");
#define MP_QC ((const bf16*)(P.ws + WS_QC))
#define MP_KC2 ((const bf16*)(P.ws + WS_KC2))
__device__ __forceinline__ int img_off(int row, int ch) { return 256 * row + 16 * (ch ^ (((row & 3) << 2) | ((row >> 2) & 3))); }
constexpr int M2_IMG = 0, M2_SC = 98304, M2_DEN = 106496, M2_QN = 107520, M2_N = 107776, M2_SSQ = 108288;

__device__ __forceinline__ void mlstm_conv_pass(unsigned char* ws, const float* conv_w, const float* conv_b, int gthread, int nthreads) {
    for (int idx = gthread; idx < BATCH * 128 * 128; idx += nthreads) {
        const int cc = idx & 127, tg = (idx >> 7) & 127, b = idx >> 14;
        const int isk = cc >> 6, ch0 = (cc & 63) * 8;
        const bf16* src = (const bf16*)(ws + (isk ? WS_MK : WS_MQ)) + (size_t)b * SEQ * 512 + ch0;
        bf16* dst = (bf16*)(ws + (isk ? WS_KC2 : WS_QC)) + ((size_t)(b * 4 + (ch0 >> 7)) * SEQ) * 128 + (ch0 & 127);
        float wt[4][8], bs[8];
#pragma unroll
        for (int j = 0; j < 4; ++j) { const f32x4 a = *(const f32x4*)(conv_w + j * 1024 + isk * 512 + ch0), c2 = *(const f32x4*)(conv_w + j * 1024 + isk * 512 + ch0 + 4);
            wt[j][0] = a.x; wt[j][1] = a.y; wt[j][2] = a.z; wt[j][3] = a.w; wt[j][4] = c2.x; wt[j][5] = c2.y; wt[j][6] = c2.z; wt[j][7] = c2.w; }
        { const f32x4 a = *(const f32x4*)(conv_b + isk * 512 + ch0), c2 = *(const f32x4*)(conv_b + isk * 512 + ch0 + 4); bs[0] = a.x; bs[1] = a.y; bs[2] = a.z; bs[3] = a.w; bs[4] = c2.x; bs[5] = c2.y; bs[6] = c2.z; bs[7] = c2.w; }
        const float osc = isk ? 0.08838834764831845f : 1.f;
        const int t0 = tg * 16;
        float x0[8], x1[8], x2[8];
#pragma unroll
        for (int e = 0; e < 8; ++e) { x0[e] = 0.f; x1[e] = 0.f; x2[e] = 0.f; }
        if (t0 > 0) {
            const v4u a = *(const v4u*)(src + (size_t)(t0 - 3) * 512), c2 = *(const v4u*)(src + (size_t)(t0 - 2) * 512), d2 = *(const v4u*)(src + (size_t)(t0 - 1) * 512);
            x0[0] = bflo(a.x); x0[1] = bfhi(a.x); x0[2] = bflo(a.y); x0[3] = bfhi(a.y); x0[4] = bflo(a.z); x0[5] = bfhi(a.z); x0[6] = bflo(a.w); x0[7] = bfhi(a.w);
            x1[0] = bflo(c2.x); x1[1] = bfhi(c2.x); x1[2] = bflo(c2.y); x1[3] = bfhi(c2.y); x1[4] = bflo(c2.z); x1[5] = bfhi(c2.z); x1[6] = bflo(c2.w); x1[7] = bfhi(c2.w);
            x2[0] = bflo(d2.x); x2[1] = bfhi(d2.x); x2[2] = bflo(d2.y); x2[3] = bfhi(d2.y); x2[4] = bflo(d2.z); x2[5] = bfhi(d2.z); x2[6] = bflo(d2.w); x2[7] = bfhi(d2.w);
        }
        v4u rows[16];
#pragma unroll
        for (int s = 0; s < 16; ++s) rows[s] = *(const v4u*)(src + (size_t)(t0 + s) * 512);
#pragma unroll
        for (int s = 0; s < 16; ++s) {
            const v4u a = rows[s];
            const float x3[8] = {bflo(a.x), bfhi(a.x), bflo(a.y), bfhi(a.y), bflo(a.z), bfhi(a.z), bflo(a.w), bfhi(a.w)};
            float o[8];
#pragma unroll
            for (int e = 0; e < 8; ++e) { float v = bs[e] + wt[0][e] * x0[e] + wt[1][e] * x1[e] + wt[2][e] * x2[e] + wt[3][e] * x3[e]; v = v * __builtin_amdgcn_rcpf(1.f + __expf(-v)); o[e] = v * osc; x0[e] = x1[e]; x1[e] = x2[e]; x2[e] = x3[e]; }
            v4u wv; wv.x = pk2(o[0], o[1]); wv.y = pk2(o[2], o[3]); wv.z = pk2(o[4], o[5]); wv.w = pk2(o[6], o[7]);
            *(v4u*)(dst + (size_t)(t0 + s) * 128) = wv;
        }
    }
}

constexpr int M2_A = 112384, M2_PM = 120576, M2_F = 128768, M2_BL = 136960, M2_AMX = 137088, M2_MC = 137216;
__device__ __forceinline__ void mlstm_unit_mfma(LAS unsigned char* L, const MixPtrs& P, int b, int hh, int tid_in) {
    int tid_l = tid_in; asm volatile("" : "+v"(tid_l));
    const int tid = tid_l, lane = tid & 63, w = __builtin_amdgcn_readfirstlane(tid >> 6), l15 = lane & 15, kg = lane >> 4;
    const size_t rb = (size_t)b * SEQ;
    const bf16* QCp = MP_QC + ((size_t)(b * 4 + hh) * SEQ) * 128; const bf16* KCp = MP_KC2 + ((size_t)(b * 4 + hh) * SEQ) * 128;
    const bf16* Vp = MP_MV + rb * 512 + hh * 128; const bf16* Op = MP_MO + rb * 512 + hh * 128 + 16 * w + 4 * kg;
    bf16* Yp = MP_Y + rb * DM + 512 + hh * 128 + 16 * w + 4 * kg;
    LAS float* DEN = (LAS float*)(L + M2_DEN); LAS float* QN = (LAS float*)(L + M2_QN); LAS float* NV = (LAS float*)(L + M2_N); LAS float* SSQ = (LAS float*)(L + M2_SSQ);
    LAS float* SA = (LAS float*)(L + M2_A); LAS float* SPM = (LAS float*)(L + M2_PM); LAS float* SF = (LAS float*)(L + M2_F);
    LAS float* SBL = (LAS float*)(L + M2_BL); LAS float* SAMX = (LAS float*)(L + M2_AMX); LAS float* SMC = (LAS float*)(L + M2_MC);
    float zf = 0.f; asm volatile("" : "+v"(zf));
    f32x4 Cacc[8], nacc = {zf, zf, zf, zf};
#pragma unroll
    for (int i = 0; i < 8; ++i) Cacc[i] = (f32x4){zf, zf, zf, zf};
    const f32x4 gn = *(const f32x4*)(P.mnorm_g + hh * 128 + 16 * w + 4 * kg);
    const int r0s = tid >> 4, c0s = tid & 15, so0 = img_off(r0s, c0s), so1 = img_off(r0s + 32, c0s);
    v4u sq0, sq1, sk0, sk1, sv0, sv1;
    sq0 = *(const v4u*)(QCp + (size_t)r0s * 128 + c0s * 8); sq1 = *(const v4u*)(QCp + (size_t)(r0s + 32) * 128 + c0s * 8);
    sk0 = *(const v4u*)(KCp + (size_t)r0s * 128 + c0s * 8); sk1 = *(const v4u*)(KCp + (size_t)(r0s + 32) * 128 + c0s * 8);
    sv0 = *(const v4u*)(Vp + (size_t)r0s * 512 + c0s * 8);  sv1 = *(const v4u*)(Vp + (size_t)(r0s + 32) * 512 + c0s * 8);
    LBAR();
    { const float ib = P.i_bias[hh], fb = P.f_bias[hh]; const float* Gp = MP_GATE + rb * 32 + hh;
#pragma unroll 1
      for (int cc = w; cc < 32; cc += 8) { const int tk = 64 * cc + lane;
          const float il = Gp[(size_t)tk * 32 + 24] + ib, fx = Gp[(size_t)tk * 32 + 28] + fb; const float fl = fminf(fx, 0.f) - log1pf(__expf(-fabsf(fx)));
          float f = fl;
#pragma unroll
          for (int o = 1; o < 64; o <<= 1) { const float v = shi(f, lane - o); if (lane >= o) f += v; }
          const float a = il - f; float pm = a;
#pragma unroll
          for (int o = 1; o < 64; o <<= 1) { const float v = shi(pm, lane - o); if (lane >= o) pm = fmaxf(pm, v); }
          SA[tk] = a; SPM[tk] = pm; SF[tk] = f; if (lane == 63) { SBL[cc] = f; SAMX[cc] = pm; } } }
    *(LAS v4u*)(L + M2_IMG + so0) = sq0; *(LAS v4u*)(L + M2_IMG + so1) = sq1; *(LAS v4u*)(L + M2_IMG + 16384 + so0) = sk0; *(LAS v4u*)(L + M2_IMG + 16384 + so1) = sk1;
    *(LAS v4u*)(L + M2_IMG + 32768 + so0) = sv0; *(LAS v4u*)(L + M2_IMG + 32768 + so1) = sv1;
    if (tid < 128) NV[tid] = zf;
    LBAR();
    if (tid == 0) { float mcar = zf; for (int cc = 0; cc < 32; ++cc) { SMC[cc] = mcar; mcar = SBL[cc] + fmaxf(mcar, SAMX[cc]); } }
    LBAR();
#pragma unroll 1
    for (int c = 0; c < 32; ++c) {
        int lc = lane; asm volatile("" : "+v"(lc));
        const int l15 = lc & 15, kg = lc >> 4, q4 = l15 >> 2, p4 = l15 & 3;
        const int t0 = c * 64; const LAS unsigned char* Qi = L + M2_IMG + (c & 1) * 49152; const LAS unsigned char* Ki = Qi + 16384; const LAS unsigned char* Vi = Qi + 32768;
        if (c + 1 < 32) { const int tn = t0 + 64;
            sq0 = *(const v4u*)(QCp + (size_t)(tn + r0s) * 128 + c0s * 8); sq1 = *(const v4u*)(QCp + (size_t)(tn + r0s + 32) * 128 + c0s * 8);
            sk0 = *(const v4u*)(KCp + (size_t)(tn + r0s) * 128 + c0s * 8); sk1 = *(const v4u*)(KCp + (size_t)(tn + r0s + 32) * 128 + c0s * 8);
            sv0 = *(const v4u*)(Vp + (size_t)(tn + r0s) * 512 + c0s * 8);  sv1 = *(const v4u*)(Vp + (size_t)(tn + r0s + 32) * 512 + c0s * 8); }
        const float mc = SMC[c], mxa = fmaxf(mc, SAMX[c]); const float cs = __expf(mc - mxa);
        { const int tblk = w >> 1, t = 16 * tblk + l15; const int sb0 = 2 * (w & 1);
          bf16x8v ka[2][4], qb[4];
#pragma unroll
          for (int ks = 0; ks < 4; ++ks) { qb[ks] = *(const LAS bf16x8v*)(Qi + img_off(t, 4 * ks + kg)); ka[0][ks] = *(const LAS bf16x8v*)(Ki + img_off(16 * sb0 + l15, 4 * ks + kg)); ka[1][ks] = *(const LAS bf16x8v*)(Ki + img_off(16 * sb0 + 16 + l15, 4 * ks + kg)); }
          const float Mt = fmaxf(SPM[t0 + t], mc);
          const f32x4 as0 = *(const LAS f32x4*)(SA + t0 + 16 * sb0 + 4 * kg), as1 = *(const LAS f32x4*)(SA + t0 + 16 * sb0 + 16 + 4 * kg);
          const int tq = tid >> 3, dp = tid & 7; const v4u q0 = *(const LAS v4u*)(Qi + img_off(tq, 2 * dp)), q1 = *(const LAS v4u*)(Qi + img_off(tq, 2 * dp + 1));
          const LAS f32x4* np = (const LAS f32x4*)(NV + 16 * dp); const f32x4 n0 = np[0], n1 = np[1], n2 = np[2], n3 = np[3];
          SBAR();
          LAS unsigned char* SC = L + M2_SC;
#pragma unroll
          for (int sb = 0; sb < 2; ++sb) { const int sblk = sb0 + sb; f32x4 acc = {0.f, 0.f, 0.f, 0.f}; float rp = 0.f; v2u wv; wv.x = 0u; wv.y = 0u;
              if (sblk <= tblk) {
#pragma unroll
                  for (int ks = 0; ks < 4; ++ks) acc = MFMA16(ka[sb][ks], qb[ks], acc);
                  const f32x4 as = sb ? as1 : as0; float v[4];
#pragma unroll
                  for (int e = 0; e < 4; ++e) { const float x = acc[e] * __expf(as[e] - Mt); v[e] = (sblk == tblk && 4 * kg + e > l15) ? 0.f : x; }
                  rp = (v[0] + v[1]) + (v[2] + v[3]); wv.x = cvtpk(v[0], v[1]); wv.y = cvtpk(v[2], v[3]);
              }
              rp += shx(rp, 16, lane); rp += shx(rp, 32, lane);
              *(LAS v2u*)(SC + t * 128 + (((2 * sblk + (kg >> 1)) ^ (t & 7)) << 4) + 8 * (kg & 1)) = wv;
              if (kg == 0) DEN[sblk * 64 + t] = rp; }
          { float s = bflo(q0.x) * n0.x + bfhi(q0.x) * n0.y + bflo(q0.y) * n0.z + bfhi(q0.y) * n0.w + bflo(q0.z) * n1.x + bfhi(q0.z) * n1.y + bflo(q0.w) * n1.z + bfhi(q0.w) * n1.w
                    + bflo(q1.x) * n2.x + bfhi(q1.x) * n2.y + bflo(q1.y) * n2.z + bfhi(q1.y) * n2.w + bflo(q1.z) * n3.x + bfhi(q1.z) * n3.y + bflo(q1.w) * n3.z + bfhi(q1.w) * n3.w;
            s += shx(s, 1, lane); s += shx(s, 2, lane); s += shx(s, 4, lane);
            if (dp == 0) QN[tq] = s; } }
        LBAR();
        v2u og[4];
#pragma unroll
        for (int tb = 0; tb < 4; ++tb) og[tb] = *(const v2u*)(Op + (size_t)(t0 + 16 * tb + l15) * 512);
        bf16x8v vf[2]; f32x4 hv[4];
        { float pmt[4], ft[4], dnp[4], qn4[4]; bf16x8v Cfrag[4];
#pragma unroll
          for (int kp = 0; kp < 4; ++kp) { v4u a; a.x = cvtpk(Cacc[2 * kp].x, Cacc[2 * kp].y); a.y = cvtpk(Cacc[2 * kp].z, Cacc[2 * kp].w); a.z = cvtpk(Cacc[2 * kp + 1].x, Cacc[2 * kp + 1].y); a.w = cvtpk(Cacc[2 * kp + 1].z, Cacc[2 * kp + 1].w);
              Cfrag[kp] = __builtin_bit_cast(bf16x8v, a); }
#pragma unroll
          for (int ks = 0; ks < 2; ++ks) { const int r0 = 32 * ks + 8 * kg;
              const s16x4v lo = tr_read(Vi + 256 * (r0 + q4) + 16 * ((2 * w + (p4 >> 1)) ^ ((q4 << 2) | ((r0 >> 2) & 3))) + 8 * (p4 & 1));
              const s16x4v hi = tr_read(Vi + 256 * (r0 + 4 + q4) + 16 * ((2 * w + (p4 >> 1)) ^ ((q4 << 2) | (((r0 + 4) >> 2) & 3))) + 8 * (p4 & 1));
              vf[ks] = __builtin_shufflevector(lo, hi, 0, 1, 2, 3, 4, 5, 6, 7); }
#pragma unroll
          for (int tb = 0; tb < 4; ++tb) { const int t = 16 * tb + l15; pmt[tb] = SPM[t0 + t]; ft[tb] = SF[t0 + t]; dnp[tb] = (DEN[t] + DEN[64 + t]) + (DEN[128 + t] + DEN[192 + t]); qn4[tb] = QN[t]; }
#pragma unroll
          for (int tp = 0; tp < 2; ++tp) {
              bf16x8v sf[2][2]; v2u qlo[2][4], qhi[2][4];
#pragma unroll
              for (int t2 = 0; t2 < 2; ++t2) { const int t = 16 * (2 * tp + t2) + l15; const int swz = ((t & 3) << 2) | ((t >> 2) & 3);
#pragma unroll
                  for (int ks = 0; ks < 2; ++ks) sf[t2][ks] = *(const LAS bf16x8v*)(L + M2_SC + t * 128 + (((4 * ks + kg) ^ (t & 7)) << 4));
#pragma unroll
                  for (int kp = 0; kp < 4; ++kp) { qlo[t2][kp] = *(const LAS v2u*)(Qi + 256 * t + 16 * ((4 * kp + (kg >> 1)) ^ swz) + 8 * (kg & 1)); qhi[t2][kp] = *(const LAS v2u*)(Qi + 256 * t + 16 * ((4 * kp + 2 + (kg >> 1)) ^ swz) + 8 * (kg & 1)); } }
              SBAR();
#pragma unroll
              for (int t2 = 0; t2 < 2; ++t2) { const int tb = 2 * tp + t2; f32x4 an = {0.f, 0.f, 0.f, 0.f}, a2 = {0.f, 0.f, 0.f, 0.f};
#pragma unroll
                  for (int ks = 0; ks < 2; ++ks) an = MFMA16(vf[ks], sf[t2][ks], an);
#pragma unroll
                  for (int kp = 0; kp < 4; ++kp) { v4u qq; qq.x = qlo[t2][kp].x; qq.y = qlo[t2][kp].y; qq.z = qhi[t2][kp].x; qq.w = qhi[t2][kp].y; a2 = MFMA16(Cfrag[kp], __builtin_bit_cast(bf16x8v, qq), a2); }
                  const float Mt = fmaxf(pmt[tb], mc), wp = __expf(mc - Mt), emt = __expf(-ft[tb] - Mt);
                  const float dn = dnp[tb] + wp * qn4[tb];
                  const float idn = __builtin_amdgcn_rcpf(fmaxf(fabsf(dn), emt));
                  hv[tb] = (an + a2 * wp) * idn;
                  float ss = (hv[tb].x * hv[tb].x + hv[tb].y * hv[tb].y) + (hv[tb].z * hv[tb].z + hv[tb].w * hv[tb].w);
                  ss += shx(ss, 16, lane); ss += shx(ss, 32, lane);
                  if (kg == 0) SSQ[((c & 1) * 8 + w) * 64 + 16 * tb + l15] = ss; }
              SBAR();
          } }
        { bf16x8v vpf[2], wkf[2];
          f32x4 aw[2][2];
#pragma unroll
          for (int ks = 0; ks < 2; ++ks) { aw[ks][0] = *(const LAS f32x4*)(SA + t0 + 32 * ks + 8 * kg); aw[ks][1] = *(const LAS f32x4*)(SA + t0 + 32 * ks + 8 * kg + 4); }
#pragma unroll
          for (int ks = 0; ks < 2; ++ks) { float wkv[8]; unsigned vp[4], wp2[4]; const v4u vu = __builtin_bit_cast(v4u, vf[ks]); const unsigned vw[4] = {vu.x, vu.y, vu.z, vu.w};
#pragma unroll
              for (int j = 0; j < 8; ++j) wkv[j] = __expf(aw[ks][j >> 2][j & 3] - mxa);
#pragma unroll
              for (int j2 = 0; j2 < 4; ++j2) { vp[j2] = cvtpk(bflo(vw[j2]) * wkv[2 * j2], bfhi(vw[j2]) * wkv[2 * j2 + 1]); wp2[j2] = cvtpk(wkv[2 * j2], wkv[2 * j2 + 1]); }
              v4u a; a.x = vp[0]; a.y = vp[1]; a.z = vp[2]; a.w = vp[3]; vpf[ks] = __builtin_bit_cast(bf16x8v, a);
              v4u b2; b2.x = wp2[0]; b2.y = wp2[1]; b2.z = wp2[2]; b2.w = wp2[3]; wkf[ks] = __builtin_bit_cast(bf16x8v, b2); }
          nacc = nacc * cs;
#pragma unroll
          for (int ih = 0; ih < 2; ++ih) {
              bf16x8v kf[4][2];
#pragma unroll
              for (int i4 = 0; i4 < 4; ++i4)
#pragma unroll
                  for (int ks = 0; ks < 2; ++ks) { const int i = 4 * ih + i4, r0 = 32 * ks + 8 * kg;
                      const s16x4v lo = tr_read(Ki + 256 * (r0 + q4) + 16 * ((2 * i + (p4 >> 1)) ^ ((q4 << 2) | ((r0 >> 2) & 3))) + 8 * (p4 & 1));
                      const s16x4v hi = tr_read(Ki + 256 * (r0 + 4 + q4) + 16 * ((2 * i + (p4 >> 1)) ^ ((q4 << 2) | (((r0 + 4) >> 2) & 3))) + 8 * (p4 & 1));
                      kf[i4][ks] = __builtin_shufflevector(lo, hi, 0, 1, 2, 3, 4, 5, 6, 7); }
              SBAR();
#pragma unroll
              for (int i4 = 0; i4 < 4; ++i4) { const int i = 4 * ih + i4; Cacc[i] = Cacc[i] * cs;
#pragma unroll
                  for (int ks = 0; ks < 2; ++ks) Cacc[i] = MFMA16(kf[i4][ks], vpf[ks], Cacc[i]); }
              SBAR();
          }
          { bf16x8v kw[2];
#pragma unroll
            for (int ks = 0; ks < 2; ++ks) { const int r0 = 32 * ks + 8 * kg;
                const s16x4v lo = tr_read(Ki + 256 * (r0 + q4) + 16 * ((2 * w + (p4 >> 1)) ^ ((q4 << 2) | ((r0 >> 2) & 3))) + 8 * (p4 & 1));
                const s16x4v hi = tr_read(Ki + 256 * (r0 + 4 + q4) + 16 * ((2 * w + (p4 >> 1)) ^ ((q4 << 2) | (((r0 + 4) >> 2) & 3))) + 8 * (p4 & 1));
                kw[ks] = __builtin_shufflevector(lo, hi, 0, 1, 2, 3, 4, 5, 6, 7); }
            nacc = MFMA16(kw[0], wkf[0], nacc); nacc = MFMA16(kw[1], wkf[1], nacc); }
          if (l15 == 0) *(LAS f32x4*)(NV + 16 * w + 4 * kg) = nacc;
 }
        if (c + 1 < 32) { LAS unsigned char* Nx = L + M2_IMG + ((c + 1) & 1) * 49152;
            *(LAS v4u*)(Nx + so0) = sq0; *(LAS v4u*)(Nx + so1) = sq1; *(LAS v4u*)(Nx + 16384 + so0) = sk0; *(LAS v4u*)(Nx + 16384 + so1) = sk1; *(LAS v4u*)(Nx + 32768 + so0) = sv0; *(LAS v4u*)(Nx + 32768 + so1) = sv1; }
        LBAR();
#pragma unroll
        for (int tb = 0; tb < 4; ++tb) { const int t = 16 * tb + l15; const LAS float* sp = SSQ + (c & 1) * 512 + t;
            const float tot = ((sp[0] + sp[64]) + (sp[128] + sp[192])) + ((sp[256] + sp[320]) + (sp[384] + sp[448]));
            const float rn = __frsqrt_rn(tot * (1.f / 128.f) + EPS);
            const float y0 = hv[tb].x * rn * gn.x * sigmoidf_(bflo(og[tb].x)), y1 = hv[tb].y * rn * gn.y * sigmoidf_(bfhi(og[tb].x)), y2 = hv[tb].z * rn * gn.z * sigmoidf_(bflo(og[tb].y)), y3 = hv[tb].w * rn * gn.w * sigmoidf_(bfhi(og[tb].y));
            v2u wv; wv.x = cvtpk(y0, y1); wv.y = cvtpk(y2, y3);
            *(v2u*)(Yp + (size_t)(t0 + t) * DM) = wv; }
    }
    LBAR();
}

__device__ __forceinline__ bf16x8v pack8(const f32x16& x, int s2) { v4u p; p.x = cvtpk(x[8 * s2 + 0], x[8 * s2 + 1]); p.y = cvtpk(x[8 * s2 + 2], x[8 * s2 + 3]); p.z = cvtpk(x[8 * s2 + 4], x[8 * s2 + 5]); p.w = cvtpk(x[8 * s2 + 6], x[8 * s2 + 7]); return __builtin_bit_cast(bf16x8v, p); }
__device__ __forceinline__ int tr32_off(int lane, int c, int ks, int t) { const int h = lane >> 5, blk = (lane >> 4) & 1, q = (lane & 15) >> 2, p = lane & 3; return img_off(16 * ks + 8 * h + 4 * t + q, 4 * c + 2 * blk + (p >> 1)) + 8 * (p & 1); }
__device__ __forceinline__ bf16x8v tr32_frag(const LAS unsigned char* img, int lane, int c, int ks) { const s16x4v lo = tr_read(img + tr32_off(lane, c, ks, 0)), hi = tr_read(img + tr32_off(lane, c, ks, 1)); return __builtin_shufflevector(lo, hi, 0, 1, 2, 3, 4, 5, 6, 7); }
constexpr int M3_DEN = M2_DEN  , M3_SSQ = M2_SSQ  ;

__device__ __forceinline__ void mlstm_unit_v3(LAS unsigned char* L, const MixPtrs& P, int b, int hh, int tid_in) {
    int tid_l = tid_in; asm volatile("" : "+v"(tid_l));
    const int tid = tid_l, lane = tid & 63, w = __builtin_amdgcn_readfirstlane(tid >> 6);
    const size_t rb = (size_t)b * SEQ;
    const bf16* QCp = MP_QC + ((size_t)(b * 4 + hh) * SEQ) * 128; const bf16* KCp = MP_KC2 + ((size_t)(b * 4 + hh) * SEQ) * 128;
    const bf16* Vp = MP_MV + rb * 512 + hh * 128;
    LAS float* DEN = (LAS float*)(L + M3_DEN); LAS float* QN = (LAS float*)(L + M2_QN); LAS float* NV = (LAS float*)(L + M2_N); LAS float* SSQ = (LAS float*)(L + M3_SSQ);
    LAS float* SA = (LAS float*)(L + M2_A); LAS float* SPM = (LAS float*)(L + M2_PM); LAS float* SF = (LAS float*)(L + M2_F);
    LAS float* SBL = (LAS float*)(L + M2_BL); LAS float* SAMX = (LAS float*)(L + M2_AMX); LAS float* SMC = (LAS float*)(L + M2_MC);
    float zf = 0.f; asm volatile("" : "+v"(zf));
    const bool isCD = w < 4; const int jw = w & 3;
    f32x16 Cacc[4]; bf16x8v vfk[4];
#pragma unroll
    for (int i = 0; i < 4; ++i) { vfk[i] = (bf16x8v){0, 0, 0, 0, 0, 0, 0, 0};
#pragma unroll
        for (int e = 0; e < 16; ++e) Cacc[i][e] = zf; }
    const int r0s = tid >> 4, c0s = tid & 15, so0 = img_off(r0s, c0s), so1 = img_off(r0s + 32, c0s);
    v4u sq0, sq1, sk0, sk1, sv0, sv1;
    sq0 = *(const v4u*)(QCp + (size_t)r0s * 128 + c0s * 8); sq1 = *(const v4u*)(QCp + (size_t)(r0s + 32) * 128 + c0s * 8);
    sk0 = *(const v4u*)(KCp + (size_t)r0s * 128 + c0s * 8); sk1 = *(const v4u*)(KCp + (size_t)(r0s + 32) * 128 + c0s * 8);
    sv0 = *(const v4u*)(Vp + (size_t)r0s * 512 + c0s * 8);  sv1 = *(const v4u*)(Vp + (size_t)(r0s + 32) * 512 + c0s * 8);
    LBAR();
    { const float ib = P.i_bias[hh], fb = P.f_bias[hh]; const float* Gp = MP_GATE + rb * 32 + hh;
#pragma unroll 1
      for (int cc = w; cc < 32; cc += 8) { const int tk = 64 * cc + lane;
          const float il = Gp[(size_t)tk * 32 + 24] + ib, fx = Gp[(size_t)tk * 32 + 28] + fb; const float fl = fminf(fx, 0.f) - log1pf(__expf(-fabsf(fx)));
          float f = fl;
#pragma unroll
          for (int o = 1; o < 64; o <<= 1) { const float v = shi(f, lane - o); if (lane >= o) f += v; }
          const float a = il - f; float pm = a;
#pragma unroll
          for (int o = 1; o < 64; o <<= 1) { const float v = shi(pm, lane - o); if (lane >= o) pm = fmaxf(pm, v); }
          SA[tk] = a; SPM[tk] = pm; SF[tk] = f; if (lane == 63) { SBL[cc] = f; SAMX[cc] = pm; } } }
    *(LAS v4u*)(L + M2_IMG + so0) = sq0; *(LAS v4u*)(L + M2_IMG + so1) = sq1; *(LAS v4u*)(L + M2_IMG + 16384 + so0) = sk0; *(LAS v4u*)(L + M2_IMG + 16384 + so1) = sk1;
    *(LAS v4u*)(L + M2_IMG + 32768 + so0) = sv0; *(LAS v4u*)(L + M2_IMG + 32768 + so1) = sv1;
    if (tid < 128) NV[tid] = zf;
    LBAR();
    if (tid == 0) { float mcar = zf; for (int cc = 0; cc < 32; ++cc) { SMC[cc] = mcar; mcar = SBL[cc] + fmaxf(mcar, SAMX[cc]); } }
    LBAR();
    f32x16 hv[2];
    hv[0] = Cacc[0]; hv[1] = Cacc[0];
#pragma unroll 1
    for (int c = 0; c < 32; ++c) {
        int lc = lane; asm volatile("" : "+v"(lc));
        const int r32 = lc & 31, hi = lc >> 5;
        const int t0 = c * 64; const LAS unsigned char* Qi = L + M2_IMG + (c & 1) * 49152; const LAS unsigned char* Ki = Qi + 16384; const LAS unsigned char* Vi = Qi + 32768;
        const LAS unsigned char* Kp = L + M2_IMG + ((c + 1) & 1) * 49152 + 16384;
        if (c + 1 < 32) { const int tn = t0 + 64;
            sq0 = *(const v4u*)(QCp + (size_t)(tn + r0s) * 128 + c0s * 8); sq1 = *(const v4u*)(QCp + (size_t)(tn + r0s + 32) * 128 + c0s * 8);
            sk0 = *(const v4u*)(KCp + (size_t)(tn + r0s) * 128 + c0s * 8); sk1 = *(const v4u*)(KCp + (size_t)(tn + r0s + 32) * 128 + c0s * 8);
            sv0 = *(const v4u*)(Vp + (size_t)(tn + r0s) * 512 + c0s * 8);  sv1 = *(const v4u*)(Vp + (size_t)(tn + r0s + 32) * 512 + c0s * 8); }
        const float mc = SMC[c];
        if (isCD) {
            if (c > 0) { const int t0p = t0 - 64; const float mcp = SMC[c - 1], mxap = fmaxf(mcp, SAMX[c - 1]); const float csp = __expf(mcp - mxap);
                bf16x8v vfp[4];
#pragma unroll
                for (int ks = 0; ks < 4; ++ks) { const f32x4 a0 = *(const LAS f32x4*)(SA + t0p + 16 * ks + 8 * hi), a1 = *(const LAS f32x4*)(SA + t0p + 16 * ks + 8 * hi + 4);
                    const float wk[8] = {__expf(a0.x - mxap), __expf(a0.y - mxap), __expf(a0.z - mxap), __expf(a0.w - mxap), __expf(a1.x - mxap), __expf(a1.y - mxap), __expf(a1.z - mxap), __expf(a1.w - mxap)};
                    const v4u vu = __builtin_bit_cast(v4u, vfk[ks]); v4u o4;
                    o4.x = cvtpk(bflo(vu.x) * wk[0], bfhi(vu.x) * wk[1]); o4.y = cvtpk(bflo(vu.y) * wk[2], bfhi(vu.y) * wk[3]); o4.z = cvtpk(bflo(vu.z) * wk[4], bfhi(vu.z) * wk[5]); o4.w = cvtpk(bflo(vu.w) * wk[6], bfhi(vu.w) * wk[7]);
                    vfp[ks] = __builtin_bit_cast(bf16x8v, o4); }
#pragma unroll
                for (int dt = 0; dt < 4; ++dt) { bf16x8v kf[4];
#pragma unroll
                    for (int ks = 0; ks < 4; ++ks) kf[ks] = tr32_frag(Kp, lc, dt, ks);
                    SBAR();
#pragma unroll
                    for (int e = 0; e < 16; ++e) Cacc[dt][e] *= csp;
#pragma unroll
                    for (int ks = 0; ks < 4; ++ks) Cacc[dt] = MFMA32(kf[ks], vfp[ks], Cacc[dt]);
                    SBAR(); } }
        } else if (jw != 2) {
            const int st = (jw == 3) ? 1 : 0, tt = (jw == 0) ? 0 : 1; const int t = 32 * tt + r32;
            const float Mt = fmaxf(SPM[t0 + t], mc);
            f32x4 as4[4];
#pragma unroll
            for (int g = 0; g < 4; ++g) as4[g] = *(const LAS f32x4*)(SA + t0 + 32 * st + 8 * g + 4 * hi);
            f32x16 acc;
#pragma unroll
            for (int e = 0; e < 16; ++e) acc[e] = 0.f;
#pragma unroll
            for (int kh = 0; kh < 2; ++kh) { bf16x8v ka[4], qb[4];
#pragma unroll
                for (int k4 = 0; k4 < 4; ++k4) { const int ks = 4 * kh + k4; ka[k4] = *(const LAS bf16x8v*)(Ki + img_off(32 * st + r32, 2 * ks + hi)); qb[k4] = *(const LAS bf16x8v*)(Qi + img_off(t, 2 * ks + hi)); }
                SBAR();
#pragma unroll
                for (int k4 = 0; k4 < 4; ++k4) acc = MFMA32(ka[k4], qb[k4], acc);
                SBAR(); }
            float rp = 0.f;
#pragma unroll
            for (int g = 0; g < 4; ++g) { float v[4];
#pragma unroll
                for (int e = 0; e < 4; ++e) { const float x = acc[4 * g + e] * __expf(as4[g][e] - Mt); v[e] = (st == tt && (8 * g + 4 * hi + e) > r32) ? 0.f : x; rp += v[e]; }
                v2u wv; wv.x = cvtpk(v[0], v[1]); wv.y = cvtpk(v[2], v[3]);
                *(LAS v2u*)(L + M2_SC + t * 128 + (((4 * st + g) ^ (t & 7)) << 4) + 8 * hi) = wv; }
            rp = xor32_sum(rp);
            if (hi == 0) DEN[st * 64 + t] = rp;
        } else {
            { const v4u z4 = {0u, 0u, 0u, 0u};
              *(LAS v4u*)(L + M2_SC + r32 * 128 + (((4 + 2 * hi) ^ (r32 & 7)) << 4)) = z4; *(LAS v4u*)(L + M2_SC + r32 * 128 + (((5 + 2 * hi) ^ (r32 & 7)) << 4)) = z4;
              if (hi == 0) DEN[64 + r32] = 0.f; }
            float qn = 0.f;
#pragma unroll 4
            for (int ch = 0; ch < 16; ++ch) { const v4u q8 = *(const LAS v4u*)(Qi + img_off(lc, ch)); const f32x4 n0 = *(const LAS f32x4*)(NV + 8 * ch), n1 = *(const LAS f32x4*)(NV + 8 * ch + 4);
                qn += bflo(q8.x) * n0.x + bfhi(q8.x) * n0.y + bflo(q8.y) * n0.z + bfhi(q8.y) * n0.w + bflo(q8.z) * n1.x + bfhi(q8.z) * n1.y + bflo(q8.w) * n1.z + bfhi(q8.w) * n1.w; }
            QN[lc] = qn;
            const float mxa = fmaxf(mc, SAMX[c]), cs = __expf(mc - mxa); const float wkl = __expf(SA[t0 + lc] - mxa);
            const f32x2v nold = *(const LAS f32x2v*)(NV + 2 * lc); float n0a = 0.f, n1a = 0.f;
#pragma unroll
            for (int s = 0; s < 64; ++s) { const unsigned kk = *(const LAS unsigned*)(Ki + img_off(s, lc >> 2) + (lc & 3) * 4); const float ws = __builtin_bit_cast(float, __builtin_amdgcn_readlane(__builtin_bit_cast(int, wkl), s)); n0a += ws * bflo(kk); n1a += ws * bfhi(kk); }
            LDS_WAIT();
            *(LAS f32x2v*)(NV + 2 * lc) = (f32x2v){cs * nold.x + n0a, cs * nold.y + n1a};
        }
        LBAR();
        v2u og[2][4];
        if (isCD) {
#pragma unroll
            for (int ks = 0; ks < 4; ++ks) vfk[ks] = tr32_frag(Vi, lc, jw, ks);
#pragma unroll
            for (int tt = 0; tt < 2; ++tt) { const int t = 32 * tt + r32;
                bf16x8v scf[4];
#pragma unroll
                for (int ks = 0; ks < 4; ++ks) scf[ks] = *(const LAS bf16x8v*)(L + M2_SC + t * 128 + (((2 * ks + hi) ^ (t & 7)) << 4));
                const float pmt = SPM[t0 + t], ft = SF[t0 + t], dnp = DEN[t] + DEN[64 + t], qnt = QN[t];
                f32x16 a1, a2;
#pragma unroll
                for (int e = 0; e < 16; ++e) { a1[e] = 0.f; a2[e] = 0.f; }
#pragma unroll
                for (int kh = 0; kh < 2; ++kh) { v2u ql[4], qh[4];
#pragma unroll
                    for (int k4 = 0; k4 < 4; ++k4) { const int k8 = 4 * kh + k4; ql[k4] = *(const LAS v2u*)(Qi + img_off(t, 2 * k8) + 8 * hi); qh[k4] = *(const LAS v2u*)(Qi + img_off(t, 2 * k8 + 1) + 8 * hi); }
                    SBAR();
                    if (kh == 0) {
#pragma unroll
                        for (int ks = 0; ks < 4; ++ks) a1 = MFMA32(vfk[ks], scf[ks], a1); }
#pragma unroll
                    for (int k4 = 0; k4 < 4; ++k4) { const int k8 = 4 * kh + k4; v4u qq; qq.x = ql[k4].x; qq.y = ql[k4].y; qq.z = qh[k4].x; qq.w = qh[k4].y; a2 = MFMA32(pack8(Cacc[k8 >> 1], k8 & 1), __builtin_bit_cast(bf16x8v, qq), a2); }
                    SBAR(); }
                const float Mt = fmaxf(pmt, mc), wp = __expf(mc - Mt), emt = __expf(-ft - Mt);
                const float idn = __builtin_amdgcn_rcpf(fmaxf(fabsf(dnp + wp * qnt), emt));
                float ss = 0.f;
#pragma unroll
                for (int e = 0; e < 16; ++e) { const float x = (a1[e] + a2[e] * wp) * idn; hv[tt][e] = x; ss += x * x; }
                ss = xor32_sum(ss);
                if (hi == 0) SSQ[((c & 1) * 4 + jw) * 64 + t] = ss;
                SBAR(); }
            { const bf16* Op = MP_MO + rb * 512 + hh * 128 + 32 * jw + 4 * hi;
#pragma unroll
              for (int tt = 0; tt < 2; ++tt)
#pragma unroll
                  for (int g = 0; g < 4; ++g) og[tt][g] = *(const v2u*)(Op + (size_t)(t0 + 32 * tt + r32) * 512 + 8 * g); }
        }
        if (c + 1 < 32) { LAS unsigned char* Nx = L + M2_IMG + ((c + 1) & 1) * 49152;
            *(LAS v4u*)(Nx + so0) = sq0; *(LAS v4u*)(Nx + so1) = sq1; *(LAS v4u*)(Nx + 16384 + so0) = sk0; *(LAS v4u*)(Nx + 16384 + so1) = sk1; *(LAS v4u*)(Nx + 32768 + so0) = sv0; *(LAS v4u*)(Nx + 32768 + so1) = sv1; }
        LBAR();
        if (isCD) {
            bf16* Yp = MP_Y + rb * DM + 512 + hh * 128 + 32 * jw + 4 * hi; const float* gnp = P.mnorm_g + hh * 128 + 32 * jw + 4 * hi;
            f32x4 gn4[4];
#pragma unroll
            for (int g = 0; g < 4; ++g) gn4[g] = *(const f32x4*)(gnp + 8 * g);
#pragma unroll
            for (int tt = 0; tt < 2; ++tt) { const int t = 32 * tt + r32; const LAS float* sp = SSQ + (c & 1) * 256 + t;
                const float rn = __frsqrt_rn(((sp[0] + sp[64]) + (sp[128] + sp[192])) * (1.f / 128.f) + EPS);
#pragma unroll
                for (int g = 0; g < 4; ++g) { const float y0 = hv[tt][4 * g] * rn * gn4[g].x * sigmoidf_(bflo(og[tt][g].x)), y1 = hv[tt][4 * g + 1] * rn * gn4[g].y * sigmoidf_(bfhi(og[tt][g].x));
                    const float y2 = hv[tt][4 * g + 2] * rn * gn4[g].z * sigmoidf_(bflo(og[tt][g].y)), y3 = hv[tt][4 * g + 3] * rn * gn4[g].w * sigmoidf_(bfhi(og[tt][g].y));
                    v2u wv; wv.x = cvtpk(y0, y1); wv.y = cvtpk(y2, y3);
                    *(v2u*)(Yp + (size_t)(t0 + t) * DM + 8 * g) = wv; } }
        }
    }
    LBAR();
}

#ifndef MK_MULTI
#define MK_MULTI 0
#endif
constexpr int PH_PER_LAYER = 9, N_PHASES = 1 + DEPTH * PH_PER_LAYER;
struct Args { const float* in[16]; float* out; unsigned char* ws; int ph_lo, ph_hi; };
static_assert(sizeof(Args) == 16 * 8 + 8 + 8 + 8, "Args has no padding");

__global__ void __launch_bounds__(NWAVES * 64, 2) fwd_kernel(Args args) {
    extern __shared__ __attribute__((aligned(16))) unsigned char lds_raw[];
    LAS unsigned char* L = (LAS unsigned char*)lds_raw;
    const int G0 = gridDim.x, blk0 = blockIdx.x;
    const int wave0 = __builtin_amdgcn_readfirstlane((int)threadIdx.x >> 6);
#define PH_IDS() PH_WS(); int wave = wave0; asm volatile("" : "+s"(wave)); const int lane = fresh_lane(), tid = wave * 64 + lane, gw = blk * NWAVES + wave; (void)gw
#define PH_WS() size_t zoff_ = 0; asm volatile("" : "+s"(zoff_)); unsigned char* ws = (unsigned char*)__builtin_assume_aligned(args.ws, 256) + zoff_; int blk = blk0, G = G0; asm volatile("" : "+s"(blk), "+s"(G)); const int NGW = G * NWAVES; (void)NGW; bf16* X16 = (bf16*)(ws + WS_X16); float* SS2 = (float*)(ws + WS_TAB + TAB_SS2); bf16* U = (bf16*)(ws + WS_U); bf16* HB = (bf16*)(ws + WS_HB); bf16* HD = (bf16*)(ws + WS_HD); \
    unsigned char* wl = ws + WS_W; const float* ng = args.in[1] + (size_t)l_ * 6 * DM; (void)X16; (void)SS2; (void)U; (void)HB; (void)HD; (void)wl; (void)ng
    unsigned char* ws0 = args.ws;
    volatile LAS unsigned* MISC = (volatile LAS unsigned*)(L + MISC_OFF);
    { const int tid_e = wave0 * 64 + fresh_lane(); if (tid_e < 16) MISC[tid_e] = 0u; }
    __syncthreads();
    XcdBarrier bar; bar.bar = (unsigned*)(ws0 + WS_CTL) + CW_BAR; bar.x = 0; bar.st = nullptr;
    if (!MK_MULTI) bar = xcd_barrier_post((unsigned*)(ws0 + WS_CTL) + CW_BAR, MISC + 8, wave0 * 64 + fresh_lane() == 0);
    const int lo = args.ph_lo, hi = args.ph_hi;
#define IN(k) (lo <= (k) && (k) < hi)
#define SEAM(k) do { if (IN(k) && IN((k) + 1)) xcd_barrier(bar, wave0 * 64 + fresh_lane() == 0); } while (0)

    if (IN(0)) {
        const int l_ = 0; PH_IDS();
        const float* x_in = args.in[0]; float* cosT = (float*)(ws + WS_TAB + TAB_COS); float* sinT = (float*)(ws + WS_TAB + TAB_SIN); float* b1T = (float*)(ws + WS_TAB + TAB_B1);
#define CONVERT_WEIGHTS(lw, GM) do { LAS float* scr = (LAS float*)(L + wave * 16384); const float* ngw = args.in[1] + (size_t)(lw) * 6 * DM; \
        constexpr int I_GU = 16 * 176, I_DN = 44 * 32, I_IN = 16 * 112, I_OUT = 16 * 32, I_CMP = 16 * 16, I_LAYER = 2 * I_GU + 2 * I_DN + I_IN + I_OUT + I_CMP; \
        for (int it = gw; it < I_LAYER; it += NGW) { int r = it; unsigned char* wlw = ws + WS_W; \
            if (r < I_GU) { if ((GM) & 1) { SrcGU s{args.in[2] + (size_t)(lw) * DM * NGU, ngw + 0 * DM}; transpose_item(s, DM, (bf16*)(wlw + WO_GU1), scr, r / 176, r % 176, lane); } continue; } r -= I_GU; \
            if (r < I_DN) { if ((GM) & 2) { SrcPlain s{args.in[3] + (size_t)(lw) * FF * DM, DM}; transpose_item(s, FF, (bf16*)(wlw + WO_DN1), scr, r / 32, r % 32, lane); } continue; } r -= I_DN; \
            if (r < I_GU) { if ((GM) & 4) { SrcGU s{args.in[4] + (size_t)(lw) * DM * NGU, ngw + 4 * DM}; transpose_item(s, DM, (bf16*)(wlw + WO_GU2), scr, r / 176, r % 176, lane); } continue; } r -= I_GU; \
            if (r < I_DN) { if ((GM) & 8) { SrcPlain s{args.in[5] + (size_t)(lw) * FF * DM, DM}; transpose_item(s, FF, (bf16*)(wlw + WO_DN2), scr, r / 32, r % 32, lane); } continue; } r -= I_DN; \
            if (r < I_IN) { if ((GM) & 16) { SrcIN s{args.in[6] + (size_t)(lw) * DM * INCOLS, ngw + 2 * DM}; transpose_item(s, DM, (bf16*)(wlw + WO_IN), scr, r / 112, r % 112, lane); } continue; } r -= I_IN; \
            if (r < I_OUT) { if ((GM) & 32) { SrcPlain s{args.in[7] + (size_t)(lw) * DM * DM, DM}; transpose_item(s, DM, (bf16*)(wlw + WO_OUT), scr, r / 32, r % 32, lane); } continue; } r -= I_OUT; \
            if ((GM) & 64) { SrcCMP s{args.in[9] + (size_t)(lw) * 2 * 2048 * 128}; transpose_item(s, DM, (bf16*)(wlw + WO_CMP), scr, r / 16, r % 16, lane); } } } while (0)
        CONVERT_WEIGHTS(0, 0x7f);
        for (int i = blk * 512 + tid; i < SEQ * 8; i += G * 512) { const int pos = i >> 3, k = i & 7;
            const double inv = pow(500000.0, -(double)k / 8.0), ang = (double)pos * inv; cosT[i] = (float)cos(ang); sinT[i] = (float)sin(ang); }
        { LAS float* part = (LAS float*)(L + 131072);
          for (int ob = blk; ob < DEPTH * 2 * 128 / 2; ob += G) { const int o = 2 * ob + (wave >> 2), qr = wave & 3; const int lk = o >> 7, c = o & 127;
              const float* pe = args.in[8] + (size_t)lk * 2048; const float* w1 = args.in[9] + (size_t)lk * 2048 * 128;
              float s = 0.f; for (int r = qr * 512 + lane; r < qr * 512 + 512; r += 64) s += pe[r] * w1[(size_t)r * 128 + c];
              s = wave_sum(s, lane); if (lane == 0) part[wave] = s;
              __syncthreads();
              if (lane == 0 && qr == 0) b1T[o] = (part[wave] + part[wave + 1]) + (part[wave + 2] + part[wave + 3]);
              __syncthreads(); } }
        thin_phase<0>(nullptr, x_in, X16, nullptr, SS2, nullptr, 0.f, gw, NGW, lane);
    }
    SEAM(0);

#pragma unroll 1
    for (int l = 0; l < DEPTH; ++l) {
        const int pb = 1 + l * PH_PER_LAYER, l_ = l;
        if (IN(pb + 0)) { PH_IDS(); pg8::Gemm g{X16, (const bf16*)(wl + WO_GU1), MTOK, NGU, DM}; pg8::StaticOrder S; S.init(MTOK, NGU, G, blk); EpiSwiglu E{HB, SS2};
            pg8::gemm_phase<EpiSwiglu, pg8::StaticOrder, true, true>(L, g, S, E, tid); }
        SEAM(pb + 0);
        if (IN(pb + 1)) { PH_IDS(); pg8::Gemm g{HB, (const bf16*)(wl + WO_DN1), MTOK, DM, FF}; pg8::StaticOrder S; S.init(MTOK, DM, G, blk);
            EpiResNorm<false> E{ws, (LAS float*)(L + 131072), ng + 1 * DM, nullptr, 0.5f, l_ * 3 + 0};
            pg8::gemm_phase<EpiResNorm<false>, pg8::StaticOrder, true, true>(L, g, S, E, tid); }
        SEAM(pb + 1);
        if (IN(pb + 2)) { PH_IDS(); pg8::Gemm g{X16, (const bf16*)(wl + WO_IN), MTOK, NINP, DM}; pg8::StaticOrder S; S.init(MTOK, NINP, G, blk);
            EpiInProj E{ws};
            pg8::gemm_phase<EpiInProj, pg8::StaticOrder, true, true>(L, g, S, E, tid); }
        SEAM(pb + 2);
        if (IN(pb + 3)) { PH_IDS(); pg8::Gemm g{(const bf16*)(ws + WS_KCR), (const bf16*)(wl + WO_CMP), 8192, 512, DM}; CmpOrder S{blk, G}; EpiPQ E{(float*)(ws + WS_PQ)};
            pg8::gemm_phase<EpiPQ, CmpOrder, false, true>(L, g, S, E, tid);
            { const int nb = (G > 32) ? 32 : 0; if (blk >= nb) { mlstm_conv_pass(ws, args.in[11] + (size_t)l_ * 4 * 1024, args.in[12] + (size_t)l_ * 1024, (blk - nb) * 512 + tid, (G - nb) * 512); } } }
        SEAM(pb + 3);
        if (IN(pb + 4)) {
            PH_IDS();
            const float* b1T = (const float*)(ws + WS_TAB + TAB_B1); const float* PQ = (const float*)(ws + WS_PQ); bf16* CC = (bf16*)(ws + WS_CC);
            LAS float* w2s = (LAS float*)L; LAS float* hs = (LAS float*)(L + 32768) + wave * 4 * 128;
            for (int item = blk; item < 256; item += G) {
                const int kv = item >> 7, r0 = (item & 127) * 32 + wave * 4;
                const float* w2 = args.in[10] + (size_t)(l_ * 2 + kv) * 128 * 64; const float* b1 = b1T + (l_ * 2 + kv) * 128;
                __syncthreads();
                for (int i = tid; i < 128 * 64 / 4; i += 512) ((LAS f32x4*)w2s)[i] = ((const f32x4*)w2)[i];
#pragma unroll
                for (int rr = 0; rr < 4; ++rr) { const int r = kv * 4096 + r0 + rr, n = (r0 + rr) & 127;
#pragma unroll
                    for (int q2 = 0; q2 < 2; ++q2) { const int c = lane + 64 * q2; float hval = 0.f;
                        if (n != 127) { const float v = PQ[(size_t)r * 256 + c] + PQ[(size_t)(r + 1) * 256 + 128 + c] + b1[c];
                            const float u3 = 0.7978845608028654f * (v + 0.044715f * v * v * v); hval = 0.5f * v * (1.f + tanhf(u3)); }
                        hs[rr * 128 + c] = hval; } }
                __syncthreads();
                float o0 = 0.f, o1 = 0.f, o2 = 0.f, o3 = 0.f;
#pragma unroll 8
                for (int c = 0; c < 128; ++c) { const float wv = w2s[c * 64 + lane]; o0 += hs[c] * wv; o1 += hs[128 + c] * wv; o2 += hs[256 + c] * wv; o3 += hs[384 + c] * wv; }
                bf16* cp = CC + ((size_t)kv * 4096 + r0) * 64 + lane;
                cp[0] = (bf16)f2bf(o0); cp[64] = (bf16)f2bf(o1); cp[128] = (bf16)f2bf(o2); cp[192] = (bf16)f2bf(o3);
            }
            __syncthreads();
            if (l_ == 0) { if (DEPTH > 1) CONVERT_WEIGHTS(1, 0x53); } else CONVERT_WEIGHTS(l_, 0x2c);
        }
        SEAM(pb + 4);
        if (IN(pb + 5)) {
            PH_IDS();
            MixPtrs P{ws, args.in[11] + (size_t)l * 4 * 1024, args.in[12] + (size_t)l * 1024, args.in[13] + l * 4, args.in[14] + l * 4, args.in[15] + l * 512};
            {
            for (int u = blk; u < 64; u += G) mlstm_unit_v3(L, P, u >> 2, u & 3, tid);
            { unsigned* qbase = (unsigned*)(ws + WS_CTL) + CW_QUEUE + 1024 * l_; volatile LAS unsigned* QW = (volatile LAS unsigned*)(L + MISC_OFF);
              const unsigned q0 = xb_xcc_id() & 7u;
#pragma unroll 1
              for (unsigned qq = 0; qq < 8u; ++qq) { unsigned* qctr = qbase + 64 * ((q0 + qq) & 7u); const int bg0 = 4 * (int)((q0 + qq) & 7u);
                  __syncthreads();
                  if (tid == 0) QW[0] = __hip_atomic_fetch_add(qctr, 1u, __ATOMIC_RELAXED, __HIP_MEMORY_SCOPE_AGENT);
                  __syncthreads();
                  unsigned u = QW[0];
                  while (u < 128u) { unsigned nxt = 0u; if (tid == 0) nxt = __hip_atomic_fetch_add(qctr, 1u, __ATOMIC_RELAXED, __HIP_MEMORY_SCOPE_AGENT);
                      const int c = 31 - (int)(u & 31u), bg = bg0 + (int)(u >> 5); nsa_unit_v3(L, P, bg >> 1, bg & 1, c, tid);
                      __syncthreads(); if (tid == 0) QW[0] = nxt; __syncthreads(); u = QW[0]; } } }
            }
        }
        SEAM(pb + 5);
        if (IN(pb + 6)) { PH_IDS(); pg8::Gemm g{U, (const bf16*)(wl + WO_OUT), MTOK, DM, DM}; pg8::StaticOrder S; S.init(MTOK, DM, G, blk);
            EpiResNorm<false> E{ws, (LAS float*)(L + 131072), ng + 3 * DM, nullptr, 1.0f, l_ * 3 + 1};
            pg8::gemm_phase<EpiResNorm<false>, pg8::StaticOrder, true, true>(L, g, S, E, tid); }
        SEAM(pb + 6);
        if (IN(pb + 7)) { PH_IDS(); pg8::Gemm g{X16, (const bf16*)(wl + WO_GU2), MTOK, NGU, DM}; pg8::StaticOrder S; S.init(MTOK, NGU, G, blk); EpiSwiglu E{HB, SS2};
            pg8::gemm_phase<EpiSwiglu, pg8::StaticOrder, true, true>(L, g, S, E, tid); }
        SEAM(pb + 7);
        if (IN(pb + 8)) { PH_IDS(); pg8::Gemm g{HB, (const bf16*)(wl + WO_DN2), MTOK, DM, FF}; pg8::StaticOrder S; S.init(MTOK, DM, G, blk);
            if (l + 1 < DEPTH) { EpiResNorm<false> E{ws, (LAS float*)(L + 131072), ng + 5 * DM, nullptr, 0.5f, l_ * 3 + 2};
                pg8::gemm_phase<EpiResNorm<false>, pg8::StaticOrder, true, true>(L, g, S, E, tid); }
            else { EpiResNorm<true> E{ws, (LAS float*)(L + 131072), ng + 5 * DM, args.out, 0.5f, l_ * 3 + 2};
                pg8::gemm_phase<EpiResNorm<true>, pg8::StaticOrder, true, true>(L, g, S, E, tid); } }
        if (l + 1 < DEPTH) SEAM(pb + 8);
    }
#undef IN
#undef SEAM
#undef CONVERT_WEIGHTS
#undef PH_IDS
#undef PH_WS
}

extern "C" void kernel_launch(void* const* d_in, const int* in_sizes, int n_in, void* d_out, int out_size, void* d_ws, size_t ws_size, hipStream_t stream) {
    static int grid = 0;
    if (grid == 0) {
        if (n_in != 16 || in_sizes[0] != MTOK * DM || out_size != MTOK * DM || ws_size < WS_END3) { fprintf(stderr, "kernel_launch: unexpected problem (n_in %d, ws %zu)\n", n_in, ws_size); grid = -1; return; }
        int dev = 0, cus = 0, per_cu = 0;
        if (hipGetDevice(&dev) != hipSuccess || hipDeviceGetAttribute(&cus, hipDeviceAttributeMultiprocessorCount, dev) != hipSuccess) { grid = -1; return; }
        if (hipFuncSetAttribute((const void*)fwd_kernel, hipFuncAttributeMaxDynamicSharedMemorySize, LDS_BYTES) != hipSuccess) { grid = -1; return; }
        if (hipOccupancyMaxActiveBlocksPerMultiprocessor(&per_cu, (const void*)fwd_kernel, NWAVES * 64, LDS_BYTES) != hipSuccess || per_cu < 1) { fprintf(stderr, "kernel_launch: occupancy query says %d\n", per_cu); }
        (void)hipGetLastError();
        grid = cus;
        if (grid != 256) { fprintf(stderr, "kernel_launch: %d CUs (the row-group exchange of the fused post-norm epilogues assumes 256 workgroups: 4 column tiles of a token tile in one round)\n", grid); grid = -1; return; }
    }
    if (grid < 0) return;
    (void)hipMemsetAsync((char*)d_ws + WS_CTL, 0, CTL_ZERO_BYTES, stream);
    Args a{};
    for (int i = 0; i < 16; ++i) a.in[i] = (const float*)d_in[i];
    a.out = (float*)d_out; a.ws = (unsigned char*)d_ws;
#if MK_MULTI
    for (int p = 0; p < N_PHASES; ++p) { a.ph_lo = p; a.ph_hi = p + 1; hipLaunchKernelGGL(fwd_kernel, dim3(grid), dim3(NWAVES * 64), LDS_BYTES, stream, a); }
#else
    a.ph_lo = 0; a.ph_hi = N_PHASES; hipLaunchKernelGGL(fwd_kernel, dim3(grid), dim3(NWAVES * 64), LDS_BYTES, stream, a);
#endif
}
```

```cpp
#include <hip/hip_runtime.h>
#include <cstdio>
#include <cstdint>
namespace pg8 {
#define PG8_LAS __attribute__((address_space(3)))
typedef unsigned short bf16_t;
typedef short bf16x8 __attribute__((ext_vector_type(8)));
typedef float f32x4 __attribute__((ext_vector_type(4)));
typedef unsigned u32x4 __attribute__((ext_vector_type(4)));
constexpr int BM = 256, BK = 64, HALF = 128, HTB = HALF * BK * 2  , STAGE_BYTES = 8 * HTB, NXCD = 8, WGM = 4;

__host__ __device__ __forceinline__ int lds_byte(int r, int c) { const int st = (r >> 4) * 2 + (c >> 5), rr = r & 15, cc = c & 31, ob = rr * 64 + cc * 2; return st * 1024 + (ob ^ (((ob >> 9) & 1) << 5)); }
__host__ __device__ __forceinline__ void stage_rc(int b, int& R, int& C) { const int st = b / 1024, sb = b % 1024, swz = sb ^ (((sb >> 9) & 1) << 5); R = (st >> 1) * 16 + swz / 64; C = (st & 1) * 32 + (swz % 64) / 2; }
__host__ __device__ __forceinline__ int perm32(int rho) { const int n = rho >> 4, i = rho & 15; return 8 * (i >> 2) + 4 * n + (i & 3); }

struct Unit { int pm, pn; };
struct Gemm { const bf16_t* A; const bf16_t* Bt; int M, N, K; };

struct StaticOrder {
    int nM, nN, nwg, G, c;
    __host__ __device__ void init(int M, int N, int G_, int c_) { nM = M / BM; nN = N / BM; nwg = nM * nN; G = G_; c = c_; }
    __host__ __device__ bool next(int i, Unit& u) const {
        const long L = (long)i * G + c; if (L >= nwg) return false;
        int wgid = (int)L; { const int q = nwg / NXCD, r = nwg % NXCD, xcd = wgid % NXCD, off = wgid / NXCD; wgid = (xcd < r ? xcd * (q + 1) : r * (q + 1) + (xcd - r) * q) + off; }
        const int nig = WGM * nN, gid = wgid / nig, fm = gid * WGM, gsz = (nM - fm) < WGM ? (nM - fm) : WGM;
        u.pm = fm + ((wgid % nig) % gsz); u.pn = (wgid % nig) / gsz; return true;
    }
    __device__ __forceinline__ void a_ready(const Unit&) const {}
    __device__ __forceinline__ void done(const Unit&) const {}
};

__device__ __forceinline__ unsigned cvt_pk_bf16(float lo, float hi) { unsigned r; asm volatile("v_cvt_pk_bf16_f32 %0, %1, %2" : "=v"(r) : "v"(lo), "v"(hi)); return r; }
typedef float f32x2 __attribute__((ext_vector_type(2)));
__device__ __forceinline__ f32x2 gelu_pk(f32x2 v) {
    const f32x2 av = __builtin_elementwise_abs(v), d = av * 0.2316418882f + 1.0f;
    f32x2 t; t.x = __builtin_amdgcn_rcpf(d.x); t.y = __builtin_amdgcn_rcpf(d.y);
    f32x2 q = t * 0.5307027145f + (-0.7265760135f); q = q * t + 0.7107068705f; q = q * t + (-0.142248368f); q = q * t + 0.127414796f; q = q * t;
    const f32x2 s = (v * v) * (-0.72134752044f);
    f32x2 e; e.x = __builtin_amdgcn_exp2f(s.x); e.y = __builtin_amdgcn_exp2f(s.y);
    const f32x2 m = v * (q * e), r = v - m;
    f32x2 o; o.x = v.x < 0.f ? m.x : r.x; o.y = v.y < 0.f ? m.y : r.y; return o;
}

template <int ACT  > struct EpiBf16 {
    static constexpr bool PERM = true, AFTER_DRAIN = false; static_assert(ACT == 0 || ACT == 1, "EpiBf16: ACT is 0 (none) or 1 (gelu_pk)");
    bf16_t* O; int ldc; const float* bias; int split_cols; size_t split_stride; float scale0;
    __device__ __forceinline__ void operator()(const f32x4 (&acc)[2][2][4][2], const Unit& u, int wr, int wc, int fr, int fq) const {
        const int row0 = u.pm * BM + wr * 64 + fr; int colt = u.pn * BM; bf16_t* base = O;
        float sc = 1.f; if (split_cols) { const int t = colt / split_cols; base += (size_t)t * split_stride; colt -= t * split_cols; if (t == 0) sc = scale0; }
        const int col0 = colt + wc * 32 + 8 * fq, bcol0 = u.pn * BM + wc * 32 + 8 * fq;
        f32x4 bv[2][2];
#pragma unroll
        for (int bj = 0; bj < 2; ++bj)
#pragma unroll
            for (int n = 0; n < 2; ++n) bv[bj][n] = bias ? *(const f32x4*)(bias + bcol0 + bj * HALF + 4 * n) : (f32x4){0.f, 0.f, 0.f, 0.f};
#pragma unroll
        for (int ai = 0; ai < 2; ++ai)
#pragma unroll
            for (int m = 0; m < 4; ++m) { bf16_t* rowp = base + (size_t)(row0 + ai * HALF + m * 16) * ldc + col0;
#pragma unroll
                for (int bj = 0; bj < 2; ++bj) { f32x4 v0 = acc[ai][bj][m][0] + bv[bj][0], v1 = acc[ai][bj][m][1] + bv[bj][1];
                    if (ACT == 1) { f32x2 a = gelu_pk((f32x2){v0[0], v0[1]}), b = gelu_pk((f32x2){v0[2], v0[3]}), c = gelu_pk((f32x2){v1[0], v1[1]}), d = gelu_pk((f32x2){v1[2], v1[3]});
                        v0 = (f32x4){a.x, a.y, b.x, b.y}; v1 = (f32x4){c.x, c.y, d.x, d.y}; }
                    v0 = v0 * sc; v1 = v1 * sc; u32x4 w; w.x = cvt_pk_bf16(v0[0], v0[1]); w.y = cvt_pk_bf16(v0[2], v0[3]); w.z = cvt_pk_bf16(v1[0], v1[1]); w.w = cvt_pk_bf16(v1[2], v1[3]);
                    *(u32x4*)(rowp + bj * HALF) = w; } }
    }
};
template <class Epi, class Sched, bool ALIGN_EPI = false, bool SP2 = false>
__device__ __forceinline__ void gemm_phase(PG8_LAS unsigned char* lds, const Gemm g, const Sched& S, const Epi& E, int tid_in) {
    int tid_l = tid_in; asm volatile("" : "+v"(tid_l));
    const int tid = tid_l, wid = __builtin_amdgcn_readfirstlane(tid >> 6), lane = tid & 63, wr = wid >> 2, wc = wid & 3, fr = lane & 15, fq = lane >> 4;
    const int K = g.K, nt = K / BK;
    unsigned voffA[2], voffB[2];
#pragma unroll
    for (int i = 0; i < 2; ++i) { int R, C; stage_rc(tid * 16 + i * 8192, R, C); const int Rb = Epi::PERM ? ((R & ~31) + perm32(R & 31)) : R;
        voffA[i] = (unsigned)(R * K + C) * 2u; voffB[i] = (unsigned)(Rb * K + C) * 2u; }
    const size_t kstep = (size_t)(BK * 2);
    const size_t hstep = (size_t)HALF * K * 2;
    const size_t tstep = 2 * hstep;
    const unsigned ldsw = (unsigned)wid * 1024u;
    const int aoff = lds_byte(wr * 64 + fr, fq * 8), boff = lds_byte(wc * 32 + fr, fq * 8);
#define PG8_SA(b, h) (((b) * 2 + (h)) * HTB)
#define PG8_SB(b, h) ((4 + (b) * 2 + (h)) * HTB)
#define PG8_STAGE(bufoff, gbase, voff) do { _Pragma("unroll") for (int _i = 0; _i < 2; ++_i) \
        __builtin_amdgcn_global_load_lds((const unsigned*)((const char*)(gbase) + (voff)[_i]), (PG8_LAS unsigned*)(lds + (bufoff) + ldsw + _i * 8192), 16, 0, 0); } while (0)
#define PG8_LDA(dst, b, h) do { _Pragma("unroll") for (int m = 0; m < 4; ++m) _Pragma("unroll") for (int k = 0; k < 2; ++k) dst[m][k] = *(const PG8_LAS bf16x8*)(lds + PG8_SA(b, h) + aoff + m * 2048 + k * 1024); } while (0)
#define PG8_LDB(dst, b, h) do { _Pragma("unroll") for (int n = 0; n < 2; ++n) _Pragma("unroll") for (int k = 0; k < 2; ++k) dst[n][k] = *(const PG8_LAS bf16x8*)(lds + PG8_SB(b, h) + boff + n * 2048 + k * 1024); } while (0)
#define PG8_MMA(ai, bj, At, Bt) do { __builtin_amdgcn_s_setprio(1); _Pragma("unroll") for (int m = 0; m < 4; ++m) _Pragma("unroll") for (int n = 0; n < 2; ++n) _Pragma("unroll") for (int k = 0; k < 2; ++k) \
        acc[ai][bj][m][n] = __builtin_amdgcn_mfma_f32_16x16x32_bf16(Bt[n][k], At[m][k], acc[ai][bj][m][n], 0, 0, 0); __builtin_amdgcn_s_setprio(0); } while (0)
#define PG8_WAIT_V(n) asm volatile("s_waitcnt vmcnt(" #n ")" ::: "memory")
#define PG8_WAIT_L(n) asm volatile("s_waitcnt lgkmcnt(" #n ")" ::: "memory")
#define PG8_BAR __builtin_amdgcn_s_barrier()
#define PG8_SCHED __builtin_amdgcn_sched_barrier(0)
    Unit cur, nxt; int ui = 0;
    if (!S.next(0, cur)) return;
    f32x4 acc[2][2][4][2];
#pragma unroll
    for (int a = 0; a < 2; ++a)
#pragma unroll
        for (int b = 0; b < 2; ++b)
#pragma unroll
            for (int m = 0; m < 4; ++m)
#pragma unroll
                for (int n = 0; n < 2; ++n) acc[a][b][m][n] = (f32x4){0.f, 0.f, 0.f, 0.f};
    bf16x8 At[4][2], B0[2][2], B1[2][2];
    const char* cA = (const char*)g.A + (size_t)cur.pm * tstep; const char* cB = (const char*)g.Bt + (size_t)cur.pn * tstep;
    S.a_ready(cur);
    if constexpr (SP2) {
        PG8_STAGE(PG8_SB(0, 0), cB, voffB); PG8_STAGE(PG8_SB(0, 1), cB + hstep, voffB); PG8_STAGE(PG8_SA(0, 0), cA, voffA); PG8_STAGE(PG8_SA(0, 1), cA + hstep, voffA);
        if (wr == 1) PG8_BAR;
        PG8_WAIT_V(2); PG8_BAR;
        PG8_STAGE(PG8_SB(1, 0), cB + kstep, voffB); PG8_STAGE(PG8_SA(1, 0), cA + kstep, voffA); PG8_STAGE(PG8_SB(1, 1), cB + hstep + kstep, voffB);
        PG8_WAIT_V(6); PG8_BAR;
    } else {
        PG8_STAGE(PG8_SB(0, 0), cB, voffB); PG8_STAGE(PG8_SA(0, 0), cA, voffA); PG8_STAGE(PG8_SB(0, 1), cB + hstep, voffB); PG8_STAGE(PG8_SA(0, 1), cA + hstep, voffA);
        if (wr == 1) PG8_BAR;
        PG8_WAIT_V(4); PG8_BAR;
        PG8_STAGE(PG8_SB(1, 0), cB + kstep, voffB); PG8_STAGE(PG8_SA(1, 0), cA + kstep, voffA); PG8_STAGE(PG8_SB(1, 1), cB + hstep + kstep, voffB);
        PG8_WAIT_V(6); PG8_BAR;
    }
    for (;;) {
        const bool has_next = S.next(ui + 1, nxt);
        const char* nA = has_next ? (const char*)g.A + (size_t)nxt.pm * tstep : cA; const char* nB = has_next ? (const char*)g.Bt + (size_t)nxt.pn * tstep : cB;
        for (int t = 0; t < nt; t += 2) {
            const bool last = (t == nt - 2);
            const char* a1 = cA + (size_t)(t + 1) * kstep;
            const char* a2 = last ? nA : cA + (size_t)(t + 2) * kstep; const char* b2 = last ? nB : cB + (size_t)(t + 2) * kstep;
            const char* a3 = a2 + kstep; const char* b3 = b2 + kstep;
            if (last && has_next) S.a_ready(nxt);
            if constexpr (SP2) {
            PG8_LDB(B0, 0, 0); PG8_LDB(B1, 0, 1); PG8_SCHED; PG8_LDA(At, 0, 0); PG8_STAGE(PG8_SA(1, 1), a1 + hstep, voffA);
            PG8_WAIT_V(8); PG8_WAIT_L(0); PG8_BAR; PG8_MMA(0, 0, At, B0); PG8_MMA(0, 1, At, B1); PG8_BAR; PG8_SCHED;
            PG8_LDA(At, 0, 1); PG8_STAGE(PG8_SB(0, 0), b2, voffB); PG8_STAGE(PG8_SB(0, 1), b2 + hstep, voffB); PG8_STAGE(PG8_SA(0, 0), a2, voffA);
            PG8_WAIT_V(8); PG8_WAIT_L(0); PG8_BAR; PG8_MMA(1, 0, At, B0); PG8_MMA(1, 1, At, B1); PG8_BAR; PG8_SCHED;
            PG8_LDB(B0, 1, 0); PG8_LDB(B1, 1, 1); PG8_SCHED; PG8_LDA(At, 1, 0); PG8_STAGE(PG8_SA(0, 1), a2 + hstep, voffA);
            PG8_WAIT_V(8); PG8_WAIT_L(0); PG8_BAR; PG8_MMA(0, 0, At, B0); PG8_MMA(0, 1, At, B1); PG8_BAR; PG8_SCHED;
            PG8_LDA(At, 1, 1); PG8_STAGE(PG8_SB(1, 0), b3, voffB); PG8_STAGE(PG8_SB(1, 1), b3 + hstep, voffB); PG8_STAGE(PG8_SA(1, 0), a3, voffA);
            PG8_WAIT_V(8); PG8_WAIT_L(0); PG8_BAR; PG8_MMA(1, 0, At, B0); PG8_MMA(1, 1, At, B1); PG8_BAR; PG8_SCHED;
            } else {
            PG8_LDB(B0, 0, 0); PG8_SCHED; PG8_LDA(At, 0, 0); PG8_STAGE(PG8_SA(1, 1), a1 + hstep, voffA);
            PG8_WAIT_L(8); PG8_BAR; PG8_WAIT_L(0); PG8_MMA(0, 0, At, B0); PG8_BAR; PG8_SCHED;
            PG8_LDB(B1, 0, 1); PG8_STAGE(PG8_SB(0, 0), b2, voffB);
            PG8_BAR; PG8_WAIT_L(0); PG8_MMA(0, 1, At, B1); PG8_BAR;
            PG8_LDA(At, 0, 1); PG8_STAGE(PG8_SA(0, 0), a2, voffA);
            PG8_BAR; PG8_WAIT_L(0); PG8_MMA(1, 0, At, B0); PG8_BAR; PG8_SCHED;
            PG8_STAGE(PG8_SB(0, 1), b2 + hstep, voffB);
            PG8_WAIT_V(6); PG8_BAR; PG8_MMA(1, 1, At, B1); PG8_BAR;
            PG8_LDB(B0, 1, 0); PG8_SCHED; PG8_LDA(At, 1, 0); PG8_STAGE(PG8_SA(0, 1), a2 + hstep, voffA);
            PG8_WAIT_L(8); PG8_BAR; PG8_WAIT_L(0); PG8_MMA(0, 0, At, B0); PG8_BAR; PG8_SCHED;
            PG8_LDB(B1, 1, 1); PG8_STAGE(PG8_SB(1, 0), b3, voffB);
            PG8_BAR; PG8_WAIT_L(0); PG8_MMA(0, 1, At, B1); PG8_BAR;
            PG8_LDA(At, 1, 1); PG8_STAGE(PG8_SA(1, 0), a3, voffA);
            PG8_BAR; PG8_WAIT_L(0); PG8_MMA(1, 0, At, B0); PG8_BAR; PG8_SCHED;
            PG8_STAGE(PG8_SB(1, 1), b3 + hstep, voffB);
            PG8_WAIT_V(6); PG8_BAR; PG8_MMA(1, 1, At, B1); PG8_BAR;
            }
        }
        if constexpr (ALIGN_EPI) { if (wr == 0) PG8_BAR; }
        if constexpr (!Epi::AFTER_DRAIN) { E(acc, cur, wr, wc, fr, fq); S.done(cur); }
        if (!has_next) break;
#pragma unroll
        for (int a = 0; a < 2; ++a)
#pragma unroll
            for (int b = 0; b < 2; ++b)
#pragma unroll
                for (int m = 0; m < 4; ++m)
#pragma unroll
                    for (int n = 0; n < 2; ++n) acc[a][b][m][n] = (f32x4){0.f, 0.f, 0.f, 0.f};
        cur = nxt; cA = nA; cB = nB; ++ui;
        if constexpr (ALIGN_EPI) { if (wr == 1) PG8_BAR; }
    }
    PG8_WAIT_V(0);
    if constexpr (!ALIGN_EPI) { if (wr == 0) PG8_BAR; }
    PG8_BAR;
    if constexpr (Epi::AFTER_DRAIN) { E.fused(acc, cur, wr, wc, fr, fq, lds, wid, lane); S.done(cur); }
#undef PG8_SA
#undef PG8_SB
#undef PG8_STAGE
#undef PG8_LDA
#undef PG8_LDB
#undef PG8_MMA
#undef PG8_WAIT_V
#undef PG8_WAIT_L
#undef PG8_BAR
#undef PG8_SCHED
}
}

#define LAS __attribute__((address_space(3)))
#define XB_TMO      128
#define XB_XCNT(j)  (256  + 64 * (j))
#define XB_XSUB(j)  (1280 + 64 * (j))
#define XB_XGEN(j)  (2304 + 64 * (j))
#define XB_TOP      3328
#define XB_TOPGEN   3392
#define XCD_BAR_WORDS 3456
#define XB_SPIN_CAP (1u << 18)

__device__ __forceinline__ unsigned xb_ld(unsigned* p)              { return __hip_atomic_load(p, __ATOMIC_RELAXED, __HIP_MEMORY_SCOPE_AGENT); }
__device__ __forceinline__ unsigned xb_add(unsigned* p, unsigned v) { return __hip_atomic_fetch_add(p, v, __ATOMIC_RELAXED, __HIP_MEMORY_SCOPE_AGENT); }
__device__ __forceinline__ unsigned xb_xcc_id() { return (unsigned)__builtin_amdgcn_s_getreg((3 << 11) | 20) & 0xFu; }
#define XB_SPIN(cond, bar) do { unsigned _sp = 0; while (cond) { __builtin_amdgcn_s_sleep(1); \
    if ((++_sp & 255u) == 0u) { if (xb_ld(&(bar)[XB_TMO])) break; if (_sp > XB_SPIN_CAP) { atomicAdd(&(bar)[XB_TMO], 1u); break; } } } } while (0)

struct XcdBarrier {
    unsigned* bar; unsigned x;
    volatile LAS unsigned* st;
};

__device__ __forceinline__ XcdBarrier xcd_barrier_post(unsigned* bar, volatile LAS unsigned* st, bool leader) {
    XcdBarrier b; b.bar = bar; b.x = xb_xcc_id(); b.st = st;
    if (leader) (void)xb_add(&bar[XB_XCNT(b.x)], 1u);
    return b;
}
__device__ __forceinline__ void xcd_barrier_complete(unsigned* bar, unsigned x, unsigned& nloc, unsigned& nx) {
    const unsigned G = gridDim.x * gridDim.y * gridDim.z;
    unsigned sum, cnt, mine, sp = 0u;
    for (;;) {
        sum = 0u; cnt = 0u; mine = 0u;
#pragma unroll
        for (unsigned j = 0; j < 16; ++j) { const unsigned c = xb_ld(&bar[XB_XCNT(j)]); sum += c; cnt += (c > 0u) ? 1u : 0u; mine = (j == x) ? c : mine; }
        if (sum == G) break;
        __builtin_amdgcn_s_sleep(1);
        if ((++sp & 255u) == 0u) { if (xb_ld(&bar[XB_TMO])) break; if (sp > XB_SPIN_CAP) { atomicAdd(&bar[XB_TMO], 1u); break; } }
    }
    nloc = mine > 0u ? mine : 1u; nx = cnt > 0u ? cnt : 1u;
}

__device__ __forceinline__ void xcd_barrier(const XcdBarrier& b, bool leader) {
    asm volatile("s_waitcnt vmcnt(0)" ::: "memory");
    __syncthreads();
    if (leader) {
        unsigned* bar = b.bar;
        __builtin_amdgcn_s_waitcnt(0);
        unsigned nloc = b.st[0], nx = b.st[1];
        if (nloc == 0u) { xcd_barrier_complete(bar, b.x, nloc, nx); b.st[0] = nloc; b.st[1] = nx; }
        const unsigned old = xb_add(&bar[XB_XSUB(b.x)], 1u);
        const unsigned gen = old / nloc;
        if (old + 1u == (gen + 1u) * nloc) {
            __builtin_amdgcn_fence(__ATOMIC_RELEASE, "agent");
            asm volatile("s_waitcnt vmcnt(0)" ::: "memory");
            const unsigned og = xb_add(&bar[XB_TOP], 1u);
            const unsigned tg = og / nx;
            if (og + 1u == (tg + 1u) * nx) xb_add(&bar[XB_TOPGEN], 1u);
            else XB_SPIN(xb_ld(&bar[XB_TOPGEN]) == tg, bar);
            __builtin_amdgcn_fence(__ATOMIC_ACQUIRE, "agent");
            xb_add(&bar[XB_XGEN(b.x)], 1u);
            asm volatile("s_waitcnt vmcnt(0)" ::: "memory");
        } else {
            XB_SPIN(xb_ld(&bar[XB_XGEN(b.x)]) == gen, bar);
            __builtin_amdgcn_fence(__ATOMIC_ACQUIRE, "agent");
            asm volatile("s_waitcnt vmcnt(0)" ::: "memory");
        }
    }
    __syncthreads();
}

constexpr int BATCH = 16, SEQ = 2048, DM = 1024, MTOK = BATCH * SEQ, FF = 2816, NGU = 2 * FF, NINP = 3584, INCOLS = 3360, DEPTH = 2;
constexpr int NWAVES = 8;
constexpr float EPS = 1e-6f;
typedef unsigned short bf16;
typedef unsigned v4u __attribute__((ext_vector_type(4)));
typedef unsigned v2u __attribute__((ext_vector_type(2)));
typedef float f32x4 __attribute__((ext_vector_type(4)));
#define LDS_WAIT() asm volatile("s_waitcnt lgkmcnt(0)" ::: "memory")

constexpr size_t MiB = 1u << 20;
constexpr size_t WS_CTL = 0, CTL_ZERO_BYTES = 160 * 1024;
constexpr size_t WS_TAB = 1 * MiB;
constexpr size_t TAB_COS = 0, TAB_SIN = 65536, TAB_B1 = 131072, TAB_W2T = 196608, TAB_SS2 = 262144;
constexpr size_t WS_W = 2 * MiB;
constexpr size_t WO_GU1 = 0, WO_DN1 = 11 * MiB, WO_GU2 = 16 * MiB + MiB / 2, WO_DN2 = 27 * MiB + MiB / 2, WO_IN = 33 * MiB, WO_OUT = 40 * MiB, WO_CMP = 42 * MiB;
constexpr size_t WS_X16 = 45 * MiB;
constexpr size_t WS_U = 109 * MiB;
constexpr size_t WS_HB = 173 * MiB;
constexpr size_t WS_HD = 349 * MiB;
constexpr size_t WS_PQ = 413 * MiB;
constexpr size_t WS_CC = 421 * MiB;
constexpr size_t WS_END = 422 * MiB;
constexpr size_t WS_QN = 173 * MiB, WS_KCR = 205 * MiB, WS_VCR = 213 * MiB, WS_KS = 221 * MiB, WS_VS = 229 * MiB, WS_KW = 237 * MiB, WS_VW = 245 * MiB;
constexpr size_t WS_MQ = 253 * MiB, WS_MK = 285 * MiB, WS_MV = 317 * MiB, WS_MO = 349 * MiB, WS_GATE = 381 * MiB;
static_assert(WS_GATE + 4 * MiB <= WS_PQ, "in-projection outputs end below PQ");
constexpr int CW_BAR = 4096, CW_QUEUE = 16384, CW_GRP = 20480;
constexpr size_t WS_PART = 486 * MiB, WS_CMPW = 489 * MiB, WS_END3 = 491 * MiB;
static_assert((CW_QUEUE + 2 * 1024) <= CW_GRP && (CW_GRP + 6 * 128 * 16) * 4 <= (int)CTL_ZERO_BYTES && (CW_BAR + 3456) <= CW_QUEUE && WS_TAB + TAB_SS2 + 16 * 32768 <= WS_W, "control words inside the zeroed region");
constexpr int PH_BYTES = 143360, MISC_OFF = PH_BYTES, LDS_BYTES = 147456;

__device__ __forceinline__ unsigned f2bf(float f) { unsigned u = __builtin_bit_cast(unsigned, f); return (u + 0x7fffu + ((u >> 16) & 1u)) >> 16; }
__device__ __forceinline__ unsigned pk2(float lo, float hi) { return f2bf(lo) | (f2bf(hi) << 16); }
typedef float f32x2v_ __attribute__((ext_vector_type(2))); typedef __bf16 bf16x2v_ __attribute__((ext_vector_type(2)));
__device__ __forceinline__ unsigned cvtpk(float lo, float hi) { f32x2v_ v = {lo, hi}; bf16x2v_ b = __builtin_convertvector(v, bf16x2v_); return __builtin_bit_cast(unsigned, b); }
__device__ __forceinline__ float bflo(unsigned u) { return __builtin_bit_cast(float, u << 16); }
__device__ __forceinline__ float bfhi(unsigned u) { return __builtin_bit_cast(float, u & 0xffff0000u); }
__device__ __forceinline__ float bf2f(bf16 b) { return __builtin_bit_cast(float, (unsigned)b << 16); }
__device__ __forceinline__ float sigmoidf_(float x) { return __builtin_amdgcn_rcpf(1.f + __expf(-x)); }
__device__ __forceinline__ int fresh_lane() { unsigned z = 0u; asm volatile("" : "+v"(z)); return (int)__builtin_amdgcn_mbcnt_hi(~0u, __builtin_amdgcn_mbcnt_lo(~0u, z)); }
__device__ __forceinline__ float shx(float v, int mask, int lane) { return __builtin_bit_cast(float, __builtin_amdgcn_ds_bpermute((lane ^ mask) << 2, __builtin_bit_cast(int, v))); }
__device__ __forceinline__ unsigned shxu(unsigned v, int mask, int lane) { return (unsigned)__builtin_amdgcn_ds_bpermute((lane ^ mask) << 2, (int)v); }
__device__ __forceinline__ float shi(float v, int src) { return __builtin_bit_cast(float, __builtin_amdgcn_ds_bpermute(src << 2, __builtin_bit_cast(int, v))); }
__device__ __forceinline__ float wave_sum(float v, int lane) {
    (void)lane;
    v += __builtin_bit_cast(float, __builtin_amdgcn_update_dpp(0, __builtin_bit_cast(int, v), 0xB1, 0xF, 0xF, false));
    v += __builtin_bit_cast(float, __builtin_amdgcn_update_dpp(0, __builtin_bit_cast(int, v), 0x4E, 0xF, 0xF, false));
    v += __builtin_bit_cast(float, __builtin_amdgcn_update_dpp(0, __builtin_bit_cast(int, v), 0x124, 0xF, 0xF, false));
    v += __builtin_bit_cast(float, __builtin_amdgcn_update_dpp(0, __builtin_bit_cast(int, v), 0x128, 0xF, 0xF, false));
    const int iv = __builtin_bit_cast(int, v);
    const float a = __builtin_bit_cast(float, __builtin_amdgcn_readlane(iv, 0)), b = __builtin_bit_cast(float, __builtin_amdgcn_readlane(iv, 16));
    const float c = __builtin_bit_cast(float, __builtin_amdgcn_readlane(iv, 32)), d = __builtin_bit_cast(float, __builtin_amdgcn_readlane(iv, 48));
    return (a + b) + (c + d);
}

struct SrcGU { const float* W; const float* g; __device__ __forceinline__ float operator()(int k, int nd) const { const int pn = nd >> 8, r = nd & 255; const int col = (r < 128) ? (pn * 128 + r) : (FF + pn * 128 + r - 128); return W[(size_t)k * NGU + col] * g[k]; } };
struct SrcPlain { const float* W; int N; __device__ __forceinline__ float operator()(int k, int nd) const { return W[(size_t)k * N + nd]; } };
struct SrcIN { const float* W; const float* g; __device__ __forceinline__ float operator()(int k, int nd) const {
    const int col = nd < 1280 ? nd : (nd < 3328 ? nd + 24 : (nd < 3352 ? nd - 3328 + 1280 : (nd < 3360 ? nd : -1)));
    return col < 0 ? 0.f : W[(size_t)k * INCOLS + col] * g[k]; } };
struct SrcCMP { const float* W1; __device__ __forceinline__ float operator()(int k, int nd) const { const int kv = nd >> 8, r = nd & 255;
    return r < 128 ? W1[((size_t)kv * 2048 + k) * 128 + r] : W1[((size_t)kv * 2048 + 1024 + k) * 128 + r - 128]; } };

template <class SrcF>
__device__ __forceinline__ void transpose_item(const SrcF& src, int K, bf16* WT, LAS float* scr, int kb, int nb, int lane) {
    const int k0 = 64 * kb, n0 = 32 * nb;
#pragma unroll 8
    for (int i = 0; i < 32; ++i) { const int kk = 2 * i + (lane >> 5); scr[kk * 33 + (lane & 31)] = src(k0 + kk, n0 + (lane & 31)); }
    LDS_WAIT(); asm volatile("" ::: "memory");
    const int c = lane & 7;
#pragma unroll
    for (int j = 0; j < 4; ++j) { const int n = (lane >> 3) + 8 * j; const LAS float* s = scr + (8 * c) * 33 + n;
        v4u o; o.x = pk2(s[0 * 33], s[1 * 33]); o.y = pk2(s[2 * 33], s[3 * 33]); o.z = pk2(s[4 * 33], s[5 * 33]); o.w = pk2(s[6 * 33], s[7 * 33]);
        *(v4u*)(WT + (size_t)(n0 + n) * K + k0 + 8 * c) = o; }
    LDS_WAIT(); asm volatile("" ::: "memory");
}

template <int MODE>
__device__ __forceinline__ void thin_phase(const bf16* HD, const float* xin_f32, bf16* X16, float* out_f32, float* R2, const float* gpost, float cc, int gw, int NGW, int lane) {
    f32x4 gp[4];
#pragma unroll
    for (int j = 0; j < 4; ++j) gp[j] = (MODE != 0) ? *(const f32x4*)(gpost + 4 * lane + 256 * j) : (f32x4){0.f, 0.f, 0.f, 0.f};
    f32x4 xf[4]; v2u xn[4], hn[4];
    if (gw < MTOK) {
#pragma unroll
        for (int j = 0; j < 4; ++j) { if (MODE == 0) xf[j] = *(const f32x4*)(xin_f32 + (size_t)gw * DM + 4 * lane + 256 * j);
            else { xn[j] = *(const v2u*)(X16 + (size_t)gw * DM + 4 * lane + 256 * j); hn[j] = *(const v2u*)(HD + (size_t)gw * DM + 4 * lane + 256 * j); } }
    }
    for (int m = gw; m < MTOK; m += NGW) {
        f32x4 x[4]; v2u hw[4];
#pragma unroll
        for (int j = 0; j < 4; ++j) { if (MODE == 0) x[j] = xf[j]; else { x[j] = (f32x4){bflo(xn[j].x), bfhi(xn[j].x), bflo(xn[j].y), bfhi(xn[j].y)}; hw[j] = hn[j]; } }
        const int m2 = m + NGW;
        if (m2 < MTOK) {
#pragma unroll
            for (int j = 0; j < 4; ++j) { if (MODE == 0) xf[j] = *(const f32x4*)(xin_f32 + (size_t)m2 * DM + 4 * lane + 256 * j);
                else { xn[j] = *(const v2u*)(X16 + (size_t)m2 * DM + 4 * lane + 256 * j); hn[j] = *(const v2u*)(HD + (size_t)m2 * DM + 4 * lane + 256 * j); } }
        }
        if (MODE != 0) {
            f32x4 h[4]; float ss = 0.f;
#pragma unroll
            for (int j = 0; j < 4; ++j) { h[j] = (f32x4){bflo(hw[j].x), bfhi(hw[j].x), bflo(hw[j].y), bfhi(hw[j].y)}; ss += (h[j].x * h[j].x + h[j].y * h[j].y) + (h[j].z * h[j].z + h[j].w * h[j].w); }
            const float r = cc * __frsqrt_rn(wave_sum(ss, lane) * (1.f / DM) + EPS);
#pragma unroll
            for (int j = 0; j < 4; ++j) x[j] = x[j] + (h[j] * r) * gp[j];
        }
        if (MODE == 2) {
#pragma unroll
            for (int j = 0; j < 4; ++j) *(f32x4*)(out_f32 + (size_t)m * DM + 4 * lane + 256 * j) = x[j];
        } else {
            float s2 = 0.f;
#pragma unroll
            for (int j = 0; j < 4; ++j) { s2 += (x[j].x * x[j].x + x[j].y * x[j].y) + (x[j].z * x[j].z + x[j].w * x[j].w);
                v2u w; w.x = cvtpk(x[j].x, x[j].y); w.y = cvtpk(x[j].z, x[j].w); *(v2u*)(X16 + (size_t)m * DM + 4 * lane + 256 * j) = w; }
            const float st = wave_sum(s2, lane);
            if (lane == 0) *(f32x4*)(R2 + (size_t)m * 4) = (f32x4){st, 0.f, 0.f, 0.f};
        }
    }
}

struct EpiSwiglu {
    static constexpr bool PERM = true, AFTER_DRAIN = false;
    bf16* H; const float* SS2;
    __device__ __forceinline__ void operator()(const pg8::f32x4 (&acc)[2][2][4][2], const pg8::Unit& u, int wr, int wc, int fr, int fq) const {
        float rsv[2][4];
#pragma unroll
        for (int ai = 0; ai < 2; ++ai)
#pragma unroll
            for (int m = 0; m < 4; ++m) { const f32x4 p = *(const f32x4*)(SS2 + (size_t)(u.pm * 256 + ai * 128 + wr * 64 + m * 16 + fr) * 4); rsv[ai][m] = __frsqrt_rn(((p.x + p.y) + (p.z + p.w)) * (1.f / DM) + EPS); }
#pragma unroll
        for (int ai = 0; ai < 2; ++ai)
#pragma unroll
            for (int m = 0; m < 4; ++m) {
                const int row = u.pm * 256 + ai * 128 + wr * 64 + m * 16 + fr; const float rs = rsv[ai][m];
                typedef float f2 __attribute__((ext_vector_type(2)));
                f2 tg[4], tu[4], ex[4]; float o[8];
#pragma unroll
                for (int n = 0; n < 2; ++n) { const pg8::f32x4 g4 = acc[ai][0][m][n], u4 = acc[ai][1][m][n];
                    tg[2 * n] = (f2){g4[0], g4[1]} * rs; tg[2 * n + 1] = (f2){g4[2], g4[3]} * rs; tu[2 * n] = (f2){u4[0], u4[1]} * rs; tu[2 * n + 1] = (f2){u4[2], u4[3]} * rs; }
#pragma unroll
                for (int e = 0; e < 4; ++e) { const f2 a2 = tg[e] * -1.4426950408889634f; ex[e].x = __builtin_amdgcn_exp2f(a2.x); ex[e].y = __builtin_amdgcn_exp2f(a2.y); }
#pragma unroll
                for (int e = 0; e < 4; ++e) { const f2 d2 = ex[e] + 1.0f; ex[e].x = __builtin_amdgcn_rcpf(d2.x); ex[e].y = __builtin_amdgcn_rcpf(d2.y); tu[e] = tg[e] * tu[e]; }
#pragma unroll
                for (int e = 0; e < 4; ++e) { const f2 r2 = tu[e] * ex[e]; o[2 * e] = r2.x; o[2 * e + 1] = r2.y; }
                v4u w; w.x = pg8::cvt_pk_bf16(o[0], o[1]); w.y = pg8::cvt_pk_bf16(o[2], o[3]); w.z = pg8::cvt_pk_bf16(o[4], o[5]); w.w = pg8::cvt_pk_bf16(o[6], o[7]);
                *(v4u*)(H + (size_t)row * FF + u.pn * 128 + wc * 32 + fq * 8) = w;
            }
    }
};
#define EPI_LBAR() do { asm volatile("s_waitcnt lgkmcnt(0)" ::: "memory"); __builtin_amdgcn_s_barrier(); } while (0)
template <bool FINAL>
struct EpiResNorm {
    static constexpr bool PERM = true, AFTER_DRAIN = false;
    unsigned char* ws; LAS float* red; const float* gpost; float* outf; float cc; int inst;
    __device__ __forceinline__ void operator()(const pg8::f32x4 (&acc)[2][2][4][2], const pg8::Unit& u, int wr, int wc, int fr_, int fq_) const {
        int fr = fr_, fq = fq_;
        bf16* X16 = (bf16*)(ws + WS_X16);
        const int ln = fresh_lane(), wv = wr * 4 + wc, tid = wv * 64 + ln; fr = ln & 15; fq = ln >> 4;
        const int r0 = u.pm * 256 + wr * 64 + fr, c0 = u.pn * 256 + wc * 32 + fq * 8;
        v4u xv[2][4][2];
        if (wv != 0) {
#pragma unroll
            for (int ai = 0; ai < 2; ++ai)
#pragma unroll
                for (int m = 0; m < 4; ++m)
#pragma unroll
                    for (int bj = 0; bj < 2; ++bj) xv[ai][m][bj] = *(const v4u*)(X16 + (size_t)(r0 + ai * 128 + m * 16) * DM + c0 + bj * 128);
        }
        if (tid >= 256) red[1280 + tid - 256] = gpost[u.pn * 256 + tid - 256];
#pragma unroll
        for (int ai = 0; ai < 2; ++ai)
#pragma unroll
            for (int m = 0; m < 4; ++m) { float s = 0.f;
#pragma unroll
                for (int bj = 0; bj < 2; ++bj)
#pragma unroll
                    for (int n = 0; n < 2; ++n) { const pg8::f32x4 a = acc[ai][bj][m][n]; s += (a[0] * a[0] + a[1] * a[1]) + (a[2] * a[2] + a[3] * a[3]); }
                s += shx(s, 16, ln); s += shx(s, 32, ln);
                if (fq == 0) red[wc * 256 + ai * 128 + wr * 64 + m * 16 + fr] = s; }
        EPI_LBAR();
        if (wv == 0) {
            unsigned* ctr = (unsigned*)(ws + WS_CTL) + CW_GRP + (inst * 128 + u.pm) * 16;
            unsigned* part = (unsigned*)(ws + WS_PART) + (size_t)inst * 4 * MTOK + u.pm * 256 + 4 * ln;
            const f32x4 p0 = *(const LAS f32x4*)(red + 4 * ln), p1 = *(const LAS f32x4*)(red + 256 + 4 * ln), p2 = *(const LAS f32x4*)(red + 512 + 4 * ln), p3 = *(const LAS f32x4*)(red + 768 + 4 * ln);
            const f32x4 ps = (p0 + p1) + (p2 + p3);
            unsigned* mine = part + (size_t)u.pn * MTOK;
            asm volatile("global_store_dwordx4 %0, %1, off sc1\n\ts_waitcnt vmcnt(0)" :: "v"(mine), "v"(ps) : "memory");
            if (ln == 0) { (void)__hip_atomic_fetch_add(ctr, 1u, __ATOMIC_RELAXED, __HIP_MEMORY_SCOPE_AGENT);
                unsigned sp = 0u; while (__hip_atomic_load(ctr, __ATOMIC_RELAXED, __HIP_MEMORY_SCOPE_AGENT) < 4u) { __builtin_amdgcn_s_sleep(1); if (++sp > (1u << 22)) break; } }
            asm volatile("" ::: "memory");
            f32x4 q0, q1, q2, q3;
            asm volatile("global_load_dwordx4 %0, %4, off sc1\n\tglobal_load_dwordx4 %1, %5, off sc1\n\tglobal_load_dwordx4 %2, %6, off sc1\n\tglobal_load_dwordx4 %3, %7, off sc1\n\ts_waitcnt vmcnt(0)"
                         : "=&v"(q0), "=&v"(q1), "=&v"(q2), "=&v"(q3) : "v"(part), "v"(part + MTOK), "v"(part + 2 * (size_t)MTOK), "v"(part + 3 * (size_t)MTOK) : "memory");
            const f32x4 t = ((q0 + q1) + (q2 + q3)) * (1.f / DM) + EPS;
            *(LAS f32x4*)(red + 1024 + 4 * ln) = (f32x4){cc * __frsqrt_rn(t.x), cc * __frsqrt_rn(t.y), cc * __frsqrt_rn(t.z), cc * __frsqrt_rn(t.w)};
#pragma unroll
            for (int ai = 0; ai < 2; ++ai)
#pragma unroll
                for (int m = 0; m < 4; ++m)
#pragma unroll
                    for (int bj = 0; bj < 2; ++bj) xv[ai][m][bj] = *(const v4u*)(X16 + (size_t)(r0 + ai * 128 + m * 16) * DM + c0 + bj * 128);
        }
        EPI_LBAR();
#pragma unroll
        for (int ai = 0; ai < 2; ++ai)
#pragma unroll
            for (int m = 0; m < 4; ++m) { const float inv = red[1024 + ai * 128 + wr * 64 + m * 16 + fr]; float s = 0.f; const size_t rowo = (size_t)(r0 + ai * 128 + m * 16) * DM + c0;
                asm volatile("" ::: "memory");
#pragma unroll
                for (int bj = 0; bj < 2; ++bj) { const v4u xw = xv[ai][m][bj]; const LAS float* gl = red + 1280 + bj * 128 + wc * 32 + fq * 8; const f32x4 gv0 = *(const LAS f32x4*)gl, gv1 = *(const LAS f32x4*)(gl + 4);
                    f32x4 x0 = (f32x4){bflo(xw.x), bfhi(xw.x), bflo(xw.y), bfhi(xw.y)}, x1 = (f32x4){bflo(xw.z), bfhi(xw.z), bflo(xw.w), bfhi(xw.w)};
                    x0 = x0 + (acc[ai][bj][m][0] * inv) * gv0; x1 = x1 + (acc[ai][bj][m][1] * inv) * gv1;
                    if (FINAL) { float* op = outf + rowo + bj * 128; *(f32x4*)op = x0; *(f32x4*)(op + 4) = x1; }
                    else { s += ((x0.x * x0.x + x0.y * x0.y) + (x0.z * x0.z + x0.w * x0.w)) + ((x1.x * x1.x + x1.y * x1.y) + (x1.z * x1.z + x1.w * x1.w));
                        v4u w; w.x = pg8::cvt_pk_bf16(x0.x, x0.y); w.y = pg8::cvt_pk_bf16(x0.z, x0.w); w.z = pg8::cvt_pk_bf16(x1.x, x1.y); w.w = pg8::cvt_pk_bf16(x1.z, x1.w);
                        *(v4u*)(X16 + rowo + bj * 128) = w; } }
                if (!FINAL) { s += shx(s, 16, ln); s += shx(s, 32, ln); if (fq == 0) red[wc * 256 + ai * 128 + wr * 64 + m * 16 + fr] = s; } }
        if (!FINAL) {
            EPI_LBAR();
            if (tid < 256) ((float*)(ws + WS_TAB + TAB_SS2))[(size_t)(u.pm * 256 + tid) * 4 + u.pn] = (red[tid] + red[256 + tid]) + (red[512 + tid] + red[768 + tid]);
        }
    }
};
struct EpiCmpMlp {
    static constexpr bool PERM = true, AFTER_DRAIN = true;
    unsigned char* ws; const float* b1; const bf16* w2t;
    __device__ __forceinline__ void operator()(const pg8::f32x4 (&)[2][2][4][2], const pg8::Unit&, int, int, int, int) const {}
    __device__ __forceinline__ void fused(const pg8::f32x4 (&acc)[2][2][4][2], const pg8::Unit& u, int wr, int wc, int fr_, int fq_, LAS unsigned char* lds, int wid, int lane_) const {
        (void)fr_; (void)fq_; (void)lane_;
        const int ln = fresh_lane(), fr = ln & 15, fq = ln >> 4, kv = u.pm >> 4;
        pg8::bf16x8 xf[4][4];
        { const bf16* wp = w2t + (size_t)kv * 64 * 128 + fr * 128 + fq * 8;
#pragma unroll
          for (int ib = 0; ib < 4; ++ib)
#pragma unroll
              for (int ks = 0; ks < 4; ++ks) xf[ib][ks] = *(const pg8::bf16x8*)(wp + ib * 16 * 128 + ks * 32); }
        f32x4 bb[2];
#pragma unroll
        for (int n = 0; n < 2; ++n) bb[n] = *(const f32x4*)(b1 + kv * 128 + wc * 32 + fq * 8 + 4 * n);
#pragma unroll
        for (int ai = 0; ai < 2; ++ai)
#pragma unroll
            for (int m = 0; m < 4; ++m) { const int row = ai * 128 + wr * 64 + m * 16 + fr;
#pragma unroll
                for (int n = 0; n < 2; ++n) *(LAS f32x4*)(lds + row * 512 + (((wc * 8 + fq * 2 + n) ^ (row & 15)) << 4)) = acc[ai][1][m][n]; }
        EPI_LBAR();
        v4u hv[2][4];
#pragma unroll
        for (int ai = 0; ai < 2; ++ai)
#pragma unroll
            for (int m = 0; m < 4; ++m) { const int row = ai * 128 + wr * 64 + m * 16 + fr, rn = (row < 255) ? row + 1 : 255; float h[8];
#pragma unroll
                for (int n = 0; n < 2; ++n) { const f32x4 q = *(const LAS f32x4*)(lds + rn * 512 + (((wc * 8 + fq * 2 + n) ^ (rn & 15)) << 4)); const f32x4 v = acc[ai][0][m][n] + q + bb[n];
#pragma unroll
                    for (int e = 0; e < 4; ++e) { const float x = v[e], t = x * (1.f + 0.044715f * x * x) * (-2.f * 0.7978845608028654f * 1.4426950408889634f);
                        h[4 * n + e] = ((row & 127) == 127) ? 0.f : x * __builtin_amdgcn_rcpf(1.f + __builtin_amdgcn_exp2f(t)); } }
                hv[ai][m] = (v4u){cvtpk(h[0], h[1]), cvtpk(h[2], h[3]), cvtpk(h[4], h[5]), cvtpk(h[6], h[7])}; }
        EPI_LBAR();
#pragma unroll
        for (int ai = 0; ai < 2; ++ai)
#pragma unroll
            for (int m = 0; m < 4; ++m) { const int row = ai * 128 + wr * 64 + m * 16 + fr; *(LAS v4u*)(lds + row * 256 + (((wc * 4 + fq) ^ (row & 15)) << 4)) = hv[ai][m]; }
        EPI_LBAR();
        bf16* CC = (bf16*)(ws + WS_CC);
#pragma unroll
        for (int jj = 0; jj < 2; ++jj) { const int row = (2 * wid + jj) * 16 + fr; pg8::f32x4 o[4];
#pragma unroll
            for (int ib = 0; ib < 4; ++ib) o[ib] = (pg8::f32x4){0.f, 0.f, 0.f, 0.f};
#pragma unroll
            for (int ks = 0; ks < 4; ++ks) { const pg8::bf16x8 y = *(const LAS pg8::bf16x8*)(lds + row * 256 + (((ks * 4 + fq) ^ (row & 15)) << 4));
#pragma unroll
                for (int ib = 0; ib < 4; ++ib) o[ib] = __builtin_amdgcn_mfma_f32_16x16x32_bf16(xf[ib][ks], y, o[ib], 0, 0, 0); }
            bf16* cp = CC + ((size_t)u.pm * 256 + row) * 64 + 4 * fq;
#pragma unroll
            for (int ib = 0; ib < 4; ++ib) { v2u w; w.x = cvtpk(o[ib][0], o[ib][1]); w.y = cvtpk(o[ib][2], o[ib][3]); *(v2u*)(cp + ib * 16) = w; } }
    }
};
struct CmpOrder {
    int c, G;
    __device__ __forceinline__ bool next(int i, pg8::Unit& u) const { const int idx = i * G + c; if (idx >= 32) return false; u.pm = idx; u.pn = idx >> 4; return true; }
    __device__ __forceinline__ void a_ready(const pg8::Unit&) const {}
    __device__ __forceinline__ void done(const pg8::Unit&) const {}
};
struct EpiInProj {
    static constexpr bool PERM = true, AFTER_DRAIN = false;
    unsigned char* ws;
    __device__ __forceinline__ void operator()(const pg8::f32x4 (&acc)[2][2][4][2], const pg8::Unit& u, int wr, int wc, int fr, int fq) const {
        const int pn = u.pn;
        const float* cosT = (const float*)(ws + WS_TAB + TAB_COS); const float* sinT = (const float*)(ws + WS_TAB + TAB_SIN);
        const bool ropet = (pn < 2) || (pn == 3) || (pn == 4);
        const bool ropew = ropet && ((wc & 1) == 0);
        float rsv[2][4];
#pragma unroll
        for (int ai = 0; ai < 2; ++ai)
#pragma unroll
            for (int m = 0; m < 4; ++m) { const f32x4 p = *(const f32x4*)((const float*)(ws + WS_TAB + TAB_SS2) + (size_t)(u.pm * 256 + ai * 128 + wr * 64 + m * 16 + fr) * 4); rsv[ai][m] = __frsqrt_rn(((p.x + p.y) + (p.z + p.w)) * (1.f / DM) + EPS); }
#pragma unroll
        for (int ai = 0; ai < 2; ++ai)
#pragma unroll
            for (int m = 0; m < 4; ++m) {
                const int row = u.pm * 256 + ai * 128 + wr * 64 + m * 16 + fr;
                const int b = row >> 11, t = row & 2047; const float rs = rsv[ai][m];
                f32x4 c0, c1, s0, s1;
                if (ropew) {
                    const float tf = (float)t; float cs_[8], sn_[8];
                    const float ifr[8] = {1.5915494309e-01f, 3.0863763405e-02f, 5.9851857127e-03f, 1.1606636412e-03f, 2.2507907904e-04f, 4.3647952793e-05f, 8.4643308082e-06f, 1.6414262628e-06f};
#pragma unroll
                    for (int e = 0; e < 8; ++e) { const float rv = __builtin_amdgcn_fractf(tf * ifr[e]); cs_[e] = __builtin_amdgcn_cosf(rv); sn_[e] = __builtin_amdgcn_sinf(rv); }
                    c0 = (f32x4){cs_[0], cs_[1], cs_[2], cs_[3]}; c1 = (f32x4){cs_[4], cs_[5], cs_[6], cs_[7]}; s0 = (f32x4){sn_[0], sn_[1], sn_[2], sn_[3]}; s1 = (f32x4){sn_[4], sn_[5], sn_[6], sn_[7]}; }
#pragma unroll
                for (int bj = 0; bj < 2; ++bj) {
                    f32x4 v0 = acc[ai][bj][m][0] * rs, v1 = acc[ai][bj][m][1] * rs;
                    const int cl = bj * 128 + wc * 32 + fq * 8;
                    if (ropew && (pn < 2 || bj == 0)) {
                        f32x4 p0, p1; const int ln = fq * 16 + fr;
                        p0.x = shx(v0.x, 16, ln); p0.y = shx(v0.y, 16, ln); p0.z = shx(v0.z, 16, ln); p0.w = shx(v0.w, 16, ln);
                        p1.x = shx(v1.x, 16, ln); p1.y = shx(v1.y, 16, ln); p1.z = shx(v1.z, 16, ln); p1.w = shx(v1.w, 16, ln);
                        const float sg = (fq == 0) ? -1.f : 1.f;
                        if (fq < 2) { v0 = v0 * c0 + (p0 * s0) * sg; v1 = v1 * c1 + (p1 * s1) * sg; }
                    }
                    if (pn < 2) { v0 = v0 * 0.18033688011112042f; v1 = v1 * 0.18033688011112042f; }
                    if (pn == 13) { if (cl < 32) { float* p = (float*)(ws + WS_GATE) + (size_t)row * 32 + cl; *(f32x4*)p = v0; *(f32x4*)(p + 4) = v1; } }
                    else {
                        size_t off;
                        if (pn < 2) off = WS_QN + ((size_t)row * 512 + pn * 256 + cl) * 2;
                        else if (pn < 5) { const int g = wc >> 1, d = (wc & 1) * 32 + fq * 8; off = WS_KCR + (size_t)((pn - 2) * 2 + bj) * (8 * MiB) + (((size_t)(b * 2 + g) * SEQ + t) * 64 + d) * 2; }
                        else { const int q = pn - 5; off = WS_MQ + (size_t)(q >> 1) * (32 * MiB) + ((size_t)row * 512 + (q & 1) * 256 + cl) * 2; }
                        v4u w; w.x = pg8::cvt_pk_bf16(v0.x, v0.y); w.y = pg8::cvt_pk_bf16(v0.z, v0.w); w.z = pg8::cvt_pk_bf16(v1.x, v1.y); w.w = pg8::cvt_pk_bf16(v1.z, v1.w);
                        *(v4u*)(ws + off) = w;
                    }
                }
            }
    }
};
static_assert(WS_VCR == WS_KCR + 8 * MiB && WS_KS == WS_KCR + 16 * MiB && WS_VS == WS_KCR + 24 * MiB && WS_KW == WS_KCR + 32 * MiB && WS_VW == WS_KCR + 40 * MiB, "kv buffers are 8 MiB apart in (pn, bj) order");
static_assert(WS_MK == WS_MQ + 32 * MiB && WS_MV == WS_MQ + 64 * MiB && WS_MO == WS_MQ + 96 * MiB, "mLSTM buffers are 32 MiB apart");

struct MixPtrs { unsigned char* ws; const float *conv_w, *conv_b, *i_bias, *f_bias, *mnorm_g; };
#define MP_QN ((const bf16*)(P.ws + WS_QN))
#define MP_KS ((const bf16*)(P.ws + WS_KS))
#define MP_VS ((const bf16*)(P.ws + WS_VS))
#define MP_KW ((const bf16*)(P.ws + WS_KW))
#define MP_VW ((const bf16*)(P.ws + WS_VW))
#define MP_KC ((const bf16*)(P.ws + WS_CC))
#define MP_VC ((const bf16*)(P.ws + WS_CC) + (size_t)4096 * 64)
#define MP_MQ ((const bf16*)(P.ws + WS_MQ))
#define MP_MK ((const bf16*)(P.ws + WS_MK))
#define MP_MV ((const bf16*)(P.ws + WS_MV))
#define MP_MO ((const bf16*)(P.ws + WS_MO))
#define MP_GATE ((const float*)(P.ws + WS_GATE))
#define MP_Y ((bf16*)(P.ws + WS_U))


typedef float f32x16 __attribute__((ext_vector_type(16)));
typedef short bf16x8v __attribute__((ext_vector_type(8)));
typedef short s16x4v __attribute__((ext_vector_type(4)));
typedef float f32x2v __attribute__((ext_vector_type(2)));
typedef __bf16 bf16x2v __attribute__((ext_vector_type(2)));
#define MFMA32(a, b, c) __builtin_amdgcn_mfma_f32_32x32x16_bf16((a), (b), (c), 0, 0, 0)
__device__ __forceinline__ s16x4v tr_read(const LAS unsigned char* p) { return __builtin_bit_cast(s16x4v, __builtin_amdgcn_ds_read_tr16_b64_v4i16((LAS s16x4v*)p)); }
__device__ __forceinline__ int tile_off(int key, int ch8) { return (ch8 >> 2) * 4096 + key * 64 + (((ch8 & 3) ^ ((key >> 2) & 3)) << 4); }
constexpr int NM_SLOT = 0, NM_IMP = 65536, NM_IMS = 99328, NM_SEL = 108544, NM_ITEM = 108864;
constexpr float QK_SCALE = 0.125f * 1.4426950408889634f;

#define SBAR() __builtin_amdgcn_sched_barrier(0)
__device__ __forceinline__ void xor32_pair(float v, float& lo, float& hi) { float a = v, b = v; asm volatile("s_nop 1\n\tv_permlane32_swap_b32 %0, %1" : "+v"(a), "+v"(b)); lo = a; hi = b; }
__device__ __forceinline__ float xor32_max(float v) { float lo, hi; xor32_pair(v, lo, hi); float r; asm("v_max_f32 %0, %1, %2" : "=v"(r) : "v"(lo), "v"(hi)); return r; }
__device__ __forceinline__ float xor32_sum(float v) { float lo, hi; xor32_pair(v, lo, hi); return lo + hi; }
__device__ __forceinline__ float max2f(float a, float b) { float r; asm("v_max_f32 %0, %1, %2" : "=v"(r) : "v"(a), "v"(b)); return r; }
__device__ __forceinline__ float max3f(float a, float b, float c) { float r; asm("v_max3_f32 %0, %1, %2, %3" : "=v"(r) : "v"(a), "v"(b), "v"(c)); return r; }
#define LBAR() asm volatile("s_waitcnt lgkmcnt(0)\n\ts_barrier" ::: "memory")
__device__ __forceinline__ void k_load(const LAS unsigned char* Ks, int r, int h, bf16x8v (&kf)[8]) {
    const int sw = (r >> 2) & 3;
#pragma unroll
    for (int ks = 0; ks < 4; ++ks) { const int off = (ks >> 1) * 4096 + r * 64 + (((((ks & 1) << 1) + h) ^ sw) << 4);
        kf[2 * ks] = *(const LAS bf16x8v*)(Ks + off); kf[2 * ks + 1] = *(const LAS bf16x8v*)(Ks + off + 2048); }
}
__device__ __forceinline__ void qk_mma(const bf16x8v (&kf)[8], const bf16x8v (&qf)[4], f32x16& p0, f32x16& p1) {
    const f32x16 z = {0.f, 0.f, 0.f, 0.f, 0.f, 0.f, 0.f, 0.f, 0.f, 0.f, 0.f, 0.f, 0.f, 0.f, 0.f, 0.f};
#pragma unroll
    for (int ks = 0; ks < 4; ++ks) { p0 = MFMA32(kf[2 * ks], qf[ks], ks ? p0 : z); p1 = MFMA32(kf[2 * ks + 1], qf[ks], ks ? p1 : z); }
}
__device__ __forceinline__ void v_load(const LAS unsigned char* Vs, int lane, bf16x8v (&vf)[8]) {
    const int h = lane >> 5, i16 = lane & 15, q = i16 >> 2, p = i16 & 3, gi = (lane >> 4) & 1;
    const int cidx = 2 * gi + (p >> 1), e8 = (p & 1) << 3;
    const int offlo = q * 64 + ((cidx ^ h) << 4) + e8 + h * 256, offhi = q * 64 + ((cidx ^ (h | 2)) << 4) + e8 + h * 256 + 512;
#pragma unroll
    for (int kb = 0; kb < 2; ++kb)
#pragma unroll
        for (int s = 0; s < 2; ++s)
#pragma unroll
            for (int db = 0; db < 2; ++db) { const LAS unsigned char* base = Vs + db * 4096 + (kb * 32 + s * 16) * 64;
                const s16x4v lo = tr_read(base + offlo), hi = tr_read(base + offhi);
                vf[(kb * 2 + s) * 2 + db] = __builtin_shufflevector(lo, hi, 0, 1, 2, 3, 4, 5, 6, 7); }
}
__device__ __forceinline__ void pv_mma(const bf16x8v (&vf)[8], const f32x16& p0, const f32x16& p1, f32x16 (&o)[2]) {
#pragma unroll
    for (int kb = 0; kb < 2; ++kb)
#pragma unroll
        for (int s = 0; s < 2; ++s) {
            const f32x16& P = kb ? p1 : p0;
            v4u pw; pw.x = cvtpk(P[8 * s + 0], P[8 * s + 1]); pw.y = cvtpk(P[8 * s + 2], P[8 * s + 3]); pw.z = cvtpk(P[8 * s + 4], P[8 * s + 5]); pw.w = cvtpk(P[8 * s + 6], P[8 * s + 7]);
            const bf16x8v pf = __builtin_bit_cast(bf16x8v, pw);
            o[0] = MFMA32(vf[(kb * 2 + s) * 2], pf, o[0]); o[1] = MFMA32(vf[(kb * 2 + s) * 2 + 1], pf, o[1]);
        }
}

__device__ __forceinline__ void nsa_unit_mfma(LAS unsigned char* L, const MixPtrs& P, int b, int g, int c, int tid_in) {
    int tid_l = tid_in; asm volatile("" : "+v"(tid_l));
    const int tid = tid_l, lane = tid & 63, w = __builtin_amdgcn_readfirstlane(tid >> 6);
    const int r = lane & 31, h = lane >> 5, head = w >> 1, qi = (w & 1) * 32 + r, t = c * 64 + qi;
    const size_t row = (size_t)b * SEQ + t;
    LAS unsigned* SEL = (LAS unsigned*)(L + NM_SEL); LAS int* ITEM = (LAS int*)(L + NM_ITEM);
    const size_t kvbase = (size_t)(b * 2 + g) * SEQ * 64, ccbase = (size_t)(b * 2 + g) * 128 * 64;
    const int skey = tid >> 3, sch = tid & 7, soff = tile_off(skey, sch);
    bf16x8v qf[4];
    { const bf16* qp = MP_QN + row * 512 + (g * 4 + head) * 64 + 8 * h;
#pragma unroll
      for (int ks = 0; ks < 4; ++ks) qf[ks] = *(const bf16x8v*)(qp + 16 * ks); }
    const float* gp = MP_GATE + row * 32 + g * 4 + head;
    float one = 1.f; asm volatile("" : "+v"(one));
    const float gate_c = __builtin_amdgcn_rcpf(one + __expf(-gp[0])), gate_s = __builtin_amdgcn_rcpf(one + __expf(-gp[8])), gate_w = __builtin_amdgcn_rcpf(one + __expf(-gp[16]));
    f32x16 oacc[2];
    {
        const bf16* kc = MP_KC + ccbase; const bf16* vc = MP_VC + ccbase;
        const v4u k0 = *(const v4u*)(kc + tid * 8), k1 = *(const v4u*)(kc + 4096 + tid * 8), v0 = *(const v4u*)(vc + tid * 8), v1 = *(const v4u*)(vc + 4096 + tid * 8);
        LBAR();
        *(LAS v4u*)(L + NM_SLOT + soff) = k0; *(LAS v4u*)(L + NM_SLOT + 8192 + soff) = v0; *(LAS v4u*)(L + NM_SLOT + 16384 + soff) = k1; *(LAS v4u*)(L + NM_SLOT + 24576 + soff) = v1;
        if (tid < 64) SEL[tid] = 0u;
        LBAR();
        f32x16 s0, s1, s2, s3;
        { bf16x8v kfa[8], kfb[8]; k_load(L + NM_SLOT, r, h, kfa); k_load(L + NM_SLOT + 16384, r, h, kfb); SBAR(); qk_mma(kfa, qf, s0, s1); qk_mma(kfb, qf, s2, s3); }
        const int nlim = (t >= 31) ? (((t - 31) >> 4) < 126 ? ((t - 31) >> 4) : 126) : -1;
        float mx, mxv[4] = {-1e20f, -1e20f, -1e20f, -1e20f};
#pragma unroll
        for (int e = 0; e < 16; ++e) { const int cr = (e & 3) + 8 * (e >> 2) + 4 * h;
            s0[e] = (cr <= nlim) ? s0[e] * QK_SCALE : -1e30f; s1[e] = (cr + 32 <= nlim) ? s1[e] * QK_SCALE : -1e30f;
            s2[e] = (cr + 64 <= nlim) ? s2[e] * QK_SCALE : -1e30f; s3[e] = (cr + 96 <= nlim) ? s3[e] * QK_SCALE : -1e30f;
            mxv[e & 3] = fmaxf(fmaxf(mxv[e & 3], fmaxf(s0[e], s1[e])), fmaxf(s2[e], s3[e])); }
        mx = fmaxf(fmaxf(mxv[0], mxv[1]), fmaxf(mxv[2], mxv[3]));
        mx = xor32_max(mx);
        float ls, lsv[4] = {0.f, 0.f, 0.f, 0.f};
#pragma unroll
        for (int e = 0; e < 16; ++e) { s0[e] = __builtin_amdgcn_exp2f(s0[e] - mx); s1[e] = __builtin_amdgcn_exp2f(s1[e] - mx); s2[e] = __builtin_amdgcn_exp2f(s2[e] - mx); s3[e] = __builtin_amdgcn_exp2f(s3[e] - mx);
            lsv[e & 3] += (s0[e] + s1[e]) + (s2[e] + s3[e]); }
        ls = (lsv[0] + lsv[1]) + (lsv[2] + lsv[3]);
        ls = xor32_sum(ls);
        const float il = (ls > 0.f) ? __builtin_amdgcn_rcpf(ls) : 0.f;
#pragma unroll
        for (int e = 0; e < 16; ++e) { s0[e] *= il; s1[e] *= il; s2[e] *= il; s3[e] *= il; }
        { LAS float* IMP = (LAS float*)(L + NM_IMP) + (w * 32 + r) * 33; float plprev = 0.f;
#pragma unroll
          for (int x = 0; x < 16; ++x) {
              const f32x16& S = (x < 4) ? s0 : ((x < 8) ? s1 : ((x < 12) ? s2 : s3)); const int g4 = (x & 3) * 4;
              const float own = (S[g4] + S[g4 + 1]) + (S[g4 + 2] + S[g4 + 3]);
              const float pl = shx(S[g4 + 3], 32, lane);
              if (h == 1) IMP[2 * x + 1] = own + pl; else IMP[2 * x] = own + plprev;
              plprev = pl;
          }
        }
        oacc[0] = (f32x16){0.f, 0.f, 0.f, 0.f, 0.f, 0.f, 0.f, 0.f, 0.f, 0.f, 0.f, 0.f, 0.f, 0.f, 0.f, 0.f}; oacc[1] = oacc[0];
        { bf16x8v vfa[8], vfb[8]; v_load(L + NM_SLOT + 8192, lane, vfa); v_load(L + NM_SLOT + 24576, lane, vfb); SBAR(); pv_mma(vfa, s0, s1, oacc); pv_mma(vfb, s2, s3, oacc); }
#pragma unroll
        for (int e = 0; e < 16; ++e) { oacc[0][e] *= gate_c; oacc[1][e] *= gate_c; }
    }
    LBAR();
    { const int i = tid & 63, jg = tid >> 6; const LAS float* I8 = (const LAS float*)(L + NM_IMP); LAS float* IMS = (LAS float*)(L + NM_IMS);
#pragma unroll
      for (int jj = 0; jj < 4; ++jj) { const int j = 4 * jg + jj; const int wq = (i >> 5), rq = i & 31;
          IMS[i * 36 + j] = (I8[((0 + wq) * 32 + rq) * 33 + j] + I8[((2 + wq) * 32 + rq) * 33 + j]) + (I8[((4 + wq) * 32 + rq) * 33 + j] + I8[((6 + wq) * 32 + rq) * 33 + j]); }
      LBAR();
      unsigned bits = 0u;
      if (c + 1 <= 16) { if (jg == 0) bits = (1u << (c + 1)) - 1u; }
      else { if (jg == 0) bits = 1u | (1u << c) | (1u << (c - 1));
          { float iv[32];
#pragma unroll
            for (int q8 = 0; q8 < 8; ++q8) { const f32x4 x = *(const LAS f32x4*)(IMS + i * 36 + 4 * q8); iv[4 * q8] = x.x; iv[4 * q8 + 1] = x.y; iv[4 * q8 + 2] = x.z; iv[4 * q8 + 3] = x.w; }
#pragma unroll
            for (int jj = 0; jj < 4; ++jj) { const int j = 4 * jg + jj; const float vj = IMS[i * 36 + j]; int rank = 0;
#pragma unroll
                for (int i2 = 1; i2 < 30; ++i2) rank += (i2 <= c - 2 && (iv[i2] > vj || (iv[i2] == vj && i2 < j))) ? 1 : 0;
                if (j >= 1 && j <= c - 2 && rank < 13) bits |= 1u << j; } } }
      if (bits) atomicOr((unsigned*)&SEL[i], bits);
      LBAR();
      if (w == 0) { unsigned so = SEL[lane];
#pragma unroll
          for (int o2 = 32; o2; o2 >>= 1) so |= shxu(so, o2, lane);
          if (lane == 0) { int n = 0; for (int j = 0; j <= c; ++j) if ((so >> j) & 1u) ITEM[n++] = j; const int j0 = (c - 8 > 0) ? c - 8 : 0; for (int j = j0; j <= c; ++j) ITEM[n++] = 64 + j; ITEM[n] = -1; ITEM[47] = n; } }
      LBAR();
    }
    const unsigned mysel = SEL[qi]; const int nitem = ITEM[47];
    f32x16 o[2]; float m = -1e20f, lsum = 0.f; int prev_kind = 0;
    o[0] = (f32x16){0.f, 0.f, 0.f, 0.f, 0.f, 0.f, 0.f, 0.f, 0.f, 0.f, 0.f, 0.f, 0.f, 0.f, 0.f, 0.f}; o[1] = o[0];
    const int npair = (nitem + 1) >> 1;
    v4u rk0, rv0, rk1, rv1;
#define NSA_LOAD_PAIR(ip_) do { const int ia_ = ITEM[2 * (ip_)], ib_ = ITEM[2 * (ip_) + 1]; \
        { const bf16* kp = ((ia_ & 64) ? MP_KW : MP_KS) + kvbase + (size_t)(ia_ & 63) * 4096; const bf16* vp = ((ia_ & 64) ? MP_VW : MP_VS) + kvbase + (size_t)(ia_ & 63) * 4096; rk0 = *(const v4u*)(kp + tid * 8); rv0 = *(const v4u*)(vp + tid * 8); } \
        if (ib_ >= 0) { const bf16* kp = ((ib_ & 64) ? MP_KW : MP_KS) + kvbase + (size_t)(ib_ & 63) * 4096; const bf16* vp = ((ib_ & 64) ? MP_VW : MP_VS) + kvbase + (size_t)(ib_ & 63) * 4096; rk1 = *(const v4u*)(kp + tid * 8); rv1 = *(const v4u*)(vp + tid * 8); } } while (0)
#define NSA_WRITE_PAIR(sb_) do { *(LAS v4u*)(L + (sb_) + soff) = rk0; *(LAS v4u*)(L + (sb_) + 8192 + soff) = rv0; *(LAS v4u*)(L + (sb_) + 16384 + soff) = rk1; *(LAS v4u*)(L + (sb_) + 24576 + soff) = rv1; } while (0)
    rk1 = (v4u){0u, 0u, 0u, 0u}; rv1 = rk1;
    NSA_LOAD_PAIR(0);
    NSA_WRITE_PAIR(NM_SLOT + 32768);
    LBAR();
#pragma unroll 1
    for (int ip = 0; ip < npair; ++ip) {
        if (ip + 1 < npair) NSA_LOAD_PAIR(ip + 1);
        const int sbase = NM_SLOT + ((ip + 1) & 1) * 32768;
#pragma unroll 1
        for (int half = 0; half < 2; ++half) {
            const int item = ITEM[2 * ip + half];
            if (item < 0) break;
            const int kind = item >> 6, j = item & 63;
            if (kind != prev_kind) {
                const float tot = xor32_sum(lsum); const float sc = gate_s * __builtin_amdgcn_rcpf(tot);
#pragma unroll
                for (int e = 0; e < 16; ++e) { oacc[0][e] += o[0][e] * sc; oacc[1][e] += o[1][e] * sc; o[0][e] = 0.f; o[1][e] = 0.f; }
                m = -1e20f; lsum = 0.f; prev_kind = kind;
            }
            int klo, khi;
            if (kind == 0) { klo = 0; khi = ((mysel >> j) & 1u) ? ((j < c) ? 63 : qi) : -1; }
            else { klo = t - 511 - 64 * j; khi = t - 64 * j; if (khi > 63) khi = 63; if (klo < 0) klo = 0; }
            const LAS unsigned char* slot = L + sbase + half * 16384;
            if (__any(khi >= klo)) {
                f32x16 p0, p1; bf16x8v vf[8];
                { bf16x8v kf[8]; k_load(slot, r, h, kf); SBAR(); qk_mma(kf, qf, p0, p1); }
                v_load(slot + 8192, lane, vf); SBAR();
                if (!__all(klo == 0 && khi == 63)) {
                    const int a = klo - 4 * h, z = khi - 4 * h;
#pragma unroll
                    for (int e = 0; e < 16; ++e) { const int cr = (e & 3) + 8 * (e >> 2);
                        p0[e] = (cr >= a && cr <= z) ? p0[e] : -1e30f; p1[e] = (cr + 32 >= a && cr + 32 <= z) ? p1[e] : -1e30f; }
                }
                float tm;
                { float ma = max2f(p0[0], p1[0]), mb = max2f(p0[1], p1[1]), mc2 = max2f(p0[2], p1[2]), md = max2f(p0[3], p1[3]);
#pragma unroll
                  for (int e = 4; e < 16; e += 4) { ma = max3f(ma, p0[e], p1[e]); mb = max3f(mb, p0[e + 1], p1[e + 1]); mc2 = max3f(mc2, p0[e + 2], p1[e + 2]); md = max3f(md, p0[e + 3], p1[e + 3]); }
                  tm = max3f(ma, mb, max2f(mc2, md)); }
                tm = xor32_max(tm);
                const float mn = fmaxf(m, tm * QK_SCALE);
                if (!__all(mn == m)) { const float corr = __builtin_amdgcn_exp2f(m - mn); lsum *= corr;
#pragma unroll
                    for (int e = 0; e < 16; ++e) { o[0][e] *= corr; o[1][e] *= corr; }
                    m = mn; }
                { const f32x2v sc2 = {QK_SCALE, QK_SCALE}, mm2 = {m, m}; f32x2v ta = {0.f, 0.f}, tb = {0.f, 0.f};
#pragma unroll
                  for (int e = 0; e < 16; e += 2) { const f32x2v a0 = (f32x2v){p0[e], p0[e + 1]} * sc2 - mm2, a1 = (f32x2v){p1[e], p1[e + 1]} * sc2 - mm2; p0[e] = a0.x; p0[e + 1] = a0.y; p1[e] = a1.x; p1[e + 1] = a1.y; }
#pragma unroll
                  for (int e = 0; e < 16; ++e) { p0[e] = __builtin_amdgcn_exp2f(p0[e]); p1[e] = __builtin_amdgcn_exp2f(p1[e]); }
#pragma unroll
                  for (int e = 0; e < 16; e += 2) { ta += (f32x2v){p0[e], p0[e + 1]}; tb += (f32x2v){p1[e], p1[e + 1]}; }
                  lsum += (ta.x + ta.y) + (tb.x + tb.y); }
                SBAR(); pv_mma(vf, p0, p1, o);
            }
        }
        if (ip + 1 < npair) NSA_WRITE_PAIR(NM_SLOT + (ip & 1) * 32768);
        LBAR();
    }
#undef NSA_LOAD_PAIR
#undef NSA_WRITE_PAIR
    { const float tot = xor32_sum(lsum); const float sc = gate_w * __builtin_amdgcn_rcpf(tot);
#pragma unroll
      for (int e = 0; e < 16; ++e) { oacc[0][e] += o[0][e] * sc; oacc[1][e] += o[1][e] * sc; } }
    { bf16* yp = MP_Y + row * DM + (g * 4 + head) * 64 + 4 * h;
#pragma unroll
      for (int db = 0; db < 2; ++db)
#pragma unroll
          for (int g4 = 0; g4 < 4; ++g4) { v2u wv; wv.x = cvtpk(oacc[db][4 * g4], oacc[db][4 * g4 + 1]); wv.y = cvtpk(oacc[db][4 * g4 + 2], oacc[db][4 * g4 + 3]); *(v2u*)(yp + db * 32 + g4 * 8) = wv; } }
}

namespace ns3 {
using f32x16 = __attribute__((ext_vector_type(16))) float;
using bf16x8 = __attribute__((ext_vector_type(8))) short;
using s16x4 = __attribute__((ext_vector_type(4))) short;
using u32x4 = __attribute__((ext_vector_type(4))) unsigned;
typedef short v4i16_t __attribute__((ext_vector_type(4)));
typedef LAS const char* lds_cptr;
constexpr int NSLOT = 3, SLOTB = 8192;
constexpr int A_K = 0, A_V = NSLOT * SLOTB, A_WS = 2 * NSLOT * SLOTB, A_OST = A_WS + 8 * 64 * 4, A_END = A_OST + 8 * 8192;
constexpr int A_IMP = A_OST, A_IMS = A_OST + 33792, A_SEL = A_END, A_TTS = A_END + 512, A_TTW = A_TTS + 256;
#define SBAR3() __builtin_amdgcn_sched_barrier(0)
#define WAIT_BAR3(N) asm volatile("s_waitcnt vmcnt(" #N ") lgkmcnt(0)\n\ts_barrier":::"memory")
__device__ __forceinline__ int crow(int r, int hi) { return (r & 3) + 8 * (r >> 2) + 4 * hi; }
__device__ __forceinline__ void glds16(const void* gsrc, unsigned lds_dst) { unsigned keep;
  asm volatile("s_mov_b32 %0, m0\n\ts_mov_b32 m0, %2\n\ts_nop 0\n\tglobal_load_lds_dwordx4 %1, off\n\ts_mov_b32 m0, %0" : "=&s"(keep) : "v"(gsrc), "s"(lds_dst) : "memory"); }
__device__ __forceinline__ float fadd_s(float a, float b) { float r; asm("v_add_f32_e32 %0, %1, %2" : "=v"(r) : "v"(a), "v"(b)); return r; }
__device__ __forceinline__ float fsub_s(float a, float b) { float r; asm("v_sub_f32_e32 %0, %1, %2" : "=v"(r) : "v"(a), "v"(b)); return r; }
__device__ __forceinline__ s16x4 vtr(lds_cptr p) { return __builtin_bit_cast(s16x4, __builtin_amdgcn_ds_read_tr16_b64_v4i16((LAS v4i16_t*)p)); }
__device__ __forceinline__ void qkt(f32x16& p0, f32x16& p1, lds_cptr Kslot, const bf16x8* qr, const f32x16& negm, int r32, int hi) {
  lds_cptr kb = Kslot + hi * 1024 + r32 * 16;
#pragma unroll
  for (int d0 = 0; d0 < 4; ++d0) {
    const bf16x8 b0 = *(const LAS bf16x8*)(kb + d0 * 2048), b1 = *(const LAS bf16x8*)(kb + d0 * 2048 + 512);
    if (d0 == 0) { p0 = __builtin_amdgcn_mfma_f32_32x32x16_bf16(b0, qr[0], negm, 0, 0, 0); p1 = __builtin_amdgcn_mfma_f32_32x32x16_bf16(b1, qr[0], negm, 0, 0, 0); }
    else { p0 = __builtin_amdgcn_mfma_f32_32x32x16_bf16(b0, qr[d0], p0, 0, 0, 0); p1 = __builtin_amdgcn_mfma_f32_32x32x16_bf16(b1, qr[d0], p1, 0, 0, 0); } }
}
__device__ __forceinline__ void kload8(bf16x8* kf, lds_cptr kp) {
  kf[0] = *(const LAS bf16x8*)(kp);        kf[1] = *(const LAS bf16x8*)(kp + 512);
  kf[2] = *(const LAS bf16x8*)(kp + 2048); kf[3] = *(const LAS bf16x8*)(kp + 2560);
  kf[4] = *(const LAS bf16x8*)(kp + 4096); kf[5] = *(const LAS bf16x8*)(kp + 4608);
  kf[6] = *(const LAS bf16x8*)(kp + 6144); kf[7] = *(const LAS bf16x8*)(kp + 6656);
}
__device__ __forceinline__ void kload2(bf16x8* kf, lds_cptr kp, int j) { kf[2 * j] = *(const LAS bf16x8*)(kp + j * 2048); kf[2 * j + 1] = *(const LAS bf16x8*)(kp + j * 2048 + 512); }
__device__ __forceinline__ float rowmax(const f32x16& p0, const f32x16& p1) {
  float a = max3f(p0[0], p0[1], p1[0]), b = max3f(p0[2], p0[3], p1[1]); a = max3f(a, p1[2], p1[3]);
#pragma unroll
  for (int r = 4; r < 16; r += 4) { a = max3f(a, p0[r], p0[r + 1]); b = max3f(b, p0[r + 2], p0[r + 3]); a = max3f(a, p1[r], p1[r + 1]); b = max3f(b, p1[r + 2], p1[r + 3]); }
  return xor32_max(max2f(a, b));
}
__device__ __forceinline__ void pv(f32x16* o, int vb, bf16x8 pa0, bf16x8 pa1, bf16x8 pa2, bf16x8 pa3) {
#pragma unroll
  for (int d0 = 0; d0 < 2; ++d0) { s16x4 lo[4], hi[4];
#pragma unroll
    for (int ks = 0; ks < 4; ++ks) {
      asm volatile("ds_read_b64_tr_b16 %0,%1 offset:%c2" : "=&v"(lo[ks]) : "v"(vb), "i"(d0 * 4096 + ks * 1024) : "memory");
      asm volatile("ds_read_b64_tr_b16 %0,%1 offset:%c2" : "=&v"(hi[ks]) : "v"(vb), "i"(d0 * 4096 + ks * 1024 + 512) : "memory"); }
    asm volatile("s_waitcnt lgkmcnt(0)" ::: "memory"); SBAR3();
#define PK3(k) (bf16x8){lo[k][0], lo[k][1], lo[k][2], lo[k][3], hi[k][0], hi[k][1], hi[k][2], hi[k][3]}
    o[d0] = __builtin_amdgcn_mfma_f32_32x32x16_bf16(pa0, PK3(0), o[d0], 0, 0, 0);
    o[d0] = __builtin_amdgcn_mfma_f32_32x32x16_bf16(pa1, PK3(1), o[d0], 0, 0, 0);
    o[d0] = __builtin_amdgcn_mfma_f32_32x32x16_bf16(pa2, PK3(2), o[d0], 0, 0, 0);
    o[d0] = __builtin_amdgcn_mfma_f32_32x32x16_bf16(pa3, PK3(3), o[d0], 0, 0, 0);
#undef PK3
  }
}
__device__ __forceinline__ void rmask(f32x16& p0, f32x16& p1, int e, unsigned mysel, int qi, int tq, int c, int hi) {
  const int kind = e >> 6, j = e & 63; int klo, khi;
  if (kind == 0) { klo = 0; khi = ((mysel >> j) & 1u) ? ((j < c) ? 63 : qi) : -1; }
  else if (kind == 1) { klo = tq - 511 - 64 * j; khi = tq - 64 * j; if (khi > 63) khi = 63; if (klo < 0) klo = 0; }
  else { klo = 0; khi = -1; }
  if (!__all(klo == 0 && khi == 63)) { const float NEG = -INFINITY; const int a = klo - 4 * hi, z = khi - 4 * hi;
#pragma unroll
    for (int r = 0; r < 16; ++r) { const int cr = (r & 3) + 8 * (r >> 2); if (cr < a || cr > z) p0[r] = NEG; if (cr + 32 < a || cr + 32 > z) p1[r] = NEG; } }
}

template <int THRL>
__device__ __forceinline__ void stream(LAS unsigned char* L, const bf16* Kb, const bf16* Vb, const LAS int* TT, const int NT, const bf16x8 (&qr)[4],
                                       int lane, int wid, unsigned mysel, int qi, int tq, int c, float gate, bool first_write) {
  const int r32 = lane & 31, hi = lane >> 5;
  const unsigned lds0 = (unsigned)(uintptr_t)L;
  LAS float* wsf = (LAS float*)(L + A_WS) + wid * 64;
  const bf16* ksrc = Kb + (long)lane * 64 + wid * 8;
  const bf16* vsrc = Vb + (long)(16 * (wid & 3) + (lane >> 2)) * 64 + (wid >> 2) * 32 + (lane & 3) * 8;
  const unsigned kdst = lds0 + A_K + wid * 1024, vdst = lds0 + A_V + wid * 1024;
#define TJ(x) ((long)(__builtin_amdgcn_readfirstlane(TT[(x)]) & 63) * 4096)
#define DMA_K(t, slot) glds16(ksrc + TJ(t), (unsigned)__builtin_amdgcn_readfirstlane(kdst + (slot)))
#define DMA_V(t, slot) glds16(vsrc + TJ(t), (unsigned)__builtin_amdgcn_readfirstlane(vdst + (slot)))
  const int vb0 = (int)(lds0 + A_V) + ((lane >> 4) & 1) * 32 + (lane & 3) * 8 + (4 * hi + ((lane & 15) >> 2)) * 64;
  bf16x8 kf[8];
  const lds_cptr shm3 = (lds_cptr)L; const lds_cptr kp0 = shm3 + A_K + hi * 1024 + r32 * 16; const lds_cptr vp0 = shm3 + A_V + ((lane >> 4) & 1) * 32 + (lane & 3) * 8 + (4 * hi + ((lane & 15) >> 2)) * 64;
  DMA_K(0, 0); DMA_V(0, 0); DMA_K(1, SLOTB);
  float mhat = 0.f, l_reg = 0.f; f32x16 o[2]; o[0] = f32x16{}; o[1] = f32x16{}; f32x16 negm = f32x16{}; asm volatile("" : "+v"(negm));
#define CMASK(P0, P1, t) rmask(P0, P1, __builtin_amdgcn_readfirstlane(TT[(t)]), mysel, qi, tq, c, hi)
  bool resc = false;
#define START(P0, P1) do { const float rm = rowmax(P0, P1); resc = false; \
    { const float dl = rm; mhat = fadd_s(mhat, dl); \
      _Pragma("unroll") for (int r = 0; r < 16; ++r) { P0[r] = fsub_s(P0[r], dl); P1[r] = fsub_s(P1[r], dl); } \
      _Pragma("unroll") for (int r = 0; r < 16; ++r) negm[r] = -mhat; asm volatile("" : "+v"(negm)); } \
    _Pragma("unroll") for (int r = 0; r < 16; ++r) P0[r] = __builtin_amdgcn_exp2f(P0[r]); } while (0)
#define RESC() do { if (resc) { asm volatile("s_waitcnt lgkmcnt(0)" ::: "memory"); \
      _Pragma("unroll") for (int d_ = 0; d_ < 2; ++d_) _Pragma("unroll") for (int r = 0; r < 16; ++r) o[d_][r] *= wsf[crow(r, hi)]; } } while (0)
  f32x16 pA0, pA1, pB0, pB1;
  int sl_prev = 0, sl_cur = 0, sl_next = SLOTB;
#define ROT() do { sl_prev = sl_cur; sl_cur = sl_next; sl_next = (sl_next == (NSLOT - 1) * SLOTB) ? 0 : sl_next + SLOTB; } while (0)
  DMA_K(2, 2 * SLOTB);
  WAIT_BAR3(3);
  qkt(pA0, pA1, shm3 + A_K, qr, negm, r32, hi); asm volatile("s_nop 15\n\ts_nop 7" : "+v"(pA0), "+v"(pA1)); CMASK(pA0, pA1, 0);
  START(pA0, pA1);
  _Pragma("unroll") for (int r = 0; r < 16; ++r) pA1[r] = __builtin_amdgcn_exp2f(pA1[r]);
  WAIT_BAR3(0);
  DMA_K(3, 0); DMA_V(1, SLOTB);
  ROT();
  kload8(kf, kp0 + sl_cur);
  WAIT_BAR3(2);
  s16x4 vlo[8], vhi[8]; u32x4 pw0, pw1, pw2, pw3;
#define PKW(P, B) cvtpk(P[B], P[B + 1])
#define PAF(k) __builtin_bit_cast(bf16x8, pw##k)
#define VFR(i) (bf16x8){vlo[i][0], vlo[i][1], vlo[i][2], vlo[i][3], vhi[i][0], vhi[i][1], vhi[i][2], vhi[i][3]}
#define PIN(x) asm volatile("" : "+v"(x))
#define MX3(a, b, c) __builtin_fmaxf(__builtin_fmaxf((a), (b)), (c))
#define GAPA(MF, A0, A1, A2, A3, W0, W1, PW) do { MF; sacc += A0; sacc += A1; sacc += A2; sacc += A3; PIN(sacc); W0; W1; PIN(PW); SBAR3(); } while (0)
#define EX(v) __builtin_amdgcn_exp2f(v)
#define GAPB(MF, X, B) do { MF; X[B] = EX(X[B]); X[B + 1] = EX(X[B + 1]); X[B + 2] = EX(X[B + 2]); X[B + 3] = EX(X[B + 3]); PIN(X); SBAR3(); } while (0)
#define VRD(i) do { vlo[i] = vtr(vp_ + (((i) >> 2) * 4096 + ((i) & 3) * 1024)); vhi[i] = vtr(vp_ + (((i) >> 2) * 4096 + ((i) & 3) * 1024 + 512)); } while (0)
#define KRD(G, j) do { if (G) { kload2(kf, kp0 + sl_next, j); SBAR3(); } } while (0)
#define STEP(C0, C1, P0, P1, t, GK, GV, GL) do { SBAR3(); \
    const lds_cptr vp_ = vp0 + sl_prev; \
    VRD(0); SBAR3(); float sacc = (P0[0] + P0[1]); \
    GAPA(C0 = __builtin_amdgcn_mfma_f32_32x32x16_bf16(kf[0], qr[0], negm, 0, 0, 0), P0[2], P0[3], P0[4], P0[5],     pw0[0] = PKW(P0, 0), pw0[1] = PKW(P0, 2), pw0); \
    VRD(4); SBAR3(); GAPA(C1 = __builtin_amdgcn_mfma_f32_32x32x16_bf16(kf[1], qr[0], negm, 0, 0, 0), P0[6], P0[7], P0[8], P0[9],     pw0[2] = PKW(P0, 4), pw0[3] = PKW(P0, 6), pw0); \
    VRD(1); SBAR3(); GAPA(C0 = __builtin_amdgcn_mfma_f32_32x32x16_bf16(kf[2], qr[1], C0, 0, 0, 0),   P0[10], P0[11], P0[12], P0[13], pw1[0] = PKW(P0, 8), pw1[1] = PKW(P0, 10), pw1); \
    VRD(5); SBAR3(); GAPA(C1 = __builtin_amdgcn_mfma_f32_32x32x16_bf16(kf[3], qr[1], C1, 0, 0, 0),   P0[14], P0[15], P1[0], P1[1],   pw1[2] = PKW(P0, 12), pw1[3] = PKW(P0, 14), pw1); \
    VRD(2); SBAR3(); GAPA(C0 = __builtin_amdgcn_mfma_f32_32x32x16_bf16(kf[4], qr[2], C0, 0, 0, 0),   P1[2], P1[3], P1[4], P1[5],     pw2[0] = PKW(P1, 0), pw2[1] = PKW(P1, 2), pw2); \
    VRD(6); SBAR3(); GAPA(C1 = __builtin_amdgcn_mfma_f32_32x32x16_bf16(kf[5], qr[2], C1, 0, 0, 0),   P1[6], P1[7], P1[8], P1[9],     pw2[2] = PKW(P1, 4), pw2[3] = PKW(P1, 6), pw2); \
    VRD(3); SBAR3(); GAPA(C0 = __builtin_amdgcn_mfma_f32_32x32x16_bf16(kf[6], qr[3], C0, 0, 0, 0),   P1[10], P1[11], P1[12], P1[13], pw3[0] = PKW(P1, 8), pw3[1] = PKW(P1, 10), pw3); \
    VRD(7); SBAR3(); GAPA(C1 = __builtin_amdgcn_mfma_f32_32x32x16_bf16(kf[7], qr[3], C1, 0, 0, 0),   P1[14], P1[15], 0.f, 0.f,       pw3[2] = PKW(P1, 12), pw3[3] = PKW(P1, 14), pw3); \
    l_reg += sacc; \
    if (GK) { DMA_K((t) + 3, sl_cur); } if (GV) { DMA_V((t) + 1, sl_next); } \
    CMASK(C0, C1, t); \
    { float a = MX3(C0[0], C0[1], C1[0]), b = MX3(C0[2], C0[3], C1[1]); a = MX3(a, C1[2], C1[3]); \
      _Pragma("unroll") for (int r = 4; r < 16; r += 4) { a = MX3(a, C0[r], C0[r + 1]); b = MX3(b, C0[r + 2], C0[r + 3]); a = MX3(a, C1[r], C1[r + 1]); b = MX3(b, C1[r + 2], C1[r + 3]); } \
      float rm = xor32_max(__builtin_fmaxf(a, b)); \
      resc = false; \
      if (__builtin_expect(__any(rm > (float)THRL), 0)) { const float dl = __builtin_fmaxf(rm, 0.f); mhat += dl; \
        _Pragma("unroll") for (int r = 0; r < 16; ++r) { C0[r] -= dl; C1[r] -= dl; } \
        _Pragma("unroll") for (int r = 0; r < 16; ++r) negm[r] = -mhat; asm volatile("" : "+v"(negm)); \
        const float f = __builtin_amdgcn_exp2f(-dl); l_reg *= f; if (hi == 0) wsf[r32] = f; resc = true; } } \
    SBAR3(); \
    GAPB(o[0] = __builtin_amdgcn_mfma_f32_32x32x16_bf16(PAF(0), VFR(0), o[0], 0, 0, 0), C0, 0); \
    GAPB(o[1] = __builtin_amdgcn_mfma_f32_32x32x16_bf16(PAF(0), VFR(4), o[1], 0, 0, 0), C0, 4); \
    KRD(GL, 0); GAPB(o[0] = __builtin_amdgcn_mfma_f32_32x32x16_bf16(PAF(1), VFR(1), o[0], 0, 0, 0), C0, 8); \
    KRD(GL, 1); GAPB(o[1] = __builtin_amdgcn_mfma_f32_32x32x16_bf16(PAF(1), VFR(5), o[1], 0, 0, 0), C0, 12); \
    KRD(GL, 2); GAPB(o[0] = __builtin_amdgcn_mfma_f32_32x32x16_bf16(PAF(2), VFR(2), o[0], 0, 0, 0), C1, 0); \
    KRD(GL, 3); GAPB(o[1] = __builtin_amdgcn_mfma_f32_32x32x16_bf16(PAF(2), VFR(6), o[1], 0, 0, 0), C1, 4); \
    GAPB(o[0] = __builtin_amdgcn_mfma_f32_32x32x16_bf16(PAF(3), VFR(3), o[0], 0, 0, 0), C1, 8); \
    GAPB(o[1] = __builtin_amdgcn_mfma_f32_32x32x16_bf16(PAF(3), VFR(7), o[1], 0, 0, 0), C1, 12); \
    } while (0)
#define ENDW(tt) do { if ((tt) + 3 < NT) { WAIT_BAR3(2); } else if ((tt) + 2 < NT) { WAIT_BAR3(1); } else { WAIT_BAR3(0); } } while (0)
  int t = 1;
#pragma unroll 1
  for (; t + 1 < NT; t += 2) {
    STEP(pB0, pB1, pA0, pA1, t, (t + 3 < NT), (t + 1 < NT), (t + 1 < NT));       ENDW(t);     RESC(); ROT();
    STEP(pA0, pA1, pB0, pB1, t + 1, (t + 4 < NT), (t + 2 < NT), (t + 2 < NT));   ENDW(t + 1); RESC(); ROT();
  }
  STEP(pB0, pB1, pA0, pA1, NT - 1, false, false, false); RESC();
  { float sacc = pB0[0] + pB0[1]; _Pragma("unroll") for (int r = 2; r < 16; ++r) sacc += pB0[r]; _Pragma("unroll") for (int r = 0; r < 16; ++r) sacc += pB1[r]; l_reg += sacc;
    pw0 = (u32x4){PKW(pB0, 0), PKW(pB0, 2), PKW(pB0, 4), PKW(pB0, 6)}; pw1 = (u32x4){PKW(pB0, 8), PKW(pB0, 10), PKW(pB0, 12), PKW(pB0, 14)}; pw2 = (u32x4){PKW(pB1, 0), PKW(pB1, 2), PKW(pB1, 4), PKW(pB1, 6)}; pw3 = (u32x4){PKW(pB1, 8), PKW(pB1, 10), PKW(pB1, 12), PKW(pB1, 14)};
    SBAR3(); pv(o, vb0 + sl_cur, PAF(0), PAF(1), PAF(2), PAF(3)); }
#undef PKW
#undef PAF
#undef VFR
#undef PIN
#undef MX3
#undef GAPA
#undef GAPB
#undef EX
#undef VRD
#undef KRD
#undef STEP
#undef ENDW
  l_reg = xor32_sum(l_reg);
  if (hi == 0) wsf[32 + r32] = gate * __builtin_amdgcn_rcpf(l_reg);
  asm volatile("s_waitcnt lgkmcnt(0)" ::: "memory");
  { LAS float* stg = (LAS float*)(L + A_OST) + wid * 2048;
#pragma unroll
    for (int r = 0; r < 16; ++r) { const int orow = crow(r, hi); const float fl = wsf[32 + orow];
#pragma unroll
      for (int d0 = 0; d0 < 2; ++d0) { LAS float* p = stg + orow * 64 + d0 * 32 + r32; const float v = o[d0][r] * fl; *p = first_write ? v : (*p + v); } } }
  asm volatile("s_waitcnt lgkmcnt(0)\n\ts_barrier" ::: "memory");
#undef TJ
#undef DMA_K
#undef DMA_V
#undef CMASK
#undef START
#undef RESC
#undef ROT
}
}

__device__ __forceinline__ void nsa_unit_v3(LAS unsigned char* L, const MixPtrs& P, int b, int g, int c, int tid_in) {
    int tid_l = tid_in; asm volatile("" : "+v"(tid_l));
    const int tid = tid_l, lane = tid & 63, w = __builtin_amdgcn_readfirstlane(tid >> 6);
    const int r = lane & 31, h = lane >> 5, head = w >> 1, qi = (w & 1) * 32 + r, t = c * 64 + qi;
    const size_t row = (size_t)b * SEQ + t;
    LAS unsigned* SEL = (LAS unsigned*)(L + ns3::A_SEL); LAS int* TTS = (LAS int*)(L + ns3::A_TTS); LAS int* TTW = (LAS int*)(L + ns3::A_TTW);
    const size_t kvbase = (size_t)(b * 2 + g) * SEQ * 64, ccbase = (size_t)(b * 2 + g) * 128 * 64;
    const int skey = tid >> 3, sch = tid & 7, soff = tile_off(skey, sch);
    bf16x8v qf[4];
    { const bf16* qp = MP_QN + row * 512 + (g * 4 + head) * 64 + 8 * h;
#pragma unroll
      for (int ks = 0; ks < 4; ++ks) qf[ks] = *(const bf16x8v*)(qp + 16 * ks); }
    const float* gp = MP_GATE + row * 32 + g * 4 + head;
    float one = 1.f; asm volatile("" : "+v"(one));
    const float gate_c = __builtin_amdgcn_rcpf(one + __expf(-gp[0])), gate_s = __builtin_amdgcn_rcpf(one + __expf(-gp[8])), gate_w = __builtin_amdgcn_rcpf(one + __expf(-gp[16]));
    f32x16 oacc[2];
    {
        const bf16* kc = MP_KC + ccbase; const bf16* vc = MP_VC + ccbase;
        const v4u k0 = *(const v4u*)(kc + tid * 8), k1 = *(const v4u*)(kc + 4096 + tid * 8), v0 = *(const v4u*)(vc + tid * 8), v1 = *(const v4u*)(vc + 4096 + tid * 8);
        LBAR();
        *(LAS v4u*)(L + soff) = k0; *(LAS v4u*)(L + 8192 + soff) = v0; *(LAS v4u*)(L + 16384 + soff) = k1; *(LAS v4u*)(L + 24576 + soff) = v1;
        if (tid < 64) SEL[tid] = 0u;
        LBAR();
        f32x16 s0, s1, s2, s3;
        { bf16x8v kfa[8], kfb[8]; k_load(L, r, h, kfa); k_load(L + 16384, r, h, kfb); SBAR(); qk_mma(kfa, qf, s0, s1); qk_mma(kfb, qf, s2, s3); }
        const int nlim = (t >= 31) ? (((t - 31) >> 4) < 126 ? ((t - 31) >> 4) : 126) : -1;
        float mx, mxv[4] = {-1e20f, -1e20f, -1e20f, -1e20f};
#pragma unroll
        for (int e = 0; e < 16; ++e) { const int cr = (e & 3) + 8 * (e >> 2) + 4 * h;
            s0[e] = (cr <= nlim) ? s0[e] : -1e30f; s1[e] = (cr + 32 <= nlim) ? s1[e] : -1e30f;
            s2[e] = (cr + 64 <= nlim) ? s2[e] : -1e30f; s3[e] = (cr + 96 <= nlim) ? s3[e] : -1e30f;
            mxv[e & 3] = fmaxf(fmaxf(mxv[e & 3], fmaxf(s0[e], s1[e])), fmaxf(s2[e], s3[e])); }
        mx = fmaxf(fmaxf(mxv[0], mxv[1]), fmaxf(mxv[2], mxv[3]));
        mx = xor32_max(mx);
        float ls, lsv[4] = {0.f, 0.f, 0.f, 0.f};
#pragma unroll
        for (int e = 0; e < 16; ++e) { s0[e] = __builtin_amdgcn_exp2f(s0[e] - mx); s1[e] = __builtin_amdgcn_exp2f(s1[e] - mx); s2[e] = __builtin_amdgcn_exp2f(s2[e] - mx); s3[e] = __builtin_amdgcn_exp2f(s3[e] - mx);
            lsv[e & 3] += (s0[e] + s1[e]) + (s2[e] + s3[e]); }
        ls = (lsv[0] + lsv[1]) + (lsv[2] + lsv[3]);
        ls = xor32_sum(ls);
        const float il = (ls > 0.f) ? __builtin_amdgcn_rcpf(ls) : 0.f;
#pragma unroll
        for (int e = 0; e < 16; ++e) { s0[e] *= il; s1[e] *= il; s2[e] *= il; s3[e] *= il; }
        { LAS float* IMP = (LAS float*)(L + ns3::A_IMP) + (w * 32 + r) * 33; float plprev = 0.f;
#pragma unroll
          for (int x = 0; x < 16; ++x) {
              const f32x16& S = (x < 4) ? s0 : ((x < 8) ? s1 : ((x < 12) ? s2 : s3)); const int g4 = (x & 3) * 4;
              const float own = (S[g4] + S[g4 + 1]) + (S[g4 + 2] + S[g4 + 3]);
              const float pl = shx(S[g4 + 3], 32, lane);
              if (h == 1) IMP[2 * x + 1] = own + pl; else IMP[2 * x] = own + plprev;
              plprev = pl;
          }
        }
        oacc[0] = (f32x16){0.f, 0.f, 0.f, 0.f, 0.f, 0.f, 0.f, 0.f, 0.f, 0.f, 0.f, 0.f, 0.f, 0.f, 0.f, 0.f}; oacc[1] = oacc[0];
        { bf16x8v vfa[8], vfb[8]; v_load(L + 8192, lane, vfa); v_load(L + 24576, lane, vfb); SBAR(); pv_mma(vfa, s0, s1, oacc); pv_mma(vfb, s2, s3, oacc); }
    }
    LBAR();
    { const int i = tid & 63, jg = tid >> 6; const LAS float* I8 = (const LAS float*)(L + ns3::A_IMP); LAS float* IMS = (LAS float*)(L + ns3::A_IMS);
#pragma unroll
      for (int jj = 0; jj < 4; ++jj) { const int j = 4 * jg + jj; const int wq = (i >> 5), rq = i & 31;
          IMS[i * 36 + j] = (I8[((0 + wq) * 32 + rq) * 33 + j] + I8[((2 + wq) * 32 + rq) * 33 + j]) + (I8[((4 + wq) * 32 + rq) * 33 + j] + I8[((6 + wq) * 32 + rq) * 33 + j]); }
      LBAR();
      unsigned bits = 0u;
      if (c + 1 <= 16) { if (jg == 0) bits = (1u << (c + 1)) - 1u; }
      else { if (jg == 0) bits = 1u | (1u << c) | (1u << (c - 1));
          { float iv[32];
#pragma unroll
            for (int q8 = 0; q8 < 8; ++q8) { const f32x4 x = *(const LAS f32x4*)(IMS + i * 36 + 4 * q8); iv[4 * q8] = x.x; iv[4 * q8 + 1] = x.y; iv[4 * q8 + 2] = x.z; iv[4 * q8 + 3] = x.w; }
#pragma unroll
            for (int jj = 0; jj < 4; ++jj) { const int j = 4 * jg + jj; const float vj = IMS[i * 36 + j]; int rank = 0;
#pragma unroll
                for (int i2 = 1; i2 < 30; ++i2) rank += (i2 <= c - 2 && (iv[i2] > vj || (iv[i2] == vj && i2 < j))) ? 1 : 0;
                if (j >= 1 && j <= c - 2 && rank < 13) bits |= 1u << j; } } }
      if (bits) atomicOr((unsigned*)&SEL[i], bits);
      LBAR();
      if (w == 0) { unsigned so = SEL[lane];
#pragma unroll
          for (int o2 = 32; o2; o2 >>= 1) so |= shxu(so, o2, lane);
          if (lane == 0) { int n = 0; for (int j = 0; j <= c; ++j) if ((so >> j) & 1u) TTS[n++] = j; while (n < 4 || (n & 1)) TTS[n++] = 128; TTS[46] = n; TTS[n] = 128; TTS[n + 1] = 128;
              int m2 = 0; TTW[m2++] = 64 + c; const int j0 = (c - 8 > 0) ? c - 8 : 0; for (int j = j0; j < c; ++j) TTW[m2++] = 64 + j; while (m2 < 4 || (m2 & 1)) TTW[m2++] = 128; TTW[14] = m2; } }
      LBAR();
    }
    const unsigned mysel = SEL[qi]; const int nts = TTS[46], ntw = TTW[14];
    { LAS float* stg = (LAS float*)(L + ns3::A_OST) + w * 2048 + r * 64 + 4 * h;
#pragma unroll
      for (int db = 0; db < 2; ++db)
#pragma unroll
          for (int g4 = 0; g4 < 4; ++g4) *(LAS f32x4*)(stg + db * 32 + g4 * 8) = (f32x4){oacc[db][4 * g4] * gate_c, oacc[db][4 * g4 + 1] * gate_c, oacc[db][4 * g4 + 2] * gate_c, oacc[db][4 * g4 + 3] * gate_c}; }
    LBAR();
    ns3::stream<8>(L, MP_KS + kvbase, MP_VS + kvbase, TTS, nts, qf, lane, w, mysel, qi, t, c, gate_s, false);
    ns3::stream<8>(L, MP_KW + kvbase, MP_VW + kvbase, TTW, ntw, qf, lane, w, mysel, qi, t, c, gate_w, false);
    { const LAS float* stg = (const LAS float*)(L + ns3::A_OST) + w * 2048; bf16* yb = MP_Y + ((size_t)b * SEQ + c * 64 + (w & 1) * 32) * DM + (g * 4 + head) * 64;
#pragma unroll
      for (int i4 = 0; i4 < 4; ++i4) { const int rr = i4 * 8 + (lane >> 3), ch = lane & 7; const f32x4 a = *(const LAS f32x4*)(stg + rr * 64 + ch * 8), bq = *(const LAS f32x4*)(stg + rr * 64 + ch * 8 + 4);
          v4u wv; wv.x = cvtpk(a.x, a.y); wv.y = cvtpk(a.z, a.w); wv.z = cvtpk(bq.x, bq.y); wv.w = cvtpk(bq.z, bq.w);
          *(v4u*)(yb + (size_t)rr * DM + ch * 8) = wv; } }
}

#define MFMA16(a, b, c) __builtin_amdgcn_mfma_f32_16x16x32_bf16((a), (b), (c), 0, 0, 0)
constexpr size_t WS_QC = 422 * MiB, WS_KC2 = 454 * MiB, WS_END2 = 486 * MiB; static_assert(WS_END2 <= WS_PART, "row-partial buffers follow");
#define MP_QC ((const bf16*)(P.ws + WS_QC))
#define MP_KC2 ((const bf16*)(P.ws + WS_KC2))
__device__ __forceinline__ int img_off(int row, int ch) { return 256 * row + 16 * (ch ^ (((row & 3) << 2) | ((row >> 2) & 3))); }
constexpr int M2_IMG = 0, M2_SC = 98304, M2_DEN = 106496, M2_QN = 107520, M2_N = 107776, M2_SSQ = 108288;

__device__ __forceinline__ void mlstm_conv_pass(unsigned char* ws, const float* conv_w, const float* conv_b, int gthread, int nthreads) {
    for (int idx = gthread; idx < BATCH * 128 * 128; idx += nthreads) {
        const int cc = idx & 127, tg = (idx >> 7) & 127, b = idx >> 14;
        const int isk = cc >> 6, ch0 = (cc & 63) * 8;
        const bf16* src = (const bf16*)(ws + (isk ? WS_MK : WS_MQ)) + (size_t)b * SEQ * 512 + ch0;
        bf16* dst = (bf16*)(ws + (isk ? WS_KC2 : WS_QC)) + ((size_t)(b * 4 + (ch0 >> 7)) * SEQ) * 128 + (ch0 & 127);
        float wt[4][8], bs[8];
#pragma unroll
        for (int j = 0; j < 4; ++j) { const f32x4 a = *(const f32x4*)(conv_w + j * 1024 + isk * 512 + ch0), c2 = *(const f32x4*)(conv_w + j * 1024 + isk * 512 + ch0 + 4);
            wt[j][0] = a.x; wt[j][1] = a.y; wt[j][2] = a.z; wt[j][3] = a.w; wt[j][4] = c2.x; wt[j][5] = c2.y; wt[j][6] = c2.z; wt[j][7] = c2.w; }
        { const f32x4 a = *(const f32x4*)(conv_b + isk * 512 + ch0), c2 = *(const f32x4*)(conv_b + isk * 512 + ch0 + 4); bs[0] = a.x; bs[1] = a.y; bs[2] = a.z; bs[3] = a.w; bs[4] = c2.x; bs[5] = c2.y; bs[6] = c2.z; bs[7] = c2.w; }
        const float osc = isk ? 0.08838834764831845f : 1.f;
        const int t0 = tg * 16;
        float x0[8], x1[8], x2[8];
#pragma unroll
        for (int e = 0; e < 8; ++e) { x0[e] = 0.f; x1[e] = 0.f; x2[e] = 0.f; }
        if (t0 > 0) {
            const v4u a = *(const v4u*)(src + (size_t)(t0 - 3) * 512), c2 = *(const v4u*)(src + (size_t)(t0 - 2) * 512), d2 = *(const v4u*)(src + (size_t)(t0 - 1) * 512);
            x0[0] = bflo(a.x); x0[1] = bfhi(a.x); x0[2] = bflo(a.y); x0[3] = bfhi(a.y); x0[4] = bflo(a.z); x0[5] = bfhi(a.z); x0[6] = bflo(a.w); x0[7] = bfhi(a.w);
            x1[0] = bflo(c2.x); x1[1] = bfhi(c2.x); x1[2] = bflo(c2.y); x1[3] = bfhi(c2.y); x1[4] = bflo(c2.z); x1[5] = bfhi(c2.z); x1[6] = bflo(c2.w); x1[7] = bfhi(c2.w);
            x2[0] = bflo(d2.x); x2[1] = bfhi(d2.x); x2[2] = bflo(d2.y); x2[3] = bfhi(d2.y); x2[4] = bflo(d2.z); x2[5] = bfhi(d2.z); x2[6] = bflo(d2.w); x2[7] = bfhi(d2.w);
        }
        v4u rows[16];
#pragma unroll
        for (int s = 0; s < 16; ++s) rows[s] = *(const v4u*)(src + (size_t)(t0 + s) * 512);
#pragma unroll
        for (int s = 0; s < 16; ++s) {
            const v4u a = rows[s];
            const float x3[8] = {bflo(a.x), bfhi(a.x), bflo(a.y), bfhi(a.y), bflo(a.z), bfhi(a.z), bflo(a.w), bfhi(a.w)};
            float o[8];
#pragma unroll
            for (int e = 0; e < 8; ++e) { float v = bs[e] + wt[0][e] * x0[e] + wt[1][e] * x1[e] + wt[2][e] * x2[e] + wt[3][e] * x3[e]; v = v * __builtin_amdgcn_rcpf(1.f + __expf(-v)); o[e] = v * osc; x0[e] = x1[e]; x1[e] = x2[e]; x2[e] = x3[e]; }
            v4u wv; wv.x = pk2(o[0], o[1]); wv.y = pk2(o[2], o[3]); wv.z = pk2(o[4], o[5]); wv.w = pk2(o[6], o[7]);
            *(v4u*)(dst + (size_t)(t0 + s) * 128) = wv;
        }
    }
}

constexpr int M2_A = 112384, M2_PM = 120576, M2_F = 128768, M2_BL = 136960, M2_AMX = 137088, M2_MC = 137216;
__device__ __forceinline__ void mlstm_unit_mfma(LAS unsigned char* L, const MixPtrs& P, int b, int hh, int tid_in) {
    int tid_l = tid_in; asm volatile("" : "+v"(tid_l));
    const int tid = tid_l, lane = tid & 63, w = __builtin_amdgcn_readfirstlane(tid >> 6), l15 = lane & 15, kg = lane >> 4;
    const size_t rb = (size_t)b * SEQ;
    const bf16* QCp = MP_QC + ((size_t)(b * 4 + hh) * SEQ) * 128; const bf16* KCp = MP_KC2 + ((size_t)(b * 4 + hh) * SEQ) * 128;
    const bf16* Vp = MP_MV + rb * 512 + hh * 128; const bf16* Op = MP_MO + rb * 512 + hh * 128 + 16 * w + 4 * kg;
    bf16* Yp = MP_Y + rb * DM + 512 + hh * 128 + 16 * w + 4 * kg;
    LAS float* DEN = (LAS float*)(L + M2_DEN); LAS float* QN = (LAS float*)(L + M2_QN); LAS float* NV = (LAS float*)(L + M2_N); LAS float* SSQ = (LAS float*)(L + M2_SSQ);
    LAS float* SA = (LAS float*)(L + M2_A); LAS float* SPM = (LAS float*)(L + M2_PM); LAS float* SF = (LAS float*)(L + M2_F);
    LAS float* SBL = (LAS float*)(L + M2_BL); LAS float* SAMX = (LAS float*)(L + M2_AMX); LAS float* SMC = (LAS float*)(L + M2_MC);
    float zf = 0.f; asm volatile("" : "+v"(zf));
    f32x4 Cacc[8], nacc = {zf, zf, zf, zf};
#pragma unroll
    for (int i = 0; i < 8; ++i) Cacc[i] = (f32x4){zf, zf, zf, zf};
    const f32x4 gn = *(const f32x4*)(P.mnorm_g + hh * 128 + 16 * w + 4 * kg);
    const int r0s = tid >> 4, c0s = tid & 15, so0 = img_off(r0s, c0s), so1 = img_off(r0s + 32, c0s);
    v4u sq0, sq1, sk0, sk1, sv0, sv1;
    sq0 = *(const v4u*)(QCp + (size_t)r0s * 128 + c0s * 8); sq1 = *(const v4u*)(QCp + (size_t)(r0s + 32) * 128 + c0s * 8);
    sk0 = *(const v4u*)(KCp + (size_t)r0s * 128 + c0s * 8); sk1 = *(const v4u*)(KCp + (size_t)(r0s + 32) * 128 + c0s * 8);
    sv0 = *(const v4u*)(Vp + (size_t)r0s * 512 + c0s * 8);  sv1 = *(const v4u*)(Vp + (size_t)(r0s + 32) * 512 + c0s * 8);
    LBAR();
    { const float ib = P.i_bias[hh], fb = P.f_bias[hh]; const float* Gp = MP_GATE + rb * 32 + hh;
#pragma unroll 1
      for (int cc = w; cc < 32; cc += 8) { const int tk = 64 * cc + lane;
          const float il = Gp[(size_t)tk * 32 + 24] + ib, fx = Gp[(size_t)tk * 32 + 28] + fb; const float fl = fminf(fx, 0.f) - log1pf(__expf(-fabsf(fx)));
          float f = fl;
#pragma unroll
          for (int o = 1; o < 64; o <<= 1) { const float v = shi(f, lane - o); if (lane >= o) f += v; }
          const float a = il - f; float pm = a;
#pragma unroll
          for (int o = 1; o < 64; o <<= 1) { const float v = shi(pm, lane - o); if (lane >= o) pm = fmaxf(pm, v); }
          SA[tk] = a; SPM[tk] = pm; SF[tk] = f; if (lane == 63) { SBL[cc] = f; SAMX[cc] = pm; } } }
    *(LAS v4u*)(L + M2_IMG + so0) = sq0; *(LAS v4u*)(L + M2_IMG + so1) = sq1; *(LAS v4u*)(L + M2_IMG + 16384 + so0) = sk0; *(LAS v4u*)(L + M2_IMG + 16384 + so1) = sk1;
    *(LAS v4u*)(L + M2_IMG + 32768 + so0) = sv0; *(LAS v4u*)(L + M2_IMG + 32768 + so1) = sv1;
    if (tid < 128) NV[tid] = zf;
    LBAR();
    if (tid == 0) { float mcar = zf; for (int cc = 0; cc < 32; ++cc) { SMC[cc] = mcar; mcar = SBL[cc] + fmaxf(mcar, SAMX[cc]); } }
    LBAR();
#pragma unroll 1
    for (int c = 0; c < 32; ++c) {
        int lc = lane; asm volatile("" : "+v"(lc));
        const int l15 = lc & 15, kg = lc >> 4, q4 = l15 >> 2, p4 = l15 & 3;
        const int t0 = c * 64; const LAS unsigned char* Qi = L + M2_IMG + (c & 1) * 49152; const LAS unsigned char* Ki = Qi + 16384; const LAS unsigned char* Vi = Qi + 32768;
        if (c + 1 < 32) { const int tn = t0 + 64;
            sq0 = *(const v4u*)(QCp + (size_t)(tn + r0s) * 128 + c0s * 8); sq1 = *(const v4u*)(QCp + (size_t)(tn + r0s + 32) * 128 + c0s * 8);
            sk0 = *(const v4u*)(KCp + (size_t)(tn + r0s) * 128 + c0s * 8); sk1 = *(const v4u*)(KCp + (size_t)(tn + r0s + 32) * 128 + c0s * 8);
            sv0 = *(const v4u*)(Vp + (size_t)(tn + r0s) * 512 + c0s * 8);  sv1 = *(const v4u*)(Vp + (size_t)(tn + r0s + 32) * 512 + c0s * 8); }
        const float mc = SMC[c], mxa = fmaxf(mc, SAMX[c]); const float cs = __expf(mc - mxa);
        { const int tblk = w >> 1, t = 16 * tblk + l15; const int sb0 = 2 * (w & 1);
          bf16x8v ka[2][4], qb[4];
#pragma unroll
          for (int ks = 0; ks < 4; ++ks) { qb[ks] = *(const LAS bf16x8v*)(Qi + img_off(t, 4 * ks + kg)); ka[0][ks] = *(const LAS bf16x8v*)(Ki + img_off(16 * sb0 + l15, 4 * ks + kg)); ka[1][ks] = *(const LAS bf16x8v*)(Ki + img_off(16 * sb0 + 16 + l15, 4 * ks + kg)); }
          const float Mt = fmaxf(SPM[t0 + t], mc);
          const f32x4 as0 = *(const LAS f32x4*)(SA + t0 + 16 * sb0 + 4 * kg), as1 = *(const LAS f32x4*)(SA + t0 + 16 * sb0 + 16 + 4 * kg);
          const int tq = tid >> 3, dp = tid & 7; const v4u q0 = *(const LAS v4u*)(Qi + img_off(tq, 2 * dp)), q1 = *(const LAS v4u*)(Qi + img_off(tq, 2 * dp + 1));
          const LAS f32x4* np = (const LAS f32x4*)(NV + 16 * dp); const f32x4 n0 = np[0], n1 = np[1], n2 = np[2], n3 = np[3];
          SBAR();
          LAS unsigned char* SC = L + M2_SC;
#pragma unroll
          for (int sb = 0; sb < 2; ++sb) { const int sblk = sb0 + sb; f32x4 acc = {0.f, 0.f, 0.f, 0.f}; float rp = 0.f; v2u wv; wv.x = 0u; wv.y = 0u;
              if (sblk <= tblk) {
#pragma unroll
                  for (int ks = 0; ks < 4; ++ks) acc = MFMA16(ka[sb][ks], qb[ks], acc);
                  const f32x4 as = sb ? as1 : as0; float v[4];
#pragma unroll
                  for (int e = 0; e < 4; ++e) { const float x = acc[e] * __expf(as[e] - Mt); v[e] = (sblk == tblk && 4 * kg + e > l15) ? 0.f : x; }
                  rp = (v[0] + v[1]) + (v[2] + v[3]); wv.x = cvtpk(v[0], v[1]); wv.y = cvtpk(v[2], v[3]);
              }
              rp += shx(rp, 16, lane); rp += shx(rp, 32, lane);
              *(LAS v2u*)(SC + t * 128 + (((2 * sblk + (kg >> 1)) ^ (t & 7)) << 4) + 8 * (kg & 1)) = wv;
              if (kg == 0) DEN[sblk * 64 + t] = rp; }
          { float s = bflo(q0.x) * n0.x + bfhi(q0.x) * n0.y + bflo(q0.y) * n0.z + bfhi(q0.y) * n0.w + bflo(q0.z) * n1.x + bfhi(q0.z) * n1.y + bflo(q0.w) * n1.z + bfhi(q0.w) * n1.w
                    + bflo(q1.x) * n2.x + bfhi(q1.x) * n2.y + bflo(q1.y) * n2.z + bfhi(q1.y) * n2.w + bflo(q1.z) * n3.x + bfhi(q1.z) * n3.y + bflo(q1.w) * n3.z + bfhi(q1.w) * n3.w;
            s += shx(s, 1, lane); s += shx(s, 2, lane); s += shx(s, 4, lane);
            if (dp == 0) QN[tq] = s; } }
        LBAR();
        v2u og[4];
#pragma unroll
        for (int tb = 0; tb < 4; ++tb) og[tb] = *(const v2u*)(Op + (size_t)(t0 + 16 * tb + l15) * 512);
        bf16x8v vf[2]; f32x4 hv[4];
        { float pmt[4], ft[4], dnp[4], qn4[4]; bf16x8v Cfrag[4];
#pragma unroll
          for (int kp = 0; kp < 4; ++kp) { v4u a; a.x = cvtpk(Cacc[2 * kp].x, Cacc[2 * kp].y); a.y = cvtpk(Cacc[2 * kp].z, Cacc[2 * kp].w); a.z = cvtpk(Cacc[2 * kp + 1].x, Cacc[2 * kp + 1].y); a.w = cvtpk(Cacc[2 * kp + 1].z, Cacc[2 * kp + 1].w);
              Cfrag[kp] = __builtin_bit_cast(bf16x8v, a); }
#pragma unroll
          for (int ks = 0; ks < 2; ++ks) { const int r0 = 32 * ks + 8 * kg;
              const s16x4v lo = tr_read(Vi + 256 * (r0 + q4) + 16 * ((2 * w + (p4 >> 1)) ^ ((q4 << 2) | ((r0 >> 2) & 3))) + 8 * (p4 & 1));
              const s16x4v hi = tr_read(Vi + 256 * (r0 + 4 + q4) + 16 * ((2 * w + (p4 >> 1)) ^ ((q4 << 2) | (((r0 + 4) >> 2) & 3))) + 8 * (p4 & 1));
              vf[ks] = __builtin_shufflevector(lo, hi, 0, 1, 2, 3, 4, 5, 6, 7); }
#pragma unroll
          for (int tb = 0; tb < 4; ++tb) { const int t = 16 * tb + l15; pmt[tb] = SPM[t0 + t]; ft[tb] = SF[t0 + t]; dnp[tb] = (DEN[t] + DEN[64 + t]) + (DEN[128 + t] + DEN[192 + t]); qn4[tb] = QN[t]; }
#pragma unroll
          for (int tp = 0; tp < 2; ++tp) {
              bf16x8v sf[2][2]; v2u qlo[2][4], qhi[2][4];
#pragma unroll
              for (int t2 = 0; t2 < 2; ++t2) { const int t = 16 * (2 * tp + t2) + l15; const int swz = ((t & 3) << 2) | ((t >> 2) & 3);
#pragma unroll
                  for (int ks = 0; ks < 2; ++ks) sf[t2][ks] = *(const LAS bf16x8v*)(L + M2_SC + t * 128 + (((4 * ks + kg) ^ (t & 7)) << 4));
#pragma unroll
                  for (int kp = 0; kp < 4; ++kp) { qlo[t2][kp] = *(const LAS v2u*)(Qi + 256 * t + 16 * ((4 * kp + (kg >> 1)) ^ swz) + 8 * (kg & 1)); qhi[t2][kp] = *(const LAS v2u*)(Qi + 256 * t + 16 * ((4 * kp + 2 + (kg >> 1)) ^ swz) + 8 * (kg & 1)); } }
              SBAR();
#pragma unroll
              for (int t2 = 0; t2 < 2; ++t2) { const int tb = 2 * tp + t2; f32x4 an = {0.f, 0.f, 0.f, 0.f}, a2 = {0.f, 0.f, 0.f, 0.f};
#pragma unroll
                  for (int ks = 0; ks < 2; ++ks) an = MFMA16(vf[ks], sf[t2][ks], an);
#pragma unroll
                  for (int kp = 0; kp < 4; ++kp) { v4u qq; qq.x = qlo[t2][kp].x; qq.y = qlo[t2][kp].y; qq.z = qhi[t2][kp].x; qq.w = qhi[t2][kp].y; a2 = MFMA16(Cfrag[kp], __builtin_bit_cast(bf16x8v, qq), a2); }
                  const float Mt = fmaxf(pmt[tb], mc), wp = __expf(mc - Mt), emt = __expf(-ft[tb] - Mt);
                  const float dn = dnp[tb] + wp * qn4[tb];
                  const float idn = __builtin_amdgcn_rcpf(fmaxf(fabsf(dn), emt));
                  hv[tb] = (an + a2 * wp) * idn;
                  float ss = (hv[tb].x * hv[tb].x + hv[tb].y * hv[tb].y) + (hv[tb].z * hv[tb].z + hv[tb].w * hv[tb].w);
                  ss += shx(ss, 16, lane); ss += shx(ss, 32, lane);
                  if (kg == 0) SSQ[((c & 1) * 8 + w) * 64 + 16 * tb + l15] = ss; }
              SBAR();
          } }
        { bf16x8v vpf[2], wkf[2];
          f32x4 aw[2][2];
#pragma unroll
          for (int ks = 0; ks < 2; ++ks) { aw[ks][0] = *(const LAS f32x4*)(SA + t0 + 32 * ks + 8 * kg); aw[ks][1] = *(const LAS f32x4*)(SA + t0 + 32 * ks + 8 * kg + 4); }
#pragma unroll
          for (int ks = 0; ks < 2; ++ks) { float wkv[8]; unsigned vp[4], wp2[4]; const v4u vu = __builtin_bit_cast(v4u, vf[ks]); const unsigned vw[4] = {vu.x, vu.y, vu.z, vu.w};
#pragma unroll
              for (int j = 0; j < 8; ++j) wkv[j] = __expf(aw[ks][j >> 2][j & 3] - mxa);
#pragma unroll
              for (int j2 = 0; j2 < 4; ++j2) { vp[j2] = cvtpk(bflo(vw[j2]) * wkv[2 * j2], bfhi(vw[j2]) * wkv[2 * j2 + 1]); wp2[j2] = cvtpk(wkv[2 * j2], wkv[2 * j2 + 1]); }
              v4u a; a.x = vp[0]; a.y = vp[1]; a.z = vp[2]; a.w = vp[3]; vpf[ks] = __builtin_bit_cast(bf16x8v, a);
              v4u b2; b2.x = wp2[0]; b2.y = wp2[1]; b2.z = wp2[2]; b2.w = wp2[3]; wkf[ks] = __builtin_bit_cast(bf16x8v, b2); }
          nacc = nacc * cs;
#pragma unroll
          for (int ih = 0; ih < 2; ++ih) {
              bf16x8v kf[4][2];
#pragma unroll
              for (int i4 = 0; i4 < 4; ++i4)
#pragma unroll
                  for (int ks = 0; ks < 2; ++ks) { const int i = 4 * ih + i4, r0 = 32 * ks + 8 * kg;
                      const s16x4v lo = tr_read(Ki + 256 * (r0 + q4) + 16 * ((2 * i + (p4 >> 1)) ^ ((q4 << 2) | ((r0 >> 2) & 3))) + 8 * (p4 & 1));
                      const s16x4v hi = tr_read(Ki + 256 * (r0 + 4 + q4) + 16 * ((2 * i + (p4 >> 1)) ^ ((q4 << 2) | (((r0 + 4) >> 2) & 3))) + 8 * (p4 & 1));
                      kf[i4][ks] = __builtin_shufflevector(lo, hi, 0, 1, 2, 3, 4, 5, 6, 7); }
              SBAR();
#pragma unroll
              for (int i4 = 0; i4 < 4; ++i4) { const int i = 4 * ih + i4; Cacc[i] = Cacc[i] * cs;
#pragma unroll
                  for (int ks = 0; ks < 2; ++ks) Cacc[i] = MFMA16(kf[i4][ks], vpf[ks], Cacc[i]); }
              SBAR();
          }
          { bf16x8v kw[2];
#pragma unroll
            for (int ks = 0; ks < 2; ++ks) { const int r0 = 32 * ks + 8 * kg;
                const s16x4v lo = tr_read(Ki + 256 * (r0 + q4) + 16 * ((2 * w + (p4 >> 1)) ^ ((q4 << 2) | ((r0 >> 2) & 3))) + 8 * (p4 & 1));
                const s16x4v hi = tr_read(Ki + 256 * (r0 + 4 + q4) + 16 * ((2 * w + (p4 >> 1)) ^ ((q4 << 2) | (((r0 + 4) >> 2) & 3))) + 8 * (p4 & 1));
                kw[ks] = __builtin_shufflevector(lo, hi, 0, 1, 2, 3, 4, 5, 6, 7); }
            nacc = MFMA16(kw[0], wkf[0], nacc); nacc = MFMA16(kw[1], wkf[1], nacc); }
          if (l15 == 0) *(LAS f32x4*)(NV + 16 * w + 4 * kg) = nacc;
 }
        if (c + 1 < 32) { LAS unsigned char* Nx = L + M2_IMG + ((c + 1) & 1) * 49152;
            *(LAS v4u*)(Nx + so0) = sq0; *(LAS v4u*)(Nx + so1) = sq1; *(LAS v4u*)(Nx + 16384 + so0) = sk0; *(LAS v4u*)(Nx + 16384 + so1) = sk1; *(LAS v4u*)(Nx + 32768 + so0) = sv0; *(LAS v4u*)(Nx + 32768 + so1) = sv1; }
        LBAR();
#pragma unroll
        for (int tb = 0; tb < 4; ++tb) { const int t = 16 * tb + l15; const LAS float* sp = SSQ + (c & 1) * 512 + t;
            const float tot = ((sp[0] + sp[64]) + (sp[128] + sp[192])) + ((sp[256] + sp[320]) + (sp[384] + sp[448]));
            const float rn = __frsqrt_rn(tot * (1.f / 128.f) + EPS);
            const float y0 = hv[tb].x * rn * gn.x * sigmoidf_(bflo(og[tb].x)), y1 = hv[tb].y * rn * gn.y * sigmoidf_(bfhi(og[tb].x)), y2 = hv[tb].z * rn * gn.z * sigmoidf_(bflo(og[tb].y)), y3 = hv[tb].w * rn * gn.w * sigmoidf_(bfhi(og[tb].y));
            v2u wv; wv.x = cvtpk(y0, y1); wv.y = cvtpk(y2, y3);
            *(v2u*)(Yp + (size_t)(t0 + t) * DM) = wv; }
    }
    LBAR();
}

__device__ __forceinline__ bf16x8v pack8(const f32x16& x, int s2) { v4u p; p.x = cvtpk(x[8 * s2 + 0], x[8 * s2 + 1]); p.y = cvtpk(x[8 * s2 + 2], x[8 * s2 + 3]); p.z = cvtpk(x[8 * s2 + 4], x[8 * s2 + 5]); p.w = cvtpk(x[8 * s2 + 6], x[8 * s2 + 7]); return __builtin_bit_cast(bf16x8v, p); }
__device__ __forceinline__ int tr32_off(int lane, int c, int ks, int t) { const int h = lane >> 5, blk = (lane >> 4) & 1, q = (lane & 15) >> 2, p = lane & 3; return img_off(16 * ks + 8 * h + 4 * t + q, 4 * c + 2 * blk + (p >> 1)) + 8 * (p & 1); }
__device__ __forceinline__ bf16x8v tr32_frag(const LAS unsigned char* img, int lane, int c, int ks) { const s16x4v lo = tr_read(img + tr32_off(lane, c, ks, 0)), hi = tr_read(img + tr32_off(lane, c, ks, 1)); return __builtin_shufflevector(lo, hi, 0, 1, 2, 3, 4, 5, 6, 7); }
constexpr int M3_DEN = M2_DEN  , M3_SSQ = M2_SSQ  ;

__device__ __forceinline__ void mlstm_unit_v3(LAS unsigned char* L, const MixPtrs& P, int b, int hh, int tid_in) {
    int tid_l = tid_in; asm volatile("" : "+v"(tid_l));
    const int tid = tid_l, lane = tid & 63, w = __builtin_amdgcn_readfirstlane(tid >> 6);
    const size_t rb = (size_t)b * SEQ;
    const bf16* QCp = MP_QC + ((size_t)(b * 4 + hh) * SEQ) * 128; const bf16* KCp = MP_KC2 + ((size_t)(b * 4 + hh) * SEQ) * 128;
    const bf16* Vp = MP_MV + rb * 512 + hh * 128;
    LAS float* DEN = (LAS float*)(L + M3_DEN); LAS float* QN = (LAS float*)(L + M2_QN); LAS float* NV = (LAS float*)(L + M2_N); LAS float* SSQ = (LAS float*)(L + M3_SSQ);
    LAS float* SA = (LAS float*)(L + M2_A); LAS float* SPM = (LAS float*)(L + M2_PM); LAS float* SF = (LAS float*)(L + M2_F);
    LAS float* SBL = (LAS float*)(L + M2_BL); LAS float* SAMX = (LAS float*)(L + M2_AMX); LAS float* SMC = (LAS float*)(L + M2_MC);
    float zf = 0.f; asm volatile("" : "+v"(zf));
    const bool isCD = w < 4; const int jw = w & 3;
    f32x16 Cacc[4]; bf16x8v vfk[4];
#pragma unroll
    for (int i = 0; i < 4; ++i) { vfk[i] = (bf16x8v){0, 0, 0, 0, 0, 0, 0, 0};
#pragma unroll
        for (int e = 0; e < 16; ++e) Cacc[i][e] = zf; }
    const int r0s = tid >> 4, c0s = tid & 15, so0 = img_off(r0s, c0s), so1 = img_off(r0s + 32, c0s);
    v4u sq0, sq1, sk0, sk1, sv0, sv1;
    sq0 = *(const v4u*)(QCp + (size_t)r0s * 128 + c0s * 8); sq1 = *(const v4u*)(QCp + (size_t)(r0s + 32) * 128 + c0s * 8);
    sk0 = *(const v4u*)(KCp + (size_t)r0s * 128 + c0s * 8); sk1 = *(const v4u*)(KCp + (size_t)(r0s + 32) * 128 + c0s * 8);
    sv0 = *(const v4u*)(Vp + (size_t)r0s * 512 + c0s * 8);  sv1 = *(const v4u*)(Vp + (size_t)(r0s + 32) * 512 + c0s * 8);
    LBAR();
    { const float ib = P.i_bias[hh], fb = P.f_bias[hh]; const float* Gp = MP_GATE + rb * 32 + hh;
#pragma unroll 1
      for (int cc = w; cc < 32; cc += 8) { const int tk = 64 * cc + lane;
          const float il = Gp[(size_t)tk * 32 + 24] + ib, fx = Gp[(size_t)tk * 32 + 28] + fb; const float fl = fminf(fx, 0.f) - log1pf(__expf(-fabsf(fx)));
          float f = fl;
#pragma unroll
          for (int o = 1; o < 64; o <<= 1) { const float v = shi(f, lane - o); if (lane >= o) f += v; }
          const float a = il - f; float pm = a;
#pragma unroll
          for (int o = 1; o < 64; o <<= 1) { const float v = shi(pm, lane - o); if (lane >= o) pm = fmaxf(pm, v); }
          SA[tk] = a; SPM[tk] = pm; SF[tk] = f; if (lane == 63) { SBL[cc] = f; SAMX[cc] = pm; } } }
    *(LAS v4u*)(L + M2_IMG + so0) = sq0; *(LAS v4u*)(L + M2_IMG + so1) = sq1; *(LAS v4u*)(L + M2_IMG + 16384 + so0) = sk0; *(LAS v4u*)(L + M2_IMG + 16384 + so1) = sk1;
    *(LAS v4u*)(L + M2_IMG + 32768 + so0) = sv0; *(LAS v4u*)(L + M2_IMG + 32768 + so1) = sv1;
    if (tid < 128) NV[tid] = zf;
    LBAR();
    if (tid == 0) { float mcar = zf; for (int cc = 0; cc < 32; ++cc) { SMC[cc] = mcar; mcar = SBL[cc] + fmaxf(mcar, SAMX[cc]); } }
    LBAR();
    f32x16 hv[2];
    hv[0] = Cacc[0]; hv[1] = Cacc[0];
#pragma unroll 1
    for (int c = 0; c < 32; ++c) {
        int lc = lane; asm volatile("" : "+v"(lc));
        const int r32 = lc & 31, hi = lc >> 5;
        const int t0 = c * 64; const LAS unsigned char* Qi = L + M2_IMG + (c & 1) * 49152; const LAS unsigned char* Ki = Qi + 16384; const LAS unsigned char* Vi = Qi + 32768;
        const LAS unsigned char* Kp = L + M2_IMG + ((c + 1) & 1) * 49152 + 16384;
        if (c + 1 < 32) { const int tn = t0 + 64;
            sq0 = *(const v4u*)(QCp + (size_t)(tn + r0s) * 128 + c0s * 8); sq1 = *(const v4u*)(QCp + (size_t)(tn + r0s + 32) * 128 + c0s * 8);
            sk0 = *(const v4u*)(KCp + (size_t)(tn + r0s) * 128 + c0s * 8); sk1 = *(const v4u*)(KCp + (size_t)(tn + r0s + 32) * 128 + c0s * 8);
            sv0 = *(const v4u*)(Vp + (size_t)(tn + r0s) * 512 + c0s * 8);  sv1 = *(const v4u*)(Vp + (size_t)(tn + r0s + 32) * 512 + c0s * 8); }
        const float mc = SMC[c];
        if (isCD) {
            if (c > 0) { const int t0p = t0 - 64; const float mcp = SMC[c - 1], mxap = fmaxf(mcp, SAMX[c - 1]); const float csp = __expf(mcp - mxap);
                bf16x8v vfp[4];
#pragma unroll
                for (int ks = 0; ks < 4; ++ks) { const f32x4 a0 = *(const LAS f32x4*)(SA + t0p + 16 * ks + 8 * hi), a1 = *(const LAS f32x4*)(SA + t0p + 16 * ks + 8 * hi + 4);
                    const float wk[8] = {__expf(a0.x - mxap), __expf(a0.y - mxap), __expf(a0.z - mxap), __expf(a0.w - mxap), __expf(a1.x - mxap), __expf(a1.y - mxap), __expf(a1.z - mxap), __expf(a1.w - mxap)};
                    const v4u vu = __builtin_bit_cast(v4u, vfk[ks]); v4u o4;
                    o4.x = cvtpk(bflo(vu.x) * wk[0], bfhi(vu.x) * wk[1]); o4.y = cvtpk(bflo(vu.y) * wk[2], bfhi(vu.y) * wk[3]); o4.z = cvtpk(bflo(vu.z) * wk[4], bfhi(vu.z) * wk[5]); o4.w = cvtpk(bflo(vu.w) * wk[6], bfhi(vu.w) * wk[7]);
                    vfp[ks] = __builtin_bit_cast(bf16x8v, o4); }
#pragma unroll
                for (int dt = 0; dt < 4; ++dt) { bf16x8v kf[4];
#pragma unroll
                    for (int ks = 0; ks < 4; ++ks) kf[ks] = tr32_frag(Kp, lc, dt, ks);
                    SBAR();
#pragma unroll
                    for (int e = 0; e < 16; ++e) Cacc[dt][e] *= csp;
#pragma unroll
                    for (int ks = 0; ks < 4; ++ks) Cacc[dt] = MFMA32(kf[ks], vfp[ks], Cacc[dt]);
                    SBAR(); } }
        } else if (jw != 2) {
            const int st = (jw == 3) ? 1 : 0, tt = (jw == 0) ? 0 : 1; const int t = 32 * tt + r32;
            const float Mt = fmaxf(SPM[t0 + t], mc);
            f32x4 as4[4];
#pragma unroll
            for (int g = 0; g < 4; ++g) as4[g] = *(const LAS f32x4*)(SA + t0 + 32 * st + 8 * g + 4 * hi);
            f32x16 acc;
#pragma unroll
            for (int e = 0; e < 16; ++e) acc[e] = 0.f;
#pragma unroll
            for (int kh = 0; kh < 2; ++kh) { bf16x8v ka[4], qb[4];
#pragma unroll
                for (int k4 = 0; k4 < 4; ++k4) { const int ks = 4 * kh + k4; ka[k4] = *(const LAS bf16x8v*)(Ki + img_off(32 * st + r32, 2 * ks + hi)); qb[k4] = *(const LAS bf16x8v*)(Qi + img_off(t, 2 * ks + hi)); }
                SBAR();
#pragma unroll
                for (int k4 = 0; k4 < 4; ++k4) acc = MFMA32(ka[k4], qb[k4], acc);
                SBAR(); }
            float rp = 0.f;
#pragma unroll
            for (int g = 0; g < 4; ++g) { float v[4];
#pragma unroll
                for (int e = 0; e < 4; ++e) { const float x = acc[4 * g + e] * __expf(as4[g][e] - Mt); v[e] = (st == tt && (8 * g + 4 * hi + e) > r32) ? 0.f : x; rp += v[e]; }
                v2u wv; wv.x = cvtpk(v[0], v[1]); wv.y = cvtpk(v[2], v[3]);
                *(LAS v2u*)(L + M2_SC + t * 128 + (((4 * st + g) ^ (t & 7)) << 4) + 8 * hi) = wv; }
            rp = xor32_sum(rp);
            if (hi == 0) DEN[st * 64 + t] = rp;
        } else {
            { const v4u z4 = {0u, 0u, 0u, 0u};
              *(LAS v4u*)(L + M2_SC + r32 * 128 + (((4 + 2 * hi) ^ (r32 & 7)) << 4)) = z4; *(LAS v4u*)(L + M2_SC + r32 * 128 + (((5 + 2 * hi) ^ (r32 & 7)) << 4)) = z4;
              if (hi == 0) DEN[64 + r32] = 0.f; }
            float qn = 0.f;
#pragma unroll 4
            for (int ch = 0; ch < 16; ++ch) { const v4u q8 = *(const LAS v4u*)(Qi + img_off(lc, ch)); const f32x4 n0 = *(const LAS f32x4*)(NV + 8 * ch), n1 = *(const LAS f32x4*)(NV + 8 * ch + 4);
                qn += bflo(q8.x) * n0.x + bfhi(q8.x) * n0.y + bflo(q8.y) * n0.z + bfhi(q8.y) * n0.w + bflo(q8.z) * n1.x + bfhi(q8.z) * n1.y + bflo(q8.w) * n1.z + bfhi(q8.w) * n1.w; }
            QN[lc] = qn;
            const float mxa = fmaxf(mc, SAMX[c]), cs = __expf(mc - mxa); const float wkl = __expf(SA[t0 + lc] - mxa);
            const f32x2v nold = *(const LAS f32x2v*)(NV + 2 * lc); float n0a = 0.f, n1a = 0.f;
#pragma unroll
            for (int s = 0; s < 64; ++s) { const unsigned kk = *(const LAS unsigned*)(Ki + img_off(s, lc >> 2) + (lc & 3) * 4); const float ws = __builtin_bit_cast(float, __builtin_amdgcn_readlane(__builtin_bit_cast(int, wkl), s)); n0a += ws * bflo(kk); n1a += ws * bfhi(kk); }
            LDS_WAIT();
            *(LAS f32x2v*)(NV + 2 * lc) = (f32x2v){cs * nold.x + n0a, cs * nold.y + n1a};
        }
        LBAR();
        v2u og[2][4];
        if (isCD) {
#pragma unroll
            for (int ks = 0; ks < 4; ++ks) vfk[ks] = tr32_frag(Vi, lc, jw, ks);
#pragma unroll
            for (int tt = 0; tt < 2; ++tt) { const int t = 32 * tt + r32;
                bf16x8v scf[4];
#pragma unroll
                for (int ks = 0; ks < 4; ++ks) scf[ks] = *(const LAS bf16x8v*)(L + M2_SC + t * 128 + (((2 * ks + hi) ^ (t & 7)) << 4));
                const float pmt = SPM[t0 + t], ft = SF[t0 + t], dnp = DEN[t] + DEN[64 + t], qnt = QN[t];
                f32x16 a1, a2;
#pragma unroll
                for (int e = 0; e < 16; ++e) { a1[e] = 0.f; a2[e] = 0.f; }
#pragma unroll
                for (int kh = 0; kh < 2; ++kh) { v2u ql[4], qh[4];
#pragma unroll
                    for (int k4 = 0; k4 < 4; ++k4) { const int k8 = 4 * kh + k4; ql[k4] = *(const LAS v2u*)(Qi + img_off(t, 2 * k8) + 8 * hi); qh[k4] = *(const LAS v2u*)(Qi + img_off(t, 2 * k8 + 1) + 8 * hi); }
                    SBAR();
                    if (kh == 0) {
#pragma unroll
                        for (int ks = 0; ks < 4; ++ks) a1 = MFMA32(vfk[ks], scf[ks], a1); }
#pragma unroll
                    for (int k4 = 0; k4 < 4; ++k4) { const int k8 = 4 * kh + k4; v4u qq; qq.x = ql[k4].x; qq.y = ql[k4].y; qq.z = qh[k4].x; qq.w = qh[k4].y; a2 = MFMA32(pack8(Cacc[k8 >> 1], k8 & 1), __builtin_bit_cast(bf16x8v, qq), a2); }
                    SBAR(); }
                const float Mt = fmaxf(pmt, mc), wp = __expf(mc - Mt), emt = __expf(-ft - Mt);
                const float idn = __builtin_amdgcn_rcpf(fmaxf(fabsf(dnp + wp * qnt), emt));
                float ss = 0.f;
#pragma unroll
                for (int e = 0; e < 16; ++e) { const float x = (a1[e] + a2[e] * wp) * idn; hv[tt][e] = x; ss += x * x; }
                ss = xor32_sum(ss);
                if (hi == 0) SSQ[((c & 1) * 4 + jw) * 64 + t] = ss;
                SBAR(); }
            { const bf16* Op = MP_MO + rb * 512 + hh * 128 + 32 * jw + 4 * hi;
#pragma unroll
              for (int tt = 0; tt < 2; ++tt)
#pragma unroll
                  for (int g = 0; g < 4; ++g) og[tt][g] = *(const v2u*)(Op + (size_t)(t0 + 32 * tt + r32) * 512 + 8 * g); }
        }
        if (c + 1 < 32) { LAS unsigned char* Nx = L + M2_IMG + ((c + 1) & 1) * 49152;
            *(LAS v4u*)(Nx + so0) = sq0; *(LAS v4u*)(Nx + so1) = sq1; *(LAS v4u*)(Nx + 16384 + so0) = sk0; *(LAS v4u*)(Nx + 16384 + so1) = sk1; *(LAS v4u*)(Nx + 32768 + so0) = sv0; *(LAS v4u*)(Nx + 32768 + so1) = sv1; }
        LBAR();
        if (isCD) {
            bf16* Yp = MP_Y + rb * DM + 512 + hh * 128 + 32 * jw + 4 * hi; const float* gnp = P.mnorm_g + hh * 128 + 32 * jw + 4 * hi;
            f32x4 gn4[4];
#pragma unroll
            for (int g = 0; g < 4; ++g) gn4[g] = *(const f32x4*)(gnp + 8 * g);
#pragma unroll
            for (int tt = 0; tt < 2; ++tt) { const int t = 32 * tt + r32; const LAS float* sp = SSQ + (c & 1) * 256 + t;
                const float rn = __frsqrt_rn(((sp[0] + sp[64]) + (sp[128] + sp[192])) * (1.f / 128.f) + EPS);
#pragma unroll
                for (int g = 0; g < 4; ++g) { const float y0 = hv[tt][4 * g] * rn * gn4[g].x * sigmoidf_(bflo(og[tt][g].x)), y1 = hv[tt][4 * g + 1] * rn * gn4[g].y * sigmoidf_(bfhi(og[tt][g].x));
                    const float y2 = hv[tt][4 * g + 2] * rn * gn4[g].z * sigmoidf_(bflo(og[tt][g].y)), y3 = hv[tt][4 * g + 3] * rn * gn4[g].w * sigmoidf_(bfhi(og[tt][g].y));
                    v2u wv; wv.x = cvtpk(y0, y1); wv.y = cvtpk(y2, y3);
                    *(v2u*)(Yp + (size_t)(t0 + t) * DM + 8 * g) = wv; } }
        }
    }
    LBAR();
}

#ifndef MK_MULTI
#define MK_MULTI 0
#endif
constexpr int PH_PER_LAYER = 8, N_PHASES = 1 + DEPTH * PH_PER_LAYER;
struct Args { const float* in[16]; float* out; unsigned char* ws; int ph_lo, ph_hi; };
static_assert(sizeof(Args) == 16 * 8 + 8 + 8 + 8, "Args has no padding");

__global__ void __launch_bounds__(NWAVES * 64, 2) fwd_kernel(Args args) {
    extern __shared__ __attribute__((aligned(16))) unsigned char lds_raw[];
    LAS unsigned char* L = (LAS unsigned char*)lds_raw;
    const int G0 = gridDim.x, blk0 = blockIdx.x;
    const int wave0 = __builtin_amdgcn_readfirstlane((int)threadIdx.x >> 6);
#define PH_IDS() PH_WS(); int wave = wave0; asm volatile("" : "+s"(wave)); const int lane = fresh_lane(), tid = wave * 64 + lane, gw = blk * NWAVES + wave; (void)gw
#define PH_WS() size_t zoff_ = 0; asm volatile("" : "+s"(zoff_)); unsigned char* ws = (unsigned char*)__builtin_assume_aligned(args.ws, 256) + zoff_; int blk = blk0, G = G0; asm volatile("" : "+s"(blk), "+s"(G)); const int NGW = G * NWAVES; (void)NGW; bf16* X16 = (bf16*)(ws + WS_X16); float* SS2 = (float*)(ws + WS_TAB + TAB_SS2); bf16* U = (bf16*)(ws + WS_U); bf16* HB = (bf16*)(ws + WS_HB); bf16* HD = (bf16*)(ws + WS_HD); \
    unsigned char* wl = ws + WS_W; const float* ng = args.in[1] + (size_t)l_ * 6 * DM; (void)X16; (void)SS2; (void)U; (void)HB; (void)HD; (void)wl; (void)ng
    unsigned char* ws0 = args.ws;
    volatile LAS unsigned* MISC = (volatile LAS unsigned*)(L + MISC_OFF);
    { const int tid_e = wave0 * 64 + fresh_lane(); if (tid_e < 16) MISC[tid_e] = 0u; }
    __syncthreads();
    XcdBarrier bar; bar.bar = (unsigned*)(ws0 + WS_CTL) + CW_BAR; bar.x = 0; bar.st = nullptr;
    if (!MK_MULTI) bar = xcd_barrier_post((unsigned*)(ws0 + WS_CTL) + CW_BAR, MISC + 8, wave0 * 64 + fresh_lane() == 0);
    const int lo = args.ph_lo, hi = args.ph_hi;
#define IN(k) (lo <= (k) && (k) < hi)
#define SEAM(k) do { if (IN(k) && IN((k) + 1)) xcd_barrier(bar, wave0 * 64 + fresh_lane() == 0); } while (0)

    if (IN(0)) {
        const int l_ = 0; PH_IDS();
        const float* x_in = args.in[0]; float* cosT = (float*)(ws + WS_TAB + TAB_COS); float* sinT = (float*)(ws + WS_TAB + TAB_SIN); float* b1T = (float*)(ws + WS_TAB + TAB_B1);
#define CONVERT_WEIGHTS(lw, GM) do { LAS float* scr = (LAS float*)(L + wave * 16384); const float* ngw = args.in[1] + (size_t)(lw) * 6 * DM; \
        constexpr int I_GU = 16 * 176, I_DN = 44 * 32, I_IN = 16 * 112, I_OUT = 16 * 32, I_CMP = 16 * 16, I_LAYER = 2 * I_GU + 2 * I_DN + I_IN + I_OUT + I_CMP; \
        for (int it = gw; it < I_LAYER; it += NGW) { int r = it; unsigned char* wlw = ws + WS_W; \
            if (r < I_GU) { if ((GM) & 1) { SrcGU s{args.in[2] + (size_t)(lw) * DM * NGU, ngw + 0 * DM}; transpose_item(s, DM, (bf16*)(wlw + WO_GU1), scr, r / 176, r % 176, lane); } continue; } r -= I_GU; \
            if (r < I_DN) { if ((GM) & 2) { SrcPlain s{args.in[3] + (size_t)(lw) * FF * DM, DM}; transpose_item(s, FF, (bf16*)(wlw + WO_DN1), scr, r / 32, r % 32, lane); } continue; } r -= I_DN; \
            if (r < I_GU) { if ((GM) & 4) { SrcGU s{args.in[4] + (size_t)(lw) * DM * NGU, ngw + 4 * DM}; transpose_item(s, DM, (bf16*)(wlw + WO_GU2), scr, r / 176, r % 176, lane); } continue; } r -= I_GU; \
            if (r < I_DN) { if ((GM) & 8) { SrcPlain s{args.in[5] + (size_t)(lw) * FF * DM, DM}; transpose_item(s, FF, (bf16*)(wlw + WO_DN2), scr, r / 32, r % 32, lane); } continue; } r -= I_DN; \
            if (r < I_IN) { if ((GM) & 16) { SrcIN s{args.in[6] + (size_t)(lw) * DM * INCOLS, ngw + 2 * DM}; transpose_item(s, DM, (bf16*)(wlw + WO_IN), scr, r / 112, r % 112, lane); } continue; } r -= I_IN; \
            if (r < I_OUT) { if ((GM) & 32) { SrcPlain s{args.in[7] + (size_t)(lw) * DM * DM, DM}; transpose_item(s, DM, (bf16*)(wlw + WO_OUT), scr, r / 32, r % 32, lane); } continue; } r -= I_OUT; \
            if ((GM) & 64) { SrcCMP s{args.in[9] + (size_t)(lw) * 2 * 2048 * 128}; transpose_item(s, DM, (bf16*)(ws + WS_CMPW + (size_t)(lw) * MiB), scr, r / 16, r % 16, lane); } } } while (0)
        CONVERT_WEIGHTS(0, 0x7f);
        if (DEPTH > 1) CONVERT_WEIGHTS(1, 0x40);
        { bf16* w2t = (bf16*)(ws + WS_TAB + TAB_W2T);
          for (int i = blk * 512 + tid; i < DEPTH * 2 * 64 * 128; i += G * 512) { const int lk = i >> 13, o = (i >> 7) & 63, kk = i & 127; w2t[i] = (bf16)f2bf(args.in[10][((size_t)lk * 128 + kk) * 64 + o]); } }
        for (int i = blk * 512 + tid; i < SEQ * 8; i += G * 512) { const int pos = i >> 3, k = i & 7;
            const double inv = pow(500000.0, -(double)k / 8.0), ang = (double)pos * inv; cosT[i] = (float)cos(ang); sinT[i] = (float)sin(ang); }
        { LAS float* part = (LAS float*)(L + 131072);
          for (int ob = blk; ob < DEPTH * 2 * 128 / 2; ob += G) { const int o = 2 * ob + (wave >> 2), qr = wave & 3; const int lk = o >> 7, c = o & 127;
              const float* pe = args.in[8] + (size_t)lk * 2048; const float* w1 = args.in[9] + (size_t)lk * 2048 * 128;
              float s = 0.f; for (int r = qr * 512 + lane; r < qr * 512 + 512; r += 64) s += pe[r] * w1[(size_t)r * 128 + c];
              s = wave_sum(s, lane); if (lane == 0) part[wave] = s;
              __syncthreads();
              if (lane == 0 && qr == 0) b1T[o] = (part[wave] + part[wave + 1]) + (part[wave + 2] + part[wave + 3]);
              __syncthreads(); } }
        thin_phase<0>(nullptr, x_in, X16, nullptr, SS2, nullptr, 0.f, gw, NGW, lane);
    }
    SEAM(0);

#pragma unroll 1
    for (int l = 0; l < DEPTH; ++l) {
        const int pb = 1 + l * PH_PER_LAYER, l_ = l;
        if (IN(pb + 0)) { PH_IDS(); pg8::Gemm g{X16, (const bf16*)(wl + WO_GU1), MTOK, NGU, DM}; pg8::StaticOrder S; S.init(MTOK, NGU, G, blk); EpiSwiglu E{HB, SS2};
            pg8::gemm_phase<EpiSwiglu, pg8::StaticOrder, true, true>(L, g, S, E, tid); }
        SEAM(pb + 0);
        if (IN(pb + 1)) { PH_IDS(); pg8::Gemm g{HB, (const bf16*)(wl + WO_DN1), MTOK, DM, FF}; pg8::StaticOrder S; S.init(MTOK, DM, G, blk);
            EpiResNorm<false> E{ws, (LAS float*)(L + 131072), ng + 1 * DM, nullptr, 0.5f, l_ * 3 + 0};
            pg8::gemm_phase<EpiResNorm<false>, pg8::StaticOrder, true, true>(L, g, S, E, tid); }
        SEAM(pb + 1);
        if (IN(pb + 2)) { PH_IDS(); pg8::Gemm g{X16, (const bf16*)(wl + WO_IN), MTOK, NINP, DM}; pg8::StaticOrder S; S.init(MTOK, NINP, G, blk);
            EpiInProj E{ws};
            pg8::gemm_phase<EpiInProj, pg8::StaticOrder, true, true>(L, g, S, E, tid); }
        SEAM(pb + 2);
        if (IN(pb + 3)) { PH_IDS(); pg8::Gemm g{(const bf16*)(ws + WS_KCR), (const bf16*)(ws + WS_CMPW + (size_t)l_ * MiB), 8192, 512, DM}; CmpOrder S{blk, G};
            EpiCmpMlp E{ws, (const float*)(ws + WS_TAB + TAB_B1) + l_ * 2 * 128, (const bf16*)(ws + WS_TAB + TAB_W2T) + (size_t)l_ * 2 * 64 * 128};
            pg8::gemm_phase<EpiCmpMlp, CmpOrder, false, true>(L, g, S, E, tid);
            { const int nb = (G > 32) ? 32 : 0; if (blk >= nb) { mlstm_conv_pass(ws, args.in[11] + (size_t)l_ * 4 * 1024, args.in[12] + (size_t)l_ * 1024, (blk - nb) * 512 + tid, (G - nb) * 512);
                if (G > 32) { const int gw = (blk - nb) * NWAVES + wave, NGW = (G - nb) * NWAVES;
                    if (l_ == 0) { if (DEPTH > 1) CONVERT_WEIGHTS(1, 0x13); } else CONVERT_WEIGHTS(l_, 0x2c); } } } }
        SEAM(pb + 3);
        if (IN(pb + 4)) {
            PH_IDS();
            MixPtrs P{ws, args.in[11] + (size_t)l * 4 * 1024, args.in[12] + (size_t)l * 1024, args.in[13] + l * 4, args.in[14] + l * 4, args.in[15] + l * 512};
            {
            for (int u = blk; u < 64; u += G) mlstm_unit_v3(L, P, u >> 2, u & 3, tid);
            { unsigned* qbase = (unsigned*)(ws + WS_CTL) + CW_QUEUE + 1024 * l_; volatile LAS unsigned* QW = (volatile LAS unsigned*)(L + MISC_OFF);
              const unsigned q0 = xb_xcc_id() & 7u;
#pragma unroll 1
              for (unsigned qq = 0; qq < 8u; ++qq) { unsigned* qctr = qbase + 64 * ((q0 + qq) & 7u); const int bg0 = 4 * (int)((q0 + qq) & 7u);
                  __syncthreads();
                  if (tid == 0) QW[0] = __hip_atomic_fetch_add(qctr, 1u, __ATOMIC_RELAXED, __HIP_MEMORY_SCOPE_AGENT);
                  __syncthreads();
                  unsigned u = QW[0];
                  while (u < 128u) { unsigned nxt = 0u; if (tid == 0) nxt = __hip_atomic_fetch_add(qctr, 1u, __ATOMIC_RELAXED, __HIP_MEMORY_SCOPE_AGENT);
                      const int c = 31 - (int)(u & 31u), bg = bg0 + (int)(u >> 5); nsa_unit_v3(L, P, bg >> 1, bg & 1, c, tid);
                      __syncthreads(); if (tid == 0) QW[0] = nxt; __syncthreads(); u = QW[0]; } } }
            }
        }
        SEAM(pb + 4);
        if (IN(pb + 5)) { PH_IDS(); pg8::Gemm g{U, (const bf16*)(wl + WO_OUT), MTOK, DM, DM}; pg8::StaticOrder S; S.init(MTOK, DM, G, blk);
            EpiResNorm<false> E{ws, (LAS float*)(L + 131072), ng + 3 * DM, nullptr, 1.0f, l_ * 3 + 1};
            pg8::gemm_phase<EpiResNorm<false>, pg8::StaticOrder, true, true>(L, g, S, E, tid); }
        SEAM(pb + 5);
        if (IN(pb + 6)) { PH_IDS(); pg8::Gemm g{X16, (const bf16*)(wl + WO_GU2), MTOK, NGU, DM}; pg8::StaticOrder S; S.init(MTOK, NGU, G, blk); EpiSwiglu E{HB, SS2};
            pg8::gemm_phase<EpiSwiglu, pg8::StaticOrder, true, true>(L, g, S, E, tid); }
        SEAM(pb + 6);
        if (IN(pb + 7)) { PH_IDS(); pg8::Gemm g{HB, (const bf16*)(wl + WO_DN2), MTOK, DM, FF}; pg8::StaticOrder S; S.init(MTOK, DM, G, blk);
            if (l + 1 < DEPTH) { EpiResNorm<false> E{ws, (LAS float*)(L + 131072), ng + 5 * DM, nullptr, 0.5f, l_ * 3 + 2};
                pg8::gemm_phase<EpiResNorm<false>, pg8::StaticOrder, true, true>(L, g, S, E, tid); }
            else { EpiResNorm<true> E{ws, (LAS float*)(L + 131072), ng + 5 * DM, args.out, 0.5f, l_ * 3 + 2};
                pg8::gemm_phase<EpiResNorm<true>, pg8::StaticOrder, true, true>(L, g, S, E, tid); } }
        if (l + 1 < DEPTH) SEAM(pb + 7);
    }
#undef IN
#undef SEAM
#undef CONVERT_WEIGHTS
#undef PH_IDS
#undef PH_WS
}

extern "C" void kernel_launch(void* const* d_in, const int* in_sizes, int n_in, void* d_out, int out_size, void* d_ws, size_t ws_size, hipStream_t stream) {
    static int grid = 0;
    if (grid == 0) {
        if (n_in != 16 || in_sizes[0] != MTOK * DM || out_size != MTOK * DM || ws_size < WS_END3) { fprintf(stderr, "kernel_launch: unexpected problem (n_in %d, ws %zu)\n", n_in, ws_size); grid = -1; return; }
        int dev = 0, cus = 0, per_cu = 0;
        if (hipGetDevice(&dev) != hipSuccess || hipDeviceGetAttribute(&cus, hipDeviceAttributeMultiprocessorCount, dev) != hipSuccess) { grid = -1; return; }
        if (hipFuncSetAttribute((const void*)fwd_kernel, hipFuncAttributeMaxDynamicSharedMemorySize, LDS_BYTES) != hipSuccess) { grid = -1; return; }
        if (hipOccupancyMaxActiveBlocksPerMultiprocessor(&per_cu, (const void*)fwd_kernel, NWAVES * 64, LDS_BYTES) != hipSuccess || per_cu < 1) { fprintf(stderr, "kernel_launch: occupancy query says %d\n", per_cu); }
        (void)hipGetLastError();
        grid = cus;
        if (grid != 256) { fprintf(stderr, "kernel_launch: %d CUs (the row-group exchange of the fused post-norm epilogues assumes 256 workgroups: 4 column tiles of a token tile in one round)\n", grid); grid = -1; return; }
    }
    if (grid < 0) return;
    (void)hipMemsetAsync((char*)d_ws + WS_CTL, 0, CTL_ZERO_BYTES, stream);
    Args a{};
    for (int i = 0; i < 16; ++i) a.in[i] = (const float*)d_in[i];
    a.out = (float*)d_out; a.ws = (unsigned char*)d_ws;
#if MK_MULTI
    for (int p = 0; p < N_PHASES; ++p) { a.ph_lo = p; a.ph_hi = p + 1; hipLaunchKernelGGL(fwd_kernel, dim3(grid), dim3(NWAVES * 64), LDS_BYTES, stream, a); }
#else
    a.ph_lo = 0; a.ph_hi = N_PHASES; hipLaunchKernelGGL(fwd_kernel, dim3(grid), dim3(NWAVES * 64), LDS_BYTES, stream, a);
#endif
}
```

```cpp
#include <hip/hip_runtime.h>
#include <cstdio>
#include <cstdint>
#ifndef FINAL_FUSED
#define FINAL_FUSED 1
#endif
#ifndef PROBE_DUP
#define PROBE_DUP 0
#endif
#ifndef GU_ALIGN
#define GU_ALIGN true
#endif
#ifndef EARLY_WB
#define EARLY_WB 0
#endif
#ifndef PROBE_BLK
#define PROBE_BLK 100
#endif
#ifndef PROBE_SC
#define PROBE_SC 0
#endif
namespace pg8 {
#define PG8_LAS __attribute__((address_space(3)))
typedef unsigned short bf16_t;
typedef short bf16x8 __attribute__((ext_vector_type(8)));
typedef float f32x4 __attribute__((ext_vector_type(4)));
typedef unsigned u32x4 __attribute__((ext_vector_type(4)));
constexpr int BM = 256, BK = 64, HALF = 128, HTB = HALF * BK * 2  , STAGE_BYTES = 8 * HTB, NXCD = 8, WGM = 4;

__host__ __device__ __forceinline__ int lds_byte(int r, int c) { const int st = (r >> 4) * 2 + (c >> 5), rr = r & 15, cc = c & 31, ob = rr * 64 + cc * 2; return st * 1024 + (ob ^ (((ob >> 9) & 1) << 5)); }
__host__ __device__ __forceinline__ void stage_rc(int b, int& R, int& C) { const int st = b / 1024, sb = b % 1024, swz = sb ^ (((sb >> 9) & 1) << 5); R = (st >> 1) * 16 + swz / 64; C = (st & 1) * 32 + (swz % 64) / 2; }
__host__ __device__ __forceinline__ int perm32(int rho) { const int n = rho >> 4, i = rho & 15; return 8 * (i >> 2) + 4 * n + (i & 3); }

struct Unit { int pm, pn; };
struct Gemm { const bf16_t* A; const bf16_t* Bt; int M, N, K; };

struct StaticOrder {
    int nM, nN, nwg, G, c;
    __host__ __device__ void init(int M, int N, int G_, int c_) { nM = M / BM; nN = N / BM; nwg = nM * nN; G = G_; c = c_; }
    __host__ __device__ bool next(int i, Unit& u) const {
        const long L = (long)i * G + c; if (L >= nwg) return false;
        int wgid = (int)L; { const int q = nwg / NXCD, r = nwg % NXCD, xcd = wgid % NXCD, off = wgid / NXCD; wgid = (xcd < r ? xcd * (q + 1) : r * (q + 1) + (xcd - r) * q) + off; }
        const int nig = WGM * nN, gid = wgid / nig, fm = gid * WGM, gsz = (nM - fm) < WGM ? (nM - fm) : WGM;
        u.pm = fm + ((wgid % nig) % gsz); u.pn = (wgid % nig) / gsz; return true;
    }
    __device__ __forceinline__ void a_ready(const Unit&) const {}
    __device__ __forceinline__ void done(const Unit&) const {}
};

__device__ __forceinline__ unsigned cvt_pk_bf16(float lo, float hi) { unsigned r; asm volatile("v_cvt_pk_bf16_f32 %0, %1, %2" : "=v"(r) : "v"(lo), "v"(hi)); return r; }
typedef float f32x2 __attribute__((ext_vector_type(2)));
__device__ __forceinline__ f32x2 gelu_pk(f32x2 v) {
    const f32x2 av = __builtin_elementwise_abs(v), d = av * 0.2316418882f + 1.0f;
    f32x2 t; t.x = __builtin_amdgcn_rcpf(d.x); t.y = __builtin_amdgcn_rcpf(d.y);
    f32x2 q = t * 0.5307027145f + (-0.7265760135f); q = q * t + 0.7107068705f; q = q * t + (-0.142248368f); q = q * t + 0.127414796f; q = q * t;
    const f32x2 s = (v * v) * (-0.72134752044f);
    f32x2 e; e.x = __builtin_amdgcn_exp2f(s.x); e.y = __builtin_amdgcn_exp2f(s.y);
    const f32x2 m = v * (q * e), r = v - m;
    f32x2 o; o.x = v.x < 0.f ? m.x : r.x; o.y = v.y < 0.f ? m.y : r.y; return o;
}

template <int ACT  > struct EpiBf16 {
    static constexpr bool PERM = true, AFTER_DRAIN = false, HAS_PRE = false; struct Pre {}; static_assert(ACT == 0 || ACT == 1, "EpiBf16: ACT is 0 (none) or 1 (gelu_pk)");
    bf16_t* O; int ldc; const float* bias; int split_cols; size_t split_stride; float scale0;
    __device__ __forceinline__ void operator()(const f32x4 (&acc)[2][2][4][2], const Unit& u, int wr, int wc, int fr, int fq) const {
        const int row0 = u.pm * BM + wr * 64 + fr; int colt = u.pn * BM; bf16_t* base = O;
        float sc = 1.f; if (split_cols) { const int t = colt / split_cols; base += (size_t)t * split_stride; colt -= t * split_cols; if (t == 0) sc = scale0; }
        const int col0 = colt + wc * 32 + 8 * fq, bcol0 = u.pn * BM + wc * 32 + 8 * fq;
        f32x4 bv[2][2];
#pragma unroll
        for (int bj = 0; bj < 2; ++bj)
#pragma unroll
            for (int n = 0; n < 2; ++n) bv[bj][n] = bias ? *(const f32x4*)(bias + bcol0 + bj * HALF + 4 * n) : (f32x4){0.f, 0.f, 0.f, 0.f};
#pragma unroll
        for (int ai = 0; ai < 2; ++ai)
#pragma unroll
            for (int m = 0; m < 4; ++m) { bf16_t* rowp = base + (size_t)(row0 + ai * HALF + m * 16) * ldc + col0;
#pragma unroll
                for (int bj = 0; bj < 2; ++bj) { f32x4 v0 = acc[ai][bj][m][0] + bv[bj][0], v1 = acc[ai][bj][m][1] + bv[bj][1];
                    if (ACT == 1) { f32x2 a = gelu_pk((f32x2){v0[0], v0[1]}), b = gelu_pk((f32x2){v0[2], v0[3]}), c = gelu_pk((f32x2){v1[0], v1[1]}), d = gelu_pk((f32x2){v1[2], v1[3]});
                        v0 = (f32x4){a.x, a.y, b.x, b.y}; v1 = (f32x4){c.x, c.y, d.x, d.y}; }
                    v0 = v0 * sc; v1 = v1 * sc; u32x4 w; w.x = cvt_pk_bf16(v0[0], v0[1]); w.y = cvt_pk_bf16(v0[2], v0[3]); w.z = cvt_pk_bf16(v1[0], v1[1]); w.w = cvt_pk_bf16(v1[2], v1[3]);
                    *(u32x4*)(rowp + bj * HALF) = w; } }
    }
};
template <class Epi, class Sched, bool ALIGN_EPI = false, bool SP2 = false, int SC = 0>
__device__ __forceinline__ void gemm_phase(PG8_LAS unsigned char* lds, const Gemm g, const Sched& S, const Epi& E, int tid_in) {
    int tid_l = tid_in; asm volatile("" : "+v"(tid_l));
    const int tid = tid_l, wid = __builtin_amdgcn_readfirstlane(tid >> 6), lane = tid & 63, wr = wid >> 2, wc = wid & 3, fr = lane & 15, fq = lane >> 4;
    const int K = g.K, nt = K / BK;
    unsigned voffA[2], voffB[2];
#pragma unroll
    for (int i = 0; i < 2; ++i) { int R, C; stage_rc(tid * 16 + i * 8192, R, C); const int Rb = Epi::PERM ? ((R & ~31) + perm32(R & 31)) : R;
        voffA[i] = (unsigned)(R * K + C) * 2u; voffB[i] = (unsigned)(Rb * K + C) * 2u; }
    const size_t kstep = (size_t)(BK * 2);
    const size_t hstep = (size_t)HALF * K * 2;
    const size_t tstep = 2 * hstep;
    const unsigned ldsw = (unsigned)wid * 1024u;
    const int aoff = lds_byte(wr * 64 + fr, fq * 8), boff = lds_byte(wc * 32 + fr, fq * 8);
#define PG8_SA(b, h) (((b) * 2 + (h)) * HTB)
#define PG8_SB(b, h) ((4 + (b) * 2 + (h)) * HTB)
#define PG8_STAGE(bufoff, gbase, voff) do { _Pragma("unroll") for (int _i = 0; _i < 2; ++_i) \
        __builtin_amdgcn_global_load_lds((const unsigned*)((const char*)(gbase) + (voff)[_i]), (PG8_LAS unsigned*)(lds + (bufoff) + ldsw + _i * 8192), 16, 0, 0); } while (0)
#define PG8_LDA(dst, b, h) do { _Pragma("unroll") for (int m = 0; m < 4; ++m) _Pragma("unroll") for (int k = 0; k < 2; ++k) dst[m][k] = *(const PG8_LAS bf16x8*)(lds + PG8_SA(b, h) + aoff + m * 2048 + k * 1024); } while (0)
#define PG8_LDB(dst, b, h) do { _Pragma("unroll") for (int n = 0; n < 2; ++n) _Pragma("unroll") for (int k = 0; k < 2; ++k) dst[n][k] = *(const PG8_LAS bf16x8*)(lds + PG8_SB(b, h) + boff + n * 2048 + k * 1024); } while (0)
#define PG8_MMA(ai, bj, At, Bt) do { __builtin_amdgcn_s_setprio(1); _Pragma("unroll") for (int m = 0; m < 4; ++m) _Pragma("unroll") for (int n = 0; n < 2; ++n) _Pragma("unroll") for (int k = 0; k < 2; ++k) \
        acc[ai][bj][m][n] = __builtin_amdgcn_mfma_f32_16x16x32_bf16(Bt[n][k], At[m][k], acc[ai][bj][m][n], 0, 0, 0); __builtin_amdgcn_s_setprio(0); } while (0)
#define PG8_WAIT_V(n) asm volatile("s_waitcnt vmcnt(" #n ")" ::: "memory")
#define PG8_WAIT_L(n) asm volatile("s_waitcnt lgkmcnt(" #n ")" ::: "memory")
#define PG8_BAR __builtin_amdgcn_s_barrier()
#define PG8_SCHED __builtin_amdgcn_sched_barrier(0)
    Unit cur, nxt; int ui = 0;
    if (!S.next(0, cur)) return;
    typename Epi::Pre pre;
    f32x4 acc[2][2][4][2];
#pragma unroll
    for (int a = 0; a < 2; ++a)
#pragma unroll
        for (int b = 0; b < 2; ++b)
#pragma unroll
            for (int m = 0; m < 4; ++m)
#pragma unroll
                for (int n = 0; n < 2; ++n) acc[a][b][m][n] = (f32x4){0.f, 0.f, 0.f, 0.f};
    bf16x8 At[4][2], B0[2][2], B1[2][2];
    const char* cA = (const char*)g.A + (size_t)cur.pm * tstep; const char* cB = (const char*)g.Bt + (size_t)cur.pn * tstep;
    S.a_ready(cur);
    if constexpr (SP2) {
        PG8_STAGE(PG8_SB(0, 0), cB, voffB); PG8_STAGE(PG8_SB(0, 1), cB + hstep, voffB); PG8_STAGE(PG8_SA(0, 0), cA, voffA); PG8_STAGE(PG8_SA(0, 1), cA + hstep, voffA);
        if (wr == 1) PG8_BAR;
        PG8_WAIT_V(2); PG8_BAR;
        PG8_STAGE(PG8_SB(1, 0), cB + kstep, voffB); PG8_STAGE(PG8_SA(1, 0), cA + kstep, voffA); PG8_STAGE(PG8_SB(1, 1), cB + hstep + kstep, voffB);
        PG8_WAIT_V(6); PG8_BAR;
    } else {
        PG8_STAGE(PG8_SB(0, 0), cB, voffB); PG8_STAGE(PG8_SA(0, 0), cA, voffA); PG8_STAGE(PG8_SB(0, 1), cB + hstep, voffB); PG8_STAGE(PG8_SA(0, 1), cA + hstep, voffA);
        if (wr == 1) PG8_BAR;
        PG8_WAIT_V(4); PG8_BAR;
        PG8_STAGE(PG8_SB(1, 0), cB + kstep, voffB); PG8_STAGE(PG8_SA(1, 0), cA + kstep, voffA); PG8_STAGE(PG8_SB(1, 1), cB + hstep + kstep, voffB);
        PG8_WAIT_V(6); PG8_BAR;
    }
    for (;;) {
        const bool has_next = S.next(ui + 1, nxt);
        unsigned long long sc_t0 = 0, sc_c0 = 0; if constexpr (SC != 0) { sc_t0 = __builtin_amdgcn_s_memrealtime(); sc_c0 = __builtin_amdgcn_s_memtime(); }
        const char* nA = has_next ? (const char*)g.A + (size_t)nxt.pm * tstep : cA; const char* nB = has_next ? (const char*)g.Bt + (size_t)nxt.pn * tstep : cB;
        for (int t = 0; t < nt; t += 2) {
            const bool last = (t == nt - 2);
            const char* a1 = cA + (size_t)(t + 1) * kstep;
            const char* a2 = last ? nA : cA + (size_t)(t + 2) * kstep; const char* b2 = last ? nB : cB + (size_t)(t + 2) * kstep;
            const char* a3 = a2 + kstep; const char* b3 = b2 + kstep;
            if (last && has_next) S.a_ready(nxt);
            if constexpr (Epi::HAS_PRE) { if (last) E.pre_load(cur, wr, wc, pre); }
            if constexpr (SP2) {
            PG8_LDB(B0, 0, 0); PG8_LDB(B1, 0, 1); PG8_SCHED; PG8_LDA(At, 0, 0); PG8_STAGE(PG8_SA(1, 1), a1 + hstep, voffA);
            PG8_WAIT_V(8); PG8_WAIT_L(0); PG8_BAR; PG8_MMA(0, 0, At, B0); PG8_MMA(0, 1, At, B1); PG8_BAR; PG8_SCHED;
            PG8_LDA(At, 0, 1); PG8_STAGE(PG8_SB(0, 0), b2, voffB); PG8_STAGE(PG8_SB(0, 1), b2 + hstep, voffB); PG8_STAGE(PG8_SA(0, 0), a2, voffA);
            PG8_WAIT_V(8); PG8_WAIT_L(0); PG8_BAR; PG8_MMA(1, 0, At, B0); PG8_MMA(1, 1, At, B1); PG8_BAR; PG8_SCHED;
            PG8_LDB(B0, 1, 0); PG8_LDB(B1, 1, 1); PG8_SCHED; PG8_LDA(At, 1, 0); PG8_STAGE(PG8_SA(0, 1), a2 + hstep, voffA);
            PG8_WAIT_V(8); PG8_WAIT_L(0); PG8_BAR; PG8_MMA(0, 0, At, B0); PG8_MMA(0, 1, At, B1); PG8_BAR; PG8_SCHED;
            PG8_LDA(At, 1, 1); PG8_STAGE(PG8_SB(1, 0), b3, voffB); PG8_STAGE(PG8_SB(1, 1), b3 + hstep, voffB); PG8_STAGE(PG8_SA(1, 0), a3, voffA);
            PG8_WAIT_V(8); PG8_WAIT_L(0); PG8_BAR; PG8_MMA(1, 0, At, B0); PG8_MMA(1, 1, At, B1); PG8_BAR; PG8_SCHED;
            } else {
            PG8_LDB(B0, 0, 0); PG8_SCHED; PG8_LDA(At, 0, 0); PG8_STAGE(PG8_SA(1, 1), a1 + hstep, voffA);
            PG8_WAIT_L(8); PG8_BAR; PG8_WAIT_L(0); PG8_MMA(0, 0, At, B0); PG8_BAR; PG8_SCHED;
            PG8_LDB(B1, 0, 1); PG8_STAGE(PG8_SB(0, 0), b2, voffB);
            PG8_BAR; PG8_WAIT_L(0); PG8_MMA(0, 1, At, B1); PG8_BAR;
            PG8_LDA(At, 0, 1); PG8_STAGE(PG8_SA(0, 0), a2, voffA);
            PG8_BAR; PG8_WAIT_L(0); PG8_MMA(1, 0, At, B0); PG8_BAR; PG8_SCHED;
            PG8_STAGE(PG8_SB(0, 1), b2 + hstep, voffB);
            PG8_WAIT_V(6); PG8_BAR; PG8_MMA(1, 1, At, B1); PG8_BAR;
            PG8_LDB(B0, 1, 0); PG8_SCHED; PG8_LDA(At, 1, 0); PG8_STAGE(PG8_SA(0, 1), a2 + hstep, voffA);
            PG8_WAIT_L(8); PG8_BAR; PG8_WAIT_L(0); PG8_MMA(0, 0, At, B0); PG8_BAR; PG8_SCHED;
            PG8_LDB(B1, 1, 1); PG8_STAGE(PG8_SB(1, 0), b3, voffB);
            PG8_BAR; PG8_WAIT_L(0); PG8_MMA(0, 1, At, B1); PG8_BAR;
            PG8_LDA(At, 1, 1); PG8_STAGE(PG8_SA(1, 0), a3, voffA);
            PG8_BAR; PG8_WAIT_L(0); PG8_MMA(1, 0, At, B0); PG8_BAR; PG8_SCHED;
            PG8_STAGE(PG8_SB(1, 1), b3 + hstep, voffB);
            PG8_WAIT_V(6); PG8_BAR; PG8_MMA(1, 1, At, B1); PG8_BAR;
            }
        }
        if constexpr (SC != 0) { const unsigned long long t1 = __builtin_amdgcn_s_memrealtime(), c1 = __builtin_amdgcn_s_memtime();
            if (tid == 0) { PG8_LAS unsigned* scw = (PG8_LAS unsigned*)(lds + 143360 + 256); scw[0] += (unsigned)(t1 - sc_t0); scw[1] += (unsigned)(c1 - sc_c0); } }
        if constexpr (ALIGN_EPI) { if (wr == 0) PG8_BAR; }
        if constexpr (!Epi::AFTER_DRAIN) { if constexpr (Epi::HAS_PRE) E(acc, cur, wr, wc, fr, fq, pre); else E(acc, cur, wr, wc, fr, fq); S.done(cur); }
        if (!has_next) break;
#pragma unroll
        for (int a = 0; a < 2; ++a)
#pragma unroll
            for (int b = 0; b < 2; ++b)
#pragma unroll
                for (int m = 0; m < 4; ++m)
#pragma unroll
                    for (int n = 0; n < 2; ++n) acc[a][b][m][n] = (f32x4){0.f, 0.f, 0.f, 0.f};
        cur = nxt; cA = nA; cB = nB; ++ui;
        if constexpr (ALIGN_EPI) { if (wr == 1) PG8_BAR; }
    }
    PG8_WAIT_V(0);
    if constexpr (!ALIGN_EPI) { if (wr == 0) PG8_BAR; }
    PG8_BAR;
    if constexpr (Epi::AFTER_DRAIN) { E.fused(acc, cur, wr, wc, fr, fq, lds, wid, lane); S.done(cur); }
#undef PG8_SA
#undef PG8_SB
#undef PG8_STAGE
#undef PG8_LDA
#undef PG8_LDB
#undef PG8_MMA
#undef PG8_WAIT_V
#undef PG8_WAIT_L
#undef PG8_BAR
#undef PG8_SCHED
}
}

#define LAS __attribute__((address_space(3)))
#define XB_TMO      128
#define XB_XCNT(j)  (256  + 64 * (j))
#define XB_XSUB(j)  (1280 + 64 * (j))
#define XB_XGEN(j)  (2304 + 64 * (j))
#define XB_TOP      3328
#define XB_TOPGEN   3392
#define XCD_BAR_WORDS 3456
#define XB_SPIN_CAP (1u << 18)

__device__ __forceinline__ unsigned xb_ld(unsigned* p)              { return __hip_atomic_load(p, __ATOMIC_RELAXED, __HIP_MEMORY_SCOPE_AGENT); }
__device__ __forceinline__ unsigned xb_add(unsigned* p, unsigned v) { return __hip_atomic_fetch_add(p, v, __ATOMIC_RELAXED, __HIP_MEMORY_SCOPE_AGENT); }
__device__ __forceinline__ unsigned xb_xcc_id() { return (unsigned)__builtin_amdgcn_s_getreg((3 << 11) | 20) & 0xFu; }
#define XB_SPIN(cond, bar) do { unsigned _sp = 0; while (cond) { __builtin_amdgcn_s_sleep(1); \
    if ((++_sp & 255u) == 0u) { if (xb_ld(&(bar)[XB_TMO])) break; if (_sp > XB_SPIN_CAP) { atomicAdd(&(bar)[XB_TMO], 1u); break; } } } } while (0)

struct XcdBarrier {
    unsigned* bar; unsigned x;
    volatile LAS unsigned* st;
};

__device__ __forceinline__ XcdBarrier xcd_barrier_post(unsigned* bar, volatile LAS unsigned* st, bool leader) {
    XcdBarrier b; b.bar = bar; b.x = xb_xcc_id(); b.st = st;
    if (leader) (void)xb_add(&bar[XB_XCNT(b.x)], 1u);
    return b;
}
__device__ __forceinline__ void xcd_barrier_complete(unsigned* bar, unsigned x, unsigned& nloc, unsigned& nx) {
    const unsigned G = gridDim.x * gridDim.y * gridDim.z;
    unsigned sum, cnt, mine, sp = 0u;
    for (;;) {
        sum = 0u; cnt = 0u; mine = 0u;
        unsigned cv[16];
        { const unsigned* cb = &bar[XB_XCNT(0)]; static_assert(XB_XCNT(1) - XB_XCNT(0) == 64, "counters are 256 bytes apart");
          asm volatile("global_load_dword %0, %16, off sc1\n\tglobal_load_dword %1, %16, off offset:256 sc1\n\tglobal_load_dword %2, %16, off offset:512 sc1\n\tglobal_load_dword %3, %16, off offset:768 sc1\n\t"
                       "global_load_dword %4, %16, off offset:1024 sc1\n\tglobal_load_dword %5, %16, off offset:1280 sc1\n\tglobal_load_dword %6, %16, off offset:1536 sc1\n\tglobal_load_dword %7, %16, off offset:1792 sc1\n\t"
                       "global_load_dword %8, %16, off offset:2048 sc1\n\tglobal_load_dword %9, %16, off offset:2304 sc1\n\tglobal_load_dword %10, %16, off offset:2560 sc1\n\tglobal_load_dword %11, %16, off offset:2816 sc1\n\t"
                       "global_load_dword %12, %16, off offset:3072 sc1\n\tglobal_load_dword %13, %16, off offset:3328 sc1\n\tglobal_load_dword %14, %16, off offset:3584 sc1\n\tglobal_load_dword %15, %16, off offset:3840 sc1\n\ts_waitcnt vmcnt(0)"
                       : "=&v"(cv[0]), "=&v"(cv[1]), "=&v"(cv[2]), "=&v"(cv[3]), "=&v"(cv[4]), "=&v"(cv[5]), "=&v"(cv[6]), "=&v"(cv[7]), "=&v"(cv[8]), "=&v"(cv[9]), "=&v"(cv[10]), "=&v"(cv[11]), "=&v"(cv[12]), "=&v"(cv[13]), "=&v"(cv[14]), "=&v"(cv[15])
                       : "v"(cb) : "memory"); }
#pragma unroll
        for (unsigned j = 0; j < 16; ++j) { const unsigned c = cv[j]; sum += c; cnt += (c > 0u) ? 1u : 0u; mine = (j == x) ? c : mine; }
        if (sum == G) break;
        __builtin_amdgcn_s_sleep(1);
        if ((++sp & 255u) == 0u) { if (xb_ld(&bar[XB_TMO])) break; if (sp > XB_SPIN_CAP) { atomicAdd(&bar[XB_TMO], 1u); break; } }
    }
    nloc = mine > 0u ? mine : 1u; nx = cnt > 0u ? cnt : 1u;
}

__device__ __forceinline__ void xcd_barrier(const XcdBarrier& b, bool leader) {
    asm volatile("s_waitcnt vmcnt(0)" ::: "memory");
    __syncthreads();
    if (leader) {
        unsigned* bar = b.bar;
        __builtin_amdgcn_s_waitcnt(0);
        unsigned nloc = b.st[0], nx = b.st[1];
        if (nloc == 0u) { xcd_barrier_complete(bar, b.x, nloc, nx); b.st[0] = nloc; b.st[1] = nx; }
#if EARLY_WB
        __builtin_amdgcn_fence(__ATOMIC_RELEASE, "agent");
        asm volatile("s_waitcnt vmcnt(0)" ::: "memory");
#endif
        const unsigned old = xb_add(&bar[XB_XSUB(b.x)], 1u);
        const unsigned gen = old / nloc;
        if (old + 1u == (gen + 1u) * nloc) {
#if !EARLY_WB
            __builtin_amdgcn_fence(__ATOMIC_RELEASE, "agent");
#endif
            asm volatile("s_waitcnt vmcnt(0)" ::: "memory");
            const unsigned og = xb_add(&bar[XB_TOP], 1u);
            const unsigned tg = og / nx;
            if (og + 1u == (tg + 1u) * nx) xb_add(&bar[XB_TOPGEN], 1u);
            else XB_SPIN(xb_ld(&bar[XB_TOPGEN]) == tg, bar);
            __builtin_amdgcn_fence(__ATOMIC_ACQUIRE, "agent");
            xb_add(&bar[XB_XGEN(b.x)], 1u);
            asm volatile("s_waitcnt vmcnt(0)" ::: "memory");
        } else {
            XB_SPIN(xb_ld(&bar[XB_XGEN(b.x)]) == gen, bar);
            __builtin_amdgcn_fence(__ATOMIC_ACQUIRE, "agent");
            asm volatile("s_waitcnt vmcnt(0)" ::: "memory");
        }
    }
    __syncthreads();
}

constexpr int BATCH = 16, SEQ = 2048, DM = 1024, MTOK = BATCH * SEQ, FF = 2816, NGU = 2 * FF, NINP = 3584, INCOLS = 3360, DEPTH = 2;
constexpr int NWAVES = 8;
constexpr float EPS = 1e-6f;
typedef unsigned short bf16;
typedef unsigned v4u __attribute__((ext_vector_type(4)));
typedef unsigned v2u __attribute__((ext_vector_type(2)));
typedef float f32x4 __attribute__((ext_vector_type(4)));
#define LDS_WAIT() asm volatile("s_waitcnt lgkmcnt(0)" ::: "memory")

constexpr size_t MiB = 1u << 20;
constexpr size_t WS_CTL = 0, CTL_ZERO_BYTES = 160 * 1024;
constexpr size_t WS_TAB = 1 * MiB;
constexpr size_t TAB_COS = 0, TAB_SIN = 65536, TAB_B1 = 131072, TAB_W2T = 196608, TAB_SS2 = 262144;
constexpr size_t WS_W = 2 * MiB;
constexpr size_t WO_GU1 = 0, WO_DN1 = 11 * MiB, WO_GU2 = 16 * MiB + MiB / 2, WO_DN2 = 27 * MiB + MiB / 2, WO_IN = 33 * MiB, WO_OUT = 40 * MiB, WO_CMP = 42 * MiB;
constexpr size_t WS_X16 = 45 * MiB;
constexpr size_t WS_U = 109 * MiB;
constexpr size_t WS_HB = 173 * MiB;
constexpr size_t WS_HD = 349 * MiB;
constexpr size_t WS_PQ = 413 * MiB;
constexpr size_t WS_CC = 421 * MiB;
constexpr size_t WS_END = 422 * MiB;
constexpr size_t WS_QN = 173 * MiB, WS_KCR = 205 * MiB, WS_VCR = 213 * MiB, WS_KS = 221 * MiB, WS_VS = 229 * MiB, WS_KW = 237 * MiB, WS_VW = 245 * MiB;
constexpr size_t WS_MQ = 253 * MiB, WS_MK = 285 * MiB, WS_MV = 317 * MiB, WS_MO = 349 * MiB, WS_GATE = 381 * MiB;
static_assert(WS_GATE + 4 * MiB <= WS_PQ, "in-projection outputs end below PQ");
constexpr int CW_BAR = 4096, CW_QUEUE = 16384, CW_GRP = 20480, CW_CFLAG = 33280;
constexpr size_t WS_PART = 486 * MiB, WS_CMPW = 489 * MiB, WS_END3 = 491 * MiB;
static_assert((CW_QUEUE + 2 * 1024) <= CW_GRP && (CW_GRP + 6 * 128 * 16) * 4 <= (int)CTL_ZERO_BYTES && (CW_BAR + 3456) <= CW_QUEUE && WS_TAB + TAB_SS2 + 16 * 32768 <= WS_W, "control words inside the zeroed region");
constexpr int PH_BYTES = 143360, MISC_OFF = PH_BYTES, LDS_BYTES = 147456;

__device__ __forceinline__ unsigned f2bf(float f) { unsigned u = __builtin_bit_cast(unsigned, f); return (u + 0x7fffu + ((u >> 16) & 1u)) >> 16; }
__device__ __forceinline__ unsigned pk2(float lo, float hi) { return f2bf(lo) | (f2bf(hi) << 16); }
typedef float f32x2v_ __attribute__((ext_vector_type(2))); typedef __bf16 bf16x2v_ __attribute__((ext_vector_type(2)));
__device__ __forceinline__ unsigned cvtpk(float lo, float hi) { f32x2v_ v = {lo, hi}; bf16x2v_ b = __builtin_convertvector(v, bf16x2v_); return __builtin_bit_cast(unsigned, b); }
__device__ __forceinline__ float bflo(unsigned u) { return __builtin_bit_cast(float, u << 16); }
__device__ __forceinline__ float bfhi(unsigned u) { return __builtin_bit_cast(float, u & 0xffff0000u); }
__device__ __forceinline__ float bf2f(bf16 b) { return __builtin_bit_cast(float, (unsigned)b << 16); }
__device__ __forceinline__ float sigmoidf_(float x) { return __builtin_amdgcn_rcpf(1.f + __expf(-x)); }
__device__ __forceinline__ int fresh_lane() { unsigned z = 0u; asm volatile("" : "+v"(z)); return (int)__builtin_amdgcn_mbcnt_hi(~0u, __builtin_amdgcn_mbcnt_lo(~0u, z)); }
__device__ __forceinline__ float shx(float v, int mask, int lane) { return __builtin_bit_cast(float, __builtin_amdgcn_ds_bpermute((lane ^ mask) << 2, __builtin_bit_cast(int, v))); }
__device__ __forceinline__ unsigned shxu(unsigned v, int mask, int lane) { return (unsigned)__builtin_amdgcn_ds_bpermute((lane ^ mask) << 2, (int)v); }
__device__ __forceinline__ float shi(float v, int src) { return __builtin_bit_cast(float, __builtin_amdgcn_ds_bpermute(src << 2, __builtin_bit_cast(int, v))); }
__device__ __forceinline__ float wave_sum(float v, int lane) {
    (void)lane;
    v += __builtin_bit_cast(float, __builtin_amdgcn_update_dpp(0, __builtin_bit_cast(int, v), 0xB1, 0xF, 0xF, false));
    v += __builtin_bit_cast(float, __builtin_amdgcn_update_dpp(0, __builtin_bit_cast(int, v), 0x4E, 0xF, 0xF, false));
    v += __builtin_bit_cast(float, __builtin_amdgcn_update_dpp(0, __builtin_bit_cast(int, v), 0x124, 0xF, 0xF, false));
    v += __builtin_bit_cast(float, __builtin_amdgcn_update_dpp(0, __builtin_bit_cast(int, v), 0x128, 0xF, 0xF, false));
    const int iv = __builtin_bit_cast(int, v);
    const float a = __builtin_bit_cast(float, __builtin_amdgcn_readlane(iv, 0)), b = __builtin_bit_cast(float, __builtin_amdgcn_readlane(iv, 16));
    const float c = __builtin_bit_cast(float, __builtin_amdgcn_readlane(iv, 32)), d = __builtin_bit_cast(float, __builtin_amdgcn_readlane(iv, 48));
    return (a + b) + (c + d);
}

struct SrcGU { const float* W; const float* g; __device__ __forceinline__ float operator()(int k, int nd) const { const int pn = nd >> 8, r = nd & 255; const int col = (r < 128) ? (pn * 128 + r) : (FF + pn * 128 + r - 128); return W[(size_t)k * NGU + col]; } };
struct SrcPlain { const float* W; int N; const float* g; __device__ __forceinline__ float operator()(int k, int nd) const { return W[(size_t)k * N + nd]; } };
struct SrcIN { const float* W; const float* g; __device__ __forceinline__ float operator()(int k, int nd) const {
    const int col = nd < 1280 ? nd : (nd < 3328 ? nd + 24 : (nd < 3352 ? nd - 3328 + 1280 : (nd < 3360 ? nd : -1)));
    return col < 0 ? 0.f : W[(size_t)k * INCOLS + col]; } };
struct SrcCMP { const float* W1; const float* g; __device__ __forceinline__ float operator()(int k, int nd) const { const int kv = nd >> 8, r = nd & 255;
    return r < 128 ? W1[((size_t)kv * 2048 + k) * 128 + r] : W1[((size_t)kv * 2048 + 1024 + k) * 128 + r - 128]; } };

template <class SrcF>
__device__ __forceinline__ void transpose_item(const SrcF& src, int K, bf16* WT, LAS float* scr, int kb, int nb, int lane) {
    const int k0 = 64 * kb, n0 = 32 * nb, c = lane & 7;
    f32x4 ga = {1.f, 1.f, 1.f, 1.f}, gb = ga;
    if (src.g) { ga = *(const f32x4*)(src.g + k0 + 8 * c); gb = *(const f32x4*)(src.g + k0 + 8 * c + 4); }
    float tv[32];
#pragma unroll
    for (int i = 0; i < 32; ++i) tv[i] = src(k0 + 2 * i + (lane >> 5), n0 + (lane & 31));
#pragma unroll
    for (int i = 0; i < 32; ++i) { const int kk = 2 * i + (lane >> 5); scr[kk * 33 + (lane & 31)] = tv[i]; }
    LDS_WAIT(); asm volatile("" ::: "memory");
#pragma unroll
    for (int j = 0; j < 4; ++j) { const int n = (lane >> 3) + 8 * j; const LAS float* s = scr + (8 * c) * 33 + n;
        v4u o; o.x = cvtpk(s[0 * 33] * ga.x, s[1 * 33] * ga.y); o.y = cvtpk(s[2 * 33] * ga.z, s[3 * 33] * ga.w); o.z = cvtpk(s[4 * 33] * gb.x, s[5 * 33] * gb.y); o.w = cvtpk(s[6 * 33] * gb.z, s[7 * 33] * gb.w);
        *(v4u*)(WT + (size_t)(n0 + n) * K + k0 + 8 * c) = o; }
    LDS_WAIT(); asm volatile("" ::: "memory");
}

template <int MODE>
__device__ __forceinline__ void thin_phase(const bf16* HD, const float* xin_f32, bf16* X16, float* out_f32, float* R2, const float* gpost, float cc, int gw, int NGW, int lane) {
    f32x4 gp[4];
#pragma unroll
    for (int j = 0; j < 4; ++j) gp[j] = (MODE != 0) ? *(const f32x4*)(gpost + 4 * lane + 256 * j) : (f32x4){0.f, 0.f, 0.f, 0.f};
    f32x4 xf[4]; v2u xn[4], hn[4];
    if (gw < MTOK) {
#pragma unroll
        for (int j = 0; j < 4; ++j) { if (MODE == 0) xf[j] = *(const f32x4*)(xin_f32 + (size_t)gw * DM + 4 * lane + 256 * j);
            else { xn[j] = *(const v2u*)(X16 + (size_t)gw * DM + 4 * lane + 256 * j); hn[j] = *(const v2u*)(HD + (size_t)gw * DM + 4 * lane + 256 * j); } }
    }
    for (int m = gw; m < MTOK; m += NGW) {
        f32x4 x[4]; v2u hw[4];
#pragma unroll
        for (int j = 0; j < 4; ++j) { if (MODE == 0) x[j] = xf[j]; else { x[j] = (f32x4){bflo(xn[j].x), bfhi(xn[j].x), bflo(xn[j].y), bfhi(xn[j].y)}; hw[j] = hn[j]; } }
        const int m2 = m + NGW;
        if (m2 < MTOK) {
#pragma unroll
            for (int j = 0; j < 4; ++j) { if (MODE == 0) xf[j] = *(const f32x4*)(xin_f32 + (size_t)m2 * DM + 4 * lane + 256 * j);
                else { xn[j] = *(const v2u*)(X16 + (size_t)m2 * DM + 4 * lane + 256 * j); hn[j] = *(const v2u*)(HD + (size_t)m2 * DM + 4 * lane + 256 * j); } }
        }
        if (MODE != 0) {
            f32x4 h[4]; float ss = 0.f;
#pragma unroll
            for (int j = 0; j < 4; ++j) { h[j] = (f32x4){bflo(hw[j].x), bfhi(hw[j].x), bflo(hw[j].y), bfhi(hw[j].y)}; ss += (h[j].x * h[j].x + h[j].y * h[j].y) + (h[j].z * h[j].z + h[j].w * h[j].w); }
            const float r = cc * __frsqrt_rn(wave_sum(ss, lane) * (1.f / DM) + EPS);
#pragma unroll
            for (int j = 0; j < 4; ++j) x[j] = x[j] + (h[j] * r) * gp[j];
        }
        if (MODE == 2) {
#pragma unroll
            for (int j = 0; j < 4; ++j) *(f32x4*)(out_f32 + (size_t)m * DM + 4 * lane + 256 * j) = x[j];
        } else {
            float s2 = 0.f;
#pragma unroll
            for (int j = 0; j < 4; ++j) { s2 += (x[j].x * x[j].x + x[j].y * x[j].y) + (x[j].z * x[j].z + x[j].w * x[j].w);
                v2u w; w.x = cvtpk(x[j].x, x[j].y); w.y = cvtpk(x[j].z, x[j].w); *(v2u*)(X16 + (size_t)m * DM + 4 * lane + 256 * j) = w; }
            const float st = wave_sum(s2, lane);
            if (lane == 0) *(f32x4*)(R2 + (size_t)m * 4) = (f32x4){st, 0.f, 0.f, 0.f};
        }
    }
}

struct EpiSwiglu {
    static constexpr bool PERM = true, AFTER_DRAIN = false, HAS_PRE = true; struct Pre {};
    bf16* H; const float* SS2; LAS unsigned char* lred;
    __device__ __forceinline__ void pre_load(const pg8::Unit& u, int wr, int wc, Pre&) const {
        if (wc == 0) { const float* sp = SS2 + (size_t)(u.pm * 256 + wr * 64 + fresh_lane()) * 4;
            __builtin_amdgcn_global_load_lds((const unsigned*)sp, (LAS unsigned*)(lred + wr * 2048), 16, 0, 0);
            __builtin_amdgcn_global_load_lds((const unsigned*)(sp + 128 * 4), (LAS unsigned*)(lred + wr * 2048 + 1024), 16, 0, 0); } }
    __device__ __forceinline__ void operator()(const pg8::f32x4 (&acc)[2][2][4][2], const pg8::Unit& u, int wr, int wc, int fr, int fq, const Pre& P) const {
        float rsv[2][4];
        { const int ln = fq * 16 + fr; const f32x4 p0 = *(const LAS f32x4*)(lred + wr * 2048 + ln * 16), p1 = *(const LAS f32x4*)(lred + wr * 2048 + 1024 + ln * 16);
          const float r0 = __frsqrt_rn(((p0.x + p0.y) + (p0.z + p0.w)) * (1.f / DM) + EPS), r1 = __frsqrt_rn(((p1.x + p1.y) + (p1.z + p1.w)) * (1.f / DM) + EPS);
#pragma unroll
          for (int m = 0; m < 4; ++m) { rsv[0][m] = shi(r0, m * 16 + fr); rsv[1][m] = shi(r1, m * 16 + fr); } }
#pragma unroll
        for (int ai = 0; ai < 2; ++ai)
#pragma unroll
            for (int m = 0; m < 4; ++m) {
                const int row = u.pm * 256 + ai * 128 + wr * 64 + m * 16 + fr; const float rs = rsv[ai][m];
                typedef float f2 __attribute__((ext_vector_type(2)));
                f2 tg[4], tu[4], ex[4]; float o[8]; const float c1 = rs * -1.4426950408889634f, rs2 = rs * rs;
#pragma unroll
                for (int n = 0; n < 2; ++n) { const pg8::f32x4 g4 = acc[ai][0][m][n], u4 = acc[ai][1][m][n];
                    tg[2 * n] = (f2){g4[0], g4[1]}; tg[2 * n + 1] = (f2){g4[2], g4[3]}; tu[2 * n] = (f2){u4[0], u4[1]}; tu[2 * n + 1] = (f2){u4[2], u4[3]}; }
#pragma unroll
                for (int e = 0; e < 4; ++e) { const f2 a2 = tg[e] * c1; ex[e].x = __builtin_amdgcn_exp2f(a2.x); ex[e].y = __builtin_amdgcn_exp2f(a2.y); }
#pragma unroll
                for (int e = 0; e < 4; ++e) { const f2 d2 = ex[e] + 1.0f; ex[e].x = __builtin_amdgcn_rcpf(d2.x); ex[e].y = __builtin_amdgcn_rcpf(d2.y); tu[e] = (tg[e] * tu[e]) * rs2; }
#pragma unroll
                for (int e = 0; e < 4; ++e) { const f2 r2 = tu[e] * ex[e]; o[2 * e] = r2.x; o[2 * e + 1] = r2.y; }
                v4u w; w.x = pg8::cvt_pk_bf16(o[0], o[1]); w.y = pg8::cvt_pk_bf16(o[2], o[3]); w.z = pg8::cvt_pk_bf16(o[4], o[5]); w.w = pg8::cvt_pk_bf16(o[6], o[7]);
                *(v4u*)(H + (size_t)row * FF + u.pn * 128 + wc * 32 + fq * 8) = w;
            }
    }
};
#define EPI_LBAR() do { asm volatile("s_waitcnt lgkmcnt(0)" ::: "memory"); __builtin_amdgcn_s_barrier(); } while (0)
template <bool FINAL>
struct EpiResNorm {
    static constexpr bool PERM = !FINAL, AFTER_DRAIN = false, HAS_PRE = false; struct Pre {};
    unsigned char* ws; LAS float* red; const float* gpost; float* outf; float cc; int inst;
    __device__ __forceinline__ void operator()(const pg8::f32x4 (&acc)[2][2][4][2], const pg8::Unit& u, int wr, int wc, int fr_, int fq_) const {
        int fr = fr_, fq = fq_;
        bf16* X16 = (bf16*)(ws + WS_X16);
        const int ln = fresh_lane(), wv = wr * 4 + wc, tid = wv * 64 + ln; fr = ln & 15; fq = ln >> 4;
        const int r0 = u.pm * 256 + wr * 64 + fr, c0 = u.pn * 256 + wc * 32 + fq * (FINAL ? 4 : 8);
        v4u xv[2][4][2];
        if (wv != 0) {
#pragma unroll
            for (int ai = 0; ai < 2; ++ai)
#pragma unroll
                for (int m = 0; m < 4; ++m)
#pragma unroll
                    for (int bj = 0; bj < 2; ++bj) { const bf16* xp = X16 + (size_t)(r0 + ai * 128 + m * 16) * DM + c0 + bj * 128;
                        if (FINAL) { const v2u lo2 = *(const v2u*)xp, hi2 = *(const v2u*)(xp + 16); xv[ai][m][bj] = (v4u){lo2.x, lo2.y, hi2.x, hi2.y}; } else xv[ai][m][bj] = *(const v4u*)xp; }
        }
        if (tid >= 256) red[1280 + tid - 256] = gpost[u.pn * 256 + tid - 256];
#pragma unroll
        for (int ai = 0; ai < 2; ++ai)
#pragma unroll
            for (int m = 0; m < 4; ++m) { float s = 0.f;
#pragma unroll
                for (int bj = 0; bj < 2; ++bj)
#pragma unroll
                    for (int n = 0; n < 2; ++n) { const pg8::f32x4 a = acc[ai][bj][m][n]; s += (a[0] * a[0] + a[1] * a[1]) + (a[2] * a[2] + a[3] * a[3]); }
                s += shx(s, 16, ln); s += shx(s, 32, ln);
                if (fq == 0) red[wc * 256 + ai * 128 + wr * 64 + m * 16 + fr] = s; }
        EPI_LBAR();
        if (wv == 0) {
            unsigned* ctr = (unsigned*)(ws + WS_CTL) + CW_GRP + (inst * 128 + u.pm) * 16;
            unsigned* part = (unsigned*)(ws + WS_PART) + (size_t)inst * 4 * MTOK + u.pm * 256 + 4 * ln;
            const f32x4 p0 = *(const LAS f32x4*)(red + 4 * ln), p1 = *(const LAS f32x4*)(red + 256 + 4 * ln), p2 = *(const LAS f32x4*)(red + 512 + 4 * ln), p3 = *(const LAS f32x4*)(red + 768 + 4 * ln);
            const f32x4 ps = (p0 + p1) + (p2 + p3);
            unsigned* mine = part + (size_t)u.pn * MTOK;
            asm volatile("global_store_dwordx4 %0, %1, off sc1\n\ts_waitcnt vmcnt(0)" :: "v"(mine), "v"(ps) : "memory");
            if (ln == 0) { (void)__hip_atomic_fetch_add(ctr, 1u, __ATOMIC_RELAXED, __HIP_MEMORY_SCOPE_AGENT);
                unsigned sp = 0u; while (__hip_atomic_load(ctr, __ATOMIC_RELAXED, __HIP_MEMORY_SCOPE_AGENT) < 4u) { __builtin_amdgcn_s_sleep(1); if (++sp > (1u << 22)) break; } }
            asm volatile("" ::: "memory");
            f32x4 q0, q1, q2, q3;
            asm volatile("global_load_dwordx4 %0, %4, off sc1\n\tglobal_load_dwordx4 %1, %5, off sc1\n\tglobal_load_dwordx4 %2, %6, off sc1\n\tglobal_load_dwordx4 %3, %7, off sc1\n\ts_waitcnt vmcnt(0)"
                         : "=&v"(q0), "=&v"(q1), "=&v"(q2), "=&v"(q3) : "v"(part), "v"(part + MTOK), "v"(part + 2 * (size_t)MTOK), "v"(part + 3 * (size_t)MTOK) : "memory");
            const f32x4 t = ((q0 + q1) + (q2 + q3)) * (1.f / DM) + EPS;
            *(LAS f32x4*)(red + 1024 + 4 * ln) = (f32x4){cc * __frsqrt_rn(t.x), cc * __frsqrt_rn(t.y), cc * __frsqrt_rn(t.z), cc * __frsqrt_rn(t.w)};
#pragma unroll
            for (int ai = 0; ai < 2; ++ai)
#pragma unroll
                for (int m = 0; m < 4; ++m)
#pragma unroll
                    for (int bj = 0; bj < 2; ++bj) { const bf16* xp = X16 + (size_t)(r0 + ai * 128 + m * 16) * DM + c0 + bj * 128;
                        if (FINAL) { const v2u lo2 = *(const v2u*)xp, hi2 = *(const v2u*)(xp + 16); xv[ai][m][bj] = (v4u){lo2.x, lo2.y, hi2.x, hi2.y}; } else xv[ai][m][bj] = *(const v4u*)xp; }
        }
        EPI_LBAR();
#pragma unroll
        for (int ai = 0; ai < 2; ++ai)
#pragma unroll
            for (int m = 0; m < 4; ++m) { const float inv = red[1024 + ai * 128 + wr * 64 + m * 16 + fr]; float s = 0.f; const size_t rowo = (size_t)(r0 + ai * 128 + m * 16) * DM + c0;
                asm volatile("" ::: "memory");
#pragma unroll
                for (int bj = 0; bj < 2; ++bj) { const v4u xw = xv[ai][m][bj]; const LAS float* gl = red + 1280 + bj * 128 + wc * 32 + fq * (FINAL ? 4 : 8); const f32x4 gv0 = *(const LAS f32x4*)gl, gv1 = *(const LAS f32x4*)(gl + (FINAL ? 16 : 4));
                    f32x4 x0 = (f32x4){bflo(xw.x), bfhi(xw.x), bflo(xw.y), bfhi(xw.y)}, x1 = (f32x4){bflo(xw.z), bfhi(xw.z), bflo(xw.w), bfhi(xw.w)};
                    x0 = x0 + (acc[ai][bj][m][0] * inv) * gv0; x1 = x1 + (acc[ai][bj][m][1] * inv) * gv1;
                    if (FINAL) { float* op = outf + rowo + bj * 128; *(f32x4*)op = x0; *(f32x4*)(op + 16) = x1; }
                    else { s += ((x0.x * x0.x + x0.y * x0.y) + (x0.z * x0.z + x0.w * x0.w)) + ((x1.x * x1.x + x1.y * x1.y) + (x1.z * x1.z + x1.w * x1.w));
                        v4u w; w.x = pg8::cvt_pk_bf16(x0.x, x0.y); w.y = pg8::cvt_pk_bf16(x0.z, x0.w); w.z = pg8::cvt_pk_bf16(x1.x, x1.y); w.w = pg8::cvt_pk_bf16(x1.z, x1.w);
                        *(v4u*)(X16 + rowo + bj * 128) = w; } }
                if (!FINAL) { s += shx(s, 16, ln); s += shx(s, 32, ln); if (fq == 0) red[wc * 256 + ai * 128 + wr * 64 + m * 16 + fr] = s; } }
        if (!FINAL) {
            EPI_LBAR();
            if (tid < 256) ((float*)(ws + WS_TAB + TAB_SS2))[(size_t)(u.pm * 256 + tid) * 4 + u.pn] = (red[tid] + red[256 + tid]) + (red[512 + tid] + red[768 + tid]);
        }
    }
};
struct EpiCmpMlp {
    static constexpr bool PERM = true, AFTER_DRAIN = true, HAS_PRE = false; struct Pre {};
    unsigned char* ws; const float* b1; const bf16* w2t;
    __device__ __forceinline__ void operator()(const pg8::f32x4 (&)[2][2][4][2], const pg8::Unit&, int, int, int, int) const {}
    __device__ __forceinline__ void fused(const pg8::f32x4 (&acc)[2][2][4][2], const pg8::Unit& u, int wr, int wc, int fr_, int fq_, LAS unsigned char* lds, int wid, int lane_) const {
        (void)fr_; (void)fq_; (void)lane_;
        const int ln = fresh_lane(), fr = ln & 15, fq = ln >> 4, kv = u.pm >> 4;
        pg8::bf16x8 xf[4][4];
        { const bf16* wp = w2t + (size_t)kv * 64 * 128 + fr * 128 + fq * 8;
#pragma unroll
          for (int ib = 0; ib < 4; ++ib)
#pragma unroll
              for (int ks = 0; ks < 4; ++ks) xf[ib][ks] = *(const pg8::bf16x8*)(wp + ib * 16 * 128 + ks * 32); }
        f32x4 bb[2];
#pragma unroll
        for (int n = 0; n < 2; ++n) bb[n] = *(const f32x4*)(b1 + kv * 128 + wc * 32 + fq * 8 + 4 * n);
#pragma unroll
        for (int ai = 0; ai < 2; ++ai)
#pragma unroll
            for (int m = 0; m < 4; ++m) { const int row = ai * 128 + wr * 64 + m * 16 + fr;
#pragma unroll
                for (int n = 0; n < 2; ++n) *(LAS f32x4*)(lds + row * 512 + (((wc * 8 + fq * 2 + n) ^ (row & 15)) << 4)) = acc[ai][1][m][n]; }
        EPI_LBAR();
        v4u hv[2][4];
#pragma unroll
        for (int ai = 0; ai < 2; ++ai)
#pragma unroll
            for (int m = 0; m < 4; ++m) { const int row = ai * 128 + wr * 64 + m * 16 + fr, rn = (row < 255) ? row + 1 : 255; float h[8];
#pragma unroll
                for (int n = 0; n < 2; ++n) { const f32x4 q = *(const LAS f32x4*)(lds + rn * 512 + (((wc * 8 + fq * 2 + n) ^ (rn & 15)) << 4)); const f32x4 v = acc[ai][0][m][n] + q + bb[n];
#pragma unroll
                    for (int e = 0; e < 4; ++e) { const float x = v[e], t = x * (1.f + 0.044715f * x * x) * (-2.f * 0.7978845608028654f * 1.4426950408889634f);
                        h[4 * n + e] = ((row & 127) == 127) ? 0.f : x * __builtin_amdgcn_rcpf(1.f + __builtin_amdgcn_exp2f(t)); } }
                hv[ai][m] = (v4u){cvtpk(h[0], h[1]), cvtpk(h[2], h[3]), cvtpk(h[4], h[5]), cvtpk(h[6], h[7])}; }
        EPI_LBAR();
#pragma unroll
        for (int ai = 0; ai < 2; ++ai)
#pragma unroll
            for (int m = 0; m < 4; ++m) { const int row = ai * 128 + wr * 64 + m * 16 + fr; *(LAS v4u*)(lds + row * 256 + (((wc * 4 + fq) ^ (row & 15)) << 4)) = hv[ai][m]; }
        EPI_LBAR();
        bf16* CC = (bf16*)(ws + WS_CC);
#pragma unroll
        for (int jj = 0; jj < 2; ++jj) { const int row = (2 * wid + jj) * 16 + fr; pg8::f32x4 o[4];
#pragma unroll
            for (int ib = 0; ib < 4; ++ib) o[ib] = (pg8::f32x4){0.f, 0.f, 0.f, 0.f};
#pragma unroll
            for (int ks = 0; ks < 4; ++ks) { const pg8::bf16x8 y = *(const LAS pg8::bf16x8*)(lds + row * 256 + (((ks * 4 + fq) ^ (row & 15)) << 4));
#pragma unroll
                for (int ib = 0; ib < 4; ++ib) o[ib] = __builtin_amdgcn_mfma_f32_16x16x32_bf16(xf[ib][ks], y, o[ib], 0, 0, 0); }
            bf16* cp = CC + ((size_t)u.pm * 256 + row) * 64 + 4 * fq;
#pragma unroll
            for (int ib = 0; ib < 4; ++ib) { v2u w; w.x = cvtpk(o[ib][0], o[ib][1]); w.y = cvtpk(o[ib][2], o[ib][3]); *(v2u*)(cp + ib * 16) = w; } }
    }
};
struct CmpOrder {
    int c, G;
    __device__ __forceinline__ bool next(int i, pg8::Unit& u) const { const int idx = i * G + c; if (idx >= 32) return false; u.pm = idx; u.pn = idx >> 4; return true; }
    __device__ __forceinline__ void a_ready(const pg8::Unit&) const {}
    __device__ __forceinline__ void done(const pg8::Unit&) const {}
};
struct EpiInProj {
    static constexpr bool PERM = true, AFTER_DRAIN = false, HAS_PRE = true; struct Pre {};
    unsigned char* ws; LAS unsigned char* lred;
    __device__ __forceinline__ void pre_load(const pg8::Unit& u, int wr, int wc, Pre&) const {
        if (wc == 0) { const float* sp = (const float*)(ws + WS_TAB + TAB_SS2) + (size_t)(u.pm * 256 + wr * 64 + fresh_lane()) * 4;
            __builtin_amdgcn_global_load_lds((const unsigned*)sp, (LAS unsigned*)(lred + wr * 2048), 16, 0, 0);
            __builtin_amdgcn_global_load_lds((const unsigned*)(sp + 128 * 4), (LAS unsigned*)(lred + wr * 2048 + 1024), 16, 0, 0); } }
    __device__ __forceinline__ void operator()(const pg8::f32x4 (&acc)[2][2][4][2], const pg8::Unit& u, int wr, int wc, int fr, int fq, const Pre&) const {
        const int pn = u.pn;
        const bool ropet = (pn < 2) || (pn == 3) || (pn == 4);
        const bool ropew = ropet && ((wc & 1) == 0);
        float rsv[2][4];
#pragma unroll
        for (int ai = 0; ai < 2; ++ai)
#pragma unroll
            for (int m = 0; m < 4; ++m) { const f32x4 p = *(const LAS f32x4*)(lred + wr * 2048 + ai * 1024 + (m * 16 + fr) * 16); rsv[ai][m] = __frsqrt_rn(((p.x + p.y) + (p.z + p.w)) * (1.f / DM) + EPS); }
#pragma unroll
        for (int ai = 0; ai < 2; ++ai)
#pragma unroll
            for (int m = 0; m < 4; ++m) {
                const int row = u.pm * 256 + ai * 128 + wr * 64 + m * 16 + fr;
                const int b = row >> 11, t = row & 2047; const float rs = rsv[ai][m];
                f32x4 c0, c1, s0, s1;
                if (ropew) {
                    const float tf = (float)t; float cs_[8], sn_[8];
                    const float ifr[8] = {1.5915494309e-01f, 3.0863763405e-02f, 5.9851857127e-03f, 1.1606636412e-03f, 2.2507907904e-04f, 4.3647952793e-05f, 8.4643308082e-06f, 1.6414262628e-06f};
#pragma unroll
                    for (int e = 0; e < 8; ++e) { const float rv = __builtin_amdgcn_fractf(tf * ifr[e]); cs_[e] = __builtin_amdgcn_cosf(rv); sn_[e] = __builtin_amdgcn_sinf(rv); }
                    c0 = (f32x4){cs_[0], cs_[1], cs_[2], cs_[3]}; c1 = (f32x4){cs_[4], cs_[5], cs_[6], cs_[7]}; s0 = (f32x4){sn_[0], sn_[1], sn_[2], sn_[3]}; s1 = (f32x4){sn_[4], sn_[5], sn_[6], sn_[7]}; }
#pragma unroll
                for (int bj = 0; bj < 2; ++bj) {
                    f32x4 v0 = acc[ai][bj][m][0] * rs, v1 = acc[ai][bj][m][1] * rs;
                    const int cl = bj * 128 + wc * 32 + fq * 8;
                    if (ropew && (pn < 2 || bj == 0)) {
                        f32x4 p0, p1; const int ln = fq * 16 + fr;
                        p0.x = shx(v0.x, 16, ln); p0.y = shx(v0.y, 16, ln); p0.z = shx(v0.z, 16, ln); p0.w = shx(v0.w, 16, ln);
                        p1.x = shx(v1.x, 16, ln); p1.y = shx(v1.y, 16, ln); p1.z = shx(v1.z, 16, ln); p1.w = shx(v1.w, 16, ln);
                        const float sg = (fq == 0) ? -1.f : 1.f;
                        if (fq < 2) { v0 = v0 * c0 + (p0 * s0) * sg; v1 = v1 * c1 + (p1 * s1) * sg; }
                    }
                    if (pn < 2) { v0 = v0 * 0.18033688011112042f; v1 = v1 * 0.18033688011112042f; }
                    if (pn == 13) { if (cl < 32) { float* p = (float*)(ws + WS_GATE) + (size_t)row * 32 + cl; *(f32x4*)p = v0; *(f32x4*)(p + 4) = v1; } }
                    else {
                        size_t off;
                        if (pn < 2) off = WS_QN + ((size_t)row * 512 + pn * 256 + cl) * 2;
                        else if (pn < 5) { const int g = wc >> 1, d = (wc & 1) * 32 + fq * 8; off = WS_KCR + (size_t)((pn - 2) * 2 + bj) * (8 * MiB) + (((size_t)(b * 2 + g) * SEQ + t) * 64 + d) * 2; }
                        else { const int q = pn - 5; off = WS_MQ + (size_t)(q >> 1) * (32 * MiB) + ((size_t)row * 512 + (q & 1) * 256 + cl) * 2; }
                        v4u w; w.x = pg8::cvt_pk_bf16(v0.x, v0.y); w.y = pg8::cvt_pk_bf16(v0.z, v0.w); w.z = pg8::cvt_pk_bf16(v1.x, v1.y); w.w = pg8::cvt_pk_bf16(v1.z, v1.w);
                        *(v4u*)(ws + off) = w;
                    }
                }
            }
    }
};
static_assert(WS_VCR == WS_KCR + 8 * MiB && WS_KS == WS_KCR + 16 * MiB && WS_VS == WS_KCR + 24 * MiB && WS_KW == WS_KCR + 32 * MiB && WS_VW == WS_KCR + 40 * MiB, "kv buffers are 8 MiB apart in (pn, bj) order");
static_assert(WS_MK == WS_MQ + 32 * MiB && WS_MV == WS_MQ + 64 * MiB && WS_MO == WS_MQ + 96 * MiB, "mLSTM buffers are 32 MiB apart");

struct MixPtrs { unsigned char* ws; const float *conv_w, *conv_b, *i_bias, *f_bias, *mnorm_g; };
#define MP_QN ((const bf16*)(P.ws + WS_QN))
#define MP_KS ((const bf16*)(P.ws + WS_KS))
#define MP_VS ((const bf16*)(P.ws + WS_VS))
#define MP_KW ((const bf16*)(P.ws + WS_KW))
#define MP_VW ((const bf16*)(P.ws + WS_VW))
#define MP_KC ((const bf16*)(P.ws + WS_CC))
#define MP_VC ((const bf16*)(P.ws + WS_CC) + (size_t)4096 * 64)
#define MP_MQ ((const bf16*)(P.ws + WS_MQ))
#define MP_MK ((const bf16*)(P.ws + WS_MK))
#define MP_MV ((const bf16*)(P.ws + WS_MV))
#define MP_MO ((const bf16*)(P.ws + WS_MO))
#define MP_GATE ((const float*)(P.ws + WS_GATE))
#define MP_Y ((bf16*)(P.ws + WS_U))


typedef float f32x16 __attribute__((ext_vector_type(16)));
typedef short bf16x8v __attribute__((ext_vector_type(8)));
typedef short s16x4v __attribute__((ext_vector_type(4)));
typedef float f32x2v __attribute__((ext_vector_type(2)));
typedef __bf16 bf16x2v __attribute__((ext_vector_type(2)));
#define MFMA32(a, b, c) __builtin_amdgcn_mfma_f32_32x32x16_bf16((a), (b), (c), 0, 0, 0)
__device__ __forceinline__ s16x4v tr_read(const LAS unsigned char* p) { return __builtin_bit_cast(s16x4v, __builtin_amdgcn_ds_read_tr16_b64_v4i16((LAS s16x4v*)p)); }
__device__ __forceinline__ int tile_off(int key, int ch8) { return (ch8 >> 2) * 4096 + key * 64 + (((ch8 & 3) ^ ((key >> 2) & 3)) << 4); }
constexpr int NM_SLOT = 0, NM_IMP = 65536, NM_IMS = 99328, NM_SEL = 108544, NM_ITEM = 108864;
constexpr float QK_SCALE = 0.125f * 1.4426950408889634f;

#define SBAR() __builtin_amdgcn_sched_barrier(0)
__device__ __forceinline__ void xor32_pair(float v, float& lo, float& hi) { float a = v, b = v; asm volatile("s_nop 1\n\tv_permlane32_swap_b32 %0, %1" : "+v"(a), "+v"(b)); lo = a; hi = b; }
__device__ __forceinline__ float xor32_max(float v) { float lo, hi; xor32_pair(v, lo, hi); float r; asm("v_max_f32 %0, %1, %2" : "=v"(r) : "v"(lo), "v"(hi)); return r; }
__device__ __forceinline__ float xor32_sum(float v) { float lo, hi; xor32_pair(v, lo, hi); return lo + hi; }
__device__ __forceinline__ float max2f(float a, float b) { float r; asm("v_max_f32 %0, %1, %2" : "=v"(r) : "v"(a), "v"(b)); return r; }
__device__ __forceinline__ float max3f(float a, float b, float c) { float r; asm("v_max3_f32 %0, %1, %2, %3" : "=v"(r) : "v"(a), "v"(b), "v"(c)); return r; }
#define LBAR() asm volatile("s_waitcnt lgkmcnt(0)\n\ts_barrier" ::: "memory")
__device__ __forceinline__ void k_load(const LAS unsigned char* Ks, int r, int h, bf16x8v (&kf)[8]) {
    const int sw = (r >> 2) & 3;
#pragma unroll
    for (int ks = 0; ks < 4; ++ks) { const int off = (ks >> 1) * 4096 + r * 64 + (((((ks & 1) << 1) + h) ^ sw) << 4);
        kf[2 * ks] = *(const LAS bf16x8v*)(Ks + off); kf[2 * ks + 1] = *(const LAS bf16x8v*)(Ks + off + 2048); }
}
__device__ __forceinline__ void qk_mma(const bf16x8v (&kf)[8], const bf16x8v (&qf)[4], f32x16& p0, f32x16& p1) {
    const f32x16 z = {0.f, 0.f, 0.f, 0.f, 0.f, 0.f, 0.f, 0.f, 0.f, 0.f, 0.f, 0.f, 0.f, 0.f, 0.f, 0.f};
#pragma unroll
    for (int ks = 0; ks < 4; ++ks) { p0 = MFMA32(kf[2 * ks], qf[ks], ks ? p0 : z); p1 = MFMA32(kf[2 * ks + 1], qf[ks], ks ? p1 : z); }
}
__device__ __forceinline__ void v_load(const LAS unsigned char* Vs, int lane, bf16x8v (&vf)[8]) {
    const int h = lane >> 5, i16 = lane & 15, q = i16 >> 2, p = i16 & 3, gi = (lane >> 4) & 1;
    const int cidx = 2 * gi + (p >> 1), e8 = (p & 1) << 3;
    const int offlo = q * 64 + ((cidx ^ h) << 4) + e8 + h * 256, offhi = q * 64 + ((cidx ^ (h | 2)) << 4) + e8 + h * 256 + 512;
#pragma unroll
    for (int kb = 0; kb < 2; ++kb)
#pragma unroll
        for (int s = 0; s < 2; ++s)
#pragma unroll
            for (int db = 0; db < 2; ++db) { const LAS unsigned char* base = Vs + db * 4096 + (kb * 32 + s * 16) * 64;
                const s16x4v lo = tr_read(base + offlo), hi = tr_read(base + offhi);
                vf[(kb * 2 + s) * 2 + db] = __builtin_shufflevector(lo, hi, 0, 1, 2, 3, 4, 5, 6, 7); }
}
__device__ __forceinline__ void pv_mma(const bf16x8v (&vf)[8], const f32x16& p0, const f32x16& p1, f32x16 (&o)[2]) {
#pragma unroll
    for (int kb = 0; kb < 2; ++kb)
#pragma unroll
        for (int s = 0; s < 2; ++s) {
            const f32x16& P = kb ? p1 : p0;
            v4u pw; pw.x = cvtpk(P[8 * s + 0], P[8 * s + 1]); pw.y = cvtpk(P[8 * s + 2], P[8 * s + 3]); pw.z = cvtpk(P[8 * s + 4], P[8 * s + 5]); pw.w = cvtpk(P[8 * s + 6], P[8 * s + 7]);
            const bf16x8v pf = __builtin_bit_cast(bf16x8v, pw);
            o[0] = MFMA32(vf[(kb * 2 + s) * 2], pf, o[0]); o[1] = MFMA32(vf[(kb * 2 + s) * 2 + 1], pf, o[1]);
        }
}

__device__ __forceinline__ void nsa_unit_mfma(LAS unsigned char* L, const MixPtrs& P, int b, int g, int c, int tid_in) {
    int tid_l = tid_in; asm volatile("" : "+v"(tid_l));
    const int tid = tid_l, lane = tid & 63, w = __builtin_amdgcn_readfirstlane(tid >> 6);
    const int r = lane & 31, h = lane >> 5, head = w >> 1, qi = (w & 1) * 32 + r, t = c * 64 + qi;
    const size_t row = (size_t)b * SEQ + t;
    LAS unsigned* SEL = (LAS unsigned*)(L + NM_SEL); LAS int* ITEM = (LAS int*)(L + NM_ITEM);
    const size_t kvbase = (size_t)(b * 2 + g) * SEQ * 64, ccbase = (size_t)(b * 2 + g) * 128 * 64;
    const int skey = tid >> 3, sch = tid & 7, soff = tile_off(skey, sch);
    bf16x8v qf[4];
    { const bf16* qp = MP_QN + row * 512 + (g * 4 + head) * 64 + 8 * h;
#pragma unroll
      for (int ks = 0; ks < 4; ++ks) qf[ks] = *(const bf16x8v*)(qp + 16 * ks); }
    const float* gp = MP_GATE + row * 32 + g * 4 + head;
    float one = 1.f; asm volatile("" : "+v"(one));
    const float gate_c = __builtin_amdgcn_rcpf(one + __expf(-gp[0])), gate_s = __builtin_amdgcn_rcpf(one + __expf(-gp[8])), gate_w = __builtin_amdgcn_rcpf(one + __expf(-gp[16]));
    f32x16 oacc[2];
    {
        const bf16* kc = MP_KC + ccbase; const bf16* vc = MP_VC + ccbase;
        const v4u k0 = *(const v4u*)(kc + tid * 8), k1 = *(const v4u*)(kc + 4096 + tid * 8), v0 = *(const v4u*)(vc + tid * 8), v1 = *(const v4u*)(vc + 4096 + tid * 8);
        LBAR();
        *(LAS v4u*)(L + NM_SLOT + soff) = k0; *(LAS v4u*)(L + NM_SLOT + 8192 + soff) = v0; *(LAS v4u*)(L + NM_SLOT + 16384 + soff) = k1; *(LAS v4u*)(L + NM_SLOT + 24576 + soff) = v1;
        if (tid < 64) SEL[tid] = 0u;
        LBAR();
        f32x16 s0, s1, s2, s3;
        { bf16x8v kfa[8], kfb[8]; k_load(L + NM_SLOT, r, h, kfa); k_load(L + NM_SLOT + 16384, r, h, kfb); SBAR(); qk_mma(kfa, qf, s0, s1); qk_mma(kfb, qf, s2, s3); }
        const int nlim = (t >= 31) ? (((t - 31) >> 4) < 126 ? ((t - 31) >> 4) : 126) : -1;
        float mx, mxv[4] = {-1e20f, -1e20f, -1e20f, -1e20f};
#pragma unroll
        for (int e = 0; e < 16; ++e) { const int cr = (e & 3) + 8 * (e >> 2) + 4 * h;
            s0[e] = (cr <= nlim) ? s0[e] * QK_SCALE : -1e30f; s1[e] = (cr + 32 <= nlim) ? s1[e] * QK_SCALE : -1e30f;
            s2[e] = (cr + 64 <= nlim) ? s2[e] * QK_SCALE : -1e30f; s3[e] = (cr + 96 <= nlim) ? s3[e] * QK_SCALE : -1e30f;
            mxv[e & 3] = fmaxf(fmaxf(mxv[e & 3], fmaxf(s0[e], s1[e])), fmaxf(s2[e], s3[e])); }
        mx = fmaxf(fmaxf(mxv[0], mxv[1]), fmaxf(mxv[2], mxv[3]));
        mx = xor32_max(mx);
        float ls, lsv[4] = {0.f, 0.f, 0.f, 0.f};
#pragma unroll
        for (int e = 0; e < 16; ++e) { s0[e] = __builtin_amdgcn_exp2f(s0[e] - mx); s1[e] = __builtin_amdgcn_exp2f(s1[e] - mx); s2[e] = __builtin_amdgcn_exp2f(s2[e] - mx); s3[e] = __builtin_amdgcn_exp2f(s3[e] - mx);
            lsv[e & 3] += (s0[e] + s1[e]) + (s2[e] + s3[e]); }
        ls = (lsv[0] + lsv[1]) + (lsv[2] + lsv[3]);
        ls = xor32_sum(ls);
        const float il = (ls > 0.f) ? __builtin_amdgcn_rcpf(ls) : 0.f;
#pragma unroll
        for (int e = 0; e < 16; ++e) { s0[e] *= il; s1[e] *= il; s2[e] *= il; s3[e] *= il; }
        { LAS float* IMP = (LAS float*)(L + NM_IMP) + (w * 32 + r) * 33; float plprev = 0.f;
#pragma unroll
          for (int x = 0; x < 16; ++x) {
              const f32x16& S = (x < 4) ? s0 : ((x < 8) ? s1 : ((x < 12) ? s2 : s3)); const int g4 = (x & 3) * 4;
              const float own = (S[g4] + S[g4 + 1]) + (S[g4 + 2] + S[g4 + 3]);
              const float pl = shx(S[g4 + 3], 32, lane);
              if (h == 1) IMP[2 * x + 1] = own + pl; else IMP[2 * x] = own + plprev;
              plprev = pl;
          }
        }
        oacc[0] = (f32x16){0.f, 0.f, 0.f, 0.f, 0.f, 0.f, 0.f, 0.f, 0.f, 0.f, 0.f, 0.f, 0.f, 0.f, 0.f, 0.f}; oacc[1] = oacc[0];
        { bf16x8v vfa[8], vfb[8]; v_load(L + NM_SLOT + 8192, lane, vfa); v_load(L + NM_SLOT + 24576, lane, vfb); SBAR(); pv_mma(vfa, s0, s1, oacc); pv_mma(vfb, s2, s3, oacc); }
#pragma unroll
        for (int e = 0; e < 16; ++e) { oacc[0][e] *= gate_c; oacc[1][e] *= gate_c; }
    }
    LBAR();
    { const int i = tid & 63, jg = tid >> 6; const LAS float* I8 = (const LAS float*)(L + NM_IMP); LAS float* IMS = (LAS float*)(L + NM_IMS);
#pragma unroll
      for (int jj = 0; jj < 4; ++jj) { const int j = 4 * jg + jj; const int wq = (i >> 5), rq = i & 31;
          IMS[i * 36 + j] = (I8[((0 + wq) * 32 + rq) * 33 + j] + I8[((2 + wq) * 32 + rq) * 33 + j]) + (I8[((4 + wq) * 32 + rq) * 33 + j] + I8[((6 + wq) * 32 + rq) * 33 + j]); }
      LBAR();
      unsigned bits = 0u;
      if (c + 1 <= 16) { if (jg == 0) bits = (1u << (c + 1)) - 1u; }
      else { if (jg == 0) bits = 1u | (1u << c) | (1u << (c - 1));
          { float iv[32];
#pragma unroll
            for (int q8 = 0; q8 < 8; ++q8) { const f32x4 x = *(const LAS f32x4*)(IMS + i * 36 + 4 * q8); iv[4 * q8] = x.x; iv[4 * q8 + 1] = x.y; iv[4 * q8 + 2] = x.z; iv[4 * q8 + 3] = x.w; }
#pragma unroll
            for (int jj = 0; jj < 4; ++jj) { const int j = 4 * jg + jj; const float vj = IMS[i * 36 + j]; int rank = 0;
#pragma unroll
                for (int i2 = 1; i2 < 30; ++i2) rank += (i2 <= c - 2 && (iv[i2] > vj || (iv[i2] == vj && i2 < j))) ? 1 : 0;
                if (j >= 1 && j <= c - 2 && rank < 13) bits |= 1u << j; } } }
      if (bits) atomicOr((unsigned*)&SEL[i], bits);
      LBAR();
      if (w == 0) { unsigned so = SEL[lane];
#pragma unroll
          for (int o2 = 32; o2; o2 >>= 1) so |= shxu(so, o2, lane);
          if (lane == 0) { int n = 0; for (int j = 0; j <= c; ++j) if ((so >> j) & 1u) ITEM[n++] = j; const int j0 = (c - 8 > 0) ? c - 8 : 0; for (int j = j0; j <= c; ++j) ITEM[n++] = 64 + j; ITEM[n] = -1; ITEM[47] = n; } }
      LBAR();
    }
    const unsigned mysel = SEL[qi]; const int nitem = ITEM[47];
    f32x16 o[2]; float m = -1e20f, lsum = 0.f; int prev_kind = 0;
    o[0] = (f32x16){0.f, 0.f, 0.f, 0.f, 0.f, 0.f, 0.f, 0.f, 0.f, 0.f, 0.f, 0.f, 0.f, 0.f, 0.f, 0.f}; o[1] = o[0];
    const int npair = (nitem + 1) >> 1;
    v4u rk0, rv0, rk1, rv1;
#define NSA_LOAD_PAIR(ip_) do { const int ia_ = ITEM[2 * (ip_)], ib_ = ITEM[2 * (ip_) + 1]; \
        { const bf16* kp = ((ia_ & 64) ? MP_KW : MP_KS) + kvbase + (size_t)(ia_ & 63) * 4096; const bf16* vp = ((ia_ & 64) ? MP_VW : MP_VS) + kvbase + (size_t)(ia_ & 63) * 4096; rk0 = *(const v4u*)(kp + tid * 8); rv0 = *(const v4u*)(vp + tid * 8); } \
        if (ib_ >= 0) { const bf16* kp = ((ib_ & 64) ? MP_KW : MP_KS) + kvbase + (size_t)(ib_ & 63) * 4096; const bf16* vp = ((ib_ & 64) ? MP_VW : MP_VS) + kvbase + (size_t)(ib_ & 63) * 4096; rk1 = *(const v4u*)(kp + tid * 8); rv1 = *(const v4u*)(vp + tid * 8); } } while (0)
#define NSA_WRITE_PAIR(sb_) do { *(LAS v4u*)(L + (sb_) + soff) = rk0; *(LAS v4u*)(L + (sb_) + 8192 + soff) = rv0; *(LAS v4u*)(L + (sb_) + 16384 + soff) = rk1; *(LAS v4u*)(L + (sb_) + 24576 + soff) = rv1; } while (0)
    rk1 = (v4u){0u, 0u, 0u, 0u}; rv1 = rk1;
    NSA_LOAD_PAIR(0);
    NSA_WRITE_PAIR(NM_SLOT + 32768);
    LBAR();
#pragma unroll 1
    for (int ip = 0; ip < npair; ++ip) {
        if (ip + 1 < npair) NSA_LOAD_PAIR(ip + 1);
        const int sbase = NM_SLOT + ((ip + 1) & 1) * 32768;
#pragma unroll 1
        for (int half = 0; half < 2; ++half) {
            const int item = ITEM[2 * ip + half];
            if (item < 0) break;
            const int kind = item >> 6, j = item & 63;
            if (kind != prev_kind) {
                const float tot = xor32_sum(lsum); const float sc = gate_s * __builtin_amdgcn_rcpf(tot);
#pragma unroll
                for (int e = 0; e < 16; ++e) { oacc[0][e] += o[0][e] * sc; oacc[1][e] += o[1][e] * sc; o[0][e] = 0.f; o[1][e] = 0.f; }
                m = -1e20f; lsum = 0.f; prev_kind = kind;
            }
            int klo, khi;
            if (kind == 0) { klo = 0; khi = ((mysel >> j) & 1u) ? ((j < c) ? 63 : qi) : -1; }
            else { klo = t - 511 - 64 * j; khi = t - 64 * j; if (khi > 63) khi = 63; if (klo < 0) klo = 0; }
            const LAS unsigned char* slot = L + sbase + half * 16384;
            if (__any(khi >= klo)) {
                f32x16 p0, p1; bf16x8v vf[8];
                { bf16x8v kf[8]; k_load(slot, r, h, kf); SBAR(); qk_mma(kf, qf, p0, p1); }
                v_load(slot + 8192, lane, vf); SBAR();
                if (!__all(klo == 0 && khi == 63)) {
                    const int a = klo - 4 * h, z = khi - 4 * h;
#pragma unroll
                    for (int e = 0; e < 16; ++e) { const int cr = (e & 3) + 8 * (e >> 2);
                        p0[e] = (cr >= a && cr <= z) ? p0[e] : -1e30f; p1[e] = (cr + 32 >= a && cr + 32 <= z) ? p1[e] : -1e30f; }
                }
                float tm;
                { float ma = max2f(p0[0], p1[0]), mb = max2f(p0[1], p1[1]), mc2 = max2f(p0[2], p1[2]), md = max2f(p0[3], p1[3]);
#pragma unroll
                  for (int e = 4; e < 16; e += 4) { ma = max3f(ma, p0[e], p1[e]); mb = max3f(mb, p0[e + 1], p1[e + 1]); mc2 = max3f(mc2, p0[e + 2], p1[e + 2]); md = max3f(md, p0[e + 3], p1[e + 3]); }
                  tm = max3f(ma, mb, max2f(mc2, md)); }
                tm = xor32_max(tm);
                const float mn = fmaxf(m, tm * QK_SCALE);
                if (!__all(mn == m)) { const float corr = __builtin_amdgcn_exp2f(m - mn); lsum *= corr;
#pragma unroll
                    for (int e = 0; e < 16; ++e) { o[0][e] *= corr; o[1][e] *= corr; }
                    m = mn; }
                { const f32x2v sc2 = {QK_SCALE, QK_SCALE}, mm2 = {m, m}; f32x2v ta = {0.f, 0.f}, tb = {0.f, 0.f};
#pragma unroll
                  for (int e = 0; e < 16; e += 2) { const f32x2v a0 = (f32x2v){p0[e], p0[e + 1]} * sc2 - mm2, a1 = (f32x2v){p1[e], p1[e + 1]} * sc2 - mm2; p0[e] = a0.x; p0[e + 1] = a0.y; p1[e] = a1.x; p1[e + 1] = a1.y; }
#pragma unroll
                  for (int e = 0; e < 16; ++e) { p0[e] = __builtin_amdgcn_exp2f(p0[e]); p1[e] = __builtin_amdgcn_exp2f(p1[e]); }
#pragma unroll
                  for (int e = 0; e < 16; e += 2) { ta += (f32x2v){p0[e], p0[e + 1]}; tb += (f32x2v){p1[e], p1[e + 1]}; }
                  lsum += (ta.x + ta.y) + (tb.x + tb.y); }
                SBAR(); pv_mma(vf, p0, p1, o);
            }
        }
        if (ip + 1 < npair) NSA_WRITE_PAIR(NM_SLOT + (ip & 1) * 32768);
        LBAR();
    }
#undef NSA_LOAD_PAIR
#undef NSA_WRITE_PAIR
    { const float tot = xor32_sum(lsum); const float sc = gate_w * __builtin_amdgcn_rcpf(tot);
#pragma unroll
      for (int e = 0; e < 16; ++e) { oacc[0][e] += o[0][e] * sc; oacc[1][e] += o[1][e] * sc; } }
    { bf16* yp = MP_Y + row * DM + (g * 4 + head) * 64 + 4 * h;
#pragma unroll
      for (int db = 0; db < 2; ++db)
#pragma unroll
          for (int g4 = 0; g4 < 4; ++g4) { v2u wv; wv.x = cvtpk(oacc[db][4 * g4], oacc[db][4 * g4 + 1]); wv.y = cvtpk(oacc[db][4 * g4 + 2], oacc[db][4 * g4 + 3]); *(v2u*)(yp + db * 32 + g4 * 8) = wv; } }
}

namespace ns3 {
using f32x16 = __attribute__((ext_vector_type(16))) float;
using bf16x8 = __attribute__((ext_vector_type(8))) short;
using s16x4 = __attribute__((ext_vector_type(4))) short;
using u32x4 = __attribute__((ext_vector_type(4))) unsigned;
typedef short v4i16_t __attribute__((ext_vector_type(4)));
typedef LAS const char* lds_cptr;
constexpr int NSLOT = 3, SLOTB = 8192;
constexpr int A_K = 0, A_V = NSLOT * SLOTB, A_WS = 2 * NSLOT * SLOTB, A_OST = A_WS + 8 * 64 * 4, A_END = A_OST + 8 * 8192;
constexpr int A_IMP = A_OST, A_IMS = A_OST + 33792, A_SEL = A_END, A_TTS = A_END + 512, A_TTW = A_TTS + 256;
#define SBAR3() __builtin_amdgcn_sched_barrier(0)
#define WAIT_BAR3(N) asm volatile("s_waitcnt vmcnt(" #N ") lgkmcnt(0)\n\ts_barrier":::"memory")
__device__ __forceinline__ int crow(int r, int hi) { return (r & 3) + 8 * (r >> 2) + 4 * hi; }
__device__ __forceinline__ void glds16(const void* gsrc, unsigned lds_dst) { unsigned keep;
  asm volatile("s_mov_b32 %0, m0\n\ts_mov_b32 m0, %2\n\ts_nop 0\n\tglobal_load_lds_dwordx4 %1, off\n\ts_mov_b32 m0, %0" : "=&s"(keep) : "v"(gsrc), "s"(lds_dst) : "memory"); }
__device__ __forceinline__ float fadd_s(float a, float b) { float r; asm("v_add_f32_e32 %0, %1, %2" : "=v"(r) : "v"(a), "v"(b)); return r; }
__device__ __forceinline__ float fsub_s(float a, float b) { float r; asm("v_sub_f32_e32 %0, %1, %2" : "=v"(r) : "v"(a), "v"(b)); return r; }
__device__ __forceinline__ s16x4 vtr(lds_cptr p) { return __builtin_bit_cast(s16x4, __builtin_amdgcn_ds_read_tr16_b64_v4i16((LAS v4i16_t*)p)); }
__device__ __forceinline__ void qkt(f32x16& p0, f32x16& p1, lds_cptr Kslot, const bf16x8* qr, const f32x16& negm, int r32, int hi) {
  lds_cptr kb = Kslot + hi * 1024 + r32 * 16;
#pragma unroll
  for (int d0 = 0; d0 < 4; ++d0) {
    const bf16x8 b0 = *(const LAS bf16x8*)(kb + d0 * 2048), b1 = *(const LAS bf16x8*)(kb + d0 * 2048 + 512);
    if (d0 == 0) { p0 = __builtin_amdgcn_mfma_f32_32x32x16_bf16(b0, qr[0], negm, 0, 0, 0); p1 = __builtin_amdgcn_mfma_f32_32x32x16_bf16(b1, qr[0], negm, 0, 0, 0); }
    else { p0 = __builtin_amdgcn_mfma_f32_32x32x16_bf16(b0, qr[d0], p0, 0, 0, 0); p1 = __builtin_amdgcn_mfma_f32_32x32x16_bf16(b1, qr[d0], p1, 0, 0, 0); } }
}
__device__ __forceinline__ void kload8(bf16x8* kf, lds_cptr kp) {
  kf[0] = *(const LAS bf16x8*)(kp);        kf[1] = *(const LAS bf16x8*)(kp + 512);
  kf[2] = *(const LAS bf16x8*)(kp + 2048); kf[3] = *(const LAS bf16x8*)(kp + 2560);
  kf[4] = *(const LAS bf16x8*)(kp + 4096); kf[5] = *(const LAS bf16x8*)(kp + 4608);
  kf[6] = *(const LAS bf16x8*)(kp + 6144); kf[7] = *(const LAS bf16x8*)(kp + 6656);
}
__device__ __forceinline__ void kload2(bf16x8* kf, lds_cptr kp, int j) { kf[2 * j] = *(const LAS bf16x8*)(kp + j * 2048); kf[2 * j + 1] = *(const LAS bf16x8*)(kp + j * 2048 + 512); }
__device__ __forceinline__ float rowmax(const f32x16& p0, const f32x16& p1) {
  float a = max3f(p0[0], p0[1], p1[0]), b = max3f(p0[2], p0[3], p1[1]); a = max3f(a, p1[2], p1[3]);
#pragma unroll
  for (int r = 4; r < 16; r += 4) { a = max3f(a, p0[r], p0[r + 1]); b = max3f(b, p0[r + 2], p0[r + 3]); a = max3f(a, p1[r], p1[r + 1]); b = max3f(b, p1[r + 2], p1[r + 3]); }
  return xor32_max(max2f(a, b));
}
__device__ __forceinline__ void pv(f32x16* o, int vb, bf16x8 pa0, bf16x8 pa1, bf16x8 pa2, bf16x8 pa3) {
#pragma unroll
  for (int d0 = 0; d0 < 2; ++d0) { s16x4 lo[4], hi[4];
#pragma unroll
    for (int ks = 0; ks < 4; ++ks) {
      asm volatile("ds_read_b64_tr_b16 %0,%1 offset:%c2" : "=&v"(lo[ks]) : "v"(vb), "i"(d0 * 4096 + ks * 1024) : "memory");
      asm volatile("ds_read_b64_tr_b16 %0,%1 offset:%c2" : "=&v"(hi[ks]) : "v"(vb), "i"(d0 * 4096 + ks * 1024 + 512) : "memory"); }
    asm volatile("s_waitcnt lgkmcnt(0)" ::: "memory"); SBAR3();
#define PK3(k) (bf16x8){lo[k][0], lo[k][1], lo[k][2], lo[k][3], hi[k][0], hi[k][1], hi[k][2], hi[k][3]}
    o[d0] = __builtin_amdgcn_mfma_f32_32x32x16_bf16(pa0, PK3(0), o[d0], 0, 0, 0);
    o[d0] = __builtin_amdgcn_mfma_f32_32x32x16_bf16(pa1, PK3(1), o[d0], 0, 0, 0);
    o[d0] = __builtin_amdgcn_mfma_f32_32x32x16_bf16(pa2, PK3(2), o[d0], 0, 0, 0);
    o[d0] = __builtin_amdgcn_mfma_f32_32x32x16_bf16(pa3, PK3(3), o[d0], 0, 0, 0);
#undef PK3
  }
}
template <int BR>
__device__ __forceinline__ void rmask(f32x16& p0, f32x16& p1, int e, unsigned mysel, int qi, int tq, int c, int hi) {
  const int kind = e >> 6, j = e & 63; const float NEG = -INFINITY;
  if (BR == 1) {
    int klo, khi;
    if (kind == 1) { klo = tq - 511 - 64 * j; khi = tq - 64 * j; if (khi > 63) khi = 63; if (klo < 0) klo = 0; }
    else { klo = 0; khi = -1; }
    if (!__all(klo == 0 && khi == 63)) { const int a = klo - 4 * hi, z = khi - 4 * hi;
#pragma unroll
      for (int r = 0; r < 16; ++r) { const int cr = (r & 3) + 8 * (r >> 2); if (cr < a || cr > z) p0[r] = NEG; if (cr + 32 < a || cr + 32 > z) p1[r] = NEG; } }
  } else {
    const bool on = (kind == 0) && ((mysel >> j) & 1u);
    const int z = on ? ((j == c) ? qi - 4 * hi : 64) : -1;
    if (!__all(z == 64)) {
#pragma unroll
      for (int r = 0; r < 16; ++r) { const int cr = (r & 3) + 8 * (r >> 2); p0[r] = (cr <= z) ? p0[r] : NEG; p1[r] = (cr + 32 <= z) ? p1[r] : NEG; }
    }
  }
}

template <int THRL, int BR>
__device__ __forceinline__ void stream(LAS unsigned char* L, const bf16* Kb, const bf16* Vb, const LAS int* TT, const int NT, const bf16x8 (&qr)[4],
                                       int lane, int wid, unsigned mysel, int qi, int tq, int c, float gate, bool first_write) {
  const int r32 = lane & 31, hi = lane >> 5;
  const unsigned lds0 = (unsigned)(uintptr_t)L;
  LAS float* wsf = (LAS float*)(L + A_WS) + wid * 64;
  const bf16* ksrc = Kb + (long)lane * 64 + wid * 8;
  const bf16* vsrc = Vb + (long)(16 * (wid & 3) + (lane >> 2)) * 64 + (wid >> 2) * 32 + (lane & 3) * 8;
  const unsigned kdst = lds0 + A_K + wid * 1024, vdst = lds0 + A_V + wid * 1024;
#define TJ(x) ((long)(__builtin_amdgcn_readfirstlane(TT[(x)]) & 63) * 4096)
#define DMA_K(t, slot) glds16(ksrc + TJ(t), (unsigned)__builtin_amdgcn_readfirstlane(kdst + (slot)))
#define DMA_V(t, slot) glds16(vsrc + TJ(t), (unsigned)__builtin_amdgcn_readfirstlane(vdst + (slot)))
  const int vb0 = (int)(lds0 + A_V) + ((lane >> 4) & 1) * 32 + (lane & 3) * 8 + (4 * hi + ((lane & 15) >> 2)) * 64;
  bf16x8 kf[8];
  const lds_cptr shm3 = (lds_cptr)L; const lds_cptr kp0 = shm3 + A_K + hi * 1024 + r32 * 16; const lds_cptr vp0 = shm3 + A_V + ((lane >> 4) & 1) * 32 + (lane & 3) * 8 + (4 * hi + ((lane & 15) >> 2)) * 64;
  DMA_K(0, 0); DMA_V(0, 0); DMA_K(1, SLOTB);
  float mhat = 0.f, l_reg = 0.f; f32x16 o[2]; o[0] = f32x16{}; o[1] = f32x16{}; f32x16 negm = f32x16{}; asm volatile("" : "+v"(negm));
#define CMASK(P0, P1, t) rmask<BR>(P0, P1, __builtin_amdgcn_readfirstlane(TT[(t)]), mysel, qi, tq, c, hi)
  bool resc = false;
#define START(P0, P1) do { const float rm = rowmax(P0, P1); resc = false; \
    { const float dl = rm; mhat = fadd_s(mhat, dl); \
      _Pragma("unroll") for (int r = 0; r < 16; ++r) { P0[r] = fsub_s(P0[r], dl); P1[r] = fsub_s(P1[r], dl); } \
      _Pragma("unroll") for (int r = 0; r < 16; ++r) negm[r] = -mhat; asm volatile("" : "+v"(negm)); } \
    _Pragma("unroll") for (int r = 0; r < 16; ++r) P0[r] = __builtin_amdgcn_exp2f(P0[r]); } while (0)
#define RESC() do { if (resc) { asm volatile("s_waitcnt lgkmcnt(0)" ::: "memory"); \
      _Pragma("unroll") for (int d_ = 0; d_ < 2; ++d_) _Pragma("unroll") for (int r = 0; r < 16; ++r) o[d_][r] *= wsf[crow(r, hi)]; } } while (0)
  f32x16 pA0, pA1, pB0, pB1;
  int sl_prev = 0, sl_cur = 0, sl_next = SLOTB;
#define ROT() do { sl_prev = sl_cur; sl_cur = sl_next; sl_next = (sl_next == (NSLOT - 1) * SLOTB) ? 0 : sl_next + SLOTB; } while (0)
  DMA_K(2, 2 * SLOTB);
  WAIT_BAR3(3);
  qkt(pA0, pA1, shm3 + A_K, qr, negm, r32, hi); asm volatile("s_nop 15\n\ts_nop 7" : "+v"(pA0), "+v"(pA1)); CMASK(pA0, pA1, 0);
  START(pA0, pA1);
  _Pragma("unroll") for (int r = 0; r < 16; ++r) pA1[r] = __builtin_amdgcn_exp2f(pA1[r]);
  WAIT_BAR3(0);
  DMA_K(3, 0); DMA_V(1, SLOTB);
  ROT();
  kload8(kf, kp0 + sl_cur);
  WAIT_BAR3(2);
  s16x4 vlo[8], vhi[8]; u32x4 pw0, pw1, pw2, pw3;
#define PKW(P, B) cvtpk(P[B], P[B + 1])
#define PAF(k) __builtin_bit_cast(bf16x8, pw##k)
#define VFR(i) (bf16x8){vlo[i][0], vlo[i][1], vlo[i][2], vlo[i][3], vhi[i][0], vhi[i][1], vhi[i][2], vhi[i][3]}
#define PIN(x) asm volatile("" : "+v"(x))
#define MX3(a, b, c) __builtin_fmaxf(__builtin_fmaxf((a), (b)), (c))
#define GAPA(MF, A0, A1, A2, A3, W0, W1, PW) do { MF; sacc += A0; sacc += A1; sacc += A2; sacc += A3; PIN(sacc); W0; W1; PIN(PW); SBAR3(); } while (0)
#define EX(v) __builtin_amdgcn_exp2f(v)
#define GAPB(MF, X, B) do { MF; X[B] = EX(X[B]); X[B + 1] = EX(X[B + 1]); X[B + 2] = EX(X[B + 2]); X[B + 3] = EX(X[B + 3]); PIN(X); SBAR3(); } while (0)
#define VRD(i) do { vlo[i] = vtr(vp_ + (((i) >> 2) * 4096 + ((i) & 3) * 1024)); vhi[i] = vtr(vp_ + (((i) >> 2) * 4096 + ((i) & 3) * 1024 + 512)); } while (0)
#define KRD(G, j) do { if (G) { kload2(kf, kp0 + sl_next, j); SBAR3(); } } while (0)
#define STEP(C0, C1, P0, P1, t, GK, GV, GL) do { SBAR3(); \
    const lds_cptr vp_ = vp0 + sl_prev; \
    VRD(0); SBAR3(); float sacc = (P0[0] + P0[1]); \
    GAPA(C0 = __builtin_amdgcn_mfma_f32_32x32x16_bf16(kf[0], qr[0], negm, 0, 0, 0), P0[2], P0[3], P0[4], P0[5],     pw0[0] = PKW(P0, 0), pw0[1] = PKW(P0, 2), pw0); \
    VRD(4); SBAR3(); GAPA(C1 = __builtin_amdgcn_mfma_f32_32x32x16_bf16(kf[1], qr[0], negm, 0, 0, 0), P0[6], P0[7], P0[8], P0[9],     pw0[2] = PKW(P0, 4), pw0[3] = PKW(P0, 6), pw0); \
    VRD(1); SBAR3(); GAPA(C0 = __builtin_amdgcn_mfma_f32_32x32x16_bf16(kf[2], qr[1], C0, 0, 0, 0),   P0[10], P0[11], P0[12], P0[13], pw1[0] = PKW(P0, 8), pw1[1] = PKW(P0, 10), pw1); \
    VRD(5); SBAR3(); GAPA(C1 = __builtin_amdgcn_mfma_f32_32x32x16_bf16(kf[3], qr[1], C1, 0, 0, 0),   P0[14], P0[15], P1[0], P1[1],   pw1[2] = PKW(P0, 12), pw1[3] = PKW(P0, 14), pw1); \
    VRD(2); SBAR3(); GAPA(C0 = __builtin_amdgcn_mfma_f32_32x32x16_bf16(kf[4], qr[2], C0, 0, 0, 0),   P1[2], P1[3], P1[4], P1[5],     pw2[0] = PKW(P1, 0), pw2[1] = PKW(P1, 2), pw2); \
    VRD(6); SBAR3(); GAPA(C1 = __builtin_amdgcn_mfma_f32_32x32x16_bf16(kf[5], qr[2], C1, 0, 0, 0),   P1[6], P1[7], P1[8], P1[9],     pw2[2] = PKW(P1, 4), pw2[3] = PKW(P1, 6), pw2); \
    VRD(3); SBAR3(); GAPA(C0 = __builtin_amdgcn_mfma_f32_32x32x16_bf16(kf[6], qr[3], C0, 0, 0, 0),   P1[10], P1[11], P1[12], P1[13], pw3[0] = PKW(P1, 8), pw3[1] = PKW(P1, 10), pw3); \
    VRD(7); SBAR3(); GAPA(C1 = __builtin_amdgcn_mfma_f32_32x32x16_bf16(kf[7], qr[3], C1, 0, 0, 0),   P1[14], P1[15], 0.f, 0.f,       pw3[2] = PKW(P1, 12), pw3[3] = PKW(P1, 14), pw3); \
    l_reg += sacc; \
    if (GK) { DMA_K((t) + 3, sl_cur); } if (GV) { DMA_V((t) + 1, sl_next); } \
    CMASK(C0, C1, t); \
    { float a = MX3(C0[0], C0[1], C1[0]), b = MX3(C0[2], C0[3], C1[1]); a = MX3(a, C1[2], C1[3]); \
      _Pragma("unroll") for (int r = 4; r < 16; r += 4) { a = MX3(a, C0[r], C0[r + 1]); b = MX3(b, C0[r + 2], C0[r + 3]); a = MX3(a, C1[r], C1[r + 1]); b = MX3(b, C1[r + 2], C1[r + 3]); } \
      float rm = xor32_max(__builtin_fmaxf(a, b)); \
      resc = false; \
      if (__builtin_expect(__any(rm > (float)THRL), 0)) { const float dl = __builtin_fmaxf(rm, 0.f); mhat += dl; \
        _Pragma("unroll") for (int r = 0; r < 16; ++r) { C0[r] -= dl; C1[r] -= dl; } \
        _Pragma("unroll") for (int r = 0; r < 16; ++r) negm[r] = -mhat; asm volatile("" : "+v"(negm)); \
        const float f = __builtin_amdgcn_exp2f(-dl); l_reg *= f; if (hi == 0) wsf[r32] = f; resc = true; } } \
    SBAR3(); \
    GAPB(o[0] = __builtin_amdgcn_mfma_f32_32x32x16_bf16(PAF(0), VFR(0), o[0], 0, 0, 0), C0, 0); \
    GAPB(o[1] = __builtin_amdgcn_mfma_f32_32x32x16_bf16(PAF(0), VFR(4), o[1], 0, 0, 0), C0, 4); \
    KRD(GL, 0); GAPB(o[0] = __builtin_amdgcn_mfma_f32_32x32x16_bf16(PAF(1), VFR(1), o[0], 0, 0, 0), C0, 8); \
    KRD(GL, 1); GAPB(o[1] = __builtin_amdgcn_mfma_f32_32x32x16_bf16(PAF(1), VFR(5), o[1], 0, 0, 0), C0, 12); \
    KRD(GL, 2); GAPB(o[0] = __builtin_amdgcn_mfma_f32_32x32x16_bf16(PAF(2), VFR(2), o[0], 0, 0, 0), C1, 0); \
    KRD(GL, 3); GAPB(o[1] = __builtin_amdgcn_mfma_f32_32x32x16_bf16(PAF(2), VFR(6), o[1], 0, 0, 0), C1, 4); \
    GAPB(o[0] = __builtin_amdgcn_mfma_f32_32x32x16_bf16(PAF(3), VFR(3), o[0], 0, 0, 0), C1, 8); \
    GAPB(o[1] = __builtin_amdgcn_mfma_f32_32x32x16_bf16(PAF(3), VFR(7), o[1], 0, 0, 0), C1, 12); \
    } while (0)
#define ENDW(tt) do { if ((tt) + 3 < NT) { WAIT_BAR3(2); } else if ((tt) + 2 < NT) { WAIT_BAR3(1); } else { WAIT_BAR3(0); } } while (0)
  int t = 1;
#pragma unroll 1
  for (; t + 1 < NT; t += 2) {
    STEP(pB0, pB1, pA0, pA1, t, (t + 3 < NT), (t + 1 < NT), (t + 1 < NT));       ENDW(t);     RESC(); ROT();
    STEP(pA0, pA1, pB0, pB1, t + 1, (t + 4 < NT), (t + 2 < NT), (t + 2 < NT));   ENDW(t + 1); RESC(); ROT();
  }
#define TAIL(P0, P1, SLOT) do { float sacc = P0[0] + P0[1]; _Pragma("unroll") for (int r = 2; r < 16; ++r) sacc += P0[r]; _Pragma("unroll") for (int r = 0; r < 16; ++r) sacc += P1[r]; l_reg += sacc; \
    pw0 = (u32x4){PKW(P0, 0), PKW(P0, 2), PKW(P0, 4), PKW(P0, 6)}; pw1 = (u32x4){PKW(P0, 8), PKW(P0, 10), PKW(P0, 12), PKW(P0, 14)}; pw2 = (u32x4){PKW(P1, 0), PKW(P1, 2), PKW(P1, 4), PKW(P1, 6)}; pw3 = (u32x4){PKW(P1, 8), PKW(P1, 10), PKW(P1, 12), PKW(P1, 14)}; \
    SBAR3(); pv(o, vb0 + (SLOT), PAF(0), PAF(1), PAF(2), PAF(3)); } while (0)
  if (NT & 1) { TAIL(pA0, pA1, sl_prev); }
  else { STEP(pB0, pB1, pA0, pA1, NT - 1, false, false, false); RESC(); TAIL(pB0, pB1, sl_cur); }
#undef TAIL
#undef PKW
#undef PAF
#undef VFR
#undef PIN
#undef MX3
#undef GAPA
#undef GAPB
#undef EX
#undef VRD
#undef KRD
#undef STEP
#undef ENDW
  l_reg = xor32_sum(l_reg);
  if (hi == 0) wsf[32 + r32] = gate * __builtin_amdgcn_rcpf(l_reg);
  asm volatile("s_waitcnt lgkmcnt(0)" ::: "memory");
  { LAS float* stg = (LAS float*)(L + A_OST) + wid * 2048;
#pragma unroll
    for (int r = 0; r < 16; ++r) { const int orow = crow(r, hi); const float fl = wsf[32 + orow];
#pragma unroll
      for (int d0 = 0; d0 < 2; ++d0) { LAS float* p = stg + orow * 64 + d0 * 32 + r32; const float v = o[d0][r] * fl; *p = first_write ? v : (*p + v); } } }
  asm volatile("s_waitcnt lgkmcnt(0)\n\ts_barrier" ::: "memory");
#undef TJ
#undef DMA_K
#undef DMA_V
#undef CMASK
#undef START
#undef RESC
#undef ROT
}
}

__device__ __forceinline__ void nsa_unit_v3(LAS unsigned char* L, const MixPtrs& P, int b, int g, int c, int tid_in) {
    int tid_l = tid_in; asm volatile("" : "+v"(tid_l));
    const int tid = tid_l, lane = tid & 63, w = __builtin_amdgcn_readfirstlane(tid >> 6);
    const int r = lane & 31, h = lane >> 5, head = w >> 1, qi = (w & 1) * 32 + r, t = c * 64 + qi;
    const size_t row = (size_t)b * SEQ + t;
    LAS unsigned* SEL = (LAS unsigned*)(L + ns3::A_SEL); LAS int* TTS = (LAS int*)(L + ns3::A_TTS); LAS int* TTW = (LAS int*)(L + ns3::A_TTW);
    const size_t kvbase = (size_t)(b * 2 + g) * SEQ * 64, ccbase = (size_t)(b * 2 + g) * 128 * 64;
    const int skey = tid >> 3, sch = tid & 7, soff = tile_off(skey, sch);
    bf16x8v qf[4];
    { const bf16* qp = MP_QN + row * 512 + (g * 4 + head) * 64 + 8 * h;
#pragma unroll
      for (int ks = 0; ks < 4; ++ks) qf[ks] = *(const bf16x8v*)(qp + 16 * ks); }
    const float* gp = MP_GATE + row * 32 + g * 4 + head;
    float one = 1.f; asm volatile("" : "+v"(one));
    const float gate_c = __builtin_amdgcn_rcpf(one + __expf(-gp[0])), gate_s = __builtin_amdgcn_rcpf(one + __expf(-gp[8])), gate_w = __builtin_amdgcn_rcpf(one + __expf(-gp[16]));
    f32x16 oacc[2];
    const bool two = c >= 16;
    {
        const bf16* kc = MP_KC + ccbase; const bf16* vc = MP_VC + ccbase;
        const v4u k0 = *(const v4u*)(kc + tid * 8), v0 = *(const v4u*)(vc + tid * 8); v4u k1 = k0, v1 = v0;
        if (two) { k1 = *(const v4u*)(kc + 4096 + tid * 8); v1 = *(const v4u*)(vc + 4096 + tid * 8); }
        LBAR();
        *(LAS v4u*)(L + soff) = k0; *(LAS v4u*)(L + 8192 + soff) = v0; if (two) { *(LAS v4u*)(L + 16384 + soff) = k1; *(LAS v4u*)(L + 24576 + soff) = v1; }
        if (tid < 64) SEL[tid] = 0u;
        LBAR();
        f32x16 s0, s1, s2, s3;
        { bf16x8v kfa[8]; k_load(L, r, h, kfa); SBAR(); qk_mma(kfa, qf, s0, s1); }
        const int nlim = (t >= 31) ? (((t - 31) >> 4) < 126 ? ((t - 31) >> 4) : 126) : -1;
        if (two) {
            { bf16x8v kfb[8]; k_load(L + 16384, r, h, kfb); SBAR(); qk_mma(kfb, qf, s2, s3); }
            float mxv[4] = {-1e20f, -1e20f, -1e20f, -1e20f};
#pragma unroll
            for (int e = 0; e < 16; ++e) { const int cr = (e & 3) + 8 * (e >> 2) + 4 * h;
                s0[e] = (cr <= nlim) ? s0[e] : -1e30f; s1[e] = (cr + 32 <= nlim) ? s1[e] : -1e30f;
                s2[e] = (cr + 64 <= nlim) ? s2[e] : -1e30f; s3[e] = (cr + 96 <= nlim) ? s3[e] : -1e30f;
                mxv[e & 3] = max3f(max3f(mxv[e & 3], s0[e], s1[e]), s2[e], s3[e]); }
            const float mx = xor32_max(max3f(mxv[0], mxv[1], max2f(mxv[2], mxv[3])));
            float lsv[4] = {0.f, 0.f, 0.f, 0.f};
#pragma unroll
            for (int e = 0; e < 16; ++e) { s0[e] = __builtin_amdgcn_exp2f(s0[e] - mx); s1[e] = __builtin_amdgcn_exp2f(s1[e] - mx); s2[e] = __builtin_amdgcn_exp2f(s2[e] - mx); s3[e] = __builtin_amdgcn_exp2f(s3[e] - mx);
                lsv[e & 3] += (s0[e] + s1[e]) + (s2[e] + s3[e]); }
            const float ls = xor32_sum((lsv[0] + lsv[1]) + (lsv[2] + lsv[3]));
            const float il = (ls > 0.f) ? __builtin_amdgcn_rcpf(ls) : 0.f;
#pragma unroll
            for (int e = 0; e < 16; ++e) { s0[e] *= il; s1[e] *= il; s2[e] *= il; s3[e] *= il; }
        } else {
            float mxv[4] = {-1e20f, -1e20f, -1e20f, -1e20f};
#pragma unroll
            for (int e = 0; e < 16; ++e) { const int cr = (e & 3) + 8 * (e >> 2) + 4 * h;
                s0[e] = (cr <= nlim) ? s0[e] : -1e30f; s1[e] = (cr + 32 <= nlim) ? s1[e] : -1e30f;
                mxv[e & 3] = max3f(mxv[e & 3], s0[e], s1[e]); }
            const float mx = xor32_max(max3f(mxv[0], mxv[1], max2f(mxv[2], mxv[3])));
            float lsv[4] = {0.f, 0.f, 0.f, 0.f};
#pragma unroll
            for (int e = 0; e < 16; ++e) { s0[e] = __builtin_amdgcn_exp2f(s0[e] - mx); s1[e] = __builtin_amdgcn_exp2f(s1[e] - mx); lsv[e & 3] += s0[e] + s1[e]; s2[e] = 0.f; s3[e] = 0.f; }
            const float ls = xor32_sum((lsv[0] + lsv[1]) + (lsv[2] + lsv[3]));
            const float il = (ls > 0.f) ? __builtin_amdgcn_rcpf(ls) : 0.f;
#pragma unroll
            for (int e = 0; e < 16; ++e) { s0[e] *= il; s1[e] *= il; }
        }
        if (two) { LAS float* IMP = (LAS float*)(L + ns3::A_IMP) + (w * 32 + r) * 33; float plprev = 0.f;
#pragma unroll
          for (int x = 0; x < 16; ++x) {
              const f32x16& S = (x < 4) ? s0 : ((x < 8) ? s1 : ((x < 12) ? s2 : s3)); const int g4 = (x & 3) * 4;
              const float own = (S[g4] + S[g4 + 1]) + (S[g4 + 2] + S[g4 + 3]);
              const float pl = shx(S[g4 + 3], 32, lane);
              if (h == 1) IMP[2 * x + 1] = own + pl; else IMP[2 * x] = own + plprev;
              plprev = pl;
          }
        }
        oacc[0] = (f32x16){0.f, 0.f, 0.f, 0.f, 0.f, 0.f, 0.f, 0.f, 0.f, 0.f, 0.f, 0.f, 0.f, 0.f, 0.f, 0.f}; oacc[1] = oacc[0];
        { bf16x8v vfa[8]; v_load(L + 8192, lane, vfa); SBAR(); pv_mma(vfa, s0, s1, oacc); }
        if (two) { bf16x8v vfb[8]; v_load(L + 24576, lane, vfb); SBAR(); pv_mma(vfb, s2, s3, oacc); }
    }
    if (two) LBAR();
    { const int i = tid & 63, jg = tid >> 6; const LAS float* I8 = (const LAS float*)(L + ns3::A_IMP); LAS float* IMS = (LAS float*)(L + ns3::A_IMS);
      if (two) {
#pragma unroll
      for (int jj = 0; jj < 4; ++jj) { const int j = 4 * jg + jj; const int wq = (i >> 5), rq = i & 31;
          IMS[i * 36 + j] = (I8[((0 + wq) * 32 + rq) * 33 + j] + I8[((2 + wq) * 32 + rq) * 33 + j]) + (I8[((4 + wq) * 32 + rq) * 33 + j] + I8[((6 + wq) * 32 + rq) * 33 + j]); }
      LBAR(); }
      unsigned bits = 0u;
      if (c + 1 <= 16) { if (jg == 0) bits = (1u << (c + 1)) - 1u; }
      else { if (jg == 0) bits = 1u | (1u << c) | (1u << (c - 1));
          { float iv[32];
#pragma unroll
            for (int q8 = 0; q8 < 8; ++q8) { const f32x4 x = *(const LAS f32x4*)(IMS + i * 36 + 4 * q8); iv[4 * q8] = x.x; iv[4 * q8 + 1] = x.y; iv[4 * q8 + 2] = x.z; iv[4 * q8 + 3] = x.w; }
#pragma unroll
            for (int jj = 0; jj < 4; ++jj) { const int j = 4 * jg + jj; const float vj = IMS[i * 36 + j]; int rank = 0;
#pragma unroll
                for (int i2 = 1; i2 < 30; ++i2) rank += (i2 <= c - 2 && (iv[i2] > vj || (iv[i2] == vj && i2 < j))) ? 1 : 0;
                if (j >= 1 && j <= c - 2 && rank < 13) bits |= 1u << j; } } }
      if (bits) atomicOr((unsigned*)&SEL[i], bits);
      LBAR();
      if (w == 0) { unsigned so = SEL[lane];
#pragma unroll
          for (int o2 = 32; o2; o2 >>= 1) so |= shxu(so, o2, lane);
          { so &= (c >= 31) ? 0xffffffffu : ((2u << c) - 1u);
            const int n = __builtin_popcount(so), nt = (n < 4) ? 4 : n;
            if (lane < 32 && ((so >> lane) & 1u)) TTS[__builtin_popcount(so & ((1u << lane) - 1u))] = lane;
            if (lane >= n && lane < nt + 2) TTS[lane] = 128;
            const int j0 = (c - 8 > 0) ? c - 8 : 0, m2 = 1 + (c - j0), mt = (m2 < 4) ? 4 : m2;
            if (lane == 0) { TTS[46] = nt; TTW[0] = 64 + c; TTW[14] = mt; }
            else if (lane < m2) TTW[lane] = 64 + j0 + lane - 1;
            else if (lane < mt) TTW[lane] = 128; } }
      LBAR();
    }
    const unsigned mysel = SEL[qi]; const int nts = TTS[46], ntw = TTW[14];
    { LAS float* stg = (LAS float*)(L + ns3::A_OST) + w * 2048 + r * 64 + 4 * h;
#pragma unroll
      for (int db = 0; db < 2; ++db)
#pragma unroll
          for (int g4 = 0; g4 < 4; ++g4) *(LAS f32x4*)(stg + db * 32 + g4 * 8) = (f32x4){oacc[db][4 * g4] * gate_c, oacc[db][4 * g4 + 1] * gate_c, oacc[db][4 * g4 + 2] * gate_c, oacc[db][4 * g4 + 3] * gate_c}; }
#if PROBE_SC == 22
    const unsigned st0_ = (unsigned)__builtin_amdgcn_s_memrealtime();
#endif
    ns3::stream<8, 0>(L, MP_KS + kvbase, MP_VS + kvbase, TTS, nts, qf, lane, w, mysel, qi, t, c, gate_s, false);
    ns3::stream<8, 1>(L, MP_KW + kvbase, MP_VW + kvbase, TTW, ntw, qf, lane, w, mysel, qi, t, c, gate_w, false);
#if PROBE_SC == 22
    if (tid == 0) { LAS unsigned* pm_ = (LAS unsigned*)(L + MISC_OFF) + 210; pm_[0] += (unsigned)__builtin_amdgcn_s_memrealtime() - st0_; pm_[1] += (unsigned)(nts + ntw); }
#endif
    { const LAS float* stg = (const LAS float*)(L + ns3::A_OST) + w * 2048; bf16* yb = MP_Y + ((size_t)b * SEQ + c * 64 + (w & 1) * 32) * DM + (g * 4 + head) * 64;
#pragma unroll
      for (int i4 = 0; i4 < 4; ++i4) { const int rr = i4 * 8 + (lane >> 3), ch = lane & 7; const f32x4 a = *(const LAS f32x4*)(stg + rr * 64 + ch * 8), bq = *(const LAS f32x4*)(stg + rr * 64 + ch * 8 + 4);
          v4u wv; wv.x = cvtpk(a.x, a.y); wv.y = cvtpk(a.z, a.w); wv.z = cvtpk(bq.x, bq.y); wv.w = cvtpk(bq.z, bq.w);
          *(v4u*)(yb + (size_t)rr * DM + ch * 8) = wv; } }
}

#define MFMA16(a, b, c) __builtin_amdgcn_mfma_f32_16x16x32_bf16((a), (b), (c), 0, 0, 0)
constexpr size_t WS_QC = 422 * MiB, WS_KC2 = 454 * MiB, WS_END2 = 486 * MiB; static_assert(WS_END2 <= WS_PART, "row-partial buffers follow");
#define MP_QC ((const bf16*)(P.ws + WS_QC))
#define MP_KC2 ((const bf16*)(P.ws + WS_KC2))
__device__ __forceinline__ int img_off(int row, int ch) { return 256 * row + 16 * (ch ^ (((row & 3) << 2) | ((row >> 2) & 3))); }
constexpr int M2_IMG = 0, M2_SC = 98304, M2_DEN = 106496, M2_QN = 107520, M2_N = 107776, M2_SSQ = 108288;

__device__ __forceinline__ void mlstm_conv_item(unsigned char* ws, const float* conv_w, const float* conv_b, int b, int tg, int isk, int ch0) {
    {
        const bf16* src = (const bf16*)(ws + (isk ? WS_MK : WS_MQ)) + (size_t)b * SEQ * 512 + ch0;
        bf16* dst = (bf16*)(ws + (isk ? WS_KC2 : WS_QC)) + ((size_t)(b * 4 + (ch0 >> 7)) * SEQ) * 128 + (ch0 & 127);
        float wt[4][8], bs[8];
#pragma unroll
        for (int j = 0; j < 4; ++j) { const f32x4 a = *(const f32x4*)(conv_w + j * 1024 + isk * 512 + ch0), c2 = *(const f32x4*)(conv_w + j * 1024 + isk * 512 + ch0 + 4);
            wt[j][0] = a.x; wt[j][1] = a.y; wt[j][2] = a.z; wt[j][3] = a.w; wt[j][4] = c2.x; wt[j][5] = c2.y; wt[j][6] = c2.z; wt[j][7] = c2.w; }
        { const f32x4 a = *(const f32x4*)(conv_b + isk * 512 + ch0), c2 = *(const f32x4*)(conv_b + isk * 512 + ch0 + 4); bs[0] = a.x; bs[1] = a.y; bs[2] = a.z; bs[3] = a.w; bs[4] = c2.x; bs[5] = c2.y; bs[6] = c2.z; bs[7] = c2.w; }
        const float osc = isk ? 0.08838834764831845f : 1.f;
        const int t0 = tg * 16;
        float x0[8], x1[8], x2[8];
#pragma unroll
        for (int e = 0; e < 8; ++e) { x0[e] = 0.f; x1[e] = 0.f; x2[e] = 0.f; }
        if (t0 > 0) {
            const v4u a = *(const v4u*)(src + (size_t)(t0 - 3) * 512), c2 = *(const v4u*)(src + (size_t)(t0 - 2) * 512), d2 = *(const v4u*)(src + (size_t)(t0 - 1) * 512);
            x0[0] = bflo(a.x); x0[1] = bfhi(a.x); x0[2] = bflo(a.y); x0[3] = bfhi(a.y); x0[4] = bflo(a.z); x0[5] = bfhi(a.z); x0[6] = bflo(a.w); x0[7] = bfhi(a.w);
            x1[0] = bflo(c2.x); x1[1] = bfhi(c2.x); x1[2] = bflo(c2.y); x1[3] = bfhi(c2.y); x1[4] = bflo(c2.z); x1[5] = bfhi(c2.z); x1[6] = bflo(c2.w); x1[7] = bfhi(c2.w);
            x2[0] = bflo(d2.x); x2[1] = bfhi(d2.x); x2[2] = bflo(d2.y); x2[3] = bfhi(d2.y); x2[4] = bflo(d2.z); x2[5] = bfhi(d2.z); x2[6] = bflo(d2.w); x2[7] = bfhi(d2.w);
        }
        v4u rows[16];
#pragma unroll
        for (int s = 0; s < 16; ++s) rows[s] = *(const v4u*)(src + (size_t)(t0 + s) * 512);
#pragma unroll
        for (int s = 0; s < 16; ++s) {
            const v4u a = rows[s];
            const float x3[8] = {bflo(a.x), bfhi(a.x), bflo(a.y), bfhi(a.y), bflo(a.z), bfhi(a.z), bflo(a.w), bfhi(a.w)};
            float o[8];
#pragma unroll
            for (int e = 0; e < 8; ++e) { float v = bs[e] + wt[0][e] * x0[e] + wt[1][e] * x1[e] + wt[2][e] * x2[e] + wt[3][e] * x3[e]; v = v * __builtin_amdgcn_rcpf(1.f + __expf(-v)); o[e] = v * osc; x0[e] = x1[e]; x1[e] = x2[e]; x2[e] = x3[e]; }
            v4u wv; wv.x = cvtpk(o[0], o[1]); wv.y = cvtpk(o[2], o[3]); wv.z = cvtpk(o[4], o[5]); wv.w = cvtpk(o[6], o[7]);
            *(v4u*)(dst + (size_t)(t0 + s) * 128) = wv;
        }
    }
}
__device__ __forceinline__ void mlstm_conv_pass(unsigned char* ws, const float* conv_w, const float* conv_b, int gthread, int nthreads) {
    for (int idx = gthread; idx < BATCH * 128 * 128; idx += nthreads) { const int cc = idx & 127, tg = (idx >> 7) & 127, b = idx >> 14; mlstm_conv_item(ws, conv_w, conv_b, b, tg, cc >> 6, (cc & 63) * 8); }
}
__device__ __forceinline__ void mlstm_conv_unit(unsigned char* ws, const float* conv_w, const float* conv_b, int b, int hh, int tid) {
#pragma unroll 1
    for (int idx = tid; idx < 4096; idx += 512) mlstm_conv_item(ws, conv_w, conv_b, b, idx >> 5, (idx >> 4) & 1, hh * 128 + (idx & 15) * 8);
}

constexpr int M2_A = 112384, M2_PM = 120576, M2_F = 128768, M2_BL = 136960, M2_AMX = 137088, M2_MC = 137216;
__device__ __forceinline__ void mlstm_unit_mfma(LAS unsigned char* L, const MixPtrs& P, int b, int hh, int tid_in) {
    int tid_l = tid_in; asm volatile("" : "+v"(tid_l));
    const int tid = tid_l, lane = tid & 63, w = __builtin_amdgcn_readfirstlane(tid >> 6), l15 = lane & 15, kg = lane >> 4;
    const size_t rb = (size_t)b * SEQ;
    const bf16* QCp = MP_QC + ((size_t)(b * 4 + hh) * SEQ) * 128; const bf16* KCp = MP_KC2 + ((size_t)(b * 4 + hh) * SEQ) * 128;
    const bf16* Vp = MP_MV + rb * 512 + hh * 128; const bf16* Op = MP_MO + rb * 512 + hh * 128 + 16 * w + 4 * kg;
    bf16* Yp = MP_Y + rb * DM + 512 + hh * 128 + 16 * w + 4 * kg;
    LAS float* DEN = (LAS float*)(L + M2_DEN); LAS float* QN = (LAS float*)(L + M2_QN); LAS float* NV = (LAS float*)(L + M2_N); LAS float* SSQ = (LAS float*)(L + M2_SSQ);
    LAS float* SA = (LAS float*)(L + M2_A); LAS float* SPM = (LAS float*)(L + M2_PM); LAS float* SF = (LAS float*)(L + M2_F);
    LAS float* SBL = (LAS float*)(L + M2_BL); LAS float* SAMX = (LAS float*)(L + M2_AMX); LAS float* SMC = (LAS float*)(L + M2_MC);
    float zf = 0.f; asm volatile("" : "+v"(zf));
    f32x4 Cacc[8], nacc = {zf, zf, zf, zf};
#pragma unroll
    for (int i = 0; i < 8; ++i) Cacc[i] = (f32x4){zf, zf, zf, zf};
    const f32x4 gn = *(const f32x4*)(P.mnorm_g + hh * 128 + 16 * w + 4 * kg);
    const int r0s = tid >> 4, c0s = tid & 15, so0 = img_off(r0s, c0s), so1 = img_off(r0s + 32, c0s);
    v4u sq0, sq1, sk0, sk1, sv0, sv1;
    sq0 = *(const v4u*)(QCp + (size_t)r0s * 128 + c0s * 8); sq1 = *(const v4u*)(QCp + (size_t)(r0s + 32) * 128 + c0s * 8);
    sk0 = *(const v4u*)(KCp + (size_t)r0s * 128 + c0s * 8); sk1 = *(const v4u*)(KCp + (size_t)(r0s + 32) * 128 + c0s * 8);
    sv0 = *(const v4u*)(Vp + (size_t)r0s * 512 + c0s * 8);  sv1 = *(const v4u*)(Vp + (size_t)(r0s + 32) * 512 + c0s * 8);
    LBAR();
    { const float ib = P.i_bias[hh], fb = P.f_bias[hh]; const float* Gp = MP_GATE + rb * 32 + hh;
#pragma unroll 1
      for (int cc = w; cc < 32; cc += 8) { const int tk = 64 * cc + lane;
          const float il = Gp[(size_t)tk * 32 + 24] + ib, fx = Gp[(size_t)tk * 32 + 28] + fb; const float fl = fminf(fx, 0.f) - log1pf(__expf(-fabsf(fx)));
          float f = fl;
#pragma unroll
          for (int o = 1; o < 64; o <<= 1) { const float v = shi(f, lane - o); if (lane >= o) f += v; }
          const float a = il - f; float pm = a;
#pragma unroll
          for (int o = 1; o < 64; o <<= 1) { const float v = shi(pm, lane - o); if (lane >= o) pm = fmaxf(pm, v); }
          SA[tk] = a; SPM[tk] = pm; SF[tk] = f; if (lane == 63) { SBL[cc] = f; SAMX[cc] = pm; } } }
    *(LAS v4u*)(L + M2_IMG + so0) = sq0; *(LAS v4u*)(L + M2_IMG + so1) = sq1; *(LAS v4u*)(L + M2_IMG + 16384 + so0) = sk0; *(LAS v4u*)(L + M2_IMG + 16384 + so1) = sk1;
    *(LAS v4u*)(L + M2_IMG + 32768 + so0) = sv0; *(LAS v4u*)(L + M2_IMG + 32768 + so1) = sv1;
    if (tid < 128) NV[tid] = zf;
    LBAR();
    if (tid == 0) { float mcar = zf; for (int cc = 0; cc < 32; ++cc) { SMC[cc] = mcar; mcar = SBL[cc] + fmaxf(mcar, SAMX[cc]); } }
    LBAR();
#pragma unroll 1
    for (int c = 0; c < 32; ++c) {
        int lc = lane; asm volatile("" : "+v"(lc));
        const int l15 = lc & 15, kg = lc >> 4, q4 = l15 >> 2, p4 = l15 & 3;
        const int t0 = c * 64; const LAS unsigned char* Qi = L + M2_IMG + (c & 1) * 49152; const LAS unsigned char* Ki = Qi + 16384; const LAS unsigned char* Vi = Qi + 32768;
        if (c + 1 < 32) { const int tn = t0 + 64;
            sq0 = *(const v4u*)(QCp + (size_t)(tn + r0s) * 128 + c0s * 8); sq1 = *(const v4u*)(QCp + (size_t)(tn + r0s + 32) * 128 + c0s * 8);
            sk0 = *(const v4u*)(KCp + (size_t)(tn + r0s) * 128 + c0s * 8); sk1 = *(const v4u*)(KCp + (size_t)(tn + r0s + 32) * 128 + c0s * 8);
            sv0 = *(const v4u*)(Vp + (size_t)(tn + r0s) * 512 + c0s * 8);  sv1 = *(const v4u*)(Vp + (size_t)(tn + r0s + 32) * 512 + c0s * 8); }
        const float mc = SMC[c], mxa = fmaxf(mc, SAMX[c]); const float cs = __expf(mc - mxa);
        { const int tblk = w >> 1, t = 16 * tblk + l15; const int sb0 = 2 * (w & 1);
          bf16x8v ka[2][4], qb[4];
#pragma unroll
          for (int ks = 0; ks < 4; ++ks) { qb[ks] = *(const LAS bf16x8v*)(Qi + img_off(t, 4 * ks + kg)); ka[0][ks] = *(const LAS bf16x8v*)(Ki + img_off(16 * sb0 + l15, 4 * ks + kg)); ka[1][ks] = *(const LAS bf16x8v*)(Ki + img_off(16 * sb0 + 16 + l15, 4 * ks + kg)); }
          const float Mt = fmaxf(SPM[t0 + t], mc);
          const f32x4 as0 = *(const LAS f32x4*)(SA + t0 + 16 * sb0 + 4 * kg), as1 = *(const LAS f32x4*)(SA + t0 + 16 * sb0 + 16 + 4 * kg);
          const int tq = tid >> 3, dp = tid & 7; const v4u q0 = *(const LAS v4u*)(Qi + img_off(tq, 2 * dp)), q1 = *(const LAS v4u*)(Qi + img_off(tq, 2 * dp + 1));
          const LAS f32x4* np = (const LAS f32x4*)(NV + 16 * dp); const f32x4 n0 = np[0], n1 = np[1], n2 = np[2], n3 = np[3];
          SBAR();
          LAS unsigned char* SC = L + M2_SC;
#pragma unroll
          for (int sb = 0; sb < 2; ++sb) { const int sblk = sb0 + sb; f32x4 acc = {0.f, 0.f, 0.f, 0.f}; float rp = 0.f; v2u wv; wv.x = 0u; wv.y = 0u;
              if (sblk <= tblk) {
#pragma unroll
                  for (int ks = 0; ks < 4; ++ks) acc = MFMA16(ka[sb][ks], qb[ks], acc);
                  const f32x4 as = sb ? as1 : as0; float v[4];
#pragma unroll
                  for (int e = 0; e < 4; ++e) { const float x = acc[e] * __expf(as[e] - Mt); v[e] = (sblk == tblk && 4 * kg + e > l15) ? 0.f : x; }
                  rp = (v[0] + v[1]) + (v[2] + v[3]); wv.x = cvtpk(v[0], v[1]); wv.y = cvtpk(v[2], v[3]);
              }
              rp += shx(rp, 16, lane); rp += shx(rp, 32, lane);
              *(LAS v2u*)(SC + t * 128 + (((2 * sblk + (kg >> 1)) ^ (t & 7)) << 4) + 8 * (kg & 1)) = wv;
              if (kg == 0) DEN[sblk * 64 + t] = rp; }
          { float s = bflo(q0.x) * n0.x + bfhi(q0.x) * n0.y + bflo(q0.y) * n0.z + bfhi(q0.y) * n0.w + bflo(q0.z) * n1.x + bfhi(q0.z) * n1.y + bflo(q0.w) * n1.z + bfhi(q0.w) * n1.w
                    + bflo(q1.x) * n2.x + bfhi(q1.x) * n2.y + bflo(q1.y) * n2.z + bfhi(q1.y) * n2.w + bflo(q1.z) * n3.x + bfhi(q1.z) * n3.y + bflo(q1.w) * n3.z + bfhi(q1.w) * n3.w;
            s += shx(s, 1, lane); s += shx(s, 2, lane); s += shx(s, 4, lane);
            if (dp == 0) QN[tq] = s; } }
        LBAR();
        v2u og[4];
#pragma unroll
        for (int tb = 0; tb < 4; ++tb) og[tb] = *(const v2u*)(Op + (size_t)(t0 + 16 * tb + l15) * 512);
        bf16x8v vf[2]; f32x4 hv[4];
        { float pmt[4], ft[4], dnp[4], qn4[4]; bf16x8v Cfrag[4];
#pragma unroll
          for (int kp = 0; kp < 4; ++kp) { v4u a; a.x = cvtpk(Cacc[2 * kp].x, Cacc[2 * kp].y); a.y = cvtpk(Cacc[2 * kp].z, Cacc[2 * kp].w); a.z = cvtpk(Cacc[2 * kp + 1].x, Cacc[2 * kp + 1].y); a.w = cvtpk(Cacc[2 * kp + 1].z, Cacc[2 * kp + 1].w);
              Cfrag[kp] = __builtin_bit_cast(bf16x8v, a); }
#pragma unroll
          for (int ks = 0; ks < 2; ++ks) { const int r0 = 32 * ks + 8 * kg;
              const s16x4v lo = tr_read(Vi + 256 * (r0 + q4) + 16 * ((2 * w + (p4 >> 1)) ^ ((q4 << 2) | ((r0 >> 2) & 3))) + 8 * (p4 & 1));
              const s16x4v hi = tr_read(Vi + 256 * (r0 + 4 + q4) + 16 * ((2 * w + (p4 >> 1)) ^ ((q4 << 2) | (((r0 + 4) >> 2) & 3))) + 8 * (p4 & 1));
              vf[ks] = __builtin_shufflevector(lo, hi, 0, 1, 2, 3, 4, 5, 6, 7); }
#pragma unroll
          for (int tb = 0; tb < 4; ++tb) { const int t = 16 * tb + l15; pmt[tb] = SPM[t0 + t]; ft[tb] = SF[t0 + t]; dnp[tb] = (DEN[t] + DEN[64 + t]) + (DEN[128 + t] + DEN[192 + t]); qn4[tb] = QN[t]; }
#pragma unroll
          for (int tp = 0; tp < 2; ++tp) {
              bf16x8v sf[2][2]; v2u qlo[2][4], qhi[2][4];
#pragma unroll
              for (int t2 = 0; t2 < 2; ++t2) { const int t = 16 * (2 * tp + t2) + l15; const int swz = ((t & 3) << 2) | ((t >> 2) & 3);
#pragma unroll
                  for (int ks = 0; ks < 2; ++ks) sf[t2][ks] = *(const LAS bf16x8v*)(L + M2_SC + t * 128 + (((4 * ks + kg) ^ (t & 7)) << 4));
#pragma unroll
                  for (int kp = 0; kp < 4; ++kp) { qlo[t2][kp] = *(const LAS v2u*)(Qi + 256 * t + 16 * ((4 * kp + (kg >> 1)) ^ swz) + 8 * (kg & 1)); qhi[t2][kp] = *(const LAS v2u*)(Qi + 256 * t + 16 * ((4 * kp + 2 + (kg >> 1)) ^ swz) + 8 * (kg & 1)); } }
              SBAR();
#pragma unroll
              for (int t2 = 0; t2 < 2; ++t2) { const int tb = 2 * tp + t2; f32x4 an = {0.f, 0.f, 0.f, 0.f}, a2 = {0.f, 0.f, 0.f, 0.f};
#pragma unroll
                  for (int ks = 0; ks < 2; ++ks) an = MFMA16(vf[ks], sf[t2][ks], an);
#pragma unroll
                  for (int kp = 0; kp < 4; ++kp) { v4u qq; qq.x = qlo[t2][kp].x; qq.y = qlo[t2][kp].y; qq.z = qhi[t2][kp].x; qq.w = qhi[t2][kp].y; a2 = MFMA16(Cfrag[kp], __builtin_bit_cast(bf16x8v, qq), a2); }
                  const float Mt = fmaxf(pmt[tb], mc), wp = __expf(mc - Mt), emt = __expf(-ft[tb] - Mt);
                  const float dn = dnp[tb] + wp * qn4[tb];
                  const float idn = __builtin_amdgcn_rcpf(fmaxf(fabsf(dn), emt));
                  hv[tb] = (an + a2 * wp) * idn;
                  float ss = (hv[tb].x * hv[tb].x + hv[tb].y * hv[tb].y) + (hv[tb].z * hv[tb].z + hv[tb].w * hv[tb].w);
                  ss += shx(ss, 16, lane); ss += shx(ss, 32, lane);
                  if (kg == 0) SSQ[((c & 1) * 8 + w) * 64 + 16 * tb + l15] = ss; }
              SBAR();
          } }
        { bf16x8v vpf[2], wkf[2];
          f32x4 aw[2][2];
#pragma unroll
          for (int ks = 0; ks < 2; ++ks) { aw[ks][0] = *(const LAS f32x4*)(SA + t0 + 32 * ks + 8 * kg); aw[ks][1] = *(const LAS f32x4*)(SA + t0 + 32 * ks + 8 * kg + 4); }
#pragma unroll
          for (int ks = 0; ks < 2; ++ks) { float wkv[8]; unsigned vp[4], wp2[4]; const v4u vu = __builtin_bit_cast(v4u, vf[ks]); const unsigned vw[4] = {vu.x, vu.y, vu.z, vu.w};
#pragma unroll
              for (int j = 0; j < 8; ++j) wkv[j] = __expf(aw[ks][j >> 2][j & 3] - mxa);
#pragma unroll
              for (int j2 = 0; j2 < 4; ++j2) { vp[j2] = cvtpk(bflo(vw[j2]) * wkv[2 * j2], bfhi(vw[j2]) * wkv[2 * j2 + 1]); wp2[j2] = cvtpk(wkv[2 * j2], wkv[2 * j2 + 1]); }
              v4u a; a.x = vp[0]; a.y = vp[1]; a.z = vp[2]; a.w = vp[3]; vpf[ks] = __builtin_bit_cast(bf16x8v, a);
              v4u b2; b2.x = wp2[0]; b2.y = wp2[1]; b2.z = wp2[2]; b2.w = wp2[3]; wkf[ks] = __builtin_bit_cast(bf16x8v, b2); }
          nacc = nacc * cs;
#pragma unroll
          for (int ih = 0; ih < 2; ++ih) {
              bf16x8v kf[4][2];
#pragma unroll
              for (int i4 = 0; i4 < 4; ++i4)
#pragma unroll
                  for (int ks = 0; ks < 2; ++ks) { const int i = 4 * ih + i4, r0 = 32 * ks + 8 * kg;
                      const s16x4v lo = tr_read(Ki + 256 * (r0 + q4) + 16 * ((2 * i + (p4 >> 1)) ^ ((q4 << 2) | ((r0 >> 2) & 3))) + 8 * (p4 & 1));
                      const s16x4v hi = tr_read(Ki + 256 * (r0 + 4 + q4) + 16 * ((2 * i + (p4 >> 1)) ^ ((q4 << 2) | (((r0 + 4) >> 2) & 3))) + 8 * (p4 & 1));
                      kf[i4][ks] = __builtin_shufflevector(lo, hi, 0, 1, 2, 3, 4, 5, 6, 7); }
              SBAR();
#pragma unroll
              for (int i4 = 0; i4 < 4; ++i4) { const int i = 4 * ih + i4; Cacc[i] = Cacc[i] * cs;
#pragma unroll
                  for (int ks = 0; ks < 2; ++ks) Cacc[i] = MFMA16(kf[i4][ks], vpf[ks], Cacc[i]); }
              SBAR();
          }
          { bf16x8v kw[2];
#pragma unroll
            for (int ks = 0; ks < 2; ++ks) { const int r0 = 32 * ks + 8 * kg;
                const s16x4v lo = tr_read(Ki + 256 * (r0 + q4) + 16 * ((2 * w + (p4 >> 1)) ^ ((q4 << 2) | ((r0 >> 2) & 3))) + 8 * (p4 & 1));
                const s16x4v hi = tr_read(Ki + 256 * (r0 + 4 + q4) + 16 * ((2 * w + (p4 >> 1)) ^ ((q4 << 2) | (((r0 + 4) >> 2) & 3))) + 8 * (p4 & 1));
                kw[ks] = __builtin_shufflevector(lo, hi, 0, 1, 2, 3, 4, 5, 6, 7); }
            nacc = MFMA16(kw[0], wkf[0], nacc); nacc = MFMA16(kw[1], wkf[1], nacc); }
          if (l15 == 0) *(LAS f32x4*)(NV + 16 * w + 4 * kg) = nacc;
 }
        if (c + 1 < 32) { LAS unsigned char* Nx = L + M2_IMG + ((c + 1) & 1) * 49152;
            *(LAS v4u*)(Nx + so0) = sq0; *(LAS v4u*)(Nx + so1) = sq1; *(LAS v4u*)(Nx + 16384 + so0) = sk0; *(LAS v4u*)(Nx + 16384 + so1) = sk1; *(LAS v4u*)(Nx + 32768 + so0) = sv0; *(LAS v4u*)(Nx + 32768 + so1) = sv1; }
        LBAR();
#pragma unroll
        for (int tb = 0; tb < 4; ++tb) { const int t = 16 * tb + l15; const LAS float* sp = SSQ + (c & 1) * 512 + t;
            const float tot = ((sp[0] + sp[64]) + (sp[128] + sp[192])) + ((sp[256] + sp[320]) + (sp[384] + sp[448]));
            const float rn = __frsqrt_rn(tot * (1.f / 128.f) + EPS);
            const float y0 = hv[tb].x * rn * gn.x * sigmoidf_(bflo(og[tb].x)), y1 = hv[tb].y * rn * gn.y * sigmoidf_(bfhi(og[tb].x)), y2 = hv[tb].z * rn * gn.z * sigmoidf_(bflo(og[tb].y)), y3 = hv[tb].w * rn * gn.w * sigmoidf_(bfhi(og[tb].y));
            v2u wv; wv.x = cvtpk(y0, y1); wv.y = cvtpk(y2, y3);
            *(v2u*)(Yp + (size_t)(t0 + t) * DM) = wv; }
    }
    LBAR();
}

__device__ __forceinline__ bf16x8v pack8(const f32x16& x, int s2) { v4u p; p.x = cvtpk(x[8 * s2 + 0], x[8 * s2 + 1]); p.y = cvtpk(x[8 * s2 + 2], x[8 * s2 + 3]); p.z = cvtpk(x[8 * s2 + 4], x[8 * s2 + 5]); p.w = cvtpk(x[8 * s2 + 6], x[8 * s2 + 7]); return __builtin_bit_cast(bf16x8v, p); }
__device__ __forceinline__ int tr32_off(int lane, int c, int ks, int t) { const int h = lane >> 5, blk = (lane >> 4) & 1, q = (lane & 15) >> 2, p = lane & 3; return img_off(16 * ks + 8 * h + 4 * t + q, 4 * c + 2 * blk + (p >> 1)) + 8 * (p & 1); }
__device__ __forceinline__ bf16x8v tr32_frag(const LAS unsigned char* img, int lane, int c, int ks) { const s16x4v lo = tr_read(img + tr32_off(lane, c, ks, 0)), hi = tr_read(img + tr32_off(lane, c, ks, 1)); return __builtin_shufflevector(lo, hi, 0, 1, 2, 3, 4, 5, 6, 7); }
constexpr int M3_DEN = M2_DEN  , M3_SSQ = M2_SSQ  ;

__device__ __forceinline__ void mlstm_unit_v3(LAS unsigned char* L, const MixPtrs& P, int b, int hh, int tid_in) {
    int tid_l = tid_in; asm volatile("" : "+v"(tid_l));
    const int tid = tid_l, lane = tid & 63, w = __builtin_amdgcn_readfirstlane(tid >> 6);
    const size_t rb = (size_t)b * SEQ;
    const bf16* QCp = MP_QC + ((size_t)(b * 4 + hh) * SEQ) * 128; const bf16* KCp = MP_KC2 + ((size_t)(b * 4 + hh) * SEQ) * 128;
    const bf16* Vp = MP_MV + rb * 512 + hh * 128;
    LAS float* DEN = (LAS float*)(L + M3_DEN); LAS float* QN = (LAS float*)(L + M2_QN); LAS float* NV = (LAS float*)(L + M2_N); LAS float* SSQ = (LAS float*)(L + M3_SSQ);
    LAS float* SA = (LAS float*)(L + M2_A); LAS float* SPM = (LAS float*)(L + M2_PM); LAS float* SF = (LAS float*)(L + M2_F);
    LAS float* SBL = (LAS float*)(L + M2_BL); LAS float* SAMX = (LAS float*)(L + M2_AMX); LAS float* SMC = (LAS float*)(L + M2_MC);
    float zf = 0.f; asm volatile("" : "+v"(zf));
    const bool isCD = w < 4; const int jw = w & 3;
    f32x16 Cacc[4]; bf16x8v vfk[4];
#pragma unroll
    for (int i = 0; i < 4; ++i) { vfk[i] = (bf16x8v){0, 0, 0, 0, 0, 0, 0, 0};
#pragma unroll
        for (int e = 0; e < 16; ++e) Cacc[i][e] = zf; }
    const int r0s = tid >> 4, c0s = tid & 15, so0 = img_off(r0s, c0s), so1 = img_off(r0s + 32, c0s);
    v4u sq0, sq1, sk0, sk1, sv0, sv1;
    sq0 = *(const v4u*)(QCp + (size_t)r0s * 128 + c0s * 8); sq1 = *(const v4u*)(QCp + (size_t)(r0s + 32) * 128 + c0s * 8);
    sk0 = *(const v4u*)(KCp + (size_t)r0s * 128 + c0s * 8); sk1 = *(const v4u*)(KCp + (size_t)(r0s + 32) * 128 + c0s * 8);
    sv0 = *(const v4u*)(Vp + (size_t)r0s * 512 + c0s * 8);  sv1 = *(const v4u*)(Vp + (size_t)(r0s + 32) * 512 + c0s * 8);
    LBAR();
    { const float ib = P.i_bias[hh], fb = P.f_bias[hh]; const float* Gp = MP_GATE + rb * 32 + hh;
#pragma unroll 1
      for (int cc = w; cc < 32; cc += 8) { const int tk = 64 * cc + lane;
          const float il = Gp[(size_t)tk * 32 + 24] + ib, fx = Gp[(size_t)tk * 32 + 28] + fb; const float fl = fminf(fx, 0.f) - log1pf(__expf(-fabsf(fx)));
          float f = fl;
#pragma unroll
          for (int o = 1; o < 64; o <<= 1) { const float v = shi(f, lane - o); if (lane >= o) f += v; }
          const float a = il - f; float pm = a;
#pragma unroll
          for (int o = 1; o < 64; o <<= 1) { const float v = shi(pm, lane - o); if (lane >= o) pm = fmaxf(pm, v); }
          SA[tk] = a; SPM[tk] = pm; SF[tk] = f; if (lane == 63) { SBL[cc] = f; SAMX[cc] = pm; } } }
    *(LAS v4u*)(L + M2_IMG + so0) = sq0; *(LAS v4u*)(L + M2_IMG + so1) = sq1; *(LAS v4u*)(L + M2_IMG + 16384 + so0) = sk0; *(LAS v4u*)(L + M2_IMG + 16384 + so1) = sk1;
    *(LAS v4u*)(L + M2_IMG + 32768 + so0) = sv0; *(LAS v4u*)(L + M2_IMG + 32768 + so1) = sv1;
    if (tid < 128) NV[tid] = zf;
    LBAR();
    if (tid == 0) { float mcar = zf; for (int cc = 0; cc < 32; ++cc) { SMC[cc] = mcar; mcar = SBL[cc] + fmaxf(mcar, SAMX[cc]); } }
    LBAR();
    f32x16 hv[2];
    hv[0] = Cacc[0]; hv[1] = Cacc[0];
#pragma unroll 1
    for (int c = 0; c < 32; ++c) {
        int lc = lane; asm volatile("" : "+v"(lc));
        const int r32 = lc & 31, hi = lc >> 5;
        const int t0 = c * 64; const LAS unsigned char* Qi = L + M2_IMG + (c & 1) * 49152; const LAS unsigned char* Ki = Qi + 16384; const LAS unsigned char* Vi = Qi + 32768;
        const LAS unsigned char* Kp = L + M2_IMG + ((c + 1) & 1) * 49152 + 16384;
        if (c + 1 < 32) { const int tn = t0 + 64;
            sq0 = *(const v4u*)(QCp + (size_t)(tn + r0s) * 128 + c0s * 8); sq1 = *(const v4u*)(QCp + (size_t)(tn + r0s + 32) * 128 + c0s * 8);
            sk0 = *(const v4u*)(KCp + (size_t)(tn + r0s) * 128 + c0s * 8); sk1 = *(const v4u*)(KCp + (size_t)(tn + r0s + 32) * 128 + c0s * 8);
            sv0 = *(const v4u*)(Vp + (size_t)(tn + r0s) * 512 + c0s * 8);  sv1 = *(const v4u*)(Vp + (size_t)(tn + r0s + 32) * 512 + c0s * 8); }
        const float mc = SMC[c];
        if (isCD) {
            if (c > 0) { const int t0p = t0 - 64; const float mcp = SMC[c - 1], mxap = fmaxf(mcp, SAMX[c - 1]); const float csp = __expf(mcp - mxap);
                bf16x8v vfp[4];
#pragma unroll
                for (int ks = 0; ks < 4; ++ks) { const f32x4 a0 = *(const LAS f32x4*)(SA + t0p + 16 * ks + 8 * hi), a1 = *(const LAS f32x4*)(SA + t0p + 16 * ks + 8 * hi + 4);
                    const float wk[8] = {__expf(a0.x - mxap), __expf(a0.y - mxap), __expf(a0.z - mxap), __expf(a0.w - mxap), __expf(a1.x - mxap), __expf(a1.y - mxap), __expf(a1.z - mxap), __expf(a1.w - mxap)};
                    const v4u vu = __builtin_bit_cast(v4u, vfk[ks]); v4u o4;
                    o4.x = cvtpk(bflo(vu.x) * wk[0], bfhi(vu.x) * wk[1]); o4.y = cvtpk(bflo(vu.y) * wk[2], bfhi(vu.y) * wk[3]); o4.z = cvtpk(bflo(vu.z) * wk[4], bfhi(vu.z) * wk[5]); o4.w = cvtpk(bflo(vu.w) * wk[6], bfhi(vu.w) * wk[7]);
                    vfp[ks] = __builtin_bit_cast(bf16x8v, o4); }
#pragma unroll
                for (int dt = 0; dt < 4; ++dt) { bf16x8v kf[4];
#pragma unroll
                    for (int ks = 0; ks < 4; ++ks) kf[ks] = tr32_frag(Kp, lc, dt, ks);
                    SBAR();
#pragma unroll
                    for (int e = 0; e < 16; ++e) Cacc[dt][e] *= csp;
#pragma unroll
                    for (int ks = 0; ks < 4; ++ks) Cacc[dt] = MFMA32(kf[ks], vfp[ks], Cacc[dt]);
                    SBAR(); } }
        } else if (jw != 2) {
            const int st = (jw == 3) ? 1 : 0, tt = (jw == 0) ? 0 : 1; const int t = 32 * tt + r32;
            const float Mt = fmaxf(SPM[t0 + t], mc);
            f32x4 as4[4];
#pragma unroll
            for (int g = 0; g < 4; ++g) as4[g] = *(const LAS f32x4*)(SA + t0 + 32 * st + 8 * g + 4 * hi);
            f32x16 acc;
#pragma unroll
            for (int e = 0; e < 16; ++e) acc[e] = 0.f;
#pragma unroll
            for (int kh = 0; kh < 2; ++kh) { bf16x8v ka[4], qb[4];
#pragma unroll
                for (int k4 = 0; k4 < 4; ++k4) { const int ks = 4 * kh + k4; ka[k4] = *(const LAS bf16x8v*)(Ki + img_off(32 * st + r32, 2 * ks + hi)); qb[k4] = *(const LAS bf16x8v*)(Qi + img_off(t, 2 * ks + hi)); }
                SBAR();
#pragma unroll
                for (int k4 = 0; k4 < 4; ++k4) acc = MFMA32(ka[k4], qb[k4], acc);
                SBAR(); }
            float rp = 0.f;
#pragma unroll
            for (int g = 0; g < 4; ++g) { float v[4];
#pragma unroll
                for (int e = 0; e < 4; ++e) { const float x = acc[4 * g + e] * __expf(as4[g][e] - Mt); v[e] = (st == tt && (8 * g + 4 * hi + e) > r32) ? 0.f : x; rp += v[e]; }
                v2u wv; wv.x = cvtpk(v[0], v[1]); wv.y = cvtpk(v[2], v[3]);
                *(LAS v2u*)(L + M2_SC + t * 128 + (((4 * st + g) ^ (t & 7)) << 4) + 8 * hi) = wv; }
            rp = xor32_sum(rp);
            if (hi == 0) DEN[st * 64 + t] = rp;
        } else {
            { const v4u z4 = {0u, 0u, 0u, 0u};
              *(LAS v4u*)(L + M2_SC + r32 * 128 + (((4 + 2 * hi) ^ (r32 & 7)) << 4)) = z4; *(LAS v4u*)(L + M2_SC + r32 * 128 + (((5 + 2 * hi) ^ (r32 & 7)) << 4)) = z4;
              if (hi == 0) DEN[64 + r32] = 0.f; }
            float qn = 0.f;
#pragma unroll 4
            for (int ch = 0; ch < 16; ++ch) { const v4u q8 = *(const LAS v4u*)(Qi + img_off(lc, ch)); const f32x4 n0 = *(const LAS f32x4*)(NV + 8 * ch), n1 = *(const LAS f32x4*)(NV + 8 * ch + 4);
                qn += bflo(q8.x) * n0.x + bfhi(q8.x) * n0.y + bflo(q8.y) * n0.z + bfhi(q8.y) * n0.w + bflo(q8.z) * n1.x + bfhi(q8.z) * n1.y + bflo(q8.w) * n1.z + bfhi(q8.w) * n1.w; }
            QN[lc] = qn;
            const float mxa = fmaxf(mc, SAMX[c]), cs = __expf(mc - mxa); const float wkl = __expf(SA[t0 + lc] - mxa);
            const f32x2v nold = *(const LAS f32x2v*)(NV + 2 * lc); float n0a = 0.f, n1a = 0.f;
#pragma unroll
            for (int s = 0; s < 64; ++s) { const unsigned kk = *(const LAS unsigned*)(Ki + img_off(s, lc >> 2) + (lc & 3) * 4); const float ws = __builtin_bit_cast(float, __builtin_amdgcn_readlane(__builtin_bit_cast(int, wkl), s)); n0a += ws * bflo(kk); n1a += ws * bfhi(kk); }
            LDS_WAIT();
            *(LAS f32x2v*)(NV + 2 * lc) = (f32x2v){cs * nold.x + n0a, cs * nold.y + n1a};
        }
        LBAR();
        v2u og[2][4];
        if (isCD) {
#pragma unroll
            for (int ks = 0; ks < 4; ++ks) vfk[ks] = tr32_frag(Vi, lc, jw, ks);
#pragma unroll
            for (int tt = 0; tt < 2; ++tt) { const int t = 32 * tt + r32;
                bf16x8v scf[4];
#pragma unroll
                for (int ks = 0; ks < 4; ++ks) scf[ks] = *(const LAS bf16x8v*)(L + M2_SC + t * 128 + (((2 * ks + hi) ^ (t & 7)) << 4));
                const float pmt = SPM[t0 + t], ft = SF[t0 + t], dnp = DEN[t] + DEN[64 + t], qnt = QN[t];
                f32x16 a1, a2;
#pragma unroll
                for (int e = 0; e < 16; ++e) { a1[e] = 0.f; a2[e] = 0.f; }
#pragma unroll
                for (int kh = 0; kh < 2; ++kh) { v2u ql[4], qh[4];
#pragma unroll
                    for (int k4 = 0; k4 < 4; ++k4) { const int k8 = 4 * kh + k4; ql[k4] = *(const LAS v2u*)(Qi + img_off(t, 2 * k8) + 8 * hi); qh[k4] = *(const LAS v2u*)(Qi + img_off(t, 2 * k8 + 1) + 8 * hi); }
                    SBAR();
                    if (kh == 0) {
#pragma unroll
                        for (int ks = 0; ks < 4; ++ks) a1 = MFMA32(vfk[ks], scf[ks], a1); }
#pragma unroll
                    for (int k4 = 0; k4 < 4; ++k4) { const int k8 = 4 * kh + k4; v4u qq; qq.x = ql[k4].x; qq.y = ql[k4].y; qq.z = qh[k4].x; qq.w = qh[k4].y; a2 = MFMA32(pack8(Cacc[k8 >> 1], k8 & 1), __builtin_bit_cast(bf16x8v, qq), a2); }
                    SBAR(); }
                const float Mt = fmaxf(pmt, mc), wp = __expf(mc - Mt), emt = __expf(-ft - Mt);
                const float idn = __builtin_amdgcn_rcpf(fmaxf(fabsf(dnp + wp * qnt), emt));
                float ss = 0.f;
#pragma unroll
                for (int e = 0; e < 16; ++e) { const float x = (a1[e] + a2[e] * wp) * idn; hv[tt][e] = x; ss += x * x; }
                ss = xor32_sum(ss);
                if (hi == 0) SSQ[((c & 1) * 4 + jw) * 64 + t] = ss;
                SBAR(); }
            { const bf16* Op = MP_MO + rb * 512 + hh * 128 + 32 * jw + 4 * hi;
#pragma unroll
              for (int tt = 0; tt < 2; ++tt)
#pragma unroll
                  for (int g = 0; g < 4; ++g) og[tt][g] = *(const v2u*)(Op + (size_t)(t0 + 32 * tt + r32) * 512 + 8 * g); }
        }
        if (c + 1 < 32) { LAS unsigned char* Nx = L + M2_IMG + ((c + 1) & 1) * 49152;
            *(LAS v4u*)(Nx + so0) = sq0; *(LAS v4u*)(Nx + so1) = sq1; *(LAS v4u*)(Nx + 16384 + so0) = sk0; *(LAS v4u*)(Nx + 16384 + so1) = sk1; *(LAS v4u*)(Nx + 32768 + so0) = sv0; *(LAS v4u*)(Nx + 32768 + so1) = sv1; }
        LBAR();
        if (isCD) {
            bf16* Yp = MP_Y + rb * DM + 512 + hh * 128 + 32 * jw + 4 * hi; const float* gnp = P.mnorm_g + hh * 128 + 32 * jw + 4 * hi;
            f32x4 gn4[4];
#pragma unroll
            for (int g = 0; g < 4; ++g) gn4[g] = *(const f32x4*)(gnp + 8 * g);
#pragma unroll
            for (int tt = 0; tt < 2; ++tt) { const int t = 32 * tt + r32; const LAS float* sp = SSQ + (c & 1) * 256 + t;
                const float rn = __frsqrt_rn(((sp[0] + sp[64]) + (sp[128] + sp[192])) * (1.f / 128.f) + EPS);
#pragma unroll
                for (int g = 0; g < 4; ++g) { const float y0 = hv[tt][4 * g] * rn * gn4[g].x * sigmoidf_(bflo(og[tt][g].x)), y1 = hv[tt][4 * g + 1] * rn * gn4[g].y * sigmoidf_(bfhi(og[tt][g].x));
                    const float y2 = hv[tt][4 * g + 2] * rn * gn4[g].z * sigmoidf_(bflo(og[tt][g].y)), y3 = hv[tt][4 * g + 3] * rn * gn4[g].w * sigmoidf_(bfhi(og[tt][g].y));
                    v2u wv; wv.x = cvtpk(y0, y1); wv.y = cvtpk(y2, y3);
                    *(v2u*)(Yp + (size_t)(t0 + t) * DM + 8 * g) = wv; } }
        }
    }
    LBAR();
}

#ifndef MK_MULTI
#define MK_MULTI 0
#endif
#define REP_IF(k) for (int rep_ = 0; rep_ < ((PROBE_DUP == (k)) ? 2 : 1); ++rep_)
constexpr int PH_PER_LAYER = 8, N_PHASES = 1 + DEPTH * PH_PER_LAYER;
struct Args { const float* in[16]; float* out; unsigned char* ws; int ph_lo, ph_hi; };
static_assert(sizeof(Args) == 16 * 8 + 8 + 8 + 8, "Args has no padding");

__global__ void __launch_bounds__(NWAVES * 64, 2) fwd_kernel(Args args) {
    extern __shared__ __attribute__((aligned(16))) unsigned char lds_raw[];
    LAS unsigned char* L = (LAS unsigned char*)lds_raw;
    const int G0 = gridDim.x, blk0 = blockIdx.x;
    const int wave0 = __builtin_amdgcn_readfirstlane((int)threadIdx.x >> 6);
#define PH_IDS() PH_WS(); int wave = wave0; asm volatile("" : "+s"(wave)); const int lane = fresh_lane(), tid = wave * 64 + lane, gw = blk * NWAVES + wave; (void)gw
#define PH_WS() size_t zoff_ = 0; asm volatile("" : "+s"(zoff_)); unsigned char* ws = (unsigned char*)__builtin_assume_aligned(args.ws, 256) + zoff_; int blk = blk0, G = G0; asm volatile("" : "+s"(blk), "+s"(G)); const int NGW = G * NWAVES; (void)NGW; bf16* X16 = (bf16*)(ws + WS_X16); float* SS2 = (float*)(ws + WS_TAB + TAB_SS2); bf16* U = (bf16*)(ws + WS_U); bf16* HB = (bf16*)(ws + WS_HB); bf16* HD = (bf16*)(ws + WS_HD); \
    unsigned char* wl = ws + WS_W; const float* ng = args.in[1] + (size_t)l_ * 6 * DM; (void)X16; (void)SS2; (void)U; (void)HB; (void)HD; (void)wl; (void)ng
    unsigned char* ws0 = args.ws;
    volatile LAS unsigned* MISC = (volatile LAS unsigned*)(L + MISC_OFF);
    { const int tid_e = wave0 * 64 + fresh_lane(); if (tid_e < 16) MISC[tid_e] = 0u; if (tid_e >= 64 && tid_e < 80) MISC[tid_e] = 0u; if (tid_e >= 208 && tid_e < 216) MISC[tid_e] = 0u; if (tid_e >= 144 && tid_e < 158) MISC[tid_e] = 0u; }
    __syncthreads();
    XcdBarrier bar; bar.bar = (unsigned*)(ws0 + WS_CTL) + CW_BAR; bar.x = 0; bar.st = nullptr;
    if (!MK_MULTI) bar = xcd_barrier_post((unsigned*)(ws0 + WS_CTL) + CW_BAR, MISC + 8, wave0 * 64 + fresh_lane() == 0);
#if PROBE_SC >= 6
    if (blk0 == 0 && wave0 * 64 + fresh_lane() == 0) { MISC[159] = (unsigned)__builtin_amdgcn_s_memrealtime(); MISC[158] = MISC[159]; }
#endif
    const int lo = args.ph_lo, hi = args.ph_hi;
#define IN(k) (lo <= (k) && (k) < hi)
#if PROBE_SC == 30 || PROBE_SC == 31
#define SEAM(k) do { const unsigned bt0_ = (unsigned)__builtin_amdgcn_s_memrealtime(); if (IN(k) && IN((k) + 1)) xcd_barrier(bar, wave0 * 64 + fresh_lane() == 0); \
    if (blk0 == PROBE_BLK && wave0 * 64 + fresh_lane() == 0) { const unsigned dt_ = (unsigned)__builtin_amdgcn_s_memrealtime() - bt0_; MISC[150] += dt_; if ((k) == 5) MISC[151] = dt_; if ((k) == 13) MISC[152] = dt_; } } while (0)
#elif PROBE_SC >= 6
#define SEAM(k) do { if (IN(k) && IN((k) + 1)) xcd_barrier(bar, wave0 * 64 + fresh_lane() == 0); \
    if (blk0 == 0 && wave0 * 64 + fresh_lane() == 0) { const unsigned now_ = (unsigned)__builtin_amdgcn_s_memrealtime(); MISC[160 + (k)] = now_ - MISC[159]; MISC[159] = now_; } } while (0)
#else
#define SEAM(k) do { if (IN(k) && IN((k) + 1)) xcd_barrier(bar, wave0 * 64 + fresh_lane() == 0); } while (0)
#endif

    REP_IF(5) {
    if (IN(0)) {
        const int l_ = 0; PH_IDS();
        const float* x_in = args.in[0]; float* b1T = (float*)(ws + WS_TAB + TAB_B1);
#define CONVERT_WEIGHTS(lw, GM) do { LAS float* scr = (LAS float*)(L + wave * 16384); const float* ngw = args.in[1] + (size_t)(lw) * 6 * DM; \
        constexpr int I_GU = 16 * 176, I_DN = 44 * 32, I_IN = 16 * 112, I_OUT = 16 * 32, I_CMP = 16 * 16, I_LAYER = 2 * I_GU + 2 * I_DN + I_IN + I_OUT + I_CMP; \
        for (int it = gw; it < I_LAYER; it += NGW) { int r = it; unsigned char* wlw = ws + WS_W; \
            if (r < I_GU) { if ((GM) & 1) { SrcGU s{args.in[2] + (size_t)(lw) * DM * NGU, ngw + 0 * DM}; transpose_item(s, DM, (bf16*)(wlw + WO_GU1), scr, r / 176, r % 176, lane); } continue; } r -= I_GU; \
            if (r < I_DN) { if ((GM) & 2) { SrcPlain s{args.in[3] + (size_t)(lw) * FF * DM, DM, nullptr}; transpose_item(s, FF, (bf16*)(wlw + WO_DN1), scr, r / 32, r % 32, lane); } continue; } r -= I_DN; \
            if (r < I_GU) { if ((GM) & 4) { SrcGU s{args.in[4] + (size_t)(lw) * DM * NGU, ngw + 4 * DM}; transpose_item(s, DM, (bf16*)(wlw + WO_GU2), scr, r / 176, r % 176, lane); } continue; } r -= I_GU; \
            if (r < I_DN) { if ((GM) & 8) { SrcPlain s{args.in[5] + (size_t)(lw) * FF * DM, DM, nullptr}; transpose_item(s, FF, (bf16*)(wlw + WO_DN2), scr, r / 32, r % 32, lane); } continue; } r -= I_DN; \
            if (r < I_IN) { if ((GM) & 16) { SrcIN s{args.in[6] + (size_t)(lw) * DM * INCOLS, ngw + 2 * DM}; transpose_item(s, DM, (bf16*)(wlw + WO_IN), scr, r / 112, r % 112, lane); } continue; } r -= I_IN; \
            if (r < I_OUT) { if ((GM) & 32) { SrcPlain s{args.in[7] + (size_t)(lw) * DM * DM, DM, nullptr}; transpose_item(s, DM, (bf16*)(wlw + WO_OUT), scr, r / 32, r % 32, lane); } continue; } r -= I_OUT; \
            if ((GM) & 64) { SrcCMP s{args.in[9] + (size_t)(lw) * 2 * 2048 * 128, nullptr}; transpose_item(s, DM, (bf16*)(ws + WS_CMPW + (size_t)(lw) * MiB), scr, r / 16, r % 16, lane); } } } while (0)
        CONVERT_WEIGHTS(0, 0x7f);
        if (DEPTH > 1) CONVERT_WEIGHTS(1, 0x40);
        { bf16* w2t = (bf16*)(ws + WS_TAB + TAB_W2T);
          for (int i = blk * 512 + tid; i < DEPTH * 2 * 64 * 128; i += G * 512) { const int lk = i >> 13, o = (i >> 7) & 63, kk = i & 127; w2t[i] = (bf16)f2bf(args.in[10][((size_t)lk * 128 + kk) * 64 + o]); } }
        { LAS float* part = (LAS float*)(L + 131072);
          for (int ob = blk; ob < DEPTH * 2 * 128 / 2; ob += G) { const int o = 2 * ob + (wave >> 2), qr = wave & 3; const int lk = o >> 7, c = o & 127;
              const float* pe = args.in[8] + (size_t)lk * 2048; const float* w1 = args.in[9] + (size_t)lk * 2048 * 128;
              float s = 0.f; for (int r = qr * 512 + lane; r < qr * 512 + 512; r += 64) s += pe[r] * w1[(size_t)r * 128 + c];
              s = wave_sum(s, lane); if (lane == 0) part[wave] = s;
              __syncthreads();
              if (lane == 0 && qr == 0) b1T[o] = (part[wave] + part[wave + 1]) + (part[wave + 2] + part[wave + 3]);
              __syncthreads(); } }
        thin_phase<0>(nullptr, x_in, X16, nullptr, SS2, nullptr, 0.f, gw, NGW, lane);
    }
    SEAM(0);
    }

#pragma unroll 1
    for (int l = 0; l < DEPTH; ++l) {
        const int pb = 1 + l * PH_PER_LAYER, l_ = l;
        REP_IF(1) {
        if (IN(pb + 0)) { PH_IDS(); pg8::Gemm g{X16, (const bf16*)(wl + WO_GU1), MTOK, NGU, DM}; pg8::StaticOrder S; S.init(MTOK, NGU, G, blk); EpiSwiglu E{HB, SS2, L + 131072};
#if PROBE_SC == 1 || PROBE_SC == 2
            if (l_ == 0) pg8::gemm_phase<EpiSwiglu, pg8::StaticOrder, true, true, 1>(L, g, S, E, tid); else
#endif
#if PROBE_SC >= 3
            const unsigned long long pt0 = __builtin_amdgcn_s_memrealtime();
#endif
            pg8::gemm_phase<EpiSwiglu, pg8::StaticOrder, GU_ALIGN, true>(L, g, S, E, tid);
#if PROBE_SC == 3
            if (l_ == 0 && tid == 0) { MISC[64] = (unsigned)(__builtin_amdgcn_s_memrealtime() - pt0); }
#endif
#if PROBE_SC == 4 || PROBE_SC == 5
            if (l_ == 0 && tid == 0) { const unsigned sp = (unsigned)(__builtin_amdgcn_s_memrealtime() - pt0); atomicMax((unsigned*)(ws + WS_CTL) + 33024, (sp << 8) | (unsigned)blk); }
#endif
            }
        SEAM(pb + 0);
        }
        if (IN(pb + 1)) { PH_IDS(); pg8::Gemm g{HB, (const bf16*)(wl + WO_DN1), MTOK, DM, FF}; pg8::StaticOrder S; S.init(MTOK, DM, G, blk);
            EpiResNorm<false> E{ws, (LAS float*)(L + 131072), ng + 1 * DM, nullptr, 0.5f, l_ * 3 + 0};
#if PROBE_SC == 21
            const unsigned pt1 = (unsigned)__builtin_amdgcn_s_memrealtime();
            if (l_ == 0) pg8::gemm_phase<EpiResNorm<false>, pg8::StaticOrder, true, true, 1>(L, g, S, E, tid); else
#endif
            pg8::gemm_phase<EpiResNorm<false>, pg8::StaticOrder, true, true>(L, g, S, E, tid);
#if PROBE_SC == 21
            if (l_ == 0 && tid == 0) MISC[66] = (unsigned)__builtin_amdgcn_s_memrealtime() - pt1;
#endif
            }
        SEAM(pb + 1);
        REP_IF(3) {
        if (IN(pb + 2)) { PH_IDS(); pg8::Gemm g{X16, (const bf16*)(wl + WO_IN), MTOK, NINP, DM}; pg8::StaticOrder S; S.init(MTOK, NINP, G, blk);
            EpiInProj E{ws, L + 131072};
#if PROBE_SC == 23
            const unsigned pt1 = (unsigned)__builtin_amdgcn_s_memrealtime();
            if (l_ == 0) pg8::gemm_phase<EpiInProj, pg8::StaticOrder, true, true, 1>(L, g, S, E, tid); else
#endif
            pg8::gemm_phase<EpiInProj, pg8::StaticOrder, true, true>(L, g, S, E, tid);
#if PROBE_SC == 23
            if (l_ == 0 && tid == 0) MISC[66] = (unsigned)__builtin_amdgcn_s_memrealtime() - pt1;
#endif
            }
        SEAM(pb + 2);
        }
        if (IN(pb + 4)) {
            PH_IDS();
            MixPtrs P{ws, args.in[11] + (size_t)l * 4 * 1024, args.in[12] + (size_t)l * 1024, args.in[13] + l * 4, args.in[14] + l * 4, args.in[15] + l * 512};
            unsigned* cflag = (unsigned*)(ws + WS_CTL) + CW_CFLAG + 1024 * l_;
            if (blk < 64 || blk >= 96) {
                const int cb = blk < 64 ? blk : blk - 32;
                mlstm_conv_pass(ws, P.conv_w, P.conv_b, cb * 512 + tid, 224 * 512);
                asm volatile("s_waitcnt vmcnt(0)" ::: "memory"); __syncthreads();
                if (tid == 0) { __builtin_amdgcn_fence(__ATOMIC_RELEASE, "agent"); asm volatile("s_waitcnt vmcnt(0)" ::: "memory");
                    (void)__hip_atomic_fetch_add(cflag + 64 * 15 + 32, 1u, __ATOMIC_RELAXED, __HIP_MEMORY_SCOPE_AGENT); }
            }
            if (blk < 64) {
                if (tid == 0) { unsigned sp = 0u; while (__hip_atomic_load(cflag + 64 * 15 + 32, __ATOMIC_RELAXED, __HIP_MEMORY_SCOPE_AGENT) < 224u) { __builtin_amdgcn_s_sleep(4); if (++sp > (1u << 17)) break; } }
                __syncthreads();
                __builtin_amdgcn_fence(__ATOMIC_ACQUIRE, "agent"); asm volatile("s_waitcnt vmcnt(0)" ::: "memory");
                mlstm_unit_v3(L, P, blk >> 2, blk & 3, tid);
            } else if (blk < 96) {
                pg8::Gemm g{(const bf16*)(ws + WS_KCR), (const bf16*)(ws + WS_CMPW + (size_t)l_ * MiB), 8192, 512, DM}; CmpOrder S{blk - 64, G};
                EpiCmpMlp E{ws, (const float*)(ws + WS_TAB + TAB_B1) + l_ * 2 * 128, (const bf16*)(ws + WS_TAB + TAB_W2T) + (size_t)l_ * 2 * 64 * 128};
                pg8::gemm_phase<EpiCmpMlp, CmpOrder, false, true>(L, g, S, E, tid);
                asm volatile("s_waitcnt vmcnt(0)" ::: "memory"); __syncthreads();
                if (tid == 0) { __builtin_amdgcn_fence(__ATOMIC_RELEASE, "agent"); asm volatile("s_waitcnt vmcnt(0)" ::: "memory");
                    (void)__hip_atomic_fetch_add(cflag + 64 * ((blk - 64) & 15), 1u, __ATOMIC_RELAXED, __HIP_MEMORY_SCOPE_AGENT); }
            } else {
                const int gw = (blk - 96) * NWAVES + wave, NGW = (G - 96) * NWAVES;
                if (l_ == 0) { if (DEPTH > 1) CONVERT_WEIGHTS(1, 0x13); } else CONVERT_WEIGHTS(l_, 0x2c);
            }
            { unsigned* qbase = (unsigned*)(ws + WS_CTL) + CW_QUEUE + 1024 * l_; volatile LAS unsigned* QW = (volatile LAS unsigned*)(L + MISC_OFF);
              const unsigned q0 = xb_xcc_id() & 7u; unsigned rdy = 0u;
#pragma unroll 1
              for (unsigned qq = 0; qq < 8u; ++qq) { unsigned* qctr = qbase + 64 * ((q0 + qq) & 7u); const int bg0 = 4 * (int)((q0 + qq) & 7u);
                  __syncthreads();
                  if (tid == 0) QW[0] = __hip_atomic_fetch_add(qctr, 1u, __ATOMIC_RELAXED, __HIP_MEMORY_SCOPE_AGENT);
                  __syncthreads();
                  unsigned u = QW[0];
                  while (u < 128u) { unsigned nxt = 0u; if (tid == 0) nxt = __hip_atomic_fetch_add(qctr, 1u, __ATOMIC_RELAXED, __HIP_MEMORY_SCOPE_AGENT);
                      const int c = 31 - (int)(u >> 2), bg = bg0 + (int)(u & 3u);
                      if (!((rdy >> (bg >> 1)) & 1u)) {
                          if (tid == 0) { unsigned sp = 0u; while (__hip_atomic_load(cflag + 64 * (bg >> 1), __ATOMIC_RELAXED, __HIP_MEMORY_SCOPE_AGENT) < 2u) { __builtin_amdgcn_s_sleep(4); if (++sp > (1u << 17)) break; } }
                          __syncthreads();
                          __builtin_amdgcn_fence(__ATOMIC_ACQUIRE, "agent"); asm volatile("s_waitcnt vmcnt(0)" ::: "memory");
                          rdy |= 1u << (bg >> 1); }
#if PROBE_SC == 22
                      const unsigned ut0_ = (unsigned)__builtin_amdgcn_s_memrealtime();
#endif
                      nsa_unit_v3(L, P, bg >> 1, bg & 1, c, tid);
#if PROBE_SC == 22
                      if (tid == 0) { MISC[212] += (unsigned)__builtin_amdgcn_s_memrealtime() - ut0_; MISC[213] += 1u; }
#endif
                      __syncthreads(); if (tid == 0) QW[0] = nxt; __syncthreads(); u = QW[0]; } } }
        }
#if PROBE_SC == 22
        if (l == 0 && blk0 == 255 && wave0 * 64 + fresh_lane() == 0) { unsigned* pw_ = (unsigned*)(ws0 + WS_CTL) + 33100;
            for (int i_ = 0; i_ < 4; ++i_) __hip_atomic_store(pw_ + i_, MISC[210 + i_], __ATOMIC_RELAXED, __HIP_MEMORY_SCOPE_AGENT); }
#endif
        SEAM(pb + 4);
        if (IN(pb + 5)) { PH_IDS(); pg8::Gemm g{U, (const bf16*)(wl + WO_OUT), MTOK, DM, DM}; pg8::StaticOrder S; S.init(MTOK, DM, G, blk);
            EpiResNorm<false> E{ws, (LAS float*)(L + 131072), ng + 3 * DM, nullptr, 1.0f, l_ * 3 + 1};
            pg8::gemm_phase<EpiResNorm<false>, pg8::StaticOrder, true, true>(L, g, S, E, tid); }
        SEAM(pb + 5);
        if (IN(pb + 6)) { PH_IDS(); pg8::Gemm g{X16, (const bf16*)(wl + WO_GU2), MTOK, NGU, DM}; pg8::StaticOrder S; S.init(MTOK, NGU, G, blk); EpiSwiglu E{HB, SS2, L + 131072};
            pg8::gemm_phase<EpiSwiglu, pg8::StaticOrder, GU_ALIGN, true>(L, g, S, E, tid); }
        SEAM(pb + 6);
        if (IN(pb + 7)) { PH_IDS(); pg8::Gemm g{HB, (const bf16*)(wl + WO_DN2), MTOK, DM, FF}; pg8::StaticOrder S; S.init(MTOK, DM, G, blk);
            if (l + 1 < DEPTH) { EpiResNorm<false> E{ws, (LAS float*)(L + 131072), ng + 5 * DM, nullptr, 0.5f, l_ * 3 + 2};
                pg8::gemm_phase<EpiResNorm<false>, pg8::StaticOrder, true, true>(L, g, S, E, tid); }
#if FINAL_FUSED
            else { EpiResNorm<true> E{ws, (LAS float*)(L + 131072), ng + 5 * DM, args.out, 0.5f, l_ * 3 + 2};
                pg8::gemm_phase<EpiResNorm<true>, pg8::StaticOrder, true, true>(L, g, S, E, tid); } }
        if (l + 1 < DEPTH) SEAM(pb + 7);
#else
            else { pg8::EpiBf16<0> E{HD, DM, nullptr, 0, 0, 1.f};
                pg8::gemm_phase<pg8::EpiBf16<0>, pg8::StaticOrder, true, true>(L, g, S, E, tid); } }
        if (l + 1 < DEPTH) SEAM(pb + 7);
        else { xcd_barrier(bar, wave0 * 64 + fresh_lane() == 0);
            if (IN(pb + 7)) { PH_IDS(); thin_phase<2>(HD, nullptr, X16, args.out, nullptr, ng + 5 * DM, 0.5f, gw, NGW, lane); } }
#endif
    }
#if PROBE_SC == 30 || PROBE_SC == 31
    if (blk0 == PROBE_BLK && wave0 * 64 + fresh_lane() == 0) { __hip_atomic_store((unsigned*)(args.ws + WS_CTL) + 33101, MISC[151], __ATOMIC_RELAXED, __HIP_MEMORY_SCOPE_AGENT); __hip_atomic_store((unsigned*)(args.ws + WS_CTL) + 33102, MISC[152], __ATOMIC_RELAXED, __HIP_MEMORY_SCOPE_AGENT);
        __hip_atomic_store((unsigned*)(args.ws + WS_CTL) + 33100, MISC[150], __ATOMIC_RELAXED, __HIP_MEMORY_SCOPE_AGENT); }
    if (blk0 == 0 && wave0 * 64 + fresh_lane() == 0) { unsigned sp_ = 0u; while (__hip_atomic_load((unsigned*)(args.ws + WS_CTL) + 33100, __ATOMIC_RELAXED, __HIP_MEMORY_SCOPE_AGENT) == 0u && ++sp_ < (1u << 20)) __builtin_amdgcn_s_sleep(8); }
#endif
#if PROBE_SC
    if (blk0 == 0 && wave0 * 64 + fresh_lane() == 0) {
        unsigned tk = MISC[64], cy = MISC[65];
        if (PROBE_SC == 4 || PROBE_SC == 5) { const unsigned pk = __hip_atomic_load((unsigned*)(args.ws + WS_CTL) + 33024, __ATOMIC_RELAXED, __HIP_MEMORY_SCOPE_AGENT); tk = (PROBE_SC == 4) ? (pk >> 8) : (pk & 255u) * 100u; }
#if PROBE_SC >= 6
        { const unsigned now_ = (unsigned)__builtin_amdgcn_s_memrealtime(); MISC[160 + 16] = now_ - MISC[159]; }
#define D_(k) MISC[160 + (k)]
        unsigned A_ = 0, B_ = 0;
        if (PROBE_SC == 6) { A_ = D_(0); B_ = D_(4) + D_(12); }
        if (PROBE_SC == 7) { A_ = D_(2) + D_(10); B_ = D_(3) + D_(11); }
        if (PROBE_SC == 8) { A_ = (D_(5) + D_(13)) / 2; B_ = D_(6) + D_(14); }
        if (PROBE_SC == 9) { A_ = (D_(7) + D_(15)) / 2; B_ = D_(8) + D_(16); }
        if (PROBE_SC == 10) { A_ = D_(1); B_ = D_(9); }
        if (PROBE_SC == 22) { const unsigned* pw_ = (const unsigned*)(args.ws + WS_CTL) + 33100; unsigned v_[4]; for (int i_ = 0; i_ < 4; ++i_) v_[i_] = __hip_atomic_load(pw_ + i_, __ATOMIC_RELAXED, __HIP_MEMORY_SCOPE_AGENT);
            A_ = (v_[1] ? (v_[0] * 50u) / v_[1] : 0u) * 4u;
            B_ = (v_[3] ? ((v_[2] - v_[0]) * 4u) / v_[3] : 0u) * 4u; }
        if (PROBE_SC == 31) { A_ = __hip_atomic_load((const unsigned*)(args.ws + WS_CTL) + 33101, __ATOMIC_RELAXED, __HIP_MEMORY_SCOPE_AGENT); B_ = __hip_atomic_load((const unsigned*)(args.ws + WS_CTL) + 33102, __ATOMIC_RELAXED, __HIP_MEMORY_SCOPE_AGENT); }
        if (PROBE_SC == 30) { const unsigned v_ = __hip_atomic_load((const unsigned*)(args.ws + WS_CTL) + 33100, __ATOMIC_RELAXED, __HIP_MEMORY_SCOPE_AGENT); A_ = v_; B_ = 0u; }
        if (PROBE_SC == 23) { A_ = MISC[64]; B_ = MISC[66]; }
        if (PROBE_SC == 21) { A_ = MISC[64]; B_ = MISC[66]; }
        if (PROBE_SC == 20) { A_ = MISC[200]; B_ = MISC[201]; }
        if (PROBE_SC == 15) { A_ = D_(3); B_ = D_(11); }
        if (PROBE_SC == 16) { A_ = D_(4); B_ = D_(12); }
        if (PROBE_SC == 17) { A_ = D_(2); B_ = D_(10); }
        if (PROBE_SC == 11) { A_ = D_(8); B_ = D_(16); }
        if (PROBE_SC == 12) { A_ = D_(7); B_ = D_(15); }
        if (PROBE_SC == 13) { A_ = D_(6); B_ = D_(14); }
        if (PROBE_SC == 14) { A_ = D_(5); B_ = D_(13); }
        { unsigned aq = (A_ + 200u) / 400u, bq = (B_ + 200u) / 400u; if (aq > 127u) aq = 127u; if (bq > 127u) bq = 127u; tk = (aq * 128u + bq) * 100u; }
#endif
        const unsigned long long delay = (PROBE_SC != 2) ? (unsigned long long)tk * 10ull : ((unsigned long long)cy * 10000ull) / (tk ? tk : 1u);
#if PROBE_SC >= 6
        while ((unsigned)__builtin_amdgcn_s_memrealtime() - MISC[158] < 500000u + (unsigned)delay) __builtin_amdgcn_s_sleep(8);
#else
        const unsigned long long t0 = __builtin_amdgcn_s_memrealtime();
        while (__builtin_amdgcn_s_memrealtime() - t0 < delay) __builtin_amdgcn_s_sleep(8);
#endif
    }
#endif
#undef IN
#undef SEAM
#undef CONVERT_WEIGHTS
#undef PH_IDS
#undef PH_WS
}

extern "C" void kernel_launch(void* const* d_in, const int* in_sizes, int n_in, void* d_out, int out_size, void* d_ws, size_t ws_size, hipStream_t stream) {
    static int grid = 0;
    if (grid == 0) {
        if (n_in != 16 || in_sizes[0] != MTOK * DM || out_size != MTOK * DM || ws_size < WS_END3) { fprintf(stderr, "kernel_launch: unexpected problem (n_in %d, ws %zu)\n", n_in, ws_size); grid = -1; return; }
        int dev = 0, cus = 0, per_cu = 0;
        if (hipGetDevice(&dev) != hipSuccess || hipDeviceGetAttribute(&cus, hipDeviceAttributeMultiprocessorCount, dev) != hipSuccess) { grid = -1; return; }
        if (hipFuncSetAttribute((const void*)fwd_kernel, hipFuncAttributeMaxDynamicSharedMemorySize, LDS_BYTES) != hipSuccess) { grid = -1; return; }
        if (hipOccupancyMaxActiveBlocksPerMultiprocessor(&per_cu, (const void*)fwd_kernel, NWAVES * 64, LDS_BYTES) != hipSuccess || per_cu < 1) { fprintf(stderr, "kernel_launch: occupancy query says %d\n", per_cu); }
        (void)hipGetLastError();
        grid = cus;
        if (grid != 256) { fprintf(stderr, "kernel_launch: %d CUs (the row-group exchange of the fused post-norm epilogues assumes 256 workgroups: 4 column tiles of a token tile in one round)\n", grid); grid = -1; return; }
    }
    if (grid < 0) return;
    (void)hipMemsetAsync((char*)d_ws + WS_CTL, 0, CTL_ZERO_BYTES, stream);
    Args a{};
    for (int i = 0; i < 16; ++i) a.in[i] = (const float*)d_in[i];
    a.out = (float*)d_out; a.ws = (unsigned char*)d_ws;
#if MK_MULTI
    for (int p = 0; p < N_PHASES; ++p) { a.ph_lo = p; a.ph_hi = p + 1; hipLaunchKernelGGL(fwd_kernel, dim3(grid), dim3(NWAVES * 64), LDS_BYTES, stream, a); }
#else
    a.ph_lo = 0; a.ph_hi = N_PHASES; hipLaunchKernelGGL(fwd_kernel, dim3(grid), dim3(NWAVES * 64), LDS_BYTES, stream, a);
#endif
}
```

```cpp
#include <hip/hip_runtime.h>
#include <cstdio>
#include <cstdint>
#ifndef FINAL_FUSED
#define FINAL_FUSED 1
#endif
#ifndef PROBE_DUP
#define PROBE_DUP 0
#endif
#ifndef GU_ALIGN
#define GU_ALIGN true
#endif
#ifndef EARLY_WB
#define EARLY_WB 0
#endif
#ifndef PROBE_BLK
#define PROBE_BLK 100
#endif
#ifndef PROBE_SC
#define PROBE_SC 0
#endif
namespace pg8 {
#define PG8_LAS __attribute__((address_space(3)))
typedef unsigned short bf16_t;
typedef short bf16x8 __attribute__((ext_vector_type(8)));
typedef float f32x4 __attribute__((ext_vector_type(4)));
typedef unsigned u32x4 __attribute__((ext_vector_type(4)));
constexpr int BM = 256, BK = 64, HALF = 128, HTB = HALF * BK * 2  , STAGE_BYTES = 8 * HTB, NXCD = 8, WGM = 4;

__host__ __device__ __forceinline__ int lds_byte(int r, int c) { const int st = (r >> 4) * 2 + (c >> 5), rr = r & 15, cc = c & 31, ob = rr * 64 + cc * 2; return st * 1024 + (ob ^ (((ob >> 9) & 1) << 5)); }
__host__ __device__ __forceinline__ void stage_rc(int b, int& R, int& C) { const int st = b / 1024, sb = b % 1024, swz = sb ^ (((sb >> 9) & 1) << 5); R = (st >> 1) * 16 + swz / 64; C = (st & 1) * 32 + (swz % 64) / 2; }
__host__ __device__ __forceinline__ int perm32(int rho) { const int n = rho >> 4, i = rho & 15; return 8 * (i >> 2) + 4 * n + (i & 3); }

struct Unit { int pm, pn; };
struct Gemm { const bf16_t* A; const bf16_t* Bt; int M, N, K; };

struct StaticOrder {
    int nM, nN, nwg, G, c;
    __host__ __device__ void init(int M, int N, int G_, int c_) { nM = M / BM; nN = N / BM; nwg = nM * nN; G = G_; c = c_; }
    __host__ __device__ bool next(int i, Unit& u) const {
        const long L = (long)i * G + c; if (L >= nwg) return false;
        int wgid = (int)L; { const int q = nwg / NXCD, r = nwg % NXCD, xcd = wgid % NXCD, off = wgid / NXCD; wgid = (xcd < r ? xcd * (q + 1) : r * (q + 1) + (xcd - r) * q) + off; }
        const int nig = WGM * nN, gid = wgid / nig, fm = gid * WGM, gsz = (nM - fm) < WGM ? (nM - fm) : WGM;
        u.pm = fm + ((wgid % nig) % gsz); u.pn = (wgid % nig) / gsz; return true;
    }
    __device__ __forceinline__ void a_ready(const Unit&) const {}
    __device__ __forceinline__ void done(const Unit&) const {}
};

__device__ __forceinline__ unsigned cvt_pk_bf16(float lo, float hi) { unsigned r; asm volatile("v_cvt_pk_bf16_f32 %0, %1, %2" : "=v"(r) : "v"(lo), "v"(hi)); return r; }
typedef float f32x2 __attribute__((ext_vector_type(2)));
__device__ __forceinline__ f32x2 gelu_pk(f32x2 v) {
    const f32x2 av = __builtin_elementwise_abs(v), d = av * 0.2316418882f + 1.0f;
    f32x2 t; t.x = __builtin_amdgcn_rcpf(d.x); t.y = __builtin_amdgcn_rcpf(d.y);
    f32x2 q = t * 0.5307027145f + (-0.7265760135f); q = q * t + 0.7107068705f; q = q * t + (-0.142248368f); q = q * t + 0.127414796f; q = q * t;
    const f32x2 s = (v * v) * (-0.72134752044f);
    f32x2 e; e.x = __builtin_amdgcn_exp2f(s.x); e.y = __builtin_amdgcn_exp2f(s.y);
    const f32x2 m = v * (q * e), r = v - m;
    f32x2 o; o.x = v.x < 0.f ? m.x : r.x; o.y = v.y < 0.f ? m.y : r.y; return o;
}

template <int ACT  > struct EpiBf16 {
    static constexpr bool PERM = true, AFTER_DRAIN = false, HAS_PRE = false; struct Pre {}; static_assert(ACT == 0 || ACT == 1, "EpiBf16: ACT is 0 (none) or 1 (gelu_pk)");
    bf16_t* O; int ldc; const float* bias; int split_cols; size_t split_stride; float scale0;
    __device__ __forceinline__ void operator()(const f32x4 (&acc)[2][2][4][2], const Unit& u, int wr, int wc, int fr, int fq) const {
        const int row0 = u.pm * BM + wr * 64 + fr; int colt = u.pn * BM; bf16_t* base = O;
        float sc = 1.f; if (split_cols) { const int t = colt / split_cols; base += (size_t)t * split_stride; colt -= t * split_cols; if (t == 0) sc = scale0; }
        const int col0 = colt + wc * 32 + 8 * fq, bcol0 = u.pn * BM + wc * 32 + 8 * fq;
        f32x4 bv[2][2];
#pragma unroll
        for (int bj = 0; bj < 2; ++bj)
#pragma unroll
            for (int n = 0; n < 2; ++n) bv[bj][n] = bias ? *(const f32x4*)(bias + bcol0 + bj * HALF + 4 * n) : (f32x4){0.f, 0.f, 0.f, 0.f};
#pragma unroll
        for (int ai = 0; ai < 2; ++ai)
#pragma unroll
            for (int m = 0; m < 4; ++m) { bf16_t* rowp = base + (size_t)(row0 + ai * HALF + m * 16) * ldc + col0;
#pragma unroll
                for (int bj = 0; bj < 2; ++bj) { f32x4 v0 = acc[ai][bj][m][0] + bv[bj][0], v1 = acc[ai][bj][m][1] + bv[bj][1];
                    if (ACT == 1) { f32x2 a = gelu_pk((f32x2){v0[0], v0[1]}), b = gelu_pk((f32x2){v0[2], v0[3]}), c = gelu_pk((f32x2){v1[0], v1[1]}), d = gelu_pk((f32x2){v1[2], v1[3]});
                        v0 = (f32x4){a.x, a.y, b.x, b.y}; v1 = (f32x4){c.x, c.y, d.x, d.y}; }
                    v0 = v0 * sc; v1 = v1 * sc; u32x4 w; w.x = cvt_pk_bf16(v0[0], v0[1]); w.y = cvt_pk_bf16(v0[2], v0[3]); w.z = cvt_pk_bf16(v1[0], v1[1]); w.w = cvt_pk_bf16(v1[2], v1[3]);
                    *(u32x4*)(rowp + bj * HALF) = w; } }
    }
};
template <class Epi, class Sched, bool ALIGN_EPI = false, bool SP2 = false, int SC = 0>
__device__ __forceinline__ void gemm_phase(PG8_LAS unsigned char* lds, const Gemm g, const Sched& S, const Epi& E, int tid_in) {
    int tid_l = tid_in; asm volatile("" : "+v"(tid_l));
    const int tid = tid_l, wid = __builtin_amdgcn_readfirstlane(tid >> 6), lane = tid & 63, wr = wid >> 2, wc = wid & 3, fr = lane & 15, fq = lane >> 4;
    const int K = g.K, nt = K / BK;
    unsigned voffA[2], voffB[2];
#pragma unroll
    for (int i = 0; i < 2; ++i) { int R, C; stage_rc(tid * 16 + i * 8192, R, C); const int Rb = Epi::PERM ? ((R & ~31) + perm32(R & 31)) : R;
        voffA[i] = (unsigned)(R * K + C) * 2u; voffB[i] = (unsigned)(Rb * K + C) * 2u; }
    const size_t kstep = (size_t)(BK * 2);
    const size_t hstep = (size_t)HALF * K * 2;
    const size_t tstep = 2 * hstep;
    const unsigned ldsw = (unsigned)wid * 1024u;
    const int aoff = lds_byte(wr * 64 + fr, fq * 8), boff = lds_byte(wc * 32 + fr, fq * 8);
#define PG8_SA(b, h) (((b) * 2 + (h)) * HTB)
#define PG8_SB(b, h) ((4 + (b) * 2 + (h)) * HTB)
#define PG8_STAGE(bufoff, gbase, voff) do { _Pragma("unroll") for (int _i = 0; _i < 2; ++_i) \
        __builtin_amdgcn_global_load_lds((const unsigned*)((const char*)(gbase) + (voff)[_i]), (PG8_LAS unsigned*)(lds + (bufoff) + ldsw + _i * 8192), 16, 0, 0); } while (0)
#define PG8_LDA(dst, b, h) do { _Pragma("unroll") for (int m = 0; m < 4; ++m) _Pragma("unroll") for (int k = 0; k < 2; ++k) dst[m][k] = *(const PG8_LAS bf16x8*)(lds + PG8_SA(b, h) + aoff + m * 2048 + k * 1024); } while (0)
#define PG8_LDB(dst, b, h) do { _Pragma("unroll") for (int n = 0; n < 2; ++n) _Pragma("unroll") for (int k = 0; k < 2; ++k) dst[n][k] = *(const PG8_LAS bf16x8*)(lds + PG8_SB(b, h) + boff + n * 2048 + k * 1024); } while (0)
#define PG8_MMA(ai, bj, At, Bt) do { __builtin_amdgcn_s_setprio(1); _Pragma("unroll") for (int m = 0; m < 4; ++m) _Pragma("unroll") for (int n = 0; n < 2; ++n) _Pragma("unroll") for (int k = 0; k < 2; ++k) \
        acc[ai][bj][m][n] = __builtin_amdgcn_mfma_f32_16x16x32_bf16(Bt[n][k], At[m][k], acc[ai][bj][m][n], 0, 0, 0); __builtin_amdgcn_s_setprio(0); } while (0)
#define PG8_WAIT_V(n) asm volatile("s_waitcnt vmcnt(" #n ")" ::: "memory")
#define PG8_WAIT_L(n) asm volatile("s_waitcnt lgkmcnt(" #n ")" ::: "memory")
#define PG8_BAR __builtin_amdgcn_s_barrier()
#define PG8_SCHED __builtin_amdgcn_sched_barrier(0)
    Unit cur, nxt; int ui = 0;
    if (!S.next(0, cur)) return;
    typename Epi::Pre pre;
    f32x4 acc[2][2][4][2];
#pragma unroll
    for (int a = 0; a < 2; ++a)
#pragma unroll
        for (int b = 0; b < 2; ++b)
#pragma unroll
            for (int m = 0; m < 4; ++m)
#pragma unroll
                for (int n = 0; n < 2; ++n) acc[a][b][m][n] = (f32x4){0.f, 0.f, 0.f, 0.f};
    bf16x8 At[4][2], B0[2][2], B1[2][2];
    const char* cA = (const char*)g.A + (size_t)cur.pm * tstep; const char* cB = (const char*)g.Bt + (size_t)cur.pn * tstep;
    S.a_ready(cur);
    if constexpr (SP2) {
        PG8_STAGE(PG8_SB(0, 0), cB, voffB); PG8_STAGE(PG8_SB(0, 1), cB + hstep, voffB); PG8_STAGE(PG8_SA(0, 0), cA, voffA); PG8_STAGE(PG8_SA(0, 1), cA + hstep, voffA);
        if (wr == 1) PG8_BAR;
        PG8_WAIT_V(2); PG8_BAR;
        PG8_STAGE(PG8_SB(1, 0), cB + kstep, voffB); PG8_STAGE(PG8_SA(1, 0), cA + kstep, voffA); PG8_STAGE(PG8_SB(1, 1), cB + hstep + kstep, voffB);
        PG8_WAIT_V(6); PG8_BAR;
    } else {
        PG8_STAGE(PG8_SB(0, 0), cB, voffB); PG8_STAGE(PG8_SA(0, 0), cA, voffA); PG8_STAGE(PG8_SB(0, 1), cB + hstep, voffB); PG8_STAGE(PG8_SA(0, 1), cA + hstep, voffA);
        if (wr == 1) PG8_BAR;
        PG8_WAIT_V(4); PG8_BAR;
        PG8_STAGE(PG8_SB(1, 0), cB + kstep, voffB); PG8_STAGE(PG8_SA(1, 0), cA + kstep, voffA); PG8_STAGE(PG8_SB(1, 1), cB + hstep + kstep, voffB);
        PG8_WAIT_V(6); PG8_BAR;
    }
    for (;;) {
        const bool has_next = S.next(ui + 1, nxt);
        unsigned long long sc_t0 = 0, sc_c0 = 0; if constexpr (SC != 0) { sc_t0 = __builtin_amdgcn_s_memrealtime(); sc_c0 = __builtin_amdgcn_s_memtime(); }
        const char* nA = has_next ? (const char*)g.A + (size_t)nxt.pm * tstep : cA; const char* nB = has_next ? (const char*)g.Bt + (size_t)nxt.pn * tstep : cB;
        for (int t = 0; t < nt; t += 2) {
            const bool last = (t == nt - 2);
            const char* a1 = cA + (size_t)(t + 1) * kstep;
            const char* a2 = last ? nA : cA + (size_t)(t + 2) * kstep; const char* b2 = last ? nB : cB + (size_t)(t + 2) * kstep;
            const char* a3 = a2 + kstep; const char* b3 = b2 + kstep;
            if (last && has_next) S.a_ready(nxt);
            if constexpr (Epi::HAS_PRE) { if (last) E.pre_load(cur, wr, wc, pre); }
            if constexpr (SP2) {
            PG8_LDB(B0, 0, 0); PG8_LDB(B1, 0, 1); PG8_SCHED; PG8_LDA(At, 0, 0); PG8_STAGE(PG8_SA(1, 1), a1 + hstep, voffA);
            PG8_WAIT_V(8); PG8_WAIT_L(0); PG8_BAR; PG8_MMA(0, 0, At, B0); PG8_MMA(0, 1, At, B1); PG8_BAR; PG8_SCHED;
            PG8_LDA(At, 0, 1); PG8_STAGE(PG8_SB(0, 0), b2, voffB); PG8_STAGE(PG8_SB(0, 1), b2 + hstep, voffB); PG8_STAGE(PG8_SA(0, 0), a2, voffA);
            PG8_WAIT_V(8); PG8_WAIT_L(0); PG8_BAR; PG8_MMA(1, 0, At, B0); PG8_MMA(1, 1, At, B1); PG8_BAR; PG8_SCHED;
            PG8_LDB(B0, 1, 0); PG8_LDB(B1, 1, 1); PG8_SCHED; PG8_LDA(At, 1, 0); PG8_STAGE(PG8_SA(0, 1), a2 + hstep, voffA);
            PG8_WAIT_V(8); PG8_WAIT_L(0); PG8_BAR; PG8_MMA(0, 0, At, B0); PG8_MMA(0, 1, At, B1); PG8_BAR; PG8_SCHED;
            PG8_LDA(At, 1, 1); PG8_STAGE(PG8_SB(1, 0), b3, voffB); PG8_STAGE(PG8_SB(1, 1), b3 + hstep, voffB); PG8_STAGE(PG8_SA(1, 0), a3, voffA);
            PG8_WAIT_V(8); PG8_WAIT_L(0); PG8_BAR; PG8_MMA(1, 0, At, B0); PG8_MMA(1, 1, At, B1); PG8_BAR; PG8_SCHED;
            } else {
            PG8_LDB(B0, 0, 0); PG8_SCHED; PG8_LDA(At, 0, 0); PG8_STAGE(PG8_SA(1, 1), a1 + hstep, voffA);
            PG8_WAIT_L(8); PG8_BAR; PG8_WAIT_L(0); PG8_MMA(0, 0, At, B0); PG8_BAR; PG8_SCHED;
            PG8_LDB(B1, 0, 1); PG8_STAGE(PG8_SB(0, 0), b2, voffB);
            PG8_BAR; PG8_WAIT_L(0); PG8_MMA(0, 1, At, B1); PG8_BAR;
            PG8_LDA(At, 0, 1); PG8_STAGE(PG8_SA(0, 0), a2, voffA);
            PG8_BAR; PG8_WAIT_L(0); PG8_MMA(1, 0, At, B0); PG8_BAR; PG8_SCHED;
            PG8_STAGE(PG8_SB(0, 1), b2 + hstep, voffB);
            PG8_WAIT_V(6); PG8_BAR; PG8_MMA(1, 1, At, B1); PG8_BAR;
            PG8_LDB(B0, 1, 0); PG8_SCHED; PG8_LDA(At, 1, 0); PG8_STAGE(PG8_SA(0, 1), a2 + hstep, voffA);
            PG8_WAIT_L(8); PG8_BAR; PG8_WAIT_L(0); PG8_MMA(0, 0, At, B0); PG8_BAR; PG8_SCHED;
            PG8_LDB(B1, 1, 1); PG8_STAGE(PG8_SB(1, 0), b3, voffB);
            PG8_BAR; PG8_WAIT_L(0); PG8_MMA(0, 1, At, B1); PG8_BAR;
            PG8_LDA(At, 1, 1); PG8_STAGE(PG8_SA(1, 0), a3, voffA);
            PG8_BAR; PG8_WAIT_L(0); PG8_MMA(1, 0, At, B0); PG8_BAR; PG8_SCHED;
            PG8_STAGE(PG8_SB(1, 1), b3 + hstep, voffB);
            PG8_WAIT_V(6); PG8_BAR; PG8_MMA(1, 1, At, B1); PG8_BAR;
            }
        }
        if constexpr (SC != 0) { const unsigned long long t1 = __builtin_amdgcn_s_memrealtime(), c1 = __builtin_amdgcn_s_memtime();
            if (tid == 0) { PG8_LAS unsigned* scw = (PG8_LAS unsigned*)(lds + 143360 + 256); scw[0] += (unsigned)(t1 - sc_t0); scw[1] += (unsigned)(c1 - sc_c0); } }
        if constexpr (ALIGN_EPI) { if (wr == 0) PG8_BAR; }
        if constexpr (!Epi::AFTER_DRAIN) { if constexpr (Epi::HAS_PRE) E(acc, cur, wr, wc, fr, fq, pre); else E(acc, cur, wr, wc, fr, fq); S.done(cur); }
        if (!has_next) break;
#pragma unroll
        for (int a = 0; a < 2; ++a)
#pragma unroll
            for (int b = 0; b < 2; ++b)
#pragma unroll
                for (int m = 0; m < 4; ++m)
#pragma unroll
                    for (int n = 0; n < 2; ++n) acc[a][b][m][n] = (f32x4){0.f, 0.f, 0.f, 0.f};
        cur = nxt; cA = nA; cB = nB; ++ui;
        if constexpr (ALIGN_EPI) { if (wr == 1) PG8_BAR; }
    }
    PG8_WAIT_V(0);
    if constexpr (!ALIGN_EPI) { if (wr == 0) PG8_BAR; }
    PG8_BAR;
    if constexpr (Epi::AFTER_DRAIN) { E.fused(acc, cur, wr, wc, fr, fq, lds, wid, lane); S.done(cur); }
#undef PG8_SA
#undef PG8_SB
#undef PG8_STAGE
#undef PG8_LDA
#undef PG8_LDB
#undef PG8_MMA
#undef PG8_WAIT_V
#undef PG8_WAIT_L
#undef PG8_BAR
#undef PG8_SCHED
}
}

#define LAS __attribute__((address_space(3)))
#define XB_TMO      128
#define XB_XCNT(j)  (256  + 64 * (j))
#define XB_XSUB(j)  (1280 + 64 * (j))
#define XB_XGEN(j)  (2304 + 64 * (j))
#define XB_TOP      3328
#define XB_TOPGEN   3392
#define XCD_BAR_WORDS 3456
#define XB_SPIN_CAP (1u << 18)

__device__ __forceinline__ unsigned xb_ld(unsigned* p)              { return __hip_atomic_load(p, __ATOMIC_RELAXED, __HIP_MEMORY_SCOPE_AGENT); }
__device__ __forceinline__ unsigned xb_add(unsigned* p, unsigned v) { return __hip_atomic_fetch_add(p, v, __ATOMIC_RELAXED, __HIP_MEMORY_SCOPE_AGENT); }
__device__ __forceinline__ unsigned xb_xcc_id() { return (unsigned)__builtin_amdgcn_s_getreg((3 << 11) | 20) & 0xFu; }
#define XB_SPIN(cond, bar) do { unsigned _sp = 0; while (cond) { __builtin_amdgcn_s_sleep(1); \
    if ((++_sp & 255u) == 0u) { if (xb_ld(&(bar)[XB_TMO])) break; if (_sp > XB_SPIN_CAP) { atomicAdd(&(bar)[XB_TMO], 1u); break; } } } } while (0)

struct XcdBarrier {
    unsigned* bar; unsigned x;
    volatile LAS unsigned* st;
};

__device__ __forceinline__ XcdBarrier xcd_barrier_post(unsigned* bar, volatile LAS unsigned* st, bool leader) {
    XcdBarrier b; b.bar = bar; b.x = xb_xcc_id(); b.st = st;
    if (leader) (void)xb_add(&bar[XB_XCNT(b.x)], 1u);
    return b;
}
__device__ __forceinline__ void xcd_barrier_complete(unsigned* bar, unsigned x, unsigned& nloc, unsigned& nx) {
    const unsigned G = gridDim.x * gridDim.y * gridDim.z;
    unsigned sum, cnt, mine, sp = 0u;
    for (;;) {
        sum = 0u; cnt = 0u; mine = 0u;
        unsigned cv[16];
        { const unsigned* cb = &bar[XB_XCNT(0)]; static_assert(XB_XCNT(1) - XB_XCNT(0) == 64, "counters are 256 bytes apart");
          asm volatile("global_load_dword %0, %16, off sc1\n\tglobal_load_dword %1, %16, off offset:256 sc1\n\tglobal_load_dword %2, %16, off offset:512 sc1\n\tglobal_load_dword %3, %16, off offset:768 sc1\n\t"
                       "global_load_dword %4, %16, off offset:1024 sc1\n\tglobal_load_dword %5, %16, off offset:1280 sc1\n\tglobal_load_dword %6, %16, off offset:1536 sc1\n\tglobal_load_dword %7, %16, off offset:1792 sc1\n\t"
                       "global_load_dword %8, %16, off offset:2048 sc1\n\tglobal_load_dword %9, %16, off offset:2304 sc1\n\tglobal_load_dword %10, %16, off offset:2560 sc1\n\tglobal_load_dword %11, %16, off offset:2816 sc1\n\t"
                       "global_load_dword %12, %16, off offset:3072 sc1\n\tglobal_load_dword %13, %16, off offset:3328 sc1\n\tglobal_load_dword %14, %16, off offset:3584 sc1\n\tglobal_load_dword %15, %16, off offset:3840 sc1\n\ts_waitcnt vmcnt(0)"
                       : "=&v"(cv[0]), "=&v"(cv[1]), "=&v"(cv[2]), "=&v"(cv[3]), "=&v"(cv[4]), "=&v"(cv[5]), "=&v"(cv[6]), "=&v"(cv[7]), "=&v"(cv[8]), "=&v"(cv[9]), "=&v"(cv[10]), "=&v"(cv[11]), "=&v"(cv[12]), "=&v"(cv[13]), "=&v"(cv[14]), "=&v"(cv[15])
                       : "v"(cb) : "memory"); }
#pragma unroll
        for (unsigned j = 0; j < 16; ++j) { const unsigned c = cv[j]; sum += c; cnt += (c > 0u) ? 1u : 0u; mine = (j == x) ? c : mine; }
        if (sum == G) break;
        __builtin_amdgcn_s_sleep(1);
        if ((++sp & 255u) == 0u) { if (xb_ld(&bar[XB_TMO])) break; if (sp > XB_SPIN_CAP) { atomicAdd(&bar[XB_TMO], 1u); break; } }
    }
    nloc = mine > 0u ? mine : 1u; nx = cnt > 0u ? cnt : 1u;
}

__device__ __forceinline__ void xcd_barrier(const XcdBarrier& b, bool leader) {
    asm volatile("s_waitcnt vmcnt(0)" ::: "memory");
    __syncthreads();
    if (leader) {
        unsigned* bar = b.bar;
        __builtin_amdgcn_s_waitcnt(0);
        unsigned nloc = b.st[0], nx = b.st[1];
        if (nloc == 0u) { xcd_barrier_complete(bar, b.x, nloc, nx); b.st[0] = nloc; b.st[1] = nx; }
#if EARLY_WB
        __builtin_amdgcn_fence(__ATOMIC_RELEASE, "agent");
        asm volatile("s_waitcnt vmcnt(0)" ::: "memory");
#endif
        const unsigned old = xb_add(&bar[XB_XSUB(b.x)], 1u);
        const unsigned gen = old / nloc;
        if (old + 1u == (gen + 1u) * nloc) {
#if !EARLY_WB
            __builtin_amdgcn_fence(__ATOMIC_RELEASE, "agent");
#endif
            asm volatile("s_waitcnt vmcnt(0)" ::: "memory");
            const unsigned og = xb_add(&bar[XB_TOP], 1u);
            const unsigned tg = og / nx;
            if (og + 1u == (tg + 1u) * nx) xb_add(&bar[XB_TOPGEN], 1u);
            else XB_SPIN(xb_ld(&bar[XB_TOPGEN]) == tg, bar);
            __builtin_amdgcn_fence(__ATOMIC_ACQUIRE, "agent");
            xb_add(&bar[XB_XGEN(b.x)], 1u);
            asm volatile("s_waitcnt vmcnt(0)" ::: "memory");
        } else {
            XB_SPIN(xb_ld(&bar[XB_XGEN(b.x)]) == gen, bar);
            __builtin_amdgcn_fence(__ATOMIC_ACQUIRE, "agent");
            asm volatile("s_waitcnt vmcnt(0)" ::: "memory");
        }
    }
    __syncthreads();
}

constexpr int BATCH = 16, SEQ = 2048, DM = 1024, MTOK = BATCH * SEQ, FF = 2816, NGU = 2 * FF, NINP = 3584, INCOLS = 3360, DEPTH = 2;
constexpr int NWAVES = 8;
constexpr float EPS = 1e-6f;
typedef unsigned short bf16;
typedef unsigned v4u __attribute__((ext_vector_type(4)));
typedef unsigned v2u __attribute__((ext_vector_type(2)));
typedef float f32x4 __attribute__((ext_vector_type(4)));
#define LDS_WAIT() asm volatile("s_waitcnt lgkmcnt(0)" ::: "memory")

constexpr size_t MiB = 1u << 20;
constexpr size_t WS_CTL = 0, CTL_ZERO_BYTES = 160 * 1024;
constexpr size_t WS_TAB = 1 * MiB;
constexpr size_t TAB_COS = 0, TAB_SIN = 65536, TAB_B1 = 131072, TAB_W2T = 196608, TAB_SS2 = 262144;
constexpr size_t WS_W = 2 * MiB;
constexpr size_t WO_GU1 = 0, WO_DN1 = 11 * MiB, WO_GU2 = 16 * MiB + MiB / 2, WO_DN2 = 27 * MiB + MiB / 2, WO_IN = 33 * MiB, WO_OUT = 40 * MiB, WO_CMP = 42 * MiB;
constexpr size_t WS_X16 = 45 * MiB;
constexpr size_t WS_U = 109 * MiB;
constexpr size_t WS_HB = 173 * MiB;
constexpr size_t WS_HD = 349 * MiB;
constexpr size_t WS_PQ = 413 * MiB;
constexpr size_t WS_CC = 421 * MiB;
constexpr size_t WS_END = 422 * MiB;
constexpr size_t WS_QN = 173 * MiB, WS_KCR = 205 * MiB, WS_VCR = 213 * MiB, WS_KS = 221 * MiB, WS_VS = 229 * MiB, WS_KW = 237 * MiB, WS_VW = 245 * MiB;
constexpr size_t WS_MQ = 253 * MiB, WS_MK = 285 * MiB, WS_MV = 317 * MiB, WS_MO = 349 * MiB, WS_GATE = 381 * MiB;
static_assert(WS_GATE + 4 * MiB <= WS_PQ, "in-projection outputs end below PQ");
constexpr int CW_BAR = 4096, CW_QUEUE = 16384, CW_GRP = 20480, CW_CFLAG = 33280;
constexpr size_t WS_PART = 486 * MiB, WS_CMPW = 489 * MiB, WS_END3 = 491 * MiB;
static_assert((CW_QUEUE + 2 * 1024) <= CW_GRP && (CW_GRP + 6 * 128 * 16) * 4 <= (int)CTL_ZERO_BYTES && (CW_BAR + 3456) <= CW_QUEUE && WS_TAB + TAB_SS2 + 16 * 32768 <= WS_W, "control words inside the zeroed region");
constexpr int PH_BYTES = 143360, MISC_OFF = PH_BYTES, LDS_BYTES = 147456;

__device__ __forceinline__ unsigned f2bf(float f) { unsigned u = __builtin_bit_cast(unsigned, f); return (u + 0x7fffu + ((u >> 16) & 1u)) >> 16; }
__device__ __forceinline__ unsigned pk2(float lo, float hi) { return f2bf(lo) | (f2bf(hi) << 16); }
typedef float f32x2v_ __attribute__((ext_vector_type(2))); typedef __bf16 bf16x2v_ __attribute__((ext_vector_type(2)));
__device__ __forceinline__ unsigned cvtpk(float lo, float hi) { f32x2v_ v = {lo, hi}; bf16x2v_ b = __builtin_convertvector(v, bf16x2v_); return __builtin_bit_cast(unsigned, b); }
__device__ __forceinline__ float bflo(unsigned u) { return __builtin_bit_cast(float, u << 16); }
__device__ __forceinline__ float bfhi(unsigned u) { return __builtin_bit_cast(float, u & 0xffff0000u); }
__device__ __forceinline__ float bf2f(bf16 b) { return __builtin_bit_cast(float, (unsigned)b << 16); }
__device__ __forceinline__ float sigmoidf_(float x) { return __builtin_amdgcn_rcpf(1.f + __expf(-x)); }
__device__ __forceinline__ int fresh_lane() { unsigned z = 0u; asm volatile("" : "+v"(z)); return (int)__builtin_amdgcn_mbcnt_hi(~0u, __builtin_amdgcn_mbcnt_lo(~0u, z)); }
__device__ __forceinline__ float shx(float v, int mask, int lane) { return __builtin_bit_cast(float, __builtin_amdgcn_ds_bpermute((lane ^ mask) << 2, __builtin_bit_cast(int, v))); }
__device__ __forceinline__ unsigned shxu(unsigned v, int mask, int lane) { return (unsigned)__builtin_amdgcn_ds_bpermute((lane ^ mask) << 2, (int)v); }
__device__ __forceinline__ float shi(float v, int src) { return __builtin_bit_cast(float, __builtin_amdgcn_ds_bpermute(src << 2, __builtin_bit_cast(int, v))); }
__device__ __forceinline__ float wave_sum(float v, int lane) {
    (void)lane;
    v += __builtin_bit_cast(float, __builtin_amdgcn_update_dpp(0, __builtin_bit_cast(int, v), 0xB1, 0xF, 0xF, false));
    v += __builtin_bit_cast(float, __builtin_amdgcn_update_dpp(0, __builtin_bit_cast(int, v), 0x4E, 0xF, 0xF, false));
    v += __builtin_bit_cast(float, __builtin_amdgcn_update_dpp(0, __builtin_bit_cast(int, v), 0x124, 0xF, 0xF, false));
    v += __builtin_bit_cast(float, __builtin_amdgcn_update_dpp(0, __builtin_bit_cast(int, v), 0x128, 0xF, 0xF, false));
    const int iv = __builtin_bit_cast(int, v);
    const float a = __builtin_bit_cast(float, __builtin_amdgcn_readlane(iv, 0)), b = __builtin_bit_cast(float, __builtin_amdgcn_readlane(iv, 16));
    const float c = __builtin_bit_cast(float, __builtin_amdgcn_readlane(iv, 32)), d = __builtin_bit_cast(float, __builtin_amdgcn_readlane(iv, 48));
    return (a + b) + (c + d);
}

struct SrcGU { const float* W; const float* g; __device__ __forceinline__ float operator()(int k, int nd) const { const int pn = nd >> 8, r = nd & 255; const int col = (r < 128) ? (pn * 128 + r) : (FF + pn * 128 + r - 128); return W[(size_t)k * NGU + col]; } };
struct SrcPlain { const float* W; int N; const float* g; __device__ __forceinline__ float operator()(int k, int nd) const { return W[(size_t)k * N + nd]; } };
struct SrcIN { const float* W; const float* g; __device__ __forceinline__ float operator()(int k, int nd) const {
    const int col = nd < 1280 ? nd : (nd < 3328 ? nd + 24 : (nd < 3352 ? nd - 3328 + 1280 : (nd < 3360 ? nd : -1)));
    return col < 0 ? 0.f : W[(size_t)k * INCOLS + col]; } };
struct SrcCMP { const float* W1; const float* g; __device__ __forceinline__ float operator()(int k, int nd) const { const int kv = nd >> 8, r = nd & 255;
    return r < 128 ? W1[((size_t)kv * 2048 + k) * 128 + r] : W1[((size_t)kv * 2048 + 1024 + k) * 128 + r - 128]; } };

template <class SrcF>
__device__ __forceinline__ void transpose_item(const SrcF& src, int K, bf16* WT, LAS float* scr, int kb, int nb, int lane) {
    const int k0 = 64 * kb, n0 = 32 * nb, c = lane & 7;
    f32x4 ga = {1.f, 1.f, 1.f, 1.f}, gb = ga;
    if (src.g) { ga = *(const f32x4*)(src.g + k0 + 8 * c); gb = *(const f32x4*)(src.g + k0 + 8 * c + 4); }
    float tv[32];
#pragma unroll
    for (int i = 0; i < 32; ++i) tv[i] = src(k0 + 2 * i + (lane >> 5), n0 + (lane & 31));
#pragma unroll
    for (int i = 0; i < 32; ++i) { const int kk = 2 * i + (lane >> 5); scr[kk * 33 + (lane & 31)] = tv[i]; }
    LDS_WAIT(); asm volatile("" ::: "memory");
#pragma unroll
    for (int j = 0; j < 4; ++j) { const int n = (lane >> 3) + 8 * j; const LAS float* s = scr + (8 * c) * 33 + n;
        v4u o; o.x = cvtpk(s[0 * 33] * ga.x, s[1 * 33] * ga.y); o.y = cvtpk(s[2 * 33] * ga.z, s[3 * 33] * ga.w); o.z = cvtpk(s[4 * 33] * gb.x, s[5 * 33] * gb.y); o.w = cvtpk(s[6 * 33] * gb.z, s[7 * 33] * gb.w);
        *(v4u*)(WT + (size_t)(n0 + n) * K + k0 + 8 * c) = o; }
    LDS_WAIT(); asm volatile("" ::: "memory");
}

template <int MODE>
__device__ __forceinline__ void thin_phase(const bf16* HD, const float* xin_f32, bf16* X16, float* out_f32, float* R2, const float* gpost, float cc, int gw, int NGW, int lane) {
    f32x4 gp[4];
#pragma unroll
    for (int j = 0; j < 4; ++j) gp[j] = (MODE != 0) ? *(const f32x4*)(gpost + 4 * lane + 256 * j) : (f32x4){0.f, 0.f, 0.f, 0.f};
    f32x4 xf[4]; v2u xn[4], hn[4];
    if (gw < MTOK) {
#pragma unroll
        for (int j = 0; j < 4; ++j) { if (MODE == 0) xf[j] = *(const f32x4*)(xin_f32 + (size_t)gw * DM + 4 * lane + 256 * j);
            else { xn[j] = *(const v2u*)(X16 + (size_t)gw * DM + 4 * lane + 256 * j); hn[j] = *(const v2u*)(HD + (size_t)gw * DM + 4 * lane + 256 * j); } }
    }
    for (int m = gw; m < MTOK; m += NGW) {
        f32x4 x[4]; v2u hw[4];
#pragma unroll
        for (int j = 0; j < 4; ++j) { if (MODE == 0) x[j] = xf[j]; else { x[j] = (f32x4){bflo(xn[j].x), bfhi(xn[j].x), bflo(xn[j].y), bfhi(xn[j].y)}; hw[j] = hn[j]; } }
        const int m2 = m + NGW;
        if (m2 < MTOK) {
#pragma unroll
            for (int j = 0; j < 4; ++j) { if (MODE == 0) xf[j] = *(const f32x4*)(xin_f32 + (size_t)m2 * DM + 4 * lane + 256 * j);
                else { xn[j] = *(const v2u*)(X16 + (size_t)m2 * DM + 4 * lane + 256 * j); hn[j] = *(const v2u*)(HD + (size_t)m2 * DM + 4 * lane + 256 * j); } }
        }
        if (MODE != 0) {
            f32x4 h[4]; float ss = 0.f;
#pragma unroll
            for (int j = 0; j < 4; ++j) { h[j] = (f32x4){bflo(hw[j].x), bfhi(hw[j].x), bflo(hw[j].y), bfhi(hw[j].y)}; ss += (h[j].x * h[j].x + h[j].y * h[j].y) + (h[j].z * h[j].z + h[j].w * h[j].w); }
            const float r = cc * __frsqrt_rn(wave_sum(ss, lane) * (1.f / DM) + EPS);
#pragma unroll
            for (int j = 0; j < 4; ++j) x[j] = x[j] + (h[j] * r) * gp[j];
        }
        if (MODE == 2) {
#pragma unroll
            for (int j = 0; j < 4; ++j) *(f32x4*)(out_f32 + (size_t)m * DM + 4 * lane + 256 * j) = x[j];
        } else {
            float s2 = 0.f;
#pragma unroll
            for (int j = 0; j < 4; ++j) { s2 += (x[j].x * x[j].x + x[j].y * x[j].y) + (x[j].z * x[j].z + x[j].w * x[j].w);
                v2u w; w.x = cvtpk(x[j].x, x[j].y); w.y = cvtpk(x[j].z, x[j].w); *(v2u*)(X16 + (size_t)m * DM + 4 * lane + 256 * j) = w; }
            const float st = wave_sum(s2, lane);
            if (lane == 0) *(f32x4*)(R2 + (size_t)m * 4) = (f32x4){st, 0.f, 0.f, 0.f};
        }
    }
}

struct EpiSwiglu {
    static constexpr bool PERM = true, AFTER_DRAIN = false, HAS_PRE = true; struct Pre {};
    bf16* H; const float* SS2; LAS unsigned char* lred;
    __device__ __forceinline__ void pre_load(const pg8::Unit& u, int wr, int wc, Pre&) const {
        if (wc == 0) { const float* sp = SS2 + (size_t)(u.pm * 256 + wr * 64 + fresh_lane()) * 4;
            __builtin_amdgcn_global_load_lds((const unsigned*)sp, (LAS unsigned*)(lred + wr * 2048), 16, 0, 0);
            __builtin_amdgcn_global_load_lds((const unsigned*)(sp + 128 * 4), (LAS unsigned*)(lred + wr * 2048 + 1024), 16, 0, 0); } }
    __device__ __forceinline__ void operator()(const pg8::f32x4 (&acc)[2][2][4][2], const pg8::Unit& u, int wr, int wc, int fr, int fq, const Pre& P) const {
        float rsv[2][4];
        { const int ln = fq * 16 + fr; const f32x4 p0 = *(const LAS f32x4*)(lred + wr * 2048 + ln * 16), p1 = *(const LAS f32x4*)(lred + wr * 2048 + 1024 + ln * 16);
          const float r0 = __frsqrt_rn(((p0.x + p0.y) + (p0.z + p0.w)) * (1.f / DM) + EPS), r1 = __frsqrt_rn(((p1.x + p1.y) + (p1.z + p1.w)) * (1.f / DM) + EPS);
#pragma unroll
          for (int m = 0; m < 4; ++m) { rsv[0][m] = shi(r0, m * 16 + fr); rsv[1][m] = shi(r1, m * 16 + fr); } }
#pragma unroll
        for (int ai = 0; ai < 2; ++ai)
#pragma unroll
            for (int m = 0; m < 4; ++m) {
                const int row = u.pm * 256 + ai * 128 + wr * 64 + m * 16 + fr; const float rs = rsv[ai][m];
                typedef float f2 __attribute__((ext_vector_type(2)));
                f2 tg[4], tu[4], ex[4]; float o[8]; const float c1 = rs * -1.4426950408889634f, rs2 = rs * rs;
#pragma unroll
                for (int n = 0; n < 2; ++n) { const pg8::f32x4 g4 = acc[ai][0][m][n], u4 = acc[ai][1][m][n];
                    tg[2 * n] = (f2){g4[0], g4[1]}; tg[2 * n + 1] = (f2){g4[2], g4[3]}; tu[2 * n] = (f2){u4[0], u4[1]}; tu[2 * n + 1] = (f2){u4[2], u4[3]}; }
#pragma unroll
                for (int e = 0; e < 4; ++e) { const f2 a2 = tg[e] * c1; ex[e].x = __builtin_amdgcn_exp2f(a2.x); ex[e].y = __builtin_amdgcn_exp2f(a2.y); }
#pragma unroll
                for (int e = 0; e < 4; ++e) { const f2 d2 = ex[e] + 1.0f; ex[e].x = __builtin_amdgcn_rcpf(d2.x); ex[e].y = __builtin_amdgcn_rcpf(d2.y); tu[e] = (tg[e] * tu[e]) * rs2; }
#pragma unroll
                for (int e = 0; e < 4; ++e) { const f2 r2 = tu[e] * ex[e]; o[2 * e] = r2.x; o[2 * e + 1] = r2.y; }
                v4u w; w.x = pg8::cvt_pk_bf16(o[0], o[1]); w.y = pg8::cvt_pk_bf16(o[2], o[3]); w.z = pg8::cvt_pk_bf16(o[4], o[5]); w.w = pg8::cvt_pk_bf16(o[6], o[7]);
                *(v4u*)(H + (size_t)row * FF + u.pn * 128 + wc * 32 + fq * 8) = w;
            }
    }
};
#define EPI_LBAR() do { asm volatile("s_waitcnt lgkmcnt(0)" ::: "memory"); __builtin_amdgcn_s_barrier(); } while (0)
template <bool FINAL>
struct EpiResNorm {
    static constexpr bool PERM = !FINAL, AFTER_DRAIN = false, HAS_PRE = false; struct Pre {};
    unsigned char* ws; LAS float* red; const float* gpost; float* outf; float cc; int inst;
    __device__ __forceinline__ void operator()(const pg8::f32x4 (&acc)[2][2][4][2], const pg8::Unit& u, int wr, int wc, int fr_, int fq_) const {
        int fr = fr_, fq = fq_;
        bf16* X16 = (bf16*)(ws + WS_X16);
        const int ln = fresh_lane(), wv = wr * 4 + wc, tid = wv * 64 + ln; fr = ln & 15; fq = ln >> 4;
        const int r0 = u.pm * 256 + wr * 64 + fr, c0 = u.pn * 256 + wc * 32 + fq * (FINAL ? 4 : 8);
        v4u xv[2][4][2];
        if (wv != 0) {
#pragma unroll
            for (int ai = 0; ai < 2; ++ai)
#pragma unroll
                for (int m = 0; m < 4; ++m)
#pragma unroll
                    for (int bj = 0; bj < 2; ++bj) { const bf16* xp = X16 + (size_t)(r0 + ai * 128 + m * 16) * DM + c0 + bj * 128;
                        if (FINAL) { const v2u lo2 = *(const v2u*)xp, hi2 = *(const v2u*)(xp + 16); xv[ai][m][bj] = (v4u){lo2.x, lo2.y, hi2.x, hi2.y}; } else xv[ai][m][bj] = *(const v4u*)xp; }
        }
        if (tid >= 256) red[1280 + tid - 256] = gpost[u.pn * 256 + tid - 256];
#pragma unroll
        for (int ai = 0; ai < 2; ++ai)
#pragma unroll
            for (int m = 0; m < 4; ++m) { float s = 0.f;
#pragma unroll
                for (int bj = 0; bj < 2; ++bj)
#pragma unroll
                    for (int n = 0; n < 2; ++n) { const pg8::f32x4 a = acc[ai][bj][m][n]; s += (a[0] * a[0] + a[1] * a[1]) + (a[2] * a[2] + a[3] * a[3]); }
                s += shx(s, 16, ln); s += shx(s, 32, ln);
                if (fq == 0) red[wc * 256 + ai * 128 + wr * 64 + m * 16 + fr] = s; }
        EPI_LBAR();
        if (wv == 0) {
            unsigned* ctr = (unsigned*)(ws + WS_CTL) + CW_GRP + (inst * 128 + u.pm) * 16;
            unsigned* part = (unsigned*)(ws + WS_PART) + (size_t)inst * 4 * MTOK + u.pm * 256 + 4 * ln;
            const f32x4 p0 = *(const LAS f32x4*)(red + 4 * ln), p1 = *(const LAS f32x4*)(red + 256 + 4 * ln), p2 = *(const LAS f32x4*)(red + 512 + 4 * ln), p3 = *(const LAS f32x4*)(red + 768 + 4 * ln);
            const f32x4 ps = (p0 + p1) + (p2 + p3);
            unsigned* mine = part + (size_t)u.pn * MTOK;
            asm volatile("global_store_dwordx4 %0, %1, off sc1\n\ts_waitcnt vmcnt(0)" :: "v"(mine), "v"(ps) : "memory");
            if (ln == 0) { (void)__hip_atomic_fetch_add(ctr, 1u, __ATOMIC_RELAXED, __HIP_MEMORY_SCOPE_AGENT);
                unsigned sp = 0u; while (__hip_atomic_load(ctr, __ATOMIC_RELAXED, __HIP_MEMORY_SCOPE_AGENT) < 4u) { __builtin_amdgcn_s_sleep(1); if (++sp > (1u << 22)) break; } }
            asm volatile("" ::: "memory");
            f32x4 q0, q1, q2, q3;
            asm volatile("global_load_dwordx4 %0, %4, off sc1\n\tglobal_load_dwordx4 %1, %5, off sc1\n\tglobal_load_dwordx4 %2, %6, off sc1\n\tglobal_load_dwordx4 %3, %7, off sc1\n\ts_waitcnt vmcnt(0)"
                         : "=&v"(q0), "=&v"(q1), "=&v"(q2), "=&v"(q3) : "v"(part), "v"(part + MTOK), "v"(part + 2 * (size_t)MTOK), "v"(part + 3 * (size_t)MTOK) : "memory");
            const f32x4 t = ((q0 + q1) + (q2 + q3)) * (1.f / DM) + EPS;
            *(LAS f32x4*)(red + 1024 + 4 * ln) = (f32x4){cc * __frsqrt_rn(t.x), cc * __frsqrt_rn(t.y), cc * __frsqrt_rn(t.z), cc * __frsqrt_rn(t.w)};
#pragma unroll
            for (int ai = 0; ai < 2; ++ai)
#pragma unroll
                for (int m = 0; m < 4; ++m)
#pragma unroll
                    for (int bj = 0; bj < 2; ++bj) { const bf16* xp = X16 + (size_t)(r0 + ai * 128 + m * 16) * DM + c0 + bj * 128;
                        if (FINAL) { const v2u lo2 = *(const v2u*)xp, hi2 = *(const v2u*)(xp + 16); xv[ai][m][bj] = (v4u){lo2.x, lo2.y, hi2.x, hi2.y}; } else xv[ai][m][bj] = *(const v4u*)xp; }
        }
        EPI_LBAR();
#pragma unroll
        for (int ai = 0; ai < 2; ++ai)
#pragma unroll
            for (int m = 0; m < 4; ++m) { const float inv = red[1024 + ai * 128 + wr * 64 + m * 16 + fr]; float s = 0.f; const size_t rowo = (size_t)(r0 + ai * 128 + m * 16) * DM + c0;
                asm volatile("" ::: "memory");
#pragma unroll
                for (int bj = 0; bj < 2; ++bj) { const v4u xw = xv[ai][m][bj]; const LAS float* gl = red + 1280 + bj * 128 + wc * 32 + fq * (FINAL ? 4 : 8); const f32x4 gv0 = *(const LAS f32x4*)gl, gv1 = *(const LAS f32x4*)(gl + (FINAL ? 16 : 4));
                    f32x4 x0 = (f32x4){bflo(xw.x), bfhi(xw.x), bflo(xw.y), bfhi(xw.y)}, x1 = (f32x4){bflo(xw.z), bfhi(xw.z), bflo(xw.w), bfhi(xw.w)};
                    x0 = x0 + (acc[ai][bj][m][0] * inv) * gv0; x1 = x1 + (acc[ai][bj][m][1] * inv) * gv1;
                    if (FINAL) { float* op = outf + rowo + bj * 128; *(f32x4*)op = x0; *(f32x4*)(op + 16) = x1; }
                    else { s += ((x0.x * x0.x + x0.y * x0.y) + (x0.z * x0.z + x0.w * x0.w)) + ((x1.x * x1.x + x1.y * x1.y) + (x1.z * x1.z + x1.w * x1.w));
                        v4u w; w.x = pg8::cvt_pk_bf16(x0.x, x0.y); w.y = pg8::cvt_pk_bf16(x0.z, x0.w); w.z = pg8::cvt_pk_bf16(x1.x, x1.y); w.w = pg8::cvt_pk_bf16(x1.z, x1.w);
                        *(v4u*)(X16 + rowo + bj * 128) = w; } }
                if (!FINAL) { s += shx(s, 16, ln); s += shx(s, 32, ln); if (fq == 0) red[wc * 256 + ai * 128 + wr * 64 + m * 16 + fr] = s; } }
        if (!FINAL) {
            EPI_LBAR();
            if (tid < 256) ((float*)(ws + WS_TAB + TAB_SS2))[(size_t)(u.pm * 256 + tid) * 4 + u.pn] = (red[tid] + red[256 + tid]) + (red[512 + tid] + red[768 + tid]);
        }
    }
};
struct EpiCmpMlp {
    static constexpr bool PERM = true, AFTER_DRAIN = true, HAS_PRE = false; struct Pre {};
    unsigned char* ws; const float* b1; const bf16* w2t;
    __device__ __forceinline__ void operator()(const pg8::f32x4 (&)[2][2][4][2], const pg8::Unit&, int, int, int, int) const {}
    __device__ __forceinline__ void fused(const pg8::f32x4 (&acc)[2][2][4][2], const pg8::Unit& u, int wr, int wc, int fr_, int fq_, LAS unsigned char* lds, int wid, int lane_) const {
        (void)fr_; (void)fq_; (void)lane_;
        const int ln = fresh_lane(), fr = ln & 15, fq = ln >> 4, kv = u.pm >> 4;
        pg8::bf16x8 xf[4][4];
        { const bf16* wp = w2t + (size_t)kv * 64 * 128 + fr * 128 + fq * 8;
#pragma unroll
          for (int ib = 0; ib < 4; ++ib)
#pragma unroll
              for (int ks = 0; ks < 4; ++ks) xf[ib][ks] = *(const pg8::bf16x8*)(wp + ib * 16 * 128 + ks * 32); }
        f32x4 bb[2];
#pragma unroll
        for (int n = 0; n < 2; ++n) bb[n] = *(const f32x4*)(b1 + kv * 128 + wc * 32 + fq * 8 + 4 * n);
#pragma unroll
        for (int ai = 0; ai < 2; ++ai)
#pragma unroll
            for (int m = 0; m < 4; ++m) { const int row = ai * 128 + wr * 64 + m * 16 + fr;
#pragma unroll
                for (int n = 0; n < 2; ++n) *(LAS f32x4*)(lds + row * 512 + (((wc * 8 + fq * 2 + n) ^ (row & 15)) << 4)) = acc[ai][1][m][n]; }
        EPI_LBAR();
        v4u hv[2][4];
#pragma unroll
        for (int ai = 0; ai < 2; ++ai)
#pragma unroll
            for (int m = 0; m < 4; ++m) { const int row = ai * 128 + wr * 64 + m * 16 + fr, rn = (row < 255) ? row + 1 : 255; float h[8];
#pragma unroll
                for (int n = 0; n < 2; ++n) { const f32x4 q = *(const LAS f32x4*)(lds + rn * 512 + (((wc * 8 + fq * 2 + n) ^ (rn & 15)) << 4)); const f32x4 v = acc[ai][0][m][n] + q + bb[n];
#pragma unroll
                    for (int e = 0; e < 4; ++e) { const float x = v[e], t = x * (1.f + 0.044715f * x * x) * (-2.f * 0.7978845608028654f * 1.4426950408889634f);
                        h[4 * n + e] = ((row & 127) == 127) ? 0.f : x * __builtin_amdgcn_rcpf(1.f + __builtin_amdgcn_exp2f(t)); } }
                hv[ai][m] = (v4u){cvtpk(h[0], h[1]), cvtpk(h[2], h[3]), cvtpk(h[4], h[5]), cvtpk(h[6], h[7])}; }
        EPI_LBAR();
#pragma unroll
        for (int ai = 0; ai < 2; ++ai)
#pragma unroll
            for (int m = 0; m < 4; ++m) { const int row = ai * 128 + wr * 64 + m * 16 + fr; *(LAS v4u*)(lds + row * 256 + (((wc * 4 + fq) ^ (row & 15)) << 4)) = hv[ai][m]; }
        EPI_LBAR();
        bf16* CC = (bf16*)(ws + WS_CC);
#pragma unroll
        for (int jj = 0; jj < 2; ++jj) { const int row = (2 * wid + jj) * 16 + fr; pg8::f32x4 o[4];
#pragma unroll
            for (int ib = 0; ib < 4; ++ib) o[ib] = (pg8::f32x4){0.f, 0.f, 0.f, 0.f};
#pragma unroll
            for (int ks = 0; ks < 4; ++ks) { const pg8::bf16x8 y = *(const LAS pg8::bf16x8*)(lds + row * 256 + (((ks * 4 + fq) ^ (row & 15)) << 4));
#pragma unroll
                for (int ib = 0; ib < 4; ++ib) o[ib] = __builtin_amdgcn_mfma_f32_16x16x32_bf16(xf[ib][ks], y, o[ib], 0, 0, 0); }
            bf16* cp = CC + ((size_t)u.pm * 256 + row) * 64 + 4 * fq;
#pragma unroll
            for (int ib = 0; ib < 4; ++ib) { v2u w; w.x = cvtpk(o[ib][0], o[ib][1]); w.y = cvtpk(o[ib][2], o[ib][3]); *(v2u*)(cp + ib * 16) = w; } }
    }
};
struct CmpOrder {
    int c, G;
    __device__ __forceinline__ bool next(int i, pg8::Unit& u) const { const int idx = i * G + c; if (idx >= 32) return false; u.pm = idx; u.pn = idx >> 4; return true; }
    __device__ __forceinline__ void a_ready(const pg8::Unit&) const {}
    __device__ __forceinline__ void done(const pg8::Unit&) const {}
};
struct EpiInProj {
    static constexpr bool PERM = true, AFTER_DRAIN = false, HAS_PRE = true; struct Pre {};
    unsigned char* ws; LAS unsigned char* lred;
    __device__ __forceinline__ void pre_load(const pg8::Unit& u, int wr, int wc, Pre&) const {
        if (wc == 0) { const float* sp = (const float*)(ws + WS_TAB + TAB_SS2) + (size_t)(u.pm * 256 + wr * 64 + fresh_lane()) * 4;
            __builtin_amdgcn_global_load_lds((const unsigned*)sp, (LAS unsigned*)(lred + wr * 2048), 16, 0, 0);
            __builtin_amdgcn_global_load_lds((const unsigned*)(sp + 128 * 4), (LAS unsigned*)(lred + wr * 2048 + 1024), 16, 0, 0); } }
    __device__ __forceinline__ void operator()(const pg8::f32x4 (&acc)[2][2][4][2], const pg8::Unit& u, int wr, int wc, int fr, int fq, const Pre&) const {
        const int pn = u.pn;
        const bool ropet = (pn < 2) || (pn == 3) || (pn == 4);
        const bool ropew = ropet && ((wc & 1) == 0);
        float rsv[2][4];
#pragma unroll
        for (int ai = 0; ai < 2; ++ai)
#pragma unroll
            for (int m = 0; m < 4; ++m) { const f32x4 p = *(const LAS f32x4*)(lred + wr * 2048 + ai * 1024 + (m * 16 + fr) * 16); rsv[ai][m] = __frsqrt_rn(((p.x + p.y) + (p.z + p.w)) * (1.f / DM) + EPS); }
#pragma unroll
        for (int ai = 0; ai < 2; ++ai)
#pragma unroll
            for (int m = 0; m < 4; ++m) {
                const int row = u.pm * 256 + ai * 128 + wr * 64 + m * 16 + fr;
                const int b = row >> 11, t = row & 2047; const float rs = rsv[ai][m];
                f32x4 c0, c1, s0, s1;
                if (ropew) {
                    const float tf = (float)t; float cs_[8], sn_[8];
                    const float ifr[8] = {1.5915494309e-01f, 3.0863763405e-02f, 5.9851857127e-03f, 1.1606636412e-03f, 2.2507907904e-04f, 4.3647952793e-05f, 8.4643308082e-06f, 1.6414262628e-06f};
#pragma unroll
                    for (int e = 0; e < 8; ++e) { const float rv = __builtin_amdgcn_fractf(tf * ifr[e]); cs_[e] = __builtin_amdgcn_cosf(rv); sn_[e] = __builtin_amdgcn_sinf(rv); }
                    c0 = (f32x4){cs_[0], cs_[1], cs_[2], cs_[3]}; c1 = (f32x4){cs_[4], cs_[5], cs_[6], cs_[7]}; s0 = (f32x4){sn_[0], sn_[1], sn_[2], sn_[3]}; s1 = (f32x4){sn_[4], sn_[5], sn_[6], sn_[7]}; }
#pragma unroll
                for (int bj = 0; bj < 2; ++bj) {
                    f32x4 v0 = acc[ai][bj][m][0] * rs, v1 = acc[ai][bj][m][1] * rs;
                    const int cl = bj * 128 + wc * 32 + fq * 8;
                    if (ropew && (pn < 2 || bj == 0)) {
                        f32x4 p0, p1; const int ln = fq * 16 + fr;
                        p0.x = shx(v0.x, 16, ln); p0.y = shx(v0.y, 16, ln); p0.z = shx(v0.z, 16, ln); p0.w = shx(v0.w, 16, ln);
                        p1.x = shx(v1.x, 16, ln); p1.y = shx(v1.y, 16, ln); p1.z = shx(v1.z, 16, ln); p1.w = shx(v1.w, 16, ln);
                        const float sg = (fq == 0) ? -1.f : 1.f;
                        if (fq < 2) { v0 = v0 * c0 + (p0 * s0) * sg; v1 = v1 * c1 + (p1 * s1) * sg; }
                    }
                    if (pn < 2) { v0 = v0 * 0.18033688011112042f; v1 = v1 * 0.18033688011112042f; }
                    if (pn == 13) { if (cl < 32) { float* p = (float*)(ws + WS_GATE) + (size_t)row * 32 + cl; *(f32x4*)p = v0; *(f32x4*)(p + 4) = v1; } }
                    else {
                        size_t off;
                        if (pn < 2) off = WS_QN + ((size_t)row * 512 + pn * 256 + cl) * 2;
                        else if (pn < 5) { const int g = wc >> 1, d = (wc & 1) * 32 + fq * 8; off = WS_KCR + (size_t)((pn - 2) * 2 + bj) * (8 * MiB) + (((size_t)(b * 2 + g) * SEQ + t) * 64 + d) * 2; }
                        else { const int q = pn - 5; off = WS_MQ + (size_t)(q >> 1) * (32 * MiB) + ((size_t)row * 512 + (q & 1) * 256 + cl) * 2; }
                        v4u w; w.x = pg8::cvt_pk_bf16(v0.x, v0.y); w.y = pg8::cvt_pk_bf16(v0.z, v0.w); w.z = pg8::cvt_pk_bf16(v1.x, v1.y); w.w = pg8::cvt_pk_bf16(v1.z, v1.w);
                        *(v4u*)(ws + off) = w;
                    }
                }
            }
    }
};
static_assert(WS_VCR == WS_KCR + 8 * MiB && WS_KS == WS_KCR + 16 * MiB && WS_VS == WS_KCR + 24 * MiB && WS_KW == WS_KCR + 32 * MiB && WS_VW == WS_KCR + 40 * MiB, "kv buffers are 8 MiB apart in (pn, bj) order");
static_assert(WS_MK == WS_MQ + 32 * MiB && WS_MV == WS_MQ + 64 * MiB && WS_MO == WS_MQ + 96 * MiB, "mLSTM buffers are 32 MiB apart");

struct MixPtrs { unsigned char* ws; const float *conv_w, *conv_b, *i_bias, *f_bias, *mnorm_g; };
#define MP_QN ((const bf16*)(P.ws + WS_QN))
#define MP_KS ((const bf16*)(P.ws + WS_KS))
#define MP_VS ((const bf16*)(P.ws + WS_VS))
#define MP_KW ((const bf16*)(P.ws + WS_KW))
#define MP_VW ((const bf16*)(P.ws + WS_VW))
#define MP_KC ((const bf16*)(P.ws + WS_CC))
#define MP_VC ((const bf16*)(P.ws + WS_CC) + (size_t)4096 * 64)
#define MP_MQ ((const bf16*)(P.ws + WS_MQ))
#define MP_MK ((const bf16*)(P.ws + WS_MK))
#define MP_MV ((const bf16*)(P.ws + WS_MV))
#define MP_MO ((const bf16*)(P.ws + WS_MO))
#define MP_GATE ((const float*)(P.ws + WS_GATE))
#define MP_Y ((bf16*)(P.ws + WS_U))


typedef float f32x16 __attribute__((ext_vector_type(16)));
typedef short bf16x8v __attribute__((ext_vector_type(8)));
typedef short s16x4v __attribute__((ext_vector_type(4)));
typedef float f32x2v __attribute__((ext_vector_type(2)));
typedef __bf16 bf16x2v __attribute__((ext_vector_type(2)));
#define MFMA32(a, b, c) __builtin_amdgcn_mfma_f32_32x32x16_bf16((a), (b), (c), 0, 0, 0)
__device__ __forceinline__ s16x4v tr_read(const LAS unsigned char* p) { return __builtin_bit_cast(s16x4v, __builtin_amdgcn_ds_read_tr16_b64_v4i16((LAS s16x4v*)p)); }
__device__ __forceinline__ int tile_off(int key, int ch8) { return (ch8 >> 2) * 4096 + key * 64 + (((ch8 & 3) ^ ((key >> 2) & 3)) << 4); }
constexpr int NM_SLOT = 0, NM_IMP = 65536, NM_IMS = 99328, NM_SEL = 108544, NM_ITEM = 108864;
constexpr float QK_SCALE = 0.125f * 1.4426950408889634f;

#define SBAR() __builtin_amdgcn_sched_barrier(0)
__device__ __forceinline__ void xor32_pair(float v, float& lo, float& hi) { float a = v, b = v; asm volatile("s_nop 1\n\tv_permlane32_swap_b32 %0, %1" : "+v"(a), "+v"(b)); lo = a; hi = b; }
__device__ __forceinline__ float xor32_max(float v) { float lo, hi; xor32_pair(v, lo, hi); float r; asm("v_max_f32 %0, %1, %2" : "=v"(r) : "v"(lo), "v"(hi)); return r; }
__device__ __forceinline__ float xor32_sum(float v) { float lo, hi; xor32_pair(v, lo, hi); return lo + hi; }
__device__ __forceinline__ float max2f(float a, float b) { float r; asm("v_max_f32 %0, %1, %2" : "=v"(r) : "v"(a), "v"(b)); return r; }
__device__ __forceinline__ float max3f(float a, float b, float c) { float r; asm("v_max3_f32 %0, %1, %2, %3" : "=v"(r) : "v"(a), "v"(b), "v"(c)); return r; }
#define LBAR() asm volatile("s_waitcnt lgkmcnt(0)\n\ts_barrier" ::: "memory")
__device__ __forceinline__ void k_load(const LAS unsigned char* Ks, int r, int h, bf16x8v (&kf)[8]) {
    const int sw = (r >> 2) & 3;
#pragma unroll
    for (int ks = 0; ks < 4; ++ks) { const int off = (ks >> 1) * 4096 + r * 64 + (((((ks & 1) << 1) + h) ^ sw) << 4);
        kf[2 * ks] = *(const LAS bf16x8v*)(Ks + off); kf[2 * ks + 1] = *(const LAS bf16x8v*)(Ks + off + 2048); }
}
__device__ __forceinline__ void qk_mma(const bf16x8v (&kf)[8], const bf16x8v (&qf)[4], f32x16& p0, f32x16& p1) {
    const f32x16 z = {0.f, 0.f, 0.f, 0.f, 0.f, 0.f, 0.f, 0.f, 0.f, 0.f, 0.f, 0.f, 0.f, 0.f, 0.f, 0.f};
#pragma unroll
    for (int ks = 0; ks < 4; ++ks) { p0 = MFMA32(kf[2 * ks], qf[ks], ks ? p0 : z); p1 = MFMA32(kf[2 * ks + 1], qf[ks], ks ? p1 : z); }
}
__device__ __forceinline__ void v_load(const LAS unsigned char* Vs, int lane, bf16x8v (&vf)[8]) {
    const int h = lane >> 5, i16 = lane & 15, q = i16 >> 2, p = i16 & 3, gi = (lane >> 4) & 1;
    const int cidx = 2 * gi + (p >> 1), e8 = (p & 1) << 3;
    const int offlo = q * 64 + ((cidx ^ h) << 4) + e8 + h * 256, offhi = q * 64 + ((cidx ^ (h | 2)) << 4) + e8 + h * 256 + 512;
#pragma unroll
    for (int kb = 0; kb < 2; ++kb)
#pragma unroll
        for (int s = 0; s < 2; ++s)
#pragma unroll
            for (int db = 0; db < 2; ++db) { const LAS unsigned char* base = Vs + db * 4096 + (kb * 32 + s * 16) * 64;
                const s16x4v lo = tr_read(base + offlo), hi = tr_read(base + offhi);
                vf[(kb * 2 + s) * 2 + db] = __builtin_shufflevector(lo, hi, 0, 1, 2, 3, 4, 5, 6, 7); }
}
__device__ __forceinline__ void pv_mma(const bf16x8v (&vf)[8], const f32x16& p0, const f32x16& p1, f32x16 (&o)[2]) {
#pragma unroll
    for (int kb = 0; kb < 2; ++kb)
#pragma unroll
        for (int s = 0; s < 2; ++s) {
            const f32x16& P = kb ? p1 : p0;
            v4u pw; pw.x = cvtpk(P[8 * s + 0], P[8 * s + 1]); pw.y = cvtpk(P[8 * s + 2], P[8 * s + 3]); pw.z = cvtpk(P[8 * s + 4], P[8 * s + 5]); pw.w = cvtpk(P[8 * s + 6], P[8 * s + 7]);
            const bf16x8v pf = __builtin_bit_cast(bf16x8v, pw);
            o[0] = MFMA32(vf[(kb * 2 + s) * 2], pf, o[0]); o[1] = MFMA32(vf[(kb * 2 + s) * 2 + 1], pf, o[1]);
        }
}

__device__ __forceinline__ void nsa_unit_mfma(LAS unsigned char* L, const MixPtrs& P, int b, int g, int c, int tid_in) {
    int tid_l = tid_in; asm volatile("" : "+v"(tid_l));
    const int tid = tid_l, lane = tid & 63, w = __builtin_amdgcn_readfirstlane(tid >> 6);
    const int r = lane & 31, h = lane >> 5, head = w >> 1, qi = (w & 1) * 32 + r, t = c * 64 + qi;
    const size_t row = (size_t)b * SEQ + t;
    LAS unsigned* SEL = (LAS unsigned*)(L + NM_SEL); LAS int* ITEM = (LAS int*)(L + NM_ITEM);
    const size_t kvbase = (size_t)(b * 2 + g) * SEQ * 64, ccbase = (size_t)(b * 2 + g) * 128 * 64;
    const int skey = tid >> 3, sch = tid & 7, soff = tile_off(skey, sch);
    bf16x8v qf[4];
    { const bf16* qp = MP_QN + row * 512 + (g * 4 + head) * 64 + 8 * h;
#pragma unroll
      for (int ks = 0; ks < 4; ++ks) qf[ks] = *(const bf16x8v*)(qp + 16 * ks); }
    const float* gp = MP_GATE + row * 32 + g * 4 + head;
    float one = 1.f; asm volatile("" : "+v"(one));
    const float gate_c = __builtin_amdgcn_rcpf(one + __expf(-gp[0])), gate_s = __builtin_amdgcn_rcpf(one + __expf(-gp[8])), gate_w = __builtin_amdgcn_rcpf(one + __expf(-gp[16]));
    f32x16 oacc[2];
    {
        const bf16* kc = MP_KC + ccbase; const bf16* vc = MP_VC + ccbase;
        const v4u k0 = *(const v4u*)(kc + tid * 8), k1 = *(const v4u*)(kc + 4096 + tid * 8), v0 = *(const v4u*)(vc + tid * 8), v1 = *(const v4u*)(vc + 4096 + tid * 8);
        LBAR();
        *(LAS v4u*)(L + NM_SLOT + soff) = k0; *(LAS v4u*)(L + NM_SLOT + 8192 + soff) = v0; *(LAS v4u*)(L + NM_SLOT + 16384 + soff) = k1; *(LAS v4u*)(L + NM_SLOT + 24576 + soff) = v1;
        if (tid < 64) SEL[tid] = 0u;
        LBAR();
        f32x16 s0, s1, s2, s3;
        { bf16x8v kfa[8], kfb[8]; k_load(L + NM_SLOT, r, h, kfa); k_load(L + NM_SLOT + 16384, r, h, kfb); SBAR(); qk_mma(kfa, qf, s0, s1); qk_mma(kfb, qf, s2, s3); }
        const int nlim = (t >= 31) ? (((t - 31) >> 4) < 126 ? ((t - 31) >> 4) : 126) : -1;
        float mx, mxv[4] = {-1e20f, -1e20f, -1e20f, -1e20f};
#pragma unroll
        for (int e = 0; e < 16; ++e) { const int cr = (e & 3) + 8 * (e >> 2) + 4 * h;
            s0[e] = (cr <= nlim) ? s0[e] * QK_SCALE : -1e30f; s1[e] = (cr + 32 <= nlim) ? s1[e] * QK_SCALE : -1e30f;
            s2[e] = (cr + 64 <= nlim) ? s2[e] * QK_SCALE : -1e30f; s3[e] = (cr + 96 <= nlim) ? s3[e] * QK_SCALE : -1e30f;
            mxv[e & 3] = fmaxf(fmaxf(mxv[e & 3], fmaxf(s0[e], s1[e])), fmaxf(s2[e], s3[e])); }
        mx = fmaxf(fmaxf(mxv[0], mxv[1]), fmaxf(mxv[2], mxv[3]));
        mx = xor32_max(mx);
        float ls, lsv[4] = {0.f, 0.f, 0.f, 0.f};
#pragma unroll
        for (int e = 0; e < 16; ++e) { s0[e] = __builtin_amdgcn_exp2f(s0[e] - mx); s1[e] = __builtin_amdgcn_exp2f(s1[e] - mx); s2[e] = __builtin_amdgcn_exp2f(s2[e] - mx); s3[e] = __builtin_amdgcn_exp2f(s3[e] - mx);
            lsv[e & 3] += (s0[e] + s1[e]) + (s2[e] + s3[e]); }
        ls = (lsv[0] + lsv[1]) + (lsv[2] + lsv[3]);
        ls = xor32_sum(ls);
        const float il = (ls > 0.f) ? __builtin_amdgcn_rcpf(ls) : 0.f;
#pragma unroll
        for (int e = 0; e < 16; ++e) { s0[e] *= il; s1[e] *= il; s2[e] *= il; s3[e] *= il; }
        { LAS float* IMP = (LAS float*)(L + NM_IMP) + (w * 32 + r) * 33; float plprev = 0.f;
#pragma unroll
          for (int x = 0; x < 16; ++x) {
              const f32x16& S = (x < 4) ? s0 : ((x < 8) ? s1 : ((x < 12) ? s2 : s3)); const int g4 = (x & 3) * 4;
              const float own = (S[g4] + S[g4 + 1]) + (S[g4 + 2] + S[g4 + 3]);
              const float pl = shx(S[g4 + 3], 32, lane);
              if (h == 1) IMP[2 * x + 1] = own + pl; else IMP[2 * x] = own + plprev;
              plprev = pl;
          }
        }
        oacc[0] = (f32x16){0.f, 0.f, 0.f, 0.f, 0.f, 0.f, 0.f, 0.f, 0.f, 0.f, 0.f, 0.f, 0.f, 0.f, 0.f, 0.f}; oacc[1] = oacc[0];
        { bf16x8v vfa[8], vfb[8]; v_load(L + NM_SLOT + 8192, lane, vfa); v_load(L + NM_SLOT + 24576, lane, vfb); SBAR(); pv_mma(vfa, s0, s1, oacc); pv_mma(vfb, s2, s3, oacc); }
#pragma unroll
        for (int e = 0; e < 16; ++e) { oacc[0][e] *= gate_c; oacc[1][e] *= gate_c; }
    }
    LBAR();
    { const int i = tid & 63, jg = tid >> 6; const LAS float* I8 = (const LAS float*)(L + NM_IMP); LAS float* IMS = (LAS float*)(L + NM_IMS);
#pragma unroll
      for (int jj = 0; jj < 4; ++jj) { const int j = 4 * jg + jj; const int wq = (i >> 5), rq = i & 31;
          IMS[i * 36 + j] = (I8[((0 + wq) * 32 + rq) * 33 + j] + I8[((2 + wq) * 32 + rq) * 33 + j]) + (I8[((4 + wq) * 32 + rq) * 33 + j] + I8[((6 + wq) * 32 + rq) * 33 + j]); }
      LBAR();
      unsigned bits = 0u;
      if (c + 1 <= 16) { if (jg == 0) bits = (1u << (c + 1)) - 1u; }
      else { if (jg == 0) bits = 1u | (1u << c) | (1u << (c - 1));
          { float iv[32];
#pragma unroll
            for (int q8 = 0; q8 < 8; ++q8) { const f32x4 x = *(const LAS f32x4*)(IMS + i * 36 + 4 * q8); iv[4 * q8] = x.x; iv[4 * q8 + 1] = x.y; iv[4 * q8 + 2] = x.z; iv[4 * q8 + 3] = x.w; }
#pragma unroll
            for (int jj = 0; jj < 4; ++jj) { const int j = 4 * jg + jj; const float vj = IMS[i * 36 + j]; int rank = 0;
#pragma unroll
                for (int i2 = 1; i2 < 30; ++i2) rank += (i2 <= c - 2 && (iv[i2] > vj || (iv[i2] == vj && i2 < j))) ? 1 : 0;
                if (j >= 1 && j <= c - 2 && rank < 13) bits |= 1u << j; } } }
      if (bits) atomicOr((unsigned*)&SEL[i], bits);
      LBAR();
      if (w == 0) { unsigned so = SEL[lane];
#pragma unroll
          for (int o2 = 32; o2; o2 >>= 1) so |= shxu(so, o2, lane);
          if (lane == 0) { int n = 0; for (int j = 0; j <= c; ++j) if ((so >> j) & 1u) ITEM[n++] = j; const int j0 = (c - 8 > 0) ? c - 8 : 0; for (int j = j0; j <= c; ++j) ITEM[n++] = 64 + j; ITEM[n] = -1; ITEM[47] = n; } }
      LBAR();
    }
    const unsigned mysel = SEL[qi]; const int nitem = ITEM[47];
    f32x16 o[2]; float m = -1e20f, lsum = 0.f; int prev_kind = 0;
    o[0] = (f32x16){0.f, 0.f, 0.f, 0.f, 0.f, 0.f, 0.f, 0.f, 0.f, 0.f, 0.f, 0.f, 0.f, 0.f, 0.f, 0.f}; o[1] = o[0];
    const int npair = (nitem + 1) >> 1;
    v4u rk0, rv0, rk1, rv1;
#define NSA_LOAD_PAIR(ip_) do { const int ia_ = ITEM[2 * (ip_)], ib_ = ITEM[2 * (ip_) + 1]; \
        { const bf16* kp = ((ia_ & 64) ? MP_KW : MP_KS) + kvbase + (size_t)(ia_ & 63) * 4096; const bf16* vp = ((ia_ & 64) ? MP_VW : MP_VS) + kvbase + (size_t)(ia_ & 63) * 4096; rk0 = *(const v4u*)(kp + tid * 8); rv0 = *(const v4u*)(vp + tid * 8); } \
        if (ib_ >= 0) { const bf16* kp = ((ib_ & 64) ? MP_KW : MP_KS) + kvbase + (size_t)(ib_ & 63) * 4096; const bf16* vp = ((ib_ & 64) ? MP_VW : MP_VS) + kvbase + (size_t)(ib_ & 63) * 4096; rk1 = *(const v4u*)(kp + tid * 8); rv1 = *(const v4u*)(vp + tid * 8); } } while (0)
#define NSA_WRITE_PAIR(sb_) do { *(LAS v4u*)(L + (sb_) + soff) = rk0; *(LAS v4u*)(L + (sb_) + 8192 + soff) = rv0; *(LAS v4u*)(L + (sb_) + 16384 + soff) = rk1; *(LAS v4u*)(L + (sb_) + 24576 + soff) = rv1; } while (0)
    rk1 = (v4u){0u, 0u, 0u, 0u}; rv1 = rk1;
    NSA_LOAD_PAIR(0);
    NSA_WRITE_PAIR(NM_SLOT + 32768);
    LBAR();
#pragma unroll 1
    for (int ip = 0; ip < npair; ++ip) {
        if (ip + 1 < npair) NSA_LOAD_PAIR(ip + 1);
        const int sbase = NM_SLOT + ((ip + 1) & 1) * 32768;
#pragma unroll 1
        for (int half = 0; half < 2; ++half) {
            const int item = ITEM[2 * ip + half];
            if (item < 0) break;
            const int kind = item >> 6, j = item & 63;
            if (kind != prev_kind) {
                const float tot = xor32_sum(lsum); const float sc = gate_s * __builtin_amdgcn_rcpf(tot);
#pragma unroll
                for (int e = 0; e < 16; ++e) { oacc[0][e] += o[0][e] * sc; oacc[1][e] += o[1][e] * sc; o[0][e] = 0.f; o[1][e] = 0.f; }
                m = -1e20f; lsum = 0.f; prev_kind = kind;
            }
            int klo, khi;
            if (kind == 0) { klo = 0; khi = ((mysel >> j) & 1u) ? ((j < c) ? 63 : qi) : -1; }
            else { klo = t - 511 - 64 * j; khi = t - 64 * j; if (khi > 63) khi = 63; if (klo < 0) klo = 0; }
            const LAS unsigned char* slot = L + sbase + half * 16384;
            if (__any(khi >= klo)) {
                f32x16 p0, p1; bf16x8v vf[8];
                { bf16x8v kf[8]; k_load(slot, r, h, kf); SBAR(); qk_mma(kf, qf, p0, p1); }
                v_load(slot + 8192, lane, vf); SBAR();
                if (!__all(klo == 0 && khi == 63)) {
                    const int a = klo - 4 * h, z = khi - 4 * h;
#pragma unroll
                    for (int e = 0; e < 16; ++e) { const int cr = (e & 3) + 8 * (e >> 2);
                        p0[e] = (cr >= a && cr <= z) ? p0[e] : -1e30f; p1[e] = (cr + 32 >= a && cr + 32 <= z) ? p1[e] : -1e30f; }
                }
                float tm;
                { float ma = max2f(p0[0], p1[0]), mb = max2f(p0[1], p1[1]), mc2 = max2f(p0[2], p1[2]), md = max2f(p0[3], p1[3]);
#pragma unroll
                  for (int e = 4; e < 16; e += 4) { ma = max3f(ma, p0[e], p1[e]); mb = max3f(mb, p0[e + 1], p1[e + 1]); mc2 = max3f(mc2, p0[e + 2], p1[e + 2]); md = max3f(md, p0[e + 3], p1[e + 3]); }
                  tm = max3f(ma, mb, max2f(mc2, md)); }
                tm = xor32_max(tm);
                const float mn = fmaxf(m, tm * QK_SCALE);
                if (!__all(mn == m)) { const float corr = __builtin_amdgcn_exp2f(m - mn); lsum *= corr;
#pragma unroll
                    for (int e = 0; e < 16; ++e) { o[0][e] *= corr; o[1][e] *= corr; }
                    m = mn; }
                { const f32x2v sc2 = {QK_SCALE, QK_SCALE}, mm2 = {m, m}; f32x2v ta = {0.f, 0.f}, tb = {0.f, 0.f};
#pragma unroll
                  for (int e = 0; e < 16; e += 2) { const f32x2v a0 = (f32x2v){p0[e], p0[e + 1]} * sc2 - mm2, a1 = (f32x2v){p1[e], p1[e + 1]} * sc2 - mm2; p0[e] = a0.x; p0[e + 1] = a0.y; p1[e] = a1.x; p1[e + 1] = a1.y; }
#pragma unroll
                  for (int e = 0; e < 16; ++e) { p0[e] = __builtin_amdgcn_exp2f(p0[e]); p1[e] = __builtin_amdgcn_exp2f(p1[e]); }
#pragma unroll
                  for (int e = 0; e < 16; e += 2) { ta += (f32x2v){p0[e], p0[e + 1]}; tb += (f32x2v){p1[e], p1[e + 1]}; }
                  lsum += (ta.x + ta.y) + (tb.x + tb.y); }
                SBAR(); pv_mma(vf, p0, p1, o);
            }
        }
        if (ip + 1 < npair) NSA_WRITE_PAIR(NM_SLOT + (ip & 1) * 32768);
        LBAR();
    }
#undef NSA_LOAD_PAIR
#undef NSA_WRITE_PAIR
    { const float tot = xor32_sum(lsum); const float sc = gate_w * __builtin_amdgcn_rcpf(tot);
#pragma unroll
      for (int e = 0; e < 16; ++e) { oacc[0][e] += o[0][e] * sc; oacc[1][e] += o[1][e] * sc; } }
    { bf16* yp = MP_Y + row * DM + (g * 4 + head) * 64 + 4 * h;
#pragma unroll
      for (int db = 0; db < 2; ++db)
#pragma unroll
          for (int g4 = 0; g4 < 4; ++g4) { v2u wv; wv.x = cvtpk(oacc[db][4 * g4], oacc[db][4 * g4 + 1]); wv.y = cvtpk(oacc[db][4 * g4 + 2], oacc[db][4 * g4 + 3]); *(v2u*)(yp + db * 32 + g4 * 8) = wv; } }
}

namespace ns3 {
using f32x16 = __attribute__((ext_vector_type(16))) float;
using bf16x8 = __attribute__((ext_vector_type(8))) short;
using s16x4 = __attribute__((ext_vector_type(4))) short;
using u32x4 = __attribute__((ext_vector_type(4))) unsigned;
typedef short v4i16_t __attribute__((ext_vector_type(4)));
typedef LAS const char* lds_cptr;
constexpr int NSLOT = 3, SLOTB = 8192;
constexpr int A_K = 0, A_V = NSLOT * SLOTB, A_WS = 2 * NSLOT * SLOTB, A_OST = A_WS + 8 * 64 * 4, A_END = A_OST + 8 * 8192;
constexpr int A_IMP = A_OST, A_IMS = A_OST + 33792, A_SEL = A_END, A_TTS = A_END + 512, A_TTW = A_TTS + 256;
#define SBAR3() __builtin_amdgcn_sched_barrier(0)
#define WAIT_BAR3(N) asm volatile("s_waitcnt vmcnt(" #N ") lgkmcnt(0)\n\ts_barrier":::"memory")
__device__ __forceinline__ int crow(int r, int hi) { return (r & 3) + 8 * (r >> 2) + 4 * hi; }
__device__ __forceinline__ void glds16(const void* gsrc, unsigned lds_dst) { unsigned keep;
  asm volatile("s_mov_b32 %0, m0\n\ts_mov_b32 m0, %2\n\ts_nop 0\n\tglobal_load_lds_dwordx4 %1, off\n\ts_mov_b32 m0, %0" : "=&s"(keep) : "v"(gsrc), "s"(lds_dst) : "memory"); }
__device__ __forceinline__ float fadd_s(float a, float b) { float r; asm("v_add_f32_e32 %0, %1, %2" : "=v"(r) : "v"(a), "v"(b)); return r; }
__device__ __forceinline__ float fsub_s(float a, float b) { float r; asm("v_sub_f32_e32 %0, %1, %2" : "=v"(r) : "v"(a), "v"(b)); return r; }
__device__ __forceinline__ s16x4 vtr(lds_cptr p) { return __builtin_bit_cast(s16x4, __builtin_amdgcn_ds_read_tr16_b64_v4i16((LAS v4i16_t*)p)); }
__device__ __forceinline__ void qkt(f32x16& p0, f32x16& p1, lds_cptr Kslot, const bf16x8* qr, const f32x16& negm, int r32, int hi) {
  lds_cptr kb = Kslot + hi * 1024 + r32 * 16;
#pragma unroll
  for (int d0 = 0; d0 < 4; ++d0) {
    const bf16x8 b0 = *(const LAS bf16x8*)(kb + d0 * 2048), b1 = *(const LAS bf16x8*)(kb + d0 * 2048 + 512);
    if (d0 == 0) { p0 = __builtin_amdgcn_mfma_f32_32x32x16_bf16(b0, qr[0], negm, 0, 0, 0); p1 = __builtin_amdgcn_mfma_f32_32x32x16_bf16(b1, qr[0], negm, 0, 0, 0); }
    else { p0 = __builtin_amdgcn_mfma_f32_32x32x16_bf16(b0, qr[d0], p0, 0, 0, 0); p1 = __builtin_amdgcn_mfma_f32_32x32x16_bf16(b1, qr[d0], p1, 0, 0, 0); } }
}
__device__ __forceinline__ void kload8(bf16x8* kf, lds_cptr kp) {
  kf[0] = *(const LAS bf16x8*)(kp);        kf[1] = *(const LAS bf16x8*)(kp + 512);
  kf[2] = *(const LAS bf16x8*)(kp + 2048); kf[3] = *(const LAS bf16x8*)(kp + 2560);
  kf[4] = *(const LAS bf16x8*)(kp + 4096); kf[5] = *(const LAS bf16x8*)(kp + 4608);
  kf[6] = *(const LAS bf16x8*)(kp + 6144); kf[7] = *(const LAS bf16x8*)(kp + 6656);
}
__device__ __forceinline__ void kload2(bf16x8* kf, lds_cptr kp, int j) { kf[2 * j] = *(const LAS bf16x8*)(kp + j * 2048); kf[2 * j + 1] = *(const LAS bf16x8*)(kp + j * 2048 + 512); }
__device__ __forceinline__ float rowmax(const f32x16& p0, const f32x16& p1) {
  float a = max3f(p0[0], p0[1], p1[0]), b = max3f(p0[2], p0[3], p1[1]); a = max3f(a, p1[2], p1[3]);
#pragma unroll
  for (int r = 4; r < 16; r += 4) { a = max3f(a, p0[r], p0[r + 1]); b = max3f(b, p0[r + 2], p0[r + 3]); a = max3f(a, p1[r], p1[r + 1]); b = max3f(b, p1[r + 2], p1[r + 3]); }
  return xor32_max(max2f(a, b));
}
__device__ __forceinline__ void pv(f32x16* o, int vb, bf16x8 pa0, bf16x8 pa1, bf16x8 pa2, bf16x8 pa3) {
#pragma unroll
  for (int d0 = 0; d0 < 2; ++d0) { s16x4 lo[4], hi[4];
#pragma unroll
    for (int ks = 0; ks < 4; ++ks) {
      asm volatile("ds_read_b64_tr_b16 %0,%1 offset:%c2" : "=&v"(lo[ks]) : "v"(vb), "i"(d0 * 4096 + ks * 1024) : "memory");
      asm volatile("ds_read_b64_tr_b16 %0,%1 offset:%c2" : "=&v"(hi[ks]) : "v"(vb), "i"(d0 * 4096 + ks * 1024 + 512) : "memory"); }
    asm volatile("s_waitcnt lgkmcnt(0)" ::: "memory"); SBAR3();
#define PK3(k) (bf16x8){lo[k][0], lo[k][1], lo[k][2], lo[k][3], hi[k][0], hi[k][1], hi[k][2], hi[k][3]}
    o[d0] = __builtin_amdgcn_mfma_f32_32x32x16_bf16(pa0, PK3(0), o[d0], 0, 0, 0);
    o[d0] = __builtin_amdgcn_mfma_f32_32x32x16_bf16(pa1, PK3(1), o[d0], 0, 0, 0);
    o[d0] = __builtin_amdgcn_mfma_f32_32x32x16_bf16(pa2, PK3(2), o[d0], 0, 0, 0);
    o[d0] = __builtin_amdgcn_mfma_f32_32x32x16_bf16(pa3, PK3(3), o[d0], 0, 0, 0);
#undef PK3
  }
}
template <int BR>
__device__ __forceinline__ void rmask(f32x16& p0, f32x16& p1, int e, unsigned mysel, int qi, int tq, int c, int hi) {
  const int kind = e >> 6, j = e & 63; const float NEG = -INFINITY;
  if (BR == 1) {
    int klo, khi;
    if (kind == 1) { klo = tq - 511 - 64 * j; khi = tq - 64 * j; if (khi > 63) khi = 63; if (klo < 0) klo = 0; }
    else { klo = 0; khi = -1; }
    if (!__all(klo == 0 && khi == 63)) { const int a = klo - 4 * hi, z = khi - 4 * hi;
#pragma unroll
      for (int r = 0; r < 16; ++r) { const int cr = (r & 3) + 8 * (r >> 2); if (cr < a || cr > z) p0[r] = NEG; if (cr + 32 < a || cr + 32 > z) p1[r] = NEG; } }
  } else {
    const bool on = (kind == 0) && ((mysel >> j) & 1u);
    const int z = on ? ((j == c) ? qi - 4 * hi : 64) : -1;
    if (!__all(z == 64)) {
#pragma unroll
      for (int r = 0; r < 16; ++r) { const int cr = (r & 3) + 8 * (r >> 2); p0[r] = (cr <= z) ? p0[r] : NEG; p1[r] = (cr + 32 <= z) ? p1[r] : NEG; }
    }
  }
}

template <int THRL, int BR>
__device__ __forceinline__ void stream(LAS unsigned char* L, const bf16* Kb, const bf16* Vb, const LAS int* TT, const int NT, const bf16x8 (&qr)[4],
                                       int lane, int wid, unsigned mysel, int qi, int tq, int c, float gate, bool first_write,
                                       const bf16* Knext  , const LAS int* TTnext,
                                       bool kpre  ) {
  const int r32 = lane & 31, hi = lane >> 5;
  const unsigned lds0 = (unsigned)(uintptr_t)L;
  LAS float* wsf = (LAS float*)(L + A_WS) + wid * 64;
  const bf16* ksrc = Kb + (long)lane * 64 + wid * 8;
  const bf16* vsrc = Vb + (long)(16 * (wid & 3) + (lane >> 2)) * 64 + (wid >> 2) * 32 + (lane & 3) * 8;
  const unsigned kdst = lds0 + A_K + wid * 1024, vdst = lds0 + A_V + wid * 1024;
#define TJ(x) ((long)(__builtin_amdgcn_readfirstlane(TT[(x)]) & 63) * 4096)
#define DMA_K(t, slot) glds16(ksrc + TJ(t), (unsigned)__builtin_amdgcn_readfirstlane(kdst + (slot)))
#define DMA_V(t, slot) glds16(vsrc + TJ(t), (unsigned)__builtin_amdgcn_readfirstlane(vdst + (slot)))
  const int vb0 = (int)(lds0 + A_V) + ((lane >> 4) & 1) * 32 + (lane & 3) * 8 + (4 * hi + ((lane & 15) >> 2)) * 64;
  bf16x8 kf[8];
  const lds_cptr shm3 = (lds_cptr)L; const lds_cptr kp0 = shm3 + A_K + hi * 1024 + r32 * 16; const lds_cptr vp0 = shm3 + A_V + ((lane >> 4) & 1) * 32 + (lane & 3) * 8 + (4 * hi + ((lane & 15) >> 2)) * 64;
  if (!kpre) { DMA_K(0, 0); DMA_V(0, 0); DMA_K(1, SLOTB); }
  float mhat = 0.f, l_reg = 0.f; f32x16 o[2]; o[0] = f32x16{}; o[1] = f32x16{}; f32x16 negm = f32x16{}; asm volatile("" : "+v"(negm));
#define CMASK(P0, P1, t) rmask<BR>(P0, P1, __builtin_amdgcn_readfirstlane(TT[(t)]), mysel, qi, tq, c, hi)
  bool resc = false;
#define START(P0, P1) do { const float rm = rowmax(P0, P1); resc = false; \
    { const float dl = rm; mhat = fadd_s(mhat, dl); \
      _Pragma("unroll") for (int r = 0; r < 16; ++r) { P0[r] = fsub_s(P0[r], dl); P1[r] = fsub_s(P1[r], dl); } \
      _Pragma("unroll") for (int r = 0; r < 16; ++r) negm[r] = -mhat; asm volatile("" : "+v"(negm)); } \
    _Pragma("unroll") for (int r = 0; r < 16; ++r) P0[r] = __builtin_amdgcn_exp2f(P0[r]); } while (0)
#define RESC() do { if (resc) { asm volatile("s_waitcnt lgkmcnt(0)" ::: "memory"); \
      _Pragma("unroll") for (int d_ = 0; d_ < 2; ++d_) _Pragma("unroll") for (int r = 0; r < 16; ++r) o[d_][r] *= wsf[crow(r, hi)]; } } while (0)
  f32x16 pA0, pA1, pB0, pB1;
  int sl_prev = 0, sl_cur = 0, sl_next = SLOTB;
#define ROT() do { sl_prev = sl_cur; sl_cur = sl_next; sl_next = (sl_next == (NSLOT - 1) * SLOTB) ? 0 : sl_next + SLOTB; } while (0)
  if (!kpre) { DMA_K(2, 2 * SLOTB); } else { DMA_V(0, 0); }
  WAIT_BAR3(3);
  qkt(pA0, pA1, shm3 + A_K, qr, negm, r32, hi); asm volatile("s_nop 15\n\ts_nop 7" : "+v"(pA0), "+v"(pA1)); CMASK(pA0, pA1, 0);
  START(pA0, pA1);
  _Pragma("unroll") for (int r = 0; r < 16; ++r) pA1[r] = __builtin_amdgcn_exp2f(pA1[r]);
  WAIT_BAR3(0);
  DMA_K(3, 0); DMA_V(1, SLOTB);
  ROT();
  kload8(kf, kp0 + sl_cur);
  WAIT_BAR3(2);
  s16x4 vlo[8], vhi[8]; u32x4 pw0, pw1, pw2, pw3;
#define PKW(P, B) cvtpk(P[B], P[B + 1])
#define PAF(k) __builtin_bit_cast(bf16x8, pw##k)
#define VFR(i) (bf16x8){vlo[i][0], vlo[i][1], vlo[i][2], vlo[i][3], vhi[i][0], vhi[i][1], vhi[i][2], vhi[i][3]}
#define PIN(x) asm volatile("" : "+v"(x))
#define MX3(a, b, c) __builtin_fmaxf(__builtin_fmaxf((a), (b)), (c))
#define GAPA(MF, A0, A1, A2, A3, W0, W1, PW) do { MF; sacc += A0; sacc += A1; sacc += A2; sacc += A3; PIN(sacc); W0; W1; PIN(PW); SBAR3(); } while (0)
#define EX(v) __builtin_amdgcn_exp2f(v)
#define GAPB(MF, X, B) do { MF; X[B] = EX(X[B]); X[B + 1] = EX(X[B + 1]); X[B + 2] = EX(X[B + 2]); X[B + 3] = EX(X[B + 3]); PIN(X); SBAR3(); } while (0)
#define VRD(i) do { vlo[i] = vtr(vp_ + (((i) >> 2) * 4096 + ((i) & 3) * 1024)); vhi[i] = vtr(vp_ + (((i) >> 2) * 4096 + ((i) & 3) * 1024 + 512)); } while (0)
#define KRD(G, j) do { if (G) { kload2(kf, kp0 + sl_next, j); SBAR3(); } } while (0)
#define STEP(C0, C1, P0, P1, t, GK, GV, GL) do { SBAR3(); \
    const lds_cptr vp_ = vp0 + sl_prev; \
    VRD(0); SBAR3(); float sacc = (P0[0] + P0[1]); \
    GAPA(C0 = __builtin_amdgcn_mfma_f32_32x32x16_bf16(kf[0], qr[0], negm, 0, 0, 0), P0[2], P0[3], P0[4], P0[5],     pw0[0] = PKW(P0, 0), pw0[1] = PKW(P0, 2), pw0); \
    VRD(4); SBAR3(); GAPA(C1 = __builtin_amdgcn_mfma_f32_32x32x16_bf16(kf[1], qr[0], negm, 0, 0, 0), P0[6], P0[7], P0[8], P0[9],     pw0[2] = PKW(P0, 4), pw0[3] = PKW(P0, 6), pw0); \
    VRD(1); SBAR3(); GAPA(C0 = __builtin_amdgcn_mfma_f32_32x32x16_bf16(kf[2], qr[1], C0, 0, 0, 0),   P0[10], P0[11], P0[12], P0[13], pw1[0] = PKW(P0, 8), pw1[1] = PKW(P0, 10), pw1); \
    VRD(5); SBAR3(); GAPA(C1 = __builtin_amdgcn_mfma_f32_32x32x16_bf16(kf[3], qr[1], C1, 0, 0, 0),   P0[14], P0[15], P1[0], P1[1],   pw1[2] = PKW(P0, 12), pw1[3] = PKW(P0, 14), pw1); \
    VRD(2); SBAR3(); GAPA(C0 = __builtin_amdgcn_mfma_f32_32x32x16_bf16(kf[4], qr[2], C0, 0, 0, 0),   P1[2], P1[3], P1[4], P1[5],     pw2[0] = PKW(P1, 0), pw2[1] = PKW(P1, 2), pw2); \
    VRD(6); SBAR3(); GAPA(C1 = __builtin_amdgcn_mfma_f32_32x32x16_bf16(kf[5], qr[2], C1, 0, 0, 0),   P1[6], P1[7], P1[8], P1[9],     pw2[2] = PKW(P1, 4), pw2[3] = PKW(P1, 6), pw2); \
    VRD(3); SBAR3(); GAPA(C0 = __builtin_amdgcn_mfma_f32_32x32x16_bf16(kf[6], qr[3], C0, 0, 0, 0),   P1[10], P1[11], P1[12], P1[13], pw3[0] = PKW(P1, 8), pw3[1] = PKW(P1, 10), pw3); \
    VRD(7); SBAR3(); GAPA(C1 = __builtin_amdgcn_mfma_f32_32x32x16_bf16(kf[7], qr[3], C1, 0, 0, 0),   P1[14], P1[15], 0.f, 0.f,       pw3[2] = PKW(P1, 12), pw3[3] = PKW(P1, 14), pw3); \
    l_reg += sacc; \
    if (GK) { DMA_K((t) + 3, sl_cur); } if (GV) { DMA_V((t) + 1, sl_next); } \
    CMASK(C0, C1, t); \
    { float a = MX3(C0[0], C0[1], C1[0]), b = MX3(C0[2], C0[3], C1[1]); a = MX3(a, C1[2], C1[3]); \
      _Pragma("unroll") for (int r = 4; r < 16; r += 4) { a = MX3(a, C0[r], C0[r + 1]); b = MX3(b, C0[r + 2], C0[r + 3]); a = MX3(a, C1[r], C1[r + 1]); b = MX3(b, C1[r + 2], C1[r + 3]); } \
      float rm = xor32_max(__builtin_fmaxf(a, b)); \
      resc = false; \
      if (__builtin_expect(__any(rm > (float)THRL), 0)) { const float dl = __builtin_fmaxf(rm, 0.f); mhat += dl; \
        _Pragma("unroll") for (int r = 0; r < 16; ++r) { C0[r] -= dl; C1[r] -= dl; } \
        _Pragma("unroll") for (int r = 0; r < 16; ++r) negm[r] = -mhat; asm volatile("" : "+v"(negm)); \
        const float f = __builtin_amdgcn_exp2f(-dl); l_reg *= f; if (hi == 0) wsf[r32] = f; resc = true; } } \
    SBAR3(); \
    GAPB(o[0] = __builtin_amdgcn_mfma_f32_32x32x16_bf16(PAF(0), VFR(0), o[0], 0, 0, 0), C0, 0); \
    GAPB(o[1] = __builtin_amdgcn_mfma_f32_32x32x16_bf16(PAF(0), VFR(4), o[1], 0, 0, 0), C0, 4); \
    KRD(GL, 0); GAPB(o[0] = __builtin_amdgcn_mfma_f32_32x32x16_bf16(PAF(1), VFR(1), o[0], 0, 0, 0), C0, 8); \
    KRD(GL, 1); GAPB(o[1] = __builtin_amdgcn_mfma_f32_32x32x16_bf16(PAF(1), VFR(5), o[1], 0, 0, 0), C0, 12); \
    KRD(GL, 2); GAPB(o[0] = __builtin_amdgcn_mfma_f32_32x32x16_bf16(PAF(2), VFR(2), o[0], 0, 0, 0), C1, 0); \
    KRD(GL, 3); GAPB(o[1] = __builtin_amdgcn_mfma_f32_32x32x16_bf16(PAF(2), VFR(6), o[1], 0, 0, 0), C1, 4); \
    GAPB(o[0] = __builtin_amdgcn_mfma_f32_32x32x16_bf16(PAF(3), VFR(3), o[0], 0, 0, 0), C1, 8); \
    GAPB(o[1] = __builtin_amdgcn_mfma_f32_32x32x16_bf16(PAF(3), VFR(7), o[1], 0, 0, 0), C1, 12); \
    } while (0)
#define ENDW(tt) do { if ((tt) + 3 < NT) { WAIT_BAR3(2); } else if ((tt) + 2 < NT) { WAIT_BAR3(1); } else { WAIT_BAR3(0); } } while (0)
  int t = 1;
#pragma unroll 1
  for (; t + 1 < NT; t += 2) {
    STEP(pB0, pB1, pA0, pA1, t, (t + 3 < NT), (t + 1 < NT), (t + 1 < NT));       ENDW(t);     RESC(); ROT();
    STEP(pA0, pA1, pB0, pB1, t + 1, (t + 4 < NT), (t + 2 < NT), (t + 2 < NT));   ENDW(t + 1); RESC(); ROT();
  }
#define TAIL(P0, P1, SLOT) do { float sacc = P0[0] + P0[1]; _Pragma("unroll") for (int r = 2; r < 16; ++r) sacc += P0[r]; _Pragma("unroll") for (int r = 0; r < 16; ++r) sacc += P1[r]; l_reg += sacc; \
    pw0 = (u32x4){PKW(P0, 0), PKW(P0, 2), PKW(P0, 4), PKW(P0, 6)}; pw1 = (u32x4){PKW(P0, 8), PKW(P0, 10), PKW(P0, 12), PKW(P0, 14)}; pw2 = (u32x4){PKW(P1, 0), PKW(P1, 2), PKW(P1, 4), PKW(P1, 6)}; pw3 = (u32x4){PKW(P1, 8), PKW(P1, 10), PKW(P1, 12), PKW(P1, 14)}; \
    SBAR3(); pv(o, vb0 + (SLOT), PAF(0), PAF(1), PAF(2), PAF(3)); } while (0)
  if (Knext) {
    const bf16* ks2 = Knext + (long)lane * 64 + wid * 8;
#define TJ2(x) ((long)(__builtin_amdgcn_readfirstlane(TTnext[(x)]) & 63) * 4096)
    glds16(ks2 + TJ2(0), (unsigned)__builtin_amdgcn_readfirstlane(kdst)); glds16(ks2 + TJ2(1), (unsigned)__builtin_amdgcn_readfirstlane(kdst + SLOTB)); glds16(ks2 + TJ2(2), (unsigned)__builtin_amdgcn_readfirstlane(kdst + 2 * SLOTB));
#undef TJ2
  }
  if (NT & 1) { TAIL(pA0, pA1, sl_prev); }
  else { STEP(pB0, pB1, pA0, pA1, NT - 1, false, false, false); RESC(); TAIL(pB0, pB1, sl_cur); }
#undef TAIL
#undef PKW
#undef PAF
#undef VFR
#undef PIN
#undef MX3
#undef GAPA
#undef GAPB
#undef EX
#undef VRD
#undef KRD
#undef STEP
#undef ENDW
  l_reg = xor32_sum(l_reg);
  if (hi == 0) wsf[32 + r32] = gate * __builtin_amdgcn_rcpf(l_reg);
  asm volatile("s_waitcnt lgkmcnt(0)" ::: "memory");
  { LAS float* stg = (LAS float*)(L + A_OST) + wid * 2048;
#pragma unroll
    for (int r = 0; r < 16; ++r) { const int orow = crow(r, hi); const float fl = wsf[32 + orow];
#pragma unroll
      for (int d0 = 0; d0 < 2; ++d0) { LAS float* p = stg + orow * 64 + d0 * 32 + r32; const float v = o[d0][r] * fl; *p = first_write ? v : (*p + v); } } }
  asm volatile("s_waitcnt lgkmcnt(0)\n\ts_barrier" ::: "memory");
#undef TJ
#undef DMA_K
#undef DMA_V
#undef CMASK
#undef START
#undef RESC
#undef ROT
}
}

__device__ __forceinline__ void nsa_unit_v3(LAS unsigned char* L, const MixPtrs& P, int b, int g, int c, int tid_in) {
    int tid_l = tid_in; asm volatile("" : "+v"(tid_l));
    const int tid = tid_l, lane = tid & 63, w = __builtin_amdgcn_readfirstlane(tid >> 6);
    const int r = lane & 31, h = lane >> 5, head = w >> 1, qi = (w & 1) * 32 + r, t = c * 64 + qi;
    const size_t row = (size_t)b * SEQ + t;
    LAS unsigned* SEL = (LAS unsigned*)(L + ns3::A_SEL); LAS int* TTS = (LAS int*)(L + ns3::A_TTS); LAS int* TTW = (LAS int*)(L + ns3::A_TTW);
    const size_t kvbase = (size_t)(b * 2 + g) * SEQ * 64, ccbase = (size_t)(b * 2 + g) * 128 * 64;
    const int skey = tid >> 3, sch = tid & 7, soff = tile_off(skey, sch);
    bf16x8v qf[4];
    { const bf16* qp = MP_QN + row * 512 + (g * 4 + head) * 64 + 8 * h;
#pragma unroll
      for (int ks = 0; ks < 4; ++ks) qf[ks] = *(const bf16x8v*)(qp + 16 * ks); }
    const float* gp = MP_GATE + row * 32 + g * 4 + head;
    float one = 1.f; asm volatile("" : "+v"(one));
    const float gate_c = __builtin_amdgcn_rcpf(one + __expf(-gp[0])), gate_s = __builtin_amdgcn_rcpf(one + __expf(-gp[8])), gate_w = __builtin_amdgcn_rcpf(one + __expf(-gp[16]));
    f32x16 oacc[2];
    const bool two = c >= 16;
    {
        const bf16* kc = MP_KC + ccbase; const bf16* vc = MP_VC + ccbase;
        const v4u k0 = *(const v4u*)(kc + tid * 8), v0 = *(const v4u*)(vc + tid * 8); v4u k1 = k0, v1 = v0;
        if (two) { k1 = *(const v4u*)(kc + 4096 + tid * 8); v1 = *(const v4u*)(vc + 4096 + tid * 8); }
        LBAR();
        *(LAS v4u*)(L + soff) = k0; *(LAS v4u*)(L + 8192 + soff) = v0; if (two) { *(LAS v4u*)(L + 16384 + soff) = k1; *(LAS v4u*)(L + 24576 + soff) = v1; }
        if (tid < 64) SEL[tid] = 0u;
        LBAR();
        f32x16 s0, s1, s2, s3;
        { bf16x8v kfa[8]; k_load(L, r, h, kfa); SBAR(); qk_mma(kfa, qf, s0, s1); }
        const int nlim = (t >= 31) ? (((t - 31) >> 4) < 126 ? ((t - 31) >> 4) : 126) : -1;
        if (two) {
            { bf16x8v kfb[8]; k_load(L + 16384, r, h, kfb); SBAR(); qk_mma(kfb, qf, s2, s3); }
            float mxv[4] = {-1e20f, -1e20f, -1e20f, -1e20f};
#pragma unroll
            for (int e = 0; e < 16; ++e) { const int cr = (e & 3) + 8 * (e >> 2) + 4 * h;
                s0[e] = (cr <= nlim) ? s0[e] : -1e30f; s1[e] = (cr + 32 <= nlim) ? s1[e] : -1e30f;
                s2[e] = (cr + 64 <= nlim) ? s2[e] : -1e30f; s3[e] = (cr + 96 <= nlim) ? s3[e] : -1e30f;
                mxv[e & 3] = max3f(max3f(mxv[e & 3], s0[e], s1[e]), s2[e], s3[e]); }
            const float mx = xor32_max(max3f(mxv[0], mxv[1], max2f(mxv[2], mxv[3])));
            float lsv[4] = {0.f, 0.f, 0.f, 0.f};
#pragma unroll
            for (int e = 0; e < 16; ++e) { s0[e] = __builtin_amdgcn_exp2f(s0[e] - mx); s1[e] = __builtin_amdgcn_exp2f(s1[e] - mx); s2[e] = __builtin_amdgcn_exp2f(s2[e] - mx); s3[e] = __builtin_amdgcn_exp2f(s3[e] - mx);
                lsv[e & 3] += (s0[e] + s1[e]) + (s2[e] + s3[e]); }
            const float ls = xor32_sum((lsv[0] + lsv[1]) + (lsv[2] + lsv[3]));
            const float il = (ls > 0.f) ? __builtin_amdgcn_rcpf(ls) : 0.f;
#pragma unroll
            for (int e = 0; e < 16; ++e) { s0[e] *= il; s1[e] *= il; s2[e] *= il; s3[e] *= il; }
        } else {
            float mxv[4] = {-1e20f, -1e20f, -1e20f, -1e20f};
#pragma unroll
            for (int e = 0; e < 16; ++e) { const int cr = (e & 3) + 8 * (e >> 2) + 4 * h;
                s0[e] = (cr <= nlim) ? s0[e] : -1e30f; s1[e] = (cr + 32 <= nlim) ? s1[e] : -1e30f;
                mxv[e & 3] = max3f(mxv[e & 3], s0[e], s1[e]); }
            const float mx = xor32_max(max3f(mxv[0], mxv[1], max2f(mxv[2], mxv[3])));
            float lsv[4] = {0.f, 0.f, 0.f, 0.f};
#pragma unroll
            for (int e = 0; e < 16; ++e) { s0[e] = __builtin_amdgcn_exp2f(s0[e] - mx); s1[e] = __builtin_amdgcn_exp2f(s1[e] - mx); lsv[e & 3] += s0[e] + s1[e]; s2[e] = 0.f; s3[e] = 0.f; }
            const float ls = xor32_sum((lsv[0] + lsv[1]) + (lsv[2] + lsv[3]));
            const float il = (ls > 0.f) ? __builtin_amdgcn_rcpf(ls) : 0.f;
#pragma unroll
            for (int e = 0; e < 16; ++e) { s0[e] *= il; s1[e] *= il; }
        }
        if (two) { LAS float* IMP = (LAS float*)(L + ns3::A_IMP) + (w * 32 + r) * 33; float plprev = 0.f;
#pragma unroll
          for (int x = 0; x < 16; ++x) {
              const f32x16& S = (x < 4) ? s0 : ((x < 8) ? s1 : ((x < 12) ? s2 : s3)); const int g4 = (x & 3) * 4;
              const float own = (S[g4] + S[g4 + 1]) + (S[g4 + 2] + S[g4 + 3]);
              const float pl = shx(S[g4 + 3], 32, lane);
              if (h == 1) IMP[2 * x + 1] = own + pl; else IMP[2 * x] = own + plprev;
              plprev = pl;
          }
        }
        oacc[0] = (f32x16){0.f, 0.f, 0.f, 0.f, 0.f, 0.f, 0.f, 0.f, 0.f, 0.f, 0.f, 0.f, 0.f, 0.f, 0.f, 0.f}; oacc[1] = oacc[0];
        { bf16x8v vfa[8]; v_load(L + 8192, lane, vfa); SBAR(); pv_mma(vfa, s0, s1, oacc); }
        if (two) { bf16x8v vfb[8]; v_load(L + 24576, lane, vfb); SBAR(); pv_mma(vfb, s2, s3, oacc); }
    }
    if (two) LBAR();
    { const int i = tid & 63, jg = tid >> 6; const LAS float* I8 = (const LAS float*)(L + ns3::A_IMP); LAS float* IMS = (LAS float*)(L + ns3::A_IMS);
      if (two) {
#pragma unroll
      for (int jj = 0; jj < 4; ++jj) { const int j = 4 * jg + jj; const int wq = (i >> 5), rq = i & 31;
          IMS[i * 36 + j] = (I8[((0 + wq) * 32 + rq) * 33 + j] + I8[((2 + wq) * 32 + rq) * 33 + j]) + (I8[((4 + wq) * 32 + rq) * 33 + j] + I8[((6 + wq) * 32 + rq) * 33 + j]); }
      LBAR(); }
      unsigned bits = 0u;
      if (c + 1 <= 16) { if (jg == 0) bits = (1u << (c + 1)) - 1u; }
      else { if (jg == 0) bits = 1u | (1u << c) | (1u << (c - 1));
          { float iv[32];
#pragma unroll
            for (int q8 = 0; q8 < 8; ++q8) { const f32x4 x = *(const LAS f32x4*)(IMS + i * 36 + 4 * q8); iv[4 * q8] = x.x; iv[4 * q8 + 1] = x.y; iv[4 * q8 + 2] = x.z; iv[4 * q8 + 3] = x.w; }
#pragma unroll
            for (int jj = 0; jj < 4; ++jj) { const int j = 4 * jg + jj; const float vj = IMS[i * 36 + j]; int rank = 0;
#pragma unroll
                for (int i2 = 1; i2 < 30; ++i2) rank += (i2 <= c - 2 && (iv[i2] > vj || (iv[i2] == vj && i2 < j))) ? 1 : 0;
                if (j >= 1 && j <= c - 2 && rank < 13) bits |= 1u << j; } } }
      if (bits) atomicOr((unsigned*)&SEL[i], bits);
      LBAR();
      if (w == 0) { unsigned so = SEL[lane];
#pragma unroll
          for (int o2 = 32; o2; o2 >>= 1) so |= shxu(so, o2, lane);
          { so &= (c >= 31) ? 0xffffffffu : ((2u << c) - 1u);
            const int n = __builtin_popcount(so), nt = (n < 4) ? 4 : n;
            if (lane < 32 && ((so >> lane) & 1u)) TTS[__builtin_popcount(so & ((1u << lane) - 1u))] = lane;
            if (lane >= n && lane < nt + 2) TTS[lane] = 128;
            const int j0 = (c - 8 > 0) ? c - 8 : 0, m2 = 1 + (c - j0), mt = (m2 < 4) ? 4 : m2;
            if (lane == 0) { TTS[46] = nt; TTW[0] = 64 + c; TTW[14] = mt; }
            else if (lane < m2) TTW[lane] = 64 + j0 + lane - 1;
            else if (lane < mt) TTW[lane] = 128; } }
      LBAR();
    }
    const unsigned mysel = SEL[qi]; const int nts = TTS[46], ntw = TTW[14];
    { LAS float* stg = (LAS float*)(L + ns3::A_OST) + w * 2048 + r * 64 + 4 * h;
#pragma unroll
      for (int db = 0; db < 2; ++db)
#pragma unroll
          for (int g4 = 0; g4 < 4; ++g4) *(LAS f32x4*)(stg + db * 32 + g4 * 8) = (f32x4){oacc[db][4 * g4] * gate_c, oacc[db][4 * g4 + 1] * gate_c, oacc[db][4 * g4 + 2] * gate_c, oacc[db][4 * g4 + 3] * gate_c}; }
#if PROBE_SC == 22
    const unsigned st0_ = (unsigned)__builtin_amdgcn_s_memrealtime();
#endif
    ns3::stream<8, 0>(L, MP_KS + kvbase, MP_VS + kvbase, TTS, nts, qf, lane, w, mysel, qi, t, c, gate_s, false, MP_KW + kvbase, TTW, false);
    ns3::stream<8, 1>(L, MP_KW + kvbase, MP_VW + kvbase, TTW, ntw, qf, lane, w, mysel, qi, t, c, gate_w, false, nullptr, nullptr, true);
#if PROBE_SC == 22
    if (tid == 0) { LAS unsigned* pm_ = (LAS unsigned*)(L + MISC_OFF) + 210; pm_[0] += (unsigned)__builtin_amdgcn_s_memrealtime() - st0_; pm_[1] += (unsigned)(nts + ntw); }
#endif
    { const LAS float* stg = (const LAS float*)(L + ns3::A_OST) + w * 2048; bf16* yb = MP_Y + ((size_t)b * SEQ + c * 64 + (w & 1) * 32) * DM + (g * 4 + head) * 64;
#pragma unroll
      for (int i4 = 0; i4 < 4; ++i4) { const int rr = i4 * 8 + (lane >> 3), ch = lane & 7; const f32x4 a = *(const LAS f32x4*)(stg + rr * 64 + ch * 8), bq = *(const LAS f32x4*)(stg + rr * 64 + ch * 8 + 4);
          v4u wv; wv.x = cvtpk(a.x, a.y); wv.y = cvtpk(a.z, a.w); wv.z = cvtpk(bq.x, bq.y); wv.w = cvtpk(bq.z, bq.w);
          *(v4u*)(yb + (size_t)rr * DM + ch * 8) = wv; } }
}

#define MFMA16(a, b, c) __builtin_amdgcn_mfma_f32_16x16x32_bf16((a), (b), (c), 0, 0, 0)
constexpr size_t WS_QC = 422 * MiB, WS_KC2 = 454 * MiB, WS_END2 = 486 * MiB; static_assert(WS_END2 <= WS_PART, "row-partial buffers follow");
#define MP_QC ((const bf16*)(P.ws + WS_QC))
#define MP_KC2 ((const bf16*)(P.ws + WS_KC2))
__device__ __forceinline__ int img_off(int row, int ch) { return 256 * row + 16 * (ch ^ (((row & 3) << 2) | ((row >> 2) & 3))); }
constexpr int M2_IMG = 0, M2_SC = 98304, M2_DEN = 106496, M2_QN = 107520, M2_N = 107776, M2_SSQ = 108288;

__device__ __forceinline__ void mlstm_conv_item(unsigned char* ws, const float* conv_w, const float* conv_b, int b, int tg, int isk, int ch0) {
    {
        const bf16* src = (const bf16*)(ws + (isk ? WS_MK : WS_MQ)) + (size_t)b * SEQ * 512 + ch0;
        bf16* dst = (bf16*)(ws + (isk ? WS_KC2 : WS_QC)) + ((size_t)(b * 4 + (ch0 >> 7)) * SEQ) * 128 + (ch0 & 127);
        float wt[4][8], bs[8];
#pragma unroll
        for (int j = 0; j < 4; ++j) { const f32x4 a = *(const f32x4*)(conv_w + j * 1024 + isk * 512 + ch0), c2 = *(const f32x4*)(conv_w + j * 1024 + isk * 512 + ch0 + 4);
            wt[j][0] = a.x; wt[j][1] = a.y; wt[j][2] = a.z; wt[j][3] = a.w; wt[j][4] = c2.x; wt[j][5] = c2.y; wt[j][6] = c2.z; wt[j][7] = c2.w; }
        { const f32x4 a = *(const f32x4*)(conv_b + isk * 512 + ch0), c2 = *(const f32x4*)(conv_b + isk * 512 + ch0 + 4); bs[0] = a.x; bs[1] = a.y; bs[2] = a.z; bs[3] = a.w; bs[4] = c2.x; bs[5] = c2.y; bs[6] = c2.z; bs[7] = c2.w; }
        const float osc = isk ? 0.08838834764831845f : 1.f;
        const int t0 = tg * 16;
        float x0[8], x1[8], x2[8];
#pragma unroll
        for (int e = 0; e < 8; ++e) { x0[e] = 0.f; x1[e] = 0.f; x2[e] = 0.f; }
        if (t0 > 0) {
            const v4u a = *(const v4u*)(src + (size_t)(t0 - 3) * 512), c2 = *(const v4u*)(src + (size_t)(t0 - 2) * 512), d2 = *(const v4u*)(src + (size_t)(t0 - 1) * 512);
            x0[0] = bflo(a.x); x0[1] = bfhi(a.x); x0[2] = bflo(a.y); x0[3] = bfhi(a.y); x0[4] = bflo(a.z); x0[5] = bfhi(a.z); x0[6] = bflo(a.w); x0[7] = bfhi(a.w);
            x1[0] = bflo(c2.x); x1[1] = bfhi(c2.x); x1[2] = bflo(c2.y); x1[3] = bfhi(c2.y); x1[4] = bflo(c2.z); x1[5] = bfhi(c2.z); x1[6] = bflo(c2.w); x1[7] = bfhi(c2.w);
            x2[0] = bflo(d2.x); x2[1] = bfhi(d2.x); x2[2] = bflo(d2.y); x2[3] = bfhi(d2.y); x2[4] = bflo(d2.z); x2[5] = bfhi(d2.z); x2[6] = bflo(d2.w); x2[7] = bfhi(d2.w);
        }
        v4u rows[16];
#pragma unroll
        for (int s = 0; s < 16; ++s) rows[s] = *(const v4u*)(src + (size_t)(t0 + s) * 512);
#pragma unroll
        for (int s = 0; s < 16; ++s) {
            const v4u a = rows[s];
            const float x3[8] = {bflo(a.x), bfhi(a.x), bflo(a.y), bfhi(a.y), bflo(a.z), bfhi(a.z), bflo(a.w), bfhi(a.w)};
            float o[8];
#pragma unroll
            for (int e = 0; e < 8; ++e) { float v = bs[e] + wt[0][e] * x0[e] + wt[1][e] * x1[e] + wt[2][e] * x2[e] + wt[3][e] * x3[e]; v = v * __builtin_amdgcn_rcpf(1.f + __expf(-v)); o[e] = v * osc; x0[e] = x1[e]; x1[e] = x2[e]; x2[e] = x3[e]; }
            v4u wv; wv.x = cvtpk(o[0], o[1]); wv.y = cvtpk(o[2], o[3]); wv.z = cvtpk(o[4], o[5]); wv.w = cvtpk(o[6], o[7]);
            *(v4u*)(dst + (size_t)(t0 + s) * 128) = wv;
        }
    }
}
__device__ __forceinline__ void mlstm_conv_pass(unsigned char* ws, const float* conv_w, const float* conv_b, int gthread, int nthreads) {
    for (int idx = gthread; idx < BATCH * 128 * 128; idx += nthreads) { const int cc = idx & 127, tg = (idx >> 7) & 127, b = idx >> 14; mlstm_conv_item(ws, conv_w, conv_b, b, tg, cc >> 6, (cc & 63) * 8); }
}
__device__ __forceinline__ void mlstm_conv_unit(unsigned char* ws, const float* conv_w, const float* conv_b, int b, int hh, int tid) {
#pragma unroll 1
    for (int idx = tid; idx < 4096; idx += 512) mlstm_conv_item(ws, conv_w, conv_b, b, idx >> 5, (idx >> 4) & 1, hh * 128 + (idx & 15) * 8);
}

constexpr int M2_A = 112384, M2_PM = 120576, M2_F = 128768, M2_BL = 136960, M2_AMX = 137088, M2_MC = 137216;
__device__ __forceinline__ void mlstm_unit_mfma(LAS unsigned char* L, const MixPtrs& P, int b, int hh, int tid_in) {
    int tid_l = tid_in; asm volatile("" : "+v"(tid_l));
    const int tid = tid_l, lane = tid & 63, w = __builtin_amdgcn_readfirstlane(tid >> 6), l15 = lane & 15, kg = lane >> 4;
    const size_t rb = (size_t)b * SEQ;
    const bf16* QCp = MP_QC + ((size_t)(b * 4 + hh) * SEQ) * 128; const bf16* KCp = MP_KC2 + ((size_t)(b * 4 + hh) * SEQ) * 128;
    const bf16* Vp = MP_MV + rb * 512 + hh * 128; const bf16* Op = MP_MO + rb * 512 + hh * 128 + 16 * w + 4 * kg;
    bf16* Yp = MP_Y + rb * DM + 512 + hh * 128 + 16 * w + 4 * kg;
    LAS float* DEN = (LAS float*)(L + M2_DEN); LAS float* QN = (LAS float*)(L + M2_QN); LAS float* NV = (LAS float*)(L + M2_N); LAS float* SSQ = (LAS float*)(L + M2_SSQ);
    LAS float* SA = (LAS float*)(L + M2_A); LAS float* SPM = (LAS float*)(L + M2_PM); LAS float* SF = (LAS float*)(L + M2_F);
    LAS float* SBL = (LAS float*)(L + M2_BL); LAS float* SAMX = (LAS float*)(L + M2_AMX); LAS float* SMC = (LAS float*)(L + M2_MC);
    float zf = 0.f; asm volatile("" : "+v"(zf));
    f32x4 Cacc[8], nacc = {zf, zf, zf, zf};
#pragma unroll
    for (int i = 0; i < 8; ++i) Cacc[i] = (f32x4){zf, zf, zf, zf};
    const f32x4 gn = *(const f32x4*)(P.mnorm_g + hh * 128 + 16 * w + 4 * kg);
    const int r0s = tid >> 4, c0s = tid & 15, so0 = img_off(r0s, c0s), so1 = img_off(r0s + 32, c0s);
    v4u sq0, sq1, sk0, sk1, sv0, sv1;
    sq0 = *(const v4u*)(QCp + (size_t)r0s * 128 + c0s * 8); sq1 = *(const v4u*)(QCp + (size_t)(r0s + 32) * 128 + c0s * 8);
    sk0 = *(const v4u*)(KCp + (size_t)r0s * 128 + c0s * 8); sk1 = *(const v4u*)(KCp + (size_t)(r0s + 32) * 128 + c0s * 8);
    sv0 = *(const v4u*)(Vp + (size_t)r0s * 512 + c0s * 8);  sv1 = *(const v4u*)(Vp + (size_t)(r0s + 32) * 512 + c0s * 8);
    LBAR();
    { const float ib = P.i_bias[hh], fb = P.f_bias[hh]; const float* Gp = MP_GATE + rb * 32 + hh;
#pragma unroll 1
      for (int cc = w; cc < 32; cc += 8) { const int tk = 64 * cc + lane;
          const float il = Gp[(size_t)tk * 32 + 24] + ib, fx = Gp[(size_t)tk * 32 + 28] + fb; const float fl = fminf(fx, 0.f) - log1pf(__expf(-fabsf(fx)));
          float f = fl;
#pragma unroll
          for (int o = 1; o < 64; o <<= 1) { const float v = shi(f, lane - o); if (lane >= o) f += v; }
          const float a = il - f; float pm = a;
#pragma unroll
          for (int o = 1; o < 64; o <<= 1) { const float v = shi(pm, lane - o); if (lane >= o) pm = fmaxf(pm, v); }
          SA[tk] = a; SPM[tk] = pm; SF[tk] = f; if (lane == 63) { SBL[cc] = f; SAMX[cc] = pm; } } }
    *(LAS v4u*)(L + M2_IMG + so0) = sq0; *(LAS v4u*)(L + M2_IMG + so1) = sq1; *(LAS v4u*)(L + M2_IMG + 16384 + so0) = sk0; *(LAS v4u*)(L + M2_IMG + 16384 + so1) = sk1;
    *(LAS v4u*)(L + M2_IMG + 32768 + so0) = sv0; *(LAS v4u*)(L + M2_IMG + 32768 + so1) = sv1;
    if (tid < 128) NV[tid] = zf;
    LBAR();
    if (tid == 0) { float mcar = zf; for (int cc = 0; cc < 32; ++cc) { SMC[cc] = mcar; mcar = SBL[cc] + fmaxf(mcar, SAMX[cc]); } }
    LBAR();
#pragma unroll 1
    for (int c = 0; c < 32; ++c) {
        int lc = lane; asm volatile("" : "+v"(lc));
        const int l15 = lc & 15, kg = lc >> 4, q4 = l15 >> 2, p4 = l15 & 3;
        const int t0 = c * 64; const LAS unsigned char* Qi = L + M2_IMG + (c & 1) * 49152; const LAS unsigned char* Ki = Qi + 16384; const LAS unsigned char* Vi = Qi + 32768;
        if (c + 1 < 32) { const int tn = t0 + 64;
            sq0 = *(const v4u*)(QCp + (size_t)(tn + r0s) * 128 + c0s * 8); sq1 = *(const v4u*)(QCp + (size_t)(tn + r0s + 32) * 128 + c0s * 8);
            sk0 = *(const v4u*)(KCp + (size_t)(tn + r0s) * 128 + c0s * 8); sk1 = *(const v4u*)(KCp + (size_t)(tn + r0s + 32) * 128 + c0s * 8);
            sv0 = *(const v4u*)(Vp + (size_t)(tn + r0s) * 512 + c0s * 8);  sv1 = *(const v4u*)(Vp + (size_t)(tn + r0s + 32) * 512 + c0s * 8); }
        const float mc = SMC[c], mxa = fmaxf(mc, SAMX[c]); const float cs = __expf(mc - mxa);
        { const int tblk = w >> 1, t = 16 * tblk + l15; const int sb0 = 2 * (w & 1);
          bf16x8v ka[2][4], qb[4];
#pragma unroll
          for (int ks = 0; ks < 4; ++ks) { qb[ks] = *(const LAS bf16x8v*)(Qi + img_off(t, 4 * ks + kg)); ka[0][ks] = *(const LAS bf16x8v*)(Ki + img_off(16 * sb0 + l15, 4 * ks + kg)); ka[1][ks] = *(const LAS bf16x8v*)(Ki + img_off(16 * sb0 + 16 + l15, 4 * ks + kg)); }
          const float Mt = fmaxf(SPM[t0 + t], mc);
          const f32x4 as0 = *(const LAS f32x4*)(SA + t0 + 16 * sb0 + 4 * kg), as1 = *(const LAS f32x4*)(SA + t0 + 16 * sb0 + 16 + 4 * kg);
          const int tq = tid >> 3, dp = tid & 7; const v4u q0 = *(const LAS v4u*)(Qi + img_off(tq, 2 * dp)), q1 = *(const LAS v4u*)(Qi + img_off(tq, 2 * dp + 1));
          const LAS f32x4* np = (const LAS f32x4*)(NV + 16 * dp); const f32x4 n0 = np[0], n1 = np[1], n2 = np[2], n3 = np[3];
          SBAR();
          LAS unsigned char* SC = L + M2_SC;
#pragma unroll
          for (int sb = 0; sb < 2; ++sb) { const int sblk = sb0 + sb; f32x4 acc = {0.f, 0.f, 0.f, 0.f}; float rp = 0.f; v2u wv; wv.x = 0u; wv.y = 0u;
              if (sblk <= tblk) {
#pragma unroll
                  for (int ks = 0; ks < 4; ++ks) acc = MFMA16(ka[sb][ks], qb[ks], acc);
                  const f32x4 as = sb ? as1 : as0; float v[4];
#pragma unroll
                  for (int e = 0; e < 4; ++e) { const float x = acc[e] * __expf(as[e] - Mt); v[e] = (sblk == tblk && 4 * kg + e > l15) ? 0.f : x; }
                  rp = (v[0] + v[1]) + (v[2] + v[3]); wv.x = cvtpk(v[0], v[1]); wv.y = cvtpk(v[2], v[3]);
              }
              rp += shx(rp, 16, lane); rp += shx(rp, 32, lane);
              *(LAS v2u*)(SC + t * 128 + (((2 * sblk + (kg >> 1)) ^ (t & 7)) << 4) + 8 * (kg & 1)) = wv;
              if (kg == 0) DEN[sblk * 64 + t] = rp; }
          { float s = bflo(q0.x) * n0.x + bfhi(q0.x) * n0.y + bflo(q0.y) * n0.z + bfhi(q0.y) * n0.w + bflo(q0.z) * n1.x + bfhi(q0.z) * n1.y + bflo(q0.w) * n1.z + bfhi(q0.w) * n1.w
                    + bflo(q1.x) * n2.x + bfhi(q1.x) * n2.y + bflo(q1.y) * n2.z + bfhi(q1.y) * n2.w + bflo(q1.z) * n3.x + bfhi(q1.z) * n3.y + bflo(q1.w) * n3.z + bfhi(q1.w) * n3.w;
            s += shx(s, 1, lane); s += shx(s, 2, lane); s += shx(s, 4, lane);
            if (dp == 0) QN[tq] = s; } }
        LBAR();
        v2u og[4];
#pragma unroll
        for (int tb = 0; tb < 4; ++tb) og[tb] = *(const v2u*)(Op + (size_t)(t0 + 16 * tb + l15) * 512);
        bf16x8v vf[2]; f32x4 hv[4];
        { float pmt[4], ft[4], dnp[4], qn4[4]; bf16x8v Cfrag[4];
#pragma unroll
          for (int kp = 0; kp < 4; ++kp) { v4u a; a.x = cvtpk(Cacc[2 * kp].x, Cacc[2 * kp].y); a.y = cvtpk(Cacc[2 * kp].z, Cacc[2 * kp].w); a.z = cvtpk(Cacc[2 * kp + 1].x, Cacc[2 * kp + 1].y); a.w = cvtpk(Cacc[2 * kp + 1].z, Cacc[2 * kp + 1].w);
              Cfrag[kp] = __builtin_bit_cast(bf16x8v, a); }
#pragma unroll
          for (int ks = 0; ks < 2; ++ks) { const int r0 = 32 * ks + 8 * kg;
              const s16x4v lo = tr_read(Vi + 256 * (r0 + q4) + 16 * ((2 * w + (p4 >> 1)) ^ ((q4 << 2) | ((r0 >> 2) & 3))) + 8 * (p4 & 1));
              const s16x4v hi = tr_read(Vi + 256 * (r0 + 4 + q4) + 16 * ((2 * w + (p4 >> 1)) ^ ((q4 << 2) | (((r0 + 4) >> 2) & 3))) + 8 * (p4 & 1));
              vf[ks] = __builtin_shufflevector(lo, hi, 0, 1, 2, 3, 4, 5, 6, 7); }
#pragma unroll
          for (int tb = 0; tb < 4; ++tb) { const int t = 16 * tb + l15; pmt[tb] = SPM[t0 + t]; ft[tb] = SF[t0 + t]; dnp[tb] = (DEN[t] + DEN[64 + t]) + (DEN[128 + t] + DEN[192 + t]); qn4[tb] = QN[t]; }
#pragma unroll
          for (int tp = 0; tp < 2; ++tp) {
              bf16x8v sf[2][2]; v2u qlo[2][4], qhi[2][4];
#pragma unroll
              for (int t2 = 0; t2 < 2; ++t2) { const int t = 16 * (2 * tp + t2) + l15; const int swz = ((t & 3) << 2) | ((t >> 2) & 3);
#pragma unroll
                  for (int ks = 0; ks < 2; ++ks) sf[t2][ks] = *(const LAS bf16x8v*)(L + M2_SC + t * 128 + (((4 * ks + kg) ^ (t & 7)) << 4));
#pragma unroll
                  for (int kp = 0; kp < 4; ++kp) { qlo[t2][kp] = *(const LAS v2u*)(Qi + 256 * t + 16 * ((4 * kp + (kg >> 1)) ^ swz) + 8 * (kg & 1)); qhi[t2][kp] = *(const LAS v2u*)(Qi + 256 * t + 16 * ((4 * kp + 2 + (kg >> 1)) ^ swz) + 8 * (kg & 1)); } }
              SBAR();
#pragma unroll
              for (int t2 = 0; t2 < 2; ++t2) { const int tb = 2 * tp + t2; f32x4 an = {0.f, 0.f, 0.f, 0.f}, a2 = {0.f, 0.f, 0.f, 0.f};
#pragma unroll
                  for (int ks = 0; ks < 2; ++ks) an = MFMA16(vf[ks], sf[t2][ks], an);
#pragma unroll
                  for (int kp = 0; kp < 4; ++kp) { v4u qq; qq.x = qlo[t2][kp].x; qq.y = qlo[t2][kp].y; qq.z = qhi[t2][kp].x; qq.w = qhi[t2][kp].y; a2 = MFMA16(Cfrag[kp], __builtin_bit_cast(bf16x8v, qq), a2); }
                  const float Mt = fmaxf(pmt[tb], mc), wp = __expf(mc - Mt), emt = __expf(-ft[tb] - Mt);
                  const float dn = dnp[tb] + wp * qn4[tb];
                  const float idn = __builtin_amdgcn_rcpf(fmaxf(fabsf(dn), emt));
                  hv[tb] = (an + a2 * wp) * idn;
                  float ss = (hv[tb].x * hv[tb].x + hv[tb].y * hv[tb].y) + (hv[tb].z * hv[tb].z + hv[tb].w * hv[tb].w);
                  ss += shx(ss, 16, lane); ss += shx(ss, 32, lane);
                  if (kg == 0) SSQ[((c & 1) * 8 + w) * 64 + 16 * tb + l15] = ss; }
              SBAR();
          } }
        { bf16x8v vpf[2], wkf[2];
          f32x4 aw[2][2];
#pragma unroll
          for (int ks = 0; ks < 2; ++ks) { aw[ks][0] = *(const LAS f32x4*)(SA + t0 + 32 * ks + 8 * kg); aw[ks][1] = *(const LAS f32x4*)(SA + t0 + 32 * ks + 8 * kg + 4); }
#pragma unroll
          for (int ks = 0; ks < 2; ++ks) { float wkv[8]; unsigned vp[4], wp2[4]; const v4u vu = __builtin_bit_cast(v4u, vf[ks]); const unsigned vw[4] = {vu.x, vu.y, vu.z, vu.w};
#pragma unroll
              for (int j = 0; j < 8; ++j) wkv[j] = __expf(aw[ks][j >> 2][j & 3] - mxa);
#pragma unroll
              for (int j2 = 0; j2 < 4; ++j2) { vp[j2] = cvtpk(bflo(vw[j2]) * wkv[2 * j2], bfhi(vw[j2]) * wkv[2 * j2 + 1]); wp2[j2] = cvtpk(wkv[2 * j2], wkv[2 * j2 + 1]); }
              v4u a; a.x = vp[0]; a.y = vp[1]; a.z = vp[2]; a.w = vp[3]; vpf[ks] = __builtin_bit_cast(bf16x8v, a);
              v4u b2; b2.x = wp2[0]; b2.y = wp2[1]; b2.z = wp2[2]; b2.w = wp2[3]; wkf[ks] = __builtin_bit_cast(bf16x8v, b2); }
          nacc = nacc * cs;
#pragma unroll
          for (int ih = 0; ih < 2; ++ih) {
              bf16x8v kf[4][2];
#pragma unroll
              for (int i4 = 0; i4 < 4; ++i4)
#pragma unroll
                  for (int ks = 0; ks < 2; ++ks) { const int i = 4 * ih + i4, r0 = 32 * ks + 8 * kg;
                      const s16x4v lo = tr_read(Ki + 256 * (r0 + q4) + 16 * ((2 * i + (p4 >> 1)) ^ ((q4 << 2) | ((r0 >> 2) & 3))) + 8 * (p4 & 1));
                      const s16x4v hi = tr_read(Ki + 256 * (r0 + 4 + q4) + 16 * ((2 * i + (p4 >> 1)) ^ ((q4 << 2) | (((r0 + 4) >> 2) & 3))) + 8 * (p4 & 1));
                      kf[i4][ks] = __builtin_shufflevector(lo, hi, 0, 1, 2, 3, 4, 5, 6, 7); }
              SBAR();
#pragma unroll
              for (int i4 = 0; i4 < 4; ++i4) { const int i = 4 * ih + i4; Cacc[i] = Cacc[i] * cs;
#pragma unroll
                  for (int ks = 0; ks < 2; ++ks) Cacc[i] = MFMA16(kf[i4][ks], vpf[ks], Cacc[i]); }
              SBAR();
          }
          { bf16x8v kw[2];
#pragma unroll
            for (int ks = 0; ks < 2; ++ks) { const int r0 = 32 * ks + 8 * kg;
                const s16x4v lo = tr_read(Ki + 256 * (r0 + q4) + 16 * ((2 * w + (p4 >> 1)) ^ ((q4 << 2) | ((r0 >> 2) & 3))) + 8 * (p4 & 1));
                const s16x4v hi = tr_read(Ki + 256 * (r0 + 4 + q4) + 16 * ((2 * w + (p4 >> 1)) ^ ((q4 << 2) | (((r0 + 4) >> 2) & 3))) + 8 * (p4 & 1));
                kw[ks] = __builtin_shufflevector(lo, hi, 0, 1, 2, 3, 4, 5, 6, 7); }
            nacc = MFMA16(kw[0], wkf[0], nacc); nacc = MFMA16(kw[1], wkf[1], nacc); }
          if (l15 == 0) *(LAS f32x4*)(NV + 16 * w + 4 * kg) = nacc;
 }
        if (c + 1 < 32) { LAS unsigned char* Nx = L + M2_IMG + ((c + 1) & 1) * 49152;
            *(LAS v4u*)(Nx + so0) = sq0; *(LAS v4u*)(Nx + so1) = sq1; *(LAS v4u*)(Nx + 16384 + so0) = sk0; *(LAS v4u*)(Nx + 16384 + so1) = sk1; *(LAS v4u*)(Nx + 32768 + so0) = sv0; *(LAS v4u*)(Nx + 32768 + so1) = sv1; }
        LBAR();
#pragma unroll
        for (int tb = 0; tb < 4; ++tb) { const int t = 16 * tb + l15; const LAS float* sp = SSQ + (c & 1) * 512 + t;
            const float tot = ((sp[0] + sp[64]) + (sp[128] + sp[192])) + ((sp[256] + sp[320]) + (sp[384] + sp[448]));
            const float rn = __frsqrt_rn(tot * (1.f / 128.f) + EPS);
            const float y0 = hv[tb].x * rn * gn.x * sigmoidf_(bflo(og[tb].x)), y1 = hv[tb].y * rn * gn.y * sigmoidf_(bfhi(og[tb].x)), y2 = hv[tb].z * rn * gn.z * sigmoidf_(bflo(og[tb].y)), y3 = hv[tb].w * rn * gn.w * sigmoidf_(bfhi(og[tb].y));
            v2u wv; wv.x = cvtpk(y0, y1); wv.y = cvtpk(y2, y3);
            *(v2u*)(Yp + (size_t)(t0 + t) * DM) = wv; }
    }
    LBAR();
}

__device__ __forceinline__ bf16x8v pack8(const f32x16& x, int s2) { v4u p; p.x = cvtpk(x[8 * s2 + 0], x[8 * s2 + 1]); p.y = cvtpk(x[8 * s2 + 2], x[8 * s2 + 3]); p.z = cvtpk(x[8 * s2 + 4], x[8 * s2 + 5]); p.w = cvtpk(x[8 * s2 + 6], x[8 * s2 + 7]); return __builtin_bit_cast(bf16x8v, p); }
__device__ __forceinline__ int tr32_off(int lane, int c, int ks, int t) { const int h = lane >> 5, blk = (lane >> 4) & 1, q = (lane & 15) >> 2, p = lane & 3; return img_off(16 * ks + 8 * h + 4 * t + q, 4 * c + 2 * blk + (p >> 1)) + 8 * (p & 1); }
__device__ __forceinline__ bf16x8v tr32_frag(const LAS unsigned char* img, int lane, int c, int ks) { const s16x4v lo = tr_read(img + tr32_off(lane, c, ks, 0)), hi = tr_read(img + tr32_off(lane, c, ks, 1)); return __builtin_shufflevector(lo, hi, 0, 1, 2, 3, 4, 5, 6, 7); }
constexpr int M3_DEN = M2_DEN  , M3_SSQ = M2_SSQ  ;

__device__ __forceinline__ void mlstm_unit_v3(LAS unsigned char* L, const MixPtrs& P, int b, int hh, int tid_in) {
    int tid_l = tid_in; asm volatile("" : "+v"(tid_l));
    const int tid = tid_l, lane = tid & 63, w = __builtin_amdgcn_readfirstlane(tid >> 6);
    const size_t rb = (size_t)b * SEQ;
    const bf16* QCp = MP_QC + ((size_t)(b * 4 + hh) * SEQ) * 128; const bf16* KCp = MP_KC2 + ((size_t)(b * 4 + hh) * SEQ) * 128;
    const bf16* Vp = MP_MV + rb * 512 + hh * 128;
    LAS float* DEN = (LAS float*)(L + M3_DEN); LAS float* QN = (LAS float*)(L + M2_QN); LAS float* NV = (LAS float*)(L + M2_N); LAS float* SSQ = (LAS float*)(L + M3_SSQ);
    LAS float* SA = (LAS float*)(L + M2_A); LAS float* SPM = (LAS float*)(L + M2_PM); LAS float* SF = (LAS float*)(L + M2_F);
    LAS float* SBL = (LAS float*)(L + M2_BL); LAS float* SAMX = (LAS float*)(L + M2_AMX); LAS float* SMC = (LAS float*)(L + M2_MC);
    float zf = 0.f; asm volatile("" : "+v"(zf));
    const bool isCD = w < 4; const int jw = w & 3;
    f32x16 Cacc[4]; bf16x8v vfk[4];
#pragma unroll
    for (int i = 0; i < 4; ++i) { vfk[i] = (bf16x8v){0, 0, 0, 0, 0, 0, 0, 0};
#pragma unroll
        for (int e = 0; e < 16; ++e) Cacc[i][e] = zf; }
    const int r0s = tid >> 4, c0s = tid & 15, so0 = img_off(r0s, c0s), so1 = img_off(r0s + 32, c0s);
    v4u sq0, sq1, sk0, sk1, sv0, sv1;
    sq0 = *(const v4u*)(QCp + (size_t)r0s * 128 + c0s * 8); sq1 = *(const v4u*)(QCp + (size_t)(r0s + 32) * 128 + c0s * 8);
    sk0 = *(const v4u*)(KCp + (size_t)r0s * 128 + c0s * 8); sk1 = *(const v4u*)(KCp + (size_t)(r0s + 32) * 128 + c0s * 8);
    sv0 = *(const v4u*)(Vp + (size_t)r0s * 512 + c0s * 8);  sv1 = *(const v4u*)(Vp + (size_t)(r0s + 32) * 512 + c0s * 8);
    LBAR();
    { const float ib = P.i_bias[hh], fb = P.f_bias[hh]; const float* Gp = MP_GATE + rb * 32 + hh;
#pragma unroll 1
      for (int cc = w; cc < 32; cc += 8) { const int tk = 64 * cc + lane;
          const float il = Gp[(size_t)tk * 32 + 24] + ib, fx = Gp[(size_t)tk * 32 + 28] + fb; const float fl = fminf(fx, 0.f) - log1pf(__expf(-fabsf(fx)));
          float f = fl;
#pragma unroll
          for (int o = 1; o < 64; o <<= 1) { const float v = shi(f, lane - o); if (lane >= o) f += v; }
          const float a = il - f; float pm = a;
#pragma unroll
          for (int o = 1; o < 64; o <<= 1) { const float v = shi(pm, lane - o); if (lane >= o) pm = fmaxf(pm, v); }
          SA[tk] = a; SPM[tk] = pm; SF[tk] = f; if (lane == 63) { SBL[cc] = f; SAMX[cc] = pm; } } }
    *(LAS v4u*)(L + M2_IMG + so0) = sq0; *(LAS v4u*)(L + M2_IMG + so1) = sq1; *(LAS v4u*)(L + M2_IMG + 16384 + so0) = sk0; *(LAS v4u*)(L + M2_IMG + 16384 + so1) = sk1;
    *(LAS v4u*)(L + M2_IMG + 32768 + so0) = sv0; *(LAS v4u*)(L + M2_IMG + 32768 + so1) = sv1;
    if (tid < 128) NV[tid] = zf;
    LBAR();
    if (tid == 0) { float mcar = zf; for (int cc = 0; cc < 32; ++cc) { SMC[cc] = mcar; mcar = SBL[cc] + fmaxf(mcar, SAMX[cc]); } }
    LBAR();
    f32x16 hv[2];
    hv[0] = Cacc[0]; hv[1] = Cacc[0];
#pragma unroll 1
    for (int c = 0; c < 32; ++c) {
        int lc = lane; asm volatile("" : "+v"(lc));
        const int r32 = lc & 31, hi = lc >> 5;
        const int t0 = c * 64; const LAS unsigned char* Qi = L + M2_IMG + (c & 1) * 49152; const LAS unsigned char* Ki = Qi + 16384; const LAS unsigned char* Vi = Qi + 32768;
        const LAS unsigned char* Kp = L + M2_IMG + ((c + 1) & 1) * 49152 + 16384;
        if (c + 1 < 32) { const int tn = t0 + 64;
            sq0 = *(const v4u*)(QCp + (size_t)(tn + r0s) * 128 + c0s * 8); sq1 = *(const v4u*)(QCp + (size_t)(tn + r0s + 32) * 128 + c0s * 8);
            sk0 = *(const v4u*)(KCp + (size_t)(tn + r0s) * 128 + c0s * 8); sk1 = *(const v4u*)(KCp + (size_t)(tn + r0s + 32) * 128 + c0s * 8);
            sv0 = *(const v4u*)(Vp + (size_t)(tn + r0s) * 512 + c0s * 8);  sv1 = *(const v4u*)(Vp + (size_t)(tn + r0s + 32) * 512 + c0s * 8); }
        const float mc = SMC[c];
        if (isCD) {
            if (c > 0) { const int t0p = t0 - 64; const float mcp = SMC[c - 1], mxap = fmaxf(mcp, SAMX[c - 1]); const float csp = __expf(mcp - mxap);
                bf16x8v vfp[4];
#pragma unroll
                for (int ks = 0; ks < 4; ++ks) { const f32x4 a0 = *(const LAS f32x4*)(SA + t0p + 16 * ks + 8 * hi), a1 = *(const LAS f32x4*)(SA + t0p + 16 * ks + 8 * hi + 4);
                    const float wk[8] = {__expf(a0.x - mxap), __expf(a0.y - mxap), __expf(a0.z - mxap), __expf(a0.w - mxap), __expf(a1.x - mxap), __expf(a1.y - mxap), __expf(a1.z - mxap), __expf(a1.w - mxap)};
                    const v4u vu = __builtin_bit_cast(v4u, vfk[ks]); v4u o4;
                    o4.x = cvtpk(bflo(vu.x) * wk[0], bfhi(vu.x) * wk[1]); o4.y = cvtpk(bflo(vu.y) * wk[2], bfhi(vu.y) * wk[3]); o4.z = cvtpk(bflo(vu.z) * wk[4], bfhi(vu.z) * wk[5]); o4.w = cvtpk(bflo(vu.w) * wk[6], bfhi(vu.w) * wk[7]);
                    vfp[ks] = __builtin_bit_cast(bf16x8v, o4); }
#pragma unroll
                for (int dt = 0; dt < 4; ++dt) { bf16x8v kf[4];
#pragma unroll
                    for (int ks = 0; ks < 4; ++ks) kf[ks] = tr32_frag(Kp, lc, dt, ks);
                    SBAR();
#pragma unroll
                    for (int e = 0; e < 16; ++e) Cacc[dt][e] *= csp;
#pragma unroll
                    for (int ks = 0; ks < 4; ++ks) Cacc[dt] = MFMA32(kf[ks], vfp[ks], Cacc[dt]);
                    SBAR(); } }
        } else if (jw != 2) {
            const int st = (jw == 3) ? 1 : 0, tt = (jw == 0) ? 0 : 1; const int t = 32 * tt + r32;
            const float Mt = fmaxf(SPM[t0 + t], mc);
            f32x4 as4[4];
#pragma unroll
            for (int g = 0; g < 4; ++g) as4[g] = *(const LAS f32x4*)(SA + t0 + 32 * st + 8 * g + 4 * hi);
            f32x16 acc;
#pragma unroll
            for (int e = 0; e < 16; ++e) acc[e] = 0.f;
#pragma unroll
            for (int kh = 0; kh < 2; ++kh) { bf16x8v ka[4], qb[4];
#pragma unroll
                for (int k4 = 0; k4 < 4; ++k4) { const int ks = 4 * kh + k4; ka[k4] = *(const LAS bf16x8v*)(Ki + img_off(32 * st + r32, 2 * ks + hi)); qb[k4] = *(const LAS bf16x8v*)(Qi + img_off(t, 2 * ks + hi)); }
                SBAR();
#pragma unroll
                for (int k4 = 0; k4 < 4; ++k4) acc = MFMA32(ka[k4], qb[k4], acc);
                SBAR(); }
            float rp = 0.f;
#pragma unroll
            for (int g = 0; g < 4; ++g) { float v[4];
#pragma unroll
                for (int e = 0; e < 4; ++e) { const float x = acc[4 * g + e] * __expf(as4[g][e] - Mt); v[e] = (st == tt && (8 * g + 4 * hi + e) > r32) ? 0.f : x; rp += v[e]; }
                v2u wv; wv.x = cvtpk(v[0], v[1]); wv.y = cvtpk(v[2], v[3]);
                *(LAS v2u*)(L + M2_SC + t * 128 + (((4 * st + g) ^ (t & 7)) << 4) + 8 * hi) = wv; }
            rp = xor32_sum(rp);
            if (hi == 0) DEN[st * 64 + t] = rp;
        } else {
            { const v4u z4 = {0u, 0u, 0u, 0u};
              *(LAS v4u*)(L + M2_SC + r32 * 128 + (((4 + 2 * hi) ^ (r32 & 7)) << 4)) = z4; *(LAS v4u*)(L + M2_SC + r32 * 128 + (((5 + 2 * hi) ^ (r32 & 7)) << 4)) = z4;
              if (hi == 0) DEN[64 + r32] = 0.f; }
            float qn = 0.f;
#pragma unroll 4
            for (int ch = 0; ch < 16; ++ch) { const v4u q8 = *(const LAS v4u*)(Qi + img_off(lc, ch)); const f32x4 n0 = *(const LAS f32x4*)(NV + 8 * ch), n1 = *(const LAS f32x4*)(NV + 8 * ch + 4);
                qn += bflo(q8.x) * n0.x + bfhi(q8.x) * n0.y + bflo(q8.y) * n0.z + bfhi(q8.y) * n0.w + bflo(q8.z) * n1.x + bfhi(q8.z) * n1.y + bflo(q8.w) * n1.z + bfhi(q8.w) * n1.w; }
            QN[lc] = qn;
            const float mxa = fmaxf(mc, SAMX[c]), cs = __expf(mc - mxa); const float wkl = __expf(SA[t0 + lc] - mxa);
            const f32x2v nold = *(const LAS f32x2v*)(NV + 2 * lc); float n0a = 0.f, n1a = 0.f;
#pragma unroll
            for (int s = 0; s < 64; ++s) { const unsigned kk = *(const LAS unsigned*)(Ki + img_off(s, lc >> 2) + (lc & 3) * 4); const float ws = __builtin_bit_cast(float, __builtin_amdgcn_readlane(__builtin_bit_cast(int, wkl), s)); n0a += ws * bflo(kk); n1a += ws * bfhi(kk); }
            LDS_WAIT();
            *(LAS f32x2v*)(NV + 2 * lc) = (f32x2v){cs * nold.x + n0a, cs * nold.y + n1a};
        }
        LBAR();
        v2u og[2][4];
        if (isCD) {
#pragma unroll
            for (int ks = 0; ks < 4; ++ks) vfk[ks] = tr32_frag(Vi, lc, jw, ks);
#pragma unroll
            for (int tt = 0; tt < 2; ++tt) { const int t = 32 * tt + r32;
                bf16x8v scf[4];
#pragma unroll
                for (int ks = 0; ks < 4; ++ks) scf[ks] = *(const LAS bf16x8v*)(L + M2_SC + t * 128 + (((2 * ks + hi) ^ (t & 7)) << 4));
                const float pmt = SPM[t0 + t], ft = SF[t0 + t], dnp = DEN[t] + DEN[64 + t], qnt = QN[t];
                f32x16 a1, a2;
#pragma unroll
                for (int e = 0; e < 16; ++e) { a1[e] = 0.f; a2[e] = 0.f; }
#pragma unroll
                for (int kh = 0; kh < 2; ++kh) { v2u ql[4], qh[4];
#pragma unroll
                    for (int k4 = 0; k4 < 4; ++k4) { const int k8 = 4 * kh + k4; ql[k4] = *(const LAS v2u*)(Qi + img_off(t, 2 * k8) + 8 * hi); qh[k4] = *(const LAS v2u*)(Qi + img_off(t, 2 * k8 + 1) + 8 * hi); }
                    SBAR();
                    if (kh == 0) {
#pragma unroll
                        for (int ks = 0; ks < 4; ++ks) a1 = MFMA32(vfk[ks], scf[ks], a1); }
#pragma unroll
                    for (int k4 = 0; k4 < 4; ++k4) { const int k8 = 4 * kh + k4; v4u qq; qq.x = ql[k4].x; qq.y = ql[k4].y; qq.z = qh[k4].x; qq.w = qh[k4].y; a2 = MFMA32(pack8(Cacc[k8 >> 1], k8 & 1), __builtin_bit_cast(bf16x8v, qq), a2); }
                    SBAR(); }
                const float Mt = fmaxf(pmt, mc), wp = __expf(mc - Mt), emt = __expf(-ft - Mt);
                const float idn = __builtin_amdgcn_rcpf(fmaxf(fabsf(dnp + wp * qnt), emt));
                float ss = 0.f;
#pragma unroll
                for (int e = 0; e < 16; ++e) { const float x = (a1[e] + a2[e] * wp) * idn; hv[tt][e] = x; ss += x * x; }
                ss = xor32_sum(ss);
                if (hi == 0) SSQ[((c & 1) * 4 + jw) * 64 + t] = ss;
                SBAR(); }
            { const bf16* Op = MP_MO + rb * 512 + hh * 128 + 32 * jw + 4 * hi;
#pragma unroll
              for (int tt = 0; tt < 2; ++tt)
#pragma unroll
                  for (int g = 0; g < 4; ++g) og[tt][g] = *(const v2u*)(Op + (size_t)(t0 + 32 * tt + r32) * 512 + 8 * g); }
        }
        if (c + 1 < 32) { LAS unsigned char* Nx = L + M2_IMG + ((c + 1) & 1) * 49152;
            *(LAS v4u*)(Nx + so0) = sq0; *(LAS v4u*)(Nx + so1) = sq1; *(LAS v4u*)(Nx + 16384 + so0) = sk0; *(LAS v4u*)(Nx + 16384 + so1) = sk1; *(LAS v4u*)(Nx + 32768 + so0) = sv0; *(LAS v4u*)(Nx + 32768 + so1) = sv1; }
        LBAR();
        if (isCD) {
            bf16* Yp = MP_Y + rb * DM + 512 + hh * 128 + 32 * jw + 4 * hi; const float* gnp = P.mnorm_g + hh * 128 + 32 * jw + 4 * hi;
            f32x4 gn4[4];
#pragma unroll
            for (int g = 0; g < 4; ++g) gn4[g] = *(const f32x4*)(gnp + 8 * g);
#pragma unroll
            for (int tt = 0; tt < 2; ++tt) { const int t = 32 * tt + r32; const LAS float* sp = SSQ + (c & 1) * 256 + t;
                const float rn = __frsqrt_rn(((sp[0] + sp[64]) + (sp[128] + sp[192])) * (1.f / 128.f) + EPS);
#pragma unroll
                for (int g = 0; g < 4; ++g) { const float y0 = hv[tt][4 * g] * rn * gn4[g].x * sigmoidf_(bflo(og[tt][g].x)), y1 = hv[tt][4 * g + 1] * rn * gn4[g].y * sigmoidf_(bfhi(og[tt][g].x));
                    const float y2 = hv[tt][4 * g + 2] * rn * gn4[g].z * sigmoidf_(bflo(og[tt][g].y)), y3 = hv[tt][4 * g + 3] * rn * gn4[g].w * sigmoidf_(bfhi(og[tt][g].y));
                    v2u wv; wv.x = cvtpk(y0, y1); wv.y = cvtpk(y2, y3);
                    *(v2u*)(Yp + (size_t)(t0 + t) * DM + 8 * g) = wv; } }
        }
    }
    LBAR();
}

#ifndef MK_MULTI
#define MK_MULTI 0
#endif
#define REP_IF(k) for (int rep_ = 0; rep_ < ((PROBE_DUP == (k)) ? 2 : 1); ++rep_)
constexpr int PH_PER_LAYER = 8, N_PHASES = 1 + DEPTH * PH_PER_LAYER;
struct Args { const float* in[16]; float* out; unsigned char* ws; int ph_lo, ph_hi; };
static_assert(sizeof(Args) == 16 * 8 + 8 + 8 + 8, "Args has no padding");

__global__ void __launch_bounds__(NWAVES * 64, 2) fwd_kernel(Args args) {
    extern __shared__ __attribute__((aligned(16))) unsigned char lds_raw[];
    LAS unsigned char* L = (LAS unsigned char*)lds_raw;
    const int G0 = gridDim.x, blk0 = blockIdx.x;
    const int wave0 = __builtin_amdgcn_readfirstlane((int)threadIdx.x >> 6);
#define PH_IDS() PH_WS(); int wave = wave0; asm volatile("" : "+s"(wave)); const int lane = fresh_lane(), tid = wave * 64 + lane, gw = blk * NWAVES + wave; (void)gw
#define PH_WS() size_t zoff_ = 0; asm volatile("" : "+s"(zoff_)); unsigned char* ws = (unsigned char*)__builtin_assume_aligned(args.ws, 256) + zoff_; int blk = blk0, G = G0; asm volatile("" : "+s"(blk), "+s"(G)); const int NGW = G * NWAVES; (void)NGW; bf16* X16 = (bf16*)(ws + WS_X16); float* SS2 = (float*)(ws + WS_TAB + TAB_SS2); bf16* U = (bf16*)(ws + WS_U); bf16* HB = (bf16*)(ws + WS_HB); bf16* HD = (bf16*)(ws + WS_HD); \
    unsigned char* wl = ws + WS_W; const float* ng = args.in[1] + (size_t)l_ * 6 * DM; (void)X16; (void)SS2; (void)U; (void)HB; (void)HD; (void)wl; (void)ng
    unsigned char* ws0 = args.ws;
    volatile LAS unsigned* MISC = (volatile LAS unsigned*)(L + MISC_OFF);
    { const int tid_e = wave0 * 64 + fresh_lane(); if (tid_e < 16) MISC[tid_e] = 0u; if (tid_e >= 64 && tid_e < 80) MISC[tid_e] = 0u; if (tid_e >= 208 && tid_e < 216) MISC[tid_e] = 0u; if (tid_e >= 144 && tid_e < 158) MISC[tid_e] = 0u; }
    __syncthreads();
    XcdBarrier bar; bar.bar = (unsigned*)(ws0 + WS_CTL) + CW_BAR; bar.x = 0; bar.st = nullptr;
    if (!MK_MULTI) bar = xcd_barrier_post((unsigned*)(ws0 + WS_CTL) + CW_BAR, MISC + 8, wave0 * 64 + fresh_lane() == 0);
#if PROBE_SC >= 6
    if (blk0 == 0 && wave0 * 64 + fresh_lane() == 0) { MISC[159] = (unsigned)__builtin_amdgcn_s_memrealtime(); MISC[158] = MISC[159]; }
#endif
    const int lo = args.ph_lo, hi = args.ph_hi;
#define IN(k) (lo <= (k) && (k) < hi)
#if PROBE_SC == 30 || PROBE_SC == 31
#define SEAM(k) do { const unsigned bt0_ = (unsigned)__builtin_amdgcn_s_memrealtime(); if (IN(k) && IN((k) + 1)) xcd_barrier(bar, wave0 * 64 + fresh_lane() == 0); \
    if (blk0 == PROBE_BLK && wave0 * 64 + fresh_lane() == 0) { const unsigned dt_ = (unsigned)__builtin_amdgcn_s_memrealtime() - bt0_; MISC[150] += dt_; if ((k) == 5) MISC[151] = dt_; if ((k) == 13) MISC[152] = dt_; } } while (0)
#elif PROBE_SC >= 6
#define SEAM(k) do { if (IN(k) && IN((k) + 1)) xcd_barrier(bar, wave0 * 64 + fresh_lane() == 0); \
    if (blk0 == 0 && wave0 * 64 + fresh_lane() == 0) { const unsigned now_ = (unsigned)__builtin_amdgcn_s_memrealtime(); MISC[160 + (k)] = now_ - MISC[159]; MISC[159] = now_; } } while (0)
#else
#define SEAM(k) do { if (IN(k) && IN((k) + 1)) xcd_barrier(bar, wave0 * 64 + fresh_lane() == 0); } while (0)
#endif

    REP_IF(5) {
    if (IN(0)) {
        const int l_ = 0; PH_IDS();
        const float* x_in = args.in[0]; float* b1T = (float*)(ws + WS_TAB + TAB_B1);
#define CONVERT_WEIGHTS(lw, GM) do { LAS float* scr = (LAS float*)(L + wave * 16384); const float* ngw = args.in[1] + (size_t)(lw) * 6 * DM; \
        constexpr int I_GU = 16 * 176, I_DN = 44 * 32, I_IN = 16 * 112, I_OUT = 16 * 32, I_CMP = 16 * 16, I_LAYER = 2 * I_GU + 2 * I_DN + I_IN + I_OUT + I_CMP; \
        for (int it = gw; it < I_LAYER; it += NGW) { int r = it; unsigned char* wlw = ws + WS_W; \
            if (r < I_GU) { if ((GM) & 1) { SrcGU s{args.in[2] + (size_t)(lw) * DM * NGU, ngw + 0 * DM}; transpose_item(s, DM, (bf16*)(wlw + WO_GU1), scr, r / 176, r % 176, lane); } continue; } r -= I_GU; \
            if (r < I_DN) { if ((GM) & 2) { SrcPlain s{args.in[3] + (size_t)(lw) * FF * DM, DM, nullptr}; transpose_item(s, FF, (bf16*)(wlw + WO_DN1), scr, r / 32, r % 32, lane); } continue; } r -= I_DN; \
            if (r < I_GU) { if ((GM) & 4) { SrcGU s{args.in[4] + (size_t)(lw) * DM * NGU, ngw + 4 * DM}; transpose_item(s, DM, (bf16*)(wlw + WO_GU2), scr, r / 176, r % 176, lane); } continue; } r -= I_GU; \
            if (r < I_DN) { if ((GM) & 8) { SrcPlain s{args.in[5] + (size_t)(lw) * FF * DM, DM, nullptr}; transpose_item(s, FF, (bf16*)(wlw + WO_DN2), scr, r / 32, r % 32, lane); } continue; } r -= I_DN; \
            if (r < I_IN) { if ((GM) & 16) { SrcIN s{args.in[6] + (size_t)(lw) * DM * INCOLS, ngw + 2 * DM}; transpose_item(s, DM, (bf16*)(wlw + WO_IN), scr, r / 112, r % 112, lane); } continue; } r -= I_IN; \
            if (r < I_OUT) { if ((GM) & 32) { SrcPlain s{args.in[7] + (size_t)(lw) * DM * DM, DM, nullptr}; transpose_item(s, DM, (bf16*)(wlw + WO_OUT), scr, r / 32, r % 32, lane); } continue; } r -= I_OUT; \
            if ((GM) & 64) { SrcCMP s{args.in[9] + (size_t)(lw) * 2 * 2048 * 128, nullptr}; transpose_item(s, DM, (bf16*)(ws + WS_CMPW + (size_t)(lw) * MiB), scr, r / 16, r % 16, lane); } } } while (0)
        CONVERT_WEIGHTS(0, 0x7f);
        if (DEPTH > 1) CONVERT_WEIGHTS(1, 0x40);
        { bf16* w2t = (bf16*)(ws + WS_TAB + TAB_W2T);
          for (int i = blk * 512 + tid; i < DEPTH * 2 * 64 * 128; i += G * 512) { const int lk = i >> 13, o = (i >> 7) & 63, kk = i & 127; w2t[i] = (bf16)f2bf(args.in[10][((size_t)lk * 128 + kk) * 64 + o]); } }
        { LAS float* part = (LAS float*)(L + 131072);
          for (int ob = blk; ob < DEPTH * 2 * 128 / 2; ob += G) { const int o = 2 * ob + (wave >> 2), qr = wave & 3; const int lk = o >> 7, c = o & 127;
              const float* pe = args.in[8] + (size_t)lk * 2048; const float* w1 = args.in[9] + (size_t)lk * 2048 * 128;
              float s = 0.f; for (int r = qr * 512 + lane; r < qr * 512 + 512; r += 64) s += pe[r] * w1[(size_t)r * 128 + c];
              s = wave_sum(s, lane); if (lane == 0) part[wave] = s;
              __syncthreads();
              if (lane == 0 && qr == 0) b1T[o] = (part[wave] + part[wave + 1]) + (part[wave + 2] + part[wave + 3]);
              __syncthreads(); } }
        thin_phase<0>(nullptr, x_in, X16, nullptr, SS2, nullptr, 0.f, gw, NGW, lane);
    }
    SEAM(0);
    }

#pragma unroll 1
    for (int l = 0; l < DEPTH; ++l) {
        const int pb = 1 + l * PH_PER_LAYER, l_ = l;
        REP_IF(1) {
        if (IN(pb + 0)) { PH_IDS(); pg8::Gemm g{X16, (const bf16*)(wl + WO_GU1), MTOK, NGU, DM}; pg8::StaticOrder S; S.init(MTOK, NGU, G, blk); EpiSwiglu E{HB, SS2, L + 131072};
#if PROBE_SC == 1 || PROBE_SC == 2
            if (l_ == 0) pg8::gemm_phase<EpiSwiglu, pg8::StaticOrder, true, true, 1>(L, g, S, E, tid); else
#endif
#if PROBE_SC >= 3
            const unsigned long long pt0 = __builtin_amdgcn_s_memrealtime();
#endif
            pg8::gemm_phase<EpiSwiglu, pg8::StaticOrder, GU_ALIGN, true>(L, g, S, E, tid);
#if PROBE_SC == 3
            if (l_ == 0 && tid == 0) { MISC[64] = (unsigned)(__builtin_amdgcn_s_memrealtime() - pt0); }
#endif
#if PROBE_SC == 4 || PROBE_SC == 5
            if (l_ == 0 && tid == 0) { const unsigned sp = (unsigned)(__builtin_amdgcn_s_memrealtime() - pt0); atomicMax((unsigned*)(ws + WS_CTL) + 33024, (sp << 8) | (unsigned)blk); }
#endif
            }
        SEAM(pb + 0);
        }
        if (IN(pb + 1)) { PH_IDS(); pg8::Gemm g{HB, (const bf16*)(wl + WO_DN1), MTOK, DM, FF}; pg8::StaticOrder S; S.init(MTOK, DM, G, blk);
            EpiResNorm<false> E{ws, (LAS float*)(L + 131072), ng + 1 * DM, nullptr, 0.5f, l_ * 3 + 0};
#if PROBE_SC == 21
            const unsigned pt1 = (unsigned)__builtin_amdgcn_s_memrealtime();
            if (l_ == 0) pg8::gemm_phase<EpiResNorm<false>, pg8::StaticOrder, true, true, 1>(L, g, S, E, tid); else
#endif
            pg8::gemm_phase<EpiResNorm<false>, pg8::StaticOrder, true, true>(L, g, S, E, tid);
#if PROBE_SC == 21
            if (l_ == 0 && tid == 0) MISC[66] = (unsigned)__builtin_amdgcn_s_memrealtime() - pt1;
#endif
            }
        SEAM(pb + 1);
        REP_IF(3) {
        if (IN(pb + 2)) { PH_IDS(); pg8::Gemm g{X16, (const bf16*)(wl + WO_IN), MTOK, NINP, DM}; pg8::StaticOrder S; S.init(MTOK, NINP, G, blk);
            EpiInProj E{ws, L + 131072};
#if PROBE_SC == 23
            const unsigned pt1 = (unsigned)__builtin_amdgcn_s_memrealtime();
            if (l_ == 0) pg8::gemm_phase<EpiInProj, pg8::StaticOrder, true, true, 1>(L, g, S, E, tid); else
#endif
            pg8::gemm_phase<EpiInProj, pg8::StaticOrder, true, true>(L, g, S, E, tid);
#if PROBE_SC == 23
            if (l_ == 0 && tid == 0) MISC[66] = (unsigned)__builtin_amdgcn_s_memrealtime() - pt1;
#endif
            }
        SEAM(pb + 2);
        }
        if (IN(pb + 4)) {
            PH_IDS();
            MixPtrs P{ws, args.in[11] + (size_t)l * 4 * 1024, args.in[12] + (size_t)l * 1024, args.in[13] + l * 4, args.in[14] + l * 4, args.in[15] + l * 512};
            unsigned* cflag = (unsigned*)(ws + WS_CTL) + CW_CFLAG + 1024 * l_;
            if (blk < 64 || blk >= 96) {
                const int cb = blk < 64 ? blk : blk - 32;
                mlstm_conv_pass(ws, P.conv_w, P.conv_b, cb * 512 + tid, 224 * 512);
                asm volatile("s_waitcnt vmcnt(0)" ::: "memory"); __syncthreads();
                if (tid == 0) { __builtin_amdgcn_fence(__ATOMIC_RELEASE, "agent"); asm volatile("s_waitcnt vmcnt(0)" ::: "memory");
                    (void)__hip_atomic_fetch_add(cflag + 64 * 15 + 32, 1u, __ATOMIC_RELAXED, __HIP_MEMORY_SCOPE_AGENT); }
            }
            if (blk < 64) {
                if (tid == 0) { unsigned sp = 0u; while (__hip_atomic_load(cflag + 64 * 15 + 32, __ATOMIC_RELAXED, __HIP_MEMORY_SCOPE_AGENT) < 224u) { __builtin_amdgcn_s_sleep(4); if (++sp > (1u << 17)) break; } }
                __syncthreads();
                __builtin_amdgcn_fence(__ATOMIC_ACQUIRE, "agent"); asm volatile("s_waitcnt vmcnt(0)" ::: "memory");
                mlstm_unit_v3(L, P, blk >> 2, blk & 3, tid);
            } else if (blk < 96) {
                pg8::Gemm g{(const bf16*)(ws + WS_KCR), (const bf16*)(ws + WS_CMPW + (size_t)l_ * MiB), 8192, 512, DM}; CmpOrder S{blk - 64, G};
                EpiCmpMlp E{ws, (const float*)(ws + WS_TAB + TAB_B1) + l_ * 2 * 128, (const bf16*)(ws + WS_TAB + TAB_W2T) + (size_t)l_ * 2 * 64 * 128};
                pg8::gemm_phase<EpiCmpMlp, CmpOrder, false, true>(L, g, S, E, tid);
                asm volatile("s_waitcnt vmcnt(0)" ::: "memory"); __syncthreads();
                if (tid == 0) { __builtin_amdgcn_fence(__ATOMIC_RELEASE, "agent"); asm volatile("s_waitcnt vmcnt(0)" ::: "memory");
                    (void)__hip_atomic_fetch_add(cflag + 64 * ((blk - 64) & 15), 1u, __ATOMIC_RELAXED, __HIP_MEMORY_SCOPE_AGENT); }
            } else {
                const int gw = (blk - 96) * NWAVES + wave, NGW = (G - 96) * NWAVES;
                if (l_ == 0) { if (DEPTH > 1) CONVERT_WEIGHTS(1, 0x13); } else CONVERT_WEIGHTS(l_, 0x2c);
            }
            { unsigned* qbase = (unsigned*)(ws + WS_CTL) + CW_QUEUE + 1024 * l_; volatile LAS unsigned* QW = (volatile LAS unsigned*)(L + MISC_OFF);
              const unsigned q0 = xb_xcc_id() & 7u; unsigned rdy = 0u;
#pragma unroll 1
              for (unsigned qq = 0; qq < 8u; ++qq) { unsigned* qctr = qbase + 64 * ((q0 + qq) & 7u); const int bg0 = 4 * (int)((q0 + qq) & 7u);
                  __syncthreads();
                  if (tid == 0) QW[0] = __hip_atomic_fetch_add(qctr, 1u, __ATOMIC_RELAXED, __HIP_MEMORY_SCOPE_AGENT);
                  __syncthreads();
                  unsigned u = QW[0];
                  while (u < 128u) { unsigned nxt = 0u; if (tid == 0) nxt = __hip_atomic_fetch_add(qctr, 1u, __ATOMIC_RELAXED, __HIP_MEMORY_SCOPE_AGENT);
                      const int c = 31 - (int)(u >> 2), bg = bg0 + (int)(u & 3u);
                      if (!((rdy >> (bg >> 1)) & 1u)) {
                          if (tid == 0) { unsigned sp = 0u; while (__hip_atomic_load(cflag + 64 * (bg >> 1), __ATOMIC_RELAXED, __HIP_MEMORY_SCOPE_AGENT) < 2u) { __builtin_amdgcn_s_sleep(4); if (++sp > (1u << 17)) break; } }
                          __syncthreads();
                          __builtin_amdgcn_fence(__ATOMIC_ACQUIRE, "agent"); asm volatile("s_waitcnt vmcnt(0)" ::: "memory");
                          rdy |= 1u << (bg >> 1); }
#if PROBE_SC == 22
                      const unsigned ut0_ = (unsigned)__builtin_amdgcn_s_memrealtime();
#endif
                      nsa_unit_v3(L, P, bg >> 1, bg & 1, c, tid);
#if PROBE_SC == 22
                      if (tid == 0) { MISC[212] += (unsigned)__builtin_amdgcn_s_memrealtime() - ut0_; MISC[213] += 1u; }
#endif
                      __syncthreads(); if (tid == 0) QW[0] = nxt; __syncthreads(); u = QW[0]; } } }
        }
#if PROBE_SC == 22
        if (l == 0 && blk0 == 255 && wave0 * 64 + fresh_lane() == 0) { unsigned* pw_ = (unsigned*)(ws0 + WS_CTL) + 33100;
            for (int i_ = 0; i_ < 4; ++i_) __hip_atomic_store(pw_ + i_, MISC[210 + i_], __ATOMIC_RELAXED, __HIP_MEMORY_SCOPE_AGENT); }
#endif
        SEAM(pb + 4);
        if (IN(pb + 5)) { PH_IDS(); pg8::Gemm g{U, (const bf16*)(wl + WO_OUT), MTOK, DM, DM}; pg8::StaticOrder S; S.init(MTOK, DM, G, blk);
            EpiResNorm<false> E{ws, (LAS float*)(L + 131072), ng + 3 * DM, nullptr, 1.0f, l_ * 3 + 1};
            pg8::gemm_phase<EpiResNorm<false>, pg8::StaticOrder, true, true>(L, g, S, E, tid); }
        SEAM(pb + 5);
        if (IN(pb + 6)) { PH_IDS(); pg8::Gemm g{X16, (const bf16*)(wl + WO_GU2), MTOK, NGU, DM}; pg8::StaticOrder S; S.init(MTOK, NGU, G, blk); EpiSwiglu E{HB, SS2, L + 131072};
            pg8::gemm_phase<EpiSwiglu, pg8::StaticOrder, GU_ALIGN, true>(L, g, S, E, tid); }
        SEAM(pb + 6);
        if (IN(pb + 7)) { PH_IDS(); pg8::Gemm g{HB, (const bf16*)(wl + WO_DN2), MTOK, DM, FF}; pg8::StaticOrder S; S.init(MTOK, DM, G, blk);
            if (l + 1 < DEPTH) { EpiResNorm<false> E{ws, (LAS float*)(L + 131072), ng + 5 * DM, nullptr, 0.5f, l_ * 3 + 2};
                pg8::gemm_phase<EpiResNorm<false>, pg8::StaticOrder, true, true>(L, g, S, E, tid); }
#if FINAL_FUSED
            else { EpiResNorm<true> E{ws, (LAS float*)(L + 131072), ng + 5 * DM, args.out, 0.5f, l_ * 3 + 2};
                pg8::gemm_phase<EpiResNorm<true>, pg8::StaticOrder, true, true>(L, g, S, E, tid); } }
        if (l + 1 < DEPTH) SEAM(pb + 7);
#else
            else { pg8::EpiBf16<0> E{HD, DM, nullptr, 0, 0, 1.f};
                pg8::gemm_phase<pg8::EpiBf16<0>, pg8::StaticOrder, true, true>(L, g, S, E, tid); } }
        if (l + 1 < DEPTH) SEAM(pb + 7);
        else { xcd_barrier(bar, wave0 * 64 + fresh_lane() == 0);
            if (IN(pb + 7)) { PH_IDS(); thin_phase<2>(HD, nullptr, X16, args.out, nullptr, ng + 5 * DM, 0.5f, gw, NGW, lane); } }
#endif
    }
#if PROBE_SC == 30 || PROBE_SC == 31
    if (blk0 == PROBE_BLK && wave0 * 64 + fresh_lane() == 0) { __hip_atomic_store((unsigned*)(args.ws + WS_CTL) + 33101, MISC[151], __ATOMIC_RELAXED, __HIP_MEMORY_SCOPE_AGENT); __hip_atomic_store((unsigned*)(args.ws + WS_CTL) + 33102, MISC[152], __ATOMIC_RELAXED, __HIP_MEMORY_SCOPE_AGENT);
        __hip_atomic_store((unsigned*)(args.ws + WS_CTL) + 33100, MISC[150], __ATOMIC_RELAXED, __HIP_MEMORY_SCOPE_AGENT); }
    if (blk0 == 0 && wave0 * 64 + fresh_lane() == 0) { unsigned sp_ = 0u; while (__hip_atomic_load((unsigned*)(args.ws + WS_CTL) + 33100, __ATOMIC_RELAXED, __HIP_MEMORY_SCOPE_AGENT) == 0u && ++sp_ < (1u << 20)) __builtin_amdgcn_s_sleep(8); }
#endif
#if PROBE_SC
    if (blk0 == 0 && wave0 * 64 + fresh_lane() == 0) {
        unsigned tk = MISC[64], cy = MISC[65];
        if (PROBE_SC == 4 || PROBE_SC == 5) { const unsigned pk = __hip_atomic_load((unsigned*)(args.ws + WS_CTL) + 33024, __ATOMIC_RELAXED, __HIP_MEMORY_SCOPE_AGENT); tk = (PROBE_SC == 4) ? (pk >> 8) : (pk & 255u) * 100u; }
#if PROBE_SC >= 6
        { const unsigned now_ = (unsigned)__builtin_amdgcn_s_memrealtime(); MISC[160 + 16] = now_ - MISC[159]; }
#define D_(k) MISC[160 + (k)]
        unsigned A_ = 0, B_ = 0;
        if (PROBE_SC == 6) { A_ = D_(0); B_ = D_(4) + D_(12); }
        if (PROBE_SC == 7) { A_ = D_(2) + D_(10); B_ = D_(3) + D_(11); }
        if (PROBE_SC == 8) { A_ = (D_(5) + D_(13)) / 2; B_ = D_(6) + D_(14); }
        if (PROBE_SC == 9) { A_ = (D_(7) + D_(15)) / 2; B_ = D_(8) + D_(16); }
        if (PROBE_SC == 10) { A_ = D_(1); B_ = D_(9); }
        if (PROBE_SC == 22) { const unsigned* pw_ = (const unsigned*)(args.ws + WS_CTL) + 33100; unsigned v_[4]; for (int i_ = 0; i_ < 4; ++i_) v_[i_] = __hip_atomic_load(pw_ + i_, __ATOMIC_RELAXED, __HIP_MEMORY_SCOPE_AGENT);
            A_ = (v_[1] ? (v_[0] * 50u) / v_[1] : 0u) * 4u;
            B_ = (v_[3] ? ((v_[2] - v_[0]) * 4u) / v_[3] : 0u) * 4u; }
        if (PROBE_SC == 31) { A_ = __hip_atomic_load((const unsigned*)(args.ws + WS_CTL) + 33101, __ATOMIC_RELAXED, __HIP_MEMORY_SCOPE_AGENT); B_ = __hip_atomic_load((const unsigned*)(args.ws + WS_CTL) + 33102, __ATOMIC_RELAXED, __HIP_MEMORY_SCOPE_AGENT); }
        if (PROBE_SC == 30) { const unsigned v_ = __hip_atomic_load((const unsigned*)(args.ws + WS_CTL) + 33100, __ATOMIC_RELAXED, __HIP_MEMORY_SCOPE_AGENT); A_ = v_; B_ = 0u; }
        if (PROBE_SC == 23) { A_ = MISC[64]; B_ = MISC[66]; }
        if (PROBE_SC == 21) { A_ = MISC[64]; B_ = MISC[66]; }
        if (PROBE_SC == 20) { A_ = MISC[200]; B_ = MISC[201]; }
        if (PROBE_SC == 15) { A_ = D_(3); B_ = D_(11); }
        if (PROBE_SC == 16) { A_ = D_(4); B_ = D_(12); }
        if (PROBE_SC == 17) { A_ = D_(2); B_ = D_(10); }
        if (PROBE_SC == 11) { A_ = D_(8); B_ = D_(16); }
        if (PROBE_SC == 12) { A_ = D_(7); B_ = D_(15); }
        if (PROBE_SC == 13) { A_ = D_(6); B_ = D_(14); }
        if (PROBE_SC == 14) { A_ = D_(5); B_ = D_(13); }
        { unsigned aq = (A_ + 200u) / 400u, bq = (B_ + 200u) / 400u; if (aq > 127u) aq = 127u; if (bq > 127u) bq = 127u; tk = (aq * 128u + bq) * 100u; }
#endif
        const unsigned long long delay = (PROBE_SC != 2) ? (unsigned long long)tk * 10ull : ((unsigned long long)cy * 10000ull) / (tk ? tk : 1u);
#if PROBE_SC >= 6
        while ((unsigned)__builtin_amdgcn_s_memrealtime() - MISC[158] < 500000u + (unsigned)delay) __builtin_amdgcn_s_sleep(8);
#else
        const unsigned long long t0 = __builtin_amdgcn_s_memrealtime();
        while (__builtin_amdgcn_s_memrealtime() - t0 < delay) __builtin_amdgcn_s_sleep(8);
#endif
    }
#endif
#undef IN
#undef SEAM
#undef CONVERT_WEIGHTS
#undef PH_IDS
#undef PH_WS
}

extern "C" void kernel_launch(void* const* d_in, const int* in_sizes, int n_in, void* d_out, int out_size, void* d_ws, size_t ws_size, hipStream_t stream) {
    static int grid = 0;
    if (grid == 0) {
        if (n_in != 16 || in_sizes[0] != MTOK * DM || out_size != MTOK * DM || ws_size < WS_END3) { fprintf(stderr, "kernel_launch: unexpected problem (n_in %d, ws %zu)\n", n_in, ws_size); grid = -1; return; }
        int dev = 0, cus = 0, per_cu = 0;
        if (hipGetDevice(&dev) != hipSuccess || hipDeviceGetAttribute(&cus, hipDeviceAttributeMultiprocessorCount, dev) != hipSuccess) { grid = -1; return; }
        if (hipFuncSetAttribute((const void*)fwd_kernel, hipFuncAttributeMaxDynamicSharedMemorySize, LDS_BYTES) != hipSuccess) { grid = -1; return; }
        if (hipOccupancyMaxActiveBlocksPerMultiprocessor(&per_cu, (const void*)fwd_kernel, NWAVES * 64, LDS_BYTES) != hipSuccess || per_cu < 1) { fprintf(stderr, "kernel_launch: occupancy query says %d\n", per_cu); }
        (void)hipGetLastError();
        grid = cus;
        if (grid != 256) { fprintf(stderr, "kernel_launch: %d CUs (the row-group exchange of the fused post-norm epilogues assumes 256 workgroups: 4 column tiles of a token tile in one round)\n", grid); grid = -1; return; }
    }
    if (grid < 0) return;
    (void)hipMemsetAsync((char*)d_ws + WS_CTL, 0, CTL_ZERO_BYTES, stream);
    Args a{};
    for (int i = 0; i < 16; ++i) a.in[i] = (const float*)d_in[i];
    a.out = (float*)d_out; a.ws = (unsigned char*)d_ws;
#if MK_MULTI
    for (int p = 0; p < N_PHASES; ++p) { a.ph_lo = p; a.ph_hi = p + 1; hipLaunchKernelGGL(fwd_kernel, dim3(grid), dim3(NWAVES * 64), LDS_BYTES, stream, a); }
#else
    a.ph_lo = 0; a.ph_hi = N_PHASES; hipLaunchKernelGGL(fwd_kernel, dim3(grid), dim3(NWAVES * 64), LDS_BYTES, stream, a);
#endif
}
```

```cpp
#include <hip/hip_runtime.h>
#include <cstdio>
#include <cstdint>
#ifndef FINAL_FUSED
#define FINAL_FUSED 1
#endif
#ifndef PROBE_DUP
#define PROBE_DUP 0
#endif
#ifndef GU_ALIGN
#define GU_ALIGN true
#endif
#ifndef EARLY_WB
#define EARLY_WB 0
#endif
#ifndef PROBE_BLK
#define PROBE_BLK 100
#endif
#ifndef PROBE_SC
#define PROBE_SC 0
#endif
namespace pg8 {
#define PG8_LAS __attribute__((address_space(3)))
typedef unsigned short bf16_t;
typedef short bf16x8 __attribute__((ext_vector_type(8)));
typedef float f32x4 __attribute__((ext_vector_type(4)));
typedef unsigned u32x4 __attribute__((ext_vector_type(4)));
constexpr int BM = 256, BK = 64, HALF = 128, HTB = HALF * BK * 2  , STAGE_BYTES = 8 * HTB, NXCD = 8, WGM = 4;

__host__ __device__ __forceinline__ int lds_byte(int r, int c) { const int st = (r >> 4) * 2 + (c >> 5), rr = r & 15, cc = c & 31, ob = rr * 64 + cc * 2; return st * 1024 + (ob ^ (((ob >> 9) & 1) << 5)); }
__host__ __device__ __forceinline__ void stage_rc(int b, int& R, int& C) { const int st = b / 1024, sb = b % 1024, swz = sb ^ (((sb >> 9) & 1) << 5); R = (st >> 1) * 16 + swz / 64; C = (st & 1) * 32 + (swz % 64) / 2; }
__host__ __device__ __forceinline__ int perm32(int rho) { const int n = rho >> 4, i = rho & 15; return 8 * (i >> 2) + 4 * n + (i & 3); }

struct Unit { int pm, pn; };
struct Gemm { const bf16_t* A; const bf16_t* Bt; int M, N, K; };

struct StaticOrder {
    int nM, nN, nwg, G, c;
    __host__ __device__ void init(int M, int N, int G_, int c_) { nM = M / BM; nN = N / BM; nwg = nM * nN; G = G_; c = c_; }
    __host__ __device__ bool next(int i, Unit& u) const {
        const long L = (long)i * G + c; if (L >= nwg) return false;
        int wgid = (int)L; { const int q = nwg / NXCD, r = nwg % NXCD, xcd = wgid % NXCD, off = wgid / NXCD; wgid = (xcd < r ? xcd * (q + 1) : r * (q + 1) + (xcd - r) * q) + off; }
        const int nig = WGM * nN, gid = wgid / nig, fm = gid * WGM, gsz = (nM - fm) < WGM ? (nM - fm) : WGM;
        u.pm = fm + ((wgid % nig) % gsz); u.pn = (wgid % nig) / gsz; return true;
    }
    __device__ __forceinline__ void a_ready(const Unit&) const {}
    __device__ __forceinline__ void done(const Unit&) const {}
};

__device__ __forceinline__ unsigned cvt_pk_bf16(float lo, float hi) { unsigned r; asm volatile("v_cvt_pk_bf16_f32 %0, %1, %2" : "=v"(r) : "v"(lo), "v"(hi)); return r; }
typedef float f32x2 __attribute__((ext_vector_type(2)));
__device__ __forceinline__ f32x2 gelu_pk(f32x2 v) {
    const f32x2 av = __builtin_elementwise_abs(v), d = av * 0.2316418882f + 1.0f;
    f32x2 t; t.x = __builtin_amdgcn_rcpf(d.x); t.y = __builtin_amdgcn_rcpf(d.y);
    f32x2 q = t * 0.5307027145f + (-0.7265760135f); q = q * t + 0.7107068705f; q = q * t + (-0.142248368f); q = q * t + 0.127414796f; q = q * t;
    const f32x2 s = (v * v) * (-0.72134752044f);
    f32x2 e; e.x = __builtin_amdgcn_exp2f(s.x); e.y = __builtin_amdgcn_exp2f(s.y);
    const f32x2 m = v * (q * e), r = v - m;
    f32x2 o; o.x = v.x < 0.f ? m.x : r.x; o.y = v.y < 0.f ? m.y : r.y; return o;
}

template <int ACT  > struct EpiBf16 {
    static constexpr bool PERM = true, AFTER_DRAIN = false, HAS_PRE = false; struct Pre {}; static_assert(ACT == 0 || ACT == 1, "EpiBf16: ACT is 0 (none) or 1 (gelu_pk)");
    bf16_t* O; int ldc; const float* bias; int split_cols; size_t split_stride; float scale0;
    __device__ __forceinline__ void operator()(const f32x4 (&acc)[2][2][4][2], const Unit& u, int wr, int wc, int fr, int fq) const {
        const int row0 = u.pm * BM + wr * 64 + fr; int colt = u.pn * BM; bf16_t* base = O;
        float sc = 1.f; if (split_cols) { const int t = colt / split_cols; base += (size_t)t * split_stride; colt -= t * split_cols; if (t == 0) sc = scale0; }
        const int col0 = colt + wc * 32 + 8 * fq, bcol0 = u.pn * BM + wc * 32 + 8 * fq;
        f32x4 bv[2][2];
#pragma unroll
        for (int bj = 0; bj < 2; ++bj)
#pragma unroll
            for (int n = 0; n < 2; ++n) bv[bj][n] = bias ? *(const f32x4*)(bias + bcol0 + bj * HALF + 4 * n) : (f32x4){0.f, 0.f, 0.f, 0.f};
#pragma unroll
        for (int ai = 0; ai < 2; ++ai)
#pragma unroll
            for (int m = 0; m < 4; ++m) { bf16_t* rowp = base + (size_t)(row0 + ai * HALF + m * 16) * ldc + col0;
#pragma unroll
                for (int bj = 0; bj < 2; ++bj) { f32x4 v0 = acc[ai][bj][m][0] + bv[bj][0], v1 = acc[ai][bj][m][1] + bv[bj][1];
                    if (ACT == 1) { f32x2 a = gelu_pk((f32x2){v0[0], v0[1]}), b = gelu_pk((f32x2){v0[2], v0[3]}), c = gelu_pk((f32x2){v1[0], v1[1]}), d = gelu_pk((f32x2){v1[2], v1[3]});
                        v0 = (f32x4){a.x, a.y, b.x, b.y}; v1 = (f32x4){c.x, c.y, d.x, d.y}; }
                    v0 = v0 * sc; v1 = v1 * sc; u32x4 w; w.x = cvt_pk_bf16(v0[0], v0[1]); w.y = cvt_pk_bf16(v0[2], v0[3]); w.z = cvt_pk_bf16(v1[0], v1[1]); w.w = cvt_pk_bf16(v1[2], v1[3]);
                    *(u32x4*)(rowp + bj * HALF) = w; } }
    }
};
template <class Epi, class Sched, bool ALIGN_EPI = false, bool SP2 = false, int SC = 0>
__device__ __forceinline__ void gemm_phase(PG8_LAS unsigned char* lds, const Gemm g, const Sched& S, const Epi& E, int tid_in) {
    int tid_l = tid_in; asm volatile("" : "+v"(tid_l));
    const int tid = tid_l, wid = __builtin_amdgcn_readfirstlane(tid >> 6), lane = tid & 63, wr = wid >> 2, wc = wid & 3, fr = lane & 15, fq = lane >> 4;
    const int K = g.K, nt = K / BK;
    unsigned voffA[2], voffB[2];
#pragma unroll
    for (int i = 0; i < 2; ++i) { int R, C; stage_rc(tid * 16 + i * 8192, R, C); const int Rb = Epi::PERM ? ((R & ~31) + perm32(R & 31)) : R;
        voffA[i] = (unsigned)(R * K + C) * 2u; voffB[i] = (unsigned)(Rb * K + C) * 2u; }
    const size_t kstep = (size_t)(BK * 2);
    const size_t hstep = (size_t)HALF * K * 2;
    const size_t tstep = 2 * hstep;
    const unsigned ldsw = (unsigned)wid * 1024u;
    const int aoff = lds_byte(wr * 64 + fr, fq * 8), boff = lds_byte(wc * 32 + fr, fq * 8);
#define PG8_SA(b, h) (((b) * 2 + (h)) * HTB)
#define PG8_SB(b, h) ((4 + (b) * 2 + (h)) * HTB)
#define PG8_STAGE(bufoff, gbase, voff) do { _Pragma("unroll") for (int _i = 0; _i < 2; ++_i) \
        __builtin_amdgcn_global_load_lds((const unsigned*)((const char*)(gbase) + (voff)[_i]), (PG8_LAS unsigned*)(lds + (bufoff) + ldsw + _i * 8192), 16, 0, 0); } while (0)
#define PG8_LDA(dst, b, h) do { _Pragma("unroll") for (int m = 0; m < 4; ++m) _Pragma("unroll") for (int k = 0; k < 2; ++k) dst[m][k] = *(const PG8_LAS bf16x8*)(lds + PG8_SA(b, h) + aoff + m * 2048 + k * 1024); } while (0)
#define PG8_LDB(dst, b, h) do { _Pragma("unroll") for (int n = 0; n < 2; ++n) _Pragma("unroll") for (int k = 0; k < 2; ++k) dst[n][k] = *(const PG8_LAS bf16x8*)(lds + PG8_SB(b, h) + boff + n * 2048 + k * 1024); } while (0)
#define PG8_MMA(ai, bj, At, Bt) do { __builtin_amdgcn_s_setprio(1); _Pragma("unroll") for (int m = 0; m < 4; ++m) _Pragma("unroll") for (int n = 0; n < 2; ++n) _Pragma("unroll") for (int k = 0; k < 2; ++k) \
        acc[ai][bj][m][n] = __builtin_amdgcn_mfma_f32_16x16x32_bf16(Bt[n][k], At[m][k], acc[ai][bj][m][n], 0, 0, 0); __builtin_amdgcn_s_setprio(0); } while (0)
#define PG8_WAIT_V(n) asm volatile("s_waitcnt vmcnt(" #n ")" ::: "memory")
#define PG8_WAIT_L(n) asm volatile("s_waitcnt lgkmcnt(" #n ")" ::: "memory")
#define PG8_BAR __builtin_amdgcn_s_barrier()
#define PG8_SCHED __builtin_amdgcn_sched_barrier(0)
    Unit cur, nxt; int ui = 0;
    if (!S.next(0, cur)) return;
    typename Epi::Pre pre;
    f32x4 acc[2][2][4][2];
#pragma unroll
    for (int a = 0; a < 2; ++a)
#pragma unroll
        for (int b = 0; b < 2; ++b)
#pragma unroll
            for (int m = 0; m < 4; ++m)
#pragma unroll
                for (int n = 0; n < 2; ++n) acc[a][b][m][n] = (f32x4){0.f, 0.f, 0.f, 0.f};
    bf16x8 At[4][2], B0[2][2], B1[2][2];
    const char* cA = (const char*)g.A + (size_t)cur.pm * tstep; const char* cB = (const char*)g.Bt + (size_t)cur.pn * tstep;
    S.a_ready(cur);
    if constexpr (SP2) {
        PG8_STAGE(PG8_SB(0, 0), cB, voffB); PG8_STAGE(PG8_SB(0, 1), cB + hstep, voffB); PG8_STAGE(PG8_SA(0, 0), cA, voffA); PG8_STAGE(PG8_SA(0, 1), cA + hstep, voffA);
        if (wr == 1) PG8_BAR;
        PG8_WAIT_V(2); PG8_BAR;
        PG8_STAGE(PG8_SB(1, 0), cB + kstep, voffB); PG8_STAGE(PG8_SA(1, 0), cA + kstep, voffA); PG8_STAGE(PG8_SB(1, 1), cB + hstep + kstep, voffB);
        PG8_WAIT_V(6); PG8_BAR;
    } else {
        PG8_STAGE(PG8_SB(0, 0), cB, voffB); PG8_STAGE(PG8_SA(0, 0), cA, voffA); PG8_STAGE(PG8_SB(0, 1), cB + hstep, voffB); PG8_STAGE(PG8_SA(0, 1), cA + hstep, voffA);
        if (wr == 1) PG8_BAR;
        PG8_WAIT_V(4); PG8_BAR;
        PG8_STAGE(PG8_SB(1, 0), cB + kstep, voffB); PG8_STAGE(PG8_SA(1, 0), cA + kstep, voffA); PG8_STAGE(PG8_SB(1, 1), cB + hstep + kstep, voffB);
        PG8_WAIT_V(6); PG8_BAR;
    }
    for (;;) {
        const bool has_next = S.next(ui + 1, nxt);
        unsigned long long sc_t0 = 0, sc_c0 = 0; if constexpr (SC != 0) { sc_t0 = __builtin_amdgcn_s_memrealtime(); sc_c0 = __builtin_amdgcn_s_memtime(); }
        const char* nA = has_next ? (const char*)g.A + (size_t)nxt.pm * tstep : cA; const char* nB = has_next ? (const char*)g.Bt + (size_t)nxt.pn * tstep : cB;
        for (int t = 0; t < nt; t += 2) {
            const bool last = (t == nt - 2);
            const char* a1 = cA + (size_t)(t + 1) * kstep;
            const char* a2 = last ? nA : cA + (size_t)(t + 2) * kstep; const char* b2 = last ? nB : cB + (size_t)(t + 2) * kstep;
            const char* a3 = a2 + kstep; const char* b3 = b2 + kstep;
            if (last && has_next) S.a_ready(nxt);
            if constexpr (Epi::HAS_PRE) { if (last) E.pre_load(cur, wr, wc, pre); }
            if constexpr (SP2) {
            PG8_LDB(B0, 0, 0); PG8_LDB(B1, 0, 1); PG8_SCHED; PG8_LDA(At, 0, 0); PG8_STAGE(PG8_SA(1, 1), a1 + hstep, voffA);
            PG8_WAIT_V(8); PG8_WAIT_L(0); PG8_BAR; PG8_MMA(0, 0, At, B0); PG8_MMA(0, 1, At, B1); PG8_BAR; PG8_SCHED;
            PG8_LDA(At, 0, 1); PG8_STAGE(PG8_SB(0, 0), b2, voffB); PG8_STAGE(PG8_SB(0, 1), b2 + hstep, voffB); PG8_STAGE(PG8_SA(0, 0), a2, voffA);
            PG8_WAIT_V(8); PG8_WAIT_L(0); PG8_BAR; PG8_MMA(1, 0, At, B0); PG8_MMA(1, 1, At, B1); PG8_BAR; PG8_SCHED;
            PG8_LDB(B0, 1, 0); PG8_LDB(B1, 1, 1); PG8_SCHED; PG8_LDA(At, 1, 0); PG8_STAGE(PG8_SA(0, 1), a2 + hstep, voffA);
            PG8_WAIT_V(8); PG8_WAIT_L(0); PG8_BAR; PG8_MMA(0, 0, At, B0); PG8_MMA(0, 1, At, B1); PG8_BAR; PG8_SCHED;
            PG8_LDA(At, 1, 1); PG8_STAGE(PG8_SB(1, 0), b3, voffB); PG8_STAGE(PG8_SB(1, 1), b3 + hstep, voffB); PG8_STAGE(PG8_SA(1, 0), a3, voffA);
            PG8_WAIT_V(8); PG8_WAIT_L(0); PG8_BAR; PG8_MMA(1, 0, At, B0); PG8_MMA(1, 1, At, B1); PG8_BAR; PG8_SCHED;
            } else {
            PG8_LDB(B0, 0, 0); PG8_SCHED; PG8_LDA(At, 0, 0); PG8_STAGE(PG8_SA(1, 1), a1 + hstep, voffA);
            PG8_WAIT_L(8); PG8_BAR; PG8_WAIT_L(0); PG8_MMA(0, 0, At, B0); PG8_BAR; PG8_SCHED;
            PG8_LDB(B1, 0, 1); PG8_STAGE(PG8_SB(0, 0), b2, voffB);
            PG8_BAR; PG8_WAIT_L(0); PG8_MMA(0, 1, At, B1); PG8_BAR;
            PG8_LDA(At, 0, 1); PG8_STAGE(PG8_SA(0, 0), a2, voffA);
            PG8_BAR; PG8_WAIT_L(0); PG8_MMA(1, 0, At, B0); PG8_BAR; PG8_SCHED;
            PG8_STAGE(PG8_SB(0, 1), b2 + hstep, voffB);
            PG8_WAIT_V(6); PG8_BAR; PG8_MMA(1, 1, At, B1); PG8_BAR;
            PG8_LDB(B0, 1, 0); PG8_SCHED; PG8_LDA(At, 1, 0); PG8_STAGE(PG8_SA(0, 1), a2 + hstep, voffA);
            PG8_WAIT_L(8); PG8_BAR; PG8_WAIT_L(0); PG8_MMA(0, 0, At, B0); PG8_BAR; PG8_SCHED;
            PG8_LDB(B1, 1, 1); PG8_STAGE(PG8_SB(1, 0), b3, voffB);
            PG8_BAR; PG8_WAIT_L(0); PG8_MMA(0, 1, At, B1); PG8_BAR;
            PG8_LDA(At, 1, 1); PG8_STAGE(PG8_SA(1, 0), a3, voffA);
            PG8_BAR; PG8_WAIT_L(0); PG8_MMA(1, 0, At, B0); PG8_BAR; PG8_SCHED;
            PG8_STAGE(PG8_SB(1, 1), b3 + hstep, voffB);
            PG8_WAIT_V(6); PG8_BAR; PG8_MMA(1, 1, At, B1); PG8_BAR;
            }
        }
        if constexpr (SC != 0) { const unsigned long long t1 = __builtin_amdgcn_s_memrealtime(), c1 = __builtin_amdgcn_s_memtime();
            if (tid == 0) { PG8_LAS unsigned* scw = (PG8_LAS unsigned*)(lds + 143360 + 256); scw[0] += (unsigned)(t1 - sc_t0); scw[1] += (unsigned)(c1 - sc_c0); } }
        if constexpr (ALIGN_EPI) { if (wr == 0) PG8_BAR; }
        if constexpr (!Epi::AFTER_DRAIN) { if constexpr (Epi::HAS_PRE) E(acc, cur, wr, wc, fr, fq, pre); else E(acc, cur, wr, wc, fr, fq); S.done(cur); }
        if (!has_next) break;
#pragma unroll
        for (int a = 0; a < 2; ++a)
#pragma unroll
            for (int b = 0; b < 2; ++b)
#pragma unroll
                for (int m = 0; m < 4; ++m)
#pragma unroll
                    for (int n = 0; n < 2; ++n) acc[a][b][m][n] = (f32x4){0.f, 0.f, 0.f, 0.f};
        cur = nxt; cA = nA; cB = nB; ++ui;
        if constexpr (ALIGN_EPI) { if (wr == 1) PG8_BAR; }
    }
    PG8_WAIT_V(0);
    if constexpr (!ALIGN_EPI) { if (wr == 0) PG8_BAR; }
    PG8_BAR;
    if constexpr (Epi::AFTER_DRAIN) { E.fused(acc, cur, wr, wc, fr, fq, lds, wid, lane); S.done(cur); }
#undef PG8_SA
#undef PG8_SB
#undef PG8_STAGE
#undef PG8_LDA
#undef PG8_LDB
#undef PG8_MMA
#undef PG8_WAIT_V
#undef PG8_WAIT_L
#undef PG8_BAR
#undef PG8_SCHED
}
}

#define LAS __attribute__((address_space(3)))
#define XB_TMO      128
#define XB_XCNT(j)  (256  + 64 * (j))
#define XB_XSUB(j)  (1280 + 64 * (j))
#define XB_XGEN(j)  (2304 + 64 * (j))
#define XB_TOP      3328
#define XB_TOPGEN   3392
#define XCD_BAR_WORDS 3456
#define XB_SPIN_CAP (1u << 18)

__device__ __forceinline__ unsigned xb_ld(unsigned* p)              { return __hip_atomic_load(p, __ATOMIC_RELAXED, __HIP_MEMORY_SCOPE_AGENT); }
__device__ __forceinline__ unsigned xb_add(unsigned* p, unsigned v) { return __hip_atomic_fetch_add(p, v, __ATOMIC_RELAXED, __HIP_MEMORY_SCOPE_AGENT); }
__device__ __forceinline__ unsigned xb_xcc_id() { return (unsigned)__builtin_amdgcn_s_getreg((3 << 11) | 20) & 0xFu; }
#define XB_SPIN(cond, bar) do { unsigned _sp = 0; while (cond) { __builtin_amdgcn_s_sleep(1); \
    if ((++_sp & 255u) == 0u) { if (xb_ld(&(bar)[XB_TMO])) break; if (_sp > XB_SPIN_CAP) { atomicAdd(&(bar)[XB_TMO], 1u); break; } } } } while (0)

struct XcdBarrier {
    unsigned* bar; unsigned x;
    volatile LAS unsigned* st;
};

__device__ __forceinline__ XcdBarrier xcd_barrier_post(unsigned* bar, volatile LAS unsigned* st, bool leader) {
    XcdBarrier b; b.bar = bar; b.x = xb_xcc_id(); b.st = st;
    if (leader) (void)xb_add(&bar[XB_XCNT(b.x)], 1u);
    return b;
}
__device__ __forceinline__ void xcd_barrier_complete(unsigned* bar, unsigned x, unsigned& nloc, unsigned& nx) {
    const unsigned G = gridDim.x * gridDim.y * gridDim.z;
    unsigned sum, cnt, mine, sp = 0u;
    for (;;) {
        sum = 0u; cnt = 0u; mine = 0u;
        unsigned cv[16];
        { const unsigned* cb = &bar[XB_XCNT(0)]; static_assert(XB_XCNT(1) - XB_XCNT(0) == 64, "counters are 256 bytes apart");
          asm volatile("global_load_dword %0, %16, off sc1\n\tglobal_load_dword %1, %16, off offset:256 sc1\n\tglobal_load_dword %2, %16, off offset:512 sc1\n\tglobal_load_dword %3, %16, off offset:768 sc1\n\t"
                       "global_load_dword %4, %16, off offset:1024 sc1\n\tglobal_load_dword %5, %16, off offset:1280 sc1\n\tglobal_load_dword %6, %16, off offset:1536 sc1\n\tglobal_load_dword %7, %16, off offset:1792 sc1\n\t"
                       "global_load_dword %8, %16, off offset:2048 sc1\n\tglobal_load_dword %9, %16, off offset:2304 sc1\n\tglobal_load_dword %10, %16, off offset:2560 sc1\n\tglobal_load_dword %11, %16, off offset:2816 sc1\n\t"
                       "global_load_dword %12, %16, off offset:3072 sc1\n\tglobal_load_dword %13, %16, off offset:3328 sc1\n\tglobal_load_dword %14, %16, off offset:3584 sc1\n\tglobal_load_dword %15, %16, off offset:3840 sc1\n\ts_waitcnt vmcnt(0)"
                       : "=&v"(cv[0]), "=&v"(cv[1]), "=&v"(cv[2]), "=&v"(cv[3]), "=&v"(cv[4]), "=&v"(cv[5]), "=&v"(cv[6]), "=&v"(cv[7]), "=&v"(cv[8]), "=&v"(cv[9]), "=&v"(cv[10]), "=&v"(cv[11]), "=&v"(cv[12]), "=&v"(cv[13]), "=&v"(cv[14]), "=&v"(cv[15])
                       : "v"(cb) : "memory"); }
#pragma unroll
        for (unsigned j = 0; j < 16; ++j) { const unsigned c = cv[j]; sum += c; cnt += (c > 0u) ? 1u : 0u; mine = (j == x) ? c : mine; }
        if (sum == G) break;
        __builtin_amdgcn_s_sleep(1);
        if ((++sp & 255u) == 0u) { if (xb_ld(&bar[XB_TMO])) break; if (sp > XB_SPIN_CAP) { atomicAdd(&bar[XB_TMO], 1u); break; } }
    }
    nloc = mine > 0u ? mine : 1u; nx = cnt > 0u ? cnt : 1u;
}

__device__ __forceinline__ void xcd_barrier(const XcdBarrier& b, bool leader) {
    asm volatile("s_waitcnt vmcnt(0)" ::: "memory");
    __syncthreads();
    if (leader) {
        unsigned* bar = b.bar;
        __builtin_amdgcn_s_waitcnt(0);
        unsigned nloc = b.st[0], nx = b.st[1];
        if (nloc == 0u) { xcd_barrier_complete(bar, b.x, nloc, nx); b.st[0] = nloc; b.st[1] = nx; }
#if EARLY_WB
        __builtin_amdgcn_fence(__ATOMIC_RELEASE, "agent");
        asm volatile("s_waitcnt vmcnt(0)" ::: "memory");
#endif
        const unsigned old = xb_add(&bar[XB_XSUB(b.x)], 1u);
        const unsigned gen = old / nloc;
        if (old + 1u == (gen + 1u) * nloc) {
#if !EARLY_WB
            __builtin_amdgcn_fence(__ATOMIC_RELEASE, "agent");
#endif
            asm volatile("s_waitcnt vmcnt(0)" ::: "memory");
            const unsigned og = xb_add(&bar[XB_TOP], 1u);
            const unsigned tg = og / nx;
            if (og + 1u == (tg + 1u) * nx) xb_add(&bar[XB_TOPGEN], 1u);
            else XB_SPIN(xb_ld(&bar[XB_TOPGEN]) == tg, bar);
            __builtin_amdgcn_fence(__ATOMIC_ACQUIRE, "agent");
            xb_add(&bar[XB_XGEN(b.x)], 1u);
            asm volatile("s_waitcnt vmcnt(0)" ::: "memory");
        } else {
            XB_SPIN(xb_ld(&bar[XB_XGEN(b.x)]) == gen, bar);
            __builtin_amdgcn_fence(__ATOMIC_ACQUIRE, "agent");
            asm volatile("s_waitcnt vmcnt(0)" ::: "memory");
        }
    }
    __syncthreads();
}

constexpr int BATCH = 16, SEQ = 2048, DM = 1024, MTOK = BATCH * SEQ, FF = 2816, NGU = 2 * FF, NINP = 3584, INCOLS = 3360, DEPTH = 2;
constexpr int NWAVES = 8;
constexpr float EPS = 1e-6f;
typedef unsigned short bf16;
typedef unsigned v4u __attribute__((ext_vector_type(4)));
typedef unsigned v2u __attribute__((ext_vector_type(2)));
typedef float f32x4 __attribute__((ext_vector_type(4)));
#define LDS_WAIT() asm volatile("s_waitcnt lgkmcnt(0)" ::: "memory")

constexpr size_t MiB = 1u << 20;
constexpr size_t WS_CTL = 0, CTL_ZERO_BYTES = 160 * 1024;
constexpr size_t WS_TAB = 1 * MiB;
constexpr size_t TAB_COS = 0, TAB_SIN = 65536, TAB_B1 = 131072, TAB_W2T = 196608, TAB_SS2 = 262144;
constexpr size_t WS_W = 2 * MiB;
constexpr size_t WO_GU1 = 0, WO_DN1 = 11 * MiB, WO_GU2 = 16 * MiB + MiB / 2, WO_DN2 = 27 * MiB + MiB / 2, WO_IN = 33 * MiB, WO_OUT = 40 * MiB, WO_CMP = 42 * MiB;
constexpr size_t WS_X16 = 45 * MiB;
constexpr size_t WS_U = 109 * MiB;
constexpr size_t WS_HB = 173 * MiB;
constexpr size_t WS_HD = 349 * MiB;
constexpr size_t WS_PQ = 413 * MiB;
constexpr size_t WS_CC = 421 * MiB;
constexpr size_t WS_END = 422 * MiB;
constexpr size_t WS_QN = 173 * MiB, WS_KCR = 205 * MiB, WS_VCR = 213 * MiB, WS_KS = 221 * MiB, WS_VS = 229 * MiB, WS_KW = 237 * MiB, WS_VW = 245 * MiB;
constexpr size_t WS_MQ = 253 * MiB, WS_MK = 285 * MiB, WS_MV = 317 * MiB, WS_MO = 349 * MiB, WS_GATE = 381 * MiB;
static_assert(WS_GATE + 4 * MiB <= WS_PQ, "in-projection outputs end below PQ");
constexpr int CW_BAR = 4096, CW_QUEUE = 16384, CW_GRP = 20480, CW_CFLAG = 33280;
constexpr size_t WS_PART = 486 * MiB, WS_CMPW = 489 * MiB, WS_END3 = 491 * MiB;
static_assert((CW_QUEUE + 2 * 1024) <= CW_GRP && (CW_GRP + 6 * 128 * 16) * 4 <= (int)CTL_ZERO_BYTES && (CW_BAR + 3456) <= CW_QUEUE && WS_TAB + TAB_SS2 + 16 * 32768 <= WS_W, "control words inside the zeroed region");
constexpr int PH_BYTES = 143360, MISC_OFF = PH_BYTES, LDS_BYTES = 147456;

__device__ __forceinline__ unsigned f2bf(float f) { unsigned u = __builtin_bit_cast(unsigned, f); return (u + 0x7fffu + ((u >> 16) & 1u)) >> 16; }
__device__ __forceinline__ unsigned pk2(float lo, float hi) { return f2bf(lo) | (f2bf(hi) << 16); }
typedef float f32x2v_ __attribute__((ext_vector_type(2))); typedef __bf16 bf16x2v_ __attribute__((ext_vector_type(2)));
__device__ __forceinline__ unsigned cvtpk(float lo, float hi) { f32x2v_ v = {lo, hi}; bf16x2v_ b = __builtin_convertvector(v, bf16x2v_); return __builtin_bit_cast(unsigned, b); }
__device__ __forceinline__ float bflo(unsigned u) { return __builtin_bit_cast(float, u << 16); }
__device__ __forceinline__ float bfhi(unsigned u) { return __builtin_bit_cast(float, u & 0xffff0000u); }
__device__ __forceinline__ float bf2f(bf16 b) { return __builtin_bit_cast(float, (unsigned)b << 16); }
__device__ __forceinline__ float sigmoidf_(float x) { return __builtin_amdgcn_rcpf(1.f + __expf(-x)); }
__device__ __forceinline__ int fresh_lane() { unsigned z = 0u; asm volatile("" : "+v"(z)); return (int)__builtin_amdgcn_mbcnt_hi(~0u, __builtin_amdgcn_mbcnt_lo(~0u, z)); }
__device__ __forceinline__ float shx(float v, int mask, int lane) { return __builtin_bit_cast(float, __builtin_amdgcn_ds_bpermute((lane ^ mask) << 2, __builtin_bit_cast(int, v))); }
__device__ __forceinline__ unsigned shxu(unsigned v, int mask, int lane) { return (unsigned)__builtin_amdgcn_ds_bpermute((lane ^ mask) << 2, (int)v); }
__device__ __forceinline__ float shi(float v, int src) { return __builtin_bit_cast(float, __builtin_amdgcn_ds_bpermute(src << 2, __builtin_bit_cast(int, v))); }
__device__ __forceinline__ float wave_sum(float v, int lane) {
    (void)lane;
    v += __builtin_bit_cast(float, __builtin_amdgcn_update_dpp(0, __builtin_bit_cast(int, v), 0xB1, 0xF, 0xF, false));
    v += __builtin_bit_cast(float, __builtin_amdgcn_update_dpp(0, __builtin_bit_cast(int, v), 0x4E, 0xF, 0xF, false));
    v += __builtin_bit_cast(float, __builtin_amdgcn_update_dpp(0, __builtin_bit_cast(int, v), 0x124, 0xF, 0xF, false));
    v += __builtin_bit_cast(float, __builtin_amdgcn_update_dpp(0, __builtin_bit_cast(int, v), 0x128, 0xF, 0xF, false));
    const int iv = __builtin_bit_cast(int, v);
    const float a = __builtin_bit_cast(float, __builtin_amdgcn_readlane(iv, 0)), b = __builtin_bit_cast(float, __builtin_amdgcn_readlane(iv, 16));
    const float c = __builtin_bit_cast(float, __builtin_amdgcn_readlane(iv, 32)), d = __builtin_bit_cast(float, __builtin_amdgcn_readlane(iv, 48));
    return (a + b) + (c + d);
}

struct SrcGU { const float* W; const float* g; __device__ __forceinline__ float operator()(int k, int nd) const { const int pn = nd >> 8, r = nd & 255; const int col = (r < 128) ? (pn * 128 + r) : (FF + pn * 128 + r - 128); return W[(size_t)k * NGU + col]; } };
struct SrcPlain { const float* W; int N; const float* g; __device__ __forceinline__ float operator()(int k, int nd) const { return W[(size_t)k * N + nd]; } };
struct SrcIN { const float* W; const float* g; __device__ __forceinline__ float operator()(int k, int nd) const {
    const int col = nd < 1280 ? nd : (nd < 3328 ? nd + 24 : (nd < 3352 ? nd - 3328 + 1280 : (nd < 3360 ? nd : -1)));
    return col < 0 ? 0.f : W[(size_t)k * INCOLS + col]; } };
struct SrcCMP { const float* W1; const float* g; __device__ __forceinline__ float operator()(int k, int nd) const { const int kv = nd >> 8, r = nd & 255;
    return r < 128 ? W1[((size_t)kv * 2048 + k) * 128 + r] : W1[((size_t)kv * 2048 + 1024 + k) * 128 + r - 128]; } };

template <class SrcF>
__device__ __forceinline__ void transpose_item(const SrcF& src, int K, bf16* WT, LAS float* scr, int kb, int nb, int lane) {
    const int k0 = 64 * kb, n0 = 32 * nb, c = lane & 7;
    f32x4 ga = {1.f, 1.f, 1.f, 1.f}, gb = ga;
    if (src.g) { ga = *(const f32x4*)(src.g + k0 + 8 * c); gb = *(const f32x4*)(src.g + k0 + 8 * c + 4); }
    float tv[32];
#pragma unroll
    for (int i = 0; i < 32; ++i) tv[i] = src(k0 + 2 * i + (lane >> 5), n0 + (lane & 31));
#pragma unroll
    for (int i = 0; i < 32; ++i) { const int kk = 2 * i + (lane >> 5); scr[kk * 33 + (lane & 31)] = tv[i]; }
    LDS_WAIT(); asm volatile("" ::: "memory");
#pragma unroll
    for (int j = 0; j < 4; ++j) { const int n = (lane >> 3) + 8 * j; const LAS float* s = scr + (8 * c) * 33 + n;
        v4u o; o.x = cvtpk(s[0 * 33] * ga.x, s[1 * 33] * ga.y); o.y = cvtpk(s[2 * 33] * ga.z, s[3 * 33] * ga.w); o.z = cvtpk(s[4 * 33] * gb.x, s[5 * 33] * gb.y); o.w = cvtpk(s[6 * 33] * gb.z, s[7 * 33] * gb.w);
        *(v4u*)(WT + (size_t)(n0 + n) * K + k0 + 8 * c) = o; }
    LDS_WAIT(); asm volatile("" ::: "memory");
}

template <int MODE>
__device__ __forceinline__ void thin_phase(const bf16* HD, const float* xin_f32, bf16* X16, float* out_f32, float* R2, const float* gpost, float cc, int gw, int NGW, int lane) {
    f32x4 gp[4];
#pragma unroll
    for (int j = 0; j < 4; ++j) gp[j] = (MODE != 0) ? *(const f32x4*)(gpost + 4 * lane + 256 * j) : (f32x4){0.f, 0.f, 0.f, 0.f};
    f32x4 xf[4]; v2u xn[4], hn[4];
    if (gw < MTOK) {
#pragma unroll
        for (int j = 0; j < 4; ++j) { if (MODE == 0) xf[j] = *(const f32x4*)(xin_f32 + (size_t)gw * DM + 4 * lane + 256 * j);
            else { xn[j] = *(const v2u*)(X16 + (size_t)gw * DM + 4 * lane + 256 * j); hn[j] = *(const v2u*)(HD + (size_t)gw * DM + 4 * lane + 256 * j); } }
    }
    for (int m = gw; m < MTOK; m += NGW) {
        f32x4 x[4]; v2u hw[4];
#pragma unroll
        for (int j = 0; j < 4; ++j) { if (MODE == 0) x[j] = xf[j]; else { x[j] = (f32x4){bflo(xn[j].x), bfhi(xn[j].x), bflo(xn[j].y), bfhi(xn[j].y)}; hw[j] = hn[j]; } }
        const int m2 = m + NGW;
        if (m2 < MTOK) {
#pragma unroll
            for (int j = 0; j < 4; ++j) { if (MODE == 0) xf[j] = *(const f32x4*)(xin_f32 + (size_t)m2 * DM + 4 * lane + 256 * j);
                else { xn[j] = *(const v2u*)(X16 + (size_t)m2 * DM + 4 * lane + 256 * j); hn[j] = *(const v2u*)(HD + (size_t)m2 * DM + 4 * lane + 256 * j); } }
        }
        if (MODE != 0) {
            f32x4 h[4]; float ss = 0.f;
#pragma unroll
            for (int j = 0; j < 4; ++j) { h[j] = (f32x4){bflo(hw[j].x), bfhi(hw[j].x), bflo(hw[j].y), bfhi(hw[j].y)}; ss += (h[j].x * h[j].x + h[j].y * h[j].y) + (h[j].z * h[j].z + h[j].w * h[j].w); }
            const float r = cc * __frsqrt_rn(wave_sum(ss, lane) * (1.f / DM) + EPS);
#pragma unroll
            for (int j = 0; j < 4; ++j) x[j] = x[j] + (h[j] * r) * gp[j];
        }
        if (MODE == 2) {
#pragma unroll
            for (int j = 0; j < 4; ++j) *(f32x4*)(out_f32 + (size_t)m * DM + 4 * lane + 256 * j) = x[j];
        } else {
            float s2 = 0.f;
#pragma unroll
            for (int j = 0; j < 4; ++j) { s2 += (x[j].x * x[j].x + x[j].y * x[j].y) + (x[j].z * x[j].z + x[j].w * x[j].w);
                v2u w; w.x = cvtpk(x[j].x, x[j].y); w.y = cvtpk(x[j].z, x[j].w); *(v2u*)(X16 + (size_t)m * DM + 4 * lane + 256 * j) = w; }
            const float st = wave_sum(s2, lane);
            if (lane == 0) *(f32x4*)(R2 + (size_t)m * 4) = (f32x4){st, 0.f, 0.f, 0.f};
        }
    }
}

struct EpiSwiglu {
    static constexpr bool PERM = true, AFTER_DRAIN = false, HAS_PRE = true; struct Pre {};
    bf16* H; const float* SS2; LAS unsigned char* lred;
    __device__ __forceinline__ void pre_load(const pg8::Unit& u, int wr, int wc, Pre&) const {
        if (wc == 0) { const float* sp = SS2 + (size_t)(u.pm * 256 + wr * 64 + fresh_lane()) * 4;
            __builtin_amdgcn_global_load_lds((const unsigned*)sp, (LAS unsigned*)(lred + wr * 2048), 16, 0, 0);
            __builtin_amdgcn_global_load_lds((const unsigned*)(sp + 128 * 4), (LAS unsigned*)(lred + wr * 2048 + 1024), 16, 0, 0); } }
    __device__ __forceinline__ void operator()(const pg8::f32x4 (&acc)[2][2][4][2], const pg8::Unit& u, int wr, int wc, int fr, int fq, const Pre& P) const {
        float rsv[2][4];
        { const int ln = fq * 16 + fr; const f32x4 p0 = *(const LAS f32x4*)(lred + wr * 2048 + ln * 16), p1 = *(const LAS f32x4*)(lred + wr * 2048 + 1024 + ln * 16);
          const float r0 = __frsqrt_rn(((p0.x + p0.y) + (p0.z + p0.w)) * (1.f / DM) + EPS), r1 = __frsqrt_rn(((p1.x + p1.y) + (p1.z + p1.w)) * (1.f / DM) + EPS);
#pragma unroll
          for (int m = 0; m < 4; ++m) { rsv[0][m] = shi(r0, m * 16 + fr); rsv[1][m] = shi(r1, m * 16 + fr); } }
#pragma unroll
        for (int ai = 0; ai < 2; ++ai)
#pragma unroll
            for (int m = 0; m < 4; ++m) {
                const int row = u.pm * 256 + ai * 128 + wr * 64 + m * 16 + fr; const float rs = rsv[ai][m];
                typedef float f2 __attribute__((ext_vector_type(2)));
                f2 tg[4], tu[4], ex[4]; float o[8]; const float c1 = rs * -1.4426950408889634f, rs2 = rs * rs;
#pragma unroll
                for (int n = 0; n < 2; ++n) { const pg8::f32x4 g4 = acc[ai][0][m][n], u4 = acc[ai][1][m][n];
                    tg[2 * n] = (f2){g4[0], g4[1]}; tg[2 * n + 1] = (f2){g4[2], g4[3]}; tu[2 * n] = (f2){u4[0], u4[1]}; tu[2 * n + 1] = (f2){u4[2], u4[3]}; }
#pragma unroll
                for (int e = 0; e < 4; ++e) { const f2 a2 = tg[e] * c1; ex[e].x = __builtin_amdgcn_exp2f(a2.x); ex[e].y = __builtin_amdgcn_exp2f(a2.y); }
#pragma unroll
                for (int e = 0; e < 4; ++e) { const f2 d2 = ex[e] + 1.0f; ex[e].x = __builtin_amdgcn_rcpf(d2.x); ex[e].y = __builtin_amdgcn_rcpf(d2.y); tu[e] = (tg[e] * tu[e]) * rs2; }
#pragma unroll
                for (int e = 0; e < 4; ++e) { const f2 r2 = tu[e] * ex[e]; o[2 * e] = r2.x; o[2 * e + 1] = r2.y; }
                v4u w; w.x = pg8::cvt_pk_bf16(o[0], o[1]); w.y = pg8::cvt_pk_bf16(o[2], o[3]); w.z = pg8::cvt_pk_bf16(o[4], o[5]); w.w = pg8::cvt_pk_bf16(o[6], o[7]);
                *(v4u*)(H + (size_t)row * FF + u.pn * 128 + wc * 32 + fq * 8) = w;
            }
    }
};
#define EPI_LBAR() do { asm volatile("s_waitcnt lgkmcnt(0)" ::: "memory"); __builtin_amdgcn_s_barrier(); } while (0)
template <bool FINAL>
struct EpiResNorm {
    static constexpr bool PERM = !FINAL, AFTER_DRAIN = false, HAS_PRE = false; struct Pre {};
    unsigned char* ws; LAS float* red; const float* gpost; float* outf; float cc; int inst;
    __device__ __forceinline__ void operator()(const pg8::f32x4 (&acc)[2][2][4][2], const pg8::Unit& u, int wr, int wc, int fr_, int fq_) const {
        int fr = fr_, fq = fq_;
        bf16* X16 = (bf16*)(ws + WS_X16);
        const int ln = fresh_lane(), wv = wr * 4 + wc, tid = wv * 64 + ln; fr = ln & 15; fq = ln >> 4;
        const int r0 = u.pm * 256 + wr * 64 + fr, c0 = u.pn * 256 + wc * 32 + fq * (FINAL ? 4 : 8);
        v4u xv[2][4][2];
        if (wv != 0) {
#pragma unroll
            for (int ai = 0; ai < 2; ++ai)
#pragma unroll
                for (int m = 0; m < 4; ++m)
#pragma unroll
                    for (int bj = 0; bj < 2; ++bj) { const bf16* xp = X16 + (size_t)(r0 + ai * 128 + m * 16) * DM + c0 + bj * 128;
                        if (FINAL) { const v2u lo2 = *(const v2u*)xp, hi2 = *(const v2u*)(xp + 16); xv[ai][m][bj] = (v4u){lo2.x, lo2.y, hi2.x, hi2.y}; } else xv[ai][m][bj] = *(const v4u*)xp; }
        }
        if (tid >= 256) red[1280 + tid - 256] = gpost[u.pn * 256 + tid - 256];
#pragma unroll
        for (int ai = 0; ai < 2; ++ai)
#pragma unroll
            for (int m = 0; m < 4; ++m) { float s = 0.f;
#pragma unroll
                for (int bj = 0; bj < 2; ++bj)
#pragma unroll
                    for (int n = 0; n < 2; ++n) { const pg8::f32x4 a = acc[ai][bj][m][n]; s += (a[0] * a[0] + a[1] * a[1]) + (a[2] * a[2] + a[3] * a[3]); }
                s += shx(s, 16, ln); s += shx(s, 32, ln);
                if (fq == 0) red[wc * 256 + ai * 128 + wr * 64 + m * 16 + fr] = s; }
        EPI_LBAR();
        if (wv == 0) {
            unsigned* ctr = (unsigned*)(ws + WS_CTL) + CW_GRP + (inst * 128 + u.pm) * 16;
            unsigned* part = (unsigned*)(ws + WS_PART) + (size_t)inst * 4 * MTOK + u.pm * 256 + 4 * ln;
            const f32x4 p0 = *(const LAS f32x4*)(red + 4 * ln), p1 = *(const LAS f32x4*)(red + 256 + 4 * ln), p2 = *(const LAS f32x4*)(red + 512 + 4 * ln), p3 = *(const LAS f32x4*)(red + 768 + 4 * ln);
            const f32x4 ps = (p0 + p1) + (p2 + p3);
            unsigned* mine = part + (size_t)u.pn * MTOK;
            asm volatile("global_store_dwordx4 %0, %1, off sc1\n\ts_waitcnt vmcnt(0)" :: "v"(mine), "v"(ps) : "memory");
            if (ln == 0) { (void)__hip_atomic_fetch_add(ctr, 1u, __ATOMIC_RELAXED, __HIP_MEMORY_SCOPE_AGENT);
                unsigned sp = 0u; while (__hip_atomic_load(ctr, __ATOMIC_RELAXED, __HIP_MEMORY_SCOPE_AGENT) < 4u) { __builtin_amdgcn_s_sleep(1); if (++sp > (1u << 22)) break; } }
            asm volatile("" ::: "memory");
            f32x4 q0, q1, q2, q3;
            asm volatile("global_load_dwordx4 %0, %4, off sc1\n\tglobal_load_dwordx4 %1, %5, off sc1\n\tglobal_load_dwordx4 %2, %6, off sc1\n\tglobal_load_dwordx4 %3, %7, off sc1\n\ts_waitcnt vmcnt(0)"
                         : "=&v"(q0), "=&v"(q1), "=&v"(q2), "=&v"(q3) : "v"(part), "v"(part + MTOK), "v"(part + 2 * (size_t)MTOK), "v"(part + 3 * (size_t)MTOK) : "memory");
            const f32x4 t = ((q0 + q1) + (q2 + q3)) * (1.f / DM) + EPS;
            *(LAS f32x4*)(red + 1024 + 4 * ln) = (f32x4){cc * __frsqrt_rn(t.x), cc * __frsqrt_rn(t.y), cc * __frsqrt_rn(t.z), cc * __frsqrt_rn(t.w)};
#pragma unroll
            for (int ai = 0; ai < 2; ++ai)
#pragma unroll
                for (int m = 0; m < 4; ++m)
#pragma unroll
                    for (int bj = 0; bj < 2; ++bj) { const bf16* xp = X16 + (size_t)(r0 + ai * 128 + m * 16) * DM + c0 + bj * 128;
                        if (FINAL) { const v2u lo2 = *(const v2u*)xp, hi2 = *(const v2u*)(xp + 16); xv[ai][m][bj] = (v4u){lo2.x, lo2.y, hi2.x, hi2.y}; } else xv[ai][m][bj] = *(const v4u*)xp; }
        }
        EPI_LBAR();
#pragma unroll
        for (int ai = 0; ai < 2; ++ai)
#pragma unroll
            for (int m = 0; m < 4; ++m) { const float inv = red[1024 + ai * 128 + wr * 64 + m * 16 + fr]; float s = 0.f; const size_t rowo = (size_t)(r0 + ai * 128 + m * 16) * DM + c0;
                asm volatile("" ::: "memory");
#pragma unroll
                for (int bj = 0; bj < 2; ++bj) { const v4u xw = xv[ai][m][bj]; const LAS float* gl = red + 1280 + bj * 128 + wc * 32 + fq * (FINAL ? 4 : 8); const f32x4 gv0 = *(const LAS f32x4*)gl, gv1 = *(const LAS f32x4*)(gl + (FINAL ? 16 : 4));
                    f32x4 x0 = (f32x4){bflo(xw.x), bfhi(xw.x), bflo(xw.y), bfhi(xw.y)}, x1 = (f32x4){bflo(xw.z), bfhi(xw.z), bflo(xw.w), bfhi(xw.w)};
                    x0 = x0 + (acc[ai][bj][m][0] * inv) * gv0; x1 = x1 + (acc[ai][bj][m][1] * inv) * gv1;
                    if (FINAL) { float* op = outf + rowo + bj * 128; *(f32x4*)op = x0; *(f32x4*)(op + 16) = x1; }
                    else { s += ((x0.x * x0.x + x0.y * x0.y) + (x0.z * x0.z + x0.w * x0.w)) + ((x1.x * x1.x + x1.y * x1.y) + (x1.z * x1.z + x1.w * x1.w));
                        v4u w; w.x = pg8::cvt_pk_bf16(x0.x, x0.y); w.y = pg8::cvt_pk_bf16(x0.z, x0.w); w.z = pg8::cvt_pk_bf16(x1.x, x1.y); w.w = pg8::cvt_pk_bf16(x1.z, x1.w);
                        *(v4u*)(X16 + rowo + bj * 128) = w; } }
                if (!FINAL) { s += shx(s, 16, ln); s += shx(s, 32, ln); if (fq == 0) red[wc * 256 + ai * 128 + wr * 64 + m * 16 + fr] = s; } }
        if (!FINAL) {
            EPI_LBAR();
            if (tid < 256) ((float*)(ws + WS_TAB + TAB_SS2))[(size_t)(u.pm * 256 + tid) * 4 + u.pn] = (red[tid] + red[256 + tid]) + (red[512 + tid] + red[768 + tid]);
        }
    }
};
struct EpiCmpMlp {
    static constexpr bool PERM = true, AFTER_DRAIN = true, HAS_PRE = false; struct Pre {};
    unsigned char* ws; const float* b1; const bf16* w2t;
    __device__ __forceinline__ void operator()(const pg8::f32x4 (&)[2][2][4][2], const pg8::Unit&, int, int, int, int) const {}
    __device__ __forceinline__ void fused(const pg8::f32x4 (&acc)[2][2][4][2], const pg8::Unit& u, int wr, int wc, int fr_, int fq_, LAS unsigned char* lds, int wid, int lane_) const {
        (void)fr_; (void)fq_; (void)lane_;
        const int ln = fresh_lane(), fr = ln & 15, fq = ln >> 4, kv = u.pm >> 4;
        pg8::bf16x8 xf[4][4];
        { const bf16* wp = w2t + (size_t)kv * 64 * 128 + fr * 128 + fq * 8;
#pragma unroll
          for (int ib = 0; ib < 4; ++ib)
#pragma unroll
              for (int ks = 0; ks < 4; ++ks) xf[ib][ks] = *(const pg8::bf16x8*)(wp + ib * 16 * 128 + ks * 32); }
        f32x4 bb[2];
#pragma unroll
        for (int n = 0; n < 2; ++n) bb[n] = *(const f32x4*)(b1 + kv * 128 + wc * 32 + fq * 8 + 4 * n);
#pragma unroll
        for (int ai = 0; ai < 2; ++ai)
#pragma unroll
            for (int m = 0; m < 4; ++m) { const int row = ai * 128 + wr * 64 + m * 16 + fr;
#pragma unroll
                for (int n = 0; n < 2; ++n) *(LAS f32x4*)(lds + row * 512 + (((wc * 8 + fq * 2 + n) ^ (row & 15)) << 4)) = acc[ai][1][m][n]; }
        EPI_LBAR();
        v4u hv[2][4];
#pragma unroll
        for (int ai = 0; ai < 2; ++ai)
#pragma unroll
            for (int m = 0; m < 4; ++m) { const int row = ai * 128 + wr * 64 + m * 16 + fr, rn = (row < 255) ? row + 1 : 255; float h[8];
#pragma unroll
                for (int n = 0; n < 2; ++n) { const f32x4 q = *(const LAS f32x4*)(lds + rn * 512 + (((wc * 8 + fq * 2 + n) ^ (rn & 15)) << 4)); const f32x4 v = acc[ai][0][m][n] + q + bb[n];
#pragma unroll
                    for (int e = 0; e < 4; ++e) { const float x = v[e], t = x * (1.f + 0.044715f * x * x) * (-2.f * 0.7978845608028654f * 1.4426950408889634f);
                        h[4 * n + e] = ((row & 127) == 127) ? 0.f : x * __builtin_amdgcn_rcpf(1.f + __builtin_amdgcn_exp2f(t)); } }
                hv[ai][m] = (v4u){cvtpk(h[0], h[1]), cvtpk(h[2], h[3]), cvtpk(h[4], h[5]), cvtpk(h[6], h[7])}; }
        EPI_LBAR();
#pragma unroll
        for (int ai = 0; ai < 2; ++ai)
#pragma unroll
            for (int m = 0; m < 4; ++m) { const int row = ai * 128 + wr * 64 + m * 16 + fr; *(LAS v4u*)(lds + row * 256 + (((wc * 4 + fq) ^ (row & 15)) << 4)) = hv[ai][m]; }
        EPI_LBAR();
        bf16* CC = (bf16*)(ws + WS_CC);
#pragma unroll
        for (int jj = 0; jj < 2; ++jj) { const int row = (2 * wid + jj) * 16 + fr; pg8::f32x4 o[4];
#pragma unroll
            for (int ib = 0; ib < 4; ++ib) o[ib] = (pg8::f32x4){0.f, 0.f, 0.f, 0.f};
#pragma unroll
            for (int ks = 0; ks < 4; ++ks) { const pg8::bf16x8 y = *(const LAS pg8::bf16x8*)(lds + row * 256 + (((ks * 4 + fq) ^ (row & 15)) << 4));
#pragma unroll
                for (int ib = 0; ib < 4; ++ib) o[ib] = __builtin_amdgcn_mfma_f32_16x16x32_bf16(xf[ib][ks], y, o[ib], 0, 0, 0); }
            bf16* cp = CC + ((size_t)u.pm * 256 + row) * 64 + 4 * fq;
#pragma unroll
            for (int ib = 0; ib < 4; ++ib) { v2u w; w.x = cvtpk(o[ib][0], o[ib][1]); w.y = cvtpk(o[ib][2], o[ib][3]); *(v2u*)(cp + ib * 16) = w; } }
    }
};
struct CmpOrder {
    int c, G;
    __device__ __forceinline__ bool next(int i, pg8::Unit& u) const { const int idx = i * G + c; if (idx >= 32) return false; u.pm = idx; u.pn = idx >> 4; return true; }
    __device__ __forceinline__ void a_ready(const pg8::Unit&) const {}
    __device__ __forceinline__ void done(const pg8::Unit&) const {}
};
struct EpiInProj {
    static constexpr bool PERM = true, AFTER_DRAIN = false, HAS_PRE = true; struct Pre {};
    unsigned char* ws; LAS unsigned char* lred;
    __device__ __forceinline__ void pre_load(const pg8::Unit& u, int wr, int wc, Pre&) const {
        if (wc == 0) { const float* sp = (const float*)(ws + WS_TAB + TAB_SS2) + (size_t)(u.pm * 256 + wr * 64 + fresh_lane()) * 4;
            __builtin_amdgcn_global_load_lds((const unsigned*)sp, (LAS unsigned*)(lred + wr * 2048), 16, 0, 0);
            __builtin_amdgcn_global_load_lds((const unsigned*)(sp + 128 * 4), (LAS unsigned*)(lred + wr * 2048 + 1024), 16, 0, 0); } }
    __device__ __forceinline__ void operator()(const pg8::f32x4 (&acc)[2][2][4][2], const pg8::Unit& u, int wr, int wc, int fr, int fq, const Pre&) const {
        const int pn = u.pn;
        const bool ropet = (pn < 2) || (pn == 3) || (pn == 4);
        const bool ropew = ropet && ((wc & 1) == 0);
        float rsv[2][4];
#pragma unroll
        for (int ai = 0; ai < 2; ++ai)
#pragma unroll
            for (int m = 0; m < 4; ++m) { const f32x4 p = *(const LAS f32x4*)(lred + wr * 2048 + ai * 1024 + (m * 16 + fr) * 16); rsv[ai][m] = __frsqrt_rn(((p.x + p.y) + (p.z + p.w)) * (1.f / DM) + EPS); }
#pragma unroll
        for (int ai = 0; ai < 2; ++ai)
#pragma unroll
            for (int m = 0; m < 4; ++m) {
                const int row = u.pm * 256 + ai * 128 + wr * 64 + m * 16 + fr;
                const int b = row >> 11, t = row & 2047; const float rs = rsv[ai][m];
                f32x4 c0, c1, s0, s1;
                if (ropew) {
                    const float tf = (float)t; float cs_[8], sn_[8];
                    const float ifr[8] = {1.5915494309e-01f, 3.0863763405e-02f, 5.9851857127e-03f, 1.1606636412e-03f, 2.2507907904e-04f, 4.3647952793e-05f, 8.4643308082e-06f, 1.6414262628e-06f};
#pragma unroll
                    for (int e = 0; e < 8; ++e) { const float rv = __builtin_amdgcn_fractf(tf * ifr[e]); cs_[e] = __builtin_amdgcn_cosf(rv); sn_[e] = __builtin_amdgcn_sinf(rv); }
                    c0 = (f32x4){cs_[0], cs_[1], cs_[2], cs_[3]}; c1 = (f32x4){cs_[4], cs_[5], cs_[6], cs_[7]}; s0 = (f32x4){sn_[0], sn_[1], sn_[2], sn_[3]}; s1 = (f32x4){sn_[4], sn_[5], sn_[6], sn_[7]}; }
#pragma unroll
                for (int bj = 0; bj < 2; ++bj) {
                    f32x4 v0 = acc[ai][bj][m][0] * rs, v1 = acc[ai][bj][m][1] * rs;
                    const int cl = bj * 128 + wc * 32 + fq * 8;
                    if (ropew && (pn < 2 || bj == 0)) {
                        f32x4 p0, p1; const int ln = fq * 16 + fr;
                        p0.x = shx(v0.x, 16, ln); p0.y = shx(v0.y, 16, ln); p0.z = shx(v0.z, 16, ln); p0.w = shx(v0.w, 16, ln);
                        p1.x = shx(v1.x, 16, ln); p1.y = shx(v1.y, 16, ln); p1.z = shx(v1.z, 16, ln); p1.w = shx(v1.w, 16, ln);
                        const float sg = (fq == 0) ? -1.f : 1.f;
                        if (fq < 2) { v0 = v0 * c0 + (p0 * s0) * sg; v1 = v1 * c1 + (p1 * s1) * sg; }
                    }
                    if (pn < 2) { v0 = v0 * 0.18033688011112042f; v1 = v1 * 0.18033688011112042f; }
                    if (pn == 13) { if (cl < 32) { float* p = (float*)(ws + WS_GATE) + (size_t)row * 32 + cl; *(f32x4*)p = v0; *(f32x4*)(p + 4) = v1; } }
                    else {
                        size_t off;
                        if (pn < 2) off = WS_QN + ((size_t)row * 512 + pn * 256 + cl) * 2;
                        else if (pn < 5) { const int g = wc >> 1, d = (wc & 1) * 32 + fq * 8; off = WS_KCR + (size_t)((pn - 2) * 2 + bj) * (8 * MiB) + (((size_t)(b * 2 + g) * SEQ + t) * 64 + d) * 2; }
                        else { const int q = pn - 5; off = WS_MQ + (size_t)(q >> 1) * (32 * MiB) + ((size_t)row * 512 + (q & 1) * 256 + cl) * 2; }
                        v4u w; w.x = pg8::cvt_pk_bf16(v0.x, v0.y); w.y = pg8::cvt_pk_bf16(v0.z, v0.w); w.z = pg8::cvt_pk_bf16(v1.x, v1.y); w.w = pg8::cvt_pk_bf16(v1.z, v1.w);
                        *(v4u*)(ws + off) = w;
                    }
                }
            }
    }
};
static_assert(WS_VCR == WS_KCR + 8 * MiB && WS_KS == WS_KCR + 16 * MiB && WS_VS == WS_KCR + 24 * MiB && WS_KW == WS_KCR + 32 * MiB && WS_VW == WS_KCR + 40 * MiB, "kv buffers are 8 MiB apart in (pn, bj) order");
static_assert(WS_MK == WS_MQ + 32 * MiB && WS_MV == WS_MQ + 64 * MiB && WS_MO == WS_MQ + 96 * MiB, "mLSTM buffers are 32 MiB apart");

struct MixPtrs { unsigned char* ws; const float *conv_w, *conv_b, *i_bias, *f_bias, *mnorm_g; };
#define MP_QN ((const bf16*)(P.ws + WS_QN))
#define MP_KS ((const bf16*)(P.ws + WS_KS))
#define MP_VS ((const bf16*)(P.ws + WS_VS))
#define MP_KW ((const bf16*)(P.ws + WS_KW))
#define MP_VW ((const bf16*)(P.ws + WS_VW))
#define MP_KC ((const bf16*)(P.ws + WS_CC))
#define MP_VC ((const bf16*)(P.ws + WS_CC) + (size_t)4096 * 64)
#define MP_MQ ((const bf16*)(P.ws + WS_MQ))
#define MP_MK ((const bf16*)(P.ws + WS_MK))
#define MP_MV ((const bf16*)(P.ws + WS_MV))
#define MP_MO ((const bf16*)(P.ws + WS_MO))
#define MP_GATE ((const float*)(P.ws + WS_GATE))
#define MP_Y ((bf16*)(P.ws + WS_U))


typedef float f32x16 __attribute__((ext_vector_type(16)));
typedef short bf16x8v __attribute__((ext_vector_type(8)));
typedef short s16x4v __attribute__((ext_vector_type(4)));
typedef float f32x2v __attribute__((ext_vector_type(2)));
typedef __bf16 bf16x2v __attribute__((ext_vector_type(2)));
#define MFMA32(a, b, c) __builtin_amdgcn_mfma_f32_32x32x16_bf16((a), (b), (c), 0, 0, 0)
__device__ __forceinline__ s16x4v tr_read(const LAS unsigned char* p) { return __builtin_bit_cast(s16x4v, __builtin_amdgcn_ds_read_tr16_b64_v4i16((LAS s16x4v*)p)); }
__device__ __forceinline__ int tile_off(int key, int ch8) { return (ch8 >> 2) * 4096 + key * 64 + (((ch8 & 3) ^ ((key >> 2) & 3)) << 4); }
constexpr int NM_SLOT = 0, NM_IMP = 65536, NM_IMS = 99328, NM_SEL = 108544, NM_ITEM = 108864;
constexpr float QK_SCALE = 0.125f * 1.4426950408889634f;

#define SBAR() __builtin_amdgcn_sched_barrier(0)
__device__ __forceinline__ void xor32_pair(float v, float& lo, float& hi) { float a = v, b = v; asm volatile("s_nop 1\n\tv_permlane32_swap_b32 %0, %1" : "+v"(a), "+v"(b)); lo = a; hi = b; }
__device__ __forceinline__ float xor32_max(float v) { float lo, hi; xor32_pair(v, lo, hi); float r; asm("v_max_f32 %0, %1, %2" : "=v"(r) : "v"(lo), "v"(hi)); return r; }
__device__ __forceinline__ float xor32_sum(float v) { float lo, hi; xor32_pair(v, lo, hi); return lo + hi; }
__device__ __forceinline__ float max2f(float a, float b) { float r; asm("v_max_f32 %0, %1, %2" : "=v"(r) : "v"(a), "v"(b)); return r; }
__device__ __forceinline__ float max3f(float a, float b, float c) { float r; asm("v_max3_f32 %0, %1, %2, %3" : "=v"(r) : "v"(a), "v"(b), "v"(c)); return r; }
#define LBAR() asm volatile("s_waitcnt lgkmcnt(0)\n\ts_barrier" ::: "memory")
__device__ __forceinline__ void k_load(const LAS unsigned char* Ks, int r, int h, bf16x8v (&kf)[8]) {
    const int sw = (r >> 2) & 3;
#pragma unroll
    for (int ks = 0; ks < 4; ++ks) { const int off = (ks >> 1) * 4096 + r * 64 + (((((ks & 1) << 1) + h) ^ sw) << 4);
        kf[2 * ks] = *(const LAS bf16x8v*)(Ks + off); kf[2 * ks + 1] = *(const LAS bf16x8v*)(Ks + off + 2048); }
}
__device__ __forceinline__ void qk_mma(const bf16x8v (&kf)[8], const bf16x8v (&qf)[4], f32x16& p0, f32x16& p1) {
    const f32x16 z = {0.f, 0.f, 0.f, 0.f, 0.f, 0.f, 0.f, 0.f, 0.f, 0.f, 0.f, 0.f, 0.f, 0.f, 0.f, 0.f};
#pragma unroll
    for (int ks = 0; ks < 4; ++ks) { p0 = MFMA32(kf[2 * ks], qf[ks], ks ? p0 : z); p1 = MFMA32(kf[2 * ks + 1], qf[ks], ks ? p1 : z); }
}
__device__ __forceinline__ void v_load(const LAS unsigned char* Vs, int lane, bf16x8v (&vf)[8]) {
    const int h = lane >> 5, i16 = lane & 15, q = i16 >> 2, p = i16 & 3, gi = (lane >> 4) & 1;
    const int cidx = 2 * gi + (p >> 1), e8 = (p & 1) << 3;
    const int offlo = q * 64 + ((cidx ^ h) << 4) + e8 + h * 256, offhi = q * 64 + ((cidx ^ (h | 2)) << 4) + e8 + h * 256 + 512;
#pragma unroll
    for (int kb = 0; kb < 2; ++kb)
#pragma unroll
        for (int s = 0; s < 2; ++s)
#pragma unroll
            for (int db = 0; db < 2; ++db) { const LAS unsigned char* base = Vs + db * 4096 + (kb * 32 + s * 16) * 64;
                const s16x4v lo = tr_read(base + offlo), hi = tr_read(base + offhi);
                vf[(kb * 2 + s) * 2 + db] = __builtin_shufflevector(lo, hi, 0, 1, 2, 3, 4, 5, 6, 7); }
}
__device__ __forceinline__ void pv_mma(const bf16x8v (&vf)[8], const f32x16& p0, const f32x16& p1, f32x16 (&o)[2]) {
#pragma unroll
    for (int kb = 0; kb < 2; ++kb)
#pragma unroll
        for (int s = 0; s < 2; ++s) {
            const f32x16& P = kb ? p1 : p0;
            v4u pw; pw.x = cvtpk(P[8 * s + 0], P[8 * s + 1]); pw.y = cvtpk(P[8 * s + 2], P[8 * s + 3]); pw.z = cvtpk(P[8 * s + 4], P[8 * s + 5]); pw.w = cvtpk(P[8 * s + 6], P[8 * s + 7]);
            const bf16x8v pf = __builtin_bit_cast(bf16x8v, pw);
            o[0] = MFMA32(vf[(kb * 2 + s) * 2], pf, o[0]); o[1] = MFMA32(vf[(kb * 2 + s) * 2 + 1], pf, o[1]);
        }
}

__device__ __forceinline__ void nsa_unit_mfma(LAS unsigned char* L, const MixPtrs& P, int b, int g, int c, int tid_in) {
    int tid_l = tid_in; asm volatile("" : "+v"(tid_l));
    const int tid = tid_l, lane = tid & 63, w = __builtin_amdgcn_readfirstlane(tid >> 6);
    const int r = lane & 31, h = lane >> 5, head = w >> 1, qi = (w & 1) * 32 + r, t = c * 64 + qi;
    const size_t row = (size_t)b * SEQ + t;
    LAS unsigned* SEL = (LAS unsigned*)(L + NM_SEL); LAS int* ITEM = (LAS int*)(L + NM_ITEM);
    const size_t kvbase = (size_t)(b * 2 + g) * SEQ * 64, ccbase = (size_t)(b * 2 + g) * 128 * 64;
    const int skey = tid >> 3, sch = tid & 7, soff = tile_off(skey, sch);
    bf16x8v qf[4];
    { const bf16* qp = MP_QN + row * 512 + (g * 4 + head) * 64 + 8 * h;
#pragma unroll
      for (int ks = 0; ks < 4; ++ks) qf[ks] = *(const bf16x8v*)(qp + 16 * ks); }
    const float* gp = MP_GATE + row * 32 + g * 4 + head;
    float one = 1.f; asm volatile("" : "+v"(one));
    const float gate_c = __builtin_amdgcn_rcpf(one + __expf(-gp[0])), gate_s = __builtin_amdgcn_rcpf(one + __expf(-gp[8])), gate_w = __builtin_amdgcn_rcpf(one + __expf(-gp[16]));
    f32x16 oacc[2];
    {
        const bf16* kc = MP_KC + ccbase; const bf16* vc = MP_VC + ccbase;
        const v4u k0 = *(const v4u*)(kc + tid * 8), k1 = *(const v4u*)(kc + 4096 + tid * 8), v0 = *(const v4u*)(vc + tid * 8), v1 = *(const v4u*)(vc + 4096 + tid * 8);
        LBAR();
        *(LAS v4u*)(L + NM_SLOT + soff) = k0; *(LAS v4u*)(L + NM_SLOT + 8192 + soff) = v0; *(LAS v4u*)(L + NM_SLOT + 16384 + soff) = k1; *(LAS v4u*)(L + NM_SLOT + 24576 + soff) = v1;
        if (tid < 64) SEL[tid] = 0u;
        LBAR();
        f32x16 s0, s1, s2, s3;
        { bf16x8v kfa[8], kfb[8]; k_load(L + NM_SLOT, r, h, kfa); k_load(L + NM_SLOT + 16384, r, h, kfb); SBAR(); qk_mma(kfa, qf, s0, s1); qk_mma(kfb, qf, s2, s3); }
        const int nlim = (t >= 31) ? (((t - 31) >> 4) < 126 ? ((t - 31) >> 4) : 126) : -1;
        float mx, mxv[4] = {-1e20f, -1e20f, -1e20f, -1e20f};
#pragma unroll
        for (int e = 0; e < 16; ++e) { const int cr = (e & 3) + 8 * (e >> 2) + 4 * h;
            s0[e] = (cr <= nlim) ? s0[e] * QK_SCALE : -1e30f; s1[e] = (cr + 32 <= nlim) ? s1[e] * QK_SCALE : -1e30f;
            s2[e] = (cr + 64 <= nlim) ? s2[e] * QK_SCALE : -1e30f; s3[e] = (cr + 96 <= nlim) ? s3[e] * QK_SCALE : -1e30f;
            mxv[e & 3] = fmaxf(fmaxf(mxv[e & 3], fmaxf(s0[e], s1[e])), fmaxf(s2[e], s3[e])); }
        mx = fmaxf(fmaxf(mxv[0], mxv[1]), fmaxf(mxv[2], mxv[3]));
        mx = xor32_max(mx);
        float ls, lsv[4] = {0.f, 0.f, 0.f, 0.f};
#pragma unroll
        for (int e = 0; e < 16; ++e) { s0[e] = __builtin_amdgcn_exp2f(s0[e] - mx); s1[e] = __builtin_amdgcn_exp2f(s1[e] - mx); s2[e] = __builtin_amdgcn_exp2f(s2[e] - mx); s3[e] = __builtin_amdgcn_exp2f(s3[e] - mx);
            lsv[e & 3] += (s0[e] + s1[e]) + (s2[e] + s3[e]); }
        ls = (lsv[0] + lsv[1]) + (lsv[2] + lsv[3]);
        ls = xor32_sum(ls);
        const float il = (ls > 0.f) ? __builtin_amdgcn_rcpf(ls) : 0.f;
#pragma unroll
        for (int e = 0; e < 16; ++e) { s0[e] *= il; s1[e] *= il; s2[e] *= il; s3[e] *= il; }
        { LAS float* IMP = (LAS float*)(L + NM_IMP) + (w * 32 + r) * 33; float plprev = 0.f;
#pragma unroll
          for (int x = 0; x < 16; ++x) {
              const f32x16& S = (x < 4) ? s0 : ((x < 8) ? s1 : ((x < 12) ? s2 : s3)); const int g4 = (x & 3) * 4;
              const float own = (S[g4] + S[g4 + 1]) + (S[g4 + 2] + S[g4 + 3]);
              const float pl = shx(S[g4 + 3], 32, lane);
              if (h == 1) IMP[2 * x + 1] = own + pl; else IMP[2 * x] = own + plprev;
              plprev = pl;
          }
        }
        oacc[0] = (f32x16){0.f, 0.f, 0.f, 0.f, 0.f, 0.f, 0.f, 0.f, 0.f, 0.f, 0.f, 0.f, 0.f, 0.f, 0.f, 0.f}; oacc[1] = oacc[0];
        { bf16x8v vfa[8], vfb[8]; v_load(L + NM_SLOT + 8192, lane, vfa); v_load(L + NM_SLOT + 24576, lane, vfb); SBAR(); pv_mma(vfa, s0, s1, oacc); pv_mma(vfb, s2, s3, oacc); }
#pragma unroll
        for (int e = 0; e < 16; ++e) { oacc[0][e] *= gate_c; oacc[1][e] *= gate_c; }
    }
    LBAR();
    { const int i = tid & 63, jg = tid >> 6; const LAS float* I8 = (const LAS float*)(L + NM_IMP); LAS float* IMS = (LAS float*)(L + NM_IMS);
#pragma unroll
      for (int jj = 0; jj < 4; ++jj) { const int j = 4 * jg + jj; const int wq = (i >> 5), rq = i & 31;
          IMS[i * 36 + j] = (I8[((0 + wq) * 32 + rq) * 33 + j] + I8[((2 + wq) * 32 + rq) * 33 + j]) + (I8[((4 + wq) * 32 + rq) * 33 + j] + I8[((6 + wq) * 32 + rq) * 33 + j]); }
      LBAR();
      unsigned bits = 0u;
      if (c + 1 <= 16) { if (jg == 0) bits = (1u << (c + 1)) - 1u; }
      else { if (jg == 0) bits = 1u | (1u << c) | (1u << (c - 1));
          { float iv[32];
#pragma unroll
            for (int q8 = 0; q8 < 8; ++q8) { const f32x4 x = *(const LAS f32x4*)(IMS + i * 36 + 4 * q8); iv[4 * q8] = x.x; iv[4 * q8 + 1] = x.y; iv[4 * q8 + 2] = x.z; iv[4 * q8 + 3] = x.w; }
#pragma unroll
            for (int jj = 0; jj < 4; ++jj) { const int j = 4 * jg + jj; const float vj = IMS[i * 36 + j]; int rank = 0;
#pragma unroll
                for (int i2 = 1; i2 < 30; ++i2) rank += (i2 <= c - 2 && (iv[i2] > vj || (iv[i2] == vj && i2 < j))) ? 1 : 0;
                if (j >= 1 && j <= c - 2 && rank < 13) bits |= 1u << j; } } }
      if (bits) atomicOr((unsigned*)&SEL[i], bits);
      LBAR();
      if (w == 0) { unsigned so = SEL[lane];
#pragma unroll
          for (int o2 = 32; o2; o2 >>= 1) so |= shxu(so, o2, lane);
          if (lane == 0) { int n = 0; for (int j = 0; j <= c; ++j) if ((so >> j) & 1u) ITEM[n++] = j; const int j0 = (c - 8 > 0) ? c - 8 : 0; for (int j = j0; j <= c; ++j) ITEM[n++] = 64 + j; ITEM[n] = -1; ITEM[47] = n; } }
      LBAR();
    }
    const unsigned mysel = SEL[qi]; const int nitem = ITEM[47];
    f32x16 o[2]; float m = -1e20f, lsum = 0.f; int prev_kind = 0;
    o[0] = (f32x16){0.f, 0.f, 0.f, 0.f, 0.f, 0.f, 0.f, 0.f, 0.f, 0.f, 0.f, 0.f, 0.f, 0.f, 0.f, 0.f}; o[1] = o[0];
    const int npair = (nitem + 1) >> 1;
    v4u rk0, rv0, rk1, rv1;
#define NSA_LOAD_PAIR(ip_) do { const int ia_ = ITEM[2 * (ip_)], ib_ = ITEM[2 * (ip_) + 1]; \
        { const bf16* kp = ((ia_ & 64) ? MP_KW : MP_KS) + kvbase + (size_t)(ia_ & 63) * 4096; const bf16* vp = ((ia_ & 64) ? MP_VW : MP_VS) + kvbase + (size_t)(ia_ & 63) * 4096; rk0 = *(const v4u*)(kp + tid * 8); rv0 = *(const v4u*)(vp + tid * 8); } \
        if (ib_ >= 0) { const bf16* kp = ((ib_ & 64) ? MP_KW : MP_KS) + kvbase + (size_t)(ib_ & 63) * 4096; const bf16* vp = ((ib_ & 64) ? MP_VW : MP_VS) + kvbase + (size_t)(ib_ & 63) * 4096; rk1 = *(const v4u*)(kp + tid * 8); rv1 = *(const v4u*)(vp + tid * 8); } } while (0)
#define NSA_WRITE_PAIR(sb_) do { *(LAS v4u*)(L + (sb_) + soff) = rk0; *(LAS v4u*)(L + (sb_) + 8192 + soff) = rv0; *(LAS v4u*)(L + (sb_) + 16384 + soff) = rk1; *(LAS v4u*)(L + (sb_) + 24576 + soff) = rv1; } while (0)
    rk1 = (v4u){0u, 0u, 0u, 0u}; rv1 = rk1;
    NSA_LOAD_PAIR(0);
    NSA_WRITE_PAIR(NM_SLOT + 32768);
    LBAR();
#pragma unroll 1
    for (int ip = 0; ip < npair; ++ip) {
        if (ip + 1 < npair) NSA_LOAD_PAIR(ip + 1);
        const int sbase = NM_SLOT + ((ip + 1) & 1) * 32768;
#pragma unroll 1
        for (int half = 0; half < 2; ++half) {
            const int item = ITEM[2 * ip + half];
            if (item < 0) break;
            const int kind = item >> 6, j = item & 63;
            if (kind != prev_kind) {
                const float tot = xor32_sum(lsum); const float sc = gate_s * __builtin_amdgcn_rcpf(tot);
#pragma unroll
                for (int e = 0; e < 16; ++e) { oacc[0][e] += o[0][e] * sc; oacc[1][e] += o[1][e] * sc; o[0][e] = 0.f; o[1][e] = 0.f; }
                m = -1e20f; lsum = 0.f; prev_kind = kind;
            }
            int klo, khi;
            if (kind == 0) { klo = 0; khi = ((mysel >> j) & 1u) ? ((j < c) ? 63 : qi) : -1; }
            else { klo = t - 511 - 64 * j; khi = t - 64 * j; if (khi > 63) khi = 63; if (klo < 0) klo = 0; }
            const LAS unsigned char* slot = L + sbase + half * 16384;
            if (__any(khi >= klo)) {
                f32x16 p0, p1; bf16x8v vf[8];
                { bf16x8v kf[8]; k_load(slot, r, h, kf); SBAR(); qk_mma(kf, qf, p0, p1); }
                v_load(slot + 8192, lane, vf); SBAR();
                if (!__all(klo == 0 && khi == 63)) {
                    const int a = klo - 4 * h, z = khi - 4 * h;
#pragma unroll
                    for (int e = 0; e < 16; ++e) { const int cr = (e & 3) + 8 * (e >> 2);
                        p0[e] = (cr >= a && cr <= z) ? p0[e] : -1e30f; p1[e] = (cr + 32 >= a && cr + 32 <= z) ? p1[e] : -1e30f; }
                }
                float tm;
                { float ma = max2f(p0[0], p1[0]), mb = max2f(p0[1], p1[1]), mc2 = max2f(p0[2], p1[2]), md = max2f(p0[3], p1[3]);
#pragma unroll
                  for (int e = 4; e < 16; e += 4) { ma = max3f(ma, p0[e], p1[e]); mb = max3f(mb, p0[e + 1], p1[e + 1]); mc2 = max3f(mc2, p0[e + 2], p1[e + 2]); md = max3f(md, p0[e + 3], p1[e + 3]); }
                  tm = max3f(ma, mb, max2f(mc2, md)); }
                tm = xor32_max(tm);
                const float mn = fmaxf(m, tm * QK_SCALE);
                if (!__all(mn == m)) { const float corr = __builtin_amdgcn_exp2f(m - mn); lsum *= corr;
#pragma unroll
                    for (int e = 0; e < 16; ++e) { o[0][e] *= corr; o[1][e] *= corr; }
                    m = mn; }
                { const f32x2v sc2 = {QK_SCALE, QK_SCALE}, mm2 = {m, m}; f32x2v ta = {0.f, 0.f}, tb = {0.f, 0.f};
#pragma unroll
                  for (int e = 0; e < 16; e += 2) { const f32x2v a0 = (f32x2v){p0[e], p0[e + 1]} * sc2 - mm2, a1 = (f32x2v){p1[e], p1[e + 1]} * sc2 - mm2; p0[e] = a0.x; p0[e + 1] = a0.y; p1[e] = a1.x; p1[e + 1] = a1.y; }
#pragma unroll
                  for (int e = 0; e < 16; ++e) { p0[e] = __builtin_amdgcn_exp2f(p0[e]); p1[e] = __builtin_amdgcn_exp2f(p1[e]); }
#pragma unroll
                  for (int e = 0; e < 16; e += 2) { ta += (f32x2v){p0[e], p0[e + 1]}; tb += (f32x2v){p1[e], p1[e + 1]}; }
                  lsum += (ta.x + ta.y) + (tb.x + tb.y); }
                SBAR(); pv_mma(vf, p0, p1, o);
            }
        }
        if (ip + 1 < npair) NSA_WRITE_PAIR(NM_SLOT + (ip & 1) * 32768);
        LBAR();
    }
#undef NSA_LOAD_PAIR
#undef NSA_WRITE_PAIR
    { const float tot = xor32_sum(lsum); const float sc = gate_w * __builtin_amdgcn_rcpf(tot);
#pragma unroll
      for (int e = 0; e < 16; ++e) { oacc[0][e] += o[0][e] * sc; oacc[1][e] += o[1][e] * sc; } }
    { bf16* yp = MP_Y + row * DM + (g * 4 + head) * 64 + 4 * h;
#pragma unroll
      for (int db = 0; db < 2; ++db)
#pragma unroll
          for (int g4 = 0; g4 < 4; ++g4) { v2u wv; wv.x = cvtpk(oacc[db][4 * g4], oacc[db][4 * g4 + 1]); wv.y = cvtpk(oacc[db][4 * g4 + 2], oacc[db][4 * g4 + 3]); *(v2u*)(yp + db * 32 + g4 * 8) = wv; } }
}

namespace ns3 {
using f32x16 = __attribute__((ext_vector_type(16))) float;
using bf16x8 = __attribute__((ext_vector_type(8))) short;
using s16x4 = __attribute__((ext_vector_type(4))) short;
using u32x4 = __attribute__((ext_vector_type(4))) unsigned;
typedef short v4i16_t __attribute__((ext_vector_type(4)));
typedef LAS const char* lds_cptr;
constexpr int NSLOT = 3, SLOTB = 8192;
constexpr int A_K = 0, A_V = NSLOT * SLOTB, A_WS = 2 * NSLOT * SLOTB, A_OST = A_WS + 8 * 64 * 4, A_END = A_OST + 8 * 8192;
constexpr int A_IMP = A_OST, A_IMS = A_OST + 33792, A_SEL = A_END, A_TTS = A_END + 512, A_TTW = A_TTS + 256;
#define SBAR3() __builtin_amdgcn_sched_barrier(0)
#define WAIT_BAR3(N) asm volatile("s_waitcnt vmcnt(" #N ") lgkmcnt(0)\n\ts_barrier":::"memory")
__device__ __forceinline__ int crow(int r, int hi) { return (r & 3) + 8 * (r >> 2) + 4 * hi; }
__device__ __forceinline__ void glds16(const void* gsrc, unsigned lds_dst) { unsigned keep;
  asm volatile("s_mov_b32 %0, m0\n\ts_mov_b32 m0, %2\n\ts_nop 0\n\tglobal_load_lds_dwordx4 %1, off\n\ts_mov_b32 m0, %0" : "=&s"(keep) : "v"(gsrc), "s"(lds_dst) : "memory"); }
__device__ __forceinline__ float fadd_s(float a, float b) { float r; asm("v_add_f32_e32 %0, %1, %2" : "=v"(r) : "v"(a), "v"(b)); return r; }
__device__ __forceinline__ float fsub_s(float a, float b) { float r; asm("v_sub_f32_e32 %0, %1, %2" : "=v"(r) : "v"(a), "v"(b)); return r; }
__device__ __forceinline__ s16x4 vtr(lds_cptr p) { return __builtin_bit_cast(s16x4, __builtin_amdgcn_ds_read_tr16_b64_v4i16((LAS v4i16_t*)p)); }
__device__ __forceinline__ void qkt(f32x16& p0, f32x16& p1, lds_cptr Kslot, const bf16x8* qr, const f32x16& negm, int r32, int hi) {
  lds_cptr kb = Kslot + hi * 1024 + r32 * 16;
#pragma unroll
  for (int d0 = 0; d0 < 4; ++d0) {
    const bf16x8 b0 = *(const LAS bf16x8*)(kb + d0 * 2048), b1 = *(const LAS bf16x8*)(kb + d0 * 2048 + 512);
    if (d0 == 0) { p0 = __builtin_amdgcn_mfma_f32_32x32x16_bf16(b0, qr[0], negm, 0, 0, 0); p1 = __builtin_amdgcn_mfma_f32_32x32x16_bf16(b1, qr[0], negm, 0, 0, 0); }
    else { p0 = __builtin_amdgcn_mfma_f32_32x32x16_bf16(b0, qr[d0], p0, 0, 0, 0); p1 = __builtin_amdgcn_mfma_f32_32x32x16_bf16(b1, qr[d0], p1, 0, 0, 0); } }
}
__device__ __forceinline__ void kload8(bf16x8* kf, lds_cptr kp) {
  kf[0] = *(const LAS bf16x8*)(kp);        kf[1] = *(const LAS bf16x8*)(kp + 512);
  kf[2] = *(const LAS bf16x8*)(kp + 2048); kf[3] = *(const LAS bf16x8*)(kp + 2560);
  kf[4] = *(const LAS bf16x8*)(kp + 4096); kf[5] = *(const LAS bf16x8*)(kp + 4608);
  kf[6] = *(const LAS bf16x8*)(kp + 6144); kf[7] = *(const LAS bf16x8*)(kp + 6656);
}
__device__ __forceinline__ void kload2(bf16x8* kf, lds_cptr kp, int j) { kf[2 * j] = *(const LAS bf16x8*)(kp + j * 2048); kf[2 * j + 1] = *(const LAS bf16x8*)(kp + j * 2048 + 512); }
__device__ __forceinline__ float rowmax(const f32x16& p0, const f32x16& p1) {
  float a = max3f(p0[0], p0[1], p1[0]), b = max3f(p0[2], p0[3], p1[1]); a = max3f(a, p1[2], p1[3]);
#pragma unroll
  for (int r = 4; r < 16; r += 4) { a = max3f(a, p0[r], p0[r + 1]); b = max3f(b, p0[r + 2], p0[r + 3]); a = max3f(a, p1[r], p1[r + 1]); b = max3f(b, p1[r + 2], p1[r + 3]); }
  return xor32_max(max2f(a, b));
}
__device__ __forceinline__ void pv(f32x16* o, int vb, bf16x8 pa0, bf16x8 pa1, bf16x8 pa2, bf16x8 pa3) {
#pragma unroll
  for (int d0 = 0; d0 < 2; ++d0) { s16x4 lo[4], hi[4];
#pragma unroll
    for (int ks = 0; ks < 4; ++ks) {
      asm volatile("ds_read_b64_tr_b16 %0,%1 offset:%c2" : "=&v"(lo[ks]) : "v"(vb), "i"(d0 * 4096 + ks * 1024) : "memory");
      asm volatile("ds_read_b64_tr_b16 %0,%1 offset:%c2" : "=&v"(hi[ks]) : "v"(vb), "i"(d0 * 4096 + ks * 1024 + 512) : "memory"); }
    asm volatile("s_waitcnt lgkmcnt(0)" ::: "memory"); SBAR3();
#define PK3(k) (bf16x8){lo[k][0], lo[k][1], lo[k][2], lo[k][3], hi[k][0], hi[k][1], hi[k][2], hi[k][3]}
    o[d0] = __builtin_amdgcn_mfma_f32_32x32x16_bf16(pa0, PK3(0), o[d0], 0, 0, 0);
    o[d0] = __builtin_amdgcn_mfma_f32_32x32x16_bf16(pa1, PK3(1), o[d0], 0, 0, 0);
    o[d0] = __builtin_amdgcn_mfma_f32_32x32x16_bf16(pa2, PK3(2), o[d0], 0, 0, 0);
    o[d0] = __builtin_amdgcn_mfma_f32_32x32x16_bf16(pa3, PK3(3), o[d0], 0, 0, 0);
#undef PK3
  }
}
template <int BR>
__device__ __forceinline__ void rmask(f32x16& p0, f32x16& p1, int e, unsigned mysel, int qi, int tq, int c, int hi) {
  const int kind = e >> 6, j = e & 63; const float NEG = -INFINITY;
  if (BR == 1) {
    int klo, khi;
    if (kind == 1) { klo = tq - 511 - 64 * j; khi = tq - 64 * j; if (khi > 63) khi = 63; if (klo < 0) klo = 0; }
    else { klo = 0; khi = -1; }
    if (!__all(klo == 0 && khi == 63)) { const int a = klo - 4 * hi, z = khi - 4 * hi;
#pragma unroll
      for (int r = 0; r < 16; ++r) { const int cr = (r & 3) + 8 * (r >> 2); if (cr < a || cr > z) p0[r] = NEG; if (cr + 32 < a || cr + 32 > z) p1[r] = NEG; } }
  } else {
    const bool on = (kind == 0) && ((mysel >> j) & 1u);
    const int z = on ? ((j == c) ? qi - 4 * hi : 64) : -1;
    if (!__all(z == 64)) {
#pragma unroll
      for (int r = 0; r < 16; ++r) { const int cr = (r & 3) + 8 * (r >> 2); p0[r] = (cr <= z) ? p0[r] : NEG; p1[r] = (cr + 32 <= z) ? p1[r] : NEG; }
    }
  }
}

template <int THRL, int BR>
__device__ __forceinline__ void stream(LAS unsigned char* L, const bf16* Kb, const bf16* Vb, const LAS int* TT, const int NT, const bf16x8 (&qr)[4],
                                       int lane, int wid, unsigned mysel, int qi, int tq, int c, float gate, bool first_write,
                                       const bf16* Knext  , const LAS int* TTnext,
                                       bool kpre  ) {
  const int r32 = lane & 31, hi = lane >> 5;
  const unsigned lds0 = (unsigned)(uintptr_t)L;
  LAS float* wsf = (LAS float*)(L + A_WS) + wid * 64;
  const bf16* ksrc = Kb + (long)lane * 64 + wid * 8;
  const bf16* vsrc = Vb + (long)(16 * (wid & 3) + (lane >> 2)) * 64 + (wid >> 2) * 32 + (lane & 3) * 8;
  const unsigned kdst = lds0 + A_K + wid * 1024, vdst = lds0 + A_V + wid * 1024;
#define TJ(x) ((long)(__builtin_amdgcn_readfirstlane(TT[(x)]) & 63) * 4096)
#define DMA_K(t, slot) glds16(ksrc + TJ(t), (unsigned)__builtin_amdgcn_readfirstlane(kdst + (slot)))
#define DMA_V(t, slot) glds16(vsrc + TJ(t), (unsigned)__builtin_amdgcn_readfirstlane(vdst + (slot)))
  const int vb0 = (int)(lds0 + A_V) + ((lane >> 4) & 1) * 32 + (lane & 3) * 8 + (4 * hi + ((lane & 15) >> 2)) * 64;
  bf16x8 kf[8];
  const lds_cptr shm3 = (lds_cptr)L; const lds_cptr kp0 = shm3 + A_K + hi * 1024 + r32 * 16; const lds_cptr vp0 = shm3 + A_V + ((lane >> 4) & 1) * 32 + (lane & 3) * 8 + (4 * hi + ((lane & 15) >> 2)) * 64;
  if (!kpre) { DMA_K(0, 0); DMA_V(0, 0); DMA_K(1, SLOTB); }
  float mhat = 0.f, l_reg = 0.f; f32x16 o[2]; o[0] = f32x16{}; o[1] = f32x16{}; f32x16 negm = f32x16{}; asm volatile("" : "+v"(negm));
#define CMASK(P0, P1, t) rmask<BR>(P0, P1, __builtin_amdgcn_readfirstlane(TT[(t)]), mysel, qi, tq, c, hi)
  bool resc = false;
#define START(P0, P1) do { const float rm = rowmax(P0, P1); resc = false; \
    { const float dl = rm; mhat = fadd_s(mhat, dl); \
      _Pragma("unroll") for (int r = 0; r < 16; ++r) { P0[r] = fsub_s(P0[r], dl); P1[r] = fsub_s(P1[r], dl); } \
      _Pragma("unroll") for (int r = 0; r < 16; ++r) negm[r] = -mhat; asm volatile("" : "+v"(negm)); } \
    _Pragma("unroll") for (int r = 0; r < 16; ++r) P0[r] = __builtin_amdgcn_exp2f(P0[r]); } while (0)
#define RESC() do { if (resc) { asm volatile("s_waitcnt lgkmcnt(0)" ::: "memory"); \
      _Pragma("unroll") for (int d_ = 0; d_ < 2; ++d_) _Pragma("unroll") for (int r = 0; r < 16; ++r) o[d_][r] *= wsf[crow(r, hi)]; } } while (0)
  f32x16 pA0, pA1, pB0, pB1;
  int sl_prev = 0, sl_cur = 0, sl_next = SLOTB;
#define ROT() do { sl_prev = sl_cur; sl_cur = sl_next; sl_next = (sl_next == (NSLOT - 1) * SLOTB) ? 0 : sl_next + SLOTB; } while (0)
  if (!kpre) { DMA_K(2, 2 * SLOTB); } else { DMA_V(0, 0); }
  WAIT_BAR3(3);
  qkt(pA0, pA1, shm3 + A_K, qr, negm, r32, hi); asm volatile("s_nop 15\n\ts_nop 7" : "+v"(pA0), "+v"(pA1)); CMASK(pA0, pA1, 0);
  START(pA0, pA1);
  _Pragma("unroll") for (int r = 0; r < 16; ++r) pA1[r] = __builtin_amdgcn_exp2f(pA1[r]);
  WAIT_BAR3(0);
  DMA_K(3, 0); DMA_V(1, SLOTB);
  ROT();
  kload8(kf, kp0 + sl_cur);
  WAIT_BAR3(2);
  s16x4 vlo[8], vhi[8]; u32x4 pw0, pw1, pw2, pw3;
#define PKW(P, B) cvtpk(P[B], P[B + 1])
#define PAF(k) __builtin_bit_cast(bf16x8, pw##k)
#define VFR(i) (bf16x8){vlo[i][0], vlo[i][1], vlo[i][2], vlo[i][3], vhi[i][0], vhi[i][1], vhi[i][2], vhi[i][3]}
#define PIN(x) asm volatile("" : "+v"(x))
#define MX3(a, b, c) __builtin_fmaxf(__builtin_fmaxf((a), (b)), (c))
#define GAPA(MF, A0, A1, A2, A3, W0, W1, PW) do { MF; sacc += A0; sacc += A1; sacc += A2; sacc += A3; PIN(sacc); W0; W1; PIN(PW); SBAR3(); } while (0)
#define EX(v) __builtin_amdgcn_exp2f(v)
#define GAPB(MF, X, B) do { MF; X[B] = EX(X[B]); X[B + 1] = EX(X[B + 1]); X[B + 2] = EX(X[B + 2]); X[B + 3] = EX(X[B + 3]); PIN(X); SBAR3(); } while (0)
#define VRD(i) do { vlo[i] = vtr(vp_ + (((i) >> 2) * 4096 + ((i) & 3) * 1024)); vhi[i] = vtr(vp_ + (((i) >> 2) * 4096 + ((i) & 3) * 1024 + 512)); } while (0)
#define KRD(G, j) do { if (G) { kload2(kf, kp0 + sl_next, j); SBAR3(); } } while (0)
#define STEP(C0, C1, P0, P1, t, GK, GV, GL) do { SBAR3(); \
    const lds_cptr vp_ = vp0 + sl_prev; \
    VRD(0); SBAR3(); float sacc = (P0[0] + P0[1]); \
    GAPA(C0 = __builtin_amdgcn_mfma_f32_32x32x16_bf16(kf[0], qr[0], negm, 0, 0, 0), P0[2], P0[3], P0[4], P0[5],     pw0[0] = PKW(P0, 0), pw0[1] = PKW(P0, 2), pw0); \
    VRD(4); SBAR3(); GAPA(C1 = __builtin_amdgcn_mfma_f32_32x32x16_bf16(kf[1], qr[0], negm, 0, 0, 0), P0[6], P0[7], P0[8], P0[9],     pw0[2] = PKW(P0, 4), pw0[3] = PKW(P0, 6), pw0); \
    VRD(1); SBAR3(); GAPA(C0 = __builtin_amdgcn_mfma_f32_32x32x16_bf16(kf[2], qr[1], C0, 0, 0, 0),   P0[10], P0[11], P0[12], P0[13], pw1[0] = PKW(P0, 8), pw1[1] = PKW(P0, 10), pw1); \
    VRD(5); SBAR3(); GAPA(C1 = __builtin_amdgcn_mfma_f32_32x32x16_bf16(kf[3], qr[1], C1, 0, 0, 0),   P0[14], P0[15], P1[0], P1[1],   pw1[2] = PKW(P0, 12), pw1[3] = PKW(P0, 14), pw1); \
    VRD(2); SBAR3(); GAPA(C0 = __builtin_amdgcn_mfma_f32_32x32x16_bf16(kf[4], qr[2], C0, 0, 0, 0),   P1[2], P1[3], P1[4], P1[5],     pw2[0] = PKW(P1, 0), pw2[1] = PKW(P1, 2), pw2); \
    VRD(6); SBAR3(); GAPA(C1 = __builtin_amdgcn_mfma_f32_32x32x16_bf16(kf[5], qr[2], C1, 0, 0, 0),   P1[6], P1[7], P1[8], P1[9],     pw2[2] = PKW(P1, 4), pw2[3] = PKW(P1, 6), pw2); \
    VRD(3); SBAR3(); GAPA(C0 = __builtin_amdgcn_mfma_f32_32x32x16_bf16(kf[6], qr[3], C0, 0, 0, 0),   P1[10], P1[11], P1[12], P1[13], pw3[0] = PKW(P1, 8), pw3[1] = PKW(P1, 10), pw3); \
    VRD(7); SBAR3(); GAPA(C1 = __builtin_amdgcn_mfma_f32_32x32x16_bf16(kf[7], qr[3], C1, 0, 0, 0),   P1[14], P1[15], 0.f, 0.f,       pw3[2] = PKW(P1, 12), pw3[3] = PKW(P1, 14), pw3); \
    l_reg += sacc; \
    if (GK) { DMA_K((t) + 3, sl_cur); } if (GV) { DMA_V((t) + 1, sl_next); } \
    CMASK(C0, C1, t); \
    { float a = MX3(C0[0], C0[1], C1[0]), b = MX3(C0[2], C0[3], C1[1]); a = MX3(a, C1[2], C1[3]); \
      _Pragma("unroll") for (int r = 4; r < 16; r += 4) { a = MX3(a, C0[r], C0[r + 1]); b = MX3(b, C0[r + 2], C0[r + 3]); a = MX3(a, C1[r], C1[r + 1]); b = MX3(b, C1[r + 2], C1[r + 3]); } \
      float rm = xor32_max(__builtin_fmaxf(a, b)); \
      resc = false; \
      if (__builtin_expect(__any(rm > (float)THRL), 0)) { const float dl = __builtin_fmaxf(rm, 0.f); mhat += dl; \
        _Pragma("unroll") for (int r = 0; r < 16; ++r) { C0[r] -= dl; C1[r] -= dl; } \
        _Pragma("unroll") for (int r = 0; r < 16; ++r) negm[r] = -mhat; asm volatile("" : "+v"(negm)); \
        const float f = __builtin_amdgcn_exp2f(-dl); l_reg *= f; if (hi == 0) wsf[r32] = f; resc = true; } } \
    SBAR3(); \
    GAPB(o[0] = __builtin_amdgcn_mfma_f32_32x32x16_bf16(PAF(0), VFR(0), o[0], 0, 0, 0), C0, 0); \
    GAPB(o[1] = __builtin_amdgcn_mfma_f32_32x32x16_bf16(PAF(0), VFR(4), o[1], 0, 0, 0), C0, 4); \
    KRD(GL, 0); GAPB(o[0] = __builtin_amdgcn_mfma_f32_32x32x16_bf16(PAF(1), VFR(1), o[0], 0, 0, 0), C0, 8); \
    KRD(GL, 1); GAPB(o[1] = __builtin_amdgcn_mfma_f32_32x32x16_bf16(PAF(1), VFR(5), o[1], 0, 0, 0), C0, 12); \
    KRD(GL, 2); GAPB(o[0] = __builtin_amdgcn_mfma_f32_32x32x16_bf16(PAF(2), VFR(2), o[0], 0, 0, 0), C1, 0); \
    KRD(GL, 3); GAPB(o[1] = __builtin_amdgcn_mfma_f32_32x32x16_bf16(PAF(2), VFR(6), o[1], 0, 0, 0), C1, 4); \
    GAPB(o[0] = __builtin_amdgcn_mfma_f32_32x32x16_bf16(PAF(3), VFR(3), o[0], 0, 0, 0), C1, 8); \
    GAPB(o[1] = __builtin_amdgcn_mfma_f32_32x32x16_bf16(PAF(3), VFR(7), o[1], 0, 0, 0), C1, 12); \
    } while (0)
#define ENDW(tt) do { if ((tt) + 3 < NT) { WAIT_BAR3(2); } else if ((tt) + 2 < NT) { WAIT_BAR3(1); } else { WAIT_BAR3(0); } } while (0)
  int t = 1;
#pragma unroll 1
  for (; t + 1 < NT; t += 2) {
    STEP(pB0, pB1, pA0, pA1, t, (t + 3 < NT), (t + 1 < NT), (t + 1 < NT));       ENDW(t);     RESC(); ROT();
    STEP(pA0, pA1, pB0, pB1, t + 1, (t + 4 < NT), (t + 2 < NT), (t + 2 < NT));   ENDW(t + 1); RESC(); ROT();
  }
#define TAIL(P0, P1, SLOT) do { float sacc = P0[0] + P0[1]; _Pragma("unroll") for (int r = 2; r < 16; ++r) sacc += P0[r]; _Pragma("unroll") for (int r = 0; r < 16; ++r) sacc += P1[r]; l_reg += sacc; \
    pw0 = (u32x4){PKW(P0, 0), PKW(P0, 2), PKW(P0, 4), PKW(P0, 6)}; pw1 = (u32x4){PKW(P0, 8), PKW(P0, 10), PKW(P0, 12), PKW(P0, 14)}; pw2 = (u32x4){PKW(P1, 0), PKW(P1, 2), PKW(P1, 4), PKW(P1, 6)}; pw3 = (u32x4){PKW(P1, 8), PKW(P1, 10), PKW(P1, 12), PKW(P1, 14)}; \
    SBAR3(); pv(o, vb0 + (SLOT), PAF(0), PAF(1), PAF(2), PAF(3)); } while (0)
  if (Knext) {
    const bf16* ks2 = Knext + (long)lane * 64 + wid * 8;
#define TJ2(x) ((long)(__builtin_amdgcn_readfirstlane(TTnext[(x)]) & 63) * 4096)
    glds16(ks2 + TJ2(0), (unsigned)__builtin_amdgcn_readfirstlane(kdst)); glds16(ks2 + TJ2(1), (unsigned)__builtin_amdgcn_readfirstlane(kdst + SLOTB)); glds16(ks2 + TJ2(2), (unsigned)__builtin_amdgcn_readfirstlane(kdst + 2 * SLOTB));
#undef TJ2
  }
  if (NT & 1) { TAIL(pA0, pA1, sl_prev); }
  else { STEP(pB0, pB1, pA0, pA1, NT - 1, false, false, false); RESC(); TAIL(pB0, pB1, sl_cur); }
#undef TAIL
#undef PKW
#undef PAF
#undef VFR
#undef PIN
#undef MX3
#undef GAPA
#undef GAPB
#undef EX
#undef VRD
#undef KRD
#undef STEP
#undef ENDW
  l_reg = xor32_sum(l_reg);
  if (hi == 0) wsf[32 + r32] = gate * __builtin_amdgcn_rcpf(l_reg);
  asm volatile("s_waitcnt lgkmcnt(0)" ::: "memory");
  { LAS float* stg = (LAS float*)(L + A_OST) + wid * 2048;
#pragma unroll
    for (int r = 0; r < 16; ++r) { const int orow = crow(r, hi); const float fl = wsf[32 + orow];
#pragma unroll
      for (int d0 = 0; d0 < 2; ++d0) { LAS float* p = stg + orow * 64 + d0 * 32 + r32; const float v = o[d0][r] * fl; *p = first_write ? v : (*p + v); } } }
  asm volatile("s_waitcnt lgkmcnt(0)\n\ts_barrier" ::: "memory");
#undef TJ
#undef DMA_K
#undef DMA_V
#undef CMASK
#undef START
#undef RESC
#undef ROT
}
}

__device__ __forceinline__ void nsa_unit_v3(LAS unsigned char* L, const MixPtrs& P, int b, int g, int c, int tid_in) {
    int tid_l = tid_in; asm volatile("" : "+v"(tid_l));
    const int tid = tid_l, lane = tid & 63, w = __builtin_amdgcn_readfirstlane(tid >> 6);
    const int r = lane & 31, h = lane >> 5, head = w >> 1, qi = (w & 1) * 32 + r, t = c * 64 + qi;
    const size_t row = (size_t)b * SEQ + t;
    LAS unsigned* SEL = (LAS unsigned*)(L + ns3::A_SEL); LAS int* TTS = (LAS int*)(L + ns3::A_TTS); LAS int* TTW = (LAS int*)(L + ns3::A_TTW);
    const size_t kvbase = (size_t)(b * 2 + g) * SEQ * 64, ccbase = (size_t)(b * 2 + g) * 128 * 64;
    const int skey = tid >> 3, sch = tid & 7, soff = tile_off(skey, sch);
    bf16x8v qf[4];
    { const bf16* qp = MP_QN + row * 512 + (g * 4 + head) * 64 + 8 * h;
#pragma unroll
      for (int ks = 0; ks < 4; ++ks) qf[ks] = *(const bf16x8v*)(qp + 16 * ks); }
    const float* gp = MP_GATE + row * 32 + g * 4 + head;
    float one = 1.f; asm volatile("" : "+v"(one));
    const float gate_c = __builtin_amdgcn_rcpf(one + __expf(-gp[0])), gate_s = __builtin_amdgcn_rcpf(one + __expf(-gp[8])), gate_w = __builtin_amdgcn_rcpf(one + __expf(-gp[16]));
    f32x16 oacc[2];
    const bool two = c >= 16;
    {
        const bf16* kc = MP_KC + ccbase; const bf16* vc = MP_VC + ccbase;
        const v4u k0 = *(const v4u*)(kc + tid * 8), v0 = *(const v4u*)(vc + tid * 8); v4u k1 = k0, v1 = v0;
        if (two) { k1 = *(const v4u*)(kc + 4096 + tid * 8); v1 = *(const v4u*)(vc + 4096 + tid * 8); }
        LBAR();
        *(LAS v4u*)(L + soff) = k0; *(LAS v4u*)(L + 8192 + soff) = v0; if (two) { *(LAS v4u*)(L + 16384 + soff) = k1; *(LAS v4u*)(L + 24576 + soff) = v1; }
        if (tid < 64) SEL[tid] = 0u;
        LBAR();
        f32x16 s0, s1, s2, s3;
        { bf16x8v kfa[8]; k_load(L, r, h, kfa); SBAR(); qk_mma(kfa, qf, s0, s1); }
        const int nlim = (t >= 31) ? (((t - 31) >> 4) < 126 ? ((t - 31) >> 4) : 126) : -1;
        if (two) {
            { bf16x8v kfb[8]; k_load(L + 16384, r, h, kfb); SBAR(); qk_mma(kfb, qf, s2, s3); }
            float mxv[4] = {-1e20f, -1e20f, -1e20f, -1e20f};
#pragma unroll
            for (int e = 0; e < 16; ++e) { const int cr = (e & 3) + 8 * (e >> 2) + 4 * h;
                s0[e] = (cr <= nlim) ? s0[e] : -1e30f; s1[e] = (cr + 32 <= nlim) ? s1[e] : -1e30f;
                s2[e] = (cr + 64 <= nlim) ? s2[e] : -1e30f; s3[e] = (cr + 96 <= nlim) ? s3[e] : -1e30f;
                mxv[e & 3] = max3f(max3f(mxv[e & 3], s0[e], s1[e]), s2[e], s3[e]); }
            const float mx = xor32_max(max3f(mxv[0], mxv[1], max2f(mxv[2], mxv[3])));
            float lsv[4] = {0.f, 0.f, 0.f, 0.f};
#pragma unroll
            for (int e = 0; e < 16; ++e) { s0[e] = __builtin_amdgcn_exp2f(s0[e] - mx); s1[e] = __builtin_amdgcn_exp2f(s1[e] - mx); s2[e] = __builtin_amdgcn_exp2f(s2[e] - mx); s3[e] = __builtin_amdgcn_exp2f(s3[e] - mx);
                lsv[e & 3] += (s0[e] + s1[e]) + (s2[e] + s3[e]); }
            const float ls = xor32_sum((lsv[0] + lsv[1]) + (lsv[2] + lsv[3]));
            const float il = (ls > 0.f) ? __builtin_amdgcn_rcpf(ls) : 0.f;
#pragma unroll
            for (int e = 0; e < 16; ++e) { s0[e] *= il; s1[e] *= il; s2[e] *= il; s3[e] *= il; }
        } else {
            float mxv[4] = {-1e20f, -1e20f, -1e20f, -1e20f};
#pragma unroll
            for (int e = 0; e < 16; ++e) { const int cr = (e & 3) + 8 * (e >> 2) + 4 * h;
                s0[e] = (cr <= nlim) ? s0[e] : -1e30f; s1[e] = (cr + 32 <= nlim) ? s1[e] : -1e30f;
                mxv[e & 3] = max3f(mxv[e & 3], s0[e], s1[e]); }
            const float mx = xor32_max(max3f(mxv[0], mxv[1], max2f(mxv[2], mxv[3])));
            float lsv[4] = {0.f, 0.f, 0.f, 0.f};
#pragma unroll
            for (int e = 0; e < 16; ++e) { s0[e] = __builtin_amdgcn_exp2f(s0[e] - mx); s1[e] = __builtin_amdgcn_exp2f(s1[e] - mx); lsv[e & 3] += s0[e] + s1[e]; s2[e] = 0.f; s3[e] = 0.f; }
            const float ls = xor32_sum((lsv[0] + lsv[1]) + (lsv[2] + lsv[3]));
            const float il = (ls > 0.f) ? __builtin_amdgcn_rcpf(ls) : 0.f;
#pragma unroll
            for (int e = 0; e < 16; ++e) { s0[e] *= il; s1[e] *= il; }
        }
        if (two) { LAS float* IMP = (LAS float*)(L + ns3::A_IMP) + (w * 32 + r) * 33; float plprev = 0.f;
#pragma unroll
          for (int x = 0; x < 16; ++x) {
              const f32x16& S = (x < 4) ? s0 : ((x < 8) ? s1 : ((x < 12) ? s2 : s3)); const int g4 = (x & 3) * 4;
              const float own = (S[g4] + S[g4 + 1]) + (S[g4 + 2] + S[g4 + 3]);
              const float pl = shx(S[g4 + 3], 32, lane);
              if (h == 1) IMP[2 * x + 1] = own + pl; else IMP[2 * x] = own + plprev;
              plprev = pl;
          }
        }
        oacc[0] = (f32x16){0.f, 0.f, 0.f, 0.f, 0.f, 0.f, 0.f, 0.f, 0.f, 0.f, 0.f, 0.f, 0.f, 0.f, 0.f, 0.f}; oacc[1] = oacc[0];
        { bf16x8v vfa[8]; v_load(L + 8192, lane, vfa); SBAR(); pv_mma(vfa, s0, s1, oacc); }
        if (two) { bf16x8v vfb[8]; v_load(L + 24576, lane, vfb); SBAR(); pv_mma(vfb, s2, s3, oacc); }
    }
    if (two) LBAR();
    { const int i = tid & 63, jg = tid >> 6; const LAS float* I8 = (const LAS float*)(L + ns3::A_IMP); LAS float* IMS = (LAS float*)(L + ns3::A_IMS);
      if (two) {
#pragma unroll
      for (int jj = 0; jj < 4; ++jj) { const int j = 4 * jg + jj; const int wq = (i >> 5), rq = i & 31;
          IMS[i * 36 + j] = (I8[((0 + wq) * 32 + rq) * 33 + j] + I8[((2 + wq) * 32 + rq) * 33 + j]) + (I8[((4 + wq) * 32 + rq) * 33 + j] + I8[((6 + wq) * 32 + rq) * 33 + j]); }
      LBAR(); }
      unsigned bits = 0u;
      if (c + 1 <= 16) { if (jg == 0) bits = (1u << (c + 1)) - 1u; }
      else { if (jg == 0) bits = 1u | (1u << c) | (1u << (c - 1));
          { float iv[32];
#pragma unroll
            for (int q8 = 0; q8 < 8; ++q8) { const f32x4 x = *(const LAS f32x4*)(IMS + i * 36 + 4 * q8); iv[4 * q8] = x.x; iv[4 * q8 + 1] = x.y; iv[4 * q8 + 2] = x.z; iv[4 * q8 + 3] = x.w; }
#pragma unroll
            for (int jj = 0; jj < 4; ++jj) { const int j = 4 * jg + jj; const float vj = IMS[i * 36 + j]; int rank = 0;
#pragma unroll
                for (int i2 = 1; i2 < 30; ++i2) rank += (i2 <= c - 2 && (iv[i2] > vj || (iv[i2] == vj && i2 < j))) ? 1 : 0;
                if (j >= 1 && j <= c - 2 && rank < 13) bits |= 1u << j; } } }
      if (bits) atomicOr((unsigned*)&SEL[i], bits);
      LBAR();
      if (w == 0) { unsigned so = SEL[lane];
#pragma unroll
          for (int o2 = 32; o2; o2 >>= 1) so |= shxu(so, o2, lane);
          { so &= (c >= 31) ? 0xffffffffu : ((2u << c) - 1u);
            const int n = __builtin_popcount(so), nt = (n < 4) ? 4 : n;
            if (lane < 32 && ((so >> lane) & 1u)) TTS[__builtin_popcount(so & ((1u << lane) - 1u))] = lane;
            if (lane >= n && lane < nt + 2) TTS[lane] = 128;
            const int j0 = (c - 8 > 0) ? c - 8 : 0, m2 = 1 + (c - j0), mt = (m2 < 4) ? 4 : m2;
            if (lane == 0) { TTS[46] = nt; TTW[0] = 64 + c; TTW[14] = mt; }
            else if (lane < m2) TTW[lane] = 64 + j0 + lane - 1;
            else if (lane < mt) TTW[lane] = 128; } }
      LBAR();
    }
    const unsigned mysel = SEL[qi]; const int nts = TTS[46], ntw = TTW[14];
    { LAS float* stg = (LAS float*)(L + ns3::A_OST) + w * 2048 + r * 64 + 4 * h;
#pragma unroll
      for (int db = 0; db < 2; ++db)
#pragma unroll
          for (int g4 = 0; g4 < 4; ++g4) *(LAS f32x4*)(stg + db * 32 + g4 * 8) = (f32x4){oacc[db][4 * g4] * gate_c, oacc[db][4 * g4 + 1] * gate_c, oacc[db][4 * g4 + 2] * gate_c, oacc[db][4 * g4 + 3] * gate_c}; }
#if PROBE_SC == 22
    const unsigned st0_ = (unsigned)__builtin_amdgcn_s_memrealtime();
#endif
    ns3::stream<8, 0>(L, MP_KS + kvbase, MP_VS + kvbase, TTS, nts, qf, lane, w, mysel, qi, t, c, gate_s, false, MP_KW + kvbase, TTW, false);
    ns3::stream<8, 1>(L, MP_KW + kvbase, MP_VW + kvbase, TTW, ntw, qf, lane, w, mysel, qi, t, c, gate_w, false, nullptr, nullptr, true);
#if PROBE_SC == 22
    if (tid == 0) { LAS unsigned* pm_ = (LAS unsigned*)(L + MISC_OFF) + 210; pm_[0] += (unsigned)__builtin_amdgcn_s_memrealtime() - st0_; pm_[1] += (unsigned)(nts + ntw); }
#endif
    { const LAS float* stg = (const LAS float*)(L + ns3::A_OST) + w * 2048; bf16* yb = MP_Y + ((size_t)b * SEQ + c * 64 + (w & 1) * 32) * DM + (g * 4 + head) * 64;
#pragma unroll
      for (int i4 = 0; i4 < 4; ++i4) { const int rr = i4 * 8 + (lane >> 3), ch = lane & 7; const f32x4 a = *(const LAS f32x4*)(stg + rr * 64 + ch * 8), bq = *(const LAS f32x4*)(stg + rr * 64 + ch * 8 + 4);
          v4u wv; wv.x = cvtpk(a.x, a.y); wv.y = cvtpk(a.z, a.w); wv.z = cvtpk(bq.x, bq.y); wv.w = cvtpk(bq.z, bq.w);
          *(v4u*)(yb + (size_t)rr * DM + ch * 8) = wv; } }
}

#define MFMA16(a, b, c) __builtin_amdgcn_mfma_f32_16x16x32_bf16((a), (b), (c), 0, 0, 0)
constexpr size_t WS_QC = 422 * MiB, WS_KC2 = 454 * MiB, WS_END2 = 486 * MiB; static_assert(WS_END2 <= WS_PART, "row-partial buffers follow");
#define MP_QC ((const bf16*)(P.ws + WS_QC))
#define MP_KC2 ((const bf16*)(P.ws + WS_KC2))
__device__ __forceinline__ int img_off(int row, int ch) { return 256 * row + 16 * (ch ^ (((row & 3) << 2) | ((row >> 2) & 3))); }
constexpr int M2_IMG = 0, M2_SC = 98304, M2_DEN = 106496, M2_QN = 107520, M2_N = 107776, M2_SSQ = 108288;

__device__ __forceinline__ void mlstm_conv_item(unsigned char* ws, const float* conv_w, const float* conv_b, int b, int tg, int isk, int ch0) {
    {
        const bf16* src = (const bf16*)(ws + (isk ? WS_MK : WS_MQ)) + (size_t)b * SEQ * 512 + ch0;
        bf16* dst = (bf16*)(ws + (isk ? WS_KC2 : WS_QC)) + ((size_t)(b * 4 + (ch0 >> 7)) * SEQ) * 128 + (ch0 & 127);
        float wt[4][8], bs[8];
#pragma unroll
        for (int j = 0; j < 4; ++j) { const f32x4 a = *(const f32x4*)(conv_w + j * 1024 + isk * 512 + ch0), c2 = *(const f32x4*)(conv_w + j * 1024 + isk * 512 + ch0 + 4);
            wt[j][0] = a.x; wt[j][1] = a.y; wt[j][2] = a.z; wt[j][3] = a.w; wt[j][4] = c2.x; wt[j][5] = c2.y; wt[j][6] = c2.z; wt[j][7] = c2.w; }
        { const f32x4 a = *(const f32x4*)(conv_b + isk * 512 + ch0), c2 = *(const f32x4*)(conv_b + isk * 512 + ch0 + 4); bs[0] = a.x; bs[1] = a.y; bs[2] = a.z; bs[3] = a.w; bs[4] = c2.x; bs[5] = c2.y; bs[6] = c2.z; bs[7] = c2.w; }
        const float osc = isk ? 0.08838834764831845f : 1.f;
        const int t0 = tg * 16;
        float x0[8], x1[8], x2[8];
#pragma unroll
        for (int e = 0; e < 8; ++e) { x0[e] = 0.f; x1[e] = 0.f; x2[e] = 0.f; }
        if (t0 > 0) {
            const v4u a = *(const v4u*)(src + (size_t)(t0 - 3) * 512), c2 = *(const v4u*)(src + (size_t)(t0 - 2) * 512), d2 = *(const v4u*)(src + (size_t)(t0 - 1) * 512);
            x0[0] = bflo(a.x); x0[1] = bfhi(a.x); x0[2] = bflo(a.y); x0[3] = bfhi(a.y); x0[4] = bflo(a.z); x0[5] = bfhi(a.z); x0[6] = bflo(a.w); x0[7] = bfhi(a.w);
            x1[0] = bflo(c2.x); x1[1] = bfhi(c2.x); x1[2] = bflo(c2.y); x1[3] = bfhi(c2.y); x1[4] = bflo(c2.z); x1[5] = bfhi(c2.z); x1[6] = bflo(c2.w); x1[7] = bfhi(c2.w);
            x2[0] = bflo(d2.x); x2[1] = bfhi(d2.x); x2[2] = bflo(d2.y); x2[3] = bfhi(d2.y); x2[4] = bflo(d2.z); x2[5] = bfhi(d2.z); x2[6] = bflo(d2.w); x2[7] = bfhi(d2.w);
        }
        v4u rows[16];
#pragma unroll
        for (int s = 0; s < 16; ++s) rows[s] = *(const v4u*)(src + (size_t)(t0 + s) * 512);
#pragma unroll
        for (int s = 0; s < 16; ++s) {
            const v4u a = rows[s];
            const float x3[8] = {bflo(a.x), bfhi(a.x), bflo(a.y), bfhi(a.y), bflo(a.z), bfhi(a.z), bflo(a.w), bfhi(a.w)};
            float o[8];
#pragma unroll
            for (int e = 0; e < 8; ++e) { float v = bs[e] + wt[0][e] * x0[e] + wt[1][e] * x1[e] + wt[2][e] * x2[e] + wt[3][e] * x3[e]; v = v * __builtin_amdgcn_rcpf(1.f + __expf(-v)); o[e] = v * osc; x0[e] = x1[e]; x1[e] = x2[e]; x2[e] = x3[e]; }
            v4u wv; wv.x = cvtpk(o[0], o[1]); wv.y = cvtpk(o[2], o[3]); wv.z = cvtpk(o[4], o[5]); wv.w = cvtpk(o[6], o[7]);
            *(v4u*)(dst + (size_t)(t0 + s) * 128) = wv;
        }
    }
}
__device__ __forceinline__ void mlstm_conv_pass(unsigned char* ws, const float* conv_w, const float* conv_b, int gthread, int nthreads) {
    for (int idx = gthread; idx < BATCH * 128 * 128; idx += nthreads) { const int cc = idx & 127, tg = (idx >> 7) & 127, b = idx >> 14; mlstm_conv_item(ws, conv_w, conv_b, b, tg, cc >> 6, (cc & 63) * 8); }
}
__device__ __forceinline__ void mlstm_conv_unit(unsigned char* ws, const float* conv_w, const float* conv_b, int b, int hh, int tid) {
#pragma unroll 1
    for (int idx = tid; idx < 4096; idx += 512) mlstm_conv_item(ws, conv_w, conv_b, b, idx >> 5, (idx >> 4) & 1, hh * 128 + (idx & 15) * 8);
}

constexpr int M2_A = 112384, M2_PM = 120576, M2_F = 128768, M2_BL = 136960, M2_AMX = 137088, M2_MC = 137216;
__device__ __forceinline__ void mlstm_unit_mfma(LAS unsigned char* L, const MixPtrs& P, int b, int hh, int tid_in) {
    int tid_l = tid_in; asm volatile("" : "+v"(tid_l));
    const int tid = tid_l, lane = tid & 63, w = __builtin_amdgcn_readfirstlane(tid >> 6), l15 = lane & 15, kg = lane >> 4;
    const size_t rb = (size_t)b * SEQ;
    const bf16* QCp = MP_QC + ((size_t)(b * 4 + hh) * SEQ) * 128; const bf16* KCp = MP_KC2 + ((size_t)(b * 4 + hh) * SEQ) * 128;
    const bf16* Vp = MP_MV + rb * 512 + hh * 128; const bf16* Op = MP_MO + rb * 512 + hh * 128 + 16 * w + 4 * kg;
    bf16* Yp = MP_Y + rb * DM + 512 + hh * 128 + 16 * w + 4 * kg;
    LAS float* DEN = (LAS float*)(L + M2_DEN); LAS float* QN = (LAS float*)(L + M2_QN); LAS float* NV = (LAS float*)(L + M2_N); LAS float* SSQ = (LAS float*)(L + M2_SSQ);
    LAS float* SA = (LAS float*)(L + M2_A); LAS float* SPM = (LAS float*)(L + M2_PM); LAS float* SF = (LAS float*)(L + M2_F);
    LAS float* SBL = (LAS float*)(L + M2_BL); LAS float* SAMX = (LAS float*)(L + M2_AMX); LAS float* SMC = (LAS float*)(L + M2_MC);
    float zf = 0.f; asm volatile("" : "+v"(zf));
    f32x4 Cacc[8], nacc = {zf, zf, zf, zf};
#pragma unroll
    for (int i = 0; i < 8; ++i) Cacc[i] = (f32x4){zf, zf, zf, zf};
    const f32x4 gn = *(const f32x4*)(P.mnorm_g + hh * 128 + 16 * w + 4 * kg);
    const int r0s = tid >> 4, c0s = tid & 15, so0 = img_off(r0s, c0s), so1 = img_off(r0s + 32, c0s);
    v4u sq0, sq1, sk0, sk1, sv0, sv1;
    sq0 = *(const v4u*)(QCp + (size_t)r0s * 128 + c0s * 8); sq1 = *(const v4u*)(QCp + (size_t)(r0s + 32) * 128 + c0s * 8);
    sk0 = *(const v4u*)(KCp + (size_t)r0s * 128 + c0s * 8); sk1 = *(const v4u*)(KCp + (size_t)(r0s + 32) * 128 + c0s * 8);
    sv0 = *(const v4u*)(Vp + (size_t)r0s * 512 + c0s * 8);  sv1 = *(const v4u*)(Vp + (size_t)(r0s + 32) * 512 + c0s * 8);
    LBAR();
    { const float ib = P.i_bias[hh], fb = P.f_bias[hh]; const float* Gp = MP_GATE + rb * 32 + hh;
#pragma unroll 1
      for (int cc = w; cc < 32; cc += 8) { const int tk = 64 * cc + lane;
          const float il = Gp[(size_t)tk * 32 + 24] + ib, fx = Gp[(size_t)tk * 32 + 28] + fb; const float fl = fminf(fx, 0.f) - log1pf(__expf(-fabsf(fx)));
          float f = fl;
#pragma unroll
          for (int o = 1; o < 64; o <<= 1) { const float v = shi(f, lane - o); if (lane >= o) f += v; }
          const float a = il - f; float pm = a;
#pragma unroll
          for (int o = 1; o < 64; o <<= 1) { const float v = shi(pm, lane - o); if (lane >= o) pm = fmaxf(pm, v); }
          SA[tk] = a; SPM[tk] = pm; SF[tk] = f; if (lane == 63) { SBL[cc] = f; SAMX[cc] = pm; } } }
    *(LAS v4u*)(L + M2_IMG + so0) = sq0; *(LAS v4u*)(L + M2_IMG + so1) = sq1; *(LAS v4u*)(L + M2_IMG + 16384 + so0) = sk0; *(LAS v4u*)(L + M2_IMG + 16384 + so1) = sk1;
    *(LAS v4u*)(L + M2_IMG + 32768 + so0) = sv0; *(LAS v4u*)(L + M2_IMG + 32768 + so1) = sv1;
    if (tid < 128) NV[tid] = zf;
    LBAR();
    if (tid == 0) { float mcar = zf; for (int cc = 0; cc < 32; ++cc) { SMC[cc] = mcar; mcar = SBL[cc] + fmaxf(mcar, SAMX[cc]); } }
    LBAR();
#pragma unroll 1
    for (int c = 0; c < 32; ++c) {
        int lc = lane; asm volatile("" : "+v"(lc));
        const int l15 = lc & 15, kg = lc >> 4, q4 = l15 >> 2, p4 = l15 & 3;
        const int t0 = c * 64; const LAS unsigned char* Qi = L + M2_IMG + (c & 1) * 49152; const LAS unsigned char* Ki = Qi + 16384; const LAS unsigned char* Vi = Qi + 32768;
        if (c + 1 < 32) { const int tn = t0 + 64;
            sq0 = *(const v4u*)(QCp + (size_t)(tn + r0s) * 128 + c0s * 8); sq1 = *(const v4u*)(QCp + (size_t)(tn + r0s + 32) * 128 + c0s * 8);
            sk0 = *(const v4u*)(KCp + (size_t)(tn + r0s) * 128 + c0s * 8); sk1 = *(const v4u*)(KCp + (size_t)(tn + r0s + 32) * 128 + c0s * 8);
            sv0 = *(const v4u*)(Vp + (size_t)(tn + r0s) * 512 + c0s * 8);  sv1 = *(const v4u*)(Vp + (size_t)(tn + r0s + 32) * 512 + c0s * 8); }
        const float mc = SMC[c], mxa = fmaxf(mc, SAMX[c]); const float cs = __expf(mc - mxa);
        { const int tblk = w >> 1, t = 16 * tblk + l15; const int sb0 = 2 * (w & 1);
          bf16x8v ka[2][4], qb[4];
#pragma unroll
          for (int ks = 0; ks < 4; ++ks) { qb[ks] = *(const LAS bf16x8v*)(Qi + img_off(t, 4 * ks + kg)); ka[0][ks] = *(const LAS bf16x8v*)(Ki + img_off(16 * sb0 + l15, 4 * ks + kg)); ka[1][ks] = *(const LAS bf16x8v*)(Ki + img_off(16 * sb0 + 16 + l15, 4 * ks + kg)); }
          const float Mt = fmaxf(SPM[t0 + t], mc);
          const f32x4 as0 = *(const LAS f32x4*)(SA + t0 + 16 * sb0 + 4 * kg), as1 = *(const LAS f32x4*)(SA + t0 + 16 * sb0 + 16 + 4 * kg);
          const int tq = tid >> 3, dp = tid & 7; const v4u q0 = *(const LAS v4u*)(Qi + img_off(tq, 2 * dp)), q1 = *(const LAS v4u*)(Qi + img_off(tq, 2 * dp + 1));
          const LAS f32x4* np = (const LAS f32x4*)(NV + 16 * dp); const f32x4 n0 = np[0], n1 = np[1], n2 = np[2], n3 = np[3];
          SBAR();
          LAS unsigned char* SC = L + M2_SC;
#pragma unroll
          for (int sb = 0; sb < 2; ++sb) { const int sblk = sb0 + sb; f32x4 acc = {0.f, 0.f, 0.f, 0.f}; float rp = 0.f; v2u wv; wv.x = 0u; wv.y = 0u;
              if (sblk <= tblk) {
#pragma unroll
                  for (int ks = 0; ks < 4; ++ks) acc = MFMA16(ka[sb][ks], qb[ks], acc);
                  const f32x4 as = sb ? as1 : as0; float v[4];
#pragma unroll
                  for (int e = 0; e < 4; ++e) { const float x = acc[e] * __expf(as[e] - Mt); v[e] = (sblk == tblk && 4 * kg + e > l15) ? 0.f : x; }
                  rp = (v[0] + v[1]) + (v[2] + v[3]); wv.x = cvtpk(v[0], v[1]); wv.y = cvtpk(v[2], v[3]);
              }
              rp += shx(rp, 16, lane); rp += shx(rp, 32, lane);
              *(LAS v2u*)(SC + t * 128 + (((2 * sblk + (kg >> 1)) ^ (t & 7)) << 4) + 8 * (kg & 1)) = wv;
              if (kg == 0) DEN[sblk * 64 + t] = rp; }
          { float s = bflo(q0.x) * n0.x + bfhi(q0.x) * n0.y + bflo(q0.y) * n0.z + bfhi(q0.y) * n0.w + bflo(q0.z) * n1.x + bfhi(q0.z) * n1.y + bflo(q0.w) * n1.z + bfhi(q0.w) * n1.w
                    + bflo(q1.x) * n2.x + bfhi(q1.x) * n2.y + bflo(q1.y) * n2.z + bfhi(q1.y) * n2.w + bflo(q1.z) * n3.x + bfhi(q1.z) * n3.y + bflo(q1.w) * n3.z + bfhi(q1.w) * n3.w;
            s += shx(s, 1, lane); s += shx(s, 2, lane); s += shx(s, 4, lane);
            if (dp == 0) QN[tq] = s; } }
        LBAR();
        v2u og[4];
#pragma unroll
        for (int tb = 0; tb < 4; ++tb) og[tb] = *(const v2u*)(Op + (size_t)(t0 + 16 * tb + l15) * 512);
        bf16x8v vf[2]; f32x4 hv[4];
        { float pmt[4], ft[4], dnp[4], qn4[4]; bf16x8v Cfrag[4];
#pragma unroll
          for (int kp = 0; kp < 4; ++kp) { v4u a; a.x = cvtpk(Cacc[2 * kp].x, Cacc[2 * kp].y); a.y = cvtpk(Cacc[2 * kp].z, Cacc[2 * kp].w); a.z = cvtpk(Cacc[2 * kp + 1].x, Cacc[2 * kp + 1].y); a.w = cvtpk(Cacc[2 * kp + 1].z, Cacc[2 * kp + 1].w);
              Cfrag[kp] = __builtin_bit_cast(bf16x8v, a); }
#pragma unroll
          for (int ks = 0; ks < 2; ++ks) { const int r0 = 32 * ks + 8 * kg;
              const s16x4v lo = tr_read(Vi + 256 * (r0 + q4) + 16 * ((2 * w + (p4 >> 1)) ^ ((q4 << 2) | ((r0 >> 2) & 3))) + 8 * (p4 & 1));
              const s16x4v hi = tr_read(Vi + 256 * (r0 + 4 + q4) + 16 * ((2 * w + (p4 >> 1)) ^ ((q4 << 2) | (((r0 + 4) >> 2) & 3))) + 8 * (p4 & 1));
              vf[ks] = __builtin_shufflevector(lo, hi, 0, 1, 2, 3, 4, 5, 6, 7); }
#pragma unroll
          for (int tb = 0; tb < 4; ++tb) { const int t = 16 * tb + l15; pmt[tb] = SPM[t0 + t]; ft[tb] = SF[t0 + t]; dnp[tb] = (DEN[t] + DEN[64 + t]) + (DEN[128 + t] + DEN[192 + t]); qn4[tb] = QN[t]; }
#pragma unroll
          for (int tp = 0; tp < 2; ++tp) {
              bf16x8v sf[2][2]; v2u qlo[2][4], qhi[2][4];
#pragma unroll
              for (int t2 = 0; t2 < 2; ++t2) { const int t = 16 * (2 * tp + t2) + l15; const int swz = ((t & 3) << 2) | ((t >> 2) & 3);
#pragma unroll
                  for (int ks = 0; ks < 2; ++ks) sf[t2][ks] = *(const LAS bf16x8v*)(L + M2_SC + t * 128 + (((4 * ks + kg) ^ (t & 7)) << 4));
#pragma unroll
                  for (int kp = 0; kp < 4; ++kp) { qlo[t2][kp] = *(const LAS v2u*)(Qi + 256 * t + 16 * ((4 * kp + (kg >> 1)) ^ swz) + 8 * (kg & 1)); qhi[t2][kp] = *(const LAS v2u*)(Qi + 256 * t + 16 * ((4 * kp + 2 + (kg >> 1)) ^ swz) + 8 * (kg & 1)); } }
              SBAR();
#pragma unroll
              for (int t2 = 0; t2 < 2; ++t2) { const int tb = 2 * tp + t2; f32x4 an = {0.f, 0.f, 0.f, 0.f}, a2 = {0.f, 0.f, 0.f, 0.f};
#pragma unroll
                  for (int ks = 0; ks < 2; ++ks) an = MFMA16(vf[ks], sf[t2][ks], an);
#pragma unroll
                  for (int kp = 0; kp < 4; ++kp) { v4u qq; qq.x = qlo[t2][kp].x; qq.y = qlo[t2][kp].y; qq.z = qhi[t2][kp].x; qq.w = qhi[t2][kp].y; a2 = MFMA16(Cfrag[kp], __builtin_bit_cast(bf16x8v, qq), a2); }
                  const float Mt = fmaxf(pmt[tb], mc), wp = __expf(mc - Mt), emt = __expf(-ft[tb] - Mt);
                  const float dn = dnp[tb] + wp * qn4[tb];
                  const float idn = __builtin_amdgcn_rcpf(fmaxf(fabsf(dn), emt));
                  hv[tb] = (an + a2 * wp) * idn;
                  float ss = (hv[tb].x * hv[tb].x + hv[tb].y * hv[tb].y) + (hv[tb].z * hv[tb].z + hv[tb].w * hv[tb].w);
                  ss += shx(ss, 16, lane); ss += shx(ss, 32, lane);
                  if (kg == 0) SSQ[((c & 1) * 8 + w) * 64 + 16 * tb + l15] = ss; }
              SBAR();
          } }
        { bf16x8v vpf[2], wkf[2];
          f32x4 aw[2][2];
#pragma unroll
          for (int ks = 0; ks < 2; ++ks) { aw[ks][0] = *(const LAS f32x4*)(SA + t0 + 32 * ks + 8 * kg); aw[ks][1] = *(const LAS f32x4*)(SA + t0 + 32 * ks + 8 * kg + 4); }
#pragma unroll
          for (int ks = 0; ks < 2; ++ks) { float wkv[8]; unsigned vp[4], wp2[4]; const v4u vu = __builtin_bit_cast(v4u, vf[ks]); const unsigned vw[4] = {vu.x, vu.y, vu.z, vu.w};
#pragma unroll
              for (int j = 0; j < 8; ++j) wkv[j] = __expf(aw[ks][j >> 2][j & 3] - mxa);
#pragma unroll
              for (int j2 = 0; j2 < 4; ++j2) { vp[j2] = cvtpk(bflo(vw[j2]) * wkv[2 * j2], bfhi(vw[j2]) * wkv[2 * j2 + 1]); wp2[j2] = cvtpk(wkv[2 * j2], wkv[2 * j2 + 1]); }
              v4u a; a.x = vp[0]; a.y = vp[1]; a.z = vp[2]; a.w = vp[3]; vpf[ks] = __builtin_bit_cast(bf16x8v, a);
              v4u b2; b2.x = wp2[0]; b2.y = wp2[1]; b2.z = wp2[2]; b2.w = wp2[3]; wkf[ks] = __builtin_bit_cast(bf16x8v, b2); }
          nacc = nacc * cs;
#pragma unroll
          for (int ih = 0; ih < 2; ++ih) {
              bf16x8v kf[4][2];
#pragma unroll
              for (int i4 = 0; i4 < 4; ++i4)
#pragma unroll
                  for (int ks = 0; ks < 2; ++ks) { const int i = 4 * ih + i4, r0 = 32 * ks + 8 * kg;
                      const s16x4v lo = tr_read(Ki + 256 * (r0 + q4) + 16 * ((2 * i + (p4 >> 1)) ^ ((q4 << 2) | ((r0 >> 2) & 3))) + 8 * (p4 & 1));
                      const s16x4v hi = tr_read(Ki + 256 * (r0 + 4 + q4) + 16 * ((2 * i + (p4 >> 1)) ^ ((q4 << 2) | (((r0 + 4) >> 2) & 3))) + 8 * (p4 & 1));
                      kf[i4][ks] = __builtin_shufflevector(lo, hi, 0, 1, 2, 3, 4, 5, 6, 7); }
              SBAR();
#pragma unroll
              for (int i4 = 0; i4 < 4; ++i4) { const int i = 4 * ih + i4; Cacc[i] = Cacc[i] * cs;
#pragma unroll
                  for (int ks = 0; ks < 2; ++ks) Cacc[i] = MFMA16(kf[i4][ks], vpf[ks], Cacc[i]); }
              SBAR();
          }
          { bf16x8v kw[2];
#pragma unroll
            for (int ks = 0; ks < 2; ++ks) { const int r0 = 32 * ks + 8 * kg;
                const s16x4v lo = tr_read(Ki + 256 * (r0 + q4) + 16 * ((2 * w + (p4 >> 1)) ^ ((q4 << 2) | ((r0 >> 2) & 3))) + 8 * (p4 & 1));
                const s16x4v hi = tr_read(Ki + 256 * (r0 + 4 + q4) + 16 * ((2 * w + (p4 >> 1)) ^ ((q4 << 2) | (((r0 + 4) >> 2) & 3))) + 8 * (p4 & 1));
                kw[ks] = __builtin_shufflevector(lo, hi, 0, 1, 2, 3, 4, 5, 6, 7); }
            nacc = MFMA16(kw[0], wkf[0], nacc); nacc = MFMA16(kw[1], wkf[1], nacc); }
          if (l15 == 0) *(LAS f32x4*)(NV + 16 * w + 4 * kg) = nacc;
 }
        if (c + 1 < 32) { LAS unsigned char* Nx = L + M2_IMG + ((c + 1) & 1) * 49152;
            *(LAS v4u*)(Nx + so0) = sq0; *(LAS v4u*)(Nx + so1) = sq1; *(LAS v4u*)(Nx + 16384 + so0) = sk0; *(LAS v4u*)(Nx + 16384 + so1) = sk1; *(LAS v4u*)(Nx + 32768 + so0) = sv0; *(LAS v4u*)(Nx + 32768 + so1) = sv1; }
        LBAR();
#pragma unroll
        for (int tb = 0; tb < 4; ++tb) { const int t = 16 * tb + l15; const LAS float* sp = SSQ + (c & 1) * 512 + t;
            const float tot = ((sp[0] + sp[64]) + (sp[128] + sp[192])) + ((sp[256] + sp[320]) + (sp[384] + sp[448]));
            const float rn = __frsqrt_rn(tot * (1.f / 128.f) + EPS);
            const float y0 = hv[tb].x * rn * gn.x * sigmoidf_(bflo(og[tb].x)), y1 = hv[tb].y * rn * gn.y * sigmoidf_(bfhi(og[tb].x)), y2 = hv[tb].z * rn * gn.z * sigmoidf_(bflo(og[tb].y)), y3 = hv[tb].w * rn * gn.w * sigmoidf_(bfhi(og[tb].y));
            v2u wv; wv.x = cvtpk(y0, y1); wv.y = cvtpk(y2, y3);
            *(v2u*)(Yp + (size_t)(t0 + t) * DM) = wv; }
    }
    LBAR();
}

__device__ __forceinline__ bf16x8v pack8(const f32x16& x, int s2) { v4u p; p.x = cvtpk(x[8 * s2 + 0], x[8 * s2 + 1]); p.y = cvtpk(x[8 * s2 + 2], x[8 * s2 + 3]); p.z = cvtpk(x[8 * s2 + 4], x[8 * s2 + 5]); p.w = cvtpk(x[8 * s2 + 6], x[8 * s2 + 7]); return __builtin_bit_cast(bf16x8v, p); }
__device__ __forceinline__ int tr32_off(int lane, int c, int ks, int t) { const int h = lane >> 5, blk = (lane >> 4) & 1, q = (lane & 15) >> 2, p = lane & 3; return img_off(16 * ks + 8 * h + 4 * t + q, 4 * c + 2 * blk + (p >> 1)) + 8 * (p & 1); }
__device__ __forceinline__ bf16x8v tr32_frag(const LAS unsigned char* img, int lane, int c, int ks) { const s16x4v lo = tr_read(img + tr32_off(lane, c, ks, 0)), hi = tr_read(img + tr32_off(lane, c, ks, 1)); return __builtin_shufflevector(lo, hi, 0, 1, 2, 3, 4, 5, 6, 7); }
constexpr int M3_DEN = M2_DEN  , M3_SSQ = M2_SSQ  ;

__device__ __forceinline__ void mlstm_unit_v3(LAS unsigned char* L, const MixPtrs& P, int b, int hh, int tid_in) {
    int tid_l = tid_in; asm volatile("" : "+v"(tid_l));
    const int tid = tid_l, lane = tid & 63, w = __builtin_amdgcn_readfirstlane(tid >> 6);
    const size_t rb = (size_t)b * SEQ;
    const bf16* QCp = MP_QC + ((size_t)(b * 4 + hh) * SEQ) * 128; const bf16* KCp = MP_KC2 + ((size_t)(b * 4 + hh) * SEQ) * 128;
    const bf16* Vp = MP_MV + rb * 512 + hh * 128;
    LAS float* DEN = (LAS float*)(L + M3_DEN); LAS float* QN = (LAS float*)(L + M2_QN); LAS float* NV = (LAS float*)(L + M2_N); LAS float* SSQ = (LAS float*)(L + M3_SSQ);
    LAS float* SA = (LAS float*)(L + M2_A); LAS float* SPM = (LAS float*)(L + M2_PM); LAS float* SF = (LAS float*)(L + M2_F);
    LAS float* SBL = (LAS float*)(L + M2_BL); LAS float* SAMX = (LAS float*)(L + M2_AMX); LAS float* SMC = (LAS float*)(L + M2_MC);
    float zf = 0.f; asm volatile("" : "+v"(zf));
    const bool isCD = w < 4; const int jw = w & 3;
    f32x16 Cacc[4]; bf16x8v vfk[4];
#pragma unroll
    for (int i = 0; i < 4; ++i) { vfk[i] = (bf16x8v){0, 0, 0, 0, 0, 0, 0, 0};
#pragma unroll
        for (int e = 0; e < 16; ++e) Cacc[i][e] = zf; }
    const int r0s = tid >> 4, c0s = tid & 15, so0 = img_off(r0s, c0s), so1 = img_off(r0s + 32, c0s);
    v4u sq0, sq1, sk0, sk1, sv0, sv1;
    sq0 = *(const v4u*)(QCp + (size_t)r0s * 128 + c0s * 8); sq1 = *(const v4u*)(QCp + (size_t)(r0s + 32) * 128 + c0s * 8);
    sk0 = *(const v4u*)(KCp + (size_t)r0s * 128 + c0s * 8); sk1 = *(const v4u*)(KCp + (size_t)(r0s + 32) * 128 + c0s * 8);
    sv0 = *(const v4u*)(Vp + (size_t)r0s * 512 + c0s * 8);  sv1 = *(const v4u*)(Vp + (size_t)(r0s + 32) * 512 + c0s * 8);
    LBAR();
    { const float ib = P.i_bias[hh], fb = P.f_bias[hh]; const float* Gp = MP_GATE + rb * 32 + hh;
#pragma unroll 1
      for (int cc = w; cc < 32; cc += 8) { const int tk = 64 * cc + lane;
          const float il = Gp[(size_t)tk * 32 + 24] + ib, fx = Gp[(size_t)tk * 32 + 28] + fb; const float fl = fminf(fx, 0.f) - log1pf(__expf(-fabsf(fx)));
          float f = fl;
#pragma unroll
          for (int o = 1; o < 64; o <<= 1) { const float v = shi(f, lane - o); if (lane >= o) f += v; }
          const float a = il - f; float pm = a;
#pragma unroll
          for (int o = 1; o < 64; o <<= 1) { const float v = shi(pm, lane - o); if (lane >= o) pm = fmaxf(pm, v); }
          SA[tk] = a; SPM[tk] = pm; SF[tk] = f; if (lane == 63) { SBL[cc] = f; SAMX[cc] = pm; } } }
    *(LAS v4u*)(L + M2_IMG + so0) = sq0; *(LAS v4u*)(L + M2_IMG + so1) = sq1; *(LAS v4u*)(L + M2_IMG + 16384 + so0) = sk0; *(LAS v4u*)(L + M2_IMG + 16384 + so1) = sk1;
    *(LAS v4u*)(L + M2_IMG + 32768 + so0) = sv0; *(LAS v4u*)(L + M2_IMG + 32768 + so1) = sv1;
    if (tid < 128) NV[tid] = zf;
    LBAR();
    if (tid == 0) { float mcar = zf; for (int cc = 0; cc < 32; ++cc) { SMC[cc] = mcar; mcar = SBL[cc] + fmaxf(mcar, SAMX[cc]); } }
    LBAR();
    f32x16 hv[2];
    hv[0] = Cacc[0]; hv[1] = Cacc[0];
    v2u og[2][4];
#pragma unroll
    for (int tt = 0; tt < 2; ++tt)
#pragma unroll
        for (int g = 0; g < 4; ++g) og[tt][g] = (v2u){0u, 0u};
#define MLSTM_NORM_STORE(cc) do { const int r32_ = lane & 31, hi_ = lane >> 5; \
        bf16* Yp = MP_Y + rb * DM + 512 + hh * 128 + 32 * jw + 4 * hi_; const float* gnp = P.mnorm_g + hh * 128 + 32 * jw + 4 * hi_; \
        f32x4 gn4[4]; \
        _Pragma("unroll") for (int g = 0; g < 4; ++g) gn4[g] = *(const f32x4*)(gnp + 8 * g); \
        _Pragma("unroll") for (int tt = 0; tt < 2; ++tt) { const int t = 32 * tt + r32_; const LAS float* sp = SSQ + ((cc) & 1) * 256 + t; \
            const float rn = __frsqrt_rn(((sp[0] + sp[64]) + (sp[128] + sp[192])) * (1.f / 128.f) + EPS); \
            _Pragma("unroll") for (int g = 0; g < 4; ++g) { const float y0 = hv[tt][4 * g] * rn * gn4[g].x * sigmoidf_(bflo(og[tt][g].x)), y1 = hv[tt][4 * g + 1] * rn * gn4[g].y * sigmoidf_(bfhi(og[tt][g].x)); \
                const float y2 = hv[tt][4 * g + 2] * rn * gn4[g].z * sigmoidf_(bflo(og[tt][g].y)), y3 = hv[tt][4 * g + 3] * rn * gn4[g].w * sigmoidf_(bfhi(og[tt][g].y)); \
                v2u wv; wv.x = cvtpk(y0, y1); wv.y = cvtpk(y2, y3); \
                *(v2u*)(Yp + (size_t)((cc) * 64 + t) * DM + 8 * g) = wv; } } } while (0)
#pragma unroll 1
    for (int c = 0; c < 32; ++c) {
        int lc = lane; asm volatile("" : "+v"(lc));
        const int r32 = lc & 31, hi = lc >> 5;
        const int t0 = c * 64; const LAS unsigned char* Qi = L + M2_IMG + (c & 1) * 49152; const LAS unsigned char* Ki = Qi + 16384; const LAS unsigned char* Vi = Qi + 32768;
        const LAS unsigned char* Kp = L + M2_IMG + ((c + 1) & 1) * 49152 + 16384;
        if (c + 1 < 32) { const int tn = t0 + 64;
            sq0 = *(const v4u*)(QCp + (size_t)(tn + r0s) * 128 + c0s * 8); sq1 = *(const v4u*)(QCp + (size_t)(tn + r0s + 32) * 128 + c0s * 8);
            sk0 = *(const v4u*)(KCp + (size_t)(tn + r0s) * 128 + c0s * 8); sk1 = *(const v4u*)(KCp + (size_t)(tn + r0s + 32) * 128 + c0s * 8);
            sv0 = *(const v4u*)(Vp + (size_t)(tn + r0s) * 512 + c0s * 8);  sv1 = *(const v4u*)(Vp + (size_t)(tn + r0s + 32) * 512 + c0s * 8); }
        const float mc = SMC[c];
        if (isCD) {
            if (c > 0) { const int t0p = t0 - 64; const float mcp = SMC[c - 1], mxap = fmaxf(mcp, SAMX[c - 1]); const float csp = __expf(mcp - mxap);
                bf16x8v vfp[4];
#pragma unroll
                for (int ks = 0; ks < 4; ++ks) { const f32x4 a0 = *(const LAS f32x4*)(SA + t0p + 16 * ks + 8 * hi), a1 = *(const LAS f32x4*)(SA + t0p + 16 * ks + 8 * hi + 4);
                    const float wk[8] = {__expf(a0.x - mxap), __expf(a0.y - mxap), __expf(a0.z - mxap), __expf(a0.w - mxap), __expf(a1.x - mxap), __expf(a1.y - mxap), __expf(a1.z - mxap), __expf(a1.w - mxap)};
                    const v4u vu = __builtin_bit_cast(v4u, vfk[ks]); v4u o4;
                    o4.x = cvtpk(bflo(vu.x) * wk[0], bfhi(vu.x) * wk[1]); o4.y = cvtpk(bflo(vu.y) * wk[2], bfhi(vu.y) * wk[3]); o4.z = cvtpk(bflo(vu.z) * wk[4], bfhi(vu.z) * wk[5]); o4.w = cvtpk(bflo(vu.w) * wk[6], bfhi(vu.w) * wk[7]);
                    vfp[ks] = __builtin_bit_cast(bf16x8v, o4); }
#pragma unroll
                for (int dt = 0; dt < 4; ++dt) { bf16x8v kf[4];
#pragma unroll
                    for (int ks = 0; ks < 4; ++ks) kf[ks] = tr32_frag(Kp, lc, dt, ks);
                    SBAR();
#pragma unroll
                    for (int e = 0; e < 16; ++e) Cacc[dt][e] *= csp;
#pragma unroll
                    for (int ks = 0; ks < 4; ++ks) Cacc[dt] = MFMA32(kf[ks], vfp[ks], Cacc[dt]);
                    SBAR(); }
                MLSTM_NORM_STORE(c - 1); }
        } else if (jw != 2) {
            const int st = (jw == 3) ? 1 : 0, tt = (jw == 0) ? 0 : 1; const int t = 32 * tt + r32;
            const float Mt = fmaxf(SPM[t0 + t], mc);
            f32x4 as4[4];
#pragma unroll
            for (int g = 0; g < 4; ++g) as4[g] = *(const LAS f32x4*)(SA + t0 + 32 * st + 8 * g + 4 * hi);
            f32x16 acc;
#pragma unroll
            for (int e = 0; e < 16; ++e) acc[e] = 0.f;
#pragma unroll
            for (int kh = 0; kh < 2; ++kh) { bf16x8v ka[4], qb[4];
#pragma unroll
                for (int k4 = 0; k4 < 4; ++k4) { const int ks = 4 * kh + k4; ka[k4] = *(const LAS bf16x8v*)(Ki + img_off(32 * st + r32, 2 * ks + hi)); qb[k4] = *(const LAS bf16x8v*)(Qi + img_off(t, 2 * ks + hi)); }
                SBAR();
#pragma unroll
                for (int k4 = 0; k4 < 4; ++k4) acc = MFMA32(ka[k4], qb[k4], acc);
                SBAR(); }
            float rp = 0.f;
#pragma unroll
            for (int g = 0; g < 4; ++g) { float v[4];
#pragma unroll
                for (int e = 0; e < 4; ++e) { const float x = acc[4 * g + e] * __expf(as4[g][e] - Mt); v[e] = (st == tt && (8 * g + 4 * hi + e) > r32) ? 0.f : x; rp += v[e]; }
                v2u wv; wv.x = cvtpk(v[0], v[1]); wv.y = cvtpk(v[2], v[3]);
                *(LAS v2u*)(L + M2_SC + t * 128 + (((4 * st + g) ^ (t & 7)) << 4) + 8 * hi) = wv; }
            rp = xor32_sum(rp);
            if (hi == 0) DEN[st * 64 + t] = rp;
        } else {
            { const v4u z4 = {0u, 0u, 0u, 0u};
              *(LAS v4u*)(L + M2_SC + r32 * 128 + (((4 + 2 * hi) ^ (r32 & 7)) << 4)) = z4; *(LAS v4u*)(L + M2_SC + r32 * 128 + (((5 + 2 * hi) ^ (r32 & 7)) << 4)) = z4;
              if (hi == 0) DEN[64 + r32] = 0.f; }
            float qn = 0.f;
#pragma unroll 4
            for (int ch = 0; ch < 16; ++ch) { const v4u q8 = *(const LAS v4u*)(Qi + img_off(lc, ch)); const f32x4 n0 = *(const LAS f32x4*)(NV + 8 * ch), n1 = *(const LAS f32x4*)(NV + 8 * ch + 4);
                qn += bflo(q8.x) * n0.x + bfhi(q8.x) * n0.y + bflo(q8.y) * n0.z + bfhi(q8.y) * n0.w + bflo(q8.z) * n1.x + bfhi(q8.z) * n1.y + bflo(q8.w) * n1.z + bfhi(q8.w) * n1.w; }
            QN[lc] = qn;
            const float mxa = fmaxf(mc, SAMX[c]), cs = __expf(mc - mxa); const float wkl = __expf(SA[t0 + lc] - mxa);
            const f32x2v nold = *(const LAS f32x2v*)(NV + 2 * lc); float n0a = 0.f, n1a = 0.f;
#pragma unroll
            for (int s = 0; s < 64; ++s) { const unsigned kk = *(const LAS unsigned*)(Ki + img_off(s, lc >> 2) + (lc & 3) * 4); const float ws = __builtin_bit_cast(float, __builtin_amdgcn_readlane(__builtin_bit_cast(int, wkl), s)); n0a += ws * bflo(kk); n1a += ws * bfhi(kk); }
            LDS_WAIT();
            *(LAS f32x2v*)(NV + 2 * lc) = (f32x2v){cs * nold.x + n0a, cs * nold.y + n1a};
        }
        LBAR();
        if (isCD) {
#pragma unroll
            for (int ks = 0; ks < 4; ++ks) vfk[ks] = tr32_frag(Vi, lc, jw, ks);
#pragma unroll
            for (int tt = 0; tt < 2; ++tt) { const int t = 32 * tt + r32;
                bf16x8v scf[4];
#pragma unroll
                for (int ks = 0; ks < 4; ++ks) scf[ks] = *(const LAS bf16x8v*)(L + M2_SC + t * 128 + (((2 * ks + hi) ^ (t & 7)) << 4));
                const float pmt = SPM[t0 + t], ft = SF[t0 + t], dnp = DEN[t] + DEN[64 + t], qnt = QN[t];
                f32x16 a1, a2;
#pragma unroll
                for (int e = 0; e < 16; ++e) { a1[e] = 0.f; a2[e] = 0.f; }
#pragma unroll
                for (int kh = 0; kh < 2; ++kh) { v2u ql[4], qh[4];
#pragma unroll
                    for (int k4 = 0; k4 < 4; ++k4) { const int k8 = 4 * kh + k4; ql[k4] = *(const LAS v2u*)(Qi + img_off(t, 2 * k8) + 8 * hi); qh[k4] = *(const LAS v2u*)(Qi + img_off(t, 2 * k8 + 1) + 8 * hi); }
                    SBAR();
                    if (kh == 0) {
#pragma unroll
                        for (int ks = 0; ks < 4; ++ks) a1 = MFMA32(vfk[ks], scf[ks], a1); }
#pragma unroll
                    for (int k4 = 0; k4 < 4; ++k4) { const int k8 = 4 * kh + k4; v4u qq; qq.x = ql[k4].x; qq.y = ql[k4].y; qq.z = qh[k4].x; qq.w = qh[k4].y; a2 = MFMA32(pack8(Cacc[k8 >> 1], k8 & 1), __builtin_bit_cast(bf16x8v, qq), a2); }
                    SBAR(); }
                const float Mt = fmaxf(pmt, mc), wp = __expf(mc - Mt), emt = __expf(-ft - Mt);
                const float idn = __builtin_amdgcn_rcpf(fmaxf(fabsf(dnp + wp * qnt), emt));
                float ss = 0.f;
#pragma unroll
                for (int e = 0; e < 16; ++e) { const float x = (a1[e] + a2[e] * wp) * idn; hv[tt][e] = x; ss += x * x; }
                ss = xor32_sum(ss);
                if (hi == 0) SSQ[((c & 1) * 4 + jw) * 64 + t] = ss;
                SBAR(); }
            { const bf16* Op = MP_MO + rb * 512 + hh * 128 + 32 * jw + 4 * hi;
#pragma unroll
              for (int tt = 0; tt < 2; ++tt)
#pragma unroll
                  for (int g = 0; g < 4; ++g) og[tt][g] = *(const v2u*)(Op + (size_t)(t0 + 32 * tt + r32) * 512 + 8 * g); }
        }
        if (c + 1 < 32) { LAS unsigned char* Nx = L + M2_IMG + ((c + 1) & 1) * 49152;
            *(LAS v4u*)(Nx + so0) = sq0; *(LAS v4u*)(Nx + so1) = sq1; *(LAS v4u*)(Nx + 16384 + so0) = sk0; *(LAS v4u*)(Nx + 16384 + so1) = sk1; *(LAS v4u*)(Nx + 32768 + so0) = sv0; *(LAS v4u*)(Nx + 32768 + so1) = sv1; }
        LBAR();
    }
    if (isCD) MLSTM_NORM_STORE(31);
#undef MLSTM_NORM_STORE
    LBAR();
}

#ifndef MK_MULTI
#define MK_MULTI 0
#endif
#define REP_IF(k) for (int rep_ = 0; rep_ < ((PROBE_DUP == (k)) ? 2 : 1); ++rep_)
constexpr int PH_PER_LAYER = 8, N_PHASES = 1 + DEPTH * PH_PER_LAYER;
struct Args { const float* in[16]; float* out; unsigned char* ws; int ph_lo, ph_hi; };
static_assert(sizeof(Args) == 16 * 8 + 8 + 8 + 8, "Args has no padding");

__global__ void __launch_bounds__(NWAVES * 64, 2) fwd_kernel(Args args) {
    extern __shared__ __attribute__((aligned(16))) unsigned char lds_raw[];
    LAS unsigned char* L = (LAS unsigned char*)lds_raw;
    const int G0 = gridDim.x, blk0 = blockIdx.x;
    const int wave0 = __builtin_amdgcn_readfirstlane((int)threadIdx.x >> 6);
#define PH_IDS() PH_WS(); int wave = wave0; asm volatile("" : "+s"(wave)); const int lane = fresh_lane(), tid = wave * 64 + lane, gw = blk * NWAVES + wave; (void)gw
#define PH_WS() size_t zoff_ = 0; asm volatile("" : "+s"(zoff_)); unsigned char* ws = (unsigned char*)__builtin_assume_aligned(args.ws, 256) + zoff_; int blk = blk0, G = G0; asm volatile("" : "+s"(blk), "+s"(G)); const int NGW = G * NWAVES; (void)NGW; bf16* X16 = (bf16*)(ws + WS_X16); float* SS2 = (float*)(ws + WS_TAB + TAB_SS2); bf16* U = (bf16*)(ws + WS_U); bf16* HB = (bf16*)(ws + WS_HB); bf16* HD = (bf16*)(ws + WS_HD); \
    unsigned char* wl = ws + WS_W; const float* ng = args.in[1] + (size_t)l_ * 6 * DM; (void)X16; (void)SS2; (void)U; (void)HB; (void)HD; (void)wl; (void)ng
    unsigned char* ws0 = args.ws;
    volatile LAS unsigned* MISC = (volatile LAS unsigned*)(L + MISC_OFF);
    { const int tid_e = wave0 * 64 + fresh_lane(); if (tid_e < 16) MISC[tid_e] = 0u; if (tid_e >= 64 && tid_e < 80) MISC[tid_e] = 0u; if (tid_e >= 208 && tid_e < 216) MISC[tid_e] = 0u; if (tid_e >= 144 && tid_e < 158) MISC[tid_e] = 0u; }
    __syncthreads();
    XcdBarrier bar; bar.bar = (unsigned*)(ws0 + WS_CTL) + CW_BAR; bar.x = 0; bar.st = nullptr;
    if (!MK_MULTI) bar = xcd_barrier_post((unsigned*)(ws0 + WS_CTL) + CW_BAR, MISC + 8, wave0 * 64 + fresh_lane() == 0);
#if PROBE_SC >= 6
    if (blk0 == 0 && wave0 * 64 + fresh_lane() == 0) { MISC[159] = (unsigned)__builtin_amdgcn_s_memrealtime(); MISC[158] = MISC[159]; }
#endif
    const int lo = args.ph_lo, hi = args.ph_hi;
#define IN(k) (lo <= (k) && (k) < hi)
#if PROBE_SC == 30 || PROBE_SC == 31
#define SEAM(k) do { const unsigned bt0_ = (unsigned)__builtin_amdgcn_s_memrealtime(); if (IN(k) && IN((k) + 1)) xcd_barrier(bar, wave0 * 64 + fresh_lane() == 0); \
    if (blk0 == PROBE_BLK && wave0 * 64 + fresh_lane() == 0) { const unsigned dt_ = (unsigned)__builtin_amdgcn_s_memrealtime() - bt0_; MISC[150] += dt_; if ((k) == 5) MISC[151] = dt_; if ((k) == 13) MISC[152] = dt_; } } while (0)
#elif PROBE_SC >= 6
#define SEAM(k) do { if (IN(k) && IN((k) + 1)) xcd_barrier(bar, wave0 * 64 + fresh_lane() == 0); \
    if (blk0 == 0 && wave0 * 64 + fresh_lane() == 0) { const unsigned now_ = (unsigned)__builtin_amdgcn_s_memrealtime(); MISC[160 + (k)] = now_ - MISC[159]; MISC[159] = now_; } } while (0)
#else
#define SEAM(k) do { if (IN(k) && IN((k) + 1)) xcd_barrier(bar, wave0 * 64 + fresh_lane() == 0); } while (0)
#endif

    REP_IF(5) {
    if (IN(0)) {
        const int l_ = 0; PH_IDS();
        const float* x_in = args.in[0]; float* b1T = (float*)(ws + WS_TAB + TAB_B1);
#define CONVERT_WEIGHTS(lw, GM) do { LAS float* scr = (LAS float*)(L + wave * 16384); const float* ngw = args.in[1] + (size_t)(lw) * 6 * DM; \
        constexpr int I_GU = 16 * 176, I_DN = 44 * 32, I_IN = 16 * 112, I_OUT = 16 * 32, I_CMP = 16 * 16, I_LAYER = 2 * I_GU + 2 * I_DN + I_IN + I_OUT + I_CMP; \
        for (int it = gw; it < I_LAYER; it += NGW) { int r = it; unsigned char* wlw = ws + WS_W; \
            if (r < I_GU) { if ((GM) & 1) { SrcGU s{args.in[2] + (size_t)(lw) * DM * NGU, ngw + 0 * DM}; transpose_item(s, DM, (bf16*)(wlw + WO_GU1), scr, r / 176, r % 176, lane); } continue; } r -= I_GU; \
            if (r < I_DN) { if ((GM) & 2) { SrcPlain s{args.in[3] + (size_t)(lw) * FF * DM, DM, nullptr}; transpose_item(s, FF, (bf16*)(wlw + WO_DN1), scr, r / 32, r % 32, lane); } continue; } r -= I_DN; \
            if (r < I_GU) { if ((GM) & 4) { SrcGU s{args.in[4] + (size_t)(lw) * DM * NGU, ngw + 4 * DM}; transpose_item(s, DM, (bf16*)(wlw + WO_GU2), scr, r / 176, r % 176, lane); } continue; } r -= I_GU; \
            if (r < I_DN) { if ((GM) & 8) { SrcPlain s{args.in[5] + (size_t)(lw) * FF * DM, DM, nullptr}; transpose_item(s, FF, (bf16*)(wlw + WO_DN2), scr, r / 32, r % 32, lane); } continue; } r -= I_DN; \
            if (r < I_IN) { if ((GM) & 16) { SrcIN s{args.in[6] + (size_t)(lw) * DM * INCOLS, ngw + 2 * DM}; transpose_item(s, DM, (bf16*)(wlw + WO_IN), scr, r / 112, r % 112, lane); } continue; } r -= I_IN; \
            if (r < I_OUT) { if ((GM) & 32) { SrcPlain s{args.in[7] + (size_t)(lw) * DM * DM, DM, nullptr}; transpose_item(s, DM, (bf16*)(wlw + WO_OUT), scr, r / 32, r % 32, lane); } continue; } r -= I_OUT; \
            if ((GM) & 64) { SrcCMP s{args.in[9] + (size_t)(lw) * 2 * 2048 * 128, nullptr}; transpose_item(s, DM, (bf16*)(ws + WS_CMPW + (size_t)(lw) * MiB), scr, r / 16, r % 16, lane); } } } while (0)
        CONVERT_WEIGHTS(0, 0x7f);
        if (DEPTH > 1) CONVERT_WEIGHTS(1, 0x40);
        { bf16* w2t = (bf16*)(ws + WS_TAB + TAB_W2T);
          for (int i = blk * 512 + tid; i < DEPTH * 2 * 64 * 128; i += G * 512) { const int lk = i >> 13, o = (i >> 7) & 63, kk = i & 127; w2t[i] = (bf16)f2bf(args.in[10][((size_t)lk * 128 + kk) * 64 + o]); } }
        { LAS float* part = (LAS float*)(L + 131072);
          for (int ob = blk; ob < DEPTH * 2 * 128 / 2; ob += G) { const int o = 2 * ob + (wave >> 2), qr = wave & 3; const int lk = o >> 7, c = o & 127;
              const float* pe = args.in[8] + (size_t)lk * 2048; const float* w1 = args.in[9] + (size_t)lk * 2048 * 128;
              float s = 0.f; for (int r = qr * 512 + lane; r < qr * 512 + 512; r += 64) s += pe[r] * w1[(size_t)r * 128 + c];
              s = wave_sum(s, lane); if (lane == 0) part[wave] = s;
              __syncthreads();
              if (lane == 0 && qr == 0) b1T[o] = (part[wave] + part[wave + 1]) + (part[wave + 2] + part[wave + 3]);
              __syncthreads(); } }
        thin_phase<0>(nullptr, x_in, X16, nullptr, SS2, nullptr, 0.f, gw, NGW, lane);
    }
    SEAM(0);
    }

#pragma unroll 1
    for (int l = 0; l < DEPTH; ++l) {
        const int pb = 1 + l * PH_PER_LAYER, l_ = l;
        REP_IF(1) {
        if (IN(pb + 0)) { PH_IDS(); pg8::Gemm g{X16, (const bf16*)(wl + WO_GU1), MTOK, NGU, DM}; pg8::StaticOrder S; S.init(MTOK, NGU, G, blk); EpiSwiglu E{HB, SS2, L + 131072};
#if PROBE_SC == 1 || PROBE_SC == 2
            if (l_ == 0) pg8::gemm_phase<EpiSwiglu, pg8::StaticOrder, true, true, 1>(L, g, S, E, tid); else
#endif
#if PROBE_SC >= 3
            const unsigned long long pt0 = __builtin_amdgcn_s_memrealtime();
#endif
            pg8::gemm_phase<EpiSwiglu, pg8::StaticOrder, GU_ALIGN, true>(L, g, S, E, tid);
#if PROBE_SC == 3
            if (l_ == 0 && tid == 0) { MISC[64] = (unsigned)(__builtin_amdgcn_s_memrealtime() - pt0); }
#endif
#if PROBE_SC == 4 || PROBE_SC == 5
            if (l_ == 0 && tid == 0) { const unsigned sp = (unsigned)(__builtin_amdgcn_s_memrealtime() - pt0); atomicMax((unsigned*)(ws + WS_CTL) + 33024, (sp << 8) | (unsigned)blk); }
#endif
            }
        SEAM(pb + 0);
        }
        if (IN(pb + 1)) { PH_IDS(); pg8::Gemm g{HB, (const bf16*)(wl + WO_DN1), MTOK, DM, FF}; pg8::StaticOrder S; S.init(MTOK, DM, G, blk);
            EpiResNorm<false> E{ws, (LAS float*)(L + 131072), ng + 1 * DM, nullptr, 0.5f, l_ * 3 + 0};
#if PROBE_SC == 21
            const unsigned pt1 = (unsigned)__builtin_amdgcn_s_memrealtime();
            if (l_ == 0) pg8::gemm_phase<EpiResNorm<false>, pg8::StaticOrder, true, true, 1>(L, g, S, E, tid); else
#endif
            pg8::gemm_phase<EpiResNorm<false>, pg8::StaticOrder, true, true>(L, g, S, E, tid);
#if PROBE_SC == 21
            if (l_ == 0 && tid == 0) MISC[66] = (unsigned)__builtin_amdgcn_s_memrealtime() - pt1;
#endif
            }
        SEAM(pb + 1);
        REP_IF(3) {
        if (IN(pb + 2)) { PH_IDS(); pg8::Gemm g{X16, (const bf16*)(wl + WO_IN), MTOK, NINP, DM}; pg8::StaticOrder S; S.init(MTOK, NINP, G, blk);
            EpiInProj E{ws, L + 131072};
#if PROBE_SC == 23
            const unsigned pt1 = (unsigned)__builtin_amdgcn_s_memrealtime();
            if (l_ == 0) pg8::gemm_phase<EpiInProj, pg8::StaticOrder, true, true, 1>(L, g, S, E, tid); else
#endif
            pg8::gemm_phase<EpiInProj, pg8::StaticOrder, true, true>(L, g, S, E, tid);
#if PROBE_SC == 23
            if (l_ == 0 && tid == 0) MISC[66] = (unsigned)__builtin_amdgcn_s_memrealtime() - pt1;
#endif
            }
        SEAM(pb + 2);
        }
        if (IN(pb + 4)) {
            PH_IDS();
            MixPtrs P{ws, args.in[11] + (size_t)l * 4 * 1024, args.in[12] + (size_t)l * 1024, args.in[13] + l * 4, args.in[14] + l * 4, args.in[15] + l * 512};
            unsigned* cflag = (unsigned*)(ws + WS_CTL) + CW_CFLAG + 1024 * l_;
            if (blk < 64 || blk >= 96) {
                const int cb = blk < 64 ? blk : blk - 32;
                mlstm_conv_pass(ws, P.conv_w, P.conv_b, cb * 512 + tid, 224 * 512);
                asm volatile("s_waitcnt vmcnt(0)" ::: "memory"); __syncthreads();
                if (tid == 0) { __builtin_amdgcn_fence(__ATOMIC_RELEASE, "agent"); asm volatile("s_waitcnt vmcnt(0)" ::: "memory");
                    (void)__hip_atomic_fetch_add(cflag + 64 * 15 + 32, 1u, __ATOMIC_RELAXED, __HIP_MEMORY_SCOPE_AGENT); }
            }
            if (blk < 64) {
                if (tid == 0) { unsigned sp = 0u; while (__hip_atomic_load(cflag + 64 * 15 + 32, __ATOMIC_RELAXED, __HIP_MEMORY_SCOPE_AGENT) < 224u) { __builtin_amdgcn_s_sleep(4); if (++sp > (1u << 17)) break; } }
                __syncthreads();
                __builtin_amdgcn_fence(__ATOMIC_ACQUIRE, "agent"); asm volatile("s_waitcnt vmcnt(0)" ::: "memory");
                mlstm_unit_v3(L, P, blk >> 2, blk & 3, tid);
            } else if (blk < 96) {
                pg8::Gemm g{(const bf16*)(ws + WS_KCR), (const bf16*)(ws + WS_CMPW + (size_t)l_ * MiB), 8192, 512, DM}; CmpOrder S{blk - 64, G};
                EpiCmpMlp E{ws, (const float*)(ws + WS_TAB + TAB_B1) + l_ * 2 * 128, (const bf16*)(ws + WS_TAB + TAB_W2T) + (size_t)l_ * 2 * 64 * 128};
                pg8::gemm_phase<EpiCmpMlp, CmpOrder, false, true>(L, g, S, E, tid);
                asm volatile("s_waitcnt vmcnt(0)" ::: "memory"); __syncthreads();
                if (tid == 0) { __builtin_amdgcn_fence(__ATOMIC_RELEASE, "agent"); asm volatile("s_waitcnt vmcnt(0)" ::: "memory");
                    (void)__hip_atomic_fetch_add(cflag + 64 * ((blk - 64) & 15), 1u, __ATOMIC_RELAXED, __HIP_MEMORY_SCOPE_AGENT); }
            } else {
                const int gw = (blk - 96) * NWAVES + wave, NGW = (G - 96) * NWAVES;
                if (l_ == 0) { if (DEPTH > 1) CONVERT_WEIGHTS(1, 0x13); } else CONVERT_WEIGHTS(l_, 0x2c);
            }
            { unsigned* qbase = (unsigned*)(ws + WS_CTL) + CW_QUEUE + 1024 * l_; volatile LAS unsigned* QW = (volatile LAS unsigned*)(L + MISC_OFF);
              const unsigned q0 = xb_xcc_id() & 7u; unsigned rdy = 0u;
#pragma unroll 1
              for (unsigned qq = 0; qq < 8u; ++qq) { unsigned* qctr = qbase + 64 * ((q0 + qq) & 7u); const int bg0 = 4 * (int)((q0 + qq) & 7u);
                  __syncthreads();
                  if (tid == 0) QW[0] = __hip_atomic_fetch_add(qctr, 1u, __ATOMIC_RELAXED, __HIP_MEMORY_SCOPE_AGENT);
                  __syncthreads();
                  unsigned u = QW[0];
                  while (u < 128u) { unsigned nxt = 0u; if (tid == 0) nxt = __hip_atomic_fetch_add(qctr, 1u, __ATOMIC_RELAXED, __HIP_MEMORY_SCOPE_AGENT);
                      const int c = 31 - (int)(u >> 2), bg = bg0 + (int)(u & 3u);
                      if (!((rdy >> (bg >> 1)) & 1u)) {
                          if (tid == 0) { unsigned sp = 0u; while (__hip_atomic_load(cflag + 64 * (bg >> 1), __ATOMIC_RELAXED, __HIP_MEMORY_SCOPE_AGENT) < 2u) { __builtin_amdgcn_s_sleep(4); if (++sp > (1u << 17)) break; } }
                          __syncthreads();
                          __builtin_amdgcn_fence(__ATOMIC_ACQUIRE, "agent"); asm volatile("s_waitcnt vmcnt(0)" ::: "memory");
                          rdy |= 1u << (bg >> 1); }
#if PROBE_SC == 22
                      const unsigned ut0_ = (unsigned)__builtin_amdgcn_s_memrealtime();
#endif
                      nsa_unit_v3(L, P, bg >> 1, bg & 1, c, tid);
#if PROBE_SC == 22
                      if (tid == 0) { MISC[212] += (unsigned)__builtin_amdgcn_s_memrealtime() - ut0_; MISC[213] += 1u; }
#endif
                      __syncthreads(); if (tid == 0) QW[0] = nxt; __syncthreads(); u = QW[0]; } } }
        }
#if PROBE_SC == 22
        if (l == 0 && blk0 == 255 && wave0 * 64 + fresh_lane() == 0) { unsigned* pw_ = (unsigned*)(ws0 + WS_CTL) + 33100;
            for (int i_ = 0; i_ < 4; ++i_) __hip_atomic_store(pw_ + i_, MISC[210 + i_], __ATOMIC_RELAXED, __HIP_MEMORY_SCOPE_AGENT); }
#endif
        SEAM(pb + 4);
        if (IN(pb + 5)) { PH_IDS(); pg8::Gemm g{U, (const bf16*)(wl + WO_OUT), MTOK, DM, DM}; pg8::StaticOrder S; S.init(MTOK, DM, G, blk);
            EpiResNorm<false> E{ws, (LAS float*)(L + 131072), ng + 3 * DM, nullptr, 1.0f, l_ * 3 + 1};
            pg8::gemm_phase<EpiResNorm<false>, pg8::StaticOrder, true, true>(L, g, S, E, tid); }
        SEAM(pb + 5);
        if (IN(pb + 6)) { PH_IDS(); pg8::Gemm g{X16, (const bf16*)(wl + WO_GU2), MTOK, NGU, DM}; pg8::StaticOrder S; S.init(MTOK, NGU, G, blk); EpiSwiglu E{HB, SS2, L + 131072};
            pg8::gemm_phase<EpiSwiglu, pg8::StaticOrder, GU_ALIGN, true>(L, g, S, E, tid); }
        SEAM(pb + 6);
        if (IN(pb + 7)) { PH_IDS(); pg8::Gemm g{HB, (const bf16*)(wl + WO_DN2), MTOK, DM, FF}; pg8::StaticOrder S; S.init(MTOK, DM, G, blk);
            if (l + 1 < DEPTH) { EpiResNorm<false> E{ws, (LAS float*)(L + 131072), ng + 5 * DM, nullptr, 0.5f, l_ * 3 + 2};
                pg8::gemm_phase<EpiResNorm<false>, pg8::StaticOrder, true, true>(L, g, S, E, tid); }
#if FINAL_FUSED
            else { EpiResNorm<true> E{ws, (LAS float*)(L + 131072), ng + 5 * DM, args.out, 0.5f, l_ * 3 + 2};
                pg8::gemm_phase<EpiResNorm<true>, pg8::StaticOrder, true, true>(L, g, S, E, tid); } }
        if (l + 1 < DEPTH) SEAM(pb + 7);
#else
            else { pg8::EpiBf16<0> E{HD, DM, nullptr, 0, 0, 1.f};
                pg8::gemm_phase<pg8::EpiBf16<0>, pg8::StaticOrder, true, true>(L, g, S, E, tid); } }
        if (l + 1 < DEPTH) SEAM(pb + 7);
        else { xcd_barrier(bar, wave0 * 64 + fresh_lane() == 0);
            if (IN(pb + 7)) { PH_IDS(); thin_phase<2>(HD, nullptr, X16, args.out, nullptr, ng + 5 * DM, 0.5f, gw, NGW, lane); } }
#endif
    }
#if PROBE_SC == 30 || PROBE_SC == 31
    if (blk0 == PROBE_BLK && wave0 * 64 + fresh_lane() == 0) { __hip_atomic_store((unsigned*)(args.ws + WS_CTL) + 33101, MISC[151], __ATOMIC_RELAXED, __HIP_MEMORY_SCOPE_AGENT); __hip_atomic_store((unsigned*)(args.ws + WS_CTL) + 33102, MISC[152], __ATOMIC_RELAXED, __HIP_MEMORY_SCOPE_AGENT);
        __hip_atomic_store((unsigned*)(args.ws + WS_CTL) + 33100, MISC[150], __ATOMIC_RELAXED, __HIP_MEMORY_SCOPE_AGENT); }
    if (blk0 == 0 && wave0 * 64 + fresh_lane() == 0) { unsigned sp_ = 0u; while (__hip_atomic_load((unsigned*)(args.ws + WS_CTL) + 33100, __ATOMIC_RELAXED, __HIP_MEMORY_SCOPE_AGENT) == 0u && ++sp_ < (1u << 20)) __builtin_amdgcn_s_sleep(8); }
#endif
#if PROBE_SC
    if (blk0 == 0 && wave0 * 64 + fresh_lane() == 0) {
        unsigned tk = MISC[64], cy = MISC[65];
        if (PROBE_SC == 4 || PROBE_SC == 5) { const unsigned pk = __hip_atomic_load((unsigned*)(args.ws + WS_CTL) + 33024, __ATOMIC_RELAXED, __HIP_MEMORY_SCOPE_AGENT); tk = (PROBE_SC == 4) ? (pk >> 8) : (pk & 255u) * 100u; }
#if PROBE_SC >= 6
        { const unsigned now_ = (unsigned)__builtin_amdgcn_s_memrealtime(); MISC[160 + 16] = now_ - MISC[159]; }
#define D_(k) MISC[160 + (k)]
        unsigned A_ = 0, B_ = 0;
        if (PROBE_SC == 6) { A_ = D_(0); B_ = D_(4) + D_(12); }
        if (PROBE_SC == 7) { A_ = D_(2) + D_(10); B_ = D_(3) + D_(11); }
        if (PROBE_SC == 8) { A_ = (D_(5) + D_(13)) / 2; B_ = D_(6) + D_(14); }
        if (PROBE_SC == 9) { A_ = (D_(7) + D_(15)) / 2; B_ = D_(8) + D_(16); }
        if (PROBE_SC == 10) { A_ = D_(1); B_ = D_(9); }
        if (PROBE_SC == 22) { const unsigned* pw_ = (const unsigned*)(args.ws + WS_CTL) + 33100; unsigned v_[4]; for (int i_ = 0; i_ < 4; ++i_) v_[i_] = __hip_atomic_load(pw_ + i_, __ATOMIC_RELAXED, __HIP_MEMORY_SCOPE_AGENT);
            A_ = (v_[1] ? (v_[0] * 50u) / v_[1] : 0u) * 4u;
            B_ = (v_[3] ? ((v_[2] - v_[0]) * 4u) / v_[3] : 0u) * 4u; }
        if (PROBE_SC == 31) { A_ = __hip_atomic_load((const unsigned*)(args.ws + WS_CTL) + 33101, __ATOMIC_RELAXED, __HIP_MEMORY_SCOPE_AGENT); B_ = __hip_atomic_load((const unsigned*)(args.ws + WS_CTL) + 33102, __ATOMIC_RELAXED, __HIP_MEMORY_SCOPE_AGENT); }
        if (PROBE_SC == 30) { const unsigned v_ = __hip_atomic_load((const unsigned*)(args.ws + WS_CTL) + 33100, __ATOMIC_RELAXED, __HIP_MEMORY_SCOPE_AGENT); A_ = v_; B_ = 0u; }
        if (PROBE_SC == 23) { A_ = MISC[64]; B_ = MISC[66]; }
        if (PROBE_SC == 21) { A_ = MISC[64]; B_ = MISC[66]; }
        if (PROBE_SC == 20) { A_ = MISC[200]; B_ = MISC[201]; }
        if (PROBE_SC == 15) { A_ = D_(3); B_ = D_(11); }
        if (PROBE_SC == 16) { A_ = D_(4); B_ = D_(12); }
        if (PROBE_SC == 17) { A_ = D_(2); B_ = D_(10); }
        if (PROBE_SC == 11) { A_ = D_(8); B_ = D_(16); }
        if (PROBE_SC == 12) { A_ = D_(7); B_ = D_(15); }
        if (PROBE_SC == 13) { A_ = D_(6); B_ = D_(14); }
        if (PROBE_SC == 14) { A_ = D_(5); B_ = D_(13); }
        { unsigned aq = (A_ + 200u) / 400u, bq = (B_ + 200u) / 400u; if (aq > 127u) aq = 127u; if (bq > 127u) bq = 127u; tk = (aq * 128u + bq) * 100u; }
#endif
        const unsigned long long delay = (PROBE_SC != 2) ? (unsigned long long)tk * 10ull : ((unsigned long long)cy * 10000ull) / (tk ? tk : 1u);
#if PROBE_SC >= 6
        while ((unsigned)__builtin_amdgcn_s_memrealtime() - MISC[158] < 500000u + (unsigned)delay) __builtin_amdgcn_s_sleep(8);
#else
        const unsigned long long t0 = __builtin_amdgcn_s_memrealtime();
        while (__builtin_amdgcn_s_memrealtime() - t0 < delay) __builtin_amdgcn_s_sleep(8);
#endif
    }
#endif
#undef IN
#undef SEAM
#undef CONVERT_WEIGHTS
#undef PH_IDS
#undef PH_WS
}

extern "C" void kernel_launch(void* const* d_in, const int* in_sizes, int n_in, void* d_out, int out_size, void* d_ws, size_t ws_size, hipStream_t stream) {
    static int grid = 0;
    if (grid == 0) {
        if (n_in != 16 || in_sizes[0] != MTOK * DM || out_size != MTOK * DM || ws_size < WS_END3) { fprintf(stderr, "kernel_launch: unexpected problem (n_in %d, ws %zu)\n", n_in, ws_size); grid = -1; return; }
        int dev = 0, cus = 0, per_cu = 0;
        if (hipGetDevice(&dev) != hipSuccess || hipDeviceGetAttribute(&cus, hipDeviceAttributeMultiprocessorCount, dev) != hipSuccess) { grid = -1; return; }
        if (hipFuncSetAttribute((const void*)fwd_kernel, hipFuncAttributeMaxDynamicSharedMemorySize, LDS_BYTES) != hipSuccess) { grid = -1; return; }
        if (hipOccupancyMaxActiveBlocksPerMultiprocessor(&per_cu, (const void*)fwd_kernel, NWAVES * 64, LDS_BYTES) != hipSuccess || per_cu < 1) { fprintf(stderr, "kernel_launch: occupancy query says %d\n", per_cu); }
        (void)hipGetLastError();
        grid = cus;
        if (grid != 256) { fprintf(stderr, "kernel_launch: %d CUs (the row-group exchange of the fused post-norm epilogues assumes 256 workgroups: 4 column tiles of a token tile in one round)\n", grid); grid = -1; return; }
    }
    if (grid < 0) return;
    (void)hipMemsetAsync((char*)d_ws + WS_CTL, 0, CTL_ZERO_BYTES, stream);
    Args a{};
    for (int i = 0; i < 16; ++i) a.in[i] = (const float*)d_in[i];
    a.out = (float*)d_out; a.ws = (unsigned char*)d_ws;
#if MK_MULTI
    for (int p = 0; p < N_PHASES; ++p) { a.ph_lo = p; a.ph_hi = p + 1; hipLaunchKernelGGL(fwd_kernel, dim3(grid), dim3(NWAVES * 64), LDS_BYTES, stream, a); }
#else
    a.ph_lo = 0; a.ph_hi = N_PHASES; hipLaunchKernelGGL(fwd_kernel, dim3(grid), dim3(NWAVES * 64), LDS_BYTES, stream, a);
#endif
}
```

```cpp
#include <hip/hip_runtime.h>
#include <cstdio>
#include <cstdint>
#ifndef FINAL_FUSED
#define FINAL_FUSED 1
#endif
#ifndef PROBE_DUP
#define PROBE_DUP 0
#endif
#ifndef GU_ALIGN
#define GU_ALIGN true
#endif
#ifndef EARLY_WB
#define EARLY_WB 0
#endif
#ifndef PROBE_BLK
#define PROBE_BLK 100
#endif
#ifndef PROBE_SC
#define PROBE_SC 0
#endif
namespace pg8 {
#define PG8_LAS __attribute__((address_space(3)))
typedef unsigned short bf16_t;
typedef short bf16x8 __attribute__((ext_vector_type(8)));
typedef float f32x4 __attribute__((ext_vector_type(4)));
typedef unsigned u32x4 __attribute__((ext_vector_type(4)));
constexpr int BM = 256, BK = 64, HALF = 128, HTB = HALF * BK * 2  , STAGE_BYTES = 8 * HTB, NXCD = 8, WGM = 4;

__host__ __device__ __forceinline__ int lds_byte(int r, int c) { const int st = (r >> 4) * 2 + (c >> 5), rr = r & 15, cc = c & 31, ob = rr * 64 + cc * 2; return st * 1024 + (ob ^ (((ob >> 9) & 1) << 5)); }
__host__ __device__ __forceinline__ void stage_rc(int b, int& R, int& C) { const int st = b / 1024, sb = b % 1024, swz = sb ^ (((sb >> 9) & 1) << 5); R = (st >> 1) * 16 + swz / 64; C = (st & 1) * 32 + (swz % 64) / 2; }
__host__ __device__ __forceinline__ int perm32(int rho) { const int n = rho >> 4, i = rho & 15; return 8 * (i >> 2) + 4 * n + (i & 3); }

struct Unit { int pm, pn; };
struct Gemm { const bf16_t* A; const bf16_t* Bt; int M, N, K; };

struct StaticOrder {
    int nM, nN, nwg, G, c;
    __host__ __device__ void init(int M, int N, int G_, int c_) { nM = M / BM; nN = N / BM; nwg = nM * nN; G = G_; c = c_; }
    __host__ __device__ bool next(int i, Unit& u) const {
        const long L = (long)i * G + c; if (L >= nwg) return false;
        int wgid = (int)L; { const int q = nwg / NXCD, r = nwg % NXCD, xcd = wgid % NXCD, off = wgid / NXCD; wgid = (xcd < r ? xcd * (q + 1) : r * (q + 1) + (xcd - r) * q) + off; }
        const int nig = WGM * nN, gid = wgid / nig, fm = gid * WGM, gsz = (nM - fm) < WGM ? (nM - fm) : WGM;
        u.pm = fm + ((wgid % nig) % gsz); u.pn = (wgid % nig) / gsz; return true;
    }
    __device__ __forceinline__ void a_ready(const Unit&) const {}
    __device__ __forceinline__ void done(const Unit&) const {}
};

__device__ __forceinline__ unsigned cvt_pk_bf16(float lo, float hi) { unsigned r; asm volatile("v_cvt_pk_bf16_f32 %0, %1, %2" : "=v"(r) : "v"(lo), "v"(hi)); return r; }
typedef float f32x2 __attribute__((ext_vector_type(2)));
__device__ __forceinline__ f32x2 gelu_pk(f32x2 v) {
    const f32x2 av = __builtin_elementwise_abs(v), d = av * 0.2316418882f + 1.0f;
    f32x2 t; t.x = __builtin_amdgcn_rcpf(d.x); t.y = __builtin_amdgcn_rcpf(d.y);
    f32x2 q = t * 0.5307027145f + (-0.7265760135f); q = q * t + 0.7107068705f; q = q * t + (-0.142248368f); q = q * t + 0.127414796f; q = q * t;
    const f32x2 s = (v * v) * (-0.72134752044f);
    f32x2 e; e.x = __builtin_amdgcn_exp2f(s.x); e.y = __builtin_amdgcn_exp2f(s.y);
    const f32x2 m = v * (q * e), r = v - m;
    f32x2 o; o.x = v.x < 0.f ? m.x : r.x; o.y = v.y < 0.f ? m.y : r.y; return o;
}

template <int ACT  > struct EpiBf16 {
    static constexpr bool PERM = true, AFTER_DRAIN = false, HAS_PRE = false; struct Pre {}; static_assert(ACT == 0 || ACT == 1, "EpiBf16: ACT is 0 (none) or 1 (gelu_pk)");
    bf16_t* O; int ldc; const float* bias; int split_cols; size_t split_stride; float scale0;
    __device__ __forceinline__ void operator()(const f32x4 (&acc)[2][2][4][2], const Unit& u, int wr, int wc, int fr, int fq) const {
        const int row0 = u.pm * BM + wr * 64 + fr; int colt = u.pn * BM; bf16_t* base = O;
        float sc = 1.f; if (split_cols) { const int t = colt / split_cols; base += (size_t)t * split_stride; colt -= t * split_cols; if (t == 0) sc = scale0; }
        const int col0 = colt + wc * 32 + 8 * fq, bcol0 = u.pn * BM + wc * 32 + 8 * fq;
        f32x4 bv[2][2];
#pragma unroll
        for (int bj = 0; bj < 2; ++bj)
#pragma unroll
            for (int n = 0; n < 2; ++n) bv[bj][n] = bias ? *(const f32x4*)(bias + bcol0 + bj * HALF + 4 * n) : (f32x4){0.f, 0.f, 0.f, 0.f};
#pragma unroll
        for (int ai = 0; ai < 2; ++ai)
#pragma unroll
            for (int m = 0; m < 4; ++m) { bf16_t* rowp = base + (size_t)(row0 + ai * HALF + m * 16) * ldc + col0;
#pragma unroll
                for (int bj = 0; bj < 2; ++bj) { f32x4 v0 = acc[ai][bj][m][0] + bv[bj][0], v1 = acc[ai][bj][m][1] + bv[bj][1];
                    if (ACT == 1) { f32x2 a = gelu_pk((f32x2){v0[0], v0[1]}), b = gelu_pk((f32x2){v0[2], v0[3]}), c = gelu_pk((f32x2){v1[0], v1[1]}), d = gelu_pk((f32x2){v1[2], v1[3]});
                        v0 = (f32x4){a.x, a.y, b.x, b.y}; v1 = (f32x4){c.x, c.y, d.x, d.y}; }
                    v0 = v0 * sc; v1 = v1 * sc; u32x4 w; w.x = cvt_pk_bf16(v0[0], v0[1]); w.y = cvt_pk_bf16(v0[2], v0[3]); w.z = cvt_pk_bf16(v1[0], v1[1]); w.w = cvt_pk_bf16(v1[2], v1[3]);
                    *(u32x4*)(rowp + bj * HALF) = w; } }
    }
};
template <class Epi, class Sched, bool ALIGN_EPI = false, bool SP2 = false, int SC = 0>
__device__ __forceinline__ void gemm_phase(PG8_LAS unsigned char* lds, const Gemm g, const Sched& S, const Epi& E, int tid_in) {
    int tid_l = tid_in; asm volatile("" : "+v"(tid_l));
    const int tid = tid_l, wid = __builtin_amdgcn_readfirstlane(tid >> 6), lane = tid & 63, wr = wid >> 2, wc = wid & 3, fr = lane & 15, fq = lane >> 4;
    const int K = g.K, nt = K / BK;
    unsigned voffA[2], voffB[2];
#pragma unroll
    for (int i = 0; i < 2; ++i) { int R, C; stage_rc(tid * 16 + i * 8192, R, C); const int Rb = Epi::PERM ? ((R & ~31) + perm32(R & 31)) : R;
        voffA[i] = (unsigned)(R * K + C) * 2u; voffB[i] = (unsigned)(Rb * K + C) * 2u; }
    const size_t kstep = (size_t)(BK * 2);
    const size_t hstep = (size_t)HALF * K * 2;
    const size_t tstep = 2 * hstep;
    const unsigned ldsw = (unsigned)wid * 1024u;
    const int aoff = lds_byte(wr * 64 + fr, fq * 8), boff = lds_byte(wc * 32 + fr, fq * 8);
#define PG8_SA(b, h) (((b) * 2 + (h)) * HTB)
#define PG8_SB(b, h) ((4 + (b) * 2 + (h)) * HTB)
#define PG8_STAGE(bufoff, gbase, voff) do { _Pragma("unroll") for (int _i = 0; _i < 2; ++_i) \
        __builtin_amdgcn_global_load_lds((const unsigned*)((const char*)(gbase) + (voff)[_i]), (PG8_LAS unsigned*)(lds + (bufoff) + ldsw + _i * 8192), 16, 0, 0); } while (0)
#define PG8_LDA(dst, b, h) do { _Pragma("unroll") for (int m = 0; m < 4; ++m) _Pragma("unroll") for (int k = 0; k < 2; ++k) dst[m][k] = *(const PG8_LAS bf16x8*)(lds + PG8_SA(b, h) + aoff + m * 2048 + k * 1024); } while (0)
#define PG8_LDB(dst, b, h) do { _Pragma("unroll") for (int n = 0; n < 2; ++n) _Pragma("unroll") for (int k = 0; k < 2; ++k) dst[n][k] = *(const PG8_LAS bf16x8*)(lds + PG8_SB(b, h) + boff + n * 2048 + k * 1024); } while (0)
#define PG8_MMA(ai, bj, At, Bt) do { __builtin_amdgcn_s_setprio(1); _Pragma("unroll") for (int m = 0; m < 4; ++m) _Pragma("unroll") for (int n = 0; n < 2; ++n) _Pragma("unroll") for (int k = 0; k < 2; ++k) \
        acc[ai][bj][m][n] = __builtin_amdgcn_mfma_f32_16x16x32_bf16(Bt[n][k], At[m][k], acc[ai][bj][m][n], 0, 0, 0); __builtin_amdgcn_s_setprio(0); } while (0)
#define PG8_WAIT_V(n) asm volatile("s_waitcnt vmcnt(" #n ")" ::: "memory")
#define PG8_WAIT_L(n) asm volatile("s_waitcnt lgkmcnt(" #n ")" ::: "memory")
#define PG8_BAR __builtin_amdgcn_s_barrier()
#define PG8_SCHED __builtin_amdgcn_sched_barrier(0)
    Unit cur, nxt; int ui = 0;
    if (!S.next(0, cur)) return;
    typename Epi::Pre pre;
    f32x4 acc[2][2][4][2];
#pragma unroll
    for (int a = 0; a < 2; ++a)
#pragma unroll
        for (int b = 0; b < 2; ++b)
#pragma unroll
            for (int m = 0; m < 4; ++m)
#pragma unroll
                for (int n = 0; n < 2; ++n) acc[a][b][m][n] = (f32x4){0.f, 0.f, 0.f, 0.f};
    bf16x8 At[4][2], B0[2][2], B1[2][2];
    const char* cA = (const char*)g.A + (size_t)cur.pm * tstep; const char* cB = (const char*)g.Bt + (size_t)cur.pn * tstep;
    S.a_ready(cur);
    if constexpr (SP2) {
        PG8_STAGE(PG8_SB(0, 0), cB, voffB); PG8_STAGE(PG8_SB(0, 1), cB + hstep, voffB); PG8_STAGE(PG8_SA(0, 0), cA, voffA); PG8_STAGE(PG8_SA(0, 1), cA + hstep, voffA);
        if (wr == 1) PG8_BAR;
        PG8_WAIT_V(2); PG8_BAR;
        PG8_STAGE(PG8_SB(1, 0), cB + kstep, voffB); PG8_STAGE(PG8_SA(1, 0), cA + kstep, voffA); PG8_STAGE(PG8_SB(1, 1), cB + hstep + kstep, voffB);
        PG8_WAIT_V(6); PG8_BAR;
    } else {
        PG8_STAGE(PG8_SB(0, 0), cB, voffB); PG8_STAGE(PG8_SA(0, 0), cA, voffA); PG8_STAGE(PG8_SB(0, 1), cB + hstep, voffB); PG8_STAGE(PG8_SA(0, 1), cA + hstep, voffA);
        if (wr == 1) PG8_BAR;
        PG8_WAIT_V(4); PG8_BAR;
        PG8_STAGE(PG8_SB(1, 0), cB + kstep, voffB); PG8_STAGE(PG8_SA(1, 0), cA + kstep, voffA); PG8_STAGE(PG8_SB(1, 1), cB + hstep + kstep, voffB);
        PG8_WAIT_V(6); PG8_BAR;
    }
    for (;;) {
        const bool has_next = S.next(ui + 1, nxt);
        unsigned long long sc_t0 = 0, sc_c0 = 0; if constexpr (SC != 0) { sc_t0 = __builtin_amdgcn_s_memrealtime(); sc_c0 = __builtin_amdgcn_s_memtime(); }
        const char* nA = has_next ? (const char*)g.A + (size_t)nxt.pm * tstep : cA; const char* nB = has_next ? (const char*)g.Bt + (size_t)nxt.pn * tstep : cB;
        for (int t = 0; t < nt; t += 2) {
            const bool last = (t == nt - 2);
            const char* a1 = cA + (size_t)(t + 1) * kstep;
            const char* a2 = last ? nA : cA + (size_t)(t + 2) * kstep; const char* b2 = last ? nB : cB + (size_t)(t + 2) * kstep;
            const char* a3 = a2 + kstep; const char* b3 = b2 + kstep;
            if (last && has_next) S.a_ready(nxt);
            if constexpr (Epi::HAS_PRE) { if (last) E.pre_load(cur, wr, wc, pre); }
            if constexpr (SP2) {
            PG8_LDB(B0, 0, 0); PG8_LDB(B1, 0, 1); PG8_SCHED; PG8_LDA(At, 0, 0); PG8_STAGE(PG8_SA(1, 1), a1 + hstep, voffA);
            PG8_WAIT_V(8); PG8_WAIT_L(0); PG8_BAR; PG8_MMA(0, 0, At, B0); PG8_MMA(0, 1, At, B1); PG8_BAR; PG8_SCHED;
            PG8_LDA(At, 0, 1); PG8_STAGE(PG8_SB(0, 0), b2, voffB); PG8_STAGE(PG8_SB(0, 1), b2 + hstep, voffB); PG8_STAGE(PG8_SA(0, 0), a2, voffA);
            PG8_WAIT_V(8); PG8_WAIT_L(0); PG8_BAR; PG8_MMA(1, 0, At, B0); PG8_MMA(1, 1, At, B1); PG8_BAR; PG8_SCHED;
            PG8_LDB(B0, 1, 0); PG8_LDB(B1, 1, 1); PG8_SCHED; PG8_LDA(At, 1, 0); PG8_STAGE(PG8_SA(0, 1), a2 + hstep, voffA);
            PG8_WAIT_V(8); PG8_WAIT_L(0); PG8_BAR; PG8_MMA(0, 0, At, B0); PG8_MMA(0, 1, At, B1); PG8_BAR; PG8_SCHED;
            PG8_LDA(At, 1, 1); PG8_STAGE(PG8_SB(1, 0), b3, voffB); PG8_STAGE(PG8_SB(1, 1), b3 + hstep, voffB); PG8_STAGE(PG8_SA(1, 0), a3, voffA);
            PG8_WAIT_V(8); PG8_WAIT_L(0); PG8_BAR; PG8_MMA(1, 0, At, B0); PG8_MMA(1, 1, At, B1); PG8_BAR; PG8_SCHED;
            } else {
            PG8_LDB(B0, 0, 0); PG8_SCHED; PG8_LDA(At, 0, 0); PG8_STAGE(PG8_SA(1, 1), a1 + hstep, voffA);
            PG8_WAIT_L(8); PG8_BAR; PG8_WAIT_L(0); PG8_MMA(0, 0, At, B0); PG8_BAR; PG8_SCHED;
            PG8_LDB(B1, 0, 1); PG8_STAGE(PG8_SB(0, 0), b2, voffB);
            PG8_BAR; PG8_WAIT_L(0); PG8_MMA(0, 1, At, B1); PG8_BAR;
            PG8_LDA(At, 0, 1); PG8_STAGE(PG8_SA(0, 0), a2, voffA);
            PG8_BAR; PG8_WAIT_L(0); PG8_MMA(1, 0, At, B0); PG8_BAR; PG8_SCHED;
            PG8_STAGE(PG8_SB(0, 1), b2 + hstep, voffB);
            PG8_WAIT_V(6); PG8_BAR; PG8_MMA(1, 1, At, B1); PG8_BAR;
            PG8_LDB(B0, 1, 0); PG8_SCHED; PG8_LDA(At, 1, 0); PG8_STAGE(PG8_SA(0, 1), a2 + hstep, voffA);
            PG8_WAIT_L(8); PG8_BAR; PG8_WAIT_L(0); PG8_MMA(0, 0, At, B0); PG8_BAR; PG8_SCHED;
            PG8_LDB(B1, 1, 1); PG8_STAGE(PG8_SB(1, 0), b3, voffB);
            PG8_BAR; PG8_WAIT_L(0); PG8_MMA(0, 1, At, B1); PG8_BAR;
            PG8_LDA(At, 1, 1); PG8_STAGE(PG8_SA(1, 0), a3, voffA);
            PG8_BAR; PG8_WAIT_L(0); PG8_MMA(1, 0, At, B0); PG8_BAR; PG8_SCHED;
            PG8_STAGE(PG8_SB(1, 1), b3 + hstep, voffB);
            PG8_WAIT_V(6); PG8_BAR; PG8_MMA(1, 1, At, B1); PG8_BAR;
            }
        }
        if constexpr (SC != 0) { const unsigned long long t1 = __builtin_amdgcn_s_memrealtime(), c1 = __builtin_amdgcn_s_memtime();
            if (tid == 0) { PG8_LAS unsigned* scw = (PG8_LAS unsigned*)(lds + 143360 + 256); scw[0] += (unsigned)(t1 - sc_t0); scw[1] += (unsigned)(c1 - sc_c0); } }
        if constexpr (ALIGN_EPI) { if (wr == 0) PG8_BAR; }
        if constexpr (!Epi::AFTER_DRAIN) { if constexpr (Epi::HAS_PRE) E(acc, cur, wr, wc, fr, fq, pre); else E(acc, cur, wr, wc, fr, fq); S.done(cur); }
        if (!has_next) break;
#pragma unroll
        for (int a = 0; a < 2; ++a)
#pragma unroll
            for (int b = 0; b < 2; ++b)
#pragma unroll
                for (int m = 0; m < 4; ++m)
#pragma unroll
                    for (int n = 0; n < 2; ++n) acc[a][b][m][n] = (f32x4){0.f, 0.f, 0.f, 0.f};
        cur = nxt; cA = nA; cB = nB; ++ui;
        if constexpr (ALIGN_EPI) { if (wr == 1) PG8_BAR; }
    }
    PG8_WAIT_V(0);
    if constexpr (!ALIGN_EPI) { if (wr == 0) PG8_BAR; }
    PG8_BAR;
    if constexpr (Epi::AFTER_DRAIN) { E.fused(acc, cur, wr, wc, fr, fq, lds, wid, lane); S.done(cur); }
#undef PG8_SA
#undef PG8_SB
#undef PG8_STAGE
#undef PG8_LDA
#undef PG8_LDB
#undef PG8_MMA
#undef PG8_WAIT_V
#undef PG8_WAIT_L
#undef PG8_BAR
#undef PG8_SCHED
}
}

#define LAS __attribute__((address_space(3)))
#define XB_TMO      128
#define XB_XCNT(j)  (256  + 64 * (j))
#define XB_XSUB(j)  (1280 + 64 * (j))
#define XB_XGEN(j)  (2304 + 64 * (j))
#define XB_TOP      3328
#define XB_TOPGEN   3392
#define XCD_BAR_WORDS 3456
#define XB_SPIN_CAP (1u << 18)

__device__ __forceinline__ unsigned xb_ld(unsigned* p)              { return __hip_atomic_load(p, __ATOMIC_RELAXED, __HIP_MEMORY_SCOPE_AGENT); }
__device__ __forceinline__ unsigned xb_add(unsigned* p, unsigned v) { return __hip_atomic_fetch_add(p, v, __ATOMIC_RELAXED, __HIP_MEMORY_SCOPE_AGENT); }
__device__ __forceinline__ unsigned xb_xcc_id() { return (unsigned)__builtin_amdgcn_s_getreg((3 << 11) | 20) & 0xFu; }
#define XB_SPIN(cond, bar) do { unsigned _sp = 0; while (cond) { __builtin_amdgcn_s_sleep(1); \
    if ((++_sp & 255u) == 0u) { if (xb_ld(&(bar)[XB_TMO])) break; if (_sp > XB_SPIN_CAP) { atomicAdd(&(bar)[XB_TMO], 1u); break; } } } } while (0)

struct XcdBarrier {
    unsigned* bar; unsigned x;
    volatile LAS unsigned* st;
};

__device__ __forceinline__ XcdBarrier xcd_barrier_post(unsigned* bar, volatile LAS unsigned* st, bool leader) {
    XcdBarrier b; b.bar = bar; b.x = xb_xcc_id(); b.st = st;
    if (leader) (void)xb_add(&bar[XB_XCNT(b.x)], 1u);
    return b;
}
__device__ __forceinline__ void xcd_barrier_complete(unsigned* bar, unsigned x, unsigned& nloc, unsigned& nx) {
    const unsigned G = gridDim.x * gridDim.y * gridDim.z;
    unsigned sum, cnt, mine, sp = 0u;
    for (;;) {
        sum = 0u; cnt = 0u; mine = 0u;
        unsigned cv[16];
        { const unsigned* cb = &bar[XB_XCNT(0)]; static_assert(XB_XCNT(1) - XB_XCNT(0) == 64, "counters are 256 bytes apart");
          asm volatile("global_load_dword %0, %16, off sc1\n\tglobal_load_dword %1, %16, off offset:256 sc1\n\tglobal_load_dword %2, %16, off offset:512 sc1\n\tglobal_load_dword %3, %16, off offset:768 sc1\n\t"
                       "global_load_dword %4, %16, off offset:1024 sc1\n\tglobal_load_dword %5, %16, off offset:1280 sc1\n\tglobal_load_dword %6, %16, off offset:1536 sc1\n\tglobal_load_dword %7, %16, off offset:1792 sc1\n\t"
                       "global_load_dword %8, %16, off offset:2048 sc1\n\tglobal_load_dword %9, %16, off offset:2304 sc1\n\tglobal_load_dword %10, %16, off offset:2560 sc1\n\tglobal_load_dword %11, %16, off offset:2816 sc1\n\t"
                       "global_load_dword %12, %16, off offset:3072 sc1\n\tglobal_load_dword %13, %16, off offset:3328 sc1\n\tglobal_load_dword %14, %16, off offset:3584 sc1\n\tglobal_load_dword %15, %16, off offset:3840 sc1\n\ts_waitcnt vmcnt(0)"
                       : "=&v"(cv[0]), "=&v"(cv[1]), "=&v"(cv[2]), "=&v"(cv[3]), "=&v"(cv[4]), "=&v"(cv[5]), "=&v"(cv[6]), "=&v"(cv[7]), "=&v"(cv[8]), "=&v"(cv[9]), "=&v"(cv[10]), "=&v"(cv[11]), "=&v"(cv[12]), "=&v"(cv[13]), "=&v"(cv[14]), "=&v"(cv[15])
                       : "v"(cb) : "memory"); }
#pragma unroll
        for (unsigned j = 0; j < 16; ++j) { const unsigned c = cv[j]; sum += c; cnt += (c > 0u) ? 1u : 0u; mine = (j == x) ? c : mine; }
        if (sum == G) break;
        __builtin_amdgcn_s_sleep(1);
        if ((++sp & 255u) == 0u) { if (xb_ld(&bar[XB_TMO])) break; if (sp > XB_SPIN_CAP) { atomicAdd(&bar[XB_TMO], 1u); break; } }
    }
    nloc = mine > 0u ? mine : 1u; nx = cnt > 0u ? cnt : 1u;
}

__device__ __forceinline__ void xcd_barrier(const XcdBarrier& b, bool leader) {
    asm volatile("s_waitcnt vmcnt(0)" ::: "memory");
    __syncthreads();
    if (leader) {
        unsigned* bar = b.bar;
        __builtin_amdgcn_s_waitcnt(0);
        unsigned nloc = b.st[0], nx = b.st[1];
        if (nloc == 0u) { xcd_barrier_complete(bar, b.x, nloc, nx); b.st[0] = nloc; b.st[1] = nx; }
#if EARLY_WB
        __builtin_amdgcn_fence(__ATOMIC_RELEASE, "agent");
        asm volatile("s_waitcnt vmcnt(0)" ::: "memory");
#endif
        const unsigned old = xb_add(&bar[XB_XSUB(b.x)], 1u);
        const unsigned gen = old / nloc;
        if (old + 1u == (gen + 1u) * nloc) {
#if !EARLY_WB
            __builtin_amdgcn_fence(__ATOMIC_RELEASE, "agent");
#endif
            asm volatile("s_waitcnt vmcnt(0)" ::: "memory");
            const unsigned og = xb_add(&bar[XB_TOP], 1u);
            const unsigned tg = og / nx;
            if (og + 1u == (tg + 1u) * nx) xb_add(&bar[XB_TOPGEN], 1u);
            else XB_SPIN(xb_ld(&bar[XB_TOPGEN]) == tg, bar);
            __builtin_amdgcn_fence(__ATOMIC_ACQUIRE, "agent");
            xb_add(&bar[XB_XGEN(b.x)], 1u);
            asm volatile("s_waitcnt vmcnt(0)" ::: "memory");
        } else {
            XB_SPIN(xb_ld(&bar[XB_XGEN(b.x)]) == gen, bar);
            __builtin_amdgcn_fence(__ATOMIC_ACQUIRE, "agent");
            asm volatile("s_waitcnt vmcnt(0)" ::: "memory");
        }
    }
    __syncthreads();
}

constexpr int BATCH = 16, SEQ = 2048, DM = 1024, MTOK = BATCH * SEQ, FF = 2816, NGU = 2 * FF, NINP = 3584, INCOLS = 3360, DEPTH = 2;
constexpr int NWAVES = 8;
constexpr float EPS = 1e-6f;
typedef unsigned short bf16;
typedef unsigned v4u __attribute__((ext_vector_type(4)));
typedef unsigned v2u __attribute__((ext_vector_type(2)));
typedef float f32x4 __attribute__((ext_vector_type(4)));
#define LDS_WAIT() asm volatile("s_waitcnt lgkmcnt(0)" ::: "memory")

constexpr size_t MiB = 1u << 20;
constexpr size_t WS_CTL = 0, CTL_ZERO_BYTES = 160 * 1024;
constexpr size_t WS_TAB = 1 * MiB;
constexpr size_t TAB_COS = 0, TAB_SIN = 65536, TAB_B1 = 131072, TAB_W2T = 196608, TAB_SS2 = 262144;
constexpr size_t WS_W = 2 * MiB;
constexpr size_t WO_GU1 = 0, WO_DN1 = 11 * MiB, WO_GU2 = 16 * MiB + MiB / 2, WO_DN2 = 27 * MiB + MiB / 2, WO_IN = 33 * MiB, WO_OUT = 40 * MiB, WO_CMP = 42 * MiB;
constexpr size_t WS_X16 = 45 * MiB;
constexpr size_t WS_U = 109 * MiB;
constexpr size_t WS_HB = 173 * MiB;
constexpr size_t WS_HD = 349 * MiB;
constexpr size_t WS_PQ = 413 * MiB;
constexpr size_t WS_CC = 421 * MiB;
constexpr size_t WS_END = 422 * MiB;
constexpr size_t WS_QN = 173 * MiB, WS_KCR = 205 * MiB, WS_VCR = 213 * MiB, WS_KS = 221 * MiB, WS_VS = 229 * MiB, WS_KW = 237 * MiB, WS_VW = 245 * MiB;
constexpr size_t WS_MQ = 253 * MiB, WS_MK = 285 * MiB, WS_MV = 317 * MiB, WS_MO = 349 * MiB, WS_GATE = 381 * MiB;
static_assert(WS_GATE + 4 * MiB <= WS_PQ, "in-projection outputs end below PQ");
constexpr int CW_BAR = 4096, CW_QUEUE = 16384, CW_GRP = 20480, CW_CFLAG = 33280;
constexpr size_t WS_PART = 486 * MiB, WS_CMPW = 489 * MiB, WS_END3 = 491 * MiB;
static_assert((CW_QUEUE + 2 * 1024) <= CW_GRP && (CW_GRP + 6 * 128 * 16) * 4 <= (int)CTL_ZERO_BYTES && (CW_BAR + 3456) <= CW_QUEUE && WS_TAB + TAB_SS2 + 16 * 32768 <= WS_W, "control words inside the zeroed region");
constexpr int PH_BYTES = 143360, MISC_OFF = PH_BYTES, LDS_BYTES = 147456;

__device__ __forceinline__ unsigned f2bf(float f) { unsigned u = __builtin_bit_cast(unsigned, f); return (u + 0x7fffu + ((u >> 16) & 1u)) >> 16; }
__device__ __forceinline__ unsigned pk2(float lo, float hi) { return f2bf(lo) | (f2bf(hi) << 16); }
typedef float f32x2v_ __attribute__((ext_vector_type(2))); typedef __bf16 bf16x2v_ __attribute__((ext_vector_type(2)));
__device__ __forceinline__ unsigned cvtpk(float lo, float hi) { f32x2v_ v = {lo, hi}; bf16x2v_ b = __builtin_convertvector(v, bf16x2v_); return __builtin_bit_cast(unsigned, b); }
__device__ __forceinline__ float bflo(unsigned u) { return __builtin_bit_cast(float, u << 16); }
__device__ __forceinline__ float bfhi(unsigned u) { return __builtin_bit_cast(float, u & 0xffff0000u); }
__device__ __forceinline__ float bf2f(bf16 b) { return __builtin_bit_cast(float, (unsigned)b << 16); }
__device__ __forceinline__ float sigmoidf_(float x) { return __builtin_amdgcn_rcpf(1.f + __expf(-x)); }
__device__ __forceinline__ int fresh_lane() { unsigned z = 0u; asm volatile("" : "+v"(z)); return (int)__builtin_amdgcn_mbcnt_hi(~0u, __builtin_amdgcn_mbcnt_lo(~0u, z)); }
__device__ __forceinline__ float shx(float v, int mask, int lane) { return __builtin_bit_cast(float, __builtin_amdgcn_ds_bpermute((lane ^ mask) << 2, __builtin_bit_cast(int, v))); }
__device__ __forceinline__ unsigned shxu(unsigned v, int mask, int lane) { return (unsigned)__builtin_amdgcn_ds_bpermute((lane ^ mask) << 2, (int)v); }
__device__ __forceinline__ float shi(float v, int src) { return __builtin_bit_cast(float, __builtin_amdgcn_ds_bpermute(src << 2, __builtin_bit_cast(int, v))); }
__device__ __forceinline__ float wave_sum(float v, int lane) {
    (void)lane;
    v += __builtin_bit_cast(float, __builtin_amdgcn_update_dpp(0, __builtin_bit_cast(int, v), 0xB1, 0xF, 0xF, false));
    v += __builtin_bit_cast(float, __builtin_amdgcn_update_dpp(0, __builtin_bit_cast(int, v), 0x4E, 0xF, 0xF, false));
    v += __builtin_bit_cast(float, __builtin_amdgcn_update_dpp(0, __builtin_bit_cast(int, v), 0x124, 0xF, 0xF, false));
    v += __builtin_bit_cast(float, __builtin_amdgcn_update_dpp(0, __builtin_bit_cast(int, v), 0x128, 0xF, 0xF, false));
    const int iv = __builtin_bit_cast(int, v);
    const float a = __builtin_bit_cast(float, __builtin_amdgcn_readlane(iv, 0)), b = __builtin_bit_cast(float, __builtin_amdgcn_readlane(iv, 16));
    const float c = __builtin_bit_cast(float, __builtin_amdgcn_readlane(iv, 32)), d = __builtin_bit_cast(float, __builtin_amdgcn_readlane(iv, 48));
    return (a + b) + (c + d);
}

struct SrcGU { const float* W; const float* g; __device__ __forceinline__ float operator()(int k, int nd) const { const int pn = nd >> 8, r = nd & 255; const int col = (r < 128) ? (pn * 128 + r) : (FF + pn * 128 + r - 128); return W[(size_t)k * NGU + col]; } };
struct SrcPlain { const float* W; int N; const float* g; __device__ __forceinline__ float operator()(int k, int nd) const { return W[(size_t)k * N + nd]; } };
struct SrcIN { const float* W; const float* g; __device__ __forceinline__ float operator()(int k, int nd) const {
    const int col = nd < 1280 ? nd : (nd < 3328 ? nd + 24 : (nd < 3352 ? nd - 3328 + 1280 : (nd < 3360 ? nd : -1)));
    return col < 0 ? 0.f : W[(size_t)k * INCOLS + col]; } };
struct SrcCMP { const float* W1; const float* g; __device__ __forceinline__ float operator()(int k, int nd) const { const int kv = nd >> 8, r = nd & 255;
    return r < 128 ? W1[((size_t)kv * 2048 + k) * 128 + r] : W1[((size_t)kv * 2048 + 1024 + k) * 128 + r - 128]; } };

template <class SrcF>
__device__ __forceinline__ void transpose_item(const SrcF& src, int K, bf16* WT, LAS float* scr, int kb, int nb, int lane) {
    const int k0 = 64 * kb, n0 = 32 * nb, c = lane & 7;
    f32x4 ga = {1.f, 1.f, 1.f, 1.f}, gb = ga;
    if (src.g) { ga = *(const f32x4*)(src.g + k0 + 8 * c); gb = *(const f32x4*)(src.g + k0 + 8 * c + 4); }
    float tv[32];
#pragma unroll
    for (int i = 0; i < 32; ++i) tv[i] = src(k0 + 2 * i + (lane >> 5), n0 + (lane & 31));
#pragma unroll
    for (int i = 0; i < 32; ++i) { const int kk = 2 * i + (lane >> 5); scr[kk * 33 + (lane & 31)] = tv[i]; }
    LDS_WAIT(); asm volatile("" ::: "memory");
#pragma unroll
    for (int j = 0; j < 4; ++j) { const int n = (lane >> 3) + 8 * j; const LAS float* s = scr + (8 * c) * 33 + n;
        v4u o; o.x = cvtpk(s[0 * 33] * ga.x, s[1 * 33] * ga.y); o.y = cvtpk(s[2 * 33] * ga.z, s[3 * 33] * ga.w); o.z = cvtpk(s[4 * 33] * gb.x, s[5 * 33] * gb.y); o.w = cvtpk(s[6 * 33] * gb.z, s[7 * 33] * gb.w);
        *(v4u*)(WT + (size_t)(n0 + n) * K + k0 + 8 * c) = o; }
    LDS_WAIT(); asm volatile("" ::: "memory");
}

template <int MODE>
__device__ __forceinline__ void thin_phase(const bf16* HD, const float* xin_f32, bf16* X16, float* out_f32, float* R2, const float* gpost, float cc, int gw, int NGW, int lane) {
    f32x4 gp[4];
#pragma unroll
    for (int j = 0; j < 4; ++j) gp[j] = (MODE != 0) ? *(const f32x4*)(gpost + 4 * lane + 256 * j) : (f32x4){0.f, 0.f, 0.f, 0.f};
    f32x4 xf[4]; v2u xn[4], hn[4];
    if (gw < MTOK) {
#pragma unroll
        for (int j = 0; j < 4; ++j) { if (MODE == 0) xf[j] = *(const f32x4*)(xin_f32 + (size_t)gw * DM + 4 * lane + 256 * j);
            else { xn[j] = *(const v2u*)(X16 + (size_t)gw * DM + 4 * lane + 256 * j); hn[j] = *(const v2u*)(HD + (size_t)gw * DM + 4 * lane + 256 * j); } }
    }
    for (int m = gw; m < MTOK; m += NGW) {
        f32x4 x[4]; v2u hw[4];
#pragma unroll
        for (int j = 0; j < 4; ++j) { if (MODE == 0) x[j] = xf[j]; else { x[j] = (f32x4){bflo(xn[j].x), bfhi(xn[j].x), bflo(xn[j].y), bfhi(xn[j].y)}; hw[j] = hn[j]; } }
        const int m2 = m + NGW;
        if (m2 < MTOK) {
#pragma unroll
            for (int j = 0; j < 4; ++j) { if (MODE == 0) xf[j] = *(const f32x4*)(xin_f32 + (size_t)m2 * DM + 4 * lane + 256 * j);
                else { xn[j] = *(const v2u*)(X16 + (size_t)m2 * DM + 4 * lane + 256 * j); hn[j] = *(const v2u*)(HD + (size_t)m2 * DM + 4 * lane + 256 * j); } }
        }
        if (MODE != 0) {
            f32x4 h[4]; float ss = 0.f;
#pragma unroll
            for (int j = 0; j < 4; ++j) { h[j] = (f32x4){bflo(hw[j].x), bfhi(hw[j].x), bflo(hw[j].y), bfhi(hw[j].y)}; ss += (h[j].x * h[j].x + h[j].y * h[j].y) + (h[j].z * h[j].z + h[j].w * h[j].w); }
            const float r = cc * __frsqrt_rn(wave_sum(ss, lane) * (1.f / DM) + EPS);
#pragma unroll
            for (int j = 0; j < 4; ++j) x[j] = x[j] + (h[j] * r) * gp[j];
        }
        if (MODE == 2) {
#pragma unroll
            for (int j = 0; j < 4; ++j) *(f32x4*)(out_f32 + (size_t)m * DM + 4 * lane + 256 * j) = x[j];
        } else {
            float s2 = 0.f;
#pragma unroll
            for (int j = 0; j < 4; ++j) { s2 += (x[j].x * x[j].x + x[j].y * x[j].y) + (x[j].z * x[j].z + x[j].w * x[j].w);
                v2u w; w.x = cvtpk(x[j].x, x[j].y); w.y = cvtpk(x[j].z, x[j].w); *(v2u*)(X16 + (size_t)m * DM + 4 * lane + 256 * j) = w; }
            const float st = wave_sum(s2, lane);
            if (lane == 0) *(f32x4*)(R2 + (size_t)m * 4) = (f32x4){st, 0.f, 0.f, 0.f};
        }
    }
}

struct EpiSwiglu {
    static constexpr bool PERM = true, AFTER_DRAIN = false, HAS_PRE = true; struct Pre {};
    bf16* H; const float* SS2; LAS unsigned char* lred;
    __device__ __forceinline__ void pre_load(const pg8::Unit& u, int wr, int wc, Pre&) const {
        if (wc == 0) { const float* sp = SS2 + (size_t)(u.pm * 256 + wr * 64 + fresh_lane()) * 4;
            __builtin_amdgcn_global_load_lds((const unsigned*)sp, (LAS unsigned*)(lred + wr * 2048), 16, 0, 0);
            __builtin_amdgcn_global_load_lds((const unsigned*)(sp + 128 * 4), (LAS unsigned*)(lred + wr * 2048 + 1024), 16, 0, 0); } }
    __device__ __forceinline__ void operator()(const pg8::f32x4 (&acc)[2][2][4][2], const pg8::Unit& u, int wr, int wc, int fr, int fq, const Pre& P) const {
        float rsv[2][4];
        { const int ln = fq * 16 + fr; const f32x4 p0 = *(const LAS f32x4*)(lred + wr * 2048 + ln * 16), p1 = *(const LAS f32x4*)(lred + wr * 2048 + 1024 + ln * 16);
          const float r0 = __frsqrt_rn(((p0.x + p0.y) + (p0.z + p0.w)) * (1.f / DM) + EPS), r1 = __frsqrt_rn(((p1.x + p1.y) + (p1.z + p1.w)) * (1.f / DM) + EPS);
#pragma unroll
          for (int m = 0; m < 4; ++m) { rsv[0][m] = shi(r0, m * 16 + fr); rsv[1][m] = shi(r1, m * 16 + fr); } }
#pragma unroll
        for (int ai = 0; ai < 2; ++ai)
#pragma unroll
            for (int m = 0; m < 4; ++m) {
                const int row = u.pm * 256 + ai * 128 + wr * 64 + m * 16 + fr; const float rs = rsv[ai][m];
                typedef float f2 __attribute__((ext_vector_type(2)));
                f2 tg[4], tu[4], ex[4]; float o[8]; const float c1 = rs * -1.4426950408889634f, rs2 = rs * rs;
#pragma unroll
                for (int n = 0; n < 2; ++n) { const pg8::f32x4 g4 = acc[ai][0][m][n], u4 = acc[ai][1][m][n];
                    tg[2 * n] = (f2){g4[0], g4[1]}; tg[2 * n + 1] = (f2){g4[2], g4[3]}; tu[2 * n] = (f2){u4[0], u4[1]}; tu[2 * n + 1] = (f2){u4[2], u4[3]}; }
#pragma unroll
                for (int e = 0; e < 4; ++e) { const f2 a2 = tg[e] * c1; ex[e].x = __builtin_amdgcn_exp2f(a2.x); ex[e].y = __builtin_amdgcn_exp2f(a2.y); }
#pragma unroll
                for (int e = 0; e < 4; ++e) { const f2 d2 = ex[e] + 1.0f; ex[e].x = __builtin_amdgcn_rcpf(d2.x); ex[e].y = __builtin_amdgcn_rcpf(d2.y); tu[e] = (tg[e] * tu[e]) * rs2; }
#pragma unroll
                for (int e = 0; e < 4; ++e) { const f2 r2 = tu[e] * ex[e]; o[2 * e] = r2.x; o[2 * e + 1] = r2.y; }
                v4u w; w.x = pg8::cvt_pk_bf16(o[0], o[1]); w.y = pg8::cvt_pk_bf16(o[2], o[3]); w.z = pg8::cvt_pk_bf16(o[4], o[5]); w.w = pg8::cvt_pk_bf16(o[6], o[7]);
                *(v4u*)(H + (size_t)row * FF + u.pn * 128 + wc * 32 + fq * 8) = w;
            }
    }
};
#define EPI_LBAR() do { asm volatile("s_waitcnt lgkmcnt(0)" ::: "memory"); __builtin_amdgcn_s_barrier(); } while (0)
template <bool FINAL>
struct EpiResNorm {
    static constexpr bool PERM = !FINAL, AFTER_DRAIN = false, HAS_PRE = false; struct Pre {};
    unsigned char* ws; LAS float* red; const float* gpost; float* outf; float cc; int inst;
    __device__ __forceinline__ void operator()(const pg8::f32x4 (&acc)[2][2][4][2], const pg8::Unit& u, int wr, int wc, int fr_, int fq_) const {
        int fr = fr_, fq = fq_;
        bf16* X16 = (bf16*)(ws + WS_X16);
        const int ln = fresh_lane(), wv = wr * 4 + wc, tid = wv * 64 + ln; fr = ln & 15; fq = ln >> 4;
        const int r0 = u.pm * 256 + wr * 64 + fr, c0 = u.pn * 256 + wc * 32 + fq * (FINAL ? 4 : 8);
        v4u xv[2][4][2];
        if (wv != 0) {
#pragma unroll
            for (int ai = 0; ai < 2; ++ai)
#pragma unroll
                for (int m = 0; m < 4; ++m)
#pragma unroll
                    for (int bj = 0; bj < 2; ++bj) { const bf16* xp = X16 + (size_t)(r0 + ai * 128 + m * 16) * DM + c0 + bj * 128;
                        if (FINAL) { const v2u lo2 = *(const v2u*)xp, hi2 = *(const v2u*)(xp + 16); xv[ai][m][bj] = (v4u){lo2.x, lo2.y, hi2.x, hi2.y}; } else xv[ai][m][bj] = *(const v4u*)xp; }
        }
        if (tid >= 256) red[1280 + tid - 256] = gpost[u.pn * 256 + tid - 256];
#pragma unroll
        for (int ai = 0; ai < 2; ++ai)
#pragma unroll
            for (int m = 0; m < 4; ++m) { float s = 0.f;
#pragma unroll
                for (int bj = 0; bj < 2; ++bj)
#pragma unroll
                    for (int n = 0; n < 2; ++n) { const pg8::f32x4 a = acc[ai][bj][m][n]; s += (a[0] * a[0] + a[1] * a[1]) + (a[2] * a[2] + a[3] * a[3]); }
                s += shx(s, 16, ln); s += shx(s, 32, ln);
                if (fq == 0) red[wc * 256 + ai * 128 + wr * 64 + m * 16 + fr] = s; }
        EPI_LBAR();
        if (wv == 0) {
            unsigned* ctr = (unsigned*)(ws + WS_CTL) + CW_GRP + (inst * 128 + u.pm) * 16;
            unsigned* part = (unsigned*)(ws + WS_PART) + (size_t)inst * 4 * MTOK + u.pm * 256 + 4 * ln;
            const f32x4 p0 = *(const LAS f32x4*)(red + 4 * ln), p1 = *(const LAS f32x4*)(red + 256 + 4 * ln), p2 = *(const LAS f32x4*)(red + 512 + 4 * ln), p3 = *(const LAS f32x4*)(red + 768 + 4 * ln);
            const f32x4 ps = (p0 + p1) + (p2 + p3);
            unsigned* mine = part + (size_t)u.pn * MTOK;
            asm volatile("global_store_dwordx4 %0, %1, off sc1\n\ts_waitcnt vmcnt(0)" :: "v"(mine), "v"(ps) : "memory");
            if (ln == 0) { (void)__hip_atomic_fetch_add(ctr, 1u, __ATOMIC_RELAXED, __HIP_MEMORY_SCOPE_AGENT);
                unsigned sp = 0u; while (__hip_atomic_load(ctr, __ATOMIC_RELAXED, __HIP_MEMORY_SCOPE_AGENT) < 4u) { __builtin_amdgcn_s_sleep(1); if (++sp > (1u << 22)) break; } }
            asm volatile("" ::: "memory");
            f32x4 q0, q1, q2, q3;
            asm volatile("global_load_dwordx4 %0, %4, off sc1\n\tglobal_load_dwordx4 %1, %5, off sc1\n\tglobal_load_dwordx4 %2, %6, off sc1\n\tglobal_load_dwordx4 %3, %7, off sc1\n\ts_waitcnt vmcnt(0)"
                         : "=&v"(q0), "=&v"(q1), "=&v"(q2), "=&v"(q3) : "v"(part), "v"(part + MTOK), "v"(part + 2 * (size_t)MTOK), "v"(part + 3 * (size_t)MTOK) : "memory");
            const f32x4 t = ((q0 + q1) + (q2 + q3)) * (1.f / DM) + EPS;
            *(LAS f32x4*)(red + 1024 + 4 * ln) = (f32x4){cc * __frsqrt_rn(t.x), cc * __frsqrt_rn(t.y), cc * __frsqrt_rn(t.z), cc * __frsqrt_rn(t.w)};
#pragma unroll
            for (int ai = 0; ai < 2; ++ai)
#pragma unroll
                for (int m = 0; m < 4; ++m)
#pragma unroll
                    for (int bj = 0; bj < 2; ++bj) { const bf16* xp = X16 + (size_t)(r0 + ai * 128 + m * 16) * DM + c0 + bj * 128;
                        if (FINAL) { const v2u lo2 = *(const v2u*)xp, hi2 = *(const v2u*)(xp + 16); xv[ai][m][bj] = (v4u){lo2.x, lo2.y, hi2.x, hi2.y}; } else xv[ai][m][bj] = *(const v4u*)xp; }
        }
        EPI_LBAR();
#pragma unroll
        for (int ai = 0; ai < 2; ++ai)
#pragma unroll
            for (int m = 0; m < 4; ++m) { const float inv = red[1024 + ai * 128 + wr * 64 + m * 16 + fr]; float s = 0.f; const size_t rowo = (size_t)(r0 + ai * 128 + m * 16) * DM + c0;
                asm volatile("" ::: "memory");
#pragma unroll
                for (int bj = 0; bj < 2; ++bj) { const v4u xw = xv[ai][m][bj]; const LAS float* gl = red + 1280 + bj * 128 + wc * 32 + fq * (FINAL ? 4 : 8); const f32x4 gv0 = *(const LAS f32x4*)gl, gv1 = *(const LAS f32x4*)(gl + (FINAL ? 16 : 4));
                    f32x4 x0 = (f32x4){bflo(xw.x), bfhi(xw.x), bflo(xw.y), bfhi(xw.y)}, x1 = (f32x4){bflo(xw.z), bfhi(xw.z), bflo(xw.w), bfhi(xw.w)};
                    x0 = x0 + (acc[ai][bj][m][0] * inv) * gv0; x1 = x1 + (acc[ai][bj][m][1] * inv) * gv1;
                    if (FINAL) { float* op = outf + rowo + bj * 128; *(f32x4*)op = x0; *(f32x4*)(op + 16) = x1; }
                    else { s += ((x0.x * x0.x + x0.y * x0.y) + (x0.z * x0.z + x0.w * x0.w)) + ((x1.x * x1.x + x1.y * x1.y) + (x1.z * x1.z + x1.w * x1.w));
                        v4u w; w.x = pg8::cvt_pk_bf16(x0.x, x0.y); w.y = pg8::cvt_pk_bf16(x0.z, x0.w); w.z = pg8::cvt_pk_bf16(x1.x, x1.y); w.w = pg8::cvt_pk_bf16(x1.z, x1.w);
                        *(v4u*)(X16 + rowo + bj * 128) = w; } }
                if (!FINAL) { s += shx(s, 16, ln); s += shx(s, 32, ln); if (fq == 0) red[wc * 256 + ai * 128 + wr * 64 + m * 16 + fr] = s; } }
        if (!FINAL) {
            EPI_LBAR();
            if (tid < 256) ((float*)(ws + WS_TAB + TAB_SS2))[(size_t)(u.pm * 256 + tid) * 4 + u.pn] = (red[tid] + red[256 + tid]) + (red[512 + tid] + red[768 + tid]);
        }
    }
};
struct EpiCmpMlp {
    static constexpr bool PERM = true, AFTER_DRAIN = true, HAS_PRE = false; struct Pre {};
    unsigned char* ws; const float* b1; const bf16* w2t;
    __device__ __forceinline__ void operator()(const pg8::f32x4 (&)[2][2][4][2], const pg8::Unit&, int, int, int, int) const {}
    __device__ __forceinline__ void fused(const pg8::f32x4 (&acc)[2][2][4][2], const pg8::Unit& u, int wr, int wc, int fr_, int fq_, LAS unsigned char* lds, int wid, int lane_) const {
        (void)fr_; (void)fq_; (void)lane_;
        const int ln = fresh_lane(), fr = ln & 15, fq = ln >> 4, kv = u.pm >> 4;
        pg8::bf16x8 xf[4][4];
        { const bf16* wp = w2t + (size_t)kv * 64 * 128 + fr * 128 + fq * 8;
#pragma unroll
          for (int ib = 0; ib < 4; ++ib)
#pragma unroll
              for (int ks = 0; ks < 4; ++ks) xf[ib][ks] = *(const pg8::bf16x8*)(wp + ib * 16 * 128 + ks * 32); }
        f32x4 bb[2];
#pragma unroll
        for (int n = 0; n < 2; ++n) bb[n] = *(const f32x4*)(b1 + kv * 128 + wc * 32 + fq * 8 + 4 * n);
#pragma unroll
        for (int ai = 0; ai < 2; ++ai)
#pragma unroll
            for (int m = 0; m < 4; ++m) { const int row = ai * 128 + wr * 64 + m * 16 + fr;
#pragma unroll
                for (int n = 0; n < 2; ++n) *(LAS f32x4*)(lds + row * 512 + (((wc * 8 + fq * 2 + n) ^ (row & 15)) << 4)) = acc[ai][1][m][n]; }
        EPI_LBAR();
        v4u hv[2][4];
#pragma unroll
        for (int ai = 0; ai < 2; ++ai)
#pragma unroll
            for (int m = 0; m < 4; ++m) { const int row = ai * 128 + wr * 64 + m * 16 + fr, rn = (row < 255) ? row + 1 : 255; float h[8];
#pragma unroll
                for (int n = 0; n < 2; ++n) { const f32x4 q = *(const LAS f32x4*)(lds + rn * 512 + (((wc * 8 + fq * 2 + n) ^ (rn & 15)) << 4)); const f32x4 v = acc[ai][0][m][n] + q + bb[n];
#pragma unroll
                    for (int e = 0; e < 4; ++e) { const float x = v[e], t = x * (1.f + 0.044715f * x * x) * (-2.f * 0.7978845608028654f * 1.4426950408889634f);
                        h[4 * n + e] = ((row & 127) == 127) ? 0.f : x * __builtin_amdgcn_rcpf(1.f + __builtin_amdgcn_exp2f(t)); } }
                hv[ai][m] = (v4u){cvtpk(h[0], h[1]), cvtpk(h[2], h[3]), cvtpk(h[4], h[5]), cvtpk(h[6], h[7])}; }
        EPI_LBAR();
#pragma unroll
        for (int ai = 0; ai < 2; ++ai)
#pragma unroll
            for (int m = 0; m < 4; ++m) { const int row = ai * 128 + wr * 64 + m * 16 + fr; *(LAS v4u*)(lds + row * 256 + (((wc * 4 + fq) ^ (row & 15)) << 4)) = hv[ai][m]; }
        EPI_LBAR();
        bf16* CC = (bf16*)(ws + WS_CC);
#pragma unroll
        for (int jj = 0; jj < 2; ++jj) { const int row = (2 * wid + jj) * 16 + fr; pg8::f32x4 o[4];
#pragma unroll
            for (int ib = 0; ib < 4; ++ib) o[ib] = (pg8::f32x4){0.f, 0.f, 0.f, 0.f};
#pragma unroll
            for (int ks = 0; ks < 4; ++ks) { const pg8::bf16x8 y = *(const LAS pg8::bf16x8*)(lds + row * 256 + (((ks * 4 + fq) ^ (row & 15)) << 4));
#pragma unroll
                for (int ib = 0; ib < 4; ++ib) o[ib] = __builtin_amdgcn_mfma_f32_16x16x32_bf16(xf[ib][ks], y, o[ib], 0, 0, 0); }
            bf16* cp = CC + ((size_t)u.pm * 256 + row) * 64 + 4 * fq;
#pragma unroll
            for (int ib = 0; ib < 4; ++ib) { v2u w; w.x = cvtpk(o[ib][0], o[ib][1]); w.y = cvtpk(o[ib][2], o[ib][3]); *(v2u*)(cp + ib * 16) = w; } }
    }
};
struct CmpOrder {
    int c, G;
    __device__ __forceinline__ bool next(int i, pg8::Unit& u) const { const int idx = i * G + c; if (idx >= 32) return false; u.pm = idx; u.pn = idx >> 4; return true; }
    __device__ __forceinline__ void a_ready(const pg8::Unit&) const {}
    __device__ __forceinline__ void done(const pg8::Unit&) const {}
};
struct EpiInProj {
    static constexpr bool PERM = true, AFTER_DRAIN = false, HAS_PRE = true; struct Pre {};
    unsigned char* ws; LAS unsigned char* lred;
    __device__ __forceinline__ void pre_load(const pg8::Unit& u, int wr, int wc, Pre&) const {
        if (wc == 0) { const float* sp = (const float*)(ws + WS_TAB + TAB_SS2) + (size_t)(u.pm * 256 + wr * 64 + fresh_lane()) * 4;
            __builtin_amdgcn_global_load_lds((const unsigned*)sp, (LAS unsigned*)(lred + wr * 2048), 16, 0, 0);
            __builtin_amdgcn_global_load_lds((const unsigned*)(sp + 128 * 4), (LAS unsigned*)(lred + wr * 2048 + 1024), 16, 0, 0); } }
    __device__ __forceinline__ void operator()(const pg8::f32x4 (&acc)[2][2][4][2], const pg8::Unit& u, int wr, int wc, int fr, int fq, const Pre&) const {
        const int pn = u.pn;
        const bool ropet = (pn < 2) || (pn == 3) || (pn == 4);
        const bool ropew = ropet && ((wc & 1) == 0);
        float rsv[2][4];
#pragma unroll
        for (int ai = 0; ai < 2; ++ai)
#pragma unroll
            for (int m = 0; m < 4; ++m) { const f32x4 p = *(const LAS f32x4*)(lred + wr * 2048 + ai * 1024 + (m * 16 + fr) * 16); rsv[ai][m] = __frsqrt_rn(((p.x + p.y) + (p.z + p.w)) * (1.f / DM) + EPS); }
#pragma unroll
        for (int ai = 0; ai < 2; ++ai)
#pragma unroll
            for (int m = 0; m < 4; ++m) {
                const int row = u.pm * 256 + ai * 128 + wr * 64 + m * 16 + fr;
                const int b = row >> 11, t = row & 2047; const float rs = rsv[ai][m];
                f32x4 c0, c1, s0, s1;
                if (ropew) {
                    const float tf = (float)t; float cs_[8], sn_[8];
                    const float ifr[8] = {1.5915494309e-01f, 3.0863763405e-02f, 5.9851857127e-03f, 1.1606636412e-03f, 2.2507907904e-04f, 4.3647952793e-05f, 8.4643308082e-06f, 1.6414262628e-06f};
#pragma unroll
                    for (int e = 0; e < 8; ++e) { const float rv = __builtin_amdgcn_fractf(tf * ifr[e]); cs_[e] = __builtin_amdgcn_cosf(rv); sn_[e] = __builtin_amdgcn_sinf(rv); }
                    c0 = (f32x4){cs_[0], cs_[1], cs_[2], cs_[3]}; c1 = (f32x4){cs_[4], cs_[5], cs_[6], cs_[7]}; s0 = (f32x4){sn_[0], sn_[1], sn_[2], sn_[3]}; s1 = (f32x4){sn_[4], sn_[5], sn_[6], sn_[7]}; }
#pragma unroll
                for (int bj = 0; bj < 2; ++bj) {
                    f32x4 v0 = acc[ai][bj][m][0] * rs, v1 = acc[ai][bj][m][1] * rs;
                    const int cl = bj * 128 + wc * 32 + fq * 8;
                    if (ropew && (pn < 2 || bj == 0)) {
                        f32x4 p0, p1; const int ln = fq * 16 + fr;
                        p0.x = shx(v0.x, 16, ln); p0.y = shx(v0.y, 16, ln); p0.z = shx(v0.z, 16, ln); p0.w = shx(v0.w, 16, ln);
                        p1.x = shx(v1.x, 16, ln); p1.y = shx(v1.y, 16, ln); p1.z = shx(v1.z, 16, ln); p1.w = shx(v1.w, 16, ln);
                        const float sg = (fq == 0) ? -1.f : 1.f;
                        if (fq < 2) { v0 = v0 * c0 + (p0 * s0) * sg; v1 = v1 * c1 + (p1 * s1) * sg; }
                    }
                    if (pn < 2) { v0 = v0 * 0.18033688011112042f; v1 = v1 * 0.18033688011112042f; }
                    if (pn == 13) { if (cl < 32) { float* p = (float*)(ws + WS_GATE) + (size_t)row * 32 + cl; *(f32x4*)p = v0; *(f32x4*)(p + 4) = v1; } }
                    else {
                        size_t off;
                        if (pn < 2) off = WS_QN + ((size_t)row * 512 + pn * 256 + cl) * 2;
                        else if (pn < 5) { const int g = wc >> 1, d = (wc & 1) * 32 + fq * 8; off = WS_KCR + (size_t)((pn - 2) * 2 + bj) * (8 * MiB) + (((size_t)(b * 2 + g) * SEQ + t) * 64 + d) * 2; }
                        else { const int q = pn - 5; off = WS_MQ + (size_t)(q >> 1) * (32 * MiB) + ((size_t)row * 512 + (q & 1) * 256 + cl) * 2; }
                        v4u w; w.x = pg8::cvt_pk_bf16(v0.x, v0.y); w.y = pg8::cvt_pk_bf16(v0.z, v0.w); w.z = pg8::cvt_pk_bf16(v1.x, v1.y); w.w = pg8::cvt_pk_bf16(v1.z, v1.w);
                        *(v4u*)(ws + off) = w;
                    }
                }
            }
    }
};
static_assert(WS_VCR == WS_KCR + 8 * MiB && WS_KS == WS_KCR + 16 * MiB && WS_VS == WS_KCR + 24 * MiB && WS_KW == WS_KCR + 32 * MiB && WS_VW == WS_KCR + 40 * MiB, "kv buffers are 8 MiB apart in (pn, bj) order");
static_assert(WS_MK == WS_MQ + 32 * MiB && WS_MV == WS_MQ + 64 * MiB && WS_MO == WS_MQ + 96 * MiB, "mLSTM buffers are 32 MiB apart");

struct MixPtrs { unsigned char* ws; const float *conv_w, *conv_b, *i_bias, *f_bias, *mnorm_g; };
#define MP_QN ((const bf16*)(P.ws + WS_QN))
#define MP_KS ((const bf16*)(P.ws + WS_KS))
#define MP_VS ((const bf16*)(P.ws + WS_VS))
#define MP_KW ((const bf16*)(P.ws + WS_KW))
#define MP_VW ((const bf16*)(P.ws + WS_VW))
#define MP_KC ((const bf16*)(P.ws + WS_CC))
#define MP_VC ((const bf16*)(P.ws + WS_CC) + (size_t)4096 * 64)
#define MP_MQ ((const bf16*)(P.ws + WS_MQ))
#define MP_MK ((const bf16*)(P.ws + WS_MK))
#define MP_MV ((const bf16*)(P.ws + WS_MV))
#define MP_MO ((const bf16*)(P.ws + WS_MO))
#define MP_GATE ((const float*)(P.ws + WS_GATE))
#define MP_Y ((bf16*)(P.ws + WS_U))


typedef float f32x16 __attribute__((ext_vector_type(16)));
typedef short bf16x8v __attribute__((ext_vector_type(8)));
typedef short s16x4v __attribute__((ext_vector_type(4)));
typedef float f32x2v __attribute__((ext_vector_type(2)));
typedef __bf16 bf16x2v __attribute__((ext_vector_type(2)));
#define MFMA32(a, b, c) __builtin_amdgcn_mfma_f32_32x32x16_bf16((a), (b), (c), 0, 0, 0)
__device__ __forceinline__ s16x4v tr_read(const LAS unsigned char* p) { return __builtin_bit_cast(s16x4v, __builtin_amdgcn_ds_read_tr16_b64_v4i16((LAS s16x4v*)p)); }
__device__ __forceinline__ int tile_off(int key, int ch8) { return (ch8 >> 2) * 4096 + key * 64 + (((ch8 & 3) ^ ((key >> 2) & 3)) << 4); }
constexpr int NM_SLOT = 0, NM_IMP = 65536, NM_IMS = 99328, NM_SEL = 108544, NM_ITEM = 108864;
constexpr float QK_SCALE = 0.125f * 1.4426950408889634f;

#define SBAR() __builtin_amdgcn_sched_barrier(0)
__device__ __forceinline__ void xor32_pair(float v, float& lo, float& hi) { float a = v, b = v; asm volatile("s_nop 1\n\tv_permlane32_swap_b32 %0, %1" : "+v"(a), "+v"(b)); lo = a; hi = b; }
__device__ __forceinline__ float xor32_max(float v) { float lo, hi; xor32_pair(v, lo, hi); float r; asm("v_max_f32 %0, %1, %2" : "=v"(r) : "v"(lo), "v"(hi)); return r; }
__device__ __forceinline__ float xor32_sum(float v) { float lo, hi; xor32_pair(v, lo, hi); return lo + hi; }
__device__ __forceinline__ float max2f(float a, float b) { float r; asm("v_max_f32 %0, %1, %2" : "=v"(r) : "v"(a), "v"(b)); return r; }
__device__ __forceinline__ float max3f(float a, float b, float c) { float r; asm("v_max3_f32 %0, %1, %2, %3" : "=v"(r) : "v"(a), "v"(b), "v"(c)); return r; }
#define LBAR() asm volatile("s_waitcnt lgkmcnt(0)\n\ts_barrier" ::: "memory")
__device__ __forceinline__ void k_load(const LAS unsigned char* Ks, int r, int h, bf16x8v (&kf)[8]) {
    const int sw = (r >> 2) & 3;
#pragma unroll
    for (int ks = 0; ks < 4; ++ks) { const int off = (ks >> 1) * 4096 + r * 64 + (((((ks & 1) << 1) + h) ^ sw) << 4);
        kf[2 * ks] = *(const LAS bf16x8v*)(Ks + off); kf[2 * ks + 1] = *(const LAS bf16x8v*)(Ks + off + 2048); }
}
__device__ __forceinline__ void qk_mma(const bf16x8v (&kf)[8], const bf16x8v (&qf)[4], f32x16& p0, f32x16& p1) {
    const f32x16 z = {0.f, 0.f, 0.f, 0.f, 0.f, 0.f, 0.f, 0.f, 0.f, 0.f, 0.f, 0.f, 0.f, 0.f, 0.f, 0.f};
#pragma unroll
    for (int ks = 0; ks < 4; ++ks) { p0 = MFMA32(kf[2 * ks], qf[ks], ks ? p0 : z); p1 = MFMA32(kf[2 * ks + 1], qf[ks], ks ? p1 : z); }
}
__device__ __forceinline__ void v_load(const LAS unsigned char* Vs, int lane, bf16x8v (&vf)[8]) {
    const int h = lane >> 5, i16 = lane & 15, q = i16 >> 2, p = i16 & 3, gi = (lane >> 4) & 1;
    const int cidx = 2 * gi + (p >> 1), e8 = (p & 1) << 3;
    const int offlo = q * 64 + ((cidx ^ h) << 4) + e8 + h * 256, offhi = q * 64 + ((cidx ^ (h | 2)) << 4) + e8 + h * 256 + 512;
#pragma unroll
    for (int kb = 0; kb < 2; ++kb)
#pragma unroll
        for (int s = 0; s < 2; ++s)
#pragma unroll
            for (int db = 0; db < 2; ++db) { const LAS unsigned char* base = Vs + db * 4096 + (kb * 32 + s * 16) * 64;
                const s16x4v lo = tr_read(base + offlo), hi = tr_read(base + offhi);
                vf[(kb * 2 + s) * 2 + db] = __builtin_shufflevector(lo, hi, 0, 1, 2, 3, 4, 5, 6, 7); }
}
__device__ __forceinline__ void pv_mma(const bf16x8v (&vf)[8], const f32x16& p0, const f32x16& p1, f32x16 (&o)[2]) {
#pragma unroll
    for (int kb = 0; kb < 2; ++kb)
#pragma unroll
        for (int s = 0; s < 2; ++s) {
            const f32x16& P = kb ? p1 : p0;
            v4u pw; pw.x = cvtpk(P[8 * s + 0], P[8 * s + 1]); pw.y = cvtpk(P[8 * s + 2], P[8 * s + 3]); pw.z = cvtpk(P[8 * s + 4], P[8 * s + 5]); pw.w = cvtpk(P[8 * s + 6], P[8 * s + 7]);
            const bf16x8v pf = __builtin_bit_cast(bf16x8v, pw);
            o[0] = MFMA32(vf[(kb * 2 + s) * 2], pf, o[0]); o[1] = MFMA32(vf[(kb * 2 + s) * 2 + 1], pf, o[1]);
        }
}

__device__ __forceinline__ void nsa_unit_mfma(LAS unsigned char* L, const MixPtrs& P, int b, int g, int c, int tid_in) {
    int tid_l = tid_in; asm volatile("" : "+v"(tid_l));
    const int tid = tid_l, lane = tid & 63, w = __builtin_amdgcn_readfirstlane(tid >> 6);
    const int r = lane & 31, h = lane >> 5, head = w >> 1, qi = (w & 1) * 32 + r, t = c * 64 + qi;
    const size_t row = (size_t)b * SEQ + t;
    LAS unsigned* SEL = (LAS unsigned*)(L + NM_SEL); LAS int* ITEM = (LAS int*)(L + NM_ITEM);
    const size_t kvbase = (size_t)(b * 2 + g) * SEQ * 64, ccbase = (size_t)(b * 2 + g) * 128 * 64;
    const int skey = tid >> 3, sch = tid & 7, soff = tile_off(skey, sch);
    bf16x8v qf[4];
    { const bf16* qp = MP_QN + row * 512 + (g * 4 + head) * 64 + 8 * h;
#pragma unroll
      for (int ks = 0; ks < 4; ++ks) qf[ks] = *(const bf16x8v*)(qp + 16 * ks); }
    const float* gp = MP_GATE + row * 32 + g * 4 + head;
    float one = 1.f; asm volatile("" : "+v"(one));
    const float gate_c = __builtin_amdgcn_rcpf(one + __expf(-gp[0])), gate_s = __builtin_amdgcn_rcpf(one + __expf(-gp[8])), gate_w = __builtin_amdgcn_rcpf(one + __expf(-gp[16]));
    f32x16 oacc[2];
    {
        const bf16* kc = MP_KC + ccbase; const bf16* vc = MP_VC + ccbase;
        const v4u k0 = *(const v4u*)(kc + tid * 8), k1 = *(const v4u*)(kc + 4096 + tid * 8), v0 = *(const v4u*)(vc + tid * 8), v1 = *(const v4u*)(vc + 4096 + tid * 8);
        LBAR();
        *(LAS v4u*)(L + NM_SLOT + soff) = k0; *(LAS v4u*)(L + NM_SLOT + 8192 + soff) = v0; *(LAS v4u*)(L + NM_SLOT + 16384 + soff) = k1; *(LAS v4u*)(L + NM_SLOT + 24576 + soff) = v1;
        if (tid < 64) SEL[tid] = 0u;
        LBAR();
        f32x16 s0, s1, s2, s3;
        { bf16x8v kfa[8], kfb[8]; k_load(L + NM_SLOT, r, h, kfa); k_load(L + NM_SLOT + 16384, r, h, kfb); SBAR(); qk_mma(kfa, qf, s0, s1); qk_mma(kfb, qf, s2, s3); }
        const int nlim = (t >= 31) ? (((t - 31) >> 4) < 126 ? ((t - 31) >> 4) : 126) : -1;
        float mx, mxv[4] = {-1e20f, -1e20f, -1e20f, -1e20f};
#pragma unroll
        for (int e = 0; e < 16; ++e) { const int cr = (e & 3) + 8 * (e >> 2) + 4 * h;
            s0[e] = (cr <= nlim) ? s0[e] * QK_SCALE : -1e30f; s1[e] = (cr + 32 <= nlim) ? s1[e] * QK_SCALE : -1e30f;
            s2[e] = (cr + 64 <= nlim) ? s2[e] * QK_SCALE : -1e30f; s3[e] = (cr + 96 <= nlim) ? s3[e] * QK_SCALE : -1e30f;
            mxv[e & 3] = fmaxf(fmaxf(mxv[e & 3], fmaxf(s0[e], s1[e])), fmaxf(s2[e], s3[e])); }
        mx = fmaxf(fmaxf(mxv[0], mxv[1]), fmaxf(mxv[2], mxv[3]));
        mx = xor32_max(mx);
        float ls, lsv[4] = {0.f, 0.f, 0.f, 0.f};
#pragma unroll
        for (int e = 0; e < 16; ++e) { s0[e] = __builtin_amdgcn_exp2f(s0[e] - mx); s1[e] = __builtin_amdgcn_exp2f(s1[e] - mx); s2[e] = __builtin_amdgcn_exp2f(s2[e] - mx); s3[e] = __builtin_amdgcn_exp2f(s3[e] - mx);
            lsv[e & 3] += (s0[e] + s1[e]) + (s2[e] + s3[e]); }
        ls = (lsv[0] + lsv[1]) + (lsv[2] + lsv[3]);
        ls = xor32_sum(ls);
        const float il = (ls > 0.f) ? __builtin_amdgcn_rcpf(ls) : 0.f;
#pragma unroll
        for (int e = 0; e < 16; ++e) { s0[e] *= il; s1[e] *= il; s2[e] *= il; s3[e] *= il; }
        { LAS float* IMP = (LAS float*)(L + NM_IMP) + (w * 32 + r) * 33; float plprev = 0.f;
#pragma unroll
          for (int x = 0; x < 16; ++x) {
              const f32x16& S = (x < 4) ? s0 : ((x < 8) ? s1 : ((x < 12) ? s2 : s3)); const int g4 = (x & 3) * 4;
              const float own = (S[g4] + S[g4 + 1]) + (S[g4 + 2] + S[g4 + 3]);
              const float pl = shx(S[g4 + 3], 32, lane);
              if (h == 1) IMP[2 * x + 1] = own + pl; else IMP[2 * x] = own + plprev;
              plprev = pl;
          }
        }
        oacc[0] = (f32x16){0.f, 0.f, 0.f, 0.f, 0.f, 0.f, 0.f, 0.f, 0.f, 0.f, 0.f, 0.f, 0.f, 0.f, 0.f, 0.f}; oacc[1] = oacc[0];
        { bf16x8v vfa[8], vfb[8]; v_load(L + NM_SLOT + 8192, lane, vfa); v_load(L + NM_SLOT + 24576, lane, vfb); SBAR(); pv_mma(vfa, s0, s1, oacc); pv_mma(vfb, s2, s3, oacc); }
#pragma unroll
        for (int e = 0; e < 16; ++e) { oacc[0][e] *= gate_c; oacc[1][e] *= gate_c; }
    }
    LBAR();
    { const int i = tid & 63, jg = tid >> 6; const LAS float* I8 = (const LAS float*)(L + NM_IMP); LAS float* IMS = (LAS float*)(L + NM_IMS);
#pragma unroll
      for (int jj = 0; jj < 4; ++jj) { const int j = 4 * jg + jj; const int wq = (i >> 5), rq = i & 31;
          IMS[i * 36 + j] = (I8[((0 + wq) * 32 + rq) * 33 + j] + I8[((2 + wq) * 32 + rq) * 33 + j]) + (I8[((4 + wq) * 32 + rq) * 33 + j] + I8[((6 + wq) * 32 + rq) * 33 + j]); }
      LBAR();
      unsigned bits = 0u;
      if (c + 1 <= 16) { if (jg == 0) bits = (1u << (c + 1)) - 1u; }
      else { if (jg == 0) bits = 1u | (1u << c) | (1u << (c - 1));
          { float iv[32];
#pragma unroll
            for (int q8 = 0; q8 < 8; ++q8) { const f32x4 x = *(const LAS f32x4*)(IMS + i * 36 + 4 * q8); iv[4 * q8] = x.x; iv[4 * q8 + 1] = x.y; iv[4 * q8 + 2] = x.z; iv[4 * q8 + 3] = x.w; }
#pragma unroll
            for (int jj = 0; jj < 4; ++jj) { const int j = 4 * jg + jj; const float vj = IMS[i * 36 + j]; int rank = 0;
#pragma unroll
                for (int i2 = 1; i2 < 30; ++i2) rank += (i2 <= c - 2 && (iv[i2] > vj || (iv[i2] == vj && i2 < j))) ? 1 : 0;
                if (j >= 1 && j <= c - 2 && rank < 13) bits |= 1u << j; } } }
      if (bits) atomicOr((unsigned*)&SEL[i], bits);
      LBAR();
      if (w == 0) { unsigned so = SEL[lane];
#pragma unroll
          for (int o2 = 32; o2; o2 >>= 1) so |= shxu(so, o2, lane);
          if (lane == 0) { int n = 0; for (int j = 0; j <= c; ++j) if ((so >> j) & 1u) ITEM[n++] = j; const int j0 = (c - 8 > 0) ? c - 8 : 0; for (int j = j0; j <= c; ++j) ITEM[n++] = 64 + j; ITEM[n] = -1; ITEM[47] = n; } }
      LBAR();
    }
    const unsigned mysel = SEL[qi]; const int nitem = ITEM[47];
    f32x16 o[2]; float m = -1e20f, lsum = 0.f; int prev_kind = 0;
    o[0] = (f32x16){0.f, 0.f, 0.f, 0.f, 0.f, 0.f, 0.f, 0.f, 0.f, 0.f, 0.f, 0.f, 0.f, 0.f, 0.f, 0.f}; o[1] = o[0];
    const int npair = (nitem + 1) >> 1;
    v4u rk0, rv0, rk1, rv1;
#define NSA_LOAD_PAIR(ip_) do { const int ia_ = ITEM[2 * (ip_)], ib_ = ITEM[2 * (ip_) + 1]; \
        { const bf16* kp = ((ia_ & 64) ? MP_KW : MP_KS) + kvbase + (size_t)(ia_ & 63) * 4096; const bf16* vp = ((ia_ & 64) ? MP_VW : MP_VS) + kvbase + (size_t)(ia_ & 63) * 4096; rk0 = *(const v4u*)(kp + tid * 8); rv0 = *(const v4u*)(vp + tid * 8); } \
        if (ib_ >= 0) { const bf16* kp = ((ib_ & 64) ? MP_KW : MP_KS) + kvbase + (size_t)(ib_ & 63) * 4096; const bf16* vp = ((ib_ & 64) ? MP_VW : MP_VS) + kvbase + (size_t)(ib_ & 63) * 4096; rk1 = *(const v4u*)(kp + tid * 8); rv1 = *(const v4u*)(vp + tid * 8); } } while (0)
#define NSA_WRITE_PAIR(sb_) do { *(LAS v4u*)(L + (sb_) + soff) = rk0; *(LAS v4u*)(L + (sb_) + 8192 + soff) = rv0; *(LAS v4u*)(L + (sb_) + 16384 + soff) = rk1; *(LAS v4u*)(L + (sb_) + 24576 + soff) = rv1; } while (0)
    rk1 = (v4u){0u, 0u, 0u, 0u}; rv1 = rk1;
    NSA_LOAD_PAIR(0);
    NSA_WRITE_PAIR(NM_SLOT + 32768);
    LBAR();
#pragma unroll 1
    for (int ip = 0; ip < npair; ++ip) {
        if (ip + 1 < npair) NSA_LOAD_PAIR(ip + 1);
        const int sbase = NM_SLOT + ((ip + 1) & 1) * 32768;
#pragma unroll 1
        for (int half = 0; half < 2; ++half) {
            const int item = ITEM[2 * ip + half];
            if (item < 0) break;
            const int kind = item >> 6, j = item & 63;
            if (kind != prev_kind) {
                const float tot = xor32_sum(lsum); const float sc = gate_s * __builtin_amdgcn_rcpf(tot);
#pragma unroll
                for (int e = 0; e < 16; ++e) { oacc[0][e] += o[0][e] * sc; oacc[1][e] += o[1][e] * sc; o[0][e] = 0.f; o[1][e] = 0.f; }
                m = -1e20f; lsum = 0.f; prev_kind = kind;
            }
            int klo, khi;
            if (kind == 0) { klo = 0; khi = ((mysel >> j) & 1u) ? ((j < c) ? 63 : qi) : -1; }
            else { klo = t - 511 - 64 * j; khi = t - 64 * j; if (khi > 63) khi = 63; if (klo < 0) klo = 0; }
            const LAS unsigned char* slot = L + sbase + half * 16384;
            if (__any(khi >= klo)) {
                f32x16 p0, p1; bf16x8v vf[8];
                { bf16x8v kf[8]; k_load(slot, r, h, kf); SBAR(); qk_mma(kf, qf, p0, p1); }
                v_load(slot + 8192, lane, vf); SBAR();
                if (!__all(klo == 0 && khi == 63)) {
                    const int a = klo - 4 * h, z = khi - 4 * h;
#pragma unroll
                    for (int e = 0; e < 16; ++e) { const int cr = (e & 3) + 8 * (e >> 2);
                        p0[e] = (cr >= a && cr <= z) ? p0[e] : -1e30f; p1[e] = (cr + 32 >= a && cr + 32 <= z) ? p1[e] : -1e30f; }
                }
                float tm;
                { float ma = max2f(p0[0], p1[0]), mb = max2f(p0[1], p1[1]), mc2 = max2f(p0[2], p1[2]), md = max2f(p0[3], p1[3]);
#pragma unroll
                  for (int e = 4; e < 16; e += 4) { ma = max3f(ma, p0[e], p1[e]); mb = max3f(mb, p0[e + 1], p1[e + 1]); mc2 = max3f(mc2, p0[e + 2], p1[e + 2]); md = max3f(md, p0[e + 3], p1[e + 3]); }
                  tm = max3f(ma, mb, max2f(mc2, md)); }
                tm = xor32_max(tm);
                const float mn = fmaxf(m, tm * QK_SCALE);
                if (!__all(mn == m)) { const float corr = __builtin_amdgcn_exp2f(m - mn); lsum *= corr;
#pragma unroll
                    for (int e = 0; e < 16; ++e) { o[0][e] *= corr; o[1][e] *= corr; }
                    m = mn; }
                { const f32x2v sc2 = {QK_SCALE, QK_SCALE}, mm2 = {m, m}; f32x2v ta = {0.f, 0.f}, tb = {0.f, 0.f};
#pragma unroll
                  for (int e = 0; e < 16; e += 2) { const f32x2v a0 = (f32x2v){p0[e], p0[e + 1]} * sc2 - mm2, a1 = (f32x2v){p1[e], p1[e + 1]} * sc2 - mm2; p0[e] = a0.x; p0[e + 1] = a0.y; p1[e] = a1.x; p1[e + 1] = a1.y; }
#pragma unroll
                  for (int e = 0; e < 16; ++e) { p0[e] = __builtin_amdgcn_exp2f(p0[e]); p1[e] = __builtin_amdgcn_exp2f(p1[e]); }
#pragma unroll
                  for (int e = 0; e < 16; e += 2) { ta += (f32x2v){p0[e], p0[e + 1]}; tb += (f32x2v){p1[e], p1[e + 1]}; }
                  lsum += (ta.x + ta.y) + (tb.x + tb.y); }
                SBAR(); pv_mma(vf, p0, p1, o);
            }
        }
        if (ip + 1 < npair) NSA_WRITE_PAIR(NM_SLOT + (ip & 1) * 32768);
        LBAR();
    }
#undef NSA_LOAD_PAIR
#undef NSA_WRITE_PAIR
    { const float tot = xor32_sum(lsum); const float sc = gate_w * __builtin_amdgcn_rcpf(tot);
#pragma unroll
      for (int e = 0; e < 16; ++e) { oacc[0][e] += o[0][e] * sc; oacc[1][e] += o[1][e] * sc; } }
    { bf16* yp = MP_Y + row * DM + (g * 4 + head) * 64 + 4 * h;
#pragma unroll
      for (int db = 0; db < 2; ++db)
#pragma unroll
          for (int g4 = 0; g4 < 4; ++g4) { v2u wv; wv.x = cvtpk(oacc[db][4 * g4], oacc[db][4 * g4 + 1]); wv.y = cvtpk(oacc[db][4 * g4 + 2], oacc[db][4 * g4 + 3]); *(v2u*)(yp + db * 32 + g4 * 8) = wv; } }
}

namespace ns3 {
using f32x16 = __attribute__((ext_vector_type(16))) float;
using bf16x8 = __attribute__((ext_vector_type(8))) short;
using s16x4 = __attribute__((ext_vector_type(4))) short;
using u32x4 = __attribute__((ext_vector_type(4))) unsigned;
typedef short v4i16_t __attribute__((ext_vector_type(4)));
typedef LAS const char* lds_cptr;
constexpr int NSLOT = 3, SLOTB = 8192;
constexpr int A_K = 0, A_V = NSLOT * SLOTB, A_WS = 2 * NSLOT * SLOTB, A_OST = A_WS + 8 * 64 * 4, A_END = A_OST + 8 * 8192;
constexpr int A_IMP = A_OST, A_IMS = A_OST + 33792, A_SEL = A_END, A_TTS = A_END + 512, A_TTW = A_TTS + 256;
#define SBAR3() __builtin_amdgcn_sched_barrier(0)
#define WAIT_BAR3(N) asm volatile("s_waitcnt vmcnt(" #N ") lgkmcnt(0)\n\ts_barrier":::"memory")
__device__ __forceinline__ int crow(int r, int hi) { return (r & 3) + 8 * (r >> 2) + 4 * hi; }
__device__ __forceinline__ void glds16(const void* gsrc, unsigned lds_dst) { unsigned keep;
  asm volatile("s_mov_b32 %0, m0\n\ts_mov_b32 m0, %2\n\ts_nop 0\n\tglobal_load_lds_dwordx4 %1, off\n\ts_mov_b32 m0, %0" : "=&s"(keep) : "v"(gsrc), "s"(lds_dst) : "memory"); }
__device__ __forceinline__ float fadd_s(float a, float b) { float r; asm("v_add_f32_e32 %0, %1, %2" : "=v"(r) : "v"(a), "v"(b)); return r; }
__device__ __forceinline__ float fsub_s(float a, float b) { float r; asm("v_sub_f32_e32 %0, %1, %2" : "=v"(r) : "v"(a), "v"(b)); return r; }
__device__ __forceinline__ s16x4 vtr(lds_cptr p) { return __builtin_bit_cast(s16x4, __builtin_amdgcn_ds_read_tr16_b64_v4i16((LAS v4i16_t*)p)); }
__device__ __forceinline__ void qkt(f32x16& p0, f32x16& p1, lds_cptr Kslot, const bf16x8* qr, const f32x16& negm, int r32, int hi) {
  lds_cptr kb = Kslot + hi * 1024 + r32 * 16;
#pragma unroll
  for (int d0 = 0; d0 < 4; ++d0) {
    const bf16x8 b0 = *(const LAS bf16x8*)(kb + d0 * 2048), b1 = *(const LAS bf16x8*)(kb + d0 * 2048 + 512);
    if (d0 == 0) { p0 = __builtin_amdgcn_mfma_f32_32x32x16_bf16(b0, qr[0], negm, 0, 0, 0); p1 = __builtin_amdgcn_mfma_f32_32x32x16_bf16(b1, qr[0], negm, 0, 0, 0); }
    else { p0 = __builtin_amdgcn_mfma_f32_32x32x16_bf16(b0, qr[d0], p0, 0, 0, 0); p1 = __builtin_amdgcn_mfma_f32_32x32x16_bf16(b1, qr[d0], p1, 0, 0, 0); } }
}
__device__ __forceinline__ void kload8(bf16x8* kf, lds_cptr kp) {
  kf[0] = *(const LAS bf16x8*)(kp);        kf[1] = *(const LAS bf16x8*)(kp + 512);
  kf[2] = *(const LAS bf16x8*)(kp + 2048); kf[3] = *(const LAS bf16x8*)(kp + 2560);
  kf[4] = *(const LAS bf16x8*)(kp + 4096); kf[5] = *(const LAS bf16x8*)(kp + 4608);
  kf[6] = *(const LAS bf16x8*)(kp + 6144); kf[7] = *(const LAS bf16x8*)(kp + 6656);
}
__device__ __forceinline__ void kload2(bf16x8* kf, lds_cptr kp, int j) { kf[2 * j] = *(const LAS bf16x8*)(kp + j * 2048); kf[2 * j + 1] = *(const LAS bf16x8*)(kp + j * 2048 + 512); }
__device__ __forceinline__ float rowmax(const f32x16& p0, const f32x16& p1) {
  float a = max3f(p0[0], p0[1], p1[0]), b = max3f(p0[2], p0[3], p1[1]); a = max3f(a, p1[2], p1[3]);
#pragma unroll
  for (int r = 4; r < 16; r += 4) { a = max3f(a, p0[r], p0[r + 1]); b = max3f(b, p0[r + 2], p0[r + 3]); a = max3f(a, p1[r], p1[r + 1]); b = max3f(b, p1[r + 2], p1[r + 3]); }
  return xor32_max(max2f(a, b));
}
__device__ __forceinline__ void pv(f32x16* o, int vb, bf16x8 pa0, bf16x8 pa1, bf16x8 pa2, bf16x8 pa3) {
#pragma unroll
  for (int d0 = 0; d0 < 2; ++d0) { s16x4 lo[4], hi[4];
#pragma unroll
    for (int ks = 0; ks < 4; ++ks) {
      asm volatile("ds_read_b64_tr_b16 %0,%1 offset:%c2" : "=&v"(lo[ks]) : "v"(vb), "i"(d0 * 4096 + ks * 1024) : "memory");
      asm volatile("ds_read_b64_tr_b16 %0,%1 offset:%c2" : "=&v"(hi[ks]) : "v"(vb), "i"(d0 * 4096 + ks * 1024 + 512) : "memory"); }
    asm volatile("s_waitcnt lgkmcnt(0)" ::: "memory"); SBAR3();
#define PK3(k) (bf16x8){lo[k][0], lo[k][1], lo[k][2], lo[k][3], hi[k][0], hi[k][1], hi[k][2], hi[k][3]}
    o[d0] = __builtin_amdgcn_mfma_f32_32x32x16_bf16(pa0, PK3(0), o[d0], 0, 0, 0);
    o[d0] = __builtin_amdgcn_mfma_f32_32x32x16_bf16(pa1, PK3(1), o[d0], 0, 0, 0);
    o[d0] = __builtin_amdgcn_mfma_f32_32x32x16_bf16(pa2, PK3(2), o[d0], 0, 0, 0);
    o[d0] = __builtin_amdgcn_mfma_f32_32x32x16_bf16(pa3, PK3(3), o[d0], 0, 0, 0);
#undef PK3
  }
}
template <int BR>
__device__ __forceinline__ void rmask(f32x16& p0, f32x16& p1, int e, unsigned mysel, int qi, int tq, int c, int hi) {
  const int kind = e >> 6, j = e & 63; const float NEG = -INFINITY;
  if (BR == 1) {
    int klo, khi;
    if (kind == 1) { klo = tq - 511 - 64 * j; khi = tq - 64 * j; if (khi > 63) khi = 63; if (klo < 0) klo = 0; }
    else { klo = 0; khi = -1; }
    if (!__all(klo == 0 && khi == 63)) { const int a = klo - 4 * hi, z = khi - 4 * hi;
#pragma unroll
      for (int r = 0; r < 16; ++r) { const int cr = (r & 3) + 8 * (r >> 2); if (cr < a || cr > z) p0[r] = NEG; if (cr + 32 < a || cr + 32 > z) p1[r] = NEG; } }
  } else {
    const bool on = (kind == 0) && ((mysel >> j) & 1u);
    const int z = on ? ((j == c) ? qi - 4 * hi : 64) : -1;
    if (!__all(z == 64)) {
#pragma unroll
      for (int r = 0; r < 16; ++r) { const int cr = (r & 3) + 8 * (r >> 2); p0[r] = (cr <= z) ? p0[r] : NEG; p1[r] = (cr + 32 <= z) ? p1[r] : NEG; }
    }
  }
}

template <int THRL, int BR>
__device__ __forceinline__ void stream(LAS unsigned char* L, const bf16* Kb, const bf16* Vb, const LAS int* TT, const int NT, const bf16x8 (&qr)[4],
                                       int lane, int wid, unsigned mysel, int qi, int tq, int c, float gate, bool first_write,
                                       const bf16* Knext  , const LAS int* TTnext,
                                       bool kpre  ) {
  const int r32 = lane & 31, hi = lane >> 5;
  const unsigned lds0 = (unsigned)(uintptr_t)L;
  LAS float* wsf = (LAS float*)(L + A_WS) + wid * 64;
  const bf16* ksrc = Kb + (long)lane * 64 + wid * 8;
  const bf16* vsrc = Vb + (long)(16 * (wid & 3) + (lane >> 2)) * 64 + (wid >> 2) * 32 + (lane & 3) * 8;
  const unsigned kdst = lds0 + A_K + wid * 1024, vdst = lds0 + A_V + wid * 1024;
#define TJ(x) ((long)(__builtin_amdgcn_readfirstlane(TT[(x)]) & 63) * 4096)
#define DMA_K(t, slot) glds16(ksrc + TJ(t), (unsigned)__builtin_amdgcn_readfirstlane(kdst + (slot)))
#define DMA_V(t, slot) glds16(vsrc + TJ(t), (unsigned)__builtin_amdgcn_readfirstlane(vdst + (slot)))
  const int vb0 = (int)(lds0 + A_V) + ((lane >> 4) & 1) * 32 + (lane & 3) * 8 + (4 * hi + ((lane & 15) >> 2)) * 64;
  bf16x8 kf[8];
  const lds_cptr shm3 = (lds_cptr)L; const lds_cptr kp0 = shm3 + A_K + hi * 1024 + r32 * 16; const lds_cptr vp0 = shm3 + A_V + ((lane >> 4) & 1) * 32 + (lane & 3) * 8 + (4 * hi + ((lane & 15) >> 2)) * 64;
  if (!kpre) { DMA_K(0, 0); DMA_V(0, 0); DMA_K(1, SLOTB); }
  float mhat = 0.f, l_reg = 0.f; f32x16 o[2]; o[0] = f32x16{}; o[1] = f32x16{}; f32x16 negm = f32x16{}; asm volatile("" : "+v"(negm));
#define CMASK(P0, P1, t) rmask<BR>(P0, P1, __builtin_amdgcn_readfirstlane(TT[(t)]), mysel, qi, tq, c, hi)
  bool resc = false;
#define START(P0, P1) do { const float rm = rowmax(P0, P1); resc = false; \
    { const float dl = rm; mhat = fadd_s(mhat, dl); \
      _Pragma("unroll") for (int r = 0; r < 16; ++r) { P0[r] = fsub_s(P0[r], dl); P1[r] = fsub_s(P1[r], dl); } \
      _Pragma("unroll") for (int r = 0; r < 16; ++r) negm[r] = -mhat; asm volatile("" : "+v"(negm)); } \
    _Pragma("unroll") for (int r = 0; r < 16; ++r) P0[r] = __builtin_amdgcn_exp2f(P0[r]); } while (0)
#define RESC() do { if (resc) { asm volatile("s_waitcnt lgkmcnt(0)" ::: "memory"); \
      _Pragma("unroll") for (int d_ = 0; d_ < 2; ++d_) _Pragma("unroll") for (int r = 0; r < 16; ++r) o[d_][r] *= wsf[crow(r, hi)]; } } while (0)
  f32x16 pA0, pA1, pB0, pB1;
  int sl_prev = 0, sl_cur = 0, sl_next = SLOTB;
#define ROT() do { sl_prev = sl_cur; sl_cur = sl_next; sl_next = (sl_next == (NSLOT - 1) * SLOTB) ? 0 : sl_next + SLOTB; } while (0)
  if (!kpre) { DMA_K(2, 2 * SLOTB); } else { DMA_V(0, 0); }
  WAIT_BAR3(3);
  qkt(pA0, pA1, shm3 + A_K, qr, negm, r32, hi); asm volatile("s_nop 15\n\ts_nop 7" : "+v"(pA0), "+v"(pA1)); CMASK(pA0, pA1, 0);
  START(pA0, pA1);
  _Pragma("unroll") for (int r = 0; r < 16; ++r) pA1[r] = __builtin_amdgcn_exp2f(pA1[r]);
  WAIT_BAR3(0);
  DMA_K(3, 0); DMA_V(1, SLOTB);
  ROT();
  kload8(kf, kp0 + sl_cur);
  WAIT_BAR3(2);
  s16x4 vlo[8], vhi[8]; u32x4 pw0, pw1, pw2, pw3;
#define PKW(P, B) cvtpk(P[B], P[B + 1])
#define PAF(k) __builtin_bit_cast(bf16x8, pw##k)
#define VFR(i) (bf16x8){vlo[i][0], vlo[i][1], vlo[i][2], vlo[i][3], vhi[i][0], vhi[i][1], vhi[i][2], vhi[i][3]}
#define PIN(x) asm volatile("" : "+v"(x))
#define MX3(a, b, c) __builtin_fmaxf(__builtin_fmaxf((a), (b)), (c))
#define GAPA(MF, A0, A1, A2, A3, W0, W1, PW) do { MF; sacc += A0; sacc += A1; sacc += A2; sacc += A3; PIN(sacc); W0; W1; PIN(PW); SBAR3(); } while (0)
#define EX(v) __builtin_amdgcn_exp2f(v)
#define GAPB(MF, X, B) do { MF; X[B] = EX(X[B]); X[B + 1] = EX(X[B + 1]); X[B + 2] = EX(X[B + 2]); X[B + 3] = EX(X[B + 3]); PIN(X); SBAR3(); } while (0)
#define VRD(i) do { vlo[i] = vtr(vp_ + (((i) >> 2) * 4096 + ((i) & 3) * 1024)); vhi[i] = vtr(vp_ + (((i) >> 2) * 4096 + ((i) & 3) * 1024 + 512)); } while (0)
#define KRD(G, j) do { if (G) { kload2(kf, kp0 + sl_next, j); SBAR3(); } } while (0)
#define STEP(C0, C1, P0, P1, t, GK, GV, GL) do { SBAR3(); \
    const lds_cptr vp_ = vp0 + sl_prev; \
    VRD(0); SBAR3(); float sacc = (P0[0] + P0[1]); \
    GAPA(C0 = __builtin_amdgcn_mfma_f32_32x32x16_bf16(kf[0], qr[0], negm, 0, 0, 0), P0[2], P0[3], P0[4], P0[5],     pw0[0] = PKW(P0, 0), pw0[1] = PKW(P0, 2), pw0); \
    VRD(4); SBAR3(); GAPA(C1 = __builtin_amdgcn_mfma_f32_32x32x16_bf16(kf[1], qr[0], negm, 0, 0, 0), P0[6], P0[7], P0[8], P0[9],     pw0[2] = PKW(P0, 4), pw0[3] = PKW(P0, 6), pw0); \
    VRD(1); SBAR3(); GAPA(C0 = __builtin_amdgcn_mfma_f32_32x32x16_bf16(kf[2], qr[1], C0, 0, 0, 0),   P0[10], P0[11], P0[12], P0[13], pw1[0] = PKW(P0, 8), pw1[1] = PKW(P0, 10), pw1); \
    VRD(5); SBAR3(); GAPA(C1 = __builtin_amdgcn_mfma_f32_32x32x16_bf16(kf[3], qr[1], C1, 0, 0, 0),   P0[14], P0[15], P1[0], P1[1],   pw1[2] = PKW(P0, 12), pw1[3] = PKW(P0, 14), pw1); \
    VRD(2); SBAR3(); GAPA(C0 = __builtin_amdgcn_mfma_f32_32x32x16_bf16(kf[4], qr[2], C0, 0, 0, 0),   P1[2], P1[3], P1[4], P1[5],     pw2[0] = PKW(P1, 0), pw2[1] = PKW(P1, 2), pw2); \
    VRD(6); SBAR3(); GAPA(C1 = __builtin_amdgcn_mfma_f32_32x32x16_bf16(kf[5], qr[2], C1, 0, 0, 0),   P1[6], P1[7], P1[8], P1[9],     pw2[2] = PKW(P1, 4), pw2[3] = PKW(P1, 6), pw2); \
    VRD(3); SBAR3(); GAPA(C0 = __builtin_amdgcn_mfma_f32_32x32x16_bf16(kf[6], qr[3], C0, 0, 0, 0),   P1[10], P1[11], P1[12], P1[13], pw3[0] = PKW(P1, 8), pw3[1] = PKW(P1, 10), pw3); \
    VRD(7); SBAR3(); GAPA(C1 = __builtin_amdgcn_mfma_f32_32x32x16_bf16(kf[7], qr[3], C1, 0, 0, 0),   P1[14], P1[15], 0.f, 0.f,       pw3[2] = PKW(P1, 12), pw3[3] = PKW(P1, 14), pw3); \
    l_reg += sacc; \
    if (GK) { DMA_K((t) + 3, sl_cur); } if (GV) { DMA_V((t) + 1, sl_next); } \
    CMASK(C0, C1, t); \
    { float a = MX3(C0[0], C0[1], C1[0]), b = MX3(C0[2], C0[3], C1[1]); a = MX3(a, C1[2], C1[3]); \
      _Pragma("unroll") for (int r = 4; r < 16; r += 4) { a = MX3(a, C0[r], C0[r + 1]); b = MX3(b, C0[r + 2], C0[r + 3]); a = MX3(a, C1[r], C1[r + 1]); b = MX3(b, C1[r + 2], C1[r + 3]); } \
      float rm = xor32_max(__builtin_fmaxf(a, b)); \
      resc = false; \
      if (__builtin_expect(__any(rm > (float)THRL), 0)) { const float dl = __builtin_fmaxf(rm, 0.f); mhat += dl; \
        _Pragma("unroll") for (int r = 0; r < 16; ++r) { C0[r] -= dl; C1[r] -= dl; } \
        _Pragma("unroll") for (int r = 0; r < 16; ++r) negm[r] = -mhat; asm volatile("" : "+v"(negm)); \
        const float f = __builtin_amdgcn_exp2f(-dl); l_reg *= f; if (hi == 0) wsf[r32] = f; resc = true; } } \
    SBAR3(); \
    GAPB(o[0] = __builtin_amdgcn_mfma_f32_32x32x16_bf16(PAF(0), VFR(0), o[0], 0, 0, 0), C0, 0); \
    GAPB(o[1] = __builtin_amdgcn_mfma_f32_32x32x16_bf16(PAF(0), VFR(4), o[1], 0, 0, 0), C0, 4); \
    KRD(GL, 0); GAPB(o[0] = __builtin_amdgcn_mfma_f32_32x32x16_bf16(PAF(1), VFR(1), o[0], 0, 0, 0), C0, 8); \
    KRD(GL, 1); GAPB(o[1] = __builtin_amdgcn_mfma_f32_32x32x16_bf16(PAF(1), VFR(5), o[1], 0, 0, 0), C0, 12); \
    KRD(GL, 2); GAPB(o[0] = __builtin_amdgcn_mfma_f32_32x32x16_bf16(PAF(2), VFR(2), o[0], 0, 0, 0), C1, 0); \
    KRD(GL, 3); GAPB(o[1] = __builtin_amdgcn_mfma_f32_32x32x16_bf16(PAF(2), VFR(6), o[1], 0, 0, 0), C1, 4); \
    GAPB(o[0] = __builtin_amdgcn_mfma_f32_32x32x16_bf16(PAF(3), VFR(3), o[0], 0, 0, 0), C1, 8); \
    GAPB(o[1] = __builtin_amdgcn_mfma_f32_32x32x16_bf16(PAF(3), VFR(7), o[1], 0, 0, 0), C1, 12); \
    } while (0)
#define ENDW(tt) do { if ((tt) + 3 < NT) { WAIT_BAR3(2); } else if ((tt) + 2 < NT) { WAIT_BAR3(1); } else { WAIT_BAR3(0); } } while (0)
  int t = 1;
#pragma unroll 1
  for (; t + 1 < NT; t += 2) {
    STEP(pB0, pB1, pA0, pA1, t, (t + 3 < NT), (t + 1 < NT), (t + 1 < NT));       ENDW(t);     RESC(); ROT();
    STEP(pA0, pA1, pB0, pB1, t + 1, (t + 4 < NT), (t + 2 < NT), (t + 2 < NT));   ENDW(t + 1); RESC(); ROT();
  }
#define TAIL(P0, P1, SLOT) do { float sacc = P0[0] + P0[1]; _Pragma("unroll") for (int r = 2; r < 16; ++r) sacc += P0[r]; _Pragma("unroll") for (int r = 0; r < 16; ++r) sacc += P1[r]; l_reg += sacc; \
    pw0 = (u32x4){PKW(P0, 0), PKW(P0, 2), PKW(P0, 4), PKW(P0, 6)}; pw1 = (u32x4){PKW(P0, 8), PKW(P0, 10), PKW(P0, 12), PKW(P0, 14)}; pw2 = (u32x4){PKW(P1, 0), PKW(P1, 2), PKW(P1, 4), PKW(P1, 6)}; pw3 = (u32x4){PKW(P1, 8), PKW(P1, 10), PKW(P1, 12), PKW(P1, 14)}; \
    SBAR3(); pv(o, vb0 + (SLOT), PAF(0), PAF(1), PAF(2), PAF(3)); } while (0)
  if (Knext) {
    const bf16* ks2 = Knext + (long)lane * 64 + wid * 8;
#define TJ2(x) ((long)(__builtin_amdgcn_readfirstlane(TTnext[(x)]) & 63) * 4096)
    glds16(ks2 + TJ2(0), (unsigned)__builtin_amdgcn_readfirstlane(kdst)); glds16(ks2 + TJ2(1), (unsigned)__builtin_amdgcn_readfirstlane(kdst + SLOTB)); glds16(ks2 + TJ2(2), (unsigned)__builtin_amdgcn_readfirstlane(kdst + 2 * SLOTB));
#undef TJ2
  }
  if (NT & 1) { TAIL(pA0, pA1, sl_prev); }
  else { STEP(pB0, pB1, pA0, pA1, NT - 1, false, false, false); RESC(); TAIL(pB0, pB1, sl_cur); }
#undef TAIL
#undef PKW
#undef PAF
#undef VFR
#undef PIN
#undef MX3
#undef GAPA
#undef GAPB
#undef EX
#undef VRD
#undef KRD
#undef STEP
#undef ENDW
  l_reg = xor32_sum(l_reg);
  if (hi == 0) wsf[32 + r32] = gate * __builtin_amdgcn_rcpf(l_reg);
  asm volatile("s_waitcnt lgkmcnt(0)" ::: "memory");
  { LAS float* stg = (LAS float*)(L + A_OST) + wid * 2048;
#pragma unroll
    for (int r = 0; r < 16; ++r) { const int orow = crow(r, hi); const float fl = wsf[32 + orow];
#pragma unroll
      for (int d0 = 0; d0 < 2; ++d0) { LAS float* p = stg + orow * 64 + d0 * 32 + r32; const float v = o[d0][r] * fl; *p = first_write ? v : (*p + v); } } }
  asm volatile("s_waitcnt lgkmcnt(0)\n\ts_barrier" ::: "memory");
#undef TJ
#undef DMA_K
#undef DMA_V
#undef CMASK
#undef START
#undef RESC
#undef ROT
}
}

__device__ __forceinline__ void nsa_unit_v3(LAS unsigned char* L, const MixPtrs& P, int b, int g, int c, int tid_in) {
    int tid_l = tid_in; asm volatile("" : "+v"(tid_l));
    const int tid = tid_l, lane = tid & 63, w = __builtin_amdgcn_readfirstlane(tid >> 6);
    const int r = lane & 31, h = lane >> 5, head = w >> 1, qi = (w & 1) * 32 + r, t = c * 64 + qi;
    const size_t row = (size_t)b * SEQ + t;
    LAS unsigned* SEL = (LAS unsigned*)(L + ns3::A_SEL); LAS int* TTS = (LAS int*)(L + ns3::A_TTS); LAS int* TTW = (LAS int*)(L + ns3::A_TTW);
    const size_t kvbase = (size_t)(b * 2 + g) * SEQ * 64, ccbase = (size_t)(b * 2 + g) * 128 * 64;
    const int skey = tid >> 3, sch = tid & 7, soff = tile_off(skey, sch);
    bf16x8v qf[4];
    { const bf16* qp = MP_QN + row * 512 + (g * 4 + head) * 64 + 8 * h;
#pragma unroll
      for (int ks = 0; ks < 4; ++ks) qf[ks] = *(const bf16x8v*)(qp + 16 * ks); }
    const float* gp = MP_GATE + row * 32 + g * 4 + head;
    float one = 1.f; asm volatile("" : "+v"(one));
    const float gate_c = __builtin_amdgcn_rcpf(one + __expf(-gp[0])), gate_s = __builtin_amdgcn_rcpf(one + __expf(-gp[8])), gate_w = __builtin_amdgcn_rcpf(one + __expf(-gp[16]));
    f32x16 oacc[2];
    const bool two = c >= 16;
    {
        const bf16* kc = MP_KC + ccbase; const bf16* vc = MP_VC + ccbase;
        const v4u k0 = *(const v4u*)(kc + tid * 8), v0 = *(const v4u*)(vc + tid * 8); v4u k1 = k0, v1 = v0;
        if (two) { k1 = *(const v4u*)(kc + 4096 + tid * 8); v1 = *(const v4u*)(vc + 4096 + tid * 8); }
        LBAR();
        *(LAS v4u*)(L + soff) = k0; *(LAS v4u*)(L + 8192 + soff) = v0; if (two) { *(LAS v4u*)(L + 16384 + soff) = k1; *(LAS v4u*)(L + 24576 + soff) = v1; }
        if (tid < 64) SEL[tid] = 0u;
        LBAR();
        f32x16 s0, s1, s2, s3;
        { bf16x8v kfa[8]; k_load(L, r, h, kfa); SBAR(); qk_mma(kfa, qf, s0, s1); }
        const int nlim = (t >= 31) ? (((t - 31) >> 4) < 126 ? ((t - 31) >> 4) : 126) : -1;
        if (two) {
            { bf16x8v kfb[8]; k_load(L + 16384, r, h, kfb); SBAR(); qk_mma(kfb, qf, s2, s3); }
            float mxv[4] = {-1e20f, -1e20f, -1e20f, -1e20f};
#pragma unroll
            for (int e = 0; e < 16; ++e) { const int cr = (e & 3) + 8 * (e >> 2) + 4 * h;
                s0[e] = (cr <= nlim) ? s0[e] : -1e30f; s1[e] = (cr + 32 <= nlim) ? s1[e] : -1e30f;
                s2[e] = (cr + 64 <= nlim) ? s2[e] : -1e30f; s3[e] = (cr + 96 <= nlim) ? s3[e] : -1e30f;
                mxv[e & 3] = max3f(max3f(mxv[e & 3], s0[e], s1[e]), s2[e], s3[e]); }
            const float mx = xor32_max(max3f(mxv[0], mxv[1], max2f(mxv[2], mxv[3])));
            float lsv[4] = {0.f, 0.f, 0.f, 0.f};
#pragma unroll
            for (int e = 0; e < 16; ++e) { s0[e] = __builtin_amdgcn_exp2f(s0[e] - mx); s1[e] = __builtin_amdgcn_exp2f(s1[e] - mx); s2[e] = __builtin_amdgcn_exp2f(s2[e] - mx); s3[e] = __builtin_amdgcn_exp2f(s3[e] - mx);
                lsv[e & 3] += (s0[e] + s1[e]) + (s2[e] + s3[e]); }
            const float ls = xor32_sum((lsv[0] + lsv[1]) + (lsv[2] + lsv[3]));
            const float il = (ls > 0.f) ? __builtin_amdgcn_rcpf(ls) : 0.f;
#pragma unroll
            for (int e = 0; e < 16; ++e) { s0[e] *= il; s1[e] *= il; s2[e] *= il; s3[e] *= il; }
        } else {
            float mxv[4] = {-1e20f, -1e20f, -1e20f, -1e20f};
#pragma unroll
            for (int e = 0; e < 16; ++e) { const int cr = (e & 3) + 8 * (e >> 2) + 4 * h;
                s0[e] = (cr <= nlim) ? s0[e] : -1e30f; s1[e] = (cr + 32 <= nlim) ? s1[e] : -1e30f;
                mxv[e & 3] = max3f(mxv[e & 3], s0[e], s1[e]); }
            const float mx = xor32_max(max3f(mxv[0], mxv[1], max2f(mxv[2], mxv[3])));
            float lsv[4] = {0.f, 0.f, 0.f, 0.f};
#pragma unroll
            for (int e = 0; e < 16; ++e) { s0[e] = __builtin_amdgcn_exp2f(s0[e] - mx); s1[e] = __builtin_amdgcn_exp2f(s1[e] - mx); lsv[e & 3] += s0[e] + s1[e]; s2[e] = 0.f; s3[e] = 0.f; }
            const float ls = xor32_sum((lsv[0] + lsv[1]) + (lsv[2] + lsv[3]));
            const float il = (ls > 0.f) ? __builtin_amdgcn_rcpf(ls) : 0.f;
#pragma unroll
            for (int e = 0; e < 16; ++e) { s0[e] *= il; s1[e] *= il; }
        }
        if (two) { LAS float* IMP = (LAS float*)(L + ns3::A_IMP) + (w * 32 + r) * 33; float plprev = 0.f;
#pragma unroll
          for (int x = 0; x < 16; ++x) {
              const f32x16& S = (x < 4) ? s0 : ((x < 8) ? s1 : ((x < 12) ? s2 : s3)); const int g4 = (x & 3) * 4;
              const float own = (S[g4] + S[g4 + 1]) + (S[g4 + 2] + S[g4 + 3]);
              const float pl = shx(S[g4 + 3], 32, lane);
              if (h == 1) IMP[2 * x + 1] = own + pl; else IMP[2 * x] = own + plprev;
              plprev = pl;
          }
        }
        oacc[0] = (f32x16){0.f, 0.f, 0.f, 0.f, 0.f, 0.f, 0.f, 0.f, 0.f, 0.f, 0.f, 0.f, 0.f, 0.f, 0.f, 0.f}; oacc[1] = oacc[0];
        { bf16x8v vfa[8]; v_load(L + 8192, lane, vfa); SBAR(); pv_mma(vfa, s0, s1, oacc); }
        if (two) { bf16x8v vfb[8]; v_load(L + 24576, lane, vfb); SBAR(); pv_mma(vfb, s2, s3, oacc); }
    }
    if (two) LBAR();
    { const int i = tid & 63, jg = tid >> 6; const LAS float* I8 = (const LAS float*)(L + ns3::A_IMP); LAS float* IMS = (LAS float*)(L + ns3::A_IMS);
      if (two) {
#pragma unroll
      for (int jj = 0; jj < 4; ++jj) { const int j = 4 * jg + jj; const int wq = (i >> 5), rq = i & 31;
          IMS[i * 36 + j] = (I8[((0 + wq) * 32 + rq) * 33 + j] + I8[((2 + wq) * 32 + rq) * 33 + j]) + (I8[((4 + wq) * 32 + rq) * 33 + j] + I8[((6 + wq) * 32 + rq) * 33 + j]); }
      LBAR(); }
      unsigned bits = 0u;
      if (c + 1 <= 16) { if (jg == 0) bits = (1u << (c + 1)) - 1u; }
      else { if (jg == 0) bits = 1u | (1u << c) | (1u << (c - 1));
          { float iv[32];
#pragma unroll
            for (int q8 = 0; q8 < 8; ++q8) { const f32x4 x = *(const LAS f32x4*)(IMS + i * 36 + 4 * q8); iv[4 * q8] = x.x; iv[4 * q8 + 1] = x.y; iv[4 * q8 + 2] = x.z; iv[4 * q8 + 3] = x.w; }
#pragma unroll
            for (int jj = 0; jj < 4; ++jj) { const int j = 4 * jg + jj; const float vj = IMS[i * 36 + j]; int rank = 0;
#pragma unroll
                for (int i2 = 1; i2 < 30; ++i2) rank += (i2 <= c - 2 && (iv[i2] > vj || (iv[i2] == vj && i2 < j))) ? 1 : 0;
                if (j >= 1 && j <= c - 2 && rank < 13) bits |= 1u << j; } } }
      if (bits) atomicOr((unsigned*)&SEL[i], bits);
      LBAR();
      if (w == 0) { unsigned so = SEL[lane];
#pragma unroll
          for (int o2 = 32; o2; o2 >>= 1) so |= shxu(so, o2, lane);
          { so &= (c >= 31) ? 0xffffffffu : ((2u << c) - 1u);
            const int n = __builtin_popcount(so), nt = (n < 4) ? 4 : n;
            if (lane < 32 && ((so >> lane) & 1u)) TTS[__builtin_popcount(so & ((1u << lane) - 1u))] = lane;
            if (lane >= n && lane < nt + 2) TTS[lane] = 128;
            const int j0 = (c - 8 > 0) ? c - 8 : 0, m2 = 1 + (c - j0), mt = (m2 < 4) ? 4 : m2;
            if (lane == 0) { TTS[46] = nt; TTW[0] = 64 + c; TTW[14] = mt; }
            else if (lane < m2) TTW[lane] = 64 + j0 + lane - 1;
            else if (lane < mt) TTW[lane] = 128; } }
      LBAR();
    }
    const unsigned mysel = SEL[qi]; const int nts = TTS[46], ntw = TTW[14];
    { LAS float* stg = (LAS float*)(L + ns3::A_OST) + w * 2048 + r * 64 + 4 * h;
#pragma unroll
      for (int db = 0; db < 2; ++db)
#pragma unroll
          for (int g4 = 0; g4 < 4; ++g4) *(LAS f32x4*)(stg + db * 32 + g4 * 8) = (f32x4){oacc[db][4 * g4] * gate_c, oacc[db][4 * g4 + 1] * gate_c, oacc[db][4 * g4 + 2] * gate_c, oacc[db][4 * g4 + 3] * gate_c}; }
#if PROBE_SC == 22
    const unsigned st0_ = (unsigned)__builtin_amdgcn_s_memrealtime();
#endif
    ns3::stream<8, 0>(L, MP_KS + kvbase, MP_VS + kvbase, TTS, nts, qf, lane, w, mysel, qi, t, c, gate_s, false, MP_KW + kvbase, TTW, false);
    ns3::stream<8, 1>(L, MP_KW + kvbase, MP_VW + kvbase, TTW, ntw, qf, lane, w, mysel, qi, t, c, gate_w, false, nullptr, nullptr, true);
#if PROBE_SC == 22
    if (tid == 0) { LAS unsigned* pm_ = (LAS unsigned*)(L + MISC_OFF) + 210; pm_[0] += (unsigned)__builtin_amdgcn_s_memrealtime() - st0_; pm_[1] += (unsigned)(nts + ntw); }
#endif
    { const LAS float* stg = (const LAS float*)(L + ns3::A_OST) + w * 2048; bf16* yb = MP_Y + ((size_t)b * SEQ + c * 64 + (w & 1) * 32) * DM + (g * 4 + head) * 64;
#pragma unroll
      for (int i4 = 0; i4 < 4; ++i4) { const int rr = i4 * 8 + (lane >> 3), ch = lane & 7; const f32x4 a = *(const LAS f32x4*)(stg + rr * 64 + ch * 8), bq = *(const LAS f32x4*)(stg + rr * 64 + ch * 8 + 4);
          v4u wv; wv.x = cvtpk(a.x, a.y); wv.y = cvtpk(a.z, a.w); wv.z = cvtpk(bq.x, bq.y); wv.w = cvtpk(bq.z, bq.w);
          *(v4u*)(yb + (size_t)rr * DM + ch * 8) = wv; } }
}

#define MFMA16(a, b, c) __builtin_amdgcn_mfma_f32_16x16x32_bf16((a), (b), (c), 0, 0, 0)
constexpr size_t WS_QC = 422 * MiB, WS_KC2 = 454 * MiB, WS_END2 = 486 * MiB; static_assert(WS_END2 <= WS_PART, "row-partial buffers follow");
#define MP_QC ((const bf16*)(P.ws + WS_QC))
#define MP_KC2 ((const bf16*)(P.ws + WS_KC2))
__device__ __forceinline__ int img_off(int row, int ch) { return 256 * row + 16 * (ch ^ (((row & 3) << 2) | ((row >> 2) & 3))); }
constexpr int M2_IMG = 0, M2_SC = 98304, M2_DEN = 106496, M2_QN = 107520, M2_N = 107776, M2_SSQ = 108288;

__device__ __forceinline__ void mlstm_conv_item(unsigned char* ws, const float* conv_w, const float* conv_b, int b, int tg, int isk, int ch0) {
    {
        const bf16* src = (const bf16*)(ws + (isk ? WS_MK : WS_MQ)) + (size_t)b * SEQ * 512 + ch0;
        bf16* dst = (bf16*)(ws + (isk ? WS_KC2 : WS_QC)) + ((size_t)(b * 4 + (ch0 >> 7)) * SEQ) * 128 + (ch0 & 127);
        float wt[4][8], bs[8];
#pragma unroll
        for (int j = 0; j < 4; ++j) { const f32x4 a = *(const f32x4*)(conv_w + j * 1024 + isk * 512 + ch0), c2 = *(const f32x4*)(conv_w + j * 1024 + isk * 512 + ch0 + 4);
            wt[j][0] = a.x; wt[j][1] = a.y; wt[j][2] = a.z; wt[j][3] = a.w; wt[j][4] = c2.x; wt[j][5] = c2.y; wt[j][6] = c2.z; wt[j][7] = c2.w; }
        { const f32x4 a = *(const f32x4*)(conv_b + isk * 512 + ch0), c2 = *(const f32x4*)(conv_b + isk * 512 + ch0 + 4); bs[0] = a.x; bs[1] = a.y; bs[2] = a.z; bs[3] = a.w; bs[4] = c2.x; bs[5] = c2.y; bs[6] = c2.z; bs[7] = c2.w; }
        const float osc = isk ? 0.08838834764831845f : 1.f;
        const int t0 = tg * 16;
        float x0[8], x1[8], x2[8];
#pragma unroll
        for (int e = 0; e < 8; ++e) { x0[e] = 0.f; x1[e] = 0.f; x2[e] = 0.f; }
        if (t0 > 0) {
            const v4u a = *(const v4u*)(src + (size_t)(t0 - 3) * 512), c2 = *(const v4u*)(src + (size_t)(t0 - 2) * 512), d2 = *(const v4u*)(src + (size_t)(t0 - 1) * 512);
            x0[0] = bflo(a.x); x0[1] = bfhi(a.x); x0[2] = bflo(a.y); x0[3] = bfhi(a.y); x0[4] = bflo(a.z); x0[5] = bfhi(a.z); x0[6] = bflo(a.w); x0[7] = bfhi(a.w);
            x1[0] = bflo(c2.x); x1[1] = bfhi(c2.x); x1[2] = bflo(c2.y); x1[3] = bfhi(c2.y); x1[4] = bflo(c2.z); x1[5] = bfhi(c2.z); x1[6] = bflo(c2.w); x1[7] = bfhi(c2.w);
            x2[0] = bflo(d2.x); x2[1] = bfhi(d2.x); x2[2] = bflo(d2.y); x2[3] = bfhi(d2.y); x2[4] = bflo(d2.z); x2[5] = bfhi(d2.z); x2[6] = bflo(d2.w); x2[7] = bfhi(d2.w);
        }
        v4u rows[16];
#pragma unroll
        for (int s = 0; s < 16; ++s) rows[s] = *(const v4u*)(src + (size_t)(t0 + s) * 512);
#pragma unroll
        for (int s = 0; s < 16; ++s) {
            const v4u a = rows[s];
            const float x3[8] = {bflo(a.x), bfhi(a.x), bflo(a.y), bfhi(a.y), bflo(a.z), bfhi(a.z), bflo(a.w), bfhi(a.w)};
            float o[8];
#pragma unroll
            for (int e = 0; e < 8; ++e) { float v = bs[e] + wt[0][e] * x0[e] + wt[1][e] * x1[e] + wt[2][e] * x2[e] + wt[3][e] * x3[e]; v = v * __builtin_amdgcn_rcpf(1.f + __expf(-v)); o[e] = v * osc; x0[e] = x1[e]; x1[e] = x2[e]; x2[e] = x3[e]; }
            v4u wv; wv.x = cvtpk(o[0], o[1]); wv.y = cvtpk(o[2], o[3]); wv.z = cvtpk(o[4], o[5]); wv.w = cvtpk(o[6], o[7]);
            *(v4u*)(dst + (size_t)(t0 + s) * 128) = wv;
        }
    }
}
__device__ __forceinline__ void mlstm_conv_pass(unsigned char* ws, const float* conv_w, const float* conv_b, int gthread, int nthreads) {
    for (int idx = gthread; idx < BATCH * 128 * 128; idx += nthreads) { const int cc = idx & 127, tg = (idx >> 7) & 127, b = idx >> 14; mlstm_conv_item(ws, conv_w, conv_b, b, tg, cc >> 6, (cc & 63) * 8); }
}
__device__ __forceinline__ void mlstm_conv_unit(unsigned char* ws, const float* conv_w, const float* conv_b, int b, int hh, int tid) {
#pragma unroll 1
    for (int idx = tid; idx < 4096; idx += 512) mlstm_conv_item(ws, conv_w, conv_b, b, idx >> 5, (idx >> 4) & 1, hh * 128 + (idx & 15) * 8);
}

constexpr int M2_A = 112384, M2_PM = 120576, M2_F = 128768, M2_BL = 136960, M2_AMX = 137088, M2_MC = 137216;
__device__ __forceinline__ void mlstm_unit_mfma(LAS unsigned char* L, const MixPtrs& P, int b, int hh, int tid_in) {
    int tid_l = tid_in; asm volatile("" : "+v"(tid_l));
    const int tid = tid_l, lane = tid & 63, w = __builtin_amdgcn_readfirstlane(tid >> 6), l15 = lane & 15, kg = lane >> 4;
    const size_t rb = (size_t)b * SEQ;
    const bf16* QCp = MP_QC + ((size_t)(b * 4 + hh) * SEQ) * 128; const bf16* KCp = MP_KC2 + ((size_t)(b * 4 + hh) * SEQ) * 128;
    const bf16* Vp = MP_MV + rb * 512 + hh * 128; const bf16* Op = MP_MO + rb * 512 + hh * 128 + 16 * w + 4 * kg;
    bf16* Yp = MP_Y + rb * DM + 512 + hh * 128 + 16 * w + 4 * kg;
    LAS float* DEN = (LAS float*)(L + M2_DEN); LAS float* QN = (LAS float*)(L + M2_QN); LAS float* NV = (LAS float*)(L + M2_N); LAS float* SSQ = (LAS float*)(L + M2_SSQ);
    LAS float* SA = (LAS float*)(L + M2_A); LAS float* SPM = (LAS float*)(L + M2_PM); LAS float* SF = (LAS float*)(L + M2_F);
    LAS float* SBL = (LAS float*)(L + M2_BL); LAS float* SAMX = (LAS float*)(L + M2_AMX); LAS float* SMC = (LAS float*)(L + M2_MC);
    float zf = 0.f; asm volatile("" : "+v"(zf));
    f32x4 Cacc[8], nacc = {zf, zf, zf, zf};
#pragma unroll
    for (int i = 0; i < 8; ++i) Cacc[i] = (f32x4){zf, zf, zf, zf};
    const f32x4 gn = *(const f32x4*)(P.mnorm_g + hh * 128 + 16 * w + 4 * kg);
    const int r0s = tid >> 4, c0s = tid & 15, so0 = img_off(r0s, c0s), so1 = img_off(r0s + 32, c0s);
    v4u sq0, sq1, sk0, sk1, sv0, sv1;
    sq0 = *(const v4u*)(QCp + (size_t)r0s * 128 + c0s * 8); sq1 = *(const v4u*)(QCp + (size_t)(r0s + 32) * 128 + c0s * 8);
    sk0 = *(const v4u*)(KCp + (size_t)r0s * 128 + c0s * 8); sk1 = *(const v4u*)(KCp + (size_t)(r0s + 32) * 128 + c0s * 8);
    sv0 = *(const v4u*)(Vp + (size_t)r0s * 512 + c0s * 8);  sv1 = *(const v4u*)(Vp + (size_t)(r0s + 32) * 512 + c0s * 8);
    LBAR();
    { const float ib = P.i_bias[hh], fb = P.f_bias[hh]; const float* Gp = MP_GATE + rb * 32 + hh;
#pragma unroll 1
      for (int cc = w; cc < 32; cc += 8) { const int tk = 64 * cc + lane;
          const float il = Gp[(size_t)tk * 32 + 24] + ib, fx = Gp[(size_t)tk * 32 + 28] + fb; const float fl = fminf(fx, 0.f) - log1pf(__expf(-fabsf(fx)));
          float f = fl;
#pragma unroll
          for (int o = 1; o < 64; o <<= 1) { const float v = shi(f, lane - o); if (lane >= o) f += v; }
          const float a = il - f; float pm = a;
#pragma unroll
          for (int o = 1; o < 64; o <<= 1) { const float v = shi(pm, lane - o); if (lane >= o) pm = fmaxf(pm, v); }
          SA[tk] = a; SPM[tk] = pm; SF[tk] = f; if (lane == 63) { SBL[cc] = f; SAMX[cc] = pm; } } }
    *(LAS v4u*)(L + M2_IMG + so0) = sq0; *(LAS v4u*)(L + M2_IMG + so1) = sq1; *(LAS v4u*)(L + M2_IMG + 16384 + so0) = sk0; *(LAS v4u*)(L + M2_IMG + 16384 + so1) = sk1;
    *(LAS v4u*)(L + M2_IMG + 32768 + so0) = sv0; *(LAS v4u*)(L + M2_IMG + 32768 + so1) = sv1;
    if (tid < 128) NV[tid] = zf;
    LBAR();
    if (tid == 0) { float mcar = zf; for (int cc = 0; cc < 32; ++cc) { SMC[cc] = mcar; mcar = SBL[cc] + fmaxf(mcar, SAMX[cc]); } }
    LBAR();
#pragma unroll 1
    for (int c = 0; c < 32; ++c) {
        int lc = lane; asm volatile("" : "+v"(lc));
        const int l15 = lc & 15, kg = lc >> 4, q4 = l15 >> 2, p4 = l15 & 3;
        const int t0 = c * 64; const LAS unsigned char* Qi = L + M2_IMG + (c & 1) * 49152; const LAS unsigned char* Ki = Qi + 16384; const LAS unsigned char* Vi = Qi + 32768;
        if (c + 1 < 32) { const int tn = t0 + 64;
            sq0 = *(const v4u*)(QCp + (size_t)(tn + r0s) * 128 + c0s * 8); sq1 = *(const v4u*)(QCp + (size_t)(tn + r0s + 32) * 128 + c0s * 8);
            sk0 = *(const v4u*)(KCp + (size_t)(tn + r0s) * 128 + c0s * 8); sk1 = *(const v4u*)(KCp + (size_t)(tn + r0s + 32) * 128 + c0s * 8);
            sv0 = *(const v4u*)(Vp + (size_t)(tn + r0s) * 512 + c0s * 8);  sv1 = *(const v4u*)(Vp + (size_t)(tn + r0s + 32) * 512 + c0s * 8); }
        const float mc = SMC[c], mxa = fmaxf(mc, SAMX[c]); const float cs = __expf(mc - mxa);
        { const int tblk = w >> 1, t = 16 * tblk + l15; const int sb0 = 2 * (w & 1);
          bf16x8v ka[2][4], qb[4];
#pragma unroll
          for (int ks = 0; ks < 4; ++ks) { qb[ks] = *(const LAS bf16x8v*)(Qi + img_off(t, 4 * ks + kg)); ka[0][ks] = *(const LAS bf16x8v*)(Ki + img_off(16 * sb0 + l15, 4 * ks + kg)); ka[1][ks] = *(const LAS bf16x8v*)(Ki + img_off(16 * sb0 + 16 + l15, 4 * ks + kg)); }
          const float Mt = fmaxf(SPM[t0 + t], mc);
          const f32x4 as0 = *(const LAS f32x4*)(SA + t0 + 16 * sb0 + 4 * kg), as1 = *(const LAS f32x4*)(SA + t0 + 16 * sb0 + 16 + 4 * kg);
          const int tq = tid >> 3, dp = tid & 7; const v4u q0 = *(const LAS v4u*)(Qi + img_off(tq, 2 * dp)), q1 = *(const LAS v4u*)(Qi + img_off(tq, 2 * dp + 1));
          const LAS f32x4* np = (const LAS f32x4*)(NV + 16 * dp); const f32x4 n0 = np[0], n1 = np[1], n2 = np[2], n3 = np[3];
          SBAR();
          LAS unsigned char* SC = L + M2_SC;
#pragma unroll
          for (int sb = 0; sb < 2; ++sb) { const int sblk = sb0 + sb; f32x4 acc = {0.f, 0.f, 0.f, 0.f}; float rp = 0.f; v2u wv; wv.x = 0u; wv.y = 0u;
              if (sblk <= tblk) {
#pragma unroll
                  for (int ks = 0; ks < 4; ++ks) acc = MFMA16(ka[sb][ks], qb[ks], acc);
                  const f32x4 as = sb ? as1 : as0; float v[4];
#pragma unroll
                  for (int e = 0; e < 4; ++e) { const float x = acc[e] * __expf(as[e] - Mt); v[e] = (sblk == tblk && 4 * kg + e > l15) ? 0.f : x; }
                  rp = (v[0] + v[1]) + (v[2] + v[3]); wv.x = cvtpk(v[0], v[1]); wv.y = cvtpk(v[2], v[3]);
              }
              rp += shx(rp, 16, lane); rp += shx(rp, 32, lane);
              *(LAS v2u*)(SC + t * 128 + (((2 * sblk + (kg >> 1)) ^ (t & 7)) << 4) + 8 * (kg & 1)) = wv;
              if (kg == 0) DEN[sblk * 64 + t] = rp; }
          { float s = bflo(q0.x) * n0.x + bfhi(q0.x) * n0.y + bflo(q0.y) * n0.z + bfhi(q0.y) * n0.w + bflo(q0.z) * n1.x + bfhi(q0.z) * n1.y + bflo(q0.w) * n1.z + bfhi(q0.w) * n1.w
                    + bflo(q1.x) * n2.x + bfhi(q1.x) * n2.y + bflo(q1.y) * n2.z + bfhi(q1.y) * n2.w + bflo(q1.z) * n3.x + bfhi(q1.z) * n3.y + bflo(q1.w) * n3.z + bfhi(q1.w) * n3.w;
            s += shx(s, 1, lane); s += shx(s, 2, lane); s += shx(s, 4, lane);
            if (dp == 0) QN[tq] = s; } }
        LBAR();
        v2u og[4];
#pragma unroll
        for (int tb = 0; tb < 4; ++tb) og[tb] = *(const v2u*)(Op + (size_t)(t0 + 16 * tb + l15) * 512);
        bf16x8v vf[2]; f32x4 hv[4];
        { float pmt[4], ft[4], dnp[4], qn4[4]; bf16x8v Cfrag[4];
#pragma unroll
          for (int kp = 0; kp < 4; ++kp) { v4u a; a.x = cvtpk(Cacc[2 * kp].x, Cacc[2 * kp].y); a.y = cvtpk(Cacc[2 * kp].z, Cacc[2 * kp].w); a.z = cvtpk(Cacc[2 * kp + 1].x, Cacc[2 * kp + 1].y); a.w = cvtpk(Cacc[2 * kp + 1].z, Cacc[2 * kp + 1].w);
              Cfrag[kp] = __builtin_bit_cast(bf16x8v, a); }
#pragma unroll
          for (int ks = 0; ks < 2; ++ks) { const int r0 = 32 * ks + 8 * kg;
              const s16x4v lo = tr_read(Vi + 256 * (r0 + q4) + 16 * ((2 * w + (p4 >> 1)) ^ ((q4 << 2) | ((r0 >> 2) & 3))) + 8 * (p4 & 1));
              const s16x4v hi = tr_read(Vi + 256 * (r0 + 4 + q4) + 16 * ((2 * w + (p4 >> 1)) ^ ((q4 << 2) | (((r0 + 4) >> 2) & 3))) + 8 * (p4 & 1));
              vf[ks] = __builtin_shufflevector(lo, hi, 0, 1, 2, 3, 4, 5, 6, 7); }
#pragma unroll
          for (int tb = 0; tb < 4; ++tb) { const int t = 16 * tb + l15; pmt[tb] = SPM[t0 + t]; ft[tb] = SF[t0 + t]; dnp[tb] = (DEN[t] + DEN[64 + t]) + (DEN[128 + t] + DEN[192 + t]); qn4[tb] = QN[t]; }
#pragma unroll
          for (int tp = 0; tp < 2; ++tp) {
              bf16x8v sf[2][2]; v2u qlo[2][4], qhi[2][4];
#pragma unroll
              for (int t2 = 0; t2 < 2; ++t2) { const int t = 16 * (2 * tp + t2) + l15; const int swz = ((t & 3) << 2) | ((t >> 2) & 3);
#pragma unroll
                  for (int ks = 0; ks < 2; ++ks) sf[t2][ks] = *(const LAS bf16x8v*)(L + M2_SC + t * 128 + (((4 * ks + kg) ^ (t & 7)) << 4));
#pragma unroll
                  for (int kp = 0; kp < 4; ++kp) { qlo[t2][kp] = *(const LAS v2u*)(Qi + 256 * t + 16 * ((4 * kp + (kg >> 1)) ^ swz) + 8 * (kg & 1)); qhi[t2][kp] = *(const LAS v2u*)(Qi + 256 * t + 16 * ((4 * kp + 2 + (kg >> 1)) ^ swz) + 8 * (kg & 1)); } }
              SBAR();
#pragma unroll
              for (int t2 = 0; t2 < 2; ++t2) { const int tb = 2 * tp + t2; f32x4 an = {0.f, 0.f, 0.f, 0.f}, a2 = {0.f, 0.f, 0.f, 0.f};
#pragma unroll
                  for (int ks = 0; ks < 2; ++ks) an = MFMA16(vf[ks], sf[t2][ks], an);
#pragma unroll
                  for (int kp = 0; kp < 4; ++kp) { v4u qq; qq.x = qlo[t2][kp].x; qq.y = qlo[t2][kp].y; qq.z = qhi[t2][kp].x; qq.w = qhi[t2][kp].y; a2 = MFMA16(Cfrag[kp], __builtin_bit_cast(bf16x8v, qq), a2); }
                  const float Mt = fmaxf(pmt[tb], mc), wp = __expf(mc - Mt), emt = __expf(-ft[tb] - Mt);
                  const float dn = dnp[tb] + wp * qn4[tb];
                  const float idn = __builtin_amdgcn_rcpf(fmaxf(fabsf(dn), emt));
                  hv[tb] = (an + a2 * wp) * idn;
                  float ss = (hv[tb].x * hv[tb].x + hv[tb].y * hv[tb].y) + (hv[tb].z * hv[tb].z + hv[tb].w * hv[tb].w);
                  ss += shx(ss, 16, lane); ss += shx(ss, 32, lane);
                  if (kg == 0) SSQ[((c & 1) * 8 + w) * 64 + 16 * tb + l15] = ss; }
              SBAR();
          } }
        { bf16x8v vpf[2], wkf[2];
          f32x4 aw[2][2];
#pragma unroll
          for (int ks = 0; ks < 2; ++ks) { aw[ks][0] = *(const LAS f32x4*)(SA + t0 + 32 * ks + 8 * kg); aw[ks][1] = *(const LAS f32x4*)(SA + t0 + 32 * ks + 8 * kg + 4); }
#pragma unroll
          for (int ks = 0; ks < 2; ++ks) { float wkv[8]; unsigned vp[4], wp2[4]; const v4u vu = __builtin_bit_cast(v4u, vf[ks]); const unsigned vw[4] = {vu.x, vu.y, vu.z, vu.w};
#pragma unroll
              for (int j = 0; j < 8; ++j) wkv[j] = __expf(aw[ks][j >> 2][j & 3] - mxa);
#pragma unroll
              for (int j2 = 0; j2 < 4; ++j2) { vp[j2] = cvtpk(bflo(vw[j2]) * wkv[2 * j2], bfhi(vw[j2]) * wkv[2 * j2 + 1]); wp2[j2] = cvtpk(wkv[2 * j2], wkv[2 * j2 + 1]); }
              v4u a; a.x = vp[0]; a.y = vp[1]; a.z = vp[2]; a.w = vp[3]; vpf[ks] = __builtin_bit_cast(bf16x8v, a);
              v4u b2; b2.x = wp2[0]; b2.y = wp2[1]; b2.z = wp2[2]; b2.w = wp2[3]; wkf[ks] = __builtin_bit_cast(bf16x8v, b2); }
          nacc = nacc * cs;
#pragma unroll
          for (int ih = 0; ih < 2; ++ih) {
              bf16x8v kf[4][2];
#pragma unroll
              for (int i4 = 0; i4 < 4; ++i4)
#pragma unroll
                  for (int ks = 0; ks < 2; ++ks) { const int i = 4 * ih + i4, r0 = 32 * ks + 8 * kg;
                      const s16x4v lo = tr_read(Ki + 256 * (r0 + q4) + 16 * ((2 * i + (p4 >> 1)) ^ ((q4 << 2) | ((r0 >> 2) & 3))) + 8 * (p4 & 1));
                      const s16x4v hi = tr_read(Ki + 256 * (r0 + 4 + q4) + 16 * ((2 * i + (p4 >> 1)) ^ ((q4 << 2) | (((r0 + 4) >> 2) & 3))) + 8 * (p4 & 1));
                      kf[i4][ks] = __builtin_shufflevector(lo, hi, 0, 1, 2, 3, 4, 5, 6, 7); }
              SBAR();
#pragma unroll
              for (int i4 = 0; i4 < 4; ++i4) { const int i = 4 * ih + i4; Cacc[i] = Cacc[i] * cs;
#pragma unroll
                  for (int ks = 0; ks < 2; ++ks) Cacc[i] = MFMA16(kf[i4][ks], vpf[ks], Cacc[i]); }
              SBAR();
          }
          { bf16x8v kw[2];
#pragma unroll
            for (int ks = 0; ks < 2; ++ks) { const int r0 = 32 * ks + 8 * kg;
                const s16x4v lo = tr_read(Ki + 256 * (r0 + q4) + 16 * ((2 * w + (p4 >> 1)) ^ ((q4 << 2) | ((r0 >> 2) & 3))) + 8 * (p4 & 1));
                const s16x4v hi = tr_read(Ki + 256 * (r0 + 4 + q4) + 16 * ((2 * w + (p4 >> 1)) ^ ((q4 << 2) | (((r0 + 4) >> 2) & 3))) + 8 * (p4 & 1));
                kw[ks] = __builtin_shufflevector(lo, hi, 0, 1, 2, 3, 4, 5, 6, 7); }
            nacc = MFMA16(kw[0], wkf[0], nacc); nacc = MFMA16(kw[1], wkf[1], nacc); }
          if (l15 == 0) *(LAS f32x4*)(NV + 16 * w + 4 * kg) = nacc;
 }
        if (c + 1 < 32) { LAS unsigned char* Nx = L + M2_IMG + ((c + 1) & 1) * 49152;
            *(LAS v4u*)(Nx + so0) = sq0; *(LAS v4u*)(Nx + so1) = sq1; *(LAS v4u*)(Nx + 16384 + so0) = sk0; *(LAS v4u*)(Nx + 16384 + so1) = sk1; *(LAS v4u*)(Nx + 32768 + so0) = sv0; *(LAS v4u*)(Nx + 32768 + so1) = sv1; }
        LBAR();
#pragma unroll
        for (int tb = 0; tb < 4; ++tb) { const int t = 16 * tb + l15; const LAS float* sp = SSQ + (c & 1) * 512 + t;
            const float tot = ((sp[0] + sp[64]) + (sp[128] + sp[192])) + ((sp[256] + sp[320]) + (sp[384] + sp[448]));
            const float rn = __frsqrt_rn(tot * (1.f / 128.f) + EPS);
            const float y0 = hv[tb].x * rn * gn.x * sigmoidf_(bflo(og[tb].x)), y1 = hv[tb].y * rn * gn.y * sigmoidf_(bfhi(og[tb].x)), y2 = hv[tb].z * rn * gn.z * sigmoidf_(bflo(og[tb].y)), y3 = hv[tb].w * rn * gn.w * sigmoidf_(bfhi(og[tb].y));
            v2u wv; wv.x = cvtpk(y0, y1); wv.y = cvtpk(y2, y3);
            *(v2u*)(Yp + (size_t)(t0 + t) * DM) = wv; }
    }
    LBAR();
}

__device__ __forceinline__ bf16x8v pack8(const f32x16& x, int s2) { v4u p; p.x = cvtpk(x[8 * s2 + 0], x[8 * s2 + 1]); p.y = cvtpk(x[8 * s2 + 2], x[8 * s2 + 3]); p.z = cvtpk(x[8 * s2 + 4], x[8 * s2 + 5]); p.w = cvtpk(x[8 * s2 + 6], x[8 * s2 + 7]); return __builtin_bit_cast(bf16x8v, p); }
__device__ __forceinline__ int tr32_off(int lane, int c, int ks, int t) { const int h = lane >> 5, blk = (lane >> 4) & 1, q = (lane & 15) >> 2, p = lane & 3; return img_off(16 * ks + 8 * h + 4 * t + q, 4 * c + 2 * blk + (p >> 1)) + 8 * (p & 1); }
__device__ __forceinline__ bf16x8v tr32_frag(const LAS unsigned char* img, int lane, int c, int ks) { const s16x4v lo = tr_read(img + tr32_off(lane, c, ks, 0)), hi = tr_read(img + tr32_off(lane, c, ks, 1)); return __builtin_shufflevector(lo, hi, 0, 1, 2, 3, 4, 5, 6, 7); }
constexpr int M3_DEN = M2_DEN  , M3_SSQ = M2_SSQ  ;

__device__ __forceinline__ void mlstm_unit_v3(LAS unsigned char* L, const MixPtrs& P, int b, int hh, int tid_in) {
    int tid_l = tid_in; asm volatile("" : "+v"(tid_l));
    const int tid = tid_l, lane = tid & 63, w = __builtin_amdgcn_readfirstlane(tid >> 6);
    const size_t rb = (size_t)b * SEQ;
    const bf16* QCp = MP_QC + ((size_t)(b * 4 + hh) * SEQ) * 128; const bf16* KCp = MP_KC2 + ((size_t)(b * 4 + hh) * SEQ) * 128;
    const bf16* Vp = MP_MV + rb * 512 + hh * 128;
    LAS float* DEN = (LAS float*)(L + M3_DEN); LAS float* QN = (LAS float*)(L + M2_QN); LAS float* NV = (LAS float*)(L + M2_N); LAS float* SSQ = (LAS float*)(L + M3_SSQ);
    LAS float* SA = (LAS float*)(L + M2_A); LAS float* SPM = (LAS float*)(L + M2_PM); LAS float* SF = (LAS float*)(L + M2_F);
    LAS float* SBL = (LAS float*)(L + M2_BL); LAS float* SAMX = (LAS float*)(L + M2_AMX); LAS float* SMC = (LAS float*)(L + M2_MC);
    float zf = 0.f; asm volatile("" : "+v"(zf));
    const bool isCD = w < 4; const int jw = w & 3;
    f32x16 Cacc[4]; bf16x8v vfk[4];
#pragma unroll
    for (int i = 0; i < 4; ++i) { vfk[i] = (bf16x8v){0, 0, 0, 0, 0, 0, 0, 0};
#pragma unroll
        for (int e = 0; e < 16; ++e) Cacc[i][e] = zf; }
    const int r0s = tid >> 4, c0s = tid & 15, so0 = img_off(r0s, c0s), so1 = img_off(r0s + 32, c0s);
    v4u sq0, sq1, sk0, sk1, sv0, sv1;
    sq0 = *(const v4u*)(QCp + (size_t)r0s * 128 + c0s * 8); sq1 = *(const v4u*)(QCp + (size_t)(r0s + 32) * 128 + c0s * 8);
    sk0 = *(const v4u*)(KCp + (size_t)r0s * 128 + c0s * 8); sk1 = *(const v4u*)(KCp + (size_t)(r0s + 32) * 128 + c0s * 8);
    sv0 = *(const v4u*)(Vp + (size_t)r0s * 512 + c0s * 8);  sv1 = *(const v4u*)(Vp + (size_t)(r0s + 32) * 512 + c0s * 8);
    LBAR();
    { const float ib = P.i_bias[hh], fb = P.f_bias[hh]; const float* Gp = MP_GATE + rb * 32 + hh;
#pragma unroll 1
      for (int cc = w; cc < 32; cc += 8) { const int tk = 64 * cc + lane;
          const float il = Gp[(size_t)tk * 32 + 24] + ib, fx = Gp[(size_t)tk * 32 + 28] + fb; const float fl = fminf(fx, 0.f) - log1pf(__expf(-fabsf(fx)));
          float f = fl;
#pragma unroll
          for (int o = 1; o < 64; o <<= 1) { const float v = shi(f, lane - o); if (lane >= o) f += v; }
          const float a = il - f; float pm = a;
#pragma unroll
          for (int o = 1; o < 64; o <<= 1) { const float v = shi(pm, lane - o); if (lane >= o) pm = fmaxf(pm, v); }
          SA[tk] = a; SPM[tk] = pm; SF[tk] = f; if (lane == 63) { SBL[cc] = f; SAMX[cc] = pm; } } }
    *(LAS v4u*)(L + M2_IMG + so0) = sq0; *(LAS v4u*)(L + M2_IMG + so1) = sq1; *(LAS v4u*)(L + M2_IMG + 16384 + so0) = sk0; *(LAS v4u*)(L + M2_IMG + 16384 + so1) = sk1;
    *(LAS v4u*)(L + M2_IMG + 32768 + so0) = sv0; *(LAS v4u*)(L + M2_IMG + 32768 + so1) = sv1;
    if (tid < 128) NV[tid] = zf;
    LBAR();
    if (tid == 0) { float mcar = zf; for (int cc = 0; cc < 32; ++cc) { SMC[cc] = mcar; mcar = SBL[cc] + fmaxf(mcar, SAMX[cc]); } }
    LBAR();
    f32x16 hv[2];
    hv[0] = Cacc[0]; hv[1] = Cacc[0];
#define MLSTM_NORM_STORE(cc) do { const int r32_ = lane & 31, hi_ = lane >> 5; v2u og[2][4]; \
        { const bf16* Op_ = MP_MO + rb * 512 + hh * 128 + 32 * jw + 4 * hi_; \
          _Pragma("unroll") for (int tt = 0; tt < 2; ++tt) _Pragma("unroll") for (int g = 0; g < 4; ++g) og[tt][g] = *(const v2u*)(Op_ + (size_t)((cc) * 64 + 32 * tt + r32_) * 512 + 8 * g); } \
        bf16* Yp = MP_Y + rb * DM + 512 + hh * 128 + 32 * jw + 4 * hi_; const float* gnp = P.mnorm_g + hh * 128 + 32 * jw + 4 * hi_; \
        f32x4 gn4[4]; \
        _Pragma("unroll") for (int g = 0; g < 4; ++g) gn4[g] = *(const f32x4*)(gnp + 8 * g); \
        _Pragma("unroll") for (int tt = 0; tt < 2; ++tt) { const int t = 32 * tt + r32_; const LAS float* sp = SSQ + ((cc) & 1) * 256 + t; \
            const float rn = __frsqrt_rn(((sp[0] + sp[64]) + (sp[128] + sp[192])) * (1.f / 128.f) + EPS); \
            _Pragma("unroll") for (int g = 0; g < 4; ++g) { const float y0 = hv[tt][4 * g] * rn * gn4[g].x * sigmoidf_(bflo(og[tt][g].x)), y1 = hv[tt][4 * g + 1] * rn * gn4[g].y * sigmoidf_(bfhi(og[tt][g].x)); \
                const float y2 = hv[tt][4 * g + 2] * rn * gn4[g].z * sigmoidf_(bflo(og[tt][g].y)), y3 = hv[tt][4 * g + 3] * rn * gn4[g].w * sigmoidf_(bfhi(og[tt][g].y)); \
                v2u wv; wv.x = cvtpk(y0, y1); wv.y = cvtpk(y2, y3); \
                *(v2u*)(Yp + (size_t)((cc) * 64 + t) * DM + 8 * g) = wv; } } } while (0)
#pragma unroll 1
    for (int c = 0; c < 32; ++c) {
        int lc = lane; asm volatile("" : "+v"(lc));
        const int r32 = lc & 31, hi = lc >> 5;
        const int t0 = c * 64; const LAS unsigned char* Qi = L + M2_IMG + (c & 1) * 49152; const LAS unsigned char* Ki = Qi + 16384; const LAS unsigned char* Vi = Qi + 32768;
        const LAS unsigned char* Kp = L + M2_IMG + ((c + 1) & 1) * 49152 + 16384;
        if (c + 1 < 32) { const int tn = t0 + 64;
            sq0 = *(const v4u*)(QCp + (size_t)(tn + r0s) * 128 + c0s * 8); sq1 = *(const v4u*)(QCp + (size_t)(tn + r0s + 32) * 128 + c0s * 8);
            sk0 = *(const v4u*)(KCp + (size_t)(tn + r0s) * 128 + c0s * 8); sk1 = *(const v4u*)(KCp + (size_t)(tn + r0s + 32) * 128 + c0s * 8);
            sv0 = *(const v4u*)(Vp + (size_t)(tn + r0s) * 512 + c0s * 8);  sv1 = *(const v4u*)(Vp + (size_t)(tn + r0s + 32) * 512 + c0s * 8); }
        const float mc = SMC[c];
        if (isCD) {
            if (c > 0) { const int t0p = t0 - 64; const float mcp = SMC[c - 1], mxap = fmaxf(mcp, SAMX[c - 1]); const float csp = __expf(mcp - mxap);
                bf16x8v vfp[4];
#pragma unroll
                for (int ks = 0; ks < 4; ++ks) { const f32x4 a0 = *(const LAS f32x4*)(SA + t0p + 16 * ks + 8 * hi), a1 = *(const LAS f32x4*)(SA + t0p + 16 * ks + 8 * hi + 4);
                    const float wk[8] = {__expf(a0.x - mxap), __expf(a0.y - mxap), __expf(a0.z - mxap), __expf(a0.w - mxap), __expf(a1.x - mxap), __expf(a1.y - mxap), __expf(a1.z - mxap), __expf(a1.w - mxap)};
                    const v4u vu = __builtin_bit_cast(v4u, vfk[ks]); v4u o4;
                    o4.x = cvtpk(bflo(vu.x) * wk[0], bfhi(vu.x) * wk[1]); o4.y = cvtpk(bflo(vu.y) * wk[2], bfhi(vu.y) * wk[3]); o4.z = cvtpk(bflo(vu.z) * wk[4], bfhi(vu.z) * wk[5]); o4.w = cvtpk(bflo(vu.w) * wk[6], bfhi(vu.w) * wk[7]);
                    vfp[ks] = __builtin_bit_cast(bf16x8v, o4); }
#pragma unroll
                for (int dt = 0; dt < 4; ++dt) { bf16x8v kf[4];
#pragma unroll
                    for (int ks = 0; ks < 4; ++ks) kf[ks] = tr32_frag(Kp, lc, dt, ks);
                    SBAR();
#pragma unroll
                    for (int e = 0; e < 16; ++e) Cacc[dt][e] *= csp;
#pragma unroll
                    for (int ks = 0; ks < 4; ++ks) Cacc[dt] = MFMA32(kf[ks], vfp[ks], Cacc[dt]);
                    SBAR(); }
                MLSTM_NORM_STORE(c - 1); }
        } else if (jw != 2) {
            const int st = (jw == 3) ? 1 : 0, tt = (jw == 0) ? 0 : 1; const int t = 32 * tt + r32;
            const float Mt = fmaxf(SPM[t0 + t], mc);
            f32x4 as4[4];
#pragma unroll
            for (int g = 0; g < 4; ++g) as4[g] = *(const LAS f32x4*)(SA + t0 + 32 * st + 8 * g + 4 * hi);
            f32x16 acc;
#pragma unroll
            for (int e = 0; e < 16; ++e) acc[e] = 0.f;
#pragma unroll
            for (int kh = 0; kh < 2; ++kh) { bf16x8v ka[4], qb[4];
#pragma unroll
                for (int k4 = 0; k4 < 4; ++k4) { const int ks = 4 * kh + k4; ka[k4] = *(const LAS bf16x8v*)(Ki + img_off(32 * st + r32, 2 * ks + hi)); qb[k4] = *(const LAS bf16x8v*)(Qi + img_off(t, 2 * ks + hi)); }
                SBAR();
#pragma unroll
                for (int k4 = 0; k4 < 4; ++k4) acc = MFMA32(ka[k4], qb[k4], acc);
                SBAR(); }
            float rp = 0.f;
#pragma unroll
            for (int g = 0; g < 4; ++g) { float v[4];
#pragma unroll
                for (int e = 0; e < 4; ++e) { const float x = acc[4 * g + e] * __expf(as4[g][e] - Mt); v[e] = (st == tt && (8 * g + 4 * hi + e) > r32) ? 0.f : x; rp += v[e]; }
                v2u wv; wv.x = cvtpk(v[0], v[1]); wv.y = cvtpk(v[2], v[3]);
                *(LAS v2u*)(L + M2_SC + t * 128 + (((4 * st + g) ^ (t & 7)) << 4) + 8 * hi) = wv; }
            rp = xor32_sum(rp);
            if (hi == 0) DEN[st * 64 + t] = rp;
        } else {
            { const v4u z4 = {0u, 0u, 0u, 0u};
              *(LAS v4u*)(L + M2_SC + r32 * 128 + (((4 + 2 * hi) ^ (r32 & 7)) << 4)) = z4; *(LAS v4u*)(L + M2_SC + r32 * 128 + (((5 + 2 * hi) ^ (r32 & 7)) << 4)) = z4;
              if (hi == 0) DEN[64 + r32] = 0.f; }
            float qn = 0.f;
#pragma unroll 4
            for (int ch = 0; ch < 16; ++ch) { const v4u q8 = *(const LAS v4u*)(Qi + img_off(lc, ch)); const f32x4 n0 = *(const LAS f32x4*)(NV + 8 * ch), n1 = *(const LAS f32x4*)(NV + 8 * ch + 4);
                qn += bflo(q8.x) * n0.x + bfhi(q8.x) * n0.y + bflo(q8.y) * n0.z + bfhi(q8.y) * n0.w + bflo(q8.z) * n1.x + bfhi(q8.z) * n1.y + bflo(q8.w) * n1.z + bfhi(q8.w) * n1.w; }
            QN[lc] = qn;
            const float mxa = fmaxf(mc, SAMX[c]), cs = __expf(mc - mxa); const float wkl = __expf(SA[t0 + lc] - mxa);
            const f32x2v nold = *(const LAS f32x2v*)(NV + 2 * lc); float n0a = 0.f, n1a = 0.f;
#pragma unroll
            for (int s = 0; s < 64; ++s) { const unsigned kk = *(const LAS unsigned*)(Ki + img_off(s, lc >> 2) + (lc & 3) * 4); const float ws = __builtin_bit_cast(float, __builtin_amdgcn_readlane(__builtin_bit_cast(int, wkl), s)); n0a += ws * bflo(kk); n1a += ws * bfhi(kk); }
            LDS_WAIT();
            *(LAS f32x2v*)(NV + 2 * lc) = (f32x2v){cs * nold.x + n0a, cs * nold.y + n1a};
        }
        LBAR();
        if (isCD) {
#pragma unroll
            for (int ks = 0; ks < 4; ++ks) vfk[ks] = tr32_frag(Vi, lc, jw, ks);
#pragma unroll
            for (int tt = 0; tt < 2; ++tt) { const int t = 32 * tt + r32;
                bf16x8v scf[4];
#pragma unroll
                for (int ks = 0; ks < 4; ++ks) scf[ks] = *(const LAS bf16x8v*)(L + M2_SC + t * 128 + (((2 * ks + hi) ^ (t & 7)) << 4));
                const float pmt = SPM[t0 + t], ft = SF[t0 + t], dnp = DEN[t] + DEN[64 + t], qnt = QN[t];
                f32x16 a1, a2;
#pragma unroll
                for (int e = 0; e < 16; ++e) { a1[e] = 0.f; a2[e] = 0.f; }
#pragma unroll
                for (int kh = 0; kh < 2; ++kh) { v2u ql[4], qh[4];
#pragma unroll
                    for (int k4 = 0; k4 < 4; ++k4) { const int k8 = 4 * kh + k4; ql[k4] = *(const LAS v2u*)(Qi + img_off(t, 2 * k8) + 8 * hi); qh[k4] = *(const LAS v2u*)(Qi + img_off(t, 2 * k8 + 1) + 8 * hi); }
                    SBAR();
                    if (kh == 0) {
#pragma unroll
                        for (int ks = 0; ks < 4; ++ks) a1 = MFMA32(vfk[ks], scf[ks], a1); }
#pragma unroll
                    for (int k4 = 0; k4 < 4; ++k4) { const int k8 = 4 * kh + k4; v4u qq; qq.x = ql[k4].x; qq.y = ql[k4].y; qq.z = qh[k4].x; qq.w = qh[k4].y; a2 = MFMA32(pack8(Cacc[k8 >> 1], k8 & 1), __builtin_bit_cast(bf16x8v, qq), a2); }
                    SBAR(); }
                const float Mt = fmaxf(pmt, mc), wp = __expf(mc - Mt), emt = __expf(-ft - Mt);
                const float idn = __builtin_amdgcn_rcpf(fmaxf(fabsf(dnp + wp * qnt), emt));
                float ss = 0.f;
#pragma unroll
                for (int e = 0; e < 16; ++e) { const float x = (a1[e] + a2[e] * wp) * idn; hv[tt][e] = x; ss += x * x; }
                ss = xor32_sum(ss);
                if (hi == 0) SSQ[((c & 1) * 4 + jw) * 64 + t] = ss;
                SBAR(); }
        }
        if (c + 1 < 32) { LAS unsigned char* Nx = L + M2_IMG + ((c + 1) & 1) * 49152;
            *(LAS v4u*)(Nx + so0) = sq0; *(LAS v4u*)(Nx + so1) = sq1; *(LAS v4u*)(Nx + 16384 + so0) = sk0; *(LAS v4u*)(Nx + 16384 + so1) = sk1; *(LAS v4u*)(Nx + 32768 + so0) = sv0; *(LAS v4u*)(Nx + 32768 + so1) = sv1; }
        LBAR();
    }
    if (isCD) { MLSTM_NORM_STORE(31); }
#undef MLSTM_NORM_STORE
    LBAR();
}

#ifndef MK_MULTI
#define MK_MULTI 0
#endif
#define REP_IF(k) for (int rep_ = 0; rep_ < ((PROBE_DUP == (k)) ? 2 : 1); ++rep_)
constexpr int PH_PER_LAYER = 8, N_PHASES = 1 + DEPTH * PH_PER_LAYER;
struct Args { const float* in[16]; float* out; unsigned char* ws; int ph_lo, ph_hi; };
static_assert(sizeof(Args) == 16 * 8 + 8 + 8 + 8, "Args has no padding");

__global__ void __launch_bounds__(NWAVES * 64, 2) fwd_kernel(Args args) {
    extern __shared__ __attribute__((aligned(16))) unsigned char lds_raw[];
    LAS unsigned char* L = (LAS unsigned char*)lds_raw;
    const int G0 = gridDim.x, blk0 = blockIdx.x;
    const int wave0 = __builtin_amdgcn_readfirstlane((int)threadIdx.x >> 6);
#define PH_IDS() PH_WS(); int wave = wave0; asm volatile("" : "+s"(wave)); const int lane = fresh_lane(), tid = wave * 64 + lane, gw = blk * NWAVES + wave; (void)gw
#define PH_WS() size_t zoff_ = 0; asm volatile("" : "+s"(zoff_)); unsigned char* ws = (unsigned char*)__builtin_assume_aligned(args.ws, 256) + zoff_; int blk = blk0, G = G0; asm volatile("" : "+s"(blk), "+s"(G)); const int NGW = G * NWAVES; (void)NGW; bf16* X16 = (bf16*)(ws + WS_X16); float* SS2 = (float*)(ws + WS_TAB + TAB_SS2); bf16* U = (bf16*)(ws + WS_U); bf16* HB = (bf16*)(ws + WS_HB); bf16* HD = (bf16*)(ws + WS_HD); \
    unsigned char* wl = ws + WS_W; const float* ng = args.in[1] + (size_t)l_ * 6 * DM; (void)X16; (void)SS2; (void)U; (void)HB; (void)HD; (void)wl; (void)ng
    unsigned char* ws0 = args.ws;
    volatile LAS unsigned* MISC = (volatile LAS unsigned*)(L + MISC_OFF);
    { const int tid_e = wave0 * 64 + fresh_lane(); if (tid_e < 16) MISC[tid_e] = 0u; if (tid_e >= 64 && tid_e < 80) MISC[tid_e] = 0u; if (tid_e >= 208 && tid_e < 216) MISC[tid_e] = 0u; if (tid_e >= 144 && tid_e < 158) MISC[tid_e] = 0u; }
    __syncthreads();
    XcdBarrier bar; bar.bar = (unsigned*)(ws0 + WS_CTL) + CW_BAR; bar.x = 0; bar.st = nullptr;
    if (!MK_MULTI) bar = xcd_barrier_post((unsigned*)(ws0 + WS_CTL) + CW_BAR, MISC + 8, wave0 * 64 + fresh_lane() == 0);
#if PROBE_SC >= 6
    if (blk0 == 0 && wave0 * 64 + fresh_lane() == 0) { MISC[159] = (unsigned)__builtin_amdgcn_s_memrealtime(); MISC[158] = MISC[159]; }
#endif
    const int lo = args.ph_lo, hi = args.ph_hi;
#define IN(k) (lo <= (k) && (k) < hi)
#if PROBE_SC == 30 || PROBE_SC == 31
#define SEAM(k) do { const unsigned bt0_ = (unsigned)__builtin_amdgcn_s_memrealtime(); if (IN(k) && IN((k) + 1)) xcd_barrier(bar, wave0 * 64 + fresh_lane() == 0); \
    if (blk0 == PROBE_BLK && wave0 * 64 + fresh_lane() == 0) { const unsigned dt_ = (unsigned)__builtin_amdgcn_s_memrealtime() - bt0_; MISC[150] += dt_; if ((k) == 5) MISC[151] = dt_; if ((k) == 13) MISC[152] = dt_; } } while (0)
#elif PROBE_SC >= 6
#define SEAM(k) do { if (IN(k) && IN((k) + 1)) xcd_barrier(bar, wave0 * 64 + fresh_lane() == 0); \
    if (blk0 == 0 && wave0 * 64 + fresh_lane() == 0) { const unsigned now_ = (unsigned)__builtin_amdgcn_s_memrealtime(); MISC[160 + (k)] = now_ - MISC[159]; MISC[159] = now_; } } while (0)
#else
#define SEAM(k) do { if (IN(k) && IN((k) + 1)) xcd_barrier(bar, wave0 * 64 + fresh_lane() == 0); } while (0)
#endif

    REP_IF(5) {
    if (IN(0)) {
        const int l_ = 0; PH_IDS();
        const float* x_in = args.in[0]; float* b1T = (float*)(ws + WS_TAB + TAB_B1);
#define CONVERT_WEIGHTS(lw, GM) do { LAS float* scr = (LAS float*)(L + wave * 16384); const float* ngw = args.in[1] + (size_t)(lw) * 6 * DM; \
        constexpr int I_GU = 16 * 176, I_DN = 44 * 32, I_IN = 16 * 112, I_OUT = 16 * 32, I_CMP = 16 * 16, I_LAYER = 2 * I_GU + 2 * I_DN + I_IN + I_OUT + I_CMP; \
        for (int it = gw; it < I_LAYER; it += NGW) { int r = it; unsigned char* wlw = ws + WS_W; \
            if (r < I_GU) { if ((GM) & 1) { SrcGU s{args.in[2] + (size_t)(lw) * DM * NGU, ngw + 0 * DM}; transpose_item(s, DM, (bf16*)(wlw + WO_GU1), scr, r / 176, r % 176, lane); } continue; } r -= I_GU; \
            if (r < I_DN) { if ((GM) & 2) { SrcPlain s{args.in[3] + (size_t)(lw) * FF * DM, DM, nullptr}; transpose_item(s, FF, (bf16*)(wlw + WO_DN1), scr, r / 32, r % 32, lane); } continue; } r -= I_DN; \
            if (r < I_GU) { if ((GM) & 4) { SrcGU s{args.in[4] + (size_t)(lw) * DM * NGU, ngw + 4 * DM}; transpose_item(s, DM, (bf16*)(wlw + WO_GU2), scr, r / 176, r % 176, lane); } continue; } r -= I_GU; \
            if (r < I_DN) { if ((GM) & 8) { SrcPlain s{args.in[5] + (size_t)(lw) * FF * DM, DM, nullptr}; transpose_item(s, FF, (bf16*)(wlw + WO_DN2), scr, r / 32, r % 32, lane); } continue; } r -= I_DN; \
            if (r < I_IN) { if ((GM) & 16) { SrcIN s{args.in[6] + (size_t)(lw) * DM * INCOLS, ngw + 2 * DM}; transpose_item(s, DM, (bf16*)(wlw + WO_IN), scr, r / 112, r % 112, lane); } continue; } r -= I_IN; \
            if (r < I_OUT) { if ((GM) & 32) { SrcPlain s{args.in[7] + (size_t)(lw) * DM * DM, DM, nullptr}; transpose_item(s, DM, (bf16*)(wlw + WO_OUT), scr, r / 32, r % 32, lane); } continue; } r -= I_OUT; \
            if ((GM) & 64) { SrcCMP s{args.in[9] + (size_t)(lw) * 2 * 2048 * 128, nullptr}; transpose_item(s, DM, (bf16*)(ws + WS_CMPW + (size_t)(lw) * MiB), scr, r / 16, r % 16, lane); } } } while (0)
        CONVERT_WEIGHTS(0, 0x7f);
        if (DEPTH > 1) CONVERT_WEIGHTS(1, 0x40);
        { bf16* w2t = (bf16*)(ws + WS_TAB + TAB_W2T);
          for (int i = blk * 512 + tid; i < DEPTH * 2 * 64 * 128; i += G * 512) { const int lk = i >> 13, o = (i >> 7) & 63, kk = i & 127; w2t[i] = (bf16)f2bf(args.in[10][((size_t)lk * 128 + kk) * 64 + o]); } }
        { LAS float* part = (LAS float*)(L + 131072);
          for (int ob = blk; ob < DEPTH * 2 * 128 / 2; ob += G) { const int o = 2 * ob + (wave >> 2), qr = wave & 3; const int lk = o >> 7, c = o & 127;
              const float* pe = args.in[8] + (size_t)lk * 2048; const float* w1 = args.in[9] + (size_t)lk * 2048 * 128;
              float s = 0.f; for (int r = qr * 512 + lane; r < qr * 512 + 512; r += 64) s += pe[r] * w1[(size_t)r * 128 + c];
              s = wave_sum(s, lane); if (lane == 0) part[wave] = s;
              __syncthreads();
              if (lane == 0 && qr == 0) b1T[o] = (part[wave] + part[wave + 1]) + (part[wave + 2] + part[wave + 3]);
              __syncthreads(); } }
        thin_phase<0>(nullptr, x_in, X16, nullptr, SS2, nullptr, 0.f, gw, NGW, lane);
    }
    SEAM(0);
    }

#pragma unroll 1
    for (int l = 0; l < DEPTH; ++l) {
        const int pb = 1 + l * PH_PER_LAYER, l_ = l;
        REP_IF(1) {
        if (IN(pb + 0)) { PH_IDS(); pg8::Gemm g{X16, (const bf16*)(wl + WO_GU1), MTOK, NGU, DM}; pg8::StaticOrder S; S.init(MTOK, NGU, G, blk); EpiSwiglu E{HB, SS2, L + 131072};
#if PROBE_SC == 1 || PROBE_SC == 2
            if (l_ == 0) pg8::gemm_phase<EpiSwiglu, pg8::StaticOrder, true, true, 1>(L, g, S, E, tid); else
#endif
#if PROBE_SC >= 3
            const unsigned long long pt0 = __builtin_amdgcn_s_memrealtime();
#endif
            pg8::gemm_phase<EpiSwiglu, pg8::StaticOrder, GU_ALIGN, true>(L, g, S, E, tid);
#if PROBE_SC == 3
            if (l_ == 0 && tid == 0) { MISC[64] = (unsigned)(__builtin_amdgcn_s_memrealtime() - pt0); }
#endif
#if PROBE_SC == 4 || PROBE_SC == 5
            if (l_ == 0 && tid == 0) { const unsigned sp = (unsigned)(__builtin_amdgcn_s_memrealtime() - pt0); atomicMax((unsigned*)(ws + WS_CTL) + 33024, (sp << 8) | (unsigned)blk); }
#endif
            }
        SEAM(pb + 0);
        }
        if (IN(pb + 1)) { PH_IDS(); pg8::Gemm g{HB, (const bf16*)(wl + WO_DN1), MTOK, DM, FF}; pg8::StaticOrder S; S.init(MTOK, DM, G, blk);
            EpiResNorm<false> E{ws, (LAS float*)(L + 131072), ng + 1 * DM, nullptr, 0.5f, l_ * 3 + 0};
#if PROBE_SC == 21
            const unsigned pt1 = (unsigned)__builtin_amdgcn_s_memrealtime();
            if (l_ == 0) pg8::gemm_phase<EpiResNorm<false>, pg8::StaticOrder, true, true, 1>(L, g, S, E, tid); else
#endif
            pg8::gemm_phase<EpiResNorm<false>, pg8::StaticOrder, true, true>(L, g, S, E, tid);
#if PROBE_SC == 21
            if (l_ == 0 && tid == 0) MISC[66] = (unsigned)__builtin_amdgcn_s_memrealtime() - pt1;
#endif
            }
        SEAM(pb + 1);
        REP_IF(3) {
        if (IN(pb + 2)) { PH_IDS(); pg8::Gemm g{X16, (const bf16*)(wl + WO_IN), MTOK, NINP, DM}; pg8::StaticOrder S; S.init(MTOK, NINP, G, blk);
            EpiInProj E{ws, L + 131072};
#if PROBE_SC == 23
            const unsigned pt1 = (unsigned)__builtin_amdgcn_s_memrealtime();
            if (l_ == 0) pg8::gemm_phase<EpiInProj, pg8::StaticOrder, true, true, 1>(L, g, S, E, tid); else
#endif
            pg8::gemm_phase<EpiInProj, pg8::StaticOrder, true, true>(L, g, S, E, tid);
#if PROBE_SC == 23
            if (l_ == 0 && tid == 0) MISC[66] = (unsigned)__builtin_amdgcn_s_memrealtime() - pt1;
#endif
            }
        SEAM(pb + 2);
        }
        if (IN(pb + 4)) {
            PH_IDS();
            MixPtrs P{ws, args.in[11] + (size_t)l * 4 * 1024, args.in[12] + (size_t)l * 1024, args.in[13] + l * 4, args.in[14] + l * 4, args.in[15] + l * 512};
            unsigned* cflag = (unsigned*)(ws + WS_CTL) + CW_CFLAG + 1024 * l_;
            if (blk < 64 || blk >= 96) {
                const int cb = blk < 64 ? blk : blk - 32;
                mlstm_conv_pass(ws, P.conv_w, P.conv_b, cb * 512 + tid, 224 * 512);
                asm volatile("s_waitcnt vmcnt(0)" ::: "memory"); __syncthreads();
                if (tid == 0) { __builtin_amdgcn_fence(__ATOMIC_RELEASE, "agent"); asm volatile("s_waitcnt vmcnt(0)" ::: "memory");
                    (void)__hip_atomic_fetch_add(cflag + 64 * 15 + 32, 1u, __ATOMIC_RELAXED, __HIP_MEMORY_SCOPE_AGENT); }
            }
            if (blk < 64) {
                if (tid == 0) { unsigned sp = 0u; while (__hip_atomic_load(cflag + 64 * 15 + 32, __ATOMIC_RELAXED, __HIP_MEMORY_SCOPE_AGENT) < 224u) { __builtin_amdgcn_s_sleep(4); if (++sp > (1u << 17)) break; } }
                __syncthreads();
                __builtin_amdgcn_fence(__ATOMIC_ACQUIRE, "agent"); asm volatile("s_waitcnt vmcnt(0)" ::: "memory");
#if PROBE_SC == 20
                const unsigned mt0_ = (unsigned)__builtin_amdgcn_s_memrealtime();
#endif
                mlstm_unit_v3(L, P, blk >> 2, blk & 3, tid);
#if PROBE_SC == 20
                if (l_ == 0 && blk == 0 && tid == 0) MISC[200] = (unsigned)__builtin_amdgcn_s_memrealtime() - mt0_;
#endif
            } else if (blk < 96) {
                pg8::Gemm g{(const bf16*)(ws + WS_KCR), (const bf16*)(ws + WS_CMPW + (size_t)l_ * MiB), 8192, 512, DM}; CmpOrder S{blk - 64, G};
                EpiCmpMlp E{ws, (const float*)(ws + WS_TAB + TAB_B1) + l_ * 2 * 128, (const bf16*)(ws + WS_TAB + TAB_W2T) + (size_t)l_ * 2 * 64 * 128};
                pg8::gemm_phase<EpiCmpMlp, CmpOrder, false, true>(L, g, S, E, tid);
                asm volatile("s_waitcnt vmcnt(0)" ::: "memory"); __syncthreads();
                if (tid == 0) { __builtin_amdgcn_fence(__ATOMIC_RELEASE, "agent"); asm volatile("s_waitcnt vmcnt(0)" ::: "memory");
                    (void)__hip_atomic_fetch_add(cflag + 64 * ((blk - 64) & 15), 1u, __ATOMIC_RELAXED, __HIP_MEMORY_SCOPE_AGENT); }
            } else {
                const int gw = (blk - 96) * NWAVES + wave, NGW = (G - 96) * NWAVES;
                if (l_ == 0) { if (DEPTH > 1) CONVERT_WEIGHTS(1, 0x13); } else CONVERT_WEIGHTS(l_, 0x2c);
            }
            { unsigned* qbase = (unsigned*)(ws + WS_CTL) + CW_QUEUE + 1024 * l_; volatile LAS unsigned* QW = (volatile LAS unsigned*)(L + MISC_OFF);
              const unsigned q0 = xb_xcc_id() & 7u; unsigned rdy = 0u;
#pragma unroll 1
              for (unsigned qq = 0; qq < 8u; ++qq) { unsigned* qctr = qbase + 64 * ((q0 + qq) & 7u); const int bg0 = 4 * (int)((q0 + qq) & 7u);
                  __syncthreads();
                  if (tid == 0) QW[0] = __hip_atomic_fetch_add(qctr, 1u, __ATOMIC_RELAXED, __HIP_MEMORY_SCOPE_AGENT);
                  __syncthreads();
                  unsigned u = QW[0];
                  while (u < 128u) { unsigned nxt = 0u; if (tid == 0) nxt = __hip_atomic_fetch_add(qctr, 1u, __ATOMIC_RELAXED, __HIP_MEMORY_SCOPE_AGENT);
                      const int c = 31 - (int)(u >> 2), bg = bg0 + (int)(u & 3u);
                      if (!((rdy >> (bg >> 1)) & 1u)) {
                          if (tid == 0) { unsigned sp = 0u; while (__hip_atomic_load(cflag + 64 * (bg >> 1), __ATOMIC_RELAXED, __HIP_MEMORY_SCOPE_AGENT) < 2u) { __builtin_amdgcn_s_sleep(4); if (++sp > (1u << 17)) break; } }
                          __syncthreads();
                          __builtin_amdgcn_fence(__ATOMIC_ACQUIRE, "agent"); asm volatile("s_waitcnt vmcnt(0)" ::: "memory");
                          rdy |= 1u << (bg >> 1); }
#if PROBE_SC == 22
                      const unsigned ut0_ = (unsigned)__builtin_amdgcn_s_memrealtime();
#endif
                      nsa_unit_v3(L, P, bg >> 1, bg & 1, c, tid);
#if PROBE_SC == 22
                      if (tid == 0) { MISC[212] += (unsigned)__builtin_amdgcn_s_memrealtime() - ut0_; MISC[213] += 1u; }
#endif
                      __syncthreads(); if (tid == 0) QW[0] = nxt; __syncthreads(); u = QW[0]; } } }
        }
#if PROBE_SC == 22
        if (l == 0 && blk0 == 255 && wave0 * 64 + fresh_lane() == 0) { unsigned* pw_ = (unsigned*)(ws0 + WS_CTL) + 33100;
            for (int i_ = 0; i_ < 4; ++i_) __hip_atomic_store(pw_ + i_, MISC[210 + i_], __ATOMIC_RELAXED, __HIP_MEMORY_SCOPE_AGENT); }
#endif
        SEAM(pb + 4);
        if (IN(pb + 5)) { PH_IDS(); pg8::Gemm g{U, (const bf16*)(wl + WO_OUT), MTOK, DM, DM}; pg8::StaticOrder S; S.init(MTOK, DM, G, blk);
            EpiResNorm<false> E{ws, (LAS float*)(L + 131072), ng + 3 * DM, nullptr, 1.0f, l_ * 3 + 1};
            pg8::gemm_phase<EpiResNorm<false>, pg8::StaticOrder, true, true>(L, g, S, E, tid); }
        SEAM(pb + 5);
        if (IN(pb + 6)) { PH_IDS(); pg8::Gemm g{X16, (const bf16*)(wl + WO_GU2), MTOK, NGU, DM}; pg8::StaticOrder S; S.init(MTOK, NGU, G, blk); EpiSwiglu E{HB, SS2, L + 131072};
            pg8::gemm_phase<EpiSwiglu, pg8::StaticOrder, GU_ALIGN, true>(L, g, S, E, tid); }
        SEAM(pb + 6);
        if (IN(pb + 7)) { PH_IDS(); pg8::Gemm g{HB, (const bf16*)(wl + WO_DN2), MTOK, DM, FF}; pg8::StaticOrder S; S.init(MTOK, DM, G, blk);
            if (l + 1 < DEPTH) { EpiResNorm<false> E{ws, (LAS float*)(L + 131072), ng + 5 * DM, nullptr, 0.5f, l_ * 3 + 2};
                pg8::gemm_phase<EpiResNorm<false>, pg8::StaticOrder, true, true>(L, g, S, E, tid); }
#if FINAL_FUSED
            else { EpiResNorm<true> E{ws, (LAS float*)(L + 131072), ng + 5 * DM, args.out, 0.5f, l_ * 3 + 2};
                pg8::gemm_phase<EpiResNorm<true>, pg8::StaticOrder, true, true>(L, g, S, E, tid); } }
        if (l + 1 < DEPTH) SEAM(pb + 7);
#else
            else { pg8::EpiBf16<0> E{HD, DM, nullptr, 0, 0, 1.f};
                pg8::gemm_phase<pg8::EpiBf16<0>, pg8::StaticOrder, true, true>(L, g, S, E, tid); } }
        if (l + 1 < DEPTH) SEAM(pb + 7);
        else { xcd_barrier(bar, wave0 * 64 + fresh_lane() == 0);
            if (IN(pb + 7)) { PH_IDS(); thin_phase<2>(HD, nullptr, X16, args.out, nullptr, ng + 5 * DM, 0.5f, gw, NGW, lane); } }
#endif
    }
#if PROBE_SC == 30 || PROBE_SC == 31
    if (blk0 == PROBE_BLK && wave0 * 64 + fresh_lane() == 0) { __hip_atomic_store((unsigned*)(args.ws + WS_CTL) + 33101, MISC[151], __ATOMIC_RELAXED, __HIP_MEMORY_SCOPE_AGENT); __hip_atomic_store((unsigned*)(args.ws + WS_CTL) + 33102, MISC[152], __ATOMIC_RELAXED, __HIP_MEMORY_SCOPE_AGENT);
        __hip_atomic_store((unsigned*)(args.ws + WS_CTL) + 33100, MISC[150], __ATOMIC_RELAXED, __HIP_MEMORY_SCOPE_AGENT); }
    if (blk0 == 0 && wave0 * 64 + fresh_lane() == 0) { unsigned sp_ = 0u; while (__hip_atomic_load((unsigned*)(args.ws + WS_CTL) + 33100, __ATOMIC_RELAXED, __HIP_MEMORY_SCOPE_AGENT) == 0u && ++sp_ < (1u << 20)) __builtin_amdgcn_s_sleep(8); }
#endif
#if PROBE_SC
    if (blk0 == 0 && wave0 * 64 + fresh_lane() == 0) {
        unsigned tk = MISC[64], cy = MISC[65];
        if (PROBE_SC == 4 || PROBE_SC == 5) { const unsigned pk = __hip_atomic_load((unsigned*)(args.ws + WS_CTL) + 33024, __ATOMIC_RELAXED, __HIP_MEMORY_SCOPE_AGENT); tk = (PROBE_SC == 4) ? (pk >> 8) : (pk & 255u) * 100u; }
#if PROBE_SC >= 6
        { const unsigned now_ = (unsigned)__builtin_amdgcn_s_memrealtime(); MISC[160 + 16] = now_ - MISC[159]; }
#define D_(k) MISC[160 + (k)]
        unsigned A_ = 0, B_ = 0;
        if (PROBE_SC == 6) { A_ = D_(0); B_ = D_(4) + D_(12); }
        if (PROBE_SC == 7) { A_ = D_(2) + D_(10); B_ = D_(3) + D_(11); }
        if (PROBE_SC == 8) { A_ = (D_(5) + D_(13)) / 2; B_ = D_(6) + D_(14); }
        if (PROBE_SC == 9) { A_ = (D_(7) + D_(15)) / 2; B_ = D_(8) + D_(16); }
        if (PROBE_SC == 10) { A_ = D_(1); B_ = D_(9); }
        if (PROBE_SC == 22) { const unsigned* pw_ = (const unsigned*)(args.ws + WS_CTL) + 33100; unsigned v_[4]; for (int i_ = 0; i_ < 4; ++i_) v_[i_] = __hip_atomic_load(pw_ + i_, __ATOMIC_RELAXED, __HIP_MEMORY_SCOPE_AGENT);
            A_ = (v_[1] ? (v_[0] * 50u) / v_[1] : 0u) * 4u;
            B_ = (v_[3] ? ((v_[2] - v_[0]) * 4u) / v_[3] : 0u) * 4u; }
        if (PROBE_SC == 31) { A_ = __hip_atomic_load((const unsigned*)(args.ws + WS_CTL) + 33101, __ATOMIC_RELAXED, __HIP_MEMORY_SCOPE_AGENT); B_ = __hip_atomic_load((const unsigned*)(args.ws + WS_CTL) + 33102, __ATOMIC_RELAXED, __HIP_MEMORY_SCOPE_AGENT); }
        if (PROBE_SC == 30) { const unsigned v_ = __hip_atomic_load((const unsigned*)(args.ws + WS_CTL) + 33100, __ATOMIC_RELAXED, __HIP_MEMORY_SCOPE_AGENT); A_ = v_; B_ = 0u; }
        if (PROBE_SC == 23) { A_ = MISC[64]; B_ = MISC[66]; }
        if (PROBE_SC == 21) { A_ = MISC[64]; B_ = MISC[66]; }
        if (PROBE_SC == 20) { A_ = MISC[200]; B_ = 0u; }
        if (PROBE_SC == 15) { A_ = D_(3); B_ = D_(11); }
        if (PROBE_SC == 16) { A_ = D_(4); B_ = D_(12); }
        if (PROBE_SC == 17) { A_ = D_(2); B_ = D_(10); }
        if (PROBE_SC == 11) { A_ = D_(8); B_ = D_(16); }
        if (PROBE_SC == 12) { A_ = D_(7); B_ = D_(15); }
        if (PROBE_SC == 13) { A_ = D_(6); B_ = D_(14); }
        if (PROBE_SC == 14) { A_ = D_(5); B_ = D_(13); }
        { unsigned aq = (A_ + 200u) / 400u, bq = (B_ + 200u) / 400u; if (aq > 127u) aq = 127u; if (bq > 127u) bq = 127u; tk = (aq * 128u + bq) * 100u; }
#endif
        const unsigned long long delay = (PROBE_SC != 2) ? (unsigned long long)tk * 10ull : ((unsigned long long)cy * 10000ull) / (tk ? tk : 1u);
#if PROBE_SC >= 6
        while ((unsigned)__builtin_amdgcn_s_memrealtime() - MISC[158] < 500000u + (unsigned)delay) __builtin_amdgcn_s_sleep(8);
#else
        const unsigned long long t0 = __builtin_amdgcn_s_memrealtime();
        while (__builtin_amdgcn_s_memrealtime() - t0 < delay) __builtin_amdgcn_s_sleep(8);
#endif
    }
#endif
#undef IN
#undef SEAM
#undef CONVERT_WEIGHTS
#undef PH_IDS
#undef PH_WS
}

extern "C" void kernel_launch(void* const* d_in, const int* in_sizes, int n_in, void* d_out, int out_size, void* d_ws, size_t ws_size, hipStream_t stream) {
    static int grid = 0;
    if (grid == 0) {
        if (n_in != 16 || in_sizes[0] != MTOK * DM || out_size != MTOK * DM || ws_size < WS_END3) { fprintf(stderr, "kernel_launch: unexpected problem (n_in %d, ws %zu)\n", n_in, ws_size); grid = -1; return; }
        int dev = 0, cus = 0, per_cu = 0;
        if (hipGetDevice(&dev) != hipSuccess || hipDeviceGetAttribute(&cus, hipDeviceAttributeMultiprocessorCount, dev) != hipSuccess) { grid = -1; return; }
        if (hipFuncSetAttribute((const void*)fwd_kernel, hipFuncAttributeMaxDynamicSharedMemorySize, LDS_BYTES) != hipSuccess) { grid = -1; return; }
        if (hipOccupancyMaxActiveBlocksPerMultiprocessor(&per_cu, (const void*)fwd_kernel, NWAVES * 64, LDS_BYTES) != hipSuccess || per_cu < 1) { fprintf(stderr, "kernel_launch: occupancy query says %d\n", per_cu); }
        (void)hipGetLastError();
        grid = cus;
        if (grid != 256) { fprintf(stderr, "kernel_launch: %d CUs (the row-group exchange of the fused post-norm epilogues assumes 256 workgroups: 4 column tiles of a token tile in one round)\n", grid); grid = -1; return; }
    }
    if (grid < 0) return;
    (void)hipMemsetAsync((char*)d_ws + WS_CTL, 0, CTL_ZERO_BYTES, stream);
    Args a{};
    for (int i = 0; i < 16; ++i) a.in[i] = (const float*)d_in[i];
    a.out = (float*)d_out; a.ws = (unsigned char*)d_ws;
#if MK_MULTI
    for (int p = 0; p < N_PHASES; ++p) { a.ph_lo = p; a.ph_hi = p + 1; hipLaunchKernelGGL(fwd_kernel, dim3(grid), dim3(NWAVES * 64), LDS_BYTES, stream, a); }
#else
    a.ph_lo = 0; a.ph_hi = N_PHASES; hipLaunchKernelGGL(fwd_kernel, dim3(grid), dim3(NWAVES * 64), LDS_BYTES, stream, a);
#endif
}
```

```cpp
#include <hip/hip_runtime.h>
#include <cstdio>
#include <cstdint>
#ifndef FINAL_FUSED
#define FINAL_FUSED 1
#endif
#ifndef PROBE_DUP
#define PROBE_DUP 0
#endif
#ifndef GU_ALIGN
#define GU_ALIGN true
#endif
#ifndef EARLY_WB
#define EARLY_WB 0
#endif
#ifndef PROBE_BLK
#define PROBE_BLK 100
#endif
#ifndef PROBE_SC
#define PROBE_SC 0
#endif
namespace pg8 {
#define PG8_LAS __attribute__((address_space(3)))
typedef unsigned short bf16_t;
typedef short bf16x8 __attribute__((ext_vector_type(8)));
typedef float f32x4 __attribute__((ext_vector_type(4)));
typedef unsigned u32x4 __attribute__((ext_vector_type(4)));
constexpr int BM = 256, BK = 64, HALF = 128, HTB = HALF * BK * 2  , STAGE_BYTES = 8 * HTB, NXCD = 8, WGM = 4;

__host__ __device__ __forceinline__ int lds_byte(int r, int c) { const int st = (r >> 4) * 2 + (c >> 5), rr = r & 15, cc = c & 31, ob = rr * 64 + cc * 2; return st * 1024 + (ob ^ (((ob >> 9) & 1) << 5)); }
__host__ __device__ __forceinline__ void stage_rc(int b, int& R, int& C) { const int st = b / 1024, sb = b % 1024, swz = sb ^ (((sb >> 9) & 1) << 5); R = (st >> 1) * 16 + swz / 64; C = (st & 1) * 32 + (swz % 64) / 2; }
__host__ __device__ __forceinline__ int perm32(int rho) { const int n = rho >> 4, i = rho & 15; return 8 * (i >> 2) + 4 * n + (i & 3); }

struct Unit { int pm, pn; };
struct Gemm { const bf16_t* A; const bf16_t* Bt; int M, N, K; };

struct StaticOrder {
    int nM, nN, nwg, G, c;
    __host__ __device__ void init(int M, int N, int G_, int c_) { nM = M / BM; nN = N / BM; nwg = nM * nN; G = G_; c = c_; }
    __host__ __device__ bool next(int i, Unit& u) const {
        const long L = (long)i * G + c; if (L >= nwg) return false;
        int wgid = (int)L; { const int q = nwg / NXCD, r = nwg % NXCD, xcd = wgid % NXCD, off = wgid / NXCD; wgid = (xcd < r ? xcd * (q + 1) : r * (q + 1) + (xcd - r) * q) + off; }
        const int nig = WGM * nN, gid = wgid / nig, fm = gid * WGM, gsz = (nM - fm) < WGM ? (nM - fm) : WGM;
        u.pm = fm + ((wgid % nig) % gsz); u.pn = (wgid % nig) / gsz; return true;
    }
    __device__ __forceinline__ void a_ready(const Unit&) const {}
    __device__ __forceinline__ void done(const Unit&) const {}
};

__device__ __forceinline__ unsigned cvt_pk_bf16(float lo, float hi) { unsigned r; asm volatile("v_cvt_pk_bf16_f32 %0, %1, %2" : "=v"(r) : "v"(lo), "v"(hi)); return r; }
typedef float f32x2 __attribute__((ext_vector_type(2)));
__device__ __forceinline__ f32x2 gelu_pk(f32x2 v) {
    const f32x2 av = __builtin_elementwise_abs(v), d = av * 0.2316418882f + 1.0f;
    f32x2 t; t.x = __builtin_amdgcn_rcpf(d.x); t.y = __builtin_amdgcn_rcpf(d.y);
    f32x2 q = t * 0.5307027145f + (-0.7265760135f); q = q * t + 0.7107068705f; q = q * t + (-0.142248368f); q = q * t + 0.127414796f; q = q * t;
    const f32x2 s = (v * v) * (-0.72134752044f);
    f32x2 e; e.x = __builtin_amdgcn_exp2f(s.x); e.y = __builtin_amdgcn_exp2f(s.y);
    const f32x2 m = v * (q * e), r = v - m;
    f32x2 o; o.x = v.x < 0.f ? m.x : r.x; o.y = v.y < 0.f ? m.y : r.y; return o;
}

template <int ACT  > struct EpiBf16 {
    static constexpr bool PERM = true, AFTER_DRAIN = false, HAS_PRE = false; struct Pre {}; static_assert(ACT == 0 || ACT == 1, "EpiBf16: ACT is 0 (none) or 1 (gelu_pk)");
    bf16_t* O; int ldc; const float* bias; int split_cols; size_t split_stride; float scale0;
    __device__ __forceinline__ void operator()(const f32x4 (&acc)[2][2][4][2], const Unit& u, int wr, int wc, int fr, int fq) const {
        const int row0 = u.pm * BM + wr * 64 + fr; int colt = u.pn * BM; bf16_t* base = O;
        float sc = 1.f; if (split_cols) { const int t = colt / split_cols; base += (size_t)t * split_stride; colt -= t * split_cols; if (t == 0) sc = scale0; }
        const int col0 = colt + wc * 32 + 8 * fq, bcol0 = u.pn * BM + wc * 32 + 8 * fq;
        f32x4 bv[2][2];
#pragma unroll
        for (int bj = 0; bj < 2; ++bj)
#pragma unroll
            for (int n = 0; n < 2; ++n) bv[bj][n] = bias ? *(const f32x4*)(bias + bcol0 + bj * HALF + 4 * n) : (f32x4){0.f, 0.f, 0.f, 0.f};
#pragma unroll
        for (int ai = 0; ai < 2; ++ai)
#pragma unroll
            for (int m = 0; m < 4; ++m) { bf16_t* rowp = base + (size_t)(row0 + ai * HALF + m * 16) * ldc + col0;
#pragma unroll
                for (int bj = 0; bj < 2; ++bj) { f32x4 v0 = acc[ai][bj][m][0] + bv[bj][0], v1 = acc[ai][bj][m][1] + bv[bj][1];
                    if (ACT == 1) { f32x2 a = gelu_pk((f32x2){v0[0], v0[1]}), b = gelu_pk((f32x2){v0[2], v0[3]}), c = gelu_pk((f32x2){v1[0], v1[1]}), d = gelu_pk((f32x2){v1[2], v1[3]});
                        v0 = (f32x4){a.x, a.y, b.x, b.y}; v1 = (f32x4){c.x, c.y, d.x, d.y}; }
                    v0 = v0 * sc; v1 = v1 * sc; u32x4 w; w.x = cvt_pk_bf16(v0[0], v0[1]); w.y = cvt_pk_bf16(v0[2], v0[3]); w.z = cvt_pk_bf16(v1[0], v1[1]); w.w = cvt_pk_bf16(v1[2], v1[3]);
                    *(u32x4*)(rowp + bj * HALF) = w; } }
    }
};
template <class Epi, class Sched, bool ALIGN_EPI = false, bool SP2 = false, int SC = 0>
__device__ __forceinline__ void gemm_phase(PG8_LAS unsigned char* lds, const Gemm g, const Sched& S, const Epi& E, int tid_in) {
    int tid_l = tid_in; asm volatile("" : "+v"(tid_l));
    const int tid = tid_l, wid = __builtin_amdgcn_readfirstlane(tid >> 6), lane = tid & 63, wr = wid >> 2, wc = wid & 3, fr = lane & 15, fq = lane >> 4;
    const int K = g.K, nt = K / BK;
    unsigned voffA[2], voffB[2];
#pragma unroll
    for (int i = 0; i < 2; ++i) { int R, C; stage_rc(tid * 16 + i * 8192, R, C); const int Rb = Epi::PERM ? ((R & ~31) + perm32(R & 31)) : R;
        voffA[i] = (unsigned)(R * K + C) * 2u; voffB[i] = (unsigned)(Rb * K + C) * 2u; }
    const size_t kstep = (size_t)(BK * 2);
    const size_t hstep = (size_t)HALF * K * 2;
    const size_t tstep = 2 * hstep;
    const unsigned ldsw = (unsigned)wid * 1024u;
    const int aoff = lds_byte(wr * 64 + fr, fq * 8), boff = lds_byte(wc * 32 + fr, fq * 8);
#define PG8_SA(b, h) (((b) * 2 + (h)) * HTB)
#define PG8_SB(b, h) ((4 + (b) * 2 + (h)) * HTB)
#define PG8_STAGE(bufoff, gbase, voff) do { _Pragma("unroll") for (int _i = 0; _i < 2; ++_i) \
        __builtin_amdgcn_global_load_lds((const unsigned*)((const char*)(gbase) + (voff)[_i]), (PG8_LAS unsigned*)(lds + (bufoff) + ldsw + _i * 8192), 16, 0, 0); } while (0)
#define PG8_LDA(dst, b, h) do { _Pragma("unroll") for (int m = 0; m < 4; ++m) _Pragma("unroll") for (int k = 0; k < 2; ++k) dst[m][k] = *(const PG8_LAS bf16x8*)(lds + PG8_SA(b, h) + aoff + m * 2048 + k * 1024); } while (0)
#define PG8_LDB(dst, b, h) do { _Pragma("unroll") for (int n = 0; n < 2; ++n) _Pragma("unroll") for (int k = 0; k < 2; ++k) dst[n][k] = *(const PG8_LAS bf16x8*)(lds + PG8_SB(b, h) + boff + n * 2048 + k * 1024); } while (0)
#define PG8_MMA(ai, bj, At, Bt) do { __builtin_amdgcn_s_setprio(1); _Pragma("unroll") for (int m = 0; m < 4; ++m) _Pragma("unroll") for (int n = 0; n < 2; ++n) _Pragma("unroll") for (int k = 0; k < 2; ++k) \
        acc[ai][bj][m][n] = __builtin_amdgcn_mfma_f32_16x16x32_bf16(Bt[n][k], At[m][k], acc[ai][bj][m][n], 0, 0, 0); __builtin_amdgcn_s_setprio(0); } while (0)
#define PG8_WAIT_V(n) asm volatile("s_waitcnt vmcnt(" #n ")" ::: "memory")
#define PG8_WAIT_L(n) asm volatile("s_waitcnt lgkmcnt(" #n ")" ::: "memory")
#define PG8_BAR __builtin_amdgcn_s_barrier()
#define PG8_SCHED __builtin_amdgcn_sched_barrier(0)
    Unit cur, nxt; int ui = 0;
    if (!S.next(0, cur)) return;
    typename Epi::Pre pre;
    f32x4 acc[2][2][4][2];
#pragma unroll
    for (int a = 0; a < 2; ++a)
#pragma unroll
        for (int b = 0; b < 2; ++b)
#pragma unroll
            for (int m = 0; m < 4; ++m)
#pragma unroll
                for (int n = 0; n < 2; ++n) acc[a][b][m][n] = (f32x4){0.f, 0.f, 0.f, 0.f};
    bf16x8 At[4][2], B0[2][2], B1[2][2];
    const char* cA = (const char*)g.A + (size_t)cur.pm * tstep; const char* cB = (const char*)g.Bt + (size_t)cur.pn * tstep;
    S.a_ready(cur);
    if constexpr (SP2) {
        PG8_STAGE(PG8_SB(0, 0), cB, voffB); PG8_STAGE(PG8_SB(0, 1), cB + hstep, voffB); PG8_STAGE(PG8_SA(0, 0), cA, voffA); PG8_STAGE(PG8_SA(0, 1), cA + hstep, voffA);
        if (wr == 1) PG8_BAR;
        PG8_WAIT_V(2); PG8_BAR;
        PG8_STAGE(PG8_SB(1, 0), cB + kstep, voffB); PG8_STAGE(PG8_SA(1, 0), cA + kstep, voffA); PG8_STAGE(PG8_SB(1, 1), cB + hstep + kstep, voffB);
        PG8_WAIT_V(6); PG8_BAR;
    } else {
        PG8_STAGE(PG8_SB(0, 0), cB, voffB); PG8_STAGE(PG8_SA(0, 0), cA, voffA); PG8_STAGE(PG8_SB(0, 1), cB + hstep, voffB); PG8_STAGE(PG8_SA(0, 1), cA + hstep, voffA);
        if (wr == 1) PG8_BAR;
        PG8_WAIT_V(4); PG8_BAR;
        PG8_STAGE(PG8_SB(1, 0), cB + kstep, voffB); PG8_STAGE(PG8_SA(1, 0), cA + kstep, voffA); PG8_STAGE(PG8_SB(1, 1), cB + hstep + kstep, voffB);
        PG8_WAIT_V(6); PG8_BAR;
    }
    for (;;) {
        const bool has_next = S.next(ui + 1, nxt);
        unsigned long long sc_t0 = 0, sc_c0 = 0; if constexpr (SC != 0) { sc_t0 = __builtin_amdgcn_s_memrealtime(); sc_c0 = __builtin_amdgcn_s_memtime(); }
        const char* nA = has_next ? (const char*)g.A + (size_t)nxt.pm * tstep : cA; const char* nB = has_next ? (const char*)g.Bt + (size_t)nxt.pn * tstep : cB;
        for (int t = 0; t < nt; t += 2) {
            const bool last = (t == nt - 2);
            const char* a1 = cA + (size_t)(t + 1) * kstep;
            const char* a2 = last ? nA : cA + (size_t)(t + 2) * kstep; const char* b2 = last ? nB : cB + (size_t)(t + 2) * kstep;
            const char* a3 = a2 + kstep; const char* b3 = b2 + kstep;
            if (last && has_next) S.a_ready(nxt);
            if constexpr (Epi::HAS_PRE) { if (last) E.pre_load(cur, wr, wc, pre); }
            if constexpr (SP2) {
            PG8_LDB(B0, 0, 0); PG8_LDB(B1, 0, 1); PG8_SCHED; PG8_LDA(At, 0, 0); PG8_STAGE(PG8_SA(1, 1), a1 + hstep, voffA);
            PG8_WAIT_V(8); PG8_WAIT_L(0); PG8_BAR; PG8_MMA(0, 0, At, B0); PG8_MMA(0, 1, At, B1); PG8_BAR; PG8_SCHED;
            PG8_LDA(At, 0, 1); PG8_STAGE(PG8_SB(0, 0), b2, voffB); PG8_STAGE(PG8_SB(0, 1), b2 + hstep, voffB); PG8_STAGE(PG8_SA(0, 0), a2, voffA);
            PG8_WAIT_V(8); PG8_WAIT_L(0); PG8_BAR; PG8_MMA(1, 0, At, B0); PG8_MMA(1, 1, At, B1); PG8_BAR; PG8_SCHED;
            PG8_LDB(B0, 1, 0); PG8_LDB(B1, 1, 1); PG8_SCHED; PG8_LDA(At, 1, 0); PG8_STAGE(PG8_SA(0, 1), a2 + hstep, voffA);
            PG8_WAIT_V(8); PG8_WAIT_L(0); PG8_BAR; PG8_MMA(0, 0, At, B0); PG8_MMA(0, 1, At, B1); PG8_BAR; PG8_SCHED;
            PG8_LDA(At, 1, 1); PG8_STAGE(PG8_SB(1, 0), b3, voffB); PG8_STAGE(PG8_SB(1, 1), b3 + hstep, voffB); PG8_STAGE(PG8_SA(1, 0), a3, voffA);
            PG8_WAIT_V(8); PG8_WAIT_L(0); PG8_BAR; PG8_MMA(1, 0, At, B0); PG8_MMA(1, 1, At, B1); PG8_BAR; PG8_SCHED;
            } else {
            PG8_LDB(B0, 0, 0); PG8_SCHED; PG8_LDA(At, 0, 0); PG8_STAGE(PG8_SA(1, 1), a1 + hstep, voffA);
            PG8_WAIT_L(8); PG8_BAR; PG8_WAIT_L(0); PG8_MMA(0, 0, At, B0); PG8_BAR; PG8_SCHED;
            PG8_LDB(B1, 0, 1); PG8_STAGE(PG8_SB(0, 0), b2, voffB);
            PG8_BAR; PG8_WAIT_L(0); PG8_MMA(0, 1, At, B1); PG8_BAR;
            PG8_LDA(At, 0, 1); PG8_STAGE(PG8_SA(0, 0), a2, voffA);
            PG8_BAR; PG8_WAIT_L(0); PG8_MMA(1, 0, At, B0); PG8_BAR; PG8_SCHED;
            PG8_STAGE(PG8_SB(0, 1), b2 + hstep, voffB);
            PG8_WAIT_V(6); PG8_BAR; PG8_MMA(1, 1, At, B1); PG8_BAR;
            PG8_LDB(B0, 1, 0); PG8_SCHED; PG8_LDA(At, 1, 0); PG8_STAGE(PG8_SA(0, 1), a2 + hstep, voffA);
            PG8_WAIT_L(8); PG8_BAR; PG8_WAIT_L(0); PG8_MMA(0, 0, At, B0); PG8_BAR; PG8_SCHED;
            PG8_LDB(B1, 1, 1); PG8_STAGE(PG8_SB(1, 0), b3, voffB);
            PG8_BAR; PG8_WAIT_L(0); PG8_MMA(0, 1, At, B1); PG8_BAR;
            PG8_LDA(At, 1, 1); PG8_STAGE(PG8_SA(1, 0), a3, voffA);
            PG8_BAR; PG8_WAIT_L(0); PG8_MMA(1, 0, At, B0); PG8_BAR; PG8_SCHED;
            PG8_STAGE(PG8_SB(1, 1), b3 + hstep, voffB);
            PG8_WAIT_V(6); PG8_BAR; PG8_MMA(1, 1, At, B1); PG8_BAR;
            }
        }
        if constexpr (SC != 0) { const unsigned long long t1 = __builtin_amdgcn_s_memrealtime(), c1 = __builtin_amdgcn_s_memtime();
            if (tid == 0) { PG8_LAS unsigned* scw = (PG8_LAS unsigned*)(lds + 143360 + 256); scw[0] += (unsigned)(t1 - sc_t0); scw[1] += (unsigned)(c1 - sc_c0); } }
        if constexpr (ALIGN_EPI) { if (wr == 0) PG8_BAR; }
        if constexpr (!Epi::AFTER_DRAIN) { if constexpr (Epi::HAS_PRE) E(acc, cur, wr, wc, fr, fq, pre); else E(acc, cur, wr, wc, fr, fq); S.done(cur); }
        if (!has_next) break;
#pragma unroll
        for (int a = 0; a < 2; ++a)
#pragma unroll
            for (int b = 0; b < 2; ++b)
#pragma unroll
                for (int m = 0; m < 4; ++m)
#pragma unroll
                    for (int n = 0; n < 2; ++n) acc[a][b][m][n] = (f32x4){0.f, 0.f, 0.f, 0.f};
        cur = nxt; cA = nA; cB = nB; ++ui;
        if constexpr (ALIGN_EPI) { if (wr == 1) PG8_BAR; }
    }
    PG8_WAIT_V(0);
    if constexpr (!ALIGN_EPI) { if (wr == 0) PG8_BAR; }
    PG8_BAR;
    if constexpr (Epi::AFTER_DRAIN) { E.fused(acc, cur, wr, wc, fr, fq, lds, wid, lane); S.done(cur); }
#undef PG8_SA
#undef PG8_SB
#undef PG8_STAGE
#undef PG8_LDA
#undef PG8_LDB
#undef PG8_MMA
#undef PG8_WAIT_V
#undef PG8_WAIT_L
#undef PG8_BAR
#undef PG8_SCHED
}
}

#define LAS __attribute__((address_space(3)))
#define XB_TMO      128
#define XB_XCNT(j)  (256  + 64 * (j))
#define XB_XSUB(j)  (1280 + 64 * (j))
#define XB_XGEN(j)  (2304 + 64 * (j))
#define XB_TOP      3328
#define XB_TOPGEN   3392
#define XCD_BAR_WORDS 3456
#define XB_SPIN_CAP (1u << 18)

__device__ __forceinline__ unsigned xb_ld(unsigned* p)              { return __hip_atomic_load(p, __ATOMIC_RELAXED, __HIP_MEMORY_SCOPE_AGENT); }
__device__ __forceinline__ unsigned xb_add(unsigned* p, unsigned v) { return __hip_atomic_fetch_add(p, v, __ATOMIC_RELAXED, __HIP_MEMORY_SCOPE_AGENT); }
__device__ __forceinline__ unsigned xb_xcc_id() { return (unsigned)__builtin_amdgcn_s_getreg((3 << 11) | 20) & 0xFu; }
#define XB_SPIN(cond, bar) do { unsigned _sp = 0; while (cond) { __builtin_amdgcn_s_sleep(1); \
    if ((++_sp & 255u) == 0u) { if (xb_ld(&(bar)[XB_TMO])) break; if (_sp > XB_SPIN_CAP) { atomicAdd(&(bar)[XB_TMO], 1u); break; } } } } while (0)

struct XcdBarrier {
    unsigned* bar; unsigned x;
    volatile LAS unsigned* st;
};

__device__ __forceinline__ XcdBarrier xcd_barrier_post(unsigned* bar, volatile LAS unsigned* st, bool leader) {
    XcdBarrier b; b.bar = bar; b.x = xb_xcc_id(); b.st = st;
    if (leader) (void)xb_add(&bar[XB_XCNT(b.x)], 1u);
    return b;
}
__device__ __forceinline__ void xcd_barrier_complete(unsigned* bar, unsigned x, unsigned& nloc, unsigned& nx) {
    const unsigned G = gridDim.x * gridDim.y * gridDim.z;
    unsigned sum, cnt, mine, sp = 0u;
    for (;;) {
        sum = 0u; cnt = 0u; mine = 0u;
        unsigned cv[16];
        { const unsigned* cb = &bar[XB_XCNT(0)]; static_assert(XB_XCNT(1) - XB_XCNT(0) == 64, "counters are 256 bytes apart");
          asm volatile("global_load_dword %0, %16, off sc1\n\tglobal_load_dword %1, %16, off offset:256 sc1\n\tglobal_load_dword %2, %16, off offset:512 sc1\n\tglobal_load_dword %3, %16, off offset:768 sc1\n\t"
                       "global_load_dword %4, %16, off offset:1024 sc1\n\tglobal_load_dword %5, %16, off offset:1280 sc1\n\tglobal_load_dword %6, %16, off offset:1536 sc1\n\tglobal_load_dword %7, %16, off offset:1792 sc1\n\t"
                       "global_load_dword %8, %16, off offset:2048 sc1\n\tglobal_load_dword %9, %16, off offset:2304 sc1\n\tglobal_load_dword %10, %16, off offset:2560 sc1\n\tglobal_load_dword %11, %16, off offset:2816 sc1\n\t"
                       "global_load_dword %12, %16, off offset:3072 sc1\n\tglobal_load_dword %13, %16, off offset:3328 sc1\n\tglobal_load_dword %14, %16, off offset:3584 sc1\n\tglobal_load_dword %15, %16, off offset:3840 sc1\n\ts_waitcnt vmcnt(0)"
                       : "=&v"(cv[0]), "=&v"(cv[1]), "=&v"(cv[2]), "=&v"(cv[3]), "=&v"(cv[4]), "=&v"(cv[5]), "=&v"(cv[6]), "=&v"(cv[7]), "=&v"(cv[8]), "=&v"(cv[9]), "=&v"(cv[10]), "=&v"(cv[11]), "=&v"(cv[12]), "=&v"(cv[13]), "=&v"(cv[14]), "=&v"(cv[15])
                       : "v"(cb) : "memory"); }
#pragma unroll
        for (unsigned j = 0; j < 16; ++j) { const unsigned c = cv[j]; sum += c; cnt += (c > 0u) ? 1u : 0u; mine = (j == x) ? c : mine; }
        if (sum == G) break;
        __builtin_amdgcn_s_sleep(1);
        if ((++sp & 255u) == 0u) { if (xb_ld(&bar[XB_TMO])) break; if (sp > XB_SPIN_CAP) { atomicAdd(&bar[XB_TMO], 1u); break; } }
    }
    nloc = mine > 0u ? mine : 1u; nx = cnt > 0u ? cnt : 1u;
}

__device__ __forceinline__ void xcd_barrier(const XcdBarrier& b, bool leader) {
    asm volatile("s_waitcnt vmcnt(0)" ::: "memory");
    __syncthreads();
    if (leader) {
        unsigned* bar = b.bar;
        __builtin_amdgcn_s_waitcnt(0);
        unsigned nloc = b.st[0], nx = b.st[1];
        if (nloc == 0u) { xcd_barrier_complete(bar, b.x, nloc, nx); b.st[0] = nloc; b.st[1] = nx; }
#if EARLY_WB
        __builtin_amdgcn_fence(__ATOMIC_RELEASE, "agent");
        asm volatile("s_waitcnt vmcnt(0)" ::: "memory");
#endif
        const unsigned old = xb_add(&bar[XB_XSUB(b.x)], 1u);
        const unsigned gen = old / nloc;
        if (old + 1u == (gen + 1u) * nloc) {
#if !EARLY_WB
            __builtin_amdgcn_fence(__ATOMIC_RELEASE, "agent");
#endif
            asm volatile("s_waitcnt vmcnt(0)" ::: "memory");
            const unsigned og = xb_add(&bar[XB_TOP], 1u);
            const unsigned tg = og / nx;
            if (og + 1u == (tg + 1u) * nx) xb_add(&bar[XB_TOPGEN], 1u);
            else XB_SPIN(xb_ld(&bar[XB_TOPGEN]) == tg, bar);
            __builtin_amdgcn_fence(__ATOMIC_ACQUIRE, "agent");
            xb_add(&bar[XB_XGEN(b.x)], 1u);
            asm volatile("s_waitcnt vmcnt(0)" ::: "memory");
        } else {
            XB_SPIN(xb_ld(&bar[XB_XGEN(b.x)]) == gen, bar);
            __builtin_amdgcn_fence(__ATOMIC_ACQUIRE, "agent");
            asm volatile("s_waitcnt vmcnt(0)" ::: "memory");
        }
    }
    __syncthreads();
}

constexpr int BATCH = 16, SEQ = 2048, DM = 1024, MTOK = BATCH * SEQ, FF = 2816, NGU = 2 * FF, NINP = 3584, INCOLS = 3360, DEPTH = 2;
constexpr int NWAVES = 8;
constexpr float EPS = 1e-6f;
typedef unsigned short bf16;
typedef unsigned v4u __attribute__((ext_vector_type(4)));
typedef unsigned v2u __attribute__((ext_vector_type(2)));
typedef float f32x4 __attribute__((ext_vector_type(4)));
#define LDS_WAIT() asm volatile("s_waitcnt lgkmcnt(0)" ::: "memory")

constexpr size_t MiB = 1u << 20;
constexpr size_t WS_CTL = 0, CTL_ZERO_BYTES = 160 * 1024;
constexpr size_t WS_TAB = 1 * MiB;
constexpr size_t TAB_COS = 0, TAB_SIN = 65536, TAB_B1 = 131072, TAB_W2T = 196608, TAB_SS2 = 262144;
constexpr size_t WS_W = 2 * MiB;
constexpr size_t WO_GU1 = 0, WO_DN1 = 11 * MiB, WO_GU2 = 16 * MiB + MiB / 2, WO_DN2 = 27 * MiB + MiB / 2, WO_IN = 33 * MiB, WO_OUT = 40 * MiB, WO_CMP = 42 * MiB;
constexpr size_t WS_X16 = 45 * MiB;
constexpr size_t WS_U = 109 * MiB;
constexpr size_t WS_HB = 173 * MiB;
constexpr size_t WS_HD = 349 * MiB;
constexpr size_t WS_PQ = 413 * MiB;
constexpr size_t WS_CC = 421 * MiB;
constexpr size_t WS_END = 422 * MiB;
constexpr size_t WS_QN = 173 * MiB, WS_KCR = 205 * MiB, WS_VCR = 213 * MiB, WS_KS = 221 * MiB, WS_VS = 229 * MiB, WS_KW = 237 * MiB, WS_VW = 245 * MiB;
constexpr size_t WS_MQ = 253 * MiB, WS_MK = 285 * MiB, WS_MV = 317 * MiB, WS_MO = 349 * MiB, WS_GATE = 381 * MiB;
static_assert(WS_GATE + 4 * MiB <= WS_PQ, "in-projection outputs end below PQ");
constexpr int CW_BAR = 4096, CW_QUEUE = 16384, CW_GRP = 20480, CW_CFLAG = 33280;
constexpr size_t WS_PART = 486 * MiB, WS_CMPW = 489 * MiB, WS_END3 = 491 * MiB;
static_assert((CW_QUEUE + 2 * 1024) <= CW_GRP && (CW_GRP + 6 * 128 * 16) * 4 <= (int)CTL_ZERO_BYTES && (CW_BAR + 3456) <= CW_QUEUE && WS_TAB + TAB_SS2 + 16 * 32768 <= WS_W, "control words inside the zeroed region");
constexpr int PH_BYTES = 143360, MISC_OFF = PH_BYTES, LDS_BYTES = 147456;

__device__ __forceinline__ unsigned f2bf(float f) { unsigned u = __builtin_bit_cast(unsigned, f); return (u + 0x7fffu + ((u >> 16) & 1u)) >> 16; }
__device__ __forceinline__ unsigned pk2(float lo, float hi) { return f2bf(lo) | (f2bf(hi) << 16); }
typedef float f32x2v_ __attribute__((ext_vector_type(2))); typedef __bf16 bf16x2v_ __attribute__((ext_vector_type(2)));
__device__ __forceinline__ unsigned cvtpk(float lo, float hi) { f32x2v_ v = {lo, hi}; bf16x2v_ b = __builtin_convertvector(v, bf16x2v_); return __builtin_bit_cast(unsigned, b); }
__device__ __forceinline__ float bflo(unsigned u) { return __builtin_bit_cast(float, u << 16); }
__device__ __forceinline__ float bfhi(unsigned u) { return __builtin_bit_cast(float, u & 0xffff0000u); }
__device__ __forceinline__ float bf2f(bf16 b) { return __builtin_bit_cast(float, (unsigned)b << 16); }
__device__ __forceinline__ float sigmoidf_(float x) { return __builtin_amdgcn_rcpf(1.f + __expf(-x)); }
__device__ __forceinline__ int fresh_lane() { unsigned z = 0u; asm volatile("" : "+v"(z)); return (int)__builtin_amdgcn_mbcnt_hi(~0u, __builtin_amdgcn_mbcnt_lo(~0u, z)); }
__device__ __forceinline__ float shx(float v, int mask, int lane) { return __builtin_bit_cast(float, __builtin_amdgcn_ds_bpermute((lane ^ mask) << 2, __builtin_bit_cast(int, v))); }
__device__ __forceinline__ unsigned shxu(unsigned v, int mask, int lane) { return (unsigned)__builtin_amdgcn_ds_bpermute((lane ^ mask) << 2, (int)v); }
__device__ __forceinline__ float shi(float v, int src) { return __builtin_bit_cast(float, __builtin_amdgcn_ds_bpermute(src << 2, __builtin_bit_cast(int, v))); }
__device__ __forceinline__ float wave_sum(float v, int lane) {
    (void)lane;
    v += __builtin_bit_cast(float, __builtin_amdgcn_update_dpp(0, __builtin_bit_cast(int, v), 0xB1, 0xF, 0xF, false));
    v += __builtin_bit_cast(float, __builtin_amdgcn_update_dpp(0, __builtin_bit_cast(int, v), 0x4E, 0xF, 0xF, false));
    v += __builtin_bit_cast(float, __builtin_amdgcn_update_dpp(0, __builtin_bit_cast(int, v), 0x124, 0xF, 0xF, false));
    v += __builtin_bit_cast(float, __builtin_amdgcn_update_dpp(0, __builtin_bit_cast(int, v), 0x128, 0xF, 0xF, false));
    const int iv = __builtin_bit_cast(int, v);
    const float a = __builtin_bit_cast(float, __builtin_amdgcn_readlane(iv, 0)), b = __builtin_bit_cast(float, __builtin_amdgcn_readlane(iv, 16));
    const float c = __builtin_bit_cast(float, __builtin_amdgcn_readlane(iv, 32)), d = __builtin_bit_cast(float, __builtin_amdgcn_readlane(iv, 48));
    return (a + b) + (c + d);
}

struct SrcGU { const float* W; const float* g; __device__ __forceinline__ float operator()(int k, int nd) const { const int pn = nd >> 8, r = nd & 255; const int col = (r < 128) ? (pn * 128 + r) : (FF + pn * 128 + r - 128); return __builtin_nontemporal_load(W + (size_t)k * NGU + col); } };
struct SrcPlain { const float* W; int N; const float* g; __device__ __forceinline__ float operator()(int k, int nd) const { return __builtin_nontemporal_load(W + (size_t)k * N + nd); } };
struct SrcIN { const float* W; const float* g; __device__ __forceinline__ float operator()(int k, int nd) const {
    const int col = nd < 1280 ? nd : (nd < 3328 ? nd + 24 : (nd < 3352 ? nd - 3328 + 1280 : (nd < 3360 ? nd : -1)));
    return col < 0 ? 0.f : __builtin_nontemporal_load(W + (size_t)k * INCOLS + col); } };
struct SrcCMP { const float* W1; const float* g; __device__ __forceinline__ float operator()(int k, int nd) const { const int kv = nd >> 8, r = nd & 255;
    return r < 128 ? __builtin_nontemporal_load(W1 + ((size_t)kv * 2048 + k) * 128 + r) : __builtin_nontemporal_load(W1 + ((size_t)kv * 2048 + 1024 + k) * 128 + r - 128); } };

template <class SrcF>
__device__ __forceinline__ void transpose_item(const SrcF& src, int K, bf16* WT, LAS float* scr, int kb, int nb, int lane) {
    const int k0 = 64 * kb, n0 = 32 * nb, c = lane & 7;
    f32x4 ga = {1.f, 1.f, 1.f, 1.f}, gb = ga;
    if (src.g) { ga = *(const f32x4*)(src.g + k0 + 8 * c); gb = *(const f32x4*)(src.g + k0 + 8 * c + 4); }
    float tv[32];
#pragma unroll
    for (int i = 0; i < 32; ++i) tv[i] = src(k0 + 2 * i + (lane >> 5), n0 + (lane & 31));
#pragma unroll
    for (int i = 0; i < 32; ++i) { const int kk = 2 * i + (lane >> 5); scr[kk * 33 + (lane & 31)] = tv[i]; }
    LDS_WAIT(); asm volatile("" ::: "memory");
#pragma unroll
    for (int j = 0; j < 4; ++j) { const int n = (lane >> 3) + 8 * j; const LAS float* s = scr + (8 * c) * 33 + n;
        v4u o; o.x = cvtpk(s[0 * 33] * ga.x, s[1 * 33] * ga.y); o.y = cvtpk(s[2 * 33] * ga.z, s[3 * 33] * ga.w); o.z = cvtpk(s[4 * 33] * gb.x, s[5 * 33] * gb.y); o.w = cvtpk(s[6 * 33] * gb.z, s[7 * 33] * gb.w);
        *(v4u*)(WT + (size_t)(n0 + n) * K + k0 + 8 * c) = o; }
    LDS_WAIT(); asm volatile("" ::: "memory");
}

template <int MODE>
__device__ __forceinline__ void thin_phase(const bf16* HD, const float* xin_f32, bf16* X16, float* out_f32, float* R2, const float* gpost, float cc, int gw, int NGW, int lane) {
    f32x4 gp[4];
#pragma unroll
    for (int j = 0; j < 4; ++j) gp[j] = (MODE != 0) ? *(const f32x4*)(gpost + 4 * lane + 256 * j) : (f32x4){0.f, 0.f, 0.f, 0.f};
    f32x4 xf[4]; v2u xn[4], hn[4];
    if (gw < MTOK) {
#pragma unroll
        for (int j = 0; j < 4; ++j) { if (MODE == 0) xf[j] = __builtin_nontemporal_load((const f32x4*)(xin_f32 + (size_t)gw * DM + 4 * lane + 256 * j));
            else { xn[j] = *(const v2u*)(X16 + (size_t)gw * DM + 4 * lane + 256 * j); hn[j] = *(const v2u*)(HD + (size_t)gw * DM + 4 * lane + 256 * j); } }
    }
    for (int m = gw; m < MTOK; m += NGW) {
        f32x4 x[4]; v2u hw[4];
#pragma unroll
        for (int j = 0; j < 4; ++j) { if (MODE == 0) x[j] = xf[j]; else { x[j] = (f32x4){bflo(xn[j].x), bfhi(xn[j].x), bflo(xn[j].y), bfhi(xn[j].y)}; hw[j] = hn[j]; } }
        const int m2 = m + NGW;
        if (m2 < MTOK) {
#pragma unroll
            for (int j = 0; j < 4; ++j) { if (MODE == 0) xf[j] = __builtin_nontemporal_load((const f32x4*)(xin_f32 + (size_t)m2 * DM + 4 * lane + 256 * j));
                else { xn[j] = *(const v2u*)(X16 + (size_t)m2 * DM + 4 * lane + 256 * j); hn[j] = *(const v2u*)(HD + (size_t)m2 * DM + 4 * lane + 256 * j); } }
        }
        if (MODE != 0) {
            f32x4 h[4]; float ss = 0.f;
#pragma unroll
            for (int j = 0; j < 4; ++j) { h[j] = (f32x4){bflo(hw[j].x), bfhi(hw[j].x), bflo(hw[j].y), bfhi(hw[j].y)}; ss += (h[j].x * h[j].x + h[j].y * h[j].y) + (h[j].z * h[j].z + h[j].w * h[j].w); }
            const float r = cc * __frsqrt_rn(wave_sum(ss, lane) * (1.f / DM) + EPS);
#pragma unroll
            for (int j = 0; j < 4; ++j) x[j] = x[j] + (h[j] * r) * gp[j];
        }
        if (MODE == 2) {
#pragma unroll
            for (int j = 0; j < 4; ++j) *(f32x4*)(out_f32 + (size_t)m * DM + 4 * lane + 256 * j) = x[j];
        } else {
            float s2 = 0.f;
#pragma unroll
            for (int j = 0; j < 4; ++j) { s2 += (x[j].x * x[j].x + x[j].y * x[j].y) + (x[j].z * x[j].z + x[j].w * x[j].w);
                v2u w; w.x = cvtpk(x[j].x, x[j].y); w.y = cvtpk(x[j].z, x[j].w); *(v2u*)(X16 + (size_t)m * DM + 4 * lane + 256 * j) = w; }
            const float st = wave_sum(s2, lane);
            if (lane == 0) *(f32x4*)(R2 + (size_t)m * 4) = (f32x4){st, 0.f, 0.f, 0.f};
        }
    }
}

struct EpiSwiglu {
    static constexpr bool PERM = true, AFTER_DRAIN = false, HAS_PRE = true; struct Pre {};
    bf16* H; const float* SS2; LAS unsigned char* lred;
    __device__ __forceinline__ void pre_load(const pg8::Unit& u, int wr, int wc, Pre&) const {
        if (wc == 0) { const float* sp = SS2 + (size_t)(u.pm * 256 + wr * 64 + fresh_lane()) * 4;
            __builtin_amdgcn_global_load_lds((const unsigned*)sp, (LAS unsigned*)(lred + wr * 2048), 16, 0, 0);
            __builtin_amdgcn_global_load_lds((const unsigned*)(sp + 128 * 4), (LAS unsigned*)(lred + wr * 2048 + 1024), 16, 0, 0); } }
    __device__ __forceinline__ void operator()(const pg8::f32x4 (&acc)[2][2][4][2], const pg8::Unit& u, int wr, int wc, int fr, int fq, const Pre& P) const {
        float rsv[2][4];
        { const int ln = fq * 16 + fr; const f32x4 p0 = *(const LAS f32x4*)(lred + wr * 2048 + ln * 16), p1 = *(const LAS f32x4*)(lred + wr * 2048 + 1024 + ln * 16);
          const float r0 = __frsqrt_rn(((p0.x + p0.y) + (p0.z + p0.w)) * (1.f / DM) + EPS), r1 = __frsqrt_rn(((p1.x + p1.y) + (p1.z + p1.w)) * (1.f / DM) + EPS);
#pragma unroll
          for (int m = 0; m < 4; ++m) { rsv[0][m] = shi(r0, m * 16 + fr); rsv[1][m] = shi(r1, m * 16 + fr); } }
#pragma unroll
        for (int ai = 0; ai < 2; ++ai)
#pragma unroll
            for (int m = 0; m < 4; ++m) {
                const int row = u.pm * 256 + ai * 128 + wr * 64 + m * 16 + fr; const float rs = rsv[ai][m];
                typedef float f2 __attribute__((ext_vector_type(2)));
                f2 tg[4], tu[4], ex[4]; float o[8]; const float c1 = rs * -1.4426950408889634f, rs2 = rs * rs;
#pragma unroll
                for (int n = 0; n < 2; ++n) { const pg8::f32x4 g4 = acc[ai][0][m][n], u4 = acc[ai][1][m][n];
                    tg[2 * n] = (f2){g4[0], g4[1]}; tg[2 * n + 1] = (f2){g4[2], g4[3]}; tu[2 * n] = (f2){u4[0], u4[1]}; tu[2 * n + 1] = (f2){u4[2], u4[3]}; }
#pragma unroll
                for (int e = 0; e < 4; ++e) { const f2 a2 = tg[e] * c1; ex[e].x = __builtin_amdgcn_exp2f(a2.x); ex[e].y = __builtin_amdgcn_exp2f(a2.y); }
#pragma unroll
                for (int e = 0; e < 4; ++e) { const f2 d2 = ex[e] + 1.0f; ex[e].x = __builtin_amdgcn_rcpf(d2.x); ex[e].y = __builtin_amdgcn_rcpf(d2.y); tu[e] = (tg[e] * tu[e]) * rs2; }
#pragma unroll
                for (int e = 0; e < 4; ++e) { const f2 r2 = tu[e] * ex[e]; o[2 * e] = r2.x; o[2 * e + 1] = r2.y; }
                v4u w; w.x = pg8::cvt_pk_bf16(o[0], o[1]); w.y = pg8::cvt_pk_bf16(o[2], o[3]); w.z = pg8::cvt_pk_bf16(o[4], o[5]); w.w = pg8::cvt_pk_bf16(o[6], o[7]);
                *(v4u*)(H + (size_t)row * FF + u.pn * 128 + wc * 32 + fq * 8) = w;
            }
    }
};
#define EPI_LBAR() do { asm volatile("s_waitcnt lgkmcnt(0)" ::: "memory"); __builtin_amdgcn_s_barrier(); } while (0)
template <bool FINAL>
struct EpiResNorm {
    static constexpr bool PERM = !FINAL, AFTER_DRAIN = false, HAS_PRE = false; struct Pre {};
    unsigned char* ws; LAS float* red; const float* gpost; float* outf; float cc; int inst;
    __device__ __forceinline__ void operator()(const pg8::f32x4 (&acc)[2][2][4][2], const pg8::Unit& u, int wr, int wc, int fr_, int fq_) const {
        int fr = fr_, fq = fq_;
        bf16* X16 = (bf16*)(ws + WS_X16);
        const int ln = fresh_lane(), wv = wr * 4 + wc, tid = wv * 64 + ln; fr = ln & 15; fq = ln >> 4;
        const int r0 = u.pm * 256 + wr * 64 + fr, c0 = u.pn * 256 + wc * 32 + fq * (FINAL ? 4 : 8);
        v4u xv[2][4][2];
        if (wv != 0) {
#pragma unroll
            for (int ai = 0; ai < 2; ++ai)
#pragma unroll
                for (int m = 0; m < 4; ++m)
#pragma unroll
                    for (int bj = 0; bj < 2; ++bj) { const bf16* xp = X16 + (size_t)(r0 + ai * 128 + m * 16) * DM + c0 + bj * 128;
                        if (FINAL) { const v2u lo2 = *(const v2u*)xp, hi2 = *(const v2u*)(xp + 16); xv[ai][m][bj] = (v4u){lo2.x, lo2.y, hi2.x, hi2.y}; } else xv[ai][m][bj] = *(const v4u*)xp; }
        }
        if (tid >= 256) red[1280 + tid - 256] = gpost[u.pn * 256 + tid - 256];
#pragma unroll
        for (int ai = 0; ai < 2; ++ai)
#pragma unroll
            for (int m = 0; m < 4; ++m) { float s = 0.f;
#pragma unroll
                for (int bj = 0; bj < 2; ++bj)
#pragma unroll
                    for (int n = 0; n < 2; ++n) { const pg8::f32x4 a = acc[ai][bj][m][n]; s += (a[0] * a[0] + a[1] * a[1]) + (a[2] * a[2] + a[3] * a[3]); }
                s += shx(s, 16, ln); s += shx(s, 32, ln);
                if (fq == 0) red[wc * 256 + ai * 128 + wr * 64 + m * 16 + fr] = s; }
        EPI_LBAR();
        if (wv == 0) {
            unsigned* ctr = (unsigned*)(ws + WS_CTL) + CW_GRP + (inst * 128 + u.pm) * 16;
            unsigned* part = (unsigned*)(ws + WS_PART) + (size_t)inst * 4 * MTOK + u.pm * 256 + 4 * ln;
            const f32x4 p0 = *(const LAS f32x4*)(red + 4 * ln), p1 = *(const LAS f32x4*)(red + 256 + 4 * ln), p2 = *(const LAS f32x4*)(red + 512 + 4 * ln), p3 = *(const LAS f32x4*)(red + 768 + 4 * ln);
            const f32x4 ps = (p0 + p1) + (p2 + p3);
            unsigned* mine = part + (size_t)u.pn * MTOK;
            asm volatile("global_store_dwordx4 %0, %1, off sc1\n\ts_waitcnt vmcnt(0)" :: "v"(mine), "v"(ps) : "memory");
            if (ln == 0) { (void)__hip_atomic_fetch_add(ctr, 1u, __ATOMIC_RELAXED, __HIP_MEMORY_SCOPE_AGENT);
                unsigned sp = 0u; while (__hip_atomic_load(ctr, __ATOMIC_RELAXED, __HIP_MEMORY_SCOPE_AGENT) < 4u) { __builtin_amdgcn_s_sleep(1); if (++sp > (1u << 22)) break; } }
            asm volatile("" ::: "memory");
            f32x4 q0, q1, q2, q3;
            asm volatile("global_load_dwordx4 %0, %4, off sc1\n\tglobal_load_dwordx4 %1, %5, off sc1\n\tglobal_load_dwordx4 %2, %6, off sc1\n\tglobal_load_dwordx4 %3, %7, off sc1\n\ts_waitcnt vmcnt(0)"
                         : "=&v"(q0), "=&v"(q1), "=&v"(q2), "=&v"(q3) : "v"(part), "v"(part + MTOK), "v"(part + 2 * (size_t)MTOK), "v"(part + 3 * (size_t)MTOK) : "memory");
            const f32x4 t = ((q0 + q1) + (q2 + q3)) * (1.f / DM) + EPS;
            *(LAS f32x4*)(red + 1024 + 4 * ln) = (f32x4){cc * __frsqrt_rn(t.x), cc * __frsqrt_rn(t.y), cc * __frsqrt_rn(t.z), cc * __frsqrt_rn(t.w)};
#pragma unroll
            for (int ai = 0; ai < 2; ++ai)
#pragma unroll
                for (int m = 0; m < 4; ++m)
#pragma unroll
                    for (int bj = 0; bj < 2; ++bj) { const bf16* xp = X16 + (size_t)(r0 + ai * 128 + m * 16) * DM + c0 + bj * 128;
                        if (FINAL) { const v2u lo2 = *(const v2u*)xp, hi2 = *(const v2u*)(xp + 16); xv[ai][m][bj] = (v4u){lo2.x, lo2.y, hi2.x, hi2.y}; } else xv[ai][m][bj] = *(const v4u*)xp; }
        }
        EPI_LBAR();
#pragma unroll
        for (int ai = 0; ai < 2; ++ai)
#pragma unroll
            for (int m = 0; m < 4; ++m) { const float inv = red[1024 + ai * 128 + wr * 64 + m * 16 + fr]; float s = 0.f; const size_t rowo = (size_t)(r0 + ai * 128 + m * 16) * DM + c0;
                asm volatile("" ::: "memory");
#pragma unroll
                for (int bj = 0; bj < 2; ++bj) { const v4u xw = xv[ai][m][bj]; const LAS float* gl = red + 1280 + bj * 128 + wc * 32 + fq * (FINAL ? 4 : 8); const f32x4 gv0 = *(const LAS f32x4*)gl, gv1 = *(const LAS f32x4*)(gl + (FINAL ? 16 : 4));
                    f32x4 x0 = (f32x4){bflo(xw.x), bfhi(xw.x), bflo(xw.y), bfhi(xw.y)}, x1 = (f32x4){bflo(xw.z), bfhi(xw.z), bflo(xw.w), bfhi(xw.w)};
                    x0 = x0 + (acc[ai][bj][m][0] * inv) * gv0; x1 = x1 + (acc[ai][bj][m][1] * inv) * gv1;
                    if (FINAL) { float* op = outf + rowo + bj * 128; __builtin_nontemporal_store(x0, (f32x4*)op); __builtin_nontemporal_store(x1, (f32x4*)(op + 16)); }
                    else { s += ((x0.x * x0.x + x0.y * x0.y) + (x0.z * x0.z + x0.w * x0.w)) + ((x1.x * x1.x + x1.y * x1.y) + (x1.z * x1.z + x1.w * x1.w));
                        v4u w; w.x = pg8::cvt_pk_bf16(x0.x, x0.y); w.y = pg8::cvt_pk_bf16(x0.z, x0.w); w.z = pg8::cvt_pk_bf16(x1.x, x1.y); w.w = pg8::cvt_pk_bf16(x1.z, x1.w);
                        *(v4u*)(X16 + rowo + bj * 128) = w; } }
                if (!FINAL) { s += shx(s, 16, ln); s += shx(s, 32, ln); if (fq == 0) red[wc * 256 + ai * 128 + wr * 64 + m * 16 + fr] = s; } }
        if (!FINAL) {
            EPI_LBAR();
            if (tid < 256) ((float*)(ws + WS_TAB + TAB_SS2))[(size_t)(u.pm * 256 + tid) * 4 + u.pn] = (red[tid] + red[256 + tid]) + (red[512 + tid] + red[768 + tid]);
        }
    }
};
struct EpiCmpMlp {
    static constexpr bool PERM = true, AFTER_DRAIN = true, HAS_PRE = false; struct Pre {};
    unsigned char* ws; const float* b1; const bf16* w2t;
    __device__ __forceinline__ void operator()(const pg8::f32x4 (&)[2][2][4][2], const pg8::Unit&, int, int, int, int) const {}
    __device__ __forceinline__ void fused(const pg8::f32x4 (&acc)[2][2][4][2], const pg8::Unit& u, int wr, int wc, int fr_, int fq_, LAS unsigned char* lds, int wid, int lane_) const {
        (void)fr_; (void)fq_; (void)lane_;
        const int ln = fresh_lane(), fr = ln & 15, fq = ln >> 4, kv = u.pm >> 4;
        pg8::bf16x8 xf[4][4];
        { const bf16* wp = w2t + (size_t)kv * 64 * 128 + fr * 128 + fq * 8;
#pragma unroll
          for (int ib = 0; ib < 4; ++ib)
#pragma unroll
              for (int ks = 0; ks < 4; ++ks) xf[ib][ks] = *(const pg8::bf16x8*)(wp + ib * 16 * 128 + ks * 32); }
        f32x4 bb[2];
#pragma unroll
        for (int n = 0; n < 2; ++n) bb[n] = *(const f32x4*)(b1 + kv * 128 + wc * 32 + fq * 8 + 4 * n);
#pragma unroll
        for (int ai = 0; ai < 2; ++ai)
#pragma unroll
            for (int m = 0; m < 4; ++m) { const int row = ai * 128 + wr * 64 + m * 16 + fr;
#pragma unroll
                for (int n = 0; n < 2; ++n) *(LAS f32x4*)(lds + row * 512 + (((wc * 8 + fq * 2 + n) ^ (row & 15)) << 4)) = acc[ai][1][m][n]; }
        EPI_LBAR();
        v4u hv[2][4];
#pragma unroll
        for (int ai = 0; ai < 2; ++ai)
#pragma unroll
            for (int m = 0; m < 4; ++m) { const int row = ai * 128 + wr * 64 + m * 16 + fr, rn = (row < 255) ? row + 1 : 255; float h[8];
#pragma unroll
                for (int n = 0; n < 2; ++n) { const f32x4 q = *(const LAS f32x4*)(lds + rn * 512 + (((wc * 8 + fq * 2 + n) ^ (rn & 15)) << 4)); const f32x4 v = acc[ai][0][m][n] + q + bb[n];
#pragma unroll
                    for (int e = 0; e < 4; ++e) { const float x = v[e], t = x * (1.f + 0.044715f * x * x) * (-2.f * 0.7978845608028654f * 1.4426950408889634f);
                        h[4 * n + e] = ((row & 127) == 127) ? 0.f : x * __builtin_amdgcn_rcpf(1.f + __builtin_amdgcn_exp2f(t)); } }
                hv[ai][m] = (v4u){cvtpk(h[0], h[1]), cvtpk(h[2], h[3]), cvtpk(h[4], h[5]), cvtpk(h[6], h[7])}; }
        EPI_LBAR();
#pragma unroll
        for (int ai = 0; ai < 2; ++ai)
#pragma unroll
            for (int m = 0; m < 4; ++m) { const int row = ai * 128 + wr * 64 + m * 16 + fr; *(LAS v4u*)(lds + row * 256 + (((wc * 4 + fq) ^ (row & 15)) << 4)) = hv[ai][m]; }
        EPI_LBAR();
        bf16* CC = (bf16*)(ws + WS_CC);
#pragma unroll
        for (int jj = 0; jj < 2; ++jj) { const int row = (2 * wid + jj) * 16 + fr; pg8::f32x4 o[4];
#pragma unroll
            for (int ib = 0; ib < 4; ++ib) o[ib] = (pg8::f32x4){0.f, 0.f, 0.f, 0.f};
#pragma unroll
            for (int ks = 0; ks < 4; ++ks) { const pg8::bf16x8 y = *(const LAS pg8::bf16x8*)(lds + row * 256 + (((ks * 4 + fq) ^ (row & 15)) << 4));
#pragma unroll
                for (int ib = 0; ib < 4; ++ib) o[ib] = __builtin_amdgcn_mfma_f32_16x16x32_bf16(xf[ib][ks], y, o[ib], 0, 0, 0); }
            bf16* cp = CC + ((size_t)u.pm * 256 + row) * 64 + 4 * fq;
#pragma unroll
            for (int ib = 0; ib < 4; ++ib) { v2u w; w.x = cvtpk(o[ib][0], o[ib][1]); w.y = cvtpk(o[ib][2], o[ib][3]); *(v2u*)(cp + ib * 16) = w; } }
    }
};
struct CmpOrder {
    int c, G;
    __device__ __forceinline__ bool next(int i, pg8::Unit& u) const { const int idx = i * G + c; if (idx >= 32) return false; u.pm = idx; u.pn = idx >> 4; return true; }
    __device__ __forceinline__ void a_ready(const pg8::Unit&) const {}
    __device__ __forceinline__ void done(const pg8::Unit&) const {}
};
struct EpiInProj {
    static constexpr bool PERM = true, AFTER_DRAIN = false, HAS_PRE = true; struct Pre {};
    unsigned char* ws; LAS unsigned char* lred;
    __device__ __forceinline__ void pre_load(const pg8::Unit& u, int wr, int wc, Pre&) const {
        if (wc == 0) { const float* sp = (const float*)(ws + WS_TAB + TAB_SS2) + (size_t)(u.pm * 256 + wr * 64 + fresh_lane()) * 4;
            __builtin_amdgcn_global_load_lds((const unsigned*)sp, (LAS unsigned*)(lred + wr * 2048), 16, 0, 0);
            __builtin_amdgcn_global_load_lds((const unsigned*)(sp + 128 * 4), (LAS unsigned*)(lred + wr * 2048 + 1024), 16, 0, 0); } }
    __device__ __forceinline__ void operator()(const pg8::f32x4 (&acc)[2][2][4][2], const pg8::Unit& u, int wr, int wc, int fr, int fq, const Pre&) const {
        const int pn = u.pn;
        const bool ropet = (pn < 2) || (pn == 3) || (pn == 4);
        const bool ropew = ropet && ((wc & 1) == 0);
        float rsv[2][4];
#pragma unroll
        for (int ai = 0; ai < 2; ++ai)
#pragma unroll
            for (int m = 0; m < 4; ++m) { const f32x4 p = *(const LAS f32x4*)(lred + wr * 2048 + ai * 1024 + (m * 16 + fr) * 16); rsv[ai][m] = __frsqrt_rn(((p.x + p.y) + (p.z + p.w)) * (1.f / DM) + EPS); }
#pragma unroll
        for (int ai = 0; ai < 2; ++ai)
#pragma unroll
            for (int m = 0; m < 4; ++m) {
                const int row = u.pm * 256 + ai * 128 + wr * 64 + m * 16 + fr;
                const int b = row >> 11, t = row & 2047; const float rs = rsv[ai][m];
                f32x4 c0, c1, s0, s1;
                if (ropew) {
                    const float tf = (float)t; float cs_[8], sn_[8];
                    const float ifr[8] = {1.5915494309e-01f, 3.0863763405e-02f, 5.9851857127e-03f, 1.1606636412e-03f, 2.2507907904e-04f, 4.3647952793e-05f, 8.4643308082e-06f, 1.6414262628e-06f};
#pragma unroll
                    for (int e = 0; e < 8; ++e) { const float rv = __builtin_amdgcn_fractf(tf * ifr[e]); cs_[e] = __builtin_amdgcn_cosf(rv); sn_[e] = __builtin_amdgcn_sinf(rv); }
                    c0 = (f32x4){cs_[0], cs_[1], cs_[2], cs_[3]}; c1 = (f32x4){cs_[4], cs_[5], cs_[6], cs_[7]}; s0 = (f32x4){sn_[0], sn_[1], sn_[2], sn_[3]}; s1 = (f32x4){sn_[4], sn_[5], sn_[6], sn_[7]}; }
#pragma unroll
                for (int bj = 0; bj < 2; ++bj) {
                    f32x4 v0 = acc[ai][bj][m][0] * rs, v1 = acc[ai][bj][m][1] * rs;
                    const int cl = bj * 128 + wc * 32 + fq * 8;
                    if (ropew && (pn < 2 || bj == 0)) {
                        f32x4 p0, p1; const int ln = fq * 16 + fr;
                        p0.x = shx(v0.x, 16, ln); p0.y = shx(v0.y, 16, ln); p0.z = shx(v0.z, 16, ln); p0.w = shx(v0.w, 16, ln);
                        p1.x = shx(v1.x, 16, ln); p1.y = shx(v1.y, 16, ln); p1.z = shx(v1.z, 16, ln); p1.w = shx(v1.w, 16, ln);
                        const float sg = (fq == 0) ? -1.f : 1.f;
                        if (fq < 2) { v0 = v0 * c0 + (p0 * s0) * sg; v1 = v1 * c1 + (p1 * s1) * sg; }
                    }
                    if (pn < 2) { v0 = v0 * 0.18033688011112042f; v1 = v1 * 0.18033688011112042f; }
                    if (pn == 13) { if (cl < 32) { float* p = (float*)(ws + WS_GATE) + (size_t)row * 32 + cl; *(f32x4*)p = v0; *(f32x4*)(p + 4) = v1; } }
                    else {
                        size_t off;
                        if (pn < 2) off = WS_QN + ((size_t)row * 512 + pn * 256 + cl) * 2;
                        else if (pn < 5) { const int g = wc >> 1, d = (wc & 1) * 32 + fq * 8; off = WS_KCR + (size_t)((pn - 2) * 2 + bj) * (8 * MiB) + (((size_t)(b * 2 + g) * SEQ + t) * 64 + d) * 2; }
                        else { const int q = pn - 5; off = WS_MQ + (size_t)(q >> 1) * (32 * MiB) + ((size_t)row * 512 + (q & 1) * 256 + cl) * 2; }
                        v4u w; w.x = pg8::cvt_pk_bf16(v0.x, v0.y); w.y = pg8::cvt_pk_bf16(v0.z, v0.w); w.z = pg8::cvt_pk_bf16(v1.x, v1.y); w.w = pg8::cvt_pk_bf16(v1.z, v1.w);
                        *(v4u*)(ws + off) = w;
                    }
                }
            }
    }
};
static_assert(WS_VCR == WS_KCR + 8 * MiB && WS_KS == WS_KCR + 16 * MiB && WS_VS == WS_KCR + 24 * MiB && WS_KW == WS_KCR + 32 * MiB && WS_VW == WS_KCR + 40 * MiB, "kv buffers are 8 MiB apart in (pn, bj) order");
static_assert(WS_MK == WS_MQ + 32 * MiB && WS_MV == WS_MQ + 64 * MiB && WS_MO == WS_MQ + 96 * MiB, "mLSTM buffers are 32 MiB apart");

struct MixPtrs { unsigned char* ws; const float *conv_w, *conv_b, *i_bias, *f_bias, *mnorm_g; };
#define MP_QN ((const bf16*)(P.ws + WS_QN))
#define MP_KS ((const bf16*)(P.ws + WS_KS))
#define MP_VS ((const bf16*)(P.ws + WS_VS))
#define MP_KW ((const bf16*)(P.ws + WS_KW))
#define MP_VW ((const bf16*)(P.ws + WS_VW))
#define MP_KC ((const bf16*)(P.ws + WS_CC))
#define MP_VC ((const bf16*)(P.ws + WS_CC) + (size_t)4096 * 64)
#define MP_MQ ((const bf16*)(P.ws + WS_MQ))
#define MP_MK ((const bf16*)(P.ws + WS_MK))
#define MP_MV ((const bf16*)(P.ws + WS_MV))
#define MP_MO ((const bf16*)(P.ws + WS_MO))
#define MP_GATE ((const float*)(P.ws + WS_GATE))
#define MP_Y ((bf16*)(P.ws + WS_U))


typedef float f32x16 __attribute__((ext_vector_type(16)));
typedef short bf16x8v __attribute__((ext_vector_type(8)));
typedef short s16x4v __attribute__((ext_vector_type(4)));
typedef float f32x2v __attribute__((ext_vector_type(2)));
typedef __bf16 bf16x2v __attribute__((ext_vector_type(2)));
#define MFMA32(a, b, c) __builtin_amdgcn_mfma_f32_32x32x16_bf16((a), (b), (c), 0, 0, 0)
__device__ __forceinline__ s16x4v tr_read(const LAS unsigned char* p) { return __builtin_bit_cast(s16x4v, __builtin_amdgcn_ds_read_tr16_b64_v4i16((LAS s16x4v*)p)); }
__device__ __forceinline__ int tile_off(int key, int ch8) { return (ch8 >> 2) * 4096 + key * 64 + (((ch8 & 3) ^ ((key >> 2) & 3)) << 4); }
constexpr int NM_SLOT = 0, NM_IMP = 65536, NM_IMS = 99328, NM_SEL = 108544, NM_ITEM = 108864;
constexpr float QK_SCALE = 0.125f * 1.4426950408889634f;

#define SBAR() __builtin_amdgcn_sched_barrier(0)
__device__ __forceinline__ void xor32_pair(float v, float& lo, float& hi) { float a = v, b = v; asm volatile("s_nop 1\n\tv_permlane32_swap_b32 %0, %1" : "+v"(a), "+v"(b)); lo = a; hi = b; }
__device__ __forceinline__ float xor32_max(float v) { float lo, hi; xor32_pair(v, lo, hi); float r; asm("v_max_f32 %0, %1, %2" : "=v"(r) : "v"(lo), "v"(hi)); return r; }
__device__ __forceinline__ float xor32_sum(float v) { float lo, hi; xor32_pair(v, lo, hi); return lo + hi; }
__device__ __forceinline__ float max2f(float a, float b) { float r; asm("v_max_f32 %0, %1, %2" : "=v"(r) : "v"(a), "v"(b)); return r; }
__device__ __forceinline__ float max3f(float a, float b, float c) { float r; asm("v_max3_f32 %0, %1, %2, %3" : "=v"(r) : "v"(a), "v"(b), "v"(c)); return r; }
#define LBAR() asm volatile("s_waitcnt lgkmcnt(0)\n\ts_barrier" ::: "memory")
__device__ __forceinline__ void k_load(const LAS unsigned char* Ks, int r, int h, bf16x8v (&kf)[8]) {
    const int sw = (r >> 2) & 3;
#pragma unroll
    for (int ks = 0; ks < 4; ++ks) { const int off = (ks >> 1) * 4096 + r * 64 + (((((ks & 1) << 1) + h) ^ sw) << 4);
        kf[2 * ks] = *(const LAS bf16x8v*)(Ks + off); kf[2 * ks + 1] = *(const LAS bf16x8v*)(Ks + off + 2048); }
}
__device__ __forceinline__ void qk_mma(const bf16x8v (&kf)[8], const bf16x8v (&qf)[4], f32x16& p0, f32x16& p1) {
    const f32x16 z = {0.f, 0.f, 0.f, 0.f, 0.f, 0.f, 0.f, 0.f, 0.f, 0.f, 0.f, 0.f, 0.f, 0.f, 0.f, 0.f};
#pragma unroll
    for (int ks = 0; ks < 4; ++ks) { p0 = MFMA32(kf[2 * ks], qf[ks], ks ? p0 : z); p1 = MFMA32(kf[2 * ks + 1], qf[ks], ks ? p1 : z); }
}
__device__ __forceinline__ void v_load(const LAS unsigned char* Vs, int lane, bf16x8v (&vf)[8]) {
    const int h = lane >> 5, i16 = lane & 15, q = i16 >> 2, p = i16 & 3, gi = (lane >> 4) & 1;
    const int cidx = 2 * gi + (p >> 1), e8 = (p & 1) << 3;
    const int offlo = q * 64 + ((cidx ^ h) << 4) + e8 + h * 256, offhi = q * 64 + ((cidx ^ (h | 2)) << 4) + e8 + h * 256 + 512;
#pragma unroll
    for (int kb = 0; kb < 2; ++kb)
#pragma unroll
        for (int s = 0; s < 2; ++s)
#pragma unroll
            for (int db = 0; db < 2; ++db) { const LAS unsigned char* base = Vs + db * 4096 + (kb * 32 + s * 16) * 64;
                const s16x4v lo = tr_read(base + offlo), hi = tr_read(base + offhi);
                vf[(kb * 2 + s) * 2 + db] = __builtin_shufflevector(lo, hi, 0, 1, 2, 3, 4, 5, 6, 7); }
}
__device__ __forceinline__ void pv_mma(const bf16x8v (&vf)[8], const f32x16& p0, const f32x16& p1, f32x16 (&o)[2]) {
#pragma unroll
    for (int kb = 0; kb < 2; ++kb)
#pragma unroll
        for (int s = 0; s < 2; ++s) {
            const f32x16& P = kb ? p1 : p0;
            v4u pw; pw.x = cvtpk(P[8 * s + 0], P[8 * s + 1]); pw.y = cvtpk(P[8 * s + 2], P[8 * s + 3]); pw.z = cvtpk(P[8 * s + 4], P[8 * s + 5]); pw.w = cvtpk(P[8 * s + 6], P[8 * s + 7]);
            const bf16x8v pf = __builtin_bit_cast(bf16x8v, pw);
            o[0] = MFMA32(vf[(kb * 2 + s) * 2], pf, o[0]); o[1] = MFMA32(vf[(kb * 2 + s) * 2 + 1], pf, o[1]);
        }
}

__device__ __forceinline__ void nsa_unit_mfma(LAS unsigned char* L, const MixPtrs& P, int b, int g, int c, int tid_in) {
    int tid_l = tid_in; asm volatile("" : "+v"(tid_l));
    const int tid = tid_l, lane = tid & 63, w = __builtin_amdgcn_readfirstlane(tid >> 6);
    const int r = lane & 31, h = lane >> 5, head = w >> 1, qi = (w & 1) * 32 + r, t = c * 64 + qi;
    const size_t row = (size_t)b * SEQ + t;
    LAS unsigned* SEL = (LAS unsigned*)(L + NM_SEL); LAS int* ITEM = (LAS int*)(L + NM_ITEM);
    const size_t kvbase = (size_t)(b * 2 + g) * SEQ * 64, ccbase = (size_t)(b * 2 + g) * 128 * 64;
    const int skey = tid >> 3, sch = tid & 7, soff = tile_off(skey, sch);
    bf16x8v qf[4];
    { const bf16* qp = MP_QN + row * 512 + (g * 4 + head) * 64 + 8 * h;
#pragma unroll
      for (int ks = 0; ks < 4; ++ks) qf[ks] = *(const bf16x8v*)(qp + 16 * ks); }
    const float* gp = MP_GATE + row * 32 + g * 4 + head;
    float one = 1.f; asm volatile("" : "+v"(one));
    const float gate_c = __builtin_amdgcn_rcpf(one + __expf(-gp[0])), gate_s = __builtin_amdgcn_rcpf(one + __expf(-gp[8])), gate_w = __builtin_amdgcn_rcpf(one + __expf(-gp[16]));
    f32x16 oacc[2];
    {
        const bf16* kc = MP_KC + ccbase; const bf16* vc = MP_VC + ccbase;
        const v4u k0 = *(const v4u*)(kc + tid * 8), k1 = *(const v4u*)(kc + 4096 + tid * 8), v0 = *(const v4u*)(vc + tid * 8), v1 = *(const v4u*)(vc + 4096 + tid * 8);
        LBAR();
        *(LAS v4u*)(L + NM_SLOT + soff) = k0; *(LAS v4u*)(L + NM_SLOT + 8192 + soff) = v0; *(LAS v4u*)(L + NM_SLOT + 16384 + soff) = k1; *(LAS v4u*)(L + NM_SLOT + 24576 + soff) = v1;
        if (tid < 64) SEL[tid] = 0u;
        LBAR();
        f32x16 s0, s1, s2, s3;
        { bf16x8v kfa[8], kfb[8]; k_load(L + NM_SLOT, r, h, kfa); k_load(L + NM_SLOT + 16384, r, h, kfb); SBAR(); qk_mma(kfa, qf, s0, s1); qk_mma(kfb, qf, s2, s3); }
        const int nlim = (t >= 31) ? (((t - 31) >> 4) < 126 ? ((t - 31) >> 4) : 126) : -1;
        float mx, mxv[4] = {-1e20f, -1e20f, -1e20f, -1e20f};
#pragma unroll
        for (int e = 0; e < 16; ++e) { const int cr = (e & 3) + 8 * (e >> 2) + 4 * h;
            s0[e] = (cr <= nlim) ? s0[e] * QK_SCALE : -1e30f; s1[e] = (cr + 32 <= nlim) ? s1[e] * QK_SCALE : -1e30f;
            s2[e] = (cr + 64 <= nlim) ? s2[e] * QK_SCALE : -1e30f; s3[e] = (cr + 96 <= nlim) ? s3[e] * QK_SCALE : -1e30f;
            mxv[e & 3] = fmaxf(fmaxf(mxv[e & 3], fmaxf(s0[e], s1[e])), fmaxf(s2[e], s3[e])); }
        mx = fmaxf(fmaxf(mxv[0], mxv[1]), fmaxf(mxv[2], mxv[3]));
        mx = xor32_max(mx);
        float ls, lsv[4] = {0.f, 0.f, 0.f, 0.f};
#pragma unroll
        for (int e = 0; e < 16; ++e) { s0[e] = __builtin_amdgcn_exp2f(s0[e] - mx); s1[e] = __builtin_amdgcn_exp2f(s1[e] - mx); s2[e] = __builtin_amdgcn_exp2f(s2[e] - mx); s3[e] = __builtin_amdgcn_exp2f(s3[e] - mx);
            lsv[e & 3] += (s0[e] + s1[e]) + (s2[e] + s3[e]); }
        ls = (lsv[0] + lsv[1]) + (lsv[2] + lsv[3]);
        ls = xor32_sum(ls);
        const float il = (ls > 0.f) ? __builtin_amdgcn_rcpf(ls) : 0.f;
#pragma unroll
        for (int e = 0; e < 16; ++e) { s0[e] *= il; s1[e] *= il; s2[e] *= il; s3[e] *= il; }
        { LAS float* IMP = (LAS float*)(L + NM_IMP) + (w * 32 + r) * 33; float plprev = 0.f;
#pragma unroll
          for (int x = 0; x < 16; ++x) {
              const f32x16& S = (x < 4) ? s0 : ((x < 8) ? s1 : ((x < 12) ? s2 : s3)); const int g4 = (x & 3) * 4;
              const float own = (S[g4] + S[g4 + 1]) + (S[g4 + 2] + S[g4 + 3]);
              const float pl = shx(S[g4 + 3], 32, lane);
              if (h == 1) IMP[2 * x + 1] = own + pl; else IMP[2 * x] = own + plprev;
              plprev = pl;
          }
        }
        oacc[0] = (f32x16){0.f, 0.f, 0.f, 0.f, 0.f, 0.f, 0.f, 0.f, 0.f, 0.f, 0.f, 0.f, 0.f, 0.f, 0.f, 0.f}; oacc[1] = oacc[0];
        { bf16x8v vfa[8], vfb[8]; v_load(L + NM_SLOT + 8192, lane, vfa); v_load(L + NM_SLOT + 24576, lane, vfb); SBAR(); pv_mma(vfa, s0, s1, oacc); pv_mma(vfb, s2, s3, oacc); }
#pragma unroll
        for (int e = 0; e < 16; ++e) { oacc[0][e] *= gate_c; oacc[1][e] *= gate_c; }
    }
    LBAR();
    { const int i = tid & 63, jg = tid >> 6; const LAS float* I8 = (const LAS float*)(L + NM_IMP); LAS float* IMS = (LAS float*)(L + NM_IMS);
#pragma unroll
      for (int jj = 0; jj < 4; ++jj) { const int j = 4 * jg + jj; const int wq = (i >> 5), rq = i & 31;
          IMS[i * 36 + j] = (I8[((0 + wq) * 32 + rq) * 33 + j] + I8[((2 + wq) * 32 + rq) * 33 + j]) + (I8[((4 + wq) * 32 + rq) * 33 + j] + I8[((6 + wq) * 32 + rq) * 33 + j]); }
      LBAR();
      unsigned bits = 0u;
      if (c + 1 <= 16) { if (jg == 0) bits = (1u << (c + 1)) - 1u; }
      else { if (jg == 0) bits = 1u | (1u << c) | (1u << (c - 1));
          { float iv[32];
#pragma unroll
            for (int q8 = 0; q8 < 8; ++q8) { const f32x4 x = *(const LAS f32x4*)(IMS + i * 36 + 4 * q8); iv[4 * q8] = x.x; iv[4 * q8 + 1] = x.y; iv[4 * q8 + 2] = x.z; iv[4 * q8 + 3] = x.w; }
#pragma unroll
            for (int jj = 0; jj < 4; ++jj) { const int j = 4 * jg + jj; const float vj = IMS[i * 36 + j]; int rank = 0;
#pragma unroll
                for (int i2 = 1; i2 < 30; ++i2) rank += (i2 <= c - 2 && (iv[i2] > vj || (iv[i2] == vj && i2 < j))) ? 1 : 0;
                if (j >= 1 && j <= c - 2 && rank < 13) bits |= 1u << j; } } }
      if (bits) atomicOr((unsigned*)&SEL[i], bits);
      LBAR();
      if (w == 0) { unsigned so = SEL[lane];
#pragma unroll
          for (int o2 = 32; o2; o2 >>= 1) so |= shxu(so, o2, lane);
          if (lane == 0) { int n = 0; for (int j = 0; j <= c; ++j) if ((so >> j) & 1u) ITEM[n++] = j; const int j0 = (c - 8 > 0) ? c - 8 : 0; for (int j = j0; j <= c; ++j) ITEM[n++] = 64 + j; ITEM[n] = -1; ITEM[47] = n; } }
      LBAR();
    }
    const unsigned mysel = SEL[qi]; const int nitem = ITEM[47];
    f32x16 o[2]; float m = -1e20f, lsum = 0.f; int prev_kind = 0;
    o[0] = (f32x16){0.f, 0.f, 0.f, 0.f, 0.f, 0.f, 0.f, 0.f, 0.f, 0.f, 0.f, 0.f, 0.f, 0.f, 0.f, 0.f}; o[1] = o[0];
    const int npair = (nitem + 1) >> 1;
    v4u rk0, rv0, rk1, rv1;
#define NSA_LOAD_PAIR(ip_) do { const int ia_ = ITEM[2 * (ip_)], ib_ = ITEM[2 * (ip_) + 1]; \
        { const bf16* kp = ((ia_ & 64) ? MP_KW : MP_KS) + kvbase + (size_t)(ia_ & 63) * 4096; const bf16* vp = ((ia_ & 64) ? MP_VW : MP_VS) + kvbase + (size_t)(ia_ & 63) * 4096; rk0 = *(const v4u*)(kp + tid * 8); rv0 = *(const v4u*)(vp + tid * 8); } \
        if (ib_ >= 0) { const bf16* kp = ((ib_ & 64) ? MP_KW : MP_KS) + kvbase + (size_t)(ib_ & 63) * 4096; const bf16* vp = ((ib_ & 64) ? MP_VW : MP_VS) + kvbase + (size_t)(ib_ & 63) * 4096; rk1 = *(const v4u*)(kp + tid * 8); rv1 = *(const v4u*)(vp + tid * 8); } } while (0)
#define NSA_WRITE_PAIR(sb_) do { *(LAS v4u*)(L + (sb_) + soff) = rk0; *(LAS v4u*)(L + (sb_) + 8192 + soff) = rv0; *(LAS v4u*)(L + (sb_) + 16384 + soff) = rk1; *(LAS v4u*)(L + (sb_) + 24576 + soff) = rv1; } while (0)
    rk1 = (v4u){0u, 0u, 0u, 0u}; rv1 = rk1;
    NSA_LOAD_PAIR(0);
    NSA_WRITE_PAIR(NM_SLOT + 32768);
    LBAR();
#pragma unroll 1
    for (int ip = 0; ip < npair; ++ip) {
        if (ip + 1 < npair) NSA_LOAD_PAIR(ip + 1);
        const int sbase = NM_SLOT + ((ip + 1) & 1) * 32768;
#pragma unroll 1
        for (int half = 0; half < 2; ++half) {
            const int item = ITEM[2 * ip + half];
            if (item < 0) break;
            const int kind = item >> 6, j = item & 63;
            if (kind != prev_kind) {
                const float tot = xor32_sum(lsum); const float sc = gate_s * __builtin_amdgcn_rcpf(tot);
#pragma unroll
                for (int e = 0; e < 16; ++e) { oacc[0][e] += o[0][e] * sc; oacc[1][e] += o[1][e] * sc; o[0][e] = 0.f; o[1][e] = 0.f; }
                m = -1e20f; lsum = 0.f; prev_kind = kind;
            }
            int klo, khi;
            if (kind == 0) { klo = 0; khi = ((mysel >> j) & 1u) ? ((j < c) ? 63 : qi) : -1; }
            else { klo = t - 511 - 64 * j; khi = t - 64 * j; if (khi > 63) khi = 63; if (klo < 0) klo = 0; }
            const LAS unsigned char* slot = L + sbase + half * 16384;
            if (__any(khi >= klo)) {
                f32x16 p0, p1; bf16x8v vf[8];
                { bf16x8v kf[8]; k_load(slot, r, h, kf); SBAR(); qk_mma(kf, qf, p0, p1); }
                v_load(slot + 8192, lane, vf); SBAR();
                if (!__all(klo == 0 && khi == 63)) {
                    const int a = klo - 4 * h, z = khi - 4 * h;
#pragma unroll
                    for (int e = 0; e < 16; ++e) { const int cr = (e & 3) + 8 * (e >> 2);
                        p0[e] = (cr >= a && cr <= z) ? p0[e] : -1e30f; p1[e] = (cr + 32 >= a && cr + 32 <= z) ? p1[e] : -1e30f; }
                }
                float tm;
                { float ma = max2f(p0[0], p1[0]), mb = max2f(p0[1], p1[1]), mc2 = max2f(p0[2], p1[2]), md = max2f(p0[3], p1[3]);
#pragma unroll
                  for (int e = 4; e < 16; e += 4) { ma = max3f(ma, p0[e], p1[e]); mb = max3f(mb, p0[e + 1], p1[e + 1]); mc2 = max3f(mc2, p0[e + 2], p1[e + 2]); md = max3f(md, p0[e + 3], p1[e + 3]); }
                  tm = max3f(ma, mb, max2f(mc2, md)); }
                tm = xor32_max(tm);
                const float mn = fmaxf(m, tm * QK_SCALE);
                if (!__all(mn == m)) { const float corr = __builtin_amdgcn_exp2f(m - mn); lsum *= corr;
#pragma unroll
                    for (int e = 0; e < 16; ++e) { o[0][e] *= corr; o[1][e] *= corr; }
                    m = mn; }
                { const f32x2v sc2 = {QK_SCALE, QK_SCALE}, mm2 = {m, m}; f32x2v ta = {0.f, 0.f}, tb = {0.f, 0.f};
#pragma unroll
                  for (int e = 0; e < 16; e += 2) { const f32x2v a0 = (f32x2v){p0[e], p0[e + 1]} * sc2 - mm2, a1 = (f32x2v){p1[e], p1[e + 1]} * sc2 - mm2; p0[e] = a0.x; p0[e + 1] = a0.y; p1[e] = a1.x; p1[e + 1] = a1.y; }
#pragma unroll
                  for (int e = 0; e < 16; ++e) { p0[e] = __builtin_amdgcn_exp2f(p0[e]); p1[e] = __builtin_amdgcn_exp2f(p1[e]); }
#pragma unroll
                  for (int e = 0; e < 16; e += 2) { ta += (f32x2v){p0[e], p0[e + 1]}; tb += (f32x2v){p1[e], p1[e + 1]}; }
                  lsum += (ta.x + ta.y) + (tb.x + tb.y); }
                SBAR(); pv_mma(vf, p0, p1, o);
            }
        }
        if (ip + 1 < npair) NSA_WRITE_PAIR(NM_SLOT + (ip & 1) * 32768);
        LBAR();
    }
#undef NSA_LOAD_PAIR
#undef NSA_WRITE_PAIR
    { const float tot = xor32_sum(lsum); const float sc = gate_w * __builtin_amdgcn_rcpf(tot);
#pragma unroll
      for (int e = 0; e < 16; ++e) { oacc[0][e] += o[0][e] * sc; oacc[1][e] += o[1][e] * sc; } }
    { bf16* yp = MP_Y + row * DM + (g * 4 + head) * 64 + 4 * h;
#pragma unroll
      for (int db = 0; db < 2; ++db)
#pragma unroll
          for (int g4 = 0; g4 < 4; ++g4) { v2u wv; wv.x = cvtpk(oacc[db][4 * g4], oacc[db][4 * g4 + 1]); wv.y = cvtpk(oacc[db][4 * g4 + 2], oacc[db][4 * g4 + 3]); *(v2u*)(yp + db * 32 + g4 * 8) = wv; } }
}

namespace ns3 {
using f32x16 = __attribute__((ext_vector_type(16))) float;
using bf16x8 = __attribute__((ext_vector_type(8))) short;
using s16x4 = __attribute__((ext_vector_type(4))) short;
using u32x4 = __attribute__((ext_vector_type(4))) unsigned;
typedef short v4i16_t __attribute__((ext_vector_type(4)));
typedef LAS const char* lds_cptr;
constexpr int NSLOT = 3, SLOTB = 8192;
constexpr int A_K = 0, A_V = NSLOT * SLOTB, A_WS = 2 * NSLOT * SLOTB, A_OST = A_WS + 8 * 64 * 4, A_END = A_OST + 8 * 8192;
constexpr int A_VX = 118784;
constexpr int A_IMP = A_OST, A_IMS = A_OST + 33792, A_SEL = A_END, A_TTS = A_END + 512, A_TTW = A_TTS + 256;
#define SBAR3() __builtin_amdgcn_sched_barrier(0)
#define WAIT_BAR3(N) asm volatile("s_waitcnt vmcnt(" #N ") lgkmcnt(0)\n\ts_barrier":::"memory")
__device__ __forceinline__ int crow(int r, int hi) { return (r & 3) + 8 * (r >> 2) + 4 * hi; }
__device__ __forceinline__ void glds16(const void* gsrc, unsigned lds_dst) { unsigned keep;
  asm volatile("s_mov_b32 %0, m0\n\ts_mov_b32 m0, %2\n\ts_nop 0\n\tglobal_load_lds_dwordx4 %1, off\n\ts_mov_b32 m0, %0" : "=&s"(keep) : "v"(gsrc), "s"(lds_dst) : "memory"); }
__device__ __forceinline__ float fadd_s(float a, float b) { float r; asm("v_add_f32_e32 %0, %1, %2" : "=v"(r) : "v"(a), "v"(b)); return r; }
__device__ __forceinline__ float fsub_s(float a, float b) { float r; asm("v_sub_f32_e32 %0, %1, %2" : "=v"(r) : "v"(a), "v"(b)); return r; }
__device__ __forceinline__ s16x4 vtr(lds_cptr p) { return __builtin_bit_cast(s16x4, __builtin_amdgcn_ds_read_tr16_b64_v4i16((LAS v4i16_t*)p)); }
__device__ __forceinline__ void qkt(f32x16& p0, f32x16& p1, lds_cptr Kslot, const bf16x8* qr, const f32x16& negm, int r32, int hi) {
  lds_cptr kb = Kslot + hi * 1024 + r32 * 16;
#pragma unroll
  for (int d0 = 0; d0 < 4; ++d0) {
    const bf16x8 b0 = *(const LAS bf16x8*)(kb + d0 * 2048), b1 = *(const LAS bf16x8*)(kb + d0 * 2048 + 512);
    if (d0 == 0) { p0 = __builtin_amdgcn_mfma_f32_32x32x16_bf16(b0, qr[0], negm, 0, 0, 0); p1 = __builtin_amdgcn_mfma_f32_32x32x16_bf16(b1, qr[0], negm, 0, 0, 0); }
    else { p0 = __builtin_amdgcn_mfma_f32_32x32x16_bf16(b0, qr[d0], p0, 0, 0, 0); p1 = __builtin_amdgcn_mfma_f32_32x32x16_bf16(b1, qr[d0], p1, 0, 0, 0); } }
}
__device__ __forceinline__ void kload8(bf16x8* kf, lds_cptr kp) {
  kf[0] = *(const LAS bf16x8*)(kp);        kf[1] = *(const LAS bf16x8*)(kp + 512);
  kf[2] = *(const LAS bf16x8*)(kp + 2048); kf[3] = *(const LAS bf16x8*)(kp + 2560);
  kf[4] = *(const LAS bf16x8*)(kp + 4096); kf[5] = *(const LAS bf16x8*)(kp + 4608);
  kf[6] = *(const LAS bf16x8*)(kp + 6144); kf[7] = *(const LAS bf16x8*)(kp + 6656);
}
__device__ __forceinline__ void kload2(bf16x8* kf, lds_cptr kp, int j) { kf[2 * j] = *(const LAS bf16x8*)(kp + j * 2048); kf[2 * j + 1] = *(const LAS bf16x8*)(kp + j * 2048 + 512); }
__device__ __forceinline__ float rowmax(const f32x16& p0, const f32x16& p1) {
  float a = max3f(p0[0], p0[1], p1[0]), b = max3f(p0[2], p0[3], p1[1]); a = max3f(a, p1[2], p1[3]);
#pragma unroll
  for (int r = 4; r < 16; r += 4) { a = max3f(a, p0[r], p0[r + 1]); b = max3f(b, p0[r + 2], p0[r + 3]); a = max3f(a, p1[r], p1[r + 1]); b = max3f(b, p1[r + 2], p1[r + 3]); }
  return xor32_max(max2f(a, b));
}
__device__ __forceinline__ void pv(f32x16* o, int vb, bf16x8 pa0, bf16x8 pa1, bf16x8 pa2, bf16x8 pa3) {
#pragma unroll
  for (int d0 = 0; d0 < 2; ++d0) { s16x4 lo[4], hi[4];
#pragma unroll
    for (int ks = 0; ks < 4; ++ks) {
      asm volatile("ds_read_b64_tr_b16 %0,%1 offset:%c2" : "=&v"(lo[ks]) : "v"(vb), "i"(d0 * 4096 + ks * 1024) : "memory");
      asm volatile("ds_read_b64_tr_b16 %0,%1 offset:%c2" : "=&v"(hi[ks]) : "v"(vb), "i"(d0 * 4096 + ks * 1024 + 512) : "memory"); }
    asm volatile("s_waitcnt lgkmcnt(0)" ::: "memory"); SBAR3();
#define PK3(k) (bf16x8){lo[k][0], lo[k][1], lo[k][2], lo[k][3], hi[k][0], hi[k][1], hi[k][2], hi[k][3]}
    o[d0] = __builtin_amdgcn_mfma_f32_32x32x16_bf16(pa0, PK3(0), o[d0], 0, 0, 0);
    o[d0] = __builtin_amdgcn_mfma_f32_32x32x16_bf16(pa1, PK3(1), o[d0], 0, 0, 0);
    o[d0] = __builtin_amdgcn_mfma_f32_32x32x16_bf16(pa2, PK3(2), o[d0], 0, 0, 0);
    o[d0] = __builtin_amdgcn_mfma_f32_32x32x16_bf16(pa3, PK3(3), o[d0], 0, 0, 0);
#undef PK3
  }
}
template <int BR>
__device__ __forceinline__ void rmask(f32x16& p0, f32x16& p1, int e, unsigned mysel, int qi, int tq, int c, int hi) {
  const int kind = e >> 6, j = e & 63; const float NEG = -INFINITY;
  if (BR == 1) {
    int klo, khi;
    if (kind == 1) { klo = tq - 511 - 64 * j; khi = tq - 64 * j; if (khi > 63) khi = 63; if (klo < 0) klo = 0; }
    else { klo = 0; khi = -1; }
    if (!__all(klo == 0 && khi == 63)) { const int a = klo - 4 * hi, z = khi - 4 * hi;
#pragma unroll
      for (int r = 0; r < 16; ++r) { const int cr = (r & 3) + 8 * (r >> 2); if (cr < a || cr > z) p0[r] = NEG; if (cr + 32 < a || cr + 32 > z) p1[r] = NEG; } }
  } else {
    const bool on = (kind == 0) && ((mysel >> j) & 1u);
    const int z = on ? ((j == c) ? qi - 4 * hi : 64) : -1;
    if (!__all(z == 64)) {
#pragma unroll
      for (int r = 0; r < 16; ++r) { const int cr = (r & 3) + 8 * (r >> 2); p0[r] = (cr <= z) ? p0[r] : NEG; p1[r] = (cr + 32 <= z) ? p1[r] : NEG; }
    }
  }
}

template <int THRL, int BR>
__device__ __forceinline__ void stream(LAS unsigned char* L, const bf16* Kb, const bf16* Vb, const LAS int* TT, const int NT, const bf16x8 (&qr)[4],
                                       int lane, int wid, unsigned mysel, int qi, int tq, int c, float gate, bool first_write,
                                       const bf16* Knext  , const LAS int* TTnext,
                                       bool kpre  , bool pre0 = false  ,
                                       const bf16* Vnext = nullptr  , bool vpre = false  ) {
  const int r32 = lane & 31, hi = lane >> 5;
  const unsigned lds0 = (unsigned)(uintptr_t)L;
  LAS float* wsf = (LAS float*)(L + A_WS) + wid * 64;
  const bf16* ksrc = Kb + (long)lane * 64 + wid * 8;
  const bf16* vsrc = Vb + (long)(16 * (wid & 3) + (lane >> 2)) * 64 + (wid >> 2) * 32 + (lane & 3) * 8;
  const unsigned kdst = lds0 + A_K + wid * 1024, vdst = lds0 + A_V + wid * 1024;
#define TJ(x) ((long)(__builtin_amdgcn_readfirstlane(TT[(x)]) & 63) * 4096)
#define DMA_K(t, slot) glds16(ksrc + TJ(t), (unsigned)__builtin_amdgcn_readfirstlane(kdst + (slot)))
#define DMA_V(t, slot) glds16(vsrc + TJ(t), (unsigned)__builtin_amdgcn_readfirstlane(vdst + (slot)))
  const int vb0 = (int)(lds0 + A_V) + ((lane >> 4) & 1) * 32 + (lane & 3) * 8 + (4 * hi + ((lane & 15) >> 2)) * 64;
  bf16x8 kf[8];
  const lds_cptr shm3 = (lds_cptr)L; const lds_cptr kp0 = shm3 + A_K + hi * 1024 + r32 * 16; const lds_cptr vp0 = shm3 + A_V + ((lane >> 4) & 1) * 32 + (lane & 3) * 8 + (4 * hi + ((lane & 15) >> 2)) * 64;
  if (!kpre) { if (!pre0) { DMA_K(0, 0); DMA_V(0, 0); } DMA_K(1, SLOTB); }
  float mhat = 0.f, l_reg = 0.f; f32x16 o[2]; o[0] = f32x16{}; o[1] = f32x16{}; f32x16 negm = f32x16{}; asm volatile("" : "+v"(negm));
#define CMASK(P0, P1, t) rmask<BR>(P0, P1, __builtin_amdgcn_readfirstlane(TT[(t)]), mysel, qi, tq, c, hi)
  bool resc = false;
#define START(P0, P1) do { const float rm = rowmax(P0, P1); resc = false; \
    { const float dl = rm; mhat = fadd_s(mhat, dl); \
      _Pragma("unroll") for (int r = 0; r < 16; ++r) { P0[r] = fsub_s(P0[r], dl); P1[r] = fsub_s(P1[r], dl); } \
      _Pragma("unroll") for (int r = 0; r < 16; ++r) negm[r] = -mhat; asm volatile("" : "+v"(negm)); } \
    _Pragma("unroll") for (int r = 0; r < 16; ++r) P0[r] = __builtin_amdgcn_exp2f(P0[r]); } while (0)
#define RESC() do { if (resc) { asm volatile("s_waitcnt lgkmcnt(0)" ::: "memory"); \
      _Pragma("unroll") for (int d_ = 0; d_ < 2; ++d_) _Pragma("unroll") for (int r = 0; r < 16; ++r) o[d_][r] *= wsf[crow(r, hi)]; } } while (0)
  f32x16 pA0, pA1, pB0, pB1;
  int sl_prev = 0, sl_cur = vpre ? (A_VX - A_V) : 0, sl_next = SLOTB;
#define ROT() do { sl_prev = sl_cur; sl_cur = sl_next; sl_next = (sl_next == (NSLOT - 1) * SLOTB) ? 0 : sl_next + SLOTB; } while (0)
  if (!kpre) { DMA_K(2, 2 * SLOTB); } else if (!vpre) { DMA_V(0, 0); }
  WAIT_BAR3(3);
  qkt(pA0, pA1, shm3 + A_K, qr, negm, r32, hi); asm volatile("s_nop 15\n\ts_nop 7" : "+v"(pA0), "+v"(pA1)); CMASK(pA0, pA1, 0);
  START(pA0, pA1);
  _Pragma("unroll") for (int r = 0; r < 16; ++r) pA1[r] = __builtin_amdgcn_exp2f(pA1[r]);
  WAIT_BAR3(0);
  DMA_K(3, 0); DMA_V(1, SLOTB);
  ROT();
  kload8(kf, kp0 + sl_cur);
  WAIT_BAR3(2);
  s16x4 vlo[8], vhi[8]; u32x4 pw0, pw1, pw2, pw3;
#define PKW(P, B) cvtpk(P[B], P[B + 1])
#define PAF(k) __builtin_bit_cast(bf16x8, pw##k)
#define VFR(i) (bf16x8){vlo[i][0], vlo[i][1], vlo[i][2], vlo[i][3], vhi[i][0], vhi[i][1], vhi[i][2], vhi[i][3]}
#define PIN(x) asm volatile("" : "+v"(x))
#define MX3(a, b, c) __builtin_fmaxf(__builtin_fmaxf((a), (b)), (c))
#define GAPA(MF, A0, A1, A2, A3, W0, W1, PW) do { MF; sacc += A0; sacc += A1; sacc += A2; sacc += A3; PIN(sacc); W0; W1; PIN(PW); SBAR3(); } while (0)
#define EX(v) __builtin_amdgcn_exp2f(v)
#define GAPB(MF, X, B) do { MF; X[B] = EX(X[B]); X[B + 1] = EX(X[B + 1]); X[B + 2] = EX(X[B + 2]); X[B + 3] = EX(X[B + 3]); PIN(X); SBAR3(); } while (0)
#define VRD(i) do { vlo[i] = vtr(vp_ + (((i) >> 2) * 4096 + ((i) & 3) * 1024)); vhi[i] = vtr(vp_ + (((i) >> 2) * 4096 + ((i) & 3) * 1024 + 512)); } while (0)
#define KRD(G, j) do { if (G) { kload2(kf, kp0 + sl_next, j); SBAR3(); } } while (0)
#define STEP(C0, C1, P0, P1, t, GK, GV, GL) do { SBAR3(); \
    const lds_cptr vp_ = vp0 + sl_prev; \
    VRD(0); SBAR3(); float sacc = (P0[0] + P0[1]); \
    GAPA(C0 = __builtin_amdgcn_mfma_f32_32x32x16_bf16(kf[0], qr[0], negm, 0, 0, 0), P0[2], P0[3], P0[4], P0[5],     pw0[0] = PKW(P0, 0), pw0[1] = PKW(P0, 2), pw0); \
    VRD(4); SBAR3(); GAPA(C1 = __builtin_amdgcn_mfma_f32_32x32x16_bf16(kf[1], qr[0], negm, 0, 0, 0), P0[6], P0[7], P0[8], P0[9],     pw0[2] = PKW(P0, 4), pw0[3] = PKW(P0, 6), pw0); \
    VRD(1); SBAR3(); GAPA(C0 = __builtin_amdgcn_mfma_f32_32x32x16_bf16(kf[2], qr[1], C0, 0, 0, 0),   P0[10], P0[11], P0[12], P0[13], pw1[0] = PKW(P0, 8), pw1[1] = PKW(P0, 10), pw1); \
    VRD(5); SBAR3(); GAPA(C1 = __builtin_amdgcn_mfma_f32_32x32x16_bf16(kf[3], qr[1], C1, 0, 0, 0),   P0[14], P0[15], P1[0], P1[1],   pw1[2] = PKW(P0, 12), pw1[3] = PKW(P0, 14), pw1); \
    VRD(2); SBAR3(); GAPA(C0 = __builtin_amdgcn_mfma_f32_32x32x16_bf16(kf[4], qr[2], C0, 0, 0, 0),   P1[2], P1[3], P1[4], P1[5],     pw2[0] = PKW(P1, 0), pw2[1] = PKW(P1, 2), pw2); \
    VRD(6); SBAR3(); GAPA(C1 = __builtin_amdgcn_mfma_f32_32x32x16_bf16(kf[5], qr[2], C1, 0, 0, 0),   P1[6], P1[7], P1[8], P1[9],     pw2[2] = PKW(P1, 4), pw2[3] = PKW(P1, 6), pw2); \
    VRD(3); SBAR3(); GAPA(C0 = __builtin_amdgcn_mfma_f32_32x32x16_bf16(kf[6], qr[3], C0, 0, 0, 0),   P1[10], P1[11], P1[12], P1[13], pw3[0] = PKW(P1, 8), pw3[1] = PKW(P1, 10), pw3); \
    VRD(7); SBAR3(); GAPA(C1 = __builtin_amdgcn_mfma_f32_32x32x16_bf16(kf[7], qr[3], C1, 0, 0, 0),   P1[14], P1[15], 0.f, 0.f,       pw3[2] = PKW(P1, 12), pw3[3] = PKW(P1, 14), pw3); \
    l_reg += sacc; \
    if (GK) { DMA_K((t) + 3, sl_cur); } if (GV) { DMA_V((t) + 1, sl_next); } \
    CMASK(C0, C1, t); \
    { float a = MX3(C0[0], C0[1], C1[0]), b = MX3(C0[2], C0[3], C1[1]); a = MX3(a, C1[2], C1[3]); \
      _Pragma("unroll") for (int r = 4; r < 16; r += 4) { a = MX3(a, C0[r], C0[r + 1]); b = MX3(b, C0[r + 2], C0[r + 3]); a = MX3(a, C1[r], C1[r + 1]); b = MX3(b, C1[r + 2], C1[r + 3]); } \
      float rm = xor32_max(__builtin_fmaxf(a, b)); \
      resc = false; \
      if (__builtin_expect(__any(rm > (float)THRL), 0)) { const float dl = __builtin_fmaxf(rm, 0.f); mhat += dl; \
        _Pragma("unroll") for (int r = 0; r < 16; ++r) { C0[r] -= dl; C1[r] -= dl; } \
        _Pragma("unroll") for (int r = 0; r < 16; ++r) negm[r] = -mhat; asm volatile("" : "+v"(negm)); \
        const float f = __builtin_amdgcn_exp2f(-dl); l_reg *= f; if (hi == 0) wsf[r32] = f; resc = true; } } \
    SBAR3(); \
    GAPB(o[0] = __builtin_amdgcn_mfma_f32_32x32x16_bf16(PAF(0), VFR(0), o[0], 0, 0, 0), C0, 0); \
    GAPB(o[1] = __builtin_amdgcn_mfma_f32_32x32x16_bf16(PAF(0), VFR(4), o[1], 0, 0, 0), C0, 4); \
    KRD(GL, 0); GAPB(o[0] = __builtin_amdgcn_mfma_f32_32x32x16_bf16(PAF(1), VFR(1), o[0], 0, 0, 0), C0, 8); \
    KRD(GL, 1); GAPB(o[1] = __builtin_amdgcn_mfma_f32_32x32x16_bf16(PAF(1), VFR(5), o[1], 0, 0, 0), C0, 12); \
    KRD(GL, 2); GAPB(o[0] = __builtin_amdgcn_mfma_f32_32x32x16_bf16(PAF(2), VFR(2), o[0], 0, 0, 0), C1, 0); \
    KRD(GL, 3); GAPB(o[1] = __builtin_amdgcn_mfma_f32_32x32x16_bf16(PAF(2), VFR(6), o[1], 0, 0, 0), C1, 4); \
    GAPB(o[0] = __builtin_amdgcn_mfma_f32_32x32x16_bf16(PAF(3), VFR(3), o[0], 0, 0, 0), C1, 8); \
    GAPB(o[1] = __builtin_amdgcn_mfma_f32_32x32x16_bf16(PAF(3), VFR(7), o[1], 0, 0, 0), C1, 12); \
    } while (0)
#define ENDW(tt) do { if ((tt) + 3 < NT) { WAIT_BAR3(2); } else if ((tt) + 2 < NT) { WAIT_BAR3(1); } else { WAIT_BAR3(0); } } while (0)
  int t = 1;
#pragma unroll 1
  for (; t + 1 < NT; t += 2) {
    STEP(pB0, pB1, pA0, pA1, t, (t + 3 < NT), (t + 1 < NT), (t + 1 < NT));       ENDW(t);     RESC(); ROT();
    STEP(pA0, pA1, pB0, pB1, t + 1, (t + 4 < NT), (t + 2 < NT), (t + 2 < NT));   ENDW(t + 1); RESC(); ROT();
  }
#define TAIL(P0, P1, SLOT) do { float sacc = P0[0] + P0[1]; _Pragma("unroll") for (int r = 2; r < 16; ++r) sacc += P0[r]; _Pragma("unroll") for (int r = 0; r < 16; ++r) sacc += P1[r]; l_reg += sacc; \
    pw0 = (u32x4){PKW(P0, 0), PKW(P0, 2), PKW(P0, 4), PKW(P0, 6)}; pw1 = (u32x4){PKW(P0, 8), PKW(P0, 10), PKW(P0, 12), PKW(P0, 14)}; pw2 = (u32x4){PKW(P1, 0), PKW(P1, 2), PKW(P1, 4), PKW(P1, 6)}; pw3 = (u32x4){PKW(P1, 8), PKW(P1, 10), PKW(P1, 12), PKW(P1, 14)}; \
    SBAR3(); pv(o, vb0 + (SLOT), PAF(0), PAF(1), PAF(2), PAF(3)); } while (0)
  if (Knext) {
    const bf16* ks2 = Knext + (long)lane * 64 + wid * 8;
#define TJ2(x) ((long)(__builtin_amdgcn_readfirstlane(TTnext[(x)]) & 63) * 4096)
    glds16(ks2 + TJ2(0), (unsigned)__builtin_amdgcn_readfirstlane(kdst)); glds16(ks2 + TJ2(1), (unsigned)__builtin_amdgcn_readfirstlane(kdst + SLOTB)); glds16(ks2 + TJ2(2), (unsigned)__builtin_amdgcn_readfirstlane(kdst + 2 * SLOTB));
    if (Vnext) glds16(Vnext + (long)(16 * (wid & 3) + (lane >> 2)) * 64 + (wid >> 2) * 32 + (lane & 3) * 8 + TJ2(0), (unsigned)__builtin_amdgcn_readfirstlane(lds0 + A_VX + wid * 1024));
#undef TJ2
  }
  if (NT & 1) { TAIL(pA0, pA1, sl_prev); }
  else { STEP(pB0, pB1, pA0, pA1, NT - 1, false, false, false); RESC(); TAIL(pB0, pB1, sl_cur); }
#undef TAIL
#undef PKW
#undef PAF
#undef VFR
#undef PIN
#undef MX3
#undef GAPA
#undef GAPB
#undef EX
#undef VRD
#undef KRD
#undef STEP
#undef ENDW
  l_reg = xor32_sum(l_reg);
  if (hi == 0) wsf[32 + r32] = gate * __builtin_amdgcn_rcpf(l_reg);
  asm volatile("s_waitcnt lgkmcnt(0)" ::: "memory");
  { LAS float* stg = (LAS float*)(L + A_OST) + wid * 2048;
#pragma unroll
    for (int r = 0; r < 16; ++r) { const int orow = crow(r, hi); const float fl = wsf[32 + orow];
#pragma unroll
      for (int d0 = 0; d0 < 2; ++d0) { LAS float* p = stg + orow * 64 + d0 * 32 + r32; const float v = o[d0][r] * fl; *p = first_write ? v : (*p + v); } } }
  asm volatile("s_waitcnt lgkmcnt(0)\n\ts_barrier" ::: "memory");
#undef TJ
#undef DMA_K
#undef DMA_V
#undef CMASK
#undef START
#undef RESC
#undef ROT
}
}

__device__ __forceinline__ void nsa_unit_v3(LAS unsigned char* L, const MixPtrs& P, int b, int g, int c, int tid_in) {
    int tid_l = tid_in; asm volatile("" : "+v"(tid_l));
    const int tid = tid_l, lane = tid & 63, w = __builtin_amdgcn_readfirstlane(tid >> 6);
    const int r = lane & 31, h = lane >> 5, head = w >> 1, qi = (w & 1) * 32 + r, t = c * 64 + qi;
    const size_t row = (size_t)b * SEQ + t;
    LAS unsigned* SEL = (LAS unsigned*)(L + ns3::A_SEL); LAS int* TTS = (LAS int*)(L + ns3::A_TTS); LAS int* TTW = (LAS int*)(L + ns3::A_TTW);
    const size_t kvbase = (size_t)(b * 2 + g) * SEQ * 64, ccbase = (size_t)(b * 2 + g) * 128 * 64;
    const int skey = tid >> 3, sch = tid & 7, soff = tile_off(skey, sch);
    { const unsigned lds0 = (unsigned)(uintptr_t)L;
      ns3::glds16(MP_KS + kvbase + (long)lane * 64 + w * 8, (unsigned)__builtin_amdgcn_readfirstlane(lds0 + ns3::A_K + w * 1024));
      ns3::glds16(MP_VS + kvbase + (long)(16 * (w & 3) + (lane >> 2)) * 64 + (w >> 2) * 32 + (lane & 3) * 8, (unsigned)__builtin_amdgcn_readfirstlane(lds0 + ns3::A_V + w * 1024)); }
    bf16x8v qf[4];
    { const bf16* qp = MP_QN + row * 512 + (g * 4 + head) * 64 + 8 * h;
#pragma unroll
      for (int ks = 0; ks < 4; ++ks) qf[ks] = *(const bf16x8v*)(qp + 16 * ks); }
    const float* gp = MP_GATE + row * 32 + g * 4 + head;
    float one = 1.f; asm volatile("" : "+v"(one));
    const float gate_c = __builtin_amdgcn_rcpf(one + __expf(-gp[0])), gate_s = __builtin_amdgcn_rcpf(one + __expf(-gp[8])), gate_w = __builtin_amdgcn_rcpf(one + __expf(-gp[16]));
    f32x16 oacc[2];
    const bool two = c >= 16;
    {
        const bf16* kc = MP_KC + ccbase; const bf16* vc = MP_VC + ccbase;
        const int o1 = two ? 4096 : 0;
        const v4u k0 = *(const v4u*)(kc + tid * 8), v0 = *(const v4u*)(vc + tid * 8), k1 = *(const v4u*)(kc + o1 + tid * 8), v1 = *(const v4u*)(vc + o1 + tid * 8);
        LBAR();
        *(LAS v4u*)(L + 8192 + soff) = k0; *(LAS v4u*)(L + 16384 + soff) = v0; *(LAS v4u*)(L + 32768 + soff) = k1; *(LAS v4u*)(L + 40960 + soff) = v1;
        if (tid < 64) SEL[tid] = 0u;
        LBAR();
        f32x16 s0, s1, s2, s3;
        { bf16x8v kfa[8]; k_load(L + 8192, r, h, kfa); SBAR(); qk_mma(kfa, qf, s0, s1); }
        const int nlim = (t >= 31) ? (((t - 31) >> 4) < 126 ? ((t - 31) >> 4) : 126) : -1;
        if (two) {
            { bf16x8v kfb[8]; k_load(L + 32768, r, h, kfb); SBAR(); qk_mma(kfb, qf, s2, s3); }
            float mxv[4] = {-1e20f, -1e20f, -1e20f, -1e20f};
#pragma unroll
            for (int e = 0; e < 16; ++e) { const int cr = (e & 3) + 8 * (e >> 2) + 4 * h;
                s0[e] = (cr <= nlim) ? s0[e] : -1e30f; s1[e] = (cr + 32 <= nlim) ? s1[e] : -1e30f;
                s2[e] = (cr + 64 <= nlim) ? s2[e] : -1e30f; s3[e] = (cr + 96 <= nlim) ? s3[e] : -1e30f;
                mxv[e & 3] = max3f(max3f(mxv[e & 3], s0[e], s1[e]), s2[e], s3[e]); }
            const float mx = xor32_max(max3f(mxv[0], mxv[1], max2f(mxv[2], mxv[3])));
            float lsv[4] = {0.f, 0.f, 0.f, 0.f};
#pragma unroll
            for (int e = 0; e < 16; ++e) { s0[e] = __builtin_amdgcn_exp2f(s0[e] - mx); s1[e] = __builtin_amdgcn_exp2f(s1[e] - mx); s2[e] = __builtin_amdgcn_exp2f(s2[e] - mx); s3[e] = __builtin_amdgcn_exp2f(s3[e] - mx);
                lsv[e & 3] += (s0[e] + s1[e]) + (s2[e] + s3[e]); }
            const float ls = xor32_sum((lsv[0] + lsv[1]) + (lsv[2] + lsv[3]));
            const float il = (ls > 0.f) ? __builtin_amdgcn_rcpf(ls) : 0.f;
#pragma unroll
            for (int e = 0; e < 16; ++e) { s0[e] *= il; s1[e] *= il; s2[e] *= il; s3[e] *= il; }
        } else {
            float mxv[4] = {-1e20f, -1e20f, -1e20f, -1e20f};
#pragma unroll
            for (int e = 0; e < 16; ++e) { const int cr = (e & 3) + 8 * (e >> 2) + 4 * h;
                s0[e] = (cr <= nlim) ? s0[e] : -1e30f; s1[e] = (cr + 32 <= nlim) ? s1[e] : -1e30f;
                mxv[e & 3] = max3f(mxv[e & 3], s0[e], s1[e]); }
            const float mx = xor32_max(max3f(mxv[0], mxv[1], max2f(mxv[2], mxv[3])));
            float lsv[4] = {0.f, 0.f, 0.f, 0.f};
#pragma unroll
            for (int e = 0; e < 16; ++e) { s0[e] = __builtin_amdgcn_exp2f(s0[e] - mx); s1[e] = __builtin_amdgcn_exp2f(s1[e] - mx); lsv[e & 3] += s0[e] + s1[e]; s2[e] = 0.f; s3[e] = 0.f; }
            const float ls = xor32_sum((lsv[0] + lsv[1]) + (lsv[2] + lsv[3]));
            const float il = (ls > 0.f) ? __builtin_amdgcn_rcpf(ls) : 0.f;
#pragma unroll
            for (int e = 0; e < 16; ++e) { s0[e] *= il; s1[e] *= il; }
        }
        if (two) { LAS float* IMP = (LAS float*)(L + ns3::A_IMP) + (w * 32 + r) * 33; float plprev = 0.f;
#pragma unroll
          for (int x = 0; x < 16; ++x) {
              const f32x16& S = (x < 4) ? s0 : ((x < 8) ? s1 : ((x < 12) ? s2 : s3)); const int g4 = (x & 3) * 4;
              const float own = (S[g4] + S[g4 + 1]) + (S[g4 + 2] + S[g4 + 3]);
              const float pl = shx(S[g4 + 3], 32, lane);
              if (h == 1) IMP[2 * x + 1] = own + pl; else IMP[2 * x] = own + plprev;
              plprev = pl;
          }
        }
        oacc[0] = (f32x16){0.f, 0.f, 0.f, 0.f, 0.f, 0.f, 0.f, 0.f, 0.f, 0.f, 0.f, 0.f, 0.f, 0.f, 0.f, 0.f}; oacc[1] = oacc[0];
        { bf16x8v vfa[8]; v_load(L + 16384, lane, vfa); SBAR(); pv_mma(vfa, s0, s1, oacc); }
        if (two) { bf16x8v vfb[8]; v_load(L + 40960, lane, vfb); SBAR(); pv_mma(vfb, s2, s3, oacc); }
    }
    if (two) LBAR();
    { const int i = tid & 63, jg = tid >> 6; const LAS float* I8 = (const LAS float*)(L + ns3::A_IMP); LAS float* IMS = (LAS float*)(L + ns3::A_IMS);
      if (two) {
#pragma unroll
      for (int jj = 0; jj < 4; ++jj) { const int j = 4 * jg + jj; const int wq = (i >> 5), rq = i & 31;
          const float sv = (I8[((0 + wq) * 32 + rq) * 33 + j] + I8[((2 + wq) * 32 + rq) * 33 + j]) + (I8[((4 + wq) * 32 + rq) * 33 + j] + I8[((6 + wq) * 32 + rq) * 33 + j]);
          ((LAS unsigned*)IMS)[i * 36 + j] = (__builtin_bit_cast(unsigned, sv) & ~31u) | (unsigned)(31 - j); }
      LBAR(); }
      unsigned bits = 0u;
      if (c + 1 <= 16) { if (jg == 0) bits = (1u << (c + 1)) - 1u; }
      else { if (jg == 0) bits = 1u | (1u << c) | (1u << (c - 1));
          { unsigned iv[32]; const LAS unsigned* IMU = (const LAS unsigned*)IMS;
#pragma unroll
            for (int q8 = 0; q8 < 8; ++q8) { const v4u x = *(const LAS v4u*)(IMU + i * 36 + 4 * q8); iv[4 * q8] = x.x; iv[4 * q8 + 1] = x.y; iv[4 * q8 + 2] = x.z; iv[4 * q8 + 3] = x.w; }
#pragma unroll
            for (int jj = 0; jj < 4; ++jj) { const int j = 4 * jg + jj; const unsigned vj = IMU[i * 36 + j]; int rank = 0;
#pragma unroll
                for (int i2 = 1; i2 < 30; ++i2) rank += (i2 <= c - 2 && iv[i2] > vj) ? 1 : 0;
                if (j >= 1 && j <= c - 2 && rank < 13) bits |= 1u << j; } } }
      if (bits) atomicOr((unsigned*)&SEL[i], bits);
      LBAR();
      if (w == 0) { unsigned so = SEL[lane];
#pragma unroll
          for (int o2 = 32; o2; o2 >>= 1) so |= shxu(so, o2, lane);
          { so &= (c >= 31) ? 0xffffffffu : ((2u << c) - 1u);
            const int n = __builtin_popcount(so), nt = (n < 4) ? 4 : n;
            if (lane < 32 && ((so >> lane) & 1u)) TTS[__builtin_popcount(so & ((1u << lane) - 1u))] = lane;
            if (lane >= n && lane < nt + 2) TTS[lane] = 128;
            const int j0 = (c - 8 > 0) ? c - 8 : 0, m2 = 1 + (c - j0), mt = (m2 < 4) ? 4 : m2;
            if (lane == 0) { TTS[46] = nt; TTW[0] = 64 + c; TTW[14] = mt; }
            else if (lane < m2) TTW[lane] = 64 + j0 + lane - 1;
            else if (lane < mt) TTW[lane] = 128; } }
      LBAR();
    }
    const unsigned mysel = SEL[qi]; const int nts = TTS[46], ntw = TTW[14];
    { LAS float* stg = (LAS float*)(L + ns3::A_OST) + w * 2048 + r * 64 + 4 * h;
#pragma unroll
      for (int db = 0; db < 2; ++db)
#pragma unroll
          for (int g4 = 0; g4 < 4; ++g4) *(LAS f32x4*)(stg + db * 32 + g4 * 8) = (f32x4){oacc[db][4 * g4] * gate_c, oacc[db][4 * g4 + 1] * gate_c, oacc[db][4 * g4 + 2] * gate_c, oacc[db][4 * g4 + 3] * gate_c}; }
#if PROBE_SC == 22
    const unsigned st0_ = (unsigned)__builtin_amdgcn_s_memrealtime();
#endif
    ns3::stream<8, 0>(L, MP_KS + kvbase, MP_VS + kvbase, TTS, nts, qf, lane, w, mysel, qi, t, c, gate_s, false, MP_KW + kvbase, TTW, false, true, MP_VW + kvbase);
    ns3::stream<8, 1>(L, MP_KW + kvbase, MP_VW + kvbase, TTW, ntw, qf, lane, w, mysel, qi, t, c, gate_w, false, nullptr, nullptr, true, false, nullptr, true);
#if PROBE_SC == 22
    if (tid == 0) { LAS unsigned* pm_ = (LAS unsigned*)(L + MISC_OFF) + 210; pm_[0] += (unsigned)__builtin_amdgcn_s_memrealtime() - st0_; pm_[1] += (unsigned)(nts + ntw); }
#endif
    { const LAS float* stg = (const LAS float*)(L + ns3::A_OST) + w * 2048; bf16* yb = MP_Y + ((size_t)b * SEQ + c * 64 + (w & 1) * 32) * DM + (g * 4 + head) * 64;
#pragma unroll
      for (int i4 = 0; i4 < 4; ++i4) { const int rr = i4 * 8 + (lane >> 3), ch = lane & 7; const f32x4 a = *(const LAS f32x4*)(stg + rr * 64 + ch * 8), bq = *(const LAS f32x4*)(stg + rr * 64 + ch * 8 + 4);
          v4u wv; wv.x = cvtpk(a.x, a.y); wv.y = cvtpk(a.z, a.w); wv.z = cvtpk(bq.x, bq.y); wv.w = cvtpk(bq.z, bq.w);
          *(v4u*)(yb + (size_t)rr * DM + ch * 8) = wv; } }
}

#define MFMA16(a, b, c) __builtin_amdgcn_mfma_f32_16x16x32_bf16((a), (b), (c), 0, 0, 0)
constexpr size_t WS_QC = 422 * MiB, WS_KC2 = 454 * MiB, WS_END2 = 486 * MiB; static_assert(WS_END2 <= WS_PART, "row-partial buffers follow");
#define MP_QC ((const bf16*)(P.ws + WS_QC))
#define MP_KC2 ((const bf16*)(P.ws + WS_KC2))
__device__ __forceinline__ int img_off(int row, int ch) { return 256 * row + 16 * (ch ^ (((row & 3) << 2) | ((row >> 2) & 3))); }
constexpr int M2_IMG = 0, M2_SC = 98304, M2_DEN = 106496, M2_QN = 107520, M2_N = 107776, M2_SSQ = 108288;

__device__ __forceinline__ void mlstm_conv_item(unsigned char* ws, const float* conv_w, const float* conv_b, int b, int tg, int isk, int ch0) {
    {
        const bf16* src = (const bf16*)(ws + (isk ? WS_MK : WS_MQ)) + (size_t)b * SEQ * 512 + ch0;
        bf16* dst = (bf16*)(ws + (isk ? WS_KC2 : WS_QC)) + ((size_t)(b * 4 + (ch0 >> 7)) * SEQ) * 128 + (ch0 & 127);
        float wt[4][8], bs[8];
#pragma unroll
        for (int j = 0; j < 4; ++j) { const f32x4 a = *(const f32x4*)(conv_w + j * 1024 + isk * 512 + ch0), c2 = *(const f32x4*)(conv_w + j * 1024 + isk * 512 + ch0 + 4);
            wt[j][0] = a.x; wt[j][1] = a.y; wt[j][2] = a.z; wt[j][3] = a.w; wt[j][4] = c2.x; wt[j][5] = c2.y; wt[j][6] = c2.z; wt[j][7] = c2.w; }
        { const f32x4 a = *(const f32x4*)(conv_b + isk * 512 + ch0), c2 = *(const f32x4*)(conv_b + isk * 512 + ch0 + 4); bs[0] = a.x; bs[1] = a.y; bs[2] = a.z; bs[3] = a.w; bs[4] = c2.x; bs[5] = c2.y; bs[6] = c2.z; bs[7] = c2.w; }
        const float osc = isk ? 0.08838834764831845f : 1.f;
        const int t0 = tg * 16;
        float x0[8], x1[8], x2[8];
#pragma unroll
        for (int e = 0; e < 8; ++e) { x0[e] = 0.f; x1[e] = 0.f; x2[e] = 0.f; }
        if (t0 > 0) {
            const v4u a = __builtin_nontemporal_load((const v4u*)(src + (size_t)(t0 - 3) * 512)), c2 = __builtin_nontemporal_load((const v4u*)(src + (size_t)(t0 - 2) * 512)), d2 = __builtin_nontemporal_load((const v4u*)(src + (size_t)(t0 - 1) * 512));
            x0[0] = bflo(a.x); x0[1] = bfhi(a.x); x0[2] = bflo(a.y); x0[3] = bfhi(a.y); x0[4] = bflo(a.z); x0[5] = bfhi(a.z); x0[6] = bflo(a.w); x0[7] = bfhi(a.w);
            x1[0] = bflo(c2.x); x1[1] = bfhi(c2.x); x1[2] = bflo(c2.y); x1[3] = bfhi(c2.y); x1[4] = bflo(c2.z); x1[5] = bfhi(c2.z); x1[6] = bflo(c2.w); x1[7] = bfhi(c2.w);
            x2[0] = bflo(d2.x); x2[1] = bfhi(d2.x); x2[2] = bflo(d2.y); x2[3] = bfhi(d2.y); x2[4] = bflo(d2.z); x2[5] = bfhi(d2.z); x2[6] = bflo(d2.w); x2[7] = bfhi(d2.w);
        }
        v4u rows[16];
#pragma unroll
        for (int s = 0; s < 16; ++s) rows[s] = __builtin_nontemporal_load((const v4u*)(src + (size_t)(t0 + s) * 512));
#pragma unroll
        for (int s = 0; s < 16; ++s) {
            const v4u a = rows[s];
            const float x3[8] = {bflo(a.x), bfhi(a.x), bflo(a.y), bfhi(a.y), bflo(a.z), bfhi(a.z), bflo(a.w), bfhi(a.w)};
            float o[8];
#pragma unroll
            for (int e = 0; e < 8; ++e) { float v = bs[e] + wt[0][e] * x0[e] + wt[1][e] * x1[e] + wt[2][e] * x2[e] + wt[3][e] * x3[e]; v = v * __builtin_amdgcn_rcpf(1.f + __expf(-v)); o[e] = v * osc; x0[e] = x1[e]; x1[e] = x2[e]; x2[e] = x3[e]; }
            v4u wv; wv.x = cvtpk(o[0], o[1]); wv.y = cvtpk(o[2], o[3]); wv.z = cvtpk(o[4], o[5]); wv.w = cvtpk(o[6], o[7]);
            *(v4u*)(dst + (size_t)(t0 + s) * 128) = wv;
        }
    }
}
__device__ __forceinline__ void mlstm_conv_pass(unsigned char* ws, const float* conv_w, const float* conv_b, int gthread, int nthreads) {
    for (int idx = gthread; idx < BATCH * 128 * 128; idx += nthreads) { const int cc = idx & 127, tg = (idx >> 7) & 127, b = idx >> 14; mlstm_conv_item(ws, conv_w, conv_b, b, tg, cc >> 6, (cc & 63) * 8); }
}
__device__ __forceinline__ void mlstm_conv_unit(unsigned char* ws, const float* conv_w, const float* conv_b, int b, int hh, int tid) {
#pragma unroll 1
    for (int idx = tid; idx < 4096; idx += 512) mlstm_conv_item(ws, conv_w, conv_b, b, idx >> 5, (idx >> 4) & 1, hh * 128 + (idx & 15) * 8);
}

constexpr int M2_A = 112384, M2_PM = 120576, M2_F = 128768, M2_BL = 136960, M2_AMX = 137088, M2_MC = 137216;
__device__ __forceinline__ void mlstm_unit_mfma(LAS unsigned char* L, const MixPtrs& P, int b, int hh, int tid_in) {
    int tid_l = tid_in; asm volatile("" : "+v"(tid_l));
    const int tid = tid_l, lane = tid & 63, w = __builtin_amdgcn_readfirstlane(tid >> 6), l15 = lane & 15, kg = lane >> 4;
    const size_t rb = (size_t)b * SEQ;
    const bf16* QCp = MP_QC + ((size_t)(b * 4 + hh) * SEQ) * 128; const bf16* KCp = MP_KC2 + ((size_t)(b * 4 + hh) * SEQ) * 128;
    const bf16* Vp = MP_MV + rb * 512 + hh * 128; const bf16* Op = MP_MO + rb * 512 + hh * 128 + 16 * w + 4 * kg;
    bf16* Yp = MP_Y + rb * DM + 512 + hh * 128 + 16 * w + 4 * kg;
    LAS float* DEN = (LAS float*)(L + M2_DEN); LAS float* QN = (LAS float*)(L + M2_QN); LAS float* NV = (LAS float*)(L + M2_N); LAS float* SSQ = (LAS float*)(L + M2_SSQ);
    LAS float* SA = (LAS float*)(L + M2_A); LAS float* SPM = (LAS float*)(L + M2_PM); LAS float* SF = (LAS float*)(L + M2_F);
    LAS float* SBL = (LAS float*)(L + M2_BL); LAS float* SAMX = (LAS float*)(L + M2_AMX); LAS float* SMC = (LAS float*)(L + M2_MC);
    float zf = 0.f; asm volatile("" : "+v"(zf));
    f32x4 Cacc[8], nacc = {zf, zf, zf, zf};
#pragma unroll
    for (int i = 0; i < 8; ++i) Cacc[i] = (f32x4){zf, zf, zf, zf};
    const f32x4 gn = *(const f32x4*)(P.mnorm_g + hh * 128 + 16 * w + 4 * kg);
    const int r0s = tid >> 4, c0s = tid & 15, so0 = img_off(r0s, c0s), so1 = img_off(r0s + 32, c0s);
    v4u sq0, sq1, sk0, sk1, sv0, sv1;
    sq0 = *(const v4u*)(QCp + (size_t)r0s * 128 + c0s * 8); sq1 = *(const v4u*)(QCp + (size_t)(r0s + 32) * 128 + c0s * 8);
    sk0 = *(const v4u*)(KCp + (size_t)r0s * 128 + c0s * 8); sk1 = *(const v4u*)(KCp + (size_t)(r0s + 32) * 128 + c0s * 8);
    sv0 = *(const v4u*)(Vp + (size_t)r0s * 512 + c0s * 8);  sv1 = *(const v4u*)(Vp + (size_t)(r0s + 32) * 512 + c0s * 8);
    LBAR();
    { const float ib = P.i_bias[hh], fb = P.f_bias[hh]; const float* Gp = MP_GATE + rb * 32 + hh;
#pragma unroll 1
      for (int cc = w; cc < 32; cc += 8) { const int tk = 64 * cc + lane;
          const float il = Gp[(size_t)tk * 32 + 24] + ib, fx = Gp[(size_t)tk * 32 + 28] + fb; const float fl = fminf(fx, 0.f) - log1pf(__expf(-fabsf(fx)));
          float f = fl;
#pragma unroll
          for (int o = 1; o < 64; o <<= 1) { const float v = shi(f, lane - o); if (lane >= o) f += v; }
          const float a = il - f; float pm = a;
#pragma unroll
          for (int o = 1; o < 64; o <<= 1) { const float v = shi(pm, lane - o); if (lane >= o) pm = fmaxf(pm, v); }
          SA[tk] = a; SPM[tk] = pm; SF[tk] = f; if (lane == 63) { SBL[cc] = f; SAMX[cc] = pm; } } }
    *(LAS v4u*)(L + M2_IMG + so0) = sq0; *(LAS v4u*)(L + M2_IMG + so1) = sq1; *(LAS v4u*)(L + M2_IMG + 16384 + so0) = sk0; *(LAS v4u*)(L + M2_IMG + 16384 + so1) = sk1;
    *(LAS v4u*)(L + M2_IMG + 32768 + so0) = sv0; *(LAS v4u*)(L + M2_IMG + 32768 + so1) = sv1;
    if (tid < 128) NV[tid] = zf;
    LBAR();
    if (tid == 0) { float mcar = zf; for (int cc = 0; cc < 32; ++cc) { SMC[cc] = mcar; mcar = SBL[cc] + fmaxf(mcar, SAMX[cc]); } }
    LBAR();
#pragma unroll 1
    for (int c = 0; c < 32; ++c) {
        int lc = lane; asm volatile("" : "+v"(lc));
        const int l15 = lc & 15, kg = lc >> 4, q4 = l15 >> 2, p4 = l15 & 3;
        const int t0 = c * 64; const LAS unsigned char* Qi = L + M2_IMG + (c & 1) * 49152; const LAS unsigned char* Ki = Qi + 16384; const LAS unsigned char* Vi = Qi + 32768;
        if (c + 1 < 32) { const int tn = t0 + 64;
            sq0 = *(const v4u*)(QCp + (size_t)(tn + r0s) * 128 + c0s * 8); sq1 = *(const v4u*)(QCp + (size_t)(tn + r0s + 32) * 128 + c0s * 8);
            sk0 = *(const v4u*)(KCp + (size_t)(tn + r0s) * 128 + c0s * 8); sk1 = *(const v4u*)(KCp + (size_t)(tn + r0s + 32) * 128 + c0s * 8);
            sv0 = *(const v4u*)(Vp + (size_t)(tn + r0s) * 512 + c0s * 8);  sv1 = *(const v4u*)(Vp + (size_t)(tn + r0s + 32) * 512 + c0s * 8); }
        const float mc = SMC[c], mxa = fmaxf(mc, SAMX[c]); const float cs = __expf(mc - mxa);
        { const int tblk = w >> 1, t = 16 * tblk + l15; const int sb0 = 2 * (w & 1);
          bf16x8v ka[2][4], qb[4];
#pragma unroll
          for (int ks = 0; ks < 4; ++ks) { qb[ks] = *(const LAS bf16x8v*)(Qi + img_off(t, 4 * ks + kg)); ka[0][ks] = *(const LAS bf16x8v*)(Ki + img_off(16 * sb0 + l15, 4 * ks + kg)); ka[1][ks] = *(const LAS bf16x8v*)(Ki + img_off(16 * sb0 + 16 + l15, 4 * ks + kg)); }
          const float Mt = fmaxf(SPM[t0 + t], mc);
          const f32x4 as0 = *(const LAS f32x4*)(SA + t0 + 16 * sb0 + 4 * kg), as1 = *(const LAS f32x4*)(SA + t0 + 16 * sb0 + 16 + 4 * kg);
          const int tq = tid >> 3, dp = tid & 7; const v4u q0 = *(const LAS v4u*)(Qi + img_off(tq, 2 * dp)), q1 = *(const LAS v4u*)(Qi + img_off(tq, 2 * dp + 1));
          const LAS f32x4* np = (const LAS f32x4*)(NV + 16 * dp); const f32x4 n0 = np[0], n1 = np[1], n2 = np[2], n3 = np[3];
          SBAR();
          LAS unsigned char* SC = L + M2_SC;
#pragma unroll
          for (int sb = 0; sb < 2; ++sb) { const int sblk = sb0 + sb; f32x4 acc = {0.f, 0.f, 0.f, 0.f}; float rp = 0.f; v2u wv; wv.x = 0u; wv.y = 0u;
              if (sblk <= tblk) {
#pragma unroll
                  for (int ks = 0; ks < 4; ++ks) acc = MFMA16(ka[sb][ks], qb[ks], acc);
                  const f32x4 as = sb ? as1 : as0; float v[4];
#pragma unroll
                  for (int e = 0; e < 4; ++e) { const float x = acc[e] * __expf(as[e] - Mt); v[e] = (sblk == tblk && 4 * kg + e > l15) ? 0.f : x; }
                  rp = (v[0] + v[1]) + (v[2] + v[3]); wv.x = cvtpk(v[0], v[1]); wv.y = cvtpk(v[2], v[3]);
              }
              rp += shx(rp, 16, lane); rp += shx(rp, 32, lane);
              *(LAS v2u*)(SC + t * 128 + (((2 * sblk + (kg >> 1)) ^ (t & 7)) << 4) + 8 * (kg & 1)) = wv;
              if (kg == 0) DEN[sblk * 64 + t] = rp; }
          { float s = bflo(q0.x) * n0.x + bfhi(q0.x) * n0.y + bflo(q0.y) * n0.z + bfhi(q0.y) * n0.w + bflo(q0.z) * n1.x + bfhi(q0.z) * n1.y + bflo(q0.w) * n1.z + bfhi(q0.w) * n1.w
                    + bflo(q1.x) * n2.x + bfhi(q1.x) * n2.y + bflo(q1.y) * n2.z + bfhi(q1.y) * n2.w + bflo(q1.z) * n3.x + bfhi(q1.z) * n3.y + bflo(q1.w) * n3.z + bfhi(q1.w) * n3.w;
            s += shx(s, 1, lane); s += shx(s, 2, lane); s += shx(s, 4, lane);
            if (dp == 0) QN[tq] = s; } }
        LBAR();
        v2u og[4];
#pragma unroll
        for (int tb = 0; tb < 4; ++tb) og[tb] = *(const v2u*)(Op + (size_t)(t0 + 16 * tb + l15) * 512);
        bf16x8v vf[2]; f32x4 hv[4];
        { float pmt[4], ft[4], dnp[4], qn4[4]; bf16x8v Cfrag[4];
#pragma unroll
          for (int kp = 0; kp < 4; ++kp) { v4u a; a.x = cvtpk(Cacc[2 * kp].x, Cacc[2 * kp].y); a.y = cvtpk(Cacc[2 * kp].z, Cacc[2 * kp].w); a.z = cvtpk(Cacc[2 * kp + 1].x, Cacc[2 * kp + 1].y); a.w = cvtpk(Cacc[2 * kp + 1].z, Cacc[2 * kp + 1].w);
              Cfrag[kp] = __builtin_bit_cast(bf16x8v, a); }
#pragma unroll
          for (int ks = 0; ks < 2; ++ks) { const int r0 = 32 * ks + 8 * kg;
              const s16x4v lo = tr_read(Vi + 256 * (r0 + q4) + 16 * ((2 * w + (p4 >> 1)) ^ ((q4 << 2) | ((r0 >> 2) & 3))) + 8 * (p4 & 1));
              const s16x4v hi = tr_read(Vi + 256 * (r0 + 4 + q4) + 16 * ((2 * w + (p4 >> 1)) ^ ((q4 << 2) | (((r0 + 4) >> 2) & 3))) + 8 * (p4 & 1));
              vf[ks] = __builtin_shufflevector(lo, hi, 0, 1, 2, 3, 4, 5, 6, 7); }
#pragma unroll
          for (int tb = 0; tb < 4; ++tb) { const int t = 16 * tb + l15; pmt[tb] = SPM[t0 + t]; ft[tb] = SF[t0 + t]; dnp[tb] = (DEN[t] + DEN[64 + t]) + (DEN[128 + t] + DEN[192 + t]); qn4[tb] = QN[t]; }
#pragma unroll
          for (int tp = 0; tp < 2; ++tp) {
              bf16x8v sf[2][2]; v2u qlo[2][4], qhi[2][4];
#pragma unroll
              for (int t2 = 0; t2 < 2; ++t2) { const int t = 16 * (2 * tp + t2) + l15; const int swz = ((t & 3) << 2) | ((t >> 2) & 3);
#pragma unroll
                  for (int ks = 0; ks < 2; ++ks) sf[t2][ks] = *(const LAS bf16x8v*)(L + M2_SC + t * 128 + (((4 * ks + kg) ^ (t & 7)) << 4));
#pragma unroll
                  for (int kp = 0; kp < 4; ++kp) { qlo[t2][kp] = *(const LAS v2u*)(Qi + 256 * t + 16 * ((4 * kp + (kg >> 1)) ^ swz) + 8 * (kg & 1)); qhi[t2][kp] = *(const LAS v2u*)(Qi + 256 * t + 16 * ((4 * kp + 2 + (kg >> 1)) ^ swz) + 8 * (kg & 1)); } }
              SBAR();
#pragma unroll
              for (int t2 = 0; t2 < 2; ++t2) { const int tb = 2 * tp + t2; f32x4 an = {0.f, 0.f, 0.f, 0.f}, a2 = {0.f, 0.f, 0.f, 0.f};
#pragma unroll
                  for (int ks = 0; ks < 2; ++ks) an = MFMA16(vf[ks], sf[t2][ks], an);
#pragma unroll
                  for (int kp = 0; kp < 4; ++kp) { v4u qq; qq.x = qlo[t2][kp].x; qq.y = qlo[t2][kp].y; qq.z = qhi[t2][kp].x; qq.w = qhi[t2][kp].y; a2 = MFMA16(Cfrag[kp], __builtin_bit_cast(bf16x8v, qq), a2); }
                  const float Mt = fmaxf(pmt[tb], mc), wp = __expf(mc - Mt), emt = __expf(-ft[tb] - Mt);
                  const float dn = dnp[tb] + wp * qn4[tb];
                  const float idn = __builtin_amdgcn_rcpf(fmaxf(fabsf(dn), emt));
                  hv[tb] = (an + a2 * wp) * idn;
                  float ss = (hv[tb].x * hv[tb].x + hv[tb].y * hv[tb].y) + (hv[tb].z * hv[tb].z + hv[tb].w * hv[tb].w);
                  ss += shx(ss, 16, lane); ss += shx(ss, 32, lane);
                  if (kg == 0) SSQ[((c & 1) * 8 + w) * 64 + 16 * tb + l15] = ss; }
              SBAR();
          } }
        { bf16x8v vpf[2], wkf[2];
          f32x4 aw[2][2];
#pragma unroll
          for (int ks = 0; ks < 2; ++ks) { aw[ks][0] = *(const LAS f32x4*)(SA + t0 + 32 * ks + 8 * kg); aw[ks][1] = *(const LAS f32x4*)(SA + t0 + 32 * ks + 8 * kg + 4); }
#pragma unroll
          for (int ks = 0; ks < 2; ++ks) { float wkv[8]; unsigned vp[4], wp2[4]; const v4u vu = __builtin_bit_cast(v4u, vf[ks]); const unsigned vw[4] = {vu.x, vu.y, vu.z, vu.w};
#pragma unroll
              for (int j = 0; j < 8; ++j) wkv[j] = __expf(aw[ks][j >> 2][j & 3] - mxa);
#pragma unroll
              for (int j2 = 0; j2 < 4; ++j2) { vp[j2] = cvtpk(bflo(vw[j2]) * wkv[2 * j2], bfhi(vw[j2]) * wkv[2 * j2 + 1]); wp2[j2] = cvtpk(wkv[2 * j2], wkv[2 * j2 + 1]); }
              v4u a; a.x = vp[0]; a.y = vp[1]; a.z = vp[2]; a.w = vp[3]; vpf[ks] = __builtin_bit_cast(bf16x8v, a);
              v4u b2; b2.x = wp2[0]; b2.y = wp2[1]; b2.z = wp2[2]; b2.w = wp2[3]; wkf[ks] = __builtin_bit_cast(bf16x8v, b2); }
          nacc = nacc * cs;
#pragma unroll
          for (int ih = 0; ih < 2; ++ih) {
              bf16x8v kf[4][2];
#pragma unroll
              for (int i4 = 0; i4 < 4; ++i4)
#pragma unroll
                  for (int ks = 0; ks < 2; ++ks) { const int i = 4 * ih + i4, r0 = 32 * ks + 8 * kg;
                      const s16x4v lo = tr_read(Ki + 256 * (r0 + q4) + 16 * ((2 * i + (p4 >> 1)) ^ ((q4 << 2) | ((r0 >> 2) & 3))) + 8 * (p4 & 1));
                      const s16x4v hi = tr_read(Ki + 256 * (r0 + 4 + q4) + 16 * ((2 * i + (p4 >> 1)) ^ ((q4 << 2) | (((r0 + 4) >> 2) & 3))) + 8 * (p4 & 1));
                      kf[i4][ks] = __builtin_shufflevector(lo, hi, 0, 1, 2, 3, 4, 5, 6, 7); }
              SBAR();
#pragma unroll
              for (int i4 = 0; i4 < 4; ++i4) { const int i = 4 * ih + i4; Cacc[i] = Cacc[i] * cs;
#pragma unroll
                  for (int ks = 0; ks < 2; ++ks) Cacc[i] = MFMA16(kf[i4][ks], vpf[ks], Cacc[i]); }
              SBAR();
          }
          { bf16x8v kw[2];
#pragma unroll
            for (int ks = 0; ks < 2; ++ks) { const int r0 = 32 * ks + 8 * kg;
                const s16x4v lo = tr_read(Ki + 256 * (r0 + q4) + 16 * ((2 * w + (p4 >> 1)) ^ ((q4 << 2) | ((r0 >> 2) & 3))) + 8 * (p4 & 1));
                const s16x4v hi = tr_read(Ki + 256 * (r0 + 4 + q4) + 16 * ((2 * w + (p4 >> 1)) ^ ((q4 << 2) | (((r0 + 4) >> 2) & 3))) + 8 * (p4 & 1));
                kw[ks] = __builtin_shufflevector(lo, hi, 0, 1, 2, 3, 4, 5, 6, 7); }
            nacc = MFMA16(kw[0], wkf[0], nacc); nacc = MFMA16(kw[1], wkf[1], nacc); }
          if (l15 == 0) *(LAS f32x4*)(NV + 16 * w + 4 * kg) = nacc;
 }
        if (c + 1 < 32) { LAS unsigned char* Nx = L + M2_IMG + ((c + 1) & 1) * 49152;
            *(LAS v4u*)(Nx + so0) = sq0; *(LAS v4u*)(Nx + so1) = sq1; *(LAS v4u*)(Nx + 16384 + so0) = sk0; *(LAS v4u*)(Nx + 16384 + so1) = sk1; *(LAS v4u*)(Nx + 32768 + so0) = sv0; *(LAS v4u*)(Nx + 32768 + so1) = sv1; }
        LBAR();
#pragma unroll
        for (int tb = 0; tb < 4; ++tb) { const int t = 16 * tb + l15; const LAS float* sp = SSQ + (c & 1) * 512 + t;
            const float tot = ((sp[0] + sp[64]) + (sp[128] + sp[192])) + ((sp[256] + sp[320]) + (sp[384] + sp[448]));
            const float rn = __frsqrt_rn(tot * (1.f / 128.f) + EPS);
            const float y0 = hv[tb].x * rn * gn.x * sigmoidf_(bflo(og[tb].x)), y1 = hv[tb].y * rn * gn.y * sigmoidf_(bfhi(og[tb].x)), y2 = hv[tb].z * rn * gn.z * sigmoidf_(bflo(og[tb].y)), y3 = hv[tb].w * rn * gn.w * sigmoidf_(bfhi(og[tb].y));
            v2u wv; wv.x = cvtpk(y0, y1); wv.y = cvtpk(y2, y3);
            *(v2u*)(Yp + (size_t)(t0 + t) * DM) = wv; }
    }
    LBAR();
}

__device__ __forceinline__ bf16x8v pack8(const f32x16& x, int s2) { v4u p; p.x = cvtpk(x[8 * s2 + 0], x[8 * s2 + 1]); p.y = cvtpk(x[8 * s2 + 2], x[8 * s2 + 3]); p.z = cvtpk(x[8 * s2 + 4], x[8 * s2 + 5]); p.w = cvtpk(x[8 * s2 + 6], x[8 * s2 + 7]); return __builtin_bit_cast(bf16x8v, p); }
__device__ __forceinline__ int tr32_off(int lane, int c, int ks, int t) { const int h = lane >> 5, blk = (lane >> 4) & 1, q = (lane & 15) >> 2, p = lane & 3; return img_off(16 * ks + 8 * h + 4 * t + q, 4 * c + 2 * blk + (p >> 1)) + 8 * (p & 1); }
__device__ __forceinline__ bf16x8v tr32_frag(const LAS unsigned char* img, int lane, int c, int ks) { const s16x4v lo = tr_read(img + tr32_off(lane, c, ks, 0)), hi = tr_read(img + tr32_off(lane, c, ks, 1)); return __builtin_shufflevector(lo, hi, 0, 1, 2, 3, 4, 5, 6, 7); }
constexpr int M3_DEN = M2_DEN  , M3_SSQ = M2_SSQ  ;

__device__ __forceinline__ void mlstm_unit_v3(LAS unsigned char* L, const MixPtrs& P, int b, int hh, int tid_in) {
    int tid_l = tid_in; asm volatile("" : "+v"(tid_l));
    const int tid = tid_l, lane = tid & 63, w = __builtin_amdgcn_readfirstlane(tid >> 6);
    const size_t rb = (size_t)b * SEQ;
    const bf16* QCp = MP_QC + ((size_t)(b * 4 + hh) * SEQ) * 128; const bf16* KCp = MP_KC2 + ((size_t)(b * 4 + hh) * SEQ) * 128;
    const bf16* Vp = MP_MV + rb * 512 + hh * 128;
    LAS float* DEN = (LAS float*)(L + M3_DEN); LAS float* QN = (LAS float*)(L + M2_QN); LAS float* NV = (LAS float*)(L + M2_N); LAS float* SSQ = (LAS float*)(L + M3_SSQ);
    LAS float* SA = (LAS float*)(L + M2_A); LAS float* SPM = (LAS float*)(L + M2_PM); LAS float* SF = (LAS float*)(L + M2_F);
    LAS float* SBL = (LAS float*)(L + M2_BL); LAS float* SAMX = (LAS float*)(L + M2_AMX); LAS float* SMC = (LAS float*)(L + M2_MC);
    float zf = 0.f; asm volatile("" : "+v"(zf));
    const bool isCD = w < 4; const int jw = w & 3;
    f32x16 Cacc[4]; bf16x8v vfk[4];
#pragma unroll
    for (int i = 0; i < 4; ++i) { vfk[i] = (bf16x8v){0, 0, 0, 0, 0, 0, 0, 0};
#pragma unroll
        for (int e = 0; e < 16; ++e) Cacc[i][e] = zf; }
    const int r0s = tid >> 4, c0s = tid & 15, so0 = img_off(r0s, c0s), so1 = img_off(r0s + 32, c0s);
    v4u sq0, sq1, sk0, sk1, sv0, sv1;
    sq0 = __builtin_nontemporal_load((const v4u*)(QCp + (size_t)r0s * 128 + c0s * 8)); sq1 = __builtin_nontemporal_load((const v4u*)(QCp + (size_t)(r0s + 32) * 128 + c0s * 8));
    sk0 = __builtin_nontemporal_load((const v4u*)(KCp + (size_t)r0s * 128 + c0s * 8)); sk1 = __builtin_nontemporal_load((const v4u*)(KCp + (size_t)(r0s + 32) * 128 + c0s * 8));
    sv0 = __builtin_nontemporal_load((const v4u*)(Vp + (size_t)r0s * 512 + c0s * 8));  sv1 = __builtin_nontemporal_load((const v4u*)(Vp + (size_t)(r0s + 32) * 512 + c0s * 8));
    LBAR();
    { const float ib = P.i_bias[hh], fb = P.f_bias[hh]; const float* Gp = MP_GATE + rb * 32 + hh;
#pragma unroll 1
      for (int cc = w; cc < 32; cc += 8) { const int tk = 64 * cc + lane;
          const float il = Gp[(size_t)tk * 32 + 24] + ib, fx = Gp[(size_t)tk * 32 + 28] + fb; const float fl = fminf(fx, 0.f) - log1pf(__expf(-fabsf(fx)));
          float f = fl;
#pragma unroll
          for (int o = 1; o < 64; o <<= 1) { const float v = shi(f, lane - o); if (lane >= o) f += v; }
          const float a = il - f; float pm = a;
#pragma unroll
          for (int o = 1; o < 64; o <<= 1) { const float v = shi(pm, lane - o); if (lane >= o) pm = fmaxf(pm, v); }
          SA[tk] = a; SPM[tk] = pm; SF[tk] = f; if (lane == 63) { SBL[cc] = f; SAMX[cc] = pm; } } }
    *(LAS v4u*)(L + M2_IMG + so0) = sq0; *(LAS v4u*)(L + M2_IMG + so1) = sq1; *(LAS v4u*)(L + M2_IMG + 16384 + so0) = sk0; *(LAS v4u*)(L + M2_IMG + 16384 + so1) = sk1;
    *(LAS v4u*)(L + M2_IMG + 32768 + so0) = sv0; *(LAS v4u*)(L + M2_IMG + 32768 + so1) = sv1;
    if (tid < 128) { NV[tid] = zf; ((LAS float*)(L + 141440))[tid] = P.mnorm_g[hh * 128 + tid]; }
    LBAR();
    if (tid == 0) { float mcar = zf; for (int cc = 0; cc < 32; ++cc) { SMC[cc] = mcar; mcar = SBL[cc] + fmaxf(mcar, SAMX[cc]); } }
    LBAR();
    f32x16 hv[2];
    hv[0] = Cacc[0]; hv[1] = Cacc[0];
#define MLSTM_NORM_STORE(cc, STAGE) do { const int r32_ = lane & 31, hi_ = lane >> 5; v2u og[2][4]; \
        { const bf16* Op_ = MP_MO + rb * 512 + hh * 128 + 32 * jw + 4 * hi_; \
          _Pragma("unroll") for (int tt = 0; tt < 2; ++tt) _Pragma("unroll") for (int g = 0; g < 4; ++g) og[tt][g] = *(const v2u*)(Op_ + (size_t)((cc) * 64 + 32 * tt + r32_) * 512 + 8 * g); } \
        bf16* Yp = MP_Y + rb * DM + 512 + hh * 128 + 32 * jw + 4 * hi_; const LAS float* gnp = (const LAS float*)(L + 141440) + 32 * jw + 4 * hi_; \
        STAGE; \
        f32x4 gn4[4]; \
        _Pragma("unroll") for (int g = 0; g < 4; ++g) gn4[g] = *(const LAS f32x4*)(gnp + 8 * g); \
        _Pragma("unroll") for (int tt = 0; tt < 2; ++tt) { const int t = 32 * tt + r32_; const LAS float* sp = SSQ + ((cc) & 1) * 256 + t; \
            const float rn = __frsqrt_rn(((sp[0] + sp[64]) + (sp[128] + sp[192])) * (1.f / 128.f) + EPS); \
            _Pragma("unroll") for (int g = 0; g < 4; ++g) { const float y0 = hv[tt][4 * g] * rn * gn4[g].x * sigmoidf_(bflo(og[tt][g].x)), y1 = hv[tt][4 * g + 1] * rn * gn4[g].y * sigmoidf_(bfhi(og[tt][g].x)); \
                const float y2 = hv[tt][4 * g + 2] * rn * gn4[g].z * sigmoidf_(bflo(og[tt][g].y)), y3 = hv[tt][4 * g + 3] * rn * gn4[g].w * sigmoidf_(bfhi(og[tt][g].y)); \
                v2u wv; wv.x = cvtpk(y0, y1); wv.y = cvtpk(y2, y3); \
                *(v2u*)(Yp + (size_t)((cc) * 64 + t) * DM + 8 * g) = wv; } } } while (0)
#pragma unroll 1
    for (int c = 0; c < 32; ++c) {
        int lc = lane; asm volatile("" : "+v"(lc));
        const int r32 = lc & 31, hi = lc >> 5;
        const int t0 = c * 64; const LAS unsigned char* Qi = L + M2_IMG + (c & 1) * 49152; const LAS unsigned char* Ki = Qi + 16384; const LAS unsigned char* Vi = Qi + 32768;
        const LAS unsigned char* Kp = L + M2_IMG + ((c + 1) & 1) * 49152 + 16384;
#define MLSTM_STAGE_LOADS() do { if (c + 1 < 32) { const int tn = t0 + 64; \
            sq0 = __builtin_nontemporal_load((const v4u*)(QCp + (size_t)(tn + r0s) * 128 + c0s * 8)); sq1 = __builtin_nontemporal_load((const v4u*)(QCp + (size_t)(tn + r0s + 32) * 128 + c0s * 8)); \
            sk0 = __builtin_nontemporal_load((const v4u*)(KCp + (size_t)(tn + r0s) * 128 + c0s * 8)); sk1 = __builtin_nontemporal_load((const v4u*)(KCp + (size_t)(tn + r0s + 32) * 128 + c0s * 8)); \
            sv0 = __builtin_nontemporal_load((const v4u*)(Vp + (size_t)(tn + r0s) * 512 + c0s * 8));  sv1 = __builtin_nontemporal_load((const v4u*)(Vp + (size_t)(tn + r0s + 32) * 512 + c0s * 8)); } } while (0)
        if (!isCD || c == 0) MLSTM_STAGE_LOADS();
        const float mc = SMC[c];
        if (isCD) {
            if (c > 0) { const int t0p = t0 - 64; const float mcp = SMC[c - 1], mxap = fmaxf(mcp, SAMX[c - 1]); const float csp = __expf(mcp - mxap);
                bf16x8v vfp[4];
#pragma unroll
                for (int ks = 0; ks < 4; ++ks) { const f32x4 a0 = *(const LAS f32x4*)(SA + t0p + 16 * ks + 8 * hi), a1 = *(const LAS f32x4*)(SA + t0p + 16 * ks + 8 * hi + 4);
                    const float wk[8] = {__expf(a0.x - mxap), __expf(a0.y - mxap), __expf(a0.z - mxap), __expf(a0.w - mxap), __expf(a1.x - mxap), __expf(a1.y - mxap), __expf(a1.z - mxap), __expf(a1.w - mxap)};
                    const v4u vu = __builtin_bit_cast(v4u, vfk[ks]); v4u o4;
                    o4.x = cvtpk(bflo(vu.x) * wk[0], bfhi(vu.x) * wk[1]); o4.y = cvtpk(bflo(vu.y) * wk[2], bfhi(vu.y) * wk[3]); o4.z = cvtpk(bflo(vu.z) * wk[4], bfhi(vu.z) * wk[5]); o4.w = cvtpk(bflo(vu.w) * wk[6], bfhi(vu.w) * wk[7]);
                    vfp[ks] = __builtin_bit_cast(bf16x8v, o4); }
#pragma unroll
                for (int dt = 0; dt < 4; ++dt) { bf16x8v kf[4];
#pragma unroll
                    for (int ks = 0; ks < 4; ++ks) kf[ks] = tr32_frag(Kp, lc, dt, ks);
                    SBAR();
#pragma unroll
                    for (int e = 0; e < 16; ++e) Cacc[dt][e] *= csp;
#pragma unroll
                    for (int ks = 0; ks < 4; ++ks) Cacc[dt] = MFMA32(kf[ks], vfp[ks], Cacc[dt]);
                    SBAR(); }
                MLSTM_NORM_STORE(c - 1, MLSTM_STAGE_LOADS()); }
        } else if (jw != 2) {
            const int st = (jw == 3) ? 1 : 0, tt = (jw == 0) ? 0 : 1; const int t = 32 * tt + r32;
            const float Mt = fmaxf(SPM[t0 + t], mc);
            f32x4 as4[4];
#pragma unroll
            for (int g = 0; g < 4; ++g) as4[g] = *(const LAS f32x4*)(SA + t0 + 32 * st + 8 * g + 4 * hi);
            f32x16 acc;
#pragma unroll
            for (int e = 0; e < 16; ++e) acc[e] = 0.f;
#pragma unroll
            for (int kh = 0; kh < 2; ++kh) { bf16x8v ka[4], qb[4];
#pragma unroll
                for (int k4 = 0; k4 < 4; ++k4) { const int ks = 4 * kh + k4; ka[k4] = *(const LAS bf16x8v*)(Ki + img_off(32 * st + r32, 2 * ks + hi)); qb[k4] = *(const LAS bf16x8v*)(Qi + img_off(t, 2 * ks + hi)); }
                SBAR();
#pragma unroll
                for (int k4 = 0; k4 < 4; ++k4) acc = MFMA32(ka[k4], qb[k4], acc);
                SBAR(); }
            float rp = 0.f;
#pragma unroll
            for (int g = 0; g < 4; ++g) { float v[4];
#pragma unroll
                for (int e = 0; e < 4; ++e) { const float x = acc[4 * g + e] * __expf(as4[g][e] - Mt); v[e] = (st == tt && (8 * g + 4 * hi + e) > r32) ? 0.f : x; rp += v[e]; }
                v2u wv; wv.x = cvtpk(v[0], v[1]); wv.y = cvtpk(v[2], v[3]);
                *(LAS v2u*)(L + M2_SC + t * 128 + (((4 * st + g) ^ (t & 7)) << 4) + 8 * hi) = wv; }
            rp = xor32_sum(rp);
            if (hi == 0) DEN[st * 64 + t] = rp;
        } else {
            { const v4u z4 = {0u, 0u, 0u, 0u};
              *(LAS v4u*)(L + M2_SC + r32 * 128 + (((4 + 2 * hi) ^ (r32 & 7)) << 4)) = z4; *(LAS v4u*)(L + M2_SC + r32 * 128 + (((5 + 2 * hi) ^ (r32 & 7)) << 4)) = z4;
              if (hi == 0) DEN[64 + r32] = 0.f; }
            float qn = 0.f;
#pragma unroll 4
            for (int ch = 0; ch < 16; ++ch) { const v4u q8 = *(const LAS v4u*)(Qi + img_off(lc, ch)); const f32x4 n0 = *(const LAS f32x4*)(NV + 8 * ch), n1 = *(const LAS f32x4*)(NV + 8 * ch + 4);
                qn += bflo(q8.x) * n0.x + bfhi(q8.x) * n0.y + bflo(q8.y) * n0.z + bfhi(q8.y) * n0.w + bflo(q8.z) * n1.x + bfhi(q8.z) * n1.y + bflo(q8.w) * n1.z + bfhi(q8.w) * n1.w; }
            QN[lc] = qn;
            const float mxa = fmaxf(mc, SAMX[c]), cs = __expf(mc - mxa); const float wkl = __expf(SA[t0 + lc] - mxa);
            const f32x2v nold = *(const LAS f32x2v*)(NV + 2 * lc); float n0a = 0.f, n1a = 0.f;
#pragma unroll
            for (int s = 0; s < 64; ++s) { const unsigned kk = *(const LAS unsigned*)(Ki + img_off(s, lc >> 2) + (lc & 3) * 4); const float ws = __builtin_bit_cast(float, __builtin_amdgcn_readlane(__builtin_bit_cast(int, wkl), s)); n0a += ws * bflo(kk); n1a += ws * bfhi(kk); }
            LDS_WAIT();
            *(LAS f32x2v*)(NV + 2 * lc) = (f32x2v){cs * nold.x + n0a, cs * nold.y + n1a};
        }
        LBAR();
        if (!isCD) {
            const bf16* ogp = MP_MO + rb * 512 + hh * 128 + 32 * jw + (size_t)(t0 + (lc >> 2)) * 512 + (lc & 3) * 8;
            const unsigned dump = (unsigned)__builtin_amdgcn_readfirstlane((int)((unsigned)(uintptr_t)L + 137344u + (unsigned)jw * 1024u));
#pragma unroll
            for (int i4 = 0; i4 < 4; ++i4) ns3::glds16(ogp + (size_t)(16 * i4) * 512, dump);
        }
        if (isCD) {
#pragma unroll
            for (int ks = 0; ks < 4; ++ks) vfk[ks] = tr32_frag(Vi, lc, jw, ks);
#pragma unroll
            for (int tt = 0; tt < 2; ++tt) { const int t = 32 * tt + r32;
                bf16x8v scf[4];
#pragma unroll
                for (int ks = 0; ks < 4; ++ks) scf[ks] = *(const LAS bf16x8v*)(L + M2_SC + t * 128 + (((2 * ks + hi) ^ (t & 7)) << 4));
                const float pmt = SPM[t0 + t], ft = SF[t0 + t], dnp = DEN[t] + DEN[64 + t], qnt = QN[t];
                f32x16 a1, a2;
#pragma unroll
                for (int e = 0; e < 16; ++e) { a1[e] = 0.f; a2[e] = 0.f; }
#pragma unroll
                for (int kh = 0; kh < 2; ++kh) { v2u ql[4], qh[4];
#pragma unroll
                    for (int k4 = 0; k4 < 4; ++k4) { const int k8 = 4 * kh + k4; ql[k4] = *(const LAS v2u*)(Qi + img_off(t, 2 * k8) + 8 * hi); qh[k4] = *(const LAS v2u*)(Qi + img_off(t, 2 * k8 + 1) + 8 * hi); }
                    SBAR();
                    if (kh == 0) {
#pragma unroll
                        for (int ks = 0; ks < 4; ++ks) a1 = MFMA32(vfk[ks], scf[ks], a1); }
#pragma unroll
                    for (int k4 = 0; k4 < 4; ++k4) { const int k8 = 4 * kh + k4; v4u qq; qq.x = ql[k4].x; qq.y = ql[k4].y; qq.z = qh[k4].x; qq.w = qh[k4].y; a2 = MFMA32(pack8(Cacc[k8 >> 1], k8 & 1), __builtin_bit_cast(bf16x8v, qq), a2); }
                    SBAR(); }
                const float Mt = fmaxf(pmt, mc), wp = __expf(mc - Mt), emt = __expf(-ft - Mt);
                const float idn = __builtin_amdgcn_rcpf(fmaxf(fabsf(dnp + wp * qnt), emt));
                float ss = 0.f;
#pragma unroll
                for (int e = 0; e < 16; ++e) { const float x = (a1[e] + a2[e] * wp) * idn; hv[tt][e] = x; ss += x * x; }
                ss = xor32_sum(ss);
                if (hi == 0) SSQ[((c & 1) * 4 + jw) * 64 + t] = ss;
                SBAR(); }
        }
        if (c + 1 < 32) { LAS unsigned char* Nx = L + M2_IMG + ((c + 1) & 1) * 49152;
            *(LAS v4u*)(Nx + so0) = sq0; *(LAS v4u*)(Nx + so1) = sq1; *(LAS v4u*)(Nx + 16384 + so0) = sk0; *(LAS v4u*)(Nx + 16384 + so1) = sk1; *(LAS v4u*)(Nx + 32768 + so0) = sv0; *(LAS v4u*)(Nx + 32768 + so1) = sv1; }
        LBAR();
    }
    if (isCD) { MLSTM_NORM_STORE(31, (void)0); }
#undef MLSTM_NORM_STORE
#undef MLSTM_STAGE_LOADS
    LBAR();
}

#ifndef MK_MULTI
#define MK_MULTI 0
#endif
#define REP_IF(k) for (int rep_ = 0; rep_ < ((PROBE_DUP == (k)) ? 2 : 1); ++rep_)
constexpr int PH_PER_LAYER = 8, N_PHASES = 1 + DEPTH * PH_PER_LAYER;
struct Args { const float* in[16]; float* out; unsigned char* ws; int ph_lo, ph_hi; };
static_assert(sizeof(Args) == 16 * 8 + 8 + 8 + 8, "Args has no padding");

__global__ void __launch_bounds__(NWAVES * 64, 2) fwd_kernel(Args args) {
    extern __shared__ __attribute__((aligned(16))) unsigned char lds_raw[];
    LAS unsigned char* L = (LAS unsigned char*)lds_raw;
    const int G0 = gridDim.x, blk0 = blockIdx.x;
    const int wave0 = __builtin_amdgcn_readfirstlane((int)threadIdx.x >> 6);
#define PH_IDS() PH_WS(); int wave = wave0; asm volatile("" : "+s"(wave)); const int lane = fresh_lane(), tid = wave * 64 + lane, gw = blk * NWAVES + wave; (void)gw
#define PH_WS() size_t zoff_ = 0; asm volatile("" : "+s"(zoff_)); unsigned char* ws = (unsigned char*)__builtin_assume_aligned(args.ws, 256) + zoff_; int blk = blk0, G = G0; asm volatile("" : "+s"(blk), "+s"(G)); const int NGW = G * NWAVES; (void)NGW; bf16* X16 = (bf16*)(ws + WS_X16); float* SS2 = (float*)(ws + WS_TAB + TAB_SS2); bf16* U = (bf16*)(ws + WS_U); bf16* HB = (bf16*)(ws + WS_HB); bf16* HD = (bf16*)(ws + WS_HD); \
    unsigned char* wl = ws + WS_W; const float* ng = args.in[1] + (size_t)l_ * 6 * DM; (void)X16; (void)SS2; (void)U; (void)HB; (void)HD; (void)wl; (void)ng
    unsigned char* ws0 = args.ws;
    volatile LAS unsigned* MISC = (volatile LAS unsigned*)(L + MISC_OFF);
    { const int tid_e = wave0 * 64 + fresh_lane(); if (tid_e < 16) MISC[tid_e] = 0u; if (tid_e >= 64 && tid_e < 80) MISC[tid_e] = 0u; if (tid_e >= 208 && tid_e < 216) MISC[tid_e] = 0u; if (tid_e >= 144 && tid_e < 158) MISC[tid_e] = 0u; }
    __syncthreads();
    XcdBarrier bar; bar.bar = (unsigned*)(ws0 + WS_CTL) + CW_BAR; bar.x = 0; bar.st = nullptr;
    if (!MK_MULTI) bar = xcd_barrier_post((unsigned*)(ws0 + WS_CTL) + CW_BAR, MISC + 8, wave0 * 64 + fresh_lane() == 0);
#if PROBE_SC >= 6
    if (blk0 == 0 && wave0 * 64 + fresh_lane() == 0) { MISC[159] = (unsigned)__builtin_amdgcn_s_memrealtime(); MISC[158] = MISC[159]; }
#endif
    const int lo = args.ph_lo, hi = args.ph_hi;
#define IN(k) (lo <= (k) && (k) < hi)
#if PROBE_SC == 30 || PROBE_SC == 31
#define SEAM(k) do { const unsigned bt0_ = (unsigned)__builtin_amdgcn_s_memrealtime(); if (IN(k) && IN((k) + 1)) xcd_barrier(bar, wave0 * 64 + fresh_lane() == 0); \
    if (blk0 == PROBE_BLK && wave0 * 64 + fresh_lane() == 0) { const unsigned dt_ = (unsigned)__builtin_amdgcn_s_memrealtime() - bt0_; MISC[150] += dt_; if ((k) == 5) MISC[151] = dt_; if ((k) == 13) MISC[152] = dt_; } } while (0)
#elif PROBE_SC >= 6
#define SEAM(k) do { if (IN(k) && IN((k) + 1)) xcd_barrier(bar, wave0 * 64 + fresh_lane() == 0); \
    if (blk0 == 0 && wave0 * 64 + fresh_lane() == 0) { const unsigned now_ = (unsigned)__builtin_amdgcn_s_memrealtime(); MISC[160 + (k)] = now_ - MISC[159]; MISC[159] = now_; } } while (0)
#else
#define SEAM(k) do { if (IN(k) && IN((k) + 1)) xcd_barrier(bar, wave0 * 64 + fresh_lane() == 0); } while (0)
#endif

    REP_IF(5) {
    if (IN(0)) {
        const int l_ = 0; PH_IDS();
        const float* x_in = args.in[0]; float* b1T = (float*)(ws + WS_TAB + TAB_B1);
#define CONVERT_WEIGHTS(lw, GM) do { LAS float* scr = (LAS float*)(L + wave * 16384); const float* ngw = args.in[1] + (size_t)(lw) * 6 * DM; \
        constexpr int I_GU = 16 * 176, I_DN = 44 * 32, I_IN = 16 * 112, I_OUT = 16 * 32, I_CMP = 16 * 16, I_LAYER = 2 * I_GU + 2 * I_DN + I_IN + I_OUT + I_CMP; \
        for (int it = gw; it < I_LAYER; it += NGW) { int r = it; unsigned char* wlw = ws + WS_W; \
            if (r < I_GU) { if ((GM) & 1) { SrcGU s{args.in[2] + (size_t)(lw) * DM * NGU, ngw + 0 * DM}; transpose_item(s, DM, (bf16*)(wlw + WO_GU1), scr, r / 176, r % 176, lane); } continue; } r -= I_GU; \
            if (r < I_DN) { if ((GM) & 2) { SrcPlain s{args.in[3] + (size_t)(lw) * FF * DM, DM, nullptr}; transpose_item(s, FF, (bf16*)(wlw + WO_DN1), scr, r / 32, r % 32, lane); } continue; } r -= I_DN; \
            if (r < I_GU) { if ((GM) & 4) { SrcGU s{args.in[4] + (size_t)(lw) * DM * NGU, ngw + 4 * DM}; transpose_item(s, DM, (bf16*)(wlw + WO_GU2), scr, r / 176, r % 176, lane); } continue; } r -= I_GU; \
            if (r < I_DN) { if ((GM) & 8) { SrcPlain s{args.in[5] + (size_t)(lw) * FF * DM, DM, nullptr}; transpose_item(s, FF, (bf16*)(wlw + WO_DN2), scr, r / 32, r % 32, lane); } continue; } r -= I_DN; \
            if (r < I_IN) { if ((GM) & 16) { SrcIN s{args.in[6] + (size_t)(lw) * DM * INCOLS, ngw + 2 * DM}; transpose_item(s, DM, (bf16*)(wlw + WO_IN), scr, r / 112, r % 112, lane); } continue; } r -= I_IN; \
            if (r < I_OUT) { if ((GM) & 32) { SrcPlain s{args.in[7] + (size_t)(lw) * DM * DM, DM, nullptr}; transpose_item(s, DM, (bf16*)(wlw + WO_OUT), scr, r / 32, r % 32, lane); } continue; } r -= I_OUT; \
            if ((GM) & 64) { SrcCMP s{args.in[9] + (size_t)(lw) * 2 * 2048 * 128, nullptr}; transpose_item(s, DM, (bf16*)(ws + WS_CMPW + (size_t)(lw) * MiB), scr, r / 16, r % 16, lane); } } } while (0)
        CONVERT_WEIGHTS(0, 0x7f);
        if (DEPTH > 1) CONVERT_WEIGHTS(1, 0x40);
        { bf16* w2t = (bf16*)(ws + WS_TAB + TAB_W2T);
          for (int i = blk * 512 + tid; i < DEPTH * 2 * 64 * 128; i += G * 512) { const int lk = i >> 13, o = (i >> 7) & 63, kk = i & 127; w2t[i] = (bf16)f2bf(args.in[10][((size_t)lk * 128 + kk) * 64 + o]); } }
        { LAS float* part = (LAS float*)(L + 131072);
          for (int ob = blk; ob < DEPTH * 2 * 128 / 2; ob += G) { const int o = 2 * ob + (wave >> 2), qr = wave & 3; const int lk = o >> 7, c = o & 127;
              const float* pe = args.in[8] + (size_t)lk * 2048; const float* w1 = args.in[9] + (size_t)lk * 2048 * 128;
              float s = 0.f; for (int r = qr * 512 + lane; r < qr * 512 + 512; r += 64) s += pe[r] * w1[(size_t)r * 128 + c];
              s = wave_sum(s, lane); if (lane == 0) part[wave] = s;
              __syncthreads();
              if (lane == 0 && qr == 0) b1T[o] = (part[wave] + part[wave + 1]) + (part[wave + 2] + part[wave + 3]);
              __syncthreads(); } }
        thin_phase<0>(nullptr, x_in, X16, nullptr, SS2, nullptr, 0.f, gw, NGW, lane);
    }
    SEAM(0);
    }

#pragma unroll 1
    for (int l = 0; l < DEPTH; ++l) {
        const int pb = 1 + l * PH_PER_LAYER, l_ = l;
        REP_IF(1) {
        if (IN(pb + 0)) { PH_IDS(); pg8::Gemm g{X16, (const bf16*)(wl + WO_GU1), MTOK, NGU, DM}; pg8::StaticOrder S; S.init(MTOK, NGU, G, blk); EpiSwiglu E{HB, SS2, L + 131072};
#if PROBE_SC == 1 || PROBE_SC == 2
            if (l_ == 0) pg8::gemm_phase<EpiSwiglu, pg8::StaticOrder, true, true, 1>(L, g, S, E, tid); else
#endif
#if PROBE_SC >= 3
            const unsigned long long pt0 = __builtin_amdgcn_s_memrealtime();
#endif
            pg8::gemm_phase<EpiSwiglu, pg8::StaticOrder, GU_ALIGN, true>(L, g, S, E, tid);
#if PROBE_SC == 3
            if (l_ == 0 && tid == 0) { MISC[64] = (unsigned)(__builtin_amdgcn_s_memrealtime() - pt0); }
#endif
#if PROBE_SC == 4 || PROBE_SC == 5
            if (l_ == 0 && tid == 0) { const unsigned sp = (unsigned)(__builtin_amdgcn_s_memrealtime() - pt0); atomicMax((unsigned*)(ws + WS_CTL) + 33024, (sp << 8) | (unsigned)blk); }
#endif
            }
        SEAM(pb + 0);
        }
        if (IN(pb + 1)) { PH_IDS(); pg8::Gemm g{HB, (const bf16*)(wl + WO_DN1), MTOK, DM, FF}; pg8::StaticOrder S; S.init(MTOK, DM, G, blk);
            EpiResNorm<false> E{ws, (LAS float*)(L + 131072), ng + 1 * DM, nullptr, 0.5f, l_ * 3 + 0};
#if PROBE_SC == 21
            const unsigned pt1 = (unsigned)__builtin_amdgcn_s_memrealtime();
            if (l_ == 0) pg8::gemm_phase<EpiResNorm<false>, pg8::StaticOrder, true, true, 1>(L, g, S, E, tid); else
#endif
            pg8::gemm_phase<EpiResNorm<false>, pg8::StaticOrder, true, true>(L, g, S, E, tid);
#if PROBE_SC == 21
            if (l_ == 0 && tid == 0) MISC[66] = (unsigned)__builtin_amdgcn_s_memrealtime() - pt1;
#endif
            }
        SEAM(pb + 1);
        REP_IF(3) {
        if (IN(pb + 2)) { PH_IDS(); pg8::Gemm g{X16, (const bf16*)(wl + WO_IN), MTOK, NINP, DM}; pg8::StaticOrder S; S.init(MTOK, NINP, G, blk);
            EpiInProj E{ws, L + 131072};
#if PROBE_SC == 23
            const unsigned pt1 = (unsigned)__builtin_amdgcn_s_memrealtime();
            if (l_ == 0) pg8::gemm_phase<EpiInProj, pg8::StaticOrder, true, true, 1>(L, g, S, E, tid); else
#endif
            pg8::gemm_phase<EpiInProj, pg8::StaticOrder, true, true>(L, g, S, E, tid);
#if PROBE_SC == 23
            if (l_ == 0 && tid == 0) MISC[66] = (unsigned)__builtin_amdgcn_s_memrealtime() - pt1;
#endif
            }
        SEAM(pb + 2);
        }
        if (IN(pb + 4)) {
            PH_IDS();
            MixPtrs P{ws, args.in[11] + (size_t)l * 4 * 1024, args.in[12] + (size_t)l * 1024, args.in[13] + l * 4, args.in[14] + l * 4, args.in[15] + l * 512};
            unsigned* cflag = (unsigned*)(ws + WS_CTL) + CW_CFLAG + 1024 * l_;
            if (blk < 64 || blk >= 96) {
                const int cb = blk < 64 ? blk : blk - 32;
                mlstm_conv_pass(ws, P.conv_w, P.conv_b, cb * 512 + tid, 224 * 512);
                asm volatile("s_waitcnt vmcnt(0)" ::: "memory"); __syncthreads();
                if (tid == 0) { __builtin_amdgcn_fence(__ATOMIC_RELEASE, "agent"); asm volatile("s_waitcnt vmcnt(0)" ::: "memory");
                    (void)__hip_atomic_fetch_add(cflag + 64 * 15 + 32, 1u, __ATOMIC_RELAXED, __HIP_MEMORY_SCOPE_AGENT); }
            }
            if (blk < 64) {
                if (tid == 0) { unsigned sp = 0u; while (__hip_atomic_load(cflag + 64 * 15 + 32, __ATOMIC_RELAXED, __HIP_MEMORY_SCOPE_AGENT) < 224u) { __builtin_amdgcn_s_sleep(4); if (++sp > (1u << 17)) break; } }
                __syncthreads();
                __builtin_amdgcn_fence(__ATOMIC_ACQUIRE, "agent"); asm volatile("s_waitcnt vmcnt(0)" ::: "memory");
#if PROBE_SC == 20
                const unsigned mt0_ = (unsigned)__builtin_amdgcn_s_memrealtime();
#endif
                mlstm_unit_v3(L, P, blk >> 2, blk & 3, tid);
#if PROBE_SC == 20
                if (l_ == 0 && blk == 0 && tid == 0) MISC[200] = (unsigned)__builtin_amdgcn_s_memrealtime() - mt0_;
#endif
            } else if (blk < 96) {
                pg8::Gemm g{(const bf16*)(ws + WS_KCR), (const bf16*)(ws + WS_CMPW + (size_t)l_ * MiB), 8192, 512, DM}; CmpOrder S{blk - 64, G};
                EpiCmpMlp E{ws, (const float*)(ws + WS_TAB + TAB_B1) + l_ * 2 * 128, (const bf16*)(ws + WS_TAB + TAB_W2T) + (size_t)l_ * 2 * 64 * 128};
                pg8::gemm_phase<EpiCmpMlp, CmpOrder, false, true>(L, g, S, E, tid);
                asm volatile("s_waitcnt vmcnt(0)" ::: "memory"); __syncthreads();
                if (tid == 0) { __builtin_amdgcn_fence(__ATOMIC_RELEASE, "agent"); asm volatile("s_waitcnt vmcnt(0)" ::: "memory");
                    (void)__hip_atomic_fetch_add(cflag + 64 * ((blk - 64) & 15), 1u, __ATOMIC_RELAXED, __HIP_MEMORY_SCOPE_AGENT); }
            } else {
                const int gw = (blk - 96) * NWAVES + wave, NGW = (G - 96) * NWAVES;
                if (l_ == 0) { if (DEPTH > 1) CONVERT_WEIGHTS(1, 0x13); } else CONVERT_WEIGHTS(l_, 0x2c);
            }
            { unsigned* qbase = (unsigned*)(ws + WS_CTL) + CW_QUEUE + 1024 * l_; volatile LAS unsigned* QW = (volatile LAS unsigned*)(L + MISC_OFF);
              const unsigned q0 = xb_xcc_id() & 7u; unsigned rdy = 0u;
#pragma unroll 1
              for (unsigned qq = 0; qq < 8u; ++qq) { unsigned* qctr = qbase + 64 * ((q0 + qq) & 7u); const int bg0 = 4 * (int)((q0 + qq) & 7u);
                  __syncthreads();
                  if (tid == 0) QW[0] = __hip_atomic_fetch_add(qctr, 1u, __ATOMIC_RELAXED, __HIP_MEMORY_SCOPE_AGENT);
                  __syncthreads();
                  unsigned u = QW[0];
                  while (u < 128u) { unsigned nxt = 0u; if (tid == 0) nxt = __hip_atomic_fetch_add(qctr, 1u, __ATOMIC_RELAXED, __HIP_MEMORY_SCOPE_AGENT);
                      const int c = 31 - (int)(u >> 2), bg = bg0 + (int)(u & 3u);
                      if (!((rdy >> (bg >> 1)) & 1u)) {
                          if (tid == 0) { unsigned sp = 0u; while (__hip_atomic_load(cflag + 64 * (bg >> 1), __ATOMIC_RELAXED, __HIP_MEMORY_SCOPE_AGENT) < 2u) { __builtin_amdgcn_s_sleep(4); if (++sp > (1u << 17)) break; } }
                          __syncthreads();
                          __builtin_amdgcn_fence(__ATOMIC_ACQUIRE, "agent"); asm volatile("s_waitcnt vmcnt(0)" ::: "memory");
                          rdy |= 1u << (bg >> 1); }
#if PROBE_SC == 22
                      const unsigned ut0_ = (unsigned)__builtin_amdgcn_s_memrealtime();
#endif
                      nsa_unit_v3(L, P, bg >> 1, bg & 1, c, tid);
#if PROBE_SC == 22
                      if (tid == 0) { MISC[212] += (unsigned)__builtin_amdgcn_s_memrealtime() - ut0_; MISC[213] += 1u; }
#endif
                      __syncthreads(); if (tid == 0) QW[0] = nxt; __syncthreads(); u = QW[0]; } } }
        }
#if PROBE_SC == 22
        if (l == 0 && blk0 == 255 && wave0 * 64 + fresh_lane() == 0) { unsigned* pw_ = (unsigned*)(ws0 + WS_CTL) + 33100;
            for (int i_ = 0; i_ < 4; ++i_) __hip_atomic_store(pw_ + i_, MISC[210 + i_], __ATOMIC_RELAXED, __HIP_MEMORY_SCOPE_AGENT); }
#endif
        SEAM(pb + 4);
        if (IN(pb + 5)) { PH_IDS(); pg8::Gemm g{U, (const bf16*)(wl + WO_OUT), MTOK, DM, DM}; pg8::StaticOrder S; S.init(MTOK, DM, G, blk);
            EpiResNorm<false> E{ws, (LAS float*)(L + 131072), ng + 3 * DM, nullptr, 1.0f, l_ * 3 + 1};
            pg8::gemm_phase<EpiResNorm<false>, pg8::StaticOrder, true, true>(L, g, S, E, tid); }
        SEAM(pb + 5);
        if (IN(pb + 6)) { PH_IDS(); pg8::Gemm g{X16, (const bf16*)(wl + WO_GU2), MTOK, NGU, DM}; pg8::StaticOrder S; S.init(MTOK, NGU, G, blk); EpiSwiglu E{HB, SS2, L + 131072};
            pg8::gemm_phase<EpiSwiglu, pg8::StaticOrder, GU_ALIGN, true>(L, g, S, E, tid); }
        SEAM(pb + 6);
        if (IN(pb + 7)) { PH_IDS(); pg8::Gemm g{HB, (const bf16*)(wl + WO_DN2), MTOK, DM, FF}; pg8::StaticOrder S; S.init(MTOK, DM, G, blk);
            if (l + 1 < DEPTH) { EpiResNorm<false> E{ws, (LAS float*)(L + 131072), ng + 5 * DM, nullptr, 0.5f, l_ * 3 + 2};
                pg8::gemm_phase<EpiResNorm<false>, pg8::StaticOrder, true, true>(L, g, S, E, tid); }
#if FINAL_FUSED
            else { EpiResNorm<true> E{ws, (LAS float*)(L + 131072), ng + 5 * DM, args.out, 0.5f, l_ * 3 + 2};
                pg8::gemm_phase<EpiResNorm<true>, pg8::StaticOrder, true, true>(L, g, S, E, tid); } }
        if (l + 1 < DEPTH) SEAM(pb + 7);
#else
            else { pg8::EpiBf16<0> E{HD, DM, nullptr, 0, 0, 1.f};
                pg8::gemm_phase<pg8::EpiBf16<0>, pg8::StaticOrder, true, true>(L, g, S, E, tid); } }
        if (l + 1 < DEPTH) SEAM(pb + 7);
        else { xcd_barrier(bar, wave0 * 64 + fresh_lane() == 0);
            if (IN(pb + 7)) { PH_IDS(); thin_phase<2>(HD, nullptr, X16, args.out, nullptr, ng + 5 * DM, 0.5f, gw, NGW, lane); } }
#endif
    }
#if PROBE_SC == 30 || PROBE_SC == 31
    if (blk0 == PROBE_BLK && wave0 * 64 + fresh_lane() == 0) { __hip_atomic_store((unsigned*)(args.ws + WS_CTL) + 33101, MISC[151], __ATOMIC_RELAXED, __HIP_MEMORY_SCOPE_AGENT); __hip_atomic_store((unsigned*)(args.ws + WS_CTL) + 33102, MISC[152], __ATOMIC_RELAXED, __HIP_MEMORY_SCOPE_AGENT);
        __hip_atomic_store((unsigned*)(args.ws + WS_CTL) + 33100, MISC[150], __ATOMIC_RELAXED, __HIP_MEMORY_SCOPE_AGENT); }
    if (blk0 == 0 && wave0 * 64 + fresh_lane() == 0) { unsigned sp_ = 0u; while (__hip_atomic_load((unsigned*)(args.ws + WS_CTL) + 33100, __ATOMIC_RELAXED, __HIP_MEMORY_SCOPE_AGENT) == 0u && ++sp_ < (1u << 20)) __builtin_amdgcn_s_sleep(8); }
#endif
#if PROBE_SC
    if (blk0 == 0 && wave0 * 64 + fresh_lane() == 0) {
        unsigned tk = MISC[64], cy = MISC[65];
        if (PROBE_SC == 4 || PROBE_SC == 5) { const unsigned pk = __hip_atomic_load((unsigned*)(args.ws + WS_CTL) + 33024, __ATOMIC_RELAXED, __HIP_MEMORY_SCOPE_AGENT); tk = (PROBE_SC == 4) ? (pk >> 8) : (pk & 255u) * 100u; }
#if PROBE_SC >= 6
        { const unsigned now_ = (unsigned)__builtin_amdgcn_s_memrealtime(); MISC[160 + 16] = now_ - MISC[159]; }
#define D_(k) MISC[160 + (k)]
        unsigned A_ = 0, B_ = 0;
        if (PROBE_SC == 6) { A_ = D_(0); B_ = D_(4) + D_(12); }
        if (PROBE_SC == 7) { A_ = D_(2) + D_(10); B_ = D_(3) + D_(11); }
        if (PROBE_SC == 8) { A_ = (D_(5) + D_(13)) / 2; B_ = D_(6) + D_(14); }
        if (PROBE_SC == 9) { A_ = (D_(7) + D_(15)) / 2; B_ = D_(8) + D_(16); }
        if (PROBE_SC == 10) { A_ = D_(1); B_ = D_(9); }
        if (PROBE_SC == 22) { const unsigned* pw_ = (const unsigned*)(args.ws + WS_CTL) + 33100; unsigned v_[4]; for (int i_ = 0; i_ < 4; ++i_) v_[i_] = __hip_atomic_load(pw_ + i_, __ATOMIC_RELAXED, __HIP_MEMORY_SCOPE_AGENT);
            A_ = (v_[1] ? (v_[0] * 50u) / v_[1] : 0u) * 4u;
            B_ = (v_[3] ? ((v_[2] - v_[0]) * 4u) / v_[3] : 0u) * 4u; }
        if (PROBE_SC == 31) { A_ = __hip_atomic_load((const unsigned*)(args.ws + WS_CTL) + 33101, __ATOMIC_RELAXED, __HIP_MEMORY_SCOPE_AGENT); B_ = __hip_atomic_load((const unsigned*)(args.ws + WS_CTL) + 33102, __ATOMIC_RELAXED, __HIP_MEMORY_SCOPE_AGENT); }
        if (PROBE_SC == 30) { const unsigned v_ = __hip_atomic_load((const unsigned*)(args.ws + WS_CTL) + 33100, __ATOMIC_RELAXED, __HIP_MEMORY_SCOPE_AGENT); A_ = v_; B_ = 0u; }
        if (PROBE_SC == 23) { A_ = MISC[64]; B_ = MISC[66]; }
        if (PROBE_SC == 21) { A_ = MISC[64]; B_ = MISC[66]; }
        if (PROBE_SC == 20) { A_ = MISC[200]; B_ = 0u; }
        if (PROBE_SC == 15) { A_ = D_(3); B_ = D_(11); }
        if (PROBE_SC == 16) { A_ = D_(4); B_ = D_(12); }
        if (PROBE_SC == 17) { A_ = D_(2); B_ = D_(10); }
        if (PROBE_SC == 11) { A_ = D_(8); B_ = D_(16); }
        if (PROBE_SC == 12) { A_ = D_(7); B_ = D_(15); }
        if (PROBE_SC == 13) { A_ = D_(6); B_ = D_(14); }
        if (PROBE_SC == 14) { A_ = D_(5); B_ = D_(13); }
        { unsigned aq = (A_ + 200u) / 400u, bq = (B_ + 200u) / 400u; if (aq > 127u) aq = 127u; if (bq > 127u) bq = 127u; tk = (aq * 128u + bq) * 100u; }
#endif
        const unsigned long long delay = (PROBE_SC != 2) ? (unsigned long long)tk * 10ull : ((unsigned long long)cy * 10000ull) / (tk ? tk : 1u);
#if PROBE_SC >= 6
        while ((unsigned)__builtin_amdgcn_s_memrealtime() - MISC[158] < 500000u + (unsigned)delay) __builtin_amdgcn_s_sleep(8);
#else
        const unsigned long long t0 = __builtin_amdgcn_s_memrealtime();
        while (__builtin_amdgcn_s_memrealtime() - t0 < delay) __builtin_amdgcn_s_sleep(8);
#endif
    }
#endif
#undef IN
#undef SEAM
#undef CONVERT_WEIGHTS
#undef PH_IDS
#undef PH_WS
}

extern "C" void kernel_launch(void* const* d_in, const int* in_sizes, int n_in, void* d_out, int out_size, void* d_ws, size_t ws_size, hipStream_t stream) {
    static int grid = 0;
    if (grid == 0) {
        if (n_in != 16 || in_sizes[0] != MTOK * DM || out_size != MTOK * DM || ws_size < WS_END3) { fprintf(stderr, "kernel_launch: unexpected problem (n_in %d, ws %zu)\n", n_in, ws_size); grid = -1; return; }
        int dev = 0, cus = 0, per_cu = 0;
        if (hipGetDevice(&dev) != hipSuccess || hipDeviceGetAttribute(&cus, hipDeviceAttributeMultiprocessorCount, dev) != hipSuccess) { grid = -1; return; }
        if (hipFuncSetAttribute((const void*)fwd_kernel, hipFuncAttributeMaxDynamicSharedMemorySize, LDS_BYTES) != hipSuccess) { grid = -1; return; }
        if (hipOccupancyMaxActiveBlocksPerMultiprocessor(&per_cu, (const void*)fwd_kernel, NWAVES * 64, LDS_BYTES) != hipSuccess || per_cu < 1) { fprintf(stderr, "kernel_launch: occupancy query says %d\n", per_cu); }
        (void)hipGetLastError();
        grid = cus;
        if (grid != 256) { fprintf(stderr, "kernel_launch: %d CUs (the row-group exchange of the fused post-norm epilogues assumes 256 workgroups: 4 column tiles of a token tile in one round)\n", grid); grid = -1; return; }
    }
    if (grid < 0) return;
    (void)hipMemsetAsync((char*)d_ws + WS_CTL, 0, CTL_ZERO_BYTES, stream);
    Args a{};
    for (int i = 0; i < 16; ++i) a.in[i] = (const float*)d_in[i];
    a.out = (float*)d_out; a.ws = (unsigned char*)d_ws;
#if MK_MULTI
    for (int p = 0; p < N_PHASES; ++p) { a.ph_lo = p; a.ph_hi = p + 1; hipLaunchKernelGGL(fwd_kernel, dim3(grid), dim3(NWAVES * 64), LDS_BYTES, stream, a); }
#else
    a.ph_lo = 0; a.ph_hi = N_PHASES; hipLaunchKernelGGL(fwd_kernel, dim3(grid), dim3(NWAVES * 64), LDS_BYTES, stream, a);
#endif
}
```
